# Optimizing an MI355X kernel written in HIP

```python
import jax
import jax.numpy as jnp
from jax import lax


D_MODEL = 1024
BATCH = 2
SEQ = 8192
DEPTH = 2

GRID_W = 64
CTX_LEN = 256
NORM_EPS = 1e-6
GLA_HEADS = 4
GLA_DK = 64
GLA_DV = 128
GLA_KW = GLA_HEADS * GLA_DK
GLA_WIDTH = GLA_HEADS * GLA_DV
GLA_GATE_RANK = 16
GLA_TAU = 16.0
GLA_CHUNK = 64
SWA_HEADS = 8
SWA_KV_HEADS = 2
SWA_GROUP = SWA_HEADS // SWA_KV_HEADS
SWA_HD = 64
SWA_WIDTH = SWA_HEADS * SWA_HD
SWA_KVW = SWA_KV_HEADS * SWA_HD
WINDOW = 128
ATT_BLOCK = 128
ROPE_THETA = 10000.0
ROPE_AXIS_DIM = SWA_HD // 2
MIX_WIDTH = GLA_WIDTH + SWA_WIDTH
N_EXPERTS = 16
N_GROUPS = 4
EXPERTS_PER_GROUP = N_EXPERTS // N_GROUPS
TOP_K = 2
D_EXPERT = 512
MOE_BLOCK = 256
IN_SIZES = (GLA_KW, GLA_KW, GLA_WIDTH, GLA_WIDTH, GLA_GATE_RANK, GLA_GATE_RANK, SWA_WIDTH, SWA_KVW, SWA_KVW)
IN_COLS = sum(IN_SIZES)

kernel_name = 'hybrid_gla_swa_moe_dit_block'


def rmsnorm(x, g):
    xf = x.astype(jnp.float32)
    y = xf * lax.rsqrt(jnp.mean(xf * xf, axis=-1, keepdims=True) + NORM_EPS)
    return (y * g.astype(jnp.float32)).astype(x.dtype)


def split_in_proj(p):
    points, acc = [], 0
    for s in IN_SIZES[:-1]:
        acc += s
        points.append(acc)
    return jnp.split(p, points, axis=-1)


def axial_rope_tables(n_tok):
    rows = n_tok // GRID_W
    row = jnp.repeat(jnp.arange(rows, dtype=jnp.float32), GRID_W)
    col = jnp.tile(jnp.arange(GRID_W, dtype=jnp.float32), rows)
    n_freq = ROPE_AXIS_DIM // 2
    inv = ROPE_THETA ** (-(jnp.arange(n_freq, dtype=jnp.float32) * 2.0 / ROPE_AXIS_DIM))
    ang_r = row[:, None] * inv[None, :]
    ang_c = col[:, None] * inv[None, :]
    return (jnp.cos(ang_r), jnp.sin(ang_r), jnp.cos(ang_c), jnp.sin(ang_c))


def rotate_half(x, cos, sin):
    x1, x2 = jnp.split(x, 2, axis=-1)
    return jnp.concatenate([x1 * cos - x2 * sin, x2 * cos + x1 * sin], axis=-1)


def apply_axial_rope(x, tabs):
    shape = (1, x.shape[1]) + (1,) * (x.ndim - 3) + (ROPE_AXIS_DIM // 2,)
    cr, sr, cc, sc = [t.reshape(shape).astype(x.dtype) for t in tabs]
    x_row, x_col = jnp.split(x, 2, axis=-1)
    return jnp.concatenate([rotate_half(x_row, cr, sr), rotate_half(x_col, cc, sc)], axis=-1)


def gla_chunked(q, k, v, log_a, s0):
    B, H, L, dk = q.shape
    dv = v.shape[-1]
    C = GLA_CHUNK
    N = L // C
    q = q.reshape(B, H, N, C, dk)
    k = k.reshape(B, H, N, C, dk)
    v = v.reshape(B, H, N, C, dv)
    b = jnp.cumsum(log_a.reshape(B, H, N, C, dk), axis=3)
    b_last = b[:, :, :, -1:, :]
    q_in = q * jnp.exp(b)
    k_in = k * jnp.exp(-b)
    k_out = k * jnp.exp(b_last - b)
    causal_in_chunk = jnp.tril(jnp.ones((C, C), dtype=bool))
    A = jnp.where(causal_in_chunk, jnp.einsum('bhncd,bhnsd->bhncs', q_in, k_in), 0.0)
    o_intra = jnp.einsum('bhncs,bhnse->bhnce', A, v)
    U = jnp.einsum('bhncd,bhnce->bhnde', k_out, v)
    dec = jnp.exp(b_last[:, :, :, 0, :])

    def step(S, inp):
        u, d = inp
        return d[..., None] * S + u, S

    s_final, s_prev = lax.scan(step, s0, (jnp.moveaxis(U, 2, 0), jnp.moveaxis(dec, 2, 0)))
    s_prev = jnp.moveaxis(s_prev, 0, 2)
    o_inter = jnp.einsum('bhncd,bhnde->bhnce', q_in, s_prev)
    return (o_intra + o_inter).reshape(B, H, L, dv), s_final


def gla_heads(q, k, v, z_f, z_b, up_f, bias_f, up_b, bias_b):
    B, L, _ = q.shape

    def heads(t, d):
        return t.reshape(B, L, GLA_HEADS, d).transpose(0, 2, 1, 3).astype(jnp.float32)

    log_a_f = jax.nn.log_sigmoid((z_f @ up_f + bias_f).astype(jnp.float32)) / GLA_TAU
    log_a_b = jax.nn.log_sigmoid((z_b @ up_b + bias_b).astype(jnp.float32)) / GLA_TAU
    return (heads(q, GLA_DK) * GLA_DK ** -0.5, heads(k, GLA_DK), heads(v, GLA_DV),
            heads(log_a_f, GLA_DK), heads(log_a_b, GLA_DK))


def gla_bidir(q, k, v, la_f, la_b, s_f0, s_b0):
    o_f, s_f = gla_chunked(q, k, v, la_f, s_f0)
    fl = lambda t: jnp.flip(t, axis=2)
    o_b, s_b = gla_chunked(fl(q), fl(k), fl(v), fl(la_b), s_b0)
    return o_f + fl(o_b), s_f, s_b


def gla_output(o, gate, norm_g):
    B, H, L, dv = o.shape
    o = o * lax.rsqrt(jnp.mean(o * o, axis=-1, keepdims=True) + NORM_EPS)
    o = o.transpose(0, 2, 1, 3).reshape(B, L, H * dv) * norm_g.astype(jnp.float32)
    return o.astype(gate.dtype) * jax.nn.silu(gate)


def swa_latent(q, k, v, kc, vc, sink):
    B, L, KV, G, hd = q.shape
    W = ATT_BLOCK
    N = L // W
    scale = hd ** -0.5
    qb = q.reshape(B, N, W, KV, G, hd)
    pad = ((0, 0), (W, W), (0, 0), (0, 0))
    kp = jnp.pad(k, pad).reshape(B, N + 2, W, KV, hd)
    vp = jnp.pad(v, pad).reshape(B, N + 2, W, KV, hd)
    kb = jnp.concatenate([kp[:, :-2], kp[:, 1:-1], kp[:, 2:]], axis=2)
    vb = jnp.concatenate([vp[:, :-2], vp[:, 1:-1], vp[:, 2:]], axis=2)
    qpos = jnp.arange(N)[:, None, None] * W + jnp.arange(W)[None, :, None]
    kpos = jnp.arange(N)[:, None, None] * W - W + jnp.arange(3 * W)[None, None, :]
    valid = (jnp.abs(kpos - qpos) <= WINDOW) & (kpos >= 0) & (kpos < L)
    s_loc = jnp.einsum('bnqhgd,bnkhd->bhgnqk', qb, kb).astype(jnp.float32) * scale
    s_loc = jnp.where(valid, s_loc, -jnp.inf)
    s_ctx = jnp.einsum('bnqhgd,bkhd->bhgnqk', qb, kc).astype(jnp.float32) * scale
    sk = sink.reshape(KV, G)[None, :, :, None, None, None].astype(jnp.float32)
    m = jnp.maximum(jnp.maximum(s_loc.max(-1, keepdims=True), s_ctx.max(-1, keepdims=True)), sk)
    p_loc = jnp.exp(s_loc - m)
    p_ctx = jnp.exp(s_ctx - m)
    denom = p_loc.sum(-1, keepdims=True) + p_ctx.sum(-1, keepdims=True) + jnp.exp(sk - m)
    o = (jnp.einsum('bhgnqk,bnkhd->bnqhgd', p_loc, vb.astype(jnp.float32))
         + jnp.einsum('bhgnqk,bkhd->bnqhgd', p_ctx, vc.astype(jnp.float32)))
    o = o / denom.transpose(0, 3, 4, 1, 2, 5)
    return o.reshape(B, L, KV * G * hd).astype(v.dtype)


def swa_context(q, k, v, sink):
    B, Lc, KV, G, hd = q.shape
    s = jnp.einsum('bqhgd,bkhd->bhgqk', q, k).astype(jnp.float32) * hd ** -0.5
    sk = sink.reshape(KV, G)[None, :, :, None, None].astype(jnp.float32)
    m = jnp.maximum(s.max(-1, keepdims=True), sk)
    p = jnp.exp(s - m)
    p = p / (p.sum(-1, keepdims=True) + jnp.exp(sk - m))
    o = jnp.einsum('bhgqk,bkhd->bqhgd', p, v.astype(jnp.float32))
    return o.reshape(B, Lc, KV * G * hd).astype(v.dtype)


def moe(h, w_router, b_router, w_gate, w_up, w_down):
    T, D = h.shape
    s = jax.nn.sigmoid((h @ w_router).astype(jnp.float32))
    sb = s + b_router.astype(jnp.float32)
    g_score = lax.top_k(sb.reshape(T, N_GROUPS, EXPERTS_PER_GROUP), 2)[0].sum(-1)
    g_sel = jnp.argmax(g_score, axis=-1)
    in_group = (jnp.arange(N_EXPERTS) // EXPERTS_PER_GROUP)[None, :] == g_sel[:, None]
    _, idx = lax.top_k(jnp.where(in_group, sb, -jnp.inf), TOP_K)
    w_sel = jnp.take_along_axis(s, idx, axis=-1)
    w_sel = w_sel / w_sel.sum(-1, keepdims=True)
    M = MOE_BLOCK
    A = T * TOP_K
    e_flat = idx.reshape(A)
    tok_flat = jnp.repeat(jnp.arange(T), TOP_K)
    w_flat = w_sel.reshape(A)
    order = jnp.argsort(e_flat)
    e_s, tok_s, w_s = e_flat[order], tok_flat[order], w_flat[order]
    counts = jnp.bincount(e_flat, length=N_EXPERTS)
    padded = ((counts + M - 1) // M) * M
    pend = jnp.cumsum(padded)
    pstart = pend - padded
    ustart = jnp.cumsum(counts) - counts
    dest = pstart[e_s] + jnp.arange(A) - ustart[e_s]
    n_blocks = -(-A // M) + N_EXPERTS
    P = n_blocks * M
    row_tok = jnp.full((P,), T, dtype=jnp.int32).at[dest].set(tok_s.astype(jnp.int32))
    row_w = jnp.zeros((P,), jnp.float32).at[dest].set(w_s)
    block_e = jnp.minimum(jnp.searchsorted(pend, jnp.arange(n_blocks) * M, side='right'), N_EXPERTS - 1)
    h_pad = jnp.concatenate([h, jnp.zeros((1, D), h.dtype)], axis=0)
    xb = h_pad[row_tok].reshape(n_blocks, M, D)

    def expert_block(args):
        xblk, e = args
        return (jax.nn.silu(xblk @ w_gate[e]) * (xblk @ w_up[e])) @ w_down[e]

    yb = lax.map(expert_block, (xb, block_e)).reshape(P, D)
    y = jax.ops.segment_sum(yb.astype(jnp.float32) * row_w[:, None], row_tok, num_segments=T + 1)[:T]
    return y.astype(h.dtype)


def setup_inputs(seed: int = 0) -> dict:
    key = jax.random.key(seed)
    ks = jax.random.split(key, 24)
    f32 = jnp.float32
    D = D_MODEL

    def nrm(k, shape, s):
        return jax.random.normal(k, shape, f32) * s

    return {
        'x': nrm(ks[0], (BATCH, SEQ, D), 1.0),
        'c': nrm(ks[1], (BATCH, D), 1.0),
        'ctx': nrm(ks[2], (BATCH, CTX_LEN, D), 1.0),
        'c_ctx': nrm(ks[3], (D,), 1.0),
        'w_ada': nrm(ks[4], (DEPTH, D, 6 * D), 0.5 * D ** -0.5),
        'b_ada': nrm(ks[5], (DEPTH, 6 * D), 0.02),
        'norm1': 1.0 + nrm(ks[6], (DEPTH, D), 0.02),
        'norm2': 1.0 + nrm(ks[7], (DEPTH, D), 0.02),
        'w_in': nrm(ks[8], (DEPTH, D, IN_COLS), D ** -0.5),
        'gla_up_f': nrm(ks[9], (DEPTH, GLA_GATE_RANK, GLA_KW), GLA_GATE_RANK ** -0.5),
        'gla_bias_f': nrm(ks[10], (DEPTH, GLA_KW), 0.1),
        'gla_up_b': nrm(ks[11], (DEPTH, GLA_GATE_RANK, GLA_KW), GLA_GATE_RANK ** -0.5),
        'gla_bias_b': nrm(ks[12], (DEPTH, GLA_KW), 0.1),
        'gla_norm': 1.0 + nrm(ks[13], (DEPTH, GLA_WIDTH), 0.02),
        'swa_sink': nrm(ks[14], (DEPTH, SWA_HEADS), 1.0),
        'w_out': nrm(ks[15], (DEPTH, MIX_WIDTH, D), MIX_WIDTH ** -0.5),
        'w_router': nrm(ks[16], (D, N_EXPERTS), D ** -0.5),
        'b_router': nrm(ks[17], (N_EXPERTS,), 0.01),
        'w_gate': nrm(ks[18], (DEPTH, N_EXPERTS, D, D_EXPERT), D ** -0.5),
        'w_up': nrm(ks[19], (DEPTH, N_EXPERTS, D, D_EXPERT), D ** -0.5),
        'w_down': nrm(ks[20], (DEPTH, N_EXPERTS, D_EXPERT, D), D_EXPERT ** -0.5),
        'final_norm': 1.0 + nrm(ks[21], (D,), 0.02),
    }


def reference(x, c, ctx, c_ctx, w_ada, b_ada, norm1, norm2, w_in, gla_up_f, gla_bias_f, gla_up_b,
              gla_bias_b, gla_norm, swa_sink, w_out, w_router, b_router, w_gate, w_up, w_down, final_norm):
    B, L, D = x.shape
    Lc = ctx.shape[1]
    rope_tabs = axial_rope_tables(L)
    c_act = jax.nn.silu(c)
    cc_act = jax.nn.silu(c_ctx)
    xl, xc = x, ctx
    for i in range(DEPTH):
        last = i == DEPTH - 1
        mod_l = (c_act @ w_ada[i] + b_ada[i])[:, None, :]
        mod_c = (cc_act @ w_ada[i] + b_ada[i])[None, None, :]
        sh1, sc1, g1, sh2, sc2, g2 = jnp.split(mod_l, 6, axis=-1)
        csh1, csc1, cg1, csh2, csc2, cg2 = jnp.split(mod_c, 6, axis=-1)

        hl = rmsnorm(xl, norm1[i]) * (1.0 + sc1) + sh1
        hc = rmsnorm(xc, norm1[i]) * (1.0 + csc1) + csh1
        lq, lk, lv, lg, lzf, lzb, lsq, lsk, lsv = split_in_proj(hl @ w_in[i])
        cq, ck, cv, cg, czf, czb, csq, csk, csv = split_in_proj(hc @ w_in[i])

        gq, gk, gv, gaf, gab = gla_heads(cq, ck, cv, czf, czb, gla_up_f[i], gla_bias_f[i], gla_up_b[i], gla_bias_b[i])
        s_zero = jnp.zeros((B, GLA_HEADS, GLA_DK, GLA_DV), jnp.float32)
        o_gla_c, s_f, s_b = gla_bidir(gq, gk, gv, gaf, gab, s_zero, s_zero)
        gq, gk, gv, gaf, gab = gla_heads(lq, lk, lv, lzf, lzb, gla_up_f[i], gla_bias_f[i], gla_up_b[i], gla_bias_b[i])
        o_gla_l, _, _ = gla_bidir(gq, gk, gv, gaf, gab, s_f, s_b)
        gla_l = gla_output(o_gla_l, lg, gla_norm[i])

        q_l = apply_axial_rope(lsq.reshape(B, L, SWA_KV_HEADS, SWA_GROUP, SWA_HD), rope_tabs)
        k_l = apply_axial_rope(lsk.reshape(B, L, SWA_KV_HEADS, SWA_HD), rope_tabs)
        v_l = lsv.reshape(B, L, SWA_KV_HEADS, SWA_HD)
        k_c = csk.reshape(B, Lc, SWA_KV_HEADS, SWA_HD)
        v_c = csv.reshape(B, Lc, SWA_KV_HEADS, SWA_HD)
        swa_l = swa_latent(q_l, k_l, v_l, k_c, v_c, swa_sink[i])

        xl = xl + g1 * (jnp.concatenate([gla_l, swa_l], axis=-1) @ w_out[i])

        h2l = rmsnorm(xl, norm2[i]) * (1.0 + sc2) + sh2
        if last:
            xl = xl + g2 * moe(h2l.reshape(B * L, D), w_router, b_router, w_gate[i], w_up[i], w_down[i]).reshape(B, L, D)
        else:
            gla_c = gla_output(o_gla_c, cg, gla_norm[i])
            q_c = csq.reshape(B, Lc, SWA_KV_HEADS, SWA_GROUP, SWA_HD)
            swa_c = swa_context(q_c, k_c, v_c, swa_sink[i])
            xc = xc + cg1 * (jnp.concatenate([gla_c, swa_c], axis=-1) @ w_out[i])
            h2c = rmsnorm(xc, norm2[i]) * (1.0 + csc2) + csh2
            tokens = jnp.concatenate([h2l.reshape(B * L, D), h2c.reshape(B * Lc, D)], axis=0)
            y = moe(tokens, w_router, b_router, w_gate[i], w_up[i], w_down[i])
            xl = xl + g2 * y[:B * L].reshape(B, L, D)
            xc = xc + cg2 * y[B * L:].reshape(B, Lc, D)
    return rmsnorm(xl, final_norm)
```

```cpp
#include <hip/hip_runtime.h>
#include <cstdio>
#include <cstdint>

#ifndef MK_N_LAUNCHES
#define MK_N_LAUNCHES 1
#endif

#define GAS __attribute__((address_space(1)))
#define LAS __attribute__((address_space(3)))
typedef unsigned short bf16;
typedef short bf16x8 __attribute__((ext_vector_type(8)));
typedef float f32x4 __attribute__((ext_vector_type(4)));
typedef float f32x2 __attribute__((ext_vector_type(2)));
typedef unsigned u32x4 __attribute__((ext_vector_type(4)));
typedef unsigned u32x2 __attribute__((ext_vector_type(2)));

constexpr int D = 1024, SEQ = 8192, LC = 256, TL = 16384, TC = 512, TT = TL + TC, DEPTH = 2;
constexpr int NE = 16, DE = 512;
constexpr int NIN = 2816;
constexpr int PC_Q = 0, PC_K = 256, PC_V = 512, PC_G = 1024, PC_SQ = 1536, PC_SK = 2048, PC_SV = 2176, PC_GF = 2304, PC_GB = 2560;
constexpr int WIN_COLS = 2336;
constexpr float EPS = 1e-6f;
constexpr int LISTCAP = TT;

constexpr size_t MiB = 1u << 20;
constexpr size_t WS_CTL = 0, CTL_ZERO_BYTES = 65536;
constexpr size_t WS_MOD = 1 * MiB;
constexpr size_t WS_ROPE = 1 * MiB + 256 * 1024;
constexpr size_t WS_LIST = 2 * MiB;
constexpr size_t WS_LISTW = 2 * MiB + 1536 * 1024;
constexpr size_t WS_XC = 5 * MiB;
constexpr size_t WS_WIN = 8 * MiB;
constexpr size_t WS_WOUT = 19 * MiB;
constexpr size_t WS_WGU = 23 * MiB;
constexpr size_t WS_WD = 87 * MiB;
constexpr size_t WS_H = 119 * MiB;
constexpr size_t WS_P = 152 * MiB;
constexpr size_t WS_MIX = 243 * MiB;
constexpr size_t WS_GL = 276 * MiB;
constexpr size_t WS_HMID = 152 * MiB;
constexpr size_t WS_Y = 190 * MiB;
constexpr size_t WS_END = 309 * MiB;
static_assert(WS_LIST + (size_t)NE * LISTCAP * 4 <= WS_LISTW && WS_LISTW + (size_t)NE * LISTCAP * 4 <= WS_XC, "ws map");
static_assert(WS_P + (size_t)TT * NIN * 2 <= WS_MIX && WS_MIX + (size_t)TT * D * 2 <= WS_GL, "ws map");
static_assert(WS_HMID + (size_t)37888 * 512 * 2 <= WS_Y && WS_Y + (size_t)2 * TT * D * 2 <= WS_GL, "ws map");
constexpr int CW_CNT = 64;
constexpr int CW_BAR = 4096;

__device__ __forceinline__ unsigned f2bf(float f) { unsigned u = __builtin_bit_cast(unsigned, f); return (u + 0x7fffu + ((u >> 16) & 1u)) >> 16; }
__device__ __forceinline__ unsigned pk2(float lo, float hi) { return f2bf(lo) | (f2bf(hi) << 16); }
__device__ __forceinline__ float bf2f(unsigned h) { return __builtin_bit_cast(float, h << 16); }
__device__ __forceinline__ float bflo(unsigned w) { return __builtin_bit_cast(float, w << 16); }
__device__ __forceinline__ float bfhi(unsigned w) { return __builtin_bit_cast(float, w & 0xffff0000u); }
__device__ __forceinline__ float wave_sum(float v) {
#pragma unroll
    for (int o = 1; o < 64; o <<= 1) v += __shfl_xor(v, o);
    return v;
}
__device__ __forceinline__ float silu_f(float x) { return x / (1.0f + __expf(-x)); }
#define LDS_WAIT() asm volatile("s_waitcnt lgkmcnt(0)" ::: "memory")
#define VM_WAIT() asm volatile("s_waitcnt vmcnt(0)" ::: "memory")

namespace pg8 {
constexpr int BM = 256, BK = 64, HALF = 128, HTB = HALF * BK * 2, STAGE_BYTES = 8 * HTB, NXCD = 8, WGM = 8;
__host__ __device__ __forceinline__ int lds_byte(int r, int c) { const int st = (r >> 4) * 2 + (c >> 5), rr = r & 15, cc = c & 31, ob = rr * 64 + cc * 2; return st * 1024 + (ob ^ (((ob >> 9) & 1) << 5)); }
__host__ __device__ __forceinline__ void stage_rc(int b, int& R, int& C) { const int st = b / 1024, sb = b % 1024, swz = sb ^ (((sb >> 9) & 1) << 5); R = (st >> 1) * 16 + swz / 64; C = (st & 1) * 32 + (swz % 64) / 2; }
__host__ __device__ __forceinline__ int perm32(int rho) { const int n = rho >> 4, i = rho & 15; return 8 * (i >> 2) + 4 * n + (i & 3); }

struct Unit { int pm, pn, e, mt; };

__device__ __forceinline__ int xcd_remap(int wgid, int nwg) { const int q = nwg / NXCD, r = nwg % NXCD, xcd = wgid % NXCD, off = wgid / NXCD; return (xcd < r ? xcd * (q + 1) : r * (q + 1) + (xcd - r) * q) + off; }

struct DenseOrder {
    static constexpr bool DYN_A = false;
    const char* A; const char* Bt; int K; int nM, nN, nwg, G, c;
    __device__ void init(const void* A_, const void* Bt_, int M, int N, int K_, int G_, int c_) { A = (const char*)A_; Bt = (const char*)Bt_; K = K_; nM = M / BM; nN = N / BM; nwg = nM * nN; G = G_; c = c_; }
    __device__ __forceinline__ bool next(int i, Unit& u) const {
        const long L = (long)i * G + c; if (L >= nwg) return false;
        const int wgid = xcd_remap((int)L, nwg);
        const int nig = WGM * nN, gid = wgid / nig, fm = gid * WGM, gsz = (nM - fm) < WGM ? (nM - fm) : WGM;
        u.pm = fm + ((wgid % nig) % gsz); u.pn = (wgid % nig) / gsz; u.e = 0; u.mt = 0; return true;
    }
    __device__ __forceinline__ const char* a_ptr(const Unit& u) const { return A + (size_t)u.pm * (size_t)(BM * K * 2); }
    __device__ __forceinline__ const char* b_ptr(const Unit& u) const { return Bt + (size_t)u.pn * (size_t)(BM * K * 2); }
    __device__ __forceinline__ void a_voff(const Unit&, const int (&R)[2], const int (&C)[2], unsigned (&v0)[2], unsigned (&v1)[2]) const {
#pragma unroll
        for (int i = 0; i < 2; ++i) { v0[i] = (unsigned)(R[i] * K + C[i]) * 2u; v1[i] = v0[i] + (unsigned)(HALF * K * 2); }
    }
};

struct MoeOrder {
    static constexpr bool DYN_A = true;
    const char* A; const char* Bt; int K; size_t bstride_e; int G, c, nunits, nN; bool gather;
    const unsigned* list; const LAS int* tab;
    __device__ __forceinline__ bool next(int i, Unit& u) const {
        const long L = (long)i * G + c; if (L >= nunits) return false;
        const int wgid = xcd_remap((int)L, nunits);
        const int tl = wgid / nN; u.pn = wgid % nN;
        int e = 0, tstart = 0;
        for (int k = 0; k < NE - 1; ++k) { const int te = tab[16 + k]; if (tl >= te) { e = k + 1; tstart = te; } }
        u.e = __builtin_amdgcn_readfirstlane(e); u.mt = __builtin_amdgcn_readfirstlane(tl - tstart); u.pm = tl; return true;
    }
    __device__ __forceinline__ const char* a_ptr(const Unit& u) const { return gather ? A : A + (size_t)u.pm * (size_t)(BM * K * 2); }
    __device__ __forceinline__ const char* b_ptr(const Unit& u) const { return Bt + (size_t)u.e * bstride_e + (size_t)u.pn * (size_t)(BM * K * 2); }
    __device__ __forceinline__ void a_voff(const Unit& u, const int (&R)[2], const int (&C)[2], unsigned (&v0)[2], unsigned (&v1)[2]) const {
        if (gather) {
            const int ce = tab[u.e];
            const unsigned* lp = list + (size_t)u.e * LISTCAP + u.mt * BM;
#pragma unroll
            for (int i = 0; i < 2; ++i) {
                const int r0 = R[i], r1 = R[i] + HALF;
                const unsigned t0 = (u.mt * BM + r0 < ce) ? (__builtin_nontemporal_load(lp + r0) >> 1) : 0u;
                const unsigned t1 = (u.mt * BM + r1 < ce) ? (__builtin_nontemporal_load(lp + r1) >> 1) : 0u;
                v0[i] = (t0 * (unsigned)K + (unsigned)C[i]) * 2u; v1[i] = (t1 * (unsigned)K + (unsigned)C[i]) * 2u;
            }
        } else {
#pragma unroll
            for (int i = 0; i < 2; ++i) { v0[i] = (unsigned)(R[i] * K + C[i]) * 2u; v1[i] = v0[i] + (unsigned)(HALF * K * 2); }
        }
    }
};

__device__ __forceinline__ unsigned cvt_pk_bf16(float lo, float hi) { unsigned r; asm volatile("v_cvt_pk_bf16_f32 %0, %1, %2" : "=v"(r) : "v"(lo), "v"(hi)); return r; }

template <class Epi, class Sched>
__device__ __forceinline__ void gemm_phase(LAS unsigned char* lds, const Sched& S, const Epi& E) {
    int tid = threadIdx.x; asm volatile("" : "+v"(tid));
    const int wid = __builtin_amdgcn_readfirstlane(tid >> 6), lane = tid & 63, wr = wid >> 2, wc = wid & 3, fr = lane & 15, fq = lane >> 4;
    const int K = S.K, nt = K / BK;
    int Rr[2], Cc[2]; unsigned voffB[2];
#pragma unroll
    for (int i = 0; i < 2; ++i) { int R, C; stage_rc(tid * 16 + i * 8192, R, C); const int Rb = Epi::PERM ? ((R & ~31) + perm32(R & 31)) : R;
        Rr[i] = R; Cc[i] = C; voffB[i] = (unsigned)(Rb * K + C) * 2u; }
    const size_t kstep = (size_t)(BK * 2);
    const size_t hstep = (size_t)HALF * K * 2;
    const unsigned ldsw = (unsigned)wid * 1024u;
    const int aoff = lds_byte(wr * 64 + fr, fq * 8), boff = lds_byte(wc * 32 + fr, fq * 8);
#define PG8_SA(b, h) (((b) * 2 + (h)) * HTB)
#define PG8_SB(b, h) ((4 + (b) * 2 + (h)) * HTB)
#define PG8_STAGE(bufoff, gbase, voff) do { _Pragma("unroll") for (int _i = 0; _i < 2; ++_i) \
        __builtin_amdgcn_global_load_lds((const unsigned*)((const char*)(gbase) + (voff)[_i]), (LAS unsigned*)(lds + (bufoff) + ldsw + _i * 8192), 16, 0, 0); } while (0)
#define PG8_LDA(dst, b, h) do { _Pragma("unroll") for (int m = 0; m < 4; ++m) _Pragma("unroll") for (int k = 0; k < 2; ++k) dst[m][k] = *(const LAS bf16x8*)(lds + PG8_SA(b, h) + aoff + m * 2048 + k * 1024); } while (0)
#define PG8_LDB(dst, b, h) do { _Pragma("unroll") for (int n = 0; n < 2; ++n) _Pragma("unroll") for (int k = 0; k < 2; ++k) dst[n][k] = *(const LAS bf16x8*)(lds + PG8_SB(b, h) + boff + n * 2048 + k * 1024); } while (0)
#define PG8_MMA(ai, bj, At, Bt) do { __builtin_amdgcn_s_setprio(1); _Pragma("unroll") for (int m = 0; m < 4; ++m) _Pragma("unroll") for (int n = 0; n < 2; ++n) _Pragma("unroll") for (int k = 0; k < 2; ++k) \
        acc[ai][bj][m][n] = __builtin_amdgcn_mfma_f32_16x16x32_bf16(Bt[n][k], At[m][k], acc[ai][bj][m][n], 0, 0, 0); __builtin_amdgcn_s_setprio(0); } while (0)
#define PG8_WAIT_V(n) asm volatile("s_waitcnt vmcnt(" #n ")" ::: "memory")
#define PG8_WAIT_L(n) asm volatile("s_waitcnt lgkmcnt(" #n ")" ::: "memory")
#define PG8_BAR __builtin_amdgcn_s_barrier()
#define PG8_SCHED __builtin_amdgcn_sched_barrier(0)
    Unit cur, nxt; int ui = 0;
    if (!S.next(0, cur)) return;
    f32x4 acc[2][2][4][2];
#pragma unroll
    for (int a = 0; a < 2; ++a)
#pragma unroll
        for (int b = 0; b < 2; ++b)
#pragma unroll
            for (int m = 0; m < 4; ++m)
#pragma unroll
                for (int n = 0; n < 2; ++n) acc[a][b][m][n] = (f32x4){0.f, 0.f, 0.f, 0.f};
    bf16x8 At[4][2], B0[2][2], B1[2][2];
    const char* cA = S.a_ptr(cur); const char* cB = S.b_ptr(cur);
    unsigned cv0[2], cv1[2], nv0[2], nv1[2];
    S.a_voff(cur, Rr, Cc, cv0, cv1);
    PG8_STAGE(PG8_SB(0, 0), cB, voffB); PG8_STAGE(PG8_SB(0, 1), cB + hstep, voffB); PG8_STAGE(PG8_SA(0, 0), cA, cv0); PG8_STAGE(PG8_SA(0, 1), cA, cv1);
    if (wr == 1) PG8_BAR;
    PG8_WAIT_V(2); PG8_BAR;
    PG8_STAGE(PG8_SB(1, 0), cB + kstep, voffB); PG8_STAGE(PG8_SA(1, 0), cA + kstep, cv0); PG8_STAGE(PG8_SB(1, 1), cB + hstep + kstep, voffB);
    PG8_WAIT_V(6); PG8_BAR;
    for (;;) {
        const bool has_next = S.next(ui + 1, nxt);
        const char* nA = has_next ? S.a_ptr(nxt) : cA; const char* nB = has_next ? S.b_ptr(nxt) : cB;
        if (has_next) S.a_voff(nxt, Rr, Cc, nv0, nv1); else { nv0[0] = cv0[0]; nv0[1] = cv0[1]; nv1[0] = cv1[0]; nv1[1] = cv1[1]; }
        if constexpr (Sched::DYN_A) asm volatile("" : "+v"(nv0[0]), "+v"(nv0[1]), "+v"(nv1[0]), "+v"(nv1[1]));
        for (int t = 0; t < nt; t += 2) {
            const bool last = (t == nt - 2);
            const char* a1 = cA + (size_t)(t + 1) * kstep;
            const char* a2 = last ? nA : cA + (size_t)(t + 2) * kstep; const char* b2 = last ? nB : cB + (size_t)(t + 2) * kstep;
            const char* a3 = a2 + kstep; const char* b3 = b2 + kstep;
            unsigned w0[2], w1[2];
            w0[0] = last ? nv0[0] : cv0[0]; w0[1] = last ? nv0[1] : cv0[1]; w1[0] = last ? nv1[0] : cv1[0]; w1[1] = last ? nv1[1] : cv1[1];
            PG8_LDB(B0, 0, 0); PG8_LDB(B1, 0, 1); PG8_SCHED; PG8_LDA(At, 0, 0); PG8_STAGE(PG8_SA(1, 1), a1, cv1);
            PG8_WAIT_V(8); PG8_WAIT_L(0); PG8_BAR; PG8_MMA(0, 0, At, B0); PG8_MMA(0, 1, At, B1); PG8_BAR; PG8_SCHED;
            PG8_LDA(At, 0, 1); PG8_STAGE(PG8_SB(0, 0), b2, voffB); PG8_STAGE(PG8_SB(0, 1), b2 + hstep, voffB); PG8_STAGE(PG8_SA(0, 0), a2, w0);
            PG8_WAIT_V(8); PG8_WAIT_L(0); PG8_BAR; PG8_MMA(1, 0, At, B0); PG8_MMA(1, 1, At, B1); PG8_BAR; PG8_SCHED;
            PG8_LDB(B0, 1, 0); PG8_LDB(B1, 1, 1); PG8_SCHED; PG8_LDA(At, 1, 0); PG8_STAGE(PG8_SA(0, 1), a2, w1);
            PG8_WAIT_V(8); PG8_WAIT_L(0); PG8_BAR; PG8_MMA(0, 0, At, B0); PG8_MMA(0, 1, At, B1); PG8_BAR; PG8_SCHED;
            PG8_LDA(At, 1, 1); PG8_STAGE(PG8_SB(1, 0), b3, voffB); PG8_STAGE(PG8_SB(1, 1), b3 + hstep, voffB); PG8_STAGE(PG8_SA(1, 0), a3, w0);
            PG8_WAIT_V(8); PG8_WAIT_L(0); PG8_BAR; PG8_MMA(1, 0, At, B0); PG8_MMA(1, 1, At, B1); PG8_BAR; PG8_SCHED;
        }
        if (wr == 0) PG8_BAR;
        E(acc, cur, wr, wc, fr, fq);
        if (!has_next) break;
#pragma unroll
        for (int a = 0; a < 2; ++a)
#pragma unroll
            for (int b = 0; b < 2; ++b)
#pragma unroll
                for (int m = 0; m < 4; ++m)
#pragma unroll
                    for (int n = 0; n < 2; ++n) acc[a][b][m][n] = (f32x4){0.f, 0.f, 0.f, 0.f};
        cur = nxt; cA = nA; cB = nB; ++ui;
        cv0[0] = nv0[0]; cv0[1] = nv0[1]; cv1[0] = nv1[0]; cv1[1] = nv1[1];
        if (wr == 1) PG8_BAR;
    }
    PG8_WAIT_V(0);
    PG8_BAR;
#undef PG8_SA
#undef PG8_SB
#undef PG8_STAGE
#undef PG8_LDA
#undef PG8_LDB
#undef PG8_MMA
#undef PG8_WAIT_V
#undef PG8_WAIT_L
#undef PG8_BAR
#undef PG8_SCHED
}
}

#define XB_TMO      128
#define XB_XCNT(j)  (256  + 64 * (j))
#define XB_XSUB(j)  (1280 + 64 * (j))
#define XB_XGEN(j)  (2304 + 64 * (j))
#define XB_TOP      3328
#define XB_TOPGEN   3392
#define XCD_BAR_WORDS 3456
#define XB_SPIN_CAP (1u << 18)
__device__ __forceinline__ unsigned xb_ld(unsigned* p)              { return __hip_atomic_load(p, __ATOMIC_RELAXED, __HIP_MEMORY_SCOPE_AGENT); }
__device__ __forceinline__ unsigned xb_add(unsigned* p, unsigned v) { return __hip_atomic_fetch_add(p, v, __ATOMIC_RELAXED, __HIP_MEMORY_SCOPE_AGENT); }
__device__ __forceinline__ unsigned xb_xcc_id() { return (unsigned)__builtin_amdgcn_s_getreg((3 << 11) | 20) & 0xFu; }
#define XB_SPIN(cond, bar) do { unsigned _sp = 0; while (cond) { __builtin_amdgcn_s_sleep(1); \
    if ((++_sp & 255u) == 0u) { if (xb_ld(&(bar)[XB_TMO])) break; if (_sp > XB_SPIN_CAP) { atomicAdd(&(bar)[XB_TMO], 1u); break; } } } } while (0)
struct XcdBarrier { unsigned* bar; unsigned x; volatile LAS unsigned* st; };
__device__ __forceinline__ XcdBarrier xcd_barrier_post(unsigned* bar, volatile LAS unsigned* st) {
    XcdBarrier b; b.bar = bar; b.x = xb_xcc_id(); b.st = st;
    if (threadIdx.x == 0) (void)xb_add(&bar[XB_XCNT(b.x)], 1u);
    return b;
}
__device__ __forceinline__ void xcd_barrier_complete(unsigned* bar, unsigned x, unsigned& nloc, unsigned& nx) {
    const unsigned G = gridDim.x * gridDim.y * gridDim.z;
    unsigned sum, cnt, mine, sp = 0u;
    for (;;) {
        sum = 0u; cnt = 0u; mine = 0u;
#pragma unroll
        for (unsigned j = 0; j < 16; ++j) { const unsigned c = xb_ld(&bar[XB_XCNT(j)]); sum += c; cnt += (c > 0u) ? 1u : 0u; mine = (j == x) ? c : mine; }
        if (sum == G) break;
        __builtin_amdgcn_s_sleep(1);
        if ((++sp & 255u) == 0u) { if (xb_ld(&bar[XB_TMO])) break; if (sp > XB_SPIN_CAP) { atomicAdd(&bar[XB_TMO], 1u); break; } }
    }
    nloc = mine > 0u ? mine : 1u; nx = cnt > 0u ? cnt : 1u;
}
__device__ __forceinline__ void xcd_barrier(const XcdBarrier& b) {
    asm volatile("s_waitcnt vmcnt(0)" ::: "memory");
    __syncthreads();
    if (threadIdx.x == 0) {
        unsigned* bar = b.bar;
        __builtin_amdgcn_s_waitcnt(0);
        unsigned nloc = b.st[0], nx = b.st[1];
        if (nloc == 0u) { xcd_barrier_complete(bar, b.x, nloc, nx); b.st[0] = nloc; b.st[1] = nx; }
        const unsigned old = xb_add(&bar[XB_XSUB(b.x)], 1u);
        const unsigned gen = old / nloc;
        if (old + 1u == (gen + 1u) * nloc) {
            __builtin_amdgcn_fence(__ATOMIC_RELEASE, "agent");
            asm volatile("s_waitcnt vmcnt(0)" ::: "memory");
            const unsigned og = xb_add(&bar[XB_TOP], 1u);
            const unsigned tg = og / nx;
            if (og + 1u == (tg + 1u) * nx) xb_add(&bar[XB_TOPGEN], 1u);
            else XB_SPIN(xb_ld(&bar[XB_TOPGEN]) == tg, bar);
            __builtin_amdgcn_fence(__ATOMIC_ACQUIRE, "agent");
            xb_add(&bar[XB_XGEN(b.x)], 1u);
            asm volatile("s_waitcnt vmcnt(0)" ::: "memory");
        } else {
            XB_SPIN(xb_ld(&bar[XB_XGEN(b.x)]) == gen, bar);
            __builtin_amdgcn_fence(__ATOMIC_ACQUIRE, "agent");
            asm volatile("s_waitcnt vmcnt(0)" ::: "memory");
        }
    }
    __syncthreads();
}

constexpr int NWAVES = 8;
constexpr int RING_BYTES = 131072, LDSCTL_OFF = RING_BYTES, MISC_OFF = LDSCTL_OFF + 320, LDS_BYTES = 147456;
struct Args { const float* in[22]; float* out; unsigned char* ws; int ph_lo, ph_hi, li, pad; };
enum { I_X = 0, I_C, I_CTX, I_CCTX, I_WADA, I_BADA, I_NORM1, I_NORM2, I_WIN, I_UPF, I_BIASF, I_UPB, I_BIASB, I_GLANORM, I_SINK, I_WOUT, I_WROUTER, I_BROUTER, I_WGATE, I_WUP, I_WDOWN, I_FNORM };

struct Frame {
    LAS unsigned char* lds; int tid, lane, wave, vcu, G, gw, NGW;
    unsigned char* ws; float* out;
};

__device__ __forceinline__ int rope_pos(int d) { return 8 * ((d & 15) >> 2) + 4 * (d >> 4) + (d & 3); }
__device__ __forceinline__ int gu_row(int h, int gu) { return (h >> 7) * 256 + ((h >> 6) & 1) * 128 + ((h >> 4) & 3) * 32 + ((h >> 2) & 3) * 8 + gu * 4 + (h & 3); }
__device__ __forceinline__ void transpose_item(const float* W, int N, bf16* WT, int Kd, int k0, int n0, int rbase, int mode, LAS float* scr, int lane) {
#pragma unroll 8
    for (int i = 0; i < 32; ++i) { const int kk = 2 * i + (lane >> 5); scr[kk * 33 + (lane & 31)] = W[(size_t)(k0 + kk) * N + n0 + (lane & 31)]; }
    LDS_WAIT(); asm volatile("" ::: "memory");
    const int c = lane & 7;
#pragma unroll
    for (int j = 0; j < 4; ++j) { const int n = (lane >> 3) + 8 * j; const LAS float* s = scr + (8 * c) * 33 + n;
        u32x4 o; o.x = pk2(s[0 * 33], s[1 * 33]); o.y = pk2(s[2 * 33], s[3 * 33]); o.z = pk2(s[4 * 33], s[5 * 33]); o.w = pk2(s[6 * 33], s[7 * 33]);
        const int row = (mode == 0) ? rbase + n : (mode == 1) ? rbase + rope_pos(n) : gu_row(n0 + n, mode - 2);
        *(u32x4*)(WT + (size_t)row * Kd + k0 + 8 * c) = o; }
    LDS_WAIT(); asm volatile("" ::: "memory");
}

__device__ __forceinline__ void p0_prologue(const Frame& F, const Args& a) {
    unsigned char* ws = F.ws;
    LAS float* scr = (LAS float*)(F.lds + F.wave * 16384);
    constexpr int IT_IN = 2 * 16 * 73, IT_OUT = 2 * 16 * 32, IT_G = 32 * 16 * 16, IT_D = 32 * 8 * 32;
    constexpr int NITEMS = IT_IN + IT_OUT + 2 * IT_G + IT_D;
    for (int it = F.gw; it < NITEMS; it += F.NGW) {
        int r = it;
        if (r < IT_IN) {
            const int l = r / 1168, rr = r % 1168, kb = rr / 73, nb = rr % 73;
            if (nb == 48) continue;
            const int n0 = nb * 32; int rbase, mode = 0;
            if (n0 < 1536) rbase = n0;
            else if (n0 < 2080) { rbase = PC_SQ + (n0 - 1568); mode = 1; }
            else if (n0 < 2208) { rbase = PC_SK + (n0 - 2080); mode = 1; }
            else rbase = PC_SV + (n0 - 2208);
            transpose_item(a.in[I_WIN] + (size_t)l * D * WIN_COLS, WIN_COLS, (bf16*)(ws + WS_WIN) + (size_t)l * NIN * D, D, kb * 64, n0, rbase, mode, scr, F.lane);
            continue;
        }
        r -= IT_IN;
        if (r < IT_OUT) { const int l = r / 512, rr = r % 512, kb = rr / 32, nb = rr % 32;
            transpose_item(a.in[I_WOUT] + (size_t)l * D * D, D, (bf16*)(ws + WS_WOUT) + (size_t)l * D * D, D, kb * 64, nb * 32, nb * 32, 0, scr, F.lane); continue; }
        r -= IT_OUT;
        if (r < 2 * IT_G) { const int gu = r / IT_G, r2 = r % IT_G, le = r2 / 256, rr = r2 % 256, kb = rr / 16, nb = rr % 16;
            transpose_item(a.in[gu ? I_WUP : I_WGATE] + (size_t)le * D * DE, DE, (bf16*)(ws + WS_WGU) + (size_t)le * D * D, D, kb * 64, nb * 32, 0, 2 + gu, scr, F.lane); continue; }
        r -= 2 * IT_G;
        { const int le = r / 256, rr = r % 256, kb = rr / 32, nb = rr % 32;
            transpose_item(a.in[I_WDOWN] + (size_t)le * DE * D, D, (bf16*)(ws + WS_WD) + (size_t)le * D * DE, DE, kb * 64, nb * 32, nb * 32, 0, scr, F.lane); }
    }
    for (int idx = F.gw * 64 + F.lane; idx < 2 * 2 * 256 * 128; idx += F.NGW * 64) {
        const int kc = idx & 127, n = (idx >> 7) & 255, dir = (idx >> 15) & 1, l = idx >> 16;
        const float* up = a.in[dir ? I_UPB : I_UPF] + (size_t)l * 16 * 256 + n;
        float u[16];
#pragma unroll
        for (int r = 0; r < 16; ++r) u[r] = up[r * 256];
        float o[8];
#pragma unroll
        for (int kk = 0; kk < 8; ++kk) {
            const f32x4* wz = (const f32x4*)(a.in[I_WIN] + ((size_t)l * D + kc * 8 + kk) * WIN_COLS + 1536 + dir * 16);
            float s = 0.f;
#pragma unroll
            for (int q = 0; q < 4; ++q) { const f32x4 w = wz[q]; s += w[0] * u[4 * q] + w[1] * u[4 * q + 1] + w[2] * u[4 * q + 2] + w[3] * u[4 * q + 3]; }
            o[kk] = s;
        }
        u32x4 ov; ov.x = pk2(o[0], o[1]); ov.y = pk2(o[2], o[3]); ov.z = pk2(o[4], o[5]); ov.w = pk2(o[6], o[7]);
        *(u32x4*)((bf16*)(ws + WS_WIN) + ((size_t)l * NIN + PC_GF + dir * 256 + n) * D + kc * 8) = ov;
    }
    if (blockIdx.x == (unsigned)(F.G - 1)) {
        float* tc = (float*)(ws + WS_ROPE); float* tsn = tc + 2048;
        for (int i = F.tid; i < 2048; i += NWAVES * 64) { const int pos = i >> 4, j = i & 15; const float inv = powf(10000.0f, -(float)j * (1.0f / 16.0f)); const float ang = (float)pos * inv;
            tc[i] = cosf(ang); tsn[i] = sinf(ang); }
    }
    __syncthreads();
    {
        LAS float* cs = (LAS float*)F.lds; LAS float* red = cs + 3072;
        for (int i = F.tid; i < 3072; i += NWAVES * 64) { const int v = i >> 10, k = i & 1023; const float cv = v < 2 ? a.in[I_C][v * D + k] : a.in[I_CCTX][k]; cs[i] = cv / (1.0f + expf(-cv)); }
        __syncthreads();
        for (int u = blockIdx.x; u < 192; u += F.G) {
            const int l = u / 96, jg = u % 96, jl = F.tid & 63, ks = F.tid >> 6;
            const float* wp = a.in[I_WADA] + ((size_t)l * D + ks * 128) * 6144 + jg * 64 + jl;
            float a0 = 0.f, a1 = 0.f, a2 = 0.f;
#pragma unroll 8
            for (int k = 0; k < 128; ++k) { const float w = wp[(size_t)k * 6144]; const int kk = ks * 128 + k; a0 += cs[kk] * w; a1 += cs[1024 + kk] * w; a2 += cs[2048 + kk] * w; }
            red[(ks * 3 + 0) * 64 + jl] = a0; red[(ks * 3 + 1) * 64 + jl] = a1; red[(ks * 3 + 2) * 64 + jl] = a2;
            __syncthreads();
            if (F.tid < 192) { const int v = F.tid >> 6, j2 = F.tid & 63; float s = 0.f;
#pragma unroll
                for (int q = 0; q < 8; ++q) s += red[(q * 3 + v) * 64 + j2];
                ((float*)(ws + WS_MOD))[(l * 3 + v) * 6144 + jg * 64 + j2] = s + a.in[I_BADA][l * 6144 + jg * 64 + j2]; }
            __syncthreads();
        }
    }
}

__device__ __forceinline__ f32x4 ld_y4(const bf16* p) { const u32x2 w = *(const u32x2*)p; return (f32x4){bflo(w.x), bfhi(w.x), bflo(w.y), bfhi(w.y)}; }
__device__ __forceinline__ void n1_phase(const Frame& F, const Args& a, int l) {
    unsigned char* ws = F.ws;
    const float* mod = (const float*)(ws + WS_MOD);
    const bf16* Y0 = (const bf16*)(ws + WS_Y); const bf16* Y1 = Y0 + (size_t)TT * D;
    bf16* H = (bf16*)(ws + WS_H);
    for (int m = F.gw; m < TT; m += F.NGW) {
        const int v = m < TL ? (m >> 13) : 2;
        float* xrow = m < TL ? F.out + (size_t)m * D : (float*)(ws + WS_XC) + (size_t)(m - TL) * D;
        const float* src = (l == 0) ? (m < TL ? a.in[I_X] + (size_t)m * D : a.in[I_CTX] + (size_t)(m - TL) * D) : xrow;
        f32x4 x[4]; float ss = 0.f;
#pragma unroll
        for (int j = 0; j < 4; ++j) {
            const int col = 4 * F.lane + 256 * j;
            x[j] = *(const f32x4*)(src + col);
            if (l > 0) {
                const f32x4 g2 = *(const f32x4*)(mod + ((l - 1) * 3 + v) * 6144 + 5 * D + col);
                const f32x4 y = ld_y4(Y0 + (size_t)m * D + col) + ld_y4(Y1 + (size_t)m * D + col);
                x[j] = x[j] + g2 * y;
                *(f32x4*)(xrow + col) = x[j];
            }
            ss += (x[j][0] * x[j][0] + x[j][1] * x[j][1]) + (x[j][2] * x[j][2] + x[j][3] * x[j][3]);
        }
        const float rstd = 1.0f / sqrtf(wave_sum(ss) * (1.0f / D) + EPS);
#pragma unroll
        for (int j = 0; j < 4; ++j) {
            const int col = 4 * F.lane + 256 * j;
            const f32x4 nw = *(const f32x4*)(a.in[I_NORM1] + l * D + col);
            const f32x4 sh = *(const f32x4*)(mod + (l * 3 + v) * 6144 + 0 * D + col);
            const f32x4 sc = *(const f32x4*)(mod + (l * 3 + v) * 6144 + 1 * D + col);
            const f32x4 h = x[j] * rstd * nw * (1.0f + sc) + sh;
            u32x2 o; o.x = pk2(h[0], h[1]); o.y = pk2(h[2], h[3]);
            *(u32x2*)(H + (size_t)m * D + col) = o;
        }
    }
}

struct EpiIn {
    static constexpr bool PERM = true;
    bf16* P; const float* bias_f; const float* bias_b; const float* tcos; const float* tsin;
    __device__ __forceinline__ void operator()(const f32x4 (&acc)[2][2][4][2], const pg8::Unit& u, int wr, int wc, int fr, int fq) const {
        const int row0 = u.pm * 256 + wr * 64 + fr, colw = wc * 32 + 8 * fq;
        const int pn = u.pn;
        const bool latent = u.pm < 64;
#pragma unroll
        for (int ai = 0; ai < 2; ++ai)
#pragma unroll
            for (int m = 0; m < 4; ++m) {
                const int row = row0 + ai * 128 + m * 16;
                bf16* rowp = P + (size_t)row * NIN + pn * 256 + colw;
#pragma unroll
                for (int bj = 0; bj < 2; ++bj) {
                    f32x4 v0 = acc[ai][bj][m][0], v1 = acc[ai][bj][m][1];
                    if (pn == 0) { v0 = v0 * 0.125f; v1 = v1 * 0.125f; }
                    else if (pn >= 9) {
                        const float* bp = (pn == 9 ? bias_f : bias_b) + colw + bj * 128;
                        const f32x4 b0 = *(const f32x4*)bp, b1 = *(const f32x4*)(bp + 4);
#pragma unroll
                        for (int i = 0; i < 4; ++i) { float x0 = v0[i] + b0[i], x1 = v1[i] + b1[i];
                            v0[i] = (fminf(x0, 0.f) - log1pf(expf(-fabsf(x0)))) * 0.0625f; v1[i] = (fminf(x1, 0.f) - log1pf(expf(-fabsf(x1)))) * 0.0625f; }
                    } else if (latent && (pn == 6 || pn == 7 || (pn == 8 && bj == 0))) {
                        const int t = row & (SEQ - 1); const int pos = (wc & 1) ? (t & 63) : (t >> 6);
                        const f32x4 cs = *(const f32x4*)(tcos + pos * 16 + 4 * fq), sn = *(const f32x4*)(tsin + pos * 16 + 4 * fq);
                        const f32x4 o0 = v0 * cs - v1 * sn, o1 = v1 * cs + v0 * sn; v0 = o0; v1 = o1;
                    }
                    u32x4 w; w.x = pg8::cvt_pk_bf16(v0[0], v0[1]); w.y = pg8::cvt_pk_bf16(v0[2], v0[3]); w.z = pg8::cvt_pk_bf16(v1[0], v1[1]); w.w = pg8::cvt_pk_bf16(v1[2], v1[3]);
                    *(u32x4*)(rowp + bj * 128) = w;
                }
            }
    }
};
struct EpiOut {
    static constexpr bool PERM = false;
    const float* resL; const float* resC; float* outL; float* outC; const float* mod_l;
    __device__ __forceinline__ void operator()(const f32x4 (&acc)[2][2][4][2], const pg8::Unit& u, int wr, int wc, int fr, int fq) const {
        const bool latent = u.pm < 64;
        const int v = latent ? (u.pm >> 5) : 2;
        const int rowb = (latent ? u.pm * 256 : u.pm * 256 - TL) + wr * 64 + fr;
        const float* res = latent ? resL : resC; float* out = latent ? outL : outC;
        const int col0 = u.pn * 256 + wc * 32 + 4 * fq;
        const float* g1p = mod_l + v * 6144 + 2 * D + col0;
#pragma unroll
        for (int ai = 0; ai < 2; ++ai)
#pragma unroll
            for (int m = 0; m < 4; ++m) {
                const size_t off = (size_t)(rowb + ai * 128 + m * 16) * D + col0;
#pragma unroll
                for (int bj = 0; bj < 2; ++bj)
#pragma unroll
                    for (int n = 0; n < 2; ++n) {
                        const f32x4 g1 = *(const f32x4*)(g1p + bj * 128 + n * 16);
                        const f32x4 r = *(const f32x4*)(res + off + bj * 128 + n * 16);
                        *(f32x4*)(out + off + bj * 128 + n * 16) = r + g1 * acc[ai][bj][m][n];
                    }
                if (m & 1) asm volatile("" ::: "memory");
            }
    }
};
struct EpiGU {
    static constexpr bool PERM = true;
    bf16* Hmid;
    __device__ __forceinline__ void operator()(const f32x4 (&acc)[2][2][4][2], const pg8::Unit& u, int wr, int wc, int fr, int fq) const {
        const int row0 = u.pm * 256 + wr * 64 + fr, hid0 = u.pn * 128 + wc * 16 + fq * 4;
#pragma unroll
        for (int ai = 0; ai < 2; ++ai)
#pragma unroll
            for (int m = 0; m < 4; ++m) {
                bf16* rowp = Hmid + (size_t)(row0 + ai * 128 + m * 16) * DE + hid0;
#pragma unroll
                for (int bj = 0; bj < 2; ++bj) {
                    const f32x4 g = acc[ai][bj][m][0], up = acc[ai][bj][m][1]; f32x4 o;
#pragma unroll
                    for (int i = 0; i < 4; ++i) o[i] = g[i] * __builtin_amdgcn_rcpf(1.0f + __expf(-g[i])) * up[i];
                    u32x2 w; w.x = pg8::cvt_pk_bf16(o[0], o[1]); w.y = pg8::cvt_pk_bf16(o[2], o[3]);
                    *(u32x2*)(rowp + bj * 64) = w;
                }
            }
    }
};
struct EpiDown {
    static constexpr bool PERM = true;
    bf16* Y; const unsigned* list; const float* listw; const LAS int* tab;
    __device__ __forceinline__ void operator()(const f32x4 (&acc)[2][2][4][2], const pg8::Unit& u, int wr, int wc, int fr, int fq) const {
        const int ce = tab[u.e];
        const int r0 = u.mt * 256 + wr * 64 + fr, col0 = u.pn * 256 + wc * 32 + 8 * fq;
        const unsigned* lp = list + (size_t)u.e * LISTCAP; const float* lw = listw + (size_t)u.e * LISTCAP;
#pragma unroll
        for (int ai = 0; ai < 2; ++ai)
#pragma unroll
            for (int m = 0; m < 4; ++m) {
                const int r = r0 + ai * 128 + m * 16;
                if (r < ce) {
                    const unsigned ts = __builtin_nontemporal_load(lp + r); const float w = __builtin_nontemporal_load(lw + r);
                    bf16* rowp = Y + ((size_t)(ts & 1u) * TT + (ts >> 1)) * D + col0;
#pragma unroll
                    for (int bj = 0; bj < 2; ++bj) {
                        const f32x4 v0 = acc[ai][bj][m][0] * w, v1 = acc[ai][bj][m][1] * w;
                        u32x4 o; o.x = pg8::cvt_pk_bf16(v0[0], v0[1]); o.y = pg8::cvt_pk_bf16(v0[2], v0[3]); o.z = pg8::cvt_pk_bf16(v1[0], v1[1]); o.w = pg8::cvt_pk_bf16(v1[2], v1[3]);
                        *(u32x4*)(rowp + bj * 128) = o;
                    }
                }
            }
    }
};

__device__ __forceinline__ void swa_naive(const Frame& F, const Args& a, int l) {
    const bf16* P = (const bf16*)(F.ws + WS_P); bf16* MIX = (bf16*)(F.ws + WS_MIX);
    const int total = (l == 0 ? TT : TL) * 8;
    for (int idx = F.gw * 64 + F.lane; idx < total; idx += F.NGW * 64) {
        const int m = idx >> 3, hq = idx & 7, kvh = hq >> 2;
        const bool latent = m < TL;
        const int b = latent ? (m >> 13) : ((m - TL) >> 8), t = m & (SEQ - 1);
        float q[64];
        { const u32x4* qp = (const u32x4*)(P + (size_t)m * NIN + PC_SQ + hq * 64);
#pragma unroll
          for (int c = 0; c < 8; ++c) { const u32x4 w = qp[c]; q[8 * c] = bflo(w.x) * 0.125f; q[8 * c + 1] = bfhi(w.x) * 0.125f; q[8 * c + 2] = bflo(w.y) * 0.125f; q[8 * c + 3] = bfhi(w.y) * 0.125f;
              q[8 * c + 4] = bflo(w.z) * 0.125f; q[8 * c + 5] = bfhi(w.z) * 0.125f; q[8 * c + 6] = bflo(w.w) * 0.125f; q[8 * c + 7] = bfhi(w.w) * 0.125f; } }
        float o[64];
#pragma unroll
        for (int d = 0; d < 64; ++d) o[d] = 0.f;
        const float sink = a.in[I_SINK][l * 8 + hq];
        float mx = sink, den = 1.0f;
        const int lo = latent ? (t - 128 < 0 ? 0 : t - 128) : 0, hi = latent ? (t + 128 > SEQ - 1 ? SEQ - 1 : t + 128) : -1;
        const int nloc = hi - lo + 1;
        for (int kk = 0; kk < nloc + LC; ++kk) {
            const int krow = kk < nloc ? b * SEQ + lo + kk : TL + b * LC + (kk - nloc);
            const u32x4* kp = (const u32x4*)(P + (size_t)krow * NIN + PC_SK + kvh * 64);
            float s = 0.f;
#pragma unroll
            for (int c = 0; c < 8; ++c) { const u32x4 w = kp[c]; s += q[8 * c] * bflo(w.x) + q[8 * c + 1] * bfhi(w.x) + q[8 * c + 2] * bflo(w.y) + q[8 * c + 3] * bfhi(w.y)
                + q[8 * c + 4] * bflo(w.z) + q[8 * c + 5] * bfhi(w.z) + q[8 * c + 6] * bflo(w.w) + q[8 * c + 7] * bfhi(w.w); }
            const float mn = fmaxf(mx, s), f = __expf(mx - mn), p = __expf(s - mn);
            den = den * f + p; mx = mn;
            const u32x4* vp = (const u32x4*)(P + (size_t)krow * NIN + PC_SV + kvh * 64);
#pragma unroll
            for (int c = 0; c < 8; ++c) { const u32x4 w = vp[c];
                o[8 * c] = o[8 * c] * f + p * bflo(w.x); o[8 * c + 1] = o[8 * c + 1] * f + p * bfhi(w.x); o[8 * c + 2] = o[8 * c + 2] * f + p * bflo(w.y); o[8 * c + 3] = o[8 * c + 3] * f + p * bfhi(w.y);
                o[8 * c + 4] = o[8 * c + 4] * f + p * bflo(w.z); o[8 * c + 5] = o[8 * c + 5] * f + p * bfhi(w.z); o[8 * c + 6] = o[8 * c + 6] * f + p * bflo(w.w); o[8 * c + 7] = o[8 * c + 7] * f + p * bfhi(w.w); }
        }
        const float inv = 1.0f / den;
        u32x4* op = (u32x4*)(MIX + (size_t)m * D + 512 + hq * 64);
#pragma unroll
        for (int c = 0; c < 8; ++c) { u32x4 w; w.x = pk2(o[8 * c] * inv, o[8 * c + 1] * inv); w.y = pk2(o[8 * c + 2] * inv, o[8 * c + 3] * inv); w.z = pk2(o[8 * c + 4] * inv, o[8 * c + 5] * inv); w.w = pk2(o[8 * c + 6] * inv, o[8 * c + 7] * inv); op[c] = w; }
    }
}

__device__ __forceinline__ void gla_naive(const Frame& F, const Args& a, int l) {
    const bf16* P = (const bf16*)(F.ws + WS_P);
    bf16* OF = (bf16*)(F.ws + WS_GL);
    for (int w = F.gw; w < 2048; w += F.NGW) {
        const int dv = w & 127, dir = (w >> 7) & 1, h = (w >> 8) & 3, b = w >> 10;
        const int pcg = dir ? PC_GB : PC_GF;
        float S = 0.f;
        for (int step = 0; step < LC + SEQ; ++step) {
            int m;
            if (dir == 0) m = step < LC ? TL + b * LC + step : b * SEQ + (step - LC);
            else m = step < LC ? TL + b * LC + (LC - 1 - step) : b * SEQ + (SEQ - 1 - (step - LC));
            const bf16* row = P + (size_t)m * NIN;
            const float la = bf2f(row[pcg + h * 64 + F.lane]), kk = bf2f(row[PC_K + h * 64 + F.lane]), qq = bf2f(row[PC_Q + h * 64 + F.lane]), vv = bf2f(row[PC_V + h * 128 + dv]);
            S = __expf(la) * S + kk * vv;
            const float o = wave_sum(qq * S);
            if (F.lane == 0) OF[((size_t)dir * TT + m) * 512 + h * 128 + dv] = (bf16)f2bf(o);
        }
    }
}
__device__ __forceinline__ void gla_out_naive(const Frame& F, const Args& a, int l) {
    const bf16* P = (const bf16*)(F.ws + WS_P); bf16* MIX = (bf16*)(F.ws + WS_MIX);
    const bf16* OF = (const bf16*)(F.ws + WS_GL);
    const int rows = (l == 0) ? TT : TL;
    for (int m = F.gw; m < rows; m += F.NGW) {
        const int c0 = 8 * F.lane;
        const u32x4 wa = *(const u32x4*)(OF + (size_t)m * 512 + c0), wb = *(const u32x4*)(OF + ((size_t)TT + m) * 512 + c0);
        float o[8] = {bflo(wa.x) + bflo(wb.x), bfhi(wa.x) + bfhi(wb.x), bflo(wa.y) + bflo(wb.y), bfhi(wa.y) + bfhi(wb.y), bflo(wa.z) + bflo(wb.z), bfhi(wa.z) + bfhi(wb.z), bflo(wa.w) + bflo(wb.w), bfhi(wa.w) + bfhi(wb.w)};
        float ss = 0.f;
#pragma unroll
        for (int i = 0; i < 8; ++i) ss += o[i] * o[i];
        ss += __shfl_xor(ss, 1); ss += __shfl_xor(ss, 2); ss += __shfl_xor(ss, 4); ss += __shfl_xor(ss, 8);
        const float rstd = 1.0f / sqrtf(ss * (1.0f / 128.0f) + EPS);
        const u32x4 wg = *(const u32x4*)(P + (size_t)m * NIN + PC_G + c0);
        const float g[8] = {bflo(wg.x), bfhi(wg.x), bflo(wg.y), bfhi(wg.y), bflo(wg.z), bfhi(wg.z), bflo(wg.w), bfhi(wg.w)};
        const f32x4 n0 = *(const f32x4*)(a.in[I_GLANORM] + l * 512 + c0), n1 = *(const f32x4*)(a.in[I_GLANORM] + l * 512 + c0 + 4);
        float r[8];
#pragma unroll
        for (int i = 0; i < 8; ++i) r[i] = o[i] * rstd * (i < 4 ? n0[i] : n1[i - 4]) * silu_f(g[i]);
        u32x4 w; w.x = pk2(r[0], r[1]); w.y = pk2(r[2], r[3]); w.z = pk2(r[4], r[5]); w.w = pk2(r[6], r[7]);
        *(u32x4*)(MIX + (size_t)m * D + c0) = w;
    }
}

__device__ __forceinline__ void n2_route_phase(const Frame& F, const Args& a, int l) {
    unsigned char* ws = F.ws;
    const float* mod = (const float*)(ws + WS_MOD);
    bf16* H = (bf16*)(ws + WS_H);
    unsigned* cnt = (unsigned*)(ws + WS_CTL) + CW_CNT + l * NE;
    unsigned* list = (unsigned*)(ws + WS_LIST); float* listw = (float*)(ws + WS_LISTW);
    LAS float* wrt = (LAS float*)F.lds;
    for (int i = F.tid; i < D * NE; i += NWAVES * 64) wrt[(i & 15) * D + (i >> 4)] = a.in[I_WROUTER][i];
    __syncthreads();
    const int rows = (l == 0) ? TT : TL;
    for (int m = F.gw; m < rows; m += F.NGW) {
        const int v = m < TL ? (m >> 13) : 2;
        const float* xrow = m < TL ? F.out + (size_t)m * D : (const float*)(ws + WS_XC) + (size_t)(m - TL) * D;
        f32x4 x[4]; float ss = 0.f;
#pragma unroll
        for (int j = 0; j < 4; ++j) { x[j] = *(const f32x4*)(xrow + 4 * F.lane + 256 * j); ss += (x[j][0] * x[j][0] + x[j][1] * x[j][1]) + (x[j][2] * x[j][2] + x[j][3] * x[j][3]); }
        const float rstd = 1.0f / sqrtf(wave_sum(ss) * (1.0f / D) + EPS);
        float lg[NE];
#pragma unroll
        for (int e = 0; e < NE; ++e) lg[e] = 0.f;
#pragma unroll
        for (int j = 0; j < 4; ++j) {
            const int col = 4 * F.lane + 256 * j;
            const f32x4 nw = *(const f32x4*)(a.in[I_NORM2] + l * D + col);
            const f32x4 sh = *(const f32x4*)(mod + (l * 3 + v) * 6144 + 3 * D + col);
            const f32x4 sc = *(const f32x4*)(mod + (l * 3 + v) * 6144 + 4 * D + col);
            const f32x4 h = x[j] * rstd * nw * (1.0f + sc) + sh;
            u32x2 o; o.x = pk2(h[0], h[1]); o.y = pk2(h[2], h[3]);
            *(u32x2*)(H + (size_t)m * D + col) = o;
#pragma unroll
            for (int e = 0; e < NE; ++e) { const f32x4 w = *(const LAS f32x4*)(wrt + e * D + col); lg[e] += (h[0] * w[0] + h[1] * w[1]) + (h[2] * w[2] + h[3] * w[3]); if ((e & 3) == 3) asm volatile("" ::: "memory"); }
        }
#pragma unroll
        for (int e = 0; e < NE; ++e) lg[e] = wave_sum(lg[e]);
        float s[NE], sb[NE];
#pragma unroll
        for (int e = 0; e < NE; ++e) { s[e] = 1.0f / (1.0f + expf(-lg[e])); sb[e] = s[e] + a.in[I_BROUTER][e]; }
        int gsel = 0; float gbest = -1e30f;
#pragma unroll
        for (int g = 0; g < 4; ++g) {
            float m1 = -1e30f, m2 = -1e30f;
#pragma unroll
            for (int i = 0; i < 4; ++i) { const float val = sb[4 * g + i]; if (val > m1) { m2 = m1; m1 = val; } else if (val > m2) m2 = val; }
            const float gs = m1 + m2; if (gs > gbest) { gbest = gs; gsel = g; }
        }
        int e0 = 0, e1 = 0; float b0 = -1e30f, b1 = -1e30f, s0 = 0.f, s1 = 0.f;
#pragma unroll
        for (int e = 0; e < NE; ++e) {
            if ((e >> 2) == gsel) { const float val = sb[e];
                if (val > b0) { b1 = b0; e1 = e0; s1 = s0; b0 = val; e0 = e; s0 = s[e]; } else if (val > b1) { b1 = val; e1 = e; s1 = s[e]; } }
        }
        if (F.lane == 0) {
            const float inv = 1.0f / (s0 + s1);
            const unsigned p0 = atomicAdd(cnt + e0, 1u); list[(size_t)e0 * LISTCAP + p0] = (unsigned)m * 2u; listw[(size_t)e0 * LISTCAP + p0] = s0 * inv;
            const unsigned p1 = atomicAdd(cnt + e1, 1u); list[(size_t)e1 * LISTCAP + p1] = (unsigned)m * 2u + 1u; listw[(size_t)e1 * LISTCAP + p1] = s1 * inv;
        }
    }
}

__device__ __forceinline__ void moe_setup(pg8::MoeOrder& S, const Frame& F, int l, int nN) {
    unsigned* cnt = (unsigned*)(F.ws + WS_CTL) + CW_CNT + l * NE;
    LAS int* tab = (LAS int*)(F.lds + MISC_OFF + 64);
    __syncthreads();
    if (F.tid == 0) { int run = 0;
        for (int e = 0; e < NE; ++e) { const int c = (int)__hip_atomic_load(cnt + e, __ATOMIC_RELAXED, __HIP_MEMORY_SCOPE_AGENT); tab[e] = c; run += (c + 255) >> 8; tab[16 + e] = run; } }
    __syncthreads();
    S.tab = tab; S.nN = nN; S.nunits = __builtin_amdgcn_readfirstlane(tab[31]) * nN; S.G = F.G; S.c = (int)blockIdx.x;
    S.list = (const unsigned*)(F.ws + WS_LIST);
}
__device__ __forceinline__ void moe1_phase(const Frame& F, const Args& a, int l) {
    pg8::MoeOrder S; moe_setup(S, F, l, 4);
    S.A = (const char*)(F.ws + WS_H); S.Bt = (const char*)(F.ws + WS_WGU) + (size_t)l * NE * D * D * 2; S.K = D; S.bstride_e = (size_t)D * D * 2; S.gather = true;
    EpiGU E{(bf16*)(F.ws + WS_HMID)};
    pg8::gemm_phase<EpiGU, pg8::MoeOrder>(F.lds, S, E);
}
__device__ __forceinline__ void moe2_phase(const Frame& F, const Args& a, int l) {
    pg8::MoeOrder S; moe_setup(S, F, l, 4);
    S.A = (const char*)(F.ws + WS_HMID); S.Bt = (const char*)(F.ws + WS_WD) + (size_t)l * NE * D * DE * 2; S.K = DE; S.bstride_e = (size_t)D * DE * 2; S.gather = false;
    EpiDown E; E.Y = (bf16*)(F.ws + WS_Y); E.list = (const unsigned*)(F.ws + WS_LIST); E.listw = (const float*)(F.ws + WS_LISTW); E.tab = S.tab;
    pg8::gemm_phase<EpiDown, pg8::MoeOrder>(F.lds, S, E);
}

__device__ __forceinline__ void final_phase(const Frame& F, const Args& a) {
    const float* mod = (const float*)(F.ws + WS_MOD);
    const bf16* Y0 = (const bf16*)(F.ws + WS_Y); const bf16* Y1 = Y0 + (size_t)TT * D;
    for (int m = F.gw; m < TL; m += F.NGW) {
        const int v = m >> 13; float* xrow = F.out + (size_t)m * D;
        f32x4 x[4]; float ss = 0.f;
#pragma unroll
        for (int j = 0; j < 4; ++j) {
            const int col = 4 * F.lane + 256 * j;
            const f32x4 g2 = *(const f32x4*)(mod + (3 + v) * 6144 + 5 * D + col);
            const f32x4 y = ld_y4(Y0 + (size_t)m * D + col) + ld_y4(Y1 + (size_t)m * D + col);
            x[j] = *(const f32x4*)(xrow + col) + g2 * y;
            ss += (x[j][0] * x[j][0] + x[j][1] * x[j][1]) + (x[j][2] * x[j][2] + x[j][3] * x[j][3]);
        }
        const float rstd = 1.0f / sqrtf(wave_sum(ss) * (1.0f / D) + EPS);
#pragma unroll
        for (int j = 0; j < 4; ++j) { const int col = 4 * F.lane + 256 * j; const f32x4 nw = *(const f32x4*)(a.in[I_FNORM] + col); *(f32x4*)(xrow + col) = x[j] * rstd * nw; }
    }
}

constexpr int PH_PER_LAYER = 8;
constexpr int N_PHASES = 1 + DEPTH * PH_PER_LAYER + 1;

__global__ void __launch_bounds__(NWAVES * 64, 2) mk_fwd(Args args) {
    extern __shared__ __attribute__((aligned(16))) unsigned char lds[];
    Frame F;
    F.lds = (LAS unsigned char*)lds;
    F.tid = threadIdx.x; F.lane = F.tid & 63; F.wave = __builtin_amdgcn_readfirstlane(F.tid >> 6);
    F.G = gridDim.x; { const int bx = blockIdx.x; F.vcu = (F.G % 8 == 0) ? (bx % 8) * (F.G / 8) + bx / 8 : bx; }
    F.gw = F.vcu * NWAVES + F.wave; F.NGW = F.G * NWAVES;
    F.ws = args.ws; F.out = args.out;
    volatile LAS unsigned* MISC = (volatile LAS unsigned*)(F.lds + MISC_OFF);
    for (int u = F.tid; u < (LDS_BYTES - LDSCTL_OFF) / 4; u += NWAVES * 64) ((LAS unsigned*)(F.lds + LDSCTL_OFF))[u] = 0u;
    __syncthreads();
    XcdBarrier bar; bar.bar = (unsigned*)(F.ws + WS_CTL) + CW_BAR; bar.x = 0; bar.st = nullptr;
    const bool fused = (args.ph_hi - args.ph_lo) > 1;
    if (fused) bar = xcd_barrier_post((unsigned*)(F.ws + WS_CTL) + CW_BAR, MISC + 8);
    const int lo = args.ph_lo, hi = args.ph_hi;
    for (int ph = lo; ph < hi; ++ph) {
        { int t_ = threadIdx.x; asm volatile("" : "+v"(t_)); F.tid = t_; F.lane = t_ & 63; }
        if (ph == 0) p0_prologue(F, args);
        else if (ph == N_PHASES - 1) final_phase(F, args);
        else {
            const int l = (ph - 1) / PH_PER_LAYER, s = (ph - 1) % PH_PER_LAYER;
            unsigned char* ws = F.ws;
            if (s == 0) n1_phase(F, args, l);
            else if (s == 1) {
                pg8::DenseOrder S; S.init(ws + WS_H, ws + WS_WIN + (size_t)l * NIN * D * 2, TT, NIN, D, F.G, (int)blockIdx.x);
                EpiIn E{(bf16*)(ws + WS_P), args.in[I_BIASF] + l * 256, args.in[I_BIASB] + l * 256, (const float*)(ws + WS_ROPE), (const float*)(ws + WS_ROPE) + 2048};
                pg8::gemm_phase<EpiIn, pg8::DenseOrder>(F.lds, S, E);
            }
            else if (s == 2) { swa_naive(F, args, l); gla_naive(F, args, l); }
            else if (s == 3) gla_out_naive(F, args, l);
            else if (s == 4) {
                pg8::DenseOrder S; S.init(ws + WS_MIX, ws + WS_WOUT + (size_t)l * D * D * 2, l == 0 ? TT : TL, D, D, F.G, (int)blockIdx.x);
                EpiOut E{l == 0 ? args.in[I_X] : F.out, l == 0 ? args.in[I_CTX] : (const float*)(ws + WS_XC), F.out, (float*)(ws + WS_XC), (const float*)(ws + WS_MOD) + l * 3 * 6144};
                pg8::gemm_phase<EpiOut, pg8::DenseOrder>(F.lds, S, E);
            }
            else if (s == 5) n2_route_phase(F, args, l);
            else if (s == 6) moe1_phase(F, args, l);
            else moe2_phase(F, args, l);
        }
        if (ph + 1 < hi) xcd_barrier(bar);
    }
}

extern "C" void kernel_launch(void* const* d_in, const int* in_sizes, int n_in, void* d_out, int out_size, void* d_ws, size_t ws_size, hipStream_t stream) {
    static int grid = 0;
    if (grid == 0) {
        if (n_in != 22 || out_size != TL * D || ws_size < WS_END) { fprintf(stderr, "kernel_launch: unexpected shapes (n_in %d out %d ws %zu)\n", n_in, out_size, ws_size); grid = -1; return; }
        int dev = 0, cus = 0, per_cu = 0;
        if (hipGetDevice(&dev) != hipSuccess || hipDeviceGetAttribute(&cus, hipDeviceAttributeMultiprocessorCount, dev) != hipSuccess) { grid = -1; return; }
        if (hipFuncSetAttribute((const void*)mk_fwd, hipFuncAttributeMaxDynamicSharedMemorySize, LDS_BYTES) != hipSuccess) { fprintf(stderr, "kernel_launch: hipFuncSetAttribute failed\n"); grid = -1; return; }
        if (hipOccupancyMaxActiveBlocksPerMultiprocessor(&per_cu, (const void*)mk_fwd, NWAVES * 64, LDS_BYTES) != hipSuccess || per_cu < 1) fprintf(stderr, "kernel_launch: occupancy query says %d\n", per_cu);
        (void)hipGetLastError();
        grid = cus;
    }
    if (grid < 0) return;
    (void)hipMemsetAsync((char*)d_ws + WS_CTL, 0, CTL_ZERO_BYTES, stream);
    Args a{};
    for (int i = 0; i < 22; ++i) a.in[i] = (const float*)d_in[i];
    a.out = (float*)d_out; a.ws = (unsigned char*)d_ws; a.li = 0; a.pad = 0;
#if MK_N_LAUNCHES == 1
    a.ph_lo = 0; a.ph_hi = N_PHASES;
    hipLaunchKernelGGL(mk_fwd, dim3(grid), dim3(NWAVES * 64), LDS_BYTES, stream, a);
#else
    for (int ph = 0; ph < N_PHASES; ++ph) { a.ph_lo = ph; a.ph_hi = ph + 1; hipLaunchKernelGGL(mk_fwd, dim3(grid), dim3(NWAVES * 64), LDS_BYTES, stream, a); }
#endif
}
```

```cpp
#include <hip/hip_runtime.h>
#include <cstdio>
#include <cstdint>

#ifndef ONLY_S
#define ONLY_S -1
#endif
#define PH_ON(k) (ONLY_S < 0 || ONLY_S == (k))
#ifndef MK_N_LAUNCHES
#define MK_N_LAUNCHES 1
#endif

#define GAS __attribute__((address_space(1)))
#define LAS __attribute__((address_space(3)))
#define CAS __attribute__((address_space(4)))
typedef unsigned short bf16;
typedef short bf16x8 __attribute__((ext_vector_type(8)));
typedef float f32x4 __attribute__((ext_vector_type(4)));
typedef float f32x2 __attribute__((ext_vector_type(2)));
typedef unsigned u32x4 __attribute__((ext_vector_type(4)));
typedef unsigned u32x2 __attribute__((ext_vector_type(2)));

constexpr int D = 1024, SEQ = 8192, LC = 256, TL = 16384, TC = 512, TT = TL + TC, DEPTH = 2;
constexpr int NE = 16, DE = 512;
constexpr int NIN = 2816;
constexpr int PC_Q = 0, PC_K = 256, PC_V = 512, PC_G = 1024, PC_SQ = 1536, PC_SK = 2048, PC_SV = 2176, PC_GF = 2304, PC_GB = 2560;
constexpr int WIN_COLS = 2336;
constexpr float EPS = 1e-6f;
constexpr float LOG2E = 1.4426950408889634f, QSCALE = 0.125f * LOG2E;
constexpr int LISTCAP = TT;

constexpr size_t MiB = 1u << 20;
constexpr size_t WS_CTL = 0, CTL_ZERO_BYTES = 65536;
constexpr size_t WS_MOD = 1 * MiB;
constexpr size_t WS_ROPE = 1 * MiB + 256 * 1024;
constexpr size_t WS_LIST = 2 * MiB;
constexpr size_t WS_LISTW = 2 * MiB + 1536 * 1024;
constexpr size_t WS_XC = 5 * MiB;
constexpr size_t WS_WIN = 8 * MiB;
constexpr size_t WS_WOUT = 19 * MiB;
constexpr size_t WS_WGU = 23 * MiB;
constexpr size_t WS_WD = 87 * MiB;
constexpr size_t WS_H = 119 * MiB;
constexpr size_t WS_P = 152 * MiB;
constexpr size_t WS_MIX = 243 * MiB;
constexpr size_t WS_GL = 276 * MiB;
constexpr size_t WS_HMID = 152 * MiB;
constexpr size_t WS_Y = 190 * MiB;
constexpr size_t WS_END = 309 * MiB;
static_assert(WS_LIST + (size_t)NE * LISTCAP * 4 <= WS_LISTW && WS_LISTW + (size_t)NE * LISTCAP * 4 <= WS_XC, "ws map");
static_assert(WS_P + (size_t)TT * NIN * 2 <= WS_MIX && WS_MIX + (size_t)TT * D * 2 <= WS_GL, "ws map");
static_assert(WS_HMID + (size_t)37888 * 512 * 2 <= WS_Y && WS_Y + (size_t)2 * TT * D * 2 <= WS_GL, "ws map");
constexpr int CW_CNT = 64;
constexpr int CW_BAR = 4096;

__device__ __forceinline__ unsigned f2bf(float f) { unsigned u = __builtin_bit_cast(unsigned, f); return (u + 0x7fffu + ((u >> 16) & 1u)) >> 16; }
__device__ __forceinline__ unsigned pk2(float lo, float hi) { return f2bf(lo) | (f2bf(hi) << 16); }
__device__ __forceinline__ float bf2f(unsigned h) { return __builtin_bit_cast(float, h << 16); }
__device__ __forceinline__ float bflo(unsigned w) { return __builtin_bit_cast(float, w << 16); }
__device__ __forceinline__ float bfhi(unsigned w) { return __builtin_bit_cast(float, w & 0xffff0000u); }
__device__ __forceinline__ float dpp_add(float v, float t) { return v + t; }
#define DPP_F(v, ctrl, rmask) __builtin_bit_cast(float, __builtin_amdgcn_update_dpp(0, __builtin_bit_cast(int, (v)), (ctrl), (rmask), 0xF, false))
__device__ __forceinline__ float row16_sum(float v) {
    v += DPP_F(v, 0xB1, 0xF); v += DPP_F(v, 0x4E, 0xF); v += DPP_F(v, 0x141, 0xF); v += DPP_F(v, 0x140, 0xF); return v;
}
__device__ __forceinline__ float wave_sum(float v) {
    v = row16_sum(v);
    v += DPP_F(v, 0x142, 0xA); v += DPP_F(v, 0x143, 0xC);
    return __builtin_bit_cast(float, __builtin_amdgcn_readlane(__builtin_bit_cast(int, v), 63));
}
__device__ __forceinline__ float silu_f(float x) { return x / (1.0f + __expf(-x)); }
#define LDS_WAIT() asm volatile("s_waitcnt lgkmcnt(0)" ::: "memory")
#define VM_WAIT() asm volatile("s_waitcnt vmcnt(0)" ::: "memory")

namespace pg8 {
constexpr int BM = 256, BK = 64, HALF = 128, HTB = HALF * BK * 2, STAGE_BYTES = 8 * HTB, NXCD = 8, WGM = 8;
__host__ __device__ __forceinline__ int lds_byte(int r, int c) { const int st = (r >> 4) * 2 + (c >> 5), rr = r & 15, cc = c & 31, ob = rr * 64 + cc * 2; return st * 1024 + (ob ^ (((ob >> 9) & 1) << 5)); }
__host__ __device__ __forceinline__ void stage_rc(int b, int& R, int& C) { const int st = b / 1024, sb = b % 1024, swz = sb ^ (((sb >> 9) & 1) << 5); R = (st >> 1) * 16 + swz / 64; C = (st & 1) * 32 + (swz % 64) / 2; }
__host__ __device__ __forceinline__ int perm32(int rho) { const int n = rho >> 4, i = rho & 15; return 8 * (i >> 2) + 4 * n + (i & 3); }

struct Unit { int pm, pn, e, mt; };

__device__ __forceinline__ int xcd_remap(int wgid, int nwg) { const int q = nwg / NXCD, r = nwg % NXCD, xcd = wgid % NXCD, off = wgid / NXCD; return (xcd < r ? xcd * (q + 1) : r * (q + 1) + (xcd - r) * q) + off; }

struct DenseOrder {
    static constexpr bool DYN_A = false;
    const char* A; const char* Bt; int K; int nM, nN, nwg, G, c;
    __device__ void init(const void* A_, const void* Bt_, int M, int N, int K_, int G_, int c_) { A = (const char*)A_; Bt = (const char*)Bt_; K = K_; nM = M / BM; nN = N / BM; nwg = nM * nN; G = G_; c = c_; }
    __device__ __forceinline__ bool next(int i, Unit& u) const {
        const long L = (long)i * G + c; if (L >= nwg) return false;
        const int wgid = xcd_remap((int)L, nwg);
        const int nig = WGM * nN, gid = wgid / nig, fm = gid * WGM, gsz = (nM - fm) < WGM ? (nM - fm) : WGM;
        u.pm = fm + ((wgid % nig) % gsz); u.pn = (wgid % nig) / gsz; u.e = 0; u.mt = 0; return true;
    }
    __device__ __forceinline__ const char* a_ptr(const Unit& u) const { return A + (size_t)u.pm * (size_t)(BM * K * 2); }
    __device__ __forceinline__ const char* b_ptr(const Unit& u) const { return Bt + (size_t)u.pn * (size_t)(BM * K * 2); }
    __device__ __forceinline__ void a_voff(const Unit&, const int (&R)[2], const int (&C)[2], unsigned (&v0)[2], unsigned (&v1)[2]) const {
#pragma unroll
        for (int i = 0; i < 2; ++i) { v0[i] = (unsigned)(R[i] * K + C[i]) * 2u; v1[i] = v0[i] + (unsigned)(HALF * K * 2); }
    }
};

struct MoeOrder {
    static constexpr bool DYN_A = true;
    const char* A; const char* Bt; int K; size_t bstride_e; int G, c, nunits, nN; bool gather;
    const unsigned* list; const LAS int* tab;
    __device__ __forceinline__ bool next(int i, Unit& u) const {
        const long L = (long)i * G + c; if (L >= nunits) return false;
        const int wgid = xcd_remap((int)L, nunits);
        const int tl = wgid / nN; u.pn = wgid % nN;
        int e = 0, tstart = 0;
#pragma unroll 1
        for (int k = 0; k < NE - 1; ++k) { const int te = tab[16 + k]; if (tl >= te) { e = k + 1; tstart = te; } }
        u.e = __builtin_amdgcn_readfirstlane(e); u.mt = __builtin_amdgcn_readfirstlane(tl - tstart); u.pm = tl; return true;
    }
    __device__ __forceinline__ const char* a_ptr(const Unit& u) const { return gather ? A : A + (size_t)u.pm * (size_t)(BM * K * 2); }
    __device__ __forceinline__ const char* b_ptr(const Unit& u) const { return Bt + (size_t)u.e * bstride_e + (size_t)u.pn * (size_t)(BM * K * 2); }
    __device__ __forceinline__ void a_voff(const Unit& u, const int (&R)[2], const int (&C)[2], unsigned (&v0)[2], unsigned (&v1)[2]) const {
        if (gather) {
            const int ce = tab[u.e];
            const unsigned* lp = list + (size_t)u.e * LISTCAP + u.mt * BM;
#pragma unroll
            for (int i = 0; i < 2; ++i) {
                const int r0 = R[i], r1 = R[i] + HALF;
                const unsigned t0 = (u.mt * BM + r0 < ce) ? (__builtin_nontemporal_load(lp + r0) >> 1) : 0u;
                const unsigned t1 = (u.mt * BM + r1 < ce) ? (__builtin_nontemporal_load(lp + r1) >> 1) : 0u;
                v0[i] = (t0 * (unsigned)K + (unsigned)C[i]) * 2u; v1[i] = (t1 * (unsigned)K + (unsigned)C[i]) * 2u;
            }
        } else {
#pragma unroll
            for (int i = 0; i < 2; ++i) { v0[i] = (unsigned)(R[i] * K + C[i]) * 2u; v1[i] = v0[i] + (unsigned)(HALF * K * 2); }
        }
    }
};

__device__ __forceinline__ unsigned cvt_pk_bf16(float lo, float hi) { unsigned r; asm volatile("v_cvt_pk_bf16_f32 %0, %1, %2" : "=v"(r) : "v"(lo), "v"(hi)); return r; }

template <class Epi, class Sched>
__device__ __forceinline__ void gemm_phase(LAS unsigned char* lds, int tid, const Sched& S, const Epi& E) {
    const int wid = __builtin_amdgcn_readfirstlane(tid >> 6), lane = tid & 63, wr = wid >> 2, wc = wid & 3, fr = lane & 15, fq = lane >> 4;
    const int K = S.K, nt = K / BK;
    int Rr[2], Cc[2]; unsigned voffB[2];
#pragma unroll
    for (int i = 0; i < 2; ++i) { int R, C; stage_rc(tid * 16 + i * 8192, R, C); const int Rb = Epi::PERM ? ((R & ~31) + perm32(R & 31)) : R;
        Rr[i] = R; Cc[i] = C; voffB[i] = (unsigned)(Rb * K + C) * 2u; }
    const size_t kstep = (size_t)(BK * 2);
    const size_t hstep = (size_t)HALF * K * 2;
    const unsigned ldsw = (unsigned)wid * 1024u;
    const int aoff = lds_byte(wr * 64 + fr, fq * 8), boff = lds_byte(wc * 32 + fr, fq * 8);
#define PG8_SA(b, h) (((b) * 2 + (h)) * HTB)
#define PG8_SB(b, h) ((4 + (b) * 2 + (h)) * HTB)
#define PG8_STAGE(bufoff, gbase, voff) do { _Pragma("unroll") for (int _i = 0; _i < 2; ++_i) \
        __builtin_amdgcn_global_load_lds((const unsigned*)((const char*)(gbase) + (voff)[_i]), (LAS unsigned*)(lds + (bufoff) + ldsw + _i * 8192), 16, 0, 0); } while (0)
#define PG8_LDA(dst, b, h) do { _Pragma("unroll") for (int m = 0; m < 4; ++m) _Pragma("unroll") for (int k = 0; k < 2; ++k) dst[m][k] = *(const LAS bf16x8*)(lds + PG8_SA(b, h) + aoff + m * 2048 + k * 1024); } while (0)
#define PG8_LDB(dst, b, h) do { _Pragma("unroll") for (int n = 0; n < 2; ++n) _Pragma("unroll") for (int k = 0; k < 2; ++k) dst[n][k] = *(const LAS bf16x8*)(lds + PG8_SB(b, h) + boff + n * 2048 + k * 1024); } while (0)
#define PG8_MMA(ai, bj, At, Bt) do { __builtin_amdgcn_s_setprio(1); _Pragma("unroll") for (int m = 0; m < 4; ++m) _Pragma("unroll") for (int n = 0; n < 2; ++n) _Pragma("unroll") for (int k = 0; k < 2; ++k) \
        acc[ai][bj][m][n] = __builtin_amdgcn_mfma_f32_16x16x32_bf16(Bt[n][k], At[m][k], acc[ai][bj][m][n], 0, 0, 0); __builtin_amdgcn_s_setprio(0); } while (0)
#define PG8_WAIT_V(n) asm volatile("s_waitcnt vmcnt(" #n ")" ::: "memory")
#define PG8_WAIT_L(n) asm volatile("s_waitcnt lgkmcnt(" #n ")" ::: "memory")
#define PG8_BAR __builtin_amdgcn_s_barrier()
#define PG8_SCHED __builtin_amdgcn_sched_barrier(0)
    Unit cur, nxt; int ui = 0;
    if (!S.next(0, cur)) return;
    f32x4 acc[2][2][4][2];
#pragma unroll
    for (int a = 0; a < 2; ++a)
#pragma unroll
        for (int b = 0; b < 2; ++b)
#pragma unroll
            for (int m = 0; m < 4; ++m)
#pragma unroll
                for (int n = 0; n < 2; ++n) acc[a][b][m][n] = (f32x4){0.f, 0.f, 0.f, 0.f};
    bf16x8 At[4][2], B0[2][2], B1[2][2];
    const char* cA = S.a_ptr(cur); const char* cB = S.b_ptr(cur);
    unsigned cv0[2], cv1[2], nv0[2], nv1[2];
    S.a_voff(cur, Rr, Cc, cv0, cv1);
    PG8_STAGE(PG8_SB(0, 0), cB, voffB); PG8_STAGE(PG8_SB(0, 1), cB + hstep, voffB); PG8_STAGE(PG8_SA(0, 0), cA, cv0); PG8_STAGE(PG8_SA(0, 1), cA, cv1);
    if (wr == 1) PG8_BAR;
    PG8_WAIT_V(2); PG8_BAR;
    PG8_STAGE(PG8_SB(1, 0), cB + kstep, voffB); PG8_STAGE(PG8_SA(1, 0), cA + kstep, cv0); PG8_STAGE(PG8_SB(1, 1), cB + hstep + kstep, voffB);
    PG8_WAIT_V(6); PG8_BAR;
    for (;;) {
        const bool has_next = S.next(ui + 1, nxt);
        const char* nA = has_next ? S.a_ptr(nxt) : cA; const char* nB = has_next ? S.b_ptr(nxt) : cB;
        if (has_next) S.a_voff(nxt, Rr, Cc, nv0, nv1); else { nv0[0] = cv0[0]; nv0[1] = cv0[1]; nv1[0] = cv1[0]; nv1[1] = cv1[1]; }
        if constexpr (Sched::DYN_A) asm volatile("" : "+v"(nv0[0]), "+v"(nv0[1]), "+v"(nv1[0]), "+v"(nv1[1]));
        for (int t = 0; t < nt; t += 2) {
            const bool last = (t == nt - 2);
            const char* a1 = cA + (size_t)(t + 1) * kstep;
            const char* a2 = last ? nA : cA + (size_t)(t + 2) * kstep; const char* b2 = last ? nB : cB + (size_t)(t + 2) * kstep;
            const char* a3 = a2 + kstep; const char* b3 = b2 + kstep;
            unsigned w0[2], w1[2];
            w0[0] = last ? nv0[0] : cv0[0]; w0[1] = last ? nv0[1] : cv0[1]; w1[0] = last ? nv1[0] : cv1[0]; w1[1] = last ? nv1[1] : cv1[1];
            PG8_LDB(B0, 0, 0); PG8_LDB(B1, 0, 1); PG8_SCHED; PG8_LDA(At, 0, 0); PG8_STAGE(PG8_SA(1, 1), a1, cv1);
            PG8_WAIT_V(8); PG8_WAIT_L(0); PG8_BAR; PG8_MMA(0, 0, At, B0); PG8_MMA(0, 1, At, B1); PG8_BAR; PG8_SCHED;
            PG8_LDA(At, 0, 1); PG8_STAGE(PG8_SB(0, 0), b2, voffB); PG8_STAGE(PG8_SB(0, 1), b2 + hstep, voffB); PG8_STAGE(PG8_SA(0, 0), a2, w0);
            PG8_WAIT_V(8); PG8_WAIT_L(0); PG8_BAR; PG8_MMA(1, 0, At, B0); PG8_MMA(1, 1, At, B1); PG8_BAR; PG8_SCHED;
            PG8_LDB(B0, 1, 0); PG8_LDB(B1, 1, 1); PG8_SCHED; PG8_LDA(At, 1, 0); PG8_STAGE(PG8_SA(0, 1), a2, w1);
            PG8_WAIT_V(8); PG8_WAIT_L(0); PG8_BAR; PG8_MMA(0, 0, At, B0); PG8_MMA(0, 1, At, B1); PG8_BAR; PG8_SCHED;
            PG8_LDA(At, 1, 1); PG8_STAGE(PG8_SB(1, 0), b3, voffB); PG8_STAGE(PG8_SB(1, 1), b3 + hstep, voffB); PG8_STAGE(PG8_SA(1, 0), a3, w0);
            PG8_WAIT_V(8); PG8_WAIT_L(0); PG8_BAR; PG8_MMA(1, 0, At, B0); PG8_MMA(1, 1, At, B1); PG8_BAR; PG8_SCHED;
        }
        if (wr == 0) PG8_BAR;
        E(acc, cur, wr, wc, fr, fq);
        if (!has_next) break;
#pragma unroll
        for (int a = 0; a < 2; ++a)
#pragma unroll
            for (int b = 0; b < 2; ++b)
#pragma unroll
                for (int m = 0; m < 4; ++m)
#pragma unroll
                    for (int n = 0; n < 2; ++n) acc[a][b][m][n] = (f32x4){0.f, 0.f, 0.f, 0.f};
        cur = nxt; cA = nA; cB = nB; ++ui;
        cv0[0] = nv0[0]; cv0[1] = nv0[1]; cv1[0] = nv1[0]; cv1[1] = nv1[1];
        if (wr == 1) PG8_BAR;
    }
    PG8_WAIT_V(0);
    PG8_BAR;
#undef PG8_SA
#undef PG8_SB
#undef PG8_STAGE
#undef PG8_LDA
#undef PG8_LDB
#undef PG8_MMA
#undef PG8_WAIT_V
#undef PG8_WAIT_L
#undef PG8_BAR
#undef PG8_SCHED
}
}

#define XB_TMO      128
#define XB_XCNT(j)  (256  + 64 * (j))
#define XB_XSUB(j)  (1280 + 64 * (j))
#define XB_XGEN(j)  (2304 + 64 * (j))
#define XB_TOP      3328
#define XB_TOPGEN   3392
#define XCD_BAR_WORDS 3456
#define XB_SPIN_CAP (1u << 18)
__device__ __forceinline__ unsigned xb_ld(unsigned* p)              { return __hip_atomic_load(p, __ATOMIC_RELAXED, __HIP_MEMORY_SCOPE_AGENT); }
__device__ __forceinline__ unsigned xb_add(unsigned* p, unsigned v) { return __hip_atomic_fetch_add(p, v, __ATOMIC_RELAXED, __HIP_MEMORY_SCOPE_AGENT); }
__device__ __forceinline__ unsigned xb_xcc_id() { return (unsigned)__builtin_amdgcn_s_getreg((3 << 11) | 20) & 0xFu; }
#define XB_SPIN(cond, bar) do { unsigned _sp = 0; while (cond) { __builtin_amdgcn_s_sleep(1); \
    if ((++_sp & 255u) == 0u) { if (xb_ld(&(bar)[XB_TMO])) break; if (_sp > XB_SPIN_CAP) { atomicAdd(&(bar)[XB_TMO], 1u); break; } } } } while (0)
struct XcdBarrier { unsigned* bar; unsigned x; volatile LAS unsigned* st; };
__device__ __forceinline__ XcdBarrier xcd_barrier_post(unsigned* bar, volatile LAS unsigned* st) {
    XcdBarrier b; b.bar = bar; b.x = xb_xcc_id(); b.st = st;
    if (threadIdx.x == 0) (void)xb_add(&bar[XB_XCNT(b.x)], 1u);
    return b;
}
__device__ __forceinline__ void xcd_barrier_complete(unsigned* bar, unsigned x, unsigned& nloc, unsigned& nx) {
    const unsigned G = gridDim.x * gridDim.y * gridDim.z;
    unsigned sum, cnt, mine, sp = 0u;
    for (;;) {
        sum = 0u; cnt = 0u; mine = 0u;
#pragma unroll
        for (unsigned j = 0; j < 16; ++j) { const unsigned c = xb_ld(&bar[XB_XCNT(j)]); sum += c; cnt += (c > 0u) ? 1u : 0u; mine = (j == x) ? c : mine; }
        if (sum == G) break;
        __builtin_amdgcn_s_sleep(1);
        if ((++sp & 255u) == 0u) { if (xb_ld(&bar[XB_TMO])) break; if (sp > XB_SPIN_CAP) { atomicAdd(&bar[XB_TMO], 1u); break; } }
    }
    nloc = mine > 0u ? mine : 1u; nx = cnt > 0u ? cnt : 1u;
}
__device__ __forceinline__ void xcd_barrier(const XcdBarrier& b, int tid) {
    asm volatile("s_waitcnt vmcnt(0)" ::: "memory");
    __syncthreads();
    if (tid == 0) {
        unsigned* bar = b.bar;
        __builtin_amdgcn_s_waitcnt(0);
        unsigned nloc = b.st[0], nx = b.st[1];
        if (nloc == 0u) { xcd_barrier_complete(bar, b.x, nloc, nx); b.st[0] = nloc; b.st[1] = nx; }
        const unsigned old = xb_add(&bar[XB_XSUB(b.x)], 1u);
        const unsigned gen = old / nloc;
        if (old + 1u == (gen + 1u) * nloc) {
            __builtin_amdgcn_fence(__ATOMIC_RELEASE, "agent");
            asm volatile("s_waitcnt vmcnt(0)" ::: "memory");
            const unsigned og = xb_add(&bar[XB_TOP], 1u);
            const unsigned tg = og / nx;
            if (og + 1u == (tg + 1u) * nx) xb_add(&bar[XB_TOPGEN], 1u);
            else XB_SPIN(xb_ld(&bar[XB_TOPGEN]) == tg, bar);
            __builtin_amdgcn_fence(__ATOMIC_ACQUIRE, "agent");
            xb_add(&bar[XB_XGEN(b.x)], 1u);
            asm volatile("s_waitcnt vmcnt(0)" ::: "memory");
        } else {
            XB_SPIN(xb_ld(&bar[XB_XGEN(b.x)]) == gen, bar);
            __builtin_amdgcn_fence(__ATOMIC_ACQUIRE, "agent");
            asm volatile("s_waitcnt vmcnt(0)" ::: "memory");
        }
    }
    __syncthreads();
}

constexpr int NWAVES = 8;
constexpr int RING_BYTES = 131072, LDSCTL_OFF = RING_BYTES, MISC_OFF = LDSCTL_OFF + 320, LDS_BYTES = 147456;
struct Args { const float* in[22]; float* out; unsigned char* ws; int ph_lo, ph_hi, li, pad; };
enum { I_X = 0, I_C, I_CTX, I_CCTX, I_WADA, I_BADA, I_NORM1, I_NORM2, I_WIN, I_UPF, I_BIASF, I_UPB, I_BIASB, I_GLANORM, I_SINK, I_WOUT, I_WROUTER, I_BROUTER, I_WGATE, I_WUP, I_WDOWN, I_FNORM };

struct Frame {
    LAS unsigned char* lds; int tid, lane, wave, vcu, G, gw, NGW;
    unsigned char* ws; float* out;
};

__device__ __forceinline__ int rope_pos(int d) { return 8 * ((d & 15) >> 2) + 4 * (d >> 4) + (d & 3); }
__device__ __forceinline__ int gu_row(int h, int gu) { return (h >> 7) * 256 + ((h >> 6) & 1) * 128 + ((h >> 4) & 3) * 32 + ((h >> 2) & 3) * 8 + gu * 4 + (h & 3); }
__device__ __forceinline__ void transpose_item(const float* W, int N, bf16* WT, int Kd, int k0, int n0, int rbase, int mode, LAS float* scr, int lane) {
#pragma unroll 8
    for (int i = 0; i < 32; ++i) { const int kk = 2 * i + (lane >> 5); scr[kk * 33 + (lane & 31)] = W[(size_t)(k0 + kk) * N + n0 + (lane & 31)]; }
    LDS_WAIT(); asm volatile("" ::: "memory");
    const int c = lane & 7;
#pragma unroll
    for (int j = 0; j < 4; ++j) { const int n = (lane >> 3) + 8 * j; const LAS float* s = scr + (8 * c) * 33 + n;
        u32x4 o; o.x = pk2(s[0 * 33], s[1 * 33]); o.y = pk2(s[2 * 33], s[3 * 33]); o.z = pk2(s[4 * 33], s[5 * 33]); o.w = pk2(s[6 * 33], s[7 * 33]);
        const int row = (mode == 0) ? rbase + n : (mode == 1) ? rbase + rope_pos(n) : gu_row(n0 + n, mode - 2);
        *(u32x4*)(WT + (size_t)row * Kd + k0 + 8 * c) = o; }
    LDS_WAIT(); asm volatile("" ::: "memory");
}

__device__ __forceinline__ void p0_prologue(const Frame& F, const CAS Args* a) {
    unsigned char* ws = F.ws;
    LAS float* scr = (LAS float*)(F.lds + F.wave * 16384);
    constexpr int IT_IN = 2 * 16 * 73, IT_OUT = 2 * 16 * 32, IT_G = 32 * 16 * 16, IT_D = 32 * 8 * 32;
    constexpr int NITEMS = IT_IN + IT_OUT + 2 * IT_G + IT_D;
    for (int it = F.gw; it < NITEMS; it += F.NGW) {
        int r = it;
        if (r < IT_IN) {
            const int l = r / 1168, rr = r % 1168, kb = rr / 73, nb = rr % 73;
            if (nb == 48) continue;
            const int n0 = nb * 32; int rbase, mode = 0;
            if (n0 < 1536) rbase = n0;
            else if (n0 < 2080) { rbase = PC_SQ + (n0 - 1568); mode = 1; }
            else if (n0 < 2208) { rbase = PC_SK + (n0 - 2080); mode = 1; }
            else rbase = PC_SV + (n0 - 2208);
            transpose_item(a->in[I_WIN] + (size_t)l * D * WIN_COLS, WIN_COLS, (bf16*)(ws + WS_WIN) + (size_t)l * NIN * D, D, kb * 64, n0, rbase, mode, scr, F.lane);
            continue;
        }
        r -= IT_IN;
        if (r < IT_OUT) { const int l = r / 512, rr = r % 512, kb = rr / 32, nb = rr % 32;
            transpose_item(a->in[I_WOUT] + (size_t)l * D * D, D, (bf16*)(ws + WS_WOUT) + (size_t)l * D * D, D, kb * 64, nb * 32, nb * 32, 0, scr, F.lane); continue; }
        r -= IT_OUT;
        if (r < 2 * IT_G) { const int gu = r / IT_G, r2 = r % IT_G, le = r2 / 256, rr = r2 % 256, kb = rr / 16, nb = rr % 16;
            transpose_item(a->in[gu ? I_WUP : I_WGATE] + (size_t)le * D * DE, DE, (bf16*)(ws + WS_WGU) + (size_t)le * D * D, D, kb * 64, nb * 32, 0, 2 + gu, scr, F.lane); continue; }
        r -= 2 * IT_G;
        { const int le = r / 256, rr = r % 256, kb = rr / 32, nb = rr % 32;
            transpose_item(a->in[I_WDOWN] + (size_t)le * DE * D, D, (bf16*)(ws + WS_WD) + (size_t)le * D * DE, DE, kb * 64, nb * 32, nb * 32, 0, scr, F.lane); }
    }
    for (int idx = F.gw * 64 + F.lane; idx < 2 * 2 * 256 * 128; idx += F.NGW * 64) {
        const int kc = idx & 127, n = (idx >> 7) & 255, dir = (idx >> 15) & 1, l = idx >> 16;
        const float* up = a->in[dir ? I_UPB : I_UPF] + (size_t)l * 16 * 256 + n;
        float u[16];
#pragma unroll
        for (int r = 0; r < 16; ++r) u[r] = up[r * 256];
        float o[8];
#pragma unroll
        for (int kk = 0; kk < 8; ++kk) {
            const f32x4* wz = (const f32x4*)(a->in[I_WIN] + ((size_t)l * D + kc * 8 + kk) * WIN_COLS + 1536 + dir * 16);
            float s = 0.f;
#pragma unroll
            for (int q = 0; q < 4; ++q) { const f32x4 w = wz[q]; s += w[0] * u[4 * q] + w[1] * u[4 * q + 1] + w[2] * u[4 * q + 2] + w[3] * u[4 * q + 3]; }
            o[kk] = s;
        }
        u32x4 ov; ov.x = pk2(o[0], o[1]); ov.y = pk2(o[2], o[3]); ov.z = pk2(o[4], o[5]); ov.w = pk2(o[6], o[7]);
        *(u32x4*)((bf16*)(ws + WS_WIN) + ((size_t)l * NIN + PC_GF + dir * 256 + n) * D + kc * 8) = ov;
    }
    if (blockIdx.x == (unsigned)(F.G - 1)) {
        float* tc = (float*)(ws + WS_ROPE); float* tsn = tc + 2048;
        for (int i = F.tid; i < 2048; i += NWAVES * 64) { const int pos = i >> 4, j = i & 15; const float inv = powf(10000.0f, -(float)j * (1.0f / 16.0f)); const float ang = (float)pos * inv;
            tc[i] = cosf(ang); tsn[i] = sinf(ang); }
    }
    __syncthreads();
    {
        LAS float* cs = (LAS float*)F.lds; LAS float* red = cs + 3072;
        for (int i = F.tid; i < 3072; i += NWAVES * 64) { const int v = i >> 10, k = i & 1023; const float cv = v < 2 ? a->in[I_C][v * D + k] : a->in[I_CCTX][k]; cs[i] = cv / (1.0f + expf(-cv)); }
        __syncthreads();
        for (int u = blockIdx.x; u < 192; u += F.G) {
            const int l = u / 96, jg = u % 96, jl = F.tid & 63, ks = F.tid >> 6;
            const float* wp = a->in[I_WADA] + ((size_t)l * D + ks * 128) * 6144 + jg * 64 + jl;
            float a0 = 0.f, a1 = 0.f, a2 = 0.f;
#pragma unroll 8
            for (int k = 0; k < 128; ++k) { const float w = wp[(size_t)k * 6144]; const int kk = ks * 128 + k; a0 += cs[kk] * w; a1 += cs[1024 + kk] * w; a2 += cs[2048 + kk] * w; }
            red[(ks * 3 + 0) * 64 + jl] = a0; red[(ks * 3 + 1) * 64 + jl] = a1; red[(ks * 3 + 2) * 64 + jl] = a2;
            __syncthreads();
            if (F.tid < 192) { const int v = F.tid >> 6, j2 = F.tid & 63; float s = 0.f;
#pragma unroll
                for (int q = 0; q < 8; ++q) s += red[(q * 3 + v) * 64 + j2];
                ((float*)(ws + WS_MOD))[(l * 3 + v) * 6144 + jg * 64 + j2] = s + a->in[I_BADA][l * 6144 + jg * 64 + j2]; }
            __syncthreads();
        }
    }
}

__device__ __forceinline__ f32x4 ld_y4(const bf16* p) { const u32x2 w = *(const u32x2*)p; return (f32x4){bflo(w.x), bfhi(w.x), bflo(w.y), bfhi(w.y)}; }
__device__ __forceinline__ void n1_phase(const Frame& F, const CAS Args* a, int l) {
    unsigned char* ws = F.ws;
    const float* mod = (const float*)(ws + WS_MOD);
    const bf16* Y0 = (const bf16*)(ws + WS_Y); const bf16* Y1 = Y0 + (size_t)TT * D;
    bf16* H = (bf16*)(ws + WS_H);
    for (int m = F.gw; m < TT; m += F.NGW) {
        const int v = m < TL ? (m >> 13) : 2;
        float* xrow = m < TL ? F.out + (size_t)m * D : (float*)(ws + WS_XC) + (size_t)(m - TL) * D;
        const float* src = (l == 0) ? (m < TL ? a->in[I_X] + (size_t)m * D : a->in[I_CTX] + (size_t)(m - TL) * D) : xrow;
        f32x4 x[4]; float ss = 0.f;
#pragma unroll
        for (int j = 0; j < 4; ++j) {
            const int col = 4 * F.lane + 256 * j;
            x[j] = *(const f32x4*)(src + col);
            if (l > 0) {
                const f32x4 g2 = *(const f32x4*)(mod + ((l - 1) * 3 + v) * 6144 + 5 * D + col);
                const f32x4 y = ld_y4(Y0 + (size_t)m * D + col) + ld_y4(Y1 + (size_t)m * D + col);
                x[j] = x[j] + g2 * y;
                *(f32x4*)(xrow + col) = x[j];
            }
            ss += (x[j][0] * x[j][0] + x[j][1] * x[j][1]) + (x[j][2] * x[j][2] + x[j][3] * x[j][3]);
        }
        const float rstd = 1.0f / sqrtf(wave_sum(ss) * (1.0f / D) + EPS);
#pragma unroll
        for (int j = 0; j < 4; ++j) {
            const int col = 4 * F.lane + 256 * j;
            const f32x4 nw = *(const f32x4*)(a->in[I_NORM1] + l * D + col);
            const f32x4 sh = *(const f32x4*)(mod + (l * 3 + v) * 6144 + 0 * D + col);
            const f32x4 sc = *(const f32x4*)(mod + (l * 3 + v) * 6144 + 1 * D + col);
            const f32x4 h = x[j] * rstd * nw * (1.0f + sc) + sh;
            u32x2 o; o.x = pk2(h[0], h[1]); o.y = pk2(h[2], h[3]);
            *(u32x2*)(H + (size_t)m * D + col) = o;
        }
    }
}

struct EpiIn {
    static constexpr bool PERM = true;
    bf16* P; const float* bias_f; const float* bias_b; const float* tcos; const float* tsin;
    __device__ __forceinline__ void operator()(const f32x4 (&acc)[2][2][4][2], const pg8::Unit& u, int wr, int wc, int fr, int fq) const {
        const int row0 = u.pm * 256 + wr * 64 + fr, colw = wc * 32 + 8 * fq;
        const int pn = u.pn;
        const bool latent = u.pm < 64;
#pragma unroll
        for (int ai = 0; ai < 2; ++ai)
#pragma unroll
            for (int m = 0; m < 4; ++m) {
                const int row = row0 + ai * 128 + m * 16;
                bf16* rowp = P + (size_t)row * NIN + pn * 256 + colw;
#pragma unroll
                for (int bj = 0; bj < 2; ++bj) {
                    f32x4 v0 = acc[ai][bj][m][0], v1 = acc[ai][bj][m][1];
                    if (pn == 0) { v0 = v0 * 0.125f; v1 = v1 * 0.125f; }
                    else if (pn >= 9) {
                        const float* bp = (pn == 9 ? bias_f : bias_b) + colw + bj * 128;
                        const f32x4 b0 = *(const f32x4*)bp, b1 = *(const f32x4*)(bp + 4);
#pragma unroll
                        for (int i = 0; i < 4; ++i) { float x0 = v0[i] + b0[i], x1 = v1[i] + b1[i];
                            v0[i] = (fminf(x0, 0.f) - log1pf(expf(-fabsf(x0)))) * 0.0625f; v1[i] = (fminf(x1, 0.f) - log1pf(expf(-fabsf(x1)))) * 0.0625f; }
                    } else if (latent && (pn == 6 || pn == 7 || (pn == 8 && bj == 0))) {
                        const int t = row & (SEQ - 1); const int pos = (wc & 1) ? (t & 63) : (t >> 6);
                        const f32x4 cs = *(const f32x4*)(tcos + pos * 16 + 4 * fq), sn = *(const f32x4*)(tsin + pos * 16 + 4 * fq);
                        const f32x4 o0 = v0 * cs - v1 * sn, o1 = v1 * cs + v0 * sn; v0 = o0; v1 = o1;
                    }
                    if (pn == 6 || pn == 7) { v0 = v0 * QSCALE; v1 = v1 * QSCALE; }
                    u32x4 w; w.x = pg8::cvt_pk_bf16(v0[0], v0[1]); w.y = pg8::cvt_pk_bf16(v0[2], v0[3]); w.z = pg8::cvt_pk_bf16(v1[0], v1[1]); w.w = pg8::cvt_pk_bf16(v1[2], v1[3]);
                    *(u32x4*)(rowp + bj * 128) = w;
                }
            }
    }
};
struct EpiOut {
    static constexpr bool PERM = false;
    const float* resL; const float* resC; float* outL; float* outC; const float* mod_l;
    __device__ __forceinline__ void operator()(const f32x4 (&acc)[2][2][4][2], const pg8::Unit& u, int wr, int wc, int fr, int fq) const {
        const bool latent = u.pm < 64;
        const int v = latent ? (u.pm >> 5) : 2;
        const int rowb = (latent ? u.pm * 256 : u.pm * 256 - TL) + wr * 64 + fr;
        const float* res = latent ? resL : resC; float* out = latent ? outL : outC;
        const int col0 = u.pn * 256 + wc * 32 + 4 * fq;
        const float* g1p = mod_l + v * 6144 + 2 * D + col0;
#pragma unroll
        for (int ai = 0; ai < 2; ++ai)
#pragma unroll
            for (int m = 0; m < 4; ++m) {
                const size_t off = (size_t)(rowb + ai * 128 + m * 16) * D + col0;
#pragma unroll
                for (int bj = 0; bj < 2; ++bj)
#pragma unroll
                    for (int n = 0; n < 2; ++n) {
                        const f32x4 g1 = *(const f32x4*)(g1p + bj * 128 + n * 16);
                        const f32x4 r = *(const f32x4*)(res + off + bj * 128 + n * 16);
                        *(f32x4*)(out + off + bj * 128 + n * 16) = r + g1 * acc[ai][bj][m][n];
                    }
                if (m & 1) asm volatile("" ::: "memory");
            }
    }
};
struct EpiGU {
    static constexpr bool PERM = true;
    bf16* Hmid;
    __device__ __forceinline__ void operator()(const f32x4 (&acc)[2][2][4][2], const pg8::Unit& u, int wr, int wc, int fr, int fq) const {
        const int row0 = u.pm * 256 + wr * 64 + fr, hid0 = u.pn * 128 + wc * 16 + fq * 4;
#pragma unroll
        for (int ai = 0; ai < 2; ++ai)
#pragma unroll
            for (int m = 0; m < 4; ++m) {
                bf16* rowp = Hmid + (size_t)(row0 + ai * 128 + m * 16) * DE + hid0;
#pragma unroll
                for (int bj = 0; bj < 2; ++bj) {
                    const f32x4 g = acc[ai][bj][m][0], up = acc[ai][bj][m][1]; f32x4 o;
#pragma unroll
                    for (int i = 0; i < 4; ++i) o[i] = g[i] * __builtin_amdgcn_rcpf(1.0f + __expf(-g[i])) * up[i];
                    u32x2 w; w.x = pg8::cvt_pk_bf16(o[0], o[1]); w.y = pg8::cvt_pk_bf16(o[2], o[3]);
                    *(u32x2*)(rowp + bj * 64) = w;
                }
            }
    }
};
struct EpiDown {
    static constexpr bool PERM = true;
    bf16* Y; const unsigned* list; const float* listw; const LAS int* tab;
    __device__ __forceinline__ void operator()(const f32x4 (&acc)[2][2][4][2], const pg8::Unit& u, int wr, int wc, int fr, int fq) const {
        const int ce = tab[u.e];
        const int r0 = u.mt * 256 + wr * 64 + fr, col0 = u.pn * 256 + wc * 32 + 8 * fq;
        const unsigned* lp = list + (size_t)u.e * LISTCAP; const float* lw = listw + (size_t)u.e * LISTCAP;
#pragma unroll
        for (int ai = 0; ai < 2; ++ai)
#pragma unroll
            for (int m = 0; m < 4; ++m) {
                const int r = r0 + ai * 128 + m * 16;
                if (r < ce) {
                    const unsigned ts = __builtin_nontemporal_load(lp + r); const float w = __builtin_nontemporal_load(lw + r);
                    bf16* rowp = Y + ((size_t)(ts & 1u) * TT + (ts >> 1)) * D + col0;
#pragma unroll
                    for (int bj = 0; bj < 2; ++bj) {
                        const f32x4 v0 = acc[ai][bj][m][0] * w, v1 = acc[ai][bj][m][1] * w;
                        u32x4 o; o.x = pg8::cvt_pk_bf16(v0[0], v0[1]); o.y = pg8::cvt_pk_bf16(v0[2], v0[3]); o.z = pg8::cvt_pk_bf16(v1[0], v1[1]); o.w = pg8::cvt_pk_bf16(v1[2], v1[3]);
                        *(u32x4*)(rowp + bj * 128) = o;
                    }
                }
            }
    }
};

__device__ __forceinline__ void swa_naive(const Frame& F, const CAS Args* a, int l) {
    const bf16* P = (const bf16*)(F.ws + WS_P); bf16* MIX = (bf16*)(F.ws + WS_MIX);
    const int total = (l == 0 ? TT : TL) * 8;
    for (int idx = F.gw * 64 + F.lane; idx < total; idx += F.NGW * 64) {
        const int m = idx >> 3, hq = idx & 7, kvh = hq >> 2;
        const bool latent = m < TL;
        const int b = latent ? (m >> 13) : ((m - TL) >> 8), t = m & (SEQ - 1);
        float q[64];
        { const u32x4* qp = (const u32x4*)(P + (size_t)m * NIN + PC_SQ + hq * 64);
#pragma unroll
          for (int c = 0; c < 8; ++c) { const u32x4 w = qp[c]; q[8 * c] = bflo(w.x); q[8 * c + 1] = bfhi(w.x); q[8 * c + 2] = bflo(w.y); q[8 * c + 3] = bfhi(w.y);
              q[8 * c + 4] = bflo(w.z); q[8 * c + 5] = bfhi(w.z); q[8 * c + 6] = bflo(w.w); q[8 * c + 7] = bfhi(w.w); } }
        float o[64];
#pragma unroll
        for (int d = 0; d < 64; ++d) o[d] = 0.f;
        const float sink = a->in[I_SINK][l * 8 + hq] * LOG2E;
        float mx = sink, den = 1.0f;
        const int lo = latent ? (t - 128 < 0 ? 0 : t - 128) : 0, hi = latent ? (t + 128 > SEQ - 1 ? SEQ - 1 : t + 128) : -1;
        const int nloc = hi - lo + 1;
        for (int kk = 0; kk < nloc + LC; ++kk) {
            const int krow = kk < nloc ? b * SEQ + lo + kk : TL + b * LC + (kk - nloc);
            const u32x4* kp = (const u32x4*)(P + (size_t)krow * NIN + PC_SK + kvh * 64);
            float s = 0.f;
#pragma unroll
            for (int c = 0; c < 8; ++c) { const u32x4 w = kp[c]; s += q[8 * c] * bflo(w.x) + q[8 * c + 1] * bfhi(w.x) + q[8 * c + 2] * bflo(w.y) + q[8 * c + 3] * bfhi(w.y)
                + q[8 * c + 4] * bflo(w.z) + q[8 * c + 5] * bfhi(w.z) + q[8 * c + 6] * bflo(w.w) + q[8 * c + 7] * bfhi(w.w); }
            const float mn = fmaxf(mx, s), f = exp2f(mx - mn), p = exp2f(s - mn);
            den = den * f + p; mx = mn;
            const u32x4* vp = (const u32x4*)(P + (size_t)krow * NIN + PC_SV + kvh * 64);
#pragma unroll
            for (int c = 0; c < 8; ++c) { const u32x4 w = vp[c];
                o[8 * c] = o[8 * c] * f + p * bflo(w.x); o[8 * c + 1] = o[8 * c + 1] * f + p * bfhi(w.x); o[8 * c + 2] = o[8 * c + 2] * f + p * bflo(w.y); o[8 * c + 3] = o[8 * c + 3] * f + p * bfhi(w.y);
                o[8 * c + 4] = o[8 * c + 4] * f + p * bflo(w.z); o[8 * c + 5] = o[8 * c + 5] * f + p * bfhi(w.z); o[8 * c + 6] = o[8 * c + 6] * f + p * bflo(w.w); o[8 * c + 7] = o[8 * c + 7] * f + p * bfhi(w.w); }
        }
        const float inv = 1.0f / den;
        u32x4* op = (u32x4*)(MIX + (size_t)m * D + 512 + hq * 64);
#pragma unroll
        for (int c = 0; c < 8; ++c) { u32x4 w; w.x = pk2(o[8 * c] * inv, o[8 * c + 1] * inv); w.y = pk2(o[8 * c + 2] * inv, o[8 * c + 3] * inv); w.z = pk2(o[8 * c + 4] * inv, o[8 * c + 5] * inv); w.w = pk2(o[8 * c + 6] * inv, o[8 * c + 7] * inv); op[c] = w; }
    }
}


typedef float f32x16 __attribute__((ext_vector_type(16)));
typedef short s16x4 __attribute__((ext_vector_type(4)));
__device__ __forceinline__ int crow(int r, int hi) { return (r & 3) + 8 * (r >> 2) + 4 * hi; }
__device__ __forceinline__ s16x4 vtr(const LAS unsigned char* p) { return __builtin_bit_cast(s16x4, __builtin_amdgcn_ds_read_tr16_b64_v4i16((LAS s16x4*)p)); }
constexpr int SWA_K = 0, SWA_V = 49152;
__device__ __forceinline__ void swa_tile(const LAS unsigned char* Kt, const LAS unsigned char* Vt, int mtype, const bf16x8 (&qf)[2][4], f32x16 (&o)[2][2], float (&mrun)[2], float (&lrun)[2], int lane) {
    const int r32 = lane & 31, hi = lane >> 5;
    const LAS unsigned char* vp = Vt + ((lane >> 4) & 1) * 32 + (lane & 3) * 8 + (4 * hi + ((lane & 15) >> 2)) * 64;
#pragma unroll
    for (int kb = 0; kb < 2; ++kb) {
        f32x16 s[2];
#pragma unroll
        for (int d0 = 0; d0 < 4; ++d0) {
            const bf16x8 kf = *(const LAS bf16x8*)(Kt + (2 * d0 + hi) * 1024 + (32 * kb + r32) * 16);
#pragma unroll
            for (int qt = 0; qt < 2; ++qt) {
                if (d0 == 0) { f32x16 z;
#pragma unroll
                    for (int r = 0; r < 16; ++r) z[r] = 0.f;
                    s[qt] = __builtin_amdgcn_mfma_f32_32x32x16_bf16(kf, qf[qt][0], z, 0, 0, 0); }
                else s[qt] = __builtin_amdgcn_mfma_f32_32x32x16_bf16(kf, qf[qt][d0], s[qt], 0, 0, 0);
            }
        }
        bf16x8 pf[2][2];
#pragma unroll
        for (int qt = 0; qt < 2; ++qt) {
            if (mtype != 0) {
                int thr = r32 + 32 * qt - 4 * hi - 32 * kb; asm volatile("" : "+v"(thr));
                if (mtype == 1) {
#pragma unroll
                    for (int r = 0; r < 16; ++r) { const int cc = (r & 3) + 8 * (r >> 2); if (cc < thr) s[qt][r] = -INFINITY; }
                } else {
#pragma unroll
                    for (int r = 0; r < 16; ++r) { const int cc = (r & 3) + 8 * (r >> 2); if (cc > thr) s[qt][r] = -INFINITY; }
                }
            }
            float rm = s[qt][0];
#pragma unroll
            for (int r = 1; r < 16; ++r) rm = fmaxf(rm, s[qt][r]);
            { auto rr = __builtin_amdgcn_permlane32_swap(__float_as_uint(rm), __float_as_uint(rm), false, false); rm = fmaxf(__uint_as_float(rr[0]), __uint_as_float(rr[1])); }
            const float mn = fmaxf(mrun[qt], rm);
            if (__any(mn > mrun[qt])) {
                const float alpha = __builtin_amdgcn_exp2f(mrun[qt] - mn);
                lrun[qt] *= alpha;
#pragma unroll
                for (int dt = 0; dt < 2; ++dt)
#pragma unroll
                    for (int r = 0; r < 16; ++r) o[dt][qt][r] *= alpha;
                mrun[qt] = mn;
            }
            float rs = 0.f;
#pragma unroll
            for (int r = 0; r < 16; ++r) { const float p = __builtin_amdgcn_exp2f(s[qt][r] - mn); s[qt][r] = p; rs += p; }
            lrun[qt] += rs;
#pragma unroll
            for (int sp = 0; sp < 2; ++sp) {
                u32x4 w; w.x = pg8::cvt_pk_bf16(s[qt][8 * sp + 0], s[qt][8 * sp + 1]); w.y = pg8::cvt_pk_bf16(s[qt][8 * sp + 2], s[qt][8 * sp + 3]);
                w.z = pg8::cvt_pk_bf16(s[qt][8 * sp + 4], s[qt][8 * sp + 5]); w.w = pg8::cvt_pk_bf16(s[qt][8 * sp + 6], s[qt][8 * sp + 7]);
                pf[qt][sp] = __builtin_bit_cast(bf16x8, w);
            }
        }
#pragma unroll
        for (int dt = 0; dt < 2; ++dt)
#pragma unroll
            for (int sp = 0; sp < 2; ++sp) {
                const int ks = 2 * kb + sp;
                const s16x4 lo = vtr(vp + dt * 4096 + ks * 1024), hi4 = vtr(vp + dt * 4096 + ks * 1024 + 512);
                const bf16x8 vf = (bf16x8){lo[0], lo[1], lo[2], lo[3], hi4[0], hi4[1], hi4[2], hi4[3]};
#pragma unroll
                for (int qt = 0; qt < 2; ++qt) o[dt][qt] = __builtin_amdgcn_mfma_f32_32x32x16_bf16(vf, pf[qt][sp], o[dt][qt], 0, 0, 0);
            }
    }
}
__device__ __forceinline__ void swa_stage(const Frame& F, const bf16* P, int grow, int kvh, int ti) {
    { const int key = 8 * F.wave + (F.lane & 7), ch = F.lane >> 3;
      const u32x4 v = *(const u32x4*)(P + (size_t)(grow + key) * NIN + PC_SK + kvh * 64 + ch * 8);
      *(LAS u32x4*)(F.lds + SWA_K + ti * 8192 + ch * 1024 + key * 16) = v; }
    { const int key = 8 * F.wave + (F.lane >> 3), ch = F.lane & 7;
      const u32x4 v = *(const u32x4*)(P + (size_t)(grow + key) * NIN + PC_SV + kvh * 64 + ch * 8);
      *(LAS u32x4*)(F.lds + SWA_V + ti * 8192 + (ch >> 2) * 4096 + key * 64 + (ch & 3) * 16) = v; }
}
__device__ __forceinline__ void swa_flash(const Frame& F, const CAS Args* a, int l) {
    const bf16* P = (const bf16*)(F.ws + WS_P); bf16* MIX = (bf16*)(F.ws + WS_MIX);
    const int nunits = 256 + (l == 0 ? 8 : 0);
    const int lane = F.lane, r32 = lane & 31, hi = lane >> 5;
    for (int u = F.vcu; u < nunits; u += F.G) {
        const bool latent = u < 256;
        const int b = latent ? (u >> 7) : ((u - 256) >> 2), kvh = latent ? ((u >> 6) & 1) : (((u - 256) >> 1) & 1), qb = latent ? (u & 63) : ((u - 256) & 1);
        const int q0 = qb * 128, g = F.wave >> 1, qs = F.wave & 1, hq = kvh * 4 + g;
        const int mrow0 = (latent ? b * SEQ : TL + b * LC) + q0 + 64 * qs;
        bf16x8 qf[2][4];
#pragma unroll
        for (int qt = 0; qt < 2; ++qt)
#pragma unroll
            for (int d0 = 0; d0 < 4; ++d0) qf[qt][d0] = *(const bf16x8*)(P + (size_t)(mrow0 + 32 * qt + r32) * NIN + PC_SQ + hq * 64 + 16 * d0 + 8 * hi);
        f32x16 o[2][2];
#pragma unroll
        for (int dt = 0; dt < 2; ++dt)
#pragma unroll
            for (int qt = 0; qt < 2; ++qt)
#pragma unroll
                for (int r = 0; r < 16; ++r) o[dt][qt][r] = 0.f;
        const float sink2 = a->in[I_SINK][l * 8 + hq] * LOG2E;
        float mrun[2] = {sink2, sink2}, lrun[2] = {hi == 0 ? 1.f : 0.f, hi == 0 ? 1.f : 0.f};
        if (latent) {
#pragma unroll 1
            for (int j = 0; j < 6; ++j) { const int ks = q0 - 128 + 64 * j; if (ks >= 0 && ks < SEQ) swa_stage(F, P, b * SEQ + ks, kvh, j); }
            __syncthreads();
#pragma unroll 1
            for (int tt = 0; tt < 5; ++tt) { const int j = qs + tt, ks = q0 - 128 + 64 * j;
                if (ks >= 0 && ks < SEQ) swa_tile(F.lds + SWA_K + j * 8192, F.lds + SWA_V + j * 8192, tt == 0 ? 1 : (tt == 4 ? 2 : 0), qf, o, mrun, lrun, lane); }
            __syncthreads();
        }
#pragma unroll 1
        for (int j = 0; j < 4; ++j) swa_stage(F, P, TL + b * LC + 64 * j, kvh, j);
        __syncthreads();
#pragma unroll 1
        for (int j = 0; j < 4; ++j) swa_tile(F.lds + SWA_K + j * 8192, F.lds + SWA_V + j * 8192, 0, qf, o, mrun, lrun, lane);
        __syncthreads();
#pragma unroll
        for (int qt = 0; qt < 2; ++qt) {
            float lt = lrun[qt];
            { auto rr = __builtin_amdgcn_permlane32_swap(__float_as_uint(lt), __float_as_uint(lt), false, false); lt = __uint_as_float(rr[0]) + __uint_as_float(rr[1]); }
            const float inv = 1.0f / lt;
            bf16* op = MIX + (size_t)(mrow0 + 32 * qt + r32) * D + 512 + hq * 64 + 4 * hi;
#pragma unroll
            for (int dt = 0; dt < 2; ++dt)
#pragma unroll
                for (int rg = 0; rg < 4; ++rg) {
                    u32x2 w; w.x = pk2(o[dt][qt][4 * rg] * inv, o[dt][qt][4 * rg + 1] * inv); w.y = pk2(o[dt][qt][4 * rg + 2] * inv, o[dt][qt][4 * rg + 3] * inv);
                    *(u32x2*)(op + 32 * dt + 8 * rg) = w;
                }
        }
    }
}


constexpr size_t WS_US = WS_GL, WS_USC = WS_GL + 32 * MiB, WS_DEC = 7 * MiB;
static_assert(WS_USC + (size_t)16 * 4 * 8192 * 2 <= WS_END && WS_DEC + (size_t)16 * 132 * 64 * 4 <= WS_WIN, "ws map (gla)");
constexpr int GL_V = 0, GL_M0 = 16384, GL_MSZ = 64 * 72 * 2, GL_RED = GL_M0 + 4 * GL_MSZ;
__device__ __forceinline__ float wave_scan_incl(float v) {
    v += DPP_F(v, 0x111, 0xF); v += DPP_F(v, 0x112, 0xF); v += DPP_F(v, 0x114, 0xF); v += DPP_F(v, 0x118, 0xF);
    v += DPP_F(v, 0x142, 0xA); v += DPP_F(v, 0x143, 0xC); return v;
}
__device__ __forceinline__ float lane63(float v) { return __builtin_bit_cast(float, __builtin_amdgcn_readlane(__builtin_bit_cast(int, v), 63)); }
__device__ __forceinline__ void unpack8(const u32x4 w, float (&f)[8]) { f[0] = bflo(w.x); f[1] = bfhi(w.x); f[2] = bflo(w.y); f[3] = bfhi(w.y); f[4] = bflo(w.z); f[5] = bfhi(w.z); f[6] = bflo(w.w); f[7] = bfhi(w.w); }
__device__ __forceinline__ void gla_stage_v(const Frame& F, const bf16* P, int m0, int h) {
#pragma unroll
    for (int i = 0; i < 2; ++i) { const int p = F.tid + 512 * i, t = p >> 4, ch = p & 15;
        const u32x4 v = *(const u32x4*)(P + (size_t)(m0 + t) * NIN + PC_V + h * 128 + ch * 8);
        *(LAS u32x4*)(F.lds + GL_V + (ch >> 2) * 4096 + t * 64 + (ch & 3) * 16) = v; }
}
__device__ __forceinline__ void gla_g1_unit(const Frame& F, const bf16* P, int m0, int h, bf16* Uf, bf16* Ub, float* decf, float* decb) {
    const int w = F.wave, t = F.lane, c = t & 31, hi = t >> 5;
    const bf16* row = P + (size_t)(m0 + t) * NIN + h * 64 + 8 * w;
    float laf[8], lab[8], kk[8];
    unpack8(*(const u32x4*)(row + PC_GF), laf); unpack8(*(const u32x4*)(row + PC_GB), lab); unpack8(*(const u32x4*)(row + PC_K), kk);
    gla_stage_v(F, P, m0, h);
    LAS bf16* KOF = (LAS bf16*)(F.lds + GL_M0); LAS bf16* KOB = (LAS bf16*)(F.lds + GL_M0 + GL_MSZ);
#pragma unroll
    for (int i = 0; i < 8; ++i) {
        const float incf = wave_scan_incl(laf[i]), tf = lane63(incf), incb = wave_scan_incl(lab[i]), tb = lane63(incb);
        KOF[(8 * w + i) * 72 + t] = (bf16)f2bf(kk[i] * __expf(tf - incf));
        KOB[(8 * w + i) * 72 + t] = (bf16)f2bf(kk[i] * __expf(incb - lab[i]));
        if (t == 0) { decf[8 * w + i] = __expf(tf); decb[8 * w + i] = __expf(tb); }
    }
    __syncthreads();
    const int dir = w >> 2, dvt = w & 3;
    const LAS unsigned char* vp = F.lds + GL_V + dvt * 4096 + ((t >> 4) & 1) * 32 + (t & 3) * 8 + ((t & 15) >> 2) * 64 + hi * 512;
    const LAS unsigned char* kb = F.lds + GL_M0 + dir * GL_MSZ + (c * 72 + 8 * hi) * 2;
    f32x16 acc[2];
#pragma unroll
    for (int j = 0; j < 2; ++j)
#pragma unroll
        for (int r = 0; r < 16; ++r) acc[j][r] = 0.f;
#pragma unroll
    for (int sp = 0; sp < 4; ++sp) {
        const s16x4 lo = vtr(vp + sp * 1024), hi4 = vtr(vp + sp * 1024 + 256);
        const bf16x8 vf = (bf16x8){lo[0], lo[1], lo[2], lo[3], hi4[0], hi4[1], hi4[2], hi4[3]};
#pragma unroll
        for (int j = 0; j < 2; ++j) { const bf16x8 kf = *(const LAS bf16x8*)(kb + j * 32 * 144 + sp * 32); acc[j] = __builtin_amdgcn_mfma_f32_32x32x16_bf16(vf, kf, acc[j], 0, 0, 0); }
    }
    bf16* U = dir ? Ub : Uf;
#pragma unroll
    for (int j = 0; j < 2; ++j)
#pragma unroll
        for (int r = 0; r < 16; ++r) U[(32 * dvt + crow(r, hi)) * 64 + 32 * j + c] = (bf16)f2bf(acc[j][r]);
    __syncthreads();
}
__device__ __forceinline__ void gla_g1(const Frame& F0, int l) {
    Frame F = F0; { int l_; asm volatile("v_mbcnt_lo_u32_b32 %0, -1, 0\n\tv_mbcnt_hi_u32_b32 %0, -1, %0" : "=v"(l_)); F.lane = l_; F.tid = F.wave * 64 + l_; }
    const bf16* P = (const bf16*)(F.ws + WS_P);
    bf16* US = (bf16*)(F.ws + WS_US); bf16* USC = (bf16*)(F.ws + WS_USC); float* DEC = (float*)(F.ws + WS_DEC);
    for (int u = F.vcu; u < 1056; u += F.G) {
        const bool latent = u < 1024; const int cc = u - 1024;
        const int b = latent ? (u >> 9) : (cc >> 4), h = latent ? ((u >> 7) & 3) : ((cc >> 2) & 3), n = latent ? (u & 127) : (cc & 3);
        const int m0 = latent ? b * SEQ + 64 * n : TL + b * LC + 64 * n;
        const int sf = (b * 4 + h) * 2;
        bf16* Uf = latent ? US + ((size_t)sf * 128 + n) * 8192 : USC + ((size_t)sf * 4 + n) * 8192;
        bf16* Ub = latent ? US + ((size_t)(sf + 1) * 128 + n) * 8192 : USC + ((size_t)(sf + 1) * 4 + n) * 8192;
        const int nd = latent ? n : 128 + n;
        gla_g1_unit(F, P, m0, h, Uf, Ub, DEC + ((size_t)sf * 132 + nd) * 64, DEC + ((size_t)(sf + 1) * 132 + nd) * 64);
    }
}
__device__ __forceinline__ void gla_scan(const Frame& F) {
    bf16* US = (bf16*)(F.ws + WS_US); bf16* USC = (bf16*)(F.ws + WS_USC); const float* DEC = (const float*)(F.ws + WS_DEC);
    for (int idx = F.vcu * 512 + F.tid; idx < 16 * 8192; idx += F.G * 512) {
        const int seq = idx >> 13, e = idx & 8191, dk = e & 63, dir = seq & 1;
        const float* dec = DEC + (size_t)seq * 132 * 64 + dk;
        float s = 0.f;
        bf16* uc = USC + (size_t)seq * 4 * 8192 + e;
#pragma unroll
        for (int i = 0; i < 4; ++i) { const int n = dir ? 3 - i : i; const float u = bf2f(uc[n * 8192]), d = dec[(128 + n) * 64]; uc[n * 8192] = (bf16)f2bf(s); s = d * s + u; }
        bf16* ul = US + (size_t)seq * 128 * 8192 + e;
#pragma unroll 8
        for (int i = 0; i < 128; ++i) { const int n = dir ? 127 - i : i; const float u = bf2f(ul[(size_t)n * 8192]), d = dec[n * 64]; ul[(size_t)n * 8192] = (bf16)f2bf(s); s = d * s + u; }
    }
}
__device__ __forceinline__ void gla_g3_unit(const Frame& F, const CAS Args* a, int l, const bf16* P, int m0, int h, const bf16* Sf, const bf16* Sb, bf16* MIX) {
    const int w = F.wave, t = F.lane, c = t & 31, hi = t >> 5;
    {
        const bf16* row = P + (size_t)(m0 + t) * NIN + h * 64 + 8 * w;
        float laf[8], lab[8], kk[8], qq[8];
        unpack8(*(const u32x4*)(row + PC_GF), laf); unpack8(*(const u32x4*)(row + PC_GB), lab); unpack8(*(const u32x4*)(row + PC_K), kk); unpack8(*(const u32x4*)(row + PC_Q), qq);
        gla_stage_v(F, P, m0, h);
        float qf[8], kf[8], qb[8], kb[8];
#pragma unroll
        for (int i = 0; i < 8; ++i) {
            const float bf = wave_scan_incl(laf[i]), incb = wave_scan_incl(lab[i]), bb = lane63(incb) - incb + lab[i];
            qf[i] = qq[i] * __expf(bf); kf[i] = kk[i] * __expf(-bf); qb[i] = qq[i] * __expf(bb); kb[i] = kk[i] * __expf(-bb);
        }
        LAS unsigned char* mb = F.lds + GL_M0 + (t * 72 + 8 * w) * 2;
        u32x4 o;
        o.x = pk2(qf[0], qf[1]); o.y = pk2(qf[2], qf[3]); o.z = pk2(qf[4], qf[5]); o.w = pk2(qf[6], qf[7]); *(LAS u32x4*)(mb) = o;
        o.x = pk2(kf[0], kf[1]); o.y = pk2(kf[2], kf[3]); o.z = pk2(kf[4], kf[5]); o.w = pk2(kf[6], kf[7]); *(LAS u32x4*)(mb + GL_MSZ) = o;
        o.x = pk2(qb[0], qb[1]); o.y = pk2(qb[2], qb[3]); o.z = pk2(qb[4], qb[5]); o.w = pk2(qb[6], qb[7]); *(LAS u32x4*)(mb + 2 * GL_MSZ) = o;
        o.x = pk2(kb[0], kb[1]); o.y = pk2(kb[2], kb[3]); o.z = pk2(kb[4], kb[5]); o.w = pk2(kb[6], kb[7]); *(LAS u32x4*)(mb + 3 * GL_MSZ) = o;
    }
    __syncthreads();
    const int dvt = w >> 1, tt = w & 1;
    bf16x8 qfB[4], qbB[4];
    { const LAS unsigned char* qp = F.lds + GL_M0 + ((32 * tt + c) * 72 + 8 * hi) * 2;
#pragma unroll
      for (int kd = 0; kd < 4; ++kd) { qfB[kd] = *(const LAS bf16x8*)(qp + kd * 32); qbB[kd] = *(const LAS bf16x8*)(qp + 2 * GL_MSZ + kd * 32); } }
    bf16x8 pfr[2][2];
#pragma unroll
    for (int st = 0; st < 2; ++st) {
        const LAS unsigned char* kp = F.lds + GL_M0 + GL_MSZ + ((32 * st + c) * 72 + 8 * hi) * 2;
        f32x16 xf, xb;
#pragma unroll
        for (int r = 0; r < 16; ++r) { xf[r] = 0.f; xb[r] = 0.f; }
        const bool needF = st <= tt, needB = st >= tt;
        if (needF) {
#pragma unroll
            for (int kd = 0; kd < 4; ++kd) xf = __builtin_amdgcn_mfma_f32_32x32x16_bf16(*(const LAS bf16x8*)(kp + kd * 32), qfB[kd], xf, 0, 0, 0);
        }
        if (needB) {
#pragma unroll
            for (int kd = 0; kd < 4; ++kd) xb = __builtin_amdgcn_mfma_f32_32x32x16_bf16(*(const LAS bf16x8*)(kp + 2 * GL_MSZ + kd * 32), qbB[kd], xb, 0, 0, 0);
        }
        if (st == tt) {
            int thr = c - 4 * hi; asm volatile("" : "+v"(thr));
#pragma unroll
            for (int r = 0; r < 16; ++r) { const int cc = (r & 3) + 8 * (r >> 2); xf[r] = (cc <= thr ? xf[r] : 0.f) + (cc >= thr ? xb[r] : 0.f); }
        } else {
#pragma unroll
            for (int r = 0; r < 16; ++r) xf[r] += xb[r];
        }
#pragma unroll
        for (int sp = 0; sp < 2; ++sp) {
            u32x4 wv; wv.x = pg8::cvt_pk_bf16(xf[8 * sp + 0], xf[8 * sp + 1]); wv.y = pg8::cvt_pk_bf16(xf[8 * sp + 2], xf[8 * sp + 3]);
            wv.z = pg8::cvt_pk_bf16(xf[8 * sp + 4], xf[8 * sp + 5]); wv.w = pg8::cvt_pk_bf16(xf[8 * sp + 6], xf[8 * sp + 7]);
            pfr[st][sp] = __builtin_bit_cast(bf16x8, wv);
        }
    }
    f32x16 o;
#pragma unroll
    for (int r = 0; r < 16; ++r) o[r] = 0.f;
    { const LAS unsigned char* vp = F.lds + GL_V + dvt * 4096 + ((t >> 4) & 1) * 32 + (t & 3) * 8 + (4 * hi + ((t & 15) >> 2)) * 64;
#pragma unroll
      for (int ks = 0; ks < 4; ++ks) {
          const s16x4 lo = vtr(vp + ks * 1024), hi4 = vtr(vp + ks * 1024 + 512);
          const bf16x8 vf = (bf16x8){lo[0], lo[1], lo[2], lo[3], hi4[0], hi4[1], hi4[2], hi4[3]};
          o = __builtin_amdgcn_mfma_f32_32x32x16_bf16(vf, pfr[ks >> 1][ks & 1], o, 0, 0, 0);
      } }
    { const bf16* sfp = Sf + (32 * dvt + c) * 64 + 8 * hi; const bf16* sbp = Sb + (32 * dvt + c) * 64 + 8 * hi;
#pragma unroll
      for (int kd = 0; kd < 4; ++kd) {
          o = __builtin_amdgcn_mfma_f32_32x32x16_bf16(*(const bf16x8*)(sfp + 16 * kd), qfB[kd], o, 0, 0, 0);
          o = __builtin_amdgcn_mfma_f32_32x32x16_bf16(*(const bf16x8*)(sbp + 16 * kd), qbB[kd], o, 0, 0, 0);
      } }
    float ssq = 0.f;
#pragma unroll
    for (int r = 0; r < 16; ++r) ssq += o[r] * o[r];
    { auto rr = __builtin_amdgcn_permlane32_swap(__float_as_uint(ssq), __float_as_uint(ssq), false, false); ssq = __uint_as_float(rr[0]) + __uint_as_float(rr[1]); }
    LAS float* red = (LAS float*)(F.lds + GL_RED);
    if (hi == 0) red[dvt * 64 + 32 * tt + c] = ssq;
    __syncthreads();
    const float tot = (red[32 * tt + c] + red[64 + 32 * tt + c]) + (red[128 + 32 * tt + c] + red[192 + 32 * tt + c]);
    const float rstd = 1.0f / sqrtf(tot * (1.0f / 128.0f) + EPS);
    const int mrow = m0 + 32 * tt + c;
#pragma unroll
    for (int rg = 0; rg < 4; ++rg) {
        const int dv = 32 * dvt + 8 * rg + 4 * hi;
        const u32x2 gw = *(const u32x2*)(P + (size_t)mrow * NIN + PC_G + h * 128 + dv);
        const f32x4 nw = *(const f32x4*)(a->in[I_GLANORM] + l * 512 + h * 128 + dv);
        const float g0 = bflo(gw.x), g1 = bfhi(gw.x), g2 = bflo(gw.y), g3 = bfhi(gw.y);
        u32x2 ov; ov.x = pk2(o[4 * rg] * rstd * nw[0] * silu_f(g0), o[4 * rg + 1] * rstd * nw[1] * silu_f(g1)); ov.y = pk2(o[4 * rg + 2] * rstd * nw[2] * silu_f(g2), o[4 * rg + 3] * rstd * nw[3] * silu_f(g3));
        *(u32x2*)(MIX + (size_t)mrow * D + h * 128 + dv) = ov;
    }
    __syncthreads();
}
__device__ __forceinline__ void gla_g3(const Frame& F, const CAS Args* a, int l) {
    const bf16* P = (const bf16*)(F.ws + WS_P); bf16* MIX = (bf16*)(F.ws + WS_MIX);
    const bf16* US = (const bf16*)(F.ws + WS_US); const bf16* USC = (const bf16*)(F.ws + WS_USC);
    const int nunits = 1024 + (l == 0 ? 32 : 0);
    for (int u = F.vcu; u < nunits; u += F.G) {
        const bool latent = u < 1024; const int cc = u - 1024;
        const int b = latent ? (u >> 9) : (cc >> 4), h = latent ? ((u >> 7) & 3) : ((cc >> 2) & 3), n = latent ? (u & 127) : (cc & 3);
        const int m0 = latent ? b * SEQ + 64 * n : TL + b * LC + 64 * n;
        const int sf = (b * 4 + h) * 2;
        const bf16* Sf = latent ? US + ((size_t)sf * 128 + n) * 8192 : USC + ((size_t)sf * 4 + n) * 8192;
        const bf16* Sb = latent ? US + ((size_t)(sf + 1) * 128 + n) * 8192 : USC + ((size_t)(sf + 1) * 4 + n) * 8192;
        gla_g3_unit(F, a, l, P, m0, h, Sf, Sb, MIX);
    }
}

__device__ __forceinline__ void gla_naive(const Frame& F, const CAS Args* a, int l) {
    const bf16* P = (const bf16*)(F.ws + WS_P);
    bf16* OF = (bf16*)(F.ws + WS_GL);
    for (int w = F.gw; w < 2048; w += F.NGW) {
        const int dv = w & 127, dir = (w >> 7) & 1, h = (w >> 8) & 3, b = w >> 10;
        const int pcg = dir ? PC_GB : PC_GF;
        float S = 0.f;
        for (int step = 0; step < LC + SEQ; ++step) {
            int m;
            if (dir == 0) m = step < LC ? TL + b * LC + step : b * SEQ + (step - LC);
            else m = step < LC ? TL + b * LC + (LC - 1 - step) : b * SEQ + (SEQ - 1 - (step - LC));
            const bf16* row = P + (size_t)m * NIN;
            const float la = bf2f(row[pcg + h * 64 + F.lane]), kk = bf2f(row[PC_K + h * 64 + F.lane]), qq = bf2f(row[PC_Q + h * 64 + F.lane]), vv = bf2f(row[PC_V + h * 128 + dv]);
            S = __expf(la) * S + kk * vv;
            const float o = wave_sum(qq * S);
            if (F.lane == 0) OF[((size_t)dir * TT + m) * 512 + h * 128 + dv] = (bf16)f2bf(o);
        }
    }
}
__device__ __forceinline__ void gla_out_naive(const Frame& F, const CAS Args* a, int l) {
    const bf16* P = (const bf16*)(F.ws + WS_P); bf16* MIX = (bf16*)(F.ws + WS_MIX);
    const bf16* OF = (const bf16*)(F.ws + WS_GL);
    const int rows = (l == 0) ? TT : TL;
    for (int m = F.gw; m < rows; m += F.NGW) {
        const int c0 = 8 * F.lane;
        const u32x4 wa = *(const u32x4*)(OF + (size_t)m * 512 + c0), wb = *(const u32x4*)(OF + ((size_t)TT + m) * 512 + c0);
        float o[8] = {bflo(wa.x) + bflo(wb.x), bfhi(wa.x) + bfhi(wb.x), bflo(wa.y) + bflo(wb.y), bfhi(wa.y) + bfhi(wb.y), bflo(wa.z) + bflo(wb.z), bfhi(wa.z) + bfhi(wb.z), bflo(wa.w) + bflo(wb.w), bfhi(wa.w) + bfhi(wb.w)};
        float ss = 0.f;
#pragma unroll
        for (int i = 0; i < 8; ++i) ss += o[i] * o[i];
        ss = row16_sum(ss);
        const float rstd = 1.0f / sqrtf(ss * (1.0f / 128.0f) + EPS);
        const u32x4 wg = *(const u32x4*)(P + (size_t)m * NIN + PC_G + c0);
        const float g[8] = {bflo(wg.x), bfhi(wg.x), bflo(wg.y), bfhi(wg.y), bflo(wg.z), bfhi(wg.z), bflo(wg.w), bfhi(wg.w)};
        const f32x4 n0 = *(const f32x4*)(a->in[I_GLANORM] + l * 512 + c0), n1 = *(const f32x4*)(a->in[I_GLANORM] + l * 512 + c0 + 4);
        float r[8];
#pragma unroll
        for (int i = 0; i < 8; ++i) r[i] = o[i] * rstd * (i < 4 ? n0[i] : n1[i - 4]) * silu_f(g[i]);
        u32x4 w; w.x = pk2(r[0], r[1]); w.y = pk2(r[2], r[3]); w.z = pk2(r[4], r[5]); w.w = pk2(r[6], r[7]);
        *(u32x4*)(MIX + (size_t)m * D + c0) = w;
    }
}

__device__ __forceinline__ void n2_route_phase(const Frame& F, const CAS Args* a, int l) {
    unsigned char* ws = F.ws;
    const float* mod = (const float*)(ws + WS_MOD);
    bf16* H = (bf16*)(ws + WS_H);
    unsigned* cnt = (unsigned*)(ws + WS_CTL) + CW_CNT + l * NE;
    unsigned* list = (unsigned*)(ws + WS_LIST); float* listw = (float*)(ws + WS_LISTW);
    LAS float* wrt = (LAS float*)F.lds;
    for (int i = F.tid; i < D * NE; i += NWAVES * 64) wrt[(i & 15) * D + (i >> 4)] = a->in[I_WROUTER][i];
    __syncthreads();
    const int rows = (l == 0) ? TT : TL;
    for (int m = F.gw; m < rows; m += F.NGW) {
        const int v = m < TL ? (m >> 13) : 2;
        const float* xrow = m < TL ? F.out + (size_t)m * D : (const float*)(ws + WS_XC) + (size_t)(m - TL) * D;
        f32x4 x[4]; float ss = 0.f;
#pragma unroll
        for (int j = 0; j < 4; ++j) { x[j] = *(const f32x4*)(xrow + 4 * F.lane + 256 * j); ss += (x[j][0] * x[j][0] + x[j][1] * x[j][1]) + (x[j][2] * x[j][2] + x[j][3] * x[j][3]); }
        const float rstd = 1.0f / sqrtf(wave_sum(ss) * (1.0f / D) + EPS);
        float lg[NE];
#pragma unroll
        for (int e = 0; e < NE; ++e) lg[e] = 0.f;
#pragma unroll
        for (int j = 0; j < 4; ++j) {
            const int col = 4 * F.lane + 256 * j;
            const f32x4 nw = *(const f32x4*)(a->in[I_NORM2] + l * D + col);
            const f32x4 sh = *(const f32x4*)(mod + (l * 3 + v) * 6144 + 3 * D + col);
            const f32x4 sc = *(const f32x4*)(mod + (l * 3 + v) * 6144 + 4 * D + col);
            const f32x4 h = x[j] * rstd * nw * (1.0f + sc) + sh;
            u32x2 o; o.x = pk2(h[0], h[1]); o.y = pk2(h[2], h[3]);
            *(u32x2*)(H + (size_t)m * D + col) = o;
#pragma unroll
            for (int e = 0; e < NE; ++e) { const f32x4 w = *(const LAS f32x4*)(wrt + e * D + col); lg[e] += (h[0] * w[0] + h[1] * w[1]) + (h[2] * w[2] + h[3] * w[3]); if ((e & 3) == 3) asm volatile("" ::: "memory"); }
        }
#pragma unroll
        for (int e = 0; e < NE; ++e) lg[e] = wave_sum(lg[e]);
        float s[NE], sb[NE];
#pragma unroll
        for (int e = 0; e < NE; ++e) { s[e] = 1.0f / (1.0f + expf(-lg[e])); sb[e] = s[e] + a->in[I_BROUTER][e]; }
        int gsel = 0; float gbest = -1e30f;
#pragma unroll
        for (int g = 0; g < 4; ++g) {
            float m1 = -1e30f, m2 = -1e30f;
#pragma unroll
            for (int i = 0; i < 4; ++i) { const float val = sb[4 * g + i]; if (val > m1) { m2 = m1; m1 = val; } else if (val > m2) m2 = val; }
            const float gs = m1 + m2; if (gs > gbest) { gbest = gs; gsel = g; }
        }
        int e0 = 0, e1 = 0; float b0 = -1e30f, b1 = -1e30f, s0 = 0.f, s1 = 0.f;
#pragma unroll
        for (int e = 0; e < NE; ++e) {
            if ((e >> 2) == gsel) { const float val = sb[e];
                if (val > b0) { b1 = b0; e1 = e0; s1 = s0; b0 = val; e0 = e; s0 = s[e]; } else if (val > b1) { b1 = val; e1 = e; s1 = s[e]; } }
        }
        if (F.lane == 0) {
            const float inv = 1.0f / (s0 + s1);
            const unsigned p0 = atomicAdd(cnt + e0, 1u); list[(size_t)e0 * LISTCAP + p0] = (unsigned)m * 2u; listw[(size_t)e0 * LISTCAP + p0] = s0 * inv;
            const unsigned p1 = atomicAdd(cnt + e1, 1u); list[(size_t)e1 * LISTCAP + p1] = (unsigned)m * 2u + 1u; listw[(size_t)e1 * LISTCAP + p1] = s1 * inv;
        }
    }
}

__device__ __forceinline__ void moe_setup(pg8::MoeOrder& S, const Frame& F, int l, int nN) {
    unsigned* cnt = (unsigned*)(F.ws + WS_CTL) + CW_CNT + l * NE;
    LAS int* tab = (LAS int*)(F.lds + MISC_OFF + 64);
    __syncthreads();
    if (F.tid == 0) { int run = 0;
        for (int e = 0; e < NE; ++e) { const int c = (int)__hip_atomic_load(cnt + e, __ATOMIC_RELAXED, __HIP_MEMORY_SCOPE_AGENT); tab[e] = c; run += (c + 255) >> 8; tab[16 + e] = run; } }
    __syncthreads();
    S.tab = tab; S.nN = nN; S.nunits = __builtin_amdgcn_readfirstlane(tab[31]) * nN; S.G = F.G; S.c = (int)blockIdx.x;
    S.list = (const unsigned*)(F.ws + WS_LIST);
}
__device__ __forceinline__ void moe1_phase(const Frame& F, const CAS Args* a, int l) {
    pg8::MoeOrder S; moe_setup(S, F, l, 4);
    S.A = (const char*)(F.ws + WS_H); S.Bt = (const char*)(F.ws + WS_WGU) + (size_t)l * NE * D * D * 2; S.K = D; S.bstride_e = (size_t)D * D * 2; S.gather = true;
    EpiGU E{(bf16*)(F.ws + WS_HMID)};
    pg8::gemm_phase<EpiGU, pg8::MoeOrder>(F.lds, F.tid, S, E);
}
__device__ __forceinline__ void moe2_phase(const Frame& F, const CAS Args* a, int l) {
    pg8::MoeOrder S; moe_setup(S, F, l, 4);
    S.A = (const char*)(F.ws + WS_HMID); S.Bt = (const char*)(F.ws + WS_WD) + (size_t)l * NE * D * DE * 2; S.K = DE; S.bstride_e = (size_t)D * DE * 2; S.gather = false;
    EpiDown E; E.Y = (bf16*)(F.ws + WS_Y); E.list = (const unsigned*)(F.ws + WS_LIST); E.listw = (const float*)(F.ws + WS_LISTW); E.tab = S.tab;
    pg8::gemm_phase<EpiDown, pg8::MoeOrder>(F.lds, F.tid, S, E);
}

__device__ __forceinline__ void final_phase(const Frame& F, const CAS Args* a) {
    const float* mod = (const float*)(F.ws + WS_MOD);
    const bf16* Y0 = (const bf16*)(F.ws + WS_Y); const bf16* Y1 = Y0 + (size_t)TT * D;
    for (int m = F.gw; m < TL; m += F.NGW) {
        const int v = m >> 13; float* xrow = F.out + (size_t)m * D;
        f32x4 x[4]; float ss = 0.f;
#pragma unroll
        for (int j = 0; j < 4; ++j) {
            const int col = 4 * F.lane + 256 * j;
            const f32x4 g2 = *(const f32x4*)(mod + (3 + v) * 6144 + 5 * D + col);
            const f32x4 y = ld_y4(Y0 + (size_t)m * D + col) + ld_y4(Y1 + (size_t)m * D + col);
            x[j] = *(const f32x4*)(xrow + col) + g2 * y;
            ss += (x[j][0] * x[j][0] + x[j][1] * x[j][1]) + (x[j][2] * x[j][2] + x[j][3] * x[j][3]);
        }
        const float rstd = 1.0f / sqrtf(wave_sum(ss) * (1.0f / D) + EPS);
#pragma unroll
        for (int j = 0; j < 4; ++j) { const int col = 4 * F.lane + 256 * j; const f32x4 nw = *(const f32x4*)(a->in[I_FNORM] + col); *(f32x4*)(xrow + col) = x[j] * rstd * nw; }
    }
}

constexpr int PH_PER_LAYER = 9;
constexpr int N_PHASES = 1 + DEPTH * PH_PER_LAYER + 1;

__global__ void __launch_bounds__(NWAVES * 64, 2) mk_fwd(Args args) {
    extern __shared__ __attribute__((aligned(16))) unsigned char lds[];
    Frame F;
    F.lds = (LAS unsigned char*)lds;
    F.tid = threadIdx.x; F.lane = F.tid & 63; F.wave = __builtin_amdgcn_readfirstlane(F.tid >> 6);
    F.G = gridDim.x; { const int bx = blockIdx.x; F.vcu = (F.G % 8 == 0) ? (bx % 8) * (F.G / 8) + bx / 8 : bx; }
    F.gw = F.vcu * NWAVES + F.wave; F.NGW = F.G * NWAVES;
    const CAS Args* ap = (const CAS Args*)__builtin_amdgcn_kernarg_segment_ptr();
    F.ws = ap->ws; F.out = ap->out;
    volatile LAS unsigned* MISC = (volatile LAS unsigned*)(F.lds + MISC_OFF);
    for (int u = F.tid; u < (LDS_BYTES - LDSCTL_OFF) / 4; u += NWAVES * 64) ((LAS unsigned*)(F.lds + LDSCTL_OFF))[u] = 0u;
    __syncthreads();
    XcdBarrier bar; bar.bar = (unsigned*)(F.ws + WS_CTL) + CW_BAR; bar.x = 0; bar.st = nullptr;
    const bool fused = (ap->ph_hi - ap->ph_lo) > 1;
    if (fused) bar = xcd_barrier_post((unsigned*)(F.ws + WS_CTL) + CW_BAR, MISC + 8);
    const int lo = ap->ph_lo, hi = ap->ph_hi;
    for (int ph = lo; ph < hi; ++ph) {
        { int l_; asm volatile("v_mbcnt_lo_u32_b32 %0, -1, 0\n\tv_mbcnt_hi_u32_b32 %0, -1, %0" : "=v"(l_)); F.lane = l_; F.tid = F.wave * 64 + l_; ap = (const CAS Args*)__builtin_amdgcn_kernarg_segment_ptr(); asm volatile("" : "+s"(ap)); F.ws = ap->ws; F.out = ap->out; }
        if (ph == 0) { if (PH_ON(10)) p0_prologue(F, ap); }
        else if (ph == N_PHASES - 1) { if (PH_ON(11)) final_phase(F, ap); }
        else {
            const int l = (ph - 1) / PH_PER_LAYER, s = (ph - 1) % PH_PER_LAYER;
            unsigned char* ws = F.ws;
            if (s == 0) { if (PH_ON(0)) n1_phase(F, ap, l); }
            else if (s == 1 && PH_ON(1)) {
                pg8::DenseOrder S; S.init(ws + WS_H, ws + WS_WIN + (size_t)l * NIN * D * 2, TT, NIN, D, F.G, (int)blockIdx.x);
                EpiIn E{(bf16*)(ws + WS_P), ap->in[I_BIASF] + l * 256, ap->in[I_BIASB] + l * 256, (const float*)(ws + WS_ROPE), (const float*)(ws + WS_ROPE) + 2048};
                pg8::gemm_phase<EpiIn, pg8::DenseOrder>(F.lds, F.tid, S, E);
            }
            else if (s == 2) { if (PH_ON(2)) swa_flash(F, ap, l); if (PH_ON(12)) gla_g1(F, l); }
            else if (s == 3) { if (PH_ON(13)) gla_scan(F); }
            else if (s == 4) { if (PH_ON(3)) gla_g3(F, ap, l); }
            else if (s == 5 && PH_ON(4)) {
                pg8::DenseOrder S; S.init(ws + WS_MIX, ws + WS_WOUT + (size_t)l * D * D * 2, l == 0 ? TT : TL, D, D, F.G, (int)blockIdx.x);
                EpiOut E{l == 0 ? ap->in[I_X] : F.out, l == 0 ? ap->in[I_CTX] : (const float*)(ws + WS_XC), F.out, (float*)(ws + WS_XC), (const float*)(ws + WS_MOD) + l * 3 * 6144};
                pg8::gemm_phase<EpiOut, pg8::DenseOrder>(F.lds, F.tid, S, E);
            }
            else if (s == 6) { if (PH_ON(5)) n2_route_phase(F, ap, l); }
            else if (s == 7) { if (PH_ON(6)) moe1_phase(F, ap, l); }
            else { if (PH_ON(7)) moe2_phase(F, ap, l); }
        }
        if (ph + 1 < hi) xcd_barrier(bar, F.tid);
    }
}

extern "C" void kernel_launch(void* const* d_in, const int* in_sizes, int n_in, void* d_out, int out_size, void* d_ws, size_t ws_size, hipStream_t stream) {
    static int grid = 0;
    if (grid == 0) {
        if (n_in != 22 || out_size != TL * D || ws_size < WS_END) { fprintf(stderr, "kernel_launch: unexpected shapes (n_in %d out %d ws %zu)\n", n_in, out_size, ws_size); grid = -1; return; }
        int dev = 0, cus = 0, per_cu = 0;
        if (hipGetDevice(&dev) != hipSuccess || hipDeviceGetAttribute(&cus, hipDeviceAttributeMultiprocessorCount, dev) != hipSuccess) { grid = -1; return; }
        if (hipFuncSetAttribute((const void*)mk_fwd, hipFuncAttributeMaxDynamicSharedMemorySize, LDS_BYTES) != hipSuccess) { fprintf(stderr, "kernel_launch: hipFuncSetAttribute failed\n"); grid = -1; return; }
        if (hipOccupancyMaxActiveBlocksPerMultiprocessor(&per_cu, (const void*)mk_fwd, NWAVES * 64, LDS_BYTES) != hipSuccess || per_cu < 1) fprintf(stderr, "kernel_launch: occupancy query says %d\n", per_cu);
        (void)hipGetLastError();
        grid = cus;
    }
    if (grid < 0) return;
    (void)hipMemsetAsync((char*)d_ws + WS_CTL, 0, CTL_ZERO_BYTES, stream);
    Args a{};
    for (int i = 0; i < 22; ++i) a.in[i] = (const float*)d_in[i];
    a.out = (float*)d_out; a.ws = (unsigned char*)d_ws; a.li = 0; a.pad = 0;
#if MK_N_LAUNCHES == 1
    a.ph_lo = 0; a.ph_hi = N_PHASES;
    hipLaunchKernelGGL(mk_fwd, dim3(grid), dim3(NWAVES * 64), LDS_BYTES, stream, a);
#else
    for (int ph = 0; ph < N_PHASES; ++ph) { a.ph_lo = ph; a.ph_hi = ph + 1; hipLaunchKernelGGL(mk_fwd, dim3(grid), dim3(NWAVES * 64), LDS_BYTES, stream, a); }
#endif
}
```

```cpp
#include <hip/hip_runtime.h>
#include <cstdio>
#include <cstdint>
#include <utility>

#ifndef ONLY_S
#define ONLY_S -1
#endif
#define PH_ON(k) (ONLY_S < 0 || ONLY_S == (k))
#ifndef REPEAT_S
#define REPEAT_S -1
#endif
#ifndef REPEAT_N
#define REPEAT_N 4
#endif
#define REP(k, cond) for (int rep_ = 0; rep_ < ((REPEAT_S == (k) && (cond)) ? REPEAT_N : 1); ++rep_)
#ifndef MK_N_LAUNCHES
#define MK_N_LAUNCHES 1
#endif

#define GAS __attribute__((address_space(1)))
#define LAS __attribute__((address_space(3)))
#define CAS __attribute__((address_space(4)))
typedef unsigned short bf16;
typedef short bf16x8 __attribute__((ext_vector_type(8)));
typedef float f32x4 __attribute__((ext_vector_type(4)));
typedef float f32x2 __attribute__((ext_vector_type(2)));
typedef unsigned u32x4 __attribute__((ext_vector_type(4)));
typedef unsigned u32x2 __attribute__((ext_vector_type(2)));

constexpr int D = 1024, SEQ = 8192, LC = 256, TL = 16384, TC = 512, TT = TL + TC, DEPTH = 2;
constexpr int NE = 16, DE = 512;
constexpr int NIN = 2816;
constexpr int PC_Q = 0, PC_K = 256, PC_V = 512, PC_G = 1024, PC_SQ = 1536, PC_SK = 2048, PC_SV = 2176, PC_GF = 2304, PC_GB = 2560;
constexpr int WIN_COLS = 2336;
constexpr float EPS = 1e-6f;
constexpr float LOG2E = 1.4426950408889634f, QSCALE = 0.125f * LOG2E;
constexpr int LISTCAP = TT;

constexpr size_t MiB = 1u << 20;
constexpr size_t WS_CTL = 0, CTL_ZERO_BYTES = 65536;
constexpr size_t WS_MOD = 1 * MiB;
constexpr size_t WS_ROPE = 1 * MiB + 256 * 1024;
constexpr size_t WS_LIST = 2 * MiB;
constexpr size_t WS_LISTW = 2 * MiB + 1536 * 1024;
constexpr size_t WS_XC = 5 * MiB;
constexpr size_t WS_WIN = 8 * MiB;
constexpr size_t WS_WOUT = 19 * MiB;
constexpr size_t WS_WGU = 23 * MiB;
constexpr size_t WS_WD = 87 * MiB;
constexpr size_t WS_H = 119 * MiB;
constexpr size_t WS_P = 152 * MiB;
constexpr size_t WS_MIX = 243 * MiB;
constexpr size_t WS_GL = 276 * MiB;
constexpr size_t WS_HMID = 152 * MiB;
constexpr size_t WS_Y = 190 * MiB;
constexpr size_t WS_END = 309 * MiB;
static_assert(WS_LIST + (size_t)NE * LISTCAP * 4 <= WS_LISTW && WS_LISTW + (size_t)NE * LISTCAP * 4 <= WS_XC, "ws map");
static_assert(WS_P + (size_t)TT * NIN * 2 <= WS_MIX && WS_MIX + (size_t)TT * D * 2 <= WS_GL, "ws map");
static_assert(WS_HMID + (size_t)37888 * 512 * 2 <= WS_Y && WS_Y + (size_t)2 * TT * D * 2 <= WS_GL, "ws map");
constexpr int CW_CNT = 64;
constexpr int CW_BAR = 4096;

__device__ __forceinline__ unsigned f2bf(float f) { unsigned u = __builtin_bit_cast(unsigned, f); return (u + 0x7fffu + ((u >> 16) & 1u)) >> 16; }
__device__ __forceinline__ unsigned pk2(float lo, float hi) { return f2bf(lo) | (f2bf(hi) << 16); }
__device__ __forceinline__ float bf2f(unsigned h) { return __builtin_bit_cast(float, h << 16); }
__device__ __forceinline__ float bflo(unsigned w) { return __builtin_bit_cast(float, w << 16); }
__device__ __forceinline__ float bfhi(unsigned w) { return __builtin_bit_cast(float, w & 0xffff0000u); }
__device__ __forceinline__ float dpp_add(float v, float t) { return v + t; }
#define DPP_F(v, ctrl, rmask) __builtin_bit_cast(float, __builtin_amdgcn_update_dpp(0, __builtin_bit_cast(int, (v)), (ctrl), (rmask), 0xF, false))
__device__ __forceinline__ float row16_sum(float v) {
    v += DPP_F(v, 0xB1, 0xF); v += DPP_F(v, 0x4E, 0xF); v += DPP_F(v, 0x141, 0xF); v += DPP_F(v, 0x140, 0xF); return v;
}
__device__ __forceinline__ float wave_sum(float v) {
    v = row16_sum(v);
    v += DPP_F(v, 0x142, 0xA); v += DPP_F(v, 0x143, 0xC);
    return __builtin_bit_cast(float, __builtin_amdgcn_readlane(__builtin_bit_cast(int, v), 63));
}
__device__ __forceinline__ float silu_f(float x) { return x / (1.0f + __expf(-x)); }
#define LDS_WAIT() asm volatile("s_waitcnt lgkmcnt(0)" ::: "memory")
#define VM_WAIT() asm volatile("s_waitcnt vmcnt(0)" ::: "memory")

namespace pg8 {
constexpr int BM = 256, BK = 64, HALF = 128, HTB = HALF * BK * 2, STAGE_BYTES = 8 * HTB, NXCD = 8, WGM = 8;
__host__ __device__ __forceinline__ int lds_byte(int r, int c) { const int st = (r >> 4) * 2 + (c >> 5), rr = r & 15, cc = c & 31, ob = rr * 64 + cc * 2; return st * 1024 + (ob ^ (((ob >> 9) & 1) << 5)); }
__host__ __device__ __forceinline__ void stage_rc(int b, int& R, int& C) { const int st = b / 1024, sb = b % 1024, swz = sb ^ (((sb >> 9) & 1) << 5); R = (st >> 1) * 16 + swz / 64; C = (st & 1) * 32 + (swz % 64) / 2; }
__host__ __device__ __forceinline__ int perm32(int rho) { const int n = rho >> 4, i = rho & 15; return 8 * (i >> 2) + 4 * n + (i & 3); }

struct Unit { int pm, pn, e, mt; };

__device__ __forceinline__ int xcd_remap(int wgid, int nwg) { const int q = nwg / NXCD, r = nwg % NXCD, xcd = wgid % NXCD, off = wgid / NXCD; return (xcd < r ? xcd * (q + 1) : r * (q + 1) + (xcd - r) * q) + off; }

struct DenseOrder {
    static constexpr bool DYN_A = false;
    const char* A; const char* Bt; int K; int nM, nN, nwg, G, c;
    __device__ void init(const void* A_, const void* Bt_, int M, int N, int K_, int G_, int c_) { A = (const char*)A_; Bt = (const char*)Bt_; K = K_; nM = M / BM; nN = N / BM; nwg = nM * nN; G = G_; c = c_; }
    __device__ __forceinline__ bool next(int i, Unit& u) const {
        const long L = (long)i * G + c; if (L >= nwg) return false;
        const int wgid = xcd_remap((int)L, nwg);
        const int nig = WGM * nN, gid = wgid / nig, fm = gid * WGM, gsz = (nM - fm) < WGM ? (nM - fm) : WGM;
        u.pm = fm + ((wgid % nig) % gsz); u.pn = (wgid % nig) / gsz; u.e = 0; u.mt = 0; return true;
    }
    __device__ __forceinline__ const char* a_ptr(const Unit& u) const { return A + (size_t)u.pm * (size_t)(BM * K * 2); }
    __device__ __forceinline__ const char* b_ptr(const Unit& u) const { return Bt + (size_t)u.pn * (size_t)(BM * K * 2); }
    __device__ __forceinline__ void a_voff(const Unit&, const int (&R)[2], const int (&C)[2], unsigned (&v0)[2], unsigned (&v1)[2]) const {
#pragma unroll
        for (int i = 0; i < 2; ++i) { v0[i] = (unsigned)(R[i] * K + C[i]) * 2u; v1[i] = v0[i] + (unsigned)(HALF * K * 2); }
    }
};

struct MoeOrder {
    static constexpr bool DYN_A = true;
    const char* A; const char* Bt; int K; size_t bstride_e; int G, c, nunits, nN; bool gather;
    const unsigned* list; const LAS int* tab;
    __device__ __forceinline__ bool next(int i, Unit& u) const {
        const long L = (long)i * G + c; if (L >= nunits) return false;
        const int wgid = xcd_remap((int)L, nunits);
        const int tl = wgid / nN; u.pn = wgid % nN;
        int e = 0, tstart = 0;
#pragma unroll 1
        for (int k = 0; k < NE - 1; ++k) { const int te = tab[16 + k]; if (tl >= te) { e = k + 1; tstart = te; } }
        u.e = __builtin_amdgcn_readfirstlane(e); u.mt = __builtin_amdgcn_readfirstlane(tl - tstart); u.pm = tl; return true;
    }
    __device__ __forceinline__ const char* a_ptr(const Unit& u) const { return gather ? A : A + (size_t)u.pm * (size_t)(BM * K * 2); }
    __device__ __forceinline__ const char* b_ptr(const Unit& u) const { return Bt + (size_t)u.e * bstride_e + (size_t)u.pn * (size_t)(BM * K * 2); }
    __device__ __forceinline__ void a_voff(const Unit& u, const int (&R)[2], const int (&C)[2], unsigned (&v0)[2], unsigned (&v1)[2]) const {
        if (gather) {
            const int ce = tab[u.e];
            const unsigned* lp = list + (size_t)u.e * LISTCAP + u.mt * BM;
#pragma unroll
            for (int i = 0; i < 2; ++i) {
                const int r0 = R[i], r1 = R[i] + HALF;
                const unsigned t0 = (u.mt * BM + r0 < ce) ? (__builtin_nontemporal_load(lp + r0) >> 1) : 0u;
                const unsigned t1 = (u.mt * BM + r1 < ce) ? (__builtin_nontemporal_load(lp + r1) >> 1) : 0u;
                v0[i] = (t0 * (unsigned)K + (unsigned)C[i]) * 2u; v1[i] = (t1 * (unsigned)K + (unsigned)C[i]) * 2u;
            }
        } else {
#pragma unroll
            for (int i = 0; i < 2; ++i) { v0[i] = (unsigned)(R[i] * K + C[i]) * 2u; v1[i] = v0[i] + (unsigned)(HALF * K * 2); }
        }
    }
};

__device__ __forceinline__ unsigned cvt_pk_bf16(float lo, float hi) { unsigned r; asm volatile("v_cvt_pk_bf16_f32 %0, %1, %2" : "=v"(r) : "v"(lo), "v"(hi)); return r; }

template <class Epi, class Sched>
__device__ __forceinline__ void gemm_phase(LAS unsigned char* lds, int tid, const Sched& S, const Epi& E) {
    const int wid = __builtin_amdgcn_readfirstlane(tid >> 6), lane = tid & 63, wr = wid >> 2, wc = wid & 3, fr = lane & 15, fq = lane >> 4;
    const int K = S.K, nt = K / BK;
    int Rr[2], Cc[2]; unsigned voffB[2];
#pragma unroll
    for (int i = 0; i < 2; ++i) { int R, C; stage_rc(tid * 16 + i * 8192, R, C); const int Rb = Epi::PERM ? ((R & ~31) + perm32(R & 31)) : R;
        Rr[i] = R; Cc[i] = C; voffB[i] = (unsigned)(Rb * K + C) * 2u; }
    const size_t kstep = (size_t)(BK * 2);
    const size_t hstep = (size_t)HALF * K * 2;
    const unsigned ldsw = (unsigned)wid * 1024u;
    const int aoff = lds_byte(wr * 64 + fr, fq * 8), boff = lds_byte(wc * 32 + fr, fq * 8);
#define PG8_SA(b, h) (((b) * 2 + (h)) * HTB)
#define PG8_SB(b, h) ((4 + (b) * 2 + (h)) * HTB)
#define PG8_STAGE(bufoff, gbase, voff) do { _Pragma("unroll") for (int _i = 0; _i < 2; ++_i) \
        __builtin_amdgcn_global_load_lds((const unsigned*)((const char*)(gbase) + (voff)[_i]), (LAS unsigned*)(lds + (bufoff) + ldsw + _i * 8192), 16, 0, 0); } while (0)
#define PG8_LDA(dst, b, h) do { _Pragma("unroll") for (int m = 0; m < 4; ++m) _Pragma("unroll") for (int k = 0; k < 2; ++k) dst[m][k] = *(const LAS bf16x8*)(lds + PG8_SA(b, h) + aoff + m * 2048 + k * 1024); } while (0)
#define PG8_LDB(dst, b, h) do { _Pragma("unroll") for (int n = 0; n < 2; ++n) _Pragma("unroll") for (int k = 0; k < 2; ++k) dst[n][k] = *(const LAS bf16x8*)(lds + PG8_SB(b, h) + boff + n * 2048 + k * 1024); } while (0)
#define PG8_MMA(ai, bj, At, Bt) do { __builtin_amdgcn_s_setprio(1); _Pragma("unroll") for (int m = 0; m < 4; ++m) _Pragma("unroll") for (int n = 0; n < 2; ++n) _Pragma("unroll") for (int k = 0; k < 2; ++k) \
        acc[ai][bj][m][n] = __builtin_amdgcn_mfma_f32_16x16x32_bf16(Bt[n][k], At[m][k], acc[ai][bj][m][n], 0, 0, 0); __builtin_amdgcn_s_setprio(0); } while (0)
#define PG8_WAIT_V(n) asm volatile("s_waitcnt vmcnt(" #n ")" ::: "memory")
#define PG8_WAIT_L(n) asm volatile("s_waitcnt lgkmcnt(" #n ")" ::: "memory")
#define PG8_BAR __builtin_amdgcn_s_barrier()
#define PG8_SCHED __builtin_amdgcn_sched_barrier(0)
    Unit cur, nxt; int ui = 0;
    if (!S.next(0, cur)) return;
    f32x4 acc[2][2][4][2];
#pragma unroll
    for (int a = 0; a < 2; ++a)
#pragma unroll
        for (int b = 0; b < 2; ++b)
#pragma unroll
            for (int m = 0; m < 4; ++m)
#pragma unroll
                for (int n = 0; n < 2; ++n) acc[a][b][m][n] = (f32x4){0.f, 0.f, 0.f, 0.f};
    bf16x8 At[4][2], B0[2][2], B1[2][2];
    const char* cA = S.a_ptr(cur); const char* cB = S.b_ptr(cur);
    unsigned cv0[2], cv1[2], nv0[2], nv1[2];
    S.a_voff(cur, Rr, Cc, cv0, cv1);
    PG8_STAGE(PG8_SB(0, 0), cB, voffB); PG8_STAGE(PG8_SB(0, 1), cB + hstep, voffB); PG8_STAGE(PG8_SA(0, 0), cA, cv0); PG8_STAGE(PG8_SA(0, 1), cA, cv1);
    if (wr == 1) PG8_BAR;
    PG8_WAIT_V(2); PG8_BAR;
    PG8_STAGE(PG8_SB(1, 0), cB + kstep, voffB); PG8_STAGE(PG8_SA(1, 0), cA + kstep, cv0); PG8_STAGE(PG8_SB(1, 1), cB + hstep + kstep, voffB);
    PG8_WAIT_V(6); PG8_BAR;
    for (;;) {
        const bool has_next = S.next(ui + 1, nxt);
        const char* nA = has_next ? S.a_ptr(nxt) : cA; const char* nB = has_next ? S.b_ptr(nxt) : cB;
        if (has_next) S.a_voff(nxt, Rr, Cc, nv0, nv1); else { nv0[0] = cv0[0]; nv0[1] = cv0[1]; nv1[0] = cv1[0]; nv1[1] = cv1[1]; }
        if constexpr (Sched::DYN_A) asm volatile("" : "+v"(nv0[0]), "+v"(nv0[1]), "+v"(nv1[0]), "+v"(nv1[1]));
        for (int t = 0; t < nt; t += 2) {
            const bool last = (t == nt - 2);
            const char* a1 = cA + (size_t)(t + 1) * kstep;
            const char* a2 = last ? nA : cA + (size_t)(t + 2) * kstep; const char* b2 = last ? nB : cB + (size_t)(t + 2) * kstep;
            const char* a3 = a2 + kstep; const char* b3 = b2 + kstep;
            unsigned w0[2], w1[2];
            w0[0] = last ? nv0[0] : cv0[0]; w0[1] = last ? nv0[1] : cv0[1]; w1[0] = last ? nv1[0] : cv1[0]; w1[1] = last ? nv1[1] : cv1[1];
            PG8_LDB(B0, 0, 0); PG8_LDB(B1, 0, 1); PG8_SCHED; PG8_LDA(At, 0, 0); PG8_STAGE(PG8_SA(1, 1), a1, cv1);
            PG8_WAIT_V(8); PG8_WAIT_L(0); PG8_BAR; PG8_MMA(0, 0, At, B0); PG8_MMA(0, 1, At, B1); PG8_BAR; PG8_SCHED;
            PG8_LDA(At, 0, 1); PG8_STAGE(PG8_SB(0, 0), b2, voffB); PG8_STAGE(PG8_SB(0, 1), b2 + hstep, voffB); PG8_STAGE(PG8_SA(0, 0), a2, w0);
            PG8_WAIT_V(8); PG8_WAIT_L(0); PG8_BAR; PG8_MMA(1, 0, At, B0); PG8_MMA(1, 1, At, B1); PG8_BAR; PG8_SCHED;
            PG8_LDB(B0, 1, 0); PG8_LDB(B1, 1, 1); PG8_SCHED; PG8_LDA(At, 1, 0); PG8_STAGE(PG8_SA(0, 1), a2, w1);
            PG8_WAIT_V(8); PG8_WAIT_L(0); PG8_BAR; PG8_MMA(0, 0, At, B0); PG8_MMA(0, 1, At, B1); PG8_BAR; PG8_SCHED;
            PG8_LDA(At, 1, 1); PG8_STAGE(PG8_SB(1, 0), b3, voffB); PG8_STAGE(PG8_SB(1, 1), b3 + hstep, voffB); PG8_STAGE(PG8_SA(1, 0), a3, w0);
            PG8_WAIT_V(8); PG8_WAIT_L(0); PG8_BAR; PG8_MMA(1, 0, At, B0); PG8_MMA(1, 1, At, B1); PG8_BAR; PG8_SCHED;
        }
        if (wr == 0) PG8_BAR;
        E(acc, cur, wr, wc, fr, fq);
        if (!has_next) break;
#pragma unroll
        for (int a = 0; a < 2; ++a)
#pragma unroll
            for (int b = 0; b < 2; ++b)
#pragma unroll
                for (int m = 0; m < 4; ++m)
#pragma unroll
                    for (int n = 0; n < 2; ++n) acc[a][b][m][n] = (f32x4){0.f, 0.f, 0.f, 0.f};
        cur = nxt; cA = nA; cB = nB; ++ui;
        cv0[0] = nv0[0]; cv0[1] = nv0[1]; cv1[0] = nv1[0]; cv1[1] = nv1[1];
        if (wr == 1) PG8_BAR;
    }
    PG8_WAIT_V(0);
    PG8_BAR;
#undef PG8_SA
#undef PG8_SB
#undef PG8_STAGE
#undef PG8_LDA
#undef PG8_LDB
#undef PG8_MMA
#undef PG8_WAIT_V
#undef PG8_WAIT_L
#undef PG8_BAR
#undef PG8_SCHED
}
}

#define XB_TMO      128
#define XB_XCNT(j)  (256  + 64 * (j))
#define XB_XSUB(j)  (1280 + 64 * (j))
#define XB_XGEN(j)  (2304 + 64 * (j))
#define XB_TOP      3328
#define XB_TOPGEN   3392
#define XCD_BAR_WORDS 3456
#define XB_SPIN_CAP (1u << 18)
__device__ __forceinline__ unsigned xb_ld(unsigned* p)              { return __hip_atomic_load(p, __ATOMIC_RELAXED, __HIP_MEMORY_SCOPE_AGENT); }
__device__ __forceinline__ unsigned xb_add(unsigned* p, unsigned v) { return __hip_atomic_fetch_add(p, v, __ATOMIC_RELAXED, __HIP_MEMORY_SCOPE_AGENT); }
__device__ __forceinline__ unsigned xb_xcc_id() { return (unsigned)__builtin_amdgcn_s_getreg((3 << 11) | 20) & 0xFu; }
#define XB_SPIN(cond, bar) do { unsigned _sp = 0; while (cond) { __builtin_amdgcn_s_sleep(1); \
    if ((++_sp & 255u) == 0u) { if (xb_ld(&(bar)[XB_TMO])) break; if (_sp > XB_SPIN_CAP) { atomicAdd(&(bar)[XB_TMO], 1u); break; } } } } while (0)
struct XcdBarrier { unsigned* bar; unsigned x; volatile LAS unsigned* st; };
__device__ __forceinline__ XcdBarrier xcd_barrier_post(unsigned* bar, volatile LAS unsigned* st) {
    XcdBarrier b; b.bar = bar; b.x = xb_xcc_id(); b.st = st;
    if (threadIdx.x == 0) (void)xb_add(&bar[XB_XCNT(b.x)], 1u);
    return b;
}
__device__ __forceinline__ void xcd_barrier_complete(unsigned* bar, unsigned x, unsigned& nloc, unsigned& nx) {
    const unsigned G = gridDim.x * gridDim.y * gridDim.z;
    unsigned sum, cnt, mine, sp = 0u;
    for (;;) {
        sum = 0u; cnt = 0u; mine = 0u;
#pragma unroll
        for (unsigned j = 0; j < 16; ++j) { const unsigned c = xb_ld(&bar[XB_XCNT(j)]); sum += c; cnt += (c > 0u) ? 1u : 0u; mine = (j == x) ? c : mine; }
        if (sum == G) break;
        __builtin_amdgcn_s_sleep(1);
        if ((++sp & 255u) == 0u) { if (xb_ld(&bar[XB_TMO])) break; if (sp > XB_SPIN_CAP) { atomicAdd(&bar[XB_TMO], 1u); break; } }
    }
    nloc = mine > 0u ? mine : 1u; nx = cnt > 0u ? cnt : 1u;
}
__device__ __forceinline__ void xcd_barrier(const XcdBarrier& b, int tid) {
    asm volatile("s_waitcnt vmcnt(0)" ::: "memory");
    __syncthreads();
    if (tid == 0) {
        unsigned* bar = b.bar;
        __builtin_amdgcn_s_waitcnt(0);
        unsigned nloc = b.st[0], nx = b.st[1];
        if (nloc == 0u) { xcd_barrier_complete(bar, b.x, nloc, nx); b.st[0] = nloc; b.st[1] = nx; }
        const unsigned old = xb_add(&bar[XB_XSUB(b.x)], 1u);
        const unsigned gen = old / nloc;
        if (old + 1u == (gen + 1u) * nloc) {
            __builtin_amdgcn_fence(__ATOMIC_RELEASE, "agent");
            asm volatile("s_waitcnt vmcnt(0)" ::: "memory");
            const unsigned og = xb_add(&bar[XB_TOP], 1u);
            const unsigned tg = og / nx;
            if (og + 1u == (tg + 1u) * nx) xb_add(&bar[XB_TOPGEN], 1u);
            else XB_SPIN(xb_ld(&bar[XB_TOPGEN]) == tg, bar);
            __builtin_amdgcn_fence(__ATOMIC_ACQUIRE, "agent");
            xb_add(&bar[XB_XGEN(b.x)], 1u);
            asm volatile("s_waitcnt vmcnt(0)" ::: "memory");
        } else {
            XB_SPIN(xb_ld(&bar[XB_XGEN(b.x)]) == gen, bar);
            __builtin_amdgcn_fence(__ATOMIC_ACQUIRE, "agent");
            asm volatile("s_waitcnt vmcnt(0)" ::: "memory");
        }
    }
    __syncthreads();
}

constexpr int NWAVES = 8;
constexpr int RING_BYTES = 131072, LDSCTL_OFF = RING_BYTES, MISC_OFF = LDSCTL_OFF + 320, LDS_BYTES = 147456;
struct Args { const float* in[22]; float* out; unsigned char* ws; int ph_lo, ph_hi, li, pad; };
enum { I_X = 0, I_C, I_CTX, I_CCTX, I_WADA, I_BADA, I_NORM1, I_NORM2, I_WIN, I_UPF, I_BIASF, I_UPB, I_BIASB, I_GLANORM, I_SINK, I_WOUT, I_WROUTER, I_BROUTER, I_WGATE, I_WUP, I_WDOWN, I_FNORM };

struct Frame {
    LAS unsigned char* lds; int tid, lane, wave, vcu, G, gw, NGW;
    unsigned char* ws; float* out;
};

__device__ __forceinline__ int rope_pos(int d) { return 8 * ((d & 15) >> 2) + 4 * (d >> 4) + (d & 3); }
__device__ __forceinline__ int gu_row(int h, int gu) { return (h >> 7) * 256 + ((h >> 6) & 1) * 128 + ((h >> 4) & 3) * 32 + ((h >> 2) & 3) * 8 + gu * 4 + (h & 3); }
__device__ __forceinline__ void transpose_item(const float* W, int N, bf16* WT, int Kd, int k0, int n0, int rbase, int mode, LAS float* scr, int lane) {
#pragma unroll 8
    for (int i = 0; i < 32; ++i) { const int kk = 2 * i + (lane >> 5); scr[kk * 33 + (lane & 31)] = W[(size_t)(k0 + kk) * N + n0 + (lane & 31)]; }
    LDS_WAIT(); asm volatile("" ::: "memory");
    const int c = lane & 7;
#pragma unroll
    for (int j = 0; j < 4; ++j) { const int n = (lane >> 3) + 8 * j; const LAS float* s = scr + (8 * c) * 33 + n;
        u32x4 o; o.x = pk2(s[0 * 33], s[1 * 33]); o.y = pk2(s[2 * 33], s[3 * 33]); o.z = pk2(s[4 * 33], s[5 * 33]); o.w = pk2(s[6 * 33], s[7 * 33]);
        const int row = (mode == 0) ? rbase + n : (mode == 1) ? rbase + rope_pos(n) : gu_row(n0 + n, mode - 2);
        *(u32x4*)(WT + (size_t)row * Kd + k0 + 8 * c) = o; }
    LDS_WAIT(); asm volatile("" ::: "memory");
}

__device__ __forceinline__ void p0_prologue(const Frame& F, const CAS Args* a) {
    unsigned char* ws = F.ws;
    LAS float* scr = (LAS float*)(F.lds + F.wave * 16384);
    constexpr int IT_IN = 2 * 16 * 73, IT_OUT = 2 * 16 * 32, IT_G = 32 * 16 * 16, IT_D = 32 * 8 * 32;
    constexpr int NITEMS = IT_IN + IT_OUT + 2 * IT_G + IT_D;
    for (int it = F.gw; it < NITEMS; it += F.NGW) {
        int r = it;
        if (r < IT_IN) {
            const int l = r / 1168, rr = r % 1168, kb = rr / 73, nb = rr % 73;
            if (nb == 48) continue;
            const int n0 = nb * 32; int rbase, mode = 0;
            if (n0 < 1536) rbase = n0;
            else if (n0 < 2080) { rbase = PC_SQ + (n0 - 1568); mode = 1; }
            else if (n0 < 2208) { rbase = PC_SK + (n0 - 2080); mode = 1; }
            else rbase = PC_SV + (n0 - 2208);
            transpose_item(a->in[I_WIN] + (size_t)l * D * WIN_COLS, WIN_COLS, (bf16*)(ws + WS_WIN) + (size_t)l * NIN * D, D, kb * 64, n0, rbase, mode, scr, F.lane);
            continue;
        }
        r -= IT_IN;
        if (r < IT_OUT) { const int l = r / 512, rr = r % 512, kb = rr / 32, nb = rr % 32;
            transpose_item(a->in[I_WOUT] + (size_t)l * D * D, D, (bf16*)(ws + WS_WOUT) + (size_t)l * D * D, D, kb * 64, nb * 32, nb * 32, 0, scr, F.lane); continue; }
        r -= IT_OUT;
        if (r < 2 * IT_G) { const int gu = r / IT_G, r2 = r % IT_G, le = r2 / 256, rr = r2 % 256, kb = rr / 16, nb = rr % 16;
            transpose_item(a->in[gu ? I_WUP : I_WGATE] + (size_t)le * D * DE, DE, (bf16*)(ws + WS_WGU) + (size_t)le * D * D, D, kb * 64, nb * 32, 0, 2 + gu, scr, F.lane); continue; }
        r -= 2 * IT_G;
        { const int le = r / 256, rr = r % 256, kb = rr / 32, nb = rr % 32;
            transpose_item(a->in[I_WDOWN] + (size_t)le * DE * D, D, (bf16*)(ws + WS_WD) + (size_t)le * D * DE, DE, kb * 64, nb * 32, nb * 32, 0, scr, F.lane); }
    }
    for (int idx = F.gw * 64 + F.lane; idx < 2 * 2 * 256 * 128; idx += F.NGW * 64) {
        const int kc = idx & 127, n = (idx >> 7) & 255, dir = (idx >> 15) & 1, l = idx >> 16;
        const float* up = a->in[dir ? I_UPB : I_UPF] + (size_t)l * 16 * 256 + n;
        float u[16];
#pragma unroll
        for (int r = 0; r < 16; ++r) u[r] = up[r * 256];
        float o[8];
#pragma unroll
        for (int kk = 0; kk < 8; ++kk) {
            const f32x4* wz = (const f32x4*)(a->in[I_WIN] + ((size_t)l * D + kc * 8 + kk) * WIN_COLS + 1536 + dir * 16);
            float s = 0.f;
#pragma unroll
            for (int q = 0; q < 4; ++q) { const f32x4 w = wz[q]; s += w[0] * u[4 * q] + w[1] * u[4 * q + 1] + w[2] * u[4 * q + 2] + w[3] * u[4 * q + 3]; }
            o[kk] = s;
        }
        u32x4 ov; ov.x = pk2(o[0], o[1]); ov.y = pk2(o[2], o[3]); ov.z = pk2(o[4], o[5]); ov.w = pk2(o[6], o[7]);
        *(u32x4*)((bf16*)(ws + WS_WIN) + ((size_t)l * NIN + PC_GF + dir * 256 + n) * D + kc * 8) = ov;
    }
    if (blockIdx.x == (unsigned)(F.G - 1)) {
        float* tc = (float*)(ws + WS_ROPE); float* tsn = tc + 2048;
        for (int i = F.tid; i < 2048; i += NWAVES * 64) { const int pos = i >> 4, j = i & 15; const float inv = powf(10000.0f, -(float)j * (1.0f / 16.0f)); const float ang = (float)pos * inv;
            tc[i] = cosf(ang); tsn[i] = sinf(ang); }
    }
    __syncthreads();
    {
        LAS float* cs = (LAS float*)F.lds; LAS float* red = cs + 3072;
        for (int i = F.tid; i < 3072; i += NWAVES * 64) { const int v = i >> 10, k = i & 1023; const float cv = v < 2 ? a->in[I_C][v * D + k] : a->in[I_CCTX][k]; cs[i] = cv / (1.0f + expf(-cv)); }
        __syncthreads();
        for (int u = blockIdx.x; u < 192; u += F.G) {
            const int l = u / 96, jg = u % 96, jl = F.tid & 63, ks = F.tid >> 6;
            const float* wp = a->in[I_WADA] + ((size_t)l * D + ks * 128) * 6144 + jg * 64 + jl;
            float a0 = 0.f, a1 = 0.f, a2 = 0.f;
#pragma unroll 8
            for (int k = 0; k < 128; ++k) { const float w = wp[(size_t)k * 6144]; const int kk = ks * 128 + k; a0 += cs[kk] * w; a1 += cs[1024 + kk] * w; a2 += cs[2048 + kk] * w; }
            red[(ks * 3 + 0) * 64 + jl] = a0; red[(ks * 3 + 1) * 64 + jl] = a1; red[(ks * 3 + 2) * 64 + jl] = a2;
            __syncthreads();
            if (F.tid < 192) { const int v = F.tid >> 6, j2 = F.tid & 63; float s = 0.f;
#pragma unroll
                for (int q = 0; q < 8; ++q) s += red[(q * 3 + v) * 64 + j2];
                ((float*)(ws + WS_MOD))[(l * 3 + v) * 6144 + jg * 64 + j2] = s + a->in[I_BADA][l * 6144 + jg * 64 + j2]; }
            __syncthreads();
        }
    }
}

__device__ __forceinline__ f32x4 ld_y4(const bf16* p) { const u32x2 w = *(const u32x2*)p; return (f32x4){bflo(w.x), bfhi(w.x), bflo(w.y), bfhi(w.y)}; }
__device__ __forceinline__ void n1_phase(const Frame& F, const CAS Args* a, int l) {
    unsigned char* ws = F.ws;
    const float* mod = (const float*)(ws + WS_MOD);
    const bf16* Y0 = (const bf16*)(ws + WS_Y); const bf16* Y1 = Y0 + (size_t)TT * D;
    bf16* H = (bf16*)(ws + WS_H);
    for (int m = F.gw; m < TT; m += F.NGW) {
        const int v = m < TL ? (m >> 13) : 2;
        float* xrow = m < TL ? F.out + (size_t)m * D : (float*)(ws + WS_XC) + (size_t)(m - TL) * D;
        const float* src = (l == 0) ? (m < TL ? a->in[I_X] + (size_t)m * D : a->in[I_CTX] + (size_t)(m - TL) * D) : xrow;
        f32x4 x[4]; float ss = 0.f;
#pragma unroll
        for (int j = 0; j < 4; ++j) {
            const int col = 4 * F.lane + 256 * j;
            x[j] = *(const f32x4*)(src + col);
            if (l > 0) {
                const f32x4 g2 = *(const f32x4*)(mod + ((l - 1) * 3 + v) * 6144 + 5 * D + col);
                const f32x4 y = ld_y4(Y0 + (size_t)m * D + col) + ld_y4(Y1 + (size_t)m * D + col);
                x[j] = x[j] + g2 * y;
                *(f32x4*)(xrow + col) = x[j];
            }
            ss += (x[j][0] * x[j][0] + x[j][1] * x[j][1]) + (x[j][2] * x[j][2] + x[j][3] * x[j][3]);
        }
        const float rstd = 1.0f / sqrtf(wave_sum(ss) * (1.0f / D) + EPS);
#pragma unroll
        for (int j = 0; j < 4; ++j) {
            const int col = 4 * F.lane + 256 * j;
            const f32x4 nw = *(const f32x4*)(a->in[I_NORM1] + l * D + col);
            const f32x4 sh = *(const f32x4*)(mod + (l * 3 + v) * 6144 + 0 * D + col);
            const f32x4 sc = *(const f32x4*)(mod + (l * 3 + v) * 6144 + 1 * D + col);
            const f32x4 h = x[j] * rstd * nw * (1.0f + sc) + sh;
            u32x2 o; o.x = pk2(h[0], h[1]); o.y = pk2(h[2], h[3]);
            *(u32x2*)(H + (size_t)m * D + col) = o;
        }
    }
}

struct EpiIn {
    static constexpr bool PERM = true;
    bf16* P; const float* bias_f; const float* bias_b; const float* tcos; const float* tsin;
    __device__ __forceinline__ void operator()(const f32x4 (&acc)[2][2][4][2], const pg8::Unit& u, int wr, int wc, int fr, int fq) const {
        const int row0 = u.pm * 256 + wr * 64 + fr, colw = wc * 32 + 8 * fq;
        const int pn = u.pn;
        const bool latent = u.pm < 64;
#pragma unroll
        for (int ai = 0; ai < 2; ++ai)
#pragma unroll
            for (int m = 0; m < 4; ++m) {
                const int row = row0 + ai * 128 + m * 16;
                bf16* rowp = P + (size_t)row * NIN + pn * 256 + colw;
#pragma unroll
                for (int bj = 0; bj < 2; ++bj) {
                    f32x4 v0 = acc[ai][bj][m][0], v1 = acc[ai][bj][m][1];
                    if (pn == 0) { v0 = v0 * 0.125f; v1 = v1 * 0.125f; }
                    else if (pn >= 9) {
                        const float* bp = (pn == 9 ? bias_f : bias_b) + colw + bj * 128;
                        const f32x4 b0 = *(const f32x4*)bp, b1 = *(const f32x4*)(bp + 4);
#pragma unroll
                        for (int i = 0; i < 4; ++i) { float x0 = v0[i] + b0[i], x1 = v1[i] + b1[i];
                            v0[i] = (fminf(x0, 0.f) - __logf(1.0f + __expf(-fabsf(x0)))) * 0.0625f; v1[i] = (fminf(x1, 0.f) - __logf(1.0f + __expf(-fabsf(x1)))) * 0.0625f; }
                    } else if (latent && (pn == 6 || pn == 7 || (pn == 8 && bj == 0))) {
                        const int t = row & (SEQ - 1); const int pos = (wc & 1) ? (t & 63) : (t >> 6);
                        const f32x4 cs = *(const f32x4*)(tcos + pos * 16 + 4 * fq), sn = *(const f32x4*)(tsin + pos * 16 + 4 * fq);
                        const f32x4 o0 = v0 * cs - v1 * sn, o1 = v1 * cs + v0 * sn; v0 = o0; v1 = o1;
                    }
                    if (pn == 6 || pn == 7) { v0 = v0 * QSCALE; v1 = v1 * QSCALE; }
                    u32x4 w; w.x = pg8::cvt_pk_bf16(v0[0], v0[1]); w.y = pg8::cvt_pk_bf16(v0[2], v0[3]); w.z = pg8::cvt_pk_bf16(v1[0], v1[1]); w.w = pg8::cvt_pk_bf16(v1[2], v1[3]);
                    *(u32x4*)(rowp + bj * 128) = w;
                }
            }
    }
};
struct EpiOut {
    static constexpr bool PERM = false;
    const float* resL; const float* resC; float* outL; float* outC; const float* mod_l;
    __device__ __forceinline__ void operator()(const f32x4 (&acc)[2][2][4][2], const pg8::Unit& u, int wr, int wc, int fr, int fq) const {
        const bool latent = u.pm < 64;
        const int v = latent ? (u.pm >> 5) : 2;
        const int rowb = (latent ? u.pm * 256 : u.pm * 256 - TL) + wr * 64 + fr;
        const float* res = latent ? resL : resC; float* out = latent ? outL : outC;
        const int col0 = u.pn * 256 + wc * 32 + 4 * fq;
        const float* g1p = mod_l + v * 6144 + 2 * D + col0;
#pragma unroll
        for (int ai = 0; ai < 2; ++ai)
#pragma unroll
            for (int m = 0; m < 4; ++m) {
                const size_t off = (size_t)(rowb + ai * 128 + m * 16) * D + col0;
#pragma unroll
                for (int bj = 0; bj < 2; ++bj)
#pragma unroll
                    for (int n = 0; n < 2; ++n) {
                        const f32x4 g1 = *(const f32x4*)(g1p + bj * 128 + n * 16);
                        const f32x4 r = *(const f32x4*)(res + off + bj * 128 + n * 16);
                        *(f32x4*)(out + off + bj * 128 + n * 16) = r + g1 * acc[ai][bj][m][n];
                    }
                if (m & 1) asm volatile("" ::: "memory");
            }
    }
};
struct EpiGU {
    static constexpr bool PERM = true;
    bf16* Hmid;
    __device__ __forceinline__ void operator()(const f32x4 (&acc)[2][2][4][2], const pg8::Unit& u, int wr, int wc, int fr, int fq) const {
        const int row0 = u.pm * 256 + wr * 64 + fr, hid0 = u.pn * 128 + wc * 16 + fq * 4;
#pragma unroll
        for (int ai = 0; ai < 2; ++ai)
#pragma unroll
            for (int m = 0; m < 4; ++m) {
                bf16* rowp = Hmid + (size_t)(row0 + ai * 128 + m * 16) * DE + hid0;
#pragma unroll
                for (int bj = 0; bj < 2; ++bj) {
                    const f32x4 g = acc[ai][bj][m][0], up = acc[ai][bj][m][1]; f32x4 o;
#pragma unroll
                    for (int i = 0; i < 4; ++i) o[i] = g[i] * __builtin_amdgcn_rcpf(1.0f + __expf(-g[i])) * up[i];
                    u32x2 w; w.x = pg8::cvt_pk_bf16(o[0], o[1]); w.y = pg8::cvt_pk_bf16(o[2], o[3]);
                    *(u32x2*)(rowp + bj * 64) = w;
                }
            }
    }
};
struct EpiDown {
    static constexpr bool PERM = true;
    bf16* Y; const unsigned* list; const float* listw; const LAS int* tab;
    __device__ __forceinline__ void operator()(const f32x4 (&acc)[2][2][4][2], const pg8::Unit& u, int wr, int wc, int fr, int fq) const {
        const int ce = tab[u.e];
        const int r0 = u.mt * 256 + wr * 64 + fr, col0 = u.pn * 256 + wc * 32 + 8 * fq;
        const unsigned* lp = list + (size_t)u.e * LISTCAP; const float* lw = listw + (size_t)u.e * LISTCAP;
#pragma unroll
        for (int ai = 0; ai < 2; ++ai)
#pragma unroll
            for (int m = 0; m < 4; ++m) {
                const int r = r0 + ai * 128 + m * 16;
                if (r < ce) {
                    const unsigned ts = __builtin_nontemporal_load(lp + r); const float w = __builtin_nontemporal_load(lw + r);
                    bf16* rowp = Y + ((size_t)(ts & 1u) * TT + (ts >> 1)) * D + col0;
#pragma unroll
                    for (int bj = 0; bj < 2; ++bj) {
                        const f32x4 v0 = acc[ai][bj][m][0] * w, v1 = acc[ai][bj][m][1] * w;
                        u32x4 o; o.x = pg8::cvt_pk_bf16(v0[0], v0[1]); o.y = pg8::cvt_pk_bf16(v0[2], v0[3]); o.z = pg8::cvt_pk_bf16(v1[0], v1[1]); o.w = pg8::cvt_pk_bf16(v1[2], v1[3]);
                        *(u32x4*)(rowp + bj * 128) = o;
                    }
                }
            }
    }
};

__device__ __forceinline__ void swa_naive(const Frame& F, const CAS Args* a, int l) {
    const bf16* P = (const bf16*)(F.ws + WS_P); bf16* MIX = (bf16*)(F.ws + WS_MIX);
    const int total = (l == 0 ? TT : TL) * 8;
    for (int idx = F.gw * 64 + F.lane; idx < total; idx += F.NGW * 64) {
        const int m = idx >> 3, hq = idx & 7, kvh = hq >> 2;
        const bool latent = m < TL;
        const int b = latent ? (m >> 13) : ((m - TL) >> 8), t = m & (SEQ - 1);
        float q[64];
        { const u32x4* qp = (const u32x4*)(P + (size_t)m * NIN + PC_SQ + hq * 64);
#pragma unroll
          for (int c = 0; c < 8; ++c) { const u32x4 w = qp[c]; q[8 * c] = bflo(w.x); q[8 * c + 1] = bfhi(w.x); q[8 * c + 2] = bflo(w.y); q[8 * c + 3] = bfhi(w.y);
              q[8 * c + 4] = bflo(w.z); q[8 * c + 5] = bfhi(w.z); q[8 * c + 6] = bflo(w.w); q[8 * c + 7] = bfhi(w.w); } }
        float o[64];
#pragma unroll
        for (int d = 0; d < 64; ++d) o[d] = 0.f;
        const float sink = a->in[I_SINK][l * 8 + hq] * LOG2E;
        float mx = sink, den = 1.0f;
        const int lo = latent ? (t - 128 < 0 ? 0 : t - 128) : 0, hi = latent ? (t + 128 > SEQ - 1 ? SEQ - 1 : t + 128) : -1;
        const int nloc = hi - lo + 1;
        for (int kk = 0; kk < nloc + LC; ++kk) {
            const int krow = kk < nloc ? b * SEQ + lo + kk : TL + b * LC + (kk - nloc);
            const u32x4* kp = (const u32x4*)(P + (size_t)krow * NIN + PC_SK + kvh * 64);
            float s = 0.f;
#pragma unroll
            for (int c = 0; c < 8; ++c) { const u32x4 w = kp[c]; s += q[8 * c] * bflo(w.x) + q[8 * c + 1] * bfhi(w.x) + q[8 * c + 2] * bflo(w.y) + q[8 * c + 3] * bfhi(w.y)
                + q[8 * c + 4] * bflo(w.z) + q[8 * c + 5] * bfhi(w.z) + q[8 * c + 6] * bflo(w.w) + q[8 * c + 7] * bfhi(w.w); }
            const float mn = fmaxf(mx, s), f = exp2f(mx - mn), p = exp2f(s - mn);
            den = den * f + p; mx = mn;
            const u32x4* vp = (const u32x4*)(P + (size_t)krow * NIN + PC_SV + kvh * 64);
#pragma unroll
            for (int c = 0; c < 8; ++c) { const u32x4 w = vp[c];
                o[8 * c] = o[8 * c] * f + p * bflo(w.x); o[8 * c + 1] = o[8 * c + 1] * f + p * bfhi(w.x); o[8 * c + 2] = o[8 * c + 2] * f + p * bflo(w.y); o[8 * c + 3] = o[8 * c + 3] * f + p * bfhi(w.y);
                o[8 * c + 4] = o[8 * c + 4] * f + p * bflo(w.z); o[8 * c + 5] = o[8 * c + 5] * f + p * bfhi(w.z); o[8 * c + 6] = o[8 * c + 6] * f + p * bflo(w.w); o[8 * c + 7] = o[8 * c + 7] * f + p * bfhi(w.w); }
        }
        const float inv = 1.0f / den;
        u32x4* op = (u32x4*)(MIX + (size_t)m * D + 512 + hq * 64);
#pragma unroll
        for (int c = 0; c < 8; ++c) { u32x4 w; w.x = pk2(o[8 * c] * inv, o[8 * c + 1] * inv); w.y = pk2(o[8 * c + 2] * inv, o[8 * c + 3] * inv); w.z = pk2(o[8 * c + 4] * inv, o[8 * c + 5] * inv); w.w = pk2(o[8 * c + 6] * inv, o[8 * c + 7] * inv); op[c] = w; }
    }
}


typedef float f32x16 __attribute__((ext_vector_type(16)));
typedef short s16x4 __attribute__((ext_vector_type(4)));
__device__ __forceinline__ int crow(int r, int hi) { return (r & 3) + 8 * (r >> 2) + 4 * hi; }
__device__ __forceinline__ s16x4 vtr(const LAS unsigned char* p) { return __builtin_bit_cast(s16x4, __builtin_amdgcn_ds_read_tr16_b64_v4i16((LAS s16x4*)p)); }
constexpr int SWA_K = 0, SWA_V = 49152;
__device__ __forceinline__ void swa_tile(const LAS unsigned char* Kt, const LAS unsigned char* Vt, int mtype, const bf16x8 (&qf)[2][4], f32x16 (&o)[2][2], float (&mrun)[2], float (&lrun)[2], int lane) {
    const int r32 = lane & 31, hi = lane >> 5;
    const LAS unsigned char* vp = Vt + ((lane >> 4) & 1) * 32 + (lane & 3) * 8 + (4 * hi + ((lane & 15) >> 2)) * 64;
#pragma unroll
    for (int kb = 0; kb < 2; ++kb) {
        f32x16 s[2];
#pragma unroll
        for (int d0 = 0; d0 < 4; ++d0) {
            const bf16x8 kf = *(const LAS bf16x8*)(Kt + (2 * d0 + hi) * 1024 + (32 * kb + r32) * 16);
#pragma unroll
            for (int qt = 0; qt < 2; ++qt) {
                if (d0 == 0) { f32x16 z;
#pragma unroll
                    for (int r = 0; r < 16; ++r) z[r] = 0.f;
                    s[qt] = __builtin_amdgcn_mfma_f32_32x32x16_bf16(kf, qf[qt][0], z, 0, 0, 0); }
                else s[qt] = __builtin_amdgcn_mfma_f32_32x32x16_bf16(kf, qf[qt][d0], s[qt], 0, 0, 0);
            }
        }
        bf16x8 pf[2][2];
#pragma unroll
        for (int qt = 0; qt < 2; ++qt) {
            if (mtype != 0) {
                int thr = r32 + 32 * qt - 4 * hi - 32 * kb; asm volatile("" : "+v"(thr));
                if (mtype == 1) {
#pragma unroll
                    for (int r = 0; r < 16; ++r) { const int cc = (r & 3) + 8 * (r >> 2); if (cc < thr) s[qt][r] = -INFINITY; }
                } else {
#pragma unroll
                    for (int r = 0; r < 16; ++r) { const int cc = (r & 3) + 8 * (r >> 2); if (cc > thr) s[qt][r] = -INFINITY; }
                }
            }
            float rm = s[qt][0];
#pragma unroll
            for (int r = 1; r < 16; ++r) rm = fmaxf(rm, s[qt][r]);
            { auto rr = __builtin_amdgcn_permlane32_swap(__float_as_uint(rm), __float_as_uint(rm), false, false); rm = fmaxf(__uint_as_float(rr[0]), __uint_as_float(rr[1])); }
            const float mn = fmaxf(mrun[qt], rm);
            if (__any(mn > mrun[qt])) {
                const float alpha = __builtin_amdgcn_exp2f(mrun[qt] - mn);
                lrun[qt] *= alpha;
#pragma unroll
                for (int dt = 0; dt < 2; ++dt)
#pragma unroll
                    for (int r = 0; r < 16; ++r) o[dt][qt][r] *= alpha;
                mrun[qt] = mn;
            }
            float rs = 0.f;
#pragma unroll
            for (int r = 0; r < 16; ++r) { const float p = __builtin_amdgcn_exp2f(s[qt][r] - mn); s[qt][r] = p; rs += p; }
            lrun[qt] += rs;
#pragma unroll
            for (int sp = 0; sp < 2; ++sp) {
                u32x4 w; w.x = pg8::cvt_pk_bf16(s[qt][8 * sp + 0], s[qt][8 * sp + 1]); w.y = pg8::cvt_pk_bf16(s[qt][8 * sp + 2], s[qt][8 * sp + 3]);
                w.z = pg8::cvt_pk_bf16(s[qt][8 * sp + 4], s[qt][8 * sp + 5]); w.w = pg8::cvt_pk_bf16(s[qt][8 * sp + 6], s[qt][8 * sp + 7]);
                pf[qt][sp] = __builtin_bit_cast(bf16x8, w);
            }
        }
#pragma unroll
        for (int dt = 0; dt < 2; ++dt)
#pragma unroll
            for (int sp = 0; sp < 2; ++sp) {
                const int ks = 2 * kb + sp;
                const s16x4 lo = vtr(vp + dt * 4096 + ks * 1024), hi4 = vtr(vp + dt * 4096 + ks * 1024 + 512);
                const bf16x8 vf = (bf16x8){lo[0], lo[1], lo[2], lo[3], hi4[0], hi4[1], hi4[2], hi4[3]};
#pragma unroll
                for (int qt = 0; qt < 2; ++qt) o[dt][qt] = __builtin_amdgcn_mfma_f32_32x32x16_bf16(vf, pf[qt][sp], o[dt][qt], 0, 0, 0);
            }
    }
}
__device__ __forceinline__ void swa_stage(const Frame& F, const bf16* P, int grow, int kvh, int ti) {
    { const int key = 8 * F.wave + (F.lane & 7), ch = F.lane >> 3;
      const u32x4 v = *(const u32x4*)(P + (size_t)(grow + key) * NIN + PC_SK + kvh * 64 + ch * 8);
      *(LAS u32x4*)(F.lds + SWA_K + ti * 8192 + ch * 1024 + key * 16) = v; }
    { const int key = 8 * F.wave + (F.lane >> 3), ch = F.lane & 7;
      const u32x4 v = *(const u32x4*)(P + (size_t)(grow + key) * NIN + PC_SV + kvh * 64 + ch * 8);
      *(LAS u32x4*)(F.lds + SWA_V + ti * 8192 + (ch >> 2) * 4096 + key * 64 + (ch & 3) * 16) = v; }
}
__device__ __forceinline__ void swa_flash(const Frame& F, const CAS Args* a, int l) {
    const bf16* P = (const bf16*)(F.ws + WS_P); bf16* MIX = (bf16*)(F.ws + WS_MIX);
    const int nunits = 256 + (l == 0 ? 8 : 0);
    const int lane = F.lane, r32 = lane & 31, hi = lane >> 5;
    for (int u = F.vcu; u < nunits; u += F.G) {
        const bool latent = u < 256;
        const int b = latent ? (u >> 7) : ((u - 256) >> 2), kvh = latent ? ((u >> 6) & 1) : (((u - 256) >> 1) & 1), qb = latent ? (u & 63) : ((u - 256) & 1);
        const int q0 = qb * 128, g = F.wave >> 1, qs = F.wave & 1, hq = kvh * 4 + g;
        const int mrow0 = (latent ? b * SEQ : TL + b * LC) + q0 + 64 * qs;
        bf16x8 qf[2][4];
#pragma unroll
        for (int qt = 0; qt < 2; ++qt)
#pragma unroll
            for (int d0 = 0; d0 < 4; ++d0) qf[qt][d0] = *(const bf16x8*)(P + (size_t)(mrow0 + 32 * qt + r32) * NIN + PC_SQ + hq * 64 + 16 * d0 + 8 * hi);
        f32x16 o[2][2];
#pragma unroll
        for (int dt = 0; dt < 2; ++dt)
#pragma unroll
            for (int qt = 0; qt < 2; ++qt)
#pragma unroll
                for (int r = 0; r < 16; ++r) o[dt][qt][r] = 0.f;
        const float sink2 = a->in[I_SINK][l * 8 + hq] * LOG2E;
        float mrun[2] = {sink2, sink2}, lrun[2] = {hi == 0 ? 1.f : 0.f, hi == 0 ? 1.f : 0.f};
        if (latent) {
#pragma unroll 1
            for (int j = 0; j < 6; ++j) { const int ks = q0 - 128 + 64 * j; if (ks >= 0 && ks < SEQ) swa_stage(F, P, b * SEQ + ks, kvh, j); }
            __syncthreads();
#pragma unroll 1
            for (int tt = 0; tt < 5; ++tt) { const int j = qs + tt, ks = q0 - 128 + 64 * j;
                if (ks >= 0 && ks < SEQ) swa_tile(F.lds + SWA_K + j * 8192, F.lds + SWA_V + j * 8192, tt == 0 ? 1 : (tt == 4 ? 2 : 0), qf, o, mrun, lrun, lane); }
            __syncthreads();
        }
#pragma unroll 1
        for (int j = 0; j < 4; ++j) swa_stage(F, P, TL + b * LC + 64 * j, kvh, j);
        __syncthreads();
#pragma unroll 1
        for (int j = 0; j < 4; ++j) swa_tile(F.lds + SWA_K + j * 8192, F.lds + SWA_V + j * 8192, 0, qf, o, mrun, lrun, lane);
        __syncthreads();
#pragma unroll
        for (int qt = 0; qt < 2; ++qt) {
            float lt = lrun[qt];
            { auto rr = __builtin_amdgcn_permlane32_swap(__float_as_uint(lt), __float_as_uint(lt), false, false); lt = __uint_as_float(rr[0]) + __uint_as_float(rr[1]); }
            const float inv = 1.0f / lt;
            bf16* op = MIX + (size_t)(mrow0 + 32 * qt + r32) * D + 512 + hq * 64 + 4 * hi;
#pragma unroll
            for (int dt = 0; dt < 2; ++dt)
#pragma unroll
                for (int rg = 0; rg < 4; ++rg) {
                    u32x2 w; w.x = pk2(o[dt][qt][4 * rg] * inv, o[dt][qt][4 * rg + 1] * inv); w.y = pk2(o[dt][qt][4 * rg + 2] * inv, o[dt][qt][4 * rg + 3] * inv);
                    *(u32x2*)(op + 32 * dt + 8 * rg) = w;
                }
        }
    }
}


constexpr size_t WS_US = WS_GL, WS_USC = WS_GL + 32 * MiB, WS_DEC = 7 * MiB;
static_assert(WS_USC + (size_t)16 * 4 * 8192 * 2 <= WS_END && WS_DEC + (size_t)16 * 132 * 64 * 4 <= WS_WIN, "ws map (gla)");
constexpr int GL_V = 0, GL_M0 = 16384, GL_MSZ = 64 * 72 * 2, GL_RED = GL_M0 + 4 * GL_MSZ;
__device__ __forceinline__ float wave_scan_incl(float v) {
    v += DPP_F(v, 0x111, 0xF); v += DPP_F(v, 0x112, 0xF); v += DPP_F(v, 0x114, 0xF); v += DPP_F(v, 0x118, 0xF);
    v += DPP_F(v, 0x142, 0xA); v += DPP_F(v, 0x143, 0xC); return v;
}
__device__ __forceinline__ float lane63(float v) { return __builtin_bit_cast(float, __builtin_amdgcn_readlane(__builtin_bit_cast(int, v), 63)); }
__device__ __forceinline__ void unpack8(const u32x4 w, float (&f)[8]) { f[0] = bflo(w.x); f[1] = bfhi(w.x); f[2] = bflo(w.y); f[3] = bfhi(w.y); f[4] = bflo(w.z); f[5] = bfhi(w.z); f[6] = bflo(w.w); f[7] = bfhi(w.w); }
__device__ __forceinline__ void gla_stage_v(const Frame& F, const bf16* P, int m0, int h) {
#pragma unroll
    for (int i = 0; i < 2; ++i) { const int p = F.tid + 512 * i, t = p >> 4, ch = p & 15;
        const u32x4 v = *(const u32x4*)(P + (size_t)(m0 + t) * NIN + PC_V + h * 128 + ch * 8);
        *(LAS u32x4*)(F.lds + GL_V + (ch >> 2) * 4096 + t * 64 + (ch & 3) * 16) = v; }
}
__device__ __forceinline__ void gla_g1_unit(const Frame& F, const bf16* P, int m0, int h, bf16* Uf, bf16* Ub, float* decf, float* decb) {
    const int w = F.wave, t = F.lane, c = t & 31, hi = t >> 5;
    const bf16* row = P + (size_t)(m0 + t) * NIN + h * 64 + 8 * w;
    float laf[8], lab[8], kk[8];
    unpack8(*(const u32x4*)(row + PC_GF), laf); unpack8(*(const u32x4*)(row + PC_GB), lab); unpack8(*(const u32x4*)(row + PC_K), kk);
    gla_stage_v(F, P, m0, h);
    LAS bf16* KOF = (LAS bf16*)(F.lds + GL_M0); LAS bf16* KOB = (LAS bf16*)(F.lds + GL_M0 + GL_MSZ);
#pragma unroll
    for (int i = 0; i < 8; ++i) {
        const float incf = wave_scan_incl(laf[i]), tf = lane63(incf), incb = wave_scan_incl(lab[i]), tb = lane63(incb);
        KOF[(8 * w + i) * 72 + t] = (bf16)f2bf(kk[i] * __expf(tf - incf));
        KOB[(8 * w + i) * 72 + t] = (bf16)f2bf(kk[i] * __expf(incb - lab[i]));
        if (t == 0) { decf[8 * w + i] = __expf(tf); decb[8 * w + i] = __expf(tb); }
    }
    __syncthreads();
    const int dir = w >> 2, dvt = w & 3;
    const LAS unsigned char* vp = F.lds + GL_V + dvt * 4096 + ((t >> 4) & 1) * 32 + (t & 3) * 8 + ((t & 15) >> 2) * 64 + hi * 512;
    const LAS unsigned char* kb = F.lds + GL_M0 + dir * GL_MSZ + (c * 72 + 8 * hi) * 2;
    f32x16 acc[2];
#pragma unroll
    for (int j = 0; j < 2; ++j)
#pragma unroll
        for (int r = 0; r < 16; ++r) acc[j][r] = 0.f;
#pragma unroll
    for (int sp = 0; sp < 4; ++sp) {
        const s16x4 lo = vtr(vp + sp * 1024), hi4 = vtr(vp + sp * 1024 + 256);
        const bf16x8 vf = (bf16x8){lo[0], lo[1], lo[2], lo[3], hi4[0], hi4[1], hi4[2], hi4[3]};
#pragma unroll
        for (int j = 0; j < 2; ++j) { const bf16x8 kf = *(const LAS bf16x8*)(kb + j * 32 * 144 + sp * 32); acc[j] = __builtin_amdgcn_mfma_f32_32x32x16_bf16(vf, kf, acc[j], 0, 0, 0); }
    }
    bf16* U = dir ? Ub : Uf;
#pragma unroll
    for (int j = 0; j < 2; ++j)
#pragma unroll
        for (int r = 0; r < 16; ++r) U[(32 * dvt + crow(r, hi)) * 64 + 32 * j + c] = (bf16)f2bf(acc[j][r]);
    __syncthreads();
}
__device__ __forceinline__ void gla_g1(const Frame& F0, int l) {
    Frame F = F0; { int l_; asm volatile("v_mbcnt_lo_u32_b32 %0, -1, 0\n\tv_mbcnt_hi_u32_b32 %0, -1, %0" : "=v"(l_)); F.lane = l_; F.tid = F.wave * 64 + l_; }
    const bf16* P = (const bf16*)(F.ws + WS_P);
    bf16* US = (bf16*)(F.ws + WS_US); bf16* USC = (bf16*)(F.ws + WS_USC); float* DEC = (float*)(F.ws + WS_DEC);
    for (int u = F.vcu; u < 1056; u += F.G) {
        const bool latent = u < 1024; const int cc = u - 1024;
        const int b = latent ? (u >> 9) : (cc >> 4), h = latent ? ((u >> 7) & 3) : ((cc >> 2) & 3), n = latent ? (u & 127) : (cc & 3);
        const int m0 = latent ? b * SEQ + 64 * n : TL + b * LC + 64 * n;
        const int sf = (b * 4 + h) * 2;
        bf16* Uf = latent ? US + ((size_t)sf * 128 + n) * 8192 : USC + ((size_t)sf * 4 + n) * 8192;
        bf16* Ub = latent ? US + ((size_t)(sf + 1) * 128 + n) * 8192 : USC + ((size_t)(sf + 1) * 4 + n) * 8192;
        const int nd = latent ? n : 128 + n;
        gla_g1_unit(F, P, m0, h, Uf, Ub, DEC + ((size_t)sf * 132 + nd) * 64, DEC + ((size_t)(sf + 1) * 132 + nd) * 64);
    }
}
__device__ __forceinline__ void gla_scan(const Frame& F) {
    bf16* US = (bf16*)(F.ws + WS_US); bf16* USC = (bf16*)(F.ws + WS_USC); const float* DEC = (const float*)(F.ws + WS_DEC);
    for (int idx = F.vcu * 512 + F.tid; idx < 16 * 8192; idx += F.G * 512) {
        const int seq = idx >> 13, e = idx & 8191, dk = e & 63, dir = seq & 1;
        const float* dec = DEC + (size_t)seq * 132 * 64 + dk;
        float s = 0.f;
        bf16* uc = USC + (size_t)seq * 4 * 8192 + e;
#pragma unroll
        for (int i = 0; i < 4; ++i) { const int n = dir ? 3 - i : i; const float u = bf2f(uc[n * 8192]), d = dec[(128 + n) * 64]; uc[n * 8192] = (bf16)f2bf(s); s = d * s + u; }
        bf16* ul = US + (size_t)seq * 128 * 8192 + e;
#pragma unroll 1
        for (int i0 = 0; i0 < 128; i0 += 16) {
            float u[16], d[16];
#pragma unroll
            for (int j = 0; j < 16; ++j) { const int n = dir ? 127 - (i0 + j) : i0 + j; u[j] = bf2f(ul[(size_t)n * 8192]); d[j] = dec[n * 64]; }
#pragma unroll
            for (int j = 0; j < 16; ++j) { const int n = dir ? 127 - (i0 + j) : i0 + j; ul[(size_t)n * 8192] = (bf16)f2bf(s); s = d[j] * s + u[j]; }
        }
    }
}
__device__ __forceinline__ void gla_g3_unit(const Frame& F, const CAS Args* a, int l, const bf16* P, int m0, int h, const bf16* Sf, const bf16* Sb, bf16* MIX) {
    const int w = F.wave, t = F.lane, c = t & 31, hi = t >> 5;
    {
        const bf16* row = P + (size_t)(m0 + t) * NIN + h * 64 + 8 * w;
        float laf[8], lab[8], kk[8], qq[8];
        unpack8(*(const u32x4*)(row + PC_GF), laf); unpack8(*(const u32x4*)(row + PC_GB), lab); unpack8(*(const u32x4*)(row + PC_K), kk); unpack8(*(const u32x4*)(row + PC_Q), qq);
        gla_stage_v(F, P, m0, h);
        float qf[8], kf[8], qb[8], kb[8];
#pragma unroll
        for (int i = 0; i < 8; ++i) {
            const float bf = wave_scan_incl(laf[i]), incb = wave_scan_incl(lab[i]), bb = lane63(incb) - incb + lab[i];
            qf[i] = qq[i] * __expf(bf); kf[i] = kk[i] * __expf(-bf); qb[i] = qq[i] * __expf(bb); kb[i] = kk[i] * __expf(-bb);
        }
        LAS unsigned char* mb = F.lds + GL_M0 + (t * 72 + 8 * w) * 2;
        u32x4 o;
        o.x = pk2(qf[0], qf[1]); o.y = pk2(qf[2], qf[3]); o.z = pk2(qf[4], qf[5]); o.w = pk2(qf[6], qf[7]); *(LAS u32x4*)(mb) = o;
        o.x = pk2(kf[0], kf[1]); o.y = pk2(kf[2], kf[3]); o.z = pk2(kf[4], kf[5]); o.w = pk2(kf[6], kf[7]); *(LAS u32x4*)(mb + GL_MSZ) = o;
        o.x = pk2(qb[0], qb[1]); o.y = pk2(qb[2], qb[3]); o.z = pk2(qb[4], qb[5]); o.w = pk2(qb[6], qb[7]); *(LAS u32x4*)(mb + 2 * GL_MSZ) = o;
        o.x = pk2(kb[0], kb[1]); o.y = pk2(kb[2], kb[3]); o.z = pk2(kb[4], kb[5]); o.w = pk2(kb[6], kb[7]); *(LAS u32x4*)(mb + 3 * GL_MSZ) = o;
    }
    __syncthreads();
    const int dvt = w >> 1, tt = w & 1;
    bf16x8 qfB[4], qbB[4];
    { const LAS unsigned char* qp = F.lds + GL_M0 + ((32 * tt + c) * 72 + 8 * hi) * 2;
#pragma unroll
      for (int kd = 0; kd < 4; ++kd) { qfB[kd] = *(const LAS bf16x8*)(qp + kd * 32); qbB[kd] = *(const LAS bf16x8*)(qp + 2 * GL_MSZ + kd * 32); } }
    bf16x8 pfr[2][2];
#pragma unroll
    for (int st = 0; st < 2; ++st) {
        const LAS unsigned char* kp = F.lds + GL_M0 + GL_MSZ + ((32 * st + c) * 72 + 8 * hi) * 2;
        f32x16 xf, xb;
#pragma unroll
        for (int r = 0; r < 16; ++r) { xf[r] = 0.f; xb[r] = 0.f; }
        const bool needF = st <= tt, needB = st >= tt;
        if (needF) {
#pragma unroll
            for (int kd = 0; kd < 4; ++kd) xf = __builtin_amdgcn_mfma_f32_32x32x16_bf16(*(const LAS bf16x8*)(kp + kd * 32), qfB[kd], xf, 0, 0, 0);
        }
        if (needB) {
#pragma unroll
            for (int kd = 0; kd < 4; ++kd) xb = __builtin_amdgcn_mfma_f32_32x32x16_bf16(*(const LAS bf16x8*)(kp + 2 * GL_MSZ + kd * 32), qbB[kd], xb, 0, 0, 0);
        }
        if (st == tt) {
            int thr = c - 4 * hi; asm volatile("" : "+v"(thr));
#pragma unroll
            for (int r = 0; r < 16; ++r) { const int cc = (r & 3) + 8 * (r >> 2); xf[r] = (cc <= thr ? xf[r] : 0.f) + (cc >= thr ? xb[r] : 0.f); }
        } else {
#pragma unroll
            for (int r = 0; r < 16; ++r) xf[r] += xb[r];
        }
#pragma unroll
        for (int sp = 0; sp < 2; ++sp) {
            u32x4 wv; wv.x = pg8::cvt_pk_bf16(xf[8 * sp + 0], xf[8 * sp + 1]); wv.y = pg8::cvt_pk_bf16(xf[8 * sp + 2], xf[8 * sp + 3]);
            wv.z = pg8::cvt_pk_bf16(xf[8 * sp + 4], xf[8 * sp + 5]); wv.w = pg8::cvt_pk_bf16(xf[8 * sp + 6], xf[8 * sp + 7]);
            pfr[st][sp] = __builtin_bit_cast(bf16x8, wv);
        }
    }
    f32x16 o;
#pragma unroll
    for (int r = 0; r < 16; ++r) o[r] = 0.f;
    { const LAS unsigned char* vp = F.lds + GL_V + dvt * 4096 + ((t >> 4) & 1) * 32 + (t & 3) * 8 + (4 * hi + ((t & 15) >> 2)) * 64;
#pragma unroll
      for (int ks = 0; ks < 4; ++ks) {
          const s16x4 lo = vtr(vp + ks * 1024), hi4 = vtr(vp + ks * 1024 + 512);
          const bf16x8 vf = (bf16x8){lo[0], lo[1], lo[2], lo[3], hi4[0], hi4[1], hi4[2], hi4[3]};
          o = __builtin_amdgcn_mfma_f32_32x32x16_bf16(vf, pfr[ks >> 1][ks & 1], o, 0, 0, 0);
      } }
    { const bf16* sfp = Sf + (32 * dvt + c) * 64 + 8 * hi; const bf16* sbp = Sb + (32 * dvt + c) * 64 + 8 * hi;
#pragma unroll
      for (int kd = 0; kd < 4; ++kd) {
          o = __builtin_amdgcn_mfma_f32_32x32x16_bf16(*(const bf16x8*)(sfp + 16 * kd), qfB[kd], o, 0, 0, 0);
          o = __builtin_amdgcn_mfma_f32_32x32x16_bf16(*(const bf16x8*)(sbp + 16 * kd), qbB[kd], o, 0, 0, 0);
      } }
    float ssq = 0.f;
#pragma unroll
    for (int r = 0; r < 16; ++r) ssq += o[r] * o[r];
    { auto rr = __builtin_amdgcn_permlane32_swap(__float_as_uint(ssq), __float_as_uint(ssq), false, false); ssq = __uint_as_float(rr[0]) + __uint_as_float(rr[1]); }
    LAS float* red = (LAS float*)(F.lds + GL_RED);
    if (hi == 0) red[dvt * 64 + 32 * tt + c] = ssq;
    __syncthreads();
    const float tot = (red[32 * tt + c] + red[64 + 32 * tt + c]) + (red[128 + 32 * tt + c] + red[192 + 32 * tt + c]);
    const float rstd = 1.0f / sqrtf(tot * (1.0f / 128.0f) + EPS);
    const int mrow = m0 + 32 * tt + c;
#pragma unroll
    for (int rg = 0; rg < 4; ++rg) {
        const int dv = 32 * dvt + 8 * rg + 4 * hi;
        const u32x2 gw = *(const u32x2*)(P + (size_t)mrow * NIN + PC_G + h * 128 + dv);
        const f32x4 nw = *(const f32x4*)(a->in[I_GLANORM] + l * 512 + h * 128 + dv);
        const float g0 = bflo(gw.x), g1 = bfhi(gw.x), g2 = bflo(gw.y), g3 = bfhi(gw.y);
        u32x2 ov; ov.x = pk2(o[4 * rg] * rstd * nw[0] * silu_f(g0), o[4 * rg + 1] * rstd * nw[1] * silu_f(g1)); ov.y = pk2(o[4 * rg + 2] * rstd * nw[2] * silu_f(g2), o[4 * rg + 3] * rstd * nw[3] * silu_f(g3));
        *(u32x2*)(MIX + (size_t)mrow * D + h * 128 + dv) = ov;
    }
    __syncthreads();
}
__device__ __forceinline__ void gla_g3(const Frame& F, const CAS Args* a, int l) {
    const bf16* P = (const bf16*)(F.ws + WS_P); bf16* MIX = (bf16*)(F.ws + WS_MIX);
    const bf16* US = (const bf16*)(F.ws + WS_US); const bf16* USC = (const bf16*)(F.ws + WS_USC);
    const int nunits = 1024 + (l == 0 ? 32 : 0);
    for (int u = F.vcu; u < nunits; u += F.G) {
        const bool latent = u < 1024; const int cc = u - 1024;
        const int b = latent ? (u >> 9) : (cc >> 4), h = latent ? ((u >> 7) & 3) : ((cc >> 2) & 3), n = latent ? (u & 127) : (cc & 3);
        const int m0 = latent ? b * SEQ + 64 * n : TL + b * LC + 64 * n;
        const int sf = (b * 4 + h) * 2;
        const bf16* Sf = latent ? US + ((size_t)sf * 128 + n) * 8192 : USC + ((size_t)sf * 4 + n) * 8192;
        const bf16* Sb = latent ? US + ((size_t)(sf + 1) * 128 + n) * 8192 : USC + ((size_t)(sf + 1) * 4 + n) * 8192;
        gla_g3_unit(F, a, l, P, m0, h, Sf, Sb, MIX);
    }
}

__device__ __forceinline__ void gla_naive(const Frame& F, const CAS Args* a, int l) {
    const bf16* P = (const bf16*)(F.ws + WS_P);
    bf16* OF = (bf16*)(F.ws + WS_GL);
    for (int w = F.gw; w < 2048; w += F.NGW) {
        const int dv = w & 127, dir = (w >> 7) & 1, h = (w >> 8) & 3, b = w >> 10;
        const int pcg = dir ? PC_GB : PC_GF;
        float S = 0.f;
        for (int step = 0; step < LC + SEQ; ++step) {
            int m;
            if (dir == 0) m = step < LC ? TL + b * LC + step : b * SEQ + (step - LC);
            else m = step < LC ? TL + b * LC + (LC - 1 - step) : b * SEQ + (SEQ - 1 - (step - LC));
            const bf16* row = P + (size_t)m * NIN;
            const float la = bf2f(row[pcg + h * 64 + F.lane]), kk = bf2f(row[PC_K + h * 64 + F.lane]), qq = bf2f(row[PC_Q + h * 64 + F.lane]), vv = bf2f(row[PC_V + h * 128 + dv]);
            S = __expf(la) * S + kk * vv;
            const float o = wave_sum(qq * S);
            if (F.lane == 0) OF[((size_t)dir * TT + m) * 512 + h * 128 + dv] = (bf16)f2bf(o);
        }
    }
}
__device__ __forceinline__ void gla_out_naive(const Frame& F, const CAS Args* a, int l) {
    const bf16* P = (const bf16*)(F.ws + WS_P); bf16* MIX = (bf16*)(F.ws + WS_MIX);
    const bf16* OF = (const bf16*)(F.ws + WS_GL);
    const int rows = (l == 0) ? TT : TL;
    for (int m = F.gw; m < rows; m += F.NGW) {
        const int c0 = 8 * F.lane;
        const u32x4 wa = *(const u32x4*)(OF + (size_t)m * 512 + c0), wb = *(const u32x4*)(OF + ((size_t)TT + m) * 512 + c0);
        float o[8] = {bflo(wa.x) + bflo(wb.x), bfhi(wa.x) + bfhi(wb.x), bflo(wa.y) + bflo(wb.y), bfhi(wa.y) + bfhi(wb.y), bflo(wa.z) + bflo(wb.z), bfhi(wa.z) + bfhi(wb.z), bflo(wa.w) + bflo(wb.w), bfhi(wa.w) + bfhi(wb.w)};
        float ss = 0.f;
#pragma unroll
        for (int i = 0; i < 8; ++i) ss += o[i] * o[i];
        ss = row16_sum(ss);
        const float rstd = 1.0f / sqrtf(ss * (1.0f / 128.0f) + EPS);
        const u32x4 wg = *(const u32x4*)(P + (size_t)m * NIN + PC_G + c0);
        const float g[8] = {bflo(wg.x), bfhi(wg.x), bflo(wg.y), bfhi(wg.y), bflo(wg.z), bfhi(wg.z), bflo(wg.w), bfhi(wg.w)};
        const f32x4 n0 = *(const f32x4*)(a->in[I_GLANORM] + l * 512 + c0), n1 = *(const f32x4*)(a->in[I_GLANORM] + l * 512 + c0 + 4);
        float r[8];
#pragma unroll
        for (int i = 0; i < 8; ++i) r[i] = o[i] * rstd * (i < 4 ? n0[i] : n1[i - 4]) * silu_f(g[i]);
        u32x4 w; w.x = pk2(r[0], r[1]); w.y = pk2(r[2], r[3]); w.z = pk2(r[4], r[5]); w.w = pk2(r[6], r[7]);
        *(u32x4*)(MIX + (size_t)m * D + c0) = w;
    }
}

__device__ __forceinline__ void n2_route_phase(const Frame& F, const CAS Args* a, int l) {
    unsigned char* ws = F.ws;
    const float* mod = (const float*)(ws + WS_MOD);
    bf16* H = (bf16*)(ws + WS_H);
    unsigned* cnt = (unsigned*)(ws + WS_CTL) + CW_CNT + l * NE;
    unsigned* list = (unsigned*)(ws + WS_LIST); float* listw = (float*)(ws + WS_LISTW);
    LAS float* wrt = (LAS float*)F.lds;
    for (int i = F.tid; i < D * NE; i += NWAVES * 64) wrt[(i & 15) * D + (i >> 4)] = a->in[I_WROUTER][i];
    __syncthreads();
    const int rows = (l == 0) ? TT : TL;
    for (int m = F.gw; m < rows; m += F.NGW) {
        const int v = m < TL ? (m >> 13) : 2;
        const float* xrow = m < TL ? F.out + (size_t)m * D : (const float*)(ws + WS_XC) + (size_t)(m - TL) * D;
        f32x4 x[4]; float ss = 0.f;
#pragma unroll
        for (int j = 0; j < 4; ++j) { x[j] = *(const f32x4*)(xrow + 4 * F.lane + 256 * j); ss += (x[j][0] * x[j][0] + x[j][1] * x[j][1]) + (x[j][2] * x[j][2] + x[j][3] * x[j][3]); }
        const float rstd = 1.0f / sqrtf(wave_sum(ss) * (1.0f / D) + EPS);
        float lg[NE];
#pragma unroll
        for (int e = 0; e < NE; ++e) lg[e] = 0.f;
#pragma unroll
        for (int j = 0; j < 4; ++j) {
            const int col = 4 * F.lane + 256 * j;
            const f32x4 nw = *(const f32x4*)(a->in[I_NORM2] + l * D + col);
            const f32x4 sh = *(const f32x4*)(mod + (l * 3 + v) * 6144 + 3 * D + col);
            const f32x4 sc = *(const f32x4*)(mod + (l * 3 + v) * 6144 + 4 * D + col);
            const f32x4 h = x[j] * rstd * nw * (1.0f + sc) + sh;
            u32x2 o; o.x = pk2(h[0], h[1]); o.y = pk2(h[2], h[3]);
            *(u32x2*)(H + (size_t)m * D + col) = o;
#pragma unroll
            for (int e = 0; e < NE; ++e) { const f32x4 w = *(const LAS f32x4*)(wrt + e * D + col); lg[e] += (h[0] * w[0] + h[1] * w[1]) + (h[2] * w[2] + h[3] * w[3]); if ((e & 3) == 3) asm volatile("" ::: "memory"); }
        }
#pragma unroll
        for (int e = 0; e < NE; ++e) lg[e] = wave_sum(lg[e]);
        float s[NE], sb[NE];
#pragma unroll
        for (int e = 0; e < NE; ++e) { s[e] = 1.0f / (1.0f + expf(-lg[e])); sb[e] = s[e] + a->in[I_BROUTER][e]; }
        int gsel = 0; float gbest = -1e30f;
#pragma unroll
        for (int g = 0; g < 4; ++g) {
            float m1 = -1e30f, m2 = -1e30f;
#pragma unroll
            for (int i = 0; i < 4; ++i) { const float val = sb[4 * g + i]; if (val > m1) { m2 = m1; m1 = val; } else if (val > m2) m2 = val; }
            const float gs = m1 + m2; if (gs > gbest) { gbest = gs; gsel = g; }
        }
        int e0 = 0, e1 = 0; float b0 = -1e30f, b1 = -1e30f, s0 = 0.f, s1 = 0.f;
#pragma unroll
        for (int e = 0; e < NE; ++e) {
            if ((e >> 2) == gsel) { const float val = sb[e];
                if (val > b0) { b1 = b0; e1 = e0; s1 = s0; b0 = val; e0 = e; s0 = s[e]; } else if (val > b1) { b1 = val; e1 = e; s1 = s[e]; } }
        }
        if (F.lane == 0) {
            const float inv = 1.0f / (s0 + s1);
            const unsigned p0 = atomicAdd(cnt + e0, 1u); list[(size_t)e0 * LISTCAP + p0] = (unsigned)m * 2u; listw[(size_t)e0 * LISTCAP + p0] = s0 * inv;
            const unsigned p1 = atomicAdd(cnt + e1, 1u); list[(size_t)e1 * LISTCAP + p1] = (unsigned)m * 2u + 1u; listw[(size_t)e1 * LISTCAP + p1] = s1 * inv;
        }
    }
}

__device__ __forceinline__ void moe_setup(pg8::MoeOrder& S, const Frame& F, int l, int nN) {
    unsigned* cnt = (unsigned*)(F.ws + WS_CTL) + CW_CNT + l * NE;
    LAS int* tab = (LAS int*)(F.lds + MISC_OFF + 64);
    __syncthreads();
    if (F.tid == 0) { int run = 0;
        for (int e = 0; e < NE; ++e) { const int c = (int)__hip_atomic_load(cnt + e, __ATOMIC_RELAXED, __HIP_MEMORY_SCOPE_AGENT); tab[e] = c; run += (c + 255) >> 8; tab[16 + e] = run; } }
    __syncthreads();
    S.tab = tab; S.nN = nN; S.nunits = __builtin_amdgcn_readfirstlane(tab[31]) * nN; S.G = F.G; S.c = (int)blockIdx.x;
    S.list = (const unsigned*)(F.ws + WS_LIST);
}
__device__ __forceinline__ void moe1_phase(const Frame& F, const CAS Args* a, int l) {
    pg8::MoeOrder S; moe_setup(S, F, l, 4);
    S.A = (const char*)(F.ws + WS_H); S.Bt = (const char*)(F.ws + WS_WGU) + (size_t)l * NE * D * D * 2; S.K = D; S.bstride_e = (size_t)D * D * 2; S.gather = true;
    EpiGU E{(bf16*)(F.ws + WS_HMID)};
    pg8::gemm_phase<EpiGU, pg8::MoeOrder>(F.lds, F.tid, S, E);
}
__device__ __forceinline__ void moe2_phase(const Frame& F, const CAS Args* a, int l) {
    pg8::MoeOrder S; moe_setup(S, F, l, 4);
    S.A = (const char*)(F.ws + WS_HMID); S.Bt = (const char*)(F.ws + WS_WD) + (size_t)l * NE * D * DE * 2; S.K = DE; S.bstride_e = (size_t)D * DE * 2; S.gather = false;
    EpiDown E; E.Y = (bf16*)(F.ws + WS_Y); E.list = (const unsigned*)(F.ws + WS_LIST); E.listw = (const float*)(F.ws + WS_LISTW); E.tab = S.tab;
    pg8::gemm_phase<EpiDown, pg8::MoeOrder>(F.lds, F.tid, S, E);
}

__device__ __forceinline__ void final_phase(const Frame& F, const CAS Args* a) {
    const float* mod = (const float*)(F.ws + WS_MOD);
    const bf16* Y0 = (const bf16*)(F.ws + WS_Y); const bf16* Y1 = Y0 + (size_t)TT * D;
    for (int m = F.gw; m < TL; m += F.NGW) {
        const int v = m >> 13; float* xrow = F.out + (size_t)m * D;
        f32x4 x[4]; float ss = 0.f;
#pragma unroll
        for (int j = 0; j < 4; ++j) {
            const int col = 4 * F.lane + 256 * j;
            const f32x4 g2 = *(const f32x4*)(mod + (3 + v) * 6144 + 5 * D + col);
            const f32x4 y = ld_y4(Y0 + (size_t)m * D + col) + ld_y4(Y1 + (size_t)m * D + col);
            x[j] = *(const f32x4*)(xrow + col) + g2 * y;
            ss += (x[j][0] * x[j][0] + x[j][1] * x[j][1]) + (x[j][2] * x[j][2] + x[j][3] * x[j][3]);
        }
        const float rstd = 1.0f / sqrtf(wave_sum(ss) * (1.0f / D) + EPS);
#pragma unroll
        for (int j = 0; j < 4; ++j) { const int col = 4 * F.lane + 256 * j; const f32x4 nw = *(const f32x4*)(a->in[I_FNORM] + col); *(f32x4*)(xrow + col) = x[j] * rstd * nw; }
    }
}

constexpr int PH_PER_LAYER = 9;
constexpr int N_PHASES = 1 + DEPTH * PH_PER_LAYER + 1;

template <int ph>
__device__ __forceinline__ void do_phase(Frame& F, XcdBarrier& bar, LAS unsigned char* lds, int lo, int hi) {
    if (!(lo <= ph && ph < hi)) return;
    const CAS Args* ap;
        { int l_; asm volatile("v_mbcnt_lo_u32_b32 %0, -1, 0\n\tv_mbcnt_hi_u32_b32 %0, -1, %0" : "=v"(l_)); F.lane = l_; F.tid = F.wave * 64 + l_; ap = (const CAS Args*)__builtin_amdgcn_kernarg_segment_ptr(); asm volatile("" : "+s"(ap)); F.ws = ap->ws; F.out = ap->out;
          LAS unsigned char* lb_ = (LAS unsigned char*)lds; asm volatile("" : "+s"(lb_)); __builtin_assume((((unsigned)(__UINTPTR_TYPE__)lb_) & 1023u) == 0u); F.lds = lb_;
          bar.bar = (unsigned*)(F.ws + WS_CTL) + CW_BAR; bar.st = (volatile LAS unsigned*)(F.lds + MISC_OFF) + 8; }
        if (ph == 0) { if (PH_ON(10)) REP(10, true) p0_prologue(F, ap); }
        else if (ph == N_PHASES - 1) { if (PH_ON(11)) final_phase(F, ap); }
        else {
            const int l = (ph - 1) / PH_PER_LAYER, s = (ph - 1) % PH_PER_LAYER;
            unsigned char* ws = F.ws;
            if (s == 0) { if (PH_ON(0)) REP(0, l == 0) n1_phase(F, ap, l); }
            else if (s == 1 && PH_ON(1)) REP(1, true) {
                pg8::DenseOrder S; S.init(ws + WS_H, ws + WS_WIN + (size_t)l * NIN * D * 2, TT, NIN, D, F.G, (int)blockIdx.x);
                EpiIn E{(bf16*)(ws + WS_P), ap->in[I_BIASF] + l * 256, ap->in[I_BIASB] + l * 256, (const float*)(ws + WS_ROPE), (const float*)(ws + WS_ROPE) + 2048};
                pg8::gemm_phase<EpiIn, pg8::DenseOrder>(F.lds, F.tid, S, E);
            }
            else if (s == 2) { if (PH_ON(2)) REP(2, true) swa_flash(F, ap, l); if (PH_ON(12)) REP(12, true) gla_g1(F, l); }
            else if (s == 3) { if (PH_ON(13)) gla_scan(F); }
            else if (s == 4) { if (PH_ON(3)) REP(3, true) gla_g3(F, ap, l); }
            else if (s == 5 && PH_ON(4)) REP(4, l == 0) {
                pg8::DenseOrder S; S.init(ws + WS_MIX, ws + WS_WOUT + (size_t)l * D * D * 2, l == 0 ? TT : TL, D, D, F.G, (int)blockIdx.x);
                EpiOut E{l == 0 ? ap->in[I_X] : F.out, l == 0 ? ap->in[I_CTX] : (const float*)(ws + WS_XC), F.out, (float*)(ws + WS_XC), (const float*)(ws + WS_MOD) + l * 3 * 6144};
                pg8::gemm_phase<EpiOut, pg8::DenseOrder>(F.lds, F.tid, S, E);
            }
            else if (s == 6) { if (PH_ON(5)) n2_route_phase(F, ap, l); }
            else if (s == 7) { if (PH_ON(6)) REP(6, true) moe1_phase(F, ap, l); }
            else { if (PH_ON(7)) REP(7, true) moe2_phase(F, ap, l); }
        }
        if (ph + 1 < hi) xcd_barrier(bar, F.tid);
}
template <int... I>
__device__ __forceinline__ void run_all(Frame& F, XcdBarrier& bar, LAS unsigned char* lds, int lo, int hi, std::integer_sequence<int, I...>) { (do_phase<I>(F, bar, lds, lo, hi), ...); }

#ifdef VGPR_CAP
__attribute__((amdgpu_num_vgpr(VGPR_CAP)))
#endif
__global__ void __launch_bounds__(NWAVES * 64, 2) mk_fwd(Args args) {
    extern __shared__ __attribute__((aligned(16))) unsigned char lds[];
    Frame F;
    F.lds = (LAS unsigned char*)lds;
    F.tid = threadIdx.x; F.lane = F.tid & 63; F.wave = __builtin_amdgcn_readfirstlane(F.tid >> 6);
    F.G = gridDim.x; { const int bx = blockIdx.x; F.vcu = (F.G % 8 == 0) ? (bx % 8) * (F.G / 8) + bx / 8 : bx; }
    F.gw = F.vcu * NWAVES + F.wave; F.NGW = F.G * NWAVES;
    const CAS Args* ap = (const CAS Args*)__builtin_amdgcn_kernarg_segment_ptr();
    F.ws = ap->ws; F.out = ap->out;
    volatile LAS unsigned* MISC = (volatile LAS unsigned*)(F.lds + MISC_OFF);
    for (int u = F.tid; u < (LDS_BYTES - LDSCTL_OFF) / 4; u += NWAVES * 64) ((LAS unsigned*)(F.lds + LDSCTL_OFF))[u] = 0u;
    __syncthreads();
    XcdBarrier bar; bar.bar = (unsigned*)(F.ws + WS_CTL) + CW_BAR; bar.x = 0; bar.st = nullptr;
    const bool fused = (ap->ph_hi - ap->ph_lo) > 1;
    if (fused) bar = xcd_barrier_post((unsigned*)(F.ws + WS_CTL) + CW_BAR, MISC + 8);
    const int lo = ap->ph_lo, hi = ap->ph_hi;
    run_all(F, bar, (LAS unsigned char*)lds, lo, hi, std::make_integer_sequence<int, N_PHASES>{});
}

extern "C" void kernel_launch(void* const* d_in, const int* in_sizes, int n_in, void* d_out, int out_size, void* d_ws, size_t ws_size, hipStream_t stream) {
    static int grid = 0;
    if (grid == 0) {
        if (n_in != 22 || out_size != TL * D || ws_size < WS_END) { fprintf(stderr, "kernel_launch: unexpected shapes (n_in %d out %d ws %zu)\n", n_in, out_size, ws_size); grid = -1; return; }
        int dev = 0, cus = 0, per_cu = 0;
        if (hipGetDevice(&dev) != hipSuccess || hipDeviceGetAttribute(&cus, hipDeviceAttributeMultiprocessorCount, dev) != hipSuccess) { grid = -1; return; }
        if (hipFuncSetAttribute((const void*)mk_fwd, hipFuncAttributeMaxDynamicSharedMemorySize, LDS_BYTES) != hipSuccess) { fprintf(stderr, "kernel_launch: hipFuncSetAttribute failed\n"); grid = -1; return; }
        if (hipOccupancyMaxActiveBlocksPerMultiprocessor(&per_cu, (const void*)mk_fwd, NWAVES * 64, LDS_BYTES) != hipSuccess || per_cu < 1) fprintf(stderr, "kernel_launch: occupancy query says %d\n", per_cu);
        (void)hipGetLastError();
        grid = cus;
    }
    if (grid < 0) return;
    (void)hipMemsetAsync((char*)d_ws + WS_CTL, 0, CTL_ZERO_BYTES, stream);
    Args a{};
    for (int i = 0; i < 22; ++i) a.in[i] = (const float*)d_in[i];
    a.out = (float*)d_out; a.ws = (unsigned char*)d_ws; a.li = 0; a.pad = 0;
#if MK_N_LAUNCHES == 1
    a.ph_lo = 0; a.ph_hi = N_PHASES;
    hipLaunchKernelGGL(mk_fwd, dim3(grid), dim3(NWAVES * 64), LDS_BYTES, stream, a);
#else
    for (int ph = 0; ph < N_PHASES; ++ph) { a.ph_lo = ph; a.ph_hi = ph + 1; hipLaunchKernelGGL(mk_fwd, dim3(grid), dim3(NWAVES * 64), LDS_BYTES, stream, a); }
#endif
}
```

```cpp
#include <hip/hip_runtime.h>
#include <cstdio>
#include <cstdint>
#include <utility>

#ifndef ONLY_S
#define ONLY_S -1
#endif
#define PH_ON(k) (ONLY_S < 0 || ONLY_S == (k))
#ifndef REPEAT_S
#define REPEAT_S -1
#endif
#ifndef REPEAT_N
#define REPEAT_N 4
#endif
#define REP(k, cond) for (int rep_ = 0; rep_ < ((pass == 1) ? PROBE_R : ((REPEAT_S == (k) && (cond)) ? REPEAT_N : 1)); ++rep_)
#ifndef MK_N_LAUNCHES
#define MK_N_LAUNCHES 1
#endif

#define GAS __attribute__((address_space(1)))
#define LAS __attribute__((address_space(3)))
#define CAS __attribute__((address_space(4)))
typedef unsigned short bf16;
typedef short bf16x8 __attribute__((ext_vector_type(8)));
typedef float f32x4 __attribute__((ext_vector_type(4)));
typedef float f32x2 __attribute__((ext_vector_type(2)));
typedef unsigned u32x4 __attribute__((ext_vector_type(4)));
typedef unsigned u32x2 __attribute__((ext_vector_type(2)));

constexpr int D = 1024, SEQ = 8192, LC = 256, TL = 16384, TC = 512, TT = TL + TC, DEPTH = 2;
constexpr int NE = 16, DE = 512;
constexpr int NIN = 2816;
constexpr int PC_Q = 0, PC_K = 256, PC_V = 512, PC_G = 1024, PC_SQ = 1536, PC_SK = 2048, PC_SV = 2176, PC_GF = 2304, PC_GB = 2560;
constexpr int WIN_COLS = 2336;
constexpr float EPS = 1e-6f;
constexpr float LOG2E = 1.4426950408889634f, QSCALE = 0.125f * LOG2E;
constexpr int LISTCAP = TT;

constexpr size_t MiB = 1u << 20;
constexpr size_t WS_CTL = 0, CTL_ZERO_BYTES = 65536;
constexpr size_t WS_MOD = 1 * MiB;
constexpr size_t WS_ROPE = 1 * MiB + 256 * 1024;
constexpr size_t WS_LIST = 2 * MiB;
constexpr size_t WS_LISTW = 2 * MiB + 1536 * 1024;
constexpr size_t WS_XC = 5 * MiB;
constexpr size_t WS_WIN = 8 * MiB;
constexpr size_t WS_WOUT = 19 * MiB;
constexpr size_t WS_WGU = 23 * MiB;
constexpr size_t WS_WD = 87 * MiB;
constexpr size_t WS_H = 119 * MiB;
constexpr size_t WS_P = 152 * MiB;
constexpr size_t WS_MIX = 243 * MiB;
constexpr size_t WS_GL = 276 * MiB;
constexpr size_t WS_HMID = 152 * MiB;
constexpr size_t WS_Y = 190 * MiB;
constexpr size_t WS_END = 309 * MiB;
static_assert(WS_LIST + (size_t)NE * LISTCAP * 4 <= WS_LISTW && WS_LISTW + (size_t)NE * LISTCAP * 4 <= WS_XC, "ws map");
static_assert(WS_P + (size_t)TT * NIN * 2 <= WS_MIX && WS_MIX + (size_t)TT * D * 2 <= WS_GL, "ws map");
static_assert(WS_HMID + (size_t)37888 * 512 * 2 <= WS_Y && WS_Y + (size_t)2 * TT * D * 2 <= WS_GL, "ws map");
constexpr int CW_CNT = 8192, CNT_STRIDE = 64;
constexpr int CW_BAR = 4096;

__device__ __forceinline__ unsigned f2bf(float f) { unsigned u = __builtin_bit_cast(unsigned, f); return (u + 0x7fffu + ((u >> 16) & 1u)) >> 16; }
__device__ __forceinline__ unsigned pk2(float lo, float hi) { return f2bf(lo) | (f2bf(hi) << 16); }
__device__ __forceinline__ float bf2f(unsigned h) { return __builtin_bit_cast(float, h << 16); }
__device__ __forceinline__ float bflo(unsigned w) { return __builtin_bit_cast(float, w << 16); }
__device__ __forceinline__ float bfhi(unsigned w) { return __builtin_bit_cast(float, w & 0xffff0000u); }
__device__ __forceinline__ float dpp_add(float v, float t) { return v + t; }
#define DPP_F(v, ctrl, rmask) __builtin_bit_cast(float, __builtin_amdgcn_update_dpp(0, __builtin_bit_cast(int, (v)), (ctrl), (rmask), 0xF, false))
__device__ __forceinline__ float row16_sum(float v) {
    v += DPP_F(v, 0xB1, 0xF); v += DPP_F(v, 0x4E, 0xF); v += DPP_F(v, 0x141, 0xF); v += DPP_F(v, 0x140, 0xF); return v;
}
__device__ __forceinline__ float wave_sum(float v) {
    v = row16_sum(v);
    v += DPP_F(v, 0x142, 0xA); v += DPP_F(v, 0x143, 0xC);
    return __builtin_bit_cast(float, __builtin_amdgcn_readlane(__builtin_bit_cast(int, v), 63));
}
__device__ __forceinline__ float silu_f(float x) { return x / (1.0f + __expf(-x)); }
#define LDS_WAIT() asm volatile("s_waitcnt lgkmcnt(0)" ::: "memory")
#define VM_WAIT() asm volatile("s_waitcnt vmcnt(0)" ::: "memory")

namespace pg8 {
constexpr int BM = 256, BK = 64, HALF = 128, HTB = HALF * BK * 2, STAGE_BYTES = 8 * HTB, NXCD = 8, WGM = 8;
__host__ __device__ __forceinline__ int lds_byte(int r, int c) { const int st = (r >> 4) * 2 + (c >> 5), rr = r & 15, cc = c & 31, ob = rr * 64 + cc * 2; return st * 1024 + (ob ^ (((ob >> 9) & 1) << 5)); }
__host__ __device__ __forceinline__ void stage_rc(int b, int& R, int& C) { const int st = b / 1024, sb = b % 1024, swz = sb ^ (((sb >> 9) & 1) << 5); R = (st >> 1) * 16 + swz / 64; C = (st & 1) * 32 + (swz % 64) / 2; }
__host__ __device__ __forceinline__ int perm32(int rho) { const int n = rho >> 4, i = rho & 15; return 8 * (i >> 2) + 4 * n + (i & 3); }

struct Unit { int pm, pn, e, mt; };

__device__ __forceinline__ int xcd_remap(int wgid, int nwg) { const int q = nwg / NXCD, r = nwg % NXCD, xcd = wgid % NXCD, off = wgid / NXCD; return (xcd < r ? xcd * (q + 1) : r * (q + 1) + (xcd - r) * q) + off; }

struct DenseOrder {
    static constexpr bool DYN_A = false;
    const char* A; const char* Bt; int K; int nM, nN, nwg, G, c;
    __device__ void init(const void* A_, const void* Bt_, int M, int N, int K_, int G_, int c_) { A = (const char*)A_; Bt = (const char*)Bt_; K = K_; nM = M / BM; nN = N / BM; nwg = nM * nN; G = G_; c = c_; }
    __device__ __forceinline__ bool next(int i, Unit& u) const {
        const long L = (long)i * G + c; if (L >= nwg) return false;
        const int wgid = xcd_remap((int)L, nwg);
        const int nig = WGM * nN, gid = wgid / nig, fm = gid * WGM, gsz = (nM - fm) < WGM ? (nM - fm) : WGM;
        u.pm = fm + ((wgid % nig) % gsz); u.pn = (wgid % nig) / gsz; u.e = 0; u.mt = 0; return true;
    }
    __device__ __forceinline__ const char* a_ptr(const Unit& u) const { return A + (size_t)u.pm * (size_t)(BM * K * 2); }
    __device__ __forceinline__ const char* b_ptr(const Unit& u) const { return Bt + (size_t)u.pn * (size_t)(BM * K * 2); }
    __device__ __forceinline__ void a_voff(const Unit&, const int (&R)[2], const int (&C)[2], unsigned (&v0)[2], unsigned (&v1)[2]) const {
#pragma unroll
        for (int i = 0; i < 2; ++i) { v0[i] = (unsigned)(R[i] * K + C[i]) * 2u; v1[i] = v0[i] + (unsigned)(HALF * K * 2); }
    }
};

struct MoeOrder {
    static constexpr bool DYN_A = true;
    const char* A; const char* Bt; int K; size_t bstride_e; int G, c, nunits, nN; bool gather;
    const unsigned* list; const LAS int* tab;
    __device__ __forceinline__ bool next(int i, Unit& u) const {
        const long L = (long)i * G + c; if (L >= nunits) return false;
        const int wgid = xcd_remap((int)L, nunits);
        const int tl = wgid / nN; u.pn = wgid % nN;
        int e = 0, tstart = 0;
#pragma unroll 1
        for (int k = 0; k < NE - 1; ++k) { const int te = tab[16 + k]; if (tl >= te) { e = k + 1; tstart = te; } }
        u.e = __builtin_amdgcn_readfirstlane(e); u.mt = __builtin_amdgcn_readfirstlane(tl - tstart); u.pm = tl; return true;
    }
    __device__ __forceinline__ const char* a_ptr(const Unit& u) const { return gather ? A : A + (size_t)u.pm * (size_t)(BM * K * 2); }
    __device__ __forceinline__ const char* b_ptr(const Unit& u) const { return Bt + (size_t)u.e * bstride_e + (size_t)u.pn * (size_t)(BM * K * 2); }
    __device__ __forceinline__ void a_voff(const Unit& u, const int (&R)[2], const int (&C)[2], unsigned (&v0)[2], unsigned (&v1)[2]) const {
        if (gather) {
            const int ce = tab[u.e];
            const unsigned* lp = list + (size_t)u.e * LISTCAP + u.mt * BM;
#pragma unroll
            for (int i = 0; i < 2; ++i) {
                const int r0 = R[i], r1 = R[i] + HALF;
                const unsigned t0 = (u.mt * BM + r0 < ce) ? (__builtin_nontemporal_load(lp + r0) >> 1) : 0u;
                const unsigned t1 = (u.mt * BM + r1 < ce) ? (__builtin_nontemporal_load(lp + r1) >> 1) : 0u;
                v0[i] = (t0 * (unsigned)K + (unsigned)C[i]) * 2u; v1[i] = (t1 * (unsigned)K + (unsigned)C[i]) * 2u;
            }
        } else {
#pragma unroll
            for (int i = 0; i < 2; ++i) { v0[i] = (unsigned)(R[i] * K + C[i]) * 2u; v1[i] = v0[i] + (unsigned)(HALF * K * 2); }
        }
    }
};

__device__ __forceinline__ unsigned cvt_pk_bf16(float lo, float hi) { unsigned r; asm volatile("v_cvt_pk_bf16_f32 %0, %1, %2" : "=v"(r) : "v"(lo), "v"(hi)); return r; }

template <class Epi, class Sched>
__device__ __forceinline__ void gemm_phase(LAS unsigned char* lds, int tid, const Sched& S, const Epi& E) {
    const int wid = __builtin_amdgcn_readfirstlane(tid >> 6), lane = tid & 63, wr = wid >> 2, wc = wid & 3, fr = lane & 15, fq = lane >> 4;
    const int K = S.K, nt = K / BK;
    int Rr[2], Cc[2]; unsigned voffB[2];
#pragma unroll
    for (int i = 0; i < 2; ++i) { int R, C; stage_rc(tid * 16 + i * 8192, R, C); const int Rb = Epi::PERM ? ((R & ~31) + perm32(R & 31)) : R;
        Rr[i] = R; Cc[i] = C; voffB[i] = (unsigned)(Rb * K + C) * 2u; }
    const size_t kstep = (size_t)(BK * 2);
    const size_t hstep = (size_t)HALF * K * 2;
    const unsigned ldsw = (unsigned)wid * 1024u;
    const int aoff = lds_byte(wr * 64 + fr, fq * 8), boff = lds_byte(wc * 32 + fr, fq * 8);
#define PG8_SA(b, h) (((b) * 2 + (h)) * HTB)
#define PG8_SB(b, h) ((4 + (b) * 2 + (h)) * HTB)
#define PG8_STAGE(bufoff, gbase, voff) do { _Pragma("unroll") for (int _i = 0; _i < 2; ++_i) \
        __builtin_amdgcn_global_load_lds((const unsigned*)((const char*)(gbase) + (voff)[_i]), (LAS unsigned*)(lds + (bufoff) + ldsw + _i * 8192), 16, 0, 0); } while (0)
#define PG8_LDA(dst, b, h) do { _Pragma("unroll") for (int m = 0; m < 4; ++m) _Pragma("unroll") for (int k = 0; k < 2; ++k) dst[m][k] = *(const LAS bf16x8*)(lds + PG8_SA(b, h) + aoff + m * 2048 + k * 1024); } while (0)
#define PG8_LDB(dst, b, h) do { _Pragma("unroll") for (int n = 0; n < 2; ++n) _Pragma("unroll") for (int k = 0; k < 2; ++k) dst[n][k] = *(const LAS bf16x8*)(lds + PG8_SB(b, h) + boff + n * 2048 + k * 1024); } while (0)
#define PG8_MMA(ai, bj, At, Bt) do { __builtin_amdgcn_s_setprio(1); _Pragma("unroll") for (int m = 0; m < 4; ++m) _Pragma("unroll") for (int n = 0; n < 2; ++n) _Pragma("unroll") for (int k = 0; k < 2; ++k) \
        acc[ai][bj][m][n] = __builtin_amdgcn_mfma_f32_16x16x32_bf16(Bt[n][k], At[m][k], acc[ai][bj][m][n], 0, 0, 0); __builtin_amdgcn_s_setprio(0); } while (0)
#define PG8_WAIT_V(n) asm volatile("s_waitcnt vmcnt(" #n ")" ::: "memory")
#define PG8_WAIT_L(n) asm volatile("s_waitcnt lgkmcnt(" #n ")" ::: "memory")
#define PG8_BAR __builtin_amdgcn_s_barrier()
#define PG8_SCHED __builtin_amdgcn_sched_barrier(0)
    Unit cur, nxt; int ui = 0;
    if (!S.next(0, cur)) return;
    f32x4 acc[2][2][4][2];
#pragma unroll
    for (int a = 0; a < 2; ++a)
#pragma unroll
        for (int b = 0; b < 2; ++b)
#pragma unroll
            for (int m = 0; m < 4; ++m)
#pragma unroll
                for (int n = 0; n < 2; ++n) acc[a][b][m][n] = (f32x4){0.f, 0.f, 0.f, 0.f};
    bf16x8 At[4][2], B0[2][2], B1[2][2];
    const char* cA = S.a_ptr(cur); const char* cB = S.b_ptr(cur);
    unsigned cv0[2], cv1[2], nv0[2], nv1[2];
    S.a_voff(cur, Rr, Cc, cv0, cv1);
    PG8_STAGE(PG8_SB(0, 0), cB, voffB); PG8_STAGE(PG8_SB(0, 1), cB + hstep, voffB); PG8_STAGE(PG8_SA(0, 0), cA, cv0); PG8_STAGE(PG8_SA(0, 1), cA, cv1);
    if (wr == 1) PG8_BAR;
    PG8_WAIT_V(2); PG8_BAR;
    PG8_STAGE(PG8_SB(1, 0), cB + kstep, voffB); PG8_STAGE(PG8_SA(1, 0), cA + kstep, cv0); PG8_STAGE(PG8_SB(1, 1), cB + hstep + kstep, voffB);
    PG8_WAIT_V(6); PG8_BAR;
    for (;;) {
        const bool has_next = S.next(ui + 1, nxt);
        const char* nA = has_next ? S.a_ptr(nxt) : cA; const char* nB = has_next ? S.b_ptr(nxt) : cB;
        if (has_next) S.a_voff(nxt, Rr, Cc, nv0, nv1); else { nv0[0] = cv0[0]; nv0[1] = cv0[1]; nv1[0] = cv1[0]; nv1[1] = cv1[1]; }
        if constexpr (Sched::DYN_A) asm volatile("" : "+v"(nv0[0]), "+v"(nv0[1]), "+v"(nv1[0]), "+v"(nv1[1]));
        for (int t = 0; t < nt; t += 2) {
            const bool last = (t == nt - 2);
            const char* a1 = cA + (size_t)(t + 1) * kstep;
            const char* a2 = last ? nA : cA + (size_t)(t + 2) * kstep; const char* b2 = last ? nB : cB + (size_t)(t + 2) * kstep;
            const char* a3 = a2 + kstep; const char* b3 = b2 + kstep;
            unsigned w0[2], w1[2];
            w0[0] = last ? nv0[0] : cv0[0]; w0[1] = last ? nv0[1] : cv0[1]; w1[0] = last ? nv1[0] : cv1[0]; w1[1] = last ? nv1[1] : cv1[1];
            PG8_LDB(B0, 0, 0); PG8_LDB(B1, 0, 1); PG8_SCHED; PG8_LDA(At, 0, 0); PG8_STAGE(PG8_SA(1, 1), a1, cv1);
            PG8_WAIT_V(8); PG8_WAIT_L(0); PG8_BAR; PG8_MMA(0, 0, At, B0); PG8_MMA(0, 1, At, B1); PG8_BAR; PG8_SCHED;
            PG8_LDA(At, 0, 1); PG8_STAGE(PG8_SB(0, 0), b2, voffB); PG8_STAGE(PG8_SB(0, 1), b2 + hstep, voffB); PG8_STAGE(PG8_SA(0, 0), a2, w0);
            PG8_WAIT_V(8); PG8_WAIT_L(0); PG8_BAR; PG8_MMA(1, 0, At, B0); PG8_MMA(1, 1, At, B1); PG8_BAR; PG8_SCHED;
            PG8_LDB(B0, 1, 0); PG8_LDB(B1, 1, 1); PG8_SCHED; PG8_LDA(At, 1, 0); PG8_STAGE(PG8_SA(0, 1), a2, w1);
            PG8_WAIT_V(8); PG8_WAIT_L(0); PG8_BAR; PG8_MMA(0, 0, At, B0); PG8_MMA(0, 1, At, B1); PG8_BAR; PG8_SCHED;
            PG8_LDA(At, 1, 1); PG8_STAGE(PG8_SB(1, 0), b3, voffB); PG8_STAGE(PG8_SB(1, 1), b3 + hstep, voffB); PG8_STAGE(PG8_SA(1, 0), a3, w0);
            PG8_WAIT_V(8); PG8_WAIT_L(0); PG8_BAR; PG8_MMA(1, 0, At, B0); PG8_MMA(1, 1, At, B1); PG8_BAR; PG8_SCHED;
        }
        if (wr == 0) PG8_BAR;
        E(acc, cur, wr, wc, fr, fq);
        if (!has_next) break;
#pragma unroll
        for (int a = 0; a < 2; ++a)
#pragma unroll
            for (int b = 0; b < 2; ++b)
#pragma unroll
                for (int m = 0; m < 4; ++m)
#pragma unroll
                    for (int n = 0; n < 2; ++n) acc[a][b][m][n] = (f32x4){0.f, 0.f, 0.f, 0.f};
        cur = nxt; cA = nA; cB = nB; ++ui;
        cv0[0] = nv0[0]; cv0[1] = nv0[1]; cv1[0] = nv1[0]; cv1[1] = nv1[1];
        if (wr == 1) PG8_BAR;
    }
    PG8_WAIT_V(0);
    PG8_BAR;
#undef PG8_SA
#undef PG8_SB
#undef PG8_STAGE
#undef PG8_LDA
#undef PG8_LDB
#undef PG8_MMA
#undef PG8_WAIT_V
#undef PG8_WAIT_L
#undef PG8_BAR
#undef PG8_SCHED
}
}

#define XB_TMO      128
#define XB_XCNT(j)  (256  + 64 * (j))
#define XB_XSUB(j)  (1280 + 64 * (j))
#define XB_XGEN(j)  (2304 + 64 * (j))
#define XB_TOP      3328
#define XB_TOPGEN   3392
#define XCD_BAR_WORDS 3456
#define XB_SPIN_CAP (1u << 18)
__device__ __forceinline__ unsigned xb_ld(unsigned* p)              { return __hip_atomic_load(p, __ATOMIC_RELAXED, __HIP_MEMORY_SCOPE_AGENT); }
__device__ __forceinline__ unsigned xb_add(unsigned* p, unsigned v) { return __hip_atomic_fetch_add(p, v, __ATOMIC_RELAXED, __HIP_MEMORY_SCOPE_AGENT); }
__device__ __forceinline__ unsigned xb_xcc_id() { return (unsigned)__builtin_amdgcn_s_getreg((3 << 11) | 20) & 0xFu; }
#define XB_SPIN(cond, bar) do { unsigned _sp = 0; while (cond) { __builtin_amdgcn_s_sleep(1); \
    if ((++_sp & 255u) == 0u) { if (xb_ld(&(bar)[XB_TMO])) break; if (_sp > XB_SPIN_CAP) { atomicAdd(&(bar)[XB_TMO], 1u); break; } } } } while (0)
struct XcdBarrier { unsigned* bar; unsigned x; volatile LAS unsigned* st; };
__device__ __forceinline__ XcdBarrier xcd_barrier_post(unsigned* bar, volatile LAS unsigned* st) {
    XcdBarrier b; b.bar = bar; b.x = xb_xcc_id(); b.st = st;
    if (threadIdx.x == 0) (void)xb_add(&bar[XB_XCNT(b.x)], 1u);
    return b;
}
__device__ __forceinline__ void xcd_barrier_complete(unsigned* bar, unsigned x, unsigned& nloc, unsigned& nx) {
    const unsigned G = gridDim.x * gridDim.y * gridDim.z;
    unsigned sum, cnt, mine, sp = 0u;
    for (;;) {
        sum = 0u; cnt = 0u; mine = 0u;
#pragma unroll
        for (unsigned j = 0; j < 16; ++j) { const unsigned c = xb_ld(&bar[XB_XCNT(j)]); sum += c; cnt += (c > 0u) ? 1u : 0u; mine = (j == x) ? c : mine; }
        if (sum == G) break;
        __builtin_amdgcn_s_sleep(1);
        if ((++sp & 255u) == 0u) { if (xb_ld(&bar[XB_TMO])) break; if (sp > XB_SPIN_CAP) { atomicAdd(&bar[XB_TMO], 1u); break; } }
    }
    nloc = mine > 0u ? mine : 1u; nx = cnt > 0u ? cnt : 1u;
}
__device__ __forceinline__ void xcd_barrier(const XcdBarrier& b, int tid) {
    asm volatile("s_waitcnt vmcnt(0)" ::: "memory");
    __syncthreads();
    if (tid == 0) {
        unsigned* bar = b.bar;
        __builtin_amdgcn_s_waitcnt(0);
        unsigned nloc = b.st[0], nx = b.st[1];
        if (nloc == 0u) { xcd_barrier_complete(bar, b.x, nloc, nx); b.st[0] = nloc; b.st[1] = nx; }
        const unsigned old = xb_add(&bar[XB_XSUB(b.x)], 1u);
        const unsigned gen = old / nloc;
        if (old + 1u == (gen + 1u) * nloc) {
            __builtin_amdgcn_fence(__ATOMIC_RELEASE, "agent");
            asm volatile("s_waitcnt vmcnt(0)" ::: "memory");
            const unsigned og = xb_add(&bar[XB_TOP], 1u);
            const unsigned tg = og / nx;
            if (og + 1u == (tg + 1u) * nx) xb_add(&bar[XB_TOPGEN], 1u);
            else XB_SPIN(xb_ld(&bar[XB_TOPGEN]) == tg, bar);
            __builtin_amdgcn_fence(__ATOMIC_ACQUIRE, "agent");
            xb_add(&bar[XB_XGEN(b.x)], 1u);
            asm volatile("s_waitcnt vmcnt(0)" ::: "memory");
        } else {
            XB_SPIN(xb_ld(&bar[XB_XGEN(b.x)]) == gen, bar);
            __builtin_amdgcn_fence(__ATOMIC_ACQUIRE, "agent");
            asm volatile("s_waitcnt vmcnt(0)" ::: "memory");
        }
    }
    __syncthreads();
}

constexpr int NWAVES = 8;
constexpr int RING_BYTES = 131072, LDSCTL_OFF = RING_BYTES, MISC_OFF = LDSCTL_OFF + 320, LDS_BYTES = 147456;
struct Args { const float* in[22]; float* out; unsigned char* ws; int ph_lo, ph_hi, li, pad; };
enum { I_X = 0, I_C, I_CTX, I_CCTX, I_WADA, I_BADA, I_NORM1, I_NORM2, I_WIN, I_UPF, I_BIASF, I_UPB, I_BIASB, I_GLANORM, I_SINK, I_WOUT, I_WROUTER, I_BROUTER, I_WGATE, I_WUP, I_WDOWN, I_FNORM };

struct Frame {
    LAS unsigned char* lds; int tid, lane, wave, vcu, G, gw, NGW;
    unsigned char* ws; float* out;
};

__device__ __forceinline__ int rope_pos(int d) { return 8 * ((d & 15) >> 2) + 4 * (d >> 4) + (d & 3); }
__device__ __forceinline__ int gu_row(int h, int gu) { return (h >> 7) * 256 + ((h >> 6) & 1) * 128 + ((h >> 4) & 3) * 32 + ((h >> 2) & 3) * 8 + gu * 4 + (h & 3); }
__device__ __forceinline__ void transpose_item(const float* W, int N, bf16* WT, int Kd, int k0, int n0, int rbase, int mode, LAS float* scr, int lane) {
#pragma unroll 8
    for (int i = 0; i < 32; ++i) { const int kk = 2 * i + (lane >> 5); scr[kk * 33 + (lane & 31)] = W[(size_t)(k0 + kk) * N + n0 + (lane & 31)]; }
    LDS_WAIT(); asm volatile("" ::: "memory");
    const int c = lane & 7;
#pragma unroll
    for (int j = 0; j < 4; ++j) { const int n = (lane >> 3) + 8 * j; const LAS float* s = scr + (8 * c) * 33 + n;
        u32x4 o; o.x = pk2(s[0 * 33], s[1 * 33]); o.y = pk2(s[2 * 33], s[3 * 33]); o.z = pk2(s[4 * 33], s[5 * 33]); o.w = pk2(s[6 * 33], s[7 * 33]);
        const int row = (mode == 0) ? rbase + n : (mode == 1) ? rbase + rope_pos(n) : gu_row(n0 + n, mode - 2);
        *(u32x4*)(WT + (size_t)row * Kd + k0 + 8 * c) = o; }
    LDS_WAIT(); asm volatile("" ::: "memory");
}

__device__ __forceinline__ void p0_prologue(const Frame& F, const CAS Args* a) {
    unsigned char* ws = F.ws;
    LAS float* scr = (LAS float*)(F.lds + F.wave * 16384);
    constexpr int IT_IN = 2 * 16 * 73, IT_OUT = 2 * 16 * 32, IT_G = 32 * 16 * 16, IT_D = 32 * 8 * 32;
    constexpr int NITEMS = IT_IN + IT_OUT + 2 * IT_G + IT_D;
    for (int it = F.gw; it < NITEMS; it += F.NGW) {
        int r = it;
        if (r < IT_IN) {
            const int l = r / 1168, rr = r % 1168, kb = rr / 73, nb = rr % 73;
            if (nb == 48) continue;
            const int n0 = nb * 32; int rbase, mode = 0;
            if (n0 < 1536) rbase = n0;
            else if (n0 < 2080) { rbase = PC_SQ + (n0 - 1568); mode = 1; }
            else if (n0 < 2208) { rbase = PC_SK + (n0 - 2080); mode = 1; }
            else rbase = PC_SV + (n0 - 2208);
            transpose_item(a->in[I_WIN] + (size_t)l * D * WIN_COLS, WIN_COLS, (bf16*)(ws + WS_WIN) + (size_t)l * NIN * D, D, kb * 64, n0, rbase, mode, scr, F.lane);
            continue;
        }
        r -= IT_IN;
        if (r < IT_OUT) { const int l = r / 512, rr = r % 512, kb = rr / 32, nb = rr % 32;
            transpose_item(a->in[I_WOUT] + (size_t)l * D * D, D, (bf16*)(ws + WS_WOUT) + (size_t)l * D * D, D, kb * 64, nb * 32, nb * 32, 0, scr, F.lane); continue; }
        r -= IT_OUT;
        if (r < 2 * IT_G) { const int gu = r / IT_G, r2 = r % IT_G, le = r2 / 256, rr = r2 % 256, kb = rr / 16, nb = rr % 16;
            transpose_item(a->in[gu ? I_WUP : I_WGATE] + (size_t)le * D * DE, DE, (bf16*)(ws + WS_WGU) + (size_t)le * D * D, D, kb * 64, nb * 32, 0, 2 + gu, scr, F.lane); continue; }
        r -= 2 * IT_G;
        { const int le = r / 256, rr = r % 256, kb = rr / 32, nb = rr % 32;
            transpose_item(a->in[I_WDOWN] + (size_t)le * DE * D, D, (bf16*)(ws + WS_WD) + (size_t)le * D * DE, DE, kb * 64, nb * 32, nb * 32, 0, scr, F.lane); }
    }
    for (int idx = F.gw * 64 + F.lane; idx < 2 * 2 * 256 * 128; idx += F.NGW * 64) {
        const int kc = idx & 127, n = (idx >> 7) & 255, dir = (idx >> 15) & 1, l = idx >> 16;
        const float* up = a->in[dir ? I_UPB : I_UPF] + (size_t)l * 16 * 256 + n;
        float u[16];
#pragma unroll
        for (int r = 0; r < 16; ++r) u[r] = up[r * 256];
        float o[8];
#pragma unroll
        for (int kk = 0; kk < 8; ++kk) {
            const f32x4* wz = (const f32x4*)(a->in[I_WIN] + ((size_t)l * D + kc * 8 + kk) * WIN_COLS + 1536 + dir * 16);
            float s = 0.f;
#pragma unroll
            for (int q = 0; q < 4; ++q) { const f32x4 w = wz[q]; s += w[0] * u[4 * q] + w[1] * u[4 * q + 1] + w[2] * u[4 * q + 2] + w[3] * u[4 * q + 3]; }
            o[kk] = s;
        }
        u32x4 ov; ov.x = pk2(o[0], o[1]); ov.y = pk2(o[2], o[3]); ov.z = pk2(o[4], o[5]); ov.w = pk2(o[6], o[7]);
        *(u32x4*)((bf16*)(ws + WS_WIN) + ((size_t)l * NIN + PC_GF + dir * 256 + n) * D + kc * 8) = ov;
    }
    if (blockIdx.x == (unsigned)(F.G - 1)) {
        float* tc = (float*)(ws + WS_ROPE); float* tsn = tc + 2048;
        for (int i = F.tid; i < 2048; i += NWAVES * 64) { const int pos = i >> 4, j = i & 15; const float inv = powf(10000.0f, -(float)j * (1.0f / 16.0f)); const float ang = (float)pos * inv;
            tc[i] = cosf(ang); tsn[i] = sinf(ang); }
    }
    __syncthreads();
    {
        LAS float* cs = (LAS float*)F.lds; LAS float* red = cs + 3072;
        for (int i = F.tid; i < 3072; i += NWAVES * 64) { const int v = i >> 10, k = i & 1023; const float cv = v < 2 ? a->in[I_C][v * D + k] : a->in[I_CCTX][k]; cs[i] = cv / (1.0f + expf(-cv)); }
        __syncthreads();
        for (int u = blockIdx.x; u < 192; u += F.G) {
            const int l = u / 96, jg = u % 96, jl = F.tid & 63, ks = F.tid >> 6;
            const float* wp = a->in[I_WADA] + ((size_t)l * D + ks * 128) * 6144 + jg * 64 + jl;
            float a0 = 0.f, a1 = 0.f, a2 = 0.f;
#pragma unroll 8
            for (int k = 0; k < 128; ++k) { const float w = wp[(size_t)k * 6144]; const int kk = ks * 128 + k; a0 += cs[kk] * w; a1 += cs[1024 + kk] * w; a2 += cs[2048 + kk] * w; }
            red[(ks * 3 + 0) * 64 + jl] = a0; red[(ks * 3 + 1) * 64 + jl] = a1; red[(ks * 3 + 2) * 64 + jl] = a2;
            __syncthreads();
            if (F.tid < 192) { const int v = F.tid >> 6, j2 = F.tid & 63; float s = 0.f;
#pragma unroll
                for (int q = 0; q < 8; ++q) s += red[(q * 3 + v) * 64 + j2];
                ((float*)(ws + WS_MOD))[(l * 3 + v) * 6144 + jg * 64 + j2] = s + a->in[I_BADA][l * 6144 + jg * 64 + j2]; }
            __syncthreads();
        }
    }
}

__device__ __forceinline__ f32x4 ld_y4(const bf16* p) { const u32x2 w = *(const u32x2*)p; return (f32x4){bflo(w.x), bfhi(w.x), bflo(w.y), bfhi(w.y)}; }
__device__ __forceinline__ void n1_phase(const Frame& F, const CAS Args* a, int l) {
    unsigned char* ws = F.ws;
    const float* mod = (const float*)(ws + WS_MOD);
    const bf16* Y0 = (const bf16*)(ws + WS_Y); const bf16* Y1 = Y0 + (size_t)TT * D;
    bf16* H = (bf16*)(ws + WS_H);
    for (int m = F.gw; m < TT; m += F.NGW) {
        const int v = m < TL ? (m >> 13) : 2;
        float* xrow = m < TL ? F.out + (size_t)m * D : (float*)(ws + WS_XC) + (size_t)(m - TL) * D;
        const float* src = (l == 0) ? (m < TL ? a->in[I_X] + (size_t)m * D : a->in[I_CTX] + (size_t)(m - TL) * D) : xrow;
        f32x4 x[4]; float ss = 0.f;
#pragma unroll
        for (int j = 0; j < 4; ++j) {
            const int col = 4 * F.lane + 256 * j;
            x[j] = *(const f32x4*)(src + col);
            if (l > 0) {
                const f32x4 g2 = *(const f32x4*)(mod + ((l - 1) * 3 + v) * 6144 + 5 * D + col);
                const f32x4 y = ld_y4(Y0 + (size_t)m * D + col) + ld_y4(Y1 + (size_t)m * D + col);
                x[j] = x[j] + g2 * y;
                *(f32x4*)(xrow + col) = x[j];
            }
            ss += (x[j][0] * x[j][0] + x[j][1] * x[j][1]) + (x[j][2] * x[j][2] + x[j][3] * x[j][3]);
        }
        const float rstd = 1.0f / sqrtf(wave_sum(ss) * (1.0f / D) + EPS);
#pragma unroll
        for (int j = 0; j < 4; ++j) {
            const int col = 4 * F.lane + 256 * j;
            const f32x4 nw = *(const f32x4*)(a->in[I_NORM1] + l * D + col);
            const f32x4 sh = *(const f32x4*)(mod + (l * 3 + v) * 6144 + 0 * D + col);
            const f32x4 sc = *(const f32x4*)(mod + (l * 3 + v) * 6144 + 1 * D + col);
            const f32x4 h = x[j] * rstd * nw * (1.0f + sc) + sh;
            u32x2 o; o.x = pk2(h[0], h[1]); o.y = pk2(h[2], h[3]);
            *(u32x2*)(H + (size_t)m * D + col) = o;
        }
    }
}

struct EpiIn {
    static constexpr bool PERM = true;
    bf16* P; const float* bias_f; const float* bias_b; const float* tcos; const float* tsin;
    __device__ __forceinline__ void operator()(const f32x4 (&acc)[2][2][4][2], const pg8::Unit& u, int wr, int wc, int fr, int fq) const {
        const int row0 = u.pm * 256 + wr * 64 + fr, colw = wc * 32 + 8 * fq;
        const int pn = u.pn;
        const bool latent = u.pm < 64;
#pragma unroll
        for (int ai = 0; ai < 2; ++ai)
#pragma unroll
            for (int m = 0; m < 4; ++m) {
                const int row = row0 + ai * 128 + m * 16;
                bf16* rowp = P + (size_t)row * NIN + pn * 256 + colw;
#pragma unroll
                for (int bj = 0; bj < 2; ++bj) {
                    f32x4 v0 = acc[ai][bj][m][0], v1 = acc[ai][bj][m][1];
                    if (pn == 0) { v0 = v0 * 0.125f; v1 = v1 * 0.125f; }
                    else if (pn >= 9) {
                        const float* bp = (pn == 9 ? bias_f : bias_b) + colw + bj * 128;
                        const f32x4 b0 = *(const f32x4*)bp, b1 = *(const f32x4*)(bp + 4);
#pragma unroll
                        for (int i = 0; i < 4; ++i) { float x0 = v0[i] + b0[i], x1 = v1[i] + b1[i];
                            v0[i] = (fminf(x0, 0.f) - __logf(1.0f + __expf(-fabsf(x0)))) * 0.0625f; v1[i] = (fminf(x1, 0.f) - __logf(1.0f + __expf(-fabsf(x1)))) * 0.0625f; }
                    } else if (latent && (pn == 6 || pn == 7 || (pn == 8 && bj == 0))) {
                        const int t = row & (SEQ - 1); const int pos = (wc & 1) ? (t & 63) : (t >> 6);
                        const f32x4 cs = *(const f32x4*)(tcos + pos * 16 + 4 * fq), sn = *(const f32x4*)(tsin + pos * 16 + 4 * fq);
                        const f32x4 o0 = v0 * cs - v1 * sn, o1 = v1 * cs + v0 * sn; v0 = o0; v1 = o1;
                    }
                    if (pn == 6 || pn == 7) { v0 = v0 * QSCALE; v1 = v1 * QSCALE; }
                    u32x4 w; w.x = pg8::cvt_pk_bf16(v0[0], v0[1]); w.y = pg8::cvt_pk_bf16(v0[2], v0[3]); w.z = pg8::cvt_pk_bf16(v1[0], v1[1]); w.w = pg8::cvt_pk_bf16(v1[2], v1[3]);
                    *(u32x4*)(rowp + bj * 128) = w;
                }
            }
    }
};
struct EpiOut {
    static constexpr bool PERM = false;
    const float* resL; const float* resC; float* outL; float* outC; const float* mod_l;
    __device__ __forceinline__ void operator()(const f32x4 (&acc)[2][2][4][2], const pg8::Unit& u, int wr, int wc, int fr, int fq) const {
        const bool latent = u.pm < 64;
        const int v = latent ? (u.pm >> 5) : 2;
        const int rowb = (latent ? u.pm * 256 : u.pm * 256 - TL) + wr * 64 + fr;
        const float* res = latent ? resL : resC; float* out = latent ? outL : outC;
        const int col0 = u.pn * 256 + wc * 32 + 4 * fq;
        const float* g1p = mod_l + v * 6144 + 2 * D + col0;
#pragma unroll
        for (int ai = 0; ai < 2; ++ai)
#pragma unroll
            for (int m = 0; m < 4; ++m) {
                const size_t off = (size_t)(rowb + ai * 128 + m * 16) * D + col0;
#pragma unroll
                for (int bj = 0; bj < 2; ++bj)
#pragma unroll
                    for (int n = 0; n < 2; ++n) {
                        const f32x4 g1 = *(const f32x4*)(g1p + bj * 128 + n * 16);
                        const f32x4 r = *(const f32x4*)(res + off + bj * 128 + n * 16);
                        *(f32x4*)(out + off + bj * 128 + n * 16) = r + g1 * acc[ai][bj][m][n];
                    }
                if (m & 1) asm volatile("" ::: "memory");
            }
    }
};
struct EpiGU {
    static constexpr bool PERM = true;
    bf16* Hmid;
    __device__ __forceinline__ void operator()(const f32x4 (&acc)[2][2][4][2], const pg8::Unit& u, int wr, int wc, int fr, int fq) const {
        const int row0 = u.pm * 256 + wr * 64 + fr, hid0 = u.pn * 128 + wc * 16 + fq * 4;
#pragma unroll
        for (int ai = 0; ai < 2; ++ai)
#pragma unroll
            for (int m = 0; m < 4; ++m) {
                bf16* rowp = Hmid + (size_t)(row0 + ai * 128 + m * 16) * DE + hid0;
#pragma unroll
                for (int bj = 0; bj < 2; ++bj) {
                    const f32x4 g = acc[ai][bj][m][0], up = acc[ai][bj][m][1]; f32x4 o;
#pragma unroll
                    for (int i = 0; i < 4; ++i) o[i] = g[i] * __builtin_amdgcn_rcpf(1.0f + __expf(-g[i])) * up[i];
                    u32x2 w; w.x = pg8::cvt_pk_bf16(o[0], o[1]); w.y = pg8::cvt_pk_bf16(o[2], o[3]);
                    *(u32x2*)(rowp + bj * 64) = w;
                }
            }
    }
};
struct EpiDown {
    static constexpr bool PERM = true;
    bf16* Y; const unsigned* list; const float* listw; const LAS int* tab;
    __device__ __forceinline__ void operator()(const f32x4 (&acc)[2][2][4][2], const pg8::Unit& u, int wr, int wc, int fr, int fq) const {
        const int ce = tab[u.e];
        const int r0 = u.mt * 256 + wr * 64 + fr, col0 = u.pn * 256 + wc * 32 + 8 * fq;
        const unsigned* lp = list + (size_t)u.e * LISTCAP; const float* lw = listw + (size_t)u.e * LISTCAP;
#pragma unroll
        for (int ai = 0; ai < 2; ++ai)
#pragma unroll
            for (int m = 0; m < 4; ++m) {
                const int r = r0 + ai * 128 + m * 16;
                if (r < ce) {
                    const unsigned ts = __builtin_nontemporal_load(lp + r); const float w = __builtin_nontemporal_load(lw + r);
                    bf16* rowp = Y + ((size_t)(ts & 1u) * TT + (ts >> 1)) * D + col0;
#pragma unroll
                    for (int bj = 0; bj < 2; ++bj) {
                        const f32x4 v0 = acc[ai][bj][m][0] * w, v1 = acc[ai][bj][m][1] * w;
                        u32x4 o; o.x = pg8::cvt_pk_bf16(v0[0], v0[1]); o.y = pg8::cvt_pk_bf16(v0[2], v0[3]); o.z = pg8::cvt_pk_bf16(v1[0], v1[1]); o.w = pg8::cvt_pk_bf16(v1[2], v1[3]);
                        *(u32x4*)(rowp + bj * 128) = o;
                    }
                }
            }
    }
};

__device__ __forceinline__ void swa_naive(const Frame& F, const CAS Args* a, int l) {
    const bf16* P = (const bf16*)(F.ws + WS_P); bf16* MIX = (bf16*)(F.ws + WS_MIX);
    const int total = (l == 0 ? TT : TL) * 8;
    for (int idx = F.gw * 64 + F.lane; idx < total; idx += F.NGW * 64) {
        const int m = idx >> 3, hq = idx & 7, kvh = hq >> 2;
        const bool latent = m < TL;
        const int b = latent ? (m >> 13) : ((m - TL) >> 8), t = m & (SEQ - 1);
        float q[64];
        { const u32x4* qp = (const u32x4*)(P + (size_t)m * NIN + PC_SQ + hq * 64);
#pragma unroll
          for (int c = 0; c < 8; ++c) { const u32x4 w = qp[c]; q[8 * c] = bflo(w.x); q[8 * c + 1] = bfhi(w.x); q[8 * c + 2] = bflo(w.y); q[8 * c + 3] = bfhi(w.y);
              q[8 * c + 4] = bflo(w.z); q[8 * c + 5] = bfhi(w.z); q[8 * c + 6] = bflo(w.w); q[8 * c + 7] = bfhi(w.w); } }
        float o[64];
#pragma unroll
        for (int d = 0; d < 64; ++d) o[d] = 0.f;
        const float sink = a->in[I_SINK][l * 8 + hq] * LOG2E;
        float mx = sink, den = 1.0f;
        const int lo = latent ? (t - 128 < 0 ? 0 : t - 128) : 0, hi = latent ? (t + 128 > SEQ - 1 ? SEQ - 1 : t + 128) : -1;
        const int nloc = hi - lo + 1;
        for (int kk = 0; kk < nloc + LC; ++kk) {
            const int krow = kk < nloc ? b * SEQ + lo + kk : TL + b * LC + (kk - nloc);
            const u32x4* kp = (const u32x4*)(P + (size_t)krow * NIN + PC_SK + kvh * 64);
            float s = 0.f;
#pragma unroll
            for (int c = 0; c < 8; ++c) { const u32x4 w = kp[c]; s += q[8 * c] * bflo(w.x) + q[8 * c + 1] * bfhi(w.x) + q[8 * c + 2] * bflo(w.y) + q[8 * c + 3] * bfhi(w.y)
                + q[8 * c + 4] * bflo(w.z) + q[8 * c + 5] * bfhi(w.z) + q[8 * c + 6] * bflo(w.w) + q[8 * c + 7] * bfhi(w.w); }
            const float mn = fmaxf(mx, s), f = exp2f(mx - mn), p = exp2f(s - mn);
            den = den * f + p; mx = mn;
            const u32x4* vp = (const u32x4*)(P + (size_t)krow * NIN + PC_SV + kvh * 64);
#pragma unroll
            for (int c = 0; c < 8; ++c) { const u32x4 w = vp[c];
                o[8 * c] = o[8 * c] * f + p * bflo(w.x); o[8 * c + 1] = o[8 * c + 1] * f + p * bfhi(w.x); o[8 * c + 2] = o[8 * c + 2] * f + p * bflo(w.y); o[8 * c + 3] = o[8 * c + 3] * f + p * bfhi(w.y);
                o[8 * c + 4] = o[8 * c + 4] * f + p * bflo(w.z); o[8 * c + 5] = o[8 * c + 5] * f + p * bfhi(w.z); o[8 * c + 6] = o[8 * c + 6] * f + p * bflo(w.w); o[8 * c + 7] = o[8 * c + 7] * f + p * bfhi(w.w); }
        }
        const float inv = 1.0f / den;
        u32x4* op = (u32x4*)(MIX + (size_t)m * D + 512 + hq * 64);
#pragma unroll
        for (int c = 0; c < 8; ++c) { u32x4 w; w.x = pk2(o[8 * c] * inv, o[8 * c + 1] * inv); w.y = pk2(o[8 * c + 2] * inv, o[8 * c + 3] * inv); w.z = pk2(o[8 * c + 4] * inv, o[8 * c + 5] * inv); w.w = pk2(o[8 * c + 6] * inv, o[8 * c + 7] * inv); op[c] = w; }
    }
}


typedef float f32x16 __attribute__((ext_vector_type(16)));
typedef short s16x4 __attribute__((ext_vector_type(4)));
__device__ __forceinline__ int crow(int r, int hi) { return (r & 3) + 8 * (r >> 2) + 4 * hi; }
__device__ __forceinline__ s16x4 vtr(const LAS unsigned char* p) { return __builtin_bit_cast(s16x4, __builtin_amdgcn_ds_read_tr16_b64_v4i16((LAS s16x4*)p)); }
constexpr int SWA_K = 0, SWA_V = 49152;
__device__ __forceinline__ void swa_tile(const LAS unsigned char* Kt, const LAS unsigned char* Vt, int mtype, const bf16x8 (&qf)[2][4], f32x16 (&o)[2][2], float (&mrun)[2], float (&lrun)[2], int lane) {
    const int r32 = lane & 31, hi = lane >> 5;
    const LAS unsigned char* vp = Vt + ((lane >> 4) & 1) * 32 + (lane & 3) * 8 + (4 * hi + ((lane & 15) >> 2)) * 64;
#pragma unroll
    for (int kb = 0; kb < 2; ++kb) {
        f32x16 s[2];
#pragma unroll
        for (int d0 = 0; d0 < 4; ++d0) {
            const bf16x8 kf = *(const LAS bf16x8*)(Kt + (2 * d0 + hi) * 1024 + (32 * kb + r32) * 16);
#pragma unroll
            for (int qt = 0; qt < 2; ++qt) {
                if (d0 == 0) { f32x16 z;
#pragma unroll
                    for (int r = 0; r < 16; ++r) z[r] = 0.f;
                    s[qt] = __builtin_amdgcn_mfma_f32_32x32x16_bf16(kf, qf[qt][0], z, 0, 0, 0); }
                else s[qt] = __builtin_amdgcn_mfma_f32_32x32x16_bf16(kf, qf[qt][d0], s[qt], 0, 0, 0);
            }
        }
        bf16x8 pf[2][2];
#pragma unroll
        for (int qt = 0; qt < 2; ++qt) {
            if (mtype != 0) {
                int thr = r32 + 32 * qt - 4 * hi - 32 * kb; asm volatile("" : "+v"(thr));
                if (mtype == 1) {
#pragma unroll
                    for (int r = 0; r < 16; ++r) { const int cc = (r & 3) + 8 * (r >> 2); if (cc < thr) s[qt][r] = -INFINITY; }
                } else {
#pragma unroll
                    for (int r = 0; r < 16; ++r) { const int cc = (r & 3) + 8 * (r >> 2); if (cc > thr) s[qt][r] = -INFINITY; }
                }
            }
            float rm = s[qt][0];
#pragma unroll
            for (int r = 1; r < 16; ++r) rm = fmaxf(rm, s[qt][r]);
            { auto rr = __builtin_amdgcn_permlane32_swap(__float_as_uint(rm), __float_as_uint(rm), false, false); rm = fmaxf(__uint_as_float(rr[0]), __uint_as_float(rr[1])); }
            const float mn = fmaxf(mrun[qt], rm);
            if (__any(mn > mrun[qt])) {
                const float alpha = __builtin_amdgcn_exp2f(mrun[qt] - mn);
                lrun[qt] *= alpha;
#pragma unroll
                for (int dt = 0; dt < 2; ++dt)
#pragma unroll
                    for (int r = 0; r < 16; ++r) o[dt][qt][r] *= alpha;
                mrun[qt] = mn;
            }
            float rs = 0.f;
#pragma unroll
            for (int r = 0; r < 16; ++r) { const float p = __builtin_amdgcn_exp2f(s[qt][r] - mn); s[qt][r] = p; rs += p; }
            lrun[qt] += rs;
#pragma unroll
            for (int sp = 0; sp < 2; ++sp) {
                u32x4 w; w.x = pg8::cvt_pk_bf16(s[qt][8 * sp + 0], s[qt][8 * sp + 1]); w.y = pg8::cvt_pk_bf16(s[qt][8 * sp + 2], s[qt][8 * sp + 3]);
                w.z = pg8::cvt_pk_bf16(s[qt][8 * sp + 4], s[qt][8 * sp + 5]); w.w = pg8::cvt_pk_bf16(s[qt][8 * sp + 6], s[qt][8 * sp + 7]);
                pf[qt][sp] = __builtin_bit_cast(bf16x8, w);
            }
        }
#pragma unroll
        for (int dt = 0; dt < 2; ++dt)
#pragma unroll
            for (int sp = 0; sp < 2; ++sp) {
                const int ks = 2 * kb + sp;
                const s16x4 lo = vtr(vp + dt * 4096 + ks * 1024), hi4 = vtr(vp + dt * 4096 + ks * 1024 + 512);
                const bf16x8 vf = (bf16x8){lo[0], lo[1], lo[2], lo[3], hi4[0], hi4[1], hi4[2], hi4[3]};
#pragma unroll
                for (int qt = 0; qt < 2; ++qt) o[dt][qt] = __builtin_amdgcn_mfma_f32_32x32x16_bf16(vf, pf[qt][sp], o[dt][qt], 0, 0, 0);
            }
    }
}
__device__ __forceinline__ void swa_stage(const Frame& F, const bf16* P, int grow, int kvh, int ti) {
    { const int key = 8 * F.wave + (F.lane & 7), ch = F.lane >> 3;
      const u32x4 v = *(const u32x4*)(P + (size_t)(grow + key) * NIN + PC_SK + kvh * 64 + ch * 8);
      *(LAS u32x4*)(F.lds + SWA_K + ti * 8192 + ch * 1024 + key * 16) = v; }
    { const int key = 8 * F.wave + (F.lane >> 3), ch = F.lane & 7;
      const u32x4 v = *(const u32x4*)(P + (size_t)(grow + key) * NIN + PC_SV + kvh * 64 + ch * 8);
      *(LAS u32x4*)(F.lds + SWA_V + ti * 8192 + (ch >> 2) * 4096 + key * 64 + (ch & 3) * 16) = v; }
}
__device__ __forceinline__ void swa_flash(const Frame& F, const CAS Args* a, int l) {
    const bf16* P = (const bf16*)(F.ws + WS_P); bf16* MIX = (bf16*)(F.ws + WS_MIX);
    const int nunits = 256 + (l == 0 ? 8 : 0);
    const int lane = F.lane, r32 = lane & 31, hi = lane >> 5;
    for (int u = F.vcu; u < nunits; u += F.G) {
        const bool latent = u < 256;
        const int b = latent ? (u >> 7) : ((u - 256) >> 2), kvh = latent ? ((u >> 6) & 1) : (((u - 256) >> 1) & 1), qb = latent ? (u & 63) : ((u - 256) & 1);
        const int q0 = qb * 128, g = F.wave >> 1, qs = F.wave & 1, hq = kvh * 4 + g;
        const int mrow0 = (latent ? b * SEQ : TL + b * LC) + q0 + 64 * qs;
        bf16x8 qf[2][4];
#pragma unroll
        for (int qt = 0; qt < 2; ++qt)
#pragma unroll
            for (int d0 = 0; d0 < 4; ++d0) qf[qt][d0] = *(const bf16x8*)(P + (size_t)(mrow0 + 32 * qt + r32) * NIN + PC_SQ + hq * 64 + 16 * d0 + 8 * hi);
        f32x16 o[2][2];
#pragma unroll
        for (int dt = 0; dt < 2; ++dt)
#pragma unroll
            for (int qt = 0; qt < 2; ++qt)
#pragma unroll
                for (int r = 0; r < 16; ++r) o[dt][qt][r] = 0.f;
        const float sink2 = a->in[I_SINK][l * 8 + hq] * LOG2E;
        float mrun[2] = {sink2, sink2}, lrun[2] = {hi == 0 ? 1.f : 0.f, hi == 0 ? 1.f : 0.f};
        if (latent) {
#pragma unroll 1
            for (int j = 0; j < 6; ++j) { const int ks = q0 - 128 + 64 * j; if (ks >= 0 && ks < SEQ) swa_stage(F, P, b * SEQ + ks, kvh, j); }
            __syncthreads();
#pragma unroll 1
            for (int tt = 0; tt < 5; ++tt) { const int j = qs + tt, ks = q0 - 128 + 64 * j;
                if (ks >= 0 && ks < SEQ) swa_tile(F.lds + SWA_K + j * 8192, F.lds + SWA_V + j * 8192, tt == 0 ? 1 : (tt == 4 ? 2 : 0), qf, o, mrun, lrun, lane); }
            __syncthreads();
        }
#pragma unroll 1
        for (int j = 0; j < 4; ++j) swa_stage(F, P, TL + b * LC + 64 * j, kvh, j);
        __syncthreads();
#pragma unroll 1
        for (int j = 0; j < 4; ++j) swa_tile(F.lds + SWA_K + j * 8192, F.lds + SWA_V + j * 8192, 0, qf, o, mrun, lrun, lane);
        __syncthreads();
#pragma unroll
        for (int qt = 0; qt < 2; ++qt) {
            float lt = lrun[qt];
            { auto rr = __builtin_amdgcn_permlane32_swap(__float_as_uint(lt), __float_as_uint(lt), false, false); lt = __uint_as_float(rr[0]) + __uint_as_float(rr[1]); }
            const float inv = 1.0f / lt;
            bf16* op = MIX + (size_t)(mrow0 + 32 * qt + r32) * D + 512 + hq * 64 + 4 * hi;
#pragma unroll
            for (int dt = 0; dt < 2; ++dt)
#pragma unroll
                for (int rg = 0; rg < 4; ++rg) {
                    u32x2 w; w.x = pk2(o[dt][qt][4 * rg] * inv, o[dt][qt][4 * rg + 1] * inv); w.y = pk2(o[dt][qt][4 * rg + 2] * inv, o[dt][qt][4 * rg + 3] * inv);
                    *(u32x2*)(op + 32 * dt + 8 * rg) = w;
                }
        }
    }
}


constexpr size_t WS_US = WS_GL, WS_USC = WS_GL + 32 * MiB, WS_DEC = 7 * MiB;
static_assert(WS_USC + (size_t)16 * 4 * 8192 * 2 <= WS_END && WS_DEC + (size_t)16 * 132 * 64 * 4 <= WS_WIN, "ws map (gla)");
constexpr int GL_V = 0, GL_M0 = 16384, GL_MSZ = 64 * 72 * 2, GL_RED = GL_M0 + 4 * GL_MSZ;
__device__ __forceinline__ float wave_scan_incl(float v) {
    v += DPP_F(v, 0x111, 0xF); v += DPP_F(v, 0x112, 0xF); v += DPP_F(v, 0x114, 0xF); v += DPP_F(v, 0x118, 0xF);
    v += DPP_F(v, 0x142, 0xA); v += DPP_F(v, 0x143, 0xC); return v;
}
__device__ __forceinline__ float lane63(float v) { return __builtin_bit_cast(float, __builtin_amdgcn_readlane(__builtin_bit_cast(int, v), 63)); }
__device__ __forceinline__ void unpack8(const u32x4 w, float (&f)[8]) { f[0] = bflo(w.x); f[1] = bfhi(w.x); f[2] = bflo(w.y); f[3] = bfhi(w.y); f[4] = bflo(w.z); f[5] = bfhi(w.z); f[6] = bflo(w.w); f[7] = bfhi(w.w); }
__device__ __forceinline__ void gla_stage_v(const Frame& F, const bf16* P, int m0, int h) {
#pragma unroll
    for (int i = 0; i < 2; ++i) { const int p = F.tid + 512 * i, t = p >> 4, ch = p & 15;
        const u32x4 v = *(const u32x4*)(P + (size_t)(m0 + t) * NIN + PC_V + h * 128 + ch * 8);
        *(LAS u32x4*)(F.lds + GL_V + (ch >> 2) * 4096 + t * 64 + (ch & 3) * 16) = v; }
}
__device__ __forceinline__ void gla_g1_unit(const Frame& F, const bf16* P, int m0, int h, bf16* Uf, bf16* Ub, float* decf, float* decb) {
    const int w = F.wave, t = F.lane, c = t & 31, hi = t >> 5;
    const bf16* row = P + (size_t)(m0 + t) * NIN + h * 64 + 8 * w;
    float laf[8], lab[8], kk[8];
    unpack8(*(const u32x4*)(row + PC_GF), laf); unpack8(*(const u32x4*)(row + PC_GB), lab); unpack8(*(const u32x4*)(row + PC_K), kk);
    gla_stage_v(F, P, m0, h);
    LAS bf16* KOF = (LAS bf16*)(F.lds + GL_M0); LAS bf16* KOB = (LAS bf16*)(F.lds + GL_M0 + GL_MSZ);
#pragma unroll
    for (int i = 0; i < 8; ++i) {
        const float incf = wave_scan_incl(laf[i]), tf = lane63(incf), incb = wave_scan_incl(lab[i]), tb = lane63(incb);
        KOF[(8 * w + i) * 72 + t] = (bf16)f2bf(kk[i] * __expf(tf - incf));
        KOB[(8 * w + i) * 72 + t] = (bf16)f2bf(kk[i] * __expf(incb - lab[i]));
        if (t == 0) { decf[8 * w + i] = __expf(tf); decb[8 * w + i] = __expf(tb); }
    }
    __syncthreads();
    const int dir = w >> 2, dvt = w & 3;
    const LAS unsigned char* vp = F.lds + GL_V + dvt * 4096 + ((t >> 4) & 1) * 32 + (t & 3) * 8 + ((t & 15) >> 2) * 64 + hi * 512;
    const LAS unsigned char* kb = F.lds + GL_M0 + dir * GL_MSZ + (c * 72 + 8 * hi) * 2;
    f32x16 acc[2];
#pragma unroll
    for (int j = 0; j < 2; ++j)
#pragma unroll
        for (int r = 0; r < 16; ++r) acc[j][r] = 0.f;
#pragma unroll
    for (int sp = 0; sp < 4; ++sp) {
        const s16x4 lo = vtr(vp + sp * 1024), hi4 = vtr(vp + sp * 1024 + 256);
        const bf16x8 vf = (bf16x8){lo[0], lo[1], lo[2], lo[3], hi4[0], hi4[1], hi4[2], hi4[3]};
#pragma unroll
        for (int j = 0; j < 2; ++j) { const bf16x8 kf = *(const LAS bf16x8*)(kb + j * 32 * 144 + sp * 32); acc[j] = __builtin_amdgcn_mfma_f32_32x32x16_bf16(vf, kf, acc[j], 0, 0, 0); }
    }
    bf16* U = dir ? Ub : Uf;
#pragma unroll
    for (int j = 0; j < 2; ++j)
#pragma unroll
        for (int r = 0; r < 16; ++r) U[(32 * dvt + crow(r, hi)) * 64 + 32 * j + c] = (bf16)f2bf(acc[j][r]);
    __syncthreads();
}
__device__ __forceinline__ void gla_g1(const Frame& F0, int l) {
    Frame F = F0; { int l_; asm volatile("v_mbcnt_lo_u32_b32 %0, -1, 0\n\tv_mbcnt_hi_u32_b32 %0, -1, %0" : "=v"(l_)); F.lane = l_; F.tid = F.wave * 64 + l_; }
    const bf16* P = (const bf16*)(F.ws + WS_P);
    bf16* US = (bf16*)(F.ws + WS_US); bf16* USC = (bf16*)(F.ws + WS_USC); float* DEC = (float*)(F.ws + WS_DEC);
    for (int u = F.vcu; u < 1056; u += F.G) {
        const bool latent = u < 1024; const int cc = u - 1024;
        const int b = latent ? (u >> 9) : (cc >> 4), h = latent ? ((u >> 7) & 3) : ((cc >> 2) & 3), n = latent ? (u & 127) : (cc & 3);
        const int m0 = latent ? b * SEQ + 64 * n : TL + b * LC + 64 * n;
        const int sf = (b * 4 + h) * 2;
        bf16* Uf = latent ? US + ((size_t)sf * 128 + n) * 8192 : USC + ((size_t)sf * 4 + n) * 8192;
        bf16* Ub = latent ? US + ((size_t)(sf + 1) * 128 + n) * 8192 : USC + ((size_t)(sf + 1) * 4 + n) * 8192;
        const int nd = latent ? n : 128 + n;
        gla_g1_unit(F, P, m0, h, Uf, Ub, DEC + ((size_t)sf * 132 + nd) * 64, DEC + ((size_t)(sf + 1) * 132 + nd) * 64);
    }
}
constexpr size_t WS_SS = WS_H, WS_SSC = WS_H + 32 * MiB;
static_assert(WS_SSC + (size_t)16 * 4 * 8192 * 2 <= WS_P, "ws map (gla states)");
__device__ __forceinline__ void gla_scan(const Frame& F) {
    const bf16* US = (const bf16*)(F.ws + WS_US); const bf16* USC = (const bf16*)(F.ws + WS_USC); const float* DEC = (const float*)(F.ws + WS_DEC);
    bf16* SS = (bf16*)(F.ws + WS_SS); bf16* SSC = (bf16*)(F.ws + WS_SSC);
    for (int idx = F.vcu * 512 + F.tid; idx < 16 * 8192; idx += F.G * 512) {
        const int seq = idx >> 13, e = idx & 8191, dk = e & 63, dir = seq & 1;
        const float* dec = DEC + (size_t)seq * 132 * 64 + dk;
        float s = 0.f;
        { const bf16* uc = USC + (size_t)seq * 4 * 8192 + e; bf16* sc = SSC + (size_t)seq * 4 * 8192 + e;
          float u[4], d[4];
#pragma unroll
          for (int i = 0; i < 4; ++i) { const int n = dir ? 3 - i : i; u[i] = bf2f(uc[n * 8192]); d[i] = dec[(128 + n) * 64]; }
#pragma unroll
          for (int i = 0; i < 4; ++i) { const int n = dir ? 3 - i : i; sc[n * 8192] = (bf16)f2bf(s); s = d[i] * s + u[i]; } }
        const bf16* ul = US + (size_t)seq * 128 * 8192 + e; bf16* sl = SS + (size_t)seq * 128 * 8192 + e;
#pragma unroll 1
        for (int i0 = 0; i0 < 128; i0 += 32) {
            float u[32], d[32];
#pragma unroll
            for (int j = 0; j < 32; ++j) { const int n = dir ? 127 - (i0 + j) : i0 + j; u[j] = bf2f(ul[(size_t)n * 8192]); d[j] = dec[n * 64]; }
#pragma unroll
            for (int j = 0; j < 32; ++j) { const int n = dir ? 127 - (i0 + j) : i0 + j; sl[(size_t)n * 8192] = (bf16)f2bf(s); s = d[j] * s + u[j]; }
        }
    }
}
__device__ __forceinline__ void gla_g3_unit(const Frame& F, const CAS Args* a, int l, const bf16* P, int m0, int h, const bf16* Sf, const bf16* Sb, bf16* MIX) {
    const int w = F.wave, t = F.lane, c = t & 31, hi = t >> 5;
    {
        const bf16* row = P + (size_t)(m0 + t) * NIN + h * 64 + 8 * w;
        float laf[8], lab[8], kk[8], qq[8];
        unpack8(*(const u32x4*)(row + PC_GF), laf); unpack8(*(const u32x4*)(row + PC_GB), lab); unpack8(*(const u32x4*)(row + PC_K), kk); unpack8(*(const u32x4*)(row + PC_Q), qq);
        gla_stage_v(F, P, m0, h);
        float qf[8], kf[8], qb[8], kb[8];
#pragma unroll
        for (int i = 0; i < 8; ++i) {
            const float bf = wave_scan_incl(laf[i]), incb = wave_scan_incl(lab[i]), bb = lane63(incb) - incb + lab[i];
            qf[i] = qq[i] * __expf(bf); kf[i] = kk[i] * __expf(-bf); qb[i] = qq[i] * __expf(bb); kb[i] = kk[i] * __expf(-bb);
        }
        LAS unsigned char* mb = F.lds + GL_M0 + (t * 72 + 8 * w) * 2;
        u32x4 o;
        o.x = pk2(qf[0], qf[1]); o.y = pk2(qf[2], qf[3]); o.z = pk2(qf[4], qf[5]); o.w = pk2(qf[6], qf[7]); *(LAS u32x4*)(mb) = o;
        o.x = pk2(kf[0], kf[1]); o.y = pk2(kf[2], kf[3]); o.z = pk2(kf[4], kf[5]); o.w = pk2(kf[6], kf[7]); *(LAS u32x4*)(mb + GL_MSZ) = o;
        o.x = pk2(qb[0], qb[1]); o.y = pk2(qb[2], qb[3]); o.z = pk2(qb[4], qb[5]); o.w = pk2(qb[6], qb[7]); *(LAS u32x4*)(mb + 2 * GL_MSZ) = o;
        o.x = pk2(kb[0], kb[1]); o.y = pk2(kb[2], kb[3]); o.z = pk2(kb[4], kb[5]); o.w = pk2(kb[6], kb[7]); *(LAS u32x4*)(mb + 3 * GL_MSZ) = o;
    }
    __syncthreads();
    const int dvt = w >> 1, tt = w & 1;
    bf16x8 qfB[4], qbB[4];
    { const LAS unsigned char* qp = F.lds + GL_M0 + ((32 * tt + c) * 72 + 8 * hi) * 2;
#pragma unroll
      for (int kd = 0; kd < 4; ++kd) { qfB[kd] = *(const LAS bf16x8*)(qp + kd * 32); qbB[kd] = *(const LAS bf16x8*)(qp + 2 * GL_MSZ + kd * 32); } }
    bf16x8 pfr[2][2];
#pragma unroll
    for (int st = 0; st < 2; ++st) {
        const LAS unsigned char* kp = F.lds + GL_M0 + GL_MSZ + ((32 * st + c) * 72 + 8 * hi) * 2;
        f32x16 xf, xb;
#pragma unroll
        for (int r = 0; r < 16; ++r) { xf[r] = 0.f; xb[r] = 0.f; }
        const bool needF = st <= tt, needB = st >= tt;
        if (needF) {
#pragma unroll
            for (int kd = 0; kd < 4; ++kd) xf = __builtin_amdgcn_mfma_f32_32x32x16_bf16(*(const LAS bf16x8*)(kp + kd * 32), qfB[kd], xf, 0, 0, 0);
        }
        if (needB) {
#pragma unroll
            for (int kd = 0; kd < 4; ++kd) xb = __builtin_amdgcn_mfma_f32_32x32x16_bf16(*(const LAS bf16x8*)(kp + 2 * GL_MSZ + kd * 32), qbB[kd], xb, 0, 0, 0);
        }
        if (st == tt) {
            int thr = c - 4 * hi; asm volatile("" : "+v"(thr));
#pragma unroll
            for (int r = 0; r < 16; ++r) { const int cc = (r & 3) + 8 * (r >> 2); xf[r] = (cc <= thr ? xf[r] : 0.f) + (cc >= thr ? xb[r] : 0.f); }
        } else {
#pragma unroll
            for (int r = 0; r < 16; ++r) xf[r] += xb[r];
        }
#pragma unroll
        for (int sp = 0; sp < 2; ++sp) {
            u32x4 wv; wv.x = pg8::cvt_pk_bf16(xf[8 * sp + 0], xf[8 * sp + 1]); wv.y = pg8::cvt_pk_bf16(xf[8 * sp + 2], xf[8 * sp + 3]);
            wv.z = pg8::cvt_pk_bf16(xf[8 * sp + 4], xf[8 * sp + 5]); wv.w = pg8::cvt_pk_bf16(xf[8 * sp + 6], xf[8 * sp + 7]);
            pfr[st][sp] = __builtin_bit_cast(bf16x8, wv);
        }
    }
    f32x16 o;
#pragma unroll
    for (int r = 0; r < 16; ++r) o[r] = 0.f;
    { const LAS unsigned char* vp = F.lds + GL_V + dvt * 4096 + ((t >> 4) & 1) * 32 + (t & 3) * 8 + (4 * hi + ((t & 15) >> 2)) * 64;
#pragma unroll
      for (int ks = 0; ks < 4; ++ks) {
          const s16x4 lo = vtr(vp + ks * 1024), hi4 = vtr(vp + ks * 1024 + 512);
          const bf16x8 vf = (bf16x8){lo[0], lo[1], lo[2], lo[3], hi4[0], hi4[1], hi4[2], hi4[3]};
          o = __builtin_amdgcn_mfma_f32_32x32x16_bf16(vf, pfr[ks >> 1][ks & 1], o, 0, 0, 0);
      } }
    { const bf16* sfp = Sf + (32 * dvt + c) * 64 + 8 * hi; const bf16* sbp = Sb + (32 * dvt + c) * 64 + 8 * hi;
#pragma unroll
      for (int kd = 0; kd < 4; ++kd) {
          o = __builtin_amdgcn_mfma_f32_32x32x16_bf16(*(const bf16x8*)(sfp + 16 * kd), qfB[kd], o, 0, 0, 0);
          o = __builtin_amdgcn_mfma_f32_32x32x16_bf16(*(const bf16x8*)(sbp + 16 * kd), qbB[kd], o, 0, 0, 0);
      } }
    float ssq = 0.f;
#pragma unroll
    for (int r = 0; r < 16; ++r) ssq += o[r] * o[r];
    { auto rr = __builtin_amdgcn_permlane32_swap(__float_as_uint(ssq), __float_as_uint(ssq), false, false); ssq = __uint_as_float(rr[0]) + __uint_as_float(rr[1]); }
    LAS float* red = (LAS float*)(F.lds + GL_RED);
    if (hi == 0) red[dvt * 64 + 32 * tt + c] = ssq;
    __syncthreads();
    const float tot = (red[32 * tt + c] + red[64 + 32 * tt + c]) + (red[128 + 32 * tt + c] + red[192 + 32 * tt + c]);
    const float rstd = 1.0f / sqrtf(tot * (1.0f / 128.0f) + EPS);
    const int mrow = m0 + 32 * tt + c;
#pragma unroll
    for (int rg = 0; rg < 4; ++rg) {
        const int dv = 32 * dvt + 8 * rg + 4 * hi;
        const u32x2 gw = *(const u32x2*)(P + (size_t)mrow * NIN + PC_G + h * 128 + dv);
        const f32x4 nw = *(const f32x4*)(a->in[I_GLANORM] + l * 512 + h * 128 + dv);
        const float g0 = bflo(gw.x), g1 = bfhi(gw.x), g2 = bflo(gw.y), g3 = bfhi(gw.y);
        u32x2 ov; ov.x = pk2(o[4 * rg] * rstd * nw[0] * silu_f(g0), o[4 * rg + 1] * rstd * nw[1] * silu_f(g1)); ov.y = pk2(o[4 * rg + 2] * rstd * nw[2] * silu_f(g2), o[4 * rg + 3] * rstd * nw[3] * silu_f(g3));
        *(u32x2*)(MIX + (size_t)mrow * D + h * 128 + dv) = ov;
    }
    __syncthreads();
}
__device__ __forceinline__ void gla_g3(const Frame& F, const CAS Args* a, int l) {
    const bf16* P = (const bf16*)(F.ws + WS_P); bf16* MIX = (bf16*)(F.ws + WS_MIX);
    const bf16* US = (const bf16*)(F.ws + WS_SS); const bf16* USC = (const bf16*)(F.ws + WS_SSC);
    const int nunits = 1024 + (l == 0 ? 32 : 0);
    for (int u = F.vcu; u < nunits; u += F.G) {
        const bool latent = u < 1024; const int cc = u - 1024;
        const int b = latent ? (u >> 9) : (cc >> 4), h = latent ? ((u >> 7) & 3) : ((cc >> 2) & 3), n = latent ? (u & 127) : (cc & 3);
        const int m0 = latent ? b * SEQ + 64 * n : TL + b * LC + 64 * n;
        const int sf = (b * 4 + h) * 2;
        const bf16* Sf = latent ? US + ((size_t)sf * 128 + n) * 8192 : USC + ((size_t)sf * 4 + n) * 8192;
        const bf16* Sb = latent ? US + ((size_t)(sf + 1) * 128 + n) * 8192 : USC + ((size_t)(sf + 1) * 4 + n) * 8192;
        gla_g3_unit(F, a, l, P, m0, h, Sf, Sb, MIX);
    }
}

__device__ __forceinline__ void gla_naive(const Frame& F, const CAS Args* a, int l) {
    const bf16* P = (const bf16*)(F.ws + WS_P);
    bf16* OF = (bf16*)(F.ws + WS_GL);
    for (int w = F.gw; w < 2048; w += F.NGW) {
        const int dv = w & 127, dir = (w >> 7) & 1, h = (w >> 8) & 3, b = w >> 10;
        const int pcg = dir ? PC_GB : PC_GF;
        float S = 0.f;
        for (int step = 0; step < LC + SEQ; ++step) {
            int m;
            if (dir == 0) m = step < LC ? TL + b * LC + step : b * SEQ + (step - LC);
            else m = step < LC ? TL + b * LC + (LC - 1 - step) : b * SEQ + (SEQ - 1 - (step - LC));
            const bf16* row = P + (size_t)m * NIN;
            const float la = bf2f(row[pcg + h * 64 + F.lane]), kk = bf2f(row[PC_K + h * 64 + F.lane]), qq = bf2f(row[PC_Q + h * 64 + F.lane]), vv = bf2f(row[PC_V + h * 128 + dv]);
            S = __expf(la) * S + kk * vv;
            const float o = wave_sum(qq * S);
            if (F.lane == 0) OF[((size_t)dir * TT + m) * 512 + h * 128 + dv] = (bf16)f2bf(o);
        }
    }
}
__device__ __forceinline__ void gla_out_naive(const Frame& F, const CAS Args* a, int l) {
    const bf16* P = (const bf16*)(F.ws + WS_P); bf16* MIX = (bf16*)(F.ws + WS_MIX);
    const bf16* OF = (const bf16*)(F.ws + WS_GL);
    const int rows = (l == 0) ? TT : TL;
    for (int m = F.gw; m < rows; m += F.NGW) {
        const int c0 = 8 * F.lane;
        const u32x4 wa = *(const u32x4*)(OF + (size_t)m * 512 + c0), wb = *(const u32x4*)(OF + ((size_t)TT + m) * 512 + c0);
        float o[8] = {bflo(wa.x) + bflo(wb.x), bfhi(wa.x) + bfhi(wb.x), bflo(wa.y) + bflo(wb.y), bfhi(wa.y) + bfhi(wb.y), bflo(wa.z) + bflo(wb.z), bfhi(wa.z) + bfhi(wb.z), bflo(wa.w) + bflo(wb.w), bfhi(wa.w) + bfhi(wb.w)};
        float ss = 0.f;
#pragma unroll
        for (int i = 0; i < 8; ++i) ss += o[i] * o[i];
        ss = row16_sum(ss);
        const float rstd = 1.0f / sqrtf(ss * (1.0f / 128.0f) + EPS);
        const u32x4 wg = *(const u32x4*)(P + (size_t)m * NIN + PC_G + c0);
        const float g[8] = {bflo(wg.x), bfhi(wg.x), bflo(wg.y), bfhi(wg.y), bflo(wg.z), bfhi(wg.z), bflo(wg.w), bfhi(wg.w)};
        const f32x4 n0 = *(const f32x4*)(a->in[I_GLANORM] + l * 512 + c0), n1 = *(const f32x4*)(a->in[I_GLANORM] + l * 512 + c0 + 4);
        float r[8];
#pragma unroll
        for (int i = 0; i < 8; ++i) r[i] = o[i] * rstd * (i < 4 ? n0[i] : n1[i - 4]) * silu_f(g[i]);
        u32x4 w; w.x = pk2(r[0], r[1]); w.y = pk2(r[2], r[3]); w.z = pk2(r[4], r[5]); w.w = pk2(r[6], r[7]);
        *(u32x4*)(MIX + (size_t)m * D + c0) = w;
    }
}

__device__ __forceinline__ void n2_route_phase(const Frame& F, const CAS Args* a, int l, bool do_route, int cset) {
    unsigned char* ws = F.ws;
    const float* mod = (const float*)(ws + WS_MOD);
    bf16* H = (bf16*)(ws + WS_H);
    unsigned* cnt = (unsigned*)(ws + WS_CTL) + CW_CNT + cset * NE * CNT_STRIDE;
    unsigned* list = (unsigned*)(ws + WS_LIST); float* listw = (float*)(ws + WS_LISTW);
    LAS float* wrt = (LAS float*)F.lds;
    for (int i = F.tid; i < D * NE; i += NWAVES * 64) wrt[(i & 15) * D + (i >> 4)] = a->in[I_WROUTER][i];
    __syncthreads();
    const int rows = (l == 0) ? TT : TL;
    constexpr int RT_PER_WAVE = 20;
    LAS unsigned* lcnt = (LAS unsigned*)(F.lds + 65536); LAS unsigned* lbase = lcnt + 16; LAS unsigned* rec = lcnt + 64;
    if (F.tid < 32) lcnt[F.tid] = 0u;
    __syncthreads();
    int it = 0;
    for (int m = F.gw; m < rows; m += F.NGW, ++it) {
        const int v = m < TL ? (m >> 13) : 2;
        const float* xrow = m < TL ? F.out + (size_t)m * D : (const float*)(ws + WS_XC) + (size_t)(m - TL) * D;
        f32x4 x[4]; float ss = 0.f;
#pragma unroll
        for (int j = 0; j < 4; ++j) { x[j] = *(const f32x4*)(xrow + 4 * F.lane + 256 * j); ss += (x[j][0] * x[j][0] + x[j][1] * x[j][1]) + (x[j][2] * x[j][2] + x[j][3] * x[j][3]); }
        const float rstd = 1.0f / sqrtf(wave_sum(ss) * (1.0f / D) + EPS);
        float lg[NE];
#pragma unroll
        for (int e = 0; e < NE; ++e) lg[e] = 0.f;
#pragma unroll
        for (int j = 0; j < 4; ++j) {
            const int col = 4 * F.lane + 256 * j;
            const f32x4 nw = *(const f32x4*)(a->in[I_NORM2] + l * D + col);
            const f32x4 sh = *(const f32x4*)(mod + (l * 3 + v) * 6144 + 3 * D + col);
            const f32x4 sc = *(const f32x4*)(mod + (l * 3 + v) * 6144 + 4 * D + col);
            const f32x4 h = x[j] * rstd * nw * (1.0f + sc) + sh;
            u32x2 o; o.x = pk2(h[0], h[1]); o.y = pk2(h[2], h[3]);
            *(u32x2*)(H + (size_t)m * D + col) = o;
#pragma unroll
            for (int e = 0; e < NE; ++e) { const f32x4 w = *(const LAS f32x4*)(wrt + e * D + col); lg[e] += (h[0] * w[0] + h[1] * w[1]) + (h[2] * w[2] + h[3] * w[3]); if ((e & 3) == 3) asm volatile("" ::: "memory"); }
        }
#pragma unroll
        for (int e = 0; e < NE; ++e) lg[e] = wave_sum(lg[e]);
        float s[NE], sb[NE];
#pragma unroll
        for (int e = 0; e < NE; ++e) { s[e] = 1.0f / (1.0f + expf(-lg[e])); sb[e] = s[e] + a->in[I_BROUTER][e]; }
        int gsel = 0; float gbest = -1e30f;
#pragma unroll
        for (int g = 0; g < 4; ++g) {
            float m1 = -1e30f, m2 = -1e30f;
#pragma unroll
            for (int i = 0; i < 4; ++i) { const float val = sb[4 * g + i]; if (val > m1) { m2 = m1; m1 = val; } else if (val > m2) m2 = val; }
            const float gs = m1 + m2; if (gs > gbest) { gbest = gs; gsel = g; }
        }
        int e0 = 0, e1 = 0; float b0 = -1e30f, b1 = -1e30f, s0 = 0.f, s1 = 0.f;
#pragma unroll
        for (int e = 0; e < NE; ++e) {
            if ((e >> 2) == gsel) { const float val = sb[e];
                if (val > b0) { b1 = b0; e1 = e0; s1 = s0; b0 = val; e0 = e; s0 = s[e]; } else if (val > b1) { b1 = val; e1 = e; s1 = s[e]; } }
        }
        if (F.lane == 0 && do_route && it >= RT_PER_WAVE) {
            const float inv = 1.0f / (s0 + s1);
            const unsigned p0 = atomicAdd(cnt + e0 * CNT_STRIDE, 1u); list[(size_t)e0 * LISTCAP + p0] = (unsigned)m * 2u; listw[(size_t)e0 * LISTCAP + p0] = s0 * inv;
            const unsigned p1 = atomicAdd(cnt + e1 * CNT_STRIDE, 1u); list[(size_t)e1 * LISTCAP + p1] = (unsigned)m * 2u + 1u; listw[(size_t)e1 * LISTCAP + p1] = s1 * inv;
        } else
        if (F.lane == 0 && do_route) {
            const float inv = 1.0f / (s0 + s1);
            const int slot = F.wave * RT_PER_WAVE + it;
            const unsigned l0 = atomicAdd((unsigned*)(lcnt + e0), 1u), l1 = atomicAdd((unsigned*)(lcnt + e1), 1u);
            rec[slot * 4 + 0] = (unsigned)m; rec[slot * 4 + 1] = (unsigned)e0 | ((unsigned)e1 << 8) | (l0 << 16) | (l1 << 24);
            rec[slot * 4 + 2] = __float_as_uint(s0 * inv); rec[slot * 4 + 3] = __float_as_uint(s1 * inv);
        }
    }
    __syncthreads();
    if (do_route) {
        if (F.tid < NE) { const unsigned c = lcnt[F.tid]; lbase[F.tid] = c ? atomicAdd(cnt + F.tid * CNT_STRIDE, c) : 0u; }
        __syncthreads();
        for (int i = F.tid; i < NWAVES * RT_PER_WAVE; i += NWAVES * 64) {
            const int wv = i / RT_PER_WAVE, k = i % RT_PER_WAVE;
            if (F.vcu * NWAVES + wv + k * F.NGW < rows) {
                const unsigned m = rec[i * 4], pk = rec[i * 4 + 1]; const unsigned e0 = pk & 255u, e1 = (pk >> 8) & 255u, l0 = (pk >> 16) & 255u, l1 = pk >> 24;
                const unsigned p0 = lbase[e0] + l0, p1 = lbase[e1] + l1;
                list[(size_t)e0 * LISTCAP + p0] = m * 2u; listw[(size_t)e0 * LISTCAP + p0] = __uint_as_float(rec[i * 4 + 2]);
                list[(size_t)e1 * LISTCAP + p1] = m * 2u + 1u; listw[(size_t)e1 * LISTCAP + p1] = __uint_as_float(rec[i * 4 + 3]);
            }
        }
    }
    __syncthreads();
}

__device__ __forceinline__ void moe_setup(pg8::MoeOrder& S, const Frame& F, int cset, int nN) {
    unsigned* cnt = (unsigned*)(F.ws + WS_CTL) + CW_CNT + cset * NE * CNT_STRIDE;
    LAS int* tab = (LAS int*)(F.lds + MISC_OFF + 64);
    __syncthreads();
    if (F.tid == 0) { int run = 0;
        for (int e = 0; e < NE; ++e) { const int c = (int)__hip_atomic_load(cnt + e * CNT_STRIDE, __ATOMIC_RELAXED, __HIP_MEMORY_SCOPE_AGENT); tab[e] = c; run += (c + 255) >> 8; tab[16 + e] = run; } }
    __syncthreads();
    S.tab = tab; S.nN = nN; S.nunits = __builtin_amdgcn_readfirstlane(tab[31]) * nN; S.G = F.G; S.c = (int)blockIdx.x;
    S.list = (const unsigned*)(F.ws + WS_LIST);
}
__device__ __forceinline__ void moe1_phase(const Frame& F, const CAS Args* a, int l, int cset) {
    pg8::MoeOrder S; moe_setup(S, F, cset, 4);
    S.A = (const char*)(F.ws + WS_H); S.Bt = (const char*)(F.ws + WS_WGU) + (size_t)l * NE * D * D * 2; S.K = D; S.bstride_e = (size_t)D * D * 2; S.gather = true;
    EpiGU E{(bf16*)(F.ws + WS_HMID)};
    pg8::gemm_phase<EpiGU, pg8::MoeOrder>(F.lds, F.tid, S, E);
}
__device__ __forceinline__ void moe2_phase(const Frame& F, const CAS Args* a, int l, int cset) {
    pg8::MoeOrder S; moe_setup(S, F, cset, 4);
    S.A = (const char*)(F.ws + WS_HMID); S.Bt = (const char*)(F.ws + WS_WD) + (size_t)l * NE * D * DE * 2; S.K = DE; S.bstride_e = (size_t)D * DE * 2; S.gather = false;
    EpiDown E; E.Y = (bf16*)(F.ws + WS_Y); E.list = (const unsigned*)(F.ws + WS_LIST); E.listw = (const float*)(F.ws + WS_LISTW); E.tab = S.tab;
    pg8::gemm_phase<EpiDown, pg8::MoeOrder>(F.lds, F.tid, S, E);
}

__device__ __forceinline__ void final_phase(const Frame& F, const CAS Args* a) {
    const float* mod = (const float*)(F.ws + WS_MOD);
    const bf16* Y0 = (const bf16*)(F.ws + WS_Y); const bf16* Y1 = Y0 + (size_t)TT * D;
    for (int m = F.gw; m < TL; m += F.NGW) {
        const int v = m >> 13; float* xrow = F.out + (size_t)m * D;
        f32x4 x[4]; float ss = 0.f;
#pragma unroll
        for (int j = 0; j < 4; ++j) {
            const int col = 4 * F.lane + 256 * j;
            const f32x4 g2 = *(const f32x4*)(mod + (3 + v) * 6144 + 5 * D + col);
            const f32x4 y = ld_y4(Y0 + (size_t)m * D + col) + ld_y4(Y1 + (size_t)m * D + col);
            x[j] = *(const f32x4*)(xrow + col) + g2 * y;
            ss += (x[j][0] * x[j][0] + x[j][1] * x[j][1]) + (x[j][2] * x[j][2] + x[j][3] * x[j][3]);
        }
        const float rstd = 1.0f / sqrtf(wave_sum(ss) * (1.0f / D) + EPS);
#pragma unroll
        for (int j = 0; j < 4; ++j) { const int col = 4 * F.lane + 256 * j; const f32x4 nw = *(const f32x4*)(a->in[I_FNORM] + col); *(f32x4*)(xrow + col) = x[j] * rstd * nw; }
    }
}

#ifndef NPASS
#define NPASS 1
#endif
#ifndef PROBE_PH
#define PROBE_PH -1
#endif
#ifndef PROBE_R
#define PROBE_R 3
#endif
constexpr int PH_PER_LAYER = 9;
constexpr int N_PHASES = 1 + DEPTH * PH_PER_LAYER + 1;

template <int ph0>
__device__ __forceinline__ void do_phase(Frame& F, XcdBarrier& bar, LAS unsigned char* lds, int lo, int hi) {
    constexpr int ph = ph0 % N_PHASES, pass = ph0 / N_PHASES;
    if (!(lo <= ph && ph < hi)) return;
    if (pass == 1 && ph != PROBE_PH) return;
    const CAS Args* ap;
        { int l_; asm volatile("v_mbcnt_lo_u32_b32 %0, -1, 0\n\tv_mbcnt_hi_u32_b32 %0, -1, %0" : "=v"(l_)); F.lane = l_; F.tid = F.wave * 64 + l_; ap = (const CAS Args*)__builtin_amdgcn_kernarg_segment_ptr(); asm volatile("" : "+s"(ap)); F.ws = ap->ws; F.out = (pass == 1) ? (float*)(ap->ws + WS_P) : ap->out;
          LAS unsigned char* lb_ = (LAS unsigned char*)lds; asm volatile("" : "+s"(lb_)); __builtin_assume((((unsigned)(__UINTPTR_TYPE__)lb_) & 1023u) == 0u); F.lds = lb_;
          bar.bar = (unsigned*)(F.ws + WS_CTL) + CW_BAR; bar.st = (volatile LAS unsigned*)(F.lds + MISC_OFF) + 8; }
        if (ph == 0) { if (PH_ON(10)) REP(10, true) p0_prologue(F, ap); }
        else if (ph == N_PHASES - 1) { if (PH_ON(11)) REP(11, false) final_phase(F, ap); }
        else {
            const int l = (ph - 1) / PH_PER_LAYER, s = (ph - 1) % PH_PER_LAYER;
            unsigned char* ws = F.ws;
            if (s == 0) { if (PH_ON(0)) REP(0, l == 0) n1_phase(F, ap, l); }
            else if (s == 1 && PH_ON(1)) REP(1, true) {
                pg8::DenseOrder S; S.init(ws + WS_H, ws + WS_WIN + (size_t)l * NIN * D * 2, TT, NIN, D, F.G, (int)blockIdx.x);
                EpiIn E{(bf16*)(ws + WS_P), ap->in[I_BIASF] + l * 256, ap->in[I_BIASB] + l * 256, (const float*)(ws + WS_ROPE), (const float*)(ws + WS_ROPE) + 2048};
                pg8::gemm_phase<EpiIn, pg8::DenseOrder>(F.lds, F.tid, S, E);
            }
            else if (s == 2) { if (PH_ON(2)) REP(2, true) swa_flash(F, ap, l); if (PH_ON(12)) REP(12, true) gla_g1(F, l); }
            else if (s == 3) { if (PH_ON(13)) REP(13, true) gla_scan(F); }
            else if (s == 4) { if (PH_ON(3)) REP(3, true) gla_g3(F, ap, l); }
            else if (s == 5 && PH_ON(4)) REP(4, l == 0) {
                pg8::DenseOrder S; S.init(ws + WS_MIX, ws + WS_WOUT + (size_t)l * D * D * 2, l == 0 ? TT : TL, D, D, F.G, (int)blockIdx.x);
                EpiOut E{l == 0 ? ap->in[I_X] : F.out, l == 0 ? ap->in[I_CTX] : (const float*)(ws + WS_XC), F.out, (float*)(ws + WS_XC), (const float*)(ws + WS_MOD) + l * 3 * 6144};
                pg8::gemm_phase<EpiOut, pg8::DenseOrder>(F.lds, F.tid, S, E);
            }
            else if (s == 6) { if (PH_ON(5)) REP(5, true) n2_route_phase(F, ap, l, rep_ == 0 || pass == 1, l + 2 * pass); }
            else if (s == 7) { if (PH_ON(6)) REP(6, true) moe1_phase(F, ap, l, l); }
            else { if (PH_ON(7)) REP(7, true) moe2_phase(F, ap, l, l); }
        }
        if (ph0 + 1 < NPASS * N_PHASES) for (int rb_ = 0; rb_ < (REPEAT_S == 20 ? REPEAT_N : 1); ++rb_) xcd_barrier(bar, F.tid);
}
template <int... I>
__device__ __forceinline__ void run_all(Frame& F, XcdBarrier& bar, LAS unsigned char* lds, int lo, int hi, std::integer_sequence<int, I...>) { (do_phase<I>(F, bar, lds, lo, hi), ...); }

#ifdef VGPR_CAP
__attribute__((amdgpu_num_vgpr(VGPR_CAP)))
#endif
__global__ void __launch_bounds__(NWAVES * 64, 2) mk_fwd(Args args) {
    extern __shared__ __attribute__((aligned(16))) unsigned char lds[];
    Frame F;
    F.lds = (LAS unsigned char*)lds;
    F.tid = threadIdx.x; F.lane = F.tid & 63; F.wave = __builtin_amdgcn_readfirstlane(F.tid >> 6);
    F.G = gridDim.x; { const int bx = blockIdx.x; F.vcu = (F.G % 8 == 0) ? (bx % 8) * (F.G / 8) + bx / 8 : bx; }
    F.gw = F.vcu * NWAVES + F.wave; F.NGW = F.G * NWAVES;
    const CAS Args* ap = (const CAS Args*)__builtin_amdgcn_kernarg_segment_ptr();
    F.ws = ap->ws; F.out = ap->out;
    volatile LAS unsigned* MISC = (volatile LAS unsigned*)(F.lds + MISC_OFF);
    for (int u = F.tid; u < (LDS_BYTES - LDSCTL_OFF) / 4; u += NWAVES * 64) ((LAS unsigned*)(F.lds + LDSCTL_OFF))[u] = 0u;
    __syncthreads();
    XcdBarrier bar; bar.bar = (unsigned*)(F.ws + WS_CTL) + CW_BAR; bar.x = 0; bar.st = nullptr;
    const bool fused = (ap->ph_hi - ap->ph_lo) > 1;
    if (fused) bar = xcd_barrier_post((unsigned*)(F.ws + WS_CTL) + CW_BAR, MISC + 8);
    const int lo = ap->ph_lo, hi = ap->ph_hi;
    run_all(F, bar, (LAS unsigned char*)lds, lo, hi, std::make_integer_sequence<int, NPASS * N_PHASES>{});
}

extern "C" void kernel_launch(void* const* d_in, const int* in_sizes, int n_in, void* d_out, int out_size, void* d_ws, size_t ws_size, hipStream_t stream) {
    static int grid = 0;
    if (grid == 0) {
        if (n_in != 22 || out_size != TL * D || ws_size < WS_END) { fprintf(stderr, "kernel_launch: unexpected shapes (n_in %d out %d ws %zu)\n", n_in, out_size, ws_size); grid = -1; return; }
        int dev = 0, cus = 0, per_cu = 0;
        if (hipGetDevice(&dev) != hipSuccess || hipDeviceGetAttribute(&cus, hipDeviceAttributeMultiprocessorCount, dev) != hipSuccess) { grid = -1; return; }
        if (hipFuncSetAttribute((const void*)mk_fwd, hipFuncAttributeMaxDynamicSharedMemorySize, LDS_BYTES) != hipSuccess) { fprintf(stderr, "kernel_launch: hipFuncSetAttribute failed\n"); grid = -1; return; }
        if (hipOccupancyMaxActiveBlocksPerMultiprocessor(&per_cu, (const void*)mk_fwd, NWAVES * 64, LDS_BYTES) != hipSuccess || per_cu < 1) fprintf(stderr, "kernel_launch: occupancy query says %d\n", per_cu);
        (void)hipGetLastError();
        grid = cus;
    }
    if (grid < 0) return;
    (void)hipMemsetAsync((char*)d_ws + WS_CTL, 0, CTL_ZERO_BYTES, stream);
    Args a{};
    for (int i = 0; i < 22; ++i) a.in[i] = (const float*)d_in[i];
    a.out = (float*)d_out; a.ws = (unsigned char*)d_ws; a.li = 0; a.pad = 0;
#if MK_N_LAUNCHES == 1
    a.ph_lo = 0; a.ph_hi = N_PHASES;
    hipLaunchKernelGGL(mk_fwd, dim3(grid), dim3(NWAVES * 64), LDS_BYTES, stream, a);
#else
    for (int ph = 0; ph < N_PHASES; ++ph) { a.ph_lo = ph; a.ph_hi = ph + 1; hipLaunchKernelGGL(mk_fwd, dim3(grid), dim3(NWAVES * 64), LDS_BYTES, stream, a); }
#endif
}
```

```cpp
#include <hip/hip_runtime.h>
#include <cstdio>
#include <cstdint>
#include <utility>

#ifndef ONLY_S
#define ONLY_S -1
#endif
#define PH_ON(k) (ONLY_S < 0 || ONLY_S == (k))
#ifndef REPEAT_S
#define REPEAT_S -1
#endif
#ifndef REPEAT_N
#define REPEAT_N 4
#endif
#define REP(k, cond) for (int rep_ = 0; rep_ < ((pass == 1) ? PROBE_R : ((REPEAT_S == (k) && (cond)) ? REPEAT_N : 1)); ++rep_)
#ifndef MK_N_LAUNCHES
#define MK_N_LAUNCHES 1
#endif

#define GAS __attribute__((address_space(1)))
#define LAS __attribute__((address_space(3)))
#define CAS __attribute__((address_space(4)))
typedef unsigned short bf16;
typedef short bf16x8 __attribute__((ext_vector_type(8)));
typedef float f32x4 __attribute__((ext_vector_type(4)));
typedef float f32x2 __attribute__((ext_vector_type(2)));
typedef unsigned u32x4 __attribute__((ext_vector_type(4)));
typedef unsigned u32x2 __attribute__((ext_vector_type(2)));

constexpr int D = 1024, SEQ = 8192, LC = 256, TL = 16384, TC = 512, TT = TL + TC, DEPTH = 2;
constexpr int NE = 16, DE = 512;
constexpr int NIN = 2816;
constexpr int PC_Q = 0, PC_K = 256, PC_V = 512, PC_G = 1024, PC_SQ = 1536, PC_SK = 2048, PC_SV = 2176, PC_GF = 2304, PC_GB = 2560;
constexpr int WIN_COLS = 2336;
constexpr float EPS = 1e-6f;
constexpr float LOG2E = 1.4426950408889634f, QSCALE = 0.125f * LOG2E;
constexpr int LISTCAP = TT;

constexpr size_t MiB = 1u << 20;
constexpr size_t WS_CTL = 0, CTL_ZERO_BYTES = 65536;
constexpr size_t WS_MOD = 1 * MiB;
constexpr size_t WS_ROPE = 1 * MiB + 256 * 1024;
constexpr size_t WS_LIST = 2 * MiB;
constexpr size_t WS_LISTW = 2 * MiB + 1536 * 1024;
constexpr size_t WS_XC = 5 * MiB;
constexpr size_t WS_WIN = 8 * MiB;
constexpr size_t WS_WOUT = 19 * MiB;
constexpr size_t WS_WGU = 23 * MiB;
constexpr size_t WS_WD = 87 * MiB;
constexpr size_t WS_H = 119 * MiB;
constexpr size_t WS_P = 152 * MiB;
constexpr size_t WS_MIX = 243 * MiB;
constexpr size_t WS_GL = 276 * MiB;
constexpr size_t WS_HMID = 152 * MiB;
constexpr size_t WS_Y = 190 * MiB;
constexpr size_t WS_END = 309 * MiB;
static_assert(WS_LIST + (size_t)NE * LISTCAP * 4 <= WS_LISTW && WS_LISTW + (size_t)NE * LISTCAP * 4 <= WS_XC, "ws map");
static_assert(WS_P + (size_t)TT * NIN * 2 <= WS_MIX && WS_MIX + (size_t)TT * D * 2 <= WS_GL, "ws map");
static_assert(WS_HMID + (size_t)37888 * 512 * 2 <= WS_Y && WS_Y + (size_t)2 * TT * D * 2 <= WS_GL, "ws map");
constexpr int CW_CNT = 8192, CNT_STRIDE = 64;
constexpr int CW_BAR = 4096;

__device__ __forceinline__ unsigned f2bf(float f) { unsigned u = __builtin_bit_cast(unsigned, f); return (u + 0x7fffu + ((u >> 16) & 1u)) >> 16; }
__device__ __forceinline__ unsigned pk2(float lo, float hi) { return f2bf(lo) | (f2bf(hi) << 16); }
__device__ __forceinline__ float bf2f(unsigned h) { return __builtin_bit_cast(float, h << 16); }
__device__ __forceinline__ float bflo(unsigned w) { return __builtin_bit_cast(float, w << 16); }
__device__ __forceinline__ float bfhi(unsigned w) { return __builtin_bit_cast(float, w & 0xffff0000u); }
__device__ __forceinline__ float dpp_add(float v, float t) { return v + t; }
#define DPP_F(v, ctrl, rmask) __builtin_bit_cast(float, __builtin_amdgcn_update_dpp(0, __builtin_bit_cast(int, (v)), (ctrl), (rmask), 0xF, false))
__device__ __forceinline__ float row16_sum(float v) {
    v += DPP_F(v, 0xB1, 0xF); v += DPP_F(v, 0x4E, 0xF); v += DPP_F(v, 0x141, 0xF); v += DPP_F(v, 0x140, 0xF); return v;
}
__device__ __forceinline__ float wave_sum(float v) {
    v = row16_sum(v);
    v += DPP_F(v, 0x142, 0xA); v += DPP_F(v, 0x143, 0xC);
    return __builtin_bit_cast(float, __builtin_amdgcn_readlane(__builtin_bit_cast(int, v), 63));
}
__device__ __forceinline__ float silu_f(float x) { return x / (1.0f + __expf(-x)); }
#define LDS_WAIT() asm volatile("s_waitcnt lgkmcnt(0)" ::: "memory")
#define VM_WAIT() asm volatile("s_waitcnt vmcnt(0)" ::: "memory")

namespace pg8 {
constexpr int BM = 256, BK = 64, HALF = 128, HTB = HALF * BK * 2, STAGE_BYTES = 8 * HTB, NXCD = 8, WGM = 8;
__host__ __device__ __forceinline__ int lds_byte(int r, int c) { const int st = (r >> 4) * 2 + (c >> 5), rr = r & 15, cc = c & 31, ob = rr * 64 + cc * 2; return st * 1024 + (ob ^ (((ob >> 9) & 1) << 5)); }
__host__ __device__ __forceinline__ void stage_rc(int b, int& R, int& C) { const int st = b / 1024, sb = b % 1024, swz = sb ^ (((sb >> 9) & 1) << 5); R = (st >> 1) * 16 + swz / 64; C = (st & 1) * 32 + (swz % 64) / 2; }
__host__ __device__ __forceinline__ int perm32(int rho) { const int n = rho >> 4, i = rho & 15; return 8 * (i >> 2) + 4 * n + (i & 3); }

struct Unit { int pm, pn, e, mt; };

__device__ __forceinline__ int xcd_remap(int wgid, int nwg) { const int q = nwg / NXCD, r = nwg % NXCD, xcd = wgid % NXCD, off = wgid / NXCD; return (xcd < r ? xcd * (q + 1) : r * (q + 1) + (xcd - r) * q) + off; }

struct DenseOrder {
    static constexpr bool DYN_A = false;
    const char* A; const char* Bt; int K; int nM, nN, nwg, G, c;
    __device__ void init(const void* A_, const void* Bt_, int M, int N, int K_, int G_, int c_) { A = (const char*)A_; Bt = (const char*)Bt_; K = K_; nM = M / BM; nN = N / BM; nwg = nM * nN; G = G_; c = c_; }
    __device__ __forceinline__ bool next(int i, Unit& u) const {
        const long L = (long)i * G + c; if (L >= nwg) return false;
        const int wgid = xcd_remap((int)L, nwg);
        const int nig = WGM * nN, gid = wgid / nig, fm = gid * WGM, gsz = (nM - fm) < WGM ? (nM - fm) : WGM;
        u.pm = fm + ((wgid % nig) % gsz); u.pn = (wgid % nig) / gsz; u.e = 0; u.mt = 0; return true;
    }
    __device__ __forceinline__ const char* a_ptr(const Unit& u) const { return A + (size_t)u.pm * (size_t)(BM * K * 2); }
    __device__ __forceinline__ const char* b_ptr(const Unit& u) const { return Bt + (size_t)u.pn * (size_t)(BM * K * 2); }
    __device__ __forceinline__ void a_voff(const Unit&, const int (&R)[2], const int (&C)[2], unsigned (&v0)[2], unsigned (&v1)[2]) const {
#pragma unroll
        for (int i = 0; i < 2; ++i) { v0[i] = (unsigned)(R[i] * K + C[i]) * 2u; v1[i] = v0[i] + (unsigned)(HALF * K * 2); }
    }
};

struct MoeOrder {
    static constexpr bool DYN_A = true;
    const char* A; const char* Bt; int K; size_t bstride_e; int G, c, nunits, nN; bool gather;
    const unsigned* list; const LAS int* tab;
    __device__ __forceinline__ bool next(int i, Unit& u) const {
        const long L = (long)i * G + c; if (L >= nunits) return false;
        const int wgid = xcd_remap((int)L, nunits);
        const int tl = wgid / nN; u.pn = wgid % nN;
        int e = 0, tstart = 0;
#pragma unroll 1
        for (int k = 0; k < NE - 1; ++k) { const int te = tab[16 + k]; if (tl >= te) { e = k + 1; tstart = te; } }
        u.e = __builtin_amdgcn_readfirstlane(e); u.mt = __builtin_amdgcn_readfirstlane(tl - tstart); u.pm = tl; return true;
    }
    __device__ __forceinline__ const char* a_ptr(const Unit& u) const { return gather ? A : A + (size_t)u.pm * (size_t)(BM * K * 2); }
    __device__ __forceinline__ const char* b_ptr(const Unit& u) const { return Bt + (size_t)u.e * bstride_e + (size_t)u.pn * (size_t)(BM * K * 2); }
    __device__ __forceinline__ void a_voff(const Unit& u, const int (&R)[2], const int (&C)[2], unsigned (&v0)[2], unsigned (&v1)[2]) const {
        if (gather) {
            const int ce = tab[u.e];
            const unsigned* lp = list + (size_t)u.e * LISTCAP + u.mt * BM;
#pragma unroll
            for (int i = 0; i < 2; ++i) {
                const int r0 = R[i], r1 = R[i] + HALF;
                const unsigned t0 = (u.mt * BM + r0 < ce) ? (__builtin_nontemporal_load(lp + r0) >> 1) : 0u;
                const unsigned t1 = (u.mt * BM + r1 < ce) ? (__builtin_nontemporal_load(lp + r1) >> 1) : 0u;
                v0[i] = (t0 * (unsigned)K + (unsigned)C[i]) * 2u; v1[i] = (t1 * (unsigned)K + (unsigned)C[i]) * 2u;
            }
        } else {
#pragma unroll
            for (int i = 0; i < 2; ++i) { v0[i] = (unsigned)(R[i] * K + C[i]) * 2u; v1[i] = v0[i] + (unsigned)(HALF * K * 2); }
        }
    }
};

__device__ __forceinline__ unsigned cvt_pk_bf16(float lo, float hi) { unsigned r; asm volatile("v_cvt_pk_bf16_f32 %0, %1, %2" : "=v"(r) : "v"(lo), "v"(hi)); return r; }

template <class Epi, class Sched>
__device__ __forceinline__ void gemm_phase(LAS unsigned char* lds, int tid, const Sched& S, const Epi& E) {
    const int wid = __builtin_amdgcn_readfirstlane(tid >> 6), lane = tid & 63, wr = wid >> 2, wc = wid & 3, fr = lane & 15, fq = lane >> 4;
    const int K = S.K, nt = K / BK;
    int Rr[2], Cc[2]; unsigned voffB[2];
#pragma unroll
    for (int i = 0; i < 2; ++i) { int R, C; stage_rc(tid * 16 + i * 8192, R, C); const int Rb = Epi::PERM ? ((R & ~31) + perm32(R & 31)) : R;
        Rr[i] = R; Cc[i] = C; voffB[i] = (unsigned)(Rb * K + C) * 2u; }
    const size_t kstep = (size_t)(BK * 2);
    const size_t hstep = (size_t)HALF * K * 2;
    const unsigned ldsw = (unsigned)wid * 1024u;
    const int aoff = lds_byte(wr * 64 + fr, fq * 8), boff = lds_byte(wc * 32 + fr, fq * 8);
#define PG8_SA(b, h) (((b) * 2 + (h)) * HTB)
#define PG8_SB(b, h) ((4 + (b) * 2 + (h)) * HTB)
#define PG8_STAGE(bufoff, gbase, voff) do { _Pragma("unroll") for (int _i = 0; _i < 2; ++_i) \
        __builtin_amdgcn_global_load_lds((const unsigned*)((const char*)(gbase) + (voff)[_i]), (LAS unsigned*)(lds + (bufoff) + ldsw + _i * 8192), 16, 0, 0); } while (0)
#define PG8_LDA(dst, b, h) do { _Pragma("unroll") for (int m = 0; m < 4; ++m) _Pragma("unroll") for (int k = 0; k < 2; ++k) dst[m][k] = *(const LAS bf16x8*)(lds + PG8_SA(b, h) + aoff + m * 2048 + k * 1024); } while (0)
#define PG8_LDB(dst, b, h) do { _Pragma("unroll") for (int n = 0; n < 2; ++n) _Pragma("unroll") for (int k = 0; k < 2; ++k) dst[n][k] = *(const LAS bf16x8*)(lds + PG8_SB(b, h) + boff + n * 2048 + k * 1024); } while (0)
#define PG8_MMA(ai, bj, At, Bt) do { __builtin_amdgcn_s_setprio(1); _Pragma("unroll") for (int m = 0; m < 4; ++m) _Pragma("unroll") for (int n = 0; n < 2; ++n) _Pragma("unroll") for (int k = 0; k < 2; ++k) \
        acc[ai][bj][m][n] = __builtin_amdgcn_mfma_f32_16x16x32_bf16(Bt[n][k], At[m][k], acc[ai][bj][m][n], 0, 0, 0); __builtin_amdgcn_s_setprio(0); } while (0)
#define PG8_WAIT_V(n) asm volatile("s_waitcnt vmcnt(" #n ")" ::: "memory")
#define PG8_WAIT_L(n) asm volatile("s_waitcnt lgkmcnt(" #n ")" ::: "memory")
#define PG8_BAR __builtin_amdgcn_s_barrier()
#define PG8_SCHED __builtin_amdgcn_sched_barrier(0)
    Unit cur, nxt; int ui = 0;
    if (!S.next(0, cur)) return;
    f32x4 acc[2][2][4][2];
#pragma unroll
    for (int a = 0; a < 2; ++a)
#pragma unroll
        for (int b = 0; b < 2; ++b)
#pragma unroll
            for (int m = 0; m < 4; ++m)
#pragma unroll
                for (int n = 0; n < 2; ++n) acc[a][b][m][n] = (f32x4){0.f, 0.f, 0.f, 0.f};
    bf16x8 At[4][2], B0[2][2], B1[2][2];
    const char* cA = S.a_ptr(cur); const char* cB = S.b_ptr(cur);
    unsigned cv0[2], cv1[2], nv0[2], nv1[2];
    S.a_voff(cur, Rr, Cc, cv0, cv1);
    PG8_STAGE(PG8_SB(0, 0), cB, voffB); PG8_STAGE(PG8_SB(0, 1), cB + hstep, voffB); PG8_STAGE(PG8_SA(0, 0), cA, cv0); PG8_STAGE(PG8_SA(0, 1), cA, cv1);
    if (wr == 1) PG8_BAR;
    PG8_WAIT_V(2); PG8_BAR;
    PG8_STAGE(PG8_SB(1, 0), cB + kstep, voffB); PG8_STAGE(PG8_SA(1, 0), cA + kstep, cv0); PG8_STAGE(PG8_SB(1, 1), cB + hstep + kstep, voffB);
    PG8_WAIT_V(6); PG8_BAR;
    for (;;) {
        const bool has_next = S.next(ui + 1, nxt);
        const char* nA = has_next ? S.a_ptr(nxt) : cA; const char* nB = has_next ? S.b_ptr(nxt) : cB;
        if (has_next) S.a_voff(nxt, Rr, Cc, nv0, nv1); else { nv0[0] = cv0[0]; nv0[1] = cv0[1]; nv1[0] = cv1[0]; nv1[1] = cv1[1]; }
        if constexpr (Sched::DYN_A) asm volatile("" : "+v"(nv0[0]), "+v"(nv0[1]), "+v"(nv1[0]), "+v"(nv1[1]));
        for (int t = 0; t < nt; t += 2) {
            const bool last = (t == nt - 2);
            const char* a1 = cA + (size_t)(t + 1) * kstep;
            const char* a2 = last ? nA : cA + (size_t)(t + 2) * kstep; const char* b2 = last ? nB : cB + (size_t)(t + 2) * kstep;
            const char* a3 = a2 + kstep; const char* b3 = b2 + kstep;
            unsigned w0[2], w1[2];
            w0[0] = last ? nv0[0] : cv0[0]; w0[1] = last ? nv0[1] : cv0[1]; w1[0] = last ? nv1[0] : cv1[0]; w1[1] = last ? nv1[1] : cv1[1];
            PG8_LDB(B0, 0, 0); PG8_LDB(B1, 0, 1); PG8_SCHED; PG8_LDA(At, 0, 0); PG8_STAGE(PG8_SA(1, 1), a1, cv1);
            PG8_WAIT_V(8); PG8_WAIT_L(0); PG8_BAR; PG8_MMA(0, 0, At, B0); PG8_MMA(0, 1, At, B1); PG8_BAR; PG8_SCHED;
            PG8_LDA(At, 0, 1); PG8_STAGE(PG8_SB(0, 0), b2, voffB); PG8_STAGE(PG8_SB(0, 1), b2 + hstep, voffB); PG8_STAGE(PG8_SA(0, 0), a2, w0);
            PG8_WAIT_V(8); PG8_WAIT_L(0); PG8_BAR; PG8_MMA(1, 0, At, B0); PG8_MMA(1, 1, At, B1); PG8_BAR; PG8_SCHED;
            PG8_LDB(B0, 1, 0); PG8_LDB(B1, 1, 1); PG8_SCHED; PG8_LDA(At, 1, 0); PG8_STAGE(PG8_SA(0, 1), a2, w1);
            PG8_WAIT_V(8); PG8_WAIT_L(0); PG8_BAR; PG8_MMA(0, 0, At, B0); PG8_MMA(0, 1, At, B1); PG8_BAR; PG8_SCHED;
            PG8_LDA(At, 1, 1); PG8_STAGE(PG8_SB(1, 0), b3, voffB); PG8_STAGE(PG8_SB(1, 1), b3 + hstep, voffB); PG8_STAGE(PG8_SA(1, 0), a3, w0);
            PG8_WAIT_V(8); PG8_WAIT_L(0); PG8_BAR; PG8_MMA(1, 0, At, B0); PG8_MMA(1, 1, At, B1); PG8_BAR; PG8_SCHED;
        }
        if (wr == 0) PG8_BAR;
        E(acc, cur, wr, wc, fr, fq);
        if (!has_next) break;
#pragma unroll
        for (int a = 0; a < 2; ++a)
#pragma unroll
            for (int b = 0; b < 2; ++b)
#pragma unroll
                for (int m = 0; m < 4; ++m)
#pragma unroll
                    for (int n = 0; n < 2; ++n) acc[a][b][m][n] = (f32x4){0.f, 0.f, 0.f, 0.f};
        cur = nxt; cA = nA; cB = nB; ++ui;
        cv0[0] = nv0[0]; cv0[1] = nv0[1]; cv1[0] = nv1[0]; cv1[1] = nv1[1];
        if (wr == 1) PG8_BAR;
    }
    PG8_WAIT_V(0);
    PG8_BAR;
#undef PG8_SA
#undef PG8_SB
#undef PG8_STAGE
#undef PG8_LDA
#undef PG8_LDB
#undef PG8_MMA
#undef PG8_WAIT_V
#undef PG8_WAIT_L
#undef PG8_BAR
#undef PG8_SCHED
}
}

#define XB_TMO      128
#define XB_XCNT(j)  (256  + 64 * (j))
#define XB_XSUB(j)  (1280 + 64 * (j))
#define XB_XGEN(j)  (2304 + 64 * (j))
#define XB_TOP      3328
#define XB_TOPGEN   3392
#define XCD_BAR_WORDS 3456
#define XB_SPIN_CAP (1u << 18)
__device__ __forceinline__ unsigned xb_ld(unsigned* p)              { return __hip_atomic_load(p, __ATOMIC_RELAXED, __HIP_MEMORY_SCOPE_AGENT); }
__device__ __forceinline__ unsigned xb_add(unsigned* p, unsigned v) { return __hip_atomic_fetch_add(p, v, __ATOMIC_RELAXED, __HIP_MEMORY_SCOPE_AGENT); }
__device__ __forceinline__ unsigned xb_xcc_id() { return (unsigned)__builtin_amdgcn_s_getreg((3 << 11) | 20) & 0xFu; }
#define XB_SPIN(cond, bar) do { unsigned _sp = 0; while (cond) { __builtin_amdgcn_s_sleep(1); \
    if ((++_sp & 255u) == 0u) { if (xb_ld(&(bar)[XB_TMO])) break; if (_sp > XB_SPIN_CAP) { atomicAdd(&(bar)[XB_TMO], 1u); break; } } } } while (0)
struct XcdBarrier { unsigned* bar; unsigned x; volatile LAS unsigned* st; };
__device__ __forceinline__ XcdBarrier xcd_barrier_post(unsigned* bar, volatile LAS unsigned* st) {
    XcdBarrier b; b.bar = bar; b.x = xb_xcc_id(); b.st = st;
    if (threadIdx.x == 0) (void)xb_add(&bar[XB_XCNT(b.x)], 1u);
    return b;
}
__device__ __forceinline__ void xcd_barrier_complete(unsigned* bar, unsigned x, unsigned& nloc, unsigned& nx) {
    const unsigned G = gridDim.x * gridDim.y * gridDim.z;
    unsigned sum, cnt, mine, sp = 0u;
    for (;;) {
        sum = 0u; cnt = 0u; mine = 0u;
#pragma unroll
        for (unsigned j = 0; j < 16; ++j) { const unsigned c = xb_ld(&bar[XB_XCNT(j)]); sum += c; cnt += (c > 0u) ? 1u : 0u; mine = (j == x) ? c : mine; }
        if (sum == G) break;
        __builtin_amdgcn_s_sleep(1);
        if ((++sp & 255u) == 0u) { if (xb_ld(&bar[XB_TMO])) break; if (sp > XB_SPIN_CAP) { atomicAdd(&bar[XB_TMO], 1u); break; } }
    }
    nloc = mine > 0u ? mine : 1u; nx = cnt > 0u ? cnt : 1u;
}
__device__ __forceinline__ void xcd_barrier(const XcdBarrier& b, int tid) {
    asm volatile("s_waitcnt vmcnt(0)" ::: "memory");
    __syncthreads();
    if (tid == 0) {
        unsigned* bar = b.bar;
        __builtin_amdgcn_s_waitcnt(0);
        unsigned nloc = b.st[0], nx = b.st[1];
        if (nloc == 0u) { xcd_barrier_complete(bar, b.x, nloc, nx); b.st[0] = nloc; b.st[1] = nx; }
        const unsigned old = xb_add(&bar[XB_XSUB(b.x)], 1u);
        const unsigned gen = old / nloc;
        if (old + 1u == (gen + 1u) * nloc) {
            __builtin_amdgcn_fence(__ATOMIC_RELEASE, "agent");
            asm volatile("s_waitcnt vmcnt(0)" ::: "memory");
            const unsigned og = xb_add(&bar[XB_TOP], 1u);
            const unsigned tg = og / nx;
            if (og + 1u == (tg + 1u) * nx) xb_add(&bar[XB_TOPGEN], 1u);
            else XB_SPIN(xb_ld(&bar[XB_TOPGEN]) == tg, bar);
            __builtin_amdgcn_fence(__ATOMIC_ACQUIRE, "agent");
            xb_add(&bar[XB_XGEN(b.x)], 1u);
            asm volatile("s_waitcnt vmcnt(0)" ::: "memory");
        } else {
            XB_SPIN(xb_ld(&bar[XB_XGEN(b.x)]) == gen, bar);
            __builtin_amdgcn_fence(__ATOMIC_ACQUIRE, "agent");
            asm volatile("s_waitcnt vmcnt(0)" ::: "memory");
        }
    }
    __syncthreads();
}

constexpr int NWAVES = 8;
constexpr int RING_BYTES = 131072, LDSCTL_OFF = RING_BYTES, MISC_OFF = LDSCTL_OFF + 320, LDS_BYTES = 147456;
struct Args { const float* in[22]; float* out; unsigned char* ws; int ph_lo, ph_hi, li, pad; };
enum { I_X = 0, I_C, I_CTX, I_CCTX, I_WADA, I_BADA, I_NORM1, I_NORM2, I_WIN, I_UPF, I_BIASF, I_UPB, I_BIASB, I_GLANORM, I_SINK, I_WOUT, I_WROUTER, I_BROUTER, I_WGATE, I_WUP, I_WDOWN, I_FNORM };

struct Frame {
    LAS unsigned char* lds; int tid, lane, wave, vcu, G, gw, NGW;
    unsigned char* ws; float* out;
};

__device__ __forceinline__ int rope_pos(int d) { return 8 * ((d & 15) >> 2) + 4 * (d >> 4) + (d & 3); }
__device__ __forceinline__ int gu_row(int h, int gu) { return (h >> 7) * 256 + ((h >> 6) & 1) * 128 + ((h >> 4) & 3) * 32 + ((h >> 2) & 3) * 8 + gu * 4 + (h & 3); }
struct TItem { const float* src; bf16* dst; int N, Kd, n0, rbase, mode; bool ok; };
__device__ __forceinline__ void titem_load(const TItem& t, int lane, f32x4 (&v)[8]) {
    const int g = lane >> 3, i8 = lane & 7;
    const float* src = t.src + (size_t)(8 * g) * t.N + 4 * i8;
#pragma unroll
    for (int q = 0; q < 8; ++q) v[q] = *(const f32x4*)(src + (size_t)q * t.N);
}
__device__ __forceinline__ void titem_store(const TItem& t, int lane, const f32x4 (&v)[8]) {
    const int g = lane >> 3, i8 = lane & 7;
#pragma unroll
    for (int i = 0; i < 4; ++i) {
        u32x4 o; o.x = pk2(v[0][i], v[1][i]); o.y = pk2(v[2][i], v[3][i]); o.z = pk2(v[4][i], v[5][i]); o.w = pk2(v[6][i], v[7][i]);
        const int n = 4 * i8 + i;
        const int row = (t.mode == 0) ? t.rbase + n : (t.mode == 1) ? t.rbase + rope_pos(n) : gu_row(t.n0 + n, t.mode - 2);
        *(u32x4*)(t.dst + (size_t)row * t.Kd + 8 * g) = o;
    }
}
constexpr int IT_IN = 2 * 16 * 73, IT_OUT = 2 * 16 * 32, IT_G = 32 * 16 * 16, IT_D = 32 * 8 * 32, NITEMS = IT_IN + IT_OUT + 2 * IT_G + IT_D;
__device__ __forceinline__ TItem titem_decode(const CAS Args* a, unsigned char* ws, int it) {
    TItem t; t.ok = it < NITEMS; t.mode = 0; t.rbase = 0; t.n0 = 0; t.N = D; t.Kd = D; t.src = nullptr; t.dst = nullptr;
    if (!t.ok) return t;
    int r = it;
    if (r < IT_IN) {
        const int l = r / 1168, rr = r % 1168, kb = rr / 73, nb = rr % 73;
        if (nb == 48) { t.ok = false; return t; }
        const int n0 = nb * 32; t.n0 = n0;
        if (n0 < 1536) t.rbase = n0;
        else if (n0 < 2080) { t.rbase = PC_SQ + (n0 - 1568); t.mode = 1; }
        else if (n0 < 2208) { t.rbase = PC_SK + (n0 - 2080); t.mode = 1; }
        else t.rbase = PC_SV + (n0 - 2208);
        t.N = WIN_COLS; t.Kd = D; t.src = a->in[I_WIN] + (size_t)l * D * WIN_COLS + (size_t)(kb * 64) * WIN_COLS + n0; t.dst = (bf16*)(ws + WS_WIN) + (size_t)l * NIN * D + kb * 64;
        return t;
    }
    r -= IT_IN;
    if (r < IT_OUT) { const int l = r / 512, rr = r % 512, kb = rr / 32, nb = rr % 32;
        t.n0 = nb * 32; t.rbase = nb * 32; t.N = D; t.Kd = D; t.src = a->in[I_WOUT] + (size_t)l * D * D + (size_t)(kb * 64) * D + nb * 32; t.dst = (bf16*)(ws + WS_WOUT) + (size_t)l * D * D + kb * 64; return t; }
    r -= IT_OUT;
    if (r < 2 * IT_G) { const int gu = r / IT_G, r2 = r % IT_G, le = r2 / 256, rr = r2 % 256, kb = rr / 16, nb = rr % 16;
        t.n0 = nb * 32; t.mode = 2 + gu; t.N = DE; t.Kd = D; t.src = a->in[gu ? I_WUP : I_WGATE] + (size_t)le * D * DE + (size_t)(kb * 64) * DE + nb * 32; t.dst = (bf16*)(ws + WS_WGU) + (size_t)le * D * D + kb * 64; return t; }
    r -= 2 * IT_G;
    { const int le = r / 256, rr = r % 256, kb = rr / 32, nb = rr % 32;
        t.n0 = nb * 32; t.rbase = nb * 32; t.N = D; t.Kd = DE; t.src = a->in[I_WDOWN] + (size_t)le * DE * D + (size_t)(kb * 64) * D + nb * 32; t.dst = (bf16*)(ws + WS_WD) + (size_t)le * D * DE + kb * 64; }
    return t;
}

template <class Map>
__device__ __forceinline__ void convert_items(const Frame& F, const CAS Args* a, int n, int worker, int nworkers, Map map) {
    unsigned char* ws = F.ws;
    for (int i = worker; i < n; i += 2 * nworkers) {
        const int i2 = i + nworkers;
        const TItem ta = titem_decode(a, ws, map(i)), tb = titem_decode(a, ws, i2 < n ? map(i2) : NITEMS);
        f32x4 va[8], vb[8];
        if (ta.ok) titem_load(ta, F.lane, va);
        if (tb.ok) titem_load(tb, F.lane, vb);
        if (ta.ok) titem_store(ta, F.lane, va);
        if (tb.ok) titem_store(tb, F.lane, vb);
    }
}
struct MapSmall { __device__ __forceinline__ int operator()(int i) const { return i; } };
struct MapMoe { int l; __device__ __forceinline__ int operator()(int i) const { const int kind = i >> 12, r = i & 4095; return IT_IN + IT_OUT + (kind < 2 ? kind * IT_G : 2 * IT_G) + l * 4096 + r; } };
__device__ __forceinline__ void convert_moe_filler(const Frame& F, const CAS Args* a, int l, int nunits) {
    const int c = (int)blockIdx.x, nfull = nunits % F.G;
    if (nfull != 0 && c < nfull) return;
    const int first = nfull, nf = F.G - nfull;
    convert_items(F, a, 3 * 4096, (c - first) * NWAVES + F.wave, nf * NWAVES, MapMoe{l});
}

__device__ __forceinline__ void p0_prologue(const Frame& F, const CAS Args* a) {
    unsigned char* ws = F.ws;
    convert_items(F, a, IT_IN + IT_OUT, F.gw, F.NGW, MapSmall{});
    for (int idx = F.gw * 64 + F.lane; idx < 2 * 2 * 256 * 128; idx += F.NGW * 64) {
        const int kc = idx & 127, n = (idx >> 7) & 255, dir = (idx >> 15) & 1, l = idx >> 16;
        const float* up = a->in[dir ? I_UPB : I_UPF] + (size_t)l * 16 * 256 + n;
        float u[16];
#pragma unroll
        for (int r = 0; r < 16; ++r) u[r] = up[r * 256];
        float o[8];
#pragma unroll
        for (int kk = 0; kk < 8; ++kk) {
            const f32x4* wz = (const f32x4*)(a->in[I_WIN] + ((size_t)l * D + kc * 8 + kk) * WIN_COLS + 1536 + dir * 16);
            float s = 0.f;
#pragma unroll
            for (int q = 0; q < 4; ++q) { const f32x4 w = wz[q]; s += w[0] * u[4 * q] + w[1] * u[4 * q + 1] + w[2] * u[4 * q + 2] + w[3] * u[4 * q + 3]; }
            o[kk] = s;
        }
        u32x4 ov; ov.x = pk2(o[0], o[1]); ov.y = pk2(o[2], o[3]); ov.z = pk2(o[4], o[5]); ov.w = pk2(o[6], o[7]);
        *(u32x4*)((bf16*)(ws + WS_WIN) + ((size_t)l * NIN + PC_GF + dir * 256 + n) * D + kc * 8) = ov;
    }
    if (blockIdx.x == (unsigned)(F.G - 1)) {
        float* tc = (float*)(ws + WS_ROPE); float* tsn = tc + 2048;
        for (int i = F.tid; i < 2048; i += NWAVES * 64) { const int pos = i >> 4, j = i & 15; const float inv = powf(10000.0f, -(float)j * (1.0f / 16.0f)); const float ang = (float)pos * inv;
            tc[i] = cosf(ang); tsn[i] = sinf(ang); }
    }
    __syncthreads();
    {
        LAS float* cs = (LAS float*)F.lds; LAS float* red = cs + 3072;
        for (int i = F.tid; i < 3072; i += NWAVES * 64) { const int v = i >> 10, k = i & 1023; const float cv = v < 2 ? a->in[I_C][v * D + k] : a->in[I_CCTX][k]; cs[i] = cv / (1.0f + expf(-cv)); }
        __syncthreads();
        for (int u = blockIdx.x; u < 192; u += F.G) {
            const int l = u / 96, jg = u % 96, jl = F.tid & 63, ks = F.tid >> 6;
            const float* wp = a->in[I_WADA] + ((size_t)l * D + ks * 128) * 6144 + jg * 64 + jl;
            float a0 = 0.f, a1 = 0.f, a2 = 0.f;
#pragma unroll 1
            for (int k0 = 0; k0 < 128; k0 += 32) {
                float wv[32];
#pragma unroll
                for (int k = 0; k < 32; ++k) wv[k] = wp[(size_t)(k0 + k) * 6144];
#pragma unroll
                for (int k = 0; k < 32; ++k) { const int kk = ks * 128 + k0 + k; a0 += cs[kk] * wv[k]; a1 += cs[1024 + kk] * wv[k]; a2 += cs[2048 + kk] * wv[k]; }
            }
            red[(ks * 3 + 0) * 64 + jl] = a0; red[(ks * 3 + 1) * 64 + jl] = a1; red[(ks * 3 + 2) * 64 + jl] = a2;
            __syncthreads();
            if (F.tid < 192) { const int v = F.tid >> 6, j2 = F.tid & 63; float s = 0.f;
#pragma unroll
                for (int q = 0; q < 8; ++q) s += red[(q * 3 + v) * 64 + j2];
                ((float*)(ws + WS_MOD))[(l * 3 + v) * 6144 + jg * 64 + j2] = s + a->in[I_BADA][l * 6144 + jg * 64 + j2]; }
            __syncthreads();
        }
    }
}

__device__ __forceinline__ f32x4 ld_y4(const bf16* p) { const u32x2 w = *(const u32x2*)p; return (f32x4){bflo(w.x), bfhi(w.x), bflo(w.y), bfhi(w.y)}; }
__device__ __forceinline__ void n1_load(const Frame& F, const CAS Args* a, int l, int m, f32x4 (&x)[4], f32x4 (&y)[4]) {
    unsigned char* ws = F.ws;
    const bf16* Y0 = (const bf16*)(ws + WS_Y); const bf16* Y1 = Y0 + (size_t)TT * D;
    const float* src = (l == 0) ? (m < TL ? a->in[I_X] + (size_t)m * D : a->in[I_CTX] + (size_t)(m - TL) * D) : (m < TL ? F.out + (size_t)m * D : (const float*)(ws + WS_XC) + (size_t)(m - TL) * D);
#pragma unroll
    for (int j = 0; j < 4; ++j) { const int col = 4 * F.lane + 256 * j; x[j] = *(const f32x4*)(src + col);
        if (l > 0) y[j] = ld_y4(Y0 + (size_t)m * D + col) + ld_y4(Y1 + (size_t)m * D + col); }
}
__device__ __forceinline__ void n1_row(const Frame& F, const CAS Args* a, int l, int m, f32x4 (&x)[4], const f32x4 (&y)[4]) {
    unsigned char* ws = F.ws;
    const float* mod = (const float*)(ws + WS_MOD);
    bf16* H = (bf16*)(ws + WS_H);
    const int v = m < TL ? (m >> 13) : 2;
    float* xrow = m < TL ? F.out + (size_t)m * D : (float*)(ws + WS_XC) + (size_t)(m - TL) * D;
    float ss = 0.f;
#pragma unroll
    for (int j = 0; j < 4; ++j) {
        const int col = 4 * F.lane + 256 * j;
        if (l > 0) { const f32x4 g2 = *(const f32x4*)(mod + ((l - 1) * 3 + v) * 6144 + 5 * D + col); x[j] = x[j] + g2 * y[j]; *(f32x4*)(xrow + col) = x[j]; }
        ss += (x[j][0] * x[j][0] + x[j][1] * x[j][1]) + (x[j][2] * x[j][2] + x[j][3] * x[j][3]);
    }
    const float rstd = 1.0f / sqrtf(wave_sum(ss) * (1.0f / D) + EPS);
#pragma unroll
    for (int j = 0; j < 4; ++j) {
        const int col = 4 * F.lane + 256 * j;
        const f32x4 nw = *(const f32x4*)(a->in[I_NORM1] + l * D + col);
        const f32x4 sh = *(const f32x4*)(mod + (l * 3 + v) * 6144 + 0 * D + col);
        const f32x4 sc = *(const f32x4*)(mod + (l * 3 + v) * 6144 + 1 * D + col);
        const f32x4 h = x[j] * rstd * nw * (1.0f + sc) + sh;
        u32x2 o; o.x = pk2(h[0], h[1]); o.y = pk2(h[2], h[3]);
        *(u32x2*)(H + (size_t)m * D + col) = o;
    }
}
__device__ __forceinline__ void n1_phase(const Frame& F, const CAS Args* a, int l) {
    for (int m = F.gw; m < TT; m += 2 * F.NGW) {
        const int m2 = m + F.NGW; const bool two = m2 < TT;
        f32x4 xa[4], ya[4], xb[4], yb[4];
        n1_load(F, a, l, m, xa, ya);
        if (two) n1_load(F, a, l, m2, xb, yb);
        n1_row(F, a, l, m, xa, ya);
        if (two) n1_row(F, a, l, m2, xb, yb);
    }
}

struct EpiIn {
    static constexpr bool PERM = true;
    bf16* P; const float* bias_f; const float* bias_b; const float* tcos; const float* tsin;
    __device__ __forceinline__ void operator()(const f32x4 (&acc)[2][2][4][2], const pg8::Unit& u, int wr, int wc, int fr, int fq) const {
        const int row0 = u.pm * 256 + wr * 64 + fr, colw = wc * 32 + 8 * fq;
        const int pn = u.pn;
        const bool latent = u.pm < 64;
#pragma unroll
        for (int ai = 0; ai < 2; ++ai)
#pragma unroll
            for (int m = 0; m < 4; ++m) {
                const int row = row0 + ai * 128 + m * 16;
                bf16* rowp = P + (size_t)row * NIN + pn * 256 + colw;
#pragma unroll
                for (int bj = 0; bj < 2; ++bj) {
                    f32x4 v0 = acc[ai][bj][m][0], v1 = acc[ai][bj][m][1];
                    if (pn == 0) { v0 = v0 * 0.125f; v1 = v1 * 0.125f; }
                    else if (pn >= 9) {
                        const float* bp = (pn == 9 ? bias_f : bias_b) + colw + bj * 128;
                        const f32x4 b0 = *(const f32x4*)bp, b1 = *(const f32x4*)(bp + 4);
#pragma unroll
                        for (int i = 0; i < 4; ++i) { float x0 = v0[i] + b0[i], x1 = v1[i] + b1[i];
                            v0[i] = (fminf(x0, 0.f) - __logf(1.0f + __expf(-fabsf(x0)))) * 0.0625f; v1[i] = (fminf(x1, 0.f) - __logf(1.0f + __expf(-fabsf(x1)))) * 0.0625f; }
                    } else if (latent && (pn == 6 || pn == 7 || (pn == 8 && bj == 0))) {
                        const int t = row & (SEQ - 1); const int pos = (wc & 1) ? (t & 63) : (t >> 6);
                        const f32x4 cs = *(const f32x4*)(tcos + pos * 16 + 4 * fq), sn = *(const f32x4*)(tsin + pos * 16 + 4 * fq);
                        const f32x4 o0 = v0 * cs - v1 * sn, o1 = v1 * cs + v0 * sn; v0 = o0; v1 = o1;
                    }
                    if (pn == 6 || pn == 7) { v0 = v0 * QSCALE; v1 = v1 * QSCALE; }
                    u32x4 w; w.x = pg8::cvt_pk_bf16(v0[0], v0[1]); w.y = pg8::cvt_pk_bf16(v0[2], v0[3]); w.z = pg8::cvt_pk_bf16(v1[0], v1[1]); w.w = pg8::cvt_pk_bf16(v1[2], v1[3]);
                    *(u32x4*)(rowp + bj * 128) = w;
                }
            }
    }
};
struct EpiOut {
    static constexpr bool PERM = false;
    const float* resL; const float* resC; float* outL; float* outC; const float* mod_l;
    __device__ __forceinline__ void operator()(const f32x4 (&acc)[2][2][4][2], const pg8::Unit& u, int wr, int wc, int fr, int fq) const {
        const bool latent = u.pm < 64;
        const int v = latent ? (u.pm >> 5) : 2;
        const int rowb = (latent ? u.pm * 256 : u.pm * 256 - TL) + wr * 64 + fr;
        const float* res = latent ? resL : resC; float* out = latent ? outL : outC;
        const int col0 = u.pn * 256 + wc * 32 + 4 * fq;
        const float* g1p = mod_l + v * 6144 + 2 * D + col0;
#pragma unroll
        for (int ai = 0; ai < 2; ++ai)
#pragma unroll
            for (int m = 0; m < 4; ++m) {
                const size_t off = (size_t)(rowb + ai * 128 + m * 16) * D + col0;
#pragma unroll
                for (int bj = 0; bj < 2; ++bj)
#pragma unroll
                    for (int n = 0; n < 2; ++n) {
                        const f32x4 g1 = *(const f32x4*)(g1p + bj * 128 + n * 16);
                        const f32x4 r = *(const f32x4*)(res + off + bj * 128 + n * 16);
                        *(f32x4*)(out + off + bj * 128 + n * 16) = r + g1 * acc[ai][bj][m][n];
                    }
                if (m & 1) asm volatile("" ::: "memory");
            }
    }
};
struct EpiGU {
    static constexpr bool PERM = true;
    bf16* Hmid;
    __device__ __forceinline__ void operator()(const f32x4 (&acc)[2][2][4][2], const pg8::Unit& u, int wr, int wc, int fr, int fq) const {
        const int row0 = u.pm * 256 + wr * 64 + fr, hid0 = u.pn * 128 + wc * 16 + fq * 4;
#pragma unroll
        for (int ai = 0; ai < 2; ++ai)
#pragma unroll
            for (int m = 0; m < 4; ++m) {
                bf16* rowp = Hmid + (size_t)(row0 + ai * 128 + m * 16) * DE + hid0;
#pragma unroll
                for (int bj = 0; bj < 2; ++bj) {
                    const f32x4 g = acc[ai][bj][m][0], up = acc[ai][bj][m][1]; f32x4 o;
#pragma unroll
                    for (int i = 0; i < 4; ++i) o[i] = g[i] * __builtin_amdgcn_rcpf(1.0f + __expf(-g[i])) * up[i];
                    u32x2 w; w.x = pg8::cvt_pk_bf16(o[0], o[1]); w.y = pg8::cvt_pk_bf16(o[2], o[3]);
                    *(u32x2*)(rowp + bj * 64) = w;
                }
            }
    }
};
struct EpiDown {
    static constexpr bool PERM = true;
    bf16* Y; const unsigned* list; const float* listw; const LAS int* tab;
    __device__ __forceinline__ void operator()(const f32x4 (&acc)[2][2][4][2], const pg8::Unit& u, int wr, int wc, int fr, int fq) const {
        const int ce = tab[u.e];
        const int r0 = u.mt * 256 + wr * 64 + fr, col0 = u.pn * 256 + wc * 32 + 8 * fq;
        const unsigned* lp = list + (size_t)u.e * LISTCAP; const float* lw = listw + (size_t)u.e * LISTCAP;
#pragma unroll
        for (int ai = 0; ai < 2; ++ai)
#pragma unroll
            for (int m = 0; m < 4; ++m) {
                const int r = r0 + ai * 128 + m * 16;
                if (r < ce) {
                    const unsigned ts = __builtin_nontemporal_load(lp + r); const float w = __builtin_nontemporal_load(lw + r);
                    bf16* rowp = Y + ((size_t)(ts & 1u) * TT + (ts >> 1)) * D + col0;
#pragma unroll
                    for (int bj = 0; bj < 2; ++bj) {
                        const f32x4 v0 = acc[ai][bj][m][0] * w, v1 = acc[ai][bj][m][1] * w;
                        u32x4 o; o.x = pg8::cvt_pk_bf16(v0[0], v0[1]); o.y = pg8::cvt_pk_bf16(v0[2], v0[3]); o.z = pg8::cvt_pk_bf16(v1[0], v1[1]); o.w = pg8::cvt_pk_bf16(v1[2], v1[3]);
                        *(u32x4*)(rowp + bj * 128) = o;
                    }
                }
            }
    }
};

__device__ __forceinline__ void swa_naive(const Frame& F, const CAS Args* a, int l) {
    const bf16* P = (const bf16*)(F.ws + WS_P); bf16* MIX = (bf16*)(F.ws + WS_MIX);
    const int total = (l == 0 ? TT : TL) * 8;
    for (int idx = F.gw * 64 + F.lane; idx < total; idx += F.NGW * 64) {
        const int m = idx >> 3, hq = idx & 7, kvh = hq >> 2;
        const bool latent = m < TL;
        const int b = latent ? (m >> 13) : ((m - TL) >> 8), t = m & (SEQ - 1);
        float q[64];
        { const u32x4* qp = (const u32x4*)(P + (size_t)m * NIN + PC_SQ + hq * 64);
#pragma unroll
          for (int c = 0; c < 8; ++c) { const u32x4 w = qp[c]; q[8 * c] = bflo(w.x); q[8 * c + 1] = bfhi(w.x); q[8 * c + 2] = bflo(w.y); q[8 * c + 3] = bfhi(w.y);
              q[8 * c + 4] = bflo(w.z); q[8 * c + 5] = bfhi(w.z); q[8 * c + 6] = bflo(w.w); q[8 * c + 7] = bfhi(w.w); } }
        float o[64];
#pragma unroll
        for (int d = 0; d < 64; ++d) o[d] = 0.f;
        const float sink = a->in[I_SINK][l * 8 + hq] * LOG2E;
        float mx = sink, den = 1.0f;
        const int lo = latent ? (t - 128 < 0 ? 0 : t - 128) : 0, hi = latent ? (t + 128 > SEQ - 1 ? SEQ - 1 : t + 128) : -1;
        const int nloc = hi - lo + 1;
        for (int kk = 0; kk < nloc + LC; ++kk) {
            const int krow = kk < nloc ? b * SEQ + lo + kk : TL + b * LC + (kk - nloc);
            const u32x4* kp = (const u32x4*)(P + (size_t)krow * NIN + PC_SK + kvh * 64);
            float s = 0.f;
#pragma unroll
            for (int c = 0; c < 8; ++c) { const u32x4 w = kp[c]; s += q[8 * c] * bflo(w.x) + q[8 * c + 1] * bfhi(w.x) + q[8 * c + 2] * bflo(w.y) + q[8 * c + 3] * bfhi(w.y)
                + q[8 * c + 4] * bflo(w.z) + q[8 * c + 5] * bfhi(w.z) + q[8 * c + 6] * bflo(w.w) + q[8 * c + 7] * bfhi(w.w); }
            const float mn = fmaxf(mx, s), f = exp2f(mx - mn), p = exp2f(s - mn);
            den = den * f + p; mx = mn;
            const u32x4* vp = (const u32x4*)(P + (size_t)krow * NIN + PC_SV + kvh * 64);
#pragma unroll
            for (int c = 0; c < 8; ++c) { const u32x4 w = vp[c];
                o[8 * c] = o[8 * c] * f + p * bflo(w.x); o[8 * c + 1] = o[8 * c + 1] * f + p * bfhi(w.x); o[8 * c + 2] = o[8 * c + 2] * f + p * bflo(w.y); o[8 * c + 3] = o[8 * c + 3] * f + p * bfhi(w.y);
                o[8 * c + 4] = o[8 * c + 4] * f + p * bflo(w.z); o[8 * c + 5] = o[8 * c + 5] * f + p * bfhi(w.z); o[8 * c + 6] = o[8 * c + 6] * f + p * bflo(w.w); o[8 * c + 7] = o[8 * c + 7] * f + p * bfhi(w.w); }
        }
        const float inv = 1.0f / den;
        u32x4* op = (u32x4*)(MIX + (size_t)m * D + 512 + hq * 64);
#pragma unroll
        for (int c = 0; c < 8; ++c) { u32x4 w; w.x = pk2(o[8 * c] * inv, o[8 * c + 1] * inv); w.y = pk2(o[8 * c + 2] * inv, o[8 * c + 3] * inv); w.z = pk2(o[8 * c + 4] * inv, o[8 * c + 5] * inv); w.w = pk2(o[8 * c + 6] * inv, o[8 * c + 7] * inv); op[c] = w; }
    }
}


typedef float f32x16 __attribute__((ext_vector_type(16)));
typedef short s16x4 __attribute__((ext_vector_type(4)));
__device__ __forceinline__ int crow(int r, int hi) { return (r & 3) + 8 * (r >> 2) + 4 * hi; }
__device__ __forceinline__ s16x4 vtr(const LAS unsigned char* p) { return __builtin_bit_cast(s16x4, __builtin_amdgcn_ds_read_tr16_b64_v4i16((LAS s16x4*)p)); }
constexpr int SWA_K = 0, SWA_V = 49152;
__device__ __forceinline__ void swa_tile(const LAS unsigned char* Kt, const LAS unsigned char* Vt, int mtype, const bf16x8 (&qf)[2][4], f32x16 (&o)[2][2], float (&mrun)[2], float (&lrun)[2], int lane) {
    const int r32 = lane & 31, hi = lane >> 5;
    const LAS unsigned char* vp = Vt + ((lane >> 4) & 1) * 32 + (lane & 3) * 8 + (4 * hi + ((lane & 15) >> 2)) * 64;
#pragma unroll
    for (int kb = 0; kb < 2; ++kb) {
        f32x16 s[2];
#pragma unroll
        for (int d0 = 0; d0 < 4; ++d0) {
            const bf16x8 kf = *(const LAS bf16x8*)(Kt + (2 * d0 + hi) * 1024 + (32 * kb + r32) * 16);
#pragma unroll
            for (int qt = 0; qt < 2; ++qt) {
                if (d0 == 0) { f32x16 z;
#pragma unroll
                    for (int r = 0; r < 16; ++r) z[r] = 0.f;
                    s[qt] = __builtin_amdgcn_mfma_f32_32x32x16_bf16(kf, qf[qt][0], z, 0, 0, 0); }
                else s[qt] = __builtin_amdgcn_mfma_f32_32x32x16_bf16(kf, qf[qt][d0], s[qt], 0, 0, 0);
            }
        }
        bf16x8 pf[2][2];
#pragma unroll
        for (int qt = 0; qt < 2; ++qt) {
            if (mtype != 0) {
                int thr = r32 + 32 * qt - 4 * hi - 32 * kb; asm volatile("" : "+v"(thr));
                if (mtype == 1) {
#pragma unroll
                    for (int r = 0; r < 16; ++r) { const int cc = (r & 3) + 8 * (r >> 2); if (cc < thr) s[qt][r] = -INFINITY; }
                } else {
#pragma unroll
                    for (int r = 0; r < 16; ++r) { const int cc = (r & 3) + 8 * (r >> 2); if (cc > thr) s[qt][r] = -INFINITY; }
                }
            }
            float rm = s[qt][0];
#pragma unroll
            for (int r = 1; r < 16; ++r) rm = fmaxf(rm, s[qt][r]);
            { auto rr = __builtin_amdgcn_permlane32_swap(__float_as_uint(rm), __float_as_uint(rm), false, false); rm = fmaxf(__uint_as_float(rr[0]), __uint_as_float(rr[1])); }
            const float mn = fmaxf(mrun[qt], rm);
            if (__any(mn > mrun[qt])) {
                const float alpha = __builtin_amdgcn_exp2f(mrun[qt] - mn);
                lrun[qt] *= alpha;
#pragma unroll
                for (int dt = 0; dt < 2; ++dt)
#pragma unroll
                    for (int r = 0; r < 16; ++r) o[dt][qt][r] *= alpha;
                mrun[qt] = mn;
            }
            float rs = 0.f;
#pragma unroll
            for (int r = 0; r < 16; ++r) { const float p = __builtin_amdgcn_exp2f(s[qt][r] - mn); s[qt][r] = p; rs += p; }
            lrun[qt] += rs;
#pragma unroll
            for (int sp = 0; sp < 2; ++sp) {
                u32x4 w; w.x = pg8::cvt_pk_bf16(s[qt][8 * sp + 0], s[qt][8 * sp + 1]); w.y = pg8::cvt_pk_bf16(s[qt][8 * sp + 2], s[qt][8 * sp + 3]);
                w.z = pg8::cvt_pk_bf16(s[qt][8 * sp + 4], s[qt][8 * sp + 5]); w.w = pg8::cvt_pk_bf16(s[qt][8 * sp + 6], s[qt][8 * sp + 7]);
                pf[qt][sp] = __builtin_bit_cast(bf16x8, w);
            }
        }
#pragma unroll
        for (int dt = 0; dt < 2; ++dt)
#pragma unroll
            for (int sp = 0; sp < 2; ++sp) {
                const int ks = 2 * kb + sp;
                const s16x4 lo = vtr(vp + dt * 4096 + ks * 1024), hi4 = vtr(vp + dt * 4096 + ks * 1024 + 512);
                const bf16x8 vf = (bf16x8){lo[0], lo[1], lo[2], lo[3], hi4[0], hi4[1], hi4[2], hi4[3]};
#pragma unroll
                for (int qt = 0; qt < 2; ++qt) o[dt][qt] = __builtin_amdgcn_mfma_f32_32x32x16_bf16(vf, pf[qt][sp], o[dt][qt], 0, 0, 0);
            }
    }
}
__device__ __forceinline__ void swa_stage(const Frame& F, const bf16* P, int grow, int kvh, int ti) {
    { const int key = 8 * F.wave + (F.lane & 7), ch = F.lane >> 3;
      const u32x4 v = *(const u32x4*)(P + (size_t)(grow + key) * NIN + PC_SK + kvh * 64 + ch * 8);
      *(LAS u32x4*)(F.lds + SWA_K + ti * 8192 + ch * 1024 + key * 16) = v; }
    { const int key = 8 * F.wave + (F.lane >> 3), ch = F.lane & 7;
      const u32x4 v = *(const u32x4*)(P + (size_t)(grow + key) * NIN + PC_SV + kvh * 64 + ch * 8);
      *(LAS u32x4*)(F.lds + SWA_V + ti * 8192 + (ch >> 2) * 4096 + key * 64 + (ch & 3) * 16) = v; }
}
__device__ __forceinline__ void swa_flash(const Frame& F, const CAS Args* a, int l) {
    const bf16* P = (const bf16*)(F.ws + WS_P); bf16* MIX = (bf16*)(F.ws + WS_MIX);
    const int nunits = 256 + (l == 0 ? 8 : 0);
    const int lane = F.lane, r32 = lane & 31, hi = lane >> 5;
    for (int u = F.vcu; u < nunits; u += F.G) {
        const bool latent = u < 256;
        const int b = latent ? (u >> 7) : ((u - 256) >> 2), kvh = latent ? ((u >> 6) & 1) : (((u - 256) >> 1) & 1), qb = latent ? (u & 63) : ((u - 256) & 1);
        const int q0 = qb * 128, g = F.wave >> 1, qs = F.wave & 1, hq = kvh * 4 + g;
        const int mrow0 = (latent ? b * SEQ : TL + b * LC) + q0 + 64 * qs;
        bf16x8 qf[2][4];
#pragma unroll
        for (int qt = 0; qt < 2; ++qt)
#pragma unroll
            for (int d0 = 0; d0 < 4; ++d0) qf[qt][d0] = *(const bf16x8*)(P + (size_t)(mrow0 + 32 * qt + r32) * NIN + PC_SQ + hq * 64 + 16 * d0 + 8 * hi);
        f32x16 o[2][2];
#pragma unroll
        for (int dt = 0; dt < 2; ++dt)
#pragma unroll
            for (int qt = 0; qt < 2; ++qt)
#pragma unroll
                for (int r = 0; r < 16; ++r) o[dt][qt][r] = 0.f;
        const float sink2 = a->in[I_SINK][l * 8 + hq] * LOG2E;
        float mrun[2] = {sink2, sink2}, lrun[2] = {hi == 0 ? 1.f : 0.f, hi == 0 ? 1.f : 0.f};
        if (latent) {
#pragma unroll 1
            for (int j = 0; j < 6; ++j) { const int ks = q0 - 128 + 64 * j; if (ks >= 0 && ks < SEQ) swa_stage(F, P, b * SEQ + ks, kvh, j); }
            __syncthreads();
#pragma unroll 1
            for (int tt = 0; tt < 5; ++tt) { const int j = qs + tt, ks = q0 - 128 + 64 * j;
                if (ks >= 0 && ks < SEQ) swa_tile(F.lds + SWA_K + j * 8192, F.lds + SWA_V + j * 8192, tt == 0 ? 1 : (tt == 4 ? 2 : 0), qf, o, mrun, lrun, lane); }
            __syncthreads();
        }
#pragma unroll 1
        for (int j = 0; j < 4; ++j) swa_stage(F, P, TL + b * LC + 64 * j, kvh, j);
        __syncthreads();
#pragma unroll 1
        for (int j = 0; j < 4; ++j) swa_tile(F.lds + SWA_K + j * 8192, F.lds + SWA_V + j * 8192, 0, qf, o, mrun, lrun, lane);
        __syncthreads();
#pragma unroll
        for (int qt = 0; qt < 2; ++qt) {
            float lt = lrun[qt];
            { auto rr = __builtin_amdgcn_permlane32_swap(__float_as_uint(lt), __float_as_uint(lt), false, false); lt = __uint_as_float(rr[0]) + __uint_as_float(rr[1]); }
            const float inv = 1.0f / lt;
            bf16* op = MIX + (size_t)(mrow0 + 32 * qt + r32) * D + 512 + hq * 64 + 4 * hi;
#pragma unroll
            for (int dt = 0; dt < 2; ++dt)
#pragma unroll
                for (int rg = 0; rg < 4; ++rg) {
                    u32x2 w; w.x = pk2(o[dt][qt][4 * rg] * inv, o[dt][qt][4 * rg + 1] * inv); w.y = pk2(o[dt][qt][4 * rg + 2] * inv, o[dt][qt][4 * rg + 3] * inv);
                    *(u32x2*)(op + 32 * dt + 8 * rg) = w;
                }
        }
    }
}


constexpr size_t WS_US = WS_GL, WS_USC = WS_GL + 32 * MiB, WS_DEC = 7 * MiB;
static_assert(WS_USC + (size_t)16 * 4 * 8192 * 2 <= WS_END && WS_DEC + (size_t)16 * 132 * 64 * 4 <= WS_WIN, "ws map (gla)");
constexpr int GL_V = 0, GL_M0 = 16384, GL_MSZ = 64 * 72 * 2, GL_RED = GL_M0 + 4 * GL_MSZ;
__device__ __forceinline__ float wave_scan_incl(float v) {
    v += DPP_F(v, 0x111, 0xF); v += DPP_F(v, 0x112, 0xF); v += DPP_F(v, 0x114, 0xF); v += DPP_F(v, 0x118, 0xF);
    v += DPP_F(v, 0x142, 0xA); v += DPP_F(v, 0x143, 0xC); return v;
}
__device__ __forceinline__ float lane63(float v) { return __builtin_bit_cast(float, __builtin_amdgcn_readlane(__builtin_bit_cast(int, v), 63)); }
__device__ __forceinline__ void unpack8(const u32x4 w, float (&f)[8]) { f[0] = bflo(w.x); f[1] = bfhi(w.x); f[2] = bflo(w.y); f[3] = bfhi(w.y); f[4] = bflo(w.z); f[5] = bfhi(w.z); f[6] = bflo(w.w); f[7] = bfhi(w.w); }
__device__ __forceinline__ void gla_stage_v(const Frame& F, const bf16* P, int m0, int h) {
#pragma unroll
    for (int i = 0; i < 2; ++i) { const int p = F.tid + 512 * i, t = p >> 4, ch = p & 15;
        const u32x4 v = *(const u32x4*)(P + (size_t)(m0 + t) * NIN + PC_V + h * 128 + ch * 8);
        *(LAS u32x4*)(F.lds + GL_V + (ch >> 2) * 4096 + t * 64 + (ch & 3) * 16) = v; }
}
__device__ __forceinline__ void gla_g1_unit(const Frame& F, const bf16* P, int m0, int h, bf16* Uf, bf16* Ub, float* decf, float* decb) {
    const int w = F.wave, t = F.lane, c = t & 31, hi = t >> 5;
    const bf16* row = P + (size_t)(m0 + t) * NIN + h * 64 + 8 * w;
    float laf[8], lab[8], kk[8];
    unpack8(*(const u32x4*)(row + PC_GF), laf); unpack8(*(const u32x4*)(row + PC_GB), lab); unpack8(*(const u32x4*)(row + PC_K), kk);
    gla_stage_v(F, P, m0, h);
    LAS bf16* KOF = (LAS bf16*)(F.lds + GL_M0); LAS bf16* KOB = (LAS bf16*)(F.lds + GL_M0 + GL_MSZ);
#pragma unroll
    for (int i = 0; i < 8; ++i) {
        const float incf = wave_scan_incl(laf[i]), tf = lane63(incf), incb = wave_scan_incl(lab[i]), tb = lane63(incb);
        KOF[(8 * w + i) * 72 + t] = (bf16)f2bf(kk[i] * __expf(tf - incf));
        KOB[(8 * w + i) * 72 + t] = (bf16)f2bf(kk[i] * __expf(incb - lab[i]));
        if (t == 0) { decf[8 * w + i] = __expf(tf); decb[8 * w + i] = __expf(tb); }
    }
    __syncthreads();
    const int dir = w >> 2, dvt = w & 3;
    const LAS unsigned char* vp = F.lds + GL_V + dvt * 4096 + ((t >> 4) & 1) * 32 + (t & 3) * 8 + ((t & 15) >> 2) * 64 + hi * 512;
    const LAS unsigned char* kb = F.lds + GL_M0 + dir * GL_MSZ + (c * 72 + 8 * hi) * 2;
    f32x16 acc[2];
#pragma unroll
    for (int j = 0; j < 2; ++j)
#pragma unroll
        for (int r = 0; r < 16; ++r) acc[j][r] = 0.f;
#pragma unroll
    for (int sp = 0; sp < 4; ++sp) {
        const s16x4 lo = vtr(vp + sp * 1024), hi4 = vtr(vp + sp * 1024 + 256);
        const bf16x8 vf = (bf16x8){lo[0], lo[1], lo[2], lo[3], hi4[0], hi4[1], hi4[2], hi4[3]};
#pragma unroll
        for (int j = 0; j < 2; ++j) { const bf16x8 kf = *(const LAS bf16x8*)(kb + j * 32 * 144 + sp * 32); acc[j] = __builtin_amdgcn_mfma_f32_32x32x16_bf16(vf, kf, acc[j], 0, 0, 0); }
    }
    bf16* U = dir ? Ub : Uf;
#pragma unroll
    for (int j = 0; j < 2; ++j)
#pragma unroll
        for (int r = 0; r < 16; ++r) U[(32 * dvt + crow(r, hi)) * 64 + 32 * j + c] = (bf16)f2bf(acc[j][r]);
    __syncthreads();
}
__device__ __forceinline__ void gla_g1(const Frame& F0, int l) {
    Frame F = F0; { int l_; asm volatile("v_mbcnt_lo_u32_b32 %0, -1, 0\n\tv_mbcnt_hi_u32_b32 %0, -1, %0" : "=v"(l_)); F.lane = l_; F.tid = F.wave * 64 + l_; }
    const bf16* P = (const bf16*)(F.ws + WS_P);
    bf16* US = (bf16*)(F.ws + WS_US); bf16* USC = (bf16*)(F.ws + WS_USC); float* DEC = (float*)(F.ws + WS_DEC);
    for (int u = F.vcu; u < 1056; u += F.G) {
        const bool latent = u < 1024; const int cc = u - 1024;
        const int b = latent ? (u >> 9) : (cc >> 4), h = latent ? ((u >> 7) & 3) : ((cc >> 2) & 3), n = latent ? (u & 127) : (cc & 3);
        const int m0 = latent ? b * SEQ + 64 * n : TL + b * LC + 64 * n;
        const int sf = (b * 4 + h) * 2;
        bf16* Uf = latent ? US + ((size_t)sf * 128 + n) * 8192 : USC + ((size_t)sf * 4 + n) * 8192;
        bf16* Ub = latent ? US + ((size_t)(sf + 1) * 128 + n) * 8192 : USC + ((size_t)(sf + 1) * 4 + n) * 8192;
        const int nd = latent ? n : 128 + n;
        gla_g1_unit(F, P, m0, h, Uf, Ub, DEC + ((size_t)sf * 132 + nd) * 64, DEC + ((size_t)(sf + 1) * 132 + nd) * 64);
    }
}
constexpr size_t WS_SS = WS_H, WS_SSC = WS_H + 32 * MiB;
static_assert(WS_SSC + (size_t)16 * 4 * 8192 * 2 <= WS_P, "ws map (gla states)");
__device__ __forceinline__ void gla_scan(const Frame& F) {
    for (int w0 = (F.vcu * NWAVES + F.wave) * 64; w0 < 16 * 4096; w0 += F.G * NWAVES * 64) {
        const int seq = __builtin_amdgcn_readfirstlane(w0 >> 12), ew = __builtin_amdgcn_readfirstlane((w0 & 4095) * 2);
        const int dir = seq & 1;
        const unsigned voff = (unsigned)F.lane * 4u;
        const unsigned doff = (unsigned)((2 * F.lane) & 63) * 4u;
        const char* decb = (const char*)(F.ws + WS_DEC) + (size_t)seq * 132 * 256;
        float s0 = 0.f, s1 = 0.f;
        { const char* ub = (const char*)(F.ws + WS_USC) + ((size_t)seq * 4 * 8192 + ew) * 2; char* sb = (char*)(F.ws + WS_SSC) + ((size_t)seq * 4 * 8192 + ew) * 2;
          unsigned u[4]; f32x2 d[4];
#pragma unroll
          for (int i = 0; i < 4; ++i) { const int n = dir ? 3 - i : i; u[i] = *(const unsigned*)(ub + (size_t)n * 16384 + voff); d[i] = *(const f32x2*)(decb + (size_t)(128 + n) * 256 + doff); }
#pragma unroll
          for (int i = 0; i < 4; ++i) { const int n = dir ? 3 - i : i; *(unsigned*)(sb + (size_t)n * 16384 + voff) = pk2(s0, s1); s0 = d[i][0] * s0 + bflo(u[i]); s1 = d[i][1] * s1 + bfhi(u[i]); } }
        const long stride = dir ? -16384 : 16384, dstride = dir ? -256 : 256;
        const char* ub = (const char*)(F.ws + WS_US) + ((size_t)seq * 128 * 8192 + ew) * 2 + (dir ? (size_t)127 * 16384 : 0);
        char* sb = (char*)(F.ws + WS_SS) + ((size_t)seq * 128 * 8192 + ew) * 2 + (dir ? (size_t)127 * 16384 : 0);
        const char* db = decb + (dir ? 127 * 256 : 0);
#pragma unroll 1
        for (int i0 = 0; i0 < 128; i0 += 32) {
            unsigned u[32]; f32x2 d[32];
#pragma unroll
            for (int j = 0; j < 32; ++j) { u[j] = *(const unsigned*)(ub + j * stride + voff); d[j] = *(const f32x2*)(db + j * dstride + doff); }
#pragma unroll
            for (int j = 0; j < 32; ++j) { *(unsigned*)(sb + j * stride + voff) = pk2(s0, s1); s0 = d[j][0] * s0 + bflo(u[j]); s1 = d[j][1] * s1 + bfhi(u[j]); }
            ub += 32 * stride; sb += 32 * stride; db += 32 * dstride;
        }
    }
}
__device__ __forceinline__ void gla_g3_unit(const Frame& F, const CAS Args* a, int l, const bf16* P, int m0, int h, const bf16* Sf, const bf16* Sb, bf16* MIX) {
    const int w = F.wave, t = F.lane, c = t & 31, hi = t >> 5;
    {
        const bf16* row = P + (size_t)(m0 + t) * NIN + h * 64 + 8 * w;
        float laf[8], lab[8], kk[8], qq[8];
        unpack8(*(const u32x4*)(row + PC_GF), laf); unpack8(*(const u32x4*)(row + PC_GB), lab); unpack8(*(const u32x4*)(row + PC_K), kk); unpack8(*(const u32x4*)(row + PC_Q), qq);
        gla_stage_v(F, P, m0, h);
        float qf[8], kf[8], qb[8], kb[8];
#pragma unroll
        for (int i = 0; i < 8; ++i) {
            const float bf = wave_scan_incl(laf[i]), incb = wave_scan_incl(lab[i]), bb = lane63(incb) - incb + lab[i];
            qf[i] = qq[i] * __expf(bf); kf[i] = kk[i] * __expf(-bf); qb[i] = qq[i] * __expf(bb); kb[i] = kk[i] * __expf(-bb);
        }
        LAS unsigned char* mb = F.lds + GL_M0 + (t * 72 + 8 * w) * 2;
        u32x4 o;
        o.x = pk2(qf[0], qf[1]); o.y = pk2(qf[2], qf[3]); o.z = pk2(qf[4], qf[5]); o.w = pk2(qf[6], qf[7]); *(LAS u32x4*)(mb) = o;
        o.x = pk2(kf[0], kf[1]); o.y = pk2(kf[2], kf[3]); o.z = pk2(kf[4], kf[5]); o.w = pk2(kf[6], kf[7]); *(LAS u32x4*)(mb + GL_MSZ) = o;
        o.x = pk2(qb[0], qb[1]); o.y = pk2(qb[2], qb[3]); o.z = pk2(qb[4], qb[5]); o.w = pk2(qb[6], qb[7]); *(LAS u32x4*)(mb + 2 * GL_MSZ) = o;
        o.x = pk2(kb[0], kb[1]); o.y = pk2(kb[2], kb[3]); o.z = pk2(kb[4], kb[5]); o.w = pk2(kb[6], kb[7]); *(LAS u32x4*)(mb + 3 * GL_MSZ) = o;
    }
    __syncthreads();
    const int dvt = w >> 1, tt = w & 1;
    bf16x8 qfB[4], qbB[4];
    { const LAS unsigned char* qp = F.lds + GL_M0 + ((32 * tt + c) * 72 + 8 * hi) * 2;
#pragma unroll
      for (int kd = 0; kd < 4; ++kd) { qfB[kd] = *(const LAS bf16x8*)(qp + kd * 32); qbB[kd] = *(const LAS bf16x8*)(qp + 2 * GL_MSZ + kd * 32); } }
    bf16x8 pfr[2][2];
#pragma unroll
    for (int st = 0; st < 2; ++st) {
        const LAS unsigned char* kp = F.lds + GL_M0 + GL_MSZ + ((32 * st + c) * 72 + 8 * hi) * 2;
        f32x16 xf, xb;
#pragma unroll
        for (int r = 0; r < 16; ++r) { xf[r] = 0.f; xb[r] = 0.f; }
        const bool needF = st <= tt, needB = st >= tt;
        if (needF) {
#pragma unroll
            for (int kd = 0; kd < 4; ++kd) xf = __builtin_amdgcn_mfma_f32_32x32x16_bf16(*(const LAS bf16x8*)(kp + kd * 32), qfB[kd], xf, 0, 0, 0);
        }
        if (needB) {
#pragma unroll
            for (int kd = 0; kd < 4; ++kd) xb = __builtin_amdgcn_mfma_f32_32x32x16_bf16(*(const LAS bf16x8*)(kp + 2 * GL_MSZ + kd * 32), qbB[kd], xb, 0, 0, 0);
        }
        if (st == tt) {
            int thr = c - 4 * hi; asm volatile("" : "+v"(thr));
#pragma unroll
            for (int r = 0; r < 16; ++r) { const int cc = (r & 3) + 8 * (r >> 2); xf[r] = (cc <= thr ? xf[r] : 0.f) + (cc >= thr ? xb[r] : 0.f); }
        } else {
#pragma unroll
            for (int r = 0; r < 16; ++r) xf[r] += xb[r];
        }
#pragma unroll
        for (int sp = 0; sp < 2; ++sp) {
            u32x4 wv; wv.x = pg8::cvt_pk_bf16(xf[8 * sp + 0], xf[8 * sp + 1]); wv.y = pg8::cvt_pk_bf16(xf[8 * sp + 2], xf[8 * sp + 3]);
            wv.z = pg8::cvt_pk_bf16(xf[8 * sp + 4], xf[8 * sp + 5]); wv.w = pg8::cvt_pk_bf16(xf[8 * sp + 6], xf[8 * sp + 7]);
            pfr[st][sp] = __builtin_bit_cast(bf16x8, wv);
        }
    }
    f32x16 o;
#pragma unroll
    for (int r = 0; r < 16; ++r) o[r] = 0.f;
    { const LAS unsigned char* vp = F.lds + GL_V + dvt * 4096 + ((t >> 4) & 1) * 32 + (t & 3) * 8 + (4 * hi + ((t & 15) >> 2)) * 64;
#pragma unroll
      for (int ks = 0; ks < 4; ++ks) {
          const s16x4 lo = vtr(vp + ks * 1024), hi4 = vtr(vp + ks * 1024 + 512);
          const bf16x8 vf = (bf16x8){lo[0], lo[1], lo[2], lo[3], hi4[0], hi4[1], hi4[2], hi4[3]};
          o = __builtin_amdgcn_mfma_f32_32x32x16_bf16(vf, pfr[ks >> 1][ks & 1], o, 0, 0, 0);
      } }
    { const bf16* sfp = Sf + (32 * dvt + c) * 64 + 8 * hi; const bf16* sbp = Sb + (32 * dvt + c) * 64 + 8 * hi;
#pragma unroll
      for (int kd = 0; kd < 4; ++kd) {
          o = __builtin_amdgcn_mfma_f32_32x32x16_bf16(*(const bf16x8*)(sfp + 16 * kd), qfB[kd], o, 0, 0, 0);
          o = __builtin_amdgcn_mfma_f32_32x32x16_bf16(*(const bf16x8*)(sbp + 16 * kd), qbB[kd], o, 0, 0, 0);
      } }
    float ssq = 0.f;
#pragma unroll
    for (int r = 0; r < 16; ++r) ssq += o[r] * o[r];
    { auto rr = __builtin_amdgcn_permlane32_swap(__float_as_uint(ssq), __float_as_uint(ssq), false, false); ssq = __uint_as_float(rr[0]) + __uint_as_float(rr[1]); }
    LAS float* red = (LAS float*)(F.lds + GL_RED);
    if (hi == 0) red[dvt * 64 + 32 * tt + c] = ssq;
    __syncthreads();
    const float tot = (red[32 * tt + c] + red[64 + 32 * tt + c]) + (red[128 + 32 * tt + c] + red[192 + 32 * tt + c]);
    const float rstd = 1.0f / sqrtf(tot * (1.0f / 128.0f) + EPS);
    const int mrow = m0 + 32 * tt + c;
#pragma unroll
    for (int rg = 0; rg < 4; ++rg) {
        const int dv = 32 * dvt + 8 * rg + 4 * hi;
        const u32x2 gw = *(const u32x2*)(P + (size_t)mrow * NIN + PC_G + h * 128 + dv);
        const f32x4 nw = *(const f32x4*)(a->in[I_GLANORM] + l * 512 + h * 128 + dv);
        const float g0 = bflo(gw.x), g1 = bfhi(gw.x), g2 = bflo(gw.y), g3 = bfhi(gw.y);
        u32x2 ov; ov.x = pk2(o[4 * rg] * rstd * nw[0] * silu_f(g0), o[4 * rg + 1] * rstd * nw[1] * silu_f(g1)); ov.y = pk2(o[4 * rg + 2] * rstd * nw[2] * silu_f(g2), o[4 * rg + 3] * rstd * nw[3] * silu_f(g3));
        *(u32x2*)(MIX + (size_t)mrow * D + h * 128 + dv) = ov;
    }
    __syncthreads();
}
__device__ __forceinline__ void gla_g3(const Frame& F, const CAS Args* a, int l) {
    const bf16* P = (const bf16*)(F.ws + WS_P); bf16* MIX = (bf16*)(F.ws + WS_MIX);
    const bf16* US = (const bf16*)(F.ws + WS_SS); const bf16* USC = (const bf16*)(F.ws + WS_SSC);
    const int nunits = 1024 + (l == 0 ? 32 : 0);
    for (int u = F.vcu; u < nunits; u += F.G) {
        const bool latent = u < 1024; const int cc = u - 1024;
        const int b = latent ? (u >> 9) : (cc >> 4), h = latent ? ((u >> 7) & 3) : ((cc >> 2) & 3), n = latent ? (u & 127) : (cc & 3);
        const int m0 = latent ? b * SEQ + 64 * n : TL + b * LC + 64 * n;
        const int sf = (b * 4 + h) * 2;
        const bf16* Sf = latent ? US + ((size_t)sf * 128 + n) * 8192 : USC + ((size_t)sf * 4 + n) * 8192;
        const bf16* Sb = latent ? US + ((size_t)(sf + 1) * 128 + n) * 8192 : USC + ((size_t)(sf + 1) * 4 + n) * 8192;
        gla_g3_unit(F, a, l, P, m0, h, Sf, Sb, MIX);
    }
}

__device__ __forceinline__ void gla_naive(const Frame& F, const CAS Args* a, int l) {
    const bf16* P = (const bf16*)(F.ws + WS_P);
    bf16* OF = (bf16*)(F.ws + WS_GL);
    for (int w = F.gw; w < 2048; w += F.NGW) {
        const int dv = w & 127, dir = (w >> 7) & 1, h = (w >> 8) & 3, b = w >> 10;
        const int pcg = dir ? PC_GB : PC_GF;
        float S = 0.f;
        for (int step = 0; step < LC + SEQ; ++step) {
            int m;
            if (dir == 0) m = step < LC ? TL + b * LC + step : b * SEQ + (step - LC);
            else m = step < LC ? TL + b * LC + (LC - 1 - step) : b * SEQ + (SEQ - 1 - (step - LC));
            const bf16* row = P + (size_t)m * NIN;
            const float la = bf2f(row[pcg + h * 64 + F.lane]), kk = bf2f(row[PC_K + h * 64 + F.lane]), qq = bf2f(row[PC_Q + h * 64 + F.lane]), vv = bf2f(row[PC_V + h * 128 + dv]);
            S = __expf(la) * S + kk * vv;
            const float o = wave_sum(qq * S);
            if (F.lane == 0) OF[((size_t)dir * TT + m) * 512 + h * 128 + dv] = (bf16)f2bf(o);
        }
    }
}
__device__ __forceinline__ void gla_out_naive(const Frame& F, const CAS Args* a, int l) {
    const bf16* P = (const bf16*)(F.ws + WS_P); bf16* MIX = (bf16*)(F.ws + WS_MIX);
    const bf16* OF = (const bf16*)(F.ws + WS_GL);
    const int rows = (l == 0) ? TT : TL;
    for (int m = F.gw; m < rows; m += F.NGW) {
        const int c0 = 8 * F.lane;
        const u32x4 wa = *(const u32x4*)(OF + (size_t)m * 512 + c0), wb = *(const u32x4*)(OF + ((size_t)TT + m) * 512 + c0);
        float o[8] = {bflo(wa.x) + bflo(wb.x), bfhi(wa.x) + bfhi(wb.x), bflo(wa.y) + bflo(wb.y), bfhi(wa.y) + bfhi(wb.y), bflo(wa.z) + bflo(wb.z), bfhi(wa.z) + bfhi(wb.z), bflo(wa.w) + bflo(wb.w), bfhi(wa.w) + bfhi(wb.w)};
        float ss = 0.f;
#pragma unroll
        for (int i = 0; i < 8; ++i) ss += o[i] * o[i];
        ss = row16_sum(ss);
        const float rstd = 1.0f / sqrtf(ss * (1.0f / 128.0f) + EPS);
        const u32x4 wg = *(const u32x4*)(P + (size_t)m * NIN + PC_G + c0);
        const float g[8] = {bflo(wg.x), bfhi(wg.x), bflo(wg.y), bfhi(wg.y), bflo(wg.z), bfhi(wg.z), bflo(wg.w), bfhi(wg.w)};
        const f32x4 n0 = *(const f32x4*)(a->in[I_GLANORM] + l * 512 + c0), n1 = *(const f32x4*)(a->in[I_GLANORM] + l * 512 + c0 + 4);
        float r[8];
#pragma unroll
        for (int i = 0; i < 8; ++i) r[i] = o[i] * rstd * (i < 4 ? n0[i] : n1[i - 4]) * silu_f(g[i]);
        u32x4 w; w.x = pk2(r[0], r[1]); w.y = pk2(r[2], r[3]); w.z = pk2(r[4], r[5]); w.w = pk2(r[6], r[7]);
        *(u32x4*)(MIX + (size_t)m * D + c0) = w;
    }
}

__device__ __forceinline__ void n2_route_phase(const Frame& F, const CAS Args* a, int l, bool do_route, int cset) {
    unsigned char* ws = F.ws;
    const float* mod = (const float*)(ws + WS_MOD);
    bf16* H = (bf16*)(ws + WS_H);
    unsigned* cnt = (unsigned*)(ws + WS_CTL) + CW_CNT + cset * NE * CNT_STRIDE;
    unsigned* list = (unsigned*)(ws + WS_LIST); float* listw = (float*)(ws + WS_LISTW);
    LAS float* wrt = (LAS float*)F.lds;
    for (int i = F.tid; i < D * NE; i += NWAVES * 64) wrt[(i & 15) * D + (i >> 4)] = a->in[I_WROUTER][i];
    __syncthreads();
    const int rows = (l == 0) ? TT : TL;
    constexpr int RT_PER_WAVE = 20;
    LAS unsigned* lcnt = (LAS unsigned*)(F.lds + 65536); LAS unsigned* lbase = lcnt + 16; LAS unsigned* rec = lcnt + 64;
    if (F.tid < 32) lcnt[F.tid] = 0u;
    __syncthreads();
    int it = 0;
    f32x4 xn[4];
    if (F.gw < rows) { const float* xr0 = F.gw < TL ? F.out + (size_t)F.gw * D : (const float*)(ws + WS_XC) + (size_t)(F.gw - TL) * D;
#pragma unroll
        for (int j = 0; j < 4; ++j) xn[j] = *(const f32x4*)(xr0 + 4 * F.lane + 256 * j); }
    for (int m = F.gw; m < rows; m += F.NGW, ++it) {
        const int v = m < TL ? (m >> 13) : 2;
        f32x4 x[4]; float ss = 0.f;
#pragma unroll
        for (int j = 0; j < 4; ++j) { x[j] = xn[j]; ss += (x[j][0] * x[j][0] + x[j][1] * x[j][1]) + (x[j][2] * x[j][2] + x[j][3] * x[j][3]); }
        { const int mn = m + F.NGW;
          if (mn < rows) { const float* xr1 = mn < TL ? F.out + (size_t)mn * D : (const float*)(ws + WS_XC) + (size_t)(mn - TL) * D;
#pragma unroll
              for (int j = 0; j < 4; ++j) xn[j] = *(const f32x4*)(xr1 + 4 * F.lane + 256 * j); } }
        const float rstd = 1.0f / sqrtf(wave_sum(ss) * (1.0f / D) + EPS);
        float lg[NE];
#pragma unroll
        for (int e = 0; e < NE; ++e) lg[e] = 0.f;
#pragma unroll
        for (int j = 0; j < 4; ++j) {
            const int col = 4 * F.lane + 256 * j;
            const f32x4 nw = *(const f32x4*)(a->in[I_NORM2] + l * D + col);
            const f32x4 sh = *(const f32x4*)(mod + (l * 3 + v) * 6144 + 3 * D + col);
            const f32x4 sc = *(const f32x4*)(mod + (l * 3 + v) * 6144 + 4 * D + col);
            const f32x4 h = x[j] * rstd * nw * (1.0f + sc) + sh;
            u32x2 o; o.x = pk2(h[0], h[1]); o.y = pk2(h[2], h[3]);
            *(u32x2*)(H + (size_t)m * D + col) = o;
#pragma unroll
            for (int e = 0; e < NE; ++e) { const f32x4 w = *(const LAS f32x4*)(wrt + e * D + col); lg[e] += (h[0] * w[0] + h[1] * w[1]) + (h[2] * w[2] + h[3] * w[3]); if ((e & 3) == 3) asm volatile("" ::: "memory"); }
        }
#pragma unroll
        for (int e = 0; e < NE; ++e) lg[e] = wave_sum(lg[e]);
        float s[NE], sb[NE];
#pragma unroll
        for (int e = 0; e < NE; ++e) { s[e] = 1.0f / (1.0f + expf(-lg[e])); sb[e] = s[e] + a->in[I_BROUTER][e]; }
        int gsel = 0; float gbest = -1e30f;
#pragma unroll
        for (int g = 0; g < 4; ++g) {
            float m1 = -1e30f, m2 = -1e30f;
#pragma unroll
            for (int i = 0; i < 4; ++i) { const float val = sb[4 * g + i]; if (val > m1) { m2 = m1; m1 = val; } else if (val > m2) m2 = val; }
            const float gs = m1 + m2; if (gs > gbest) { gbest = gs; gsel = g; }
        }
        int e0 = 0, e1 = 0; float b0 = -1e30f, b1 = -1e30f, s0 = 0.f, s1 = 0.f;
#pragma unroll
        for (int e = 0; e < NE; ++e) {
            if ((e >> 2) == gsel) { const float val = sb[e];
                if (val > b0) { b1 = b0; e1 = e0; s1 = s0; b0 = val; e0 = e; s0 = s[e]; } else if (val > b1) { b1 = val; e1 = e; s1 = s[e]; } }
        }
        if (F.lane == 0 && do_route && it >= RT_PER_WAVE) {
            const float inv = 1.0f / (s0 + s1);
            const unsigned p0 = atomicAdd(cnt + e0 * CNT_STRIDE, 1u); list[(size_t)e0 * LISTCAP + p0] = (unsigned)m * 2u; listw[(size_t)e0 * LISTCAP + p0] = s0 * inv;
            const unsigned p1 = atomicAdd(cnt + e1 * CNT_STRIDE, 1u); list[(size_t)e1 * LISTCAP + p1] = (unsigned)m * 2u + 1u; listw[(size_t)e1 * LISTCAP + p1] = s1 * inv;
        } else
        if (F.lane == 0 && do_route) {
            const float inv = 1.0f / (s0 + s1);
            const int slot = F.wave * RT_PER_WAVE + it;
            const unsigned l0 = atomicAdd((unsigned*)(lcnt + e0), 1u), l1 = atomicAdd((unsigned*)(lcnt + e1), 1u);
            rec[slot * 4 + 0] = (unsigned)m; rec[slot * 4 + 1] = (unsigned)e0 | ((unsigned)e1 << 8) | (l0 << 16) | (l1 << 24);
            rec[slot * 4 + 2] = __float_as_uint(s0 * inv); rec[slot * 4 + 3] = __float_as_uint(s1 * inv);
        }
    }
    __syncthreads();
    if (do_route) {
        if (F.tid < NE) { const unsigned c = lcnt[F.tid]; lbase[F.tid] = c ? atomicAdd(cnt + F.tid * CNT_STRIDE, c) : 0u; }
        __syncthreads();
        for (int i = F.tid; i < NWAVES * RT_PER_WAVE; i += NWAVES * 64) {
            const int wv = i / RT_PER_WAVE, k = i % RT_PER_WAVE;
            if (F.vcu * NWAVES + wv + k * F.NGW < rows) {
                const unsigned m = rec[i * 4], pk = rec[i * 4 + 1]; const unsigned e0 = pk & 255u, e1 = (pk >> 8) & 255u, l0 = (pk >> 16) & 255u, l1 = pk >> 24;
                const unsigned p0 = lbase[e0] + l0, p1 = lbase[e1] + l1;
                list[(size_t)e0 * LISTCAP + p0] = m * 2u; listw[(size_t)e0 * LISTCAP + p0] = __uint_as_float(rec[i * 4 + 2]);
                list[(size_t)e1 * LISTCAP + p1] = m * 2u + 1u; listw[(size_t)e1 * LISTCAP + p1] = __uint_as_float(rec[i * 4 + 3]);
            }
        }
    }
    __syncthreads();
}

__device__ __forceinline__ void moe_setup(pg8::MoeOrder& S, const Frame& F, int cset, int nN) {
    unsigned* cnt = (unsigned*)(F.ws + WS_CTL) + CW_CNT + cset * NE * CNT_STRIDE;
    LAS int* tab = (LAS int*)(F.lds + MISC_OFF + 64);
    __syncthreads();
    if (F.tid == 0) { int run = 0;
        for (int e = 0; e < NE; ++e) { const int c = (int)__hip_atomic_load(cnt + e * CNT_STRIDE, __ATOMIC_RELAXED, __HIP_MEMORY_SCOPE_AGENT); tab[e] = c; run += (c + 255) >> 8; tab[16 + e] = run; } }
    __syncthreads();
    S.tab = tab; S.nN = nN; S.nunits = __builtin_amdgcn_readfirstlane(tab[31]) * nN; S.G = F.G; S.c = (int)blockIdx.x;
    S.list = (const unsigned*)(F.ws + WS_LIST);
}
__device__ __forceinline__ void moe1_phase(const Frame& F, const CAS Args* a, int l, int cset) {
    pg8::MoeOrder S; moe_setup(S, F, cset, 4);
    S.A = (const char*)(F.ws + WS_H); S.Bt = (const char*)(F.ws + WS_WGU) + (size_t)l * NE * D * D * 2; S.K = D; S.bstride_e = (size_t)D * D * 2; S.gather = true;
    EpiGU E{(bf16*)(F.ws + WS_HMID)};
    pg8::gemm_phase<EpiGU, pg8::MoeOrder>(F.lds, F.tid, S, E);
    if (l == 0 && cset == 0) convert_moe_filler(F, a, 1, S.nunits);
}
__device__ __forceinline__ void moe2_phase(const Frame& F, const CAS Args* a, int l, int cset) {
    pg8::MoeOrder S; moe_setup(S, F, cset, 4);
    S.A = (const char*)(F.ws + WS_HMID); S.Bt = (const char*)(F.ws + WS_WD) + (size_t)l * NE * D * DE * 2; S.K = DE; S.bstride_e = (size_t)D * DE * 2; S.gather = false;
    EpiDown E; E.Y = (bf16*)(F.ws + WS_Y); E.list = (const unsigned*)(F.ws + WS_LIST); E.listw = (const float*)(F.ws + WS_LISTW); E.tab = S.tab;
    pg8::gemm_phase<EpiDown, pg8::MoeOrder>(F.lds, F.tid, S, E);
}

__device__ __forceinline__ void final_load(const Frame& F, int m, f32x4 (&x)[4]) {
    const float* mod = (const float*)(F.ws + WS_MOD);
    const bf16* Y0 = (const bf16*)(F.ws + WS_Y); const bf16* Y1 = Y0 + (size_t)TT * D;
    const int v = m >> 13; const float* xrow = F.out + (size_t)m * D;
#pragma unroll
    for (int j = 0; j < 4; ++j) {
        const int col = 4 * F.lane + 256 * j;
        const f32x4 g2 = *(const f32x4*)(mod + (3 + v) * 6144 + 5 * D + col);
        const f32x4 y = ld_y4(Y0 + (size_t)m * D + col) + ld_y4(Y1 + (size_t)m * D + col);
        x[j] = *(const f32x4*)(xrow + col) + g2 * y;
    }
}
__device__ __forceinline__ void final_row(const Frame& F, const CAS Args* a, int m, const f32x4 (&x)[4]) {
    float* xrow = F.out + (size_t)m * D; float ss = 0.f;
#pragma unroll
    for (int j = 0; j < 4; ++j) ss += (x[j][0] * x[j][0] + x[j][1] * x[j][1]) + (x[j][2] * x[j][2] + x[j][3] * x[j][3]);
    const float rstd = 1.0f / sqrtf(wave_sum(ss) * (1.0f / D) + EPS);
#pragma unroll
    for (int j = 0; j < 4; ++j) { const int col = 4 * F.lane + 256 * j; const f32x4 nw = *(const f32x4*)(a->in[I_FNORM] + col); *(f32x4*)(xrow + col) = x[j] * rstd * nw; }
}
__device__ __forceinline__ void final_phase(const Frame& F, const CAS Args* a) {
    for (int m = F.gw; m < TL; m += 2 * F.NGW) {
        const int m2 = m + F.NGW; const bool two = m2 < TL;
        f32x4 xa[4], xb[4];
        final_load(F, m, xa);
        if (two) final_load(F, m2, xb);
        final_row(F, a, m, xa);
        if (two) final_row(F, a, m2, xb);
    }
}

#ifndef NPASS
#define NPASS 1
#endif
#ifndef PROBE_PH
#define PROBE_PH -1
#endif
#ifndef PROBE_R
#define PROBE_R 3
#endif
constexpr int PH_PER_LAYER = 9;
constexpr int N_PHASES = 1 + DEPTH * PH_PER_LAYER + 1;

template <int ph0>
__device__ __forceinline__ void do_phase(Frame& F, XcdBarrier& bar, LAS unsigned char* lds, int lo, int hi) {
    constexpr int ph = ph0 % N_PHASES, pass = ph0 / N_PHASES;
    if (!(lo <= ph && ph < hi)) return;
    if (pass == 1 && ph != PROBE_PH) return;
    const CAS Args* ap;
        { int l_; asm volatile("v_mbcnt_lo_u32_b32 %0, -1, 0\n\tv_mbcnt_hi_u32_b32 %0, -1, %0" : "=v"(l_)); F.lane = l_; F.tid = F.wave * 64 + l_; ap = (const CAS Args*)__builtin_amdgcn_kernarg_segment_ptr(); asm volatile("" : "+s"(ap)); F.ws = ap->ws; F.out = (pass == 1) ? (float*)(ap->ws + WS_P) : ap->out;
          LAS unsigned char* lb_ = (LAS unsigned char*)lds; asm volatile("" : "+s"(lb_)); __builtin_assume((((unsigned)(__UINTPTR_TYPE__)lb_) & 1023u) == 0u); F.lds = lb_;
          bar.bar = (unsigned*)(F.ws + WS_CTL) + CW_BAR; bar.st = (volatile LAS unsigned*)(F.lds + MISC_OFF) + 8; }
        if (ph == 0) { if (PH_ON(10)) REP(10, true) p0_prologue(F, ap); }
        else if (ph == N_PHASES - 1) { if (PH_ON(11)) REP(11, false) final_phase(F, ap); }
        else {
            const int l = (ph - 1) / PH_PER_LAYER, s = (ph - 1) % PH_PER_LAYER;
            unsigned char* ws = F.ws;
            if (s == 0) { if (PH_ON(0)) REP(0, l == 0) n1_phase(F, ap, l); }
            else if (s == 1 && PH_ON(1)) REP(1, true) {
                pg8::DenseOrder S; S.init(ws + WS_H, ws + WS_WIN + (size_t)l * NIN * D * 2, TT, NIN, D, F.G, (int)blockIdx.x);
                EpiIn E{(bf16*)(ws + WS_P), ap->in[I_BIASF] + l * 256, ap->in[I_BIASB] + l * 256, (const float*)(ws + WS_ROPE), (const float*)(ws + WS_ROPE) + 2048};
                pg8::gemm_phase<EpiIn, pg8::DenseOrder>(F.lds, F.tid, S, E);
            }
            else if (s == 2) { if (PH_ON(2)) REP(2, true) swa_flash(F, ap, l); if (PH_ON(12)) REP(12, true) gla_g1(F, l); }
            else if (s == 3) { if (PH_ON(13)) REP(13, true) gla_scan(F); }
            else if (s == 4) { if (PH_ON(3)) REP(3, true) gla_g3(F, ap, l); }
            else if (s == 5 && PH_ON(4)) REP(4, l == 0) {
                pg8::DenseOrder S; S.init(ws + WS_MIX, ws + WS_WOUT + (size_t)l * D * D * 2, l == 0 ? TT : TL, D, D, F.G, (int)blockIdx.x);
                EpiOut E{l == 0 ? ap->in[I_X] : F.out, l == 0 ? ap->in[I_CTX] : (const float*)(ws + WS_XC), F.out, (float*)(ws + WS_XC), (const float*)(ws + WS_MOD) + l * 3 * 6144};
                pg8::gemm_phase<EpiOut, pg8::DenseOrder>(F.lds, F.tid, S, E);
                if (l == 0 && pass == 0) convert_moe_filler(F, ap, 0, S.nwg);
            }
            else if (s == 6) { if (PH_ON(5)) REP(5, true) n2_route_phase(F, ap, l, rep_ == 0 || pass == 1, l + 2 * pass); }
            else if (s == 7) { if (PH_ON(6)) REP(6, true) moe1_phase(F, ap, l, l); }
            else { if (PH_ON(7)) REP(7, true) moe2_phase(F, ap, l, l); }
        }
        if (ph0 + 1 < NPASS * N_PHASES) for (int rb_ = 0; rb_ < (REPEAT_S == 20 ? REPEAT_N : 1); ++rb_) xcd_barrier(bar, F.tid);
}
template <int... I>
__device__ __forceinline__ void run_all(Frame& F, XcdBarrier& bar, LAS unsigned char* lds, int lo, int hi, std::integer_sequence<int, I...>) { (do_phase<I>(F, bar, lds, lo, hi), ...); }

#ifdef VGPR_CAP
__attribute__((amdgpu_num_vgpr(VGPR_CAP)))
#endif
__global__ void __launch_bounds__(NWAVES * 64, 2) mk_fwd(Args args) {
    extern __shared__ __attribute__((aligned(16))) unsigned char lds[];
    Frame F;
    F.lds = (LAS unsigned char*)lds;
    F.tid = threadIdx.x; F.lane = F.tid & 63; F.wave = __builtin_amdgcn_readfirstlane(F.tid >> 6);
    F.G = gridDim.x; { const int bx = blockIdx.x; F.vcu = (F.G % 8 == 0) ? (bx % 8) * (F.G / 8) + bx / 8 : bx; }
    F.gw = F.vcu * NWAVES + F.wave; F.NGW = F.G * NWAVES;
    const CAS Args* ap = (const CAS Args*)__builtin_amdgcn_kernarg_segment_ptr();
    F.ws = ap->ws; F.out = ap->out;
    volatile LAS unsigned* MISC = (volatile LAS unsigned*)(F.lds + MISC_OFF);
    for (int u = F.tid; u < (LDS_BYTES - LDSCTL_OFF) / 4; u += NWAVES * 64) ((LAS unsigned*)(F.lds + LDSCTL_OFF))[u] = 0u;
    __syncthreads();
    XcdBarrier bar; bar.bar = (unsigned*)(F.ws + WS_CTL) + CW_BAR; bar.x = 0; bar.st = nullptr;
    const bool fused = (ap->ph_hi - ap->ph_lo) > 1;
    if (fused) bar = xcd_barrier_post((unsigned*)(F.ws + WS_CTL) + CW_BAR, MISC + 8);
    const int lo = ap->ph_lo, hi = ap->ph_hi;
    run_all(F, bar, (LAS unsigned char*)lds, lo, hi, std::make_integer_sequence<int, NPASS * N_PHASES>{});
}

extern "C" void kernel_launch(void* const* d_in, const int* in_sizes, int n_in, void* d_out, int out_size, void* d_ws, size_t ws_size, hipStream_t stream) {
    static int grid = 0;
    if (grid == 0) {
        if (n_in != 22 || out_size != TL * D || ws_size < WS_END) { fprintf(stderr, "kernel_launch: unexpected shapes (n_in %d out %d ws %zu)\n", n_in, out_size, ws_size); grid = -1; return; }
        int dev = 0, cus = 0, per_cu = 0;
        if (hipGetDevice(&dev) != hipSuccess || hipDeviceGetAttribute(&cus, hipDeviceAttributeMultiprocessorCount, dev) != hipSuccess) { grid = -1; return; }
        if (hipFuncSetAttribute((const void*)mk_fwd, hipFuncAttributeMaxDynamicSharedMemorySize, LDS_BYTES) != hipSuccess) { fprintf(stderr, "kernel_launch: hipFuncSetAttribute failed\n"); grid = -1; return; }
        if (hipOccupancyMaxActiveBlocksPerMultiprocessor(&per_cu, (const void*)mk_fwd, NWAVES * 64, LDS_BYTES) != hipSuccess || per_cu < 1) fprintf(stderr, "kernel_launch: occupancy query says %d\n", per_cu);
        (void)hipGetLastError();
        grid = cus;
    }
    if (grid < 0) return;
    (void)hipMemsetAsync((char*)d_ws + WS_CTL, 0, CTL_ZERO_BYTES, stream);
    Args a{};
    for (int i = 0; i < 22; ++i) a.in[i] = (const float*)d_in[i];
    a.out = (float*)d_out; a.ws = (unsigned char*)d_ws; a.li = 0; a.pad = 0;
#if MK_N_LAUNCHES == 1
    a.ph_lo = 0; a.ph_hi = N_PHASES;
    hipLaunchKernelGGL(mk_fwd, dim3(grid), dim3(NWAVES * 64), LDS_BYTES, stream, a);
#else
    for (int ph = 0; ph < N_PHASES; ++ph) { a.ph_lo = ph; a.ph_hi = ph + 1; hipLaunchKernelGGL(mk_fwd, dim3(grid), dim3(NWAVES * 64), LDS_BYTES, stream, a); }
#endif
}
```

```cpp
#include <hip/hip_runtime.h>
#include <cstdio>
#include <cstdint>
#include <utility>

#ifndef ONLY_S
#define ONLY_S -1
#endif
#define PH_ON(k) (ONLY_S < 0 || ONLY_S == (k))
#ifndef REPEAT_S
#define REPEAT_S -1
#endif
#ifndef REPEAT_N
#define REPEAT_N 4
#endif
#define REP(k, cond) for (int rep_ = 0; rep_ < ((pass == 1) ? PROBE_R : ((REPEAT_S == (k) && (cond)) ? REPEAT_N : 1)); ++rep_)
#ifndef MK_N_LAUNCHES
#define MK_N_LAUNCHES 1
#endif

#define GAS __attribute__((address_space(1)))
#define LAS __attribute__((address_space(3)))
#define CAS __attribute__((address_space(4)))
typedef unsigned short bf16;
typedef short bf16x8 __attribute__((ext_vector_type(8)));
typedef float f32x4 __attribute__((ext_vector_type(4)));
typedef float f32x2 __attribute__((ext_vector_type(2)));
typedef unsigned u32x4 __attribute__((ext_vector_type(4)));
typedef unsigned u32x2 __attribute__((ext_vector_type(2)));

constexpr int D = 1024, SEQ = 8192, LC = 256, TL = 16384, TC = 512, TT = TL + TC, DEPTH = 2;
constexpr int NE = 16, DE = 512;
constexpr int NIN = 2816;
constexpr int PC_Q = 0, PC_K = 256, PC_V = 512, PC_G = 1024, PC_SQ = 1536, PC_SK = 2048, PC_SV = 2176, PC_GF = 2304, PC_GB = 2560;
constexpr int WIN_COLS = 2336;
constexpr float EPS = 1e-6f;
constexpr float LOG2E = 1.4426950408889634f, QSCALE = 0.125f * LOG2E;
constexpr int LISTCAP = TT;

constexpr size_t MiB = 1u << 20;
constexpr size_t WS_CTL = 0, CTL_ZERO_BYTES = 131072;
constexpr size_t WS_MOD = 1 * MiB;
constexpr size_t WS_ROPE = 1 * MiB + 256 * 1024;
constexpr size_t WS_LIST = 2 * MiB;
constexpr size_t WS_LISTW = 2 * MiB + 1536 * 1024;
constexpr size_t WS_XC = 5 * MiB;
constexpr size_t WS_WIN = 8 * MiB;
constexpr size_t WS_WOUT = 19 * MiB;
constexpr size_t WS_WGU = 23 * MiB;
constexpr size_t WS_WD = 87 * MiB;
constexpr size_t WS_H = 119 * MiB;
constexpr size_t WS_P = 152 * MiB;
constexpr size_t WS_MIX = 243 * MiB;
constexpr size_t WS_GL = 276 * MiB;
constexpr size_t WS_HMID = 152 * MiB;
constexpr size_t WS_Y = 190 * MiB;
constexpr size_t WS_END = 309 * MiB;
static_assert(WS_LIST + (size_t)NE * LISTCAP * 4 <= WS_LISTW && WS_LISTW + (size_t)NE * LISTCAP * 4 <= WS_XC, "ws map");
static_assert(WS_P + (size_t)TT * NIN * 2 <= WS_MIX && WS_MIX + (size_t)TT * D * 2 <= WS_GL, "ws map");
static_assert(WS_HMID + (size_t)37888 * 512 * 2 <= WS_Y && WS_Y + (size_t)2 * TT * D * 2 <= WS_GL, "ws map");
constexpr int CW_CNT = 8192, CNT_STRIDE = 64;
constexpr int CW_TDONE = 16384;
constexpr int CW_BAR = 4096;

__device__ __forceinline__ unsigned f2bf(float f) { unsigned u = __builtin_bit_cast(unsigned, f); return (u + 0x7fffu + ((u >> 16) & 1u)) >> 16; }
__device__ __forceinline__ unsigned pk2(float lo, float hi) { return f2bf(lo) | (f2bf(hi) << 16); }
__device__ __forceinline__ float bf2f(unsigned h) { return __builtin_bit_cast(float, h << 16); }
__device__ __forceinline__ float bflo(unsigned w) { return __builtin_bit_cast(float, w << 16); }
__device__ __forceinline__ float bfhi(unsigned w) { return __builtin_bit_cast(float, w & 0xffff0000u); }
__device__ __forceinline__ float dpp_add(float v, float t) { return v + t; }
#define DPP_F(v, ctrl, rmask) __builtin_bit_cast(float, __builtin_amdgcn_update_dpp(0, __builtin_bit_cast(int, (v)), (ctrl), (rmask), 0xF, false))
__device__ __forceinline__ float row16_sum(float v) {
    v += DPP_F(v, 0xB1, 0xF); v += DPP_F(v, 0x4E, 0xF); v += DPP_F(v, 0x141, 0xF); v += DPP_F(v, 0x140, 0xF); return v;
}
__device__ __forceinline__ float wave_sum(float v) {
    v = row16_sum(v);
    v += DPP_F(v, 0x142, 0xA); v += DPP_F(v, 0x143, 0xC);
    return __builtin_bit_cast(float, __builtin_amdgcn_readlane(__builtin_bit_cast(int, v), 63));
}
__device__ __forceinline__ float silu_f(float x) { return x / (1.0f + __expf(-x)); }
#define LDS_WAIT() asm volatile("s_waitcnt lgkmcnt(0)" ::: "memory")
#define VM_WAIT() asm volatile("s_waitcnt vmcnt(0)" ::: "memory")

namespace pg8 {
constexpr int BM = 256, BK = 64, HALF = 128, HTB = HALF * BK * 2, STAGE_BYTES = 8 * HTB, NXCD = 8, WGM = 8;
__host__ __device__ __forceinline__ int lds_byte(int r, int c) { const int st = (r >> 4) * 2 + (c >> 5), rr = r & 15, cc = c & 31, ob = rr * 64 + cc * 2; return st * 1024 + (ob ^ (((ob >> 9) & 1) << 5)); }
__host__ __device__ __forceinline__ void stage_rc(int b, int& R, int& C) { const int st = b / 1024, sb = b % 1024, swz = sb ^ (((sb >> 9) & 1) << 5); R = (st >> 1) * 16 + swz / 64; C = (st & 1) * 32 + (swz % 64) / 2; }
__host__ __device__ __forceinline__ int perm32(int rho) { const int n = rho >> 4, i = rho & 15; return 8 * (i >> 2) + 4 * n + (i & 3); }

struct Unit { int pm, pn, e, mt; };

__device__ __forceinline__ int xcd_remap(int wgid, int nwg) { const int q = nwg / NXCD, r = nwg % NXCD, xcd = wgid % NXCD, off = wgid / NXCD; return (xcd < r ? xcd * (q + 1) : r * (q + 1) + (xcd - r) * q) + off; }

struct DenseOrder {
    static constexpr bool DYN_A = false;
    const char* A; const char* Bt; int K; int nM, nN, nwg, G, c;
    __device__ void init(const void* A_, const void* Bt_, int M, int N, int K_, int G_, int c_) { A = (const char*)A_; Bt = (const char*)Bt_; K = K_; nM = M / BM; nN = N / BM; nwg = nM * nN; G = G_; c = c_; }
    __device__ __forceinline__ bool next(int i, Unit& u) const {
        const long L = (long)i * G + c; if (L >= nwg) return false;
        const int wgid = xcd_remap((int)L, nwg);
        const int nig = WGM * nN, gid = wgid / nig, fm = gid * WGM, gsz = (nM - fm) < WGM ? (nM - fm) : WGM;
        u.pm = fm + ((wgid % nig) % gsz); u.pn = (wgid % nig) / gsz; u.e = 0; u.mt = 0; return true;
    }
    __device__ __forceinline__ void a_ready(const Unit&, int) const {}
    __device__ __forceinline__ void done(const Unit&, int) const {}
    __device__ __forceinline__ const char* a_ptr(const Unit& u) const { return A + (size_t)u.pm * (size_t)(BM * K * 2); }
    __device__ __forceinline__ const char* b_ptr(const Unit& u) const { return Bt + (size_t)u.pn * (size_t)(BM * K * 2); }
    __device__ __forceinline__ void a_voff(const Unit&, const int (&R)[2], const int (&C)[2], unsigned (&v0)[2], unsigned (&v1)[2]) const {
#pragma unroll
        for (int i = 0; i < 2; ++i) { v0[i] = (unsigned)(R[i] * K + C[i]) * 2u; v1[i] = v0[i] + (unsigned)(HALF * K * 2); }
    }
};

struct MoeOrder {
    static constexpr bool DYN_A = true;
    const char* A; const char* Bt; int K; size_t bstride_e; int G, c, nunits, nN; bool gather;
    const unsigned* list; const LAS int* tab;
    unsigned* tdone; int role;
    __device__ __forceinline__ void a_ready(const Unit& u, int wid) const {
        if (role == 2) {
            if (wid == 0) { unsigned sp = 0;
                while (__hip_atomic_load(tdone + u.pm * 16, __ATOMIC_RELAXED, __HIP_MEMORY_SCOPE_AGENT) < 32u) { __builtin_amdgcn_s_sleep(2); if (++sp > (1u << 22)) break; }
                __builtin_amdgcn_fence(__ATOMIC_ACQUIRE, "agent"); asm volatile("s_waitcnt vmcnt(0)" ::: "memory"); }
            __builtin_amdgcn_s_barrier();
        }
    }
    __device__ __forceinline__ void done(const Unit& u, int lane) const {
        if (role == 1) { asm volatile("s_waitcnt vmcnt(0)" ::: "memory");
            if (lane == 0) __hip_atomic_fetch_add(tdone + u.pm * 16, 1u, __ATOMIC_RELAXED, __HIP_MEMORY_SCOPE_AGENT); }
    }
    __device__ __forceinline__ bool next(int i, Unit& u) const {
        const long L = (long)i * G + c; if (L >= nunits) return false;
        const int wgid = xcd_remap((int)L, nunits);
        const int tl = wgid / nN; u.pn = wgid % nN;
        int e = 0, tstart = 0;
#pragma unroll 1
        for (int k = 0; k < NE - 1; ++k) { const int te = tab[16 + k]; if (tl >= te) { e = k + 1; tstart = te; } }
        u.e = __builtin_amdgcn_readfirstlane(e); u.mt = __builtin_amdgcn_readfirstlane(tl - tstart); u.pm = tl; return true;
    }
    __device__ __forceinline__ const char* a_ptr(const Unit& u) const { return gather ? A : A + (size_t)u.pm * (size_t)(BM * K * 2); }
    __device__ __forceinline__ const char* b_ptr(const Unit& u) const { return Bt + (size_t)u.e * bstride_e + (size_t)u.pn * (size_t)(BM * K * 2); }
    __device__ __forceinline__ void a_voff(const Unit& u, const int (&R)[2], const int (&C)[2], unsigned (&v0)[2], unsigned (&v1)[2]) const {
        if (gather) {
            const int ce = tab[u.e];
            const unsigned* lp = list + (size_t)u.e * LISTCAP + u.mt * BM;
#pragma unroll
            for (int i = 0; i < 2; ++i) {
                const int r0 = R[i], r1 = R[i] + HALF;
                const unsigned t0 = (u.mt * BM + r0 < ce) ? (__builtin_nontemporal_load(lp + r0) >> 1) : 0u;
                const unsigned t1 = (u.mt * BM + r1 < ce) ? (__builtin_nontemporal_load(lp + r1) >> 1) : 0u;
                v0[i] = (t0 * (unsigned)K + (unsigned)C[i]) * 2u; v1[i] = (t1 * (unsigned)K + (unsigned)C[i]) * 2u;
            }
        } else {
#pragma unroll
            for (int i = 0; i < 2; ++i) { v0[i] = (unsigned)(R[i] * K + C[i]) * 2u; v1[i] = v0[i] + (unsigned)(HALF * K * 2); }
        }
    }
};

__device__ __forceinline__ unsigned cvt_pk_bf16(float lo, float hi) { unsigned r; asm volatile("v_cvt_pk_bf16_f32 %0, %1, %2" : "=v"(r) : "v"(lo), "v"(hi)); return r; }

template <class Epi, class Sched>
__device__ __forceinline__ void gemm_phase(LAS unsigned char* lds, int tid, const Sched& S, const Epi& E) {
    const int wid = __builtin_amdgcn_readfirstlane(tid >> 6), lane = tid & 63, wr = wid >> 2, wc = wid & 3, fr = lane & 15, fq = lane >> 4;
    const int K = S.K, nt = K / BK;
    int Rr[2], Cc[2]; unsigned voffB[2];
#pragma unroll
    for (int i = 0; i < 2; ++i) { int R, C; stage_rc(tid * 16 + i * 8192, R, C); const int Rb = Epi::PERM ? ((R & ~31) + perm32(R & 31)) : R;
        Rr[i] = R; Cc[i] = C; voffB[i] = (unsigned)(Rb * K + C) * 2u; }
    const size_t kstep = (size_t)(BK * 2);
    const size_t hstep = (size_t)HALF * K * 2;
    const unsigned ldsw = (unsigned)wid * 1024u;
    const int aoff = lds_byte(wr * 64 + fr, fq * 8), boff = lds_byte(wc * 32 + fr, fq * 8);
#define PG8_SA(b, h) (((b) * 2 + (h)) * HTB)
#define PG8_SB(b, h) ((4 + (b) * 2 + (h)) * HTB)
#define PG8_STAGE(bufoff, gbase, voff) do { _Pragma("unroll") for (int _i = 0; _i < 2; ++_i) \
        __builtin_amdgcn_global_load_lds((const unsigned*)((const char*)(gbase) + (voff)[_i]), (LAS unsigned*)(lds + (bufoff) + ldsw + _i * 8192), 16, 0, 0); } while (0)
#define PG8_LDA(dst, b, h) do { _Pragma("unroll") for (int m = 0; m < 4; ++m) _Pragma("unroll") for (int k = 0; k < 2; ++k) dst[m][k] = *(const LAS bf16x8*)(lds + PG8_SA(b, h) + aoff + m * 2048 + k * 1024); } while (0)
#define PG8_LDB(dst, b, h) do { _Pragma("unroll") for (int n = 0; n < 2; ++n) _Pragma("unroll") for (int k = 0; k < 2; ++k) dst[n][k] = *(const LAS bf16x8*)(lds + PG8_SB(b, h) + boff + n * 2048 + k * 1024); } while (0)
#define PG8_MMA(ai, bj, At, Bt) do { __builtin_amdgcn_s_setprio(1); _Pragma("unroll") for (int m = 0; m < 4; ++m) _Pragma("unroll") for (int n = 0; n < 2; ++n) _Pragma("unroll") for (int k = 0; k < 2; ++k) \
        acc[ai][bj][m][n] = __builtin_amdgcn_mfma_f32_16x16x32_bf16(Bt[n][k], At[m][k], acc[ai][bj][m][n], 0, 0, 0); __builtin_amdgcn_s_setprio(0); } while (0)
#define PG8_WAIT_V(n) asm volatile("s_waitcnt vmcnt(" #n ")" ::: "memory")
#define PG8_WAIT_L(n) asm volatile("s_waitcnt lgkmcnt(" #n ")" ::: "memory")
#define PG8_BAR __builtin_amdgcn_s_barrier()
#define PG8_SCHED __builtin_amdgcn_sched_barrier(0)
    Unit cur, nxt; int ui = 0;
    if (!S.next(0, cur)) return;
    f32x4 acc[2][2][4][2];
#pragma unroll
    for (int a = 0; a < 2; ++a)
#pragma unroll
        for (int b = 0; b < 2; ++b)
#pragma unroll
            for (int m = 0; m < 4; ++m)
#pragma unroll
                for (int n = 0; n < 2; ++n) acc[a][b][m][n] = (f32x4){0.f, 0.f, 0.f, 0.f};
    bf16x8 At[4][2], B0[2][2], B1[2][2];
    const char* cA = S.a_ptr(cur); const char* cB = S.b_ptr(cur);
    unsigned cv0[2], cv1[2], nv0[2], nv1[2];
    S.a_ready(cur, wid);
    S.a_voff(cur, Rr, Cc, cv0, cv1);
    PG8_STAGE(PG8_SB(0, 0), cB, voffB); PG8_STAGE(PG8_SB(0, 1), cB + hstep, voffB); PG8_STAGE(PG8_SA(0, 0), cA, cv0); PG8_STAGE(PG8_SA(0, 1), cA, cv1);
    if (wr == 1) PG8_BAR;
    PG8_WAIT_V(2); PG8_BAR;
    PG8_STAGE(PG8_SB(1, 0), cB + kstep, voffB); PG8_STAGE(PG8_SA(1, 0), cA + kstep, cv0); PG8_STAGE(PG8_SB(1, 1), cB + hstep + kstep, voffB);
    PG8_WAIT_V(6); PG8_BAR;
    for (;;) {
        const bool has_next = S.next(ui + 1, nxt);
        const char* nA = has_next ? S.a_ptr(nxt) : cA; const char* nB = has_next ? S.b_ptr(nxt) : cB;
        if (has_next) S.a_voff(nxt, Rr, Cc, nv0, nv1); else { nv0[0] = cv0[0]; nv0[1] = cv0[1]; nv1[0] = cv1[0]; nv1[1] = cv1[1]; }
        if constexpr (Sched::DYN_A) asm volatile("" : "+v"(nv0[0]), "+v"(nv0[1]), "+v"(nv1[0]), "+v"(nv1[1]));
        for (int t = 0; t < nt; t += 2) {
            const bool last = (t == nt - 2);
            if (last && has_next) S.a_ready(nxt, wid);
            const char* a1 = cA + (size_t)(t + 1) * kstep;
            const char* a2 = last ? nA : cA + (size_t)(t + 2) * kstep; const char* b2 = last ? nB : cB + (size_t)(t + 2) * kstep;
            const char* a3 = a2 + kstep; const char* b3 = b2 + kstep;
            unsigned w0[2], w1[2];
            w0[0] = last ? nv0[0] : cv0[0]; w0[1] = last ? nv0[1] : cv0[1]; w1[0] = last ? nv1[0] : cv1[0]; w1[1] = last ? nv1[1] : cv1[1];
            PG8_LDB(B0, 0, 0); PG8_LDB(B1, 0, 1); PG8_SCHED; PG8_LDA(At, 0, 0); PG8_STAGE(PG8_SA(1, 1), a1, cv1);
            PG8_WAIT_V(8); PG8_WAIT_L(0); PG8_BAR; PG8_MMA(0, 0, At, B0); PG8_MMA(0, 1, At, B1); PG8_BAR; PG8_SCHED;
            PG8_LDA(At, 0, 1); PG8_STAGE(PG8_SB(0, 0), b2, voffB); PG8_STAGE(PG8_SB(0, 1), b2 + hstep, voffB); PG8_STAGE(PG8_SA(0, 0), a2, w0);
            PG8_WAIT_V(8); PG8_WAIT_L(0); PG8_BAR; PG8_MMA(1, 0, At, B0); PG8_MMA(1, 1, At, B1); PG8_BAR; PG8_SCHED;
            PG8_LDB(B0, 1, 0); PG8_LDB(B1, 1, 1); PG8_SCHED; PG8_LDA(At, 1, 0); PG8_STAGE(PG8_SA(0, 1), a2, w1);
            PG8_WAIT_V(8); PG8_WAIT_L(0); PG8_BAR; PG8_MMA(0, 0, At, B0); PG8_MMA(0, 1, At, B1); PG8_BAR; PG8_SCHED;
            PG8_LDA(At, 1, 1); PG8_STAGE(PG8_SB(1, 0), b3, voffB); PG8_STAGE(PG8_SB(1, 1), b3 + hstep, voffB); PG8_STAGE(PG8_SA(1, 0), a3, w0);
            PG8_WAIT_V(8); PG8_WAIT_L(0); PG8_BAR; PG8_MMA(1, 0, At, B0); PG8_MMA(1, 1, At, B1); PG8_BAR; PG8_SCHED;
        }
        if (wr == 0) PG8_BAR;
        E(acc, cur, wr, wc, fr, fq);
        S.done(cur, lane);
        if (!has_next) break;
#pragma unroll
        for (int a = 0; a < 2; ++a)
#pragma unroll
            for (int b = 0; b < 2; ++b)
#pragma unroll
                for (int m = 0; m < 4; ++m)
#pragma unroll
                    for (int n = 0; n < 2; ++n) acc[a][b][m][n] = (f32x4){0.f, 0.f, 0.f, 0.f};
        cur = nxt; cA = nA; cB = nB; ++ui;
        cv0[0] = nv0[0]; cv0[1] = nv0[1]; cv1[0] = nv1[0]; cv1[1] = nv1[1];
        if (wr == 1) PG8_BAR;
    }
    PG8_WAIT_V(0);
    PG8_BAR;
#undef PG8_SA
#undef PG8_SB
#undef PG8_STAGE
#undef PG8_LDA
#undef PG8_LDB
#undef PG8_MMA
#undef PG8_WAIT_V
#undef PG8_WAIT_L
#undef PG8_BAR
#undef PG8_SCHED
}
}

#define XB_TMO      128
#define XB_XCNT(j)  (256  + 64 * (j))
#define XB_XSUB(j)  (1280 + 64 * (j))
#define XB_XGEN(j)  (2304 + 64 * (j))
#define XB_TOP      3328
#define XB_TOPGEN   3392
#define XCD_BAR_WORDS 3456
#define XB_SPIN_CAP (1u << 18)
__device__ __forceinline__ unsigned xb_ld(unsigned* p)              { return __hip_atomic_load(p, __ATOMIC_RELAXED, __HIP_MEMORY_SCOPE_AGENT); }
__device__ __forceinline__ unsigned xb_add(unsigned* p, unsigned v) { return __hip_atomic_fetch_add(p, v, __ATOMIC_RELAXED, __HIP_MEMORY_SCOPE_AGENT); }
__device__ __forceinline__ unsigned xb_xcc_id() { return (unsigned)__builtin_amdgcn_s_getreg((3 << 11) | 20) & 0xFu; }
#define XB_SPIN(cond, bar) do { unsigned _sp = 0; while (cond) { __builtin_amdgcn_s_sleep(1); \
    if ((++_sp & 255u) == 0u) { if (xb_ld(&(bar)[XB_TMO])) break; if (_sp > XB_SPIN_CAP) { atomicAdd(&(bar)[XB_TMO], 1u); break; } } } } while (0)
struct XcdBarrier { unsigned* bar; unsigned x; volatile LAS unsigned* st; };
__device__ __forceinline__ XcdBarrier xcd_barrier_post(unsigned* bar, volatile LAS unsigned* st) {
    XcdBarrier b; b.bar = bar; b.x = xb_xcc_id(); b.st = st;
    if (threadIdx.x == 0) (void)xb_add(&bar[XB_XCNT(b.x)], 1u);
    return b;
}
__device__ __forceinline__ void xcd_barrier_complete(unsigned* bar, unsigned x, unsigned& nloc, unsigned& nx) {
    const unsigned G = gridDim.x * gridDim.y * gridDim.z;
    unsigned sum, cnt, mine, sp = 0u;
    for (;;) {
        sum = 0u; cnt = 0u; mine = 0u;
#pragma unroll
        for (unsigned j = 0; j < 16; ++j) { const unsigned c = xb_ld(&bar[XB_XCNT(j)]); sum += c; cnt += (c > 0u) ? 1u : 0u; mine = (j == x) ? c : mine; }
        if (sum == G) break;
        __builtin_amdgcn_s_sleep(1);
        if ((++sp & 255u) == 0u) { if (xb_ld(&bar[XB_TMO])) break; if (sp > XB_SPIN_CAP) { atomicAdd(&bar[XB_TMO], 1u); break; } }
    }
    nloc = mine > 0u ? mine : 1u; nx = cnt > 0u ? cnt : 1u;
}
__device__ __forceinline__ void xcd_barrier(const XcdBarrier& b, int tid) {
    asm volatile("s_waitcnt vmcnt(0)" ::: "memory");
    __syncthreads();
    if (tid == 0) {
        unsigned* bar = b.bar;
        __builtin_amdgcn_s_waitcnt(0);
        unsigned nloc = b.st[0], nx = b.st[1];
        if (nloc == 0u) { xcd_barrier_complete(bar, b.x, nloc, nx); b.st[0] = nloc; b.st[1] = nx; }
        const unsigned old = xb_add(&bar[XB_XSUB(b.x)], 1u);
        const unsigned gen = old / nloc;
        if (old + 1u == (gen + 1u) * nloc) {
            __builtin_amdgcn_fence(__ATOMIC_RELEASE, "agent");
            asm volatile("s_waitcnt vmcnt(0)" ::: "memory");
            const unsigned og = xb_add(&bar[XB_TOP], 1u);
            const unsigned tg = og / nx;
            if (og + 1u == (tg + 1u) * nx) xb_add(&bar[XB_TOPGEN], 1u);
            else XB_SPIN(xb_ld(&bar[XB_TOPGEN]) == tg, bar);
            __builtin_amdgcn_fence(__ATOMIC_ACQUIRE, "agent");
            xb_add(&bar[XB_XGEN(b.x)], 1u);
            asm volatile("s_waitcnt vmcnt(0)" ::: "memory");
        } else {
            XB_SPIN(xb_ld(&bar[XB_XGEN(b.x)]) == gen, bar);
            __builtin_amdgcn_fence(__ATOMIC_ACQUIRE, "agent");
            asm volatile("s_waitcnt vmcnt(0)" ::: "memory");
        }
    }
    __syncthreads();
}

constexpr int NWAVES = 8;
constexpr int RING_BYTES = 131072, LDSCTL_OFF = RING_BYTES, MISC_OFF = LDSCTL_OFF + 320, LDS_BYTES = 147456;
struct Args { const float* in[22]; float* out; unsigned char* ws; int ph_lo, ph_hi, li, pad; };
enum { I_X = 0, I_C, I_CTX, I_CCTX, I_WADA, I_BADA, I_NORM1, I_NORM2, I_WIN, I_UPF, I_BIASF, I_UPB, I_BIASB, I_GLANORM, I_SINK, I_WOUT, I_WROUTER, I_BROUTER, I_WGATE, I_WUP, I_WDOWN, I_FNORM };

struct Frame {
    LAS unsigned char* lds; int tid, lane, wave, vcu, G, gw, NGW;
    unsigned char* ws; float* out;
};

__device__ __forceinline__ int rope_pos(int d) { return 8 * ((d & 15) >> 2) + 4 * (d >> 4) + (d & 3); }
__device__ __forceinline__ int gu_row(int h, int gu) { return (h >> 7) * 256 + ((h >> 6) & 1) * 128 + ((h >> 4) & 3) * 32 + ((h >> 2) & 3) * 8 + gu * 4 + (h & 3); }
struct TItem { const float* src; bf16* dst; int N, Kd, n0, rbase, mode; bool ok; };
__device__ __forceinline__ void titem_load(const TItem& t, int lane, f32x4 (&v)[8]) {
    const int g = lane >> 3, i8 = lane & 7;
    const float* src = t.src + (size_t)(8 * g) * t.N + 4 * i8;
#pragma unroll
    for (int q = 0; q < 8; ++q) v[q] = *(const f32x4*)(src + (size_t)q * t.N);
}
__device__ __forceinline__ void titem_store(const TItem& t, int lane, const f32x4 (&v)[8]) {
    const int g = lane >> 3, i8 = lane & 7;
#pragma unroll
    for (int i = 0; i < 4; ++i) {
        u32x4 o; o.x = pk2(v[0][i], v[1][i]); o.y = pk2(v[2][i], v[3][i]); o.z = pk2(v[4][i], v[5][i]); o.w = pk2(v[6][i], v[7][i]);
        const int n = 4 * i8 + i;
        const int row = (t.mode == 0) ? t.rbase + n : (t.mode == 1) ? t.rbase + rope_pos(n) : gu_row(t.n0 + n, t.mode - 2);
        *(u32x4*)(t.dst + (size_t)row * t.Kd + 8 * g) = o;
    }
}
constexpr int IT_IN = 2 * 16 * 73, IT_OUT = 2 * 16 * 32, IT_G = 32 * 16 * 16, IT_D = 32 * 8 * 32, NITEMS = IT_IN + IT_OUT + 2 * IT_G + IT_D;
__device__ __forceinline__ TItem titem_decode(const CAS Args* a, unsigned char* ws, int it) {
    TItem t; t.ok = it < NITEMS; t.mode = 0; t.rbase = 0; t.n0 = 0; t.N = D; t.Kd = D; t.src = nullptr; t.dst = nullptr;
    if (!t.ok) return t;
    int r = it;
    if (r < IT_IN) {
        const int l = r / 1168, rr = r % 1168, kb = rr / 73, nb = rr % 73;
        if (nb == 48) { t.ok = false; return t; }
        const int n0 = nb * 32; t.n0 = n0;
        if (n0 < 1536) t.rbase = n0;
        else if (n0 < 2080) { t.rbase = PC_SQ + (n0 - 1568); t.mode = 1; }
        else if (n0 < 2208) { t.rbase = PC_SK + (n0 - 2080); t.mode = 1; }
        else t.rbase = PC_SV + (n0 - 2208);
        t.N = WIN_COLS; t.Kd = D; t.src = a->in[I_WIN] + (size_t)l * D * WIN_COLS + (size_t)(kb * 64) * WIN_COLS + n0; t.dst = (bf16*)(ws + WS_WIN) + (size_t)l * NIN * D + kb * 64;
        return t;
    }
    r -= IT_IN;
    if (r < IT_OUT) { const int l = r / 512, rr = r % 512, kb = rr / 32, nb = rr % 32;
        t.n0 = nb * 32; t.rbase = nb * 32; t.N = D; t.Kd = D; t.src = a->in[I_WOUT] + (size_t)l * D * D + (size_t)(kb * 64) * D + nb * 32; t.dst = (bf16*)(ws + WS_WOUT) + (size_t)l * D * D + kb * 64; return t; }
    r -= IT_OUT;
    if (r < 2 * IT_G) { const int gu = r / IT_G, r2 = r % IT_G, le = r2 / 256, rr = r2 % 256, kb = rr / 16, nb = rr % 16;
        t.n0 = nb * 32; t.mode = 2 + gu; t.N = DE; t.Kd = D; t.src = a->in[gu ? I_WUP : I_WGATE] + (size_t)le * D * DE + (size_t)(kb * 64) * DE + nb * 32; t.dst = (bf16*)(ws + WS_WGU) + (size_t)le * D * D + kb * 64; return t; }
    r -= 2 * IT_G;
    { const int le = r / 256, rr = r % 256, kb = rr / 32, nb = rr % 32;
        t.n0 = nb * 32; t.rbase = nb * 32; t.N = D; t.Kd = DE; t.src = a->in[I_WDOWN] + (size_t)le * DE * D + (size_t)(kb * 64) * D + nb * 32; t.dst = (bf16*)(ws + WS_WD) + (size_t)le * D * DE + kb * 64; }
    return t;
}

template <class Map>
__device__ __forceinline__ void convert_items(const Frame& F, const CAS Args* a, int n, int worker, int nworkers, Map map) {
    unsigned char* ws = F.ws;
    for (int i = worker; i < n; i += 2 * nworkers) {
        const int i2 = i + nworkers;
        const TItem ta = titem_decode(a, ws, map(i)), tb = titem_decode(a, ws, i2 < n ? map(i2) : NITEMS);
        f32x4 va[8], vb[8];
        if (ta.ok) titem_load(ta, F.lane, va);
        if (tb.ok) titem_load(tb, F.lane, vb);
        if (ta.ok) titem_store(ta, F.lane, va);
        if (tb.ok) titem_store(tb, F.lane, vb);
    }
}
struct MapSmall { __device__ __forceinline__ int operator()(int i) const { return i; } };
struct MapMoe { int l; __device__ __forceinline__ int operator()(int i) const { const int kind = i >> 12, r = i & 4095; return IT_IN + IT_OUT + (kind < 2 ? kind * IT_G : 2 * IT_G) + l * 4096 + r; } };
__device__ __forceinline__ void convert_moe_filler(const Frame& F, const CAS Args* a, int l, int nunits, bool both = false) {
    const int c = (int)blockIdx.x, nfull = nunits % F.G;
    int first = nfull, nf = F.G - nfull - (both ? nfull : 0);
    if (nfull == 0 || nf <= 0) { first = 0; nf = F.G; }
    if (c < first || c >= first + nf) return;
    convert_items(F, a, 3 * 4096, (c - first) * NWAVES + F.wave, nf * NWAVES, MapMoe{l});
}

__device__ __forceinline__ void p0_prologue(const Frame& F, const CAS Args* a) {
    unsigned char* ws = F.ws;
    convert_items(F, a, IT_IN + IT_OUT, F.gw, F.NGW, MapSmall{});
    for (int idx = F.gw * 64 + F.lane; idx < 2 * 2 * 256 * 128; idx += F.NGW * 64) {
        const int kc = idx & 127, n = (idx >> 7) & 255, dir = (idx >> 15) & 1, l = idx >> 16;
        const float* up = a->in[dir ? I_UPB : I_UPF] + (size_t)l * 16 * 256 + n;
        float u[16];
#pragma unroll
        for (int r = 0; r < 16; ++r) u[r] = up[r * 256];
        float o[8];
#pragma unroll
        for (int kk = 0; kk < 8; ++kk) {
            const f32x4* wz = (const f32x4*)(a->in[I_WIN] + ((size_t)l * D + kc * 8 + kk) * WIN_COLS + 1536 + dir * 16);
            float s = 0.f;
#pragma unroll
            for (int q = 0; q < 4; ++q) { const f32x4 w = wz[q]; s += w[0] * u[4 * q] + w[1] * u[4 * q + 1] + w[2] * u[4 * q + 2] + w[3] * u[4 * q + 3]; }
            o[kk] = s;
        }
        u32x4 ov; ov.x = pk2(o[0], o[1]); ov.y = pk2(o[2], o[3]); ov.z = pk2(o[4], o[5]); ov.w = pk2(o[6], o[7]);
        *(u32x4*)((bf16*)(ws + WS_WIN) + ((size_t)l * NIN + PC_GF + dir * 256 + n) * D + kc * 8) = ov;
    }
    if (blockIdx.x == (unsigned)(F.G - 1)) {
        float* tc = (float*)(ws + WS_ROPE); float* tsn = tc + 2048;
        for (int i = F.tid; i < 2048; i += NWAVES * 64) { const int pos = i >> 4, j = i & 15; const float inv = powf(10000.0f, -(float)j * (1.0f / 16.0f)); const float ang = (float)pos * inv;
            tc[i] = cosf(ang); tsn[i] = sinf(ang); }
    }
    __syncthreads();
    {
        LAS float* cs = (LAS float*)F.lds; LAS float* red = cs + 3072;
        for (int i = F.tid; i < 3072; i += NWAVES * 64) { const int v = i >> 10, k = i & 1023; const float cv = v < 2 ? a->in[I_C][v * D + k] : a->in[I_CCTX][k]; cs[i] = cv / (1.0f + expf(-cv)); }
        __syncthreads();
        for (int u = blockIdx.x; u < 192; u += F.G) {
            const int l = u / 96, jg = u % 96, jl = F.tid & 63, ks = F.tid >> 6;
            const float* wp = a->in[I_WADA] + ((size_t)l * D + ks * 128) * 6144 + jg * 64 + jl;
            float a0 = 0.f, a1 = 0.f, a2 = 0.f;
#pragma unroll 1
            for (int k0 = 0; k0 < 128; k0 += 32) {
                float wv[32];
#pragma unroll
                for (int k = 0; k < 32; ++k) wv[k] = wp[(size_t)(k0 + k) * 6144];
#pragma unroll
                for (int k = 0; k < 32; ++k) { const int kk = ks * 128 + k0 + k; a0 += cs[kk] * wv[k]; a1 += cs[1024 + kk] * wv[k]; a2 += cs[2048 + kk] * wv[k]; }
            }
            red[(ks * 3 + 0) * 64 + jl] = a0; red[(ks * 3 + 1) * 64 + jl] = a1; red[(ks * 3 + 2) * 64 + jl] = a2;
            __syncthreads();
            if (F.tid < 192) { const int v = F.tid >> 6, j2 = F.tid & 63; float s = 0.f;
#pragma unroll
                for (int q = 0; q < 8; ++q) s += red[(q * 3 + v) * 64 + j2];
                ((float*)(ws + WS_MOD))[(l * 3 + v) * 6144 + jg * 64 + j2] = s + a->in[I_BADA][l * 6144 + jg * 64 + j2]; }
            __syncthreads();
        }
    }
}

__device__ __forceinline__ f32x4 ld_y4(const bf16* p) { const u32x2 w = *(const u32x2*)p; return (f32x4){bflo(w.x), bfhi(w.x), bflo(w.y), bfhi(w.y)}; }
__device__ __forceinline__ void n1_load(const Frame& F, const CAS Args* a, int l, int m, f32x4 (&x)[4], f32x4 (&y)[4]) {
    unsigned char* ws = F.ws;
    const bf16* Y0 = (const bf16*)(ws + WS_Y); const bf16* Y1 = Y0 + (size_t)TT * D;
    const float* src = (l == 0) ? (m < TL ? a->in[I_X] + (size_t)m * D : a->in[I_CTX] + (size_t)(m - TL) * D) : (m < TL ? F.out + (size_t)m * D : (const float*)(ws + WS_XC) + (size_t)(m - TL) * D);
#pragma unroll
    for (int j = 0; j < 4; ++j) { const int col = 4 * F.lane + 256 * j; x[j] = *(const f32x4*)(src + col);
        if (l > 0) y[j] = ld_y4(Y0 + (size_t)m * D + col) + ld_y4(Y1 + (size_t)m * D + col); }
}
__device__ __forceinline__ void n1_row(const Frame& F, const CAS Args* a, int l, int m, f32x4 (&x)[4], const f32x4 (&y)[4]) {
    unsigned char* ws = F.ws;
    const float* mod = (const float*)(ws + WS_MOD);
    bf16* H = (bf16*)(ws + WS_H);
    const int v = m < TL ? (m >> 13) : 2;
    float* xrow = m < TL ? F.out + (size_t)m * D : (float*)(ws + WS_XC) + (size_t)(m - TL) * D;
    float ss = 0.f;
#pragma unroll
    for (int j = 0; j < 4; ++j) {
        const int col = 4 * F.lane + 256 * j;
        if (l > 0) { const f32x4 g2 = *(const f32x4*)(mod + ((l - 1) * 3 + v) * 6144 + 5 * D + col); x[j] = x[j] + g2 * y[j]; *(f32x4*)(xrow + col) = x[j]; }
        ss += (x[j][0] * x[j][0] + x[j][1] * x[j][1]) + (x[j][2] * x[j][2] + x[j][3] * x[j][3]);
    }
    const float rstd = 1.0f / sqrtf(wave_sum(ss) * (1.0f / D) + EPS);
#pragma unroll
    for (int j = 0; j < 4; ++j) {
        const int col = 4 * F.lane + 256 * j;
        const f32x4 nw = *(const f32x4*)(a->in[I_NORM1] + l * D + col);
        const f32x4 sh = *(const f32x4*)(mod + (l * 3 + v) * 6144 + 0 * D + col);
        const f32x4 sc = *(const f32x4*)(mod + (l * 3 + v) * 6144 + 1 * D + col);
        const f32x4 h = x[j] * rstd * nw * (1.0f + sc) + sh;
        u32x2 o; o.x = pk2(h[0], h[1]); o.y = pk2(h[2], h[3]);
        *(u32x2*)(H + (size_t)m * D + col) = o;
    }
}
__device__ __forceinline__ void n1_phase(const Frame& F, const CAS Args* a, int l) {
    for (int m = F.gw; m < TT; m += 2 * F.NGW) {
        const int m2 = m + F.NGW; const bool two = m2 < TT;
        f32x4 xa[4], ya[4], xb[4], yb[4];
        n1_load(F, a, l, m, xa, ya);
        if (two) n1_load(F, a, l, m2, xb, yb);
        n1_row(F, a, l, m, xa, ya);
        if (two) n1_row(F, a, l, m2, xb, yb);
    }
}

struct EpiIn {
    static constexpr bool PERM = true;
    bf16* P; const float* bias_f; const float* bias_b; const float* tcos; const float* tsin;
    __device__ __forceinline__ void operator()(const f32x4 (&acc)[2][2][4][2], const pg8::Unit& u, int wr, int wc, int fr, int fq) const {
        const int row0 = u.pm * 256 + wr * 64 + fr, colw = wc * 32 + 8 * fq;
        const int pn = u.pn;
        const bool latent = u.pm < 64;
#pragma unroll
        for (int ai = 0; ai < 2; ++ai)
#pragma unroll
            for (int m = 0; m < 4; ++m) {
                const int row = row0 + ai * 128 + m * 16;
                bf16* rowp = P + (size_t)row * NIN + pn * 256 + colw;
#pragma unroll
                for (int bj = 0; bj < 2; ++bj) {
                    f32x4 v0 = acc[ai][bj][m][0], v1 = acc[ai][bj][m][1];
                    if (pn == 0) { v0 = v0 * 0.125f; v1 = v1 * 0.125f; }
                    else if (pn >= 9) {
                        const float* bp = (pn == 9 ? bias_f : bias_b) + colw + bj * 128;
                        const f32x4 b0 = *(const f32x4*)bp, b1 = *(const f32x4*)(bp + 4);
#pragma unroll
                        for (int i = 0; i < 4; ++i) { float x0 = v0[i] + b0[i], x1 = v1[i] + b1[i];
                            v0[i] = (fminf(x0, 0.f) - __logf(1.0f + __expf(-fabsf(x0)))) * 0.0625f; v1[i] = (fminf(x1, 0.f) - __logf(1.0f + __expf(-fabsf(x1)))) * 0.0625f; }
                    } else if (latent && (pn == 6 || pn == 7 || (pn == 8 && bj == 0))) {
                        const int t = row & (SEQ - 1); const int pos = (wc & 1) ? (t & 63) : (t >> 6);
                        const f32x4 cs = *(const f32x4*)(tcos + pos * 16 + 4 * fq), sn = *(const f32x4*)(tsin + pos * 16 + 4 * fq);
                        const f32x4 o0 = v0 * cs - v1 * sn, o1 = v1 * cs + v0 * sn; v0 = o0; v1 = o1;
                    }
                    if (pn == 6 || pn == 7) { v0 = v0 * QSCALE; v1 = v1 * QSCALE; }
                    u32x4 w; w.x = pg8::cvt_pk_bf16(v0[0], v0[1]); w.y = pg8::cvt_pk_bf16(v0[2], v0[3]); w.z = pg8::cvt_pk_bf16(v1[0], v1[1]); w.w = pg8::cvt_pk_bf16(v1[2], v1[3]);
                    *(u32x4*)(rowp + bj * 128) = w;
                }
            }
    }
};
struct EpiOut {
    static constexpr bool PERM = false;
    const float* resL; const float* resC; float* outL; float* outC; const float* mod_l;
    __device__ __forceinline__ void operator()(const f32x4 (&acc)[2][2][4][2], const pg8::Unit& u, int wr, int wc, int fr, int fq) const {
        const bool latent = u.pm < 64;
        const int v = latent ? (u.pm >> 5) : 2;
        const int rowb = (latent ? u.pm * 256 : u.pm * 256 - TL) + wr * 64 + fr;
        const float* res = latent ? resL : resC; float* out = latent ? outL : outC;
        const int col0 = u.pn * 256 + wc * 32 + 4 * fq;
        const float* g1p = mod_l + v * 6144 + 2 * D + col0;
#pragma unroll
        for (int ai = 0; ai < 2; ++ai)
#pragma unroll
            for (int m = 0; m < 4; ++m) {
                const size_t off = (size_t)(rowb + ai * 128 + m * 16) * D + col0;
#pragma unroll
                for (int bj = 0; bj < 2; ++bj)
#pragma unroll
                    for (int n = 0; n < 2; ++n) {
                        const f32x4 g1 = *(const f32x4*)(g1p + bj * 128 + n * 16);
                        const f32x4 r = *(const f32x4*)(res + off + bj * 128 + n * 16);
                        *(f32x4*)(out + off + bj * 128 + n * 16) = r + g1 * acc[ai][bj][m][n];
                    }
                if (m & 1) asm volatile("" ::: "memory");
            }
    }
};
struct EpiGU {
    static constexpr bool PERM = true;
    bf16* Hmid;
    __device__ __forceinline__ void operator()(const f32x4 (&acc)[2][2][4][2], const pg8::Unit& u, int wr, int wc, int fr, int fq) const {
        const int row0 = u.pm * 256 + wr * 64 + fr, hid0 = u.pn * 128 + wc * 16 + fq * 4;
#pragma unroll
        for (int ai = 0; ai < 2; ++ai)
#pragma unroll
            for (int m = 0; m < 4; ++m) {
                bf16* rowp = Hmid + (size_t)(row0 + ai * 128 + m * 16) * DE + hid0;
#pragma unroll
                for (int bj = 0; bj < 2; ++bj) {
                    const f32x4 g = acc[ai][bj][m][0], up = acc[ai][bj][m][1]; f32x4 o;
#pragma unroll
                    for (int i = 0; i < 4; ++i) o[i] = g[i] * __builtin_amdgcn_rcpf(1.0f + __expf(-g[i])) * up[i];
                    u32x2 w; w.x = pg8::cvt_pk_bf16(o[0], o[1]); w.y = pg8::cvt_pk_bf16(o[2], o[3]);
                    __hip_atomic_store((unsigned long long*)(rowp + bj * 64), ((unsigned long long)w.y << 32) | w.x, __ATOMIC_RELAXED, __HIP_MEMORY_SCOPE_AGENT);
                }
            }
    }
};
struct EpiDown {
    static constexpr bool PERM = true;
    bf16* Y; const unsigned* list; const float* listw; const LAS int* tab;
    __device__ __forceinline__ void operator()(const f32x4 (&acc)[2][2][4][2], const pg8::Unit& u, int wr, int wc, int fr, int fq) const {
        const int ce = tab[u.e];
        const int r0 = u.mt * 256 + wr * 64 + fr, col0 = u.pn * 256 + wc * 32 + 8 * fq;
        const unsigned* lp = list + (size_t)u.e * LISTCAP; const float* lw = listw + (size_t)u.e * LISTCAP;
#pragma unroll
        for (int ai = 0; ai < 2; ++ai)
#pragma unroll
            for (int m = 0; m < 4; ++m) {
                const int r = r0 + ai * 128 + m * 16;
                if (r < ce) {
                    const unsigned ts = __builtin_nontemporal_load(lp + r); const float w = __builtin_nontemporal_load(lw + r);
                    bf16* rowp = Y + ((size_t)(ts & 1u) * TT + (ts >> 1)) * D + col0;
#pragma unroll
                    for (int bj = 0; bj < 2; ++bj) {
                        const f32x4 v0 = acc[ai][bj][m][0] * w, v1 = acc[ai][bj][m][1] * w;
                        u32x4 o; o.x = pg8::cvt_pk_bf16(v0[0], v0[1]); o.y = pg8::cvt_pk_bf16(v0[2], v0[3]); o.z = pg8::cvt_pk_bf16(v1[0], v1[1]); o.w = pg8::cvt_pk_bf16(v1[2], v1[3]);
                        *(u32x4*)(rowp + bj * 128) = o;
                    }
                }
            }
    }
};

__device__ __forceinline__ void swa_naive(const Frame& F, const CAS Args* a, int l) {
    const bf16* P = (const bf16*)(F.ws + WS_P); bf16* MIX = (bf16*)(F.ws + WS_MIX);
    const int total = (l == 0 ? TT : TL) * 8;
    for (int idx = F.gw * 64 + F.lane; idx < total; idx += F.NGW * 64) {
        const int m = idx >> 3, hq = idx & 7, kvh = hq >> 2;
        const bool latent = m < TL;
        const int b = latent ? (m >> 13) : ((m - TL) >> 8), t = m & (SEQ - 1);
        float q[64];
        { const u32x4* qp = (const u32x4*)(P + (size_t)m * NIN + PC_SQ + hq * 64);
#pragma unroll
          for (int c = 0; c < 8; ++c) { const u32x4 w = qp[c]; q[8 * c] = bflo(w.x); q[8 * c + 1] = bfhi(w.x); q[8 * c + 2] = bflo(w.y); q[8 * c + 3] = bfhi(w.y);
              q[8 * c + 4] = bflo(w.z); q[8 * c + 5] = bfhi(w.z); q[8 * c + 6] = bflo(w.w); q[8 * c + 7] = bfhi(w.w); } }
        float o[64];
#pragma unroll
        for (int d = 0; d < 64; ++d) o[d] = 0.f;
        const float sink = a->in[I_SINK][l * 8 + hq] * LOG2E;
        float mx = sink, den = 1.0f;
        const int lo = latent ? (t - 128 < 0 ? 0 : t - 128) : 0, hi = latent ? (t + 128 > SEQ - 1 ? SEQ - 1 : t + 128) : -1;
        const int nloc = hi - lo + 1;
        for (int kk = 0; kk < nloc + LC; ++kk) {
            const int krow = kk < nloc ? b * SEQ + lo + kk : TL + b * LC + (kk - nloc);
            const u32x4* kp = (const u32x4*)(P + (size_t)krow * NIN + PC_SK + kvh * 64);
            float s = 0.f;
#pragma unroll
            for (int c = 0; c < 8; ++c) { const u32x4 w = kp[c]; s += q[8 * c] * bflo(w.x) + q[8 * c + 1] * bfhi(w.x) + q[8 * c + 2] * bflo(w.y) + q[8 * c + 3] * bfhi(w.y)
                + q[8 * c + 4] * bflo(w.z) + q[8 * c + 5] * bfhi(w.z) + q[8 * c + 6] * bflo(w.w) + q[8 * c + 7] * bfhi(w.w); }
            const float mn = fmaxf(mx, s), f = exp2f(mx - mn), p = exp2f(s - mn);
            den = den * f + p; mx = mn;
            const u32x4* vp = (const u32x4*)(P + (size_t)krow * NIN + PC_SV + kvh * 64);
#pragma unroll
            for (int c = 0; c < 8; ++c) { const u32x4 w = vp[c];
                o[8 * c] = o[8 * c] * f + p * bflo(w.x); o[8 * c + 1] = o[8 * c + 1] * f + p * bfhi(w.x); o[8 * c + 2] = o[8 * c + 2] * f + p * bflo(w.y); o[8 * c + 3] = o[8 * c + 3] * f + p * bfhi(w.y);
                o[8 * c + 4] = o[8 * c + 4] * f + p * bflo(w.z); o[8 * c + 5] = o[8 * c + 5] * f + p * bfhi(w.z); o[8 * c + 6] = o[8 * c + 6] * f + p * bflo(w.w); o[8 * c + 7] = o[8 * c + 7] * f + p * bfhi(w.w); }
        }
        const float inv = 1.0f / den;
        u32x4* op = (u32x4*)(MIX + (size_t)m * D + 512 + hq * 64);
#pragma unroll
        for (int c = 0; c < 8; ++c) { u32x4 w; w.x = pk2(o[8 * c] * inv, o[8 * c + 1] * inv); w.y = pk2(o[8 * c + 2] * inv, o[8 * c + 3] * inv); w.z = pk2(o[8 * c + 4] * inv, o[8 * c + 5] * inv); w.w = pk2(o[8 * c + 6] * inv, o[8 * c + 7] * inv); op[c] = w; }
    }
}


typedef float f32x16 __attribute__((ext_vector_type(16)));
typedef short s16x4 __attribute__((ext_vector_type(4)));
__device__ __forceinline__ int crow(int r, int hi) { return (r & 3) + 8 * (r >> 2) + 4 * hi; }
__device__ __forceinline__ s16x4 vtr(const LAS unsigned char* p) { return __builtin_bit_cast(s16x4, __builtin_amdgcn_ds_read_tr16_b64_v4i16((LAS s16x4*)p)); }
constexpr int SWA_K = 0, SWA_V = 49152;
__device__ __forceinline__ void swa_tile(const LAS unsigned char* Kt, const LAS unsigned char* Vt, int mtype, const bf16x8 (&qf)[2][4], f32x16 (&o)[2][2], float (&mrun)[2], float (&lrun)[2], int lane) {
    const int r32 = lane & 31, hi = lane >> 5;
    const LAS unsigned char* vp = Vt + ((lane >> 4) & 1) * 32 + (lane & 3) * 8 + (4 * hi + ((lane & 15) >> 2)) * 64;
#pragma unroll
    for (int kb = 0; kb < 2; ++kb) {
        f32x16 s[2];
#pragma unroll
        for (int d0 = 0; d0 < 4; ++d0) {
            const bf16x8 kf = *(const LAS bf16x8*)(Kt + (2 * d0 + hi) * 1024 + (32 * kb + r32) * 16);
#pragma unroll
            for (int qt = 0; qt < 2; ++qt) {
                if (d0 == 0) { f32x16 z;
#pragma unroll
                    for (int r = 0; r < 16; ++r) z[r] = 0.f;
                    s[qt] = __builtin_amdgcn_mfma_f32_32x32x16_bf16(kf, qf[qt][0], z, 0, 0, 0); }
                else s[qt] = __builtin_amdgcn_mfma_f32_32x32x16_bf16(kf, qf[qt][d0], s[qt], 0, 0, 0);
            }
        }
        bf16x8 pf[2][2];
#pragma unroll
        for (int qt = 0; qt < 2; ++qt) {
            if (mtype != 0) {
                int thr = r32 + 32 * qt - 4 * hi - 32 * kb; asm volatile("" : "+v"(thr));
                if (mtype == 1) {
#pragma unroll
                    for (int r = 0; r < 16; ++r) { const int cc = (r & 3) + 8 * (r >> 2); if (cc < thr) s[qt][r] = -INFINITY; }
                } else {
#pragma unroll
                    for (int r = 0; r < 16; ++r) { const int cc = (r & 3) + 8 * (r >> 2); if (cc > thr) s[qt][r] = -INFINITY; }
                }
            }
            float rm = s[qt][0];
#pragma unroll
            for (int r = 1; r < 16; ++r) rm = fmaxf(rm, s[qt][r]);
            { auto rr = __builtin_amdgcn_permlane32_swap(__float_as_uint(rm), __float_as_uint(rm), false, false); rm = fmaxf(__uint_as_float(rr[0]), __uint_as_float(rr[1])); }
            const float mn = fmaxf(mrun[qt], rm);
            if (__any(mn > mrun[qt])) {
                const float alpha = __builtin_amdgcn_exp2f(mrun[qt] - mn);
                lrun[qt] *= alpha;
#pragma unroll
                for (int dt = 0; dt < 2; ++dt)
#pragma unroll
                    for (int r = 0; r < 16; ++r) o[dt][qt][r] *= alpha;
                mrun[qt] = mn;
            }
            float rs = 0.f;
#pragma unroll
            for (int r = 0; r < 16; ++r) { const float p = __builtin_amdgcn_exp2f(s[qt][r] - mn); s[qt][r] = p; rs += p; }
            lrun[qt] += rs;
#pragma unroll
            for (int sp = 0; sp < 2; ++sp) {
                u32x4 w; w.x = pg8::cvt_pk_bf16(s[qt][8 * sp + 0], s[qt][8 * sp + 1]); w.y = pg8::cvt_pk_bf16(s[qt][8 * sp + 2], s[qt][8 * sp + 3]);
                w.z = pg8::cvt_pk_bf16(s[qt][8 * sp + 4], s[qt][8 * sp + 5]); w.w = pg8::cvt_pk_bf16(s[qt][8 * sp + 6], s[qt][8 * sp + 7]);
                pf[qt][sp] = __builtin_bit_cast(bf16x8, w);
            }
        }
#pragma unroll
        for (int dt = 0; dt < 2; ++dt)
#pragma unroll
            for (int sp = 0; sp < 2; ++sp) {
                const int ks = 2 * kb + sp;
                const s16x4 lo = vtr(vp + dt * 4096 + ks * 1024), hi4 = vtr(vp + dt * 4096 + ks * 1024 + 512);
                const bf16x8 vf = (bf16x8){lo[0], lo[1], lo[2], lo[3], hi4[0], hi4[1], hi4[2], hi4[3]};
#pragma unroll
                for (int qt = 0; qt < 2; ++qt) o[dt][qt] = __builtin_amdgcn_mfma_f32_32x32x16_bf16(vf, pf[qt][sp], o[dt][qt], 0, 0, 0);
            }
    }
}
__device__ __forceinline__ void swa_stage(const Frame& F, const bf16* P, int grow, int kvh, int ti) {
    { const int key = 8 * F.wave + (F.lane & 7), ch = F.lane >> 3;
      const u32x4 v = *(const u32x4*)(P + (size_t)(grow + key) * NIN + PC_SK + kvh * 64 + ch * 8);
      *(LAS u32x4*)(F.lds + SWA_K + ti * 8192 + ch * 1024 + key * 16) = v; }
    { const int key = 8 * F.wave + (F.lane >> 3), ch = F.lane & 7;
      const u32x4 v = *(const u32x4*)(P + (size_t)(grow + key) * NIN + PC_SV + kvh * 64 + ch * 8);
      *(LAS u32x4*)(F.lds + SWA_V + ti * 8192 + (ch >> 2) * 4096 + key * 64 + (ch & 3) * 16) = v; }
}
__device__ __forceinline__ void swa_flash(const Frame& F, const CAS Args* a, int l) {
    const bf16* P = (const bf16*)(F.ws + WS_P); bf16* MIX = (bf16*)(F.ws + WS_MIX);
    const int nunits = 256 + (l == 0 ? 8 : 0);
    const int lane = F.lane, r32 = lane & 31, hi = lane >> 5;
    for (int u = F.vcu; u < nunits; u += F.G) {
        const bool latent = u < 256;
        const int b = latent ? (u >> 7) : ((u - 256) >> 2), kvh = latent ? ((u >> 6) & 1) : (((u - 256) >> 1) & 1), qb = latent ? (u & 63) : ((u - 256) & 1);
        const int q0 = qb * 128, g = F.wave >> 1, qs = F.wave & 1, hq = kvh * 4 + g;
        const int mrow0 = (latent ? b * SEQ : TL + b * LC) + q0 + 64 * qs;
        bf16x8 qf[2][4];
#pragma unroll
        for (int qt = 0; qt < 2; ++qt)
#pragma unroll
            for (int d0 = 0; d0 < 4; ++d0) qf[qt][d0] = *(const bf16x8*)(P + (size_t)(mrow0 + 32 * qt + r32) * NIN + PC_SQ + hq * 64 + 16 * d0 + 8 * hi);
        f32x16 o[2][2];
#pragma unroll
        for (int dt = 0; dt < 2; ++dt)
#pragma unroll
            for (int qt = 0; qt < 2; ++qt)
#pragma unroll
                for (int r = 0; r < 16; ++r) o[dt][qt][r] = 0.f;
        const float sink2 = a->in[I_SINK][l * 8 + hq] * LOG2E;
        float mrun[2] = {sink2, sink2}, lrun[2] = {hi == 0 ? 1.f : 0.f, hi == 0 ? 1.f : 0.f};
        if (latent) {
#pragma unroll 1
            for (int j = 0; j < 6; ++j) { const int ks = q0 - 128 + 64 * j; if (ks >= 0 && ks < SEQ) swa_stage(F, P, b * SEQ + ks, kvh, j); }
            __syncthreads();
#pragma unroll 1
            for (int tt = 0; tt < 5; ++tt) { const int j = qs + tt, ks = q0 - 128 + 64 * j;
                if (ks >= 0 && ks < SEQ) swa_tile(F.lds + SWA_K + j * 8192, F.lds + SWA_V + j * 8192, tt == 0 ? 1 : (tt == 4 ? 2 : 0), qf, o, mrun, lrun, lane); }
            __syncthreads();
        }
#pragma unroll 1
        for (int j = 0; j < 4; ++j) swa_stage(F, P, TL + b * LC + 64 * j, kvh, j);
        __syncthreads();
#pragma unroll 1
        for (int j = 0; j < 4; ++j) swa_tile(F.lds + SWA_K + j * 8192, F.lds + SWA_V + j * 8192, 0, qf, o, mrun, lrun, lane);
        __syncthreads();
#pragma unroll
        for (int qt = 0; qt < 2; ++qt) {
            float lt = lrun[qt];
            { auto rr = __builtin_amdgcn_permlane32_swap(__float_as_uint(lt), __float_as_uint(lt), false, false); lt = __uint_as_float(rr[0]) + __uint_as_float(rr[1]); }
            const float inv = 1.0f / lt;
            bf16* op = MIX + (size_t)(mrow0 + 32 * qt + r32) * D + 512 + hq * 64 + 4 * hi;
#pragma unroll
            for (int dt = 0; dt < 2; ++dt)
#pragma unroll
                for (int rg = 0; rg < 4; ++rg) {
                    u32x2 w; w.x = pk2(o[dt][qt][4 * rg] * inv, o[dt][qt][4 * rg + 1] * inv); w.y = pk2(o[dt][qt][4 * rg + 2] * inv, o[dt][qt][4 * rg + 3] * inv);
                    *(u32x2*)(op + 32 * dt + 8 * rg) = w;
                }
        }
    }
}


constexpr size_t WS_US = WS_GL, WS_USC = WS_GL + 32 * MiB, WS_DEC = 7 * MiB;
static_assert(WS_USC + (size_t)16 * 4 * 8192 * 2 <= WS_END && WS_DEC + (size_t)16 * 132 * 64 * 4 <= WS_WIN, "ws map (gla)");
constexpr int GL_V = 0, GL_M0 = 16384, GL_MSZ = 64 * 72 * 2, GL_RED = GL_M0 + 4 * GL_MSZ;
__device__ __forceinline__ float wave_scan_incl(float v) {
    v += DPP_F(v, 0x111, 0xF); v += DPP_F(v, 0x112, 0xF); v += DPP_F(v, 0x114, 0xF); v += DPP_F(v, 0x118, 0xF);
    v += DPP_F(v, 0x142, 0xA); v += DPP_F(v, 0x143, 0xC); return v;
}
__device__ __forceinline__ float lane63(float v) { return __builtin_bit_cast(float, __builtin_amdgcn_readlane(__builtin_bit_cast(int, v), 63)); }
__device__ __forceinline__ void unpack8(const u32x4 w, float (&f)[8]) { f[0] = bflo(w.x); f[1] = bfhi(w.x); f[2] = bflo(w.y); f[3] = bfhi(w.y); f[4] = bflo(w.z); f[5] = bfhi(w.z); f[6] = bflo(w.w); f[7] = bfhi(w.w); }
__device__ __forceinline__ void gla_stage_v(const Frame& F, const bf16* P, int m0, int h) {
#pragma unroll
    for (int i = 0; i < 2; ++i) { const int p = F.tid + 512 * i, t = p >> 4, ch = p & 15;
        const u32x4 v = *(const u32x4*)(P + (size_t)(m0 + t) * NIN + PC_V + h * 128 + ch * 8);
        *(LAS u32x4*)(F.lds + GL_V + (ch >> 2) * 4096 + t * 64 + (ch & 3) * 16) = v; }
}
__device__ __forceinline__ void gla_g1_unit(const Frame& F, const bf16* P, int m0, int h, bf16* Uf, bf16* Ub, float* decf, float* decb) {
    const int w = F.wave, t = F.lane, c = t & 31, hi = t >> 5;
    const bf16* row = P + (size_t)(m0 + t) * NIN + h * 64 + 8 * w;
    float laf[8], lab[8], kk[8];
    unpack8(*(const u32x4*)(row + PC_GF), laf); unpack8(*(const u32x4*)(row + PC_GB), lab); unpack8(*(const u32x4*)(row + PC_K), kk);
    gla_stage_v(F, P, m0, h);
    LAS bf16* KOF = (LAS bf16*)(F.lds + GL_M0); LAS bf16* KOB = (LAS bf16*)(F.lds + GL_M0 + GL_MSZ);
#pragma unroll
    for (int i = 0; i < 8; ++i) {
        const float incf = wave_scan_incl(laf[i]), tf = lane63(incf), incb = wave_scan_incl(lab[i]), tb = lane63(incb);
        KOF[(8 * w + i) * 72 + t] = (bf16)f2bf(kk[i] * __expf(tf - incf));
        KOB[(8 * w + i) * 72 + t] = (bf16)f2bf(kk[i] * __expf(incb - lab[i]));
        if (t == 0) { decf[8 * w + i] = __expf(tf); decb[8 * w + i] = __expf(tb); }
    }
    __syncthreads();
    const int dir = w >> 2, dvt = w & 3;
    const LAS unsigned char* vp = F.lds + GL_V + dvt * 4096 + ((t >> 4) & 1) * 32 + (t & 3) * 8 + ((t & 15) >> 2) * 64 + hi * 512;
    const LAS unsigned char* kb = F.lds + GL_M0 + dir * GL_MSZ + (c * 72 + 8 * hi) * 2;
    f32x16 acc[2];
#pragma unroll
    for (int j = 0; j < 2; ++j)
#pragma unroll
        for (int r = 0; r < 16; ++r) acc[j][r] = 0.f;
#pragma unroll
    for (int sp = 0; sp < 4; ++sp) {
        const s16x4 lo = vtr(vp + sp * 1024), hi4 = vtr(vp + sp * 1024 + 256);
        const bf16x8 vf = (bf16x8){lo[0], lo[1], lo[2], lo[3], hi4[0], hi4[1], hi4[2], hi4[3]};
#pragma unroll
        for (int j = 0; j < 2; ++j) { const bf16x8 kf = *(const LAS bf16x8*)(kb + j * 32 * 144 + sp * 32); acc[j] = __builtin_amdgcn_mfma_f32_32x32x16_bf16(vf, kf, acc[j], 0, 0, 0); }
    }
    bf16* U = dir ? Ub : Uf;
#pragma unroll
    for (int j = 0; j < 2; ++j)
#pragma unroll
        for (int r = 0; r < 16; ++r) U[(32 * dvt + crow(r, hi)) * 64 + 32 * j + c] = (bf16)f2bf(acc[j][r]);
    __syncthreads();
}
__device__ __forceinline__ void gla_g1(const Frame& F0, int l) {
    Frame F = F0; { int l_; asm volatile("v_mbcnt_lo_u32_b32 %0, -1, 0\n\tv_mbcnt_hi_u32_b32 %0, -1, %0" : "=v"(l_)); F.lane = l_; F.tid = F.wave * 64 + l_; }
    const bf16* P = (const bf16*)(F.ws + WS_P);
    bf16* US = (bf16*)(F.ws + WS_US); bf16* USC = (bf16*)(F.ws + WS_USC); float* DEC = (float*)(F.ws + WS_DEC);
    for (int u = F.vcu; u < 1056; u += F.G) {
        const bool latent = u < 1024; const int cc = u - 1024;
        const int b = latent ? (u >> 9) : (cc >> 4), h = latent ? ((u >> 7) & 3) : ((cc >> 2) & 3), n = latent ? (u & 127) : (cc & 3);
        const int m0 = latent ? b * SEQ + 64 * n : TL + b * LC + 64 * n;
        const int sf = (b * 4 + h) * 2;
        bf16* Uf = latent ? US + ((size_t)sf * 128 + n) * 8192 : USC + ((size_t)sf * 4 + n) * 8192;
        bf16* Ub = latent ? US + ((size_t)(sf + 1) * 128 + n) * 8192 : USC + ((size_t)(sf + 1) * 4 + n) * 8192;
        const int nd = latent ? n : 128 + n;
        gla_g1_unit(F, P, m0, h, Uf, Ub, DEC + ((size_t)sf * 132 + nd) * 64, DEC + ((size_t)(sf + 1) * 132 + nd) * 64);
    }
}
constexpr size_t WS_SS = WS_H, WS_SSC = WS_H + 32 * MiB;
static_assert(WS_SSC + (size_t)16 * 4 * 8192 * 2 <= WS_P, "ws map (gla states)");
__device__ __forceinline__ void gla_scan(const Frame& F) {
    for (int w0 = (F.vcu * NWAVES + F.wave) * 64; w0 < 16 * 4096; w0 += F.G * NWAVES * 64) {
        const int seq = __builtin_amdgcn_readfirstlane(w0 >> 12), ew = __builtin_amdgcn_readfirstlane((w0 & 4095) * 2);
        const int dir = seq & 1;
        const unsigned voff = (unsigned)F.lane * 4u;
        const unsigned doff = (unsigned)((2 * F.lane) & 63) * 4u;
        const char* decb = (const char*)(F.ws + WS_DEC) + (size_t)seq * 132 * 256;
        float s0 = 0.f, s1 = 0.f;
        { const char* ub = (const char*)(F.ws + WS_USC) + ((size_t)seq * 4 * 8192 + ew) * 2; char* sb = (char*)(F.ws + WS_SSC) + ((size_t)seq * 4 * 8192 + ew) * 2;
          unsigned u[4]; f32x2 d[4];
#pragma unroll
          for (int i = 0; i < 4; ++i) { const int n = dir ? 3 - i : i; u[i] = *(const unsigned*)(ub + (size_t)n * 16384 + voff); d[i] = *(const f32x2*)(decb + (size_t)(128 + n) * 256 + doff); }
#pragma unroll
          for (int i = 0; i < 4; ++i) { const int n = dir ? 3 - i : i; *(unsigned*)(sb + (size_t)n * 16384 + voff) = pk2(s0, s1); s0 = d[i][0] * s0 + bflo(u[i]); s1 = d[i][1] * s1 + bfhi(u[i]); } }
        const long stride = dir ? -16384 : 16384, dstride = dir ? -256 : 256;
        const char* ub = (const char*)(F.ws + WS_US) + ((size_t)seq * 128 * 8192 + ew) * 2 + (dir ? (size_t)127 * 16384 : 0);
        char* sb = (char*)(F.ws + WS_SS) + ((size_t)seq * 128 * 8192 + ew) * 2 + (dir ? (size_t)127 * 16384 : 0);
        const char* db = decb + (dir ? 127 * 256 : 0);
#pragma unroll 1
        for (int i0 = 0; i0 < 128; i0 += 32) {
            unsigned u[32]; f32x2 d[32];
#pragma unroll
            for (int j = 0; j < 32; ++j) { u[j] = *(const unsigned*)(ub + j * stride + voff); d[j] = *(const f32x2*)(db + j * dstride + doff); }
#pragma unroll
            for (int j = 0; j < 32; ++j) { *(unsigned*)(sb + j * stride + voff) = pk2(s0, s1); s0 = d[j][0] * s0 + bflo(u[j]); s1 = d[j][1] * s1 + bfhi(u[j]); }
            ub += 32 * stride; sb += 32 * stride; db += 32 * dstride;
        }
    }
}
__device__ __forceinline__ void gla_g3_unit(const Frame& F, const CAS Args* a, int l, const bf16* P, int m0, int h, const bf16* Sf, const bf16* Sb, bf16* MIX) {
    const int w = F.wave, t = F.lane, c = t & 31, hi = t >> 5;
    {
        const bf16* row = P + (size_t)(m0 + t) * NIN + h * 64 + 8 * w;
        float laf[8], lab[8], kk[8], qq[8];
        unpack8(*(const u32x4*)(row + PC_GF), laf); unpack8(*(const u32x4*)(row + PC_GB), lab); unpack8(*(const u32x4*)(row + PC_K), kk); unpack8(*(const u32x4*)(row + PC_Q), qq);
        gla_stage_v(F, P, m0, h);
        float qf[8], kf[8], qb[8], kb[8];
#pragma unroll
        for (int i = 0; i < 8; ++i) {
            const float bf = wave_scan_incl(laf[i]), incb = wave_scan_incl(lab[i]), bb = lane63(incb) - incb + lab[i];
            qf[i] = qq[i] * __expf(bf); kf[i] = kk[i] * __expf(-bf); qb[i] = qq[i] * __expf(bb); kb[i] = kk[i] * __expf(-bb);
        }
        LAS unsigned char* mb = F.lds + GL_M0 + (t * 72 + 8 * w) * 2;
        u32x4 o;
        o.x = pk2(qf[0], qf[1]); o.y = pk2(qf[2], qf[3]); o.z = pk2(qf[4], qf[5]); o.w = pk2(qf[6], qf[7]); *(LAS u32x4*)(mb) = o;
        o.x = pk2(kf[0], kf[1]); o.y = pk2(kf[2], kf[3]); o.z = pk2(kf[4], kf[5]); o.w = pk2(kf[6], kf[7]); *(LAS u32x4*)(mb + GL_MSZ) = o;
        o.x = pk2(qb[0], qb[1]); o.y = pk2(qb[2], qb[3]); o.z = pk2(qb[4], qb[5]); o.w = pk2(qb[6], qb[7]); *(LAS u32x4*)(mb + 2 * GL_MSZ) = o;
        o.x = pk2(kb[0], kb[1]); o.y = pk2(kb[2], kb[3]); o.z = pk2(kb[4], kb[5]); o.w = pk2(kb[6], kb[7]); *(LAS u32x4*)(mb + 3 * GL_MSZ) = o;
    }
    __syncthreads();
    const int dvt = w >> 1, tt = w & 1;
    bf16x8 qfB[4], qbB[4];
    { const LAS unsigned char* qp = F.lds + GL_M0 + ((32 * tt + c) * 72 + 8 * hi) * 2;
#pragma unroll
      for (int kd = 0; kd < 4; ++kd) { qfB[kd] = *(const LAS bf16x8*)(qp + kd * 32); qbB[kd] = *(const LAS bf16x8*)(qp + 2 * GL_MSZ + kd * 32); } }
    bf16x8 pfr[2][2];
#pragma unroll
    for (int st = 0; st < 2; ++st) {
        const LAS unsigned char* kp = F.lds + GL_M0 + GL_MSZ + ((32 * st + c) * 72 + 8 * hi) * 2;
        f32x16 xf, xb;
#pragma unroll
        for (int r = 0; r < 16; ++r) { xf[r] = 0.f; xb[r] = 0.f; }
        const bool needF = st <= tt, needB = st >= tt;
        if (needF) {
#pragma unroll
            for (int kd = 0; kd < 4; ++kd) xf = __builtin_amdgcn_mfma_f32_32x32x16_bf16(*(const LAS bf16x8*)(kp + kd * 32), qfB[kd], xf, 0, 0, 0);
        }
        if (needB) {
#pragma unroll
            for (int kd = 0; kd < 4; ++kd) xb = __builtin_amdgcn_mfma_f32_32x32x16_bf16(*(const LAS bf16x8*)(kp + 2 * GL_MSZ + kd * 32), qbB[kd], xb, 0, 0, 0);
        }
        if (st == tt) {
            int thr = c - 4 * hi; asm volatile("" : "+v"(thr));
#pragma unroll
            for (int r = 0; r < 16; ++r) { const int cc = (r & 3) + 8 * (r >> 2); xf[r] = (cc <= thr ? xf[r] : 0.f) + (cc >= thr ? xb[r] : 0.f); }
        } else {
#pragma unroll
            for (int r = 0; r < 16; ++r) xf[r] += xb[r];
        }
#pragma unroll
        for (int sp = 0; sp < 2; ++sp) {
            u32x4 wv; wv.x = pg8::cvt_pk_bf16(xf[8 * sp + 0], xf[8 * sp + 1]); wv.y = pg8::cvt_pk_bf16(xf[8 * sp + 2], xf[8 * sp + 3]);
            wv.z = pg8::cvt_pk_bf16(xf[8 * sp + 4], xf[8 * sp + 5]); wv.w = pg8::cvt_pk_bf16(xf[8 * sp + 6], xf[8 * sp + 7]);
            pfr[st][sp] = __builtin_bit_cast(bf16x8, wv);
        }
    }
    f32x16 o;
#pragma unroll
    for (int r = 0; r < 16; ++r) o[r] = 0.f;
    { const LAS unsigned char* vp = F.lds + GL_V + dvt * 4096 + ((t >> 4) & 1) * 32 + (t & 3) * 8 + (4 * hi + ((t & 15) >> 2)) * 64;
#pragma unroll
      for (int ks = 0; ks < 4; ++ks) {
          const s16x4 lo = vtr(vp + ks * 1024), hi4 = vtr(vp + ks * 1024 + 512);
          const bf16x8 vf = (bf16x8){lo[0], lo[1], lo[2], lo[3], hi4[0], hi4[1], hi4[2], hi4[3]};
          o = __builtin_amdgcn_mfma_f32_32x32x16_bf16(vf, pfr[ks >> 1][ks & 1], o, 0, 0, 0);
      } }
    { const bf16* sfp = Sf + (32 * dvt + c) * 64 + 8 * hi; const bf16* sbp = Sb + (32 * dvt + c) * 64 + 8 * hi;
#pragma unroll
      for (int kd = 0; kd < 4; ++kd) {
          o = __builtin_amdgcn_mfma_f32_32x32x16_bf16(*(const bf16x8*)(sfp + 16 * kd), qfB[kd], o, 0, 0, 0);
          o = __builtin_amdgcn_mfma_f32_32x32x16_bf16(*(const bf16x8*)(sbp + 16 * kd), qbB[kd], o, 0, 0, 0);
      } }
    float ssq = 0.f;
#pragma unroll
    for (int r = 0; r < 16; ++r) ssq += o[r] * o[r];
    { auto rr = __builtin_amdgcn_permlane32_swap(__float_as_uint(ssq), __float_as_uint(ssq), false, false); ssq = __uint_as_float(rr[0]) + __uint_as_float(rr[1]); }
    LAS float* red = (LAS float*)(F.lds + GL_RED);
    if (hi == 0) red[dvt * 64 + 32 * tt + c] = ssq;
    __syncthreads();
    const float tot = (red[32 * tt + c] + red[64 + 32 * tt + c]) + (red[128 + 32 * tt + c] + red[192 + 32 * tt + c]);
    const float rstd = 1.0f / sqrtf(tot * (1.0f / 128.0f) + EPS);
    const int mrow = m0 + 32 * tt + c;
#pragma unroll
    for (int rg = 0; rg < 4; ++rg) {
        const int dv = 32 * dvt + 8 * rg + 4 * hi;
        const u32x2 gw = *(const u32x2*)(P + (size_t)mrow * NIN + PC_G + h * 128 + dv);
        const f32x4 nw = *(const f32x4*)(a->in[I_GLANORM] + l * 512 + h * 128 + dv);
        const float g0 = bflo(gw.x), g1 = bfhi(gw.x), g2 = bflo(gw.y), g3 = bfhi(gw.y);
        u32x2 ov; ov.x = pk2(o[4 * rg] * rstd * nw[0] * silu_f(g0), o[4 * rg + 1] * rstd * nw[1] * silu_f(g1)); ov.y = pk2(o[4 * rg + 2] * rstd * nw[2] * silu_f(g2), o[4 * rg + 3] * rstd * nw[3] * silu_f(g3));
        *(u32x2*)(MIX + (size_t)mrow * D + h * 128 + dv) = ov;
    }
    __syncthreads();
}
__device__ __forceinline__ void gla_g3(const Frame& F, const CAS Args* a, int l) {
    const bf16* P = (const bf16*)(F.ws + WS_P); bf16* MIX = (bf16*)(F.ws + WS_MIX);
    const bf16* US = (const bf16*)(F.ws + WS_SS); const bf16* USC = (const bf16*)(F.ws + WS_SSC);
    const int nunits = 1024 + (l == 0 ? 32 : 0);
    for (int u = F.vcu; u < nunits; u += F.G) {
        const bool latent = u < 1024; const int cc = u - 1024;
        const int b = latent ? (u >> 9) : (cc >> 4), h = latent ? ((u >> 7) & 3) : ((cc >> 2) & 3), n = latent ? (u & 127) : (cc & 3);
        const int m0 = latent ? b * SEQ + 64 * n : TL + b * LC + 64 * n;
        const int sf = (b * 4 + h) * 2;
        const bf16* Sf = latent ? US + ((size_t)sf * 128 + n) * 8192 : USC + ((size_t)sf * 4 + n) * 8192;
        const bf16* Sb = latent ? US + ((size_t)(sf + 1) * 128 + n) * 8192 : USC + ((size_t)(sf + 1) * 4 + n) * 8192;
        gla_g3_unit(F, a, l, P, m0, h, Sf, Sb, MIX);
    }
}

__device__ __forceinline__ void gla_naive(const Frame& F, const CAS Args* a, int l) {
    const bf16* P = (const bf16*)(F.ws + WS_P);
    bf16* OF = (bf16*)(F.ws + WS_GL);
    for (int w = F.gw; w < 2048; w += F.NGW) {
        const int dv = w & 127, dir = (w >> 7) & 1, h = (w >> 8) & 3, b = w >> 10;
        const int pcg = dir ? PC_GB : PC_GF;
        float S = 0.f;
        for (int step = 0; step < LC + SEQ; ++step) {
            int m;
            if (dir == 0) m = step < LC ? TL + b * LC + step : b * SEQ + (step - LC);
            else m = step < LC ? TL + b * LC + (LC - 1 - step) : b * SEQ + (SEQ - 1 - (step - LC));
            const bf16* row = P + (size_t)m * NIN;
            const float la = bf2f(row[pcg + h * 64 + F.lane]), kk = bf2f(row[PC_K + h * 64 + F.lane]), qq = bf2f(row[PC_Q + h * 64 + F.lane]), vv = bf2f(row[PC_V + h * 128 + dv]);
            S = __expf(la) * S + kk * vv;
            const float o = wave_sum(qq * S);
            if (F.lane == 0) OF[((size_t)dir * TT + m) * 512 + h * 128 + dv] = (bf16)f2bf(o);
        }
    }
}
__device__ __forceinline__ void gla_out_naive(const Frame& F, const CAS Args* a, int l) {
    const bf16* P = (const bf16*)(F.ws + WS_P); bf16* MIX = (bf16*)(F.ws + WS_MIX);
    const bf16* OF = (const bf16*)(F.ws + WS_GL);
    const int rows = (l == 0) ? TT : TL;
    for (int m = F.gw; m < rows; m += F.NGW) {
        const int c0 = 8 * F.lane;
        const u32x4 wa = *(const u32x4*)(OF + (size_t)m * 512 + c0), wb = *(const u32x4*)(OF + ((size_t)TT + m) * 512 + c0);
        float o[8] = {bflo(wa.x) + bflo(wb.x), bfhi(wa.x) + bfhi(wb.x), bflo(wa.y) + bflo(wb.y), bfhi(wa.y) + bfhi(wb.y), bflo(wa.z) + bflo(wb.z), bfhi(wa.z) + bfhi(wb.z), bflo(wa.w) + bflo(wb.w), bfhi(wa.w) + bfhi(wb.w)};
        float ss = 0.f;
#pragma unroll
        for (int i = 0; i < 8; ++i) ss += o[i] * o[i];
        ss = row16_sum(ss);
        const float rstd = 1.0f / sqrtf(ss * (1.0f / 128.0f) + EPS);
        const u32x4 wg = *(const u32x4*)(P + (size_t)m * NIN + PC_G + c0);
        const float g[8] = {bflo(wg.x), bfhi(wg.x), bflo(wg.y), bfhi(wg.y), bflo(wg.z), bfhi(wg.z), bflo(wg.w), bfhi(wg.w)};
        const f32x4 n0 = *(const f32x4*)(a->in[I_GLANORM] + l * 512 + c0), n1 = *(const f32x4*)(a->in[I_GLANORM] + l * 512 + c0 + 4);
        float r[8];
#pragma unroll
        for (int i = 0; i < 8; ++i) r[i] = o[i] * rstd * (i < 4 ? n0[i] : n1[i - 4]) * silu_f(g[i]);
        u32x4 w; w.x = pk2(r[0], r[1]); w.y = pk2(r[2], r[3]); w.z = pk2(r[4], r[5]); w.w = pk2(r[6], r[7]);
        *(u32x4*)(MIX + (size_t)m * D + c0) = w;
    }
}

constexpr int N2_WHI = 0, N2_WLO = 32768, N2_HHI = 65536, N2_HLO = 98304, N2_PART = 132096, N2_CNT = N2_PART + 8192, N2_RT = 20;
static_assert(N2_CNT + 256 + NWAVES * N2_RT * 16 <= LDS_BYTES && N2_PART >= MISC_OFF + 64 + 128, "N2 LDS map");
__device__ __forceinline__ int n2_addr(int r, int k) { return r * 2048 + ((((k >> 3) ^ r) & 127) << 4) + (k & 7) * 2; }
__device__ __forceinline__ void n2_route_phase(const Frame& F, const CAS Args* a, int l, bool do_route, int cset) {
    unsigned char* ws = F.ws;
    const float* mod = (const float*)(ws + WS_MOD);
    bf16* H = (bf16*)(ws + WS_H);
    unsigned* cnt = (unsigned*)(ws + WS_CTL) + CW_CNT + cset * NE * CNT_STRIDE;
    unsigned* list = (unsigned*)(ws + WS_LIST); float* listw = (float*)(ws + WS_LISTW);
    LAS unsigned* lcnt = (LAS unsigned*)(F.lds + N2_CNT); LAS unsigned* lbase = lcnt + 16; LAS unsigned* rec = lcnt + 64;
    for (int i = F.tid; i < D * NE; i += NWAVES * 64) { const int e = i & 15, k = i >> 4; const float w = a->in[I_WROUTER][i];
        const unsigned hi = f2bf(w); const unsigned lo = f2bf(w - bf2f(hi));
        *(LAS bf16*)(F.lds + N2_WHI + n2_addr(e, k)) = (bf16)hi; *(LAS bf16*)(F.lds + N2_WLO + n2_addr(e, k)) = (bf16)lo; }
    if (F.tid < 32) lcnt[F.tid] = 0u;
    __syncthreads();
    const int rows = (l == 0) ? TT : TL;
    const int t0 = F.gw;
    const int nch = (rows - F.vcu * NWAVES + F.NGW - 1) / F.NGW;
    f32x4 xn[4];
    if (t0 < rows) { const float* xr0 = t0 < TL ? F.out + (size_t)t0 * D : (const float*)(ws + WS_XC) + (size_t)(t0 - TL) * D;
#pragma unroll
        for (int j = 0; j < 4; ++j) xn[j] = *(const f32x4*)(xr0 + 4 * F.lane + 256 * j); }
    for (int c2 = 0; c2 < nch; c2 += 2) {
#pragma unroll
        for (int half = 0; half < 2; ++half) {
            const int m = t0 + (c2 + half) * F.NGW, r = 8 * half + F.wave;
            if (m < rows) {
                const int v = m < TL ? (m >> 13) : 2;
                f32x4 x[4]; float ss = 0.f;
#pragma unroll
                for (int j = 0; j < 4; ++j) { x[j] = xn[j]; ss += (x[j][0] * x[j][0] + x[j][1] * x[j][1]) + (x[j][2] * x[j][2] + x[j][3] * x[j][3]); }
                { const int mn = m + F.NGW;
                  if (mn < rows) { const float* xr1 = mn < TL ? F.out + (size_t)mn * D : (const float*)(ws + WS_XC) + (size_t)(mn - TL) * D;
#pragma unroll
                      for (int j = 0; j < 4; ++j) xn[j] = *(const f32x4*)(xr1 + 4 * F.lane + 256 * j); } }
                const float rstd = 1.0f / sqrtf(wave_sum(ss) * (1.0f / D) + EPS);
#pragma unroll
                for (int j = 0; j < 4; ++j) {
                    const int col = 4 * F.lane + 256 * j;
                    const f32x4 nw = *(const f32x4*)(a->in[I_NORM2] + l * D + col);
                    const f32x4 sh = *(const f32x4*)(mod + (l * 3 + v) * 6144 + 3 * D + col);
                    const f32x4 sc = *(const f32x4*)(mod + (l * 3 + v) * 6144 + 4 * D + col);
                    const f32x4 h = x[j] * rstd * nw * (1.0f + sc) + sh;
                    const unsigned h0 = f2bf(h[0]), h1 = f2bf(h[1]), h2 = f2bf(h[2]), h3 = f2bf(h[3]);
                    u32x2 o; o.x = h0 | (h1 << 16); o.y = h2 | (h3 << 16);
                    *(u32x2*)(H + (size_t)m * D + col) = o;
                    u32x2 lo; lo.x = pk2(h[0] - bf2f(h0), h[1] - bf2f(h1)); lo.y = pk2(h[2] - bf2f(h2), h[3] - bf2f(h3));
                    const int ad = n2_addr(r, col);
                    *(LAS u32x2*)(F.lds + N2_HHI + ad) = o; *(LAS u32x2*)(F.lds + N2_HLO + ad) = lo;
                }
            }
        }
        __syncthreads();
        {
            const int rr = F.lane & 15, kg = F.lane >> 4;
            f32x4 acc = (f32x4){0.f, 0.f, 0.f, 0.f};
#pragma unroll
            for (int ks = 0; ks < 4; ++ks) {
                const int ad = n2_addr(rr, 128 * F.wave + 32 * ks + 8 * kg);
                const bf16x8 whi = *(const LAS bf16x8*)(F.lds + N2_WHI + ad), wlo = *(const LAS bf16x8*)(F.lds + N2_WLO + ad);
                const bf16x8 hhi = *(const LAS bf16x8*)(F.lds + N2_HHI + ad), hlo = *(const LAS bf16x8*)(F.lds + N2_HLO + ad);
                acc = __builtin_amdgcn_mfma_f32_16x16x32_bf16(whi, hhi, acc, 0, 0, 0);
                acc = __builtin_amdgcn_mfma_f32_16x16x32_bf16(whi, hlo, acc, 0, 0, 0);
                acc = __builtin_amdgcn_mfma_f32_16x16x32_bf16(wlo, hhi, acc, 0, 0, 0);
            }
            *(LAS f32x4*)(F.lds + N2_PART + ((F.wave * 16 + rr) * 16 + 4 * kg) * 4) = acc;
        }
        __syncthreads();
        if (F.wave == 0) {
            const int rr = F.lane & 15, eg = F.lane >> 4;
            f32x4 lg = (f32x4){0.f, 0.f, 0.f, 0.f};
#pragma unroll
            for (int w = 0; w < NWAVES; ++w) lg = lg + *(const LAS f32x4*)(F.lds + N2_PART + ((w * 16 + rr) * 16 + 4 * eg) * 4);
            const f32x4 br = *(const f32x4*)(a->in[I_BROUTER] + 4 * eg);
            float sg[4], sb[4];
#pragma unroll
            for (int i = 0; i < 4; ++i) { sg[i] = 1.0f / (1.0f + expf(-lg[i])); sb[i] = sg[i] + br[i]; }
            int i0 = 0, i1 = 0; float b0 = -1e30f, b1 = -1e30f, s0 = 0.f, s1 = 0.f;
#pragma unroll
            for (int i = 0; i < 4; ++i) { const float val = sb[i];
                if (val > b0) { b1 = b0; i1 = i0; s1 = s0; b0 = val; i0 = i; s0 = sg[i]; } else if (val > b1) { b1 = val; i1 = i; s1 = sg[i]; } }
            const float gs = b0 + b1;
            float best = gs; int bg = eg;
#pragma unroll
            for (int st = 16; st < 64; st <<= 1) {
                const float og = __builtin_bit_cast(float, __builtin_amdgcn_ds_bpermute((F.lane ^ st) << 2, __builtin_bit_cast(int, best)));
                const int oi = __builtin_amdgcn_ds_bpermute((F.lane ^ st) << 2, bg);
                if (og > best || (og == best && oi < bg)) { best = og; bg = oi; }
            }
            const int half = rr >> 3, wv = rr & 7, ch = c2 + half;
            const int m = F.vcu * NWAVES + wv + ch * F.NGW;
            if (do_route && bg == eg && m < rows) {
                const int e0 = 4 * eg + i0, e1 = 4 * eg + i1; const float inv = 1.0f / (s0 + s1);
                if (ch < N2_RT) {
                    const int slot = wv * N2_RT + ch;
                    const unsigned l0 = atomicAdd((unsigned*)(lcnt + e0), 1u), l1 = atomicAdd((unsigned*)(lcnt + e1), 1u);
                    rec[slot * 4 + 0] = (unsigned)m; rec[slot * 4 + 1] = (unsigned)e0 | ((unsigned)e1 << 8) | (l0 << 16) | (l1 << 24);
                    rec[slot * 4 + 2] = __float_as_uint(s0 * inv); rec[slot * 4 + 3] = __float_as_uint(s1 * inv);
                } else {
                    const unsigned p0 = atomicAdd(cnt + e0 * CNT_STRIDE, 1u); list[(size_t)e0 * LISTCAP + p0] = (unsigned)m * 2u; listw[(size_t)e0 * LISTCAP + p0] = s0 * inv;
                    const unsigned p1 = atomicAdd(cnt + e1 * CNT_STRIDE, 1u); list[(size_t)e1 * LISTCAP + p1] = (unsigned)m * 2u + 1u; listw[(size_t)e1 * LISTCAP + p1] = s1 * inv;
                }
            }
        }
    }
    __syncthreads();
    if (do_route) {
        if (F.tid < NE) { const unsigned c = lcnt[F.tid]; lbase[F.tid] = c ? atomicAdd(cnt + F.tid * CNT_STRIDE, c) : 0u; }
        __syncthreads();
        for (int i = F.tid; i < NWAVES * N2_RT; i += NWAVES * 64) {
            const int wv = i / N2_RT, k = i % N2_RT;
            if (F.vcu * NWAVES + wv + k * F.NGW < rows) {
                const unsigned m = rec[i * 4], pk = rec[i * 4 + 1]; const unsigned e0 = pk & 255u, e1 = (pk >> 8) & 255u, l0 = (pk >> 16) & 255u, l1 = pk >> 24;
                const unsigned p0 = lbase[e0] + l0, p1 = lbase[e1] + l1;
                list[(size_t)e0 * LISTCAP + p0] = m * 2u; listw[(size_t)e0 * LISTCAP + p0] = __uint_as_float(rec[i * 4 + 2]);
                list[(size_t)e1 * LISTCAP + p1] = m * 2u + 1u; listw[(size_t)e1 * LISTCAP + p1] = __uint_as_float(rec[i * 4 + 3]);
            }
        }
    }
    __syncthreads();
}

__device__ __forceinline__ void moe_setup(pg8::MoeOrder& S, const Frame& F, int cset, int nN) {
    unsigned* cnt = (unsigned*)(F.ws + WS_CTL) + CW_CNT + cset * NE * CNT_STRIDE;
    LAS int* tab = (LAS int*)(F.lds + MISC_OFF + 64);
    __syncthreads();
    if (F.tid == 0) { int run = 0;
        for (int e = 0; e < NE; ++e) { const int c = (int)__hip_atomic_load(cnt + e * CNT_STRIDE, __ATOMIC_RELAXED, __HIP_MEMORY_SCOPE_AGENT); tab[e] = c; run += (c + 255) >> 8; tab[16 + e] = run; } }
    __syncthreads();
    S.tab = tab; S.nN = nN; S.nunits = __builtin_amdgcn_readfirstlane(tab[31]) * nN; S.G = F.G; S.c = (int)blockIdx.x;
    S.tdone = (unsigned*)(F.ws + WS_CTL) + CW_TDONE + cset * 160 * 16; S.role = 0;
    S.list = (const unsigned*)(F.ws + WS_LIST);
}
__device__ __forceinline__ void moe1_phase(const Frame& F, const CAS Args* a, int l, int cset) {
    pg8::MoeOrder S; moe_setup(S, F, cset, 4);
    S.A = (const char*)(F.ws + WS_H); S.Bt = (const char*)(F.ws + WS_WGU) + (size_t)l * NE * D * D * 2; S.K = D; S.bstride_e = (size_t)D * D * 2; S.gather = true; S.role = 1;
    EpiGU E{(bf16*)(F.ws + WS_HMID)};
    pg8::gemm_phase<EpiGU, pg8::MoeOrder>(F.lds, F.tid, S, E);
}
__device__ __forceinline__ void moe2_phase(const Frame& F, const CAS Args* a, int l, int cset) {
    pg8::MoeOrder S; moe_setup(S, F, cset, 4);
    S.A = (const char*)(F.ws + WS_HMID); S.Bt = (const char*)(F.ws + WS_WD) + (size_t)l * NE * D * DE * 2; S.K = DE; S.bstride_e = (size_t)D * DE * 2; S.gather = false; S.role = 2; S.c = F.G - 1 - (int)blockIdx.x;
    EpiDown E; E.Y = (bf16*)(F.ws + WS_Y); E.list = (const unsigned*)(F.ws + WS_LIST); E.listw = (const float*)(F.ws + WS_LISTW); E.tab = S.tab;
    pg8::gemm_phase<EpiDown, pg8::MoeOrder>(F.lds, F.tid, S, E);
    if (l == 0 && cset == 0) convert_moe_filler(F, a, 1, S.nunits, true);
}

__device__ __forceinline__ void final_load(const Frame& F, int m, f32x4 (&x)[4]) {
    const float* mod = (const float*)(F.ws + WS_MOD);
    const bf16* Y0 = (const bf16*)(F.ws + WS_Y); const bf16* Y1 = Y0 + (size_t)TT * D;
    const int v = m >> 13; const float* xrow = F.out + (size_t)m * D;
#pragma unroll
    for (int j = 0; j < 4; ++j) {
        const int col = 4 * F.lane + 256 * j;
        const f32x4 g2 = *(const f32x4*)(mod + (3 + v) * 6144 + 5 * D + col);
        const f32x4 y = ld_y4(Y0 + (size_t)m * D + col) + ld_y4(Y1 + (size_t)m * D + col);
        x[j] = *(const f32x4*)(xrow + col) + g2 * y;
    }
}
__device__ __forceinline__ void final_row(const Frame& F, const CAS Args* a, int m, const f32x4 (&x)[4]) {
    float* xrow = F.out + (size_t)m * D; float ss = 0.f;
#pragma unroll
    for (int j = 0; j < 4; ++j) ss += (x[j][0] * x[j][0] + x[j][1] * x[j][1]) + (x[j][2] * x[j][2] + x[j][3] * x[j][3]);
    const float rstd = 1.0f / sqrtf(wave_sum(ss) * (1.0f / D) + EPS);
#pragma unroll
    for (int j = 0; j < 4; ++j) { const int col = 4 * F.lane + 256 * j; const f32x4 nw = *(const f32x4*)(a->in[I_FNORM] + col); *(f32x4*)(xrow + col) = x[j] * rstd * nw; }
}
__device__ __forceinline__ void final_phase(const Frame& F, const CAS Args* a) {
    for (int m = F.gw; m < TL; m += 2 * F.NGW) {
        const int m2 = m + F.NGW; const bool two = m2 < TL;
        f32x4 xa[4], xb[4];
        final_load(F, m, xa);
        if (two) final_load(F, m2, xb);
        final_row(F, a, m, xa);
        if (two) final_row(F, a, m2, xb);
    }
}

#ifndef NPASS
#define NPASS 1
#endif
#ifndef PROBE_PH
#define PROBE_PH -1
#endif
#ifndef PROBE_R
#define PROBE_R 3
#endif
constexpr int PH_PER_LAYER = 8;
constexpr int N_PHASES = 1 + DEPTH * PH_PER_LAYER + 1;

template <int ph0>
__device__ __forceinline__ void do_phase(Frame& F, XcdBarrier& bar, LAS unsigned char* lds, int lo, int hi) {
    constexpr int ph = ph0 % N_PHASES, pass = ph0 / N_PHASES;
    if (!(lo <= ph && ph < hi)) return;
    if (pass == 1 && ph != PROBE_PH) return;
    const CAS Args* ap;
        { int l_; asm volatile("v_mbcnt_lo_u32_b32 %0, -1, 0\n\tv_mbcnt_hi_u32_b32 %0, -1, %0" : "=v"(l_)); F.lane = l_; F.tid = F.wave * 64 + l_; ap = (const CAS Args*)__builtin_amdgcn_kernarg_segment_ptr(); asm volatile("" : "+s"(ap)); F.ws = ap->ws; F.out = (pass == 1) ? (float*)(ap->ws + WS_P) : ap->out;
          LAS unsigned char* lb_ = (LAS unsigned char*)lds; asm volatile("" : "+s"(lb_)); __builtin_assume((((unsigned)(__UINTPTR_TYPE__)lb_) & 1023u) == 0u); F.lds = lb_;
          bar.bar = (unsigned*)(F.ws + WS_CTL) + CW_BAR; bar.st = (volatile LAS unsigned*)(F.lds + MISC_OFF) + 8; }
        if (ph == 0) { if (PH_ON(10)) REP(10, true) p0_prologue(F, ap); }
        else if (ph == N_PHASES - 1) { if (PH_ON(11)) REP(11, false) final_phase(F, ap); }
        else {
            const int l = (ph - 1) / PH_PER_LAYER, s = (ph - 1) % PH_PER_LAYER;
            unsigned char* ws = F.ws;
            if (s == 0) { if (PH_ON(0)) REP(0, l == 0) n1_phase(F, ap, l); }
            else if (s == 1 && PH_ON(1)) REP(1, true) {
                pg8::DenseOrder S; S.init(ws + WS_H, ws + WS_WIN + (size_t)l * NIN * D * 2, TT, NIN, D, F.G, (int)blockIdx.x);
                EpiIn E{(bf16*)(ws + WS_P), ap->in[I_BIASF] + l * 256, ap->in[I_BIASB] + l * 256, (const float*)(ws + WS_ROPE), (const float*)(ws + WS_ROPE) + 2048};
                pg8::gemm_phase<EpiIn, pg8::DenseOrder>(F.lds, F.tid, S, E);
            }
            else if (s == 2) { if (PH_ON(2)) REP(2, true) swa_flash(F, ap, l); if (PH_ON(12)) REP(12, true) gla_g1(F, l); }
            else if (s == 3) { if (PH_ON(13)) REP(13, true) gla_scan(F); }
            else if (s == 4) { if (PH_ON(3)) REP(3, true) gla_g3(F, ap, l); }
            else if (s == 5 && PH_ON(4)) REP(4, l == 0) {
                pg8::DenseOrder S; S.init(ws + WS_MIX, ws + WS_WOUT + (size_t)l * D * D * 2, l == 0 ? TT : TL, D, D, F.G, (int)blockIdx.x);
                EpiOut E{l == 0 ? ap->in[I_X] : F.out, l == 0 ? ap->in[I_CTX] : (const float*)(ws + WS_XC), F.out, (float*)(ws + WS_XC), (const float*)(ws + WS_MOD) + l * 3 * 6144};
                pg8::gemm_phase<EpiOut, pg8::DenseOrder>(F.lds, F.tid, S, E);
                if (l == 0 && pass == 0) convert_moe_filler(F, ap, 0, S.nwg);
            }
            else if (s == 6) { if (PH_ON(5)) REP(5, true) n2_route_phase(F, ap, l, rep_ == 0 || pass == 1, l + 2 * pass); }
            else { if (PH_ON(6)) { moe1_phase(F, ap, l, l); moe2_phase(F, ap, l, l); } }
        }
        if (ph0 + 1 < NPASS * N_PHASES) for (int rb_ = 0; rb_ < (REPEAT_S == 20 ? REPEAT_N : 1); ++rb_) xcd_barrier(bar, F.tid);
}
template <int... I>
__device__ __forceinline__ void run_all(Frame& F, XcdBarrier& bar, LAS unsigned char* lds, int lo, int hi, std::integer_sequence<int, I...>) { (do_phase<I>(F, bar, lds, lo, hi), ...); }

#ifdef VGPR_CAP
__attribute__((amdgpu_num_vgpr(VGPR_CAP)))
#endif
__global__ void __launch_bounds__(NWAVES * 64, 2) mk_fwd(Args args) {
    extern __shared__ __attribute__((aligned(16))) unsigned char lds[];
    Frame F;
    F.lds = (LAS unsigned char*)lds;
    F.tid = threadIdx.x; F.lane = F.tid & 63; F.wave = __builtin_amdgcn_readfirstlane(F.tid >> 6);
    F.G = gridDim.x; { const int bx = blockIdx.x; F.vcu = (F.G % 8 == 0) ? (bx % 8) * (F.G / 8) + bx / 8 : bx; }
    F.gw = F.vcu * NWAVES + F.wave; F.NGW = F.G * NWAVES;
    const CAS Args* ap = (const CAS Args*)__builtin_amdgcn_kernarg_segment_ptr();
    F.ws = ap->ws; F.out = ap->out;
    volatile LAS unsigned* MISC = (volatile LAS unsigned*)(F.lds + MISC_OFF);
    for (int u = F.tid; u < (LDS_BYTES - LDSCTL_OFF) / 4; u += NWAVES * 64) ((LAS unsigned*)(F.lds + LDSCTL_OFF))[u] = 0u;
    __syncthreads();
    XcdBarrier bar; bar.bar = (unsigned*)(F.ws + WS_CTL) + CW_BAR; bar.x = 0; bar.st = nullptr;
    const bool fused = (ap->ph_hi - ap->ph_lo) > 1;
    if (fused) bar = xcd_barrier_post((unsigned*)(F.ws + WS_CTL) + CW_BAR, MISC + 8);
    const int lo = ap->ph_lo, hi = ap->ph_hi;
    run_all(F, bar, (LAS unsigned char*)lds, lo, hi, std::make_integer_sequence<int, NPASS * N_PHASES>{});
}

extern "C" void kernel_launch(void* const* d_in, const int* in_sizes, int n_in, void* d_out, int out_size, void* d_ws, size_t ws_size, hipStream_t stream) {
    static int grid = 0;
    if (grid == 0) {
        if (n_in != 22 || out_size != TL * D || ws_size < WS_END) { fprintf(stderr, "kernel_launch: unexpected shapes (n_in %d out %d ws %zu)\n", n_in, out_size, ws_size); grid = -1; return; }
        int dev = 0, cus = 0, per_cu = 0;
        if (hipGetDevice(&dev) != hipSuccess || hipDeviceGetAttribute(&cus, hipDeviceAttributeMultiprocessorCount, dev) != hipSuccess) { grid = -1; return; }
        if (hipFuncSetAttribute((const void*)mk_fwd, hipFuncAttributeMaxDynamicSharedMemorySize, LDS_BYTES) != hipSuccess) { fprintf(stderr, "kernel_launch: hipFuncSetAttribute failed\n"); grid = -1; return; }
        if (hipOccupancyMaxActiveBlocksPerMultiprocessor(&per_cu, (const void*)mk_fwd, NWAVES * 64, LDS_BYTES) != hipSuccess || per_cu < 1) fprintf(stderr, "kernel_launch: occupancy query says %d\n", per_cu);
        (void)hipGetLastError();
        grid = cus;
    }
    if (grid < 0) return;
    (void)hipMemsetAsync((char*)d_ws + WS_CTL, 0, CTL_ZERO_BYTES, stream);
    Args a{};
    for (int i = 0; i < 22; ++i) a.in[i] = (const float*)d_in[i];
    a.out = (float*)d_out; a.ws = (unsigned char*)d_ws; a.li = 0; a.pad = 0;
#if MK_N_LAUNCHES == 1
    a.ph_lo = 0; a.ph_hi = N_PHASES;
    hipLaunchKernelGGL(mk_fwd, dim3(grid), dim3(NWAVES * 64), LDS_BYTES, stream, a);
#else
    for (int ph = 0; ph < N_PHASES; ++ph) { a.ph_lo = ph; a.ph_hi = ph + 1; hipLaunchKernelGGL(mk_fwd, dim3(grid), dim3(NWAVES * 64), LDS_BYTES, stream, a); }
#endif
}
```

```cpp
#include <hip/hip_runtime.h>
#include <cstdio>
#include <cstdint>
#include <utility>

#ifndef ONLY_S
#define ONLY_S -1
#endif
#define PH_ON(k) (ONLY_S < 0 || ONLY_S == (k))
#ifndef REPEAT_S
#define REPEAT_S -1
#endif
#ifndef REPEAT_N
#define REPEAT_N 4
#endif
#define REP(k, cond) for (int rep_ = 0; rep_ < ((pass == 1) ? PROBE_R : ((REPEAT_S == (k) && (cond)) ? REPEAT_N : 1)); ++rep_)
#ifndef MK_N_LAUNCHES
#define MK_N_LAUNCHES 1
#endif

#define GAS __attribute__((address_space(1)))
#define LAS __attribute__((address_space(3)))
#define CAS __attribute__((address_space(4)))
typedef unsigned short bf16;
typedef short bf16x8 __attribute__((ext_vector_type(8)));
typedef float f32x4 __attribute__((ext_vector_type(4)));
typedef float f32x2 __attribute__((ext_vector_type(2)));
typedef unsigned u32x4 __attribute__((ext_vector_type(4)));
typedef unsigned u32x2 __attribute__((ext_vector_type(2)));

constexpr int D = 1024, SEQ = 8192, LC = 256, TL = 16384, TC = 512, TT = TL + TC, DEPTH = 2;
constexpr int NE = 16, DE = 512;
constexpr int NIN = 2816;
constexpr int PC_Q = 0, PC_K = 256, PC_V = 512, PC_G = 1024, PC_SQ = 1536, PC_SK = 2048, PC_SV = 2176, PC_GF = 2304, PC_GB = 2560;
constexpr int WIN_COLS = 2336;
constexpr float EPS = 1e-6f;
constexpr float LOG2E = 1.4426950408889634f, QSCALE = 0.125f * LOG2E;
constexpr int LISTCAP = TT;

constexpr size_t MiB = 1u << 20;
constexpr size_t WS_CTL = 0, CTL_ZERO_BYTES = 131072;
constexpr size_t WS_MOD = 1 * MiB;
constexpr size_t WS_ROPE = 1 * MiB + 256 * 1024;
constexpr size_t WS_LIST = 2 * MiB;
constexpr size_t WS_LISTW = 2 * MiB + 1536 * 1024;
constexpr size_t WS_XC = 5 * MiB;
constexpr size_t WS_WIN = 8 * MiB;
constexpr size_t WS_WOUT = 19 * MiB;
constexpr size_t WS_WGU = 23 * MiB;
constexpr size_t WS_WD = 87 * MiB;
constexpr size_t WS_H = 119 * MiB;
constexpr size_t WS_P = 152 * MiB;
constexpr size_t WS_MIX = 243 * MiB;
constexpr size_t WS_GL = 276 * MiB;
constexpr size_t WS_HMID = 152 * MiB;
constexpr size_t WS_Y = 190 * MiB;
constexpr size_t WS_END = 309 * MiB;
static_assert(WS_LIST + (size_t)NE * LISTCAP * 4 <= WS_LISTW && WS_LISTW + (size_t)NE * LISTCAP * 4 <= WS_XC, "ws map");
static_assert(WS_P + (size_t)TT * NIN * 2 <= WS_MIX && WS_MIX + (size_t)TT * D * 2 <= WS_GL, "ws map");
static_assert(WS_HMID + (size_t)37888 * 512 * 2 <= WS_Y && WS_Y + (size_t)2 * TT * D * 2 <= WS_GL, "ws map");
constexpr int CW_CNT = 8192, CNT_STRIDE = 64;
constexpr int CW_TDONE = 16384;
constexpr int CW_BAR = 4096;

__device__ __forceinline__ unsigned f2bf(float f) { unsigned u = __builtin_bit_cast(unsigned, f); return (u + 0x7fffu + ((u >> 16) & 1u)) >> 16; }
__device__ __forceinline__ unsigned pk2(float lo, float hi) { return f2bf(lo) | (f2bf(hi) << 16); }
__device__ __forceinline__ float bf2f(unsigned h) { return __builtin_bit_cast(float, h << 16); }
__device__ __forceinline__ float bflo(unsigned w) { return __builtin_bit_cast(float, w << 16); }
__device__ __forceinline__ float bfhi(unsigned w) { return __builtin_bit_cast(float, w & 0xffff0000u); }
__device__ __forceinline__ float dpp_add(float v, float t) { return v + t; }
#define DPP_F(v, ctrl, rmask) __builtin_bit_cast(float, __builtin_amdgcn_update_dpp(0, __builtin_bit_cast(int, (v)), (ctrl), (rmask), 0xF, false))
__device__ __forceinline__ float row16_sum(float v) {
    v += DPP_F(v, 0xB1, 0xF); v += DPP_F(v, 0x4E, 0xF); v += DPP_F(v, 0x141, 0xF); v += DPP_F(v, 0x140, 0xF); return v;
}
__device__ __forceinline__ float wave_sum(float v) {
    v = row16_sum(v);
    v += DPP_F(v, 0x142, 0xA); v += DPP_F(v, 0x143, 0xC);
    return __builtin_bit_cast(float, __builtin_amdgcn_readlane(__builtin_bit_cast(int, v), 63));
}
__device__ __forceinline__ float silu_f(float x) { return x / (1.0f + __expf(-x)); }
#define LDS_WAIT() asm volatile("s_waitcnt lgkmcnt(0)" ::: "memory")
#define VM_WAIT() asm volatile("s_waitcnt vmcnt(0)" ::: "memory")

namespace pg8 {
constexpr int BM = 256, BK = 64, HALF = 128, HTB = HALF * BK * 2, STAGE_BYTES = 8 * HTB, NXCD = 8, WGM = 8;
__host__ __device__ __forceinline__ int lds_byte(int r, int c) { const int st = (r >> 4) * 2 + (c >> 5), rr = r & 15, cc = c & 31, ob = rr * 64 + cc * 2; return st * 1024 + (ob ^ (((ob >> 9) & 1) << 5)); }
__host__ __device__ __forceinline__ void stage_rc(int b, int& R, int& C) { const int st = b / 1024, sb = b % 1024, swz = sb ^ (((sb >> 9) & 1) << 5); R = (st >> 1) * 16 + swz / 64; C = (st & 1) * 32 + (swz % 64) / 2; }
__host__ __device__ __forceinline__ int perm32(int rho) { const int n = rho >> 4, i = rho & 15; return 8 * (i >> 2) + 4 * n + (i & 3); }

struct Unit { int pm, pn, e, mt; };

__device__ __forceinline__ int xcd_remap(int wgid, int nwg) { const int q = nwg / NXCD, r = nwg % NXCD, xcd = wgid % NXCD, off = wgid / NXCD; return (xcd < r ? xcd * (q + 1) : r * (q + 1) + (xcd - r) * q) + off; }

struct DenseOrder {
    static constexpr bool DYN_A = false;
    const char* A; const char* Bt; int K; int nM, nN, nwg, G, c;
    __device__ void init(const void* A_, const void* Bt_, int M, int N, int K_, int G_, int c_) { A = (const char*)A_; Bt = (const char*)Bt_; K = K_; nM = M / BM; nN = N / BM; nwg = nM * nN; G = G_; c = c_; }
    __device__ __forceinline__ bool next(int i, Unit& u) const {
        const long L = (long)i * G + c; if (L >= nwg) return false;
        const int wgid = xcd_remap((int)L, nwg);
        const int nig = WGM * nN, gid = wgid / nig, fm = gid * WGM, gsz = (nM - fm) < WGM ? (nM - fm) : WGM;
        u.pm = fm + ((wgid % nig) % gsz); u.pn = (wgid % nig) / gsz; u.e = 0; u.mt = 0; return true;
    }
    __device__ __forceinline__ void a_ready(const Unit&, int) const {}
    __device__ __forceinline__ void done(const Unit&, int) const {}
    __device__ __forceinline__ const char* a_ptr(const Unit& u) const { return A + (size_t)u.pm * (size_t)(BM * K * 2); }
    __device__ __forceinline__ const char* b_ptr(const Unit& u) const { return Bt + (size_t)u.pn * (size_t)(BM * K * 2); }
    __device__ __forceinline__ void a_voff(const Unit&, const int (&R)[2], const int (&C)[2], unsigned (&v0)[2], unsigned (&v1)[2]) const {
#pragma unroll
        for (int i = 0; i < 2; ++i) { v0[i] = (unsigned)(R[i] * K + C[i]) * 2u; v1[i] = v0[i] + (unsigned)(HALF * K * 2); }
    }
};

struct MoeOrder {
    static constexpr bool DYN_A = true;
    const char* A; const char* Bt; int K; size_t bstride_e; int G, c, nunits, nN; bool gather;
    const unsigned* list; const LAS int* tab;
    unsigned* tdone; int role;
    __device__ __forceinline__ void a_ready(const Unit& u, int wid) const {
        if (role == 2) {
            if (wid == 0) { unsigned sp = 0;
                while (__hip_atomic_load(tdone + u.pm * 16, __ATOMIC_RELAXED, __HIP_MEMORY_SCOPE_AGENT) < 32u) { __builtin_amdgcn_s_sleep(2); if (++sp > (1u << 22)) break; }
                __builtin_amdgcn_fence(__ATOMIC_ACQUIRE, "agent"); asm volatile("s_waitcnt vmcnt(0)" ::: "memory"); }
            __builtin_amdgcn_s_barrier();
        }
    }
    __device__ __forceinline__ void done(const Unit& u, int lane) const {
        if (role == 1) { asm volatile("s_waitcnt vmcnt(0)" ::: "memory");
            if (lane == 0) __hip_atomic_fetch_add(tdone + u.pm * 16, 1u, __ATOMIC_RELAXED, __HIP_MEMORY_SCOPE_AGENT); }
    }
    __device__ __forceinline__ bool next(int i, Unit& u) const {
        const long L = (long)i * G + c; if (L >= nunits) return false;
        const int wgid = xcd_remap((int)L, nunits);
        const int tl = wgid / nN; u.pn = wgid % nN;
        int e = 0, tstart = 0;
#pragma unroll 1
        for (int k = 0; k < NE - 1; ++k) { const int te = tab[16 + k]; if (tl >= te) { e = k + 1; tstart = te; } }
        u.e = __builtin_amdgcn_readfirstlane(e); u.mt = __builtin_amdgcn_readfirstlane(tl - tstart); u.pm = tl; return true;
    }
    __device__ __forceinline__ const char* a_ptr(const Unit& u) const { return gather ? A : A + (size_t)u.pm * (size_t)(BM * K * 2); }
    __device__ __forceinline__ const char* b_ptr(const Unit& u) const { return Bt + (size_t)u.e * bstride_e + (size_t)u.pn * (size_t)(BM * K * 2); }
    __device__ __forceinline__ void a_voff(const Unit& u, const int (&R)[2], const int (&C)[2], unsigned (&v0)[2], unsigned (&v1)[2]) const {
        if (gather) {
            const int ce = tab[u.e];
            const unsigned* lp = list + (size_t)u.e * LISTCAP + u.mt * BM;
#pragma unroll
            for (int i = 0; i < 2; ++i) {
                const int r0 = R[i], r1 = R[i] + HALF;
                const unsigned t0 = (u.mt * BM + r0 < ce) ? (__builtin_nontemporal_load(lp + r0) >> 1) : 0u;
                const unsigned t1 = (u.mt * BM + r1 < ce) ? (__builtin_nontemporal_load(lp + r1) >> 1) : 0u;
                v0[i] = (t0 * (unsigned)K + (unsigned)C[i]) * 2u; v1[i] = (t1 * (unsigned)K + (unsigned)C[i]) * 2u;
            }
        } else {
#pragma unroll
            for (int i = 0; i < 2; ++i) { v0[i] = (unsigned)(R[i] * K + C[i]) * 2u; v1[i] = v0[i] + (unsigned)(HALF * K * 2); }
        }
    }
};

__device__ __forceinline__ unsigned cvt_pk_bf16(float lo, float hi) { unsigned r; asm volatile("v_cvt_pk_bf16_f32 %0, %1, %2" : "=v"(r) : "v"(lo), "v"(hi)); return r; }

template <class Epi, class Sched>
__device__ __forceinline__ void gemm_phase(LAS unsigned char* lds, int tid, const Sched& S, const Epi& E) {
    const int wid = __builtin_amdgcn_readfirstlane(tid >> 6), lane = tid & 63, wr = wid >> 2, wc = wid & 3, fr = lane & 15, fq = lane >> 4;
    const int K = S.K, nt = K / BK;
    int Rr[2], Cc[2]; unsigned voffB[2];
#pragma unroll
    for (int i = 0; i < 2; ++i) { int R, C; stage_rc(tid * 16 + i * 8192, R, C); const int Rb = Epi::PERM ? ((R & ~31) + perm32(R & 31)) : R;
        Rr[i] = R; Cc[i] = C; voffB[i] = (unsigned)(Rb * K + C) * 2u; }
    const size_t kstep = (size_t)(BK * 2);
    const size_t hstep = (size_t)HALF * K * 2;
    const unsigned ldsw = (unsigned)wid * 1024u;
    const int aoff = lds_byte(wr * 64 + fr, fq * 8), boff = lds_byte(wc * 32 + fr, fq * 8);
#define PG8_SA(b, h) (((b) * 2 + (h)) * HTB)
#define PG8_SB(b, h) ((4 + (b) * 2 + (h)) * HTB)
#define PG8_STAGE(bufoff, gbase, voff) do { _Pragma("unroll") for (int _i = 0; _i < 2; ++_i) \
        __builtin_amdgcn_global_load_lds((const unsigned*)((const char*)(gbase) + (voff)[_i]), (LAS unsigned*)(lds + (bufoff) + ldsw + _i * 8192), 16, 0, 0); } while (0)
#define PG8_LDA(dst, b, h) do { _Pragma("unroll") for (int m = 0; m < 4; ++m) _Pragma("unroll") for (int k = 0; k < 2; ++k) dst[m][k] = *(const LAS bf16x8*)(lds + PG8_SA(b, h) + aoff + m * 2048 + k * 1024); } while (0)
#define PG8_LDB(dst, b, h) do { _Pragma("unroll") for (int n = 0; n < 2; ++n) _Pragma("unroll") for (int k = 0; k < 2; ++k) dst[n][k] = *(const LAS bf16x8*)(lds + PG8_SB(b, h) + boff + n * 2048 + k * 1024); } while (0)
#define PG8_MMA(ai, bj, At, Bt) do { __builtin_amdgcn_s_setprio(1); _Pragma("unroll") for (int m = 0; m < 4; ++m) _Pragma("unroll") for (int n = 0; n < 2; ++n) _Pragma("unroll") for (int k = 0; k < 2; ++k) \
        acc[ai][bj][m][n] = __builtin_amdgcn_mfma_f32_16x16x32_bf16(Bt[n][k], At[m][k], acc[ai][bj][m][n], 0, 0, 0); __builtin_amdgcn_s_setprio(0); } while (0)
#define PG8_WAIT_V(n) asm volatile("s_waitcnt vmcnt(" #n ")" ::: "memory")
#define PG8_WAIT_L(n) asm volatile("s_waitcnt lgkmcnt(" #n ")" ::: "memory")
#define PG8_BAR __builtin_amdgcn_s_barrier()
#define PG8_SCHED __builtin_amdgcn_sched_barrier(0)
    Unit cur, nxt; int ui = 0;
    if (!S.next(0, cur)) return;
    f32x4 acc[2][2][4][2];
#pragma unroll
    for (int a = 0; a < 2; ++a)
#pragma unroll
        for (int b = 0; b < 2; ++b)
#pragma unroll
            for (int m = 0; m < 4; ++m)
#pragma unroll
                for (int n = 0; n < 2; ++n) acc[a][b][m][n] = (f32x4){0.f, 0.f, 0.f, 0.f};
    bf16x8 At[4][2], B0[2][2], B1[2][2];
    const char* cA = S.a_ptr(cur); const char* cB = S.b_ptr(cur);
    unsigned cv0[2], cv1[2], nv0[2], nv1[2];
    S.a_ready(cur, wid);
    S.a_voff(cur, Rr, Cc, cv0, cv1);
    PG8_STAGE(PG8_SB(0, 0), cB, voffB); PG8_STAGE(PG8_SB(0, 1), cB + hstep, voffB); PG8_STAGE(PG8_SA(0, 0), cA, cv0); PG8_STAGE(PG8_SA(0, 1), cA, cv1);
    if (wr == 1) PG8_BAR;
    PG8_WAIT_V(2); PG8_BAR;
    PG8_STAGE(PG8_SB(1, 0), cB + kstep, voffB); PG8_STAGE(PG8_SA(1, 0), cA + kstep, cv0); PG8_STAGE(PG8_SB(1, 1), cB + hstep + kstep, voffB);
    PG8_WAIT_V(6); PG8_BAR;
    for (;;) {
        const bool has_next = S.next(ui + 1, nxt);
        const char* nA = has_next ? S.a_ptr(nxt) : cA; const char* nB = has_next ? S.b_ptr(nxt) : cB;
        if (has_next) S.a_voff(nxt, Rr, Cc, nv0, nv1); else { nv0[0] = cv0[0]; nv0[1] = cv0[1]; nv1[0] = cv1[0]; nv1[1] = cv1[1]; }
        if constexpr (Sched::DYN_A) asm volatile("" : "+v"(nv0[0]), "+v"(nv0[1]), "+v"(nv1[0]), "+v"(nv1[1]));
        for (int t = 0; t < nt; t += 2) {
            const bool last = (t == nt - 2);
            if (last && has_next) S.a_ready(nxt, wid);
            const char* a1 = cA + (size_t)(t + 1) * kstep;
            const char* a2 = last ? nA : cA + (size_t)(t + 2) * kstep; const char* b2 = last ? nB : cB + (size_t)(t + 2) * kstep;
            const char* a3 = a2 + kstep; const char* b3 = b2 + kstep;
            unsigned w0[2], w1[2];
            w0[0] = last ? nv0[0] : cv0[0]; w0[1] = last ? nv0[1] : cv0[1]; w1[0] = last ? nv1[0] : cv1[0]; w1[1] = last ? nv1[1] : cv1[1];
            PG8_LDB(B0, 0, 0); PG8_LDB(B1, 0, 1); PG8_SCHED; PG8_LDA(At, 0, 0); PG8_STAGE(PG8_SA(1, 1), a1, cv1);
            PG8_WAIT_V(8); PG8_WAIT_L(0); PG8_BAR; PG8_MMA(0, 0, At, B0); PG8_MMA(0, 1, At, B1); PG8_BAR; PG8_SCHED;
            PG8_LDA(At, 0, 1); PG8_STAGE(PG8_SB(0, 0), b2, voffB); PG8_STAGE(PG8_SB(0, 1), b2 + hstep, voffB); PG8_STAGE(PG8_SA(0, 0), a2, w0);
            PG8_WAIT_V(8); PG8_WAIT_L(0); PG8_BAR; PG8_MMA(1, 0, At, B0); PG8_MMA(1, 1, At, B1); PG8_BAR; PG8_SCHED;
            PG8_LDB(B0, 1, 0); PG8_LDB(B1, 1, 1); PG8_SCHED; PG8_LDA(At, 1, 0); PG8_STAGE(PG8_SA(0, 1), a2, w1);
            PG8_WAIT_V(8); PG8_WAIT_L(0); PG8_BAR; PG8_MMA(0, 0, At, B0); PG8_MMA(0, 1, At, B1); PG8_BAR; PG8_SCHED;
            PG8_LDA(At, 1, 1); PG8_STAGE(PG8_SB(1, 0), b3, voffB); PG8_STAGE(PG8_SB(1, 1), b3 + hstep, voffB); PG8_STAGE(PG8_SA(1, 0), a3, w0);
            PG8_WAIT_V(8); PG8_WAIT_L(0); PG8_BAR; PG8_MMA(1, 0, At, B0); PG8_MMA(1, 1, At, B1); PG8_BAR; PG8_SCHED;
        }
        if (wr == 0) PG8_BAR;
        E(acc, cur, wr, wc, fr, fq);
        S.done(cur, lane);
        if (!has_next) break;
#pragma unroll
        for (int a = 0; a < 2; ++a)
#pragma unroll
            for (int b = 0; b < 2; ++b)
#pragma unroll
                for (int m = 0; m < 4; ++m)
#pragma unroll
                    for (int n = 0; n < 2; ++n) acc[a][b][m][n] = (f32x4){0.f, 0.f, 0.f, 0.f};
        cur = nxt; cA = nA; cB = nB; ++ui;
        cv0[0] = nv0[0]; cv0[1] = nv0[1]; cv1[0] = nv1[0]; cv1[1] = nv1[1];
        if (wr == 1) PG8_BAR;
    }
    PG8_WAIT_V(0);
    PG8_BAR;
#undef PG8_SA
#undef PG8_SB
#undef PG8_STAGE
#undef PG8_LDA
#undef PG8_LDB
#undef PG8_MMA
#undef PG8_WAIT_V
#undef PG8_WAIT_L
#undef PG8_BAR
#undef PG8_SCHED
}
}

#define XB_TMO      128
#define XB_XCNT(j)  (256  + 64 * (j))
#define XB_XSUB(j)  (1280 + 64 * (j))
#define XB_XGEN(j)  (2304 + 64 * (j))
#define XB_TOP      3328
#define XB_TOPGEN   3392
#define XCD_BAR_WORDS 3456
#define XB_SPIN_CAP (1u << 18)
__device__ __forceinline__ unsigned xb_ld(unsigned* p)              { return __hip_atomic_load(p, __ATOMIC_RELAXED, __HIP_MEMORY_SCOPE_AGENT); }
__device__ __forceinline__ unsigned xb_add(unsigned* p, unsigned v) { return __hip_atomic_fetch_add(p, v, __ATOMIC_RELAXED, __HIP_MEMORY_SCOPE_AGENT); }
__device__ __forceinline__ unsigned xb_xcc_id() { return (unsigned)__builtin_amdgcn_s_getreg((3 << 11) | 20) & 0xFu; }
#define XB_SPIN(cond, bar) do { unsigned _sp = 0; while (cond) { __builtin_amdgcn_s_sleep(1); \
    if ((++_sp & 255u) == 0u) { if (xb_ld(&(bar)[XB_TMO])) break; if (_sp > XB_SPIN_CAP) { atomicAdd(&(bar)[XB_TMO], 1u); break; } } } } while (0)
struct XcdBarrier { unsigned* bar; unsigned x; volatile LAS unsigned* st; };
__device__ __forceinline__ XcdBarrier xcd_barrier_post(unsigned* bar, volatile LAS unsigned* st) {
    XcdBarrier b; b.bar = bar; b.x = xb_xcc_id(); b.st = st;
    if (threadIdx.x == 0) (void)xb_add(&bar[XB_XCNT(b.x)], 1u);
    return b;
}
__device__ __forceinline__ void xcd_barrier_complete(unsigned* bar, unsigned x, unsigned& nloc, unsigned& nx) {
    const unsigned G = gridDim.x * gridDim.y * gridDim.z;
    unsigned sum, cnt, mine, sp = 0u;
    for (;;) {
        sum = 0u; cnt = 0u; mine = 0u;
#pragma unroll
        for (unsigned j = 0; j < 16; ++j) { const unsigned c = xb_ld(&bar[XB_XCNT(j)]); sum += c; cnt += (c > 0u) ? 1u : 0u; mine = (j == x) ? c : mine; }
        if (sum == G) break;
        __builtin_amdgcn_s_sleep(1);
        if ((++sp & 255u) == 0u) { if (xb_ld(&bar[XB_TMO])) break; if (sp > XB_SPIN_CAP) { atomicAdd(&bar[XB_TMO], 1u); break; } }
    }
    nloc = mine > 0u ? mine : 1u; nx = cnt > 0u ? cnt : 1u;
}
__device__ __forceinline__ void xcd_barrier(const XcdBarrier& b, int tid) {
    asm volatile("s_waitcnt vmcnt(0)" ::: "memory");
    __syncthreads();
    if (tid == 0) {
        unsigned* bar = b.bar;
        __builtin_amdgcn_s_waitcnt(0);
        unsigned nloc = b.st[0], nx = b.st[1];
        if (nloc == 0u) { xcd_barrier_complete(bar, b.x, nloc, nx); b.st[0] = nloc; b.st[1] = nx; }
        const unsigned old = xb_add(&bar[XB_XSUB(b.x)], 1u);
        const unsigned gen = old / nloc;
        if (old + 1u == (gen + 1u) * nloc) {
            __builtin_amdgcn_fence(__ATOMIC_RELEASE, "agent");
            asm volatile("s_waitcnt vmcnt(0)" ::: "memory");
            const unsigned og = xb_add(&bar[XB_TOP], 1u);
            const unsigned tg = og / nx;
            if (og + 1u == (tg + 1u) * nx) xb_add(&bar[XB_TOPGEN], 1u);
            else XB_SPIN(xb_ld(&bar[XB_TOPGEN]) == tg, bar);
            __builtin_amdgcn_fence(__ATOMIC_ACQUIRE, "agent");
            xb_add(&bar[XB_XGEN(b.x)], 1u);
            asm volatile("s_waitcnt vmcnt(0)" ::: "memory");
        } else {
            XB_SPIN(xb_ld(&bar[XB_XGEN(b.x)]) == gen, bar);
            __builtin_amdgcn_fence(__ATOMIC_ACQUIRE, "agent");
            asm volatile("s_waitcnt vmcnt(0)" ::: "memory");
        }
    }
    __syncthreads();
}

constexpr int NWAVES = 8;
constexpr int RING_BYTES = 131072, LDSCTL_OFF = RING_BYTES, MISC_OFF = LDSCTL_OFF + 320, LDS_BYTES = 147456;
struct Args { const float* in[22]; float* out; unsigned char* ws; int ph_lo, ph_hi, li, pad; };
enum { I_X = 0, I_C, I_CTX, I_CCTX, I_WADA, I_BADA, I_NORM1, I_NORM2, I_WIN, I_UPF, I_BIASF, I_UPB, I_BIASB, I_GLANORM, I_SINK, I_WOUT, I_WROUTER, I_BROUTER, I_WGATE, I_WUP, I_WDOWN, I_FNORM };

struct Frame {
    LAS unsigned char* lds; int tid, lane, wave, vcu, G, gw, NGW;
    unsigned char* ws; float* out;
};

__device__ __forceinline__ int rope_pos(int d) { return 8 * ((d & 15) >> 2) + 4 * (d >> 4) + (d & 3); }
__device__ __forceinline__ int gu_row(int h, int gu) { return (h >> 7) * 256 + ((h >> 6) & 1) * 128 + ((h >> 4) & 3) * 32 + ((h >> 2) & 3) * 8 + gu * 4 + (h & 3); }
struct TItem { const float* src; bf16* dst; int N, Kd, n0, rbase, mode; bool ok; };
__device__ __forceinline__ void titem_load(const TItem& t, int lane, f32x4 (&v)[8]) {
    const int g = lane >> 3, i8 = lane & 7;
    const float* src = t.src + (size_t)(8 * g) * t.N + 4 * i8;
#pragma unroll
    for (int q = 0; q < 8; ++q) v[q] = *(const f32x4*)(src + (size_t)q * t.N);
}
__device__ __forceinline__ void titem_store(const TItem& t, int lane, const f32x4 (&v)[8]) {
    const int g = lane >> 3, i8 = lane & 7;
#pragma unroll
    for (int i = 0; i < 4; ++i) {
        u32x4 o; o.x = pk2(v[0][i], v[1][i]); o.y = pk2(v[2][i], v[3][i]); o.z = pk2(v[4][i], v[5][i]); o.w = pk2(v[6][i], v[7][i]);
        const int n = 4 * i8 + i;
        const int row = (t.mode == 0) ? t.rbase + n : (t.mode == 1) ? t.rbase + rope_pos(n) : gu_row(t.n0 + n, t.mode - 2);
        *(u32x4*)(t.dst + (size_t)row * t.Kd + 8 * g) = o;
    }
}
constexpr int IT_IN = 2 * 16 * 73, IT_OUT = 2 * 16 * 32, IT_G = 32 * 16 * 16, IT_D = 32 * 8 * 32, NITEMS = IT_IN + IT_OUT + 2 * IT_G + IT_D;
__device__ __forceinline__ TItem titem_decode(const CAS Args* a, unsigned char* ws, int it) {
    TItem t; t.ok = it < NITEMS; t.mode = 0; t.rbase = 0; t.n0 = 0; t.N = D; t.Kd = D; t.src = nullptr; t.dst = nullptr;
    if (!t.ok) return t;
    int r = it;
    if (r < IT_IN) {
        const int l = r / 1168, rr = r % 1168, kb = rr / 73, nb = rr % 73;
        if (nb == 48) { t.ok = false; return t; }
        const int n0 = nb * 32; t.n0 = n0;
        if (n0 < 1536) t.rbase = n0;
        else if (n0 < 2080) { t.rbase = PC_SQ + (n0 - 1568); t.mode = 1; }
        else if (n0 < 2208) { t.rbase = PC_SK + (n0 - 2080); t.mode = 1; }
        else t.rbase = PC_SV + (n0 - 2208);
        t.N = WIN_COLS; t.Kd = D; t.src = a->in[I_WIN] + (size_t)l * D * WIN_COLS + (size_t)(kb * 64) * WIN_COLS + n0; t.dst = (bf16*)(ws + WS_WIN) + (size_t)l * NIN * D + kb * 64;
        return t;
    }
    r -= IT_IN;
    if (r < IT_OUT) { const int l = r / 512, rr = r % 512, kb = rr / 32, nb = rr % 32;
        t.n0 = nb * 32; t.rbase = nb * 32; t.N = D; t.Kd = D; t.src = a->in[I_WOUT] + (size_t)l * D * D + (size_t)(kb * 64) * D + nb * 32; t.dst = (bf16*)(ws + WS_WOUT) + (size_t)l * D * D + kb * 64; return t; }
    r -= IT_OUT;
    if (r < 2 * IT_G) { const int gu = r / IT_G, r2 = r % IT_G, le = r2 / 256, rr = r2 % 256, kb = rr / 16, nb = rr % 16;
        t.n0 = nb * 32; t.mode = 2 + gu; t.N = DE; t.Kd = D; t.src = a->in[gu ? I_WUP : I_WGATE] + (size_t)le * D * DE + (size_t)(kb * 64) * DE + nb * 32; t.dst = (bf16*)(ws + WS_WGU) + (size_t)le * D * D + kb * 64; return t; }
    r -= 2 * IT_G;
    { const int le = r / 256, rr = r % 256, kb = rr / 32, nb = rr % 32;
        t.n0 = nb * 32; t.rbase = nb * 32; t.N = D; t.Kd = DE; t.src = a->in[I_WDOWN] + (size_t)le * DE * D + (size_t)(kb * 64) * D + nb * 32; t.dst = (bf16*)(ws + WS_WD) + (size_t)le * D * DE + kb * 64; }
    return t;
}

template <class Map>
__device__ __forceinline__ void convert_items(const Frame& F, const CAS Args* a, int n, int worker, int nworkers, Map map) {
    unsigned char* ws = F.ws;
    for (int i = worker; i < n; i += 2 * nworkers) {
        const int i2 = i + nworkers;
        const TItem ta = titem_decode(a, ws, map(i)), tb = titem_decode(a, ws, i2 < n ? map(i2) : NITEMS);
        f32x4 va[8], vb[8];
        if (ta.ok) titem_load(ta, F.lane, va);
        if (tb.ok) titem_load(tb, F.lane, vb);
        if (ta.ok) titem_store(ta, F.lane, va);
        if (tb.ok) titem_store(tb, F.lane, vb);
    }
}
struct MapSmall { __device__ __forceinline__ int operator()(int i) const { return i; } };
struct MapMoe { int l; __device__ __forceinline__ int operator()(int i) const { const int kind = i >> 12, r = i & 4095; return IT_IN + IT_OUT + (kind < 2 ? kind * IT_G : 2 * IT_G) + l * 4096 + r; } };
__device__ __forceinline__ void convert_moe_filler(const Frame& F, const CAS Args* a, int l, int nunits, bool both = false) {
    const int c = (int)blockIdx.x, nfull = nunits % F.G;
    int first = nfull, nf = F.G - nfull - (both ? nfull : 0);
    if (nfull == 0 || nf <= 0) { first = 0; nf = F.G; }
    if (c < first || c >= first + nf) return;
    convert_items(F, a, 3 * 4096, (c - first) * NWAVES + F.wave, nf * NWAVES, MapMoe{l});
}

__device__ __forceinline__ void p0_prologue(const Frame& F, const CAS Args* a) {
    unsigned char* ws = F.ws;
    convert_items(F, a, IT_IN + IT_OUT, F.gw, F.NGW, MapSmall{});
    for (int idx = F.gw * 64 + F.lane; idx < 2 * 2 * 256 * 128; idx += F.NGW * 64) {
        const int kc = idx & 127, n = (idx >> 7) & 255, dir = (idx >> 15) & 1, l = idx >> 16;
        const float* up = a->in[dir ? I_UPB : I_UPF] + (size_t)l * 16 * 256 + n;
        float u[16];
#pragma unroll
        for (int r = 0; r < 16; ++r) u[r] = up[r * 256];
        float o[8];
#pragma unroll
        for (int kk = 0; kk < 8; ++kk) {
            const f32x4* wz = (const f32x4*)(a->in[I_WIN] + ((size_t)l * D + kc * 8 + kk) * WIN_COLS + 1536 + dir * 16);
            float s = 0.f;
#pragma unroll
            for (int q = 0; q < 4; ++q) { const f32x4 w = wz[q]; s += w[0] * u[4 * q] + w[1] * u[4 * q + 1] + w[2] * u[4 * q + 2] + w[3] * u[4 * q + 3]; }
            o[kk] = s;
        }
        u32x4 ov; ov.x = pk2(o[0], o[1]); ov.y = pk2(o[2], o[3]); ov.z = pk2(o[4], o[5]); ov.w = pk2(o[6], o[7]);
        *(u32x4*)((bf16*)(ws + WS_WIN) + ((size_t)l * NIN + PC_GF + dir * 256 + n) * D + kc * 8) = ov;
    }
    if (blockIdx.x == (unsigned)(F.G - 1)) {
        float* tc = (float*)(ws + WS_ROPE); float* tsn = tc + 2048;
        for (int i = F.tid; i < 2048; i += NWAVES * 64) { const int pos = i >> 4, j = i & 15; const float inv = powf(10000.0f, -(float)j * (1.0f / 16.0f)); const float ang = (float)pos * inv;
            tc[i] = cosf(ang); tsn[i] = sinf(ang); }
    }
    __syncthreads();
    {
        LAS float* cs = (LAS float*)F.lds; LAS float* red = cs + 3072;
        for (int i = F.tid; i < 3072; i += NWAVES * 64) { const int v = i >> 10, k = i & 1023; const float cv = v < 2 ? a->in[I_C][v * D + k] : a->in[I_CCTX][k]; cs[i] = cv / (1.0f + expf(-cv)); }
        __syncthreads();
        for (int u = blockIdx.x; u < 192; u += F.G) {
            const int l = u / 96, jg = u % 96, jl = F.tid & 63, ks = F.tid >> 6;
            const float* wp = a->in[I_WADA] + ((size_t)l * D + ks * 128) * 6144 + jg * 64 + jl;
            float a0 = 0.f, a1 = 0.f, a2 = 0.f;
#pragma unroll 1
            for (int k0 = 0; k0 < 128; k0 += 32) {
                float wv[32];
#pragma unroll
                for (int k = 0; k < 32; ++k) wv[k] = wp[(size_t)(k0 + k) * 6144];
#pragma unroll
                for (int k = 0; k < 32; ++k) { const int kk = ks * 128 + k0 + k; a0 += cs[kk] * wv[k]; a1 += cs[1024 + kk] * wv[k]; a2 += cs[2048 + kk] * wv[k]; }
            }
            red[(ks * 3 + 0) * 64 + jl] = a0; red[(ks * 3 + 1) * 64 + jl] = a1; red[(ks * 3 + 2) * 64 + jl] = a2;
            __syncthreads();
            if (F.tid < 192) { const int v = F.tid >> 6, j2 = F.tid & 63; float s = 0.f;
#pragma unroll
                for (int q = 0; q < 8; ++q) s += red[(q * 3 + v) * 64 + j2];
                ((float*)(ws + WS_MOD))[(l * 3 + v) * 6144 + jg * 64 + j2] = s + a->in[I_BADA][l * 6144 + jg * 64 + j2]; }
            __syncthreads();
        }
    }
}

__device__ __forceinline__ f32x4 ld_y4(const bf16* p) { const u32x2 w = *(const u32x2*)p; return (f32x4){bflo(w.x), bfhi(w.x), bflo(w.y), bfhi(w.y)}; }
__device__ __forceinline__ void n1_load(const Frame& F, const CAS Args* a, int l, int m, f32x4 (&x)[4], f32x4 (&y)[4]) {
    unsigned char* ws = F.ws;
    const bf16* Y0 = (const bf16*)(ws + WS_Y); const bf16* Y1 = Y0 + (size_t)TT * D;
    const float* src = (l == 0) ? (m < TL ? a->in[I_X] + (size_t)m * D : a->in[I_CTX] + (size_t)(m - TL) * D) : (m < TL ? F.out + (size_t)m * D : (const float*)(ws + WS_XC) + (size_t)(m - TL) * D);
#pragma unroll
    for (int j = 0; j < 4; ++j) { const int col = 4 * F.lane + 256 * j; x[j] = *(const f32x4*)(src + col);
        if (l > 0) y[j] = ld_y4(Y0 + (size_t)m * D + col) + ld_y4(Y1 + (size_t)m * D + col); }
}
__device__ __forceinline__ void n1_row(const Frame& F, const CAS Args* a, int l, int m, f32x4 (&x)[4], const f32x4 (&y)[4]) {
    unsigned char* ws = F.ws;
    const float* mod = (const float*)(ws + WS_MOD);
    bf16* H = (bf16*)(ws + WS_H);
    const int v = m < TL ? (m >> 13) : 2;
    float* xrow = m < TL ? F.out + (size_t)m * D : (float*)(ws + WS_XC) + (size_t)(m - TL) * D;
    float ss = 0.f;
#pragma unroll
    for (int j = 0; j < 4; ++j) {
        const int col = 4 * F.lane + 256 * j;
        if (l > 0) { const f32x4 g2 = *(const f32x4*)(mod + ((l - 1) * 3 + v) * 6144 + 5 * D + col); x[j] = x[j] + g2 * y[j]; *(f32x4*)(xrow + col) = x[j]; }
        ss += (x[j][0] * x[j][0] + x[j][1] * x[j][1]) + (x[j][2] * x[j][2] + x[j][3] * x[j][3]);
    }
    const float rstd = 1.0f / sqrtf(wave_sum(ss) * (1.0f / D) + EPS);
#pragma unroll
    for (int j = 0; j < 4; ++j) {
        const int col = 4 * F.lane + 256 * j;
        const f32x4 nw = *(const f32x4*)(a->in[I_NORM1] + l * D + col);
        const f32x4 sh = *(const f32x4*)(mod + (l * 3 + v) * 6144 + 0 * D + col);
        const f32x4 sc = *(const f32x4*)(mod + (l * 3 + v) * 6144 + 1 * D + col);
        const f32x4 h = x[j] * rstd * nw * (1.0f + sc) + sh;
        u32x2 o; o.x = pk2(h[0], h[1]); o.y = pk2(h[2], h[3]);
        *(u32x2*)(H + (size_t)m * D + col) = o;
    }
}
__device__ __forceinline__ void n1_phase(const Frame& F, const CAS Args* a, int l) {
    for (int m = F.gw; m < TT; m += 2 * F.NGW) {
        const int m2 = m + F.NGW; const bool two = m2 < TT;
        f32x4 xa[4], ya[4], xb[4], yb[4];
        n1_load(F, a, l, m, xa, ya);
        if (two) n1_load(F, a, l, m2, xb, yb);
        n1_row(F, a, l, m, xa, ya);
        if (two) n1_row(F, a, l, m2, xb, yb);
    }
}

struct EpiIn {
    static constexpr bool PERM = true;
    bf16* P; const float* bias_f; const float* bias_b; const float* tcos; const float* tsin;
    __device__ __forceinline__ void operator()(const f32x4 (&acc)[2][2][4][2], const pg8::Unit& u, int wr, int wc, int fr, int fq) const {
        const int row0 = u.pm * 256 + wr * 64 + fr, colw = wc * 32 + 8 * fq;
        const int pn = u.pn;
        const bool latent = u.pm < 64;
        const bool rope = latent && (pn == 6 || pn == 7 || pn == 8);
        f32x4 cs[4], sn[4], b0[2], b1[2];
        if (pn >= 9) {
#pragma unroll
            for (int bj = 0; bj < 2; ++bj) { const float* bp = (pn == 9 ? bias_f : bias_b) + colw + bj * 128; b0[bj] = *(const f32x4*)bp; b1[bj] = *(const f32x4*)(bp + 4); }
        }
#pragma unroll
        for (int ai = 0; ai < 2; ++ai) {
            if (rope) {
#pragma unroll
                for (int m = 0; m < 4; ++m) { const int t = (row0 + ai * 128 + m * 16) & (SEQ - 1); const int pos = (wc & 1) ? (t & 63) : (t >> 6);
                    cs[m] = *(const f32x4*)(tcos + pos * 16 + 4 * fq); sn[m] = *(const f32x4*)(tsin + pos * 16 + 4 * fq); }
            }
#pragma unroll
            for (int m = 0; m < 4; ++m) {
                const int row = row0 + ai * 128 + m * 16;
                bf16* rowp = P + (size_t)row * NIN + pn * 256 + colw;
#pragma unroll
                for (int bj = 0; bj < 2; ++bj) {
                    f32x4 v0 = acc[ai][bj][m][0], v1 = acc[ai][bj][m][1];
                    if (pn == 0) { v0 = v0 * 0.125f; v1 = v1 * 0.125f; }
                    else if (pn >= 9) {
#pragma unroll
                        for (int i = 0; i < 4; ++i) { float x0 = v0[i] + b0[bj][i], x1 = v1[i] + b1[bj][i];
                            v0[i] = (fminf(x0, 0.f) - __logf(1.0f + __expf(-fabsf(x0)))) * 0.0625f; v1[i] = (fminf(x1, 0.f) - __logf(1.0f + __expf(-fabsf(x1)))) * 0.0625f; }
                    } else if (rope && (pn != 8 || bj == 0)) {
                        const f32x4 o0 = v0 * cs[m] - v1 * sn[m], o1 = v1 * cs[m] + v0 * sn[m]; v0 = o0; v1 = o1;
                    }
                    if (pn == 6 || pn == 7) { v0 = v0 * QSCALE; v1 = v1 * QSCALE; }
                    u32x4 w; w.x = pg8::cvt_pk_bf16(v0[0], v0[1]); w.y = pg8::cvt_pk_bf16(v0[2], v0[3]); w.z = pg8::cvt_pk_bf16(v1[0], v1[1]); w.w = pg8::cvt_pk_bf16(v1[2], v1[3]);
                    *(u32x4*)(rowp + bj * 128) = w;
                }
            }
            asm volatile("" ::: "memory");
        }
    }
};
struct EpiOut {
    static constexpr bool PERM = false;
    const float* resL; const float* resC; float* outL; float* outC; const float* mod_l;
    __device__ __forceinline__ void operator()(const f32x4 (&acc)[2][2][4][2], const pg8::Unit& u, int wr, int wc, int fr, int fq) const {
        const bool latent = u.pm < 64;
        const int v = latent ? (u.pm >> 5) : 2;
        const int rowb = (latent ? u.pm * 256 : u.pm * 256 - TL) + wr * 64 + fr;
        const float* res = latent ? resL : resC; float* out = latent ? outL : outC;
        const int col0 = u.pn * 256 + wc * 32 + 4 * fq;
        const float* g1p = mod_l + v * 6144 + 2 * D + col0;
        f32x4 g1[2][2];
#pragma unroll
        for (int bj = 0; bj < 2; ++bj)
#pragma unroll
            for (int n = 0; n < 2; ++n) g1[bj][n] = *(const f32x4*)(g1p + bj * 128 + n * 16);
#pragma unroll
        for (int ai = 0; ai < 2; ++ai)
#pragma unroll
            for (int mp = 0; mp < 4; mp += 2) {
                f32x4 r[2][2][2];
#pragma unroll
                for (int m = 0; m < 2; ++m) { const size_t off = (size_t)(rowb + ai * 128 + (mp + m) * 16) * D + col0;
#pragma unroll
                    for (int bj = 0; bj < 2; ++bj)
#pragma unroll
                        for (int n = 0; n < 2; ++n) r[m][bj][n] = *(const f32x4*)(res + off + bj * 128 + n * 16); }
#pragma unroll
                for (int m = 0; m < 2; ++m) { const size_t off = (size_t)(rowb + ai * 128 + (mp + m) * 16) * D + col0;
#pragma unroll
                    for (int bj = 0; bj < 2; ++bj)
#pragma unroll
                        for (int n = 0; n < 2; ++n) *(f32x4*)(out + off + bj * 128 + n * 16) = r[m][bj][n] + g1[bj][n] * acc[ai][bj][mp + m][n]; }
                asm volatile("" ::: "memory");
            }
    }
};
struct EpiGU {
    static constexpr bool PERM = true;
    bf16* Hmid;
    __device__ __forceinline__ void operator()(const f32x4 (&acc)[2][2][4][2], const pg8::Unit& u, int wr, int wc, int fr, int fq) const {
        const int row0 = u.pm * 256 + wr * 64 + fr, hid0 = u.pn * 128 + wc * 16 + fq * 4;
#pragma unroll
        for (int ai = 0; ai < 2; ++ai)
#pragma unroll
            for (int m = 0; m < 4; ++m) {
                bf16* rowp = Hmid + (size_t)(row0 + ai * 128 + m * 16) * DE + hid0;
#pragma unroll
                for (int bj = 0; bj < 2; ++bj) {
                    const f32x4 g = acc[ai][bj][m][0], up = acc[ai][bj][m][1]; f32x4 o;
#pragma unroll
                    for (int i = 0; i < 4; ++i) o[i] = g[i] * __builtin_amdgcn_rcpf(1.0f + __expf(-g[i])) * up[i];
                    u32x2 w; w.x = pg8::cvt_pk_bf16(o[0], o[1]); w.y = pg8::cvt_pk_bf16(o[2], o[3]);
                    __hip_atomic_store((unsigned long long*)(rowp + bj * 64), ((unsigned long long)w.y << 32) | w.x, __ATOMIC_RELAXED, __HIP_MEMORY_SCOPE_AGENT);
                }
            }
    }
};
struct EpiDown {
    static constexpr bool PERM = true;
    bf16* Y; const unsigned* list; const float* listw; const LAS int* tab;
    __device__ __forceinline__ void operator()(const f32x4 (&acc)[2][2][4][2], const pg8::Unit& u, int wr, int wc, int fr, int fq) const {
        const int ce = tab[u.e];
        const int r0 = u.mt * 256 + wr * 64 + fr, col0 = u.pn * 256 + wc * 32 + 8 * fq;
        const unsigned* lp = list + (size_t)u.e * LISTCAP; const float* lw = listw + (size_t)u.e * LISTCAP;
        unsigned tsv[2][4]; float wv[2][4];
#pragma unroll
        for (int ai = 0; ai < 2; ++ai)
#pragma unroll
            for (int m = 0; m < 4; ++m) { const int r = r0 + ai * 128 + m * 16; const bool ok = r < ce; tsv[ai][m] = ok ? __builtin_nontemporal_load(lp + r) : 0xffffffffu; wv[ai][m] = ok ? __builtin_nontemporal_load(lw + r) : 0.f; }
#pragma unroll
        for (int ai = 0; ai < 2; ++ai)
#pragma unroll
            for (int m = 0; m < 4; ++m) {
                const unsigned ts = tsv[ai][m]; const float w = wv[ai][m];
                if (ts != 0xffffffffu) {
                    bf16* rowp = Y + ((size_t)(ts & 1u) * TT + (ts >> 1)) * D + col0;
#pragma unroll
                    for (int bj = 0; bj < 2; ++bj) {
                        const f32x4 v0 = acc[ai][bj][m][0] * w, v1 = acc[ai][bj][m][1] * w;
                        u32x4 o; o.x = pg8::cvt_pk_bf16(v0[0], v0[1]); o.y = pg8::cvt_pk_bf16(v0[2], v0[3]); o.z = pg8::cvt_pk_bf16(v1[0], v1[1]); o.w = pg8::cvt_pk_bf16(v1[2], v1[3]);
                        *(u32x4*)(rowp + bj * 128) = o;
                    }
                }
            }
    }
};

__device__ __forceinline__ void swa_naive(const Frame& F, const CAS Args* a, int l) {
    const bf16* P = (const bf16*)(F.ws + WS_P); bf16* MIX = (bf16*)(F.ws + WS_MIX);
    const int total = (l == 0 ? TT : TL) * 8;
    for (int idx = F.gw * 64 + F.lane; idx < total; idx += F.NGW * 64) {
        const int m = idx >> 3, hq = idx & 7, kvh = hq >> 2;
        const bool latent = m < TL;
        const int b = latent ? (m >> 13) : ((m - TL) >> 8), t = m & (SEQ - 1);
        float q[64];
        { const u32x4* qp = (const u32x4*)(P + (size_t)m * NIN + PC_SQ + hq * 64);
#pragma unroll
          for (int c = 0; c < 8; ++c) { const u32x4 w = qp[c]; q[8 * c] = bflo(w.x); q[8 * c + 1] = bfhi(w.x); q[8 * c + 2] = bflo(w.y); q[8 * c + 3] = bfhi(w.y);
              q[8 * c + 4] = bflo(w.z); q[8 * c + 5] = bfhi(w.z); q[8 * c + 6] = bflo(w.w); q[8 * c + 7] = bfhi(w.w); } }
        float o[64];
#pragma unroll
        for (int d = 0; d < 64; ++d) o[d] = 0.f;
        const float sink = a->in[I_SINK][l * 8 + hq] * LOG2E;
        float mx = sink, den = 1.0f;
        const int lo = latent ? (t - 128 < 0 ? 0 : t - 128) : 0, hi = latent ? (t + 128 > SEQ - 1 ? SEQ - 1 : t + 128) : -1;
        const int nloc = hi - lo + 1;
        for (int kk = 0; kk < nloc + LC; ++kk) {
            const int krow = kk < nloc ? b * SEQ + lo + kk : TL + b * LC + (kk - nloc);
            const u32x4* kp = (const u32x4*)(P + (size_t)krow * NIN + PC_SK + kvh * 64);
            float s = 0.f;
#pragma unroll
            for (int c = 0; c < 8; ++c) { const u32x4 w = kp[c]; s += q[8 * c] * bflo(w.x) + q[8 * c + 1] * bfhi(w.x) + q[8 * c + 2] * bflo(w.y) + q[8 * c + 3] * bfhi(w.y)
                + q[8 * c + 4] * bflo(w.z) + q[8 * c + 5] * bfhi(w.z) + q[8 * c + 6] * bflo(w.w) + q[8 * c + 7] * bfhi(w.w); }
            const float mn = fmaxf(mx, s), f = exp2f(mx - mn), p = exp2f(s - mn);
            den = den * f + p; mx = mn;
            const u32x4* vp = (const u32x4*)(P + (size_t)krow * NIN + PC_SV + kvh * 64);
#pragma unroll
            for (int c = 0; c < 8; ++c) { const u32x4 w = vp[c];
                o[8 * c] = o[8 * c] * f + p * bflo(w.x); o[8 * c + 1] = o[8 * c + 1] * f + p * bfhi(w.x); o[8 * c + 2] = o[8 * c + 2] * f + p * bflo(w.y); o[8 * c + 3] = o[8 * c + 3] * f + p * bfhi(w.y);
                o[8 * c + 4] = o[8 * c + 4] * f + p * bflo(w.z); o[8 * c + 5] = o[8 * c + 5] * f + p * bfhi(w.z); o[8 * c + 6] = o[8 * c + 6] * f + p * bflo(w.w); o[8 * c + 7] = o[8 * c + 7] * f + p * bfhi(w.w); }
        }
        const float inv = 1.0f / den;
        u32x4* op = (u32x4*)(MIX + (size_t)m * D + 512 + hq * 64);
#pragma unroll
        for (int c = 0; c < 8; ++c) { u32x4 w; w.x = pk2(o[8 * c] * inv, o[8 * c + 1] * inv); w.y = pk2(o[8 * c + 2] * inv, o[8 * c + 3] * inv); w.z = pk2(o[8 * c + 4] * inv, o[8 * c + 5] * inv); w.w = pk2(o[8 * c + 6] * inv, o[8 * c + 7] * inv); op[c] = w; }
    }
}


typedef float f32x16 __attribute__((ext_vector_type(16)));
typedef short s16x4 __attribute__((ext_vector_type(4)));
__device__ __forceinline__ int crow(int r, int hi) { return (r & 3) + 8 * (r >> 2) + 4 * hi; }
__device__ __forceinline__ s16x4 vtr(const LAS unsigned char* p) { return __builtin_bit_cast(s16x4, __builtin_amdgcn_ds_read_tr16_b64_v4i16((LAS s16x4*)p)); }
constexpr int SWA_K = 0, SWA_V = 49152;
__device__ __forceinline__ void swa_kload(const LAS unsigned char* Kt, int kb, int lane, bf16x8 (&kf)[4]) {
    const int r32 = lane & 31, hi = lane >> 5;
#pragma unroll
    for (int d0 = 0; d0 < 4; ++d0) kf[d0] = *(const LAS bf16x8*)(Kt + (2 * d0 + hi) * 1024 + (32 * kb + r32) * 16);
}
__device__ __forceinline__ void swa_tile(const LAS unsigned char* Kt, const LAS unsigned char* Vt, const LAS unsigned char* Kn, int mtype, const bf16x8 (&qf)[2][4], bf16x8 (&kf)[4], f32x16 (&o)[2][2], float (&mrun)[2], float (&lrun)[2], int lane, int abl = 0) {
    const int r32 = lane & 31, hi = lane >> 5;
    const LAS unsigned char* vp = Vt + ((lane >> 4) & 1) * 32 + (lane & 3) * 8 + (4 * hi + ((lane & 15) >> 2)) * 64;
#pragma unroll
    for (int kb = 0; kb < 2; ++kb) {
        f32x16 s[2];
        swa_kload(Kt, kb, lane, kf);
#pragma unroll
        for (int d0 = 0; d0 < 4; ++d0)
#pragma unroll
            for (int qt = 0; qt < 2; ++qt) {
                if (d0 == 0) { f32x16 z;
#pragma unroll
                    for (int r = 0; r < 16; ++r) z[r] = 0.f;
                    s[qt] = __builtin_amdgcn_mfma_f32_32x32x16_bf16(kf[0], qf[qt][0], z, 0, 0, 0); }
                else if (abl != 4) s[qt] = __builtin_amdgcn_mfma_f32_32x32x16_bf16(kf[d0], qf[qt][d0], s[qt], 0, 0, 0);
            }
        __builtin_amdgcn_sched_barrier(0);
        s16x4 vlo[2][2], vhi[2][2];
#pragma unroll
        for (int dt = 0; dt < 2; ++dt)
#pragma unroll
            for (int sp = 0; sp < 2; ++sp) { vlo[dt][sp] = vtr(vp + dt * 4096 + (2 * kb + sp) * 1024); vhi[dt][sp] = vtr(vp + dt * 4096 + (2 * kb + sp) * 1024 + 512); }
        __builtin_amdgcn_sched_barrier(0);
        bf16x8 pf[2][2];
#pragma unroll
        for (int qt = 0; qt < 2; ++qt) {
            if (mtype != 0) {
                int thr = r32 + 32 * qt - 4 * hi - 32 * kb; asm volatile("" : "+v"(thr));
                if (mtype == 1) {
#pragma unroll
                    for (int r = 0; r < 16; ++r) { const int cc = (r & 3) + 8 * (r >> 2); if (cc < thr) s[qt][r] = -INFINITY; }
                } else {
#pragma unroll
                    for (int r = 0; r < 16; ++r) { const int cc = (r & 3) + 8 * (r >> 2); if (cc > thr) s[qt][r] = -INFINITY; }
                }
            }
            float rm = s[qt][0];
            if (abl != 1) {
#pragma unroll
            for (int r = 1; r < 16; ++r) rm = fmaxf(rm, s[qt][r]);
            }
            { auto rr = __builtin_amdgcn_permlane32_swap(__float_as_uint(rm), __float_as_uint(rm), false, false); rm = fmaxf(__uint_as_float(rr[0]), __uint_as_float(rr[1])); }
            const float mn = fmaxf(mrun[qt], rm);
            if (__any(mn > mrun[qt])) {
                const float alpha = __builtin_amdgcn_exp2f(mrun[qt] - mn);
                lrun[qt] *= alpha;
#pragma unroll
                for (int dt = 0; dt < 2; ++dt)
#pragma unroll
                    for (int r = 0; r < 16; ++r) o[dt][qt][r] *= alpha;
                mrun[qt] = mn;
            }
            float rs = 0.f;
            if (abl != 1) {
#pragma unroll
            for (int r = 0; r < 16; ++r) { const float p = __builtin_amdgcn_exp2f(s[qt][r] - mn); s[qt][r] = p; rs += p; }
            }
            lrun[qt] += rs;
#pragma unroll
            for (int sp = 0; sp < 2; ++sp) {
                u32x4 w; w.x = pg8::cvt_pk_bf16(s[qt][8 * sp + 0], s[qt][8 * sp + 1]); w.y = pg8::cvt_pk_bf16(s[qt][8 * sp + 2], s[qt][8 * sp + 3]);
                w.z = pg8::cvt_pk_bf16(s[qt][8 * sp + 4], s[qt][8 * sp + 5]); w.w = pg8::cvt_pk_bf16(s[qt][8 * sp + 6], s[qt][8 * sp + 7]);
                pf[qt][sp] = __builtin_bit_cast(bf16x8, w);
            }
        }
#pragma unroll
        for (int dt = 0; dt < 2; ++dt)
#pragma unroll
            for (int sp = 0; sp < 2; ++sp) {
                const bf16x8 vf = (bf16x8){vlo[dt][sp][0], vlo[dt][sp][1], vlo[dt][sp][2], vlo[dt][sp][3], vhi[dt][sp][0], vhi[dt][sp][1], vhi[dt][sp][2], vhi[dt][sp][3]};
#pragma unroll
                for (int qt = 0; qt < 2; ++qt) if (abl != 2) o[dt][qt] = __builtin_amdgcn_mfma_f32_32x32x16_bf16(vf, pf[qt][sp], o[dt][qt], 0, 0, 0);
            }
    }
}
__device__ __forceinline__ void swa_stage(const Frame& F, const bf16* P, int grow, int kvh, int ti) {
    { const int key = 8 * F.wave + (F.lane & 7), ch = F.lane >> 3;
      const u32x4 v = *(const u32x4*)(P + (size_t)(grow + key) * NIN + PC_SK + kvh * 64 + ch * 8);
      *(LAS u32x4*)(F.lds + SWA_K + ti * 8192 + ch * 1024 + key * 16) = v; }
    { const int key = 8 * F.wave + (F.lane >> 3), ch = F.lane & 7;
      const u32x4 v = *(const u32x4*)(P + (size_t)(grow + key) * NIN + PC_SV + kvh * 64 + ch * 8);
      *(LAS u32x4*)(F.lds + SWA_V + ti * 8192 + (ch >> 2) * 4096 + key * 64 + (ch & 3) * 16) = v; }
}
__device__ __forceinline__ void swa_flash(const Frame& F, const CAS Args* a, int l, int abl = 0) {
    const bf16* P = (const bf16*)(F.ws + WS_P); bf16* MIX = (bf16*)(F.ws + WS_MIX);
    const int nunits = 256 + (l == 0 ? 8 : 0);
    const int lane = F.lane, r32 = lane & 31, hi = lane >> 5;
    for (int u = F.vcu; u < nunits; u += F.G) {
        const bool latent = u < 256;
        const int b = latent ? (u >> 7) : ((u - 256) >> 2), kvh = latent ? ((u >> 6) & 1) : (((u - 256) >> 1) & 1), qb = latent ? (u & 63) : ((u - 256) & 1);
        const int q0 = qb * 128, g = F.wave >> 1, qs = F.wave & 1, hq = kvh * 4 + g;
        const int mrow0 = (latent ? b * SEQ : TL + b * LC) + q0 + 64 * qs;
        bf16x8 qf[2][4];
#pragma unroll
        for (int qt = 0; qt < 2; ++qt)
#pragma unroll
            for (int d0 = 0; d0 < 4; ++d0) { if (abl != 7) qf[qt][d0] = *(const bf16x8*)(P + (size_t)(mrow0 + 32 * qt + r32) * NIN + PC_SQ + hq * 64 + 16 * d0 + 8 * hi); else qf[qt][d0] = (bf16x8){(short)lane, 1, 2, 3, 4, 5, 6, 7}; }
        f32x16 o[2][2];
#pragma unroll
        for (int dt = 0; dt < 2; ++dt)
#pragma unroll
            for (int qt = 0; qt < 2; ++qt)
#pragma unroll
                for (int r = 0; r < 16; ++r) o[dt][qt][r] = 0.f;
        const float sink2 = a->in[I_SINK][l * 8 + hq] * LOG2E;
        float mrun[2] = {sink2, sink2}, lrun[2] = {hi == 0 ? 1.f : 0.f, hi == 0 ? 1.f : 0.f};
        if (latent) {
#pragma unroll 1
            for (int j = 0; j < 6; ++j) { const int ks = q0 - 128 + 64 * j; if (ks >= 0 && ks < SEQ && abl != 3) swa_stage(F, P, b * SEQ + ks, kvh, j); }
            __syncthreads();
            { int jf = qs; while (q0 - 128 + 64 * jf < 0) ++jf;
              bf16x8 kf[4]; swa_kload(F.lds + SWA_K + jf * 8192, 0, lane, kf);
#pragma unroll 1
              for (int tt = 0; tt < 5; ++tt) { const int j = qs + tt, ks = q0 - 128 + 64 * j;
                  if (ks >= 0 && ks < SEQ && abl != 8) { const int jn = (j + 1 < 6) ? j + 1 : j;
                      swa_tile(F.lds + SWA_K + j * 8192, F.lds + SWA_V + j * 8192, F.lds + SWA_K + jn * 8192, tt == 0 ? 1 : (tt == 4 ? 2 : 0), qf, kf, o, mrun, lrun, lane, abl); } } }
            __syncthreads();
        }
#pragma unroll 1
        for (int j = 0; j < 4; ++j) if (abl != 3) swa_stage(F, P, TL + b * LC + 64 * j, kvh, j);
        __syncthreads();
        { bf16x8 kf[4]; swa_kload(F.lds + SWA_K, 0, lane, kf);
#pragma unroll 1
          for (int j = 0; j < 4; ++j) if (abl != 8) swa_tile(F.lds + SWA_K + j * 8192, F.lds + SWA_V + j * 8192, F.lds + SWA_K + (j < 3 ? j + 1 : j) * 8192, 0, qf, kf, o, mrun, lrun, lane, abl); }
        __syncthreads();
#pragma unroll
        for (int qt = 0; qt < 2; ++qt) {
            float lt = lrun[qt];
            { auto rr = __builtin_amdgcn_permlane32_swap(__float_as_uint(lt), __float_as_uint(lt), false, false); lt = __uint_as_float(rr[0]) + __uint_as_float(rr[1]); }
            const float inv = 1.0f / lt;
            bf16* op = MIX + (size_t)(mrow0 + 32 * qt + r32) * D + 512 + hq * 64 + 4 * hi;
#pragma unroll
            for (int dt = 0; dt < 2; ++dt)
#pragma unroll
                for (int rg = 0; rg < 4; ++rg) {
                    u32x2 w; w.x = pk2(o[dt][qt][4 * rg] * inv, o[dt][qt][4 * rg + 1] * inv); w.y = pk2(o[dt][qt][4 * rg + 2] * inv, o[dt][qt][4 * rg + 3] * inv);
                    if (abl != 7 || w.x == 0x12345u) *(u32x2*)(op + 32 * dt + 8 * rg) = w;
                }
        }
    }
}


constexpr size_t WS_US = WS_GL, WS_USC = WS_GL + 32 * MiB, WS_DEC = 7 * MiB;
static_assert(WS_USC + (size_t)16 * 4 * 8192 * 2 <= WS_END && WS_DEC + (size_t)16 * 132 * 64 * 4 <= WS_WIN, "ws map (gla)");
constexpr int GL_V = 0, GL_M0 = 16384, GL_MSZ = 64 * 72 * 2, GL_RED = GL_M0 + 4 * GL_MSZ;
__device__ __forceinline__ float wave_scan_incl(float v) {
    v += DPP_F(v, 0x111, 0xF); v += DPP_F(v, 0x112, 0xF); v += DPP_F(v, 0x114, 0xF); v += DPP_F(v, 0x118, 0xF);
    v += DPP_F(v, 0x142, 0xA); v += DPP_F(v, 0x143, 0xC); return v;
}
__device__ __forceinline__ float lane63(float v) { return __builtin_bit_cast(float, __builtin_amdgcn_readlane(__builtin_bit_cast(int, v), 63)); }
__device__ __forceinline__ void unpack8(const u32x4 w, float (&f)[8]) { f[0] = bflo(w.x); f[1] = bfhi(w.x); f[2] = bflo(w.y); f[3] = bfhi(w.y); f[4] = bflo(w.z); f[5] = bfhi(w.z); f[6] = bflo(w.w); f[7] = bfhi(w.w); }
__device__ __forceinline__ void gla_stage_v(const Frame& F, const bf16* P, int m0, int h) {
#pragma unroll
    for (int i = 0; i < 2; ++i) { const int p = F.tid + 512 * i, t = p >> 4, ch = p & 15;
        const u32x4 v = *(const u32x4*)(P + (size_t)(m0 + t) * NIN + PC_V + h * 128 + ch * 8);
        *(LAS u32x4*)(F.lds + GL_V + (ch >> 2) * 4096 + t * 64 + (ch & 3) * 16) = v; }
}
__device__ __forceinline__ void gla_g1_unit(const Frame& F, const bf16* P, int m0, int h, bf16* Uf, bf16* Ub, float* decf, float* decb) {
    const int w = F.wave, t = F.lane, c = t & 31, hi = t >> 5;
    const bf16* row = P + (size_t)(m0 + t) * NIN + h * 64 + 8 * w;
    float laf[8], lab[8], kk[8];
    unpack8(*(const u32x4*)(row + PC_GF), laf); unpack8(*(const u32x4*)(row + PC_GB), lab); unpack8(*(const u32x4*)(row + PC_K), kk);
    gla_stage_v(F, P, m0, h);
    LAS bf16* KOF = (LAS bf16*)(F.lds + GL_M0); LAS bf16* KOB = (LAS bf16*)(F.lds + GL_M0 + GL_MSZ);
#pragma unroll
    for (int i = 0; i < 8; ++i) {
        const float incf = wave_scan_incl(laf[i]), tf = lane63(incf), incb = wave_scan_incl(lab[i]), tb = lane63(incb);
        KOF[(8 * w + i) * 72 + t] = (bf16)f2bf(kk[i] * __expf(tf - incf));
        KOB[(8 * w + i) * 72 + t] = (bf16)f2bf(kk[i] * __expf(incb - lab[i]));
        if (t == 0) { decf[8 * w + i] = __expf(tf); decb[8 * w + i] = __expf(tb); }
    }
    __syncthreads();
    const int dir = w >> 2, dvt = w & 3;
    const LAS unsigned char* vp = F.lds + GL_V + dvt * 4096 + ((t >> 4) & 1) * 32 + (t & 3) * 8 + ((t & 15) >> 2) * 64 + hi * 512;
    const LAS unsigned char* kb = F.lds + GL_M0 + dir * GL_MSZ + (c * 72 + 8 * hi) * 2;
    f32x16 acc[2];
#pragma unroll
    for (int j = 0; j < 2; ++j)
#pragma unroll
        for (int r = 0; r < 16; ++r) acc[j][r] = 0.f;
#pragma unroll
    for (int sp = 0; sp < 4; ++sp) {
        const s16x4 lo = vtr(vp + sp * 1024), hi4 = vtr(vp + sp * 1024 + 256);
        const bf16x8 vf = (bf16x8){lo[0], lo[1], lo[2], lo[3], hi4[0], hi4[1], hi4[2], hi4[3]};
#pragma unroll
        for (int j = 0; j < 2; ++j) { const bf16x8 kf = *(const LAS bf16x8*)(kb + j * 32 * 144 + sp * 32); acc[j] = __builtin_amdgcn_mfma_f32_32x32x16_bf16(kf, vf, acc[j], 0, 0, 0); }
    }
    bf16* U = dir ? Ub : Uf;
#pragma unroll
    for (int j = 0; j < 2; ++j) {
        u32x4 w0, w1;
        w0.x = pk2(acc[j][0], acc[j][1]); w0.y = pk2(acc[j][2], acc[j][3]); w0.z = pk2(acc[j][4], acc[j][5]); w0.w = pk2(acc[j][6], acc[j][7]);
        w1.x = pk2(acc[j][8], acc[j][9]); w1.y = pk2(acc[j][10], acc[j][11]); w1.z = pk2(acc[j][12], acc[j][13]); w1.w = pk2(acc[j][14], acc[j][15]);
        u32x4* up = (u32x4*)(U + ((j * 4 + dvt) * 64 + t) * 16);
        up[0] = w0; up[1] = w1;
    }
    __syncthreads();
}
__device__ __forceinline__ void gla_g1(const Frame& F0, int l) {
    Frame F = F0; { int l_; asm volatile("v_mbcnt_lo_u32_b32 %0, -1, 0\n\tv_mbcnt_hi_u32_b32 %0, -1, %0" : "=v"(l_)); F.lane = l_; F.tid = F.wave * 64 + l_; }
    const bf16* P = (const bf16*)(F.ws + WS_P);
    bf16* US = (bf16*)(F.ws + WS_US); bf16* USC = (bf16*)(F.ws + WS_USC); float* DEC = (float*)(F.ws + WS_DEC);
    for (int u = F.vcu; u < 1056; u += F.G) {
        const bool latent = u < 1024; const int cc = u - 1024;
        const int b = latent ? (u >> 9) : (cc >> 4), h = latent ? ((u >> 7) & 3) : ((cc >> 2) & 3), n = latent ? (u & 127) : (cc & 3);
        const int m0 = latent ? b * SEQ + 64 * n : TL + b * LC + 64 * n;
        const int sf = (b * 4 + h) * 2;
        bf16* Uf = latent ? US + ((size_t)sf * 128 + n) * 8192 : USC + ((size_t)sf * 4 + n) * 8192;
        bf16* Ub = latent ? US + ((size_t)(sf + 1) * 128 + n) * 8192 : USC + ((size_t)(sf + 1) * 4 + n) * 8192;
        const int nd = latent ? n : 128 + n;
        gla_g1_unit(F, P, m0, h, Uf, Ub, DEC + ((size_t)sf * 132 + nd) * 64, DEC + ((size_t)(sf + 1) * 132 + nd) * 64);
    }
}
constexpr size_t WS_SS = WS_H, WS_SSC = WS_H + 32 * MiB;
static_assert(WS_SSC + (size_t)16 * 4 * 8192 * 2 <= WS_P, "ws map (gla states)");
__device__ __forceinline__ void gla_scan(const Frame& F) {
    for (int w0 = (F.vcu * NWAVES + F.wave) * 64; w0 < 16 * 4096; w0 += F.G * NWAVES * 64) {
        const int seq = __builtin_amdgcn_readfirstlane(w0 >> 12), ew = __builtin_amdgcn_readfirstlane((w0 & 4095) * 2);
        const int dir = seq & 1;
        const unsigned voff = (unsigned)F.lane * 4u;
        unsigned doff;
        { const int e = ew + 2 * F.lane, r = e & 15, ln = (e >> 4) & 63, dkt = e >> 12; doff = (unsigned)(32 * dkt + (r & 3) + 8 * (r >> 2) + 4 * (ln >> 5)) * 4u; }
        const char* decb = (const char*)(F.ws + WS_DEC) + (size_t)seq * 132 * 256;
        float s0 = 0.f, s1 = 0.f;
        { const char* ub = (const char*)(F.ws + WS_USC) + ((size_t)seq * 4 * 8192 + ew) * 2; char* sb = (char*)(F.ws + WS_SSC) + ((size_t)seq * 4 * 8192 + ew) * 2;
          unsigned u[4]; f32x2 d[4];
#pragma unroll
          for (int i = 0; i < 4; ++i) { const int n = dir ? 3 - i : i; u[i] = *(const unsigned*)(ub + (size_t)n * 16384 + voff); d[i] = *(const f32x2*)(decb + (size_t)(128 + n) * 256 + doff); }
#pragma unroll
          for (int i = 0; i < 4; ++i) { const int n = dir ? 3 - i : i; *(unsigned*)(sb + (size_t)n * 16384 + voff) = pk2(s0, s1); s0 = d[i][0] * s0 + bflo(u[i]); s1 = d[i][1] * s1 + bfhi(u[i]); } }
        const long stride = dir ? -16384 : 16384, dstride = dir ? -256 : 256;
        const char* ub = (const char*)(F.ws + WS_US) + ((size_t)seq * 128 * 8192 + ew) * 2 + (dir ? (size_t)127 * 16384 : 0);
        char* sb = (char*)(F.ws + WS_SS) + ((size_t)seq * 128 * 8192 + ew) * 2 + (dir ? (size_t)127 * 16384 : 0);
        const char* db = decb + (dir ? 127 * 256 : 0);
#pragma unroll 1
        for (int i0 = 0; i0 < 128; i0 += 32) {
            unsigned u[32]; f32x2 d[32];
#pragma unroll
            for (int j = 0; j < 32; ++j) { u[j] = *(const unsigned*)(ub + j * stride + voff); d[j] = *(const f32x2*)(db + j * dstride + doff); }
#pragma unroll
            for (int j = 0; j < 32; ++j) { *(unsigned*)(sb + j * stride + voff) = pk2(s0, s1); s0 = d[j][0] * s0 + bflo(u[j]); s1 = d[j][1] * s1 + bfhi(u[j]); }
            ub += 32 * stride; sb += 32 * stride; db += 32 * dstride;
        }
    }
}
__device__ __forceinline__ void gla_g3_unit(const Frame& F, const CAS Args* a, int l, const bf16* P, int m0, int h, const bf16* Sf, const bf16* Sb, bf16* MIX) {
    const int w = F.wave, t = F.lane, c = t & 31, hi = t >> 5;
    bf16x8 sfr[4], sbr[4]; u32x2 gwv[4]; f32x4 nwv[4];
    { const int dvt_ = w >> 1, tt_ = w & 1;
#pragma unroll
      for (int kd = 0; kd < 4; ++kd) { const size_t off = (size_t)(((kd >> 1) * 4 + dvt_) * 64 + t) * 16 + 8 * (kd & 1); sfr[kd] = *(const bf16x8*)(Sf + off); sbr[kd] = *(const bf16x8*)(Sb + off); }
#pragma unroll
      for (int rg = 0; rg < 4; ++rg) { const int dv = 32 * dvt_ + 8 * rg + 4 * hi;
          gwv[rg] = *(const u32x2*)(P + (size_t)(m0 + 32 * tt_ + c) * NIN + PC_G + h * 128 + dv); nwv[rg] = *(const f32x4*)(a->in[I_GLANORM] + l * 512 + h * 128 + dv); } }
    {
        const bf16* row = P + (size_t)(m0 + t) * NIN + h * 64 + 8 * w;
        float laf[8], lab[8], kk[8], qq[8];
        unpack8(*(const u32x4*)(row + PC_GF), laf); unpack8(*(const u32x4*)(row + PC_GB), lab); unpack8(*(const u32x4*)(row + PC_K), kk); unpack8(*(const u32x4*)(row + PC_Q), qq);
        gla_stage_v(F, P, m0, h);
        float qf[8], kf[8], qb[8], kb[8];
#pragma unroll
        for (int i = 0; i < 8; ++i) {
            const float bf = wave_scan_incl(laf[i]), incb = wave_scan_incl(lab[i]), bb = lane63(incb) - incb + lab[i];
            qf[i] = qq[i] * __expf(bf); kf[i] = kk[i] * __expf(-bf); qb[i] = qq[i] * __expf(bb); kb[i] = kk[i] * __expf(-bb);
        }
        LAS unsigned char* mb = F.lds + GL_M0 + (t * 72 + 8 * w) * 2;
        u32x4 o;
        o.x = pk2(qf[0], qf[1]); o.y = pk2(qf[2], qf[3]); o.z = pk2(qf[4], qf[5]); o.w = pk2(qf[6], qf[7]); *(LAS u32x4*)(mb) = o;
        o.x = pk2(kf[0], kf[1]); o.y = pk2(kf[2], kf[3]); o.z = pk2(kf[4], kf[5]); o.w = pk2(kf[6], kf[7]); *(LAS u32x4*)(mb + GL_MSZ) = o;
        o.x = pk2(qb[0], qb[1]); o.y = pk2(qb[2], qb[3]); o.z = pk2(qb[4], qb[5]); o.w = pk2(qb[6], qb[7]); *(LAS u32x4*)(mb + 2 * GL_MSZ) = o;
        o.x = pk2(kb[0], kb[1]); o.y = pk2(kb[2], kb[3]); o.z = pk2(kb[4], kb[5]); o.w = pk2(kb[6], kb[7]); *(LAS u32x4*)(mb + 3 * GL_MSZ) = o;
    }
    __syncthreads();
    const int dvt = w >> 1, tt = w & 1;
    bf16x8 qfB[4], qbB[4], qfP[4], qbP[4];
    { const LAS unsigned char* qp = F.lds + GL_M0 + ((32 * tt + c) * 72 + 8 * hi) * 2;
#pragma unroll
      for (int kd = 0; kd < 4; ++kd) { qfB[kd] = *(const LAS bf16x8*)(qp + kd * 32); qbB[kd] = *(const LAS bf16x8*)(qp + 2 * GL_MSZ + kd * 32); }
      const LAS unsigned char* pp = F.lds + GL_M0 + ((32 * tt + c) * 72 + 4 * hi) * 2;
#pragma unroll
      for (int kd = 0; kd < 4; ++kd) {
          const u32x2 a0 = *(const LAS u32x2*)(pp + kd * 32), a1 = *(const LAS u32x2*)(pp + kd * 32 + 16);
          const u32x2 b0 = *(const LAS u32x2*)(pp + 2 * GL_MSZ + kd * 32), b1 = *(const LAS u32x2*)(pp + 2 * GL_MSZ + kd * 32 + 16);
          qfP[kd] = __builtin_bit_cast(bf16x8, (u32x4){a0.x, a0.y, a1.x, a1.y}); qbP[kd] = __builtin_bit_cast(bf16x8, (u32x4){b0.x, b0.y, b1.x, b1.y});
      } }
    bf16x8 pfr[2][2];
#pragma unroll
    for (int st = 0; st < 2; ++st) {
        const LAS unsigned char* kp = F.lds + GL_M0 + GL_MSZ + ((32 * st + c) * 72 + 8 * hi) * 2;
        f32x16 xf, xb;
#pragma unroll
        for (int r = 0; r < 16; ++r) { xf[r] = 0.f; xb[r] = 0.f; }
        const bool needF = st <= tt, needB = st >= tt;
        if (needF) {
#pragma unroll
            for (int kd = 0; kd < 4; ++kd) xf = __builtin_amdgcn_mfma_f32_32x32x16_bf16(*(const LAS bf16x8*)(kp + kd * 32), qfB[kd], xf, 0, 0, 0);
        }
        if (needB) {
#pragma unroll
            for (int kd = 0; kd < 4; ++kd) xb = __builtin_amdgcn_mfma_f32_32x32x16_bf16(*(const LAS bf16x8*)(kp + 2 * GL_MSZ + kd * 32), qbB[kd], xb, 0, 0, 0);
        }
        if (st == tt) {
            int thr = c - 4 * hi; asm volatile("" : "+v"(thr));
#pragma unroll
            for (int r = 0; r < 16; ++r) { const int cc = (r & 3) + 8 * (r >> 2); xf[r] = (cc <= thr ? xf[r] : 0.f) + (cc >= thr ? xb[r] : 0.f); }
        } else {
#pragma unroll
            for (int r = 0; r < 16; ++r) xf[r] += xb[r];
        }
#pragma unroll
        for (int sp = 0; sp < 2; ++sp) {
            u32x4 wv; wv.x = pg8::cvt_pk_bf16(xf[8 * sp + 0], xf[8 * sp + 1]); wv.y = pg8::cvt_pk_bf16(xf[8 * sp + 2], xf[8 * sp + 3]);
            wv.z = pg8::cvt_pk_bf16(xf[8 * sp + 4], xf[8 * sp + 5]); wv.w = pg8::cvt_pk_bf16(xf[8 * sp + 6], xf[8 * sp + 7]);
            pfr[st][sp] = __builtin_bit_cast(bf16x8, wv);
        }
    }
    f32x16 o;
#pragma unroll
    for (int r = 0; r < 16; ++r) o[r] = 0.f;
    { const LAS unsigned char* vp = F.lds + GL_V + dvt * 4096 + ((t >> 4) & 1) * 32 + (t & 3) * 8 + (4 * hi + ((t & 15) >> 2)) * 64;
#pragma unroll
      for (int ks = 0; ks < 4; ++ks) {
          const s16x4 lo = vtr(vp + ks * 1024), hi4 = vtr(vp + ks * 1024 + 512);
          const bf16x8 vf = (bf16x8){lo[0], lo[1], lo[2], lo[3], hi4[0], hi4[1], hi4[2], hi4[3]};
          o = __builtin_amdgcn_mfma_f32_32x32x16_bf16(vf, pfr[ks >> 1][ks & 1], o, 0, 0, 0);
      } }
#pragma unroll
    for (int kd = 0; kd < 4; ++kd) {
        o = __builtin_amdgcn_mfma_f32_32x32x16_bf16(sfr[kd], qfP[kd], o, 0, 0, 0);
        o = __builtin_amdgcn_mfma_f32_32x32x16_bf16(sbr[kd], qbP[kd], o, 0, 0, 0);
    }
    float ssq = 0.f;
#pragma unroll
    for (int r = 0; r < 16; ++r) ssq += o[r] * o[r];
    { auto rr = __builtin_amdgcn_permlane32_swap(__float_as_uint(ssq), __float_as_uint(ssq), false, false); ssq = __uint_as_float(rr[0]) + __uint_as_float(rr[1]); }
    LAS float* red = (LAS float*)(F.lds + GL_RED);
    if (hi == 0) red[dvt * 64 + 32 * tt + c] = ssq;
    __syncthreads();
    const float tot = (red[32 * tt + c] + red[64 + 32 * tt + c]) + (red[128 + 32 * tt + c] + red[192 + 32 * tt + c]);
    const float rstd = 1.0f / sqrtf(tot * (1.0f / 128.0f) + EPS);
    const int mrow = m0 + 32 * tt + c;
#pragma unroll
    for (int rg = 0; rg < 4; ++rg) {
        const int dv = 32 * dvt + 8 * rg + 4 * hi;
        const u32x2 gw = gwv[rg]; const f32x4 nw = nwv[rg];
        const float g0 = bflo(gw.x), g1 = bfhi(gw.x), g2 = bflo(gw.y), g3 = bfhi(gw.y);
        u32x2 ov; ov.x = pk2(o[4 * rg] * rstd * nw[0] * silu_f(g0), o[4 * rg + 1] * rstd * nw[1] * silu_f(g1)); ov.y = pk2(o[4 * rg + 2] * rstd * nw[2] * silu_f(g2), o[4 * rg + 3] * rstd * nw[3] * silu_f(g3));
        *(u32x2*)(MIX + (size_t)mrow * D + h * 128 + dv) = ov;
    }
    __syncthreads();
}
__device__ __forceinline__ void gla_g3(const Frame& F, const CAS Args* a, int l) {
    const bf16* P = (const bf16*)(F.ws + WS_P); bf16* MIX = (bf16*)(F.ws + WS_MIX);
    const bf16* US = (const bf16*)(F.ws + WS_SS); const bf16* USC = (const bf16*)(F.ws + WS_SSC);
    const int nunits = 1024 + (l == 0 ? 32 : 0);
    for (int u = F.vcu; u < nunits; u += F.G) {
        const bool latent = u < 1024; const int cc = u - 1024;
        const int b = latent ? (u >> 9) : (cc >> 4), h = latent ? ((u >> 7) & 3) : ((cc >> 2) & 3), n = latent ? (u & 127) : (cc & 3);
        const int m0 = latent ? b * SEQ + 64 * n : TL + b * LC + 64 * n;
        const int sf = (b * 4 + h) * 2;
        const bf16* Sf = latent ? US + ((size_t)sf * 128 + n) * 8192 : USC + ((size_t)sf * 4 + n) * 8192;
        const bf16* Sb = latent ? US + ((size_t)(sf + 1) * 128 + n) * 8192 : USC + ((size_t)(sf + 1) * 4 + n) * 8192;
        gla_g3_unit(F, a, l, P, m0, h, Sf, Sb, MIX);
    }
}

__device__ __forceinline__ void gla_naive(const Frame& F, const CAS Args* a, int l) {
    const bf16* P = (const bf16*)(F.ws + WS_P);
    bf16* OF = (bf16*)(F.ws + WS_GL);
    for (int w = F.gw; w < 2048; w += F.NGW) {
        const int dv = w & 127, dir = (w >> 7) & 1, h = (w >> 8) & 3, b = w >> 10;
        const int pcg = dir ? PC_GB : PC_GF;
        float S = 0.f;
        for (int step = 0; step < LC + SEQ; ++step) {
            int m;
            if (dir == 0) m = step < LC ? TL + b * LC + step : b * SEQ + (step - LC);
            else m = step < LC ? TL + b * LC + (LC - 1 - step) : b * SEQ + (SEQ - 1 - (step - LC));
            const bf16* row = P + (size_t)m * NIN;
            const float la = bf2f(row[pcg + h * 64 + F.lane]), kk = bf2f(row[PC_K + h * 64 + F.lane]), qq = bf2f(row[PC_Q + h * 64 + F.lane]), vv = bf2f(row[PC_V + h * 128 + dv]);
            S = __expf(la) * S + kk * vv;
            const float o = wave_sum(qq * S);
            if (F.lane == 0) OF[((size_t)dir * TT + m) * 512 + h * 128 + dv] = (bf16)f2bf(o);
        }
    }
}
__device__ __forceinline__ void gla_out_naive(const Frame& F, const CAS Args* a, int l) {
    const bf16* P = (const bf16*)(F.ws + WS_P); bf16* MIX = (bf16*)(F.ws + WS_MIX);
    const bf16* OF = (const bf16*)(F.ws + WS_GL);
    const int rows = (l == 0) ? TT : TL;
    for (int m = F.gw; m < rows; m += F.NGW) {
        const int c0 = 8 * F.lane;
        const u32x4 wa = *(const u32x4*)(OF + (size_t)m * 512 + c0), wb = *(const u32x4*)(OF + ((size_t)TT + m) * 512 + c0);
        float o[8] = {bflo(wa.x) + bflo(wb.x), bfhi(wa.x) + bfhi(wb.x), bflo(wa.y) + bflo(wb.y), bfhi(wa.y) + bfhi(wb.y), bflo(wa.z) + bflo(wb.z), bfhi(wa.z) + bfhi(wb.z), bflo(wa.w) + bflo(wb.w), bfhi(wa.w) + bfhi(wb.w)};
        float ss = 0.f;
#pragma unroll
        for (int i = 0; i < 8; ++i) ss += o[i] * o[i];
        ss = row16_sum(ss);
        const float rstd = 1.0f / sqrtf(ss * (1.0f / 128.0f) + EPS);
        const u32x4 wg = *(const u32x4*)(P + (size_t)m * NIN + PC_G + c0);
        const float g[8] = {bflo(wg.x), bfhi(wg.x), bflo(wg.y), bfhi(wg.y), bflo(wg.z), bfhi(wg.z), bflo(wg.w), bfhi(wg.w)};
        const f32x4 n0 = *(const f32x4*)(a->in[I_GLANORM] + l * 512 + c0), n1 = *(const f32x4*)(a->in[I_GLANORM] + l * 512 + c0 + 4);
        float r[8];
#pragma unroll
        for (int i = 0; i < 8; ++i) r[i] = o[i] * rstd * (i < 4 ? n0[i] : n1[i - 4]) * silu_f(g[i]);
        u32x4 w; w.x = pk2(r[0], r[1]); w.y = pk2(r[2], r[3]); w.z = pk2(r[4], r[5]); w.w = pk2(r[6], r[7]);
        *(u32x4*)(MIX + (size_t)m * D + c0) = w;
    }
}

constexpr int N2_WHI = 0, N2_WLO = 32768, N2_HHI = 65536, N2_HLO = 98304, N2_PART = 132096, N2_CNT = N2_PART + 8192, N2_RT = 20;
static_assert(N2_CNT + 256 + NWAVES * N2_RT * 16 <= LDS_BYTES && N2_PART >= MISC_OFF + 64 + 128, "N2 LDS map");
__device__ __forceinline__ int n2_addr(int r, int k) { return r * 2048 + ((((k >> 3) ^ r) & 127) << 4) + (k & 7) * 2; }
__device__ __forceinline__ void n2_route_phase(const Frame& F, const CAS Args* a, int l, bool do_route, int cset) {
    unsigned char* ws = F.ws;
    const float* mod = (const float*)(ws + WS_MOD);
    bf16* H = (bf16*)(ws + WS_H);
    unsigned* cnt = (unsigned*)(ws + WS_CTL) + CW_CNT + cset * NE * CNT_STRIDE;
    unsigned* list = (unsigned*)(ws + WS_LIST); float* listw = (float*)(ws + WS_LISTW);
    LAS unsigned* lcnt = (LAS unsigned*)(F.lds + N2_CNT); LAS unsigned* lbase = lcnt + 16; LAS unsigned* rec = lcnt + 64;
    for (int i = F.tid; i < D * NE; i += NWAVES * 64) { const int e = i & 15, k = i >> 4; const float w = a->in[I_WROUTER][i];
        const unsigned hi = f2bf(w); const unsigned lo = f2bf(w - bf2f(hi));
        *(LAS bf16*)(F.lds + N2_WHI + n2_addr(e, k)) = (bf16)hi; *(LAS bf16*)(F.lds + N2_WLO + n2_addr(e, k)) = (bf16)lo; }
    if (F.tid < 32) lcnt[F.tid] = 0u;
    __syncthreads();
    const int rows = (l == 0) ? TT : TL;
    const int t0 = F.gw;
    const int nch = (rows - F.vcu * NWAVES + F.NGW - 1) / F.NGW;
    f32x4 xc[2][4], xq[2][4];
#pragma unroll
    for (int half = 0; half < 2; ++half) { const int m = t0 + half * F.NGW;
        if (m < rows) { const float* xr = m < TL ? F.out + (size_t)m * D : (const float*)(ws + WS_XC) + (size_t)(m - TL) * D;
#pragma unroll
            for (int j = 0; j < 4; ++j) xq[half][j] = *(const f32x4*)(xr + 4 * F.lane + 256 * j); } }
    for (int c2 = 0; c2 < nch; c2 += 2) {
#pragma unroll
        for (int half = 0; half < 2; ++half)
#pragma unroll
            for (int j = 0; j < 4; ++j) xc[half][j] = xq[half][j];
#pragma unroll
        for (int half = 0; half < 2; ++half) { const int m = t0 + (c2 + 2 + half) * F.NGW;
            if (m < rows) { const float* xr = m < TL ? F.out + (size_t)m * D : (const float*)(ws + WS_XC) + (size_t)(m - TL) * D;
#pragma unroll
                for (int j = 0; j < 4; ++j) xq[half][j] = *(const f32x4*)(xr + 4 * F.lane + 256 * j); } }
#pragma unroll
        for (int half = 0; half < 2; ++half) {
            const int m = t0 + (c2 + half) * F.NGW, r = 8 * half + F.wave;
            if (m < rows) {
                const int v = m < TL ? (m >> 13) : 2;
                f32x4 x[4]; float ss = 0.f;
#pragma unroll
                for (int j = 0; j < 4; ++j) { x[j] = xc[half][j]; ss += (x[j][0] * x[j][0] + x[j][1] * x[j][1]) + (x[j][2] * x[j][2] + x[j][3] * x[j][3]); }
                const float rstd = 1.0f / sqrtf(wave_sum(ss) * (1.0f / D) + EPS);
#pragma unroll
                for (int j = 0; j < 4; ++j) {
                    const int col = 4 * F.lane + 256 * j;
                    const f32x4 nw = *(const f32x4*)(a->in[I_NORM2] + l * D + col);
                    const f32x4 sh = *(const f32x4*)(mod + (l * 3 + v) * 6144 + 3 * D + col);
                    const f32x4 sc = *(const f32x4*)(mod + (l * 3 + v) * 6144 + 4 * D + col);
                    const f32x4 h = x[j] * rstd * nw * (1.0f + sc) + sh;
                    const unsigned h0 = f2bf(h[0]), h1 = f2bf(h[1]), h2 = f2bf(h[2]), h3 = f2bf(h[3]);
                    u32x2 o; o.x = h0 | (h1 << 16); o.y = h2 | (h3 << 16);
                    *(u32x2*)(H + (size_t)m * D + col) = o;
                    u32x2 lo; lo.x = pk2(h[0] - bf2f(h0), h[1] - bf2f(h1)); lo.y = pk2(h[2] - bf2f(h2), h[3] - bf2f(h3));
                    const int ad = n2_addr(r, col);
                    *(LAS u32x2*)(F.lds + N2_HHI + ad) = o; *(LAS u32x2*)(F.lds + N2_HLO + ad) = lo;
                }
            }
        }
        __syncthreads();
        {
            const int rr = F.lane & 15, kg = F.lane >> 4;
            f32x4 acc = (f32x4){0.f, 0.f, 0.f, 0.f};
#pragma unroll
            for (int ks = 0; ks < 4; ++ks) {
                const int ad = n2_addr(rr, 128 * F.wave + 32 * ks + 8 * kg);
                const bf16x8 whi = *(const LAS bf16x8*)(F.lds + N2_WHI + ad), wlo = *(const LAS bf16x8*)(F.lds + N2_WLO + ad);
                const bf16x8 hhi = *(const LAS bf16x8*)(F.lds + N2_HHI + ad), hlo = *(const LAS bf16x8*)(F.lds + N2_HLO + ad);
                acc = __builtin_amdgcn_mfma_f32_16x16x32_bf16(whi, hhi, acc, 0, 0, 0);
                acc = __builtin_amdgcn_mfma_f32_16x16x32_bf16(whi, hlo, acc, 0, 0, 0);
                acc = __builtin_amdgcn_mfma_f32_16x16x32_bf16(wlo, hhi, acc, 0, 0, 0);
            }
            *(LAS f32x4*)(F.lds + N2_PART + ((F.wave * 16 + rr) * 16 + 4 * kg) * 4) = acc;
        }
        __syncthreads();
        if (F.wave == 0) {
            const int rr = F.lane & 15, eg = F.lane >> 4;
            f32x4 lg = (f32x4){0.f, 0.f, 0.f, 0.f};
#pragma unroll
            for (int w = 0; w < NWAVES; ++w) lg = lg + *(const LAS f32x4*)(F.lds + N2_PART + ((w * 16 + rr) * 16 + 4 * eg) * 4);
            const f32x4 br = *(const f32x4*)(a->in[I_BROUTER] + 4 * eg);
            float sg[4], sb[4];
#pragma unroll
            for (int i = 0; i < 4; ++i) { sg[i] = 1.0f / (1.0f + expf(-lg[i])); sb[i] = sg[i] + br[i]; }
            int i0 = 0, i1 = 0; float b0 = -1e30f, b1 = -1e30f, s0 = 0.f, s1 = 0.f;
#pragma unroll
            for (int i = 0; i < 4; ++i) { const float val = sb[i];
                if (val > b0) { b1 = b0; i1 = i0; s1 = s0; b0 = val; i0 = i; s0 = sg[i]; } else if (val > b1) { b1 = val; i1 = i; s1 = sg[i]; } }
            const float gs = b0 + b1;
            float best = gs; int bg = eg;
#pragma unroll
            for (int st = 16; st < 64; st <<= 1) {
                const float og = __builtin_bit_cast(float, __builtin_amdgcn_ds_bpermute((F.lane ^ st) << 2, __builtin_bit_cast(int, best)));
                const int oi = __builtin_amdgcn_ds_bpermute((F.lane ^ st) << 2, bg);
                if (og > best || (og == best && oi < bg)) { best = og; bg = oi; }
            }
            const int half = rr >> 3, wv = rr & 7, ch = c2 + half;
            const int m = F.vcu * NWAVES + wv + ch * F.NGW;
            if (do_route && bg == eg && m < rows) {
                const int e0 = 4 * eg + i0, e1 = 4 * eg + i1; const float inv = 1.0f / (s0 + s1);
                if (ch < N2_RT) {
                    const int slot = wv * N2_RT + ch;
                    const unsigned l0 = atomicAdd((unsigned*)(lcnt + e0), 1u), l1 = atomicAdd((unsigned*)(lcnt + e1), 1u);
                    rec[slot * 4 + 0] = (unsigned)m; rec[slot * 4 + 1] = (unsigned)e0 | ((unsigned)e1 << 8) | (l0 << 16) | (l1 << 24);
                    rec[slot * 4 + 2] = __float_as_uint(s0 * inv); rec[slot * 4 + 3] = __float_as_uint(s1 * inv);
                } else {
                    const unsigned p0 = atomicAdd(cnt + e0 * CNT_STRIDE, 1u); list[(size_t)e0 * LISTCAP + p0] = (unsigned)m * 2u; listw[(size_t)e0 * LISTCAP + p0] = s0 * inv;
                    const unsigned p1 = atomicAdd(cnt + e1 * CNT_STRIDE, 1u); list[(size_t)e1 * LISTCAP + p1] = (unsigned)m * 2u + 1u; listw[(size_t)e1 * LISTCAP + p1] = s1 * inv;
                }
            }
        }
    }
    __syncthreads();
    if (do_route) {
        if (F.tid < NE) { const unsigned c = lcnt[F.tid]; lbase[F.tid] = c ? atomicAdd(cnt + F.tid * CNT_STRIDE, c) : 0u; }
        __syncthreads();
        for (int i = F.tid; i < NWAVES * N2_RT; i += NWAVES * 64) {
            const int wv = i / N2_RT, k = i % N2_RT;
            if (F.vcu * NWAVES + wv + k * F.NGW < rows) {
                const unsigned m = rec[i * 4], pk = rec[i * 4 + 1]; const unsigned e0 = pk & 255u, e1 = (pk >> 8) & 255u, l0 = (pk >> 16) & 255u, l1 = pk >> 24;
                const unsigned p0 = lbase[e0] + l0, p1 = lbase[e1] + l1;
                list[(size_t)e0 * LISTCAP + p0] = m * 2u; listw[(size_t)e0 * LISTCAP + p0] = __uint_as_float(rec[i * 4 + 2]);
                list[(size_t)e1 * LISTCAP + p1] = m * 2u + 1u; listw[(size_t)e1 * LISTCAP + p1] = __uint_as_float(rec[i * 4 + 3]);
            }
        }
    }
    __syncthreads();
}

__device__ __forceinline__ void moe_setup(pg8::MoeOrder& S, const Frame& F, int cset, int nN) {
    unsigned* cnt = (unsigned*)(F.ws + WS_CTL) + CW_CNT + cset * NE * CNT_STRIDE;
    LAS int* tab = (LAS int*)(F.lds + MISC_OFF + 64);
    __syncthreads();
    if (F.tid == 0) { int run = 0;
        for (int e = 0; e < NE; ++e) { const int c = (int)__hip_atomic_load(cnt + e * CNT_STRIDE, __ATOMIC_RELAXED, __HIP_MEMORY_SCOPE_AGENT); tab[e] = c; run += (c + 255) >> 8; tab[16 + e] = run; } }
    __syncthreads();
    S.tab = tab; S.nN = nN; S.nunits = __builtin_amdgcn_readfirstlane(tab[31]) * nN; S.G = F.G; S.c = (int)blockIdx.x;
    S.tdone = (unsigned*)(F.ws + WS_CTL) + CW_TDONE + cset * 160 * 16; S.role = 0;
    S.list = (const unsigned*)(F.ws + WS_LIST);
}
__device__ __forceinline__ void moe1_phase(const Frame& F, const CAS Args* a, int l, int cset) {
    pg8::MoeOrder S; moe_setup(S, F, cset, 4);
    S.A = (const char*)(F.ws + WS_H); S.Bt = (const char*)(F.ws + WS_WGU) + (size_t)l * NE * D * D * 2; S.K = D; S.bstride_e = (size_t)D * D * 2; S.gather = true; S.role = 1;
    EpiGU E{(bf16*)(F.ws + WS_HMID)};
    pg8::gemm_phase<EpiGU, pg8::MoeOrder>(F.lds, F.tid, S, E);
}
__device__ __forceinline__ void moe2_phase(const Frame& F, const CAS Args* a, int l, int cset) {
    pg8::MoeOrder S; moe_setup(S, F, cset, 4);
    S.A = (const char*)(F.ws + WS_HMID); S.Bt = (const char*)(F.ws + WS_WD) + (size_t)l * NE * D * DE * 2; S.K = DE; S.bstride_e = (size_t)D * DE * 2; S.gather = false; S.role = 2; S.c = F.G - 1 - (int)blockIdx.x;
    EpiDown E; E.Y = (bf16*)(F.ws + WS_Y); E.list = (const unsigned*)(F.ws + WS_LIST); E.listw = (const float*)(F.ws + WS_LISTW); E.tab = S.tab;
    pg8::gemm_phase<EpiDown, pg8::MoeOrder>(F.lds, F.tid, S, E);
    if (l == 0 && cset == 0) convert_moe_filler(F, a, 1, S.nunits, true);
}

__device__ __forceinline__ void final_load(const Frame& F, int m, f32x4 (&x)[4]) {
    const float* mod = (const float*)(F.ws + WS_MOD);
    const bf16* Y0 = (const bf16*)(F.ws + WS_Y); const bf16* Y1 = Y0 + (size_t)TT * D;
    const int v = m >> 13; const float* xrow = F.out + (size_t)m * D;
#pragma unroll
    for (int j = 0; j < 4; ++j) {
        const int col = 4 * F.lane + 256 * j;
        const f32x4 g2 = *(const f32x4*)(mod + (3 + v) * 6144 + 5 * D + col);
        const f32x4 y = ld_y4(Y0 + (size_t)m * D + col) + ld_y4(Y1 + (size_t)m * D + col);
        x[j] = *(const f32x4*)(xrow + col) + g2 * y;
    }
}
__device__ __forceinline__ void final_row(const Frame& F, const CAS Args* a, int m, const f32x4 (&x)[4]) {
    float* xrow = F.out + (size_t)m * D; float ss = 0.f;
#pragma unroll
    for (int j = 0; j < 4; ++j) ss += (x[j][0] * x[j][0] + x[j][1] * x[j][1]) + (x[j][2] * x[j][2] + x[j][3] * x[j][3]);
    const float rstd = 1.0f / sqrtf(wave_sum(ss) * (1.0f / D) + EPS);
#pragma unroll
    for (int j = 0; j < 4; ++j) { const int col = 4 * F.lane + 256 * j; const f32x4 nw = *(const f32x4*)(a->in[I_FNORM] + col); *(f32x4*)(xrow + col) = x[j] * rstd * nw; }
}
__device__ __forceinline__ void final_phase(const Frame& F, const CAS Args* a) {
    for (int m = F.gw; m < TL; m += 2 * F.NGW) {
        const int m2 = m + F.NGW; const bool two = m2 < TL;
        f32x4 xa[4], xb[4];
        final_load(F, m, xa);
        if (two) final_load(F, m2, xb);
        final_row(F, a, m, xa);
        if (two) final_row(F, a, m2, xb);
    }
}

#ifndef NPASS
#define NPASS 1
#endif
#ifndef PROBE_PH
#define PROBE_PH -1
#endif
#ifndef PROBE_R
#define PROBE_R 3
#endif
#ifndef PROBE_UPTO
#define PROBE_UPTO -1
#endif
#ifndef PROBE_ABL
#define PROBE_ABL 0
#endif
constexpr int PH_PER_LAYER = 8;
constexpr int N_PHASES = 1 + DEPTH * PH_PER_LAYER + 1;

template <int ph0>
__device__ __forceinline__ void do_phase(Frame& F, XcdBarrier& bar, LAS unsigned char* lds, int lo, int hi) {
    constexpr int ph = ph0 % N_PHASES, pass = ph0 / N_PHASES;
    if (!(lo <= ph && ph < hi)) return;
    if (pass == 1 && (PROBE_UPTO >= 0 ? ph >= PROBE_UPTO : ph != PROBE_PH)) return;
    const CAS Args* ap;
        { int l_; asm volatile("v_mbcnt_lo_u32_b32 %0, -1, 0\n\tv_mbcnt_hi_u32_b32 %0, -1, %0" : "=v"(l_)); F.lane = l_; F.tid = F.wave * 64 + l_; ap = (const CAS Args*)__builtin_amdgcn_kernarg_segment_ptr(); asm volatile("" : "+s"(ap)); F.ws = ap->ws; F.out = (pass == 1) ? (float*)(ap->ws + WS_P) : ap->out;
          LAS unsigned char* lb_ = (LAS unsigned char*)lds; asm volatile("" : "+s"(lb_)); __builtin_assume((((unsigned)(__UINTPTR_TYPE__)lb_) & 1023u) == 0u); F.lds = lb_;
          bar.bar = (unsigned*)(F.ws + WS_CTL) + CW_BAR; bar.st = (volatile LAS unsigned*)(F.lds + MISC_OFF) + 8; }
        if (ph == 0) { if (PH_ON(10)) REP(10, true) p0_prologue(F, ap); }
        else if (ph == N_PHASES - 1) { if (PH_ON(11)) REP(11, false) final_phase(F, ap); }
        else {
            const int l = (ph - 1) / PH_PER_LAYER, s = (ph - 1) % PH_PER_LAYER;
            unsigned char* ws = F.ws;
            if (s == 0) { if (PH_ON(0)) REP(0, l == 0) n1_phase(F, ap, l); }
            else if (s == 1 && PH_ON(1)) REP(1, true) {
                pg8::DenseOrder S; S.init(ws + WS_H, ws + WS_WIN + (size_t)l * NIN * D * 2, TT, NIN, D, F.G, (int)blockIdx.x);
                EpiIn E{(bf16*)(ws + WS_P), ap->in[I_BIASF] + l * 256, ap->in[I_BIASB] + l * 256, (const float*)(ws + WS_ROPE), (const float*)(ws + WS_ROPE) + 2048};
                pg8::gemm_phase<EpiIn, pg8::DenseOrder>(F.lds, F.tid, S, E);
            }
            else if (s == 2) { constexpr int abl = (pass == 1) ? PROBE_ABL : 0; if (PH_ON(2) && abl != 5) REP(2, true) swa_flash(F, ap, l, abl); if (PH_ON(12) && abl != 6) REP(12, true) gla_g1(F, l); }
            else if (s == 3) { if (PH_ON(13)) REP(13, true) gla_scan(F); }
            else if (s == 4) { if (PH_ON(3)) REP(3, true) gla_g3(F, ap, l); }
            else if (s == 5 && PH_ON(4)) REP(4, l == 0) {
                pg8::DenseOrder S; S.init(ws + WS_MIX, ws + WS_WOUT + (size_t)l * D * D * 2, l == 0 ? TT : TL, D, D, F.G, (int)blockIdx.x);
                EpiOut E{l == 0 ? ap->in[I_X] : F.out, l == 0 ? ap->in[I_CTX] : (const float*)(ws + WS_XC), F.out, (float*)(ws + WS_XC), (const float*)(ws + WS_MOD) + l * 3 * 6144};
                pg8::gemm_phase<EpiOut, pg8::DenseOrder>(F.lds, F.tid, S, E);
                if (l == 0 && pass == 0) convert_moe_filler(F, ap, 0, S.nwg);
            }
            else if (s == 6) { if (PH_ON(5)) REP(5, true) n2_route_phase(F, ap, l, rep_ == 0 || pass == 1, l + 2 * pass); }
            else { if (PH_ON(6)) { moe1_phase(F, ap, l, l + 2 * pass); moe2_phase(F, ap, l, l + 2 * pass); } }
        }
        if (ph0 + 1 < NPASS * N_PHASES) for (int rb_ = 0; rb_ < (REPEAT_S == 20 ? REPEAT_N : 1); ++rb_) xcd_barrier(bar, F.tid);
}
template <int... I>
__device__ __forceinline__ void run_all(Frame& F, XcdBarrier& bar, LAS unsigned char* lds, int lo, int hi, std::integer_sequence<int, I...>) { (do_phase<I>(F, bar, lds, lo, hi), ...); }

#ifdef VGPR_CAP
__attribute__((amdgpu_num_vgpr(VGPR_CAP)))
#endif
__global__ void __launch_bounds__(NWAVES * 64, 2) mk_fwd(Args args) {
    extern __shared__ __attribute__((aligned(16))) unsigned char lds[];
    Frame F;
    F.lds = (LAS unsigned char*)lds;
    F.tid = threadIdx.x; F.lane = F.tid & 63; F.wave = __builtin_amdgcn_readfirstlane(F.tid >> 6);
    F.G = gridDim.x; { const int bx = blockIdx.x; F.vcu = (F.G % 8 == 0) ? (bx % 8) * (F.G / 8) + bx / 8 : bx; }
    F.gw = F.vcu * NWAVES + F.wave; F.NGW = F.G * NWAVES;
    const CAS Args* ap = (const CAS Args*)__builtin_amdgcn_kernarg_segment_ptr();
    F.ws = ap->ws; F.out = ap->out;
    volatile LAS unsigned* MISC = (volatile LAS unsigned*)(F.lds + MISC_OFF);
    for (int u = F.tid; u < (LDS_BYTES - LDSCTL_OFF) / 4; u += NWAVES * 64) ((LAS unsigned*)(F.lds + LDSCTL_OFF))[u] = 0u;
    __syncthreads();
    XcdBarrier bar; bar.bar = (unsigned*)(F.ws + WS_CTL) + CW_BAR; bar.x = 0; bar.st = nullptr;
    const bool fused = (ap->ph_hi - ap->ph_lo) > 1;
    if (fused) bar = xcd_barrier_post((unsigned*)(F.ws + WS_CTL) + CW_BAR, MISC + 8);
    const int lo = ap->ph_lo, hi = ap->ph_hi;
    run_all(F, bar, (LAS unsigned char*)lds, lo, hi, std::make_integer_sequence<int, NPASS * N_PHASES>{});
}

extern "C" void kernel_launch(void* const* d_in, const int* in_sizes, int n_in, void* d_out, int out_size, void* d_ws, size_t ws_size, hipStream_t stream) {
    static int grid = 0;
    if (grid == 0) {
        if (n_in != 22 || out_size != TL * D || ws_size < WS_END) { fprintf(stderr, "kernel_launch: unexpected shapes (n_in %d out %d ws %zu)\n", n_in, out_size, ws_size); grid = -1; return; }
        int dev = 0, cus = 0, per_cu = 0;
        if (hipGetDevice(&dev) != hipSuccess || hipDeviceGetAttribute(&cus, hipDeviceAttributeMultiprocessorCount, dev) != hipSuccess) { grid = -1; return; }
        if (hipFuncSetAttribute((const void*)mk_fwd, hipFuncAttributeMaxDynamicSharedMemorySize, LDS_BYTES) != hipSuccess) { fprintf(stderr, "kernel_launch: hipFuncSetAttribute failed\n"); grid = -1; return; }
        if (hipOccupancyMaxActiveBlocksPerMultiprocessor(&per_cu, (const void*)mk_fwd, NWAVES * 64, LDS_BYTES) != hipSuccess || per_cu < 1) fprintf(stderr, "kernel_launch: occupancy query says %d\n", per_cu);
        (void)hipGetLastError();
        grid = cus;
    }
    if (grid < 0) return;
    (void)hipMemsetAsync((char*)d_ws + WS_CTL, 0, CTL_ZERO_BYTES, stream);
    Args a{};
    for (int i = 0; i < 22; ++i) a.in[i] = (const float*)d_in[i];
    a.out = (float*)d_out; a.ws = (unsigned char*)d_ws; a.li = 0; a.pad = 0;
#if MK_N_LAUNCHES == 1
    a.ph_lo = 0; a.ph_hi = N_PHASES;
    hipLaunchKernelGGL(mk_fwd, dim3(grid), dim3(NWAVES * 64), LDS_BYTES, stream, a);
#else
    for (int ph = 0; ph < N_PHASES; ++ph) { a.ph_lo = ph; a.ph_hi = ph + 1; hipLaunchKernelGGL(mk_fwd, dim3(grid), dim3(NWAVES * 64), LDS_BYTES, stream, a); }
#endif
}
```

```cpp
#include <hip/hip_runtime.h>
#include <cstdio>
#include <cstdint>
#include <utility>

#ifndef ONLY_S
#define ONLY_S -1
#endif
#define PH_ON(k) (ONLY_S < 0 || ONLY_S == (k))
#ifndef REPEAT_S
#define REPEAT_S -1
#endif
#ifndef REPEAT_N
#define REPEAT_N 4
#endif
#define REP(k, cond) for (int rep_ = 0; rep_ < ((pass == 1) ? PROBE_R : ((REPEAT_S == (k) && (cond)) ? REPEAT_N : 1)); ++rep_)
#ifndef MK_N_LAUNCHES
#define MK_N_LAUNCHES 1
#endif

#define GAS __attribute__((address_space(1)))
#define LAS __attribute__((address_space(3)))
#define CAS __attribute__((address_space(4)))
typedef unsigned short bf16;
typedef short bf16x8 __attribute__((ext_vector_type(8)));
typedef float f32x4 __attribute__((ext_vector_type(4)));
typedef float f32x2 __attribute__((ext_vector_type(2)));
typedef unsigned u32x4 __attribute__((ext_vector_type(4)));
typedef unsigned u32x2 __attribute__((ext_vector_type(2)));
typedef int v8i __attribute__((ext_vector_type(8)));

constexpr int D = 1024, SEQ = 8192, LC = 256, TL = 16384, TC = 512, TT = TL + TC, DEPTH = 2;
constexpr int NE = 16, DE = 512;
constexpr int NIN = 2816;
constexpr int PC_Q = 0, PC_K = 256, PC_V = 512, PC_G = 1024, PC_SQ = 1536, PC_SK = 2048, PC_SV = 2176, PC_GF = 2304, PC_GB = 2560;
constexpr int WIN_COLS = 2336;
constexpr float EPS = 1e-6f;
constexpr float LOG2E = 1.4426950408889634f, QSCALE = 0.125f * LOG2E;
constexpr int LISTCAP = TT;

constexpr size_t MiB = 1u << 20;
constexpr size_t WS_CTL = 0, CTL_ZERO_BYTES = 131072;
constexpr size_t WS_MOD = 1 * MiB;
constexpr size_t WS_ROPE = 1 * MiB + 256 * 1024;
constexpr size_t WS_LIST = 2 * MiB;
constexpr size_t WS_LISTW = 2 * MiB + 1536 * 1024;
constexpr size_t WS_XC = 5 * MiB;
constexpr size_t WS_WIN = 8 * MiB;
constexpr size_t WS_WOUT = 19 * MiB;
constexpr size_t WS_WGU = 23 * MiB;
constexpr size_t WS_WD = 87 * MiB;
constexpr size_t WS_H = 119 * MiB;
constexpr size_t WS_P = 152 * MiB;
constexpr size_t WS_MIX = 243 * MiB;
constexpr size_t WS_GL = 276 * MiB;
constexpr size_t WS_HMID = 152 * MiB;
constexpr size_t WS_Y = 190 * MiB;
constexpr size_t WS_END = 309 * MiB;
static_assert(WS_LIST + (size_t)NE * LISTCAP * 4 <= WS_LISTW && WS_LISTW + (size_t)NE * LISTCAP * 4 <= WS_XC, "ws map");
static_assert(WS_P + (size_t)TT * NIN * 2 <= WS_MIX && WS_MIX + (size_t)TT * D * 2 <= WS_GL, "ws map");
static_assert(WS_HMID + (size_t)37888 * 512 * 2 <= WS_Y && WS_Y + (size_t)2 * TT * D * 2 <= WS_GL, "ws map");
constexpr int CW_CNT = 8192, CNT_STRIDE = 64;
constexpr int CW_TDONE = 16384;
constexpr int CW_BAR = 4096;

__device__ __forceinline__ unsigned f2bf(float f) { unsigned u = __builtin_bit_cast(unsigned, f); return (u + 0x7fffu + ((u >> 16) & 1u)) >> 16; }
__device__ __forceinline__ unsigned pk2(float lo, float hi) { return f2bf(lo) | (f2bf(hi) << 16); }
__device__ __forceinline__ float bf2f(unsigned h) { return __builtin_bit_cast(float, h << 16); }
__device__ __forceinline__ float bflo(unsigned w) { return __builtin_bit_cast(float, w << 16); }
__device__ __forceinline__ float bfhi(unsigned w) { return __builtin_bit_cast(float, w & 0xffff0000u); }
__device__ __forceinline__ float dpp_add(float v, float t) { return v + t; }
#define DPP_F(v, ctrl, rmask) __builtin_bit_cast(float, __builtin_amdgcn_update_dpp(0, __builtin_bit_cast(int, (v)), (ctrl), (rmask), 0xF, false))
__device__ __forceinline__ float row16_sum(float v) {
    v += DPP_F(v, 0xB1, 0xF); v += DPP_F(v, 0x4E, 0xF); v += DPP_F(v, 0x141, 0xF); v += DPP_F(v, 0x140, 0xF); return v;
}
__device__ __forceinline__ float wave_sum(float v) {
    v = row16_sum(v);
    v += DPP_F(v, 0x142, 0xA); v += DPP_F(v, 0x143, 0xC);
    return __builtin_bit_cast(float, __builtin_amdgcn_readlane(__builtin_bit_cast(int, v), 63));
}
__device__ __forceinline__ float silu_f(float x) { return x / (1.0f + __expf(-x)); }
__device__ __forceinline__ unsigned pk4_fp8(float a, float b, float c, float d) {
    a = fminf(fmaxf(a, -448.f), 448.f); b = fminf(fmaxf(b, -448.f), 448.f); c = fminf(fmaxf(c, -448.f), 448.f); d = fminf(fmaxf(d, -448.f), 448.f);
    int w = __builtin_amdgcn_cvt_pk_fp8_f32(a, b, 0, false); w = __builtin_amdgcn_cvt_pk_fp8_f32(c, d, w, true); return (unsigned)w;
}
constexpr float W1_SCALE = 64.f, W2_SCALE = 32.f, HMID_SCALE = 4.f;
constexpr int SC_ONE = 127, SC_W1 = 121, SC_W2 = 122, SC_HMID = 125;
#define LDS_WAIT() asm volatile("s_waitcnt lgkmcnt(0)" ::: "memory")
#define VM_WAIT() asm volatile("s_waitcnt vmcnt(0)" ::: "memory")

namespace pg8 {
constexpr int BM = 256, BK = 64, HALF = 128, HTB = HALF * BK * 2, STAGE_BYTES = 8 * HTB, NXCD = 8, WGM = 8;
__host__ __device__ __forceinline__ int lds_byte(int r, int c) { const int st = (r >> 4) * 2 + (c >> 5), rr = r & 15, cc = c & 31, ob = rr * 64 + cc * 2; return st * 1024 + (ob ^ (((ob >> 9) & 1) << 5)); }
__host__ __device__ __forceinline__ void stage_rc(int b, int& R, int& C) { const int st = b / 1024, sb = b % 1024, swz = sb ^ (((sb >> 9) & 1) << 5); R = (st >> 1) * 16 + swz / 64; C = (st & 1) * 32 + (swz % 64) / 2; }
__host__ __device__ __forceinline__ int perm32(int rho) { const int n = rho >> 4, i = rho & 15; return 8 * (i >> 2) + 4 * n + (i & 3); }

struct Unit { int pm, pn, e, mt; };

__device__ __forceinline__ int xcd_remap(int wgid, int nwg) { const int q = nwg / NXCD, r = nwg % NXCD, xcd = wgid % NXCD, off = wgid / NXCD; return (xcd < r ? xcd * (q + 1) : r * (q + 1) + (xcd - r) * q) + off; }

struct DenseOrder {
    static constexpr bool DYN_A = false;
    const char* A; const char* Bt; int K; int nM, nN, nwg, G, c;
    __device__ void init(const void* A_, const void* Bt_, int M, int N, int K_, int G_, int c_) { A = (const char*)A_; Bt = (const char*)Bt_; K = K_; nM = M / BM; nN = N / BM; nwg = nM * nN; G = G_; c = c_; }
    __device__ __forceinline__ bool next(int i, Unit& u) const {
        const long L = (long)i * G + c; if (L >= nwg) return false;
        const int wgid = xcd_remap((int)L, nwg);
        const int nig = WGM * nN, gid = wgid / nig, fm = gid * WGM, gsz = (nM - fm) < WGM ? (nM - fm) : WGM;
        u.pm = fm + ((wgid % nig) % gsz); u.pn = (wgid % nig) / gsz; u.e = 0; u.mt = 0; return true;
    }
    __device__ __forceinline__ void a_ready(const Unit&, int) const {}
    __device__ __forceinline__ void done(const Unit&, int) const {}
    __device__ __forceinline__ const char* a_ptr(const Unit& u) const { return A + (size_t)u.pm * (size_t)(BM * K * 2); }
    __device__ __forceinline__ const char* b_ptr(const Unit& u) const { return Bt + (size_t)u.pn * (size_t)(BM * K * 2); }
    __device__ __forceinline__ void a_voff(const Unit&, const int (&R)[2], const int (&C)[2], unsigned (&v0)[2], unsigned (&v1)[2]) const {
#pragma unroll
        for (int i = 0; i < 2; ++i) { v0[i] = (unsigned)(R[i] * K + C[i]) * 2u; v1[i] = v0[i] + (unsigned)(HALF * K * 2); }
    }
};

struct MoeOrder {
    static constexpr bool DYN_A = true;
    const char* A; const char* Bt; int K; size_t bstride_e; int G, c, nunits, nN; bool gather;
    const unsigned* list; const LAS int* tab;
    unsigned* tdone; int role;
    __device__ __forceinline__ void a_ready(const Unit& u, int wid) const {
        if (role == 2) {
            if (wid == 0) { unsigned sp = 0;
                while (__hip_atomic_load(tdone + u.pm * 16, __ATOMIC_RELAXED, __HIP_MEMORY_SCOPE_AGENT) < 32u) { __builtin_amdgcn_s_sleep(2); if (++sp > (1u << 22)) break; }
                __builtin_amdgcn_fence(__ATOMIC_ACQUIRE, "agent"); asm volatile("s_waitcnt vmcnt(0)" ::: "memory"); }
            __builtin_amdgcn_s_barrier();
        }
    }
    __device__ __forceinline__ void done(const Unit& u, int lane) const {
        if (role == 1) { asm volatile("s_waitcnt vmcnt(0)" ::: "memory");
            if (lane == 0) __hip_atomic_fetch_add(tdone + u.pm * 16, 1u, __ATOMIC_RELAXED, __HIP_MEMORY_SCOPE_AGENT); }
    }
    __device__ __forceinline__ bool next(int i, Unit& u) const {
        const long L = (long)i * G + c; if (L >= nunits) return false;
        const int wgid = xcd_remap((int)L, nunits);
        const int tl = wgid / nN; u.pn = wgid % nN;
        int e = 0, tstart = 0;
#pragma unroll 1
        for (int k = 0; k < NE - 1; ++k) { const int te = tab[16 + k]; if (tl >= te) { e = k + 1; tstart = te; } }
        u.e = __builtin_amdgcn_readfirstlane(e); u.mt = __builtin_amdgcn_readfirstlane(tl - tstart); u.pm = tl; return true;
    }
    __device__ __forceinline__ const char* a_ptr(const Unit& u) const { return gather ? A : A + (size_t)u.pm * (size_t)(BM * K * 2); }
    __device__ __forceinline__ const char* b_ptr(const Unit& u) const { return Bt + (size_t)u.e * bstride_e + (size_t)u.pn * (size_t)(BM * K * 2); }
    __device__ __forceinline__ void a_voff(const Unit& u, const int (&R)[2], const int (&C)[2], unsigned (&v0)[2], unsigned (&v1)[2]) const {
        if (gather) {
            const int ce = tab[u.e];
            const unsigned* lp = list + (size_t)u.e * LISTCAP + u.mt * BM;
#pragma unroll
            for (int i = 0; i < 2; ++i) {
                const int r0 = R[i], r1 = R[i] + HALF;
                const unsigned t0 = (u.mt * BM + r0 < ce) ? (__builtin_nontemporal_load(lp + r0) >> 1) : 0u;
                const unsigned t1 = (u.mt * BM + r1 < ce) ? (__builtin_nontemporal_load(lp + r1) >> 1) : 0u;
                v0[i] = (t0 * (unsigned)K + (unsigned)C[i]) * 2u; v1[i] = (t1 * (unsigned)K + (unsigned)C[i]) * 2u;
            }
        } else {
#pragma unroll
            for (int i = 0; i < 2; ++i) { v0[i] = (unsigned)(R[i] * K + C[i]) * 2u; v1[i] = v0[i] + (unsigned)(HALF * K * 2); }
        }
    }
};

__device__ __forceinline__ unsigned cvt_pk_bf16(float lo, float hi) { unsigned r; asm volatile("v_cvt_pk_bf16_f32 %0, %1, %2" : "=v"(r) : "v"(lo), "v"(hi)); return r; }

template <class Epi, class Sched, bool F8 = false>
__device__ __forceinline__ void gemm_phase(LAS unsigned char* lds, int tid, const Sched& S, const Epi& E, int sc_w = 127, int sc_a = 127) {
    const int wid = __builtin_amdgcn_readfirstlane(tid >> 6), lane = tid & 63, wr = wid >> 2, wc = wid & 3, fr = lane & 15, fq = lane >> 4;
    const int K = S.K, nt = K / BK;
    int Rr[2], Cc[2]; unsigned voffB[2];
#pragma unroll
    for (int i = 0; i < 2; ++i) { int R, C; stage_rc(tid * 16 + i * 8192, R, C); const int Rb = Epi::PERM ? ((R & ~31) + perm32(R & 31)) : R;
        Rr[i] = R; Cc[i] = C; voffB[i] = (unsigned)(Rb * K + C) * 2u; }
    const size_t kstep = (size_t)(BK * 2);
    const size_t hstep = (size_t)HALF * K * 2;
    const unsigned ldsw = (unsigned)wid * 1024u;
    const int aoff = lds_byte(wr * 64 + fr, fq * 8), boff = lds_byte(wc * 32 + fr, fq * 8);
#define PG8_SA(b, h) (((b) * 2 + (h)) * HTB)
#define PG8_SB(b, h) ((4 + (b) * 2 + (h)) * HTB)
#define PG8_STAGE(bufoff, gbase, voff) do { _Pragma("unroll") for (int _i = 0; _i < 2; ++_i) \
        __builtin_amdgcn_global_load_lds((const unsigned*)((const char*)(gbase) + (voff)[_i]), (LAS unsigned*)(lds + (bufoff) + ldsw + _i * 8192), 16, 0, 0); } while (0)
#define PG8_CAT(lo_, hi_) ((v8i){(int)(lo_).x, (int)(lo_).y, (int)(lo_).z, (int)(lo_).w, (int)(hi_).x, (int)(hi_).y, (int)(hi_).z, (int)(hi_).w})
#define PG8_LDA(dst, b, h) do { _Pragma("unroll") for (int m = 0; m < 4; ++m) { if constexpr (F8) { const u32x4 l_ = *(const LAS u32x4*)(lds + PG8_SA(b, h) + aoff + m * 2048), h_ = *(const LAS u32x4*)(lds + PG8_SA(b, h) + aoff + m * 2048 + 1024); dst##8[m] = PG8_CAT(l_, h_); } \
        else { _Pragma("unroll") for (int k = 0; k < 2; ++k) dst[m][k] = *(const LAS bf16x8*)(lds + PG8_SA(b, h) + aoff + m * 2048 + k * 1024); } } } while (0)
#define PG8_LDB(dst, b, h) do { _Pragma("unroll") for (int n = 0; n < 2; ++n) { if constexpr (F8) { const u32x4 l_ = *(const LAS u32x4*)(lds + PG8_SB(b, h) + boff + n * 2048), h_ = *(const LAS u32x4*)(lds + PG8_SB(b, h) + boff + n * 2048 + 1024); dst##8[n] = PG8_CAT(l_, h_); } \
        else { _Pragma("unroll") for (int k = 0; k < 2; ++k) dst[n][k] = *(const LAS bf16x8*)(lds + PG8_SB(b, h) + boff + n * 2048 + k * 1024); } } } while (0)
#define PG8_MMA(ai, bj, At, Bt) do { __builtin_amdgcn_s_setprio(1); _Pragma("unroll") for (int m = 0; m < 4; ++m) _Pragma("unroll") for (int n = 0; n < 2; ++n) { \
        if constexpr (F8) asm volatile("v_mfma_scale_f32_16x16x128_f8f6f4 %0, %1, %2, %0, %3, %4 op_sel_hi:[0,0,0]" : "+v"(acc[ai][bj][m][n]) : "v"(Bt##8[n]), "v"(At##8[m]), "v"(sc_w), "v"(sc_a)); \
        else { _Pragma("unroll") for (int k = 0; k < 2; ++k) acc[ai][bj][m][n] = __builtin_amdgcn_mfma_f32_16x16x32_bf16(Bt[n][k], At[m][k], acc[ai][bj][m][n], 0, 0, 0); } } \
        __builtin_amdgcn_s_setprio(0); } while (0)
#define PG8_WAIT_V(n) asm volatile("s_waitcnt vmcnt(" #n ")" ::: "memory")
#define PG8_WAIT_L(n) asm volatile("s_waitcnt lgkmcnt(" #n ")" ::: "memory")
#define PG8_BAR __builtin_amdgcn_s_barrier()
#define PG8_SCHED __builtin_amdgcn_sched_barrier(0)
    Unit cur, nxt; int ui = 0;
    if (!S.next(0, cur)) return;
    f32x4 acc[2][2][4][2];
#pragma unroll
    for (int a = 0; a < 2; ++a)
#pragma unroll
        for (int b = 0; b < 2; ++b)
#pragma unroll
            for (int m = 0; m < 4; ++m)
#pragma unroll
                for (int n = 0; n < 2; ++n) acc[a][b][m][n] = (f32x4){0.f, 0.f, 0.f, 0.f};
    bf16x8 At[4][2], B0[2][2], B1[2][2]; v8i At8[4], B08[2], B18[2];
    const char* cA = S.a_ptr(cur); const char* cB = S.b_ptr(cur);
    unsigned cv0[2], cv1[2], nv0[2], nv1[2];
    S.a_ready(cur, wid);
    S.a_voff(cur, Rr, Cc, cv0, cv1);
    PG8_STAGE(PG8_SB(0, 0), cB, voffB); PG8_STAGE(PG8_SB(0, 1), cB + hstep, voffB); PG8_STAGE(PG8_SA(0, 0), cA, cv0); PG8_STAGE(PG8_SA(0, 1), cA, cv1);
    if (wr == 1) PG8_BAR;
    PG8_WAIT_V(2); PG8_BAR;
    PG8_STAGE(PG8_SB(1, 0), cB + kstep, voffB); PG8_STAGE(PG8_SA(1, 0), cA + kstep, cv0); PG8_STAGE(PG8_SB(1, 1), cB + hstep + kstep, voffB);
    PG8_WAIT_V(6); PG8_BAR;
    for (;;) {
        const bool has_next = S.next(ui + 1, nxt);
        const char* nA = has_next ? S.a_ptr(nxt) : cA; const char* nB = has_next ? S.b_ptr(nxt) : cB;
        if (has_next) S.a_voff(nxt, Rr, Cc, nv0, nv1); else { nv0[0] = cv0[0]; nv0[1] = cv0[1]; nv1[0] = cv1[0]; nv1[1] = cv1[1]; }
        if constexpr (Sched::DYN_A) asm volatile("" : "+v"(nv0[0]), "+v"(nv0[1]), "+v"(nv1[0]), "+v"(nv1[1]));
        for (int t = 0; t < nt; t += 2) {
            const bool last = (t == nt - 2);
            if (last && has_next) S.a_ready(nxt, wid);
            const char* a1 = cA + (size_t)(t + 1) * kstep;
            const char* a2 = last ? nA : cA + (size_t)(t + 2) * kstep; const char* b2 = last ? nB : cB + (size_t)(t + 2) * kstep;
            const char* a3 = a2 + kstep; const char* b3 = b2 + kstep;
            unsigned w0[2], w1[2];
            w0[0] = last ? nv0[0] : cv0[0]; w0[1] = last ? nv0[1] : cv0[1]; w1[0] = last ? nv1[0] : cv1[0]; w1[1] = last ? nv1[1] : cv1[1];
            PG8_LDB(B0, 0, 0); PG8_LDB(B1, 0, 1); PG8_SCHED; PG8_LDA(At, 0, 0); PG8_STAGE(PG8_SA(1, 1), a1, cv1);
            PG8_WAIT_V(8); PG8_WAIT_L(0); PG8_BAR; PG8_MMA(0, 0, At, B0); PG8_MMA(0, 1, At, B1); PG8_BAR; PG8_SCHED;
            PG8_LDA(At, 0, 1); PG8_STAGE(PG8_SB(0, 0), b2, voffB); PG8_STAGE(PG8_SB(0, 1), b2 + hstep, voffB); PG8_STAGE(PG8_SA(0, 0), a2, w0);
            PG8_WAIT_V(8); PG8_WAIT_L(0); PG8_BAR; PG8_MMA(1, 0, At, B0); PG8_MMA(1, 1, At, B1); PG8_BAR; PG8_SCHED;
            PG8_LDB(B0, 1, 0); PG8_LDB(B1, 1, 1); PG8_SCHED; PG8_LDA(At, 1, 0); PG8_STAGE(PG8_SA(0, 1), a2, w1);
            PG8_WAIT_V(8); PG8_WAIT_L(0); PG8_BAR; PG8_MMA(0, 0, At, B0); PG8_MMA(0, 1, At, B1); PG8_BAR; PG8_SCHED;
            PG8_LDA(At, 1, 1); PG8_STAGE(PG8_SB(1, 0), b3, voffB); PG8_STAGE(PG8_SB(1, 1), b3 + hstep, voffB); PG8_STAGE(PG8_SA(1, 0), a3, w0);
            PG8_WAIT_V(8); PG8_WAIT_L(0); PG8_BAR; PG8_MMA(1, 0, At, B0); PG8_MMA(1, 1, At, B1); PG8_BAR; PG8_SCHED;
        }
        if constexpr (F8) asm volatile("s_nop 15\n\ts_nop 15" ::: "memory");
        if (wr == 0) PG8_BAR;
        E(acc, cur, wr, wc, fr, fq);
        S.done(cur, lane);
        if (!has_next) break;
#pragma unroll
        for (int a = 0; a < 2; ++a)
#pragma unroll
            for (int b = 0; b < 2; ++b)
#pragma unroll
                for (int m = 0; m < 4; ++m)
#pragma unroll
                    for (int n = 0; n < 2; ++n) acc[a][b][m][n] = (f32x4){0.f, 0.f, 0.f, 0.f};
        cur = nxt; cA = nA; cB = nB; ++ui;
        cv0[0] = nv0[0]; cv0[1] = nv0[1]; cv1[0] = nv1[0]; cv1[1] = nv1[1];
        if (wr == 1) PG8_BAR;
    }
    PG8_WAIT_V(0);
    PG8_BAR;
#undef PG8_SA
#undef PG8_SB
#undef PG8_STAGE
#undef PG8_CAT
#undef PG8_LDA
#undef PG8_LDB
#undef PG8_MMA
#undef PG8_WAIT_V
#undef PG8_WAIT_L
#undef PG8_BAR
#undef PG8_SCHED
}
}

#define XB_TMO      128
#define XB_XCNT(j)  (256  + 64 * (j))
#define XB_XSUB(j)  (1280 + 64 * (j))
#define XB_XGEN(j)  (2304 + 64 * (j))
#define XB_TOP      3328
#define XB_TOPGEN   3392
#define XCD_BAR_WORDS 3456
#define XB_SPIN_CAP (1u << 18)
__device__ __forceinline__ unsigned xb_ld(unsigned* p)              { return __hip_atomic_load(p, __ATOMIC_RELAXED, __HIP_MEMORY_SCOPE_AGENT); }
__device__ __forceinline__ unsigned xb_add(unsigned* p, unsigned v) { return __hip_atomic_fetch_add(p, v, __ATOMIC_RELAXED, __HIP_MEMORY_SCOPE_AGENT); }
__device__ __forceinline__ unsigned xb_xcc_id() { return (unsigned)__builtin_amdgcn_s_getreg((3 << 11) | 20) & 0xFu; }
#define XB_SPIN(cond, bar) do { unsigned _sp = 0; while (cond) { __builtin_amdgcn_s_sleep(1); \
    if ((++_sp & 255u) == 0u) { if (xb_ld(&(bar)[XB_TMO])) break; if (_sp > XB_SPIN_CAP) { atomicAdd(&(bar)[XB_TMO], 1u); break; } } } } while (0)
struct XcdBarrier { unsigned* bar; unsigned x; volatile LAS unsigned* st; };
__device__ __forceinline__ XcdBarrier xcd_barrier_post(unsigned* bar, volatile LAS unsigned* st) {
    XcdBarrier b; b.bar = bar; b.x = xb_xcc_id(); b.st = st;
    if (threadIdx.x == 0) (void)xb_add(&bar[XB_XCNT(b.x)], 1u);
    return b;
}
__device__ __forceinline__ void xcd_barrier_complete(unsigned* bar, unsigned x, unsigned& nloc, unsigned& nx) {
    const unsigned G = gridDim.x * gridDim.y * gridDim.z;
    unsigned sum, cnt, mine, sp = 0u;
    for (;;) {
        sum = 0u; cnt = 0u; mine = 0u;
#pragma unroll
        for (unsigned j = 0; j < 16; ++j) { const unsigned c = xb_ld(&bar[XB_XCNT(j)]); sum += c; cnt += (c > 0u) ? 1u : 0u; mine = (j == x) ? c : mine; }
        if (sum == G) break;
        __builtin_amdgcn_s_sleep(1);
        if ((++sp & 255u) == 0u) { if (xb_ld(&bar[XB_TMO])) break; if (sp > XB_SPIN_CAP) { atomicAdd(&bar[XB_TMO], 1u); break; } }
    }
    nloc = mine > 0u ? mine : 1u; nx = cnt > 0u ? cnt : 1u;
}
__device__ __forceinline__ void xcd_barrier(const XcdBarrier& b, int tid) {
    asm volatile("s_waitcnt vmcnt(0)" ::: "memory");
    __syncthreads();
    if (tid == 0) {
        unsigned* bar = b.bar;
        __builtin_amdgcn_s_waitcnt(0);
        unsigned nloc = b.st[0], nx = b.st[1];
        if (nloc == 0u) { xcd_barrier_complete(bar, b.x, nloc, nx); b.st[0] = nloc; b.st[1] = nx; }
        const unsigned old = xb_add(&bar[XB_XSUB(b.x)], 1u);
        const unsigned gen = old / nloc;
        if (old + 1u == (gen + 1u) * nloc) {
            __builtin_amdgcn_fence(__ATOMIC_RELEASE, "agent");
            asm volatile("s_waitcnt vmcnt(0)" ::: "memory");
            const unsigned og = xb_add(&bar[XB_TOP], 1u);
            const unsigned tg = og / nx;
            if (og + 1u == (tg + 1u) * nx) xb_add(&bar[XB_TOPGEN], 1u);
            else XB_SPIN(xb_ld(&bar[XB_TOPGEN]) == tg, bar);
            __builtin_amdgcn_fence(__ATOMIC_ACQUIRE, "agent");
            xb_add(&bar[XB_XGEN(b.x)], 1u);
            asm volatile("s_waitcnt vmcnt(0)" ::: "memory");
        } else {
            XB_SPIN(xb_ld(&bar[XB_XGEN(b.x)]) == gen, bar);
            __builtin_amdgcn_fence(__ATOMIC_ACQUIRE, "agent");
            asm volatile("s_waitcnt vmcnt(0)" ::: "memory");
        }
    }
    __syncthreads();
}

constexpr int NWAVES = 8;
constexpr int RING_BYTES = 131072, LDSCTL_OFF = RING_BYTES, MISC_OFF = LDSCTL_OFF + 320, LDS_BYTES = 147456;
struct Args { const float* in[22]; float* out; unsigned char* ws; int ph_lo, ph_hi, li, pad; };
enum { I_X = 0, I_C, I_CTX, I_CCTX, I_WADA, I_BADA, I_NORM1, I_NORM2, I_WIN, I_UPF, I_BIASF, I_UPB, I_BIASB, I_GLANORM, I_SINK, I_WOUT, I_WROUTER, I_BROUTER, I_WGATE, I_WUP, I_WDOWN, I_FNORM };

struct Frame {
    LAS unsigned char* lds; int tid, lane, wave, vcu, G, gw, NGW;
    unsigned char* ws; float* out;
};

__device__ __forceinline__ int rope_pos(int d) { return 8 * ((d & 15) >> 2) + 4 * (d >> 4) + (d & 3); }
__device__ __forceinline__ int gu_row(int h, int gu) { return (h >> 7) * 256 + ((h >> 6) & 1) * 128 + ((h >> 4) & 3) * 32 + ((h >> 2) & 3) * 8 + gu * 4 + (h & 3); }
struct TItem { const float* src; bf16* dst; int N, Kd, n0, rbase, mode; bool ok; float f8scale; };
__device__ __forceinline__ void titem_load(const TItem& t, int lane, f32x4 (&v)[8]) {
    const int g = lane >> 3, i8 = lane & 7;
    const float* src = t.src + (size_t)(8 * g) * t.N + 4 * i8;
#pragma unroll
    for (int q = 0; q < 8; ++q) v[q] = *(const f32x4*)(src + (size_t)q * t.N);
}
__device__ __forceinline__ void titem_store(const TItem& t, int lane, const f32x4 (&v)[8]) {
    const int g = lane >> 3, i8 = lane & 7;
#pragma unroll
    for (int i = 0; i < 4; ++i) {
        const int n = 4 * i8 + i;
        const int row = (t.mode == 0) ? t.rbase + n : (t.mode == 1) ? t.rbase + rope_pos(n) : gu_row(t.n0 + n, t.mode - 2);
        if (t.f8scale != 0.f) {
            const float sc = t.f8scale; u32x2 o; o.x = pk4_fp8(v[0][i] * sc, v[1][i] * sc, v[2][i] * sc, v[3][i] * sc); o.y = pk4_fp8(v[4][i] * sc, v[5][i] * sc, v[6][i] * sc, v[7][i] * sc);
            *(u32x2*)((unsigned char*)t.dst + (size_t)row * t.Kd + 8 * g) = o;
        } else {
            u32x4 o; o.x = pk2(v[0][i], v[1][i]); o.y = pk2(v[2][i], v[3][i]); o.z = pk2(v[4][i], v[5][i]); o.w = pk2(v[6][i], v[7][i]);
            *(u32x4*)(t.dst + (size_t)row * t.Kd + 8 * g) = o;
        }
    }
}
constexpr int IT_IN = 2 * 16 * 73, IT_OUT = 2 * 16 * 32, IT_G = 32 * 16 * 16, IT_D = 32 * 8 * 32, NITEMS = IT_IN + IT_OUT + 2 * IT_G + IT_D;
__device__ __forceinline__ TItem titem_decode(const CAS Args* a, unsigned char* ws, int it) {
    TItem t; t.ok = it < NITEMS; t.mode = 0; t.rbase = 0; t.n0 = 0; t.N = D; t.Kd = D; t.src = nullptr; t.dst = nullptr; t.f8scale = 0.f;
    if (!t.ok) return t;
    int r = it;
    if (r < IT_IN) {
        const int l = r / 1168, rr = r % 1168, kb = rr / 73, nb = rr % 73;
        if (nb == 48) { t.ok = false; return t; }
        const int n0 = nb * 32; t.n0 = n0;
        if (n0 < 1536) t.rbase = n0;
        else if (n0 < 2080) { t.rbase = PC_SQ + (n0 - 1568); t.mode = 1; }
        else if (n0 < 2208) { t.rbase = PC_SK + (n0 - 2080); t.mode = 1; }
        else t.rbase = PC_SV + (n0 - 2208);
        t.N = WIN_COLS; t.Kd = D; t.src = a->in[I_WIN] + (size_t)l * D * WIN_COLS + (size_t)(kb * 64) * WIN_COLS + n0; t.dst = (bf16*)(ws + WS_WIN) + (size_t)l * NIN * D + kb * 64;
        return t;
    }
    r -= IT_IN;
    if (r < IT_OUT) { const int l = r / 512, rr = r % 512, kb = rr / 32, nb = rr % 32;
        t.n0 = nb * 32; t.rbase = nb * 32; t.N = D; t.Kd = D; t.src = a->in[I_WOUT] + (size_t)l * D * D + (size_t)(kb * 64) * D + nb * 32; t.dst = (bf16*)(ws + WS_WOUT) + (size_t)l * D * D + kb * 64; return t; }
    r -= IT_OUT;
    if (r < 2 * IT_G) { const int gu = r / IT_G, r2 = r % IT_G, le = r2 / 256, rr = r2 % 256, kb = rr / 16, nb = rr % 16;
        t.n0 = nb * 32; t.mode = 2 + gu; t.N = DE; t.Kd = D; t.src = a->in[gu ? I_WUP : I_WGATE] + (size_t)le * D * DE + (size_t)(kb * 64) * DE + nb * 32; t.dst = (bf16*)(ws + WS_WGU + (size_t)le * D * D + kb * 64); t.f8scale = W1_SCALE; return t; }
    r -= 2 * IT_G;
    { const int le = r / 256, rr = r % 256, kb = rr / 32, nb = rr % 32;
        t.n0 = nb * 32; t.rbase = nb * 32; t.N = D; t.Kd = DE; t.src = a->in[I_WDOWN] + (size_t)le * DE * D + (size_t)(kb * 64) * D + nb * 32; t.dst = (bf16*)(ws + WS_WD + (size_t)le * D * DE + kb * 64); t.f8scale = W2_SCALE; }
    return t;
}

template <class Map>
__device__ __forceinline__ void convert_items(const Frame& F, const CAS Args* a, int n, int worker, int nworkers, Map map) {
    unsigned char* ws = F.ws;
    for (int i = worker; i < n; i += 2 * nworkers) {
        const int i2 = i + nworkers;
        const TItem ta = titem_decode(a, ws, map(i)), tb = titem_decode(a, ws, i2 < n ? map(i2) : NITEMS);
        f32x4 va[8], vb[8];
        if (ta.ok) titem_load(ta, F.lane, va);
        if (tb.ok) titem_load(tb, F.lane, vb);
        if (ta.ok) titem_store(ta, F.lane, va);
        if (tb.ok) titem_store(tb, F.lane, vb);
    }
}
struct MapSmall { __device__ __forceinline__ int operator()(int i) const { return i; } };
struct MapMoe { int l; __device__ __forceinline__ int operator()(int i) const { const int kind = i >> 12, r = i & 4095; return IT_IN + IT_OUT + (kind < 2 ? kind * IT_G : 2 * IT_G) + l * 4096 + r; } };
__device__ __forceinline__ void convert_moe_filler(const Frame& F, const CAS Args* a, int l, int nunits, bool both = false) {
    const int c = (int)blockIdx.x, nfull = nunits % F.G;
    int first = nfull, nf = F.G - nfull - (both ? nfull : 0);
    if (nfull == 0 || nf <= 0) { first = 0; nf = F.G; }
    if (c < first || c >= first + nf) return;
    convert_items(F, a, 3 * 4096, (c - first) * NWAVES + F.wave, nf * NWAVES, MapMoe{l});
}

__device__ __forceinline__ void p0_prologue(const Frame& F, const CAS Args* a) {
    unsigned char* ws = F.ws;
    convert_items(F, a, IT_IN + IT_OUT, F.gw, F.NGW, MapSmall{});
    for (int idx = F.gw * 64 + F.lane; idx < 2 * 2 * 256 * 128; idx += F.NGW * 64) {
        const int kc = idx & 127, n = (idx >> 7) & 255, dir = (idx >> 15) & 1, l = idx >> 16;
        const float* up = a->in[dir ? I_UPB : I_UPF] + (size_t)l * 16 * 256 + n;
        float u[16];
#pragma unroll
        for (int r = 0; r < 16; ++r) u[r] = up[r * 256];
        float o[8];
#pragma unroll
        for (int kk = 0; kk < 8; ++kk) {
            const f32x4* wz = (const f32x4*)(a->in[I_WIN] + ((size_t)l * D + kc * 8 + kk) * WIN_COLS + 1536 + dir * 16);
            float s = 0.f;
#pragma unroll
            for (int q = 0; q < 4; ++q) { const f32x4 w = wz[q]; s += w[0] * u[4 * q] + w[1] * u[4 * q + 1] + w[2] * u[4 * q + 2] + w[3] * u[4 * q + 3]; }
            o[kk] = s;
        }
        u32x4 ov; ov.x = pk2(o[0], o[1]); ov.y = pk2(o[2], o[3]); ov.z = pk2(o[4], o[5]); ov.w = pk2(o[6], o[7]);
        *(u32x4*)((bf16*)(ws + WS_WIN) + ((size_t)l * NIN + PC_GF + dir * 256 + n) * D + kc * 8) = ov;
    }
    if (blockIdx.x == (unsigned)(F.G - 1)) {
        float* tc = (float*)(ws + WS_ROPE); float* tsn = tc + 2048;
        for (int i = F.tid; i < 2048; i += NWAVES * 64) { const int pos = i >> 4, j = i & 15; const float inv = powf(10000.0f, -(float)j * (1.0f / 16.0f)); const float ang = (float)pos * inv;
            tc[i] = cosf(ang); tsn[i] = sinf(ang); }
    }
    __syncthreads();
    {
        LAS float* cs = (LAS float*)F.lds; LAS float* red = cs + 3072;
        for (int i = F.tid; i < 3072; i += NWAVES * 64) { const int v = i >> 10, k = i & 1023; const float cv = v < 2 ? a->in[I_C][v * D + k] : a->in[I_CCTX][k]; cs[i] = cv / (1.0f + expf(-cv)); }
        __syncthreads();
        for (int u = blockIdx.x; u < 192; u += F.G) {
            const int l = u / 96, jg = u % 96, jl = F.tid & 63, ks = F.tid >> 6;
            const float* wp = a->in[I_WADA] + ((size_t)l * D + ks * 128) * 6144 + jg * 64 + jl;
            float a0 = 0.f, a1 = 0.f, a2 = 0.f;
#pragma unroll 1
            for (int k0 = 0; k0 < 128; k0 += 32) {
                float wv[32];
#pragma unroll
                for (int k = 0; k < 32; ++k) wv[k] = wp[(size_t)(k0 + k) * 6144];
#pragma unroll
                for (int k = 0; k < 32; ++k) { const int kk = ks * 128 + k0 + k; a0 += cs[kk] * wv[k]; a1 += cs[1024 + kk] * wv[k]; a2 += cs[2048 + kk] * wv[k]; }
            }
            red[(ks * 3 + 0) * 64 + jl] = a0; red[(ks * 3 + 1) * 64 + jl] = a1; red[(ks * 3 + 2) * 64 + jl] = a2;
            __syncthreads();
            if (F.tid < 192) { const int v = F.tid >> 6, j2 = F.tid & 63; float s = 0.f;
#pragma unroll
                for (int q = 0; q < 8; ++q) s += red[(q * 3 + v) * 64 + j2];
                ((float*)(ws + WS_MOD))[(l * 3 + v) * 6144 + jg * 64 + j2] = s + a->in[I_BADA][l * 6144 + jg * 64 + j2]; }
            __syncthreads();
        }
    }
}

__device__ __forceinline__ f32x4 ld_y4(const bf16* p) { const u32x2 w = *(const u32x2*)p; return (f32x4){bflo(w.x), bfhi(w.x), bflo(w.y), bfhi(w.y)}; }
__device__ __forceinline__ void n1_load(const Frame& F, const CAS Args* a, int l, int m, f32x4 (&x)[4], f32x4 (&y)[4]) {
    unsigned char* ws = F.ws;
    const bf16* Y0 = (const bf16*)(ws + WS_Y); const bf16* Y1 = Y0 + (size_t)TT * D;
    const float* src = (l == 0) ? (m < TL ? a->in[I_X] + (size_t)m * D : a->in[I_CTX] + (size_t)(m - TL) * D) : (m < TL ? F.out + (size_t)m * D : (const float*)(ws + WS_XC) + (size_t)(m - TL) * D);
#pragma unroll
    for (int j = 0; j < 4; ++j) { const int col = 4 * F.lane + 256 * j; x[j] = *(const f32x4*)(src + col);
        if (l > 0) y[j] = ld_y4(Y0 + (size_t)m * D + col) + ld_y4(Y1 + (size_t)m * D + col); }
}
__device__ __forceinline__ void n1_row(const Frame& F, const CAS Args* a, int l, int m, f32x4 (&x)[4], const f32x4 (&y)[4]) {
    unsigned char* ws = F.ws;
    const float* mod = (const float*)(ws + WS_MOD);
    bf16* H = (bf16*)(ws + WS_H);
    const int v = m < TL ? (m >> 13) : 2;
    float* xrow = m < TL ? F.out + (size_t)m * D : (float*)(ws + WS_XC) + (size_t)(m - TL) * D;
    float ss = 0.f;
#pragma unroll
    for (int j = 0; j < 4; ++j) {
        const int col = 4 * F.lane + 256 * j;
        if (l > 0) { const f32x4 g2 = *(const f32x4*)(mod + ((l - 1) * 3 + v) * 6144 + 5 * D + col); x[j] = x[j] + g2 * y[j]; *(f32x4*)(xrow + col) = x[j]; }
        ss += (x[j][0] * x[j][0] + x[j][1] * x[j][1]) + (x[j][2] * x[j][2] + x[j][3] * x[j][3]);
    }
    const float rstd = 1.0f / sqrtf(wave_sum(ss) * (1.0f / D) + EPS);
#pragma unroll
    for (int j = 0; j < 4; ++j) {
        const int col = 4 * F.lane + 256 * j;
        const f32x4 nw = *(const f32x4*)(a->in[I_NORM1] + l * D + col);
        const f32x4 sh = *(const f32x4*)(mod + (l * 3 + v) * 6144 + 0 * D + col);
        const f32x4 sc = *(const f32x4*)(mod + (l * 3 + v) * 6144 + 1 * D + col);
        const f32x4 h = x[j] * rstd * nw * (1.0f + sc) + sh;
        u32x2 o; o.x = pk2(h[0], h[1]); o.y = pk2(h[2], h[3]);
        *(u32x2*)(H + (size_t)m * D + col) = o;
    }
}
__device__ __forceinline__ void n1_phase(const Frame& F, const CAS Args* a, int l) {
    for (int m = F.gw; m < TT; m += 2 * F.NGW) {
        const int m2 = m + F.NGW; const bool two = m2 < TT;
        f32x4 xa[4], ya[4], xb[4], yb[4];
        n1_load(F, a, l, m, xa, ya);
        if (two) n1_load(F, a, l, m2, xb, yb);
        n1_row(F, a, l, m, xa, ya);
        if (two) n1_row(F, a, l, m2, xb, yb);
    }
}

struct EpiIn {
    static constexpr bool PERM = true;
    bf16* P; const float* bias_f; const float* bias_b; const float* tcos; const float* tsin;
    __device__ __forceinline__ void operator()(const f32x4 (&acc)[2][2][4][2], const pg8::Unit& u, int wr, int wc, int fr, int fq) const {
        const int row0 = u.pm * 256 + wr * 64 + fr, colw = wc * 32 + 8 * fq;
        const int pn = u.pn;
        const bool latent = u.pm < 64;
        const bool rope = latent && (pn == 6 || pn == 7 || pn == 8);
        f32x4 cs[4], sn[4], b0[2], b1[2];
        if (pn >= 9) {
#pragma unroll
            for (int bj = 0; bj < 2; ++bj) { const float* bp = (pn == 9 ? bias_f : bias_b) + colw + bj * 128; b0[bj] = *(const f32x4*)bp; b1[bj] = *(const f32x4*)(bp + 4); }
        }
#pragma unroll
        for (int ai = 0; ai < 2; ++ai) {
            if (rope) {
#pragma unroll
                for (int m = 0; m < 4; ++m) { const int t = (row0 + ai * 128 + m * 16) & (SEQ - 1); const int pos = (wc & 1) ? (t & 63) : (t >> 6);
                    cs[m] = *(const f32x4*)(tcos + pos * 16 + 4 * fq); sn[m] = *(const f32x4*)(tsin + pos * 16 + 4 * fq); }
            }
#pragma unroll
            for (int m = 0; m < 4; ++m) {
                const int row = row0 + ai * 128 + m * 16;
                bf16* rowp = P + (size_t)row * NIN + pn * 256 + colw;
#pragma unroll
                for (int bj = 0; bj < 2; ++bj) {
                    f32x4 v0 = acc[ai][bj][m][0], v1 = acc[ai][bj][m][1];
                    if (pn == 0) { v0 = v0 * 0.125f; v1 = v1 * 0.125f; }
                    else if (pn >= 9) {
#pragma unroll
                        for (int i = 0; i < 4; ++i) { float x0 = v0[i] + b0[bj][i], x1 = v1[i] + b1[bj][i];
                            v0[i] = (fminf(x0, 0.f) - __logf(1.0f + __expf(-fabsf(x0)))) * 0.0625f; v1[i] = (fminf(x1, 0.f) - __logf(1.0f + __expf(-fabsf(x1)))) * 0.0625f; }
                    } else if (rope && (pn != 8 || bj == 0)) {
                        const f32x4 o0 = v0 * cs[m] - v1 * sn[m], o1 = v1 * cs[m] + v0 * sn[m]; v0 = o0; v1 = o1;
                    }
                    if (pn == 6 || pn == 7) { v0 = v0 * QSCALE; v1 = v1 * QSCALE; }
                    u32x4 w; w.x = pg8::cvt_pk_bf16(v0[0], v0[1]); w.y = pg8::cvt_pk_bf16(v0[2], v0[3]); w.z = pg8::cvt_pk_bf16(v1[0], v1[1]); w.w = pg8::cvt_pk_bf16(v1[2], v1[3]);
                    *(u32x4*)(rowp + bj * 128) = w;
                }
            }
            asm volatile("" ::: "memory");
        }
    }
};
struct EpiOut {
    static constexpr bool PERM = false;
    const float* resL; const float* resC; float* outL; float* outC; const float* mod_l;
    __device__ __forceinline__ void operator()(const f32x4 (&acc)[2][2][4][2], const pg8::Unit& u, int wr, int wc, int fr, int fq) const {
        const bool latent = u.pm < 64;
        const int v = latent ? (u.pm >> 5) : 2;
        const int rowb = (latent ? u.pm * 256 : u.pm * 256 - TL) + wr * 64 + fr;
        const float* res = latent ? resL : resC; float* out = latent ? outL : outC;
        const int col0 = u.pn * 256 + wc * 32 + 4 * fq;
        const float* g1p = mod_l + v * 6144 + 2 * D + col0;
        f32x4 g1[2][2];
#pragma unroll
        for (int bj = 0; bj < 2; ++bj)
#pragma unroll
            for (int n = 0; n < 2; ++n) g1[bj][n] = *(const f32x4*)(g1p + bj * 128 + n * 16);
#pragma unroll
        for (int ai = 0; ai < 2; ++ai)
#pragma unroll
            for (int mp = 0; mp < 4; mp += 2) {
                f32x4 r[2][2][2];
#pragma unroll
                for (int m = 0; m < 2; ++m) { const size_t off = (size_t)(rowb + ai * 128 + (mp + m) * 16) * D + col0;
#pragma unroll
                    for (int bj = 0; bj < 2; ++bj)
#pragma unroll
                        for (int n = 0; n < 2; ++n) r[m][bj][n] = *(const f32x4*)(res + off + bj * 128 + n * 16); }
#pragma unroll
                for (int m = 0; m < 2; ++m) { const size_t off = (size_t)(rowb + ai * 128 + (mp + m) * 16) * D + col0;
#pragma unroll
                    for (int bj = 0; bj < 2; ++bj)
#pragma unroll
                        for (int n = 0; n < 2; ++n) *(f32x4*)(out + off + bj * 128 + n * 16) = r[m][bj][n] + g1[bj][n] * acc[ai][bj][mp + m][n]; }
                asm volatile("" ::: "memory");
            }
    }
};
struct EpiGU {
    static constexpr bool PERM = true;
    bf16* Hmid;
    __device__ __forceinline__ void operator()(const f32x4 (&acc)[2][2][4][2], const pg8::Unit& u, int wr, int wc, int fr, int fq) const {
        const int row0 = u.pm * 256 + wr * 64 + fr, hid0 = u.pn * 128 + wc * 16 + fq * 4;
#pragma unroll
        for (int ai = 0; ai < 2; ++ai)
#pragma unroll
            for (int m = 0; m < 4; ++m) {
                unsigned char* rowp = (unsigned char*)Hmid + (size_t)(row0 + ai * 128 + m * 16) * DE + hid0;
#pragma unroll
                for (int bj = 0; bj < 2; ++bj) {
                    const f32x4 g = acc[ai][bj][m][0], up = acc[ai][bj][m][1]; f32x4 o;
#pragma unroll
                    for (int i = 0; i < 4; ++i) o[i] = g[i] * __builtin_amdgcn_rcpf(1.0f + __expf(-g[i])) * up[i];
                    __hip_atomic_store((unsigned*)(rowp + bj * 64), pk4_fp8(o[0] * HMID_SCALE, o[1] * HMID_SCALE, o[2] * HMID_SCALE, o[3] * HMID_SCALE), __ATOMIC_RELAXED, __HIP_MEMORY_SCOPE_AGENT);
                }
            }
    }
};
struct EpiDown {
    static constexpr bool PERM = true;
    bf16* Y; const unsigned* list; const float* listw; const LAS int* tab;
    __device__ __forceinline__ void operator()(const f32x4 (&acc)[2][2][4][2], const pg8::Unit& u, int wr, int wc, int fr, int fq) const {
        const int ce = tab[u.e];
        const int r0 = u.mt * 256 + wr * 64 + fr, col0 = u.pn * 256 + wc * 32 + 8 * fq;
        const unsigned* lp = list + (size_t)u.e * LISTCAP; const float* lw = listw + (size_t)u.e * LISTCAP;
        unsigned tsv[2][4]; float wv[2][4];
#pragma unroll
        for (int ai = 0; ai < 2; ++ai)
#pragma unroll
            for (int m = 0; m < 4; ++m) { const int r = r0 + ai * 128 + m * 16; const bool ok = r < ce; tsv[ai][m] = ok ? __builtin_nontemporal_load(lp + r) : 0xffffffffu; wv[ai][m] = ok ? __builtin_nontemporal_load(lw + r) : 0.f; }
#pragma unroll
        for (int ai = 0; ai < 2; ++ai)
#pragma unroll
            for (int m = 0; m < 4; ++m) {
                const unsigned ts = tsv[ai][m]; const float w = wv[ai][m];
                if (ts != 0xffffffffu) {
                    bf16* rowp = Y + ((size_t)(ts & 1u) * TT + (ts >> 1)) * D + col0;
#pragma unroll
                    for (int bj = 0; bj < 2; ++bj) {
                        const f32x4 v0 = acc[ai][bj][m][0] * w, v1 = acc[ai][bj][m][1] * w;
                        u32x4 o; o.x = pg8::cvt_pk_bf16(v0[0], v0[1]); o.y = pg8::cvt_pk_bf16(v0[2], v0[3]); o.z = pg8::cvt_pk_bf16(v1[0], v1[1]); o.w = pg8::cvt_pk_bf16(v1[2], v1[3]);
                        *(u32x4*)(rowp + bj * 128) = o;
                    }
                }
            }
    }
};

__device__ __forceinline__ void swa_naive(const Frame& F, const CAS Args* a, int l) {
    const bf16* P = (const bf16*)(F.ws + WS_P); bf16* MIX = (bf16*)(F.ws + WS_MIX);
    const int total = (l == 0 ? TT : TL) * 8;
    for (int idx = F.gw * 64 + F.lane; idx < total; idx += F.NGW * 64) {
        const int m = idx >> 3, hq = idx & 7, kvh = hq >> 2;
        const bool latent = m < TL;
        const int b = latent ? (m >> 13) : ((m - TL) >> 8), t = m & (SEQ - 1);
        float q[64];
        { const u32x4* qp = (const u32x4*)(P + (size_t)m * NIN + PC_SQ + hq * 64);
#pragma unroll
          for (int c = 0; c < 8; ++c) { const u32x4 w = qp[c]; q[8 * c] = bflo(w.x); q[8 * c + 1] = bfhi(w.x); q[8 * c + 2] = bflo(w.y); q[8 * c + 3] = bfhi(w.y);
              q[8 * c + 4] = bflo(w.z); q[8 * c + 5] = bfhi(w.z); q[8 * c + 6] = bflo(w.w); q[8 * c + 7] = bfhi(w.w); } }
        float o[64];
#pragma unroll
        for (int d = 0; d < 64; ++d) o[d] = 0.f;
        const float sink = a->in[I_SINK][l * 8 + hq] * LOG2E;
        float mx = sink, den = 1.0f;
        const int lo = latent ? (t - 128 < 0 ? 0 : t - 128) : 0, hi = latent ? (t + 128 > SEQ - 1 ? SEQ - 1 : t + 128) : -1;
        const int nloc = hi - lo + 1;
        for (int kk = 0; kk < nloc + LC; ++kk) {
            const int krow = kk < nloc ? b * SEQ + lo + kk : TL + b * LC + (kk - nloc);
            const u32x4* kp = (const u32x4*)(P + (size_t)krow * NIN + PC_SK + kvh * 64);
            float s = 0.f;
#pragma unroll
            for (int c = 0; c < 8; ++c) { const u32x4 w = kp[c]; s += q[8 * c] * bflo(w.x) + q[8 * c + 1] * bfhi(w.x) + q[8 * c + 2] * bflo(w.y) + q[8 * c + 3] * bfhi(w.y)
                + q[8 * c + 4] * bflo(w.z) + q[8 * c + 5] * bfhi(w.z) + q[8 * c + 6] * bflo(w.w) + q[8 * c + 7] * bfhi(w.w); }
            const float mn = fmaxf(mx, s), f = exp2f(mx - mn), p = exp2f(s - mn);
            den = den * f + p; mx = mn;
            const u32x4* vp = (const u32x4*)(P + (size_t)krow * NIN + PC_SV + kvh * 64);
#pragma unroll
            for (int c = 0; c < 8; ++c) { const u32x4 w = vp[c];
                o[8 * c] = o[8 * c] * f + p * bflo(w.x); o[8 * c + 1] = o[8 * c + 1] * f + p * bfhi(w.x); o[8 * c + 2] = o[8 * c + 2] * f + p * bflo(w.y); o[8 * c + 3] = o[8 * c + 3] * f + p * bfhi(w.y);
                o[8 * c + 4] = o[8 * c + 4] * f + p * bflo(w.z); o[8 * c + 5] = o[8 * c + 5] * f + p * bfhi(w.z); o[8 * c + 6] = o[8 * c + 6] * f + p * bflo(w.w); o[8 * c + 7] = o[8 * c + 7] * f + p * bfhi(w.w); }
        }
        const float inv = 1.0f / den;
        u32x4* op = (u32x4*)(MIX + (size_t)m * D + 512 + hq * 64);
#pragma unroll
        for (int c = 0; c < 8; ++c) { u32x4 w; w.x = pk2(o[8 * c] * inv, o[8 * c + 1] * inv); w.y = pk2(o[8 * c + 2] * inv, o[8 * c + 3] * inv); w.z = pk2(o[8 * c + 4] * inv, o[8 * c + 5] * inv); w.w = pk2(o[8 * c + 6] * inv, o[8 * c + 7] * inv); op[c] = w; }
    }
}


typedef float f32x16 __attribute__((ext_vector_type(16)));
typedef short s16x4 __attribute__((ext_vector_type(4)));
__device__ __forceinline__ int crow(int r, int hi) { return (r & 3) + 8 * (r >> 2) + 4 * hi; }
__device__ __forceinline__ s16x4 vtr(const LAS unsigned char* p) { return __builtin_bit_cast(s16x4, __builtin_amdgcn_ds_read_tr16_b64_v4i16((LAS s16x4*)p)); }
constexpr int SWA_K = 0, SWA_V = 49152;
__device__ __forceinline__ void swa_kload(const LAS unsigned char* Kt, int kb, int lane, bf16x8 (&kf)[4]) {
    const int r32 = lane & 31, hi = lane >> 5;
#pragma unroll
    for (int d0 = 0; d0 < 4; ++d0) kf[d0] = *(const LAS bf16x8*)(Kt + (2 * d0 + hi) * 1024 + (32 * kb + r32) * 16);
}
__device__ __forceinline__ void swa_tile(const LAS unsigned char* Kt, const LAS unsigned char* Vt, const LAS unsigned char* Kn, int mtype, const bf16x8 (&qf)[2][4], bf16x8 (&kf)[4], f32x16 (&o)[2][2], float (&mrun)[2], float (&lrun)[2], int lane, int abl = 0) {
    const int r32 = lane & 31, hi = lane >> 5;
    const LAS unsigned char* vp = Vt + ((lane >> 4) & 1) * 32 + (lane & 3) * 8 + (4 * hi + ((lane & 15) >> 2)) * 64;
#pragma unroll
    for (int kb = 0; kb < 2; ++kb) {
        f32x16 s[2];
        swa_kload(Kt, kb, lane, kf);
#pragma unroll
        for (int d0 = 0; d0 < 4; ++d0)
#pragma unroll
            for (int qt = 0; qt < 2; ++qt) {
                if (d0 == 0) { f32x16 z;
#pragma unroll
                    for (int r = 0; r < 16; ++r) z[r] = 0.f;
                    s[qt] = __builtin_amdgcn_mfma_f32_32x32x16_bf16(kf[0], qf[qt][0], z, 0, 0, 0); }
                else if (abl != 4) s[qt] = __builtin_amdgcn_mfma_f32_32x32x16_bf16(kf[d0], qf[qt][d0], s[qt], 0, 0, 0);
            }
        __builtin_amdgcn_sched_barrier(0);
        s16x4 vlo[2][2], vhi[2][2];
#pragma unroll
        for (int dt = 0; dt < 2; ++dt)
#pragma unroll
            for (int sp = 0; sp < 2; ++sp) { vlo[dt][sp] = vtr(vp + dt * 4096 + (2 * kb + sp) * 1024); vhi[dt][sp] = vtr(vp + dt * 4096 + (2 * kb + sp) * 1024 + 512); }
        __builtin_amdgcn_sched_barrier(0);
        bf16x8 pf[2][2];
#pragma unroll
        for (int qt = 0; qt < 2; ++qt) {
            if (mtype != 0) {
                int thr = r32 + 32 * qt - 4 * hi - 32 * kb; asm volatile("" : "+v"(thr));
                if (mtype == 1) {
#pragma unroll
                    for (int r = 0; r < 16; ++r) { const int cc = (r & 3) + 8 * (r >> 2); if (cc < thr) s[qt][r] = -INFINITY; }
                } else {
#pragma unroll
                    for (int r = 0; r < 16; ++r) { const int cc = (r & 3) + 8 * (r >> 2); if (cc > thr) s[qt][r] = -INFINITY; }
                }
            }
            float rm = s[qt][0];
            if (abl != 1) {
#pragma unroll
            for (int r = 1; r < 16; ++r) rm = fmaxf(rm, s[qt][r]);
            }
            { auto rr = __builtin_amdgcn_permlane32_swap(__float_as_uint(rm), __float_as_uint(rm), false, false); rm = fmaxf(__uint_as_float(rr[0]), __uint_as_float(rr[1])); }
            const float mn = fmaxf(mrun[qt], rm);
            if (__any(mn > mrun[qt])) {
                const float alpha = __builtin_amdgcn_exp2f(mrun[qt] - mn);
                lrun[qt] *= alpha;
#pragma unroll
                for (int dt = 0; dt < 2; ++dt)
#pragma unroll
                    for (int r = 0; r < 16; ++r) o[dt][qt][r] *= alpha;
                mrun[qt] = mn;
            }
            float rs = 0.f;
            if (abl != 1) {
#pragma unroll
            for (int r = 0; r < 16; ++r) { const float p = __builtin_amdgcn_exp2f(s[qt][r] - mn); s[qt][r] = p; rs += p; }
            }
            lrun[qt] += rs;
#pragma unroll
            for (int sp = 0; sp < 2; ++sp) {
                u32x4 w; w.x = pg8::cvt_pk_bf16(s[qt][8 * sp + 0], s[qt][8 * sp + 1]); w.y = pg8::cvt_pk_bf16(s[qt][8 * sp + 2], s[qt][8 * sp + 3]);
                w.z = pg8::cvt_pk_bf16(s[qt][8 * sp + 4], s[qt][8 * sp + 5]); w.w = pg8::cvt_pk_bf16(s[qt][8 * sp + 6], s[qt][8 * sp + 7]);
                pf[qt][sp] = __builtin_bit_cast(bf16x8, w);
            }
        }
#pragma unroll
        for (int dt = 0; dt < 2; ++dt)
#pragma unroll
            for (int sp = 0; sp < 2; ++sp) {
                const bf16x8 vf = (bf16x8){vlo[dt][sp][0], vlo[dt][sp][1], vlo[dt][sp][2], vlo[dt][sp][3], vhi[dt][sp][0], vhi[dt][sp][1], vhi[dt][sp][2], vhi[dt][sp][3]};
#pragma unroll
                for (int qt = 0; qt < 2; ++qt) if (abl != 2) o[dt][qt] = __builtin_amdgcn_mfma_f32_32x32x16_bf16(vf, pf[qt][sp], o[dt][qt], 0, 0, 0);
            }
    }
}
__device__ __forceinline__ void swa_stage(const Frame& F, const bf16* P, int grow, int kvh, int ti) {
    { const int key = 8 * F.wave + (F.lane & 7), ch = F.lane >> 3;
      const u32x4 v = *(const u32x4*)(P + (size_t)(grow + key) * NIN + PC_SK + kvh * 64 + ch * 8);
      *(LAS u32x4*)(F.lds + SWA_K + ti * 8192 + ch * 1024 + key * 16) = v; }
    { const int key = 8 * F.wave + (F.lane >> 3), ch = F.lane & 7;
      const u32x4 v = *(const u32x4*)(P + (size_t)(grow + key) * NIN + PC_SV + kvh * 64 + ch * 8);
      *(LAS u32x4*)(F.lds + SWA_V + ti * 8192 + (ch >> 2) * 4096 + key * 64 + (ch & 3) * 16) = v; }
}
__device__ __forceinline__ void swa_flash(const Frame& F, const CAS Args* a, int l, int abl = 0) {
    const bf16* P = (const bf16*)(F.ws + WS_P); bf16* MIX = (bf16*)(F.ws + WS_MIX);
    const int nunits = 256 + (l == 0 ? 8 : 0);
    const int lane = F.lane, r32 = lane & 31, hi = lane >> 5;
    for (int u = F.vcu; u < nunits; u += F.G) {
        const bool latent = u < 256;
        const int b = latent ? (u >> 7) : ((u - 256) >> 2), kvh = latent ? ((u >> 6) & 1) : (((u - 256) >> 1) & 1), qb = latent ? (u & 63) : ((u - 256) & 1);
        const int q0 = qb * 128, g = F.wave >> 1, qs = F.wave & 1, hq = kvh * 4 + g;
        const int mrow0 = (latent ? b * SEQ : TL + b * LC) + q0 + 64 * qs;
        bf16x8 qf[2][4];
#pragma unroll
        for (int qt = 0; qt < 2; ++qt)
#pragma unroll
            for (int d0 = 0; d0 < 4; ++d0) { if (abl != 7) qf[qt][d0] = *(const bf16x8*)(P + (size_t)(mrow0 + 32 * qt + r32) * NIN + PC_SQ + hq * 64 + 16 * d0 + 8 * hi); else qf[qt][d0] = (bf16x8){(short)lane, 1, 2, 3, 4, 5, 6, 7}; }
        f32x16 o[2][2];
#pragma unroll
        for (int dt = 0; dt < 2; ++dt)
#pragma unroll
            for (int qt = 0; qt < 2; ++qt)
#pragma unroll
                for (int r = 0; r < 16; ++r) o[dt][qt][r] = 0.f;
        const float sink2 = a->in[I_SINK][l * 8 + hq] * LOG2E;
        float mrun[2] = {sink2, sink2}, lrun[2] = {hi == 0 ? 1.f : 0.f, hi == 0 ? 1.f : 0.f};
        if (latent) {
#pragma unroll 1
            for (int j = 0; j < 6; ++j) { const int ks = q0 - 128 + 64 * j; if (ks >= 0 && ks < SEQ && abl != 3) swa_stage(F, P, b * SEQ + ks, kvh, j); }
            __syncthreads();
            { int jf = qs; while (q0 - 128 + 64 * jf < 0) ++jf;
              bf16x8 kf[4]; swa_kload(F.lds + SWA_K + jf * 8192, 0, lane, kf);
#pragma unroll 1
              for (int tt = 0; tt < 5; ++tt) { const int j = qs + tt, ks = q0 - 128 + 64 * j;
                  if (ks >= 0 && ks < SEQ && abl != 8) { const int jn = (j + 1 < 6) ? j + 1 : j;
                      swa_tile(F.lds + SWA_K + j * 8192, F.lds + SWA_V + j * 8192, F.lds + SWA_K + jn * 8192, tt == 0 ? 1 : (tt == 4 ? 2 : 0), qf, kf, o, mrun, lrun, lane, abl); } } }
            __syncthreads();
        }
#pragma unroll 1
        for (int j = 0; j < 4; ++j) if (abl != 3) swa_stage(F, P, TL + b * LC + 64 * j, kvh, j);
        __syncthreads();
        { bf16x8 kf[4]; swa_kload(F.lds + SWA_K, 0, lane, kf);
#pragma unroll 1
          for (int j = 0; j < 4; ++j) if (abl != 8) swa_tile(F.lds + SWA_K + j * 8192, F.lds + SWA_V + j * 8192, F.lds + SWA_K + (j < 3 ? j + 1 : j) * 8192, 0, qf, kf, o, mrun, lrun, lane, abl); }
        __syncthreads();
#pragma unroll
        for (int qt = 0; qt < 2; ++qt) {
            float lt = lrun[qt];
            { auto rr = __builtin_amdgcn_permlane32_swap(__float_as_uint(lt), __float_as_uint(lt), false, false); lt = __uint_as_float(rr[0]) + __uint_as_float(rr[1]); }
            const float inv = 1.0f / lt;
            bf16* op = MIX + (size_t)(mrow0 + 32 * qt + r32) * D + 512 + hq * 64 + 4 * hi;
#pragma unroll
            for (int dt = 0; dt < 2; ++dt)
#pragma unroll
                for (int rg = 0; rg < 4; ++rg) {
                    u32x2 w; w.x = pk2(o[dt][qt][4 * rg] * inv, o[dt][qt][4 * rg + 1] * inv); w.y = pk2(o[dt][qt][4 * rg + 2] * inv, o[dt][qt][4 * rg + 3] * inv);
                    if (abl != 7 || w.x == 0x12345u) *(u32x2*)(op + 32 * dt + 8 * rg) = w;
                }
        }
    }
}


constexpr size_t WS_US = WS_GL, WS_USC = WS_GL + 32 * MiB, WS_DEC = 7 * MiB;
static_assert(WS_USC + (size_t)16 * 4 * 8192 * 2 <= WS_END && WS_DEC + (size_t)16 * 132 * 64 * 4 <= WS_WIN, "ws map (gla)");
constexpr int GL_V = 0, GL_M0 = 16384, GL_MSZ = 64 * 72 * 2, GL_RED = GL_M0 + 4 * GL_MSZ;
__device__ __forceinline__ float wave_scan_incl(float v) {
    v += DPP_F(v, 0x111, 0xF); v += DPP_F(v, 0x112, 0xF); v += DPP_F(v, 0x114, 0xF); v += DPP_F(v, 0x118, 0xF);
    v += DPP_F(v, 0x142, 0xA); v += DPP_F(v, 0x143, 0xC); return v;
}
__device__ __forceinline__ float lane63(float v) { return __builtin_bit_cast(float, __builtin_amdgcn_readlane(__builtin_bit_cast(int, v), 63)); }
__device__ __forceinline__ void unpack8(const u32x4 w, float (&f)[8]) { f[0] = bflo(w.x); f[1] = bfhi(w.x); f[2] = bflo(w.y); f[3] = bfhi(w.y); f[4] = bflo(w.z); f[5] = bfhi(w.z); f[6] = bflo(w.w); f[7] = bfhi(w.w); }
__device__ __forceinline__ void gla_stage_v(const Frame& F, const bf16* P, int m0, int h) {
#pragma unroll
    for (int i = 0; i < 2; ++i) { const int p = F.tid + 512 * i, t = p >> 4, ch = p & 15;
        const u32x4 v = *(const u32x4*)(P + (size_t)(m0 + t) * NIN + PC_V + h * 128 + ch * 8);
        *(LAS u32x4*)(F.lds + GL_V + (ch >> 2) * 4096 + t * 64 + (ch & 3) * 16) = v; }
}
__device__ __forceinline__ void gla_g1_unit(const Frame& F, const bf16* P, int m0, int h, bf16* Uf, bf16* Ub, float* decf, float* decb) {
    const int w = F.wave, t = F.lane, c = t & 31, hi = t >> 5;
    const bf16* row = P + (size_t)(m0 + t) * NIN + h * 64 + 8 * w;
    float laf[8], lab[8], kk[8];
    unpack8(*(const u32x4*)(row + PC_GF), laf); unpack8(*(const u32x4*)(row + PC_GB), lab); unpack8(*(const u32x4*)(row + PC_K), kk);
    gla_stage_v(F, P, m0, h);
    LAS bf16* KOF = (LAS bf16*)(F.lds + GL_M0); LAS bf16* KOB = (LAS bf16*)(F.lds + GL_M0 + GL_MSZ);
#pragma unroll
    for (int i = 0; i < 8; ++i) {
        const float incf = wave_scan_incl(laf[i]), tf = lane63(incf), incb = wave_scan_incl(lab[i]), tb = lane63(incb);
        KOF[(8 * w + i) * 72 + t] = (bf16)f2bf(kk[i] * __expf(tf - incf));
        KOB[(8 * w + i) * 72 + t] = (bf16)f2bf(kk[i] * __expf(incb - lab[i]));
        if (t == 0) { decf[8 * w + i] = __expf(tf); decb[8 * w + i] = __expf(tb); }
    }
    __syncthreads();
    const int dir = w >> 2, dvt = w & 3;
    const LAS unsigned char* vp = F.lds + GL_V + dvt * 4096 + ((t >> 4) & 1) * 32 + (t & 3) * 8 + ((t & 15) >> 2) * 64 + hi * 512;
    const LAS unsigned char* kb = F.lds + GL_M0 + dir * GL_MSZ + (c * 72 + 8 * hi) * 2;
    f32x16 acc[2];
#pragma unroll
    for (int j = 0; j < 2; ++j)
#pragma unroll
        for (int r = 0; r < 16; ++r) acc[j][r] = 0.f;
#pragma unroll
    for (int sp = 0; sp < 4; ++sp) {
        const s16x4 lo = vtr(vp + sp * 1024), hi4 = vtr(vp + sp * 1024 + 256);
        const bf16x8 vf = (bf16x8){lo[0], lo[1], lo[2], lo[3], hi4[0], hi4[1], hi4[2], hi4[3]};
#pragma unroll
        for (int j = 0; j < 2; ++j) { const bf16x8 kf = *(const LAS bf16x8*)(kb + j * 32 * 144 + sp * 32); acc[j] = __builtin_amdgcn_mfma_f32_32x32x16_bf16(kf, vf, acc[j], 0, 0, 0); }
    }
    bf16* U = dir ? Ub : Uf;
#pragma unroll
    for (int j = 0; j < 2; ++j) {
        u32x4 w0, w1;
        w0.x = pk2(acc[j][0], acc[j][1]); w0.y = pk2(acc[j][2], acc[j][3]); w0.z = pk2(acc[j][4], acc[j][5]); w0.w = pk2(acc[j][6], acc[j][7]);
        w1.x = pk2(acc[j][8], acc[j][9]); w1.y = pk2(acc[j][10], acc[j][11]); w1.z = pk2(acc[j][12], acc[j][13]); w1.w = pk2(acc[j][14], acc[j][15]);
        u32x4* up = (u32x4*)(U + ((j * 4 + dvt) * 64 + t) * 16);
        up[0] = w0; up[1] = w1;
    }
    __syncthreads();
}
__device__ __forceinline__ void gla_g1(const Frame& F0, int l) {
    Frame F = F0; { int l_; asm volatile("v_mbcnt_lo_u32_b32 %0, -1, 0\n\tv_mbcnt_hi_u32_b32 %0, -1, %0" : "=v"(l_)); F.lane = l_; F.tid = F.wave * 64 + l_; }
    const bf16* P = (const bf16*)(F.ws + WS_P);
    bf16* US = (bf16*)(F.ws + WS_US); bf16* USC = (bf16*)(F.ws + WS_USC); float* DEC = (float*)(F.ws + WS_DEC);
    for (int u = F.vcu; u < 1056; u += F.G) {
        const bool latent = u < 1024; const int cc = u - 1024;
        const int b = latent ? (u >> 9) : (cc >> 4), h = latent ? ((u >> 7) & 3) : ((cc >> 2) & 3), n = latent ? (u & 127) : (cc & 3);
        const int m0 = latent ? b * SEQ + 64 * n : TL + b * LC + 64 * n;
        const int sf = (b * 4 + h) * 2;
        bf16* Uf = latent ? US + ((size_t)sf * 128 + n) * 8192 : USC + ((size_t)sf * 4 + n) * 8192;
        bf16* Ub = latent ? US + ((size_t)(sf + 1) * 128 + n) * 8192 : USC + ((size_t)(sf + 1) * 4 + n) * 8192;
        const int nd = latent ? n : 128 + n;
        gla_g1_unit(F, P, m0, h, Uf, Ub, DEC + ((size_t)sf * 132 + nd) * 64, DEC + ((size_t)(sf + 1) * 132 + nd) * 64);
    }
}
constexpr size_t WS_SS = WS_H, WS_SSC = WS_H + 32 * MiB;
static_assert(WS_SSC + (size_t)16 * 4 * 8192 * 2 <= WS_P, "ws map (gla states)");
__device__ __forceinline__ void gla_scan(const Frame& F) {
    for (int w0 = (F.vcu * NWAVES + F.wave) * 64; w0 < 16 * 4096; w0 += F.G * NWAVES * 64) {
        const int seq = __builtin_amdgcn_readfirstlane(w0 >> 12), ew = __builtin_amdgcn_readfirstlane((w0 & 4095) * 2);
        const int dir = seq & 1;
        const unsigned voff = (unsigned)F.lane * 4u;
        unsigned doff;
        { const int e = ew + 2 * F.lane, r = e & 15, ln = (e >> 4) & 63, dkt = e >> 12; doff = (unsigned)(32 * dkt + (r & 3) + 8 * (r >> 2) + 4 * (ln >> 5)) * 4u; }
        const char* decb = (const char*)(F.ws + WS_DEC) + (size_t)seq * 132 * 256;
        float s0 = 0.f, s1 = 0.f;
        { const char* ub = (const char*)(F.ws + WS_USC) + ((size_t)seq * 4 * 8192 + ew) * 2; char* sb = (char*)(F.ws + WS_SSC) + ((size_t)seq * 4 * 8192 + ew) * 2;
          unsigned u[4]; f32x2 d[4];
#pragma unroll
          for (int i = 0; i < 4; ++i) { const int n = dir ? 3 - i : i; u[i] = *(const unsigned*)(ub + (size_t)n * 16384 + voff); d[i] = *(const f32x2*)(decb + (size_t)(128 + n) * 256 + doff); }
#pragma unroll
          for (int i = 0; i < 4; ++i) { const int n = dir ? 3 - i : i; *(unsigned*)(sb + (size_t)n * 16384 + voff) = pk2(s0, s1); s0 = d[i][0] * s0 + bflo(u[i]); s1 = d[i][1] * s1 + bfhi(u[i]); } }
        const long stride = dir ? -16384 : 16384, dstride = dir ? -256 : 256;
        const char* ub = (const char*)(F.ws + WS_US) + ((size_t)seq * 128 * 8192 + ew) * 2 + (dir ? (size_t)127 * 16384 : 0);
        char* sb = (char*)(F.ws + WS_SS) + ((size_t)seq * 128 * 8192 + ew) * 2 + (dir ? (size_t)127 * 16384 : 0);
        const char* db = decb + (dir ? 127 * 256 : 0);
#pragma unroll 1
        for (int i0 = 0; i0 < 128; i0 += 32) {
            unsigned u[32]; f32x2 d[32];
#pragma unroll
            for (int j = 0; j < 32; ++j) { u[j] = *(const unsigned*)(ub + j * stride + voff); d[j] = *(const f32x2*)(db + j * dstride + doff); }
#pragma unroll
            for (int j = 0; j < 32; ++j) { *(unsigned*)(sb + j * stride + voff) = pk2(s0, s1); s0 = d[j][0] * s0 + bflo(u[j]); s1 = d[j][1] * s1 + bfhi(u[j]); }
            ub += 32 * stride; sb += 32 * stride; db += 32 * dstride;
        }
    }
}
__device__ __forceinline__ void gla_g3_unit(const Frame& F, const CAS Args* a, int l, const bf16* P, int m0, int h, const bf16* Sf, const bf16* Sb, bf16* MIX) {
    const int w = F.wave, t = F.lane, c = t & 31, hi = t >> 5;
    bf16x8 sfr[4], sbr[4]; u32x2 gwv[4]; f32x4 nwv[4];
    { const int dvt_ = w >> 1, tt_ = w & 1;
#pragma unroll
      for (int kd = 0; kd < 4; ++kd) { const size_t off = (size_t)(((kd >> 1) * 4 + dvt_) * 64 + t) * 16 + 8 * (kd & 1); sfr[kd] = *(const bf16x8*)(Sf + off); sbr[kd] = *(const bf16x8*)(Sb + off); }
#pragma unroll
      for (int rg = 0; rg < 4; ++rg) { const int dv = 32 * dvt_ + 8 * rg + 4 * hi;
          gwv[rg] = *(const u32x2*)(P + (size_t)(m0 + 32 * tt_ + c) * NIN + PC_G + h * 128 + dv); nwv[rg] = *(const f32x4*)(a->in[I_GLANORM] + l * 512 + h * 128 + dv); } }
    {
        const bf16* row = P + (size_t)(m0 + t) * NIN + h * 64 + 8 * w;
        float laf[8], lab[8], kk[8], qq[8];
        unpack8(*(const u32x4*)(row + PC_GF), laf); unpack8(*(const u32x4*)(row + PC_GB), lab); unpack8(*(const u32x4*)(row + PC_K), kk); unpack8(*(const u32x4*)(row + PC_Q), qq);
        gla_stage_v(F, P, m0, h);
        float qf[8], kf[8], qb[8], kb[8];
#pragma unroll
        for (int i = 0; i < 8; ++i) {
            const float bf = wave_scan_incl(laf[i]), incb = wave_scan_incl(lab[i]), bb = lane63(incb) - incb + lab[i];
            qf[i] = qq[i] * __expf(bf); kf[i] = kk[i] * __expf(-bf); qb[i] = qq[i] * __expf(bb); kb[i] = kk[i] * __expf(-bb);
        }
        LAS unsigned char* mb = F.lds + GL_M0 + (t * 72 + 8 * w) * 2;
        u32x4 o;
        o.x = pk2(qf[0], qf[1]); o.y = pk2(qf[2], qf[3]); o.z = pk2(qf[4], qf[5]); o.w = pk2(qf[6], qf[7]); *(LAS u32x4*)(mb) = o;
        o.x = pk2(kf[0], kf[1]); o.y = pk2(kf[2], kf[3]); o.z = pk2(kf[4], kf[5]); o.w = pk2(kf[6], kf[7]); *(LAS u32x4*)(mb + GL_MSZ) = o;
        o.x = pk2(qb[0], qb[1]); o.y = pk2(qb[2], qb[3]); o.z = pk2(qb[4], qb[5]); o.w = pk2(qb[6], qb[7]); *(LAS u32x4*)(mb + 2 * GL_MSZ) = o;
        o.x = pk2(kb[0], kb[1]); o.y = pk2(kb[2], kb[3]); o.z = pk2(kb[4], kb[5]); o.w = pk2(kb[6], kb[7]); *(LAS u32x4*)(mb + 3 * GL_MSZ) = o;
    }
    __syncthreads();
    const int dvt = w >> 1, tt = w & 1;
    bf16x8 qfB[4], qbB[4], qfP[4], qbP[4];
    { const LAS unsigned char* qp = F.lds + GL_M0 + ((32 * tt + c) * 72 + 8 * hi) * 2;
#pragma unroll
      for (int kd = 0; kd < 4; ++kd) { qfB[kd] = *(const LAS bf16x8*)(qp + kd * 32); qbB[kd] = *(const LAS bf16x8*)(qp + 2 * GL_MSZ + kd * 32); }
      const LAS unsigned char* pp = F.lds + GL_M0 + ((32 * tt + c) * 72 + 4 * hi) * 2;
#pragma unroll
      for (int kd = 0; kd < 4; ++kd) {
          const u32x2 a0 = *(const LAS u32x2*)(pp + kd * 32), a1 = *(const LAS u32x2*)(pp + kd * 32 + 16);
          const u32x2 b0 = *(const LAS u32x2*)(pp + 2 * GL_MSZ + kd * 32), b1 = *(const LAS u32x2*)(pp + 2 * GL_MSZ + kd * 32 + 16);
          qfP[kd] = __builtin_bit_cast(bf16x8, (u32x4){a0.x, a0.y, a1.x, a1.y}); qbP[kd] = __builtin_bit_cast(bf16x8, (u32x4){b0.x, b0.y, b1.x, b1.y});
      } }
    bf16x8 pfr[2][2];
#pragma unroll
    for (int st = 0; st < 2; ++st) {
        const LAS unsigned char* kp = F.lds + GL_M0 + GL_MSZ + ((32 * st + c) * 72 + 8 * hi) * 2;
        f32x16 xf, xb;
#pragma unroll
        for (int r = 0; r < 16; ++r) { xf[r] = 0.f; xb[r] = 0.f; }
        const bool needF = st <= tt, needB = st >= tt;
        if (needF) {
#pragma unroll
            for (int kd = 0; kd < 4; ++kd) xf = __builtin_amdgcn_mfma_f32_32x32x16_bf16(*(const LAS bf16x8*)(kp + kd * 32), qfB[kd], xf, 0, 0, 0);
        }
        if (needB) {
#pragma unroll
            for (int kd = 0; kd < 4; ++kd) xb = __builtin_amdgcn_mfma_f32_32x32x16_bf16(*(const LAS bf16x8*)(kp + 2 * GL_MSZ + kd * 32), qbB[kd], xb, 0, 0, 0);
        }
        if (st == tt) {
            int thr = c - 4 * hi; asm volatile("" : "+v"(thr));
#pragma unroll
            for (int r = 0; r < 16; ++r) { const int cc = (r & 3) + 8 * (r >> 2); xf[r] = (cc <= thr ? xf[r] : 0.f) + (cc >= thr ? xb[r] : 0.f); }
        } else {
#pragma unroll
            for (int r = 0; r < 16; ++r) xf[r] += xb[r];
        }
#pragma unroll
        for (int sp = 0; sp < 2; ++sp) {
            u32x4 wv; wv.x = pg8::cvt_pk_bf16(xf[8 * sp + 0], xf[8 * sp + 1]); wv.y = pg8::cvt_pk_bf16(xf[8 * sp + 2], xf[8 * sp + 3]);
            wv.z = pg8::cvt_pk_bf16(xf[8 * sp + 4], xf[8 * sp + 5]); wv.w = pg8::cvt_pk_bf16(xf[8 * sp + 6], xf[8 * sp + 7]);
            pfr[st][sp] = __builtin_bit_cast(bf16x8, wv);
        }
    }
    f32x16 o;
#pragma unroll
    for (int r = 0; r < 16; ++r) o[r] = 0.f;
    { const LAS unsigned char* vp = F.lds + GL_V + dvt * 4096 + ((t >> 4) & 1) * 32 + (t & 3) * 8 + (4 * hi + ((t & 15) >> 2)) * 64;
#pragma unroll
      for (int ks = 0; ks < 4; ++ks) {
          const s16x4 lo = vtr(vp + ks * 1024), hi4 = vtr(vp + ks * 1024 + 512);
          const bf16x8 vf = (bf16x8){lo[0], lo[1], lo[2], lo[3], hi4[0], hi4[1], hi4[2], hi4[3]};
          o = __builtin_amdgcn_mfma_f32_32x32x16_bf16(vf, pfr[ks >> 1][ks & 1], o, 0, 0, 0);
      } }
#pragma unroll
    for (int kd = 0; kd < 4; ++kd) {
        o = __builtin_amdgcn_mfma_f32_32x32x16_bf16(sfr[kd], qfP[kd], o, 0, 0, 0);
        o = __builtin_amdgcn_mfma_f32_32x32x16_bf16(sbr[kd], qbP[kd], o, 0, 0, 0);
    }
    float ssq = 0.f;
#pragma unroll
    for (int r = 0; r < 16; ++r) ssq += o[r] * o[r];
    { auto rr = __builtin_amdgcn_permlane32_swap(__float_as_uint(ssq), __float_as_uint(ssq), false, false); ssq = __uint_as_float(rr[0]) + __uint_as_float(rr[1]); }
    LAS float* red = (LAS float*)(F.lds + GL_RED);
    if (hi == 0) red[dvt * 64 + 32 * tt + c] = ssq;
    __syncthreads();
    const float tot = (red[32 * tt + c] + red[64 + 32 * tt + c]) + (red[128 + 32 * tt + c] + red[192 + 32 * tt + c]);
    const float rstd = 1.0f / sqrtf(tot * (1.0f / 128.0f) + EPS);
    const int mrow = m0 + 32 * tt + c;
#pragma unroll
    for (int rg = 0; rg < 4; ++rg) {
        const int dv = 32 * dvt + 8 * rg + 4 * hi;
        const u32x2 gw = gwv[rg]; const f32x4 nw = nwv[rg];
        const float g0 = bflo(gw.x), g1 = bfhi(gw.x), g2 = bflo(gw.y), g3 = bfhi(gw.y);
        u32x2 ov; ov.x = pk2(o[4 * rg] * rstd * nw[0] * silu_f(g0), o[4 * rg + 1] * rstd * nw[1] * silu_f(g1)); ov.y = pk2(o[4 * rg + 2] * rstd * nw[2] * silu_f(g2), o[4 * rg + 3] * rstd * nw[3] * silu_f(g3));
        *(u32x2*)(MIX + (size_t)mrow * D + h * 128 + dv) = ov;
    }
    __syncthreads();
}
__device__ __forceinline__ void gla_g3(const Frame& F, const CAS Args* a, int l) {
    const bf16* P = (const bf16*)(F.ws + WS_P); bf16* MIX = (bf16*)(F.ws + WS_MIX);
    const bf16* US = (const bf16*)(F.ws + WS_SS); const bf16* USC = (const bf16*)(F.ws + WS_SSC);
    const int nunits = 1024 + (l == 0 ? 32 : 0);
    for (int u = F.vcu; u < nunits; u += F.G) {
        const bool latent = u < 1024; const int cc = u - 1024;
        const int b = latent ? (u >> 9) : (cc >> 4), h = latent ? ((u >> 7) & 3) : ((cc >> 2) & 3), n = latent ? (u & 127) : (cc & 3);
        const int m0 = latent ? b * SEQ + 64 * n : TL + b * LC + 64 * n;
        const int sf = (b * 4 + h) * 2;
        const bf16* Sf = latent ? US + ((size_t)sf * 128 + n) * 8192 : USC + ((size_t)sf * 4 + n) * 8192;
        const bf16* Sb = latent ? US + ((size_t)(sf + 1) * 128 + n) * 8192 : USC + ((size_t)(sf + 1) * 4 + n) * 8192;
        gla_g3_unit(F, a, l, P, m0, h, Sf, Sb, MIX);
    }
}

__device__ __forceinline__ void gla_naive(const Frame& F, const CAS Args* a, int l) {
    const bf16* P = (const bf16*)(F.ws + WS_P);
    bf16* OF = (bf16*)(F.ws + WS_GL);
    for (int w = F.gw; w < 2048; w += F.NGW) {
        const int dv = w & 127, dir = (w >> 7) & 1, h = (w >> 8) & 3, b = w >> 10;
        const int pcg = dir ? PC_GB : PC_GF;
        float S = 0.f;
        for (int step = 0; step < LC + SEQ; ++step) {
            int m;
            if (dir == 0) m = step < LC ? TL + b * LC + step : b * SEQ + (step - LC);
            else m = step < LC ? TL + b * LC + (LC - 1 - step) : b * SEQ + (SEQ - 1 - (step - LC));
            const bf16* row = P + (size_t)m * NIN;
            const float la = bf2f(row[pcg + h * 64 + F.lane]), kk = bf2f(row[PC_K + h * 64 + F.lane]), qq = bf2f(row[PC_Q + h * 64 + F.lane]), vv = bf2f(row[PC_V + h * 128 + dv]);
            S = __expf(la) * S + kk * vv;
            const float o = wave_sum(qq * S);
            if (F.lane == 0) OF[((size_t)dir * TT + m) * 512 + h * 128 + dv] = (bf16)f2bf(o);
        }
    }
}
__device__ __forceinline__ void gla_out_naive(const Frame& F, const CAS Args* a, int l) {
    const bf16* P = (const bf16*)(F.ws + WS_P); bf16* MIX = (bf16*)(F.ws + WS_MIX);
    const bf16* OF = (const bf16*)(F.ws + WS_GL);
    const int rows = (l == 0) ? TT : TL;
    for (int m = F.gw; m < rows; m += F.NGW) {
        const int c0 = 8 * F.lane;
        const u32x4 wa = *(const u32x4*)(OF + (size_t)m * 512 + c0), wb = *(const u32x4*)(OF + ((size_t)TT + m) * 512 + c0);
        float o[8] = {bflo(wa.x) + bflo(wb.x), bfhi(wa.x) + bfhi(wb.x), bflo(wa.y) + bflo(wb.y), bfhi(wa.y) + bfhi(wb.y), bflo(wa.z) + bflo(wb.z), bfhi(wa.z) + bfhi(wb.z), bflo(wa.w) + bflo(wb.w), bfhi(wa.w) + bfhi(wb.w)};
        float ss = 0.f;
#pragma unroll
        for (int i = 0; i < 8; ++i) ss += o[i] * o[i];
        ss = row16_sum(ss);
        const float rstd = 1.0f / sqrtf(ss * (1.0f / 128.0f) + EPS);
        const u32x4 wg = *(const u32x4*)(P + (size_t)m * NIN + PC_G + c0);
        const float g[8] = {bflo(wg.x), bfhi(wg.x), bflo(wg.y), bfhi(wg.y), bflo(wg.z), bfhi(wg.z), bflo(wg.w), bfhi(wg.w)};
        const f32x4 n0 = *(const f32x4*)(a->in[I_GLANORM] + l * 512 + c0), n1 = *(const f32x4*)(a->in[I_GLANORM] + l * 512 + c0 + 4);
        float r[8];
#pragma unroll
        for (int i = 0; i < 8; ++i) r[i] = o[i] * rstd * (i < 4 ? n0[i] : n1[i - 4]) * silu_f(g[i]);
        u32x4 w; w.x = pk2(r[0], r[1]); w.y = pk2(r[2], r[3]); w.z = pk2(r[4], r[5]); w.w = pk2(r[6], r[7]);
        *(u32x4*)(MIX + (size_t)m * D + c0) = w;
    }
}

constexpr int N2_WHI = 0, N2_WLO = 32768, N2_HHI = 65536, N2_HLO = 98304, N2_PART = 132096, N2_CNT = N2_PART + 8192, N2_RT = 20;
static_assert(N2_CNT + 256 + NWAVES * N2_RT * 16 <= LDS_BYTES && N2_PART >= MISC_OFF + 64 + 128, "N2 LDS map");
__device__ __forceinline__ int n2_addr(int r, int k) { return r * 2048 + ((((k >> 3) ^ r) & 127) << 4) + (k & 7) * 2; }
__device__ __forceinline__ void n2_route_phase(const Frame& F, const CAS Args* a, int l, bool do_route, int cset) {
    unsigned char* ws = F.ws;
    const float* mod = (const float*)(ws + WS_MOD);
    bf16* H = (bf16*)(ws + WS_H);
    unsigned* cnt = (unsigned*)(ws + WS_CTL) + CW_CNT + cset * NE * CNT_STRIDE;
    unsigned* list = (unsigned*)(ws + WS_LIST); float* listw = (float*)(ws + WS_LISTW);
    LAS unsigned* lcnt = (LAS unsigned*)(F.lds + N2_CNT); LAS unsigned* lbase = lcnt + 16; LAS unsigned* rec = lcnt + 64;
    for (int i = F.tid; i < D * NE; i += NWAVES * 64) { const int e = i & 15, k = i >> 4; const float w = a->in[I_WROUTER][i];
        const unsigned hi = f2bf(w); const unsigned lo = f2bf(w - bf2f(hi));
        *(LAS bf16*)(F.lds + N2_WHI + n2_addr(e, k)) = (bf16)hi; *(LAS bf16*)(F.lds + N2_WLO + n2_addr(e, k)) = (bf16)lo; }
    if (F.tid < 32) lcnt[F.tid] = 0u;
    __syncthreads();
    const int rows = (l == 0) ? TT : TL;
    const int t0 = F.gw;
    const int nch = (rows - F.vcu * NWAVES + F.NGW - 1) / F.NGW;
    f32x4 xc[2][4], xq[2][4];
#pragma unroll
    for (int half = 0; half < 2; ++half) { const int m = t0 + half * F.NGW;
        if (m < rows) { const float* xr = m < TL ? F.out + (size_t)m * D : (const float*)(ws + WS_XC) + (size_t)(m - TL) * D;
#pragma unroll
            for (int j = 0; j < 4; ++j) xq[half][j] = *(const f32x4*)(xr + 4 * F.lane + 256 * j); } }
    for (int c2 = 0; c2 < nch; c2 += 2) {
#pragma unroll
        for (int half = 0; half < 2; ++half)
#pragma unroll
            for (int j = 0; j < 4; ++j) xc[half][j] = xq[half][j];
#pragma unroll
        for (int half = 0; half < 2; ++half) { const int m = t0 + (c2 + 2 + half) * F.NGW;
            if (m < rows) { const float* xr = m < TL ? F.out + (size_t)m * D : (const float*)(ws + WS_XC) + (size_t)(m - TL) * D;
#pragma unroll
                for (int j = 0; j < 4; ++j) xq[half][j] = *(const f32x4*)(xr + 4 * F.lane + 256 * j); } }
#pragma unroll
        for (int half = 0; half < 2; ++half) {
            const int m = t0 + (c2 + half) * F.NGW, r = 8 * half + F.wave;
            if (m < rows) {
                const int v = m < TL ? (m >> 13) : 2;
                f32x4 x[4]; float ss = 0.f;
#pragma unroll
                for (int j = 0; j < 4; ++j) { x[j] = xc[half][j]; ss += (x[j][0] * x[j][0] + x[j][1] * x[j][1]) + (x[j][2] * x[j][2] + x[j][3] * x[j][3]); }
                const float rstd = 1.0f / sqrtf(wave_sum(ss) * (1.0f / D) + EPS);
#pragma unroll
                for (int j = 0; j < 4; ++j) {
                    const int col = 4 * F.lane + 256 * j;
                    const f32x4 nw = *(const f32x4*)(a->in[I_NORM2] + l * D + col);
                    const f32x4 sh = *(const f32x4*)(mod + (l * 3 + v) * 6144 + 3 * D + col);
                    const f32x4 sc = *(const f32x4*)(mod + (l * 3 + v) * 6144 + 4 * D + col);
                    const f32x4 h = x[j] * rstd * nw * (1.0f + sc) + sh;
                    const unsigned h0 = f2bf(h[0]), h1 = f2bf(h[1]), h2 = f2bf(h[2]), h3 = f2bf(h[3]);
                    u32x2 o; o.x = h0 | (h1 << 16); o.y = h2 | (h3 << 16);
                    *(unsigned*)((unsigned char*)H + (size_t)m * D + col) = pk4_fp8(h[0], h[1], h[2], h[3]);
                    u32x2 lo; lo.x = pk2(h[0] - bf2f(h0), h[1] - bf2f(h1)); lo.y = pk2(h[2] - bf2f(h2), h[3] - bf2f(h3));
                    const int ad = n2_addr(r, col);
                    *(LAS u32x2*)(F.lds + N2_HHI + ad) = o; *(LAS u32x2*)(F.lds + N2_HLO + ad) = lo;
                }
            }
        }
        __syncthreads();
        {
            const int rr = F.lane & 15, kg = F.lane >> 4;
            f32x4 acc = (f32x4){0.f, 0.f, 0.f, 0.f};
#pragma unroll
            for (int ks = 0; ks < 4; ++ks) {
                const int ad = n2_addr(rr, 128 * F.wave + 32 * ks + 8 * kg);
                const bf16x8 whi = *(const LAS bf16x8*)(F.lds + N2_WHI + ad), wlo = *(const LAS bf16x8*)(F.lds + N2_WLO + ad);
                const bf16x8 hhi = *(const LAS bf16x8*)(F.lds + N2_HHI + ad), hlo = *(const LAS bf16x8*)(F.lds + N2_HLO + ad);
                acc = __builtin_amdgcn_mfma_f32_16x16x32_bf16(whi, hhi, acc, 0, 0, 0);
                acc = __builtin_amdgcn_mfma_f32_16x16x32_bf16(whi, hlo, acc, 0, 0, 0);
                acc = __builtin_amdgcn_mfma_f32_16x16x32_bf16(wlo, hhi, acc, 0, 0, 0);
            }
            *(LAS f32x4*)(F.lds + N2_PART + ((F.wave * 16 + rr) * 16 + 4 * kg) * 4) = acc;
        }
        __syncthreads();
        if (F.wave == 0) {
            const int rr = F.lane & 15, eg = F.lane >> 4;
            f32x4 lg = (f32x4){0.f, 0.f, 0.f, 0.f};
#pragma unroll
            for (int w = 0; w < NWAVES; ++w) lg = lg + *(const LAS f32x4*)(F.lds + N2_PART + ((w * 16 + rr) * 16 + 4 * eg) * 4);
            const f32x4 br = *(const f32x4*)(a->in[I_BROUTER] + 4 * eg);
            float sg[4], sb[4];
#pragma unroll
            for (int i = 0; i < 4; ++i) { sg[i] = 1.0f / (1.0f + expf(-lg[i])); sb[i] = sg[i] + br[i]; }
            int i0 = 0, i1 = 0; float b0 = -1e30f, b1 = -1e30f, s0 = 0.f, s1 = 0.f;
#pragma unroll
            for (int i = 0; i < 4; ++i) { const float val = sb[i];
                if (val > b0) { b1 = b0; i1 = i0; s1 = s0; b0 = val; i0 = i; s0 = sg[i]; } else if (val > b1) { b1 = val; i1 = i; s1 = sg[i]; } }
            const float gs = b0 + b1;
            float best = gs; int bg = eg;
#pragma unroll
            for (int st = 16; st < 64; st <<= 1) {
                const float og = __builtin_bit_cast(float, __builtin_amdgcn_ds_bpermute((F.lane ^ st) << 2, __builtin_bit_cast(int, best)));
                const int oi = __builtin_amdgcn_ds_bpermute((F.lane ^ st) << 2, bg);
                if (og > best || (og == best && oi < bg)) { best = og; bg = oi; }
            }
            const int half = rr >> 3, wv = rr & 7, ch = c2 + half;
            const int m = F.vcu * NWAVES + wv + ch * F.NGW;
            if (do_route && bg == eg && m < rows) {
                const int e0 = 4 * eg + i0, e1 = 4 * eg + i1; const float inv = 1.0f / (s0 + s1);
                if (ch < N2_RT) {
                    const int slot = wv * N2_RT + ch;
                    const unsigned l0 = atomicAdd((unsigned*)(lcnt + e0), 1u), l1 = atomicAdd((unsigned*)(lcnt + e1), 1u);
                    rec[slot * 4 + 0] = (unsigned)m; rec[slot * 4 + 1] = (unsigned)e0 | ((unsigned)e1 << 8) | (l0 << 16) | (l1 << 24);
                    rec[slot * 4 + 2] = __float_as_uint(s0 * inv); rec[slot * 4 + 3] = __float_as_uint(s1 * inv);
                } else {
                    const unsigned p0 = atomicAdd(cnt + e0 * CNT_STRIDE, 1u); list[(size_t)e0 * LISTCAP + p0] = (unsigned)m * 2u; listw[(size_t)e0 * LISTCAP + p0] = s0 * inv;
                    const unsigned p1 = atomicAdd(cnt + e1 * CNT_STRIDE, 1u); list[(size_t)e1 * LISTCAP + p1] = (unsigned)m * 2u + 1u; listw[(size_t)e1 * LISTCAP + p1] = s1 * inv;
                }
            }
        }
    }
    __syncthreads();
    if (do_route) {
        if (F.tid < NE) { const unsigned c = lcnt[F.tid]; lbase[F.tid] = c ? atomicAdd(cnt + F.tid * CNT_STRIDE, c) : 0u; }
        __syncthreads();
        for (int i = F.tid; i < NWAVES * N2_RT; i += NWAVES * 64) {
            const int wv = i / N2_RT, k = i % N2_RT;
            if (F.vcu * NWAVES + wv + k * F.NGW < rows) {
                const unsigned m = rec[i * 4], pk = rec[i * 4 + 1]; const unsigned e0 = pk & 255u, e1 = (pk >> 8) & 255u, l0 = (pk >> 16) & 255u, l1 = pk >> 24;
                const unsigned p0 = lbase[e0] + l0, p1 = lbase[e1] + l1;
                list[(size_t)e0 * LISTCAP + p0] = m * 2u; listw[(size_t)e0 * LISTCAP + p0] = __uint_as_float(rec[i * 4 + 2]);
                list[(size_t)e1 * LISTCAP + p1] = m * 2u + 1u; listw[(size_t)e1 * LISTCAP + p1] = __uint_as_float(rec[i * 4 + 3]);
            }
        }
    }
    __syncthreads();
}

__device__ __forceinline__ void moe_setup(pg8::MoeOrder& S, const Frame& F, int cset, int nN) {
    unsigned* cnt = (unsigned*)(F.ws + WS_CTL) + CW_CNT + cset * NE * CNT_STRIDE;
    LAS int* tab = (LAS int*)(F.lds + MISC_OFF + 64);
    __syncthreads();
    if (F.tid == 0) { int run = 0;
        for (int e = 0; e < NE; ++e) { const int c = (int)__hip_atomic_load(cnt + e * CNT_STRIDE, __ATOMIC_RELAXED, __HIP_MEMORY_SCOPE_AGENT); tab[e] = c; run += (c + 255) >> 8; tab[16 + e] = run; } }
    __syncthreads();
    S.tab = tab; S.nN = nN; S.nunits = __builtin_amdgcn_readfirstlane(tab[31]) * nN; S.G = F.G; S.c = (int)blockIdx.x;
    S.tdone = (unsigned*)(F.ws + WS_CTL) + CW_TDONE + cset * 160 * 16; S.role = 0;
    S.list = (const unsigned*)(F.ws + WS_LIST);
}
__device__ __forceinline__ void moe1_phase(const Frame& F, const CAS Args* a, int l, int cset) {
    pg8::MoeOrder S; moe_setup(S, F, cset, 4);
    S.A = (const char*)(F.ws + WS_H); S.Bt = (const char*)(F.ws + WS_WGU) + (size_t)l * NE * D * D; S.K = D / 2; S.bstride_e = (size_t)D * D; S.gather = true; S.role = 1;
    EpiGU E{(bf16*)(F.ws + WS_HMID)};
    pg8::gemm_phase<EpiGU, pg8::MoeOrder, true>(F.lds, F.tid, S, E, SC_W1, SC_ONE);
}
__device__ __forceinline__ void moe2_phase(const Frame& F, const CAS Args* a, int l, int cset) {
    pg8::MoeOrder S; moe_setup(S, F, cset, 4);
    S.A = (const char*)(F.ws + WS_HMID); S.Bt = (const char*)(F.ws + WS_WD) + (size_t)l * NE * D * DE; S.K = DE / 2; S.bstride_e = (size_t)D * DE; S.gather = false; S.role = 2; S.c = F.G - 1 - (int)blockIdx.x;
    EpiDown E; E.Y = (bf16*)(F.ws + WS_Y); E.list = (const unsigned*)(F.ws + WS_LIST); E.listw = (const float*)(F.ws + WS_LISTW); E.tab = S.tab;
    pg8::gemm_phase<EpiDown, pg8::MoeOrder, true>(F.lds, F.tid, S, E, SC_W2, SC_HMID);
    if (l == 0 && cset == 0) convert_moe_filler(F, a, 1, S.nunits, true);
}

__device__ __forceinline__ void final_load(const Frame& F, int m, f32x4 (&x)[4]) {
    const float* mod = (const float*)(F.ws + WS_MOD);
    const bf16* Y0 = (const bf16*)(F.ws + WS_Y); const bf16* Y1 = Y0 + (size_t)TT * D;
    const int v = m >> 13; const float* xrow = F.out + (size_t)m * D;
#pragma unroll
    for (int j = 0; j < 4; ++j) {
        const int col = 4 * F.lane + 256 * j;
        const f32x4 g2 = *(const f32x4*)(mod + (3 + v) * 6144 + 5 * D + col);
        const f32x4 y = ld_y4(Y0 + (size_t)m * D + col) + ld_y4(Y1 + (size_t)m * D + col);
        x[j] = *(const f32x4*)(xrow + col) + g2 * y;
    }
}
__device__ __forceinline__ void final_row(const Frame& F, const CAS Args* a, int m, const f32x4 (&x)[4]) {
    float* xrow = F.out + (size_t)m * D; float ss = 0.f;
#pragma unroll
    for (int j = 0; j < 4; ++j) ss += (x[j][0] * x[j][0] + x[j][1] * x[j][1]) + (x[j][2] * x[j][2] + x[j][3] * x[j][3]);
    const float rstd = 1.0f / sqrtf(wave_sum(ss) * (1.0f / D) + EPS);
#pragma unroll
    for (int j = 0; j < 4; ++j) { const int col = 4 * F.lane + 256 * j; const f32x4 nw = *(const f32x4*)(a->in[I_FNORM] + col); *(f32x4*)(xrow + col) = x[j] * rstd * nw; }
}
__device__ __forceinline__ void final_phase(const Frame& F, const CAS Args* a) {
    for (int m = F.gw; m < TL; m += 2 * F.NGW) {
        const int m2 = m + F.NGW; const bool two = m2 < TL;
        f32x4 xa[4], xb[4];
        final_load(F, m, xa);
        if (two) final_load(F, m2, xb);
        final_row(F, a, m, xa);
        if (two) final_row(F, a, m2, xb);
    }
}

#ifndef NPASS
#define NPASS 1
#endif
#ifndef PROBE_PH
#define PROBE_PH -1
#endif
#ifndef PROBE_R
#define PROBE_R 3
#endif
#ifndef PROBE_UPTO
#define PROBE_UPTO -1
#endif
#ifndef PROBE_ABL
#define PROBE_ABL 0
#endif
constexpr int PH_PER_LAYER = 8;
constexpr int N_PHASES = 1 + DEPTH * PH_PER_LAYER + 1;

template <int ph0>
__device__ __forceinline__ void do_phase(Frame& F, XcdBarrier& bar, LAS unsigned char* lds, int lo, int hi) {
    constexpr int ph = ph0 % N_PHASES, pass = ph0 / N_PHASES;
    if (!(lo <= ph && ph < hi)) return;
    if (pass == 1 && (PROBE_UPTO >= 0 ? ph >= PROBE_UPTO : ph != PROBE_PH)) return;
    const CAS Args* ap;
        { int l_; asm volatile("v_mbcnt_lo_u32_b32 %0, -1, 0\n\tv_mbcnt_hi_u32_b32 %0, -1, %0" : "=v"(l_)); F.lane = l_; F.tid = F.wave * 64 + l_; ap = (const CAS Args*)__builtin_amdgcn_kernarg_segment_ptr(); asm volatile("" : "+s"(ap)); F.ws = ap->ws; F.out = (pass == 1) ? (float*)(ap->ws + WS_P) : ap->out;
          LAS unsigned char* lb_ = (LAS unsigned char*)lds; asm volatile("" : "+s"(lb_)); __builtin_assume((((unsigned)(__UINTPTR_TYPE__)lb_) & 1023u) == 0u); F.lds = lb_;
          bar.bar = (unsigned*)(F.ws + WS_CTL) + CW_BAR; bar.st = (volatile LAS unsigned*)(F.lds + MISC_OFF) + 8; }
        if (ph == 0) { if (PH_ON(10)) REP(10, true) p0_prologue(F, ap); }
        else if (ph == N_PHASES - 1) { if (PH_ON(11)) REP(11, false) final_phase(F, ap); }
        else {
            const int l = (ph - 1) / PH_PER_LAYER, s = (ph - 1) % PH_PER_LAYER;
            unsigned char* ws = F.ws;
            if (s == 0) { if (PH_ON(0)) REP(0, l == 0) n1_phase(F, ap, l); }
            else if (s == 1 && PH_ON(1)) REP(1, true) {
                pg8::DenseOrder S; S.init(ws + WS_H, ws + WS_WIN + (size_t)l * NIN * D * 2, TT, NIN, D, F.G, (int)blockIdx.x);
                EpiIn E{(bf16*)(ws + WS_P), ap->in[I_BIASF] + l * 256, ap->in[I_BIASB] + l * 256, (const float*)(ws + WS_ROPE), (const float*)(ws + WS_ROPE) + 2048};
                pg8::gemm_phase<EpiIn, pg8::DenseOrder>(F.lds, F.tid, S, E);
            }
            else if (s == 2) { constexpr int abl = (pass == 1) ? PROBE_ABL : 0; if (PH_ON(2) && abl != 5) REP(2, true) swa_flash(F, ap, l, abl); if (PH_ON(12) && abl != 6) REP(12, true) gla_g1(F, l); }
            else if (s == 3) { if (PH_ON(13)) REP(13, true) gla_scan(F); }
            else if (s == 4) { if (PH_ON(3)) REP(3, true) gla_g3(F, ap, l); }
            else if (s == 5 && PH_ON(4)) REP(4, l == 0) {
                pg8::DenseOrder S; S.init(ws + WS_MIX, ws + WS_WOUT + (size_t)l * D * D * 2, l == 0 ? TT : TL, D, D, F.G, (int)blockIdx.x);
                EpiOut E{l == 0 ? ap->in[I_X] : F.out, l == 0 ? ap->in[I_CTX] : (const float*)(ws + WS_XC), F.out, (float*)(ws + WS_XC), (const float*)(ws + WS_MOD) + l * 3 * 6144};
                pg8::gemm_phase<EpiOut, pg8::DenseOrder>(F.lds, F.tid, S, E);
                if (l == 0 && pass == 0) convert_moe_filler(F, ap, 0, S.nwg);
            }
            else if (s == 6) { if (PH_ON(5)) REP(5, true) n2_route_phase(F, ap, l, rep_ == 0 || pass == 1, l + 2 * pass); }
            else { if (PH_ON(6)) { moe1_phase(F, ap, l, l + 2 * pass); moe2_phase(F, ap, l, l + 2 * pass); } }
        }
        if (ph0 + 1 < NPASS * N_PHASES) for (int rb_ = 0; rb_ < (REPEAT_S == 20 ? REPEAT_N : 1); ++rb_) xcd_barrier(bar, F.tid);
}
template <int... I>
__device__ __forceinline__ void run_all(Frame& F, XcdBarrier& bar, LAS unsigned char* lds, int lo, int hi, std::integer_sequence<int, I...>) { (do_phase<I>(F, bar, lds, lo, hi), ...); }

#ifdef VGPR_CAP
__attribute__((amdgpu_num_vgpr(VGPR_CAP)))
#endif
__global__ void __launch_bounds__(NWAVES * 64, 2) mk_fwd(Args args) {
    extern __shared__ __attribute__((aligned(16))) unsigned char lds[];
    Frame F;
    F.lds = (LAS unsigned char*)lds;
    F.tid = threadIdx.x; F.lane = F.tid & 63; F.wave = __builtin_amdgcn_readfirstlane(F.tid >> 6);
    F.G = gridDim.x; { const int bx = blockIdx.x; F.vcu = (F.G % 8 == 0) ? (bx % 8) * (F.G / 8) + bx / 8 : bx; }
    F.gw = F.vcu * NWAVES + F.wave; F.NGW = F.G * NWAVES;
    const CAS Args* ap = (const CAS Args*)__builtin_amdgcn_kernarg_segment_ptr();
    F.ws = ap->ws; F.out = ap->out;
    volatile LAS unsigned* MISC = (volatile LAS unsigned*)(F.lds + MISC_OFF);
    for (int u = F.tid; u < (LDS_BYTES - LDSCTL_OFF) / 4; u += NWAVES * 64) ((LAS unsigned*)(F.lds + LDSCTL_OFF))[u] = 0u;
    __syncthreads();
    XcdBarrier bar; bar.bar = (unsigned*)(F.ws + WS_CTL) + CW_BAR; bar.x = 0; bar.st = nullptr;
    const bool fused = (ap->ph_hi - ap->ph_lo) > 1;
    if (fused) bar = xcd_barrier_post((unsigned*)(F.ws + WS_CTL) + CW_BAR, MISC + 8);
    const int lo = ap->ph_lo, hi = ap->ph_hi;
    run_all(F, bar, (LAS unsigned char*)lds, lo, hi, std::make_integer_sequence<int, NPASS * N_PHASES>{});
}

extern "C" void kernel_launch(void* const* d_in, const int* in_sizes, int n_in, void* d_out, int out_size, void* d_ws, size_t ws_size, hipStream_t stream) {
    static int grid = 0;
    if (grid == 0) {
        if (n_in != 22 || out_size != TL * D || ws_size < WS_END) { fprintf(stderr, "kernel_launch: unexpected shapes (n_in %d out %d ws %zu)\n", n_in, out_size, ws_size); grid = -1; return; }
        int dev = 0, cus = 0, per_cu = 0;
        if (hipGetDevice(&dev) != hipSuccess || hipDeviceGetAttribute(&cus, hipDeviceAttributeMultiprocessorCount, dev) != hipSuccess) { grid = -1; return; }
        if (hipFuncSetAttribute((const void*)mk_fwd, hipFuncAttributeMaxDynamicSharedMemorySize, LDS_BYTES) != hipSuccess) { fprintf(stderr, "kernel_launch: hipFuncSetAttribute failed\n"); grid = -1; return; }
        if (hipOccupancyMaxActiveBlocksPerMultiprocessor(&per_cu, (const void*)mk_fwd, NWAVES * 64, LDS_BYTES) != hipSuccess || per_cu < 1) fprintf(stderr, "kernel_launch: occupancy query says %d\n", per_cu);
        (void)hipGetLastError();
        grid = cus;
    }
    if (grid < 0) return;
    (void)hipMemsetAsync((char*)d_ws + WS_CTL, 0, CTL_ZERO_BYTES, stream);
    Args a{};
    for (int i = 0; i < 22; ++i) a.in[i] = (const float*)d_in[i];
    a.out = (float*)d_out; a.ws = (unsigned char*)d_ws; a.li = 0; a.pad = 0;
#if MK_N_LAUNCHES == 1
    a.ph_lo = 0; a.ph_hi = N_PHASES;
    hipLaunchKernelGGL(mk_fwd, dim3(grid), dim3(NWAVES * 64), LDS_BYTES, stream, a);
#else
    for (int ph = 0; ph < N_PHASES; ++ph) { a.ph_lo = ph; a.ph_hi = ph + 1; hipLaunchKernelGGL(mk_fwd, dim3(grid), dim3(NWAVES * 64), LDS_BYTES, stream, a); }
#endif
}
```

```cpp
#include <hip/hip_runtime.h>
#include <cstdio>
#include <cstdint>
#include <utility>

#ifndef ONLY_S
#define ONLY_S -1
#endif
#define PH_ON(k) (ONLY_S < 0 || ONLY_S == (k))
#ifndef REPEAT_S
#define REPEAT_S -1
#endif
#ifndef REPEAT_N
#define REPEAT_N 4
#endif
#define REP(k, cond) for (int rep_ = 0; rep_ < ((pass == 1) ? PROBE_R : ((REPEAT_S == (k) && (cond)) ? REPEAT_N : 1)); ++rep_)
#ifndef MK_N_LAUNCHES
#define MK_N_LAUNCHES 1
#endif

#define GAS __attribute__((address_space(1)))
#define LAS __attribute__((address_space(3)))
#define CAS __attribute__((address_space(4)))
typedef unsigned short bf16;
typedef short bf16x8 __attribute__((ext_vector_type(8)));
typedef float f32x4 __attribute__((ext_vector_type(4)));
typedef float f32x2 __attribute__((ext_vector_type(2)));
typedef unsigned u32x4 __attribute__((ext_vector_type(4)));
typedef unsigned u32x2 __attribute__((ext_vector_type(2)));
typedef int v8i __attribute__((ext_vector_type(8)));

constexpr int D = 1024, SEQ = 8192, LC = 256, TL = 16384, TC = 512, TT = TL + TC, DEPTH = 2;
constexpr int NE = 16, DE = 512;
constexpr int NIN = 2816;
constexpr int PC_Q = 0, PC_K = 256, PC_V = 512, PC_G = 1024, PC_SQ = 1536, PC_SK = 2048, PC_SV = 2176, PC_GF = 2304, PC_GB = 2560;
constexpr int WIN_COLS = 2336;
constexpr float EPS = 1e-6f;
constexpr float LOG2E = 1.4426950408889634f, QSCALE = 0.125f * LOG2E;
constexpr int LISTCAP = TT;

constexpr size_t MiB = 1u << 20;
constexpr size_t WS_CTL = 0, CTL_ZERO_BYTES = 131072;
constexpr size_t WS_MOD = 1 * MiB;
constexpr size_t WS_ROPE = 1 * MiB + 256 * 1024;
constexpr size_t WS_LIST = 2 * MiB;
constexpr size_t WS_LISTW = 2 * MiB + 1536 * 1024;
constexpr size_t WS_XC = 5 * MiB;
constexpr size_t WS_WIN = 8 * MiB;
constexpr size_t WS_WOUT = 19 * MiB;
constexpr size_t WS_WGU = 23 * MiB;
constexpr size_t WS_WD = 87 * MiB;
constexpr size_t WS_H = 119 * MiB;
constexpr size_t WS_P = 152 * MiB;
constexpr size_t WS_MIX = 243 * MiB;
constexpr size_t WS_GL = 276 * MiB;
constexpr size_t WS_HMID = 152 * MiB;
constexpr size_t WS_Y = 190 * MiB;
constexpr size_t WS_END = 309 * MiB;
static_assert(WS_LIST + (size_t)NE * LISTCAP * 4 <= WS_LISTW && WS_LISTW + (size_t)NE * LISTCAP * 4 <= WS_XC, "ws map");
static_assert(WS_P + (size_t)TT * NIN * 2 <= WS_MIX && WS_MIX + (size_t)TT * D * 2 <= WS_GL, "ws map");
static_assert(WS_HMID + (size_t)37888 * 512 * 2 <= WS_Y && WS_Y + (size_t)2 * TT * D * 2 <= WS_GL, "ws map");
constexpr int CW_CNT = 8192, CNT_STRIDE = 64;
constexpr int CW_TDONE = 16384;
constexpr int CW_BAR = 4096;

__device__ __forceinline__ unsigned f2bf(float f) { unsigned u = __builtin_bit_cast(unsigned, f); return (u + 0x7fffu + ((u >> 16) & 1u)) >> 16; }
__device__ __forceinline__ unsigned pk2(float lo, float hi) { return f2bf(lo) | (f2bf(hi) << 16); }
__device__ __forceinline__ float bf2f(unsigned h) { return __builtin_bit_cast(float, h << 16); }
__device__ __forceinline__ float bflo(unsigned w) { return __builtin_bit_cast(float, w << 16); }
__device__ __forceinline__ float bfhi(unsigned w) { return __builtin_bit_cast(float, w & 0xffff0000u); }
__device__ __forceinline__ float dpp_add(float v, float t) { return v + t; }
#define DPP_F(v, ctrl, rmask) __builtin_bit_cast(float, __builtin_amdgcn_update_dpp(0, __builtin_bit_cast(int, (v)), (ctrl), (rmask), 0xF, false))
__device__ __forceinline__ float row16_sum(float v) {
    v += DPP_F(v, 0xB1, 0xF); v += DPP_F(v, 0x4E, 0xF); v += DPP_F(v, 0x141, 0xF); v += DPP_F(v, 0x140, 0xF); return v;
}
__device__ __forceinline__ float wave_sum(float v) {
    v = row16_sum(v);
    v += DPP_F(v, 0x142, 0xA); v += DPP_F(v, 0x143, 0xC);
    return __builtin_bit_cast(float, __builtin_amdgcn_readlane(__builtin_bit_cast(int, v), 63));
}
__device__ __forceinline__ float silu_f(float x) { return x / (1.0f + __expf(-x)); }
__device__ __forceinline__ unsigned pk4_fp8(float a, float b, float c, float d) {
    a = fminf(fmaxf(a, -448.f), 448.f); b = fminf(fmaxf(b, -448.f), 448.f); c = fminf(fmaxf(c, -448.f), 448.f); d = fminf(fmaxf(d, -448.f), 448.f);
    int w = __builtin_amdgcn_cvt_pk_fp8_f32(a, b, 0, false); w = __builtin_amdgcn_cvt_pk_fp8_f32(c, d, w, true); return (unsigned)w;
}
constexpr float W1_SCALE = 64.f, W2_SCALE = 32.f, HMID_SCALE = 4.f;
constexpr int SC_ONE = 127, SC_W1 = 121, SC_W2 = 122, SC_HMID = 125;
#define LDS_WAIT() asm volatile("s_waitcnt lgkmcnt(0)" ::: "memory")
#define VM_WAIT() asm volatile("s_waitcnt vmcnt(0)" ::: "memory")

namespace pg8 {
constexpr int BM = 256, BK = 64, HALF = 128, HTB = HALF * BK * 2, STAGE_BYTES = 8 * HTB, NXCD = 8, WGM = 8;
__host__ __device__ __forceinline__ int lds_byte(int r, int c) { const int st = (r >> 4) * 2 + (c >> 5), rr = r & 15, cc = c & 31, ob = rr * 64 + cc * 2; return st * 1024 + (ob ^ (((ob >> 9) & 1) << 5)); }
__host__ __device__ __forceinline__ void stage_rc(int b, int& R, int& C) { const int st = b / 1024, sb = b % 1024, swz = sb ^ (((sb >> 9) & 1) << 5); R = (st >> 1) * 16 + swz / 64; C = (st & 1) * 32 + (swz % 64) / 2; }
__host__ __device__ __forceinline__ int perm32(int rho) { const int n = rho >> 4, i = rho & 15; return 8 * (i >> 2) + 4 * n + (i & 3); }

struct Unit { int pm, pn, e, mt; };

__device__ __forceinline__ int xcd_remap(int wgid, int nwg) { const int q = nwg / NXCD, r = nwg % NXCD, xcd = wgid % NXCD, off = wgid / NXCD; return (xcd < r ? xcd * (q + 1) : r * (q + 1) + (xcd - r) * q) + off; }

struct DenseOrder {
    static constexpr bool DYN_A = false;
    const char* A; const char* Bt; int K; int nM, nN, nwg, G, c;
    __device__ void init(const void* A_, const void* Bt_, int M, int N, int K_, int G_, int c_) { A = (const char*)A_; Bt = (const char*)Bt_; K = K_; nM = M / BM; nN = N / BM; nwg = nM * nN; G = G_; c = c_; }
    __device__ __forceinline__ bool next(int i, Unit& u) const {
        const long L = (long)i * G + c; if (L >= nwg) return false;
        const int wgid = xcd_remap((int)L, nwg);
        const int nig = WGM * nN, gid = wgid / nig, fm = gid * WGM, gsz = (nM - fm) < WGM ? (nM - fm) : WGM;
        u.pm = fm + ((wgid % nig) % gsz); u.pn = (wgid % nig) / gsz; u.e = 0; u.mt = 0; return true;
    }
    __device__ __forceinline__ void a_ready(const Unit&, int) const {}
    __device__ __forceinline__ void done(const Unit&, int) const {}
    __device__ __forceinline__ const char* a_ptr(const Unit& u) const { return A + (size_t)u.pm * (size_t)(BM * K * 2); }
    __device__ __forceinline__ const char* b_ptr(const Unit& u) const { return Bt + (size_t)u.pn * (size_t)(BM * K * 2); }
    __device__ __forceinline__ void a_voff(const Unit&, const int (&R)[2], const int (&C)[2], unsigned (&v0)[2], unsigned (&v1)[2]) const {
#pragma unroll
        for (int i = 0; i < 2; ++i) { v0[i] = (unsigned)(R[i] * K + C[i]) * 2u; v1[i] = v0[i] + (unsigned)(HALF * K * 2); }
    }
};

struct MoeOrder {
    static constexpr bool DYN_A = true;
    const char* A; const char* Bt; int K; size_t bstride_e; int G, c, nunits, nN; bool gather;
    const unsigned* list; const LAS int* tab;
    unsigned* tdone; int role;
    __device__ __forceinline__ void a_ready(const Unit& u, int wid) const {
        if (role == 2) {
            if (wid == 0) { unsigned sp = 0;
                while (__hip_atomic_load(tdone + u.pm * 16, __ATOMIC_RELAXED, __HIP_MEMORY_SCOPE_AGENT) < 32u) { __builtin_amdgcn_s_sleep(2); if (++sp > (1u << 22)) break; }
                __builtin_amdgcn_fence(__ATOMIC_ACQUIRE, "agent"); asm volatile("s_waitcnt vmcnt(0)" ::: "memory"); }
            __builtin_amdgcn_s_barrier();
        }
    }
    __device__ __forceinline__ void done(const Unit& u, int lane) const {
        if (role == 1) { asm volatile("s_waitcnt vmcnt(0)" ::: "memory");
            if (lane == 0) __hip_atomic_fetch_add(tdone + u.pm * 16, 1u, __ATOMIC_RELAXED, __HIP_MEMORY_SCOPE_AGENT); }
    }
    __device__ __forceinline__ bool next(int i, Unit& u) const {
        const long L = (long)i * G + c; if (L >= nunits) return false;
        const int wgid = xcd_remap((int)L, nunits);
        const int tl = wgid / nN; u.pn = wgid % nN;
        int e = 0, tstart = 0;
#pragma unroll 1
        for (int k = 0; k < NE - 1; ++k) { const int te = tab[16 + k]; if (tl >= te) { e = k + 1; tstart = te; } }
        u.e = __builtin_amdgcn_readfirstlane(e); u.mt = __builtin_amdgcn_readfirstlane(tl - tstart); u.pm = tl; return true;
    }
    __device__ __forceinline__ const char* a_ptr(const Unit& u) const { return gather ? A : A + (size_t)u.pm * (size_t)(BM * K * 2); }
    __device__ __forceinline__ const char* b_ptr(const Unit& u) const { return Bt + (size_t)u.e * bstride_e + (size_t)u.pn * (size_t)(BM * K * 2); }
    __device__ __forceinline__ void a_voff(const Unit& u, const int (&R)[2], const int (&C)[2], unsigned (&v0)[2], unsigned (&v1)[2]) const {
        if (gather) {
            const int ce = tab[u.e];
            const unsigned* lp = list + (size_t)u.e * LISTCAP + u.mt * BM;
#pragma unroll
            for (int i = 0; i < 2; ++i) {
                const int r0 = R[i], r1 = R[i] + HALF;
                const unsigned t0 = (u.mt * BM + r0 < ce) ? (__builtin_nontemporal_load(lp + r0) >> 1) : 0u;
                const unsigned t1 = (u.mt * BM + r1 < ce) ? (__builtin_nontemporal_load(lp + r1) >> 1) : 0u;
                v0[i] = (t0 * (unsigned)K + (unsigned)C[i]) * 2u; v1[i] = (t1 * (unsigned)K + (unsigned)C[i]) * 2u;
            }
        } else {
#pragma unroll
            for (int i = 0; i < 2; ++i) { v0[i] = (unsigned)(R[i] * K + C[i]) * 2u; v1[i] = v0[i] + (unsigned)(HALF * K * 2); }
        }
    }
};

__device__ __forceinline__ unsigned cvt_pk_bf16(float lo, float hi) { unsigned r; asm volatile("v_cvt_pk_bf16_f32 %0, %1, %2" : "=v"(r) : "v"(lo), "v"(hi)); return r; }

template <class Epi, class Sched, bool F8 = false>
__device__ __forceinline__ void gemm_phase(LAS unsigned char* lds, int tid, const Sched& S, const Epi& E, int sc_w = 127, int sc_a = 127) {
    const int wid = __builtin_amdgcn_readfirstlane(tid >> 6), lane = tid & 63, wr = wid >> 2, wc = wid & 3, fr = lane & 15, fq = lane >> 4;
    const int K = S.K, nt = K / BK;
    int Rr[2], Cc[2]; unsigned voffB[2];
#pragma unroll
    for (int i = 0; i < 2; ++i) { int R, C; stage_rc(tid * 16 + i * 8192, R, C); const int Rb = Epi::PERM ? ((R & ~31) + perm32(R & 31)) : R;
        Rr[i] = R; Cc[i] = C; voffB[i] = (unsigned)(Rb * K + C) * 2u; }
    const size_t kstep = (size_t)(BK * 2);
    const size_t hstep = (size_t)HALF * K * 2;
    const unsigned ldsw = (unsigned)wid * 1024u;
    const int aoff = lds_byte(wr * 64 + fr, fq * 8), boff = lds_byte(wc * 32 + fr, fq * 8);
#define PG8_SA(b, h) (((b) * 2 + (h)) * HTB)
#define PG8_SB(b, h) ((4 + (b) * 2 + (h)) * HTB)
#define PG8_STAGE(bufoff, gbase, voff) do { _Pragma("unroll") for (int _i = 0; _i < 2; ++_i) \
        __builtin_amdgcn_global_load_lds((const unsigned*)((const char*)(gbase) + (voff)[_i]), (LAS unsigned*)(lds + (bufoff) + ldsw + _i * 8192), 16, 0, 0); } while (0)
#define PG8_CAT(lo_, hi_) ((v8i){(int)(lo_).x, (int)(lo_).y, (int)(lo_).z, (int)(lo_).w, (int)(hi_).x, (int)(hi_).y, (int)(hi_).z, (int)(hi_).w})
#define PG8_LDA(dst, b, h) do { _Pragma("unroll") for (int m = 0; m < 4; ++m) { if constexpr (F8) { const u32x4 l_ = *(const LAS u32x4*)(lds + PG8_SA(b, h) + aoff + m * 2048), h_ = *(const LAS u32x4*)(lds + PG8_SA(b, h) + aoff + m * 2048 + 1024); dst##8[m] = PG8_CAT(l_, h_); } \
        else { _Pragma("unroll") for (int k = 0; k < 2; ++k) dst[m][k] = *(const LAS bf16x8*)(lds + PG8_SA(b, h) + aoff + m * 2048 + k * 1024); } } } while (0)
#define PG8_LDB(dst, b, h) do { _Pragma("unroll") for (int n = 0; n < 2; ++n) { if constexpr (F8) { const u32x4 l_ = *(const LAS u32x4*)(lds + PG8_SB(b, h) + boff + n * 2048), h_ = *(const LAS u32x4*)(lds + PG8_SB(b, h) + boff + n * 2048 + 1024); dst##8[n] = PG8_CAT(l_, h_); } \
        else { _Pragma("unroll") for (int k = 0; k < 2; ++k) dst[n][k] = *(const LAS bf16x8*)(lds + PG8_SB(b, h) + boff + n * 2048 + k * 1024); } } } while (0)
#define PG8_MMA(ai, bj, At, Bt) do { __builtin_amdgcn_s_setprio(1); _Pragma("unroll") for (int m = 0; m < 4; ++m) _Pragma("unroll") for (int n = 0; n < 2; ++n) { \
        if constexpr (F8) asm volatile("v_mfma_scale_f32_16x16x128_f8f6f4 %0, %1, %2, %0, %3, %4 op_sel_hi:[0,0,0]" : "+v"(acc[ai][bj][m][n]) : "v"(Bt##8[n]), "v"(At##8[m]), "v"(sc_w), "v"(sc_a)); \
        else { _Pragma("unroll") for (int k = 0; k < 2; ++k) acc[ai][bj][m][n] = __builtin_amdgcn_mfma_f32_16x16x32_bf16(Bt[n][k], At[m][k], acc[ai][bj][m][n], 0, 0, 0); } } \
        __builtin_amdgcn_s_setprio(0); } while (0)
#define PG8_WAIT_V(n) asm volatile("s_waitcnt vmcnt(" #n ")" ::: "memory")
#define PG8_WAIT_L(n) asm volatile("s_waitcnt lgkmcnt(" #n ")" ::: "memory")
#define PG8_BAR __builtin_amdgcn_s_barrier()
#define PG8_SCHED __builtin_amdgcn_sched_barrier(0)
    Unit cur, nxt; int ui = 0;
    if (!S.next(0, cur)) return;
    f32x4 acc[2][2][4][2];
#pragma unroll
    for (int a = 0; a < 2; ++a)
#pragma unroll
        for (int b = 0; b < 2; ++b)
#pragma unroll
            for (int m = 0; m < 4; ++m)
#pragma unroll
                for (int n = 0; n < 2; ++n) acc[a][b][m][n] = (f32x4){0.f, 0.f, 0.f, 0.f};
    bf16x8 At[4][2], B0[2][2], B1[2][2]; v8i At8[4], B08[2], B18[2];
    const char* cA = S.a_ptr(cur); const char* cB = S.b_ptr(cur);
    unsigned cv0[2], cv1[2], nv0[2], nv1[2];
    S.a_ready(cur, wid);
    S.a_voff(cur, Rr, Cc, cv0, cv1);
    PG8_STAGE(PG8_SB(0, 0), cB, voffB); PG8_STAGE(PG8_SB(0, 1), cB + hstep, voffB); PG8_STAGE(PG8_SA(0, 0), cA, cv0); PG8_STAGE(PG8_SA(0, 1), cA, cv1);
    if (wr == 1) PG8_BAR;
    PG8_WAIT_V(2); PG8_BAR;
    PG8_STAGE(PG8_SB(1, 0), cB + kstep, voffB); PG8_STAGE(PG8_SA(1, 0), cA + kstep, cv0); PG8_STAGE(PG8_SB(1, 1), cB + hstep + kstep, voffB);
    PG8_WAIT_V(6); PG8_BAR;
    for (;;) {
        const bool has_next = S.next(ui + 1, nxt);
        const char* nA = has_next ? S.a_ptr(nxt) : cA; const char* nB = has_next ? S.b_ptr(nxt) : cB;
        if (has_next) S.a_voff(nxt, Rr, Cc, nv0, nv1); else { nv0[0] = cv0[0]; nv0[1] = cv0[1]; nv1[0] = cv1[0]; nv1[1] = cv1[1]; }
        if constexpr (Sched::DYN_A) asm volatile("" : "+v"(nv0[0]), "+v"(nv0[1]), "+v"(nv1[0]), "+v"(nv1[1]));
        for (int t = 0; t < nt; t += 2) {
            const bool last = (t == nt - 2);
            if (last && has_next) S.a_ready(nxt, wid);
            const char* a1 = cA + (size_t)(t + 1) * kstep;
            const char* a2 = last ? nA : cA + (size_t)(t + 2) * kstep; const char* b2 = last ? nB : cB + (size_t)(t + 2) * kstep;
            const char* a3 = a2 + kstep; const char* b3 = b2 + kstep;
            unsigned w0[2], w1[2];
            w0[0] = last ? nv0[0] : cv0[0]; w0[1] = last ? nv0[1] : cv0[1]; w1[0] = last ? nv1[0] : cv1[0]; w1[1] = last ? nv1[1] : cv1[1];
            PG8_LDB(B0, 0, 0); PG8_LDB(B1, 0, 1); PG8_SCHED; PG8_LDA(At, 0, 0); PG8_STAGE(PG8_SA(1, 1), a1, cv1);
            PG8_WAIT_V(8); PG8_WAIT_L(0); PG8_BAR; PG8_MMA(0, 0, At, B0); PG8_MMA(0, 1, At, B1); PG8_BAR; PG8_SCHED;
            PG8_LDA(At, 0, 1); PG8_STAGE(PG8_SB(0, 0), b2, voffB); PG8_STAGE(PG8_SB(0, 1), b2 + hstep, voffB); PG8_STAGE(PG8_SA(0, 0), a2, w0);
            PG8_WAIT_V(8); PG8_WAIT_L(0); PG8_BAR; PG8_MMA(1, 0, At, B0); PG8_MMA(1, 1, At, B1); PG8_BAR; PG8_SCHED;
            PG8_LDB(B0, 1, 0); PG8_LDB(B1, 1, 1); PG8_SCHED; PG8_LDA(At, 1, 0); PG8_STAGE(PG8_SA(0, 1), a2, w1);
            PG8_WAIT_V(8); PG8_WAIT_L(0); PG8_BAR; PG8_MMA(0, 0, At, B0); PG8_MMA(0, 1, At, B1); PG8_BAR; PG8_SCHED;
            PG8_LDA(At, 1, 1); PG8_STAGE(PG8_SB(1, 0), b3, voffB); PG8_STAGE(PG8_SB(1, 1), b3 + hstep, voffB); PG8_STAGE(PG8_SA(1, 0), a3, w0);
            PG8_WAIT_V(8); PG8_WAIT_L(0); PG8_BAR; PG8_MMA(1, 0, At, B0); PG8_MMA(1, 1, At, B1); PG8_BAR; PG8_SCHED;
        }
        if constexpr (F8) asm volatile("s_nop 15\n\ts_nop 15" ::: "memory");
        if (wr == 0) PG8_BAR;
        E(acc, cur, wr, wc, fr, fq);
        S.done(cur, lane);
        if (!has_next) break;
#pragma unroll
        for (int a = 0; a < 2; ++a)
#pragma unroll
            for (int b = 0; b < 2; ++b)
#pragma unroll
                for (int m = 0; m < 4; ++m)
#pragma unroll
                    for (int n = 0; n < 2; ++n) acc[a][b][m][n] = (f32x4){0.f, 0.f, 0.f, 0.f};
        cur = nxt; cA = nA; cB = nB; ++ui;
        cv0[0] = nv0[0]; cv0[1] = nv0[1]; cv1[0] = nv1[0]; cv1[1] = nv1[1];
        if (wr == 1) PG8_BAR;
    }
    PG8_WAIT_V(0);
    PG8_BAR;
#undef PG8_SA
#undef PG8_SB
#undef PG8_STAGE
#undef PG8_CAT
#undef PG8_LDA
#undef PG8_LDB
#undef PG8_MMA
#undef PG8_WAIT_V
#undef PG8_WAIT_L
#undef PG8_BAR
#undef PG8_SCHED
}
}

#define XB_TMO      128
#define XB_XCNT(j)  (256  + 64 * (j))
#define XB_XSUB(j)  (1280 + 64 * (j))
#define XB_XGEN(j)  (2304 + 64 * (j))
#define XB_TOP      3328
#define XB_TOPGEN   3392
#define XCD_BAR_WORDS 3456
#define XB_SPIN_CAP (1u << 18)
__device__ __forceinline__ unsigned xb_ld(unsigned* p)              { return __hip_atomic_load(p, __ATOMIC_RELAXED, __HIP_MEMORY_SCOPE_AGENT); }
__device__ __forceinline__ unsigned xb_add(unsigned* p, unsigned v) { return __hip_atomic_fetch_add(p, v, __ATOMIC_RELAXED, __HIP_MEMORY_SCOPE_AGENT); }
__device__ __forceinline__ unsigned xb_xcc_id() { return (unsigned)__builtin_amdgcn_s_getreg((3 << 11) | 20) & 0xFu; }
#define XB_SPIN(cond, bar) do { unsigned _sp = 0; while (cond) { __builtin_amdgcn_s_sleep(1); \
    if ((++_sp & 255u) == 0u) { if (xb_ld(&(bar)[XB_TMO])) break; if (_sp > XB_SPIN_CAP) { atomicAdd(&(bar)[XB_TMO], 1u); break; } } } } while (0)
struct XcdBarrier { unsigned* bar; unsigned x; volatile LAS unsigned* st; };
__device__ __forceinline__ XcdBarrier xcd_barrier_post(unsigned* bar, volatile LAS unsigned* st) {
    XcdBarrier b; b.bar = bar; b.x = xb_xcc_id(); b.st = st;
    if (threadIdx.x == 0) (void)xb_add(&bar[XB_XCNT(b.x)], 1u);
    return b;
}
__device__ __forceinline__ void xcd_barrier_complete(unsigned* bar, unsigned x, unsigned& nloc, unsigned& nx) {
    const unsigned G = gridDim.x * gridDim.y * gridDim.z;
    unsigned sum, cnt, mine, sp = 0u;
    for (;;) {
        sum = 0u; cnt = 0u; mine = 0u;
#pragma unroll
        for (unsigned j = 0; j < 16; ++j) { const unsigned c = xb_ld(&bar[XB_XCNT(j)]); sum += c; cnt += (c > 0u) ? 1u : 0u; mine = (j == x) ? c : mine; }
        if (sum == G) break;
        __builtin_amdgcn_s_sleep(1);
        if ((++sp & 255u) == 0u) { if (xb_ld(&bar[XB_TMO])) break; if (sp > XB_SPIN_CAP) { atomicAdd(&bar[XB_TMO], 1u); break; } }
    }
    nloc = mine > 0u ? mine : 1u; nx = cnt > 0u ? cnt : 1u;
}
__device__ __forceinline__ void xcd_barrier(const XcdBarrier& b, int tid) {
    asm volatile("s_waitcnt vmcnt(0)" ::: "memory");
    __syncthreads();
    if (tid == 0) {
        unsigned* bar = b.bar;
        __builtin_amdgcn_s_waitcnt(0);
        unsigned nloc = b.st[0], nx = b.st[1];
        if (nloc == 0u) { xcd_barrier_complete(bar, b.x, nloc, nx); b.st[0] = nloc; b.st[1] = nx; }
        const unsigned old = xb_add(&bar[XB_XSUB(b.x)], 1u);
        const unsigned gen = old / nloc;
        if (old + 1u == (gen + 1u) * nloc) {
            __builtin_amdgcn_fence(__ATOMIC_RELEASE, "agent");
            asm volatile("s_waitcnt vmcnt(0)" ::: "memory");
            const unsigned og = xb_add(&bar[XB_TOP], 1u);
            const unsigned tg = og / nx;
            if (og + 1u == (tg + 1u) * nx) xb_add(&bar[XB_TOPGEN], 1u);
            else XB_SPIN(xb_ld(&bar[XB_TOPGEN]) == tg, bar);
            __builtin_amdgcn_fence(__ATOMIC_ACQUIRE, "agent");
            xb_add(&bar[XB_XGEN(b.x)], 1u);
            asm volatile("s_waitcnt vmcnt(0)" ::: "memory");
        } else {
            XB_SPIN(xb_ld(&bar[XB_XGEN(b.x)]) == gen, bar);
            __builtin_amdgcn_fence(__ATOMIC_ACQUIRE, "agent");
            asm volatile("s_waitcnt vmcnt(0)" ::: "memory");
        }
    }
    __syncthreads();
}

constexpr int NWAVES = 8;
constexpr int RING_BYTES = 131072, LDSCTL_OFF = RING_BYTES, MISC_OFF = LDSCTL_OFF + 320, LDS_BYTES = 147456;
struct Args { const float* in[22]; float* out; unsigned char* ws; int ph_lo, ph_hi, li, pad; };
enum { I_X = 0, I_C, I_CTX, I_CCTX, I_WADA, I_BADA, I_NORM1, I_NORM2, I_WIN, I_UPF, I_BIASF, I_UPB, I_BIASB, I_GLANORM, I_SINK, I_WOUT, I_WROUTER, I_BROUTER, I_WGATE, I_WUP, I_WDOWN, I_FNORM };

struct Frame {
    LAS unsigned char* lds; int tid, lane, wave, vcu, G, gw, NGW;
    unsigned char* ws; float* out;
};

__device__ __forceinline__ int rope_pos(int d) { return 8 * ((d & 15) >> 2) + 4 * (d >> 4) + (d & 3); }
__device__ __forceinline__ int gu_row(int h, int gu) { return (h >> 7) * 256 + ((h >> 6) & 1) * 128 + ((h >> 4) & 3) * 32 + ((h >> 2) & 3) * 8 + gu * 4 + (h & 3); }
struct TItem { const float* src; bf16* dst; int N, Kd, n0, rbase, mode; bool ok; float f8scale; };
__device__ __forceinline__ void titem_load(const TItem& t, int lane, f32x4 (&v)[8]) {
    const int g = lane >> 3, i8 = lane & 7;
    const float* src = t.src + (size_t)(8 * g) * t.N + 4 * i8;
#pragma unroll
    for (int q = 0; q < 8; ++q) v[q] = *(const f32x4*)(src + (size_t)q * t.N);
}
__device__ __forceinline__ void titem_store(const TItem& t, int lane, const f32x4 (&v)[8]) {
    const int g = lane >> 3, i8 = lane & 7;
#pragma unroll
    for (int i = 0; i < 4; ++i) {
        const int n = 4 * i8 + i;
        const int row = (t.mode == 0) ? t.rbase + n : (t.mode == 1) ? t.rbase + rope_pos(n) : gu_row(t.n0 + n, t.mode - 2);
        if (t.f8scale != 0.f) {
            const float sc = t.f8scale; u32x2 o; o.x = pk4_fp8(v[0][i] * sc, v[1][i] * sc, v[2][i] * sc, v[3][i] * sc); o.y = pk4_fp8(v[4][i] * sc, v[5][i] * sc, v[6][i] * sc, v[7][i] * sc);
            *(u32x2*)((unsigned char*)t.dst + (size_t)row * t.Kd + 8 * g) = o;
        } else {
            u32x4 o; o.x = pk2(v[0][i], v[1][i]); o.y = pk2(v[2][i], v[3][i]); o.z = pk2(v[4][i], v[5][i]); o.w = pk2(v[6][i], v[7][i]);
            *(u32x4*)(t.dst + (size_t)row * t.Kd + 8 * g) = o;
        }
    }
}
constexpr int IT_IN = 2 * 16 * 73, IT_OUT = 2 * 16 * 32, IT_G = 32 * 16 * 16, IT_D = 32 * 8 * 32, NITEMS = IT_IN + IT_OUT + 2 * IT_G + IT_D;
__device__ __forceinline__ TItem titem_decode(const CAS Args* a, unsigned char* ws, int it) {
    TItem t; t.ok = it < NITEMS; t.mode = 0; t.rbase = 0; t.n0 = 0; t.N = D; t.Kd = D; t.src = nullptr; t.dst = nullptr; t.f8scale = 0.f;
    if (!t.ok) return t;
    int r = it;
    if (r < IT_IN) {
        const int l = r / 1168, rr = r % 1168, kb = rr / 73, nb = rr % 73;
        if (nb == 48) { t.ok = false; return t; }
        const int n0 = nb * 32; t.n0 = n0;
        if (n0 < 1536) t.rbase = n0;
        else if (n0 < 2080) { t.rbase = PC_SQ + (n0 - 1568); t.mode = 1; }
        else if (n0 < 2208) { t.rbase = PC_SK + (n0 - 2080); t.mode = 1; }
        else t.rbase = PC_SV + (n0 - 2208);
        t.N = WIN_COLS; t.Kd = D; t.src = a->in[I_WIN] + (size_t)l * D * WIN_COLS + (size_t)(kb * 64) * WIN_COLS + n0; t.dst = (bf16*)(ws + WS_WIN + (size_t)l * NIN * D + kb * 64); t.f8scale = W1_SCALE;
        return t;
    }
    r -= IT_IN;
    if (r < IT_OUT) { const int l = r / 512, rr = r % 512, kb = rr / 32, nb = rr % 32;
        t.n0 = nb * 32; t.rbase = nb * 32; t.N = D; t.Kd = D; t.src = a->in[I_WOUT] + (size_t)l * D * D + (size_t)(kb * 64) * D + nb * 32; t.dst = (bf16*)(ws + WS_WOUT) + (size_t)l * D * D + kb * 64; return t; }
    r -= IT_OUT;
    if (r < 2 * IT_G) { const int gu = r / IT_G, r2 = r % IT_G, le = r2 / 256, rr = r2 % 256, kb = rr / 16, nb = rr % 16;
        t.n0 = nb * 32; t.mode = 2 + gu; t.N = DE; t.Kd = D; t.src = a->in[gu ? I_WUP : I_WGATE] + (size_t)le * D * DE + (size_t)(kb * 64) * DE + nb * 32; t.dst = (bf16*)(ws + WS_WGU + (size_t)le * D * D + kb * 64); t.f8scale = W1_SCALE; return t; }
    r -= 2 * IT_G;
    { const int le = r / 256, rr = r % 256, kb = rr / 32, nb = rr % 32;
        t.n0 = nb * 32; t.rbase = nb * 32; t.N = D; t.Kd = DE; t.src = a->in[I_WDOWN] + (size_t)le * DE * D + (size_t)(kb * 64) * D + nb * 32; t.dst = (bf16*)(ws + WS_WD + (size_t)le * D * DE + kb * 64); t.f8scale = W2_SCALE; }
    return t;
}

template <class Map>
__device__ __forceinline__ void convert_items(const Frame& F, const CAS Args* a, int n, int worker, int nworkers, Map map) {
    unsigned char* ws = F.ws;
    for (int i = worker; i < n; i += 2 * nworkers) {
        const int i2 = i + nworkers;
        const TItem ta = titem_decode(a, ws, map(i)), tb = titem_decode(a, ws, i2 < n ? map(i2) : NITEMS);
        f32x4 va[8], vb[8];
        if (ta.ok) titem_load(ta, F.lane, va);
        if (tb.ok) titem_load(tb, F.lane, vb);
        if (ta.ok) titem_store(ta, F.lane, va);
        if (tb.ok) titem_store(tb, F.lane, vb);
    }
}
struct MapSmall { __device__ __forceinline__ int operator()(int i) const { return i; } };
struct MapMoe { int l; __device__ __forceinline__ int operator()(int i) const { const int kind = i >> 12, r = i & 4095; return IT_IN + IT_OUT + (kind < 2 ? kind * IT_G : 2 * IT_G) + l * 4096 + r; } };
__device__ __forceinline__ void convert_moe_filler(const Frame& F, const CAS Args* a, int l, int nunits, bool both = false) {
    const int c = (int)blockIdx.x, nfull = nunits % F.G;
    int first = nfull, nf = F.G - nfull - (both ? nfull : 0);
    if (nfull == 0 || nf <= 0) { first = 0; nf = F.G; }
    if (c < first || c >= first + nf) return;
    convert_items(F, a, 3 * 4096, (c - first) * NWAVES + F.wave, nf * NWAVES, MapMoe{l});
}

__device__ __forceinline__ void p0_prologue(const Frame& F, const CAS Args* a) {
    unsigned char* ws = F.ws;
    convert_items(F, a, IT_IN + IT_OUT, F.gw, F.NGW, MapSmall{});
    for (int idx = F.gw * 64 + F.lane; idx < 2 * 2 * 256 * 128; idx += F.NGW * 64) {
        const int kc = idx & 127, n = (idx >> 7) & 255, dir = (idx >> 15) & 1, l = idx >> 16;
        const float* up = a->in[dir ? I_UPB : I_UPF] + (size_t)l * 16 * 256 + n;
        float u[16];
#pragma unroll
        for (int r = 0; r < 16; ++r) u[r] = up[r * 256];
        float o[8];
#pragma unroll
        for (int kk = 0; kk < 8; ++kk) {
            const f32x4* wz = (const f32x4*)(a->in[I_WIN] + ((size_t)l * D + kc * 8 + kk) * WIN_COLS + 1536 + dir * 16);
            float s = 0.f;
#pragma unroll
            for (int q = 0; q < 4; ++q) { const f32x4 w = wz[q]; s += w[0] * u[4 * q] + w[1] * u[4 * q + 1] + w[2] * u[4 * q + 2] + w[3] * u[4 * q + 3]; }
            o[kk] = s;
        }
        u32x2 ov; ov.x = pk4_fp8(o[0] * W1_SCALE, o[1] * W1_SCALE, o[2] * W1_SCALE, o[3] * W1_SCALE); ov.y = pk4_fp8(o[4] * W1_SCALE, o[5] * W1_SCALE, o[6] * W1_SCALE, o[7] * W1_SCALE);
        *(u32x2*)(ws + WS_WIN + ((size_t)l * NIN + PC_GF + dir * 256 + n) * D + kc * 8) = ov;
    }
    if (blockIdx.x == (unsigned)(F.G - 1)) {
        float* tc = (float*)(ws + WS_ROPE); float* tsn = tc + 2048;
        for (int i = F.tid; i < 2048; i += NWAVES * 64) { const int pos = i >> 4, j = i & 15; const float inv = powf(10000.0f, -(float)j * (1.0f / 16.0f)); const float ang = (float)pos * inv;
            tc[i] = cosf(ang); tsn[i] = sinf(ang); }
    }
    __syncthreads();
    {
        LAS float* cs = (LAS float*)F.lds; LAS float* red = cs + 3072;
        for (int i = F.tid; i < 3072; i += NWAVES * 64) { const int v = i >> 10, k = i & 1023; const float cv = v < 2 ? a->in[I_C][v * D + k] : a->in[I_CCTX][k]; cs[i] = cv / (1.0f + expf(-cv)); }
        __syncthreads();
        for (int u = blockIdx.x; u < 192; u += F.G) {
            const int l = u / 96, jg = u % 96, jl = F.tid & 63, ks = F.tid >> 6;
            const float* wp = a->in[I_WADA] + ((size_t)l * D + ks * 128) * 6144 + jg * 64 + jl;
            float a0 = 0.f, a1 = 0.f, a2 = 0.f;
#pragma unroll 1
            for (int k0 = 0; k0 < 128; k0 += 32) {
                float wv[32];
#pragma unroll
                for (int k = 0; k < 32; ++k) wv[k] = wp[(size_t)(k0 + k) * 6144];
#pragma unroll
                for (int k = 0; k < 32; ++k) { const int kk = ks * 128 + k0 + k; a0 += cs[kk] * wv[k]; a1 += cs[1024 + kk] * wv[k]; a2 += cs[2048 + kk] * wv[k]; }
            }
            red[(ks * 3 + 0) * 64 + jl] = a0; red[(ks * 3 + 1) * 64 + jl] = a1; red[(ks * 3 + 2) * 64 + jl] = a2;
            __syncthreads();
            if (F.tid < 192) { const int v = F.tid >> 6, j2 = F.tid & 63; float s = 0.f;
#pragma unroll
                for (int q = 0; q < 8; ++q) s += red[(q * 3 + v) * 64 + j2];
                ((float*)(ws + WS_MOD))[(l * 3 + v) * 6144 + jg * 64 + j2] = s + a->in[I_BADA][l * 6144 + jg * 64 + j2]; }
            __syncthreads();
        }
    }
}

__device__ __forceinline__ f32x4 ld_y4(const bf16* p) { const u32x2 w = *(const u32x2*)p; return (f32x4){bflo(w.x), bfhi(w.x), bflo(w.y), bfhi(w.y)}; }
__device__ __forceinline__ void n1_load(const Frame& F, const CAS Args* a, int l, int m, f32x4 (&x)[4], f32x4 (&y)[4]) {
    unsigned char* ws = F.ws;
    const bf16* Y0 = (const bf16*)(ws + WS_Y); const bf16* Y1 = Y0 + (size_t)TT * D;
    const float* src = (l == 0) ? (m < TL ? a->in[I_X] + (size_t)m * D : a->in[I_CTX] + (size_t)(m - TL) * D) : (m < TL ? F.out + (size_t)m * D : (const float*)(ws + WS_XC) + (size_t)(m - TL) * D);
#pragma unroll
    for (int j = 0; j < 4; ++j) { const int col = 4 * F.lane + 256 * j; x[j] = *(const f32x4*)(src + col);
        if (l > 0) y[j] = ld_y4(Y0 + (size_t)m * D + col) + ld_y4(Y1 + (size_t)m * D + col); }
}
__device__ __forceinline__ void n1_row(const Frame& F, const CAS Args* a, int l, int m, f32x4 (&x)[4], const f32x4 (&y)[4]) {
    unsigned char* ws = F.ws;
    const float* mod = (const float*)(ws + WS_MOD);
    bf16* H = (bf16*)(ws + WS_H);
    const int v = m < TL ? (m >> 13) : 2;
    float* xrow = m < TL ? F.out + (size_t)m * D : (float*)(ws + WS_XC) + (size_t)(m - TL) * D;
    float ss = 0.f;
#pragma unroll
    for (int j = 0; j < 4; ++j) {
        const int col = 4 * F.lane + 256 * j;
        if (l > 0) { const f32x4 g2 = *(const f32x4*)(mod + ((l - 1) * 3 + v) * 6144 + 5 * D + col); x[j] = x[j] + g2 * y[j]; *(f32x4*)(xrow + col) = x[j]; }
        ss += (x[j][0] * x[j][0] + x[j][1] * x[j][1]) + (x[j][2] * x[j][2] + x[j][3] * x[j][3]);
    }
    const float rstd = 1.0f / sqrtf(wave_sum(ss) * (1.0f / D) + EPS);
#pragma unroll
    for (int j = 0; j < 4; ++j) {
        const int col = 4 * F.lane + 256 * j;
        const f32x4 nw = *(const f32x4*)(a->in[I_NORM1] + l * D + col);
        const f32x4 sh = *(const f32x4*)(mod + (l * 3 + v) * 6144 + 0 * D + col);
        const f32x4 sc = *(const f32x4*)(mod + (l * 3 + v) * 6144 + 1 * D + col);
        const f32x4 h = x[j] * rstd * nw * (1.0f + sc) + sh;
        *(unsigned*)((unsigned char*)H + (size_t)m * D + col) = pk4_fp8(h[0], h[1], h[2], h[3]);
    }
}
__device__ __forceinline__ void n1_phase(const Frame& F, const CAS Args* a, int l) {
    for (int m = F.gw; m < TT; m += 2 * F.NGW) {
        const int m2 = m + F.NGW; const bool two = m2 < TT;
        f32x4 xa[4], ya[4], xb[4], yb[4];
        n1_load(F, a, l, m, xa, ya);
        if (two) n1_load(F, a, l, m2, xb, yb);
        n1_row(F, a, l, m, xa, ya);
        if (two) n1_row(F, a, l, m2, xb, yb);
    }
}

struct EpiIn {
    static constexpr bool PERM = true;
    bf16* P; const float* bias_f; const float* bias_b; const float* tcos; const float* tsin;
    __device__ __forceinline__ void operator()(const f32x4 (&acc)[2][2][4][2], const pg8::Unit& u, int wr, int wc, int fr, int fq) const {
        const int row0 = u.pm * 256 + wr * 64 + fr, colw = wc * 32 + 8 * fq;
        const int pn = u.pn;
        const bool latent = u.pm < 64;
        const bool rope = latent && (pn == 6 || pn == 7 || pn == 8);
        f32x4 cs[4], sn[4], b0[2], b1[2];
        if (pn >= 9) {
#pragma unroll
            for (int bj = 0; bj < 2; ++bj) { const float* bp = (pn == 9 ? bias_f : bias_b) + colw + bj * 128; b0[bj] = *(const f32x4*)bp; b1[bj] = *(const f32x4*)(bp + 4); }
        }
#pragma unroll
        for (int ai = 0; ai < 2; ++ai) {
            if (rope) {
#pragma unroll
                for (int m = 0; m < 4; ++m) { const int t = (row0 + ai * 128 + m * 16) & (SEQ - 1); const int pos = (wc & 1) ? (t & 63) : (t >> 6);
                    cs[m] = *(const f32x4*)(tcos + pos * 16 + 4 * fq); sn[m] = *(const f32x4*)(tsin + pos * 16 + 4 * fq); }
            }
#pragma unroll
            for (int m = 0; m < 4; ++m) {
                const int row = row0 + ai * 128 + m * 16;
                bf16* rowp = P + (size_t)row * NIN + pn * 256 + colw;
#pragma unroll
                for (int bj = 0; bj < 2; ++bj) {
                    f32x4 v0 = acc[ai][bj][m][0], v1 = acc[ai][bj][m][1];
                    if (pn == 0) { v0 = v0 * 0.125f; v1 = v1 * 0.125f; }
                    else if (pn >= 9) {
#pragma unroll
                        for (int i = 0; i < 4; ++i) { float x0 = v0[i] + b0[bj][i], x1 = v1[i] + b1[bj][i];
                            v0[i] = (fminf(x0, 0.f) - __logf(1.0f + __expf(-fabsf(x0)))) * 0.0625f; v1[i] = (fminf(x1, 0.f) - __logf(1.0f + __expf(-fabsf(x1)))) * 0.0625f; }
                    } else if (rope && (pn != 8 || bj == 0)) {
                        const f32x4 o0 = v0 * cs[m] - v1 * sn[m], o1 = v1 * cs[m] + v0 * sn[m]; v0 = o0; v1 = o1;
                    }
                    if (pn == 6 || pn == 7) { v0 = v0 * QSCALE; v1 = v1 * QSCALE; }
                    u32x4 w; w.x = pg8::cvt_pk_bf16(v0[0], v0[1]); w.y = pg8::cvt_pk_bf16(v0[2], v0[3]); w.z = pg8::cvt_pk_bf16(v1[0], v1[1]); w.w = pg8::cvt_pk_bf16(v1[2], v1[3]);
                    *(u32x4*)(rowp + bj * 128) = w;
                }
            }
            asm volatile("" ::: "memory");
        }
    }
};
struct EpiOut {
    static constexpr bool PERM = false;
    const float* resL; const float* resC; float* outL; float* outC; const float* mod_l;
    __device__ __forceinline__ void operator()(const f32x4 (&acc)[2][2][4][2], const pg8::Unit& u, int wr, int wc, int fr, int fq) const {
        const bool latent = u.pm < 64;
        const int v = latent ? (u.pm >> 5) : 2;
        const int rowb = (latent ? u.pm * 256 : u.pm * 256 - TL) + wr * 64 + fr;
        const float* res = latent ? resL : resC; float* out = latent ? outL : outC;
        const int col0 = u.pn * 256 + wc * 32 + 4 * fq;
        const float* g1p = mod_l + v * 6144 + 2 * D + col0;
        f32x4 g1[2][2];
#pragma unroll
        for (int bj = 0; bj < 2; ++bj)
#pragma unroll
            for (int n = 0; n < 2; ++n) g1[bj][n] = *(const f32x4*)(g1p + bj * 128 + n * 16);
#pragma unroll
        for (int ai = 0; ai < 2; ++ai)
#pragma unroll
            for (int mp = 0; mp < 4; mp += 2) {
                f32x4 r[2][2][2];
#pragma unroll
                for (int m = 0; m < 2; ++m) { const size_t off = (size_t)(rowb + ai * 128 + (mp + m) * 16) * D + col0;
#pragma unroll
                    for (int bj = 0; bj < 2; ++bj)
#pragma unroll
                        for (int n = 0; n < 2; ++n) r[m][bj][n] = *(const f32x4*)(res + off + bj * 128 + n * 16); }
#pragma unroll
                for (int m = 0; m < 2; ++m) { const size_t off = (size_t)(rowb + ai * 128 + (mp + m) * 16) * D + col0;
#pragma unroll
                    for (int bj = 0; bj < 2; ++bj)
#pragma unroll
                        for (int n = 0; n < 2; ++n) *(f32x4*)(out + off + bj * 128 + n * 16) = r[m][bj][n] + g1[bj][n] * acc[ai][bj][mp + m][n]; }
                asm volatile("" ::: "memory");
            }
    }
};
struct EpiGU {
    static constexpr bool PERM = true;
    bf16* Hmid;
    __device__ __forceinline__ void operator()(const f32x4 (&acc)[2][2][4][2], const pg8::Unit& u, int wr, int wc, int fr, int fq) const {
        const int row0 = u.pm * 256 + wr * 64 + fr, hid0 = u.pn * 128 + wc * 16 + fq * 4;
#pragma unroll
        for (int ai = 0; ai < 2; ++ai)
#pragma unroll
            for (int m = 0; m < 4; ++m) {
                unsigned char* rowp = (unsigned char*)Hmid + (size_t)(row0 + ai * 128 + m * 16) * DE + hid0;
#pragma unroll
                for (int bj = 0; bj < 2; ++bj) {
                    const f32x4 g = acc[ai][bj][m][0], up = acc[ai][bj][m][1]; f32x4 o;
#pragma unroll
                    for (int i = 0; i < 4; ++i) o[i] = g[i] * __builtin_amdgcn_rcpf(1.0f + __expf(-g[i])) * up[i];
                    __hip_atomic_store((unsigned*)(rowp + bj * 64), pk4_fp8(o[0] * HMID_SCALE, o[1] * HMID_SCALE, o[2] * HMID_SCALE, o[3] * HMID_SCALE), __ATOMIC_RELAXED, __HIP_MEMORY_SCOPE_AGENT);
                }
            }
    }
};
struct EpiDown {
    static constexpr bool PERM = true;
    bf16* Y; const unsigned* list; const float* listw; const LAS int* tab;
    __device__ __forceinline__ void operator()(const f32x4 (&acc)[2][2][4][2], const pg8::Unit& u, int wr, int wc, int fr, int fq) const {
        const int ce = tab[u.e];
        const int r0 = u.mt * 256 + wr * 64 + fr, col0 = u.pn * 256 + wc * 32 + 8 * fq;
        const unsigned* lp = list + (size_t)u.e * LISTCAP; const float* lw = listw + (size_t)u.e * LISTCAP;
        unsigned tsv[2][4]; float wv[2][4];
#pragma unroll
        for (int ai = 0; ai < 2; ++ai)
#pragma unroll
            for (int m = 0; m < 4; ++m) { const int r = r0 + ai * 128 + m * 16; const bool ok = r < ce; tsv[ai][m] = ok ? __builtin_nontemporal_load(lp + r) : 0xffffffffu; wv[ai][m] = ok ? __builtin_nontemporal_load(lw + r) : 0.f; }
#pragma unroll
        for (int ai = 0; ai < 2; ++ai)
#pragma unroll
            for (int m = 0; m < 4; ++m) {
                const unsigned ts = tsv[ai][m]; const float w = wv[ai][m];
                if (ts != 0xffffffffu) {
                    bf16* rowp = Y + ((size_t)(ts & 1u) * TT + (ts >> 1)) * D + col0;
#pragma unroll
                    for (int bj = 0; bj < 2; ++bj) {
                        const f32x4 v0 = acc[ai][bj][m][0] * w, v1 = acc[ai][bj][m][1] * w;
                        u32x4 o; o.x = pg8::cvt_pk_bf16(v0[0], v0[1]); o.y = pg8::cvt_pk_bf16(v0[2], v0[3]); o.z = pg8::cvt_pk_bf16(v1[0], v1[1]); o.w = pg8::cvt_pk_bf16(v1[2], v1[3]);
                        *(u32x4*)(rowp + bj * 128) = o;
                    }
                }
            }
    }
};

__device__ __forceinline__ void swa_naive(const Frame& F, const CAS Args* a, int l) {
    const bf16* P = (const bf16*)(F.ws + WS_P); bf16* MIX = (bf16*)(F.ws + WS_MIX);
    const int total = (l == 0 ? TT : TL) * 8;
    for (int idx = F.gw * 64 + F.lane; idx < total; idx += F.NGW * 64) {
        const int m = idx >> 3, hq = idx & 7, kvh = hq >> 2;
        const bool latent = m < TL;
        const int b = latent ? (m >> 13) : ((m - TL) >> 8), t = m & (SEQ - 1);
        float q[64];
        { const u32x4* qp = (const u32x4*)(P + (size_t)m * NIN + PC_SQ + hq * 64);
#pragma unroll
          for (int c = 0; c < 8; ++c) { const u32x4 w = qp[c]; q[8 * c] = bflo(w.x); q[8 * c + 1] = bfhi(w.x); q[8 * c + 2] = bflo(w.y); q[8 * c + 3] = bfhi(w.y);
              q[8 * c + 4] = bflo(w.z); q[8 * c + 5] = bfhi(w.z); q[8 * c + 6] = bflo(w.w); q[8 * c + 7] = bfhi(w.w); } }
        float o[64];
#pragma unroll
        for (int d = 0; d < 64; ++d) o[d] = 0.f;
        const float sink = a->in[I_SINK][l * 8 + hq] * LOG2E;
        float mx = sink, den = 1.0f;
        const int lo = latent ? (t - 128 < 0 ? 0 : t - 128) : 0, hi = latent ? (t + 128 > SEQ - 1 ? SEQ - 1 : t + 128) : -1;
        const int nloc = hi - lo + 1;
        for (int kk = 0; kk < nloc + LC; ++kk) {
            const int krow = kk < nloc ? b * SEQ + lo + kk : TL + b * LC + (kk - nloc);
            const u32x4* kp = (const u32x4*)(P + (size_t)krow * NIN + PC_SK + kvh * 64);
            float s = 0.f;
#pragma unroll
            for (int c = 0; c < 8; ++c) { const u32x4 w = kp[c]; s += q[8 * c] * bflo(w.x) + q[8 * c + 1] * bfhi(w.x) + q[8 * c + 2] * bflo(w.y) + q[8 * c + 3] * bfhi(w.y)
                + q[8 * c + 4] * bflo(w.z) + q[8 * c + 5] * bfhi(w.z) + q[8 * c + 6] * bflo(w.w) + q[8 * c + 7] * bfhi(w.w); }
            const float mn = fmaxf(mx, s), f = exp2f(mx - mn), p = exp2f(s - mn);
            den = den * f + p; mx = mn;
            const u32x4* vp = (const u32x4*)(P + (size_t)krow * NIN + PC_SV + kvh * 64);
#pragma unroll
            for (int c = 0; c < 8; ++c) { const u32x4 w = vp[c];
                o[8 * c] = o[8 * c] * f + p * bflo(w.x); o[8 * c + 1] = o[8 * c + 1] * f + p * bfhi(w.x); o[8 * c + 2] = o[8 * c + 2] * f + p * bflo(w.y); o[8 * c + 3] = o[8 * c + 3] * f + p * bfhi(w.y);
                o[8 * c + 4] = o[8 * c + 4] * f + p * bflo(w.z); o[8 * c + 5] = o[8 * c + 5] * f + p * bfhi(w.z); o[8 * c + 6] = o[8 * c + 6] * f + p * bflo(w.w); o[8 * c + 7] = o[8 * c + 7] * f + p * bfhi(w.w); }
        }
        const float inv = 1.0f / den;
        u32x4* op = (u32x4*)(MIX + (size_t)m * D + 512 + hq * 64);
#pragma unroll
        for (int c = 0; c < 8; ++c) { u32x4 w; w.x = pk2(o[8 * c] * inv, o[8 * c + 1] * inv); w.y = pk2(o[8 * c + 2] * inv, o[8 * c + 3] * inv); w.z = pk2(o[8 * c + 4] * inv, o[8 * c + 5] * inv); w.w = pk2(o[8 * c + 6] * inv, o[8 * c + 7] * inv); op[c] = w; }
    }
}


typedef float f32x16 __attribute__((ext_vector_type(16)));
typedef short s16x4 __attribute__((ext_vector_type(4)));
__device__ __forceinline__ int crow(int r, int hi) { return (r & 3) + 8 * (r >> 2) + 4 * hi; }
__device__ __forceinline__ s16x4 vtr(const LAS unsigned char* p) { return __builtin_bit_cast(s16x4, __builtin_amdgcn_ds_read_tr16_b64_v4i16((LAS s16x4*)p)); }
constexpr int SWA_K = 0, SWA_V = 49152;
__device__ __forceinline__ void swa_kload(const LAS unsigned char* Kt, int kb, int lane, bf16x8 (&kf)[4]) {
    const int r32 = lane & 31, hi = lane >> 5;
#pragma unroll
    for (int d0 = 0; d0 < 4; ++d0) kf[d0] = *(const LAS bf16x8*)(Kt + (2 * d0 + hi) * 1024 + (32 * kb + r32) * 16);
}
__device__ __forceinline__ void swa_tile(const LAS unsigned char* Kt, const LAS unsigned char* Vt, const LAS unsigned char* Kn, int mtype, const bf16x8 (&qf)[2][4], bf16x8 (&kf)[4], f32x16 (&o)[2][2], float (&mrun)[2], float (&lrun)[2], int lane, int abl = 0) {
    const int r32 = lane & 31, hi = lane >> 5;
    const LAS unsigned char* vp = Vt + ((lane >> 4) & 1) * 32 + (lane & 3) * 8 + (4 * hi + ((lane & 15) >> 2)) * 64;
#pragma unroll
    for (int kb = 0; kb < 2; ++kb) {
        f32x16 s[2];
        swa_kload(Kt, kb, lane, kf);
#pragma unroll
        for (int d0 = 0; d0 < 4; ++d0)
#pragma unroll
            for (int qt = 0; qt < 2; ++qt) {
                if (d0 == 0) { f32x16 z;
#pragma unroll
                    for (int r = 0; r < 16; ++r) z[r] = 0.f;
                    s[qt] = __builtin_amdgcn_mfma_f32_32x32x16_bf16(kf[0], qf[qt][0], z, 0, 0, 0); }
                else if (abl != 4) s[qt] = __builtin_amdgcn_mfma_f32_32x32x16_bf16(kf[d0], qf[qt][d0], s[qt], 0, 0, 0);
            }
        __builtin_amdgcn_sched_barrier(0);
        s16x4 vlo[2][2], vhi[2][2];
#pragma unroll
        for (int dt = 0; dt < 2; ++dt)
#pragma unroll
            for (int sp = 0; sp < 2; ++sp) { vlo[dt][sp] = vtr(vp + dt * 4096 + (2 * kb + sp) * 1024); vhi[dt][sp] = vtr(vp + dt * 4096 + (2 * kb + sp) * 1024 + 512); }
        __builtin_amdgcn_sched_barrier(0);
        bf16x8 pf[2][2];
#pragma unroll
        for (int qt = 0; qt < 2; ++qt) {
            if (mtype != 0) {
                int thr = r32 + 32 * qt - 4 * hi - 32 * kb; asm volatile("" : "+v"(thr));
                if (mtype == 1) {
#pragma unroll
                    for (int r = 0; r < 16; ++r) { const int cc = (r & 3) + 8 * (r >> 2); if (cc < thr) s[qt][r] = -INFINITY; }
                } else {
#pragma unroll
                    for (int r = 0; r < 16; ++r) { const int cc = (r & 3) + 8 * (r >> 2); if (cc > thr) s[qt][r] = -INFINITY; }
                }
            }
            float rm = s[qt][0];
            if (abl != 1) {
#pragma unroll
            for (int r = 1; r < 16; ++r) rm = fmaxf(rm, s[qt][r]);
            }
            { auto rr = __builtin_amdgcn_permlane32_swap(__float_as_uint(rm), __float_as_uint(rm), false, false); rm = fmaxf(__uint_as_float(rr[0]), __uint_as_float(rr[1])); }
            const float mn = fmaxf(mrun[qt], rm);
            if (__any(mn > mrun[qt])) {
                const float alpha = __builtin_amdgcn_exp2f(mrun[qt] - mn);
                lrun[qt] *= alpha;
#pragma unroll
                for (int dt = 0; dt < 2; ++dt)
#pragma unroll
                    for (int r = 0; r < 16; ++r) o[dt][qt][r] *= alpha;
                mrun[qt] = mn;
            }
            float rs = 0.f;
            if (abl != 1) {
#pragma unroll
            for (int r = 0; r < 16; ++r) { const float p = __builtin_amdgcn_exp2f(s[qt][r] - mn); s[qt][r] = p; rs += p; }
            }
            lrun[qt] += rs;
#pragma unroll
            for (int sp = 0; sp < 2; ++sp) {
                u32x4 w; w.x = pg8::cvt_pk_bf16(s[qt][8 * sp + 0], s[qt][8 * sp + 1]); w.y = pg8::cvt_pk_bf16(s[qt][8 * sp + 2], s[qt][8 * sp + 3]);
                w.z = pg8::cvt_pk_bf16(s[qt][8 * sp + 4], s[qt][8 * sp + 5]); w.w = pg8::cvt_pk_bf16(s[qt][8 * sp + 6], s[qt][8 * sp + 7]);
                pf[qt][sp] = __builtin_bit_cast(bf16x8, w);
            }
        }
#pragma unroll
        for (int dt = 0; dt < 2; ++dt)
#pragma unroll
            for (int sp = 0; sp < 2; ++sp) {
                const bf16x8 vf = (bf16x8){vlo[dt][sp][0], vlo[dt][sp][1], vlo[dt][sp][2], vlo[dt][sp][3], vhi[dt][sp][0], vhi[dt][sp][1], vhi[dt][sp][2], vhi[dt][sp][3]};
#pragma unroll
                for (int qt = 0; qt < 2; ++qt) if (abl != 2) o[dt][qt] = __builtin_amdgcn_mfma_f32_32x32x16_bf16(vf, pf[qt][sp], o[dt][qt], 0, 0, 0);
            }
    }
}
__device__ __forceinline__ void swa_stage(const Frame& F, const bf16* P, int grow, int kvh, int ti) {
    { const int key = 8 * F.wave + (F.lane & 7), ch = F.lane >> 3;
      const u32x4 v = *(const u32x4*)(P + (size_t)(grow + key) * NIN + PC_SK + kvh * 64 + ch * 8);
      *(LAS u32x4*)(F.lds + SWA_K + ti * 8192 + ch * 1024 + key * 16) = v; }
    { const int key = 8 * F.wave + (F.lane >> 3), ch = F.lane & 7;
      const u32x4 v = *(const u32x4*)(P + (size_t)(grow + key) * NIN + PC_SV + kvh * 64 + ch * 8);
      *(LAS u32x4*)(F.lds + SWA_V + ti * 8192 + (ch >> 2) * 4096 + key * 64 + (ch & 3) * 16) = v; }
}
__device__ __forceinline__ void swa_flash(const Frame& F, const CAS Args* a, int l, int abl = 0) {
    const bf16* P = (const bf16*)(F.ws + WS_P); bf16* MIX = (bf16*)(F.ws + WS_MIX);
    const int nunits = 256 + (l == 0 ? 8 : 0);
    const int lane = F.lane, r32 = lane & 31, hi = lane >> 5;
    for (int u = F.vcu; u < nunits; u += F.G) {
        const bool latent = u < 256;
        const int b = latent ? (u >> 7) : ((u - 256) >> 2), kvh = latent ? ((u >> 6) & 1) : (((u - 256) >> 1) & 1), qb = latent ? (u & 63) : ((u - 256) & 1);
        const int q0 = qb * 128, g = F.wave >> 1, qs = F.wave & 1, hq = kvh * 4 + g;
        const int mrow0 = (latent ? b * SEQ : TL + b * LC) + q0 + 64 * qs;
        bf16x8 qf[2][4];
#pragma unroll
        for (int qt = 0; qt < 2; ++qt)
#pragma unroll
            for (int d0 = 0; d0 < 4; ++d0) { if (abl != 7) qf[qt][d0] = *(const bf16x8*)(P + (size_t)(mrow0 + 32 * qt + r32) * NIN + PC_SQ + hq * 64 + 16 * d0 + 8 * hi); else qf[qt][d0] = (bf16x8){(short)lane, 1, 2, 3, 4, 5, 6, 7}; }
        f32x16 o[2][2];
#pragma unroll
        for (int dt = 0; dt < 2; ++dt)
#pragma unroll
            for (int qt = 0; qt < 2; ++qt)
#pragma unroll
                for (int r = 0; r < 16; ++r) o[dt][qt][r] = 0.f;
        const float sink2 = a->in[I_SINK][l * 8 + hq] * LOG2E;
        float mrun[2] = {sink2, sink2}, lrun[2] = {hi == 0 ? 1.f : 0.f, hi == 0 ? 1.f : 0.f};
        if (latent) {
#pragma unroll 1
            for (int j = 0; j < 6; ++j) { const int ks = q0 - 128 + 64 * j; if (ks >= 0 && ks < SEQ && abl != 3) swa_stage(F, P, b * SEQ + ks, kvh, j); }
            __syncthreads();
            { int jf = qs; while (q0 - 128 + 64 * jf < 0) ++jf;
              bf16x8 kf[4]; swa_kload(F.lds + SWA_K + jf * 8192, 0, lane, kf);
#pragma unroll 1
              for (int tt = 0; tt < 5; ++tt) { const int j = qs + tt, ks = q0 - 128 + 64 * j;
                  if (ks >= 0 && ks < SEQ && abl != 8) { const int jn = (j + 1 < 6) ? j + 1 : j;
                      swa_tile(F.lds + SWA_K + j * 8192, F.lds + SWA_V + j * 8192, F.lds + SWA_K + jn * 8192, tt == 0 ? 1 : (tt == 4 ? 2 : 0), qf, kf, o, mrun, lrun, lane, abl); } } }
            __syncthreads();
        }
#pragma unroll 1
        for (int j = 0; j < 4; ++j) if (abl != 3) swa_stage(F, P, TL + b * LC + 64 * j, kvh, j);
        __syncthreads();
        { bf16x8 kf[4]; swa_kload(F.lds + SWA_K, 0, lane, kf);
#pragma unroll 1
          for (int j = 0; j < 4; ++j) if (abl != 8) swa_tile(F.lds + SWA_K + j * 8192, F.lds + SWA_V + j * 8192, F.lds + SWA_K + (j < 3 ? j + 1 : j) * 8192, 0, qf, kf, o, mrun, lrun, lane, abl); }
        __syncthreads();
#pragma unroll
        for (int qt = 0; qt < 2; ++qt) {
            float lt = lrun[qt];
            { auto rr = __builtin_amdgcn_permlane32_swap(__float_as_uint(lt), __float_as_uint(lt), false, false); lt = __uint_as_float(rr[0]) + __uint_as_float(rr[1]); }
            const float inv = 1.0f / lt;
            bf16* op = MIX + (size_t)(mrow0 + 32 * qt + r32) * D + 512 + hq * 64 + 4 * hi;
#pragma unroll
            for (int dt = 0; dt < 2; ++dt)
#pragma unroll
                for (int rg = 0; rg < 4; ++rg) {
                    u32x2 w; w.x = pk2(o[dt][qt][4 * rg] * inv, o[dt][qt][4 * rg + 1] * inv); w.y = pk2(o[dt][qt][4 * rg + 2] * inv, o[dt][qt][4 * rg + 3] * inv);
                    if (abl != 7 || w.x == 0x12345u) *(u32x2*)(op + 32 * dt + 8 * rg) = w;
                }
        }
    }
}


constexpr size_t WS_US = WS_GL, WS_USC = WS_GL + 32 * MiB, WS_DEC = 7 * MiB;
static_assert(WS_USC + (size_t)16 * 4 * 8192 * 2 <= WS_END && WS_DEC + (size_t)16 * 132 * 64 * 4 <= WS_WIN, "ws map (gla)");
constexpr int GL_V = 0, GL_M0 = 16384, GL_MSZ = 64 * 72 * 2, GL_RED = GL_M0 + 4 * GL_MSZ;
__device__ __forceinline__ float wave_scan_incl(float v) {
    v += DPP_F(v, 0x111, 0xF); v += DPP_F(v, 0x112, 0xF); v += DPP_F(v, 0x114, 0xF); v += DPP_F(v, 0x118, 0xF);
    v += DPP_F(v, 0x142, 0xA); v += DPP_F(v, 0x143, 0xC); return v;
}
__device__ __forceinline__ float lane63(float v) { return __builtin_bit_cast(float, __builtin_amdgcn_readlane(__builtin_bit_cast(int, v), 63)); }
__device__ __forceinline__ void unpack8(const u32x4 w, float (&f)[8]) { f[0] = bflo(w.x); f[1] = bfhi(w.x); f[2] = bflo(w.y); f[3] = bfhi(w.y); f[4] = bflo(w.z); f[5] = bfhi(w.z); f[6] = bflo(w.w); f[7] = bfhi(w.w); }
__device__ __forceinline__ void gla_stage_v(const Frame& F, const bf16* P, int m0, int h) {
#pragma unroll
    for (int i = 0; i < 2; ++i) { const int p = F.tid + 512 * i, t = p >> 4, ch = p & 15;
        const u32x4 v = *(const u32x4*)(P + (size_t)(m0 + t) * NIN + PC_V + h * 128 + ch * 8);
        *(LAS u32x4*)(F.lds + GL_V + (ch >> 2) * 4096 + t * 64 + (ch & 3) * 16) = v; }
}
__device__ __forceinline__ void gla_g1_unit(const Frame& F, const bf16* P, int m0, int h, bf16* Uf, bf16* Ub, float* decf, float* decb) {
    const int w = F.wave, t = F.lane, c = t & 31, hi = t >> 5;
    const bf16* row = P + (size_t)(m0 + t) * NIN + h * 64 + 8 * w;
    float laf[8], lab[8], kk[8];
    unpack8(*(const u32x4*)(row + PC_GF), laf); unpack8(*(const u32x4*)(row + PC_GB), lab); unpack8(*(const u32x4*)(row + PC_K), kk);
    gla_stage_v(F, P, m0, h);
    LAS bf16* KOF = (LAS bf16*)(F.lds + GL_M0); LAS bf16* KOB = (LAS bf16*)(F.lds + GL_M0 + GL_MSZ);
#pragma unroll
    for (int i = 0; i < 8; ++i) {
        const float incf = wave_scan_incl(laf[i]), tf = lane63(incf), incb = wave_scan_incl(lab[i]), tb = lane63(incb);
        KOF[(8 * w + i) * 72 + t] = (bf16)f2bf(kk[i] * __expf(tf - incf));
        KOB[(8 * w + i) * 72 + t] = (bf16)f2bf(kk[i] * __expf(incb - lab[i]));
        if (t == 0) { decf[8 * w + i] = __expf(tf); decb[8 * w + i] = __expf(tb); }
    }
    __syncthreads();
    const int dir = w >> 2, dvt = w & 3;
    const LAS unsigned char* vp = F.lds + GL_V + dvt * 4096 + ((t >> 4) & 1) * 32 + (t & 3) * 8 + ((t & 15) >> 2) * 64 + hi * 512;
    const LAS unsigned char* kb = F.lds + GL_M0 + dir * GL_MSZ + (c * 72 + 8 * hi) * 2;
    f32x16 acc[2];
#pragma unroll
    for (int j = 0; j < 2; ++j)
#pragma unroll
        for (int r = 0; r < 16; ++r) acc[j][r] = 0.f;
#pragma unroll
    for (int sp = 0; sp < 4; ++sp) {
        const s16x4 lo = vtr(vp + sp * 1024), hi4 = vtr(vp + sp * 1024 + 256);
        const bf16x8 vf = (bf16x8){lo[0], lo[1], lo[2], lo[3], hi4[0], hi4[1], hi4[2], hi4[3]};
#pragma unroll
        for (int j = 0; j < 2; ++j) { const bf16x8 kf = *(const LAS bf16x8*)(kb + j * 32 * 144 + sp * 32); acc[j] = __builtin_amdgcn_mfma_f32_32x32x16_bf16(kf, vf, acc[j], 0, 0, 0); }
    }
    bf16* U = dir ? Ub : Uf;
#pragma unroll
    for (int j = 0; j < 2; ++j) {
        u32x4 w0, w1;
        w0.x = pk2(acc[j][0], acc[j][1]); w0.y = pk2(acc[j][2], acc[j][3]); w0.z = pk2(acc[j][4], acc[j][5]); w0.w = pk2(acc[j][6], acc[j][7]);
        w1.x = pk2(acc[j][8], acc[j][9]); w1.y = pk2(acc[j][10], acc[j][11]); w1.z = pk2(acc[j][12], acc[j][13]); w1.w = pk2(acc[j][14], acc[j][15]);
        u32x4* up = (u32x4*)(U + ((j * 4 + dvt) * 64 + t) * 16);
        up[0] = w0; up[1] = w1;
    }
    __syncthreads();
}
__device__ __forceinline__ void gla_g1(const Frame& F0, int l) {
    Frame F = F0; { int l_; asm volatile("v_mbcnt_lo_u32_b32 %0, -1, 0\n\tv_mbcnt_hi_u32_b32 %0, -1, %0" : "=v"(l_)); F.lane = l_; F.tid = F.wave * 64 + l_; }
    const bf16* P = (const bf16*)(F.ws + WS_P);
    bf16* US = (bf16*)(F.ws + WS_US); bf16* USC = (bf16*)(F.ws + WS_USC); float* DEC = (float*)(F.ws + WS_DEC);
    for (int u = F.vcu; u < 1056; u += F.G) {
        const bool latent = u < 1024; const int cc = u - 1024;
        const int b = latent ? (u >> 9) : (cc >> 4), h = latent ? ((u >> 7) & 3) : ((cc >> 2) & 3), n = latent ? (u & 127) : (cc & 3);
        const int m0 = latent ? b * SEQ + 64 * n : TL + b * LC + 64 * n;
        const int sf = (b * 4 + h) * 2;
        bf16* Uf = latent ? US + ((size_t)sf * 128 + n) * 8192 : USC + ((size_t)sf * 4 + n) * 8192;
        bf16* Ub = latent ? US + ((size_t)(sf + 1) * 128 + n) * 8192 : USC + ((size_t)(sf + 1) * 4 + n) * 8192;
        const int nd = latent ? n : 128 + n;
        gla_g1_unit(F, P, m0, h, Uf, Ub, DEC + ((size_t)sf * 132 + nd) * 64, DEC + ((size_t)(sf + 1) * 132 + nd) * 64);
    }
}
constexpr size_t WS_SS = WS_H, WS_SSC = WS_H + 32 * MiB;
static_assert(WS_SSC + (size_t)16 * 4 * 8192 * 2 <= WS_P, "ws map (gla states)");
__device__ __forceinline__ void gla_scan(const Frame& F) {
    for (int w0 = (F.vcu * NWAVES + F.wave) * 64; w0 < 16 * 4096; w0 += F.G * NWAVES * 64) {
        const int seq = __builtin_amdgcn_readfirstlane(w0 >> 12), ew = __builtin_amdgcn_readfirstlane((w0 & 4095) * 2);
        const int dir = seq & 1;
        const unsigned voff = (unsigned)F.lane * 4u;
        unsigned doff;
        { const int e = ew + 2 * F.lane, r = e & 15, ln = (e >> 4) & 63, dkt = e >> 12; doff = (unsigned)(32 * dkt + (r & 3) + 8 * (r >> 2) + 4 * (ln >> 5)) * 4u; }
        const char* decb = (const char*)(F.ws + WS_DEC) + (size_t)seq * 132 * 256;
        float s0 = 0.f, s1 = 0.f;
        { const char* ub = (const char*)(F.ws + WS_USC) + ((size_t)seq * 4 * 8192 + ew) * 2; char* sb = (char*)(F.ws + WS_SSC) + ((size_t)seq * 4 * 8192 + ew) * 2;
          unsigned u[4]; f32x2 d[4];
#pragma unroll
          for (int i = 0; i < 4; ++i) { const int n = dir ? 3 - i : i; u[i] = *(const unsigned*)(ub + (size_t)n * 16384 + voff); d[i] = *(const f32x2*)(decb + (size_t)(128 + n) * 256 + doff); }
#pragma unroll
          for (int i = 0; i < 4; ++i) { const int n = dir ? 3 - i : i; *(unsigned*)(sb + (size_t)n * 16384 + voff) = pk2(s0, s1); s0 = d[i][0] * s0 + bflo(u[i]); s1 = d[i][1] * s1 + bfhi(u[i]); } }
        const long stride = dir ? -16384 : 16384, dstride = dir ? -256 : 256;
        const char* ub = (const char*)(F.ws + WS_US) + ((size_t)seq * 128 * 8192 + ew) * 2 + (dir ? (size_t)127 * 16384 : 0);
        char* sb = (char*)(F.ws + WS_SS) + ((size_t)seq * 128 * 8192 + ew) * 2 + (dir ? (size_t)127 * 16384 : 0);
        const char* db = decb + (dir ? 127 * 256 : 0);
#pragma unroll 1
        for (int i0 = 0; i0 < 128; i0 += 32) {
            unsigned u[32]; f32x2 d[32];
#pragma unroll
            for (int j = 0; j < 32; ++j) { u[j] = *(const unsigned*)(ub + j * stride + voff); d[j] = *(const f32x2*)(db + j * dstride + doff); }
#pragma unroll
            for (int j = 0; j < 32; ++j) { *(unsigned*)(sb + j * stride + voff) = pk2(s0, s1); s0 = d[j][0] * s0 + bflo(u[j]); s1 = d[j][1] * s1 + bfhi(u[j]); }
            ub += 32 * stride; sb += 32 * stride; db += 32 * dstride;
        }
    }
}
__device__ __forceinline__ void gla_g3_unit(const Frame& F, const CAS Args* a, int l, const bf16* P, int m0, int h, const bf16* Sf, const bf16* Sb, bf16* MIX) {
    const int w = F.wave, t = F.lane, c = t & 31, hi = t >> 5;
    bf16x8 sfr[4], sbr[4]; u32x2 gwv[4]; f32x4 nwv[4];
    { const int dvt_ = w >> 1, tt_ = w & 1;
#pragma unroll
      for (int kd = 0; kd < 4; ++kd) { const size_t off = (size_t)(((kd >> 1) * 4 + dvt_) * 64 + t) * 16 + 8 * (kd & 1); sfr[kd] = *(const bf16x8*)(Sf + off); sbr[kd] = *(const bf16x8*)(Sb + off); }
#pragma unroll
      for (int rg = 0; rg < 4; ++rg) { const int dv = 32 * dvt_ + 8 * rg + 4 * hi;
          gwv[rg] = *(const u32x2*)(P + (size_t)(m0 + 32 * tt_ + c) * NIN + PC_G + h * 128 + dv); nwv[rg] = *(const f32x4*)(a->in[I_GLANORM] + l * 512 + h * 128 + dv); } }
    {
        const bf16* row = P + (size_t)(m0 + t) * NIN + h * 64 + 8 * w;
        float laf[8], lab[8], kk[8], qq[8];
        unpack8(*(const u32x4*)(row + PC_GF), laf); unpack8(*(const u32x4*)(row + PC_GB), lab); unpack8(*(const u32x4*)(row + PC_K), kk); unpack8(*(const u32x4*)(row + PC_Q), qq);
        gla_stage_v(F, P, m0, h);
        float qf[8], kf[8], qb[8], kb[8];
#pragma unroll
        for (int i = 0; i < 8; ++i) {
            const float bf = wave_scan_incl(laf[i]), incb = wave_scan_incl(lab[i]), bb = lane63(incb) - incb + lab[i];
            qf[i] = qq[i] * __expf(bf); kf[i] = kk[i] * __expf(-bf); qb[i] = qq[i] * __expf(bb); kb[i] = kk[i] * __expf(-bb);
        }
        LAS unsigned char* mb = F.lds + GL_M0 + (t * 72 + 8 * w) * 2;
        u32x4 o;
        o.x = pk2(qf[0], qf[1]); o.y = pk2(qf[2], qf[3]); o.z = pk2(qf[4], qf[5]); o.w = pk2(qf[6], qf[7]); *(LAS u32x4*)(mb) = o;
        o.x = pk2(kf[0], kf[1]); o.y = pk2(kf[2], kf[3]); o.z = pk2(kf[4], kf[5]); o.w = pk2(kf[6], kf[7]); *(LAS u32x4*)(mb + GL_MSZ) = o;
        o.x = pk2(qb[0], qb[1]); o.y = pk2(qb[2], qb[3]); o.z = pk2(qb[4], qb[5]); o.w = pk2(qb[6], qb[7]); *(LAS u32x4*)(mb + 2 * GL_MSZ) = o;
        o.x = pk2(kb[0], kb[1]); o.y = pk2(kb[2], kb[3]); o.z = pk2(kb[4], kb[5]); o.w = pk2(kb[6], kb[7]); *(LAS u32x4*)(mb + 3 * GL_MSZ) = o;
    }
    __syncthreads();
    const int dvt = w >> 1, tt = w & 1;
    bf16x8 qfB[4], qbB[4], qfP[4], qbP[4];
    { const LAS unsigned char* qp = F.lds + GL_M0 + ((32 * tt + c) * 72 + 8 * hi) * 2;
#pragma unroll
      for (int kd = 0; kd < 4; ++kd) { qfB[kd] = *(const LAS bf16x8*)(qp + kd * 32); qbB[kd] = *(const LAS bf16x8*)(qp + 2 * GL_MSZ + kd * 32); }
      const LAS unsigned char* pp = F.lds + GL_M0 + ((32 * tt + c) * 72 + 4 * hi) * 2;
#pragma unroll
      for (int kd = 0; kd < 4; ++kd) {
          const u32x2 a0 = *(const LAS u32x2*)(pp + kd * 32), a1 = *(const LAS u32x2*)(pp + kd * 32 + 16);
          const u32x2 b0 = *(const LAS u32x2*)(pp + 2 * GL_MSZ + kd * 32), b1 = *(const LAS u32x2*)(pp + 2 * GL_MSZ + kd * 32 + 16);
          qfP[kd] = __builtin_bit_cast(bf16x8, (u32x4){a0.x, a0.y, a1.x, a1.y}); qbP[kd] = __builtin_bit_cast(bf16x8, (u32x4){b0.x, b0.y, b1.x, b1.y});
      } }
    bf16x8 pfr[2][2];
#pragma unroll
    for (int st = 0; st < 2; ++st) {
        const LAS unsigned char* kp = F.lds + GL_M0 + GL_MSZ + ((32 * st + c) * 72 + 8 * hi) * 2;
        f32x16 xf, xb;
#pragma unroll
        for (int r = 0; r < 16; ++r) { xf[r] = 0.f; xb[r] = 0.f; }
        const bool needF = st <= tt, needB = st >= tt;
        if (needF) {
#pragma unroll
            for (int kd = 0; kd < 4; ++kd) xf = __builtin_amdgcn_mfma_f32_32x32x16_bf16(*(const LAS bf16x8*)(kp + kd * 32), qfB[kd], xf, 0, 0, 0);
        }
        if (needB) {
#pragma unroll
            for (int kd = 0; kd < 4; ++kd) xb = __builtin_amdgcn_mfma_f32_32x32x16_bf16(*(const LAS bf16x8*)(kp + 2 * GL_MSZ + kd * 32), qbB[kd], xb, 0, 0, 0);
        }
        if (st == tt) {
            int thr = c - 4 * hi; asm volatile("" : "+v"(thr));
#pragma unroll
            for (int r = 0; r < 16; ++r) { const int cc = (r & 3) + 8 * (r >> 2); xf[r] = (cc <= thr ? xf[r] : 0.f) + (cc >= thr ? xb[r] : 0.f); }
        } else {
#pragma unroll
            for (int r = 0; r < 16; ++r) xf[r] += xb[r];
        }
#pragma unroll
        for (int sp = 0; sp < 2; ++sp) {
            u32x4 wv; wv.x = pg8::cvt_pk_bf16(xf[8 * sp + 0], xf[8 * sp + 1]); wv.y = pg8::cvt_pk_bf16(xf[8 * sp + 2], xf[8 * sp + 3]);
            wv.z = pg8::cvt_pk_bf16(xf[8 * sp + 4], xf[8 * sp + 5]); wv.w = pg8::cvt_pk_bf16(xf[8 * sp + 6], xf[8 * sp + 7]);
            pfr[st][sp] = __builtin_bit_cast(bf16x8, wv);
        }
    }
    f32x16 o;
#pragma unroll
    for (int r = 0; r < 16; ++r) o[r] = 0.f;
    { const LAS unsigned char* vp = F.lds + GL_V + dvt * 4096 + ((t >> 4) & 1) * 32 + (t & 3) * 8 + (4 * hi + ((t & 15) >> 2)) * 64;
#pragma unroll
      for (int ks = 0; ks < 4; ++ks) {
          const s16x4 lo = vtr(vp + ks * 1024), hi4 = vtr(vp + ks * 1024 + 512);
          const bf16x8 vf = (bf16x8){lo[0], lo[1], lo[2], lo[3], hi4[0], hi4[1], hi4[2], hi4[3]};
          o = __builtin_amdgcn_mfma_f32_32x32x16_bf16(vf, pfr[ks >> 1][ks & 1], o, 0, 0, 0);
      } }
#pragma unroll
    for (int kd = 0; kd < 4; ++kd) {
        o = __builtin_amdgcn_mfma_f32_32x32x16_bf16(sfr[kd], qfP[kd], o, 0, 0, 0);
        o = __builtin_amdgcn_mfma_f32_32x32x16_bf16(sbr[kd], qbP[kd], o, 0, 0, 0);
    }
    float ssq = 0.f;
#pragma unroll
    for (int r = 0; r < 16; ++r) ssq += o[r] * o[r];
    { auto rr = __builtin_amdgcn_permlane32_swap(__float_as_uint(ssq), __float_as_uint(ssq), false, false); ssq = __uint_as_float(rr[0]) + __uint_as_float(rr[1]); }
    LAS float* red = (LAS float*)(F.lds + GL_RED);
    if (hi == 0) red[dvt * 64 + 32 * tt + c] = ssq;
    __syncthreads();
    const float tot = (red[32 * tt + c] + red[64 + 32 * tt + c]) + (red[128 + 32 * tt + c] + red[192 + 32 * tt + c]);
    const float rstd = 1.0f / sqrtf(tot * (1.0f / 128.0f) + EPS);
    const int mrow = m0 + 32 * tt + c;
#pragma unroll
    for (int rg = 0; rg < 4; ++rg) {
        const int dv = 32 * dvt + 8 * rg + 4 * hi;
        const u32x2 gw = gwv[rg]; const f32x4 nw = nwv[rg];
        const float g0 = bflo(gw.x), g1 = bfhi(gw.x), g2 = bflo(gw.y), g3 = bfhi(gw.y);
        u32x2 ov; ov.x = pk2(o[4 * rg] * rstd * nw[0] * silu_f(g0), o[4 * rg + 1] * rstd * nw[1] * silu_f(g1)); ov.y = pk2(o[4 * rg + 2] * rstd * nw[2] * silu_f(g2), o[4 * rg + 3] * rstd * nw[3] * silu_f(g3));
        *(u32x2*)(MIX + (size_t)mrow * D + h * 128 + dv) = ov;
    }
    __syncthreads();
}
__device__ __forceinline__ void gla_g3(const Frame& F, const CAS Args* a, int l) {
    const bf16* P = (const bf16*)(F.ws + WS_P); bf16* MIX = (bf16*)(F.ws + WS_MIX);
    const bf16* US = (const bf16*)(F.ws + WS_SS); const bf16* USC = (const bf16*)(F.ws + WS_SSC);
    const int nunits = 1024 + (l == 0 ? 32 : 0);
    for (int u = F.vcu; u < nunits; u += F.G) {
        const bool latent = u < 1024; const int cc = u - 1024;
        const int b = latent ? (u >> 9) : (cc >> 4), h = latent ? ((u >> 7) & 3) : ((cc >> 2) & 3), n = latent ? (u & 127) : (cc & 3);
        const int m0 = latent ? b * SEQ + 64 * n : TL + b * LC + 64 * n;
        const int sf = (b * 4 + h) * 2;
        const bf16* Sf = latent ? US + ((size_t)sf * 128 + n) * 8192 : USC + ((size_t)sf * 4 + n) * 8192;
        const bf16* Sb = latent ? US + ((size_t)(sf + 1) * 128 + n) * 8192 : USC + ((size_t)(sf + 1) * 4 + n) * 8192;
        gla_g3_unit(F, a, l, P, m0, h, Sf, Sb, MIX);
    }
}

__device__ __forceinline__ void gla_naive(const Frame& F, const CAS Args* a, int l) {
    const bf16* P = (const bf16*)(F.ws + WS_P);
    bf16* OF = (bf16*)(F.ws + WS_GL);
    for (int w = F.gw; w < 2048; w += F.NGW) {
        const int dv = w & 127, dir = (w >> 7) & 1, h = (w >> 8) & 3, b = w >> 10;
        const int pcg = dir ? PC_GB : PC_GF;
        float S = 0.f;
        for (int step = 0; step < LC + SEQ; ++step) {
            int m;
            if (dir == 0) m = step < LC ? TL + b * LC + step : b * SEQ + (step - LC);
            else m = step < LC ? TL + b * LC + (LC - 1 - step) : b * SEQ + (SEQ - 1 - (step - LC));
            const bf16* row = P + (size_t)m * NIN;
            const float la = bf2f(row[pcg + h * 64 + F.lane]), kk = bf2f(row[PC_K + h * 64 + F.lane]), qq = bf2f(row[PC_Q + h * 64 + F.lane]), vv = bf2f(row[PC_V + h * 128 + dv]);
            S = __expf(la) * S + kk * vv;
            const float o = wave_sum(qq * S);
            if (F.lane == 0) OF[((size_t)dir * TT + m) * 512 + h * 128 + dv] = (bf16)f2bf(o);
        }
    }
}
__device__ __forceinline__ void gla_out_naive(const Frame& F, const CAS Args* a, int l) {
    const bf16* P = (const bf16*)(F.ws + WS_P); bf16* MIX = (bf16*)(F.ws + WS_MIX);
    const bf16* OF = (const bf16*)(F.ws + WS_GL);
    const int rows = (l == 0) ? TT : TL;
    for (int m = F.gw; m < rows; m += F.NGW) {
        const int c0 = 8 * F.lane;
        const u32x4 wa = *(const u32x4*)(OF + (size_t)m * 512 + c0), wb = *(const u32x4*)(OF + ((size_t)TT + m) * 512 + c0);
        float o[8] = {bflo(wa.x) + bflo(wb.x), bfhi(wa.x) + bfhi(wb.x), bflo(wa.y) + bflo(wb.y), bfhi(wa.y) + bfhi(wb.y), bflo(wa.z) + bflo(wb.z), bfhi(wa.z) + bfhi(wb.z), bflo(wa.w) + bflo(wb.w), bfhi(wa.w) + bfhi(wb.w)};
        float ss = 0.f;
#pragma unroll
        for (int i = 0; i < 8; ++i) ss += o[i] * o[i];
        ss = row16_sum(ss);
        const float rstd = 1.0f / sqrtf(ss * (1.0f / 128.0f) + EPS);
        const u32x4 wg = *(const u32x4*)(P + (size_t)m * NIN + PC_G + c0);
        const float g[8] = {bflo(wg.x), bfhi(wg.x), bflo(wg.y), bfhi(wg.y), bflo(wg.z), bfhi(wg.z), bflo(wg.w), bfhi(wg.w)};
        const f32x4 n0 = *(const f32x4*)(a->in[I_GLANORM] + l * 512 + c0), n1 = *(const f32x4*)(a->in[I_GLANORM] + l * 512 + c0 + 4);
        float r[8];
#pragma unroll
        for (int i = 0; i < 8; ++i) r[i] = o[i] * rstd * (i < 4 ? n0[i] : n1[i - 4]) * silu_f(g[i]);
        u32x4 w; w.x = pk2(r[0], r[1]); w.y = pk2(r[2], r[3]); w.z = pk2(r[4], r[5]); w.w = pk2(r[6], r[7]);
        *(u32x4*)(MIX + (size_t)m * D + c0) = w;
    }
}

constexpr int N2_WHI = 0, N2_WLO = 32768, N2_HHI = 65536, N2_HLO = 98304, N2_PART = 132096, N2_CNT = N2_PART + 8192, N2_RT = 20;
static_assert(N2_CNT + 256 + NWAVES * N2_RT * 16 <= LDS_BYTES && N2_PART >= MISC_OFF + 64 + 128, "N2 LDS map");
__device__ __forceinline__ int n2_addr(int r, int k) { return r * 2048 + ((((k >> 3) ^ r) & 127) << 4) + (k & 7) * 2; }
__device__ __forceinline__ void n2_route_phase(const Frame& F, const CAS Args* a, int l, bool do_route, int cset) {
    unsigned char* ws = F.ws;
    const float* mod = (const float*)(ws + WS_MOD);
    bf16* H = (bf16*)(ws + WS_H);
    unsigned* cnt = (unsigned*)(ws + WS_CTL) + CW_CNT + cset * NE * CNT_STRIDE;
    unsigned* list = (unsigned*)(ws + WS_LIST); float* listw = (float*)(ws + WS_LISTW);
    LAS unsigned* lcnt = (LAS unsigned*)(F.lds + N2_CNT); LAS unsigned* lbase = lcnt + 16; LAS unsigned* rec = lcnt + 64;
    for (int i = F.tid; i < D * NE; i += NWAVES * 64) { const int e = i & 15, k = i >> 4; const float w = a->in[I_WROUTER][i];
        const unsigned hi = f2bf(w); const unsigned lo = f2bf(w - bf2f(hi));
        *(LAS bf16*)(F.lds + N2_WHI + n2_addr(e, k)) = (bf16)hi; *(LAS bf16*)(F.lds + N2_WLO + n2_addr(e, k)) = (bf16)lo; }
    if (F.tid < 32) lcnt[F.tid] = 0u;
    __syncthreads();
    const int rows = (l == 0) ? TT : TL;
    const int t0 = F.gw;
    const int nch = (rows - F.vcu * NWAVES + F.NGW - 1) / F.NGW;
    f32x4 xc[2][4], xq[2][4];
#pragma unroll
    for (int half = 0; half < 2; ++half) { const int m = t0 + half * F.NGW;
        if (m < rows) { const float* xr = m < TL ? F.out + (size_t)m * D : (const float*)(ws + WS_XC) + (size_t)(m - TL) * D;
#pragma unroll
            for (int j = 0; j < 4; ++j) xq[half][j] = *(const f32x4*)(xr + 4 * F.lane + 256 * j); } }
    for (int c2 = 0; c2 < nch; c2 += 2) {
#pragma unroll
        for (int half = 0; half < 2; ++half)
#pragma unroll
            for (int j = 0; j < 4; ++j) xc[half][j] = xq[half][j];
#pragma unroll
        for (int half = 0; half < 2; ++half) { const int m = t0 + (c2 + 2 + half) * F.NGW;
            if (m < rows) { const float* xr = m < TL ? F.out + (size_t)m * D : (const float*)(ws + WS_XC) + (size_t)(m - TL) * D;
#pragma unroll
                for (int j = 0; j < 4; ++j) xq[half][j] = *(const f32x4*)(xr + 4 * F.lane + 256 * j); } }
#pragma unroll
        for (int half = 0; half < 2; ++half) {
            const int m = t0 + (c2 + half) * F.NGW, r = 8 * half + F.wave;
            if (m < rows) {
                const int v = m < TL ? (m >> 13) : 2;
                f32x4 x[4]; float ss = 0.f;
#pragma unroll
                for (int j = 0; j < 4; ++j) { x[j] = xc[half][j]; ss += (x[j][0] * x[j][0] + x[j][1] * x[j][1]) + (x[j][2] * x[j][2] + x[j][3] * x[j][3]); }
                const float rstd = 1.0f / sqrtf(wave_sum(ss) * (1.0f / D) + EPS);
#pragma unroll
                for (int j = 0; j < 4; ++j) {
                    const int col = 4 * F.lane + 256 * j;
                    const f32x4 nw = *(const f32x4*)(a->in[I_NORM2] + l * D + col);
                    const f32x4 sh = *(const f32x4*)(mod + (l * 3 + v) * 6144 + 3 * D + col);
                    const f32x4 sc = *(const f32x4*)(mod + (l * 3 + v) * 6144 + 4 * D + col);
                    const f32x4 h = x[j] * rstd * nw * (1.0f + sc) + sh;
                    const unsigned h0 = f2bf(h[0]), h1 = f2bf(h[1]), h2 = f2bf(h[2]), h3 = f2bf(h[3]);
                    u32x2 o; o.x = h0 | (h1 << 16); o.y = h2 | (h3 << 16);
                    *(unsigned*)((unsigned char*)H + (size_t)m * D + col) = pk4_fp8(h[0], h[1], h[2], h[3]);
                    u32x2 lo; lo.x = pk2(h[0] - bf2f(h0), h[1] - bf2f(h1)); lo.y = pk2(h[2] - bf2f(h2), h[3] - bf2f(h3));
                    const int ad = n2_addr(r, col);
                    *(LAS u32x2*)(F.lds + N2_HHI + ad) = o; *(LAS u32x2*)(F.lds + N2_HLO + ad) = lo;
                }
            }
        }
        __syncthreads();
        {
            const int rr = F.lane & 15, kg = F.lane >> 4;
            f32x4 acc = (f32x4){0.f, 0.f, 0.f, 0.f};
#pragma unroll
            for (int ks = 0; ks < 4; ++ks) {
                const int ad = n2_addr(rr, 128 * F.wave + 32 * ks + 8 * kg);
                const bf16x8 whi = *(const LAS bf16x8*)(F.lds + N2_WHI + ad), wlo = *(const LAS bf16x8*)(F.lds + N2_WLO + ad);
                const bf16x8 hhi = *(const LAS bf16x8*)(F.lds + N2_HHI + ad), hlo = *(const LAS bf16x8*)(F.lds + N2_HLO + ad);
                acc = __builtin_amdgcn_mfma_f32_16x16x32_bf16(whi, hhi, acc, 0, 0, 0);
                acc = __builtin_amdgcn_mfma_f32_16x16x32_bf16(whi, hlo, acc, 0, 0, 0);
                acc = __builtin_amdgcn_mfma_f32_16x16x32_bf16(wlo, hhi, acc, 0, 0, 0);
            }
            *(LAS f32x4*)(F.lds + N2_PART + ((F.wave * 16 + rr) * 16 + 4 * kg) * 4) = acc;
        }
        __syncthreads();
        if (F.wave == 0) {
            const int rr = F.lane & 15, eg = F.lane >> 4;
            f32x4 lg = (f32x4){0.f, 0.f, 0.f, 0.f};
#pragma unroll
            for (int w = 0; w < NWAVES; ++w) lg = lg + *(const LAS f32x4*)(F.lds + N2_PART + ((w * 16 + rr) * 16 + 4 * eg) * 4);
            const f32x4 br = *(const f32x4*)(a->in[I_BROUTER] + 4 * eg);
            float sg[4], sb[4];
#pragma unroll
            for (int i = 0; i < 4; ++i) { sg[i] = 1.0f / (1.0f + expf(-lg[i])); sb[i] = sg[i] + br[i]; }
            int i0 = 0, i1 = 0; float b0 = -1e30f, b1 = -1e30f, s0 = 0.f, s1 = 0.f;
#pragma unroll
            for (int i = 0; i < 4; ++i) { const float val = sb[i];
                if (val > b0) { b1 = b0; i1 = i0; s1 = s0; b0 = val; i0 = i; s0 = sg[i]; } else if (val > b1) { b1 = val; i1 = i; s1 = sg[i]; } }
            const float gs = b0 + b1;
            float best = gs; int bg = eg;
#pragma unroll
            for (int st = 16; st < 64; st <<= 1) {
                const float og = __builtin_bit_cast(float, __builtin_amdgcn_ds_bpermute((F.lane ^ st) << 2, __builtin_bit_cast(int, best)));
                const int oi = __builtin_amdgcn_ds_bpermute((F.lane ^ st) << 2, bg);
                if (og > best || (og == best && oi < bg)) { best = og; bg = oi; }
            }
            const int half = rr >> 3, wv = rr & 7, ch = c2 + half;
            const int m = F.vcu * NWAVES + wv + ch * F.NGW;
            if (do_route && bg == eg && m < rows) {
                const int e0 = 4 * eg + i0, e1 = 4 * eg + i1; const float inv = 1.0f / (s0 + s1);
                if (ch < N2_RT) {
                    const int slot = wv * N2_RT + ch;
                    const unsigned l0 = atomicAdd((unsigned*)(lcnt + e0), 1u), l1 = atomicAdd((unsigned*)(lcnt + e1), 1u);
                    rec[slot * 4 + 0] = (unsigned)m; rec[slot * 4 + 1] = (unsigned)e0 | ((unsigned)e1 << 8) | (l0 << 16) | (l1 << 24);
                    rec[slot * 4 + 2] = __float_as_uint(s0 * inv); rec[slot * 4 + 3] = __float_as_uint(s1 * inv);
                } else {
                    const unsigned p0 = atomicAdd(cnt + e0 * CNT_STRIDE, 1u); list[(size_t)e0 * LISTCAP + p0] = (unsigned)m * 2u; listw[(size_t)e0 * LISTCAP + p0] = s0 * inv;
                    const unsigned p1 = atomicAdd(cnt + e1 * CNT_STRIDE, 1u); list[(size_t)e1 * LISTCAP + p1] = (unsigned)m * 2u + 1u; listw[(size_t)e1 * LISTCAP + p1] = s1 * inv;
                }
            }
        }
    }
    __syncthreads();
    if (do_route) {
        if (F.tid < NE) { const unsigned c = lcnt[F.tid]; lbase[F.tid] = c ? atomicAdd(cnt + F.tid * CNT_STRIDE, c) : 0u; }
        __syncthreads();
        for (int i = F.tid; i < NWAVES * N2_RT; i += NWAVES * 64) {
            const int wv = i / N2_RT, k = i % N2_RT;
            if (F.vcu * NWAVES + wv + k * F.NGW < rows) {
                const unsigned m = rec[i * 4], pk = rec[i * 4 + 1]; const unsigned e0 = pk & 255u, e1 = (pk >> 8) & 255u, l0 = (pk >> 16) & 255u, l1 = pk >> 24;
                const unsigned p0 = lbase[e0] + l0, p1 = lbase[e1] + l1;
                list[(size_t)e0 * LISTCAP + p0] = m * 2u; listw[(size_t)e0 * LISTCAP + p0] = __uint_as_float(rec[i * 4 + 2]);
                list[(size_t)e1 * LISTCAP + p1] = m * 2u + 1u; listw[(size_t)e1 * LISTCAP + p1] = __uint_as_float(rec[i * 4 + 3]);
            }
        }
    }
    __syncthreads();
}

__device__ __forceinline__ void moe_setup(pg8::MoeOrder& S, const Frame& F, int cset, int nN) {
    unsigned* cnt = (unsigned*)(F.ws + WS_CTL) + CW_CNT + cset * NE * CNT_STRIDE;
    LAS int* tab = (LAS int*)(F.lds + MISC_OFF + 64);
    __syncthreads();
    if (F.tid == 0) { int run = 0;
        for (int e = 0; e < NE; ++e) { const int c = (int)__hip_atomic_load(cnt + e * CNT_STRIDE, __ATOMIC_RELAXED, __HIP_MEMORY_SCOPE_AGENT); tab[e] = c; run += (c + 255) >> 8; tab[16 + e] = run; } }
    __syncthreads();
    S.tab = tab; S.nN = nN; S.nunits = __builtin_amdgcn_readfirstlane(tab[31]) * nN; S.G = F.G; S.c = (int)blockIdx.x;
    S.tdone = (unsigned*)(F.ws + WS_CTL) + CW_TDONE + cset * 160 * 16; S.role = 0;
    S.list = (const unsigned*)(F.ws + WS_LIST);
}
__device__ __forceinline__ void moe1_phase(const Frame& F, const CAS Args* a, int l, int cset) {
    pg8::MoeOrder S; moe_setup(S, F, cset, 4);
    S.A = (const char*)(F.ws + WS_H); S.Bt = (const char*)(F.ws + WS_WGU) + (size_t)l * NE * D * D; S.K = D / 2; S.bstride_e = (size_t)D * D; S.gather = true; S.role = 1;
    EpiGU E{(bf16*)(F.ws + WS_HMID)};
    pg8::gemm_phase<EpiGU, pg8::MoeOrder, true>(F.lds, F.tid, S, E, SC_W1, SC_ONE);
}
__device__ __forceinline__ void moe2_phase(const Frame& F, const CAS Args* a, int l, int cset) {
    pg8::MoeOrder S; moe_setup(S, F, cset, 4);
    S.A = (const char*)(F.ws + WS_HMID); S.Bt = (const char*)(F.ws + WS_WD) + (size_t)l * NE * D * DE; S.K = DE / 2; S.bstride_e = (size_t)D * DE; S.gather = false; S.role = 2; S.c = F.G - 1 - (int)blockIdx.x;
    EpiDown E; E.Y = (bf16*)(F.ws + WS_Y); E.list = (const unsigned*)(F.ws + WS_LIST); E.listw = (const float*)(F.ws + WS_LISTW); E.tab = S.tab;
    pg8::gemm_phase<EpiDown, pg8::MoeOrder, true>(F.lds, F.tid, S, E, SC_W2, SC_HMID);
    if (l == 0 && cset == 0) convert_moe_filler(F, a, 1, S.nunits, true);
}

__device__ __forceinline__ void final_load(const Frame& F, int m, f32x4 (&x)[4]) {
    const float* mod = (const float*)(F.ws + WS_MOD);
    const bf16* Y0 = (const bf16*)(F.ws + WS_Y); const bf16* Y1 = Y0 + (size_t)TT * D;
    const int v = m >> 13; const float* xrow = F.out + (size_t)m * D;
#pragma unroll
    for (int j = 0; j < 4; ++j) {
        const int col = 4 * F.lane + 256 * j;
        const f32x4 g2 = *(const f32x4*)(mod + (3 + v) * 6144 + 5 * D + col);
        const f32x4 y = ld_y4(Y0 + (size_t)m * D + col) + ld_y4(Y1 + (size_t)m * D + col);
        x[j] = *(const f32x4*)(xrow + col) + g2 * y;
    }
}
__device__ __forceinline__ void final_row(const Frame& F, const CAS Args* a, int m, const f32x4 (&x)[4]) {
    float* xrow = F.out + (size_t)m * D; float ss = 0.f;
#pragma unroll
    for (int j = 0; j < 4; ++j) ss += (x[j][0] * x[j][0] + x[j][1] * x[j][1]) + (x[j][2] * x[j][2] + x[j][3] * x[j][3]);
    const float rstd = 1.0f / sqrtf(wave_sum(ss) * (1.0f / D) + EPS);
#pragma unroll
    for (int j = 0; j < 4; ++j) { const int col = 4 * F.lane + 256 * j; const f32x4 nw = *(const f32x4*)(a->in[I_FNORM] + col); *(f32x4*)(xrow + col) = x[j] * rstd * nw; }
}
__device__ __forceinline__ void final_phase(const Frame& F, const CAS Args* a) {
    for (int m = F.gw; m < TL; m += 2 * F.NGW) {
        const int m2 = m + F.NGW; const bool two = m2 < TL;
        f32x4 xa[4], xb[4];
        final_load(F, m, xa);
        if (two) final_load(F, m2, xb);
        final_row(F, a, m, xa);
        if (two) final_row(F, a, m2, xb);
    }
}

#ifndef NPASS
#define NPASS 1
#endif
#ifndef PROBE_PH
#define PROBE_PH -1
#endif
#ifndef PROBE_R
#define PROBE_R 3
#endif
#ifndef PROBE_UPTO
#define PROBE_UPTO -1
#endif
#ifndef PROBE_ABL
#define PROBE_ABL 0
#endif
constexpr int PH_PER_LAYER = 8;
constexpr int N_PHASES = 1 + DEPTH * PH_PER_LAYER + 1;

template <int ph0>
__device__ __forceinline__ void do_phase(Frame& F, XcdBarrier& bar, LAS unsigned char* lds, int lo, int hi) {
    constexpr int ph = ph0 % N_PHASES, pass = ph0 / N_PHASES;
    if (!(lo <= ph && ph < hi)) return;
    if (pass == 1 && (PROBE_UPTO >= 0 ? ph >= PROBE_UPTO : ph != PROBE_PH)) return;
    const CAS Args* ap;
        { int l_; asm volatile("v_mbcnt_lo_u32_b32 %0, -1, 0\n\tv_mbcnt_hi_u32_b32 %0, -1, %0" : "=v"(l_)); F.lane = l_; F.tid = F.wave * 64 + l_; ap = (const CAS Args*)__builtin_amdgcn_kernarg_segment_ptr(); asm volatile("" : "+s"(ap)); F.ws = ap->ws; F.out = (pass == 1) ? (float*)(ap->ws + WS_P) : ap->out;
          LAS unsigned char* lb_ = (LAS unsigned char*)lds; asm volatile("" : "+s"(lb_)); __builtin_assume((((unsigned)(__UINTPTR_TYPE__)lb_) & 1023u) == 0u); F.lds = lb_;
          bar.bar = (unsigned*)(F.ws + WS_CTL) + CW_BAR; bar.st = (volatile LAS unsigned*)(F.lds + MISC_OFF) + 8; }
        if (ph == 0) { if (PH_ON(10)) REP(10, true) p0_prologue(F, ap); }
        else if (ph == N_PHASES - 1) { if (PH_ON(11)) REP(11, false) final_phase(F, ap); }
        else {
            const int l = (ph - 1) / PH_PER_LAYER, s = (ph - 1) % PH_PER_LAYER;
            unsigned char* ws = F.ws;
            if (s == 0) { if (PH_ON(0)) REP(0, l == 0) n1_phase(F, ap, l); }
            else if (s == 1 && PH_ON(1)) REP(1, true) {
                pg8::DenseOrder S; S.init(ws + WS_H, ws + WS_WIN + (size_t)l * NIN * D, TT, NIN, D / 2, F.G, (int)blockIdx.x);
                EpiIn E{(bf16*)(ws + WS_P), ap->in[I_BIASF] + l * 256, ap->in[I_BIASB] + l * 256, (const float*)(ws + WS_ROPE), (const float*)(ws + WS_ROPE) + 2048};
                pg8::gemm_phase<EpiIn, pg8::DenseOrder, true>(F.lds, F.tid, S, E, SC_W1, SC_ONE);
            }
            else if (s == 2) { constexpr int abl = (pass == 1) ? PROBE_ABL : 0; if (PH_ON(2) && abl != 5) REP(2, true) swa_flash(F, ap, l, abl); if (PH_ON(12) && abl != 6) REP(12, true) gla_g1(F, l); }
            else if (s == 3) { if (PH_ON(13)) REP(13, true) gla_scan(F); }
            else if (s == 4) { if (PH_ON(3)) REP(3, true) gla_g3(F, ap, l); }
            else if (s == 5 && PH_ON(4)) REP(4, l == 0) {
                pg8::DenseOrder S; S.init(ws + WS_MIX, ws + WS_WOUT + (size_t)l * D * D * 2, l == 0 ? TT : TL, D, D, F.G, (int)blockIdx.x);
                EpiOut E{l == 0 ? ap->in[I_X] : F.out, l == 0 ? ap->in[I_CTX] : (const float*)(ws + WS_XC), F.out, (float*)(ws + WS_XC), (const float*)(ws + WS_MOD) + l * 3 * 6144};
                pg8::gemm_phase<EpiOut, pg8::DenseOrder>(F.lds, F.tid, S, E);
                if (l == 0 && pass == 0) convert_moe_filler(F, ap, 0, S.nwg);
            }
            else if (s == 6) { if (PH_ON(5)) REP(5, true) n2_route_phase(F, ap, l, rep_ == 0 || pass == 1, l + 2 * pass); }
            else { if (PH_ON(6)) { moe1_phase(F, ap, l, l + 2 * pass); moe2_phase(F, ap, l, l + 2 * pass); } }
        }
        if (ph0 + 1 < NPASS * N_PHASES) for (int rb_ = 0; rb_ < (REPEAT_S == 20 ? REPEAT_N : 1); ++rb_) xcd_barrier(bar, F.tid);
}
template <int... I>
__device__ __forceinline__ void run_all(Frame& F, XcdBarrier& bar, LAS unsigned char* lds, int lo, int hi, std::integer_sequence<int, I...>) { (do_phase<I>(F, bar, lds, lo, hi), ...); }

#ifdef VGPR_CAP
__attribute__((amdgpu_num_vgpr(VGPR_CAP)))
#endif
__global__ void __launch_bounds__(NWAVES * 64, 2) mk_fwd(Args args) {
    extern __shared__ __attribute__((aligned(16))) unsigned char lds[];
    Frame F;
    F.lds = (LAS unsigned char*)lds;
    F.tid = threadIdx.x; F.lane = F.tid & 63; F.wave = __builtin_amdgcn_readfirstlane(F.tid >> 6);
    F.G = gridDim.x; { const int bx = blockIdx.x; F.vcu = (F.G % 8 == 0) ? (bx % 8) * (F.G / 8) + bx / 8 : bx; }
    F.gw = F.vcu * NWAVES + F.wave; F.NGW = F.G * NWAVES;
    const CAS Args* ap = (const CAS Args*)__builtin_amdgcn_kernarg_segment_ptr();
    F.ws = ap->ws; F.out = ap->out;
    volatile LAS unsigned* MISC = (volatile LAS unsigned*)(F.lds + MISC_OFF);
    for (int u = F.tid; u < (LDS_BYTES - LDSCTL_OFF) / 4; u += NWAVES * 64) ((LAS unsigned*)(F.lds + LDSCTL_OFF))[u] = 0u;
    __syncthreads();
    XcdBarrier bar; bar.bar = (unsigned*)(F.ws + WS_CTL) + CW_BAR; bar.x = 0; bar.st = nullptr;
    const bool fused = (ap->ph_hi - ap->ph_lo) > 1;
    if (fused) bar = xcd_barrier_post((unsigned*)(F.ws + WS_CTL) + CW_BAR, MISC + 8);
    const int lo = ap->ph_lo, hi = ap->ph_hi;
    run_all(F, bar, (LAS unsigned char*)lds, lo, hi, std::make_integer_sequence<int, NPASS * N_PHASES>{});
}

extern "C" void kernel_launch(void* const* d_in, const int* in_sizes, int n_in, void* d_out, int out_size, void* d_ws, size_t ws_size, hipStream_t stream) {
    static int grid = 0;
    if (grid == 0) {
        if (n_in != 22 || out_size != TL * D || ws_size < WS_END) { fprintf(stderr, "kernel_launch: unexpected shapes (n_in %d out %d ws %zu)\n", n_in, out_size, ws_size); grid = -1; return; }
        int dev = 0, cus = 0, per_cu = 0;
        if (hipGetDevice(&dev) != hipSuccess || hipDeviceGetAttribute(&cus, hipDeviceAttributeMultiprocessorCount, dev) != hipSuccess) { grid = -1; return; }
        if (hipFuncSetAttribute((const void*)mk_fwd, hipFuncAttributeMaxDynamicSharedMemorySize, LDS_BYTES) != hipSuccess) { fprintf(stderr, "kernel_launch: hipFuncSetAttribute failed\n"); grid = -1; return; }
        if (hipOccupancyMaxActiveBlocksPerMultiprocessor(&per_cu, (const void*)mk_fwd, NWAVES * 64, LDS_BYTES) != hipSuccess || per_cu < 1) fprintf(stderr, "kernel_launch: occupancy query says %d\n", per_cu);
        (void)hipGetLastError();
        grid = cus;
    }
    if (grid < 0) return;
    (void)hipMemsetAsync((char*)d_ws + WS_CTL, 0, CTL_ZERO_BYTES, stream);
    Args a{};
    for (int i = 0; i < 22; ++i) a.in[i] = (const float*)d_in[i];
    a.out = (float*)d_out; a.ws = (unsigned char*)d_ws; a.li = 0; a.pad = 0;
#if MK_N_LAUNCHES == 1
    a.ph_lo = 0; a.ph_hi = N_PHASES;
    hipLaunchKernelGGL(mk_fwd, dim3(grid), dim3(NWAVES * 64), LDS_BYTES, stream, a);
#else
    for (int ph = 0; ph < N_PHASES; ++ph) { a.ph_lo = ph; a.ph_hi = ph + 1; hipLaunchKernelGGL(mk_fwd, dim3(grid), dim3(NWAVES * 64), LDS_BYTES, stream, a); }
#endif
}
```

```cpp
#include <hip/hip_runtime.h>
#include <cstdio>
#include <cstdint>
#include <utility>

#ifndef ONLY_S
#define ONLY_S -1
#endif
#define PH_ON(k) (ONLY_S < 0 || ONLY_S == (k))
#ifndef REPEAT_S
#define REPEAT_S -1
#endif
#ifndef REPEAT_N
#define REPEAT_N 4
#endif
#define REP(k, cond) for (int rep_ = 0; rep_ < ((pass == 1) ? PROBE_R : ((REPEAT_S == (k) && (cond)) ? REPEAT_N : 1)); ++rep_)
#ifndef MK_N_LAUNCHES
#define MK_N_LAUNCHES 1
#endif

#define GAS __attribute__((address_space(1)))
#define LAS __attribute__((address_space(3)))
#define CAS __attribute__((address_space(4)))
typedef unsigned short bf16;
typedef short bf16x8 __attribute__((ext_vector_type(8)));
typedef float f32x4 __attribute__((ext_vector_type(4)));
typedef float f32x2 __attribute__((ext_vector_type(2)));
typedef unsigned u32x4 __attribute__((ext_vector_type(4)));
typedef unsigned u32x2 __attribute__((ext_vector_type(2)));
typedef int v8i __attribute__((ext_vector_type(8)));

constexpr int D = 1024, SEQ = 8192, LC = 256, TL = 16384, TC = 512, TT = TL + TC, DEPTH = 2;
constexpr int NE = 16, DE = 512;
constexpr int NIN = 2816;
constexpr int PC_Q = 0, PC_K = 256, PC_V = 512, PC_G = 1024, PC_SQ = 1536, PC_SK = 2048, PC_SV = 2176, PC_GF = 2304, PC_GB = 2560;
constexpr int WIN_COLS = 2336;
constexpr float EPS = 1e-6f;
constexpr float LOG2E = 1.4426950408889634f, QSCALE = 0.125f * LOG2E;
constexpr int LISTCAP = TT;

constexpr size_t MiB = 1u << 20;
constexpr size_t WS_CTL = 0, CTL_ZERO_BYTES = 131072;
constexpr size_t WS_MOD = 1 * MiB;
constexpr size_t WS_ROPE = 1 * MiB + 256 * 1024;
constexpr size_t WS_LIST = 2 * MiB;
constexpr size_t WS_LISTW = 2 * MiB + 1536 * 1024;
constexpr size_t WS_XC = 5 * MiB;
constexpr size_t WS_WIN = 8 * MiB;
constexpr size_t WS_WOUT = 19 * MiB;
constexpr size_t WS_WGU = 23 * MiB;
constexpr size_t WS_WD = 87 * MiB;
constexpr size_t WS_H = 119 * MiB;
constexpr size_t WS_P = 152 * MiB;
constexpr size_t WS_MIX = 243 * MiB;
constexpr size_t WS_GL = 276 * MiB;
constexpr size_t WS_HMID = 152 * MiB;
constexpr size_t WS_Y = 190 * MiB;
constexpr size_t WS_END = 309 * MiB;
static_assert(WS_LIST + (size_t)NE * LISTCAP * 4 <= WS_LISTW && WS_LISTW + (size_t)NE * LISTCAP * 4 <= WS_XC, "ws map");
static_assert(WS_P + (size_t)TT * NIN * 2 <= WS_MIX && WS_MIX + (size_t)TT * D * 2 <= WS_GL, "ws map");
static_assert(WS_HMID + (size_t)37888 * 512 * 2 <= WS_Y && WS_Y + (size_t)2 * TT * D * 2 <= WS_GL, "ws map");
constexpr int CW_CNT = 8192, CNT_STRIDE = 64;
constexpr int CW_TDONE = 16384;
constexpr int CW_BAR = 4096;

__device__ __forceinline__ unsigned f2bf(float f) { unsigned u = __builtin_bit_cast(unsigned, f); return (u + 0x7fffu + ((u >> 16) & 1u)) >> 16; }
__device__ __forceinline__ unsigned pk2(float lo, float hi) { return f2bf(lo) | (f2bf(hi) << 16); }
__device__ __forceinline__ float bf2f(unsigned h) { return __builtin_bit_cast(float, h << 16); }
__device__ __forceinline__ float bflo(unsigned w) { return __builtin_bit_cast(float, w << 16); }
__device__ __forceinline__ float bfhi(unsigned w) { return __builtin_bit_cast(float, w & 0xffff0000u); }
__device__ __forceinline__ float dpp_add(float v, float t) { return v + t; }
#define DPP_F(v, ctrl, rmask) __builtin_bit_cast(float, __builtin_amdgcn_update_dpp(0, __builtin_bit_cast(int, (v)), (ctrl), (rmask), 0xF, false))
__device__ __forceinline__ float row16_sum(float v) {
    v += DPP_F(v, 0xB1, 0xF); v += DPP_F(v, 0x4E, 0xF); v += DPP_F(v, 0x141, 0xF); v += DPP_F(v, 0x140, 0xF); return v;
}
__device__ __forceinline__ float wave_sum(float v) {
    v = row16_sum(v);
    v += DPP_F(v, 0x142, 0xA); v += DPP_F(v, 0x143, 0xC);
    return __builtin_bit_cast(float, __builtin_amdgcn_readlane(__builtin_bit_cast(int, v), 63));
}
__device__ __forceinline__ float silu_f(float x) { return x / (1.0f + __expf(-x)); }
__device__ __forceinline__ unsigned pk4_fp8(float a, float b, float c, float d) {
    a = fminf(fmaxf(a, -448.f), 448.f); b = fminf(fmaxf(b, -448.f), 448.f); c = fminf(fmaxf(c, -448.f), 448.f); d = fminf(fmaxf(d, -448.f), 448.f);
    int w = __builtin_amdgcn_cvt_pk_fp8_f32(a, b, 0, false); w = __builtin_amdgcn_cvt_pk_fp8_f32(c, d, w, true); return (unsigned)w;
}
constexpr float W1_SCALE = 64.f, W2_SCALE = 32.f, HMID_SCALE = 4.f, MIX_SCALE = 4.f;
constexpr int SC_ONE = 127, SC_W1 = 121, SC_W2 = 122, SC_HMID = 125;
#define LDS_WAIT() asm volatile("s_waitcnt lgkmcnt(0)" ::: "memory")
#define VM_WAIT() asm volatile("s_waitcnt vmcnt(0)" ::: "memory")

namespace pg8 {
constexpr int BM = 256, BK = 64, HALF = 128, HTB = HALF * BK * 2, STAGE_BYTES = 8 * HTB, NXCD = 8, WGM = 8;
__host__ __device__ __forceinline__ int lds_byte(int r, int c) { const int st = (r >> 4) * 2 + (c >> 5), rr = r & 15, cc = c & 31, ob = rr * 64 + cc * 2; return st * 1024 + (ob ^ (((ob >> 9) & 1) << 5)); }
__host__ __device__ __forceinline__ void stage_rc(int b, int& R, int& C) { const int st = b / 1024, sb = b % 1024, swz = sb ^ (((sb >> 9) & 1) << 5); R = (st >> 1) * 16 + swz / 64; C = (st & 1) * 32 + (swz % 64) / 2; }
__host__ __device__ __forceinline__ int perm32(int rho) { const int n = rho >> 4, i = rho & 15; return 8 * (i >> 2) + 4 * n + (i & 3); }

struct Unit { int pm, pn, e, mt; };

__device__ __forceinline__ int xcd_remap(int wgid, int nwg) { const int q = nwg / NXCD, r = nwg % NXCD, xcd = wgid % NXCD, off = wgid / NXCD; return (xcd < r ? xcd * (q + 1) : r * (q + 1) + (xcd - r) * q) + off; }

struct DenseOrder {
    static constexpr bool DYN_A = false;
    const char* A; const char* Bt; int K; int nM, nN, nwg, G, c;
    __device__ void init(const void* A_, const void* Bt_, int M, int N, int K_, int G_, int c_) { A = (const char*)A_; Bt = (const char*)Bt_; K = K_; nM = M / BM; nN = N / BM; nwg = nM * nN; G = G_; c = c_; }
    __device__ __forceinline__ bool next(int i, Unit& u) const {
        const long L = (long)i * G + c; if (L >= nwg) return false;
        const int wgid = xcd_remap((int)L, nwg);
        const int nig = WGM * nN, gid = wgid / nig, fm = gid * WGM, gsz = (nM - fm) < WGM ? (nM - fm) : WGM;
        u.pm = fm + ((wgid % nig) % gsz); u.pn = (wgid % nig) / gsz; u.e = 0; u.mt = 0; return true;
    }
    __device__ __forceinline__ void a_ready(const Unit&, int) const {}
    __device__ __forceinline__ void done(const Unit&, int) const {}
    __device__ __forceinline__ const char* a_ptr(const Unit& u) const { return A + (size_t)u.pm * (size_t)(BM * K * 2); }
    __device__ __forceinline__ const char* b_ptr(const Unit& u) const { return Bt + (size_t)u.pn * (size_t)(BM * K * 2); }
    __device__ __forceinline__ void a_voff(const Unit&, const int (&R)[2], const int (&C)[2], unsigned (&v0)[2], unsigned (&v1)[2]) const {
#pragma unroll
        for (int i = 0; i < 2; ++i) { v0[i] = (unsigned)(R[i] * K + C[i]) * 2u; v1[i] = v0[i] + (unsigned)(HALF * K * 2); }
    }
};

struct MoeOrder {
    static constexpr bool DYN_A = true;
    const char* A; const char* Bt; int K; size_t bstride_e; int G, c, nunits, nN; bool gather;
    const unsigned* list; const LAS int* tab;
    unsigned* tdone; int role;
    __device__ __forceinline__ void a_ready(const Unit& u, int wid) const {
        if (role == 2) {
            if (wid == 0) { unsigned sp = 0;
                while (__hip_atomic_load(tdone + u.pm * 16, __ATOMIC_RELAXED, __HIP_MEMORY_SCOPE_AGENT) < 32u) { __builtin_amdgcn_s_sleep(2); if (++sp > (1u << 22)) break; }
                __builtin_amdgcn_fence(__ATOMIC_ACQUIRE, "agent"); asm volatile("s_waitcnt vmcnt(0)" ::: "memory"); }
            __builtin_amdgcn_s_barrier();
        }
    }
    __device__ __forceinline__ void done(const Unit& u, int lane) const {
        if (role == 1) { asm volatile("s_waitcnt vmcnt(0)" ::: "memory");
            if (lane == 0) __hip_atomic_fetch_add(tdone + u.pm * 16, 1u, __ATOMIC_RELAXED, __HIP_MEMORY_SCOPE_AGENT); }
    }
    __device__ __forceinline__ bool next(int i, Unit& u) const {
        const long L = (long)i * G + c; if (L >= nunits) return false;
        const int wgid = xcd_remap((int)L, nunits);
        const int tl = wgid / nN; u.pn = wgid % nN;
        int e = 0, tstart = 0;
#pragma unroll 1
        for (int k = 0; k < NE - 1; ++k) { const int te = tab[16 + k]; if (tl >= te) { e = k + 1; tstart = te; } }
        u.e = __builtin_amdgcn_readfirstlane(e); u.mt = __builtin_amdgcn_readfirstlane(tl - tstart); u.pm = tl; return true;
    }
    __device__ __forceinline__ const char* a_ptr(const Unit& u) const { return gather ? A : A + (size_t)u.pm * (size_t)(BM * K * 2); }
    __device__ __forceinline__ const char* b_ptr(const Unit& u) const { return Bt + (size_t)u.e * bstride_e + (size_t)u.pn * (size_t)(BM * K * 2); }
    __device__ __forceinline__ void a_voff(const Unit& u, const int (&R)[2], const int (&C)[2], unsigned (&v0)[2], unsigned (&v1)[2]) const {
        if (gather) {
            const int ce = tab[u.e];
            const unsigned* lp = list + (size_t)u.e * LISTCAP + u.mt * BM;
#pragma unroll
            for (int i = 0; i < 2; ++i) {
                const int r0 = R[i], r1 = R[i] + HALF;
                const unsigned t0 = (u.mt * BM + r0 < ce) ? (__builtin_nontemporal_load(lp + r0) >> 1) : 0u;
                const unsigned t1 = (u.mt * BM + r1 < ce) ? (__builtin_nontemporal_load(lp + r1) >> 1) : 0u;
                v0[i] = (t0 * (unsigned)K + (unsigned)C[i]) * 2u; v1[i] = (t1 * (unsigned)K + (unsigned)C[i]) * 2u;
            }
        } else {
#pragma unroll
            for (int i = 0; i < 2; ++i) { v0[i] = (unsigned)(R[i] * K + C[i]) * 2u; v1[i] = v0[i] + (unsigned)(HALF * K * 2); }
        }
    }
};

__device__ __forceinline__ unsigned cvt_pk_bf16(float lo, float hi) { unsigned r; asm volatile("v_cvt_pk_bf16_f32 %0, %1, %2" : "=v"(r) : "v"(lo), "v"(hi)); return r; }

template <class Epi, class Sched, bool F8 = false>
__device__ __forceinline__ void gemm_phase(LAS unsigned char* lds, int tid, const Sched& S, const Epi& E, int sc_w = 127, int sc_a = 127) {
    const int wid = __builtin_amdgcn_readfirstlane(tid >> 6), lane = tid & 63, wr = wid >> 2, wc = wid & 3, fr = lane & 15, fq = lane >> 4;
    const int K = S.K, nt = K / BK;
    int Rr[2], Cc[2]; unsigned voffB[2];
#pragma unroll
    for (int i = 0; i < 2; ++i) { int R, C; stage_rc(tid * 16 + i * 8192, R, C); const int Rb = Epi::PERM ? ((R & ~31) + perm32(R & 31)) : R;
        Rr[i] = R; Cc[i] = C; voffB[i] = (unsigned)(Rb * K + C) * 2u; }
    const size_t kstep = (size_t)(BK * 2);
    const size_t hstep = (size_t)HALF * K * 2;
    const unsigned ldsw = (unsigned)wid * 1024u;
    const int aoff = lds_byte(wr * 64 + fr, fq * 8), boff = lds_byte(wc * 32 + fr, fq * 8);
#define PG8_SA(b, h) (((b) * 2 + (h)) * HTB)
#define PG8_SB(b, h) ((4 + (b) * 2 + (h)) * HTB)
#define PG8_STAGE(bufoff, gbase, voff) do { _Pragma("unroll") for (int _i = 0; _i < 2; ++_i) \
        __builtin_amdgcn_global_load_lds((const unsigned*)((const char*)(gbase) + (voff)[_i]), (LAS unsigned*)(lds + (bufoff) + ldsw + _i * 8192), 16, 0, 0); } while (0)
#define PG8_CAT(lo_, hi_) ((v8i){(int)(lo_).x, (int)(lo_).y, (int)(lo_).z, (int)(lo_).w, (int)(hi_).x, (int)(hi_).y, (int)(hi_).z, (int)(hi_).w})
#define PG8_LDA(dst, b, h) do { _Pragma("unroll") for (int m = 0; m < 4; ++m) { if constexpr (F8) { const u32x4 l_ = *(const LAS u32x4*)(lds + PG8_SA(b, h) + aoff + m * 2048), h_ = *(const LAS u32x4*)(lds + PG8_SA(b, h) + aoff + m * 2048 + 1024); dst##8[m] = PG8_CAT(l_, h_); } \
        else { _Pragma("unroll") for (int k = 0; k < 2; ++k) dst[m][k] = *(const LAS bf16x8*)(lds + PG8_SA(b, h) + aoff + m * 2048 + k * 1024); } } } while (0)
#define PG8_LDB(dst, b, h) do { _Pragma("unroll") for (int n = 0; n < 2; ++n) { if constexpr (F8) { const u32x4 l_ = *(const LAS u32x4*)(lds + PG8_SB(b, h) + boff + n * 2048), h_ = *(const LAS u32x4*)(lds + PG8_SB(b, h) + boff + n * 2048 + 1024); dst##8[n] = PG8_CAT(l_, h_); } \
        else { _Pragma("unroll") for (int k = 0; k < 2; ++k) dst[n][k] = *(const LAS bf16x8*)(lds + PG8_SB(b, h) + boff + n * 2048 + k * 1024); } } } while (0)
#define PG8_MMA(ai, bj, At, Bt) do { __builtin_amdgcn_s_setprio(1); _Pragma("unroll") for (int m = 0; m < 4; ++m) _Pragma("unroll") for (int n = 0; n < 2; ++n) { \
        if constexpr (F8) asm volatile("v_mfma_scale_f32_16x16x128_f8f6f4 %0, %1, %2, %0, %3, %4 op_sel_hi:[0,0,0]" : "+v"(acc[ai][bj][m][n]) : "v"(Bt##8[n]), "v"(At##8[m]), "v"(sc_w), "v"(sc_a)); \
        else { _Pragma("unroll") for (int k = 0; k < 2; ++k) acc[ai][bj][m][n] = __builtin_amdgcn_mfma_f32_16x16x32_bf16(Bt[n][k], At[m][k], acc[ai][bj][m][n], 0, 0, 0); } } \
        __builtin_amdgcn_s_setprio(0); } while (0)
#define PG8_WAIT_V(n) asm volatile("s_waitcnt vmcnt(" #n ")" ::: "memory")
#define PG8_WAIT_L(n) asm volatile("s_waitcnt lgkmcnt(" #n ")" ::: "memory")
#define PG8_BAR __builtin_amdgcn_s_barrier()
#define PG8_SCHED __builtin_amdgcn_sched_barrier(0)
    Unit cur, nxt; int ui = 0;
    if (!S.next(0, cur)) return;
    f32x4 acc[2][2][4][2];
#pragma unroll
    for (int a = 0; a < 2; ++a)
#pragma unroll
        for (int b = 0; b < 2; ++b)
#pragma unroll
            for (int m = 0; m < 4; ++m)
#pragma unroll
                for (int n = 0; n < 2; ++n) acc[a][b][m][n] = (f32x4){0.f, 0.f, 0.f, 0.f};
    bf16x8 At[4][2], B0[2][2], B1[2][2]; v8i At8[4], B08[2], B18[2];
    const char* cA = S.a_ptr(cur); const char* cB = S.b_ptr(cur);
    unsigned cv0[2], cv1[2], nv0[2], nv1[2];
    S.a_ready(cur, wid);
    S.a_voff(cur, Rr, Cc, cv0, cv1);
    PG8_STAGE(PG8_SB(0, 0), cB, voffB); PG8_STAGE(PG8_SB(0, 1), cB + hstep, voffB); PG8_STAGE(PG8_SA(0, 0), cA, cv0); PG8_STAGE(PG8_SA(0, 1), cA, cv1);
    if (wr == 1) PG8_BAR;
    PG8_WAIT_V(2); PG8_BAR;
    PG8_STAGE(PG8_SB(1, 0), cB + kstep, voffB); PG8_STAGE(PG8_SA(1, 0), cA + kstep, cv0); PG8_STAGE(PG8_SB(1, 1), cB + hstep + kstep, voffB);
    PG8_WAIT_V(6); PG8_BAR;
    for (;;) {
        const bool has_next = S.next(ui + 1, nxt);
        const char* nA = has_next ? S.a_ptr(nxt) : cA; const char* nB = has_next ? S.b_ptr(nxt) : cB;
        if (has_next) S.a_voff(nxt, Rr, Cc, nv0, nv1); else { nv0[0] = cv0[0]; nv0[1] = cv0[1]; nv1[0] = cv1[0]; nv1[1] = cv1[1]; }
        if constexpr (Sched::DYN_A) asm volatile("" : "+v"(nv0[0]), "+v"(nv0[1]), "+v"(nv1[0]), "+v"(nv1[1]));
        for (int t = 0; t < nt; t += 2) {
            const bool last = (t == nt - 2);
            if (last && has_next) S.a_ready(nxt, wid);
            const char* a1 = cA + (size_t)(t + 1) * kstep;
            const char* a2 = last ? nA : cA + (size_t)(t + 2) * kstep; const char* b2 = last ? nB : cB + (size_t)(t + 2) * kstep;
            const char* a3 = a2 + kstep; const char* b3 = b2 + kstep;
            unsigned w0[2], w1[2];
            w0[0] = last ? nv0[0] : cv0[0]; w0[1] = last ? nv0[1] : cv0[1]; w1[0] = last ? nv1[0] : cv1[0]; w1[1] = last ? nv1[1] : cv1[1];
            PG8_LDB(B0, 0, 0); PG8_LDB(B1, 0, 1); PG8_SCHED; PG8_LDA(At, 0, 0); PG8_STAGE(PG8_SA(1, 1), a1, cv1);
            PG8_WAIT_V(8); PG8_WAIT_L(0); PG8_BAR; PG8_MMA(0, 0, At, B0); PG8_MMA(0, 1, At, B1); PG8_BAR; PG8_SCHED;
            PG8_LDA(At, 0, 1); PG8_STAGE(PG8_SB(0, 0), b2, voffB); PG8_STAGE(PG8_SB(0, 1), b2 + hstep, voffB); PG8_STAGE(PG8_SA(0, 0), a2, w0);
            PG8_WAIT_V(8); PG8_WAIT_L(0); PG8_BAR; PG8_MMA(1, 0, At, B0); PG8_MMA(1, 1, At, B1); PG8_BAR; PG8_SCHED;
            PG8_LDB(B0, 1, 0); PG8_LDB(B1, 1, 1); PG8_SCHED; PG8_LDA(At, 1, 0); PG8_STAGE(PG8_SA(0, 1), a2, w1);
            PG8_WAIT_V(8); PG8_WAIT_L(0); PG8_BAR; PG8_MMA(0, 0, At, B0); PG8_MMA(0, 1, At, B1); PG8_BAR; PG8_SCHED;
            PG8_LDA(At, 1, 1); PG8_STAGE(PG8_SB(1, 0), b3, voffB); PG8_STAGE(PG8_SB(1, 1), b3 + hstep, voffB); PG8_STAGE(PG8_SA(1, 0), a3, w0);
            PG8_WAIT_V(8); PG8_WAIT_L(0); PG8_BAR; PG8_MMA(1, 0, At, B0); PG8_MMA(1, 1, At, B1); PG8_BAR; PG8_SCHED;
        }
        if constexpr (F8) asm volatile("s_nop 15\n\ts_nop 15" ::: "memory");
        if (wr == 0) PG8_BAR;
        E(acc, cur, wr, wc, fr, fq);
        S.done(cur, lane);
        if (!has_next) break;
#pragma unroll
        for (int a = 0; a < 2; ++a)
#pragma unroll
            for (int b = 0; b < 2; ++b)
#pragma unroll
                for (int m = 0; m < 4; ++m)
#pragma unroll
                    for (int n = 0; n < 2; ++n) acc[a][b][m][n] = (f32x4){0.f, 0.f, 0.f, 0.f};
        cur = nxt; cA = nA; cB = nB; ++ui;
        cv0[0] = nv0[0]; cv0[1] = nv0[1]; cv1[0] = nv1[0]; cv1[1] = nv1[1];
        if (wr == 1) PG8_BAR;
    }
    PG8_WAIT_V(0);
    PG8_BAR;
#undef PG8_SA
#undef PG8_SB
#undef PG8_STAGE
#undef PG8_CAT
#undef PG8_LDA
#undef PG8_LDB
#undef PG8_MMA
#undef PG8_WAIT_V
#undef PG8_WAIT_L
#undef PG8_BAR
#undef PG8_SCHED
}
}

#define XB_TMO      128
#define XB_XCNT(j)  (256  + 64 * (j))
#define XB_XSUB(j)  (1280 + 64 * (j))
#define XB_XGEN(j)  (2304 + 64 * (j))
#define XB_TOP      3328
#define XB_TOPGEN   3392
#define XCD_BAR_WORDS 3456
#define XB_SPIN_CAP (1u << 18)
__device__ __forceinline__ unsigned xb_ld(unsigned* p)              { return __hip_atomic_load(p, __ATOMIC_RELAXED, __HIP_MEMORY_SCOPE_AGENT); }
__device__ __forceinline__ unsigned xb_add(unsigned* p, unsigned v) { return __hip_atomic_fetch_add(p, v, __ATOMIC_RELAXED, __HIP_MEMORY_SCOPE_AGENT); }
__device__ __forceinline__ unsigned xb_xcc_id() { return (unsigned)__builtin_amdgcn_s_getreg((3 << 11) | 20) & 0xFu; }
#define XB_SPIN(cond, bar) do { unsigned _sp = 0; while (cond) { __builtin_amdgcn_s_sleep(1); \
    if ((++_sp & 255u) == 0u) { if (xb_ld(&(bar)[XB_TMO])) break; if (_sp > XB_SPIN_CAP) { atomicAdd(&(bar)[XB_TMO], 1u); break; } } } } while (0)
struct XcdBarrier { unsigned* bar; unsigned x; volatile LAS unsigned* st; };
__device__ __forceinline__ XcdBarrier xcd_barrier_post(unsigned* bar, volatile LAS unsigned* st) {
    XcdBarrier b; b.bar = bar; b.x = xb_xcc_id(); b.st = st;
    if (threadIdx.x == 0) (void)xb_add(&bar[XB_XCNT(b.x)], 1u);
    return b;
}
__device__ __forceinline__ void xcd_barrier_complete(unsigned* bar, unsigned x, unsigned& nloc, unsigned& nx) {
    const unsigned G = gridDim.x * gridDim.y * gridDim.z;
    unsigned sum, cnt, mine, sp = 0u;
    for (;;) {
        sum = 0u; cnt = 0u; mine = 0u;
#pragma unroll
        for (unsigned j = 0; j < 16; ++j) { const unsigned c = xb_ld(&bar[XB_XCNT(j)]); sum += c; cnt += (c > 0u) ? 1u : 0u; mine = (j == x) ? c : mine; }
        if (sum == G) break;
        __builtin_amdgcn_s_sleep(1);
        if ((++sp & 255u) == 0u) { if (xb_ld(&bar[XB_TMO])) break; if (sp > XB_SPIN_CAP) { atomicAdd(&bar[XB_TMO], 1u); break; } }
    }
    nloc = mine > 0u ? mine : 1u; nx = cnt > 0u ? cnt : 1u;
}
__device__ __forceinline__ void xcd_barrier(const XcdBarrier& b, int tid) {
    asm volatile("s_waitcnt vmcnt(0)" ::: "memory");
    __syncthreads();
    if (tid == 0) {
        unsigned* bar = b.bar;
        __builtin_amdgcn_s_waitcnt(0);
        unsigned nloc = b.st[0], nx = b.st[1];
        if (nloc == 0u) { xcd_barrier_complete(bar, b.x, nloc, nx); b.st[0] = nloc; b.st[1] = nx; }
        const unsigned old = xb_add(&bar[XB_XSUB(b.x)], 1u);
        const unsigned gen = old / nloc;
        if (old + 1u == (gen + 1u) * nloc) {
            __builtin_amdgcn_fence(__ATOMIC_RELEASE, "agent");
            asm volatile("s_waitcnt vmcnt(0)" ::: "memory");
            const unsigned og = xb_add(&bar[XB_TOP], 1u);
            const unsigned tg = og / nx;
            if (og + 1u == (tg + 1u) * nx) xb_add(&bar[XB_TOPGEN], 1u);
            else XB_SPIN(xb_ld(&bar[XB_TOPGEN]) == tg, bar);
            __builtin_amdgcn_fence(__ATOMIC_ACQUIRE, "agent");
            xb_add(&bar[XB_XGEN(b.x)], 1u);
            asm volatile("s_waitcnt vmcnt(0)" ::: "memory");
        } else {
            XB_SPIN(xb_ld(&bar[XB_XGEN(b.x)]) == gen, bar);
            __builtin_amdgcn_fence(__ATOMIC_ACQUIRE, "agent");
            asm volatile("s_waitcnt vmcnt(0)" ::: "memory");
        }
    }
    __syncthreads();
}

constexpr int NWAVES = 8;
constexpr int RING_BYTES = 131072, LDSCTL_OFF = RING_BYTES, MISC_OFF = LDSCTL_OFF + 320, LDS_BYTES = 147456;
struct Args { const float* in[22]; float* out; unsigned char* ws; int ph_lo, ph_hi, li, pad; };
enum { I_X = 0, I_C, I_CTX, I_CCTX, I_WADA, I_BADA, I_NORM1, I_NORM2, I_WIN, I_UPF, I_BIASF, I_UPB, I_BIASB, I_GLANORM, I_SINK, I_WOUT, I_WROUTER, I_BROUTER, I_WGATE, I_WUP, I_WDOWN, I_FNORM };

struct Frame {
    LAS unsigned char* lds; int tid, lane, wave, vcu, G, gw, NGW;
    unsigned char* ws; float* out;
};

__device__ __forceinline__ int rope_pos(int d) { return 8 * ((d & 15) >> 2) + 4 * (d >> 4) + (d & 3); }
__device__ __forceinline__ int gu_row(int h, int gu) { return (h >> 7) * 256 + ((h >> 6) & 1) * 128 + ((h >> 4) & 3) * 32 + ((h >> 2) & 3) * 8 + gu * 4 + (h & 3); }
struct TItem { const float* src; bf16* dst; int N, Kd, n0, rbase, mode; bool ok; float f8scale; };
__device__ __forceinline__ void titem_load(const TItem& t, int lane, f32x4 (&v)[8]) {
    const int g = lane >> 3, i8 = lane & 7;
    const float* src = t.src + (size_t)(8 * g) * t.N + 4 * i8;
#pragma unroll
    for (int q = 0; q < 8; ++q) v[q] = *(const f32x4*)(src + (size_t)q * t.N);
}
__device__ __forceinline__ void titem_store(const TItem& t, int lane, const f32x4 (&v)[8]) {
    const int g = lane >> 3, i8 = lane & 7;
#pragma unroll
    for (int i = 0; i < 4; ++i) {
        const int n = 4 * i8 + i;
        const int row = (t.mode == 0) ? t.rbase + n : (t.mode == 1) ? t.rbase + rope_pos(n) : gu_row(t.n0 + n, t.mode - 2);
        if (t.f8scale != 0.f) {
            const float sc = t.f8scale; u32x2 o; o.x = pk4_fp8(v[0][i] * sc, v[1][i] * sc, v[2][i] * sc, v[3][i] * sc); o.y = pk4_fp8(v[4][i] * sc, v[5][i] * sc, v[6][i] * sc, v[7][i] * sc);
            *(u32x2*)((unsigned char*)t.dst + (size_t)row * t.Kd + 8 * g) = o;
        } else {
            u32x4 o; o.x = pk2(v[0][i], v[1][i]); o.y = pk2(v[2][i], v[3][i]); o.z = pk2(v[4][i], v[5][i]); o.w = pk2(v[6][i], v[7][i]);
            *(u32x4*)(t.dst + (size_t)row * t.Kd + 8 * g) = o;
        }
    }
}
constexpr int IT_IN = 2 * 16 * 73, IT_OUT = 2 * 16 * 32, IT_G = 32 * 16 * 16, IT_D = 32 * 8 * 32, NITEMS = IT_IN + IT_OUT + 2 * IT_G + IT_D;
__device__ __forceinline__ TItem titem_decode(const CAS Args* a, unsigned char* ws, int it) {
    TItem t; t.ok = it < NITEMS; t.mode = 0; t.rbase = 0; t.n0 = 0; t.N = D; t.Kd = D; t.src = nullptr; t.dst = nullptr; t.f8scale = 0.f;
    if (!t.ok) return t;
    int r = it;
    if (r < IT_IN) {
        const int l = r / 1168, rr = r % 1168, kb = rr / 73, nb = rr % 73;
        if (nb == 48) { t.ok = false; return t; }
        const int n0 = nb * 32; t.n0 = n0;
        if (n0 < 1536) t.rbase = n0;
        else if (n0 < 2080) { t.rbase = PC_SQ + (n0 - 1568); t.mode = 1; }
        else if (n0 < 2208) { t.rbase = PC_SK + (n0 - 2080); t.mode = 1; }
        else t.rbase = PC_SV + (n0 - 2208);
        t.N = WIN_COLS; t.Kd = D; t.src = a->in[I_WIN] + (size_t)l * D * WIN_COLS + (size_t)(kb * 64) * WIN_COLS + n0; t.dst = (bf16*)(ws + WS_WIN + (size_t)l * NIN * D + kb * 64); t.f8scale = W1_SCALE;
        return t;
    }
    r -= IT_IN;
    if (r < IT_OUT) { const int l = r / 512, rr = r % 512, kb = rr / 32, nb = rr % 32;
        t.n0 = nb * 32; t.rbase = nb * 32; t.N = D; t.Kd = D; t.src = a->in[I_WOUT] + (size_t)l * D * D + (size_t)(kb * 64) * D + nb * 32; t.dst = (bf16*)(ws + WS_WOUT + (size_t)l * D * D + kb * 64); t.f8scale = W1_SCALE; return t; }
    r -= IT_OUT;
    if (r < 2 * IT_G) { const int gu = r / IT_G, r2 = r % IT_G, le = r2 / 256, rr = r2 % 256, kb = rr / 16, nb = rr % 16;
        t.n0 = nb * 32; t.mode = 2 + gu; t.N = DE; t.Kd = D; t.src = a->in[gu ? I_WUP : I_WGATE] + (size_t)le * D * DE + (size_t)(kb * 64) * DE + nb * 32; t.dst = (bf16*)(ws + WS_WGU + (size_t)le * D * D + kb * 64); t.f8scale = W1_SCALE; return t; }
    r -= 2 * IT_G;
    { const int le = r / 256, rr = r % 256, kb = rr / 32, nb = rr % 32;
        t.n0 = nb * 32; t.rbase = nb * 32; t.N = D; t.Kd = DE; t.src = a->in[I_WDOWN] + (size_t)le * DE * D + (size_t)(kb * 64) * D + nb * 32; t.dst = (bf16*)(ws + WS_WD + (size_t)le * D * DE + kb * 64); t.f8scale = W2_SCALE; }
    return t;
}

template <class Map>
__device__ __forceinline__ void convert_items(const Frame& F, const CAS Args* a, int n, int worker, int nworkers, Map map) {
    unsigned char* ws = F.ws;
    for (int i = worker; i < n; i += 2 * nworkers) {
        const int i2 = i + nworkers;
        const TItem ta = titem_decode(a, ws, map(i)), tb = titem_decode(a, ws, i2 < n ? map(i2) : NITEMS);
        f32x4 va[8], vb[8];
        if (ta.ok) titem_load(ta, F.lane, va);
        if (tb.ok) titem_load(tb, F.lane, vb);
        if (ta.ok) titem_store(ta, F.lane, va);
        if (tb.ok) titem_store(tb, F.lane, vb);
    }
}
struct MapSmall { __device__ __forceinline__ int operator()(int i) const { return i; } };
struct MapMoe { int l; __device__ __forceinline__ int operator()(int i) const { const int kind = i >> 12, r = i & 4095; return IT_IN + IT_OUT + (kind < 2 ? kind * IT_G : 2 * IT_G) + l * 4096 + r; } };
__device__ __forceinline__ void convert_moe_filler(const Frame& F, const CAS Args* a, int l, int nunits, bool both = false) {
    const int c = (int)blockIdx.x, nfull = nunits % F.G;
    int first = nfull, nf = F.G - nfull - (both ? nfull : 0);
    if (nfull == 0 || nf <= 0) { first = 0; nf = F.G; }
    if (c < first || c >= first + nf) return;
    convert_items(F, a, 3 * 4096, (c - first) * NWAVES + F.wave, nf * NWAVES, MapMoe{l});
}

__device__ __forceinline__ void p0_prologue(const Frame& F, const CAS Args* a) {
    unsigned char* ws = F.ws;
    convert_items(F, a, IT_IN + IT_OUT, F.gw, F.NGW, MapSmall{});
    for (int idx = F.gw * 64 + F.lane; idx < 2 * 2 * 256 * 128; idx += F.NGW * 64) {
        const int kc = idx & 127, n = (idx >> 7) & 255, dir = (idx >> 15) & 1, l = idx >> 16;
        const float* up = a->in[dir ? I_UPB : I_UPF] + (size_t)l * 16 * 256 + n;
        float u[16];
#pragma unroll
        for (int r = 0; r < 16; ++r) u[r] = up[r * 256];
        float o[8];
#pragma unroll
        for (int kk = 0; kk < 8; ++kk) {
            const f32x4* wz = (const f32x4*)(a->in[I_WIN] + ((size_t)l * D + kc * 8 + kk) * WIN_COLS + 1536 + dir * 16);
            float s = 0.f;
#pragma unroll
            for (int q = 0; q < 4; ++q) { const f32x4 w = wz[q]; s += w[0] * u[4 * q] + w[1] * u[4 * q + 1] + w[2] * u[4 * q + 2] + w[3] * u[4 * q + 3]; }
            o[kk] = s;
        }
        u32x2 ov; ov.x = pk4_fp8(o[0] * W1_SCALE, o[1] * W1_SCALE, o[2] * W1_SCALE, o[3] * W1_SCALE); ov.y = pk4_fp8(o[4] * W1_SCALE, o[5] * W1_SCALE, o[6] * W1_SCALE, o[7] * W1_SCALE);
        *(u32x2*)(ws + WS_WIN + ((size_t)l * NIN + PC_GF + dir * 256 + n) * D + kc * 8) = ov;
    }
    if (blockIdx.x == (unsigned)(F.G - 1)) {
        float* tc = (float*)(ws + WS_ROPE); float* tsn = tc + 2048;
        for (int i = F.tid; i < 2048; i += NWAVES * 64) { const int pos = i >> 4, j = i & 15; const float inv = powf(10000.0f, -(float)j * (1.0f / 16.0f)); const float ang = (float)pos * inv;
            tc[i] = cosf(ang); tsn[i] = sinf(ang); }
    }
    __syncthreads();
    {
        LAS float* cs = (LAS float*)F.lds; LAS float* red = cs + 3072;
        for (int i = F.tid; i < 3072; i += NWAVES * 64) { const int v = i >> 10, k = i & 1023; const float cv = v < 2 ? a->in[I_C][v * D + k] : a->in[I_CCTX][k]; cs[i] = cv / (1.0f + expf(-cv)); }
        __syncthreads();
        for (int u = blockIdx.x; u < 192; u += F.G) {
            const int l = u / 96, jg = u % 96, jl = F.tid & 63, ks = F.tid >> 6;
            const float* wp = a->in[I_WADA] + ((size_t)l * D + ks * 128) * 6144 + jg * 64 + jl;
            float a0 = 0.f, a1 = 0.f, a2 = 0.f;
#pragma unroll 1
            for (int k0 = 0; k0 < 128; k0 += 32) {
                float wv[32];
#pragma unroll
                for (int k = 0; k < 32; ++k) wv[k] = wp[(size_t)(k0 + k) * 6144];
#pragma unroll
                for (int k = 0; k < 32; ++k) { const int kk = ks * 128 + k0 + k; a0 += cs[kk] * wv[k]; a1 += cs[1024 + kk] * wv[k]; a2 += cs[2048 + kk] * wv[k]; }
            }
            red[(ks * 3 + 0) * 64 + jl] = a0; red[(ks * 3 + 1) * 64 + jl] = a1; red[(ks * 3 + 2) * 64 + jl] = a2;
            __syncthreads();
            if (F.tid < 192) { const int v = F.tid >> 6, j2 = F.tid & 63; float s = 0.f;
#pragma unroll
                for (int q = 0; q < 8; ++q) s += red[(q * 3 + v) * 64 + j2];
                ((float*)(ws + WS_MOD))[(l * 3 + v) * 6144 + jg * 64 + j2] = s + a->in[I_BADA][l * 6144 + jg * 64 + j2]; }
            __syncthreads();
        }
    }
}

__device__ __forceinline__ f32x4 ld_y4(const bf16* p) { const u32x2 w = *(const u32x2*)p; return (f32x4){bflo(w.x), bfhi(w.x), bflo(w.y), bfhi(w.y)}; }
__device__ __forceinline__ void n1_load(const Frame& F, const CAS Args* a, int l, int m, f32x4 (&x)[4], f32x4 (&y)[4]) {
    unsigned char* ws = F.ws;
    const bf16* Y0 = (const bf16*)(ws + WS_Y); const bf16* Y1 = Y0 + (size_t)TT * D;
    const float* src = (l == 0) ? (m < TL ? a->in[I_X] + (size_t)m * D : a->in[I_CTX] + (size_t)(m - TL) * D) : (m < TL ? F.out + (size_t)m * D : (const float*)(ws + WS_XC) + (size_t)(m - TL) * D);
#pragma unroll
    for (int j = 0; j < 4; ++j) { const int col = 4 * F.lane + 256 * j; x[j] = *(const f32x4*)(src + col);
        if (l > 0) y[j] = ld_y4(Y0 + (size_t)m * D + col) + ld_y4(Y1 + (size_t)m * D + col); }
}
__device__ __forceinline__ void n1_row(const Frame& F, const CAS Args* a, int l, int m, f32x4 (&x)[4], const f32x4 (&y)[4]) {
    unsigned char* ws = F.ws;
    const float* mod = (const float*)(ws + WS_MOD);
    bf16* H = (bf16*)(ws + WS_H);
    const int v = m < TL ? (m >> 13) : 2;
    float* xrow = m < TL ? F.out + (size_t)m * D : (float*)(ws + WS_XC) + (size_t)(m - TL) * D;
    float ss = 0.f;
#pragma unroll
    for (int j = 0; j < 4; ++j) {
        const int col = 4 * F.lane + 256 * j;
        if (l > 0) { const f32x4 g2 = *(const f32x4*)(mod + ((l - 1) * 3 + v) * 6144 + 5 * D + col); x[j] = x[j] + g2 * y[j]; *(f32x4*)(xrow + col) = x[j]; }
        ss += (x[j][0] * x[j][0] + x[j][1] * x[j][1]) + (x[j][2] * x[j][2] + x[j][3] * x[j][3]);
    }
    const float rstd = 1.0f / sqrtf(wave_sum(ss) * (1.0f / D) + EPS);
#pragma unroll
    for (int j = 0; j < 4; ++j) {
        const int col = 4 * F.lane + 256 * j;
        const f32x4 nw = *(const f32x4*)(a->in[I_NORM1] + l * D + col);
        const f32x4 sh = *(const f32x4*)(mod + (l * 3 + v) * 6144 + 0 * D + col);
        const f32x4 sc = *(const f32x4*)(mod + (l * 3 + v) * 6144 + 1 * D + col);
        const f32x4 h = x[j] * rstd * nw * (1.0f + sc) + sh;
        *(unsigned*)((unsigned char*)H + (size_t)m * D + col) = pk4_fp8(h[0], h[1], h[2], h[3]);
    }
}
__device__ __forceinline__ void n1_phase(const Frame& F, const CAS Args* a, int l) {
    for (int m = F.gw; m < TT; m += 2 * F.NGW) {
        const int m2 = m + F.NGW; const bool two = m2 < TT;
        f32x4 xa[4], ya[4], xb[4], yb[4];
        n1_load(F, a, l, m, xa, ya);
        if (two) n1_load(F, a, l, m2, xb, yb);
        n1_row(F, a, l, m, xa, ya);
        if (two) n1_row(F, a, l, m2, xb, yb);
    }
}

struct EpiIn {
    static constexpr bool PERM = true;
    bf16* P; const float* bias_f; const float* bias_b; const float* tcos; const float* tsin;
    __device__ __forceinline__ void operator()(const f32x4 (&acc)[2][2][4][2], const pg8::Unit& u, int wr, int wc, int fr, int fq) const {
        const int row0 = u.pm * 256 + wr * 64 + fr, colw = wc * 32 + 8 * fq;
        const int pn = u.pn;
        const bool latent = u.pm < 64;
        const bool rope = latent && (pn == 6 || pn == 7 || pn == 8);
        f32x4 cs[4], sn[4], b0[2], b1[2];
        if (pn >= 9) {
#pragma unroll
            for (int bj = 0; bj < 2; ++bj) { const float* bp = (pn == 9 ? bias_f : bias_b) + colw + bj * 128; b0[bj] = *(const f32x4*)bp; b1[bj] = *(const f32x4*)(bp + 4); }
        }
#pragma unroll
        for (int ai = 0; ai < 2; ++ai) {
            if (rope) {
#pragma unroll
                for (int m = 0; m < 4; ++m) { const int t = (row0 + ai * 128 + m * 16) & (SEQ - 1); const int pos = (wc & 1) ? (t & 63) : (t >> 6);
                    cs[m] = *(const f32x4*)(tcos + pos * 16 + 4 * fq); sn[m] = *(const f32x4*)(tsin + pos * 16 + 4 * fq); }
            }
#pragma unroll
            for (int m = 0; m < 4; ++m) {
                const int row = row0 + ai * 128 + m * 16;
                bf16* rowp = P + (size_t)row * NIN + pn * 256 + colw;
#pragma unroll
                for (int bj = 0; bj < 2; ++bj) {
                    f32x4 v0 = acc[ai][bj][m][0], v1 = acc[ai][bj][m][1];
                    if (pn == 0) { v0 = v0 * 0.125f; v1 = v1 * 0.125f; }
                    else if (pn >= 9) {
#pragma unroll
                        for (int i = 0; i < 4; ++i) { float x0 = v0[i] + b0[bj][i], x1 = v1[i] + b1[bj][i];
                            v0[i] = (fminf(x0, 0.f) - __logf(1.0f + __expf(-fabsf(x0)))) * 0.0625f; v1[i] = (fminf(x1, 0.f) - __logf(1.0f + __expf(-fabsf(x1)))) * 0.0625f; }
                    } else if (rope && (pn != 8 || bj == 0)) {
                        const f32x4 o0 = v0 * cs[m] - v1 * sn[m], o1 = v1 * cs[m] + v0 * sn[m]; v0 = o0; v1 = o1;
                    }
                    if (pn == 6 || pn == 7) { v0 = v0 * QSCALE; v1 = v1 * QSCALE; }
                    u32x4 w; w.x = pg8::cvt_pk_bf16(v0[0], v0[1]); w.y = pg8::cvt_pk_bf16(v0[2], v0[3]); w.z = pg8::cvt_pk_bf16(v1[0], v1[1]); w.w = pg8::cvt_pk_bf16(v1[2], v1[3]);
                    *(u32x4*)(rowp + bj * 128) = w;
                }
            }
            asm volatile("" ::: "memory");
        }
    }
};
struct EpiOut {
    static constexpr bool PERM = false;
    const float* resL; const float* resC; float* outL; float* outC; const float* mod_l;
    __device__ __forceinline__ void operator()(const f32x4 (&acc)[2][2][4][2], const pg8::Unit& u, int wr, int wc, int fr, int fq) const {
        const bool latent = u.pm < 64;
        const int v = latent ? (u.pm >> 5) : 2;
        const int rowb = (latent ? u.pm * 256 : u.pm * 256 - TL) + wr * 64 + fr;
        const float* res = latent ? resL : resC; float* out = latent ? outL : outC;
        const int col0 = u.pn * 256 + wc * 32 + 4 * fq;
        const float* g1p = mod_l + v * 6144 + 2 * D + col0;
        f32x4 g1[2][2];
#pragma unroll
        for (int bj = 0; bj < 2; ++bj)
#pragma unroll
            for (int n = 0; n < 2; ++n) g1[bj][n] = *(const f32x4*)(g1p + bj * 128 + n * 16);
#pragma unroll
        for (int ai = 0; ai < 2; ++ai)
#pragma unroll
            for (int mp = 0; mp < 4; mp += 2) {
                f32x4 r[2][2][2];
#pragma unroll
                for (int m = 0; m < 2; ++m) { const size_t off = (size_t)(rowb + ai * 128 + (mp + m) * 16) * D + col0;
#pragma unroll
                    for (int bj = 0; bj < 2; ++bj)
#pragma unroll
                        for (int n = 0; n < 2; ++n) r[m][bj][n] = *(const f32x4*)(res + off + bj * 128 + n * 16); }
#pragma unroll
                for (int m = 0; m < 2; ++m) { const size_t off = (size_t)(rowb + ai * 128 + (mp + m) * 16) * D + col0;
#pragma unroll
                    for (int bj = 0; bj < 2; ++bj)
#pragma unroll
                        for (int n = 0; n < 2; ++n) *(f32x4*)(out + off + bj * 128 + n * 16) = r[m][bj][n] + g1[bj][n] * acc[ai][bj][mp + m][n]; }
                asm volatile("" ::: "memory");
            }
    }
};
struct EpiGU {
    static constexpr bool PERM = true;
    bf16* Hmid;
    __device__ __forceinline__ void operator()(const f32x4 (&acc)[2][2][4][2], const pg8::Unit& u, int wr, int wc, int fr, int fq) const {
        const int row0 = u.pm * 256 + wr * 64 + fr, hid0 = u.pn * 128 + wc * 16 + fq * 4;
#pragma unroll
        for (int ai = 0; ai < 2; ++ai)
#pragma unroll
            for (int m = 0; m < 4; ++m) {
                unsigned char* rowp = (unsigned char*)Hmid + (size_t)(row0 + ai * 128 + m * 16) * DE + hid0;
#pragma unroll
                for (int bj = 0; bj < 2; ++bj) {
                    const f32x4 g = acc[ai][bj][m][0], up = acc[ai][bj][m][1]; f32x4 o;
#pragma unroll
                    for (int i = 0; i < 4; ++i) o[i] = g[i] * __builtin_amdgcn_rcpf(1.0f + __expf(-g[i])) * up[i];
                    __hip_atomic_store((unsigned*)(rowp + bj * 64), pk4_fp8(o[0] * HMID_SCALE, o[1] * HMID_SCALE, o[2] * HMID_SCALE, o[3] * HMID_SCALE), __ATOMIC_RELAXED, __HIP_MEMORY_SCOPE_AGENT);
                }
            }
    }
};
struct EpiDown {
    static constexpr bool PERM = true;
    bf16* Y; const unsigned* list; const float* listw; const LAS int* tab;
    __device__ __forceinline__ void operator()(const f32x4 (&acc)[2][2][4][2], const pg8::Unit& u, int wr, int wc, int fr, int fq) const {
        const int ce = tab[u.e];
        const int r0 = u.mt * 256 + wr * 64 + fr, col0 = u.pn * 256 + wc * 32 + 8 * fq;
        const unsigned* lp = list + (size_t)u.e * LISTCAP; const float* lw = listw + (size_t)u.e * LISTCAP;
        unsigned tsv[2][4]; float wv[2][4];
#pragma unroll
        for (int ai = 0; ai < 2; ++ai)
#pragma unroll
            for (int m = 0; m < 4; ++m) { const int r = r0 + ai * 128 + m * 16; const bool ok = r < ce; tsv[ai][m] = ok ? __builtin_nontemporal_load(lp + r) : 0xffffffffu; wv[ai][m] = ok ? __builtin_nontemporal_load(lw + r) : 0.f; }
#pragma unroll
        for (int ai = 0; ai < 2; ++ai)
#pragma unroll
            for (int m = 0; m < 4; ++m) {
                const unsigned ts = tsv[ai][m]; const float w = wv[ai][m];
                if (ts != 0xffffffffu) {
                    bf16* rowp = Y + ((size_t)(ts & 1u) * TT + (ts >> 1)) * D + col0;
#pragma unroll
                    for (int bj = 0; bj < 2; ++bj) {
                        const f32x4 v0 = acc[ai][bj][m][0] * w, v1 = acc[ai][bj][m][1] * w;
                        u32x4 o; o.x = pg8::cvt_pk_bf16(v0[0], v0[1]); o.y = pg8::cvt_pk_bf16(v0[2], v0[3]); o.z = pg8::cvt_pk_bf16(v1[0], v1[1]); o.w = pg8::cvt_pk_bf16(v1[2], v1[3]);
                        *(u32x4*)(rowp + bj * 128) = o;
                    }
                }
            }
    }
};

__device__ __forceinline__ void swa_naive(const Frame& F, const CAS Args* a, int l) {
    const bf16* P = (const bf16*)(F.ws + WS_P); bf16* MIX = (bf16*)(F.ws + WS_MIX);
    const int total = (l == 0 ? TT : TL) * 8;
    for (int idx = F.gw * 64 + F.lane; idx < total; idx += F.NGW * 64) {
        const int m = idx >> 3, hq = idx & 7, kvh = hq >> 2;
        const bool latent = m < TL;
        const int b = latent ? (m >> 13) : ((m - TL) >> 8), t = m & (SEQ - 1);
        float q[64];
        { const u32x4* qp = (const u32x4*)(P + (size_t)m * NIN + PC_SQ + hq * 64);
#pragma unroll
          for (int c = 0; c < 8; ++c) { const u32x4 w = qp[c]; q[8 * c] = bflo(w.x); q[8 * c + 1] = bfhi(w.x); q[8 * c + 2] = bflo(w.y); q[8 * c + 3] = bfhi(w.y);
              q[8 * c + 4] = bflo(w.z); q[8 * c + 5] = bfhi(w.z); q[8 * c + 6] = bflo(w.w); q[8 * c + 7] = bfhi(w.w); } }
        float o[64];
#pragma unroll
        for (int d = 0; d < 64; ++d) o[d] = 0.f;
        const float sink = a->in[I_SINK][l * 8 + hq] * LOG2E;
        float mx = sink, den = 1.0f;
        const int lo = latent ? (t - 128 < 0 ? 0 : t - 128) : 0, hi = latent ? (t + 128 > SEQ - 1 ? SEQ - 1 : t + 128) : -1;
        const int nloc = hi - lo + 1;
        for (int kk = 0; kk < nloc + LC; ++kk) {
            const int krow = kk < nloc ? b * SEQ + lo + kk : TL + b * LC + (kk - nloc);
            const u32x4* kp = (const u32x4*)(P + (size_t)krow * NIN + PC_SK + kvh * 64);
            float s = 0.f;
#pragma unroll
            for (int c = 0; c < 8; ++c) { const u32x4 w = kp[c]; s += q[8 * c] * bflo(w.x) + q[8 * c + 1] * bfhi(w.x) + q[8 * c + 2] * bflo(w.y) + q[8 * c + 3] * bfhi(w.y)
                + q[8 * c + 4] * bflo(w.z) + q[8 * c + 5] * bfhi(w.z) + q[8 * c + 6] * bflo(w.w) + q[8 * c + 7] * bfhi(w.w); }
            const float mn = fmaxf(mx, s), f = exp2f(mx - mn), p = exp2f(s - mn);
            den = den * f + p; mx = mn;
            const u32x4* vp = (const u32x4*)(P + (size_t)krow * NIN + PC_SV + kvh * 64);
#pragma unroll
            for (int c = 0; c < 8; ++c) { const u32x4 w = vp[c];
                o[8 * c] = o[8 * c] * f + p * bflo(w.x); o[8 * c + 1] = o[8 * c + 1] * f + p * bfhi(w.x); o[8 * c + 2] = o[8 * c + 2] * f + p * bflo(w.y); o[8 * c + 3] = o[8 * c + 3] * f + p * bfhi(w.y);
                o[8 * c + 4] = o[8 * c + 4] * f + p * bflo(w.z); o[8 * c + 5] = o[8 * c + 5] * f + p * bfhi(w.z); o[8 * c + 6] = o[8 * c + 6] * f + p * bflo(w.w); o[8 * c + 7] = o[8 * c + 7] * f + p * bfhi(w.w); }
        }
        const float inv = 1.0f / den;
        u32x4* op = (u32x4*)(MIX + (size_t)m * D + 512 + hq * 64);
#pragma unroll
        for (int c = 0; c < 8; ++c) { u32x4 w; w.x = pk2(o[8 * c] * inv, o[8 * c + 1] * inv); w.y = pk2(o[8 * c + 2] * inv, o[8 * c + 3] * inv); w.z = pk2(o[8 * c + 4] * inv, o[8 * c + 5] * inv); w.w = pk2(o[8 * c + 6] * inv, o[8 * c + 7] * inv); op[c] = w; }
    }
}


typedef float f32x16 __attribute__((ext_vector_type(16)));
typedef short s16x4 __attribute__((ext_vector_type(4)));
__device__ __forceinline__ int crow(int r, int hi) { return (r & 3) + 8 * (r >> 2) + 4 * hi; }
__device__ __forceinline__ s16x4 vtr(const LAS unsigned char* p) { return __builtin_bit_cast(s16x4, __builtin_amdgcn_ds_read_tr16_b64_v4i16((LAS s16x4*)p)); }
constexpr int SWA_K = 0, SWA_V = 49152;
__device__ __forceinline__ void swa_kload(const LAS unsigned char* Kt, int kb, int lane, bf16x8 (&kf)[4]) {
    const int r32 = lane & 31, hi = lane >> 5;
#pragma unroll
    for (int d0 = 0; d0 < 4; ++d0) kf[d0] = *(const LAS bf16x8*)(Kt + (2 * d0 + hi) * 1024 + (32 * kb + r32) * 16);
}
__device__ __forceinline__ void swa_tile(const LAS unsigned char* Kt, const LAS unsigned char* Vt, const LAS unsigned char* Kn, int mtype, const bf16x8 (&qf)[2][4], bf16x8 (&kf)[4], f32x16 (&o)[2][2], float (&mrun)[2], float (&lrun)[2], int lane, int abl = 0) {
    const int r32 = lane & 31, hi = lane >> 5;
    const LAS unsigned char* vp = Vt + ((lane >> 4) & 1) * 32 + (lane & 3) * 8 + (4 * hi + ((lane & 15) >> 2)) * 64;
#pragma unroll
    for (int kb = 0; kb < 2; ++kb) {
        f32x16 s[2];
        swa_kload(Kt, kb, lane, kf);
#pragma unroll
        for (int d0 = 0; d0 < 4; ++d0)
#pragma unroll
            for (int qt = 0; qt < 2; ++qt) {
                if (d0 == 0) { f32x16 z;
#pragma unroll
                    for (int r = 0; r < 16; ++r) z[r] = 0.f;
                    s[qt] = __builtin_amdgcn_mfma_f32_32x32x16_bf16(kf[0], qf[qt][0], z, 0, 0, 0); }
                else if (abl != 4) s[qt] = __builtin_amdgcn_mfma_f32_32x32x16_bf16(kf[d0], qf[qt][d0], s[qt], 0, 0, 0);
            }
        __builtin_amdgcn_sched_barrier(0);
        s16x4 vlo[2][2], vhi[2][2];
#pragma unroll
        for (int dt = 0; dt < 2; ++dt)
#pragma unroll
            for (int sp = 0; sp < 2; ++sp) { vlo[dt][sp] = vtr(vp + dt * 4096 + (2 * kb + sp) * 1024); vhi[dt][sp] = vtr(vp + dt * 4096 + (2 * kb + sp) * 1024 + 512); }
        __builtin_amdgcn_sched_barrier(0);
        bf16x8 pf[2][2];
#pragma unroll
        for (int qt = 0; qt < 2; ++qt) {
            if (mtype != 0) {
                int thr = r32 + 32 * qt - 4 * hi - 32 * kb; asm volatile("" : "+v"(thr));
                if (mtype == 1) {
#pragma unroll
                    for (int r = 0; r < 16; ++r) { const int cc = (r & 3) + 8 * (r >> 2); if (cc < thr) s[qt][r] = -INFINITY; }
                } else {
#pragma unroll
                    for (int r = 0; r < 16; ++r) { const int cc = (r & 3) + 8 * (r >> 2); if (cc > thr) s[qt][r] = -INFINITY; }
                }
            }
            float rm = s[qt][0];
            if (abl != 1) {
#pragma unroll
            for (int r = 1; r < 16; ++r) rm = fmaxf(rm, s[qt][r]);
            }
            { auto rr = __builtin_amdgcn_permlane32_swap(__float_as_uint(rm), __float_as_uint(rm), false, false); rm = fmaxf(__uint_as_float(rr[0]), __uint_as_float(rr[1])); }
            const float mn = fmaxf(mrun[qt], rm);
            if (__any(mn > mrun[qt])) {
                const float alpha = __builtin_amdgcn_exp2f(mrun[qt] - mn);
                lrun[qt] *= alpha;
#pragma unroll
                for (int dt = 0; dt < 2; ++dt)
#pragma unroll
                    for (int r = 0; r < 16; ++r) o[dt][qt][r] *= alpha;
                mrun[qt] = mn;
            }
            float rs = 0.f;
            if (abl != 1) {
#pragma unroll
            for (int r = 0; r < 16; ++r) { const float p = __builtin_amdgcn_exp2f(s[qt][r] - mn); s[qt][r] = p; rs += p; }
            }
            lrun[qt] += rs;
#pragma unroll
            for (int sp = 0; sp < 2; ++sp) {
                u32x4 w; w.x = pg8::cvt_pk_bf16(s[qt][8 * sp + 0], s[qt][8 * sp + 1]); w.y = pg8::cvt_pk_bf16(s[qt][8 * sp + 2], s[qt][8 * sp + 3]);
                w.z = pg8::cvt_pk_bf16(s[qt][8 * sp + 4], s[qt][8 * sp + 5]); w.w = pg8::cvt_pk_bf16(s[qt][8 * sp + 6], s[qt][8 * sp + 7]);
                pf[qt][sp] = __builtin_bit_cast(bf16x8, w);
            }
        }
#pragma unroll
        for (int dt = 0; dt < 2; ++dt)
#pragma unroll
            for (int sp = 0; sp < 2; ++sp) {
                const bf16x8 vf = (bf16x8){vlo[dt][sp][0], vlo[dt][sp][1], vlo[dt][sp][2], vlo[dt][sp][3], vhi[dt][sp][0], vhi[dt][sp][1], vhi[dt][sp][2], vhi[dt][sp][3]};
#pragma unroll
                for (int qt = 0; qt < 2; ++qt) if (abl != 2) o[dt][qt] = __builtin_amdgcn_mfma_f32_32x32x16_bf16(vf, pf[qt][sp], o[dt][qt], 0, 0, 0);
            }
    }
}
__device__ __forceinline__ void swa_stage(const Frame& F, const bf16* P, int grow, int kvh, int ti) {
    { const int key = 8 * F.wave + (F.lane & 7), ch = F.lane >> 3;
      const u32x4 v = *(const u32x4*)(P + (size_t)(grow + key) * NIN + PC_SK + kvh * 64 + ch * 8);
      *(LAS u32x4*)(F.lds + SWA_K + ti * 8192 + ch * 1024 + key * 16) = v; }
    { const int key = 8 * F.wave + (F.lane >> 3), ch = F.lane & 7;
      const u32x4 v = *(const u32x4*)(P + (size_t)(grow + key) * NIN + PC_SV + kvh * 64 + ch * 8);
      *(LAS u32x4*)(F.lds + SWA_V + ti * 8192 + (ch >> 2) * 4096 + key * 64 + (ch & 3) * 16) = v; }
}
__device__ __forceinline__ void swa_flash(const Frame& F, const CAS Args* a, int l, int abl = 0) {
    const bf16* P = (const bf16*)(F.ws + WS_P); bf16* MIX = (bf16*)(F.ws + WS_MIX);
    const int nunits = 256 + (l == 0 ? 8 : 0);
    const int lane = F.lane, r32 = lane & 31, hi = lane >> 5;
    for (int u = F.vcu; u < nunits; u += F.G) {
        const bool latent = u < 256;
        const int b = latent ? (u >> 7) : ((u - 256) >> 2), kvh = latent ? ((u >> 6) & 1) : (((u - 256) >> 1) & 1), qb = latent ? (u & 63) : ((u - 256) & 1);
        const int q0 = qb * 128, g = F.wave >> 1, qs = F.wave & 1, hq = kvh * 4 + g;
        const int mrow0 = (latent ? b * SEQ : TL + b * LC) + q0 + 64 * qs;
        bf16x8 qf[2][4];
#pragma unroll
        for (int qt = 0; qt < 2; ++qt)
#pragma unroll
            for (int d0 = 0; d0 < 4; ++d0) { if (abl != 7) qf[qt][d0] = *(const bf16x8*)(P + (size_t)(mrow0 + 32 * qt + r32) * NIN + PC_SQ + hq * 64 + 16 * d0 + 8 * hi); else qf[qt][d0] = (bf16x8){(short)lane, 1, 2, 3, 4, 5, 6, 7}; }
        f32x16 o[2][2];
#pragma unroll
        for (int dt = 0; dt < 2; ++dt)
#pragma unroll
            for (int qt = 0; qt < 2; ++qt)
#pragma unroll
                for (int r = 0; r < 16; ++r) o[dt][qt][r] = 0.f;
        const float sink2 = a->in[I_SINK][l * 8 + hq] * LOG2E;
        float mrun[2] = {sink2, sink2}, lrun[2] = {hi == 0 ? 1.f : 0.f, hi == 0 ? 1.f : 0.f};
        if (latent) {
#pragma unroll 1
            for (int j = 0; j < 6; ++j) { const int ks = q0 - 128 + 64 * j; if (ks >= 0 && ks < SEQ && abl != 3) swa_stage(F, P, b * SEQ + ks, kvh, j); }
            __syncthreads();
            { int jf = qs; while (q0 - 128 + 64 * jf < 0) ++jf;
              bf16x8 kf[4]; swa_kload(F.lds + SWA_K + jf * 8192, 0, lane, kf);
#pragma unroll 1
              for (int tt = 0; tt < 5; ++tt) { const int j = qs + tt, ks = q0 - 128 + 64 * j;
                  if (ks >= 0 && ks < SEQ && abl != 8) { const int jn = (j + 1 < 6) ? j + 1 : j;
                      swa_tile(F.lds + SWA_K + j * 8192, F.lds + SWA_V + j * 8192, F.lds + SWA_K + jn * 8192, tt == 0 ? 1 : (tt == 4 ? 2 : 0), qf, kf, o, mrun, lrun, lane, abl); } } }
            __syncthreads();
        }
#pragma unroll 1
        for (int j = 0; j < 4; ++j) if (abl != 3) swa_stage(F, P, TL + b * LC + 64 * j, kvh, j);
        __syncthreads();
        { bf16x8 kf[4]; swa_kload(F.lds + SWA_K, 0, lane, kf);
#pragma unroll 1
          for (int j = 0; j < 4; ++j) if (abl != 8) swa_tile(F.lds + SWA_K + j * 8192, F.lds + SWA_V + j * 8192, F.lds + SWA_K + (j < 3 ? j + 1 : j) * 8192, 0, qf, kf, o, mrun, lrun, lane, abl); }
        __syncthreads();
#pragma unroll
        for (int qt = 0; qt < 2; ++qt) {
            float lt = lrun[qt];
            { auto rr = __builtin_amdgcn_permlane32_swap(__float_as_uint(lt), __float_as_uint(lt), false, false); lt = __uint_as_float(rr[0]) + __uint_as_float(rr[1]); }
            const float inv = 1.0f / lt;
            unsigned char* op = (unsigned char*)MIX + (size_t)(mrow0 + 32 * qt + r32) * D + 512 + hq * 64 + 4 * hi;
            const float is = inv * MIX_SCALE;
#pragma unroll
            for (int dt = 0; dt < 2; ++dt)
#pragma unroll
                for (int rg = 0; rg < 4; ++rg) {
                    const unsigned w = pk4_fp8(o[dt][qt][4 * rg] * is, o[dt][qt][4 * rg + 1] * is, o[dt][qt][4 * rg + 2] * is, o[dt][qt][4 * rg + 3] * is);
                    if (abl != 7 || w == 0x12345u) *(unsigned*)(op + 32 * dt + 8 * rg) = w;
                }
        }
    }
}


constexpr size_t WS_US = WS_GL, WS_USC = WS_GL + 32 * MiB, WS_DEC = 7 * MiB;
static_assert(WS_USC + (size_t)16 * 4 * 8192 * 2 <= WS_END && WS_DEC + (size_t)16 * 132 * 64 * 4 <= WS_WIN, "ws map (gla)");
constexpr int GL_V = 0, GL_M0 = 16384, GL_MSZ = 64 * 72 * 2, GL_RED = GL_M0 + 4 * GL_MSZ;
__device__ __forceinline__ float wave_scan_incl(float v) {
    v += DPP_F(v, 0x111, 0xF); v += DPP_F(v, 0x112, 0xF); v += DPP_F(v, 0x114, 0xF); v += DPP_F(v, 0x118, 0xF);
    v += DPP_F(v, 0x142, 0xA); v += DPP_F(v, 0x143, 0xC); return v;
}
__device__ __forceinline__ float lane63(float v) { return __builtin_bit_cast(float, __builtin_amdgcn_readlane(__builtin_bit_cast(int, v), 63)); }
__device__ __forceinline__ void unpack8(const u32x4 w, float (&f)[8]) { f[0] = bflo(w.x); f[1] = bfhi(w.x); f[2] = bflo(w.y); f[3] = bfhi(w.y); f[4] = bflo(w.z); f[5] = bfhi(w.z); f[6] = bflo(w.w); f[7] = bfhi(w.w); }
__device__ __forceinline__ void gla_stage_v(const Frame& F, const bf16* P, int m0, int h) {
#pragma unroll
    for (int i = 0; i < 2; ++i) { const int p = F.tid + 512 * i, t = p >> 4, ch = p & 15;
        const u32x4 v = *(const u32x4*)(P + (size_t)(m0 + t) * NIN + PC_V + h * 128 + ch * 8);
        *(LAS u32x4*)(F.lds + GL_V + (ch >> 2) * 4096 + t * 64 + (ch & 3) * 16) = v; }
}
__device__ __forceinline__ void gla_g1_unit(const Frame& F, const bf16* P, int m0, int h, bf16* Uf, bf16* Ub, float* decf, float* decb) {
    const int w = F.wave, t = F.lane, c = t & 31, hi = t >> 5;
    const bf16* row = P + (size_t)(m0 + t) * NIN + h * 64 + 8 * w;
    float laf[8], lab[8], kk[8];
    unpack8(*(const u32x4*)(row + PC_GF), laf); unpack8(*(const u32x4*)(row + PC_GB), lab); unpack8(*(const u32x4*)(row + PC_K), kk);
    gla_stage_v(F, P, m0, h);
    LAS bf16* KOF = (LAS bf16*)(F.lds + GL_M0); LAS bf16* KOB = (LAS bf16*)(F.lds + GL_M0 + GL_MSZ);
#pragma unroll
    for (int i = 0; i < 8; ++i) {
        const float incf = wave_scan_incl(laf[i]), tf = lane63(incf), incb = wave_scan_incl(lab[i]), tb = lane63(incb);
        KOF[(8 * w + i) * 72 + t] = (bf16)f2bf(kk[i] * __expf(tf - incf));
        KOB[(8 * w + i) * 72 + t] = (bf16)f2bf(kk[i] * __expf(incb - lab[i]));
        if (t == 0) { decf[8 * w + i] = __expf(tf); decb[8 * w + i] = __expf(tb); }
    }
    __syncthreads();
    const int dir = w >> 2, dvt = w & 3;
    const LAS unsigned char* vp = F.lds + GL_V + dvt * 4096 + ((t >> 4) & 1) * 32 + (t & 3) * 8 + ((t & 15) >> 2) * 64 + hi * 512;
    const LAS unsigned char* kb = F.lds + GL_M0 + dir * GL_MSZ + (c * 72 + 8 * hi) * 2;
    f32x16 acc[2];
#pragma unroll
    for (int j = 0; j < 2; ++j)
#pragma unroll
        for (int r = 0; r < 16; ++r) acc[j][r] = 0.f;
#pragma unroll
    for (int sp = 0; sp < 4; ++sp) {
        const s16x4 lo = vtr(vp + sp * 1024), hi4 = vtr(vp + sp * 1024 + 256);
        const bf16x8 vf = (bf16x8){lo[0], lo[1], lo[2], lo[3], hi4[0], hi4[1], hi4[2], hi4[3]};
#pragma unroll
        for (int j = 0; j < 2; ++j) { const bf16x8 kf = *(const LAS bf16x8*)(kb + j * 32 * 144 + sp * 32); acc[j] = __builtin_amdgcn_mfma_f32_32x32x16_bf16(kf, vf, acc[j], 0, 0, 0); }
    }
    bf16* U = dir ? Ub : Uf;
#pragma unroll
    for (int j = 0; j < 2; ++j) {
        u32x4 w0, w1;
        w0.x = pk2(acc[j][0], acc[j][1]); w0.y = pk2(acc[j][2], acc[j][3]); w0.z = pk2(acc[j][4], acc[j][5]); w0.w = pk2(acc[j][6], acc[j][7]);
        w1.x = pk2(acc[j][8], acc[j][9]); w1.y = pk2(acc[j][10], acc[j][11]); w1.z = pk2(acc[j][12], acc[j][13]); w1.w = pk2(acc[j][14], acc[j][15]);
        u32x4* up = (u32x4*)(U + ((j * 4 + dvt) * 64 + t) * 16);
        up[0] = w0; up[1] = w1;
    }
    __syncthreads();
}
__device__ __forceinline__ void gla_g1(const Frame& F0, int l) {
    Frame F = F0; { int l_; asm volatile("v_mbcnt_lo_u32_b32 %0, -1, 0\n\tv_mbcnt_hi_u32_b32 %0, -1, %0" : "=v"(l_)); F.lane = l_; F.tid = F.wave * 64 + l_; }
    const bf16* P = (const bf16*)(F.ws + WS_P);
    bf16* US = (bf16*)(F.ws + WS_US); bf16* USC = (bf16*)(F.ws + WS_USC); float* DEC = (float*)(F.ws + WS_DEC);
    for (int u = F.vcu; u < 1056; u += F.G) {
        const bool latent = u < 1024; const int cc = u - 1024;
        const int b = latent ? (u >> 9) : (cc >> 4), h = latent ? ((u >> 7) & 3) : ((cc >> 2) & 3), n = latent ? (u & 127) : (cc & 3);
        const int m0 = latent ? b * SEQ + 64 * n : TL + b * LC + 64 * n;
        const int sf = (b * 4 + h) * 2;
        bf16* Uf = latent ? US + ((size_t)sf * 128 + n) * 8192 : USC + ((size_t)sf * 4 + n) * 8192;
        bf16* Ub = latent ? US + ((size_t)(sf + 1) * 128 + n) * 8192 : USC + ((size_t)(sf + 1) * 4 + n) * 8192;
        const int nd = latent ? n : 128 + n;
        gla_g1_unit(F, P, m0, h, Uf, Ub, DEC + ((size_t)sf * 132 + nd) * 64, DEC + ((size_t)(sf + 1) * 132 + nd) * 64);
    }
}
constexpr size_t WS_SS = WS_H, WS_SSC = WS_H + 32 * MiB;
static_assert(WS_SSC + (size_t)16 * 4 * 8192 * 2 <= WS_P, "ws map (gla states)");
__device__ __forceinline__ void gla_scan(const Frame& F) {
    for (int w0 = (F.vcu * NWAVES + F.wave) * 64; w0 < 16 * 4096; w0 += F.G * NWAVES * 64) {
        const int seq = __builtin_amdgcn_readfirstlane(w0 >> 12), ew = __builtin_amdgcn_readfirstlane((w0 & 4095) * 2);
        const int dir = seq & 1;
        const unsigned voff = (unsigned)F.lane * 4u;
        unsigned doff;
        { const int e = ew + 2 * F.lane, r = e & 15, ln = (e >> 4) & 63, dkt = e >> 12; doff = (unsigned)(32 * dkt + (r & 3) + 8 * (r >> 2) + 4 * (ln >> 5)) * 4u; }
        const char* decb = (const char*)(F.ws + WS_DEC) + (size_t)seq * 132 * 256;
        float s0 = 0.f, s1 = 0.f;
        { const char* ub = (const char*)(F.ws + WS_USC) + ((size_t)seq * 4 * 8192 + ew) * 2; char* sb = (char*)(F.ws + WS_SSC) + ((size_t)seq * 4 * 8192 + ew) * 2;
          unsigned u[4]; f32x2 d[4];
#pragma unroll
          for (int i = 0; i < 4; ++i) { const int n = dir ? 3 - i : i; u[i] = *(const unsigned*)(ub + (size_t)n * 16384 + voff); d[i] = *(const f32x2*)(decb + (size_t)(128 + n) * 256 + doff); }
#pragma unroll
          for (int i = 0; i < 4; ++i) { const int n = dir ? 3 - i : i; *(unsigned*)(sb + (size_t)n * 16384 + voff) = pk2(s0, s1); s0 = d[i][0] * s0 + bflo(u[i]); s1 = d[i][1] * s1 + bfhi(u[i]); } }
        const long stride = dir ? -16384 : 16384, dstride = dir ? -256 : 256;
        const char* ub = (const char*)(F.ws + WS_US) + ((size_t)seq * 128 * 8192 + ew) * 2 + (dir ? (size_t)127 * 16384 : 0);
        char* sb = (char*)(F.ws + WS_SS) + ((size_t)seq * 128 * 8192 + ew) * 2 + (dir ? (size_t)127 * 16384 : 0);
        const char* db = decb + (dir ? 127 * 256 : 0);
#pragma unroll 1
        for (int i0 = 0; i0 < 128; i0 += 32) {
            unsigned u[32]; f32x2 d[32];
#pragma unroll
            for (int j = 0; j < 32; ++j) { u[j] = *(const unsigned*)(ub + j * stride + voff); d[j] = *(const f32x2*)(db + j * dstride + doff); }
#pragma unroll
            for (int j = 0; j < 32; ++j) { *(unsigned*)(sb + j * stride + voff) = pk2(s0, s1); s0 = d[j][0] * s0 + bflo(u[j]); s1 = d[j][1] * s1 + bfhi(u[j]); }
            ub += 32 * stride; sb += 32 * stride; db += 32 * dstride;
        }
    }
}
__device__ __forceinline__ void gla_g3_unit(const Frame& F, const CAS Args* a, int l, const bf16* P, int m0, int h, const bf16* Sf, const bf16* Sb, bf16* MIX) {
    const int w = F.wave, t = F.lane, c = t & 31, hi = t >> 5;
    bf16x8 sfr[4], sbr[4]; u32x2 gwv[4]; f32x4 nwv[4];
    { const int dvt_ = w >> 1, tt_ = w & 1;
#pragma unroll
      for (int kd = 0; kd < 4; ++kd) { const size_t off = (size_t)(((kd >> 1) * 4 + dvt_) * 64 + t) * 16 + 8 * (kd & 1); sfr[kd] = *(const bf16x8*)(Sf + off); sbr[kd] = *(const bf16x8*)(Sb + off); }
#pragma unroll
      for (int rg = 0; rg < 4; ++rg) { const int dv = 32 * dvt_ + 8 * rg + 4 * hi;
          gwv[rg] = *(const u32x2*)(P + (size_t)(m0 + 32 * tt_ + c) * NIN + PC_G + h * 128 + dv); nwv[rg] = *(const f32x4*)(a->in[I_GLANORM] + l * 512 + h * 128 + dv); } }
    {
        const bf16* row = P + (size_t)(m0 + t) * NIN + h * 64 + 8 * w;
        float laf[8], lab[8], kk[8], qq[8];
        unpack8(*(const u32x4*)(row + PC_GF), laf); unpack8(*(const u32x4*)(row + PC_GB), lab); unpack8(*(const u32x4*)(row + PC_K), kk); unpack8(*(const u32x4*)(row + PC_Q), qq);
        gla_stage_v(F, P, m0, h);
        float qf[8], kf[8], qb[8], kb[8];
#pragma unroll
        for (int i = 0; i < 8; ++i) {
            const float bf = wave_scan_incl(laf[i]), incb = wave_scan_incl(lab[i]), bb = lane63(incb) - incb + lab[i];
            qf[i] = qq[i] * __expf(bf); kf[i] = kk[i] * __expf(-bf); qb[i] = qq[i] * __expf(bb); kb[i] = kk[i] * __expf(-bb);
        }
        LAS unsigned char* mb = F.lds + GL_M0 + (t * 72 + 8 * w) * 2;
        u32x4 o;
        o.x = pk2(qf[0], qf[1]); o.y = pk2(qf[2], qf[3]); o.z = pk2(qf[4], qf[5]); o.w = pk2(qf[6], qf[7]); *(LAS u32x4*)(mb) = o;
        o.x = pk2(kf[0], kf[1]); o.y = pk2(kf[2], kf[3]); o.z = pk2(kf[4], kf[5]); o.w = pk2(kf[6], kf[7]); *(LAS u32x4*)(mb + GL_MSZ) = o;
        o.x = pk2(qb[0], qb[1]); o.y = pk2(qb[2], qb[3]); o.z = pk2(qb[4], qb[5]); o.w = pk2(qb[6], qb[7]); *(LAS u32x4*)(mb + 2 * GL_MSZ) = o;
        o.x = pk2(kb[0], kb[1]); o.y = pk2(kb[2], kb[3]); o.z = pk2(kb[4], kb[5]); o.w = pk2(kb[6], kb[7]); *(LAS u32x4*)(mb + 3 * GL_MSZ) = o;
    }
    __syncthreads();
    const int dvt = w >> 1, tt = w & 1;
    bf16x8 qfB[4], qbB[4], qfP[4], qbP[4];
    { const LAS unsigned char* qp = F.lds + GL_M0 + ((32 * tt + c) * 72 + 8 * hi) * 2;
#pragma unroll
      for (int kd = 0; kd < 4; ++kd) { qfB[kd] = *(const LAS bf16x8*)(qp + kd * 32); qbB[kd] = *(const LAS bf16x8*)(qp + 2 * GL_MSZ + kd * 32); }
      const LAS unsigned char* pp = F.lds + GL_M0 + ((32 * tt + c) * 72 + 4 * hi) * 2;
#pragma unroll
      for (int kd = 0; kd < 4; ++kd) {
          const u32x2 a0 = *(const LAS u32x2*)(pp + kd * 32), a1 = *(const LAS u32x2*)(pp + kd * 32 + 16);
          const u32x2 b0 = *(const LAS u32x2*)(pp + 2 * GL_MSZ + kd * 32), b1 = *(const LAS u32x2*)(pp + 2 * GL_MSZ + kd * 32 + 16);
          qfP[kd] = __builtin_bit_cast(bf16x8, (u32x4){a0.x, a0.y, a1.x, a1.y}); qbP[kd] = __builtin_bit_cast(bf16x8, (u32x4){b0.x, b0.y, b1.x, b1.y});
      } }
    bf16x8 pfr[2][2];
#pragma unroll
    for (int st = 0; st < 2; ++st) {
        const LAS unsigned char* kp = F.lds + GL_M0 + GL_MSZ + ((32 * st + c) * 72 + 8 * hi) * 2;
        f32x16 xf, xb;
#pragma unroll
        for (int r = 0; r < 16; ++r) { xf[r] = 0.f; xb[r] = 0.f; }
        const bool needF = st <= tt, needB = st >= tt;
        if (needF) {
#pragma unroll
            for (int kd = 0; kd < 4; ++kd) xf = __builtin_amdgcn_mfma_f32_32x32x16_bf16(*(const LAS bf16x8*)(kp + kd * 32), qfB[kd], xf, 0, 0, 0);
        }
        if (needB) {
#pragma unroll
            for (int kd = 0; kd < 4; ++kd) xb = __builtin_amdgcn_mfma_f32_32x32x16_bf16(*(const LAS bf16x8*)(kp + 2 * GL_MSZ + kd * 32), qbB[kd], xb, 0, 0, 0);
        }
        if (st == tt) {
            int thr = c - 4 * hi; asm volatile("" : "+v"(thr));
#pragma unroll
            for (int r = 0; r < 16; ++r) { const int cc = (r & 3) + 8 * (r >> 2); xf[r] = (cc <= thr ? xf[r] : 0.f) + (cc >= thr ? xb[r] : 0.f); }
        } else {
#pragma unroll
            for (int r = 0; r < 16; ++r) xf[r] += xb[r];
        }
#pragma unroll
        for (int sp = 0; sp < 2; ++sp) {
            u32x4 wv; wv.x = pg8::cvt_pk_bf16(xf[8 * sp + 0], xf[8 * sp + 1]); wv.y = pg8::cvt_pk_bf16(xf[8 * sp + 2], xf[8 * sp + 3]);
            wv.z = pg8::cvt_pk_bf16(xf[8 * sp + 4], xf[8 * sp + 5]); wv.w = pg8::cvt_pk_bf16(xf[8 * sp + 6], xf[8 * sp + 7]);
            pfr[st][sp] = __builtin_bit_cast(bf16x8, wv);
        }
    }
    f32x16 o;
#pragma unroll
    for (int r = 0; r < 16; ++r) o[r] = 0.f;
    { const LAS unsigned char* vp = F.lds + GL_V + dvt * 4096 + ((t >> 4) & 1) * 32 + (t & 3) * 8 + (4 * hi + ((t & 15) >> 2)) * 64;
#pragma unroll
      for (int ks = 0; ks < 4; ++ks) {
          const s16x4 lo = vtr(vp + ks * 1024), hi4 = vtr(vp + ks * 1024 + 512);
          const bf16x8 vf = (bf16x8){lo[0], lo[1], lo[2], lo[3], hi4[0], hi4[1], hi4[2], hi4[3]};
          o = __builtin_amdgcn_mfma_f32_32x32x16_bf16(vf, pfr[ks >> 1][ks & 1], o, 0, 0, 0);
      } }
#pragma unroll
    for (int kd = 0; kd < 4; ++kd) {
        o = __builtin_amdgcn_mfma_f32_32x32x16_bf16(sfr[kd], qfP[kd], o, 0, 0, 0);
        o = __builtin_amdgcn_mfma_f32_32x32x16_bf16(sbr[kd], qbP[kd], o, 0, 0, 0);
    }
    float ssq = 0.f;
#pragma unroll
    for (int r = 0; r < 16; ++r) ssq += o[r] * o[r];
    { auto rr = __builtin_amdgcn_permlane32_swap(__float_as_uint(ssq), __float_as_uint(ssq), false, false); ssq = __uint_as_float(rr[0]) + __uint_as_float(rr[1]); }
    LAS float* red = (LAS float*)(F.lds + GL_RED);
    if (hi == 0) red[dvt * 64 + 32 * tt + c] = ssq;
    __syncthreads();
    const float tot = (red[32 * tt + c] + red[64 + 32 * tt + c]) + (red[128 + 32 * tt + c] + red[192 + 32 * tt + c]);
    const float rstd = 1.0f / sqrtf(tot * (1.0f / 128.0f) + EPS);
    const int mrow = m0 + 32 * tt + c;
#pragma unroll
    for (int rg = 0; rg < 4; ++rg) {
        const int dv = 32 * dvt + 8 * rg + 4 * hi;
        const u32x2 gw = gwv[rg]; const f32x4 nw = nwv[rg];
        const float g0 = bflo(gw.x), g1 = bfhi(gw.x), g2 = bflo(gw.y), g3 = bfhi(gw.y);
        const float rs = rstd * MIX_SCALE;
        *(unsigned*)((unsigned char*)MIX + (size_t)mrow * D + h * 128 + dv) = pk4_fp8(o[4 * rg] * rs * nw[0] * silu_f(g0), o[4 * rg + 1] * rs * nw[1] * silu_f(g1), o[4 * rg + 2] * rs * nw[2] * silu_f(g2), o[4 * rg + 3] * rs * nw[3] * silu_f(g3));
    }
    __syncthreads();
}
__device__ __forceinline__ void gla_g3(const Frame& F, const CAS Args* a, int l) {
    const bf16* P = (const bf16*)(F.ws + WS_P); bf16* MIX = (bf16*)(F.ws + WS_MIX);
    const bf16* US = (const bf16*)(F.ws + WS_SS); const bf16* USC = (const bf16*)(F.ws + WS_SSC);
    const int nunits = 1024 + (l == 0 ? 32 : 0);
    for (int u = F.vcu; u < nunits; u += F.G) {
        const bool latent = u < 1024; const int cc = u - 1024;
        const int b = latent ? (u >> 9) : (cc >> 4), h = latent ? ((u >> 7) & 3) : ((cc >> 2) & 3), n = latent ? (u & 127) : (cc & 3);
        const int m0 = latent ? b * SEQ + 64 * n : TL + b * LC + 64 * n;
        const int sf = (b * 4 + h) * 2;
        const bf16* Sf = latent ? US + ((size_t)sf * 128 + n) * 8192 : USC + ((size_t)sf * 4 + n) * 8192;
        const bf16* Sb = latent ? US + ((size_t)(sf + 1) * 128 + n) * 8192 : USC + ((size_t)(sf + 1) * 4 + n) * 8192;
        gla_g3_unit(F, a, l, P, m0, h, Sf, Sb, MIX);
    }
}

__device__ __forceinline__ void gla_naive(const Frame& F, const CAS Args* a, int l) {
    const bf16* P = (const bf16*)(F.ws + WS_P);
    bf16* OF = (bf16*)(F.ws + WS_GL);
    for (int w = F.gw; w < 2048; w += F.NGW) {
        const int dv = w & 127, dir = (w >> 7) & 1, h = (w >> 8) & 3, b = w >> 10;
        const int pcg = dir ? PC_GB : PC_GF;
        float S = 0.f;
        for (int step = 0; step < LC + SEQ; ++step) {
            int m;
            if (dir == 0) m = step < LC ? TL + b * LC + step : b * SEQ + (step - LC);
            else m = step < LC ? TL + b * LC + (LC - 1 - step) : b * SEQ + (SEQ - 1 - (step - LC));
            const bf16* row = P + (size_t)m * NIN;
            const float la = bf2f(row[pcg + h * 64 + F.lane]), kk = bf2f(row[PC_K + h * 64 + F.lane]), qq = bf2f(row[PC_Q + h * 64 + F.lane]), vv = bf2f(row[PC_V + h * 128 + dv]);
            S = __expf(la) * S + kk * vv;
            const float o = wave_sum(qq * S);
            if (F.lane == 0) OF[((size_t)dir * TT + m) * 512 + h * 128 + dv] = (bf16)f2bf(o);
        }
    }
}
__device__ __forceinline__ void gla_out_naive(const Frame& F, const CAS Args* a, int l) {
    const bf16* P = (const bf16*)(F.ws + WS_P); bf16* MIX = (bf16*)(F.ws + WS_MIX);
    const bf16* OF = (const bf16*)(F.ws + WS_GL);
    const int rows = (l == 0) ? TT : TL;
    for (int m = F.gw; m < rows; m += F.NGW) {
        const int c0 = 8 * F.lane;
        const u32x4 wa = *(const u32x4*)(OF + (size_t)m * 512 + c0), wb = *(const u32x4*)(OF + ((size_t)TT + m) * 512 + c0);
        float o[8] = {bflo(wa.x) + bflo(wb.x), bfhi(wa.x) + bfhi(wb.x), bflo(wa.y) + bflo(wb.y), bfhi(wa.y) + bfhi(wb.y), bflo(wa.z) + bflo(wb.z), bfhi(wa.z) + bfhi(wb.z), bflo(wa.w) + bflo(wb.w), bfhi(wa.w) + bfhi(wb.w)};
        float ss = 0.f;
#pragma unroll
        for (int i = 0; i < 8; ++i) ss += o[i] * o[i];
        ss = row16_sum(ss);
        const float rstd = 1.0f / sqrtf(ss * (1.0f / 128.0f) + EPS);
        const u32x4 wg = *(const u32x4*)(P + (size_t)m * NIN + PC_G + c0);
        const float g[8] = {bflo(wg.x), bfhi(wg.x), bflo(wg.y), bfhi(wg.y), bflo(wg.z), bfhi(wg.z), bflo(wg.w), bfhi(wg.w)};
        const f32x4 n0 = *(const f32x4*)(a->in[I_GLANORM] + l * 512 + c0), n1 = *(const f32x4*)(a->in[I_GLANORM] + l * 512 + c0 + 4);
        float r[8];
#pragma unroll
        for (int i = 0; i < 8; ++i) r[i] = o[i] * rstd * (i < 4 ? n0[i] : n1[i - 4]) * silu_f(g[i]);
        u32x4 w; w.x = pk2(r[0], r[1]); w.y = pk2(r[2], r[3]); w.z = pk2(r[4], r[5]); w.w = pk2(r[6], r[7]);
        *(u32x4*)(MIX + (size_t)m * D + c0) = w;
    }
}

constexpr int N2_WHI = 0, N2_WLO = 32768, N2_HHI = 65536, N2_HLO = 98304, N2_PART = 132096, N2_CNT = N2_PART + 8192, N2_RT = 20;
static_assert(N2_CNT + 256 + NWAVES * N2_RT * 16 <= LDS_BYTES && N2_PART >= MISC_OFF + 64 + 128, "N2 LDS map");
__device__ __forceinline__ int n2_addr(int r, int k) { return r * 2048 + ((((k >> 3) ^ r) & 127) << 4) + (k & 7) * 2; }
__device__ __forceinline__ void n2_route_phase(const Frame& F, const CAS Args* a, int l, bool do_route, int cset) {
    unsigned char* ws = F.ws;
    const float* mod = (const float*)(ws + WS_MOD);
    bf16* H = (bf16*)(ws + WS_H);
    unsigned* cnt = (unsigned*)(ws + WS_CTL) + CW_CNT + cset * NE * CNT_STRIDE;
    unsigned* list = (unsigned*)(ws + WS_LIST); float* listw = (float*)(ws + WS_LISTW);
    LAS unsigned* lcnt = (LAS unsigned*)(F.lds + N2_CNT); LAS unsigned* lbase = lcnt + 16; LAS unsigned* rec = lcnt + 64;
    for (int i = F.tid; i < D * NE; i += NWAVES * 64) { const int e = i & 15, k = i >> 4; const float w = a->in[I_WROUTER][i];
        const unsigned hi = f2bf(w); const unsigned lo = f2bf(w - bf2f(hi));
        *(LAS bf16*)(F.lds + N2_WHI + n2_addr(e, k)) = (bf16)hi; *(LAS bf16*)(F.lds + N2_WLO + n2_addr(e, k)) = (bf16)lo; }
    if (F.tid < 32) lcnt[F.tid] = 0u;
    __syncthreads();
    const int rows = (l == 0) ? TT : TL;
    const int t0 = F.gw;
    const int nch = (rows - F.vcu * NWAVES + F.NGW - 1) / F.NGW;
    f32x4 xc[2][4], xq[2][4];
#pragma unroll
    for (int half = 0; half < 2; ++half) { const int m = t0 + half * F.NGW;
        if (m < rows) { const float* xr = m < TL ? F.out + (size_t)m * D : (const float*)(ws + WS_XC) + (size_t)(m - TL) * D;
#pragma unroll
            for (int j = 0; j < 4; ++j) xq[half][j] = *(const f32x4*)(xr + 4 * F.lane + 256 * j); } }
    for (int c2 = 0; c2 < nch; c2 += 2) {
#pragma unroll
        for (int half = 0; half < 2; ++half)
#pragma unroll
            for (int j = 0; j < 4; ++j) xc[half][j] = xq[half][j];
#pragma unroll
        for (int half = 0; half < 2; ++half) { const int m = t0 + (c2 + 2 + half) * F.NGW;
            if (m < rows) { const float* xr = m < TL ? F.out + (size_t)m * D : (const float*)(ws + WS_XC) + (size_t)(m - TL) * D;
#pragma unroll
                for (int j = 0; j < 4; ++j) xq[half][j] = *(const f32x4*)(xr + 4 * F.lane + 256 * j); } }
#pragma unroll
        for (int half = 0; half < 2; ++half) {
            const int m = t0 + (c2 + half) * F.NGW, r = 8 * half + F.wave;
            if (m < rows) {
                const int v = m < TL ? (m >> 13) : 2;
                f32x4 x[4]; float ss = 0.f;
#pragma unroll
                for (int j = 0; j < 4; ++j) { x[j] = xc[half][j]; ss += (x[j][0] * x[j][0] + x[j][1] * x[j][1]) + (x[j][2] * x[j][2] + x[j][3] * x[j][3]); }
                const float rstd = 1.0f / sqrtf(wave_sum(ss) * (1.0f / D) + EPS);
#pragma unroll
                for (int j = 0; j < 4; ++j) {
                    const int col = 4 * F.lane + 256 * j;
                    const f32x4 nw = *(const f32x4*)(a->in[I_NORM2] + l * D + col);
                    const f32x4 sh = *(const f32x4*)(mod + (l * 3 + v) * 6144 + 3 * D + col);
                    const f32x4 sc = *(const f32x4*)(mod + (l * 3 + v) * 6144 + 4 * D + col);
                    const f32x4 h = x[j] * rstd * nw * (1.0f + sc) + sh;
                    const unsigned h0 = f2bf(h[0]), h1 = f2bf(h[1]), h2 = f2bf(h[2]), h3 = f2bf(h[3]);
                    u32x2 o; o.x = h0 | (h1 << 16); o.y = h2 | (h3 << 16);
                    *(unsigned*)((unsigned char*)H + (size_t)m * D + col) = pk4_fp8(h[0], h[1], h[2], h[3]);
                    u32x2 lo; lo.x = pk2(h[0] - bf2f(h0), h[1] - bf2f(h1)); lo.y = pk2(h[2] - bf2f(h2), h[3] - bf2f(h3));
                    const int ad = n2_addr(r, col);
                    *(LAS u32x2*)(F.lds + N2_HHI + ad) = o; *(LAS u32x2*)(F.lds + N2_HLO + ad) = lo;
                }
            }
        }
        __syncthreads();
        {
            const int rr = F.lane & 15, kg = F.lane >> 4;
            f32x4 acc = (f32x4){0.f, 0.f, 0.f, 0.f};
#pragma unroll
            for (int ks = 0; ks < 4; ++ks) {
                const int ad = n2_addr(rr, 128 * F.wave + 32 * ks + 8 * kg);
                const bf16x8 whi = *(const LAS bf16x8*)(F.lds + N2_WHI + ad), wlo = *(const LAS bf16x8*)(F.lds + N2_WLO + ad);
                const bf16x8 hhi = *(const LAS bf16x8*)(F.lds + N2_HHI + ad), hlo = *(const LAS bf16x8*)(F.lds + N2_HLO + ad);
                acc = __builtin_amdgcn_mfma_f32_16x16x32_bf16(whi, hhi, acc, 0, 0, 0);
                acc = __builtin_amdgcn_mfma_f32_16x16x32_bf16(whi, hlo, acc, 0, 0, 0);
                acc = __builtin_amdgcn_mfma_f32_16x16x32_bf16(wlo, hhi, acc, 0, 0, 0);
            }
            *(LAS f32x4*)(F.lds + N2_PART + ((F.wave * 16 + rr) * 16 + 4 * kg) * 4) = acc;
        }
        __syncthreads();
        if (F.wave == 0) {
            const int rr = F.lane & 15, eg = F.lane >> 4;
            f32x4 lg = (f32x4){0.f, 0.f, 0.f, 0.f};
#pragma unroll
            for (int w = 0; w < NWAVES; ++w) lg = lg + *(const LAS f32x4*)(F.lds + N2_PART + ((w * 16 + rr) * 16 + 4 * eg) * 4);
            const f32x4 br = *(const f32x4*)(a->in[I_BROUTER] + 4 * eg);
            float sg[4], sb[4];
#pragma unroll
            for (int i = 0; i < 4; ++i) { sg[i] = 1.0f / (1.0f + expf(-lg[i])); sb[i] = sg[i] + br[i]; }
            int i0 = 0, i1 = 0; float b0 = -1e30f, b1 = -1e30f, s0 = 0.f, s1 = 0.f;
#pragma unroll
            for (int i = 0; i < 4; ++i) { const float val = sb[i];
                if (val > b0) { b1 = b0; i1 = i0; s1 = s0; b0 = val; i0 = i; s0 = sg[i]; } else if (val > b1) { b1 = val; i1 = i; s1 = sg[i]; } }
            const float gs = b0 + b1;
            float best = gs; int bg = eg;
#pragma unroll
            for (int st = 16; st < 64; st <<= 1) {
                const float og = __builtin_bit_cast(float, __builtin_amdgcn_ds_bpermute((F.lane ^ st) << 2, __builtin_bit_cast(int, best)));
                const int oi = __builtin_amdgcn_ds_bpermute((F.lane ^ st) << 2, bg);
                if (og > best || (og == best && oi < bg)) { best = og; bg = oi; }
            }
            const int half = rr >> 3, wv = rr & 7, ch = c2 + half;
            const int m = F.vcu * NWAVES + wv + ch * F.NGW;
            if (do_route && bg == eg && m < rows) {
                const int e0 = 4 * eg + i0, e1 = 4 * eg + i1; const float inv = 1.0f / (s0 + s1);
                if (ch < N2_RT) {
                    const int slot = wv * N2_RT + ch;
                    const unsigned l0 = atomicAdd((unsigned*)(lcnt + e0), 1u), l1 = atomicAdd((unsigned*)(lcnt + e1), 1u);
                    rec[slot * 4 + 0] = (unsigned)m; rec[slot * 4 + 1] = (unsigned)e0 | ((unsigned)e1 << 8) | (l0 << 16) | (l1 << 24);
                    rec[slot * 4 + 2] = __float_as_uint(s0 * inv); rec[slot * 4 + 3] = __float_as_uint(s1 * inv);
                } else {
                    const unsigned p0 = atomicAdd(cnt + e0 * CNT_STRIDE, 1u); list[(size_t)e0 * LISTCAP + p0] = (unsigned)m * 2u; listw[(size_t)e0 * LISTCAP + p0] = s0 * inv;
                    const unsigned p1 = atomicAdd(cnt + e1 * CNT_STRIDE, 1u); list[(size_t)e1 * LISTCAP + p1] = (unsigned)m * 2u + 1u; listw[(size_t)e1 * LISTCAP + p1] = s1 * inv;
                }
            }
        }
    }
    __syncthreads();
    if (do_route) {
        if (F.tid < NE) { const unsigned c = lcnt[F.tid]; lbase[F.tid] = c ? atomicAdd(cnt + F.tid * CNT_STRIDE, c) : 0u; }
        __syncthreads();
        for (int i = F.tid; i < NWAVES * N2_RT; i += NWAVES * 64) {
            const int wv = i / N2_RT, k = i % N2_RT;
            if (F.vcu * NWAVES + wv + k * F.NGW < rows) {
                const unsigned m = rec[i * 4], pk = rec[i * 4 + 1]; const unsigned e0 = pk & 255u, e1 = (pk >> 8) & 255u, l0 = (pk >> 16) & 255u, l1 = pk >> 24;
                const unsigned p0 = lbase[e0] + l0, p1 = lbase[e1] + l1;
                list[(size_t)e0 * LISTCAP + p0] = m * 2u; listw[(size_t)e0 * LISTCAP + p0] = __uint_as_float(rec[i * 4 + 2]);
                list[(size_t)e1 * LISTCAP + p1] = m * 2u + 1u; listw[(size_t)e1 * LISTCAP + p1] = __uint_as_float(rec[i * 4 + 3]);
            }
        }
    }
    __syncthreads();
}

__device__ __forceinline__ void moe_setup(pg8::MoeOrder& S, const Frame& F, int cset, int nN) {
    unsigned* cnt = (unsigned*)(F.ws + WS_CTL) + CW_CNT + cset * NE * CNT_STRIDE;
    LAS int* tab = (LAS int*)(F.lds + MISC_OFF + 64);
    __syncthreads();
    if (F.tid == 0) { int run = 0;
        for (int e = 0; e < NE; ++e) { const int c = (int)__hip_atomic_load(cnt + e * CNT_STRIDE, __ATOMIC_RELAXED, __HIP_MEMORY_SCOPE_AGENT); tab[e] = c; run += (c + 255) >> 8; tab[16 + e] = run; } }
    __syncthreads();
    S.tab = tab; S.nN = nN; S.nunits = __builtin_amdgcn_readfirstlane(tab[31]) * nN; S.G = F.G; S.c = (int)blockIdx.x;
    S.tdone = (unsigned*)(F.ws + WS_CTL) + CW_TDONE + cset * 160 * 16; S.role = 0;
    S.list = (const unsigned*)(F.ws + WS_LIST);
}
__device__ __forceinline__ void moe1_phase(const Frame& F, const CAS Args* a, int l, int cset) {
    pg8::MoeOrder S; moe_setup(S, F, cset, 4);
    S.A = (const char*)(F.ws + WS_H); S.Bt = (const char*)(F.ws + WS_WGU) + (size_t)l * NE * D * D; S.K = D / 2; S.bstride_e = (size_t)D * D; S.gather = true; S.role = 1;
    EpiGU E{(bf16*)(F.ws + WS_HMID)};
    pg8::gemm_phase<EpiGU, pg8::MoeOrder, true>(F.lds, F.tid, S, E, SC_W1, SC_ONE);
}
__device__ __forceinline__ void moe2_phase(const Frame& F, const CAS Args* a, int l, int cset) {
    pg8::MoeOrder S; moe_setup(S, F, cset, 4);
    S.A = (const char*)(F.ws + WS_HMID); S.Bt = (const char*)(F.ws + WS_WD) + (size_t)l * NE * D * DE; S.K = DE / 2; S.bstride_e = (size_t)D * DE; S.gather = false; S.role = 2; S.c = F.G - 1 - (int)blockIdx.x;
    EpiDown E; E.Y = (bf16*)(F.ws + WS_Y); E.list = (const unsigned*)(F.ws + WS_LIST); E.listw = (const float*)(F.ws + WS_LISTW); E.tab = S.tab;
    pg8::gemm_phase<EpiDown, pg8::MoeOrder, true>(F.lds, F.tid, S, E, SC_W2, SC_HMID);
    if (l == 0 && cset == 0) convert_moe_filler(F, a, 1, S.nunits, true);
}

__device__ __forceinline__ void final_load(const Frame& F, int m, f32x4 (&x)[4]) {
    const float* mod = (const float*)(F.ws + WS_MOD);
    const bf16* Y0 = (const bf16*)(F.ws + WS_Y); const bf16* Y1 = Y0 + (size_t)TT * D;
    const int v = m >> 13; const float* xrow = F.out + (size_t)m * D;
#pragma unroll
    for (int j = 0; j < 4; ++j) {
        const int col = 4 * F.lane + 256 * j;
        const f32x4 g2 = *(const f32x4*)(mod + (3 + v) * 6144 + 5 * D + col);
        const f32x4 y = ld_y4(Y0 + (size_t)m * D + col) + ld_y4(Y1 + (size_t)m * D + col);
        x[j] = *(const f32x4*)(xrow + col) + g2 * y;
    }
}
__device__ __forceinline__ void final_row(const Frame& F, const CAS Args* a, int m, const f32x4 (&x)[4]) {
    float* xrow = F.out + (size_t)m * D; float ss = 0.f;
#pragma unroll
    for (int j = 0; j < 4; ++j) ss += (x[j][0] * x[j][0] + x[j][1] * x[j][1]) + (x[j][2] * x[j][2] + x[j][3] * x[j][3]);
    const float rstd = 1.0f / sqrtf(wave_sum(ss) * (1.0f / D) + EPS);
#pragma unroll
    for (int j = 0; j < 4; ++j) { const int col = 4 * F.lane + 256 * j; const f32x4 nw = *(const f32x4*)(a->in[I_FNORM] + col); *(f32x4*)(xrow + col) = x[j] * rstd * nw; }
}
__device__ __forceinline__ void final_phase(const Frame& F, const CAS Args* a) {
    for (int m = F.gw; m < TL; m += 2 * F.NGW) {
        const int m2 = m + F.NGW; const bool two = m2 < TL;
        f32x4 xa[4], xb[4];
        final_load(F, m, xa);
        if (two) final_load(F, m2, xb);
        final_row(F, a, m, xa);
        if (two) final_row(F, a, m2, xb);
    }
}

#ifndef NPASS
#define NPASS 1
#endif
#ifndef PROBE_PH
#define PROBE_PH -1
#endif
#ifndef PROBE_R
#define PROBE_R 3
#endif
#ifndef PROBE_UPTO
#define PROBE_UPTO -1
#endif
#ifndef PROBE_ABL
#define PROBE_ABL 0
#endif
constexpr int PH_PER_LAYER = 8;
constexpr int N_PHASES = 1 + DEPTH * PH_PER_LAYER + 1;

template <int ph0>
__device__ __forceinline__ void do_phase(Frame& F, XcdBarrier& bar, LAS unsigned char* lds, int lo, int hi) {
    constexpr int ph = ph0 % N_PHASES, pass = ph0 / N_PHASES;
    if (!(lo <= ph && ph < hi)) return;
    if (pass == 1 && (PROBE_UPTO >= 0 ? ph >= PROBE_UPTO : ph != PROBE_PH)) return;
    const CAS Args* ap;
        { int l_; asm volatile("v_mbcnt_lo_u32_b32 %0, -1, 0\n\tv_mbcnt_hi_u32_b32 %0, -1, %0" : "=v"(l_)); F.lane = l_; F.tid = F.wave * 64 + l_; ap = (const CAS Args*)__builtin_amdgcn_kernarg_segment_ptr(); asm volatile("" : "+s"(ap)); F.ws = ap->ws; F.out = (pass == 1) ? (float*)(ap->ws + WS_P) : ap->out;
          LAS unsigned char* lb_ = (LAS unsigned char*)lds; asm volatile("" : "+s"(lb_)); __builtin_assume((((unsigned)(__UINTPTR_TYPE__)lb_) & 1023u) == 0u); F.lds = lb_;
          bar.bar = (unsigned*)(F.ws + WS_CTL) + CW_BAR; bar.st = (volatile LAS unsigned*)(F.lds + MISC_OFF) + 8; }
        if (ph == 0) { if (PH_ON(10)) REP(10, true) p0_prologue(F, ap); }
        else if (ph == N_PHASES - 1) { if (PH_ON(11)) REP(11, false) final_phase(F, ap); }
        else {
            const int l = (ph - 1) / PH_PER_LAYER, s = (ph - 1) % PH_PER_LAYER;
            unsigned char* ws = F.ws;
            if (s == 0) { if (PH_ON(0)) REP(0, l == 0) n1_phase(F, ap, l); }
            else if (s == 1 && PH_ON(1)) REP(1, true) {
                pg8::DenseOrder S; S.init(ws + WS_H, ws + WS_WIN + (size_t)l * NIN * D, TT, NIN, D / 2, F.G, (int)blockIdx.x);
                EpiIn E{(bf16*)(ws + WS_P), ap->in[I_BIASF] + l * 256, ap->in[I_BIASB] + l * 256, (const float*)(ws + WS_ROPE), (const float*)(ws + WS_ROPE) + 2048};
                pg8::gemm_phase<EpiIn, pg8::DenseOrder, true>(F.lds, F.tid, S, E, SC_W1, SC_ONE);
            }
            else if (s == 2) { constexpr int abl = (pass == 1) ? PROBE_ABL : 0; if (PH_ON(2) && abl != 5) REP(2, true) swa_flash(F, ap, l, abl); if (PH_ON(12) && abl != 6) REP(12, true) gla_g1(F, l); }
            else if (s == 3) { if (PH_ON(13)) REP(13, true) gla_scan(F); }
            else if (s == 4) { if (PH_ON(3)) REP(3, true) gla_g3(F, ap, l); }
            else if (s == 5 && PH_ON(4)) REP(4, l == 0) {
                pg8::DenseOrder S; S.init(ws + WS_MIX, ws + WS_WOUT + (size_t)l * D * D, l == 0 ? TT : TL, D, D / 2, F.G, (int)blockIdx.x);
                EpiOut E{l == 0 ? ap->in[I_X] : F.out, l == 0 ? ap->in[I_CTX] : (const float*)(ws + WS_XC), F.out, (float*)(ws + WS_XC), (const float*)(ws + WS_MOD) + l * 3 * 6144};
                pg8::gemm_phase<EpiOut, pg8::DenseOrder, true>(F.lds, F.tid, S, E, SC_W1, SC_HMID);
                if (l == 0 && pass == 0) convert_moe_filler(F, ap, 0, S.nwg);
            }
            else if (s == 6) { if (PH_ON(5)) REP(5, true) n2_route_phase(F, ap, l, rep_ == 0 || pass == 1, l + 2 * pass); }
            else { if (PH_ON(6)) { moe1_phase(F, ap, l, l + 2 * pass); moe2_phase(F, ap, l, l + 2 * pass); } }
        }
        if (ph0 + 1 < NPASS * N_PHASES) for (int rb_ = 0; rb_ < (REPEAT_S == 20 ? REPEAT_N : 1); ++rb_) xcd_barrier(bar, F.tid);
}
template <int... I>
__device__ __forceinline__ void run_all(Frame& F, XcdBarrier& bar, LAS unsigned char* lds, int lo, int hi, std::integer_sequence<int, I...>) { (do_phase<I>(F, bar, lds, lo, hi), ...); }

#ifdef VGPR_CAP
__attribute__((amdgpu_num_vgpr(VGPR_CAP)))
#endif
__global__ void __launch_bounds__(NWAVES * 64, 2) mk_fwd(Args args) {
    extern __shared__ __attribute__((aligned(16))) unsigned char lds[];
    Frame F;
    F.lds = (LAS unsigned char*)lds;
    F.tid = threadIdx.x; F.lane = F.tid & 63; F.wave = __builtin_amdgcn_readfirstlane(F.tid >> 6);
    F.G = gridDim.x; { const int bx = blockIdx.x; F.vcu = (F.G % 8 == 0) ? (bx % 8) * (F.G / 8) + bx / 8 : bx; }
    F.gw = F.vcu * NWAVES + F.wave; F.NGW = F.G * NWAVES;
    const CAS Args* ap = (const CAS Args*)__builtin_amdgcn_kernarg_segment_ptr();
    F.ws = ap->ws; F.out = ap->out;
    volatile LAS unsigned* MISC = (volatile LAS unsigned*)(F.lds + MISC_OFF);
    for (int u = F.tid; u < (LDS_BYTES - LDSCTL_OFF) / 4; u += NWAVES * 64) ((LAS unsigned*)(F.lds + LDSCTL_OFF))[u] = 0u;
    __syncthreads();
    XcdBarrier bar; bar.bar = (unsigned*)(F.ws + WS_CTL) + CW_BAR; bar.x = 0; bar.st = nullptr;
    const bool fused = (ap->ph_hi - ap->ph_lo) > 1;
    if (fused) bar = xcd_barrier_post((unsigned*)(F.ws + WS_CTL) + CW_BAR, MISC + 8);
    const int lo = ap->ph_lo, hi = ap->ph_hi;
    run_all(F, bar, (LAS unsigned char*)lds, lo, hi, std::make_integer_sequence<int, NPASS * N_PHASES>{});
}

extern "C" void kernel_launch(void* const* d_in, const int* in_sizes, int n_in, void* d_out, int out_size, void* d_ws, size_t ws_size, hipStream_t stream) {
    static int grid = 0;
    if (grid == 0) {
        if (n_in != 22 || out_size != TL * D || ws_size < WS_END) { fprintf(stderr, "kernel_launch: unexpected shapes (n_in %d out %d ws %zu)\n", n_in, out_size, ws_size); grid = -1; return; }
        int dev = 0, cus = 0, per_cu = 0;
        if (hipGetDevice(&dev) != hipSuccess || hipDeviceGetAttribute(&cus, hipDeviceAttributeMultiprocessorCount, dev) != hipSuccess) { grid = -1; return; }
        if (hipFuncSetAttribute((const void*)mk_fwd, hipFuncAttributeMaxDynamicSharedMemorySize, LDS_BYTES) != hipSuccess) { fprintf(stderr, "kernel_launch: hipFuncSetAttribute failed\n"); grid = -1; return; }
        if (hipOccupancyMaxActiveBlocksPerMultiprocessor(&per_cu, (const void*)mk_fwd, NWAVES * 64, LDS_BYTES) != hipSuccess || per_cu < 1) fprintf(stderr, "kernel_launch: occupancy query says %d\n", per_cu);
        (void)hipGetLastError();
        grid = cus;
    }
    if (grid < 0) return;
    (void)hipMemsetAsync((char*)d_ws + WS_CTL, 0, CTL_ZERO_BYTES, stream);
    Args a{};
    for (int i = 0; i < 22; ++i) a.in[i] = (const float*)d_in[i];
    a.out = (float*)d_out; a.ws = (unsigned char*)d_ws; a.li = 0; a.pad = 0;
#if MK_N_LAUNCHES == 1
    a.ph_lo = 0; a.ph_hi = N_PHASES;
    hipLaunchKernelGGL(mk_fwd, dim3(grid), dim3(NWAVES * 64), LDS_BYTES, stream, a);
#else
    for (int ph = 0; ph < N_PHASES; ++ph) { a.ph_lo = ph; a.ph_hi = ph + 1; hipLaunchKernelGGL(mk_fwd, dim3(grid), dim3(NWAVES * 64), LDS_BYTES, stream, a); }
#endif
}
```

```cpp
#include <hip/hip_runtime.h>
#include <cstdio>
#include <cstdint>
#include <utility>

#ifndef GIN_STAG
#define GIN_STAG 0
#endif
#ifndef ALIGN_EPI
#define ALIGN_EPI 1
#endif
#ifndef ONLY_S
#define ONLY_S -1
#endif
#define PH_ON(k) (ONLY_S < 0 || ONLY_S == (k))
#ifndef REPEAT_S
#define REPEAT_S -1
#endif
#ifndef REPEAT_N
#define REPEAT_N 4
#endif
#define REP(k, cond) for (int rep_ = 0; rep_ < ((pass == 1) ? PROBE_R : ((REPEAT_S == (k) && (cond)) ? REPEAT_N : 1)); ++rep_)
#ifndef MK_N_LAUNCHES
#define MK_N_LAUNCHES 1
#endif

#define GAS __attribute__((address_space(1)))
#define LAS __attribute__((address_space(3)))
#define CAS __attribute__((address_space(4)))
typedef unsigned short bf16;
typedef short bf16x8 __attribute__((ext_vector_type(8)));
typedef float f32x4 __attribute__((ext_vector_type(4)));
typedef float f32x2 __attribute__((ext_vector_type(2)));
typedef unsigned u32x4 __attribute__((ext_vector_type(4)));
typedef unsigned u32x2 __attribute__((ext_vector_type(2)));
typedef int v8i __attribute__((ext_vector_type(8)));

constexpr int D = 1024, SEQ = 8192, LC = 256, TL = 16384, TC = 512, TT = TL + TC, DEPTH = 2;
constexpr int NE = 16, DE = 512;
constexpr int NIN = 2816;
constexpr int PC_Q = 0, PC_K = 256, PC_V = 512, PC_G = 1024, PC_SQ = 1536, PC_SK = 2048, PC_SV = 2176, PC_GF = 2304, PC_GB = 2560;
constexpr int WIN_COLS = 2336;
constexpr float EPS = 1e-6f;
constexpr float LOG2E = 1.4426950408889634f, QSCALE = 0.125f * LOG2E;
constexpr int LISTCAP = TT;

constexpr size_t MiB = 1u << 20;
constexpr size_t WS_CTL = 0, CTL_ZERO_BYTES = 131072;
constexpr size_t WS_MOD = 1 * MiB;
constexpr size_t WS_ROPE = 1 * MiB + 256 * 1024;
constexpr size_t WS_LIST = 2 * MiB;
constexpr size_t WS_LISTW = 2 * MiB + 1536 * 1024;
constexpr size_t WS_XC = 5 * MiB;
constexpr size_t WS_WIN = 8 * MiB;
constexpr size_t WS_WOUT = 19 * MiB;
constexpr size_t WS_WGU = 23 * MiB;
constexpr size_t WS_WD = 87 * MiB;
constexpr size_t WS_H = 119 * MiB;
constexpr size_t WS_P = 152 * MiB;
constexpr size_t WS_MIX = 243 * MiB;
constexpr size_t WS_GL = 276 * MiB;
constexpr size_t WS_HMID = 152 * MiB;
constexpr size_t WS_Y = 190 * MiB;
constexpr size_t WS_END = 309 * MiB;
static_assert(WS_LIST + (size_t)NE * LISTCAP * 4 <= WS_LISTW && WS_LISTW + (size_t)NE * LISTCAP * 4 <= WS_XC, "ws map");
static_assert(WS_P + (size_t)TT * NIN * 2 <= WS_MIX && WS_MIX + (size_t)TT * D * 2 <= WS_GL, "ws map");
static_assert(WS_HMID + (size_t)37888 * 512 * 2 <= WS_Y && WS_Y + (size_t)2 * TT * D * 2 <= WS_GL, "ws map");
constexpr int CW_CNT = 8192, CNT_STRIDE = 64;
constexpr int CW_TDONE = 16384;
constexpr int CW_BAR = 4096;

__device__ __forceinline__ unsigned f2bf(float f) { unsigned u = __builtin_bit_cast(unsigned, f); return (u + 0x7fffu + ((u >> 16) & 1u)) >> 16; }
__device__ __forceinline__ unsigned pk2(float lo, float hi) { return f2bf(lo) | (f2bf(hi) << 16); }
__device__ __forceinline__ float bf2f(unsigned h) { return __builtin_bit_cast(float, h << 16); }
__device__ __forceinline__ float bflo(unsigned w) { return __builtin_bit_cast(float, w << 16); }
__device__ __forceinline__ float bfhi(unsigned w) { return __builtin_bit_cast(float, w & 0xffff0000u); }
__device__ __forceinline__ float dpp_add(float v, float t) { return v + t; }
#define DPP_F(v, ctrl, rmask) __builtin_bit_cast(float, __builtin_amdgcn_update_dpp(0, __builtin_bit_cast(int, (v)), (ctrl), (rmask), 0xF, false))
__device__ __forceinline__ float row16_sum(float v) {
    v += DPP_F(v, 0xB1, 0xF); v += DPP_F(v, 0x4E, 0xF); v += DPP_F(v, 0x141, 0xF); v += DPP_F(v, 0x140, 0xF); return v;
}
__device__ __forceinline__ float wave_sum(float v) {
    v = row16_sum(v);
    v += DPP_F(v, 0x142, 0xA); v += DPP_F(v, 0x143, 0xC);
    return __builtin_bit_cast(float, __builtin_amdgcn_readlane(__builtin_bit_cast(int, v), 63));
}
__device__ __forceinline__ float silu_f(float x) { return x / (1.0f + __expf(-x)); }
__device__ __forceinline__ unsigned pk4_fp8(float a, float b, float c, float d) {
    a = fminf(fmaxf(a, -448.f), 448.f); b = fminf(fmaxf(b, -448.f), 448.f); c = fminf(fmaxf(c, -448.f), 448.f); d = fminf(fmaxf(d, -448.f), 448.f);
    int w = __builtin_amdgcn_cvt_pk_fp8_f32(a, b, 0, false); w = __builtin_amdgcn_cvt_pk_fp8_f32(c, d, w, true); return (unsigned)w;
}
constexpr float W1_SCALE = 64.f, W2_SCALE = 32.f, HMID_SCALE = 4.f, MIX_SCALE = 4.f;
constexpr int SC_ONE = 127, SC_W1 = 121, SC_W2 = 122, SC_HMID = 125;
#define LDS_WAIT() asm volatile("s_waitcnt lgkmcnt(0)" ::: "memory")
#define VM_WAIT() asm volatile("s_waitcnt vmcnt(0)" ::: "memory")

namespace pg8 {
constexpr int BM = 256, BK = 64, HALF = 128, HTB = HALF * BK * 2, STAGE_BYTES = 8 * HTB, NXCD = 8, WGM = 8;
__host__ __device__ __forceinline__ int lds_byte(int r, int c) { const int st = (r >> 4) * 2 + (c >> 5), rr = r & 15, cc = c & 31, ob = rr * 64 + cc * 2; return st * 1024 + (ob ^ (((ob >> 9) & 1) << 5)); }
__host__ __device__ __forceinline__ void stage_rc(int b, int& R, int& C) { const int st = b / 1024, sb = b % 1024, swz = sb ^ (((sb >> 9) & 1) << 5); R = (st >> 1) * 16 + swz / 64; C = (st & 1) * 32 + (swz % 64) / 2; }
__host__ __device__ __forceinline__ int perm32(int rho) { const int n = rho >> 4, i = rho & 15; return 8 * (i >> 2) + 4 * n + (i & 3); }

struct Unit { int pm, pn, e, mt; };

__device__ __forceinline__ int xcd_remap(int wgid, int nwg) { const int q = nwg / NXCD, r = nwg % NXCD, xcd = wgid % NXCD, off = wgid / NXCD; return (xcd < r ? xcd * (q + 1) : r * (q + 1) + (xcd - r) * q) + off; }

struct DenseOrder {
    static constexpr bool DYN_A = false;
    const char* A; const char* Bt; int K; int nM, nN, nwg, G, c;
    __device__ void init(const void* A_, const void* Bt_, int M, int N, int K_, int G_, int c_) { A = (const char*)A_; Bt = (const char*)Bt_; K = K_; nM = M / BM; nN = N / BM; nwg = nM * nN; G = G_; c = c_; }
    __device__ __forceinline__ bool next(int i, Unit& u) const {
        const long L = (long)i * G + c; if (L >= nwg) return false;
        const int wgid = xcd_remap((int)L, nwg);
        const int nig = WGM * nN, gid = wgid / nig, fm = gid * WGM, gsz = (nM - fm) < WGM ? (nM - fm) : WGM;
        u.pm = fm + ((wgid % nig) % gsz); u.pn = (wgid % nig) / gsz; u.e = 0; u.mt = 0; return true;
    }
    __device__ __forceinline__ void a_ready(const Unit&, int) const {}
    __device__ __forceinline__ void done(const Unit&, int) const {}
    __device__ __forceinline__ const char* a_ptr(const Unit& u) const { return A + (size_t)u.pm * (size_t)(BM * K * 2); }
    __device__ __forceinline__ const char* b_ptr(const Unit& u) const { return Bt + (size_t)u.pn * (size_t)(BM * K * 2); }
    __device__ __forceinline__ void a_voff(const Unit&, const int (&R)[2], const int (&C)[2], unsigned (&v0)[2], unsigned (&v1)[2]) const {
#pragma unroll
        for (int i = 0; i < 2; ++i) { v0[i] = (unsigned)(R[i] * K + C[i]) * 2u; v1[i] = v0[i] + (unsigned)(HALF * K * 2); }
    }
};

struct MoeOrder {
    static constexpr bool DYN_A = true;
    const char* A; const char* Bt; int K; size_t bstride_e; int G, c, nunits, nN; bool gather;
    const unsigned* list; const LAS int* tab;
    unsigned* tdone; int role;
    __device__ __forceinline__ void a_ready(const Unit& u, int wid) const {
        if (role == 2) {
            if (wid == 0) { unsigned sp = 0;
                while (__hip_atomic_load(tdone + u.pm * 16, __ATOMIC_RELAXED, __HIP_MEMORY_SCOPE_AGENT) < 32u) { __builtin_amdgcn_s_sleep(2); if (++sp > (1u << 22)) break; }
                __builtin_amdgcn_fence(__ATOMIC_ACQUIRE, "agent"); asm volatile("s_waitcnt vmcnt(0)" ::: "memory"); }
            __builtin_amdgcn_s_barrier();
        }
    }
    __device__ __forceinline__ void done(const Unit& u, int lane) const {
        if (role == 1) { asm volatile("s_waitcnt vmcnt(0)" ::: "memory");
            if (lane == 0) __hip_atomic_fetch_add(tdone + u.pm * 16, 1u, __ATOMIC_RELAXED, __HIP_MEMORY_SCOPE_AGENT); }
    }
    __device__ __forceinline__ bool next(int i, Unit& u) const {
        const long L = (long)i * G + c; if (L >= nunits) return false;
        const int wgid = xcd_remap((int)L, nunits);
        const int tl = wgid / nN; u.pn = wgid % nN;
        int e = 0, tstart = 0;
#pragma unroll 1
        for (int k = 0; k < NE - 1; ++k) { const int te = tab[16 + k]; if (tl >= te) { e = k + 1; tstart = te; } }
        u.e = __builtin_amdgcn_readfirstlane(e); u.mt = __builtin_amdgcn_readfirstlane(tl - tstart); u.pm = tl; return true;
    }
    __device__ __forceinline__ const char* a_ptr(const Unit& u) const { return gather ? A : A + (size_t)u.pm * (size_t)(BM * K * 2); }
    __device__ __forceinline__ const char* b_ptr(const Unit& u) const { return Bt + (size_t)u.e * bstride_e + (size_t)u.pn * (size_t)(BM * K * 2); }
    __device__ __forceinline__ void a_voff(const Unit& u, const int (&R)[2], const int (&C)[2], unsigned (&v0)[2], unsigned (&v1)[2]) const {
        if (gather) {
            const int ce = tab[u.e];
            const unsigned* lp = list + (size_t)u.e * LISTCAP + u.mt * BM;
#pragma unroll
            for (int i = 0; i < 2; ++i) {
                const int r0 = R[i], r1 = R[i] + HALF;
                const unsigned t0 = (u.mt * BM + r0 < ce) ? (__builtin_nontemporal_load(lp + r0) >> 1) : 0u;
                const unsigned t1 = (u.mt * BM + r1 < ce) ? (__builtin_nontemporal_load(lp + r1) >> 1) : 0u;
                v0[i] = (t0 * (unsigned)K + (unsigned)C[i]) * 2u; v1[i] = (t1 * (unsigned)K + (unsigned)C[i]) * 2u;
            }
        } else {
#pragma unroll
            for (int i = 0; i < 2; ++i) { v0[i] = (unsigned)(R[i] * K + C[i]) * 2u; v1[i] = v0[i] + (unsigned)(HALF * K * 2); }
        }
    }
};

__device__ __forceinline__ unsigned cvt_pk_bf16(float lo, float hi) { unsigned r; asm volatile("v_cvt_pk_bf16_f32 %0, %1, %2" : "=v"(r) : "v"(lo), "v"(hi)); return r; }

template <class Epi, class Sched, bool F8 = false>
__device__ __forceinline__ void gemm_phase(LAS unsigned char* lds, int tid, const Sched& S, const Epi& E, int sc_w = 127, int sc_a = 127, int stag = 0) {
    if (stag) {
        const unsigned long long t0 = __builtin_amdgcn_s_memrealtime(), dl = (unsigned long long)((blockIdx.x >> 3) & 3) * (unsigned)stag;
        while (__builtin_amdgcn_s_memrealtime() - t0 < dl) __builtin_amdgcn_s_sleep(8);
    }
    const int wid = __builtin_amdgcn_readfirstlane(tid >> 6), lane = tid & 63, wr = wid >> 2, wc = wid & 3, fr = lane & 15, fq = lane >> 4;
    const int K = S.K, nt = K / BK;
    int Rr[2], Cc[2]; unsigned voffB[2];
#pragma unroll
    for (int i = 0; i < 2; ++i) { int R, C; stage_rc(tid * 16 + i * 8192, R, C); const int Rb = Epi::PERM ? ((R & ~31) + perm32(R & 31)) : R;
        Rr[i] = R; Cc[i] = C; voffB[i] = (unsigned)(Rb * K + C) * 2u; }
    const size_t kstep = (size_t)(BK * 2);
    const size_t hstep = (size_t)HALF * K * 2;
    const unsigned ldsw = (unsigned)wid * 1024u;
    const int aoff = lds_byte(wr * 64 + fr, fq * 8), boff = lds_byte(wc * 32 + fr, fq * 8);
#define PG8_SA(b, h) (((b) * 2 + (h)) * HTB)
#define PG8_SB(b, h) ((4 + (b) * 2 + (h)) * HTB)
#define PG8_STAGE(bufoff, gbase, voff) do { _Pragma("unroll") for (int _i = 0; _i < 2; ++_i) \
        __builtin_amdgcn_global_load_lds((const unsigned*)((const char*)(gbase) + (voff)[_i]), (LAS unsigned*)(lds + (bufoff) + ldsw + _i * 8192), 16, 0, 0); } while (0)
#define PG8_CAT(lo_, hi_) ((v8i){(int)(lo_).x, (int)(lo_).y, (int)(lo_).z, (int)(lo_).w, (int)(hi_).x, (int)(hi_).y, (int)(hi_).z, (int)(hi_).w})
#define PG8_LDA(dst, b, h) do { _Pragma("unroll") for (int m = 0; m < 4; ++m) { if constexpr (F8) { const u32x4 l_ = *(const LAS u32x4*)(lds + PG8_SA(b, h) + aoff + m * 2048), h_ = *(const LAS u32x4*)(lds + PG8_SA(b, h) + aoff + m * 2048 + 1024); dst##8[m] = PG8_CAT(l_, h_); } \
        else { _Pragma("unroll") for (int k = 0; k < 2; ++k) dst[m][k] = *(const LAS bf16x8*)(lds + PG8_SA(b, h) + aoff + m * 2048 + k * 1024); } } } while (0)
#define PG8_LDB(dst, b, h) do { _Pragma("unroll") for (int n = 0; n < 2; ++n) { if constexpr (F8) { const u32x4 l_ = *(const LAS u32x4*)(lds + PG8_SB(b, h) + boff + n * 2048), h_ = *(const LAS u32x4*)(lds + PG8_SB(b, h) + boff + n * 2048 + 1024); dst##8[n] = PG8_CAT(l_, h_); } \
        else { _Pragma("unroll") for (int k = 0; k < 2; ++k) dst[n][k] = *(const LAS bf16x8*)(lds + PG8_SB(b, h) + boff + n * 2048 + k * 1024); } } } while (0)
#define PG8_MMA(ai, bj, At, Bt) do { __builtin_amdgcn_s_setprio(1); _Pragma("unroll") for (int m = 0; m < 4; ++m) _Pragma("unroll") for (int n = 0; n < 2; ++n) { \
        if constexpr (F8) asm volatile("v_mfma_scale_f32_16x16x128_f8f6f4 %0, %1, %2, %0, %3, %4 op_sel_hi:[0,0,0]" : "+v"(acc[ai][bj][m][n]) : "v"(Bt##8[n]), "v"(At##8[m]), "v"(sc_w), "v"(sc_a)); \
        else { _Pragma("unroll") for (int k = 0; k < 2; ++k) acc[ai][bj][m][n] = __builtin_amdgcn_mfma_f32_16x16x32_bf16(Bt[n][k], At[m][k], acc[ai][bj][m][n], 0, 0, 0); } } \
        __builtin_amdgcn_s_setprio(0); } while (0)
#define PG8_WAIT_V(n) asm volatile("s_waitcnt vmcnt(" #n ")" ::: "memory")
#define PG8_WAIT_L(n) asm volatile("s_waitcnt lgkmcnt(" #n ")" ::: "memory")
#define PG8_BAR __builtin_amdgcn_s_barrier()
#define PG8_SCHED __builtin_amdgcn_sched_barrier(0)
    Unit cur, nxt; int ui = 0;
    if (!S.next(0, cur)) return;
    f32x4 acc[2][2][4][2];
#pragma unroll
    for (int a = 0; a < 2; ++a)
#pragma unroll
        for (int b = 0; b < 2; ++b)
#pragma unroll
            for (int m = 0; m < 4; ++m)
#pragma unroll
                for (int n = 0; n < 2; ++n) acc[a][b][m][n] = (f32x4){0.f, 0.f, 0.f, 0.f};
    bf16x8 At[4][2], B0[2][2], B1[2][2]; v8i At8[4], B08[2], B18[2];
    const char* cA = S.a_ptr(cur); const char* cB = S.b_ptr(cur);
    unsigned cv0[2], cv1[2], nv0[2], nv1[2];
    S.a_ready(cur, wid);
    S.a_voff(cur, Rr, Cc, cv0, cv1);
    PG8_STAGE(PG8_SB(0, 0), cB, voffB); PG8_STAGE(PG8_SB(0, 1), cB + hstep, voffB); PG8_STAGE(PG8_SA(0, 0), cA, cv0); PG8_STAGE(PG8_SA(0, 1), cA, cv1);
    if (wr == 1) PG8_BAR;
    PG8_WAIT_V(2); PG8_BAR;
    PG8_STAGE(PG8_SB(1, 0), cB + kstep, voffB); PG8_STAGE(PG8_SA(1, 0), cA + kstep, cv0); PG8_STAGE(PG8_SB(1, 1), cB + hstep + kstep, voffB);
    PG8_WAIT_V(6); PG8_BAR;
    for (;;) {
        const bool has_next = S.next(ui + 1, nxt);
        const char* nA = has_next ? S.a_ptr(nxt) : cA; const char* nB = has_next ? S.b_ptr(nxt) : cB;
        if (has_next) S.a_voff(nxt, Rr, Cc, nv0, nv1); else { nv0[0] = cv0[0]; nv0[1] = cv0[1]; nv1[0] = cv1[0]; nv1[1] = cv1[1]; }
        if constexpr (Sched::DYN_A) asm volatile("" : "+v"(nv0[0]), "+v"(nv0[1]), "+v"(nv1[0]), "+v"(nv1[1]));
        for (int t = 0; t < nt; t += 2) {
            const bool last = (t == nt - 2);
            if (last && has_next) S.a_ready(nxt, wid);
            const char* a1 = cA + (size_t)(t + 1) * kstep;
            const char* a2 = last ? nA : cA + (size_t)(t + 2) * kstep; const char* b2 = last ? nB : cB + (size_t)(t + 2) * kstep;
            const char* a3 = a2 + kstep; const char* b3 = b2 + kstep;
            unsigned w0[2], w1[2];
            w0[0] = last ? nv0[0] : cv0[0]; w0[1] = last ? nv0[1] : cv0[1]; w1[0] = last ? nv1[0] : cv1[0]; w1[1] = last ? nv1[1] : cv1[1];
            PG8_LDB(B0, 0, 0); PG8_LDB(B1, 0, 1); PG8_SCHED; PG8_LDA(At, 0, 0); PG8_STAGE(PG8_SA(1, 1), a1, cv1);
            PG8_WAIT_V(8); PG8_WAIT_L(0); PG8_BAR; PG8_MMA(0, 0, At, B0); PG8_MMA(0, 1, At, B1); PG8_BAR; PG8_SCHED;
            PG8_LDA(At, 0, 1); PG8_STAGE(PG8_SB(0, 0), b2, voffB); PG8_STAGE(PG8_SB(0, 1), b2 + hstep, voffB); PG8_STAGE(PG8_SA(0, 0), a2, w0);
            PG8_WAIT_V(8); PG8_WAIT_L(0); PG8_BAR; PG8_MMA(1, 0, At, B0); PG8_MMA(1, 1, At, B1); PG8_BAR; PG8_SCHED;
            PG8_LDB(B0, 1, 0); PG8_LDB(B1, 1, 1); PG8_SCHED; PG8_LDA(At, 1, 0); PG8_STAGE(PG8_SA(0, 1), a2, w1);
            PG8_WAIT_V(8); PG8_WAIT_L(0); PG8_BAR; PG8_MMA(0, 0, At, B0); PG8_MMA(0, 1, At, B1); PG8_BAR; PG8_SCHED;
            PG8_LDA(At, 1, 1); PG8_STAGE(PG8_SB(1, 0), b3, voffB); PG8_STAGE(PG8_SB(1, 1), b3 + hstep, voffB); PG8_STAGE(PG8_SA(1, 0), a3, w0);
            PG8_WAIT_V(8); PG8_WAIT_L(0); PG8_BAR; PG8_MMA(1, 0, At, B0); PG8_MMA(1, 1, At, B1); PG8_BAR; PG8_SCHED;
        }
        if constexpr (F8) asm volatile("s_nop 15\n\ts_nop 15" ::: "memory");
        if (ALIGN_EPI) { if (wr == 0) PG8_BAR; }
        E(acc, cur, wr, wc, fr, fq);
        S.done(cur, lane);
        if (!has_next) break;
#pragma unroll
        for (int a = 0; a < 2; ++a)
#pragma unroll
            for (int b = 0; b < 2; ++b)
#pragma unroll
                for (int m = 0; m < 4; ++m)
#pragma unroll
                    for (int n = 0; n < 2; ++n) acc[a][b][m][n] = (f32x4){0.f, 0.f, 0.f, 0.f};
        cur = nxt; cA = nA; cB = nB; ++ui;
        cv0[0] = nv0[0]; cv0[1] = nv0[1]; cv1[0] = nv1[0]; cv1[1] = nv1[1];
        if (ALIGN_EPI) { if (wr == 1) PG8_BAR; }
    }
    PG8_WAIT_V(0);
    if (!ALIGN_EPI) { if (wr == 0) PG8_BAR; }
    PG8_BAR;
#undef PG8_SA
#undef PG8_SB
#undef PG8_STAGE
#undef PG8_CAT
#undef PG8_LDA
#undef PG8_LDB
#undef PG8_MMA
#undef PG8_WAIT_V
#undef PG8_WAIT_L
#undef PG8_BAR
#undef PG8_SCHED
}
}

#define XB_TMO      128
#define XB_XCNT(j)  (256  + 64 * (j))
#define XB_XSUB(j)  (1280 + 64 * (j))
#define XB_XGEN(j)  (2304 + 64 * (j))
#define XB_TOP      3328
#define XB_TOPGEN   3392
#define XCD_BAR_WORDS 3456
#define XB_SPIN_CAP (1u << 18)
__device__ __forceinline__ unsigned xb_ld(unsigned* p)              { return __hip_atomic_load(p, __ATOMIC_RELAXED, __HIP_MEMORY_SCOPE_AGENT); }
__device__ __forceinline__ unsigned xb_add(unsigned* p, unsigned v) { return __hip_atomic_fetch_add(p, v, __ATOMIC_RELAXED, __HIP_MEMORY_SCOPE_AGENT); }
__device__ __forceinline__ unsigned xb_xcc_id() { return (unsigned)__builtin_amdgcn_s_getreg((3 << 11) | 20) & 0xFu; }
#define XB_SPIN(cond, bar) do { unsigned _sp = 0; while (cond) { __builtin_amdgcn_s_sleep(1); \
    if ((++_sp & 255u) == 0u) { if (xb_ld(&(bar)[XB_TMO])) break; if (_sp > XB_SPIN_CAP) { atomicAdd(&(bar)[XB_TMO], 1u); break; } } } } while (0)
struct XcdBarrier { unsigned* bar; unsigned x; volatile LAS unsigned* st; };
__device__ __forceinline__ XcdBarrier xcd_barrier_post(unsigned* bar, volatile LAS unsigned* st) {
    XcdBarrier b; b.bar = bar; b.x = xb_xcc_id(); b.st = st;
    if (threadIdx.x == 0) (void)xb_add(&bar[XB_XCNT(b.x)], 1u);
    return b;
}
__device__ __forceinline__ void xcd_barrier_complete(unsigned* bar, unsigned x, unsigned& nloc, unsigned& nx) {
    const unsigned G = gridDim.x * gridDim.y * gridDim.z;
    unsigned sum, cnt, mine, sp = 0u;
    for (;;) {
        sum = 0u; cnt = 0u; mine = 0u;
#pragma unroll
        for (unsigned j = 0; j < 16; ++j) { const unsigned c = xb_ld(&bar[XB_XCNT(j)]); sum += c; cnt += (c > 0u) ? 1u : 0u; mine = (j == x) ? c : mine; }
        if (sum == G) break;
        __builtin_amdgcn_s_sleep(1);
        if ((++sp & 255u) == 0u) { if (xb_ld(&bar[XB_TMO])) break; if (sp > XB_SPIN_CAP) { atomicAdd(&bar[XB_TMO], 1u); break; } }
    }
    nloc = mine > 0u ? mine : 1u; nx = cnt > 0u ? cnt : 1u;
}
__device__ __forceinline__ void xcd_barrier(const XcdBarrier& b, int tid) {
    asm volatile("s_waitcnt vmcnt(0)" ::: "memory");
    __syncthreads();
    if (tid == 0) {
        unsigned* bar = b.bar;
        __builtin_amdgcn_s_waitcnt(0);
        unsigned nloc = b.st[0], nx = b.st[1];
        if (nloc == 0u) { xcd_barrier_complete(bar, b.x, nloc, nx); b.st[0] = nloc; b.st[1] = nx; }
        const unsigned old = xb_add(&bar[XB_XSUB(b.x)], 1u);
        const unsigned gen = old / nloc;
        if (old + 1u == (gen + 1u) * nloc) {
            __builtin_amdgcn_fence(__ATOMIC_RELEASE, "agent");
            asm volatile("s_waitcnt vmcnt(0)" ::: "memory");
            const unsigned og = xb_add(&bar[XB_TOP], 1u);
            const unsigned tg = og / nx;
            if (og + 1u == (tg + 1u) * nx) xb_add(&bar[XB_TOPGEN], 1u);
            else XB_SPIN(xb_ld(&bar[XB_TOPGEN]) == tg, bar);
            __builtin_amdgcn_fence(__ATOMIC_ACQUIRE, "agent");
            xb_add(&bar[XB_XGEN(b.x)], 1u);
            asm volatile("s_waitcnt vmcnt(0)" ::: "memory");
        } else {
            XB_SPIN(xb_ld(&bar[XB_XGEN(b.x)]) == gen, bar);
            __builtin_amdgcn_fence(__ATOMIC_ACQUIRE, "agent");
            asm volatile("s_waitcnt vmcnt(0)" ::: "memory");
        }
    }
    __syncthreads();
}

constexpr int NWAVES = 8;
constexpr int RING_BYTES = 131072, LDSCTL_OFF = RING_BYTES, MISC_OFF = LDSCTL_OFF + 320, LDS_BYTES = 147456;
struct Args { const float* in[22]; float* out; unsigned char* ws; int ph_lo, ph_hi, li, pad; };
enum { I_X = 0, I_C, I_CTX, I_CCTX, I_WADA, I_BADA, I_NORM1, I_NORM2, I_WIN, I_UPF, I_BIASF, I_UPB, I_BIASB, I_GLANORM, I_SINK, I_WOUT, I_WROUTER, I_BROUTER, I_WGATE, I_WUP, I_WDOWN, I_FNORM };

struct Frame {
    LAS unsigned char* lds; int tid, lane, wave, vcu, G, gw, NGW;
    unsigned char* ws; float* out;
};

__device__ __forceinline__ int rope_pos(int d) { return 8 * ((d & 15) >> 2) + 4 * (d >> 4) + (d & 3); }
__device__ __forceinline__ int gu_row(int h, int gu) { return (h >> 7) * 256 + ((h >> 6) & 1) * 128 + ((h >> 4) & 3) * 32 + ((h >> 2) & 3) * 8 + gu * 4 + (h & 3); }
struct TItem { const float* src; bf16* dst; int N, Kd, n0, rbase, mode; bool ok; float f8scale; };
__device__ __forceinline__ void titem_load(const TItem& t, int lane, f32x4 (&v)[8]) {
    const int g = lane >> 3, i8 = lane & 7;
    const float* src = t.src + (size_t)(8 * g) * t.N + 4 * i8;
#pragma unroll
    for (int q = 0; q < 8; ++q) v[q] = *(const f32x4*)(src + (size_t)q * t.N);
}
__device__ __forceinline__ void titem_store(const TItem& t, int lane, const f32x4 (&v)[8]) {
    const int g = lane >> 3, i8 = lane & 7;
#pragma unroll
    for (int i = 0; i < 4; ++i) {
        const int n = 4 * i8 + i;
        const int row = (t.mode == 0) ? t.rbase + n : (t.mode == 1) ? t.rbase + rope_pos(n) : gu_row(t.n0 + n, t.mode - 2);
        if (t.f8scale != 0.f) {
            const float sc = t.f8scale; u32x2 o; o.x = pk4_fp8(v[0][i] * sc, v[1][i] * sc, v[2][i] * sc, v[3][i] * sc); o.y = pk4_fp8(v[4][i] * sc, v[5][i] * sc, v[6][i] * sc, v[7][i] * sc);
            *(u32x2*)((unsigned char*)t.dst + (size_t)row * t.Kd + 8 * g) = o;
        } else {
            u32x4 o; o.x = pk2(v[0][i], v[1][i]); o.y = pk2(v[2][i], v[3][i]); o.z = pk2(v[4][i], v[5][i]); o.w = pk2(v[6][i], v[7][i]);
            *(u32x4*)(t.dst + (size_t)row * t.Kd + 8 * g) = o;
        }
    }
}
constexpr int IT_IN = 2 * 16 * 73, IT_OUT = 2 * 16 * 32, IT_G = 32 * 16 * 16, IT_D = 32 * 8 * 32, NITEMS = IT_IN + IT_OUT + 2 * IT_G + IT_D;
__device__ __forceinline__ TItem titem_decode(const CAS Args* a, unsigned char* ws, int it) {
    TItem t; t.ok = it < NITEMS; t.mode = 0; t.rbase = 0; t.n0 = 0; t.N = D; t.Kd = D; t.src = nullptr; t.dst = nullptr; t.f8scale = 0.f;
    if (!t.ok) return t;
    int r = it;
    if (r < IT_IN) {
        const int l = r / 1168, rr = r % 1168, kb = rr / 73, nb = rr % 73;
        if (nb == 48) { t.ok = false; return t; }
        const int n0 = nb * 32; t.n0 = n0;
        if (n0 < 1536) t.rbase = n0;
        else if (n0 < 2080) { t.rbase = PC_SQ + (n0 - 1568); t.mode = 1; }
        else if (n0 < 2208) { t.rbase = PC_SK + (n0 - 2080); t.mode = 1; }
        else t.rbase = PC_SV + (n0 - 2208);
        t.N = WIN_COLS; t.Kd = D; t.src = a->in[I_WIN] + (size_t)l * D * WIN_COLS + (size_t)(kb * 64) * WIN_COLS + n0; t.dst = (bf16*)(ws + WS_WIN + (size_t)l * NIN * D + kb * 64); t.f8scale = W1_SCALE;
        return t;
    }
    r -= IT_IN;
    if (r < IT_OUT) { const int l = r / 512, rr = r % 512, kb = rr / 32, nb = rr % 32;
        t.n0 = nb * 32; t.rbase = nb * 32; t.N = D; t.Kd = D; t.src = a->in[I_WOUT] + (size_t)l * D * D + (size_t)(kb * 64) * D + nb * 32; t.dst = (bf16*)(ws + WS_WOUT + (size_t)l * D * D + kb * 64); t.f8scale = W1_SCALE; return t; }
    r -= IT_OUT;
    if (r < 2 * IT_G) { const int gu = r / IT_G, r2 = r % IT_G, le = r2 / 256, rr = r2 % 256, kb = rr / 16, nb = rr % 16;
        t.n0 = nb * 32; t.mode = 2 + gu; t.N = DE; t.Kd = D; t.src = a->in[gu ? I_WUP : I_WGATE] + (size_t)le * D * DE + (size_t)(kb * 64) * DE + nb * 32; t.dst = (bf16*)(ws + WS_WGU + (size_t)le * D * D + kb * 64); t.f8scale = W1_SCALE; return t; }
    r -= 2 * IT_G;
    { const int le = r / 256, rr = r % 256, kb = rr / 32, nb = rr % 32;
        t.n0 = nb * 32; t.rbase = nb * 32; t.N = D; t.Kd = DE; t.src = a->in[I_WDOWN] + (size_t)le * DE * D + (size_t)(kb * 64) * D + nb * 32; t.dst = (bf16*)(ws + WS_WD + (size_t)le * D * DE + kb * 64); t.f8scale = W2_SCALE; }
    return t;
}

template <class Map>
__device__ __forceinline__ void convert_items(const Frame& F, const CAS Args* a, int n, int worker, int nworkers, Map map) {
    unsigned char* ws = F.ws;
    for (int i = worker; i < n; i += 2 * nworkers) {
        const int i2 = i + nworkers;
        const TItem ta = titem_decode(a, ws, map(i)), tb = titem_decode(a, ws, i2 < n ? map(i2) : NITEMS);
        f32x4 va[8], vb[8];
        if (ta.ok) titem_load(ta, F.lane, va);
        if (tb.ok) titem_load(tb, F.lane, vb);
        if (ta.ok) titem_store(ta, F.lane, va);
        if (tb.ok) titem_store(tb, F.lane, vb);
    }
}
struct MapSmall { __device__ __forceinline__ int operator()(int i) const { return i; } };
struct MapMoe { int l; __device__ __forceinline__ int operator()(int i) const { const int kind = i >> 12, r = i & 4095; return IT_IN + IT_OUT + (kind < 2 ? kind * IT_G : 2 * IT_G) + l * 4096 + r; } };
__device__ __forceinline__ void convert_moe_filler(const Frame& F, const CAS Args* a, int l, int nunits, bool both = false) {
    const int c = (int)blockIdx.x, nfull = nunits % F.G;
    int first = nfull, nf = F.G - nfull - (both ? nfull : 0);
    if (nfull == 0 || nf <= 0) { first = 0; nf = F.G; }
    if (c < first || c >= first + nf) return;
    convert_items(F, a, 3 * 4096, (c - first) * NWAVES + F.wave, nf * NWAVES, MapMoe{l});
}

__device__ __forceinline__ void p0_prologue(const Frame& F, const CAS Args* a) {
    unsigned char* ws = F.ws;
    convert_items(F, a, IT_IN + IT_OUT, F.gw, F.NGW, MapSmall{});
    for (int idx = F.gw * 64 + F.lane; idx < 2 * 2 * 256 * 128; idx += F.NGW * 64) {
        const int kc = idx & 127, n = (idx >> 7) & 255, dir = (idx >> 15) & 1, l = idx >> 16;
        const float* up = a->in[dir ? I_UPB : I_UPF] + (size_t)l * 16 * 256 + n;
        float u[16];
#pragma unroll
        for (int r = 0; r < 16; ++r) u[r] = up[r * 256];
        float o[8];
#pragma unroll
        for (int kk = 0; kk < 8; ++kk) {
            const f32x4* wz = (const f32x4*)(a->in[I_WIN] + ((size_t)l * D + kc * 8 + kk) * WIN_COLS + 1536 + dir * 16);
            float s = 0.f;
#pragma unroll
            for (int q = 0; q < 4; ++q) { const f32x4 w = wz[q]; s += w[0] * u[4 * q] + w[1] * u[4 * q + 1] + w[2] * u[4 * q + 2] + w[3] * u[4 * q + 3]; }
            o[kk] = s;
        }
        u32x2 ov; ov.x = pk4_fp8(o[0] * W1_SCALE, o[1] * W1_SCALE, o[2] * W1_SCALE, o[3] * W1_SCALE); ov.y = pk4_fp8(o[4] * W1_SCALE, o[5] * W1_SCALE, o[6] * W1_SCALE, o[7] * W1_SCALE);
        *(u32x2*)(ws + WS_WIN + ((size_t)l * NIN + PC_GF + dir * 256 + n) * D + kc * 8) = ov;
    }
    if (blockIdx.x == (unsigned)(F.G - 1)) {
        float* tc = (float*)(ws + WS_ROPE); float* tsn = tc + 2048;
        for (int i = F.tid; i < 2048; i += NWAVES * 64) { const int pos = i >> 4, j = i & 15; const float inv = powf(10000.0f, -(float)j * (1.0f / 16.0f)); const float ang = (float)pos * inv;
            tc[i] = cosf(ang); tsn[i] = sinf(ang); }
    }
    __syncthreads();
    {
        LAS float* cs = (LAS float*)F.lds; LAS float* red = cs + 3072;
        for (int i = F.tid; i < 3072; i += NWAVES * 64) { const int v = i >> 10, k = i & 1023; const float cv = v < 2 ? a->in[I_C][v * D + k] : a->in[I_CCTX][k]; cs[i] = cv / (1.0f + expf(-cv)); }
        __syncthreads();
        for (int u = blockIdx.x; u < 192; u += F.G) {
            const int l = u / 96, jg = u % 96, jl = F.tid & 63, ks = F.tid >> 6;
            const float* wp = a->in[I_WADA] + ((size_t)l * D + ks * 128) * 6144 + jg * 64 + jl;
            float a0 = 0.f, a1 = 0.f, a2 = 0.f;
#pragma unroll 1
            for (int k0 = 0; k0 < 128; k0 += 32) {
                float wv[32];
#pragma unroll
                for (int k = 0; k < 32; ++k) wv[k] = wp[(size_t)(k0 + k) * 6144];
#pragma unroll
                for (int k = 0; k < 32; ++k) { const int kk = ks * 128 + k0 + k; a0 += cs[kk] * wv[k]; a1 += cs[1024 + kk] * wv[k]; a2 += cs[2048 + kk] * wv[k]; }
            }
            red[(ks * 3 + 0) * 64 + jl] = a0; red[(ks * 3 + 1) * 64 + jl] = a1; red[(ks * 3 + 2) * 64 + jl] = a2;
            __syncthreads();
            if (F.tid < 192) { const int v = F.tid >> 6, j2 = F.tid & 63; float s = 0.f;
#pragma unroll
                for (int q = 0; q < 8; ++q) s += red[(q * 3 + v) * 64 + j2];
                ((float*)(ws + WS_MOD))[(l * 3 + v) * 6144 + jg * 64 + j2] = s + a->in[I_BADA][l * 6144 + jg * 64 + j2]; }
            __syncthreads();
        }
    }
}

__device__ __forceinline__ f32x4 ld_y4(const bf16* p) { const u32x2 w = *(const u32x2*)p; return (f32x4){bflo(w.x), bfhi(w.x), bflo(w.y), bfhi(w.y)}; }
__device__ __forceinline__ void n1_load(const Frame& F, const CAS Args* a, int l, int m, f32x4 (&x)[4], f32x4 (&y)[4]) {
    unsigned char* ws = F.ws;
    const bf16* Y0 = (const bf16*)(ws + WS_Y); const bf16* Y1 = Y0 + (size_t)TT * D;
    const float* src = (l == 0) ? (m < TL ? a->in[I_X] + (size_t)m * D : a->in[I_CTX] + (size_t)(m - TL) * D) : (m < TL ? F.out + (size_t)m * D : (const float*)(ws + WS_XC) + (size_t)(m - TL) * D);
#pragma unroll
    for (int j = 0; j < 4; ++j) { const int col = 4 * F.lane + 256 * j; x[j] = *(const f32x4*)(src + col);
        if (l > 0) y[j] = ld_y4(Y0 + (size_t)m * D + col) + ld_y4(Y1 + (size_t)m * D + col); }
}
__device__ __forceinline__ void n1_row(const Frame& F, const CAS Args* a, int l, int m, f32x4 (&x)[4], const f32x4 (&y)[4]) {
    unsigned char* ws = F.ws;
    const float* mod = (const float*)(ws + WS_MOD);
    bf16* H = (bf16*)(ws + WS_H);
    const int v = m < TL ? (m >> 13) : 2;
    float* xrow = m < TL ? F.out + (size_t)m * D : (float*)(ws + WS_XC) + (size_t)(m - TL) * D;
    float ss = 0.f;
#pragma unroll
    for (int j = 0; j < 4; ++j) {
        const int col = 4 * F.lane + 256 * j;
        if (l > 0) { const f32x4 g2 = *(const f32x4*)(mod + ((l - 1) * 3 + v) * 6144 + 5 * D + col); x[j] = x[j] + g2 * y[j]; *(f32x4*)(xrow + col) = x[j]; }
        ss += (x[j][0] * x[j][0] + x[j][1] * x[j][1]) + (x[j][2] * x[j][2] + x[j][3] * x[j][3]);
    }
    const float rstd = 1.0f / sqrtf(wave_sum(ss) * (1.0f / D) + EPS);
#pragma unroll
    for (int j = 0; j < 4; ++j) {
        const int col = 4 * F.lane + 256 * j;
        const f32x4 nw = *(const f32x4*)(a->in[I_NORM1] + l * D + col);
        const f32x4 sh = *(const f32x4*)(mod + (l * 3 + v) * 6144 + 0 * D + col);
        const f32x4 sc = *(const f32x4*)(mod + (l * 3 + v) * 6144 + 1 * D + col);
        const f32x4 h = x[j] * rstd * nw * (1.0f + sc) + sh;
        *(unsigned*)((unsigned char*)H + (size_t)m * D + col) = pk4_fp8(h[0], h[1], h[2], h[3]);
    }
}
__device__ __forceinline__ void n1_phase(const Frame& F, const CAS Args* a, int l) {
    for (int m = F.gw; m < TT; m += 2 * F.NGW) {
        const int m2 = m + F.NGW; const bool two = m2 < TT;
        f32x4 xa[4], ya[4], xb[4], yb[4];
        n1_load(F, a, l, m, xa, ya);
        if (two) n1_load(F, a, l, m2, xb, yb);
        n1_row(F, a, l, m, xa, ya);
        if (two) n1_row(F, a, l, m2, xb, yb);
    }
}

struct EpiIn {
    static constexpr bool PERM = true;
    bf16* P; const float* bias_f; const float* bias_b; const float* tcos; const float* tsin; int abl;
    template <int KIND>
    __device__ __forceinline__ void body(const f32x4 (&acc)[2][2][4][2], const pg8::Unit& u, int wr, int wc, int fr, int fq) const {
        const int row0 = u.pm * 256 + wr * 64 + fr, colw = wc * 32 + 8 * fq;
        f32x4 cs[4], sn[4], b0[2], b1[2];
        const bool wodd = (wc & 1) != 0;
        if (KIND == 3 || KIND == 5) {
            const int t0 = row0 & (SEQ - 1);
#pragma unroll
            for (int j = 0; j < 4; ++j) { const int pos = wodd ? ((t0 + 16 * j) & 63) : ((t0 + 128 * (j & 1)) >> 6);
                cs[j] = *(const f32x4*)(tcos + pos * 16 + 4 * fq); sn[j] = *(const f32x4*)(tsin + pos * 16 + 4 * fq); }
        }
        if (KIND == 2) {
#pragma unroll
            for (int bj = 0; bj < 2; ++bj) { const float* bp = (u.pn == 9 ? bias_f : bias_b) + colw + bj * 128; b0[bj] = *(const f32x4*)bp; b1[bj] = *(const f32x4*)(bp + 4); }
        }
#pragma unroll
        for (int ai = 0; ai < 2; ++ai)
#pragma unroll
            for (int m = 0; m < 4; ++m) {
                const int row = row0 + ai * 128 + m * 16;
                bf16* rowp = P + (size_t)row * NIN + u.pn * 256 + colw;
#pragma unroll
                for (int bj = 0; bj < 2; ++bj) {
                    f32x4 v0 = acc[ai][bj][m][0], v1 = acc[ai][bj][m][1];
                    if (KIND == 1) { v0 = v0 * 0.125f; v1 = v1 * 0.125f; }
                    if (KIND == 2) {
#pragma unroll
                        for (int i = 0; i < 4; ++i) { float x0 = v0[i] + b0[bj][i], x1 = v1[i] + b1[bj][i];
                            v0[i] = (fminf(x0, 0.f) - __logf(1.0f + __expf(-fabsf(x0)))) * 0.0625f; v1[i] = (fminf(x1, 0.f) - __logf(1.0f + __expf(-fabsf(x1)))) * 0.0625f; }
                    }
                    if (KIND == 3 || (KIND == 5 && bj == 0)) {
                        const f32x4 c = wodd ? cs[m] : cs[ai], sv = wodd ? sn[m] : sn[ai];
                        const f32x4 o0 = v0 * c - v1 * sv, o1 = v1 * c + v0 * sv; v0 = o0; v1 = o1;
                    }
                    if (KIND == 3 || KIND == 4) { v0 = v0 * QSCALE; v1 = v1 * QSCALE; }
                    u32x4 w; w.x = pg8::cvt_pk_bf16(v0[0], v0[1]); w.y = pg8::cvt_pk_bf16(v0[2], v0[3]); w.z = pg8::cvt_pk_bf16(v1[0], v1[1]); w.w = pg8::cvt_pk_bf16(v1[2], v1[3]);
                    *(u32x4*)(rowp + bj * 128) = w;
                }
            }
    }
    __device__ __forceinline__ void operator()(const f32x4 (&acc)[2][2][4][2], const pg8::Unit& u, int wr, int wc, int fr, int fq) const {
        const int pn = u.pn; const bool latent = u.pm < 64;
        if (pn == 0) body<1>(acc, u, wr, wc, fr, fq);
        else if (pn < 6) body<0>(acc, u, wr, wc, fr, fq);
        else if (pn < 8) { if (latent) body<3>(acc, u, wr, wc, fr, fq); else body<4>(acc, u, wr, wc, fr, fq); }
        else if (pn == 8) { if (latent) body<5>(acc, u, wr, wc, fr, fq); else body<0>(acc, u, wr, wc, fr, fq); }
        else body<2>(acc, u, wr, wc, fr, fq);
    }
};
struct EpiOut {
    static constexpr bool PERM = false;
    const float* resL; const float* resC; float* outL; float* outC; const float* mod_l;
    __device__ __forceinline__ void operator()(const f32x4 (&acc)[2][2][4][2], const pg8::Unit& u, int wr, int wc, int fr, int fq) const {
        const bool latent = u.pm < 64;
        const int v = latent ? (u.pm >> 5) : 2;
        const int rowb = (latent ? u.pm * 256 : u.pm * 256 - TL) + wr * 64 + fr;
        const float* res = latent ? resL : resC; float* out = latent ? outL : outC;
        const int col0 = u.pn * 256 + wc * 32 + 4 * fq;
        const float* g1p = mod_l + v * 6144 + 2 * D + col0;
        f32x4 g1[2][2];
#pragma unroll
        for (int bj = 0; bj < 2; ++bj)
#pragma unroll
            for (int n = 0; n < 2; ++n) g1[bj][n] = *(const f32x4*)(g1p + bj * 128 + n * 16);
#pragma unroll
        for (int ai = 0; ai < 2; ++ai)
#pragma unroll
            for (int mp = 0; mp < 4; mp += 2) {
                f32x4 r[2][2][2];
#pragma unroll
                for (int m = 0; m < 2; ++m) { const size_t off = (size_t)(rowb + ai * 128 + (mp + m) * 16) * D + col0;
#pragma unroll
                    for (int bj = 0; bj < 2; ++bj)
#pragma unroll
                        for (int n = 0; n < 2; ++n) r[m][bj][n] = *(const f32x4*)(res + off + bj * 128 + n * 16); }
#pragma unroll
                for (int m = 0; m < 2; ++m) { const size_t off = (size_t)(rowb + ai * 128 + (mp + m) * 16) * D + col0;
#pragma unroll
                    for (int bj = 0; bj < 2; ++bj)
#pragma unroll
                        for (int n = 0; n < 2; ++n) *(f32x4*)(out + off + bj * 128 + n * 16) = r[m][bj][n] + g1[bj][n] * acc[ai][bj][mp + m][n]; }
                asm volatile("" ::: "memory");
            }
    }
};
struct EpiGU {
    static constexpr bool PERM = true;
    bf16* Hmid;
    __device__ __forceinline__ void operator()(const f32x4 (&acc)[2][2][4][2], const pg8::Unit& u, int wr, int wc, int fr, int fq) const {
        const int row0 = u.pm * 256 + wr * 64 + fr, hid0 = u.pn * 128 + wc * 16 + fq * 4;
#pragma unroll
        for (int ai = 0; ai < 2; ++ai)
#pragma unroll
            for (int m = 0; m < 4; ++m) {
                unsigned char* rowp = (unsigned char*)Hmid + (size_t)(row0 + ai * 128 + m * 16) * DE + hid0;
#pragma unroll
                for (int bj = 0; bj < 2; ++bj) {
                    const f32x4 g = acc[ai][bj][m][0], up = acc[ai][bj][m][1]; f32x4 o;
#pragma unroll
                    for (int i = 0; i < 4; ++i) o[i] = g[i] * __builtin_amdgcn_rcpf(1.0f + __expf(-g[i])) * up[i];
                    __hip_atomic_store((unsigned*)(rowp + bj * 64), pk4_fp8(o[0] * HMID_SCALE, o[1] * HMID_SCALE, o[2] * HMID_SCALE, o[3] * HMID_SCALE), __ATOMIC_RELAXED, __HIP_MEMORY_SCOPE_AGENT);
                }
            }
    }
};
struct EpiDown {
    static constexpr bool PERM = true;
    bf16* Y; const unsigned* list; const float* listw; const LAS int* tab;
    __device__ __forceinline__ void operator()(const f32x4 (&acc)[2][2][4][2], const pg8::Unit& u, int wr, int wc, int fr, int fq) const {
        const int ce = tab[u.e];
        const int r0 = u.mt * 256 + wr * 64 + fr, col0 = u.pn * 256 + wc * 32 + 8 * fq;
        const unsigned* lp = list + (size_t)u.e * LISTCAP; const float* lw = listw + (size_t)u.e * LISTCAP;
        unsigned tsv[2][4]; float wv[2][4];
#pragma unroll
        for (int ai = 0; ai < 2; ++ai)
#pragma unroll
            for (int m = 0; m < 4; ++m) { const int r = r0 + ai * 128 + m * 16; const bool ok = r < ce; tsv[ai][m] = ok ? __builtin_nontemporal_load(lp + r) : 0xffffffffu; wv[ai][m] = ok ? __builtin_nontemporal_load(lw + r) : 0.f; }
#pragma unroll
        for (int ai = 0; ai < 2; ++ai)
#pragma unroll
            for (int m = 0; m < 4; ++m) {
                const unsigned ts = tsv[ai][m]; const float w = wv[ai][m];
                if (ts != 0xffffffffu) {
                    bf16* rowp = Y + ((size_t)(ts & 1u) * TT + (ts >> 1)) * D + col0;
#pragma unroll
                    for (int bj = 0; bj < 2; ++bj) {
                        const f32x4 v0 = acc[ai][bj][m][0] * w, v1 = acc[ai][bj][m][1] * w;
                        u32x4 o; o.x = pg8::cvt_pk_bf16(v0[0], v0[1]); o.y = pg8::cvt_pk_bf16(v0[2], v0[3]); o.z = pg8::cvt_pk_bf16(v1[0], v1[1]); o.w = pg8::cvt_pk_bf16(v1[2], v1[3]);
                        *(u32x4*)(rowp + bj * 128) = o;
                    }
                }
            }
    }
};

__device__ __forceinline__ void swa_naive(const Frame& F, const CAS Args* a, int l) {
    const bf16* P = (const bf16*)(F.ws + WS_P); bf16* MIX = (bf16*)(F.ws + WS_MIX);
    const int total = (l == 0 ? TT : TL) * 8;
    for (int idx = F.gw * 64 + F.lane; idx < total; idx += F.NGW * 64) {
        const int m = idx >> 3, hq = idx & 7, kvh = hq >> 2;
        const bool latent = m < TL;
        const int b = latent ? (m >> 13) : ((m - TL) >> 8), t = m & (SEQ - 1);
        float q[64];
        { const u32x4* qp = (const u32x4*)(P + (size_t)m * NIN + PC_SQ + hq * 64);
#pragma unroll
          for (int c = 0; c < 8; ++c) { const u32x4 w = qp[c]; q[8 * c] = bflo(w.x); q[8 * c + 1] = bfhi(w.x); q[8 * c + 2] = bflo(w.y); q[8 * c + 3] = bfhi(w.y);
              q[8 * c + 4] = bflo(w.z); q[8 * c + 5] = bfhi(w.z); q[8 * c + 6] = bflo(w.w); q[8 * c + 7] = bfhi(w.w); } }
        float o[64];
#pragma unroll
        for (int d = 0; d < 64; ++d) o[d] = 0.f;
        const float sink = a->in[I_SINK][l * 8 + hq] * LOG2E;
        float mx = sink, den = 1.0f;
        const int lo = latent ? (t - 128 < 0 ? 0 : t - 128) : 0, hi = latent ? (t + 128 > SEQ - 1 ? SEQ - 1 : t + 128) : -1;
        const int nloc = hi - lo + 1;
        for (int kk = 0; kk < nloc + LC; ++kk) {
            const int krow = kk < nloc ? b * SEQ + lo + kk : TL + b * LC + (kk - nloc);
            const u32x4* kp = (const u32x4*)(P + (size_t)krow * NIN + PC_SK + kvh * 64);
            float s = 0.f;
#pragma unroll
            for (int c = 0; c < 8; ++c) { const u32x4 w = kp[c]; s += q[8 * c] * bflo(w.x) + q[8 * c + 1] * bfhi(w.x) + q[8 * c + 2] * bflo(w.y) + q[8 * c + 3] * bfhi(w.y)
                + q[8 * c + 4] * bflo(w.z) + q[8 * c + 5] * bfhi(w.z) + q[8 * c + 6] * bflo(w.w) + q[8 * c + 7] * bfhi(w.w); }
            const float mn = fmaxf(mx, s), f = exp2f(mx - mn), p = exp2f(s - mn);
            den = den * f + p; mx = mn;
            const u32x4* vp = (const u32x4*)(P + (size_t)krow * NIN + PC_SV + kvh * 64);
#pragma unroll
            for (int c = 0; c < 8; ++c) { const u32x4 w = vp[c];
                o[8 * c] = o[8 * c] * f + p * bflo(w.x); o[8 * c + 1] = o[8 * c + 1] * f + p * bfhi(w.x); o[8 * c + 2] = o[8 * c + 2] * f + p * bflo(w.y); o[8 * c + 3] = o[8 * c + 3] * f + p * bfhi(w.y);
                o[8 * c + 4] = o[8 * c + 4] * f + p * bflo(w.z); o[8 * c + 5] = o[8 * c + 5] * f + p * bfhi(w.z); o[8 * c + 6] = o[8 * c + 6] * f + p * bflo(w.w); o[8 * c + 7] = o[8 * c + 7] * f + p * bfhi(w.w); }
        }
        const float inv = 1.0f / den;
        u32x4* op = (u32x4*)(MIX + (size_t)m * D + 512 + hq * 64);
#pragma unroll
        for (int c = 0; c < 8; ++c) { u32x4 w; w.x = pk2(o[8 * c] * inv, o[8 * c + 1] * inv); w.y = pk2(o[8 * c + 2] * inv, o[8 * c + 3] * inv); w.z = pk2(o[8 * c + 4] * inv, o[8 * c + 5] * inv); w.w = pk2(o[8 * c + 6] * inv, o[8 * c + 7] * inv); op[c] = w; }
    }
}


typedef float f32x16 __attribute__((ext_vector_type(16)));
typedef short s16x4 __attribute__((ext_vector_type(4)));
__device__ __forceinline__ int crow(int r, int hi) { return (r & 3) + 8 * (r >> 2) + 4 * hi; }
__device__ __forceinline__ s16x4 vtr(const LAS unsigned char* p) { return __builtin_bit_cast(s16x4, __builtin_amdgcn_ds_read_tr16_b64_v4i16((LAS s16x4*)p)); }
constexpr int SWA_K = 0, SWA_V = 49152;
__device__ __forceinline__ void swa_kload(const LAS unsigned char* Kt, int kb, int lane, bf16x8 (&kf)[4]) {
    const int r32 = lane & 31, hi = lane >> 5;
#pragma unroll
    for (int d0 = 0; d0 < 4; ++d0) kf[d0] = *(const LAS bf16x8*)(Kt + (2 * d0 + hi) * 1024 + (32 * kb + r32) * 16);
}
__device__ __forceinline__ void swa_tile(const LAS unsigned char* Kt, const LAS unsigned char* Vt, const LAS unsigned char* Kn, int mtype, const bf16x8 (&qf)[2][4], f32x16 (&o)[2][2], float (&mrun)[2], float (&lrun)[2], int lane, int abl = 0) {
    const int r32 = lane & 31, hi = lane >> 5; bf16x8 kf[4]; (void)Kn;
    const LAS unsigned char* vp = Vt + ((lane >> 4) & 1) * 32 + (lane & 3) * 8 + (4 * hi + ((lane & 15) >> 2)) * 64;
#pragma unroll
    for (int kb = 0; kb < 2; ++kb) {
        f32x16 s[2];
        swa_kload(Kt, kb, lane, kf);
#pragma unroll
        for (int d0 = 0; d0 < 4; ++d0)
#pragma unroll
            for (int qt = 0; qt < 2; ++qt) {
                if (d0 == 0) { f32x16 z;
#pragma unroll
                    for (int r = 0; r < 16; ++r) z[r] = 0.f;
                    s[qt] = __builtin_amdgcn_mfma_f32_32x32x16_bf16(kf[0], qf[qt][0], z, 0, 0, 0); }
                else if (abl != 4) s[qt] = __builtin_amdgcn_mfma_f32_32x32x16_bf16(kf[d0], qf[qt][d0], s[qt], 0, 0, 0);
            }
        __builtin_amdgcn_sched_barrier(0);
        s16x4 vlo[2][2], vhi[2][2];
#pragma unroll
        for (int dt = 0; dt < 2; ++dt)
#pragma unroll
            for (int sp = 0; sp < 2; ++sp) { vlo[dt][sp] = vtr(vp + dt * 4096 + (2 * kb + sp) * 1024); vhi[dt][sp] = vtr(vp + dt * 4096 + (2 * kb + sp) * 1024 + 512); }
        __builtin_amdgcn_sched_barrier(0);
        bf16x8 pf[2][2];
#pragma unroll
        for (int qt = 0; qt < 2; ++qt) {
            if (mtype != 0) {
                int thr = r32 + 32 * qt - 4 * hi - 32 * kb; asm volatile("" : "+v"(thr));
                if (mtype == 1) {
#pragma unroll
                    for (int r = 0; r < 16; ++r) { const int cc = (r & 3) + 8 * (r >> 2); if (cc < thr) s[qt][r] = -INFINITY; }
                } else {
#pragma unroll
                    for (int r = 0; r < 16; ++r) { const int cc = (r & 3) + 8 * (r >> 2); if (cc > thr) s[qt][r] = -INFINITY; }
                }
            }
            float rm = s[qt][0];
            if (abl != 1) {
#pragma unroll
            for (int r = 1; r < 16; ++r) rm = fmaxf(rm, s[qt][r]);
            }
            { auto rr = __builtin_amdgcn_permlane32_swap(__float_as_uint(rm), __float_as_uint(rm), false, false); rm = fmaxf(__uint_as_float(rr[0]), __uint_as_float(rr[1])); }
            const float mn = fmaxf(mrun[qt], rm);
            if (__any(mn > mrun[qt])) {
                const float alpha = __builtin_amdgcn_exp2f(mrun[qt] - mn);
                lrun[qt] *= alpha;
#pragma unroll
                for (int dt = 0; dt < 2; ++dt)
#pragma unroll
                    for (int r = 0; r < 16; ++r) o[dt][qt][r] *= alpha;
                mrun[qt] = mn;
            }
            float rs = 0.f;
            if (abl != 1) {
#pragma unroll
            for (int r = 0; r < 16; ++r) { const float p = __builtin_amdgcn_exp2f(s[qt][r] - mn); s[qt][r] = p; rs += p; }
            }
            lrun[qt] += rs;
#pragma unroll
            for (int sp = 0; sp < 2; ++sp) {
                u32x4 w; w.x = pg8::cvt_pk_bf16(s[qt][8 * sp + 0], s[qt][8 * sp + 1]); w.y = pg8::cvt_pk_bf16(s[qt][8 * sp + 2], s[qt][8 * sp + 3]);
                w.z = pg8::cvt_pk_bf16(s[qt][8 * sp + 4], s[qt][8 * sp + 5]); w.w = pg8::cvt_pk_bf16(s[qt][8 * sp + 6], s[qt][8 * sp + 7]);
                pf[qt][sp] = __builtin_bit_cast(bf16x8, w);
            }
        }
#pragma unroll
        for (int dt = 0; dt < 2; ++dt)
#pragma unroll
            for (int sp = 0; sp < 2; ++sp) {
                const bf16x8 vf = (bf16x8){vlo[dt][sp][0], vlo[dt][sp][1], vlo[dt][sp][2], vlo[dt][sp][3], vhi[dt][sp][0], vhi[dt][sp][1], vhi[dt][sp][2], vhi[dt][sp][3]};
#pragma unroll
                for (int qt = 0; qt < 2; ++qt) if (abl != 2) o[dt][qt] = __builtin_amdgcn_mfma_f32_32x32x16_bf16(vf, pf[qt][sp], o[dt][qt], 0, 0, 0);
            }
    }
}
__device__ __forceinline__ void swa_stage(const Frame& F, const bf16* P, int grow, int kvh, int ti) {
    { const int key = 8 * F.wave + (F.lane & 7), ch = F.lane >> 3;
      const u32x4 v = *(const u32x4*)(P + (size_t)(grow + key) * NIN + PC_SK + kvh * 64 + ch * 8);
      *(LAS u32x4*)(F.lds + SWA_K + ti * 8192 + ch * 1024 + key * 16) = v; }
    { const int key = 8 * F.wave + (F.lane >> 3), ch = F.lane & 7;
      const u32x4 v = *(const u32x4*)(P + (size_t)(grow + key) * NIN + PC_SV + kvh * 64 + ch * 8);
      *(LAS u32x4*)(F.lds + SWA_V + ti * 8192 + (ch >> 2) * 4096 + key * 64 + (ch & 3) * 16) = v; }
}
__device__ __forceinline__ void swa_flash(const Frame& F, const CAS Args* a, int l, int abl = 0) {
    const bf16* P = (const bf16*)(F.ws + WS_P); bf16* MIX = (bf16*)(F.ws + WS_MIX);
    const int nunits = 256 + (l == 0 ? 8 : 0);
    const int lane = F.lane, r32 = lane & 31, hi = lane >> 5;
    for (int u = F.vcu; u < nunits; u += F.G) {
        const bool latent = u < 256;
        const int b = latent ? (u >> 7) : ((u - 256) >> 2), kvh = latent ? ((u >> 6) & 1) : (((u - 256) >> 1) & 1), qb = latent ? (u & 63) : ((u - 256) & 1);
        const int q0 = qb * 128, g = F.wave >> 1, qs = F.wave & 1, hq = kvh * 4 + g;
        const int mrow0 = (latent ? b * SEQ : TL + b * LC) + q0 + 64 * qs;
        bf16x8 qf[2][4];
#pragma unroll
        for (int qt = 0; qt < 2; ++qt)
#pragma unroll
            for (int d0 = 0; d0 < 4; ++d0) { if (abl != 7) qf[qt][d0] = *(const bf16x8*)(P + (size_t)(mrow0 + 32 * qt + r32) * NIN + PC_SQ + hq * 64 + 16 * d0 + 8 * hi); else qf[qt][d0] = (bf16x8){(short)lane, 1, 2, 3, 4, 5, 6, 7}; }
        f32x16 o[2][2];
#pragma unroll
        for (int dt = 0; dt < 2; ++dt)
#pragma unroll
            for (int qt = 0; qt < 2; ++qt)
#pragma unroll
                for (int r = 0; r < 16; ++r) o[dt][qt][r] = 0.f;
        const float sink2 = a->in[I_SINK][l * 8 + hq] * LOG2E;
        float mrun[2] = {sink2, sink2}, lrun[2] = {hi == 0 ? 1.f : 0.f, hi == 0 ? 1.f : 0.f};
        if (latent) {
#pragma unroll 1
            for (int j = 0; j < 6; ++j) { const int ks = q0 - 128 + 64 * j; if (ks >= 0 && ks < SEQ && abl != 3) swa_stage(F, P, b * SEQ + ks, kvh, j); }
            __syncthreads();
            { int jf = qs; while (q0 - 128 + 64 * jf < 0) ++jf;
              (void)jf;
#pragma unroll 1
              for (int tt = 0; tt < 5; ++tt) { const int j = qs + tt, ks = q0 - 128 + 64 * j;
                  if (ks >= 0 && ks < SEQ && abl != 8) { const int jn = (j + 1 < 6) ? j + 1 : j;
                      swa_tile(F.lds + SWA_K + j * 8192, F.lds + SWA_V + j * 8192, F.lds + SWA_K + jn * 8192, tt == 0 ? 1 : (tt == 4 ? 2 : 0), qf, o, mrun, lrun, lane, abl); } } }
            __syncthreads();
        }
#pragma unroll 1
        for (int j = 0; j < 4; ++j) if (abl != 3) swa_stage(F, P, TL + b * LC + 64 * j, kvh, j);
        __syncthreads();
        {
#pragma unroll 1
          for (int j = 0; j < 4; ++j) if (abl != 8) swa_tile(F.lds + SWA_K + j * 8192, F.lds + SWA_V + j * 8192, F.lds + SWA_K + (j < 3 ? j + 1 : j) * 8192, 0, qf, o, mrun, lrun, lane, abl); }
        __syncthreads();
        LAS unsigned char* stg = F.lds + F.wave * 4096;
#pragma unroll
        for (int qt = 0; qt < 2; ++qt) {
            float lt = lrun[qt];
            { auto rr = __builtin_amdgcn_permlane32_swap(__float_as_uint(lt), __float_as_uint(lt), false, false); lt = __uint_as_float(rr[0]) + __uint_as_float(rr[1]); }
            const float is = MIX_SCALE / lt;
#pragma unroll
            for (int dt = 0; dt < 2; ++dt)
#pragma unroll
                for (int rg = 0; rg < 4; ++rg)
                    *(LAS unsigned*)(stg + (32 * qt + r32) * 64 + 32 * dt + 8 * rg + 4 * hi) = pk4_fp8(o[dt][qt][4 * rg] * is, o[dt][qt][4 * rg + 1] * is, o[dt][qt][4 * rg + 2] * is, o[dt][qt][4 * rg + 3] * is);
        }
        LDS_WAIT();
        if (abl != 7) {
            int le = lane; asm volatile("" : "+v"(le));
#pragma unroll
            for (int i = 0; i < 4; ++i) { const int row = 16 * i + (le >> 2), ch = le & 3;
                const u32x4 v = *(const LAS u32x4*)(stg + row * 64 + ch * 16);
                *(u32x4*)((unsigned char*)MIX + (size_t)(mrow0 + row) * D + 512 + hq * 64 + ch * 16) = v; }
        }
        __syncthreads();
    }
}

constexpr size_t WS_US = WS_GL, WS_USC = WS_GL + 32 * MiB, WS_DEC = 7 * MiB;
static_assert(WS_USC + (size_t)16 * 4 * 8192 * 2 <= WS_END && WS_DEC + (size_t)16 * 132 * 64 * 4 <= WS_WIN, "ws map (gla)");
constexpr int GL_V = 0, GL_M0 = 16384, GL_MSZ = 64 * 72 * 2, GL_RED = GL_M0 + 4 * GL_MSZ;
__device__ __forceinline__ float wave_scan_incl(float v) {
    v += DPP_F(v, 0x111, 0xF); v += DPP_F(v, 0x112, 0xF); v += DPP_F(v, 0x114, 0xF); v += DPP_F(v, 0x118, 0xF);
    v += DPP_F(v, 0x142, 0xA); v += DPP_F(v, 0x143, 0xC); return v;
}
__device__ __forceinline__ float lane63(float v) { return __builtin_bit_cast(float, __builtin_amdgcn_readlane(__builtin_bit_cast(int, v), 63)); }
__device__ __forceinline__ void unpack8(const u32x4 w, float (&f)[8]) { f[0] = bflo(w.x); f[1] = bfhi(w.x); f[2] = bflo(w.y); f[3] = bfhi(w.y); f[4] = bflo(w.z); f[5] = bfhi(w.z); f[6] = bflo(w.w); f[7] = bfhi(w.w); }
__device__ __forceinline__ void gla_stage_v(const Frame& F, const bf16* P, int m0, int h) {
#pragma unroll
    for (int i = 0; i < 2; ++i) { const int p = F.tid + 512 * i, t = p >> 4, ch = p & 15;
        const u32x4 v = *(const u32x4*)(P + (size_t)(m0 + t) * NIN + PC_V + h * 128 + ch * 8);
        *(LAS u32x4*)(F.lds + GL_V + (ch >> 2) * 4096 + t * 64 + (ch & 3) * 16) = v; }
}
__device__ __forceinline__ void gla_g1_unit(const Frame& F, const bf16* P, int m0, int h, bf16* Uf, bf16* Ub, float* decf, float* decb) {
    const int w = F.wave, t = F.lane, c = t & 31, hi = t >> 5;
    const bf16* row = P + (size_t)(m0 + t) * NIN + h * 64 + 8 * w;
    float laf[8], lab[8], kk[8];
    unpack8(*(const u32x4*)(row + PC_GF), laf); unpack8(*(const u32x4*)(row + PC_GB), lab); unpack8(*(const u32x4*)(row + PC_K), kk);
    gla_stage_v(F, P, m0, h);
    LAS bf16* KOF = (LAS bf16*)(F.lds + GL_M0); LAS bf16* KOB = (LAS bf16*)(F.lds + GL_M0 + GL_MSZ);
#pragma unroll
    for (int i = 0; i < 8; ++i) {
        const float incf = wave_scan_incl(laf[i]), tf = lane63(incf), incb = wave_scan_incl(lab[i]), tb = lane63(incb);
        KOF[(8 * w + i) * 72 + t] = (bf16)f2bf(kk[i] * __expf(tf - incf));
        KOB[(8 * w + i) * 72 + t] = (bf16)f2bf(kk[i] * __expf(incb - lab[i]));
        if (t == 0) { decf[8 * w + i] = __expf(tf); decb[8 * w + i] = __expf(tb); }
    }
    __syncthreads();
    const int dir = w >> 2, dvt = w & 3;
    const LAS unsigned char* vp = F.lds + GL_V + dvt * 4096 + ((t >> 4) & 1) * 32 + (t & 3) * 8 + ((t & 15) >> 2) * 64 + hi * 512;
    const LAS unsigned char* kb = F.lds + GL_M0 + dir * GL_MSZ + (c * 72 + 8 * hi) * 2;
    f32x16 acc[2];
#pragma unroll
    for (int j = 0; j < 2; ++j)
#pragma unroll
        for (int r = 0; r < 16; ++r) acc[j][r] = 0.f;
#pragma unroll
    for (int sp = 0; sp < 4; ++sp) {
        const s16x4 lo = vtr(vp + sp * 1024), hi4 = vtr(vp + sp * 1024 + 256);
        const bf16x8 vf = (bf16x8){lo[0], lo[1], lo[2], lo[3], hi4[0], hi4[1], hi4[2], hi4[3]};
#pragma unroll
        for (int j = 0; j < 2; ++j) { const bf16x8 kf = *(const LAS bf16x8*)(kb + j * 32 * 144 + sp * 32); acc[j] = __builtin_amdgcn_mfma_f32_32x32x16_bf16(kf, vf, acc[j], 0, 0, 0); }
    }
    bf16* U = dir ? Ub : Uf;
#pragma unroll
    for (int j = 0; j < 2; ++j) {
        u32x4 w0, w1;
        w0.x = pk2(acc[j][0], acc[j][1]); w0.y = pk2(acc[j][2], acc[j][3]); w0.z = pk2(acc[j][4], acc[j][5]); w0.w = pk2(acc[j][6], acc[j][7]);
        w1.x = pk2(acc[j][8], acc[j][9]); w1.y = pk2(acc[j][10], acc[j][11]); w1.z = pk2(acc[j][12], acc[j][13]); w1.w = pk2(acc[j][14], acc[j][15]);
        u32x4* up = (u32x4*)(U + ((j * 4 + dvt) * 64 + t) * 16);
        up[0] = w0; up[1] = w1;
    }
    __syncthreads();
}
__device__ __forceinline__ void gla_g1(const Frame& F0, int l) {
    Frame F = F0; { int l_; asm volatile("v_mbcnt_lo_u32_b32 %0, -1, 0\n\tv_mbcnt_hi_u32_b32 %0, -1, %0" : "=v"(l_)); F.lane = l_; F.tid = F.wave * 64 + l_; }
    const bf16* P = (const bf16*)(F.ws + WS_P);
    bf16* US = (bf16*)(F.ws + WS_US); bf16* USC = (bf16*)(F.ws + WS_USC); float* DEC = (float*)(F.ws + WS_DEC);
    for (int u = F.vcu; u < 1056; u += F.G) {
        const bool latent = u < 1024; const int cc = u - 1024;
        const int b = latent ? (u >> 9) : (cc >> 4), h = latent ? ((u >> 7) & 3) : ((cc >> 2) & 3), n = latent ? (u & 127) : (cc & 3);
        const int m0 = latent ? b * SEQ + 64 * n : TL + b * LC + 64 * n;
        const int sf = (b * 4 + h) * 2;
        bf16* Uf = latent ? US + ((size_t)sf * 128 + n) * 8192 : USC + ((size_t)sf * 4 + n) * 8192;
        bf16* Ub = latent ? US + ((size_t)(sf + 1) * 128 + n) * 8192 : USC + ((size_t)(sf + 1) * 4 + n) * 8192;
        const int nd = latent ? n : 128 + n;
        gla_g1_unit(F, P, m0, h, Uf, Ub, DEC + ((size_t)sf * 132 + nd) * 64, DEC + ((size_t)(sf + 1) * 132 + nd) * 64);
    }
}
constexpr size_t WS_SS = WS_H, WS_SSC = WS_H + 32 * MiB;
static_assert(WS_SSC + (size_t)16 * 4 * 8192 * 2 <= WS_P, "ws map (gla states)");
__device__ __forceinline__ void gla_scan(const Frame& F) {
    for (int w0 = (F.vcu * NWAVES + F.wave) * 64; w0 < 16 * 4096; w0 += F.G * NWAVES * 64) {
        const int seq = __builtin_amdgcn_readfirstlane(w0 >> 12), ew = __builtin_amdgcn_readfirstlane((w0 & 4095) * 2);
        const int dir = seq & 1;
        const unsigned voff = (unsigned)F.lane * 4u;
        unsigned doff;
        { const int e = ew + 2 * F.lane, r = e & 15, ln = (e >> 4) & 63, dkt = e >> 12; doff = (unsigned)(32 * dkt + (r & 3) + 8 * (r >> 2) + 4 * (ln >> 5)) * 4u; }
        const char* decb = (const char*)(F.ws + WS_DEC) + (size_t)seq * 132 * 256;
        float s0 = 0.f, s1 = 0.f;
        { const char* ub = (const char*)(F.ws + WS_USC) + ((size_t)seq * 4 * 8192 + ew) * 2; char* sb = (char*)(F.ws + WS_SSC) + ((size_t)seq * 4 * 8192 + ew) * 2;
          unsigned u[4]; f32x2 d[4];
#pragma unroll
          for (int i = 0; i < 4; ++i) { const int n = dir ? 3 - i : i; u[i] = *(const unsigned*)(ub + (size_t)n * 16384 + voff); d[i] = *(const f32x2*)(decb + (size_t)(128 + n) * 256 + doff); }
#pragma unroll
          for (int i = 0; i < 4; ++i) { const int n = dir ? 3 - i : i; *(unsigned*)(sb + (size_t)n * 16384 + voff) = pk2(s0, s1); s0 = d[i][0] * s0 + bflo(u[i]); s1 = d[i][1] * s1 + bfhi(u[i]); } }
        const long stride = dir ? -16384 : 16384, dstride = dir ? -256 : 256;
        const char* ub = (const char*)(F.ws + WS_US) + ((size_t)seq * 128 * 8192 + ew) * 2 + (dir ? (size_t)127 * 16384 : 0);
        char* sb = (char*)(F.ws + WS_SS) + ((size_t)seq * 128 * 8192 + ew) * 2 + (dir ? (size_t)127 * 16384 : 0);
        const char* db = decb + (dir ? 127 * 256 : 0);
#pragma unroll 1
        for (int i0 = 0; i0 < 128; i0 += 32) {
            unsigned u[32]; f32x2 d[32];
#pragma unroll
            for (int j = 0; j < 32; ++j) { u[j] = *(const unsigned*)(ub + j * stride + voff); d[j] = *(const f32x2*)(db + j * dstride + doff); }
#pragma unroll
            for (int j = 0; j < 32; ++j) { *(unsigned*)(sb + j * stride + voff) = pk2(s0, s1); s0 = d[j][0] * s0 + bflo(u[j]); s1 = d[j][1] * s1 + bfhi(u[j]); }
            ub += 32 * stride; sb += 32 * stride; db += 32 * dstride;
        }
    }
}
__device__ __forceinline__ void gla_g3_unit(const Frame& F, const CAS Args* a, int l, const bf16* P, int m0, int h, const bf16* Sf, const bf16* Sb, bf16* MIX) {
    const int w = F.wave, t = F.lane, c = t & 31, hi = t >> 5;
    bf16x8 sfr[4], sbr[4]; u32x2 gwv[4]; f32x4 nwv[4];
    { const int dvt_ = w >> 1, tt_ = w & 1;
#pragma unroll
      for (int kd = 0; kd < 4; ++kd) { const size_t off = (size_t)(((kd >> 1) * 4 + dvt_) * 64 + t) * 16 + 8 * (kd & 1); sfr[kd] = *(const bf16x8*)(Sf + off); sbr[kd] = *(const bf16x8*)(Sb + off); }
#pragma unroll
      for (int rg = 0; rg < 4; ++rg) { const int dv = 32 * dvt_ + 8 * rg + 4 * hi;
          gwv[rg] = *(const u32x2*)(P + (size_t)(m0 + 32 * tt_ + c) * NIN + PC_G + h * 128 + dv); nwv[rg] = *(const f32x4*)(a->in[I_GLANORM] + l * 512 + h * 128 + dv); } }
    {
        const bf16* row = P + (size_t)(m0 + t) * NIN + h * 64 + 8 * w;
        float laf[8], lab[8], kk[8], qq[8];
        unpack8(*(const u32x4*)(row + PC_GF), laf); unpack8(*(const u32x4*)(row + PC_GB), lab); unpack8(*(const u32x4*)(row + PC_K), kk); unpack8(*(const u32x4*)(row + PC_Q), qq);
        gla_stage_v(F, P, m0, h);
        float qf[8], kf[8], qb[8], kb[8];
#pragma unroll
        for (int i = 0; i < 8; ++i) {
            const float bf = wave_scan_incl(laf[i]), incb = wave_scan_incl(lab[i]), bb = lane63(incb) - incb + lab[i];
            qf[i] = qq[i] * __expf(bf); kf[i] = kk[i] * __expf(-bf); qb[i] = qq[i] * __expf(bb); kb[i] = kk[i] * __expf(-bb);
        }
        LAS unsigned char* mb = F.lds + GL_M0 + (t * 72 + 8 * w) * 2;
        u32x4 o;
        o.x = pk2(qf[0], qf[1]); o.y = pk2(qf[2], qf[3]); o.z = pk2(qf[4], qf[5]); o.w = pk2(qf[6], qf[7]); *(LAS u32x4*)(mb) = o;
        o.x = pk2(kf[0], kf[1]); o.y = pk2(kf[2], kf[3]); o.z = pk2(kf[4], kf[5]); o.w = pk2(kf[6], kf[7]); *(LAS u32x4*)(mb + GL_MSZ) = o;
        o.x = pk2(qb[0], qb[1]); o.y = pk2(qb[2], qb[3]); o.z = pk2(qb[4], qb[5]); o.w = pk2(qb[6], qb[7]); *(LAS u32x4*)(mb + 2 * GL_MSZ) = o;
        o.x = pk2(kb[0], kb[1]); o.y = pk2(kb[2], kb[3]); o.z = pk2(kb[4], kb[5]); o.w = pk2(kb[6], kb[7]); *(LAS u32x4*)(mb + 3 * GL_MSZ) = o;
    }
    __syncthreads();
    const int dvt = w >> 1, tt = w & 1;
    bf16x8 qfB[4], qbB[4], qfP[4], qbP[4];
    { const LAS unsigned char* qp = F.lds + GL_M0 + ((32 * tt + c) * 72 + 8 * hi) * 2;
#pragma unroll
      for (int kd = 0; kd < 4; ++kd) { qfB[kd] = *(const LAS bf16x8*)(qp + kd * 32); qbB[kd] = *(const LAS bf16x8*)(qp + 2 * GL_MSZ + kd * 32); }
      const LAS unsigned char* pp = F.lds + GL_M0 + ((32 * tt + c) * 72 + 4 * hi) * 2;
#pragma unroll
      for (int kd = 0; kd < 4; ++kd) {
          const u32x2 a0 = *(const LAS u32x2*)(pp + kd * 32), a1 = *(const LAS u32x2*)(pp + kd * 32 + 16);
          const u32x2 b0 = *(const LAS u32x2*)(pp + 2 * GL_MSZ + kd * 32), b1 = *(const LAS u32x2*)(pp + 2 * GL_MSZ + kd * 32 + 16);
          qfP[kd] = __builtin_bit_cast(bf16x8, (u32x4){a0.x, a0.y, a1.x, a1.y}); qbP[kd] = __builtin_bit_cast(bf16x8, (u32x4){b0.x, b0.y, b1.x, b1.y});
      } }
    bf16x8 pfr[2][2];
#pragma unroll
    for (int st = 0; st < 2; ++st) {
        const LAS unsigned char* kp = F.lds + GL_M0 + GL_MSZ + ((32 * st + c) * 72 + 8 * hi) * 2;
        f32x16 xf, xb;
#pragma unroll
        for (int r = 0; r < 16; ++r) { xf[r] = 0.f; xb[r] = 0.f; }
        const bool needF = st <= tt, needB = st >= tt;
        if (needF) {
#pragma unroll
            for (int kd = 0; kd < 4; ++kd) xf = __builtin_amdgcn_mfma_f32_32x32x16_bf16(*(const LAS bf16x8*)(kp + kd * 32), qfB[kd], xf, 0, 0, 0);
        }
        if (needB) {
#pragma unroll
            for (int kd = 0; kd < 4; ++kd) xb = __builtin_amdgcn_mfma_f32_32x32x16_bf16(*(const LAS bf16x8*)(kp + 2 * GL_MSZ + kd * 32), qbB[kd], xb, 0, 0, 0);
        }
        if (st == tt) {
            int thr = c - 4 * hi; asm volatile("" : "+v"(thr));
#pragma unroll
            for (int r = 0; r < 16; ++r) { const int cc = (r & 3) + 8 * (r >> 2); xf[r] = (cc <= thr ? xf[r] : 0.f) + (cc >= thr ? xb[r] : 0.f); }
        } else {
#pragma unroll
            for (int r = 0; r < 16; ++r) xf[r] += xb[r];
        }
#pragma unroll
        for (int sp = 0; sp < 2; ++sp) {
            u32x4 wv; wv.x = pg8::cvt_pk_bf16(xf[8 * sp + 0], xf[8 * sp + 1]); wv.y = pg8::cvt_pk_bf16(xf[8 * sp + 2], xf[8 * sp + 3]);
            wv.z = pg8::cvt_pk_bf16(xf[8 * sp + 4], xf[8 * sp + 5]); wv.w = pg8::cvt_pk_bf16(xf[8 * sp + 6], xf[8 * sp + 7]);
            pfr[st][sp] = __builtin_bit_cast(bf16x8, wv);
        }
    }
    f32x16 o;
#pragma unroll
    for (int r = 0; r < 16; ++r) o[r] = 0.f;
    { const LAS unsigned char* vp = F.lds + GL_V + dvt * 4096 + ((t >> 4) & 1) * 32 + (t & 3) * 8 + (4 * hi + ((t & 15) >> 2)) * 64;
#pragma unroll
      for (int ks = 0; ks < 4; ++ks) {
          const s16x4 lo = vtr(vp + ks * 1024), hi4 = vtr(vp + ks * 1024 + 512);
          const bf16x8 vf = (bf16x8){lo[0], lo[1], lo[2], lo[3], hi4[0], hi4[1], hi4[2], hi4[3]};
          o = __builtin_amdgcn_mfma_f32_32x32x16_bf16(vf, pfr[ks >> 1][ks & 1], o, 0, 0, 0);
      } }
#pragma unroll
    for (int kd = 0; kd < 4; ++kd) {
        o = __builtin_amdgcn_mfma_f32_32x32x16_bf16(sfr[kd], qfP[kd], o, 0, 0, 0);
        o = __builtin_amdgcn_mfma_f32_32x32x16_bf16(sbr[kd], qbP[kd], o, 0, 0, 0);
    }
    float ssq = 0.f;
#pragma unroll
    for (int r = 0; r < 16; ++r) ssq += o[r] * o[r];
    { auto rr = __builtin_amdgcn_permlane32_swap(__float_as_uint(ssq), __float_as_uint(ssq), false, false); ssq = __uint_as_float(rr[0]) + __uint_as_float(rr[1]); }
    LAS float* red = (LAS float*)(F.lds + GL_RED);
    if (hi == 0) red[dvt * 64 + 32 * tt + c] = ssq;
    __syncthreads();
    const float tot = (red[32 * tt + c] + red[64 + 32 * tt + c]) + (red[128 + 32 * tt + c] + red[192 + 32 * tt + c]);
    const float rstd = 1.0f / sqrtf(tot * (1.0f / 128.0f) + EPS);
    const int mrow = m0 + 32 * tt + c;
#pragma unroll
    for (int rg = 0; rg < 4; ++rg) {
        const int dv = 32 * dvt + 8 * rg + 4 * hi;
        const u32x2 gw = gwv[rg]; const f32x4 nw = nwv[rg];
        const float g0 = bflo(gw.x), g1 = bfhi(gw.x), g2 = bflo(gw.y), g3 = bfhi(gw.y);
        const float rs = rstd * MIX_SCALE;
        *(unsigned*)((unsigned char*)MIX + (size_t)mrow * D + h * 128 + dv) = pk4_fp8(o[4 * rg] * rs * nw[0] * silu_f(g0), o[4 * rg + 1] * rs * nw[1] * silu_f(g1), o[4 * rg + 2] * rs * nw[2] * silu_f(g2), o[4 * rg + 3] * rs * nw[3] * silu_f(g3));
    }
    __syncthreads();
}
__device__ __forceinline__ void gla_g3(const Frame& F, const CAS Args* a, int l) {
    const bf16* P = (const bf16*)(F.ws + WS_P); bf16* MIX = (bf16*)(F.ws + WS_MIX);
    const bf16* US = (const bf16*)(F.ws + WS_SS); const bf16* USC = (const bf16*)(F.ws + WS_SSC);
    const int nunits = 1024 + (l == 0 ? 32 : 0);
    for (int u = F.vcu; u < nunits; u += F.G) {
        const bool latent = u < 1024; const int cc = u - 1024;
        const int b = latent ? (u >> 9) : (cc >> 4), h = latent ? ((u >> 7) & 3) : ((cc >> 2) & 3), n = latent ? (u & 127) : (cc & 3);
        const int m0 = latent ? b * SEQ + 64 * n : TL + b * LC + 64 * n;
        const int sf = (b * 4 + h) * 2;
        const bf16* Sf = latent ? US + ((size_t)sf * 128 + n) * 8192 : USC + ((size_t)sf * 4 + n) * 8192;
        const bf16* Sb = latent ? US + ((size_t)(sf + 1) * 128 + n) * 8192 : USC + ((size_t)(sf + 1) * 4 + n) * 8192;
        gla_g3_unit(F, a, l, P, m0, h, Sf, Sb, MIX);
    }
}

__device__ __forceinline__ void gla_naive(const Frame& F, const CAS Args* a, int l) {
    const bf16* P = (const bf16*)(F.ws + WS_P);
    bf16* OF = (bf16*)(F.ws + WS_GL);
    for (int w = F.gw; w < 2048; w += F.NGW) {
        const int dv = w & 127, dir = (w >> 7) & 1, h = (w >> 8) & 3, b = w >> 10;
        const int pcg = dir ? PC_GB : PC_GF;
        float S = 0.f;
        for (int step = 0; step < LC + SEQ; ++step) {
            int m;
            if (dir == 0) m = step < LC ? TL + b * LC + step : b * SEQ + (step - LC);
            else m = step < LC ? TL + b * LC + (LC - 1 - step) : b * SEQ + (SEQ - 1 - (step - LC));
            const bf16* row = P + (size_t)m * NIN;
            const float la = bf2f(row[pcg + h * 64 + F.lane]), kk = bf2f(row[PC_K + h * 64 + F.lane]), qq = bf2f(row[PC_Q + h * 64 + F.lane]), vv = bf2f(row[PC_V + h * 128 + dv]);
            S = __expf(la) * S + kk * vv;
            const float o = wave_sum(qq * S);
            if (F.lane == 0) OF[((size_t)dir * TT + m) * 512 + h * 128 + dv] = (bf16)f2bf(o);
        }
    }
}
__device__ __forceinline__ void gla_out_naive(const Frame& F, const CAS Args* a, int l) {
    const bf16* P = (const bf16*)(F.ws + WS_P); bf16* MIX = (bf16*)(F.ws + WS_MIX);
    const bf16* OF = (const bf16*)(F.ws + WS_GL);
    const int rows = (l == 0) ? TT : TL;
    for (int m = F.gw; m < rows; m += F.NGW) {
        const int c0 = 8 * F.lane;
        const u32x4 wa = *(const u32x4*)(OF + (size_t)m * 512 + c0), wb = *(const u32x4*)(OF + ((size_t)TT + m) * 512 + c0);
        float o[8] = {bflo(wa.x) + bflo(wb.x), bfhi(wa.x) + bfhi(wb.x), bflo(wa.y) + bflo(wb.y), bfhi(wa.y) + bfhi(wb.y), bflo(wa.z) + bflo(wb.z), bfhi(wa.z) + bfhi(wb.z), bflo(wa.w) + bflo(wb.w), bfhi(wa.w) + bfhi(wb.w)};
        float ss = 0.f;
#pragma unroll
        for (int i = 0; i < 8; ++i) ss += o[i] * o[i];
        ss = row16_sum(ss);
        const float rstd = 1.0f / sqrtf(ss * (1.0f / 128.0f) + EPS);
        const u32x4 wg = *(const u32x4*)(P + (size_t)m * NIN + PC_G + c0);
        const float g[8] = {bflo(wg.x), bfhi(wg.x), bflo(wg.y), bfhi(wg.y), bflo(wg.z), bfhi(wg.z), bflo(wg.w), bfhi(wg.w)};
        const f32x4 n0 = *(const f32x4*)(a->in[I_GLANORM] + l * 512 + c0), n1 = *(const f32x4*)(a->in[I_GLANORM] + l * 512 + c0 + 4);
        float r[8];
#pragma unroll
        for (int i = 0; i < 8; ++i) r[i] = o[i] * rstd * (i < 4 ? n0[i] : n1[i - 4]) * silu_f(g[i]);
        u32x4 w; w.x = pk2(r[0], r[1]); w.y = pk2(r[2], r[3]); w.z = pk2(r[4], r[5]); w.w = pk2(r[6], r[7]);
        *(u32x4*)(MIX + (size_t)m * D + c0) = w;
    }
}

constexpr int N2_WHI = 0, N2_WLO = 32768, N2_HHI = 65536, N2_HLO = 98304, N2_PART = 132096, N2_CNT = N2_PART + 8192, N2_RT = 20;
static_assert(N2_CNT + 256 + NWAVES * N2_RT * 16 <= LDS_BYTES && N2_PART >= MISC_OFF + 64 + 128, "N2 LDS map");
__device__ __forceinline__ int n2_addr(int r, int k) { return r * 2048 + ((((k >> 3) ^ r) & 127) << 4) + (k & 7) * 2; }
__device__ __forceinline__ void n2_route_phase(const Frame& F, const CAS Args* a, int l, bool do_route, int cset) {
    unsigned char* ws = F.ws;
    const float* mod = (const float*)(ws + WS_MOD);
    bf16* H = (bf16*)(ws + WS_H);
    unsigned* cnt = (unsigned*)(ws + WS_CTL) + CW_CNT + cset * NE * CNT_STRIDE;
    unsigned* list = (unsigned*)(ws + WS_LIST); float* listw = (float*)(ws + WS_LISTW);
    LAS unsigned* lcnt = (LAS unsigned*)(F.lds + N2_CNT); LAS unsigned* lbase = lcnt + 16; LAS unsigned* rec = lcnt + 64;
    for (int i = F.tid; i < D * NE; i += NWAVES * 64) { const int e = i & 15, k = i >> 4; const float w = a->in[I_WROUTER][i];
        const unsigned hi = f2bf(w); const unsigned lo = f2bf(w - bf2f(hi));
        *(LAS bf16*)(F.lds + N2_WHI + n2_addr(e, k)) = (bf16)hi; *(LAS bf16*)(F.lds + N2_WLO + n2_addr(e, k)) = (bf16)lo; }
    if (F.tid < 32) lcnt[F.tid] = 0u;
    __syncthreads();
    const int rows = (l == 0) ? TT : TL;
    const int t0 = F.gw;
    const int nch = (rows - F.vcu * NWAVES + F.NGW - 1) / F.NGW;
    f32x4 xc[2][4], xq[2][4];
#pragma unroll
    for (int half = 0; half < 2; ++half) { const int m = t0 + half * F.NGW;
        if (m < rows) { const float* xr = m < TL ? F.out + (size_t)m * D : (const float*)(ws + WS_XC) + (size_t)(m - TL) * D;
#pragma unroll
            for (int j = 0; j < 4; ++j) xq[half][j] = *(const f32x4*)(xr + 4 * F.lane + 256 * j); } }
    for (int c2 = 0; c2 < nch; c2 += 2) {
#pragma unroll
        for (int half = 0; half < 2; ++half)
#pragma unroll
            for (int j = 0; j < 4; ++j) xc[half][j] = xq[half][j];
#pragma unroll
        for (int half = 0; half < 2; ++half) { const int m = t0 + (c2 + 2 + half) * F.NGW;
            if (m < rows) { const float* xr = m < TL ? F.out + (size_t)m * D : (const float*)(ws + WS_XC) + (size_t)(m - TL) * D;
#pragma unroll
                for (int j = 0; j < 4; ++j) xq[half][j] = *(const f32x4*)(xr + 4 * F.lane + 256 * j); } }
#pragma unroll
        for (int half = 0; half < 2; ++half) {
            const int m = t0 + (c2 + half) * F.NGW, r = 8 * half + F.wave;
            if (m < rows) {
                const int v = m < TL ? (m >> 13) : 2;
                f32x4 x[4]; float ss = 0.f;
#pragma unroll
                for (int j = 0; j < 4; ++j) { x[j] = xc[half][j]; ss += (x[j][0] * x[j][0] + x[j][1] * x[j][1]) + (x[j][2] * x[j][2] + x[j][3] * x[j][3]); }
                const float rstd = 1.0f / sqrtf(wave_sum(ss) * (1.0f / D) + EPS);
#pragma unroll
                for (int j = 0; j < 4; ++j) {
                    const int col = 4 * F.lane + 256 * j;
                    const f32x4 nw = *(const f32x4*)(a->in[I_NORM2] + l * D + col);
                    const f32x4 sh = *(const f32x4*)(mod + (l * 3 + v) * 6144 + 3 * D + col);
                    const f32x4 sc = *(const f32x4*)(mod + (l * 3 + v) * 6144 + 4 * D + col);
                    const f32x4 h = x[j] * rstd * nw * (1.0f + sc) + sh;
                    const unsigned h0 = f2bf(h[0]), h1 = f2bf(h[1]), h2 = f2bf(h[2]), h3 = f2bf(h[3]);
                    u32x2 o; o.x = h0 | (h1 << 16); o.y = h2 | (h3 << 16);
                    *(unsigned*)((unsigned char*)H + (size_t)m * D + col) = pk4_fp8(h[0], h[1], h[2], h[3]);
                    u32x2 lo; lo.x = pk2(h[0] - bf2f(h0), h[1] - bf2f(h1)); lo.y = pk2(h[2] - bf2f(h2), h[3] - bf2f(h3));
                    const int ad = n2_addr(r, col);
                    *(LAS u32x2*)(F.lds + N2_HHI + ad) = o; *(LAS u32x2*)(F.lds + N2_HLO + ad) = lo;
                }
            }
        }
        __syncthreads();
        {
            const int rr = F.lane & 15, kg = F.lane >> 4;
            f32x4 acc = (f32x4){0.f, 0.f, 0.f, 0.f};
#pragma unroll
            for (int ks = 0; ks < 4; ++ks) {
                const int ad = n2_addr(rr, 128 * F.wave + 32 * ks + 8 * kg);
                const bf16x8 whi = *(const LAS bf16x8*)(F.lds + N2_WHI + ad), wlo = *(const LAS bf16x8*)(F.lds + N2_WLO + ad);
                const bf16x8 hhi = *(const LAS bf16x8*)(F.lds + N2_HHI + ad), hlo = *(const LAS bf16x8*)(F.lds + N2_HLO + ad);
                acc = __builtin_amdgcn_mfma_f32_16x16x32_bf16(whi, hhi, acc, 0, 0, 0);
                acc = __builtin_amdgcn_mfma_f32_16x16x32_bf16(whi, hlo, acc, 0, 0, 0);
                acc = __builtin_amdgcn_mfma_f32_16x16x32_bf16(wlo, hhi, acc, 0, 0, 0);
            }
            *(LAS f32x4*)(F.lds + N2_PART + ((F.wave * 16 + rr) * 16 + 4 * kg) * 4) = acc;
        }
        __syncthreads();
        if (F.wave == 0) {
            const int rr = F.lane & 15, eg = F.lane >> 4;
            f32x4 lg = (f32x4){0.f, 0.f, 0.f, 0.f};
#pragma unroll
            for (int w = 0; w < NWAVES; ++w) lg = lg + *(const LAS f32x4*)(F.lds + N2_PART + ((w * 16 + rr) * 16 + 4 * eg) * 4);
            const f32x4 br = *(const f32x4*)(a->in[I_BROUTER] + 4 * eg);
            float sg[4], sb[4];
#pragma unroll
            for (int i = 0; i < 4; ++i) { sg[i] = 1.0f / (1.0f + expf(-lg[i])); sb[i] = sg[i] + br[i]; }
            int i0 = 0, i1 = 0; float b0 = -1e30f, b1 = -1e30f, s0 = 0.f, s1 = 0.f;
#pragma unroll
            for (int i = 0; i < 4; ++i) { const float val = sb[i];
                if (val > b0) { b1 = b0; i1 = i0; s1 = s0; b0 = val; i0 = i; s0 = sg[i]; } else if (val > b1) { b1 = val; i1 = i; s1 = sg[i]; } }
            const float gs = b0 + b1;
            float best = gs; int bg = eg;
#pragma unroll
            for (int st = 16; st < 64; st <<= 1) {
                const float og = __builtin_bit_cast(float, __builtin_amdgcn_ds_bpermute((F.lane ^ st) << 2, __builtin_bit_cast(int, best)));
                const int oi = __builtin_amdgcn_ds_bpermute((F.lane ^ st) << 2, bg);
                if (og > best || (og == best && oi < bg)) { best = og; bg = oi; }
            }
            const int half = rr >> 3, wv = rr & 7, ch = c2 + half;
            const int m = F.vcu * NWAVES + wv + ch * F.NGW;
            if (do_route && bg == eg && m < rows) {
                const int e0 = 4 * eg + i0, e1 = 4 * eg + i1; const float inv = 1.0f / (s0 + s1);
                if (ch < N2_RT) {
                    const int slot = wv * N2_RT + ch;
                    const unsigned l0 = atomicAdd((unsigned*)(lcnt + e0), 1u), l1 = atomicAdd((unsigned*)(lcnt + e1), 1u);
                    rec[slot * 4 + 0] = (unsigned)m; rec[slot * 4 + 1] = (unsigned)e0 | ((unsigned)e1 << 8) | (l0 << 16) | (l1 << 24);
                    rec[slot * 4 + 2] = __float_as_uint(s0 * inv); rec[slot * 4 + 3] = __float_as_uint(s1 * inv);
                } else {
                    const unsigned p0 = atomicAdd(cnt + e0 * CNT_STRIDE, 1u); list[(size_t)e0 * LISTCAP + p0] = (unsigned)m * 2u; listw[(size_t)e0 * LISTCAP + p0] = s0 * inv;
                    const unsigned p1 = atomicAdd(cnt + e1 * CNT_STRIDE, 1u); list[(size_t)e1 * LISTCAP + p1] = (unsigned)m * 2u + 1u; listw[(size_t)e1 * LISTCAP + p1] = s1 * inv;
                }
            }
        }
    }
    __syncthreads();
    if (do_route) {
        if (F.tid < NE) { const unsigned c = lcnt[F.tid]; lbase[F.tid] = c ? atomicAdd(cnt + F.tid * CNT_STRIDE, c) : 0u; }
        __syncthreads();
        for (int i = F.tid; i < NWAVES * N2_RT; i += NWAVES * 64) {
            const int wv = i / N2_RT, k = i % N2_RT;
            if (F.vcu * NWAVES + wv + k * F.NGW < rows) {
                const unsigned m = rec[i * 4], pk = rec[i * 4 + 1]; const unsigned e0 = pk & 255u, e1 = (pk >> 8) & 255u, l0 = (pk >> 16) & 255u, l1 = pk >> 24;
                const unsigned p0 = lbase[e0] + l0, p1 = lbase[e1] + l1;
                list[(size_t)e0 * LISTCAP + p0] = m * 2u; listw[(size_t)e0 * LISTCAP + p0] = __uint_as_float(rec[i * 4 + 2]);
                list[(size_t)e1 * LISTCAP + p1] = m * 2u + 1u; listw[(size_t)e1 * LISTCAP + p1] = __uint_as_float(rec[i * 4 + 3]);
            }
        }
    }
    __syncthreads();
}

__device__ __forceinline__ void moe_setup(pg8::MoeOrder& S, const Frame& F, int cset, int nN) {
    unsigned* cnt = (unsigned*)(F.ws + WS_CTL) + CW_CNT + cset * NE * CNT_STRIDE;
    LAS int* tab = (LAS int*)(F.lds + MISC_OFF + 64);
    __syncthreads();
    if (F.tid == 0) { int run = 0;
        for (int e = 0; e < NE; ++e) { const int c = (int)__hip_atomic_load(cnt + e * CNT_STRIDE, __ATOMIC_RELAXED, __HIP_MEMORY_SCOPE_AGENT); tab[e] = c; run += (c + 255) >> 8; tab[16 + e] = run; } }
    __syncthreads();
    S.tab = tab; S.nN = nN; S.nunits = __builtin_amdgcn_readfirstlane(tab[31]) * nN; S.G = F.G; S.c = (int)blockIdx.x;
    S.tdone = (unsigned*)(F.ws + WS_CTL) + CW_TDONE + cset * 160 * 16; S.role = 0;
    S.list = (const unsigned*)(F.ws + WS_LIST);
}
__device__ __forceinline__ void moe1_phase(const Frame& F, const CAS Args* a, int l, int cset) {
    pg8::MoeOrder S; moe_setup(S, F, cset, 4);
    S.A = (const char*)(F.ws + WS_H); S.Bt = (const char*)(F.ws + WS_WGU) + (size_t)l * NE * D * D; S.K = D / 2; S.bstride_e = (size_t)D * D; S.gather = true; S.role = 1;
    EpiGU E{(bf16*)(F.ws + WS_HMID)};
    pg8::gemm_phase<EpiGU, pg8::MoeOrder, true>(F.lds, F.tid, S, E, SC_W1, SC_ONE);
}
__device__ __forceinline__ void moe2_phase(const Frame& F, const CAS Args* a, int l, int cset) {
    pg8::MoeOrder S; moe_setup(S, F, cset, 4);
    S.A = (const char*)(F.ws + WS_HMID); S.Bt = (const char*)(F.ws + WS_WD) + (size_t)l * NE * D * DE; S.K = DE / 2; S.bstride_e = (size_t)D * DE; S.gather = false; S.role = 2; S.c = F.G - 1 - (int)blockIdx.x;
    EpiDown E; E.Y = (bf16*)(F.ws + WS_Y); E.list = (const unsigned*)(F.ws + WS_LIST); E.listw = (const float*)(F.ws + WS_LISTW); E.tab = S.tab;
    pg8::gemm_phase<EpiDown, pg8::MoeOrder, true>(F.lds, F.tid, S, E, SC_W2, SC_HMID);
    if (l == 0 && cset == 0) convert_moe_filler(F, a, 1, S.nunits, true);
}

__device__ __forceinline__ void final_load(const Frame& F, int m, f32x4 (&x)[4]) {
    const float* mod = (const float*)(F.ws + WS_MOD);
    const bf16* Y0 = (const bf16*)(F.ws + WS_Y); const bf16* Y1 = Y0 + (size_t)TT * D;
    const int v = m >> 13; const float* xrow = F.out + (size_t)m * D;
#pragma unroll
    for (int j = 0; j < 4; ++j) {
        const int col = 4 * F.lane + 256 * j;
        const f32x4 g2 = *(const f32x4*)(mod + (3 + v) * 6144 + 5 * D + col);
        const f32x4 y = ld_y4(Y0 + (size_t)m * D + col) + ld_y4(Y1 + (size_t)m * D + col);
        x[j] = *(const f32x4*)(xrow + col) + g2 * y;
    }
}
__device__ __forceinline__ void final_row(const Frame& F, const CAS Args* a, int m, const f32x4 (&x)[4]) {
    float* xrow = F.out + (size_t)m * D; float ss = 0.f;
#pragma unroll
    for (int j = 0; j < 4; ++j) ss += (x[j][0] * x[j][0] + x[j][1] * x[j][1]) + (x[j][2] * x[j][2] + x[j][3] * x[j][3]);
    const float rstd = 1.0f / sqrtf(wave_sum(ss) * (1.0f / D) + EPS);
#pragma unroll
    for (int j = 0; j < 4; ++j) { const int col = 4 * F.lane + 256 * j; const f32x4 nw = *(const f32x4*)(a->in[I_FNORM] + col); *(f32x4*)(xrow + col) = x[j] * rstd * nw; }
}
__device__ __forceinline__ void final_phase(const Frame& F, const CAS Args* a) {
    for (int m = F.gw; m < TL; m += 2 * F.NGW) {
        const int m2 = m + F.NGW; const bool two = m2 < TL;
        f32x4 xa[4], xb[4];
        final_load(F, m, xa);
        if (two) final_load(F, m2, xb);
        final_row(F, a, m, xa);
        if (two) final_row(F, a, m2, xb);
    }
}

#ifndef NPASS
#define NPASS 1
#endif
#ifndef PROBE_PH
#define PROBE_PH -1
#endif
#ifndef PROBE_R
#define PROBE_R 3
#endif
#ifndef PROBE_UPTO
#define PROBE_UPTO -1
#endif
#ifndef PROBE_ABL
#define PROBE_ABL 0
#endif
constexpr int PH_PER_LAYER = 8;
constexpr int N_PHASES = 1 + DEPTH * PH_PER_LAYER + 1;

template <int ph0>
__device__ __forceinline__ void do_phase(Frame& F, XcdBarrier& bar, LAS unsigned char* lds, int lo, int hi) {
    constexpr int ph = ph0 % N_PHASES, pass = ph0 / N_PHASES;
    if (!(lo <= ph && ph < hi)) return;
    if (pass == 1 && (PROBE_UPTO >= 0 ? ph >= PROBE_UPTO : ph != PROBE_PH)) return;
    const CAS Args* ap;
        { int l_; asm volatile("v_mbcnt_lo_u32_b32 %0, -1, 0\n\tv_mbcnt_hi_u32_b32 %0, -1, %0" : "=v"(l_)); F.lane = l_; F.tid = F.wave * 64 + l_; ap = (const CAS Args*)__builtin_amdgcn_kernarg_segment_ptr(); asm volatile("" : "+s"(ap)); F.ws = ap->ws; F.out = (pass == 1) ? (float*)(ap->ws + WS_P) : ap->out;
          LAS unsigned char* lb_ = (LAS unsigned char*)lds; asm volatile("" : "+s"(lb_)); __builtin_assume((((unsigned)(__UINTPTR_TYPE__)lb_) & 1023u) == 0u); F.lds = lb_;
          bar.bar = (unsigned*)(F.ws + WS_CTL) + CW_BAR; bar.st = (volatile LAS unsigned*)(F.lds + MISC_OFF) + 8; }
        if (ph == 0) { if (PH_ON(10)) REP(10, true) p0_prologue(F, ap); }
        else if (ph == N_PHASES - 1) { if (PH_ON(11)) REP(11, false) final_phase(F, ap); }
        else {
            const int l = (ph - 1) / PH_PER_LAYER, s = (ph - 1) % PH_PER_LAYER;
            unsigned char* ws = F.ws;
            if (s == 0) { if (PH_ON(0)) REP(0, l == 0) n1_phase(F, ap, l); }
            else if (s == 1 && PH_ON(1)) REP(1, true) {
                pg8::DenseOrder S; S.init(ws + WS_H, ws + WS_WIN + (size_t)l * NIN * D, TT, NIN, D / 2, F.G, (int)blockIdx.x);
                EpiIn E{(bf16*)(ws + WS_P), ap->in[I_BIASF] + l * 256, ap->in[I_BIASB] + l * 256, (const float*)(ws + WS_ROPE), (const float*)(ws + WS_ROPE) + 2048, (pass == 1) ? PROBE_ABL : 0};
                pg8::gemm_phase<EpiIn, pg8::DenseOrder, true>(F.lds, F.tid, S, E, SC_W1, SC_ONE, GIN_STAG);
            }
            else if (s == 2) { constexpr int abl = (pass == 1) ? PROBE_ABL : 0; if (PH_ON(2) && abl != 5) REP(2, true) swa_flash(F, ap, l, abl); if (PH_ON(12) && abl != 6) REP(12, true) gla_g1(F, l); }
            else if (s == 3) { if (PH_ON(13)) REP(13, true) gla_scan(F); }
            else if (s == 4) { if (PH_ON(3)) REP(3, true) gla_g3(F, ap, l); }
            else if (s == 5 && PH_ON(4)) REP(4, l == 0) {
                pg8::DenseOrder S; S.init(ws + WS_MIX, ws + WS_WOUT + (size_t)l * D * D, l == 0 ? TT : TL, D, D / 2, F.G, (int)blockIdx.x);
                EpiOut E{l == 0 ? ap->in[I_X] : F.out, l == 0 ? ap->in[I_CTX] : (const float*)(ws + WS_XC), F.out, (float*)(ws + WS_XC), (const float*)(ws + WS_MOD) + l * 3 * 6144};
                pg8::gemm_phase<EpiOut, pg8::DenseOrder, true>(F.lds, F.tid, S, E, SC_W1, SC_HMID);
                if (l == 0 && pass == 0) convert_moe_filler(F, ap, 0, S.nwg);
            }
            else if (s == 6) { if (PH_ON(5)) REP(5, true) n2_route_phase(F, ap, l, rep_ == 0 || pass == 1, l + 2 * pass); }
            else { if (PH_ON(6)) { moe1_phase(F, ap, l, l + 2 * pass); moe2_phase(F, ap, l, l + 2 * pass); } }
        }
        if (ph0 + 1 < NPASS * N_PHASES) for (int rb_ = 0; rb_ < (REPEAT_S == 20 ? REPEAT_N : 1); ++rb_) xcd_barrier(bar, F.tid);
}
template <int... I>
__device__ __forceinline__ void run_all(Frame& F, XcdBarrier& bar, LAS unsigned char* lds, int lo, int hi, std::integer_sequence<int, I...>) { (do_phase<I>(F, bar, lds, lo, hi), ...); }

#ifdef VGPR_CAP
__attribute__((amdgpu_num_vgpr(VGPR_CAP)))
#endif
__global__ void __launch_bounds__(NWAVES * 64, 2) mk_fwd(Args args) {
    extern __shared__ __attribute__((aligned(16))) unsigned char lds[];
    Frame F;
    F.lds = (LAS unsigned char*)lds;
    F.tid = threadIdx.x; F.lane = F.tid & 63; F.wave = __builtin_amdgcn_readfirstlane(F.tid >> 6);
    F.G = gridDim.x; { const int bx = blockIdx.x; F.vcu = (F.G % 8 == 0) ? (bx % 8) * (F.G / 8) + bx / 8 : bx; }
    F.gw = F.vcu * NWAVES + F.wave; F.NGW = F.G * NWAVES;
    const CAS Args* ap = (const CAS Args*)__builtin_amdgcn_kernarg_segment_ptr();
    F.ws = ap->ws; F.out = ap->out;
    volatile LAS unsigned* MISC = (volatile LAS unsigned*)(F.lds + MISC_OFF);
    for (int u = F.tid; u < (LDS_BYTES - LDSCTL_OFF) / 4; u += NWAVES * 64) ((LAS unsigned*)(F.lds + LDSCTL_OFF))[u] = 0u;
    __syncthreads();
    XcdBarrier bar; bar.bar = (unsigned*)(F.ws + WS_CTL) + CW_BAR; bar.x = 0; bar.st = nullptr;
    const bool fused = (ap->ph_hi - ap->ph_lo) > 1;
    if (fused) bar = xcd_barrier_post((unsigned*)(F.ws + WS_CTL) + CW_BAR, MISC + 8);
    const int lo = ap->ph_lo, hi = ap->ph_hi;
    run_all(F, bar, (LAS unsigned char*)lds, lo, hi, std::make_integer_sequence<int, NPASS * N_PHASES>{});
}

extern "C" void kernel_launch(void* const* d_in, const int* in_sizes, int n_in, void* d_out, int out_size, void* d_ws, size_t ws_size, hipStream_t stream) {
    static int grid = 0;
    if (grid == 0) {
        if (n_in != 22 || out_size != TL * D || ws_size < WS_END) { fprintf(stderr, "kernel_launch: unexpected shapes (n_in %d out %d ws %zu)\n", n_in, out_size, ws_size); grid = -1; return; }
        int dev = 0, cus = 0, per_cu = 0;
        if (hipGetDevice(&dev) != hipSuccess || hipDeviceGetAttribute(&cus, hipDeviceAttributeMultiprocessorCount, dev) != hipSuccess) { grid = -1; return; }
        if (hipFuncSetAttribute((const void*)mk_fwd, hipFuncAttributeMaxDynamicSharedMemorySize, LDS_BYTES) != hipSuccess) { fprintf(stderr, "kernel_launch: hipFuncSetAttribute failed\n"); grid = -1; return; }
        if (hipOccupancyMaxActiveBlocksPerMultiprocessor(&per_cu, (const void*)mk_fwd, NWAVES * 64, LDS_BYTES) != hipSuccess || per_cu < 1) fprintf(stderr, "kernel_launch: occupancy query says %d\n", per_cu);
        (void)hipGetLastError();
        grid = cus;
    }
    if (grid < 0) return;
    (void)hipMemsetAsync((char*)d_ws + WS_CTL, 0, CTL_ZERO_BYTES, stream);
    Args a{};
    for (int i = 0; i < 22; ++i) a.in[i] = (const float*)d_in[i];
    a.out = (float*)d_out; a.ws = (unsigned char*)d_ws; a.li = 0; a.pad = 0;
#if MK_N_LAUNCHES == 1
    a.ph_lo = 0; a.ph_hi = N_PHASES;
    hipLaunchKernelGGL(mk_fwd, dim3(grid), dim3(NWAVES * 64), LDS_BYTES, stream, a);
#else
    for (int ph = 0; ph < N_PHASES; ++ph) { a.ph_lo = ph; a.ph_hi = ph + 1; hipLaunchKernelGGL(mk_fwd, dim3(grid), dim3(NWAVES * 64), LDS_BYTES, stream, a); }
#endif
}
```

```cpp
#include <hip/hip_runtime.h>
#include <cstdio>
#include <cstdint>
#include <utility>

#ifndef GIN_STAG
#define GIN_STAG 0
#endif
#ifndef ALIGN_EPI
#define ALIGN_EPI 1
#endif
#ifndef ONLY_S
#define ONLY_S -1
#endif
#define PH_ON(k) (ONLY_S < 0 || ONLY_S == (k))
#ifndef REPEAT_S
#define REPEAT_S -1
#endif
#ifndef REPEAT_N
#define REPEAT_N 4
#endif
#define REP(k, cond) for (int rep_ = 0; rep_ < ((pass == 1) ? PROBE_R : ((REPEAT_S == (k) && (cond)) ? REPEAT_N : 1)); ++rep_)
#ifndef MK_N_LAUNCHES
#define MK_N_LAUNCHES 1
#endif

#define GAS __attribute__((address_space(1)))
#define LAS __attribute__((address_space(3)))
#define CAS __attribute__((address_space(4)))
typedef unsigned short bf16;
typedef short bf16x8 __attribute__((ext_vector_type(8)));
typedef float f32x4 __attribute__((ext_vector_type(4)));
typedef float f32x2 __attribute__((ext_vector_type(2)));
typedef unsigned u32x4 __attribute__((ext_vector_type(4)));
typedef unsigned u32x2 __attribute__((ext_vector_type(2)));
typedef int v8i __attribute__((ext_vector_type(8)));

constexpr int D = 1024, SEQ = 8192, LC = 256, TL = 16384, TC = 512, TT = TL + TC, DEPTH = 2;
constexpr int NE = 16, DE = 512;
constexpr int NIN = 2816;
constexpr int PC_Q = 0, PC_K = 256, PC_V = 512, PC_G = 1024, PC_SQ = 1536, PC_SK = 2048, PC_SV = 2176, PC_GF = 2304, PC_GB = 2560;
constexpr int WIN_COLS = 2336;
constexpr float EPS = 1e-6f;
constexpr float LOG2E = 1.4426950408889634f, QSCALE = 0.125f * LOG2E;
constexpr int LISTCAP = TT;

constexpr size_t MiB = 1u << 20;
constexpr size_t WS_CTL = 0, CTL_ZERO_BYTES = 131072;
constexpr size_t WS_MOD = 1 * MiB;
constexpr size_t WS_ROPE = 1 * MiB + 256 * 1024;
constexpr size_t WS_LIST = 2 * MiB;
constexpr size_t WS_LISTW = 2 * MiB + 1536 * 1024;
constexpr size_t WS_XC = 5 * MiB;
constexpr size_t WS_WIN = 8 * MiB;
constexpr size_t WS_WOUT = 19 * MiB;
constexpr size_t WS_WGU = 23 * MiB;
constexpr size_t WS_WD = 87 * MiB;
constexpr size_t WS_XLB = 55 * MiB;
constexpr size_t WS_H = 119 * MiB;
constexpr size_t WS_P = 152 * MiB;
constexpr size_t WS_MIX = 243 * MiB;
constexpr size_t WS_GL = 276 * MiB;
constexpr size_t WS_HMID = 152 * MiB;
constexpr size_t WS_Y = 190 * MiB;
constexpr size_t WS_END = 309 * MiB;
static_assert(WS_LIST + (size_t)NE * LISTCAP * 4 <= WS_LISTW && WS_LISTW + (size_t)NE * LISTCAP * 4 <= WS_XC, "ws map");
static_assert(WS_P + (size_t)TT * NIN * 2 <= WS_MIX && WS_MIX + (size_t)TT * D * 2 <= WS_GL, "ws map");
static_assert(WS_HMID + (size_t)37888 * 512 * 2 <= WS_Y && WS_Y + (size_t)2 * TT * D * 2 <= WS_GL, "ws map");
constexpr int CW_CNT = 8192, CNT_STRIDE = 64;
constexpr int CW_TDONE = 16384;
constexpr int CW_BAR = 4096;

__device__ __forceinline__ unsigned f2bf(float f) { unsigned u = __builtin_bit_cast(unsigned, f); return (u + 0x7fffu + ((u >> 16) & 1u)) >> 16; }
__device__ __forceinline__ unsigned pk2(float lo, float hi) { return f2bf(lo) | (f2bf(hi) << 16); }
__device__ __forceinline__ float bf2f(unsigned h) { return __builtin_bit_cast(float, h << 16); }
__device__ __forceinline__ float bflo(unsigned w) { return __builtin_bit_cast(float, w << 16); }
__device__ __forceinline__ float bfhi(unsigned w) { return __builtin_bit_cast(float, w & 0xffff0000u); }
__device__ __forceinline__ float dpp_add(float v, float t) { return v + t; }
#define DPP_F(v, ctrl, rmask) __builtin_bit_cast(float, __builtin_amdgcn_update_dpp(0, __builtin_bit_cast(int, (v)), (ctrl), (rmask), 0xF, false))
__device__ __forceinline__ float row16_sum(float v) {
    v += DPP_F(v, 0xB1, 0xF); v += DPP_F(v, 0x4E, 0xF); v += DPP_F(v, 0x141, 0xF); v += DPP_F(v, 0x140, 0xF); return v;
}
__device__ __forceinline__ float wave_sum(float v) {
    v = row16_sum(v);
    v += DPP_F(v, 0x142, 0xA); v += DPP_F(v, 0x143, 0xC);
    return __builtin_bit_cast(float, __builtin_amdgcn_readlane(__builtin_bit_cast(int, v), 63));
}
__device__ __forceinline__ float silu_f(float x) { return x / (1.0f + __expf(-x)); }
__device__ __forceinline__ unsigned pk4_fp8(float a, float b, float c, float d) {
    a = fminf(fmaxf(a, -448.f), 448.f); b = fminf(fmaxf(b, -448.f), 448.f); c = fminf(fmaxf(c, -448.f), 448.f); d = fminf(fmaxf(d, -448.f), 448.f);
    int w = __builtin_amdgcn_cvt_pk_fp8_f32(a, b, 0, false); w = __builtin_amdgcn_cvt_pk_fp8_f32(c, d, w, true); return (unsigned)w;
}
constexpr float W1_SCALE = 64.f, W2_SCALE = 32.f, HMID_SCALE = 4.f, MIX_SCALE = 4.f;
constexpr int SC_ONE = 127, SC_W1 = 121, SC_W2 = 122, SC_HMID = 125;
#define LDS_BARRIER() asm volatile("s_waitcnt lgkmcnt(0)\n\ts_barrier" ::: "memory")
#define LDS_WAIT() asm volatile("s_waitcnt lgkmcnt(0)" ::: "memory")
#define VM_WAIT() asm volatile("s_waitcnt vmcnt(0)" ::: "memory")

namespace pg8 {
constexpr int BM = 256, BK = 64, HALF = 128, HTB = HALF * BK * 2, STAGE_BYTES = 8 * HTB, NXCD = 8, WGM = 8;
__host__ __device__ __forceinline__ int lds_byte(int r, int c) { const int st = (r >> 4) * 2 + (c >> 5), rr = r & 15, cc = c & 31, ob = rr * 64 + cc * 2; return st * 1024 + (ob ^ (((ob >> 9) & 1) << 5)); }
__host__ __device__ __forceinline__ void stage_rc(int b, int& R, int& C) { const int st = b / 1024, sb = b % 1024, swz = sb ^ (((sb >> 9) & 1) << 5); R = (st >> 1) * 16 + swz / 64; C = (st & 1) * 32 + (swz % 64) / 2; }
__host__ __device__ __forceinline__ int perm32(int rho) { const int n = rho >> 4, i = rho & 15; return 8 * (i >> 2) + 4 * n + (i & 3); }

struct Unit { int pm, pn, e, mt; };

__device__ __forceinline__ int xcd_remap(int wgid, int nwg) { const int q = nwg / NXCD, r = nwg % NXCD, xcd = wgid % NXCD, off = wgid / NXCD; return (xcd < r ? xcd * (q + 1) : r * (q + 1) + (xcd - r) * q) + off; }

struct DenseOrder {
    static constexpr bool DYN_A = false;
    const char* A; const char* Bt; int K; int nM, nN, nwg, G, c;
    __device__ void init(const void* A_, const void* Bt_, int M, int N, int K_, int G_, int c_) { A = (const char*)A_; Bt = (const char*)Bt_; K = K_; nM = M / BM; nN = N / BM; nwg = nM * nN; G = G_; c = c_; }
    __device__ __forceinline__ bool next(int i, Unit& u) const {
        const long L = (long)i * G + c; if (L >= nwg) return false;
        const int wgid = xcd_remap((int)L, nwg);
        const int nig = WGM * nN, gid = wgid / nig, fm = gid * WGM, gsz = (nM - fm) < WGM ? (nM - fm) : WGM;
        u.pm = fm + ((wgid % nig) % gsz); u.pn = (wgid % nig) / gsz; u.e = 0; u.mt = 0; return true;
    }
    __device__ __forceinline__ void a_ready(const Unit&, int) const {}
    __device__ __forceinline__ void done(const Unit&, int) const {}
    __device__ __forceinline__ const char* a_ptr(const Unit& u) const { return A + (size_t)u.pm * (size_t)(BM * K * 2); }
    __device__ __forceinline__ const char* b_ptr(const Unit& u) const { return Bt + (size_t)u.pn * (size_t)(BM * K * 2); }
    __device__ __forceinline__ void a_voff(const Unit&, const int (&R)[2], const int (&C)[2], unsigned (&v0)[2], unsigned (&v1)[2]) const {
#pragma unroll
        for (int i = 0; i < 2; ++i) { v0[i] = (unsigned)(R[i] * K + C[i]) * 2u; v1[i] = v0[i] + (unsigned)(HALF * K * 2); }
    }
};

struct MoeOrder {
    static constexpr bool DYN_A = true;
    const char* A; const char* Bt; int K; size_t bstride_e; int G, c, nunits, nN; bool gather;
    const unsigned* list; const LAS int* tab;
    unsigned* tdone; int role;
    __device__ __forceinline__ void a_ready(const Unit& u, int wid) const {
        if (role == 2) {
            if (wid == 0) { unsigned sp = 0;
                while (__hip_atomic_load(tdone + u.pm * 16, __ATOMIC_RELAXED, __HIP_MEMORY_SCOPE_AGENT) < 32u) { __builtin_amdgcn_s_sleep(2); if (++sp > (1u << 22)) break; }
                __builtin_amdgcn_fence(__ATOMIC_ACQUIRE, "agent"); asm volatile("s_waitcnt vmcnt(0)" ::: "memory"); }
            __builtin_amdgcn_s_barrier();
        }
    }
    __device__ __forceinline__ void done(const Unit& u, int lane) const {
        if (role == 1) { asm volatile("s_waitcnt vmcnt(0)" ::: "memory");
            if (lane == 0) __hip_atomic_fetch_add(tdone + u.pm * 16, 1u, __ATOMIC_RELAXED, __HIP_MEMORY_SCOPE_AGENT); }
    }
    __device__ __forceinline__ bool next(int i, Unit& u) const {
        const long L = (long)i * G + c; if (L >= nunits) return false;
        const int wgid = xcd_remap((int)L, nunits);
        const int tl = wgid / nN; u.pn = wgid % nN;
        int e = 0, tstart = 0;
#pragma unroll 1
        for (int k = 0; k < NE - 1; ++k) { const int te = tab[16 + k]; if (tl >= te) { e = k + 1; tstart = te; } }
        u.e = __builtin_amdgcn_readfirstlane(e); u.mt = __builtin_amdgcn_readfirstlane(tl - tstart); u.pm = tl; return true;
    }
    __device__ __forceinline__ const char* a_ptr(const Unit& u) const { return gather ? A : A + (size_t)u.pm * (size_t)(BM * K * 2); }
    __device__ __forceinline__ const char* b_ptr(const Unit& u) const { return Bt + (size_t)u.e * bstride_e + (size_t)u.pn * (size_t)(BM * K * 2); }
    __device__ __forceinline__ void a_voff(const Unit& u, const int (&R)[2], const int (&C)[2], unsigned (&v0)[2], unsigned (&v1)[2]) const {
        if (gather) {
            const int ce = tab[u.e];
            const unsigned* lp = list + (size_t)u.e * LISTCAP + u.mt * BM;
#pragma unroll
            for (int i = 0; i < 2; ++i) {
                const int r0 = R[i], r1 = R[i] + HALF;
                const unsigned t0 = (u.mt * BM + r0 < ce) ? (__builtin_nontemporal_load(lp + r0) >> 1) : 0u;
                const unsigned t1 = (u.mt * BM + r1 < ce) ? (__builtin_nontemporal_load(lp + r1) >> 1) : 0u;
                v0[i] = (t0 * (unsigned)K + (unsigned)C[i]) * 2u; v1[i] = (t1 * (unsigned)K + (unsigned)C[i]) * 2u;
            }
        } else {
#pragma unroll
            for (int i = 0; i < 2; ++i) { v0[i] = (unsigned)(R[i] * K + C[i]) * 2u; v1[i] = v0[i] + (unsigned)(HALF * K * 2); }
        }
    }
};

__device__ __forceinline__ unsigned cvt_pk_bf16(float lo, float hi) { unsigned r; asm volatile("v_cvt_pk_bf16_f32 %0, %1, %2" : "=v"(r) : "v"(lo), "v"(hi)); return r; }

template <class Epi, class Sched, bool F8 = false>
__device__ __forceinline__ void gemm_phase(LAS unsigned char* lds, int tid, const Sched& S, const Epi& E, int sc_w = 127, int sc_a = 127, int stag = 0) {
    if (stag) {
        const unsigned long long t0 = __builtin_amdgcn_s_memrealtime(), dl = (unsigned long long)((blockIdx.x >> 3) & 3) * (unsigned)stag;
        while (__builtin_amdgcn_s_memrealtime() - t0 < dl) __builtin_amdgcn_s_sleep(8);
    }
    const int wid = __builtin_amdgcn_readfirstlane(tid >> 6), lane = tid & 63, wr = wid >> 2, wc = wid & 3, fr = lane & 15, fq = lane >> 4;
    const int K = S.K, nt = K / BK;
    int Rr[2], Cc[2]; unsigned voffB[2];
#pragma unroll
    for (int i = 0; i < 2; ++i) { int R, C; stage_rc(tid * 16 + i * 8192, R, C); const int Rb = Epi::PERM ? ((R & ~31) + perm32(R & 31)) : R;
        Rr[i] = R; Cc[i] = C; voffB[i] = (unsigned)(Rb * K + C) * 2u; }
    const size_t kstep = (size_t)(BK * 2);
    const size_t hstep = (size_t)HALF * K * 2;
    const unsigned ldsw = (unsigned)wid * 1024u;
    const int aoff = lds_byte(wr * 64 + fr, fq * 8), boff = lds_byte(wc * 32 + fr, fq * 8);
#define PG8_SA(b, h) (((b) * 2 + (h)) * HTB)
#define PG8_SB(b, h) ((4 + (b) * 2 + (h)) * HTB)
#define PG8_STAGE(bufoff, gbase, voff) do { _Pragma("unroll") for (int _i = 0; _i < 2; ++_i) \
        __builtin_amdgcn_global_load_lds((const unsigned*)((const char*)(gbase) + (voff)[_i]), (LAS unsigned*)(lds + (bufoff) + ldsw + _i * 8192), 16, 0, 0); } while (0)
#define PG8_CAT(lo_, hi_) ((v8i){(int)(lo_).x, (int)(lo_).y, (int)(lo_).z, (int)(lo_).w, (int)(hi_).x, (int)(hi_).y, (int)(hi_).z, (int)(hi_).w})
#define PG8_LDA(dst, b, h) do { _Pragma("unroll") for (int m = 0; m < 4; ++m) { if constexpr (F8) { const u32x4 l_ = *(const LAS u32x4*)(lds + PG8_SA(b, h) + aoff + m * 2048), h_ = *(const LAS u32x4*)(lds + PG8_SA(b, h) + aoff + m * 2048 + 1024); dst##8[m] = PG8_CAT(l_, h_); } \
        else { _Pragma("unroll") for (int k = 0; k < 2; ++k) dst[m][k] = *(const LAS bf16x8*)(lds + PG8_SA(b, h) + aoff + m * 2048 + k * 1024); } } } while (0)
#define PG8_LDB(dst, b, h) do { _Pragma("unroll") for (int n = 0; n < 2; ++n) { if constexpr (F8) { const u32x4 l_ = *(const LAS u32x4*)(lds + PG8_SB(b, h) + boff + n * 2048), h_ = *(const LAS u32x4*)(lds + PG8_SB(b, h) + boff + n * 2048 + 1024); dst##8[n] = PG8_CAT(l_, h_); } \
        else { _Pragma("unroll") for (int k = 0; k < 2; ++k) dst[n][k] = *(const LAS bf16x8*)(lds + PG8_SB(b, h) + boff + n * 2048 + k * 1024); } } } while (0)
#define PG8_MMA(ai, bj, At, Bt) do { __builtin_amdgcn_s_setprio(1); _Pragma("unroll") for (int m = 0; m < 4; ++m) _Pragma("unroll") for (int n = 0; n < 2; ++n) { \
        if constexpr (F8) asm volatile("v_mfma_scale_f32_16x16x128_f8f6f4 %0, %1, %2, %0, %3, %4 op_sel_hi:[0,0,0]" : "+v"(acc[ai][bj][m][n]) : "v"(Bt##8[n]), "v"(At##8[m]), "v"(sc_w), "v"(sc_a)); \
        else { _Pragma("unroll") for (int k = 0; k < 2; ++k) acc[ai][bj][m][n] = __builtin_amdgcn_mfma_f32_16x16x32_bf16(Bt[n][k], At[m][k], acc[ai][bj][m][n], 0, 0, 0); } } \
        __builtin_amdgcn_s_setprio(0); } while (0)
#define PG8_WAIT_V(n) asm volatile("s_waitcnt vmcnt(" #n ")" ::: "memory")
#define PG8_WAIT_L(n) asm volatile("s_waitcnt lgkmcnt(" #n ")" ::: "memory")
#define PG8_BAR __builtin_amdgcn_s_barrier()
#define PG8_SCHED __builtin_amdgcn_sched_barrier(0)
    Unit cur, nxt; int ui = 0;
    if (!S.next(0, cur)) return;
    f32x4 acc[2][2][4][2];
#pragma unroll
    for (int a = 0; a < 2; ++a)
#pragma unroll
        for (int b = 0; b < 2; ++b)
#pragma unroll
            for (int m = 0; m < 4; ++m)
#pragma unroll
                for (int n = 0; n < 2; ++n) acc[a][b][m][n] = (f32x4){0.f, 0.f, 0.f, 0.f};
    bf16x8 At[4][2], B0[2][2], B1[2][2]; v8i At8[4], B08[2], B18[2];
    const char* cA = S.a_ptr(cur); const char* cB = S.b_ptr(cur);
    unsigned cv0[2], cv1[2], nv0[2], nv1[2];
    S.a_ready(cur, wid);
    S.a_voff(cur, Rr, Cc, cv0, cv1);
    PG8_STAGE(PG8_SB(0, 0), cB, voffB); PG8_STAGE(PG8_SB(0, 1), cB + hstep, voffB); PG8_STAGE(PG8_SA(0, 0), cA, cv0); PG8_STAGE(PG8_SA(0, 1), cA, cv1);
    if (wr == 1) PG8_BAR;
    PG8_WAIT_V(2); PG8_BAR;
    PG8_STAGE(PG8_SB(1, 0), cB + kstep, voffB); PG8_STAGE(PG8_SA(1, 0), cA + kstep, cv0); PG8_STAGE(PG8_SB(1, 1), cB + hstep + kstep, voffB);
    PG8_WAIT_V(6); PG8_BAR;
    for (;;) {
        const bool has_next = S.next(ui + 1, nxt);
        const char* nA = has_next ? S.a_ptr(nxt) : cA; const char* nB = has_next ? S.b_ptr(nxt) : cB;
        if (has_next) S.a_voff(nxt, Rr, Cc, nv0, nv1); else { nv0[0] = cv0[0]; nv0[1] = cv0[1]; nv1[0] = cv1[0]; nv1[1] = cv1[1]; }
        if constexpr (Sched::DYN_A) asm volatile("" : "+v"(nv0[0]), "+v"(nv0[1]), "+v"(nv1[0]), "+v"(nv1[1]));
        for (int t = 0; t < nt; t += 2) {
            const bool last = (t == nt - 2);
            if (last && has_next) S.a_ready(nxt, wid);
            const char* a1 = cA + (size_t)(t + 1) * kstep;
            const char* a2 = last ? nA : cA + (size_t)(t + 2) * kstep; const char* b2 = last ? nB : cB + (size_t)(t + 2) * kstep;
            const char* a3 = a2 + kstep; const char* b3 = b2 + kstep;
            unsigned w0[2], w1[2];
            w0[0] = last ? nv0[0] : cv0[0]; w0[1] = last ? nv0[1] : cv0[1]; w1[0] = last ? nv1[0] : cv1[0]; w1[1] = last ? nv1[1] : cv1[1];
            PG8_LDB(B0, 0, 0); PG8_LDB(B1, 0, 1); PG8_SCHED; PG8_LDA(At, 0, 0); PG8_STAGE(PG8_SA(1, 1), a1, cv1);
            PG8_WAIT_V(8); PG8_WAIT_L(0); PG8_BAR; PG8_MMA(0, 0, At, B0); PG8_MMA(0, 1, At, B1); PG8_BAR; PG8_SCHED;
            PG8_LDA(At, 0, 1); PG8_STAGE(PG8_SB(0, 0), b2, voffB); PG8_STAGE(PG8_SB(0, 1), b2 + hstep, voffB); PG8_STAGE(PG8_SA(0, 0), a2, w0);
            PG8_WAIT_V(8); PG8_WAIT_L(0); PG8_BAR; PG8_MMA(1, 0, At, B0); PG8_MMA(1, 1, At, B1); PG8_BAR; PG8_SCHED;
            PG8_LDB(B0, 1, 0); PG8_LDB(B1, 1, 1); PG8_SCHED; PG8_LDA(At, 1, 0); PG8_STAGE(PG8_SA(0, 1), a2, w1);
            PG8_WAIT_V(8); PG8_WAIT_L(0); PG8_BAR; PG8_MMA(0, 0, At, B0); PG8_MMA(0, 1, At, B1); PG8_BAR; PG8_SCHED;
            PG8_LDA(At, 1, 1); PG8_STAGE(PG8_SB(1, 0), b3, voffB); PG8_STAGE(PG8_SB(1, 1), b3 + hstep, voffB); PG8_STAGE(PG8_SA(1, 0), a3, w0);
            PG8_WAIT_V(8); PG8_WAIT_L(0); PG8_BAR; PG8_MMA(1, 0, At, B0); PG8_MMA(1, 1, At, B1); PG8_BAR; PG8_SCHED;
        }
        if constexpr (F8) asm volatile("s_nop 15\n\ts_nop 15" ::: "memory");
        if (ALIGN_EPI) { if (wr == 0) PG8_BAR; }
        E(acc, cur, wr, wc, fr, fq);
        S.done(cur, lane);
        if (!has_next) break;
#pragma unroll
        for (int a = 0; a < 2; ++a)
#pragma unroll
            for (int b = 0; b < 2; ++b)
#pragma unroll
                for (int m = 0; m < 4; ++m)
#pragma unroll
                    for (int n = 0; n < 2; ++n) acc[a][b][m][n] = (f32x4){0.f, 0.f, 0.f, 0.f};
        cur = nxt; cA = nA; cB = nB; ++ui;
        cv0[0] = nv0[0]; cv0[1] = nv0[1]; cv1[0] = nv1[0]; cv1[1] = nv1[1];
        if (ALIGN_EPI) { if (wr == 1) PG8_BAR; }
    }
    PG8_WAIT_V(0);
    if (!ALIGN_EPI) { if (wr == 0) PG8_BAR; }
    PG8_BAR;
#undef PG8_SA
#undef PG8_SB
#undef PG8_STAGE
#undef PG8_CAT
#undef PG8_LDA
#undef PG8_LDB
#undef PG8_MMA
#undef PG8_WAIT_V
#undef PG8_WAIT_L
#undef PG8_BAR
#undef PG8_SCHED
}
}

#define XB_TMO      128
#define XB_XCNT(j)  (256  + 64 * (j))
#define XB_XSUB(j)  (1280 + 64 * (j))
#define XB_XGEN(j)  (2304 + 64 * (j))
#define XB_TOP      3328
#define XB_TOPGEN   3392
#define XCD_BAR_WORDS 3456
#define XB_SPIN_CAP (1u << 18)
__device__ __forceinline__ unsigned xb_ld(unsigned* p)              { return __hip_atomic_load(p, __ATOMIC_RELAXED, __HIP_MEMORY_SCOPE_AGENT); }
__device__ __forceinline__ unsigned xb_add(unsigned* p, unsigned v) { return __hip_atomic_fetch_add(p, v, __ATOMIC_RELAXED, __HIP_MEMORY_SCOPE_AGENT); }
__device__ __forceinline__ unsigned xb_xcc_id() { return (unsigned)__builtin_amdgcn_s_getreg((3 << 11) | 20) & 0xFu; }
#define XB_SPIN(cond, bar) do { unsigned _sp = 0; while (cond) { __builtin_amdgcn_s_sleep(1); \
    if ((++_sp & 255u) == 0u) { if (xb_ld(&(bar)[XB_TMO])) break; if (_sp > XB_SPIN_CAP) { atomicAdd(&(bar)[XB_TMO], 1u); break; } } } } while (0)
struct XcdBarrier { unsigned* bar; unsigned x; volatile LAS unsigned* st; };
__device__ __forceinline__ XcdBarrier xcd_barrier_post(unsigned* bar, volatile LAS unsigned* st) {
    XcdBarrier b; b.bar = bar; b.x = xb_xcc_id(); b.st = st;
    if (threadIdx.x == 0) (void)xb_add(&bar[XB_XCNT(b.x)], 1u);
    return b;
}
__device__ __forceinline__ void xcd_barrier_complete(unsigned* bar, unsigned x, unsigned& nloc, unsigned& nx) {
    const unsigned G = gridDim.x * gridDim.y * gridDim.z;
    unsigned sum, cnt, mine, sp = 0u;
    for (;;) {
        sum = 0u; cnt = 0u; mine = 0u;
#pragma unroll
        for (unsigned j = 0; j < 16; ++j) { const unsigned c = xb_ld(&bar[XB_XCNT(j)]); sum += c; cnt += (c > 0u) ? 1u : 0u; mine = (j == x) ? c : mine; }
        if (sum == G) break;
        __builtin_amdgcn_s_sleep(1);
        if ((++sp & 255u) == 0u) { if (xb_ld(&bar[XB_TMO])) break; if (sp > XB_SPIN_CAP) { atomicAdd(&bar[XB_TMO], 1u); break; } }
    }
    nloc = mine > 0u ? mine : 1u; nx = cnt > 0u ? cnt : 1u;
}
__device__ __forceinline__ void xcd_barrier(const XcdBarrier& b, int tid) {
    asm volatile("s_waitcnt vmcnt(0)" ::: "memory");
    __syncthreads();
    if (tid == 0) {
        unsigned* bar = b.bar;
        __builtin_amdgcn_s_waitcnt(0);
        unsigned nloc = b.st[0], nx = b.st[1];
        if (nloc == 0u) { xcd_barrier_complete(bar, b.x, nloc, nx); b.st[0] = nloc; b.st[1] = nx; }
        const unsigned old = xb_add(&bar[XB_XSUB(b.x)], 1u);
        const unsigned gen = old / nloc;
        if (old + 1u == (gen + 1u) * nloc) {
            __builtin_amdgcn_fence(__ATOMIC_RELEASE, "agent");
            asm volatile("s_waitcnt vmcnt(0)" ::: "memory");
            const unsigned og = xb_add(&bar[XB_TOP], 1u);
            const unsigned tg = og / nx;
            if (og + 1u == (tg + 1u) * nx) xb_add(&bar[XB_TOPGEN], 1u);
            else XB_SPIN(xb_ld(&bar[XB_TOPGEN]) == tg, bar);
            __builtin_amdgcn_fence(__ATOMIC_ACQUIRE, "agent");
            xb_add(&bar[XB_XGEN(b.x)], 1u);
            asm volatile("s_waitcnt vmcnt(0)" ::: "memory");
        } else {
            XB_SPIN(xb_ld(&bar[XB_XGEN(b.x)]) == gen, bar);
            __builtin_amdgcn_fence(__ATOMIC_ACQUIRE, "agent");
            asm volatile("s_waitcnt vmcnt(0)" ::: "memory");
        }
    }
    __syncthreads();
}

constexpr int NWAVES = 8;
constexpr int RING_BYTES = 131072, LDSCTL_OFF = RING_BYTES, MISC_OFF = LDSCTL_OFF + 320, LDS_BYTES = 147456;
struct Args { const float* in[22]; float* out; unsigned char* ws; int ph_lo, ph_hi, li, pad; };
enum { I_X = 0, I_C, I_CTX, I_CCTX, I_WADA, I_BADA, I_NORM1, I_NORM2, I_WIN, I_UPF, I_BIASF, I_UPB, I_BIASB, I_GLANORM, I_SINK, I_WOUT, I_WROUTER, I_BROUTER, I_WGATE, I_WUP, I_WDOWN, I_FNORM };

struct Frame {
    LAS unsigned char* lds; int tid, lane, wave, vcu, G, gw, NGW;
    unsigned char* ws; float* out; bf16* xlb;
};

__device__ __forceinline__ int rope_pos(int d) { return 8 * ((d & 15) >> 2) + 4 * (d >> 4) + (d & 3); }
__device__ __forceinline__ int gu_row(int h, int gu) { return (h >> 7) * 256 + ((h >> 6) & 1) * 128 + ((h >> 4) & 3) * 32 + ((h >> 2) & 3) * 8 + gu * 4 + (h & 3); }
struct TItem { const float* src; bf16* dst; int N, Kd, n0, rbase, mode; bool ok; float f8scale; };
__device__ __forceinline__ void titem_load(const TItem& t, int lane, f32x4 (&v)[8]) {
    const int g = lane >> 3, i8 = lane & 7;
    const float* src = t.src + (size_t)(8 * g) * t.N + 4 * i8;
#pragma unroll
    for (int q = 0; q < 8; ++q) v[q] = *(const f32x4*)(src + (size_t)q * t.N);
}
__device__ __forceinline__ void titem_store(const TItem& t, int lane, const f32x4 (&v)[8]) {
    const int g = lane >> 3, i8 = lane & 7;
#pragma unroll
    for (int i = 0; i < 4; ++i) {
        const int n = 4 * i8 + i;
        const int row = (t.mode == 0) ? t.rbase + n : (t.mode == 1) ? t.rbase + rope_pos(n) : gu_row(t.n0 + n, t.mode - 2);
        if (t.f8scale != 0.f) {
            const float sc = t.f8scale; u32x2 o; o.x = pk4_fp8(v[0][i] * sc, v[1][i] * sc, v[2][i] * sc, v[3][i] * sc); o.y = pk4_fp8(v[4][i] * sc, v[5][i] * sc, v[6][i] * sc, v[7][i] * sc);
            *(u32x2*)((unsigned char*)t.dst + (size_t)row * t.Kd + 8 * g) = o;
        } else {
            u32x4 o; o.x = pk2(v[0][i], v[1][i]); o.y = pk2(v[2][i], v[3][i]); o.z = pk2(v[4][i], v[5][i]); o.w = pk2(v[6][i], v[7][i]);
            *(u32x4*)(t.dst + (size_t)row * t.Kd + 8 * g) = o;
        }
    }
}
constexpr int IT_IN = 2 * 16 * 73, IT_OUT = 2 * 16 * 32, IT_G = 32 * 16 * 16, IT_D = 32 * 8 * 32, NITEMS = IT_IN + IT_OUT + 2 * IT_G + IT_D;
__device__ __forceinline__ TItem titem_decode(const CAS Args* a, unsigned char* ws, int it) {
    TItem t; t.ok = it < NITEMS; t.mode = 0; t.rbase = 0; t.n0 = 0; t.N = D; t.Kd = D; t.src = nullptr; t.dst = nullptr; t.f8scale = 0.f;
    if (!t.ok) return t;
    int r = it;
    if (r < IT_IN) {
        const int l = r / 1168, rr = r % 1168, kb = rr / 73, nb = rr % 73;
        if (nb == 48) { t.ok = false; return t; }
        const int n0 = nb * 32; t.n0 = n0;
        if (n0 < 1536) t.rbase = n0;
        else if (n0 < 2080) { t.rbase = PC_SQ + (n0 - 1568); t.mode = 1; }
        else if (n0 < 2208) { t.rbase = PC_SK + (n0 - 2080); t.mode = 1; }
        else t.rbase = PC_SV + (n0 - 2208);
        t.N = WIN_COLS; t.Kd = D; t.src = a->in[I_WIN] + (size_t)l * D * WIN_COLS + (size_t)(kb * 64) * WIN_COLS + n0; t.dst = (bf16*)(ws + WS_WIN + (size_t)l * NIN * D + kb * 64); t.f8scale = W1_SCALE;
        return t;
    }
    r -= IT_IN;
    if (r < IT_OUT) { const int l = r / 512, rr = r % 512, kb = rr / 32, nb = rr % 32;
        t.n0 = nb * 32; t.rbase = nb * 32; t.N = D; t.Kd = D; t.src = a->in[I_WOUT] + (size_t)l * D * D + (size_t)(kb * 64) * D + nb * 32; t.dst = (bf16*)(ws + WS_WOUT + (size_t)l * D * D + kb * 64); t.f8scale = W1_SCALE; return t; }
    r -= IT_OUT;
    if (r < 2 * IT_G) { const int gu = r / IT_G, r2 = r % IT_G, le = r2 / 256, rr = r2 % 256, kb = rr / 16, nb = rr % 16;
        t.n0 = nb * 32; t.mode = 2 + gu; t.N = DE; t.Kd = D; t.src = a->in[gu ? I_WUP : I_WGATE] + (size_t)le * D * DE + (size_t)(kb * 64) * DE + nb * 32; t.dst = (bf16*)(ws + WS_WGU + (size_t)le * D * D + kb * 64); t.f8scale = W1_SCALE; return t; }
    r -= 2 * IT_G;
    { const int le = r / 256, rr = r % 256, kb = rr / 32, nb = rr % 32;
        t.n0 = nb * 32; t.rbase = nb * 32; t.N = D; t.Kd = DE; t.src = a->in[I_WDOWN] + (size_t)le * DE * D + (size_t)(kb * 64) * D + nb * 32; t.dst = (bf16*)(ws + WS_WD + (size_t)le * D * DE + kb * 64); t.f8scale = W2_SCALE; }
    return t;
}

template <class Map>
__device__ __forceinline__ void convert_items(const Frame& F, const CAS Args* a, int n, int worker, int nworkers, Map map) {
    unsigned char* ws = F.ws;
    for (int i = worker; i < n; i += 2 * nworkers) {
        const int i2 = i + nworkers;
        const TItem ta = titem_decode(a, ws, map(i)), tb = titem_decode(a, ws, i2 < n ? map(i2) : NITEMS);
        f32x4 va[8], vb[8];
        if (ta.ok) titem_load(ta, F.lane, va);
        if (tb.ok) titem_load(tb, F.lane, vb);
        if (ta.ok) titem_store(ta, F.lane, va);
        if (tb.ok) titem_store(tb, F.lane, vb);
    }
}
struct MapSmall { __device__ __forceinline__ int operator()(int i) const { return i; } };
struct MapMoe { int l; __device__ __forceinline__ int operator()(int i) const { const int kind = i >> 12, r = i & 4095; return IT_IN + IT_OUT + (kind < 2 ? kind * IT_G : 2 * IT_G) + l * 4096 + r; } };
__device__ __forceinline__ void convert_moe_filler(const Frame& F, const CAS Args* a, int l, int nunits, bool both = false) {
    const int c = (int)blockIdx.x, nfull = nunits % F.G;
    int first = nfull, nf = F.G - nfull - (both ? nfull : 0);
    if (nfull == 0 || nf <= 0) { first = 0; nf = F.G; }
    if (c < first || c >= first + nf) return;
    convert_items(F, a, 3 * 4096, (c - first) * NWAVES + F.wave, nf * NWAVES, MapMoe{l});
}

__device__ __forceinline__ void p0_prologue(const Frame& F, const CAS Args* a) {
    unsigned char* ws = F.ws;
    convert_items(F, a, IT_IN + IT_OUT, F.gw, F.NGW, MapSmall{});
    for (int idx = F.gw * 64 + F.lane; idx < 2 * 2 * 256 * 128; idx += F.NGW * 64) {
        const int kc = idx & 127, n = (idx >> 7) & 255, dir = (idx >> 15) & 1, l = idx >> 16;
        const float* up = a->in[dir ? I_UPB : I_UPF] + (size_t)l * 16 * 256 + n;
        float u[16];
#pragma unroll
        for (int r = 0; r < 16; ++r) u[r] = up[r * 256];
        float o[8];
#pragma unroll
        for (int kk = 0; kk < 8; ++kk) {
            const f32x4* wz = (const f32x4*)(a->in[I_WIN] + ((size_t)l * D + kc * 8 + kk) * WIN_COLS + 1536 + dir * 16);
            float s = 0.f;
#pragma unroll
            for (int q = 0; q < 4; ++q) { const f32x4 w = wz[q]; s += w[0] * u[4 * q] + w[1] * u[4 * q + 1] + w[2] * u[4 * q + 2] + w[3] * u[4 * q + 3]; }
            o[kk] = s;
        }
        u32x2 ov; ov.x = pk4_fp8(o[0] * W1_SCALE, o[1] * W1_SCALE, o[2] * W1_SCALE, o[3] * W1_SCALE); ov.y = pk4_fp8(o[4] * W1_SCALE, o[5] * W1_SCALE, o[6] * W1_SCALE, o[7] * W1_SCALE);
        *(u32x2*)(ws + WS_WIN + ((size_t)l * NIN + PC_GF + dir * 256 + n) * D + kc * 8) = ov;
    }
    if (blockIdx.x == (unsigned)(F.G - 1)) {
        float* tc = (float*)(ws + WS_ROPE); float* tsn = tc + 2048;
        for (int i = F.tid; i < 2048; i += NWAVES * 64) { const int pos = i >> 4, j = i & 15; const float inv = powf(10000.0f, -(float)j * (1.0f / 16.0f)); const float ang = (float)pos * inv;
            tc[i] = cosf(ang); tsn[i] = sinf(ang); }
    }
    __syncthreads();
    {
        LAS float* cs = (LAS float*)F.lds; LAS float* red = cs + 3072;
        for (int i = F.tid; i < 3072; i += NWAVES * 64) { const int v = i >> 10, k = i & 1023; const float cv = v < 2 ? a->in[I_C][v * D + k] : a->in[I_CCTX][k]; cs[i] = cv / (1.0f + expf(-cv)); }
        __syncthreads();
        for (int u = blockIdx.x; u < 192; u += F.G) {
            const int l = u / 96, jg = u % 96, jl = F.tid & 63, ks = F.tid >> 6;
            const float* wp = a->in[I_WADA] + ((size_t)l * D + ks * 128) * 6144 + jg * 64 + jl;
            float a0 = 0.f, a1 = 0.f, a2 = 0.f;
#pragma unroll 1
            for (int k0 = 0; k0 < 128; k0 += 32) {
                float wv[32];
#pragma unroll
                for (int k = 0; k < 32; ++k) wv[k] = wp[(size_t)(k0 + k) * 6144];
#pragma unroll
                for (int k = 0; k < 32; ++k) { const int kk = ks * 128 + k0 + k; a0 += cs[kk] * wv[k]; a1 += cs[1024 + kk] * wv[k]; a2 += cs[2048 + kk] * wv[k]; }
            }
            red[(ks * 3 + 0) * 64 + jl] = a0; red[(ks * 3 + 1) * 64 + jl] = a1; red[(ks * 3 + 2) * 64 + jl] = a2;
            __syncthreads();
            if (F.tid < 192) { const int v = F.tid >> 6, j2 = F.tid & 63; float s = 0.f;
#pragma unroll
                for (int q = 0; q < 8; ++q) s += red[(q * 3 + v) * 64 + j2];
                ((float*)(ws + WS_MOD))[(l * 3 + v) * 6144 + jg * 64 + j2] = s + a->in[I_BADA][l * 6144 + jg * 64 + j2]; }
            __syncthreads();
        }
    }
}

__device__ __forceinline__ f32x4 ld_y4(const bf16* p) { const u32x2 w = *(const u32x2*)p; return (f32x4){bflo(w.x), bfhi(w.x), bflo(w.y), bfhi(w.y)}; }
__device__ __forceinline__ void n1_load(const Frame& F, const CAS Args* a, int l, int m, f32x4 (&x)[4], f32x4 (&y)[4]) {
    unsigned char* ws = F.ws;
    const bf16* Y0 = (const bf16*)(ws + WS_Y); const bf16* Y1 = Y0 + (size_t)TT * D;
    const float* src = (l == 0) ? (m < TL ? a->in[I_X] + (size_t)m * D : a->in[I_CTX] + (size_t)(m - TL) * D) : (const float*)(ws + WS_XC) + (size_t)(m - TL) * D;
    const bool from_b = (l > 0) && (m < TL);
#pragma unroll
    for (int j = 0; j < 4; ++j) { const int col = 4 * F.lane + 256 * j; x[j] = from_b ? ld_y4(F.xlb + (size_t)m * D + col) : *(const f32x4*)(src + col);
        if (l > 0) y[j] = ld_y4(Y0 + (size_t)m * D + col) + ld_y4(Y1 + (size_t)m * D + col); }
}
__device__ __forceinline__ void n1_row(const Frame& F, const CAS Args* a, int l, int m, f32x4 (&x)[4], const f32x4 (&y)[4]) {
    unsigned char* ws = F.ws;
    const float* mod = (const float*)(ws + WS_MOD);
    bf16* H = (bf16*)(ws + WS_H);
    const int v = m < TL ? (m >> 13) : 2;
    float* xrow = (float*)(ws + WS_XC) + (size_t)(m - TL) * D;
    float ss = 0.f;
#pragma unroll
    for (int j = 0; j < 4; ++j) {
        const int col = 4 * F.lane + 256 * j;
        if (l > 0) { const f32x4 g2 = *(const f32x4*)(mod + ((l - 1) * 3 + v) * 6144 + 5 * D + col); x[j] = x[j] + g2 * y[j];
            if (m < TL) { u32x2 o; o.x = pk2(x[j][0], x[j][1]); o.y = pk2(x[j][2], x[j][3]); *(u32x2*)(F.xlb + (size_t)m * D + col) = o; } else *(f32x4*)(xrow + col) = x[j]; }
        ss += (x[j][0] * x[j][0] + x[j][1] * x[j][1]) + (x[j][2] * x[j][2] + x[j][3] * x[j][3]);
    }
    const float rstd = 1.0f / sqrtf(wave_sum(ss) * (1.0f / D) + EPS);
#pragma unroll
    for (int j = 0; j < 4; ++j) {
        const int col = 4 * F.lane + 256 * j;
        const f32x4 nw = *(const f32x4*)(a->in[I_NORM1] + l * D + col);
        const f32x4 sh = *(const f32x4*)(mod + (l * 3 + v) * 6144 + 0 * D + col);
        const f32x4 sc = *(const f32x4*)(mod + (l * 3 + v) * 6144 + 1 * D + col);
        const f32x4 h = x[j] * rstd * nw * (1.0f + sc) + sh;
        *(unsigned*)((unsigned char*)H + (size_t)m * D + col) = pk4_fp8(h[0], h[1], h[2], h[3]);
    }
}
__device__ __forceinline__ void n1_phase(const Frame& F, const CAS Args* a, int l) {
    for (int m = F.gw; m < TT; m += 2 * F.NGW) {
        const int m2 = m + F.NGW; const bool two = m2 < TT;
        f32x4 xa[4], ya[4], xb[4], yb[4];
        n1_load(F, a, l, m, xa, ya);
        if (two) n1_load(F, a, l, m2, xb, yb);
        n1_row(F, a, l, m, xa, ya);
        if (two) n1_row(F, a, l, m2, xb, yb);
    }
}

struct EpiIn {
    static constexpr bool PERM = true;
    bf16* P; const float* bias_f; const float* bias_b; const float* tcos; const float* tsin; int abl;
    template <int KIND>
    __device__ __forceinline__ void body(const f32x4 (&acc)[2][2][4][2], const pg8::Unit& u, int wr, int wc, int fr, int fq) const {
        const int row0 = u.pm * 256 + wr * 64 + fr, colw = wc * 32 + 8 * fq;
        f32x4 cs[4], sn[4], b0[2], b1[2];
        const bool wodd = (wc & 1) != 0;
        if (KIND == 3 || KIND == 5) {
            const int t0 = row0 & (SEQ - 1);
#pragma unroll
            for (int j = 0; j < 4; ++j) { const int pos = wodd ? ((t0 + 16 * j) & 63) : ((t0 + 128 * (j & 1)) >> 6);
                cs[j] = *(const f32x4*)(tcos + pos * 16 + 4 * fq); sn[j] = *(const f32x4*)(tsin + pos * 16 + 4 * fq); }
        }
        if (KIND == 2) {
#pragma unroll
            for (int bj = 0; bj < 2; ++bj) { const float* bp = (u.pn == 9 ? bias_f : bias_b) + colw + bj * 128; b0[bj] = *(const f32x4*)bp; b1[bj] = *(const f32x4*)(bp + 4); }
        }
#pragma unroll
        for (int ai = 0; ai < 2; ++ai)
#pragma unroll
            for (int m = 0; m < 4; ++m) {
                const int row = row0 + ai * 128 + m * 16;
                bf16* rowp = P + (size_t)row * NIN + u.pn * 256 + colw;
#pragma unroll
                for (int bj = 0; bj < 2; ++bj) {
                    f32x4 v0 = acc[ai][bj][m][0], v1 = acc[ai][bj][m][1];
                    if (KIND == 1) { v0 = v0 * 0.125f; v1 = v1 * 0.125f; }
                    if (KIND == 2) {
#pragma unroll
                        for (int i = 0; i < 4; ++i) { float x0 = v0[i] + b0[bj][i], x1 = v1[i] + b1[bj][i];
                            v0[i] = (fminf(x0, 0.f) - __logf(1.0f + __expf(-fabsf(x0)))) * 0.0625f; v1[i] = (fminf(x1, 0.f) - __logf(1.0f + __expf(-fabsf(x1)))) * 0.0625f; }
                    }
                    if (KIND == 3 || (KIND == 5 && bj == 0)) {
                        const f32x4 c = wodd ? cs[m] : cs[ai], sv = wodd ? sn[m] : sn[ai];
                        const f32x4 o0 = v0 * c - v1 * sv, o1 = v1 * c + v0 * sv; v0 = o0; v1 = o1;
                    }
                    if (KIND == 3 || KIND == 4) { v0 = v0 * QSCALE; v1 = v1 * QSCALE; }
                    u32x4 w; w.x = pg8::cvt_pk_bf16(v0[0], v0[1]); w.y = pg8::cvt_pk_bf16(v0[2], v0[3]); w.z = pg8::cvt_pk_bf16(v1[0], v1[1]); w.w = pg8::cvt_pk_bf16(v1[2], v1[3]);
                    *(u32x4*)(rowp + bj * 128) = w;
                }
            }
    }
    __device__ __forceinline__ void operator()(const f32x4 (&acc)[2][2][4][2], const pg8::Unit& u, int wr, int wc, int fr, int fq) const {
        const int pn = u.pn; const bool latent = u.pm < 64;
        if (pn == 0) body<1>(acc, u, wr, wc, fr, fq);
        else if (pn < 6) body<0>(acc, u, wr, wc, fr, fq);
        else if (pn < 8) { if (latent) body<3>(acc, u, wr, wc, fr, fq); else body<4>(acc, u, wr, wc, fr, fq); }
        else if (pn == 8) { if (latent) body<5>(acc, u, wr, wc, fr, fq); else body<0>(acc, u, wr, wc, fr, fq); }
        else body<2>(acc, u, wr, wc, fr, fq);
    }
};
struct EpiOut {
    static constexpr bool PERM = false;
    const float* resL; const float* resC; bf16* xlb; float* outC; const float* mod_l; bool res_b;
    __device__ __forceinline__ void operator()(const f32x4 (&acc)[2][2][4][2], const pg8::Unit& u, int wr, int wc, int fr, int fq) const {
        const bool latent = u.pm < 64;
        const int v = latent ? (u.pm >> 5) : 2;
        const int rowb = (latent ? u.pm * 256 : u.pm * 256 - TL) + wr * 64 + fr;
        const int col0 = u.pn * 256 + wc * 32 + 4 * fq;
        const float* g1p = mod_l + v * 6144 + 2 * D + col0;
        f32x4 g1[2][2];
#pragma unroll
        for (int bj = 0; bj < 2; ++bj)
#pragma unroll
            for (int n = 0; n < 2; ++n) g1[bj][n] = *(const f32x4*)(g1p + bj * 128 + n * 16);
        const bool rb = latent && res_b;
        const float* res = latent ? resL : resC;
#pragma unroll
        for (int ai = 0; ai < 2; ++ai)
#pragma unroll
            for (int mp = 0; mp < 4; mp += 2) {
                f32x4 r[2][2][2];
#pragma unroll
                for (int m = 0; m < 2; ++m) { const size_t off = (size_t)(rowb + ai * 128 + (mp + m) * 16) * D + col0;
#pragma unroll
                    for (int bj = 0; bj < 2; ++bj)
#pragma unroll
                        for (int n = 0; n < 2; ++n) r[m][bj][n] = rb ? ld_y4(xlb + off + bj * 128 + n * 16) : *(const f32x4*)(res + off + bj * 128 + n * 16); }
#pragma unroll
                for (int m = 0; m < 2; ++m) { const size_t off = (size_t)(rowb + ai * 128 + (mp + m) * 16) * D + col0;
#pragma unroll
                    for (int bj = 0; bj < 2; ++bj)
#pragma unroll
                        for (int n = 0; n < 2; ++n) { const f32x4 o = r[m][bj][n] + g1[bj][n] * acc[ai][bj][mp + m][n];
                            if (latent) { u32x2 w; w.x = pk2(o[0], o[1]); w.y = pk2(o[2], o[3]); *(u32x2*)(xlb + off + bj * 128 + n * 16) = w; }
                            else *(f32x4*)(outC + off + bj * 128 + n * 16) = o; } }
                asm volatile("" ::: "memory");
            }
    }
};
struct EpiGU {
    static constexpr bool PERM = true;
    bf16* Hmid;
    __device__ __forceinline__ void operator()(const f32x4 (&acc)[2][2][4][2], const pg8::Unit& u, int wr, int wc, int fr, int fq) const {
        const int row0 = u.pm * 256 + wr * 64 + fr, hid0 = u.pn * 128 + wc * 16 + fq * 4;
#pragma unroll
        for (int ai = 0; ai < 2; ++ai)
#pragma unroll
            for (int m = 0; m < 4; ++m) {
                unsigned char* rowp = (unsigned char*)Hmid + (size_t)(row0 + ai * 128 + m * 16) * DE + hid0;
#pragma unroll
                for (int bj = 0; bj < 2; ++bj) {
                    const f32x4 g = acc[ai][bj][m][0], up = acc[ai][bj][m][1]; f32x4 o;
#pragma unroll
                    for (int i = 0; i < 4; ++i) o[i] = g[i] * __builtin_amdgcn_rcpf(1.0f + __expf(-g[i])) * up[i];
                    __hip_atomic_store((unsigned*)(rowp + bj * 64), pk4_fp8(o[0] * HMID_SCALE, o[1] * HMID_SCALE, o[2] * HMID_SCALE, o[3] * HMID_SCALE), __ATOMIC_RELAXED, __HIP_MEMORY_SCOPE_AGENT);
                }
            }
    }
};
struct EpiDown {
    static constexpr bool PERM = true;
    bf16* Y; const unsigned* list; const float* listw; const LAS int* tab;
    __device__ __forceinline__ void operator()(const f32x4 (&acc)[2][2][4][2], const pg8::Unit& u, int wr, int wc, int fr, int fq) const {
        const int ce = tab[u.e];
        const int r0 = u.mt * 256 + wr * 64 + fr, col0 = u.pn * 256 + wc * 32 + 8 * fq;
        const unsigned* lp = list + (size_t)u.e * LISTCAP; const float* lw = listw + (size_t)u.e * LISTCAP;
        unsigned tsv[2][4]; float wv[2][4];
#pragma unroll
        for (int ai = 0; ai < 2; ++ai)
#pragma unroll
            for (int m = 0; m < 4; ++m) { const int r = r0 + ai * 128 + m * 16; const bool ok = r < ce; tsv[ai][m] = ok ? __builtin_nontemporal_load(lp + r) : 0xffffffffu; wv[ai][m] = ok ? __builtin_nontemporal_load(lw + r) : 0.f; }
#pragma unroll
        for (int ai = 0; ai < 2; ++ai)
#pragma unroll
            for (int m = 0; m < 4; ++m) {
                const unsigned ts = tsv[ai][m]; const float w = wv[ai][m];
                if (ts != 0xffffffffu) {
                    bf16* rowp = Y + ((size_t)(ts & 1u) * TT + (ts >> 1)) * D + col0;
#pragma unroll
                    for (int bj = 0; bj < 2; ++bj) {
                        const f32x4 v0 = acc[ai][bj][m][0] * w, v1 = acc[ai][bj][m][1] * w;
                        u32x4 o; o.x = pg8::cvt_pk_bf16(v0[0], v0[1]); o.y = pg8::cvt_pk_bf16(v0[2], v0[3]); o.z = pg8::cvt_pk_bf16(v1[0], v1[1]); o.w = pg8::cvt_pk_bf16(v1[2], v1[3]);
                        *(u32x4*)(rowp + bj * 128) = o;
                    }
                }
            }
    }
};

__device__ __forceinline__ void swa_naive(const Frame& F, const CAS Args* a, int l) {
    const bf16* P = (const bf16*)(F.ws + WS_P); bf16* MIX = (bf16*)(F.ws + WS_MIX);
    const int total = (l == 0 ? TT : TL) * 8;
    for (int idx = F.gw * 64 + F.lane; idx < total; idx += F.NGW * 64) {
        const int m = idx >> 3, hq = idx & 7, kvh = hq >> 2;
        const bool latent = m < TL;
        const int b = latent ? (m >> 13) : ((m - TL) >> 8), t = m & (SEQ - 1);
        float q[64];
        { const u32x4* qp = (const u32x4*)(P + (size_t)m * NIN + PC_SQ + hq * 64);
#pragma unroll
          for (int c = 0; c < 8; ++c) { const u32x4 w = qp[c]; q[8 * c] = bflo(w.x); q[8 * c + 1] = bfhi(w.x); q[8 * c + 2] = bflo(w.y); q[8 * c + 3] = bfhi(w.y);
              q[8 * c + 4] = bflo(w.z); q[8 * c + 5] = bfhi(w.z); q[8 * c + 6] = bflo(w.w); q[8 * c + 7] = bfhi(w.w); } }
        float o[64];
#pragma unroll
        for (int d = 0; d < 64; ++d) o[d] = 0.f;
        const float sink = a->in[I_SINK][l * 8 + hq] * LOG2E;
        float mx = sink, den = 1.0f;
        const int lo = latent ? (t - 128 < 0 ? 0 : t - 128) : 0, hi = latent ? (t + 128 > SEQ - 1 ? SEQ - 1 : t + 128) : -1;
        const int nloc = hi - lo + 1;
        for (int kk = 0; kk < nloc + LC; ++kk) {
            const int krow = kk < nloc ? b * SEQ + lo + kk : TL + b * LC + (kk - nloc);
            const u32x4* kp = (const u32x4*)(P + (size_t)krow * NIN + PC_SK + kvh * 64);
            float s = 0.f;
#pragma unroll
            for (int c = 0; c < 8; ++c) { const u32x4 w = kp[c]; s += q[8 * c] * bflo(w.x) + q[8 * c + 1] * bfhi(w.x) + q[8 * c + 2] * bflo(w.y) + q[8 * c + 3] * bfhi(w.y)
                + q[8 * c + 4] * bflo(w.z) + q[8 * c + 5] * bfhi(w.z) + q[8 * c + 6] * bflo(w.w) + q[8 * c + 7] * bfhi(w.w); }
            const float mn = fmaxf(mx, s), f = exp2f(mx - mn), p = exp2f(s - mn);
            den = den * f + p; mx = mn;
            const u32x4* vp = (const u32x4*)(P + (size_t)krow * NIN + PC_SV + kvh * 64);
#pragma unroll
            for (int c = 0; c < 8; ++c) { const u32x4 w = vp[c];
                o[8 * c] = o[8 * c] * f + p * bflo(w.x); o[8 * c + 1] = o[8 * c + 1] * f + p * bfhi(w.x); o[8 * c + 2] = o[8 * c + 2] * f + p * bflo(w.y); o[8 * c + 3] = o[8 * c + 3] * f + p * bfhi(w.y);
                o[8 * c + 4] = o[8 * c + 4] * f + p * bflo(w.z); o[8 * c + 5] = o[8 * c + 5] * f + p * bfhi(w.z); o[8 * c + 6] = o[8 * c + 6] * f + p * bflo(w.w); o[8 * c + 7] = o[8 * c + 7] * f + p * bfhi(w.w); }
        }
        const float inv = 1.0f / den;
        u32x4* op = (u32x4*)(MIX + (size_t)m * D + 512 + hq * 64);
#pragma unroll
        for (int c = 0; c < 8; ++c) { u32x4 w; w.x = pk2(o[8 * c] * inv, o[8 * c + 1] * inv); w.y = pk2(o[8 * c + 2] * inv, o[8 * c + 3] * inv); w.z = pk2(o[8 * c + 4] * inv, o[8 * c + 5] * inv); w.w = pk2(o[8 * c + 6] * inv, o[8 * c + 7] * inv); op[c] = w; }
    }
}


typedef float f32x16 __attribute__((ext_vector_type(16)));
typedef short s16x4 __attribute__((ext_vector_type(4)));
__device__ __forceinline__ int crow(int r, int hi) { return (r & 3) + 8 * (r >> 2) + 4 * hi; }
__device__ __forceinline__ s16x4 vtr(const LAS unsigned char* p) { return __builtin_bit_cast(s16x4, __builtin_amdgcn_ds_read_tr16_b64_v4i16((LAS s16x4*)p)); }
constexpr int SWA_K = 0, SWA_V = 49152;
__device__ __forceinline__ void swa_kload(const LAS unsigned char* Kt, int kb, int lane, bf16x8 (&kf)[4]) {
    const int r32 = lane & 31, hi = lane >> 5;
#pragma unroll
    for (int d0 = 0; d0 < 4; ++d0) kf[d0] = *(const LAS bf16x8*)(Kt + (2 * d0 + hi) * 1024 + (32 * kb + r32) * 16);
}
__device__ __forceinline__ void swa_tile(const LAS unsigned char* Kt, const LAS unsigned char* Vt, const LAS unsigned char* Kn, int mtype, const bf16x8 (&qf)[2][4], f32x16 (&o)[2][2], float (&mrun)[2], float (&lrun)[2], int lane, int abl = 0) {
    const int r32 = lane & 31, hi = lane >> 5; bf16x8 kf[4]; (void)Kn;
    const LAS unsigned char* vp = Vt + ((lane >> 4) & 1) * 32 + (lane & 3) * 8 + (4 * hi + ((lane & 15) >> 2)) * 64;
#pragma unroll
    for (int kb = 0; kb < 2; ++kb) {
        f32x16 s[2];
        swa_kload(Kt, kb, lane, kf);
#pragma unroll
        for (int d0 = 0; d0 < 4; ++d0)
#pragma unroll
            for (int qt = 0; qt < 2; ++qt) {
                if (d0 == 0) { f32x16 z;
#pragma unroll
                    for (int r = 0; r < 16; ++r) z[r] = 0.f;
                    s[qt] = __builtin_amdgcn_mfma_f32_32x32x16_bf16(kf[0], qf[qt][0], z, 0, 0, 0); }
                else if (abl != 4) s[qt] = __builtin_amdgcn_mfma_f32_32x32x16_bf16(kf[d0], qf[qt][d0], s[qt], 0, 0, 0);
            }
        __builtin_amdgcn_sched_barrier(0);
        s16x4 vlo[2][2], vhi[2][2];
#pragma unroll
        for (int dt = 0; dt < 2; ++dt)
#pragma unroll
            for (int sp = 0; sp < 2; ++sp) { vlo[dt][sp] = vtr(vp + dt * 4096 + (2 * kb + sp) * 1024); vhi[dt][sp] = vtr(vp + dt * 4096 + (2 * kb + sp) * 1024 + 512); }
        __builtin_amdgcn_sched_barrier(0);
        bf16x8 pf[2][2];
#pragma unroll
        for (int qt = 0; qt < 2; ++qt) {
            if (mtype != 0) {
                int thr = r32 + 32 * qt - 4 * hi - 32 * kb; asm volatile("" : "+v"(thr));
                if (mtype == 1) {
#pragma unroll
                    for (int r = 0; r < 16; ++r) { const int cc = (r & 3) + 8 * (r >> 2); if (cc < thr) s[qt][r] = -INFINITY; }
                } else {
#pragma unroll
                    for (int r = 0; r < 16; ++r) { const int cc = (r & 3) + 8 * (r >> 2); if (cc > thr) s[qt][r] = -INFINITY; }
                }
            }
            float rm = s[qt][0];
            if (abl != 1) {
#pragma unroll
            for (int r = 1; r < 16; ++r) rm = fmaxf(rm, s[qt][r]);
            }
            { auto rr = __builtin_amdgcn_permlane32_swap(__float_as_uint(rm), __float_as_uint(rm), false, false); rm = fmaxf(__uint_as_float(rr[0]), __uint_as_float(rr[1])); }
            const float mn = fmaxf(mrun[qt], rm);
            if (__any(mn > mrun[qt])) {
                const float alpha = __builtin_amdgcn_exp2f(mrun[qt] - mn);
                lrun[qt] *= alpha;
#pragma unroll
                for (int dt = 0; dt < 2; ++dt)
#pragma unroll
                    for (int r = 0; r < 16; ++r) o[dt][qt][r] *= alpha;
                mrun[qt] = mn;
            }
            float rs = 0.f;
            if (abl != 1) {
#pragma unroll
            for (int r = 0; r < 16; ++r) { const float p = __builtin_amdgcn_exp2f(s[qt][r] - mn); s[qt][r] = p; rs += p; }
            }
            lrun[qt] += rs;
#pragma unroll
            for (int sp = 0; sp < 2; ++sp) {
                u32x4 w; w.x = pg8::cvt_pk_bf16(s[qt][8 * sp + 0], s[qt][8 * sp + 1]); w.y = pg8::cvt_pk_bf16(s[qt][8 * sp + 2], s[qt][8 * sp + 3]);
                w.z = pg8::cvt_pk_bf16(s[qt][8 * sp + 4], s[qt][8 * sp + 5]); w.w = pg8::cvt_pk_bf16(s[qt][8 * sp + 6], s[qt][8 * sp + 7]);
                pf[qt][sp] = __builtin_bit_cast(bf16x8, w);
            }
        }
#pragma unroll
        for (int dt = 0; dt < 2; ++dt)
#pragma unroll
            for (int sp = 0; sp < 2; ++sp) {
                const bf16x8 vf = (bf16x8){vlo[dt][sp][0], vlo[dt][sp][1], vlo[dt][sp][2], vlo[dt][sp][3], vhi[dt][sp][0], vhi[dt][sp][1], vhi[dt][sp][2], vhi[dt][sp][3]};
#pragma unroll
                for (int qt = 0; qt < 2; ++qt) if (abl != 2) o[dt][qt] = __builtin_amdgcn_mfma_f32_32x32x16_bf16(vf, pf[qt][sp], o[dt][qt], 0, 0, 0);
            }
    }
}
__device__ __forceinline__ void swa_stage(const Frame& F, const bf16* P, int grow, int kvh, int ti) {
    { const int key = 8 * F.wave + (F.lane & 7), ch = F.lane >> 3;
      const u32x4 v = *(const u32x4*)(P + (size_t)(grow + key) * NIN + PC_SK + kvh * 64 + ch * 8);
      *(LAS u32x4*)(F.lds + SWA_K + ti * 8192 + ch * 1024 + key * 16) = v; }
    { const int key = 8 * F.wave + (F.lane >> 3), ch = F.lane & 7;
      const u32x4 v = *(const u32x4*)(P + (size_t)(grow + key) * NIN + PC_SV + kvh * 64 + ch * 8);
      *(LAS u32x4*)(F.lds + SWA_V + ti * 8192 + (ch >> 2) * 4096 + key * 64 + (ch & 3) * 16) = v; }
}
__device__ __forceinline__ void swa_flash(const Frame& F, const CAS Args* a, int l, int abl = 0) {
    const bf16* P = (const bf16*)(F.ws + WS_P); bf16* MIX = (bf16*)(F.ws + WS_MIX);
    const int nunits = 256 + (l == 0 ? 8 : 0);
    const int lane = F.lane, r32 = lane & 31, hi = lane >> 5;
    for (int u = F.vcu; u < nunits; u += F.G) {
        const bool latent = u < 256;
        const int b = latent ? (u >> 7) : ((u - 256) >> 2), kvh = latent ? ((u >> 6) & 1) : (((u - 256) >> 1) & 1), qb = latent ? (u & 63) : ((u - 256) & 1);
        const int q0 = qb * 128, g = F.wave >> 1, qs = F.wave & 1, hq = kvh * 4 + g;
        const int mrow0 = (latent ? b * SEQ : TL + b * LC) + q0 + 64 * qs;
        bf16x8 qf[2][4];
#pragma unroll
        for (int qt = 0; qt < 2; ++qt)
#pragma unroll
            for (int d0 = 0; d0 < 4; ++d0) { if (abl != 7) qf[qt][d0] = *(const bf16x8*)(P + (size_t)(mrow0 + 32 * qt + r32) * NIN + PC_SQ + hq * 64 + 16 * d0 + 8 * hi); else qf[qt][d0] = (bf16x8){(short)lane, 1, 2, 3, 4, 5, 6, 7}; }
        f32x16 o[2][2];
#pragma unroll
        for (int dt = 0; dt < 2; ++dt)
#pragma unroll
            for (int qt = 0; qt < 2; ++qt)
#pragma unroll
                for (int r = 0; r < 16; ++r) o[dt][qt][r] = 0.f;
        const float sink2 = a->in[I_SINK][l * 8 + hq] * LOG2E;
        float mrun[2] = {sink2, sink2}, lrun[2] = {hi == 0 ? 1.f : 0.f, hi == 0 ? 1.f : 0.f};
        if (latent) {
#pragma unroll 1
            for (int j = 0; j < 6; ++j) { const int ks = q0 - 128 + 64 * j; if (ks >= 0 && ks < SEQ && abl != 3) swa_stage(F, P, b * SEQ + ks, kvh, j); }
            LDS_BARRIER();
            { int jf = qs; while (q0 - 128 + 64 * jf < 0) ++jf;
              (void)jf;
#pragma unroll 1
              for (int tt = 0; tt < 5; ++tt) { const int j = qs + tt, ks = q0 - 128 + 64 * j;
                  if (ks >= 0 && ks < SEQ && abl != 8) { const int jn = (j + 1 < 6) ? j + 1 : j;
                      swa_tile(F.lds + SWA_K + j * 8192, F.lds + SWA_V + j * 8192, F.lds + SWA_K + jn * 8192, tt == 0 ? 1 : (tt == 4 ? 2 : 0), qf, o, mrun, lrun, lane, abl); } } }
            LDS_BARRIER();
        }
#pragma unroll 1
        for (int j = 0; j < 4; ++j) if (abl != 3) swa_stage(F, P, TL + b * LC + 64 * j, kvh, j);
        LDS_BARRIER();
        {
#pragma unroll 1
          for (int j = 0; j < 4; ++j) if (abl != 8) swa_tile(F.lds + SWA_K + j * 8192, F.lds + SWA_V + j * 8192, F.lds + SWA_K + (j < 3 ? j + 1 : j) * 8192, 0, qf, o, mrun, lrun, lane, abl); }
        LDS_BARRIER();
        LAS unsigned char* stg = F.lds + F.wave * 4096;
#pragma unroll
        for (int qt = 0; qt < 2; ++qt) {
            float lt = lrun[qt];
            { auto rr = __builtin_amdgcn_permlane32_swap(__float_as_uint(lt), __float_as_uint(lt), false, false); lt = __uint_as_float(rr[0]) + __uint_as_float(rr[1]); }
            const float is = MIX_SCALE / lt;
#pragma unroll
            for (int dt = 0; dt < 2; ++dt)
#pragma unroll
                for (int rg = 0; rg < 4; ++rg)
                    *(LAS unsigned*)(stg + (32 * qt + r32) * 64 + 32 * dt + 8 * rg + 4 * hi) = pk4_fp8(o[dt][qt][4 * rg] * is, o[dt][qt][4 * rg + 1] * is, o[dt][qt][4 * rg + 2] * is, o[dt][qt][4 * rg + 3] * is);
        }
        LDS_WAIT();
        if (abl != 7) {
            int le = lane; asm volatile("" : "+v"(le));
#pragma unroll
            for (int i = 0; i < 4; ++i) { const int row = 16 * i + (le >> 2), ch = le & 3;
                const u32x4 v = *(const LAS u32x4*)(stg + row * 64 + ch * 16);
                *(u32x4*)((unsigned char*)MIX + (size_t)(mrow0 + row) * D + 512 + hq * 64 + ch * 16) = v; }
        }
        LDS_BARRIER();
    }
}

constexpr size_t WS_US = WS_GL, WS_USC = WS_GL + 32 * MiB, WS_DEC = 7 * MiB;
static_assert(WS_USC + (size_t)16 * 4 * 8192 * 2 <= WS_END && WS_DEC + (size_t)16 * 132 * 64 * 4 <= WS_WIN, "ws map (gla)");
constexpr int GL_V = 0, GL_M0 = 16384, GL_MSZ = 64 * 72 * 2, GL_RED = GL_M0 + 4 * GL_MSZ;
__device__ __forceinline__ float wave_scan_incl(float v) {
    v += DPP_F(v, 0x111, 0xF); v += DPP_F(v, 0x112, 0xF); v += DPP_F(v, 0x114, 0xF); v += DPP_F(v, 0x118, 0xF);
    v += DPP_F(v, 0x142, 0xA); v += DPP_F(v, 0x143, 0xC); return v;
}
__device__ __forceinline__ float lane63(float v) { return __builtin_bit_cast(float, __builtin_amdgcn_readlane(__builtin_bit_cast(int, v), 63)); }
__device__ __forceinline__ void unpack8(const u32x4 w, float (&f)[8]) { f[0] = bflo(w.x); f[1] = bfhi(w.x); f[2] = bflo(w.y); f[3] = bfhi(w.y); f[4] = bflo(w.z); f[5] = bfhi(w.z); f[6] = bflo(w.w); f[7] = bfhi(w.w); }
__device__ __forceinline__ void gla_stage_v(const Frame& F, const bf16* P, int m0, int h) {
#pragma unroll
    for (int i = 0; i < 2; ++i) { const int p = F.tid + 512 * i, t = p >> 4, ch = p & 15;
        const u32x4 v = *(const u32x4*)(P + (size_t)(m0 + t) * NIN + PC_V + h * 128 + ch * 8);
        *(LAS u32x4*)(F.lds + GL_V + (ch >> 2) * 4096 + t * 64 + (ch & 3) * 16) = v; }
}
__device__ __forceinline__ void gla_g1_unit(const Frame& F, const bf16* P, int m0, int h, bf16* Uf, bf16* Ub, float* decf, float* decb) {
    const int w = F.wave, t = F.lane, c = t & 31, hi = t >> 5;
    const bf16* row = P + (size_t)(m0 + t) * NIN + h * 64 + 8 * w;
    float laf[8], lab[8], kk[8];
    unpack8(*(const u32x4*)(row + PC_GF), laf); unpack8(*(const u32x4*)(row + PC_GB), lab); unpack8(*(const u32x4*)(row + PC_K), kk);
    gla_stage_v(F, P, m0, h);
    LAS bf16* KOF = (LAS bf16*)(F.lds + GL_M0); LAS bf16* KOB = (LAS bf16*)(F.lds + GL_M0 + GL_MSZ);
#pragma unroll
    for (int i = 0; i < 8; ++i) {
        const float incf = wave_scan_incl(laf[i]), tf = lane63(incf), incb = wave_scan_incl(lab[i]), tb = lane63(incb);
        KOF[(8 * w + i) * 72 + t] = (bf16)f2bf(kk[i] * __expf(tf - incf));
        KOB[(8 * w + i) * 72 + t] = (bf16)f2bf(kk[i] * __expf(incb - lab[i]));
        if (t == 0) { decf[8 * w + i] = __expf(tf); decb[8 * w + i] = __expf(tb); }
    }
    LDS_BARRIER();
    const int dir = w >> 2, dvt = w & 3;
    const LAS unsigned char* vp = F.lds + GL_V + dvt * 4096 + ((t >> 4) & 1) * 32 + (t & 3) * 8 + ((t & 15) >> 2) * 64 + hi * 512;
    const LAS unsigned char* kb = F.lds + GL_M0 + dir * GL_MSZ + (c * 72 + 8 * hi) * 2;
    f32x16 acc[2];
#pragma unroll
    for (int j = 0; j < 2; ++j)
#pragma unroll
        for (int r = 0; r < 16; ++r) acc[j][r] = 0.f;
#pragma unroll
    for (int sp = 0; sp < 4; ++sp) {
        const s16x4 lo = vtr(vp + sp * 1024), hi4 = vtr(vp + sp * 1024 + 256);
        const bf16x8 vf = (bf16x8){lo[0], lo[1], lo[2], lo[3], hi4[0], hi4[1], hi4[2], hi4[3]};
#pragma unroll
        for (int j = 0; j < 2; ++j) { const bf16x8 kf = *(const LAS bf16x8*)(kb + j * 32 * 144 + sp * 32); acc[j] = __builtin_amdgcn_mfma_f32_32x32x16_bf16(kf, vf, acc[j], 0, 0, 0); }
    }
    bf16* U = dir ? Ub : Uf;
#pragma unroll
    for (int j = 0; j < 2; ++j) {
        u32x4 w0, w1;
        w0.x = pk2(acc[j][0], acc[j][1]); w0.y = pk2(acc[j][2], acc[j][3]); w0.z = pk2(acc[j][4], acc[j][5]); w0.w = pk2(acc[j][6], acc[j][7]);
        w1.x = pk2(acc[j][8], acc[j][9]); w1.y = pk2(acc[j][10], acc[j][11]); w1.z = pk2(acc[j][12], acc[j][13]); w1.w = pk2(acc[j][14], acc[j][15]);
        u32x4* up = (u32x4*)(U + ((j * 4 + dvt) * 64 + t) * 16);
        up[0] = w0; up[1] = w1;
    }
    LDS_BARRIER();
}
__device__ __forceinline__ void gla_g1(const Frame& F0, int l) {
    Frame F = F0; { int l_; asm volatile("v_mbcnt_lo_u32_b32 %0, -1, 0\n\tv_mbcnt_hi_u32_b32 %0, -1, %0" : "=v"(l_)); F.lane = l_; F.tid = F.wave * 64 + l_; }
    const bf16* P = (const bf16*)(F.ws + WS_P);
    bf16* US = (bf16*)(F.ws + WS_US); bf16* USC = (bf16*)(F.ws + WS_USC); float* DEC = (float*)(F.ws + WS_DEC);
    for (int u = F.vcu; u < 1056; u += F.G) {
        const bool latent = u < 1024; const int cc = u - 1024;
        const int b = latent ? (u >> 9) : (cc >> 4), h = latent ? ((u >> 7) & 3) : ((cc >> 2) & 3), n = latent ? (u & 127) : (cc & 3);
        const int m0 = latent ? b * SEQ + 64 * n : TL + b * LC + 64 * n;
        const int sf = (b * 4 + h) * 2;
        bf16* Uf = latent ? US + ((size_t)sf * 128 + n) * 8192 : USC + ((size_t)sf * 4 + n) * 8192;
        bf16* Ub = latent ? US + ((size_t)(sf + 1) * 128 + n) * 8192 : USC + ((size_t)(sf + 1) * 4 + n) * 8192;
        const int nd = latent ? n : 128 + n;
        gla_g1_unit(F, P, m0, h, Uf, Ub, DEC + ((size_t)sf * 132 + nd) * 64, DEC + ((size_t)(sf + 1) * 132 + nd) * 64);
    }
}
constexpr size_t WS_SS = WS_H, WS_SSC = WS_H + 32 * MiB;
static_assert(WS_SSC + (size_t)16 * 4 * 8192 * 2 <= WS_P, "ws map (gla states)");
__device__ __forceinline__ void gla_scan(const Frame& F) {
    for (int w0 = (F.vcu * NWAVES + F.wave) * 64; w0 < 16 * 4096; w0 += F.G * NWAVES * 64) {
        const int seq = __builtin_amdgcn_readfirstlane(w0 >> 12), ew = __builtin_amdgcn_readfirstlane((w0 & 4095) * 2);
        const int dir = seq & 1;
        const unsigned voff = (unsigned)F.lane * 4u;
        unsigned doff;
        { const int e = ew + 2 * F.lane, r = e & 15, ln = (e >> 4) & 63, dkt = e >> 12; doff = (unsigned)(32 * dkt + (r & 3) + 8 * (r >> 2) + 4 * (ln >> 5)) * 4u; }
        const char* decb = (const char*)(F.ws + WS_DEC) + (size_t)seq * 132 * 256;
        float s0 = 0.f, s1 = 0.f;
        { const char* ub = (const char*)(F.ws + WS_USC) + ((size_t)seq * 4 * 8192 + ew) * 2; char* sb = (char*)(F.ws + WS_SSC) + ((size_t)seq * 4 * 8192 + ew) * 2;
          unsigned u[4]; f32x2 d[4];
#pragma unroll
          for (int i = 0; i < 4; ++i) { const int n = dir ? 3 - i : i; u[i] = *(const unsigned*)(ub + (size_t)n * 16384 + voff); d[i] = *(const f32x2*)(decb + (size_t)(128 + n) * 256 + doff); }
#pragma unroll
          for (int i = 0; i < 4; ++i) { const int n = dir ? 3 - i : i; *(unsigned*)(sb + (size_t)n * 16384 + voff) = pk2(s0, s1); s0 = d[i][0] * s0 + bflo(u[i]); s1 = d[i][1] * s1 + bfhi(u[i]); } }
        const long stride = dir ? -16384 : 16384, dstride = dir ? -256 : 256;
        const char* ub = (const char*)(F.ws + WS_US) + ((size_t)seq * 128 * 8192 + ew) * 2 + (dir ? (size_t)127 * 16384 : 0);
        char* sb = (char*)(F.ws + WS_SS) + ((size_t)seq * 128 * 8192 + ew) * 2 + (dir ? (size_t)127 * 16384 : 0);
        const char* db = decb + (dir ? 127 * 256 : 0);
#pragma unroll 1
        for (int i0 = 0; i0 < 128; i0 += 32) {
            unsigned u[32]; f32x2 d[32];
#pragma unroll
            for (int j = 0; j < 32; ++j) { u[j] = *(const unsigned*)(ub + j * stride + voff); d[j] = *(const f32x2*)(db + j * dstride + doff); }
#pragma unroll
            for (int j = 0; j < 32; ++j) { *(unsigned*)(sb + j * stride + voff) = pk2(s0, s1); s0 = d[j][0] * s0 + bflo(u[j]); s1 = d[j][1] * s1 + bfhi(u[j]); }
            ub += 32 * stride; sb += 32 * stride; db += 32 * dstride;
        }
    }
}
__device__ __forceinline__ void gla_g3_unit(const Frame& F, const CAS Args* a, int l, const bf16* P, int m0, int h, const bf16* Sf, const bf16* Sb, bf16* MIX) {
    const int w = F.wave, t = F.lane, c = t & 31, hi = t >> 5;
    bf16x8 sfr[4], sbr[4]; u32x2 gwv[4]; f32x4 nwv[4];
    { const int dvt_ = w >> 1, tt_ = w & 1;
#pragma unroll
      for (int kd = 0; kd < 4; ++kd) { const size_t off = (size_t)(((kd >> 1) * 4 + dvt_) * 64 + t) * 16 + 8 * (kd & 1); sfr[kd] = *(const bf16x8*)(Sf + off); sbr[kd] = *(const bf16x8*)(Sb + off); }
#pragma unroll
      for (int rg = 0; rg < 4; ++rg) { const int dv = 32 * dvt_ + 8 * rg + 4 * hi;
          gwv[rg] = *(const u32x2*)(P + (size_t)(m0 + 32 * tt_ + c) * NIN + PC_G + h * 128 + dv); nwv[rg] = *(const f32x4*)(a->in[I_GLANORM] + l * 512 + h * 128 + dv); } }
    {
        const bf16* row = P + (size_t)(m0 + t) * NIN + h * 64 + 8 * w;
        float laf[8], lab[8], kk[8], qq[8];
        unpack8(*(const u32x4*)(row + PC_GF), laf); unpack8(*(const u32x4*)(row + PC_GB), lab); unpack8(*(const u32x4*)(row + PC_K), kk); unpack8(*(const u32x4*)(row + PC_Q), qq);
        gla_stage_v(F, P, m0, h);
        float qf[8], kf[8], qb[8], kb[8];
#pragma unroll
        for (int i = 0; i < 8; ++i) {
            const float bf = wave_scan_incl(laf[i]), incb = wave_scan_incl(lab[i]), bb = lane63(incb) - incb + lab[i];
            qf[i] = qq[i] * __expf(bf); kf[i] = kk[i] * __expf(-bf); qb[i] = qq[i] * __expf(bb); kb[i] = kk[i] * __expf(-bb);
        }
        LAS unsigned char* mb = F.lds + GL_M0 + (t * 72 + 8 * w) * 2;
        u32x4 o;
        o.x = pk2(qf[0], qf[1]); o.y = pk2(qf[2], qf[3]); o.z = pk2(qf[4], qf[5]); o.w = pk2(qf[6], qf[7]); *(LAS u32x4*)(mb) = o;
        o.x = pk2(kf[0], kf[1]); o.y = pk2(kf[2], kf[3]); o.z = pk2(kf[4], kf[5]); o.w = pk2(kf[6], kf[7]); *(LAS u32x4*)(mb + GL_MSZ) = o;
        o.x = pk2(qb[0], qb[1]); o.y = pk2(qb[2], qb[3]); o.z = pk2(qb[4], qb[5]); o.w = pk2(qb[6], qb[7]); *(LAS u32x4*)(mb + 2 * GL_MSZ) = o;
        o.x = pk2(kb[0], kb[1]); o.y = pk2(kb[2], kb[3]); o.z = pk2(kb[4], kb[5]); o.w = pk2(kb[6], kb[7]); *(LAS u32x4*)(mb + 3 * GL_MSZ) = o;
    }
    LDS_BARRIER();
    const int dvt = w >> 1, tt = w & 1;
    bf16x8 qfB[4], qbB[4], qfP[4], qbP[4];
    { const LAS unsigned char* qp = F.lds + GL_M0 + ((32 * tt + c) * 72 + 8 * hi) * 2;
#pragma unroll
      for (int kd = 0; kd < 4; ++kd) { qfB[kd] = *(const LAS bf16x8*)(qp + kd * 32); qbB[kd] = *(const LAS bf16x8*)(qp + 2 * GL_MSZ + kd * 32); }
      const LAS unsigned char* pp = F.lds + GL_M0 + ((32 * tt + c) * 72 + 4 * hi) * 2;
#pragma unroll
      for (int kd = 0; kd < 4; ++kd) {
          const u32x2 a0 = *(const LAS u32x2*)(pp + kd * 32), a1 = *(const LAS u32x2*)(pp + kd * 32 + 16);
          const u32x2 b0 = *(const LAS u32x2*)(pp + 2 * GL_MSZ + kd * 32), b1 = *(const LAS u32x2*)(pp + 2 * GL_MSZ + kd * 32 + 16);
          qfP[kd] = __builtin_bit_cast(bf16x8, (u32x4){a0.x, a0.y, a1.x, a1.y}); qbP[kd] = __builtin_bit_cast(bf16x8, (u32x4){b0.x, b0.y, b1.x, b1.y});
      } }
    bf16x8 pfr[2][2];
#pragma unroll
    for (int st = 0; st < 2; ++st) {
        const LAS unsigned char* kp = F.lds + GL_M0 + GL_MSZ + ((32 * st + c) * 72 + 8 * hi) * 2;
        f32x16 xf, xb;
#pragma unroll
        for (int r = 0; r < 16; ++r) { xf[r] = 0.f; xb[r] = 0.f; }
        const bool needF = st <= tt, needB = st >= tt;
        if (needF) {
#pragma unroll
            for (int kd = 0; kd < 4; ++kd) xf = __builtin_amdgcn_mfma_f32_32x32x16_bf16(*(const LAS bf16x8*)(kp + kd * 32), qfB[kd], xf, 0, 0, 0);
        }
        if (needB) {
#pragma unroll
            for (int kd = 0; kd < 4; ++kd) xb = __builtin_amdgcn_mfma_f32_32x32x16_bf16(*(const LAS bf16x8*)(kp + 2 * GL_MSZ + kd * 32), qbB[kd], xb, 0, 0, 0);
        }
        if (st == tt) {
            int thr = c - 4 * hi; asm volatile("" : "+v"(thr));
#pragma unroll
            for (int r = 0; r < 16; ++r) { const int cc = (r & 3) + 8 * (r >> 2); xf[r] = (cc <= thr ? xf[r] : 0.f) + (cc >= thr ? xb[r] : 0.f); }
        } else {
#pragma unroll
            for (int r = 0; r < 16; ++r) xf[r] += xb[r];
        }
#pragma unroll
        for (int sp = 0; sp < 2; ++sp) {
            u32x4 wv; wv.x = pg8::cvt_pk_bf16(xf[8 * sp + 0], xf[8 * sp + 1]); wv.y = pg8::cvt_pk_bf16(xf[8 * sp + 2], xf[8 * sp + 3]);
            wv.z = pg8::cvt_pk_bf16(xf[8 * sp + 4], xf[8 * sp + 5]); wv.w = pg8::cvt_pk_bf16(xf[8 * sp + 6], xf[8 * sp + 7]);
            pfr[st][sp] = __builtin_bit_cast(bf16x8, wv);
        }
    }
    f32x16 o;
#pragma unroll
    for (int r = 0; r < 16; ++r) o[r] = 0.f;
    { const LAS unsigned char* vp = F.lds + GL_V + dvt * 4096 + ((t >> 4) & 1) * 32 + (t & 3) * 8 + (4 * hi + ((t & 15) >> 2)) * 64;
#pragma unroll
      for (int ks = 0; ks < 4; ++ks) {
          const s16x4 lo = vtr(vp + ks * 1024), hi4 = vtr(vp + ks * 1024 + 512);
          const bf16x8 vf = (bf16x8){lo[0], lo[1], lo[2], lo[3], hi4[0], hi4[1], hi4[2], hi4[3]};
          o = __builtin_amdgcn_mfma_f32_32x32x16_bf16(vf, pfr[ks >> 1][ks & 1], o, 0, 0, 0);
      } }
#pragma unroll
    for (int kd = 0; kd < 4; ++kd) {
        o = __builtin_amdgcn_mfma_f32_32x32x16_bf16(sfr[kd], qfP[kd], o, 0, 0, 0);
        o = __builtin_amdgcn_mfma_f32_32x32x16_bf16(sbr[kd], qbP[kd], o, 0, 0, 0);
    }
    float ssq = 0.f;
#pragma unroll
    for (int r = 0; r < 16; ++r) ssq += o[r] * o[r];
    { auto rr = __builtin_amdgcn_permlane32_swap(__float_as_uint(ssq), __float_as_uint(ssq), false, false); ssq = __uint_as_float(rr[0]) + __uint_as_float(rr[1]); }
    LAS float* red = (LAS float*)(F.lds + GL_RED);
    if (hi == 0) red[dvt * 64 + 32 * tt + c] = ssq;
    LDS_BARRIER();
    const float tot = (red[32 * tt + c] + red[64 + 32 * tt + c]) + (red[128 + 32 * tt + c] + red[192 + 32 * tt + c]);
    const float rstd = 1.0f / sqrtf(tot * (1.0f / 128.0f) + EPS);
    const int mrow = m0 + 32 * tt + c;
#pragma unroll
    for (int rg = 0; rg < 4; ++rg) {
        const int dv = 32 * dvt + 8 * rg + 4 * hi;
        const u32x2 gw = gwv[rg]; const f32x4 nw = nwv[rg];
        const float g0 = bflo(gw.x), g1 = bfhi(gw.x), g2 = bflo(gw.y), g3 = bfhi(gw.y);
        const float rs = rstd * MIX_SCALE;
        *(unsigned*)((unsigned char*)MIX + (size_t)mrow * D + h * 128 + dv) = pk4_fp8(o[4 * rg] * rs * nw[0] * silu_f(g0), o[4 * rg + 1] * rs * nw[1] * silu_f(g1), o[4 * rg + 2] * rs * nw[2] * silu_f(g2), o[4 * rg + 3] * rs * nw[3] * silu_f(g3));
    }
    LDS_BARRIER();
}
__device__ __forceinline__ void gla_g3(const Frame& F, const CAS Args* a, int l) {
    const bf16* P = (const bf16*)(F.ws + WS_P); bf16* MIX = (bf16*)(F.ws + WS_MIX);
    const bf16* US = (const bf16*)(F.ws + WS_SS); const bf16* USC = (const bf16*)(F.ws + WS_SSC);
    const int nunits = 1024 + (l == 0 ? 32 : 0);
    for (int u = F.vcu; u < nunits; u += F.G) {
        const bool latent = u < 1024; const int cc = u - 1024;
        const int b = latent ? (u >> 9) : (cc >> 4), h = latent ? ((u >> 7) & 3) : ((cc >> 2) & 3), n = latent ? (u & 127) : (cc & 3);
        const int m0 = latent ? b * SEQ + 64 * n : TL + b * LC + 64 * n;
        const int sf = (b * 4 + h) * 2;
        const bf16* Sf = latent ? US + ((size_t)sf * 128 + n) * 8192 : USC + ((size_t)sf * 4 + n) * 8192;
        const bf16* Sb = latent ? US + ((size_t)(sf + 1) * 128 + n) * 8192 : USC + ((size_t)(sf + 1) * 4 + n) * 8192;
        gla_g3_unit(F, a, l, P, m0, h, Sf, Sb, MIX);
    }
}

__device__ __forceinline__ void gla_naive(const Frame& F, const CAS Args* a, int l) {
    const bf16* P = (const bf16*)(F.ws + WS_P);
    bf16* OF = (bf16*)(F.ws + WS_GL);
    for (int w = F.gw; w < 2048; w += F.NGW) {
        const int dv = w & 127, dir = (w >> 7) & 1, h = (w >> 8) & 3, b = w >> 10;
        const int pcg = dir ? PC_GB : PC_GF;
        float S = 0.f;
        for (int step = 0; step < LC + SEQ; ++step) {
            int m;
            if (dir == 0) m = step < LC ? TL + b * LC + step : b * SEQ + (step - LC);
            else m = step < LC ? TL + b * LC + (LC - 1 - step) : b * SEQ + (SEQ - 1 - (step - LC));
            const bf16* row = P + (size_t)m * NIN;
            const float la = bf2f(row[pcg + h * 64 + F.lane]), kk = bf2f(row[PC_K + h * 64 + F.lane]), qq = bf2f(row[PC_Q + h * 64 + F.lane]), vv = bf2f(row[PC_V + h * 128 + dv]);
            S = __expf(la) * S + kk * vv;
            const float o = wave_sum(qq * S);
            if (F.lane == 0) OF[((size_t)dir * TT + m) * 512 + h * 128 + dv] = (bf16)f2bf(o);
        }
    }
}
__device__ __forceinline__ void gla_out_naive(const Frame& F, const CAS Args* a, int l) {
    const bf16* P = (const bf16*)(F.ws + WS_P); bf16* MIX = (bf16*)(F.ws + WS_MIX);
    const bf16* OF = (const bf16*)(F.ws + WS_GL);
    const int rows = (l == 0) ? TT : TL;
    for (int m = F.gw; m < rows; m += F.NGW) {
        const int c0 = 8 * F.lane;
        const u32x4 wa = *(const u32x4*)(OF + (size_t)m * 512 + c0), wb = *(const u32x4*)(OF + ((size_t)TT + m) * 512 + c0);
        float o[8] = {bflo(wa.x) + bflo(wb.x), bfhi(wa.x) + bfhi(wb.x), bflo(wa.y) + bflo(wb.y), bfhi(wa.y) + bfhi(wb.y), bflo(wa.z) + bflo(wb.z), bfhi(wa.z) + bfhi(wb.z), bflo(wa.w) + bflo(wb.w), bfhi(wa.w) + bfhi(wb.w)};
        float ss = 0.f;
#pragma unroll
        for (int i = 0; i < 8; ++i) ss += o[i] * o[i];
        ss = row16_sum(ss);
        const float rstd = 1.0f / sqrtf(ss * (1.0f / 128.0f) + EPS);
        const u32x4 wg = *(const u32x4*)(P + (size_t)m * NIN + PC_G + c0);
        const float g[8] = {bflo(wg.x), bfhi(wg.x), bflo(wg.y), bfhi(wg.y), bflo(wg.z), bfhi(wg.z), bflo(wg.w), bfhi(wg.w)};
        const f32x4 n0 = *(const f32x4*)(a->in[I_GLANORM] + l * 512 + c0), n1 = *(const f32x4*)(a->in[I_GLANORM] + l * 512 + c0 + 4);
        float r[8];
#pragma unroll
        for (int i = 0; i < 8; ++i) r[i] = o[i] * rstd * (i < 4 ? n0[i] : n1[i - 4]) * silu_f(g[i]);
        u32x4 w; w.x = pk2(r[0], r[1]); w.y = pk2(r[2], r[3]); w.z = pk2(r[4], r[5]); w.w = pk2(r[6], r[7]);
        *(u32x4*)(MIX + (size_t)m * D + c0) = w;
    }
}

constexpr int N2_WHI = 0, N2_WLO = 32768, N2_HHI = 65536, N2_HLO = 98304, N2_PART = 132096, N2_CNT = N2_PART + 8192, N2_RT = 20;
static_assert(N2_CNT + 256 + NWAVES * N2_RT * 16 <= LDS_BYTES && N2_PART >= MISC_OFF + 64 + 128, "N2 LDS map");
__device__ __forceinline__ int n2_addr(int r, int k) { return r * 2048 + ((((k >> 3) ^ r) & 127) << 4) + (k & 7) * 2; }
__device__ __forceinline__ void n2_route_phase(const Frame& F, const CAS Args* a, int l, bool do_route, int cset) {
    unsigned char* ws = F.ws;
    const float* mod = (const float*)(ws + WS_MOD);
    bf16* H = (bf16*)(ws + WS_H);
    unsigned* cnt = (unsigned*)(ws + WS_CTL) + CW_CNT + cset * NE * CNT_STRIDE;
    unsigned* list = (unsigned*)(ws + WS_LIST); float* listw = (float*)(ws + WS_LISTW);
    LAS unsigned* lcnt = (LAS unsigned*)(F.lds + N2_CNT); LAS unsigned* lbase = lcnt + 16; LAS unsigned* rec = lcnt + 64;
    for (int i = F.tid; i < D * NE; i += NWAVES * 64) { const int e = i & 15, k = i >> 4; const float w = a->in[I_WROUTER][i];
        const unsigned hi = f2bf(w); const unsigned lo = f2bf(w - bf2f(hi));
        *(LAS bf16*)(F.lds + N2_WHI + n2_addr(e, k)) = (bf16)hi; *(LAS bf16*)(F.lds + N2_WLO + n2_addr(e, k)) = (bf16)lo; }
    if (F.tid < 32) lcnt[F.tid] = 0u;
    LDS_BARRIER();
    const int rows = (l == 0) ? TT : TL;
    const int t0 = F.gw;
    const int nch = (rows - F.vcu * NWAVES + F.NGW - 1) / F.NGW;
    f32x4 xc[2][4], xq[2][4];
#pragma unroll
    for (int half = 0; half < 2; ++half) { const int m = t0 + half * F.NGW;
        if (m < rows) { const float* xr = (const float*)(ws + WS_XC) + (size_t)(m - TL) * D;
#pragma unroll
            for (int j = 0; j < 4; ++j) xq[half][j] = m < TL ? ld_y4(F.xlb + (size_t)m * D + 4 * F.lane + 256 * j) : *(const f32x4*)(xr + 4 * F.lane + 256 * j); } }
    for (int c2 = 0; c2 < nch; c2 += 2) {
#pragma unroll
        for (int half = 0; half < 2; ++half)
#pragma unroll
            for (int j = 0; j < 4; ++j) xc[half][j] = xq[half][j];
#pragma unroll
        for (int half = 0; half < 2; ++half) { const int m = t0 + (c2 + 2 + half) * F.NGW;
            if (m < rows) { const float* xr = (const float*)(ws + WS_XC) + (size_t)(m - TL) * D;
#pragma unroll
                for (int j = 0; j < 4; ++j) xq[half][j] = m < TL ? ld_y4(F.xlb + (size_t)m * D + 4 * F.lane + 256 * j) : *(const f32x4*)(xr + 4 * F.lane + 256 * j); } }
#pragma unroll
        for (int half = 0; half < 2; ++half) {
            const int m = t0 + (c2 + half) * F.NGW, r = 8 * half + F.wave;
            if (m < rows) {
                const int v = m < TL ? (m >> 13) : 2;
                f32x4 x[4]; float ss = 0.f;
#pragma unroll
                for (int j = 0; j < 4; ++j) { x[j] = xc[half][j]; ss += (x[j][0] * x[j][0] + x[j][1] * x[j][1]) + (x[j][2] * x[j][2] + x[j][3] * x[j][3]); }
                const float rstd = 1.0f / sqrtf(wave_sum(ss) * (1.0f / D) + EPS);
#pragma unroll
                for (int j = 0; j < 4; ++j) {
                    const int col = 4 * F.lane + 256 * j;
                    const f32x4 nw = *(const f32x4*)(a->in[I_NORM2] + l * D + col);
                    const f32x4 sh = *(const f32x4*)(mod + (l * 3 + v) * 6144 + 3 * D + col);
                    const f32x4 sc = *(const f32x4*)(mod + (l * 3 + v) * 6144 + 4 * D + col);
                    const f32x4 h = x[j] * rstd * nw * (1.0f + sc) + sh;
                    const unsigned h0 = f2bf(h[0]), h1 = f2bf(h[1]), h2 = f2bf(h[2]), h3 = f2bf(h[3]);
                    u32x2 o; o.x = h0 | (h1 << 16); o.y = h2 | (h3 << 16);
                    *(unsigned*)((unsigned char*)H + (size_t)m * D + col) = pk4_fp8(h[0], h[1], h[2], h[3]);
                    u32x2 lo; lo.x = pk2(h[0] - bf2f(h0), h[1] - bf2f(h1)); lo.y = pk2(h[2] - bf2f(h2), h[3] - bf2f(h3));
                    const int ad = n2_addr(r, col);
                    *(LAS u32x2*)(F.lds + N2_HHI + ad) = o; *(LAS u32x2*)(F.lds + N2_HLO + ad) = lo;
                }
            }
        }
        LDS_BARRIER();
        {
            const int rr = F.lane & 15, kg = F.lane >> 4;
            f32x4 acc = (f32x4){0.f, 0.f, 0.f, 0.f};
#pragma unroll
            for (int ks = 0; ks < 4; ++ks) {
                const int ad = n2_addr(rr, 128 * F.wave + 32 * ks + 8 * kg);
                const bf16x8 whi = *(const LAS bf16x8*)(F.lds + N2_WHI + ad), wlo = *(const LAS bf16x8*)(F.lds + N2_WLO + ad);
                const bf16x8 hhi = *(const LAS bf16x8*)(F.lds + N2_HHI + ad), hlo = *(const LAS bf16x8*)(F.lds + N2_HLO + ad);
                acc = __builtin_amdgcn_mfma_f32_16x16x32_bf16(whi, hhi, acc, 0, 0, 0);
                acc = __builtin_amdgcn_mfma_f32_16x16x32_bf16(whi, hlo, acc, 0, 0, 0);
                acc = __builtin_amdgcn_mfma_f32_16x16x32_bf16(wlo, hhi, acc, 0, 0, 0);
            }
            *(LAS f32x4*)(F.lds + N2_PART + ((F.wave * 16 + rr) * 16 + 4 * kg) * 4) = acc;
        }
        LDS_BARRIER();
        if (F.wave == 0) {
            const int rr = F.lane & 15, eg = F.lane >> 4;
            f32x4 lg = (f32x4){0.f, 0.f, 0.f, 0.f};
#pragma unroll
            for (int w = 0; w < NWAVES; ++w) lg = lg + *(const LAS f32x4*)(F.lds + N2_PART + ((w * 16 + rr) * 16 + 4 * eg) * 4);
            const f32x4 br = *(const f32x4*)(a->in[I_BROUTER] + 4 * eg);
            float sg[4], sb[4];
#pragma unroll
            for (int i = 0; i < 4; ++i) { sg[i] = 1.0f / (1.0f + expf(-lg[i])); sb[i] = sg[i] + br[i]; }
            int i0 = 0, i1 = 0; float b0 = -1e30f, b1 = -1e30f, s0 = 0.f, s1 = 0.f;
#pragma unroll
            for (int i = 0; i < 4; ++i) { const float val = sb[i];
                if (val > b0) { b1 = b0; i1 = i0; s1 = s0; b0 = val; i0 = i; s0 = sg[i]; } else if (val > b1) { b1 = val; i1 = i; s1 = sg[i]; } }
            const float gs = b0 + b1;
            float best = gs; int bg = eg;
#pragma unroll
            for (int st = 16; st < 64; st <<= 1) {
                const float og = __builtin_bit_cast(float, __builtin_amdgcn_ds_bpermute((F.lane ^ st) << 2, __builtin_bit_cast(int, best)));
                const int oi = __builtin_amdgcn_ds_bpermute((F.lane ^ st) << 2, bg);
                if (og > best || (og == best && oi < bg)) { best = og; bg = oi; }
            }
            const int half = rr >> 3, wv = rr & 7, ch = c2 + half;
            const int m = F.vcu * NWAVES + wv + ch * F.NGW;
            if (do_route && bg == eg && m < rows) {
                const int e0 = 4 * eg + i0, e1 = 4 * eg + i1; const float inv = 1.0f / (s0 + s1);
                if (ch < N2_RT) {
                    const int slot = wv * N2_RT + ch;
                    const unsigned l0 = atomicAdd((unsigned*)(lcnt + e0), 1u), l1 = atomicAdd((unsigned*)(lcnt + e1), 1u);
                    rec[slot * 4 + 0] = (unsigned)m; rec[slot * 4 + 1] = (unsigned)e0 | ((unsigned)e1 << 8) | (l0 << 16) | (l1 << 24);
                    rec[slot * 4 + 2] = __float_as_uint(s0 * inv); rec[slot * 4 + 3] = __float_as_uint(s1 * inv);
                } else {
                    const unsigned p0 = atomicAdd(cnt + e0 * CNT_STRIDE, 1u); list[(size_t)e0 * LISTCAP + p0] = (unsigned)m * 2u; listw[(size_t)e0 * LISTCAP + p0] = s0 * inv;
                    const unsigned p1 = atomicAdd(cnt + e1 * CNT_STRIDE, 1u); list[(size_t)e1 * LISTCAP + p1] = (unsigned)m * 2u + 1u; listw[(size_t)e1 * LISTCAP + p1] = s1 * inv;
                }
            }
        }
    }
    LDS_BARRIER();
    if (do_route) {
        if (F.tid < NE) { const unsigned c = lcnt[F.tid]; lbase[F.tid] = c ? atomicAdd(cnt + F.tid * CNT_STRIDE, c) : 0u; }
        LDS_BARRIER();
        for (int i = F.tid; i < NWAVES * N2_RT; i += NWAVES * 64) {
            const int wv = i / N2_RT, k = i % N2_RT;
            if (F.vcu * NWAVES + wv + k * F.NGW < rows) {
                const unsigned m = rec[i * 4], pk = rec[i * 4 + 1]; const unsigned e0 = pk & 255u, e1 = (pk >> 8) & 255u, l0 = (pk >> 16) & 255u, l1 = pk >> 24;
                const unsigned p0 = lbase[e0] + l0, p1 = lbase[e1] + l1;
                list[(size_t)e0 * LISTCAP + p0] = m * 2u; listw[(size_t)e0 * LISTCAP + p0] = __uint_as_float(rec[i * 4 + 2]);
                list[(size_t)e1 * LISTCAP + p1] = m * 2u + 1u; listw[(size_t)e1 * LISTCAP + p1] = __uint_as_float(rec[i * 4 + 3]);
            }
        }
    }
    LDS_BARRIER();
}

__device__ __forceinline__ void moe_setup(pg8::MoeOrder& S, const Frame& F, int cset, int nN) {
    unsigned* cnt = (unsigned*)(F.ws + WS_CTL) + CW_CNT + cset * NE * CNT_STRIDE;
    LAS int* tab = (LAS int*)(F.lds + MISC_OFF + 64);
    __syncthreads();
    if (F.tid == 0) { int run = 0;
        for (int e = 0; e < NE; ++e) { const int c = (int)__hip_atomic_load(cnt + e * CNT_STRIDE, __ATOMIC_RELAXED, __HIP_MEMORY_SCOPE_AGENT); tab[e] = c; run += (c + 255) >> 8; tab[16 + e] = run; } }
    __syncthreads();
    S.tab = tab; S.nN = nN; S.nunits = __builtin_amdgcn_readfirstlane(tab[31]) * nN; S.G = F.G; S.c = (int)blockIdx.x;
    S.tdone = (unsigned*)(F.ws + WS_CTL) + CW_TDONE + cset * 160 * 16; S.role = 0;
    S.list = (const unsigned*)(F.ws + WS_LIST);
}
__device__ __forceinline__ void moe1_phase(const Frame& F, const CAS Args* a, int l, int cset) {
    pg8::MoeOrder S; moe_setup(S, F, cset, 4);
    S.A = (const char*)(F.ws + WS_H); S.Bt = (const char*)(F.ws + WS_WGU) + (size_t)l * NE * D * D; S.K = D / 2; S.bstride_e = (size_t)D * D; S.gather = true; S.role = 1;
    EpiGU E{(bf16*)(F.ws + WS_HMID)};
    pg8::gemm_phase<EpiGU, pg8::MoeOrder, true>(F.lds, F.tid, S, E, SC_W1, SC_ONE);
}
__device__ __forceinline__ void moe2_phase(const Frame& F, const CAS Args* a, int l, int cset) {
    pg8::MoeOrder S; moe_setup(S, F, cset, 4);
    S.A = (const char*)(F.ws + WS_HMID); S.Bt = (const char*)(F.ws + WS_WD) + (size_t)l * NE * D * DE; S.K = DE / 2; S.bstride_e = (size_t)D * DE; S.gather = false; S.role = 2; S.c = F.G - 1 - (int)blockIdx.x;
    EpiDown E; E.Y = (bf16*)(F.ws + WS_Y); E.list = (const unsigned*)(F.ws + WS_LIST); E.listw = (const float*)(F.ws + WS_LISTW); E.tab = S.tab;
    pg8::gemm_phase<EpiDown, pg8::MoeOrder, true>(F.lds, F.tid, S, E, SC_W2, SC_HMID);
    if (l == 0 && cset == 0) convert_moe_filler(F, a, 1, S.nunits, true);
}

__device__ __forceinline__ void final_load(const Frame& F, int m, f32x4 (&x)[4]) {
    const float* mod = (const float*)(F.ws + WS_MOD);
    const bf16* Y0 = (const bf16*)(F.ws + WS_Y); const bf16* Y1 = Y0 + (size_t)TT * D;
    const int v = m >> 13; const bf16* xrow = F.xlb + (size_t)m * D;
#pragma unroll
    for (int j = 0; j < 4; ++j) {
        const int col = 4 * F.lane + 256 * j;
        const f32x4 g2 = *(const f32x4*)(mod + (3 + v) * 6144 + 5 * D + col);
        const f32x4 y = ld_y4(Y0 + (size_t)m * D + col) + ld_y4(Y1 + (size_t)m * D + col);
        x[j] = ld_y4(xrow + col) + g2 * y;
    }
}
__device__ __forceinline__ void final_row(const Frame& F, const CAS Args* a, int m, const f32x4 (&x)[4]) {
    float* xrow = F.out + (size_t)m * D; float ss = 0.f;
#pragma unroll
    for (int j = 0; j < 4; ++j) ss += (x[j][0] * x[j][0] + x[j][1] * x[j][1]) + (x[j][2] * x[j][2] + x[j][3] * x[j][3]);
    const float rstd = 1.0f / sqrtf(wave_sum(ss) * (1.0f / D) + EPS);
#pragma unroll
    for (int j = 0; j < 4; ++j) { const int col = 4 * F.lane + 256 * j; const f32x4 nw = *(const f32x4*)(a->in[I_FNORM] + col); *(f32x4*)(xrow + col) = x[j] * rstd * nw; }
}
__device__ __forceinline__ void final_phase(const Frame& F, const CAS Args* a) {
    for (int m = F.gw; m < TL; m += 2 * F.NGW) {
        const int m2 = m + F.NGW; const bool two = m2 < TL;
        f32x4 xa[4], xb[4];
        final_load(F, m, xa);
        if (two) final_load(F, m2, xb);
        final_row(F, a, m, xa);
        if (two) final_row(F, a, m2, xb);
    }
}

#ifndef NPASS
#define NPASS 1
#endif
#ifndef PROBE_PH
#define PROBE_PH -1
#endif
#ifndef PROBE_R
#define PROBE_R 3
#endif
#ifndef PROBE_UPTO
#define PROBE_UPTO -1
#endif
#ifndef PROBE_ABL
#define PROBE_ABL 0
#endif
constexpr int PH_PER_LAYER = 8;
constexpr int N_PHASES = 1 + DEPTH * PH_PER_LAYER + 1;

template <int ph0>
__device__ __forceinline__ void do_phase(Frame& F, XcdBarrier& bar, LAS unsigned char* lds, int lo, int hi) {
    constexpr int ph = ph0 % N_PHASES, pass = ph0 / N_PHASES;
    if (!(lo <= ph && ph < hi)) return;
    if (pass == 1 && (PROBE_UPTO >= 0 ? ph >= PROBE_UPTO : ph != PROBE_PH)) return;
    const CAS Args* ap;
        { int l_; asm volatile("v_mbcnt_lo_u32_b32 %0, -1, 0\n\tv_mbcnt_hi_u32_b32 %0, -1, %0" : "=v"(l_)); F.lane = l_; F.tid = F.wave * 64 + l_; ap = (const CAS Args*)__builtin_amdgcn_kernarg_segment_ptr(); asm volatile("" : "+s"(ap)); F.ws = ap->ws; F.out = (pass == 1) ? (float*)(ap->ws + WS_P) : ap->out; F.xlb = (bf16*)(ap->ws + ((pass == 1) ? WS_P + 64 * MiB : WS_XLB));
          LAS unsigned char* lb_ = (LAS unsigned char*)lds; asm volatile("" : "+s"(lb_)); __builtin_assume((((unsigned)(__UINTPTR_TYPE__)lb_) & 1023u) == 0u); F.lds = lb_;
          bar.bar = (unsigned*)(F.ws + WS_CTL) + CW_BAR; bar.st = (volatile LAS unsigned*)(F.lds + MISC_OFF) + 8; }
        if (ph == 0) { if (PH_ON(10)) REP(10, true) p0_prologue(F, ap); }
        else if (ph == N_PHASES - 1) { if (PH_ON(11)) REP(11, false) final_phase(F, ap); }
        else {
            const int l = (ph - 1) / PH_PER_LAYER, s = (ph - 1) % PH_PER_LAYER;
            unsigned char* ws = F.ws;
            if (s == 0) { if (PH_ON(0)) REP(0, l == 0) n1_phase(F, ap, l); }
            else if (s == 1 && PH_ON(1)) REP(1, true) {
                pg8::DenseOrder S; S.init(ws + WS_H, ws + WS_WIN + (size_t)l * NIN * D, TT, NIN, D / 2, F.G, (int)blockIdx.x);
                EpiIn E{(bf16*)(ws + WS_P), ap->in[I_BIASF] + l * 256, ap->in[I_BIASB] + l * 256, (const float*)(ws + WS_ROPE), (const float*)(ws + WS_ROPE) + 2048, (pass == 1) ? PROBE_ABL : 0};
                pg8::gemm_phase<EpiIn, pg8::DenseOrder, true>(F.lds, F.tid, S, E, SC_W1, SC_ONE, GIN_STAG);
            }
            else if (s == 2) { constexpr int abl = (pass == 1) ? PROBE_ABL : 0; if (PH_ON(2) && abl != 5) REP(2, true) swa_flash(F, ap, l, abl); if (PH_ON(12) && abl != 6) REP(12, true) gla_g1(F, l); }
            else if (s == 3) { if (PH_ON(13)) REP(13, true) gla_scan(F); }
            else if (s == 4) { if (PH_ON(3)) REP(3, true) gla_g3(F, ap, l); }
            else if (s == 5 && PH_ON(4)) REP(4, l == 0) {
                pg8::DenseOrder S; S.init(ws + WS_MIX, ws + WS_WOUT + (size_t)l * D * D, l == 0 ? TT : TL, D, D / 2, F.G, (int)blockIdx.x);
                EpiOut E{ap->in[I_X], l == 0 ? ap->in[I_CTX] : (const float*)(ws + WS_XC), F.xlb, (float*)(ws + WS_XC), (const float*)(ws + WS_MOD) + l * 3 * 6144, l > 0};
                pg8::gemm_phase<EpiOut, pg8::DenseOrder, true>(F.lds, F.tid, S, E, SC_W1, SC_HMID);
                if (l == 0 && pass == 0) convert_moe_filler(F, ap, 0, S.nwg);
            }
            else if (s == 6) { if (PH_ON(5)) REP(5, true) n2_route_phase(F, ap, l, rep_ == 0 || pass == 1, l + 2 * pass); }
            else { if (PH_ON(6)) { moe1_phase(F, ap, l, l + 2 * pass); moe2_phase(F, ap, l, l + 2 * pass); } }
        }
        if (ph0 + 1 < NPASS * N_PHASES) for (int rb_ = 0; rb_ < (REPEAT_S == 20 ? REPEAT_N : 1); ++rb_) xcd_barrier(bar, F.tid);
}
template <int... I>
__device__ __forceinline__ void run_all(Frame& F, XcdBarrier& bar, LAS unsigned char* lds, int lo, int hi, std::integer_sequence<int, I...>) { (do_phase<I>(F, bar, lds, lo, hi), ...); }

#ifdef VGPR_CAP
__attribute__((amdgpu_num_vgpr(VGPR_CAP)))
#endif
__global__ void __launch_bounds__(NWAVES * 64, 2) mk_fwd(Args args) {
    extern __shared__ __attribute__((aligned(16))) unsigned char lds[];
    Frame F;
    F.lds = (LAS unsigned char*)lds;
    F.tid = threadIdx.x; F.lane = F.tid & 63; F.wave = __builtin_amdgcn_readfirstlane(F.tid >> 6);
    F.G = gridDim.x; { const int bx = blockIdx.x; F.vcu = (F.G % 8 == 0) ? (bx % 8) * (F.G / 8) + bx / 8 : bx; }
    F.gw = F.vcu * NWAVES + F.wave; F.NGW = F.G * NWAVES;
    const CAS Args* ap = (const CAS Args*)__builtin_amdgcn_kernarg_segment_ptr();
    F.ws = ap->ws; F.out = ap->out; F.xlb = (bf16*)(ap->ws + WS_XLB);
    volatile LAS unsigned* MISC = (volatile LAS unsigned*)(F.lds + MISC_OFF);
    for (int u = F.tid; u < (LDS_BYTES - LDSCTL_OFF) / 4; u += NWAVES * 64) ((LAS unsigned*)(F.lds + LDSCTL_OFF))[u] = 0u;
    __syncthreads();
    XcdBarrier bar; bar.bar = (unsigned*)(F.ws + WS_CTL) + CW_BAR; bar.x = 0; bar.st = nullptr;
    const bool fused = (ap->ph_hi - ap->ph_lo) > 1;
    if (fused) bar = xcd_barrier_post((unsigned*)(F.ws + WS_CTL) + CW_BAR, MISC + 8);
    const int lo = ap->ph_lo, hi = ap->ph_hi;
    run_all(F, bar, (LAS unsigned char*)lds, lo, hi, std::make_integer_sequence<int, NPASS * N_PHASES>{});
}

extern "C" void kernel_launch(void* const* d_in, const int* in_sizes, int n_in, void* d_out, int out_size, void* d_ws, size_t ws_size, hipStream_t stream) {
    static int grid = 0;
    if (grid == 0) {
        if (n_in != 22 || out_size != TL * D || ws_size < WS_END) { fprintf(stderr, "kernel_launch: unexpected shapes (n_in %d out %d ws %zu)\n", n_in, out_size, ws_size); grid = -1; return; }
        int dev = 0, cus = 0, per_cu = 0;
        if (hipGetDevice(&dev) != hipSuccess || hipDeviceGetAttribute(&cus, hipDeviceAttributeMultiprocessorCount, dev) != hipSuccess) { grid = -1; return; }
        if (hipFuncSetAttribute((const void*)mk_fwd, hipFuncAttributeMaxDynamicSharedMemorySize, LDS_BYTES) != hipSuccess) { fprintf(stderr, "kernel_launch: hipFuncSetAttribute failed\n"); grid = -1; return; }
        if (hipOccupancyMaxActiveBlocksPerMultiprocessor(&per_cu, (const void*)mk_fwd, NWAVES * 64, LDS_BYTES) != hipSuccess || per_cu < 1) fprintf(stderr, "kernel_launch: occupancy query says %d\n", per_cu);
        (void)hipGetLastError();
        grid = cus;
    }
    if (grid < 0) return;
    (void)hipMemsetAsync((char*)d_ws + WS_CTL, 0, CTL_ZERO_BYTES, stream);
    Args a{};
    for (int i = 0; i < 22; ++i) a.in[i] = (const float*)d_in[i];
    a.out = (float*)d_out; a.ws = (unsigned char*)d_ws; a.li = 0; a.pad = 0;
#if MK_N_LAUNCHES == 1
    a.ph_lo = 0; a.ph_hi = N_PHASES;
    hipLaunchKernelGGL(mk_fwd, dim3(grid), dim3(NWAVES * 64), LDS_BYTES, stream, a);
#else
    for (int ph = 0; ph < N_PHASES; ++ph) { a.ph_lo = ph; a.ph_hi = ph + 1; hipLaunchKernelGGL(mk_fwd, dim3(grid), dim3(NWAVES * 64), LDS_BYTES, stream, a); }
#endif
}
```

```cpp
#include <hip/hip_runtime.h>
#include <cstdio>
#include <cstdint>
#include <utility>

#ifndef GIN_STAG
#define GIN_STAG 0
#endif
#ifndef ALIGN_EPI
#define ALIGN_EPI 1
#endif
#ifndef ONLY_S
#define ONLY_S -1
#endif
#define PH_ON(k) (ONLY_S < 0 || ONLY_S == (k))
#ifndef REPEAT_S
#define REPEAT_S -1
#endif
#ifndef REPEAT_N
#define REPEAT_N 4
#endif
#define REP(k, cond) for (int rep_ = 0; rep_ < ((pass == 1) ? PROBE_R : ((REPEAT_S == (k) && (cond)) ? REPEAT_N : 1)); ++rep_)
#ifndef MK_N_LAUNCHES
#define MK_N_LAUNCHES 1
#endif

#define GAS __attribute__((address_space(1)))
#define LAS __attribute__((address_space(3)))
#define CAS __attribute__((address_space(4)))
typedef unsigned short bf16;
typedef short bf16x8 __attribute__((ext_vector_type(8)));
typedef float f32x4 __attribute__((ext_vector_type(4)));
typedef float f32x2 __attribute__((ext_vector_type(2)));
typedef unsigned u32x4 __attribute__((ext_vector_type(4)));
typedef unsigned u32x2 __attribute__((ext_vector_type(2)));
typedef int v8i __attribute__((ext_vector_type(8)));

constexpr int D = 1024, SEQ = 8192, LC = 256, TL = 16384, TC = 512, TT = TL + TC, DEPTH = 2;
constexpr int NE = 16, DE = 512;
constexpr int NIN = 2816;
constexpr int PC_Q = 0, PC_K = 256, PC_V = 512, PC_G = 1024, PC_SQ = 1536, PC_SK = 2048, PC_SV = 2176, PC_GF = 2304, PC_GB = 2560;
constexpr int WIN_COLS = 2336;
constexpr float EPS = 1e-6f;
constexpr float LOG2E = 1.4426950408889634f, QSCALE = 0.125f * LOG2E;
constexpr int LISTCAP = TT;

constexpr size_t MiB = 1u << 20;
constexpr size_t WS_CTL = 0, CTL_ZERO_BYTES = 131072;
constexpr size_t WS_MOD = 1 * MiB;
constexpr size_t WS_ROPE = 1 * MiB + 256 * 1024;
constexpr size_t WS_LIST = 2 * MiB;
constexpr size_t WS_LISTW = 2 * MiB + 1536 * 1024;
constexpr size_t WS_XC = 5 * MiB;
constexpr size_t WS_WIN = 8 * MiB;
constexpr size_t WS_WOUT = 19 * MiB;
constexpr size_t WS_WGU = 23 * MiB;
constexpr size_t WS_WD = 87 * MiB;
constexpr size_t WS_XLB = 55 * MiB;
constexpr size_t WS_H = 119 * MiB;
constexpr size_t WS_P = 152 * MiB;
constexpr size_t WS_MIX = 243 * MiB;
constexpr size_t WS_GL = 276 * MiB;
constexpr size_t WS_HMID = 152 * MiB;
constexpr size_t WS_Y = 190 * MiB;
constexpr size_t WS_END = 309 * MiB;
static_assert(WS_LIST + (size_t)NE * LISTCAP * 4 <= WS_LISTW && WS_LISTW + (size_t)NE * LISTCAP * 4 <= WS_XC, "ws map");
static_assert(WS_P + (size_t)TT * NIN * 2 <= WS_MIX && WS_MIX + (size_t)TT * D * 2 <= WS_GL, "ws map");
static_assert(WS_HMID + (size_t)37888 * 512 * 2 <= WS_Y && WS_Y + (size_t)2 * TT * D * 2 <= WS_GL, "ws map");
constexpr int CW_CNT = 8192, CNT_STRIDE = 64;
constexpr int CW_TDONE = 16384;
constexpr int CW_BAR = 4096;

__device__ __forceinline__ unsigned f2bf(float f) { unsigned u = __builtin_bit_cast(unsigned, f); return (u + 0x7fffu + ((u >> 16) & 1u)) >> 16; }
__device__ __forceinline__ unsigned pk2(float lo, float hi) { return f2bf(lo) | (f2bf(hi) << 16); }
__device__ __forceinline__ float bf2f(unsigned h) { return __builtin_bit_cast(float, h << 16); }
__device__ __forceinline__ float bflo(unsigned w) { return __builtin_bit_cast(float, w << 16); }
__device__ __forceinline__ float bfhi(unsigned w) { return __builtin_bit_cast(float, w & 0xffff0000u); }
__device__ __forceinline__ float dpp_add(float v, float t) { return v + t; }
#define DPP_F(v, ctrl, rmask) __builtin_bit_cast(float, __builtin_amdgcn_update_dpp(0, __builtin_bit_cast(int, (v)), (ctrl), (rmask), 0xF, false))
__device__ __forceinline__ float row16_sum(float v) {
    v += DPP_F(v, 0xB1, 0xF); v += DPP_F(v, 0x4E, 0xF); v += DPP_F(v, 0x141, 0xF); v += DPP_F(v, 0x140, 0xF); return v;
}
__device__ __forceinline__ float wave_sum(float v) {
    v = row16_sum(v);
    v += DPP_F(v, 0x142, 0xA); v += DPP_F(v, 0x143, 0xC);
    return __builtin_bit_cast(float, __builtin_amdgcn_readlane(__builtin_bit_cast(int, v), 63));
}
__device__ __forceinline__ float silu_f(float x) { return x / (1.0f + __expf(-x)); }
__device__ __forceinline__ unsigned pk4_fp8(float a, float b, float c, float d) {
    a = fminf(fmaxf(a, -448.f), 448.f); b = fminf(fmaxf(b, -448.f), 448.f); c = fminf(fmaxf(c, -448.f), 448.f); d = fminf(fmaxf(d, -448.f), 448.f);
    int w = __builtin_amdgcn_cvt_pk_fp8_f32(a, b, 0, false); w = __builtin_amdgcn_cvt_pk_fp8_f32(c, d, w, true); return (unsigned)w;
}
constexpr float W1_SCALE = 64.f, W2_SCALE = 32.f, HMID_SCALE = 4.f, MIX_SCALE = 4.f;
constexpr int SC_ONE = 127, SC_W1 = 121, SC_W2 = 122, SC_HMID = 125;
#define LDS_BARRIER() asm volatile("s_waitcnt lgkmcnt(0)\n\ts_barrier" ::: "memory")
#define LDS_WAIT() asm volatile("s_waitcnt lgkmcnt(0)" ::: "memory")
#define VM_WAIT() asm volatile("s_waitcnt vmcnt(0)" ::: "memory")

namespace pg8 {
constexpr int BM = 256, BK = 64, HALF = 128, HTB = HALF * BK * 2, STAGE_BYTES = 8 * HTB, NXCD = 8, WGM = 8;
__host__ __device__ __forceinline__ int lds_byte(int r, int c) { const int st = (r >> 4) * 2 + (c >> 5), rr = r & 15, cc = c & 31, ob = rr * 64 + cc * 2; return st * 1024 + (ob ^ (((ob >> 9) & 1) << 5)); }
__host__ __device__ __forceinline__ void stage_rc(int b, int& R, int& C) { const int st = b / 1024, sb = b % 1024, swz = sb ^ (((sb >> 9) & 1) << 5); R = (st >> 1) * 16 + swz / 64; C = (st & 1) * 32 + (swz % 64) / 2; }
__host__ __device__ __forceinline__ int perm32(int rho) { const int n = rho >> 4, i = rho & 15; return 8 * (i >> 2) + 4 * n + (i & 3); }

struct Unit { int pm, pn, e, mt; };

__device__ __forceinline__ int xcd_remap(int wgid, int nwg) { const int q = nwg / NXCD, r = nwg % NXCD, xcd = wgid % NXCD, off = wgid / NXCD; return (xcd < r ? xcd * (q + 1) : r * (q + 1) + (xcd - r) * q) + off; }

struct DenseOrder {
    static constexpr bool DYN_A = false;
    const char* A; const char* Bt; int K; int nM, nN, nwg, G, c;
    __device__ void init(const void* A_, const void* Bt_, int M, int N, int K_, int G_, int c_) { A = (const char*)A_; Bt = (const char*)Bt_; K = K_; nM = M / BM; nN = N / BM; nwg = nM * nN; G = G_; c = c_; }
    __device__ __forceinline__ bool next(int i, Unit& u) const {
        const long L = (long)i * G + c; if (L >= nwg) return false;
        const int wgid = xcd_remap((int)L, nwg);
        const int nig = WGM * nN, gid = wgid / nig, fm = gid * WGM, gsz = (nM - fm) < WGM ? (nM - fm) : WGM;
        u.pm = fm + ((wgid % nig) % gsz); u.pn = (wgid % nig) / gsz; u.e = 0; u.mt = 0; return true;
    }
    __device__ __forceinline__ void a_ready(const Unit&, int) const {}
    __device__ __forceinline__ void done(const Unit&, int) const {}
    __device__ __forceinline__ const char* a_ptr(const Unit& u) const { return A + (size_t)u.pm * (size_t)(BM * K * 2); }
    __device__ __forceinline__ const char* b_ptr(const Unit& u) const { return Bt + (size_t)u.pn * (size_t)(BM * K * 2); }
    __device__ __forceinline__ void a_voff(const Unit&, const int (&R)[2], const int (&C)[2], unsigned (&v0)[2], unsigned (&v1)[2]) const {
#pragma unroll
        for (int i = 0; i < 2; ++i) { v0[i] = (unsigned)(R[i] * K + C[i]) * 2u; v1[i] = v0[i] + (unsigned)(HALF * K * 2); }
    }
};

struct MoeOrder {
    static constexpr bool DYN_A = true;
    const char* A; const char* Bt; int K; size_t bstride_e; int G, c, nunits, nN; bool gather;
    const unsigned* list; const LAS int* tab;
    unsigned* tdone; int role;
    __device__ __forceinline__ void a_ready(const Unit& u, int wid) const {
        if (role == 2) {
            if (wid == 0) { unsigned sp = 0;
                while (__hip_atomic_load(tdone + u.pm * 16, __ATOMIC_RELAXED, __HIP_MEMORY_SCOPE_AGENT) < 32u) { __builtin_amdgcn_s_sleep(2); if (++sp > (1u << 22)) break; }
                __builtin_amdgcn_fence(__ATOMIC_ACQUIRE, "agent"); asm volatile("s_waitcnt vmcnt(0)" ::: "memory"); }
            __builtin_amdgcn_s_barrier();
        }
    }
    __device__ __forceinline__ void done(const Unit& u, int lane) const {
        if (role == 1) { asm volatile("s_waitcnt vmcnt(0)" ::: "memory");
            if (lane == 0) __hip_atomic_fetch_add(tdone + u.pm * 16, 1u, __ATOMIC_RELAXED, __HIP_MEMORY_SCOPE_AGENT); }
    }
    __device__ __forceinline__ bool next(int i, Unit& u) const {
        const long L = (long)i * G + c; if (L >= nunits) return false;
        const int wgid = xcd_remap((int)L, nunits);
        const int tl = wgid / nN; u.pn = wgid % nN;
        int e = 0, tstart = 0;
#pragma unroll 1
        for (int k = 0; k < NE - 1; ++k) { const int te = tab[16 + k]; if (tl >= te) { e = k + 1; tstart = te; } }
        u.e = __builtin_amdgcn_readfirstlane(e); u.mt = __builtin_amdgcn_readfirstlane(tl - tstart); u.pm = tl; return true;
    }
    __device__ __forceinline__ const char* a_ptr(const Unit& u) const { return gather ? A : A + (size_t)u.pm * (size_t)(BM * K * 2); }
    __device__ __forceinline__ const char* b_ptr(const Unit& u) const { return Bt + (size_t)u.e * bstride_e + (size_t)u.pn * (size_t)(BM * K * 2); }
    __device__ __forceinline__ void a_voff(const Unit& u, const int (&R)[2], const int (&C)[2], unsigned (&v0)[2], unsigned (&v1)[2]) const {
        if (gather) {
            const int ce = tab[u.e];
            const unsigned* lp = list + (size_t)u.e * LISTCAP + u.mt * BM;
#pragma unroll
            for (int i = 0; i < 2; ++i) {
                const int r0 = R[i], r1 = R[i] + HALF;
                const unsigned t0 = (u.mt * BM + r0 < ce) ? (__builtin_nontemporal_load(lp + r0) >> 1) : 0u;
                const unsigned t1 = (u.mt * BM + r1 < ce) ? (__builtin_nontemporal_load(lp + r1) >> 1) : 0u;
                v0[i] = (t0 * (unsigned)K + (unsigned)C[i]) * 2u; v1[i] = (t1 * (unsigned)K + (unsigned)C[i]) * 2u;
            }
        } else {
#pragma unroll
            for (int i = 0; i < 2; ++i) { v0[i] = (unsigned)(R[i] * K + C[i]) * 2u; v1[i] = v0[i] + (unsigned)(HALF * K * 2); }
        }
    }
};

__device__ __forceinline__ unsigned cvt_pk_bf16(float lo, float hi) { unsigned r; asm volatile("v_cvt_pk_bf16_f32 %0, %1, %2" : "=v"(r) : "v"(lo), "v"(hi)); return r; }

template <class Epi, class Sched, bool F8 = false>
__device__ __forceinline__ void gemm_phase(LAS unsigned char* lds, int tid, const Sched& S, const Epi& E, int sc_w = 127, int sc_a = 127, int stag = 0) {
    if (stag) {
        const unsigned long long t0 = __builtin_amdgcn_s_memrealtime(), dl = (unsigned long long)((blockIdx.x >> 3) & 3) * (unsigned)stag;
        while (__builtin_amdgcn_s_memrealtime() - t0 < dl) __builtin_amdgcn_s_sleep(8);
    }
    const int wid = __builtin_amdgcn_readfirstlane(tid >> 6), lane = tid & 63, wr = wid >> 2, wc = wid & 3, fr = lane & 15, fq = lane >> 4;
    const int K = S.K, nt = K / BK;
    int Rr[2], Cc[2]; unsigned voffB[2];
#pragma unroll
    for (int i = 0; i < 2; ++i) { int R, C; stage_rc(tid * 16 + i * 8192, R, C); const int Rb = Epi::PERM ? ((R & ~31) + perm32(R & 31)) : R;
        Rr[i] = R; Cc[i] = C; voffB[i] = (unsigned)(Rb * K + C) * 2u; }
    const size_t kstep = (size_t)(BK * 2);
    const size_t hstep = (size_t)HALF * K * 2;
    const unsigned ldsw = (unsigned)wid * 1024u;
    const int aoff = lds_byte(wr * 64 + fr, fq * 8), boff = lds_byte(wc * 32 + fr, fq * 8);
#define PG8_SA(b, h) (((b) * 2 + (h)) * HTB)
#define PG8_SB(b, h) ((4 + (b) * 2 + (h)) * HTB)
#define PG8_STAGE(bufoff, gbase, voff) do { _Pragma("unroll") for (int _i = 0; _i < 2; ++_i) \
        __builtin_amdgcn_global_load_lds((const unsigned*)((const char*)(gbase) + (voff)[_i]), (LAS unsigned*)(lds + (bufoff) + ldsw + _i * 8192), 16, 0, 0); } while (0)
#define PG8_CAT(lo_, hi_) ((v8i){(int)(lo_).x, (int)(lo_).y, (int)(lo_).z, (int)(lo_).w, (int)(hi_).x, (int)(hi_).y, (int)(hi_).z, (int)(hi_).w})
#define PG8_LDA(dst, b, h) do { _Pragma("unroll") for (int m = 0; m < 4; ++m) { if constexpr (F8) { const u32x4 l_ = *(const LAS u32x4*)(lds + PG8_SA(b, h) + aoff + m * 2048), h_ = *(const LAS u32x4*)(lds + PG8_SA(b, h) + aoff + m * 2048 + 1024); dst##8[m] = PG8_CAT(l_, h_); } \
        else { _Pragma("unroll") for (int k = 0; k < 2; ++k) dst[m][k] = *(const LAS bf16x8*)(lds + PG8_SA(b, h) + aoff + m * 2048 + k * 1024); } } } while (0)
#define PG8_LDB(dst, b, h) do { _Pragma("unroll") for (int n = 0; n < 2; ++n) { if constexpr (F8) { const u32x4 l_ = *(const LAS u32x4*)(lds + PG8_SB(b, h) + boff + n * 2048), h_ = *(const LAS u32x4*)(lds + PG8_SB(b, h) + boff + n * 2048 + 1024); dst##8[n] = PG8_CAT(l_, h_); } \
        else { _Pragma("unroll") for (int k = 0; k < 2; ++k) dst[n][k] = *(const LAS bf16x8*)(lds + PG8_SB(b, h) + boff + n * 2048 + k * 1024); } } } while (0)
#define PG8_MMA(ai, bj, At, Bt) do { __builtin_amdgcn_s_setprio(1); _Pragma("unroll") for (int m = 0; m < 4; ++m) _Pragma("unroll") for (int n = 0; n < 2; ++n) { \
        if constexpr (F8) asm volatile("v_mfma_scale_f32_16x16x128_f8f6f4 %0, %1, %2, %0, %3, %4 op_sel_hi:[0,0,0]" : "+v"(acc[ai][bj][m][n]) : "v"(Bt##8[n]), "v"(At##8[m]), "v"(sc_w), "v"(sc_a)); \
        else { _Pragma("unroll") for (int k = 0; k < 2; ++k) acc[ai][bj][m][n] = __builtin_amdgcn_mfma_f32_16x16x32_bf16(Bt[n][k], At[m][k], acc[ai][bj][m][n], 0, 0, 0); } } \
        __builtin_amdgcn_s_setprio(0); } while (0)
#define PG8_WAIT_V(n) asm volatile("s_waitcnt vmcnt(" #n ")" ::: "memory")
#define PG8_WAIT_L(n) asm volatile("s_waitcnt lgkmcnt(" #n ")" ::: "memory")
#define PG8_BAR __builtin_amdgcn_s_barrier()
#define PG8_SCHED __builtin_amdgcn_sched_barrier(0)
    Unit cur, nxt; int ui = 0;
    if (!S.next(0, cur)) return;
    f32x4 acc[2][2][4][2];
#pragma unroll
    for (int a = 0; a < 2; ++a)
#pragma unroll
        for (int b = 0; b < 2; ++b)
#pragma unroll
            for (int m = 0; m < 4; ++m)
#pragma unroll
                for (int n = 0; n < 2; ++n) acc[a][b][m][n] = (f32x4){0.f, 0.f, 0.f, 0.f};
    bf16x8 At[4][2], B0[2][2], B1[2][2]; v8i At8[4], B08[2], B18[2];
    const char* cA = S.a_ptr(cur); const char* cB = S.b_ptr(cur);
    unsigned cv0[2], cv1[2], nv0[2], nv1[2];
    S.a_ready(cur, wid);
    S.a_voff(cur, Rr, Cc, cv0, cv1);
    PG8_STAGE(PG8_SB(0, 0), cB, voffB); PG8_STAGE(PG8_SB(0, 1), cB + hstep, voffB); PG8_STAGE(PG8_SA(0, 0), cA, cv0); PG8_STAGE(PG8_SA(0, 1), cA, cv1);
    if (wr == 1) PG8_BAR;
    PG8_WAIT_V(2); PG8_BAR;
    PG8_STAGE(PG8_SB(1, 0), cB + kstep, voffB); PG8_STAGE(PG8_SA(1, 0), cA + kstep, cv0); PG8_STAGE(PG8_SB(1, 1), cB + hstep + kstep, voffB);
    PG8_WAIT_V(6); PG8_BAR;
    for (;;) {
        const bool has_next = S.next(ui + 1, nxt);
        const char* nA = has_next ? S.a_ptr(nxt) : cA; const char* nB = has_next ? S.b_ptr(nxt) : cB;
        if (has_next) S.a_voff(nxt, Rr, Cc, nv0, nv1); else { nv0[0] = cv0[0]; nv0[1] = cv0[1]; nv1[0] = cv1[0]; nv1[1] = cv1[1]; }
        if constexpr (Sched::DYN_A) asm volatile("" : "+v"(nv0[0]), "+v"(nv0[1]), "+v"(nv1[0]), "+v"(nv1[1]));
        for (int t = 0; t < nt; t += 2) {
            const bool last = (t == nt - 2);
            if (last && has_next) S.a_ready(nxt, wid);
            const char* a1 = cA + (size_t)(t + 1) * kstep;
            const char* a2 = last ? nA : cA + (size_t)(t + 2) * kstep; const char* b2 = last ? nB : cB + (size_t)(t + 2) * kstep;
            const char* a3 = a2 + kstep; const char* b3 = b2 + kstep;
            unsigned w0[2], w1[2];
            w0[0] = last ? nv0[0] : cv0[0]; w0[1] = last ? nv0[1] : cv0[1]; w1[0] = last ? nv1[0] : cv1[0]; w1[1] = last ? nv1[1] : cv1[1];
            PG8_LDB(B0, 0, 0); PG8_LDB(B1, 0, 1); PG8_SCHED; PG8_LDA(At, 0, 0); PG8_STAGE(PG8_SA(1, 1), a1, cv1);
            PG8_WAIT_V(8); PG8_WAIT_L(0); PG8_BAR; PG8_MMA(0, 0, At, B0); PG8_MMA(0, 1, At, B1); PG8_BAR; PG8_SCHED;
            PG8_LDA(At, 0, 1); PG8_STAGE(PG8_SB(0, 0), b2, voffB); PG8_STAGE(PG8_SB(0, 1), b2 + hstep, voffB); PG8_STAGE(PG8_SA(0, 0), a2, w0);
            PG8_WAIT_V(8); PG8_WAIT_L(0); PG8_BAR; PG8_MMA(1, 0, At, B0); PG8_MMA(1, 1, At, B1); PG8_BAR; PG8_SCHED;
            PG8_LDB(B0, 1, 0); PG8_LDB(B1, 1, 1); PG8_SCHED; PG8_LDA(At, 1, 0); PG8_STAGE(PG8_SA(0, 1), a2, w1);
            PG8_WAIT_V(8); PG8_WAIT_L(0); PG8_BAR; PG8_MMA(0, 0, At, B0); PG8_MMA(0, 1, At, B1); PG8_BAR; PG8_SCHED;
            PG8_LDA(At, 1, 1); PG8_STAGE(PG8_SB(1, 0), b3, voffB); PG8_STAGE(PG8_SB(1, 1), b3 + hstep, voffB); PG8_STAGE(PG8_SA(1, 0), a3, w0);
            PG8_WAIT_V(8); PG8_WAIT_L(0); PG8_BAR; PG8_MMA(1, 0, At, B0); PG8_MMA(1, 1, At, B1); PG8_BAR; PG8_SCHED;
        }
        if constexpr (F8) asm volatile("s_nop 15\n\ts_nop 15" ::: "memory");
        if (ALIGN_EPI) { if (wr == 0) PG8_BAR; }
        E(acc, cur, wr, wc, fr, fq);
        S.done(cur, lane);
        if (!has_next) break;
#pragma unroll
        for (int a = 0; a < 2; ++a)
#pragma unroll
            for (int b = 0; b < 2; ++b)
#pragma unroll
                for (int m = 0; m < 4; ++m)
#pragma unroll
                    for (int n = 0; n < 2; ++n) acc[a][b][m][n] = (f32x4){0.f, 0.f, 0.f, 0.f};
        cur = nxt; cA = nA; cB = nB; ++ui;
        cv0[0] = nv0[0]; cv0[1] = nv0[1]; cv1[0] = nv1[0]; cv1[1] = nv1[1];
        if (ALIGN_EPI) { if (wr == 1) PG8_BAR; }
    }
    PG8_WAIT_V(0);
    if (!ALIGN_EPI) { if (wr == 0) PG8_BAR; }
    PG8_BAR;
#undef PG8_SA
#undef PG8_SB
#undef PG8_STAGE
#undef PG8_CAT
#undef PG8_LDA
#undef PG8_LDB
#undef PG8_MMA
#undef PG8_WAIT_V
#undef PG8_WAIT_L
#undef PG8_BAR
#undef PG8_SCHED
}
}

#define XB_TMO      128
#define XB_XCNT(j)  (256  + 64 * (j))
#define XB_XSUB(j)  (1280 + 64 * (j))
#define XB_XGEN(j)  (2304 + 64 * (j))
#define XB_TOP      3328
#define XB_TOPGEN   3392
#define XCD_BAR_WORDS 3456
#define XB_SPIN_CAP (1u << 18)
__device__ __forceinline__ unsigned xb_ld(unsigned* p)              { return __hip_atomic_load(p, __ATOMIC_RELAXED, __HIP_MEMORY_SCOPE_AGENT); }
__device__ __forceinline__ unsigned xb_add(unsigned* p, unsigned v) { return __hip_atomic_fetch_add(p, v, __ATOMIC_RELAXED, __HIP_MEMORY_SCOPE_AGENT); }
__device__ __forceinline__ unsigned xb_xcc_id() { return (unsigned)__builtin_amdgcn_s_getreg((3 << 11) | 20) & 0xFu; }
#define XB_SPIN(cond, bar) do { unsigned _sp = 0; while (cond) { __builtin_amdgcn_s_sleep(1); \
    if ((++_sp & 255u) == 0u) { if (xb_ld(&(bar)[XB_TMO])) break; if (_sp > XB_SPIN_CAP) { atomicAdd(&(bar)[XB_TMO], 1u); break; } } } } while (0)
struct XcdBarrier { unsigned* bar; unsigned x; volatile LAS unsigned* st; };
__device__ __forceinline__ XcdBarrier xcd_barrier_post(unsigned* bar, volatile LAS unsigned* st) {
    XcdBarrier b; b.bar = bar; b.x = xb_xcc_id(); b.st = st;
    if (threadIdx.x == 0) (void)xb_add(&bar[XB_XCNT(b.x)], 1u);
    return b;
}
__device__ __forceinline__ void xcd_barrier_complete(unsigned* bar, unsigned x, unsigned& nloc, unsigned& nx) {
    const unsigned G = gridDim.x * gridDim.y * gridDim.z;
    unsigned sum, cnt, mine, sp = 0u;
    for (;;) {
        sum = 0u; cnt = 0u; mine = 0u;
#pragma unroll
        for (unsigned j = 0; j < 16; ++j) { const unsigned c = xb_ld(&bar[XB_XCNT(j)]); sum += c; cnt += (c > 0u) ? 1u : 0u; mine = (j == x) ? c : mine; }
        if (sum == G) break;
        __builtin_amdgcn_s_sleep(1);
        if ((++sp & 255u) == 0u) { if (xb_ld(&bar[XB_TMO])) break; if (sp > XB_SPIN_CAP) { atomicAdd(&bar[XB_TMO], 1u); break; } }
    }
    nloc = mine > 0u ? mine : 1u; nx = cnt > 0u ? cnt : 1u;
}
__device__ __forceinline__ void xcd_barrier(const XcdBarrier& b, int tid) {
    asm volatile("s_waitcnt vmcnt(0)" ::: "memory");
    __syncthreads();
    if (tid == 0) {
        unsigned* bar = b.bar;
        __builtin_amdgcn_s_waitcnt(0);
        unsigned nloc = b.st[0], nx = b.st[1];
        if (nloc == 0u) { xcd_barrier_complete(bar, b.x, nloc, nx); b.st[0] = nloc; b.st[1] = nx; }
        const unsigned old = xb_add(&bar[XB_XSUB(b.x)], 1u);
        const unsigned gen = old / nloc;
        if (old + 1u == (gen + 1u) * nloc) {
            __builtin_amdgcn_fence(__ATOMIC_RELEASE, "agent");
            asm volatile("s_waitcnt vmcnt(0)" ::: "memory");
            const unsigned og = xb_add(&bar[XB_TOP], 1u);
            const unsigned tg = og / nx;
            if (og + 1u == (tg + 1u) * nx) xb_add(&bar[XB_TOPGEN], 1u);
            else XB_SPIN(xb_ld(&bar[XB_TOPGEN]) == tg, bar);
            __builtin_amdgcn_fence(__ATOMIC_ACQUIRE, "agent");
            xb_add(&bar[XB_XGEN(b.x)], 1u);
            asm volatile("s_waitcnt vmcnt(0)" ::: "memory");
        } else {
            XB_SPIN(xb_ld(&bar[XB_XGEN(b.x)]) == gen, bar);
            __builtin_amdgcn_fence(__ATOMIC_ACQUIRE, "agent");
            asm volatile("s_waitcnt vmcnt(0)" ::: "memory");
        }
    }
    __syncthreads();
}

constexpr int NWAVES = 8;
constexpr int RING_BYTES = 131072, LDSCTL_OFF = RING_BYTES, MISC_OFF = LDSCTL_OFF + 320, LDS_BYTES = 147456;
struct Args { const float* in[22]; float* out; unsigned char* ws; int ph_lo, ph_hi, li, pad; };
enum { I_X = 0, I_C, I_CTX, I_CCTX, I_WADA, I_BADA, I_NORM1, I_NORM2, I_WIN, I_UPF, I_BIASF, I_UPB, I_BIASB, I_GLANORM, I_SINK, I_WOUT, I_WROUTER, I_BROUTER, I_WGATE, I_WUP, I_WDOWN, I_FNORM };

struct Frame {
    LAS unsigned char* lds; int tid, lane, wave, vcu, G, gw, NGW;
    unsigned char* ws; float* out; bf16* xlb;
};

__device__ __forceinline__ int rope_pos(int d) { return 8 * ((d & 15) >> 2) + 4 * (d >> 4) + (d & 3); }
__device__ __forceinline__ int gu_row(int h, int gu) { return (h >> 7) * 256 + ((h >> 6) & 1) * 128 + ((h >> 4) & 3) * 32 + ((h >> 2) & 3) * 8 + gu * 4 + (h & 3); }
struct TItem { const float* src; bf16* dst; int N, Kd, n0, rbase, mode; bool ok; float f8scale; };
__device__ __forceinline__ void titem_load(const TItem& t, int lane, f32x4 (&v)[8]) {
    const int g = lane >> 3, i8 = lane & 7;
    const float* src = t.src + (size_t)(8 * g) * t.N + 4 * i8;
#pragma unroll
    for (int q = 0; q < 8; ++q) v[q] = *(const f32x4*)(src + (size_t)q * t.N);
}
__device__ __forceinline__ void titem_store(const TItem& t, int lane, const f32x4 (&v)[8]) {
    const int g = lane >> 3, i8 = lane & 7;
#pragma unroll
    for (int i = 0; i < 4; ++i) {
        const int n = 4 * i8 + i;
        const int row = (t.mode == 0) ? t.rbase + n : (t.mode == 1) ? t.rbase + rope_pos(n) : gu_row(t.n0 + n, t.mode - 2);
        if (t.f8scale != 0.f) {
            const float sc = t.f8scale; u32x2 o; o.x = pk4_fp8(v[0][i] * sc, v[1][i] * sc, v[2][i] * sc, v[3][i] * sc); o.y = pk4_fp8(v[4][i] * sc, v[5][i] * sc, v[6][i] * sc, v[7][i] * sc);
            *(u32x2*)((unsigned char*)t.dst + (size_t)row * t.Kd + 8 * g) = o;
        } else {
            u32x4 o; o.x = pk2(v[0][i], v[1][i]); o.y = pk2(v[2][i], v[3][i]); o.z = pk2(v[4][i], v[5][i]); o.w = pk2(v[6][i], v[7][i]);
            *(u32x4*)(t.dst + (size_t)row * t.Kd + 8 * g) = o;
        }
    }
}
constexpr int IT_IN = 2 * 16 * 73, IT_OUT = 2 * 16 * 32, IT_G = 32 * 16 * 16, IT_D = 32 * 8 * 32, NITEMS = IT_IN + IT_OUT + 2 * IT_G + IT_D;
__device__ __forceinline__ TItem titem_decode(const CAS Args* a, unsigned char* ws, int it) {
    TItem t; t.ok = it < NITEMS; t.mode = 0; t.rbase = 0; t.n0 = 0; t.N = D; t.Kd = D; t.src = nullptr; t.dst = nullptr; t.f8scale = 0.f;
    if (!t.ok) return t;
    int r = it;
    if (r < IT_IN) {
        const int l = r / 1168, rr = r % 1168, kb = rr / 73, nb = rr % 73;
        if (nb == 48) { t.ok = false; return t; }
        const int n0 = nb * 32; t.n0 = n0;
        if (n0 < 1536) t.rbase = n0;
        else if (n0 < 2080) { t.rbase = PC_SQ + (n0 - 1568); t.mode = 1; }
        else if (n0 < 2208) { t.rbase = PC_SK + (n0 - 2080); t.mode = 1; }
        else t.rbase = PC_SV + (n0 - 2208);
        t.N = WIN_COLS; t.Kd = D; t.src = a->in[I_WIN] + (size_t)l * D * WIN_COLS + (size_t)(kb * 64) * WIN_COLS + n0; t.dst = (bf16*)(ws + WS_WIN + (size_t)l * NIN * D + kb * 64); t.f8scale = W1_SCALE;
        return t;
    }
    r -= IT_IN;
    if (r < IT_OUT) { const int l = r / 512, rr = r % 512, kb = rr / 32, nb = rr % 32;
        t.n0 = nb * 32; t.rbase = nb * 32; t.N = D; t.Kd = D; t.src = a->in[I_WOUT] + (size_t)l * D * D + (size_t)(kb * 64) * D + nb * 32; t.dst = (bf16*)(ws + WS_WOUT + (size_t)l * D * D + kb * 64); t.f8scale = W1_SCALE; return t; }
    r -= IT_OUT;
    if (r < 2 * IT_G) { const int gu = r / IT_G, r2 = r % IT_G, le = r2 / 256, rr = r2 % 256, kb = rr / 16, nb = rr % 16;
        t.n0 = nb * 32; t.mode = 2 + gu; t.N = DE; t.Kd = D; t.src = a->in[gu ? I_WUP : I_WGATE] + (size_t)le * D * DE + (size_t)(kb * 64) * DE + nb * 32; t.dst = (bf16*)(ws + WS_WGU + (size_t)le * D * D + kb * 64); t.f8scale = W1_SCALE; return t; }
    r -= 2 * IT_G;
    { const int le = r / 256, rr = r % 256, kb = rr / 32, nb = rr % 32;
        t.n0 = nb * 32; t.rbase = nb * 32; t.N = D; t.Kd = DE; t.src = a->in[I_WDOWN] + (size_t)le * DE * D + (size_t)(kb * 64) * D + nb * 32; t.dst = (bf16*)(ws + WS_WD + (size_t)le * D * DE + kb * 64); t.f8scale = W2_SCALE; }
    return t;
}

template <class Map>
__device__ __forceinline__ void convert_items(const Frame& F, const CAS Args* a, int n, int worker, int nworkers, Map map) {
    unsigned char* ws = F.ws;
    for (int i = worker; i < n; i += 2 * nworkers) {
        const int i2 = i + nworkers;
        const TItem ta = titem_decode(a, ws, map(i)), tb = titem_decode(a, ws, i2 < n ? map(i2) : NITEMS);
        f32x4 va[8], vb[8];
        if (ta.ok) titem_load(ta, F.lane, va);
        if (tb.ok) titem_load(tb, F.lane, vb);
        if (ta.ok) titem_store(ta, F.lane, va);
        if (tb.ok) titem_store(tb, F.lane, vb);
    }
}
struct MapSmall { __device__ __forceinline__ int operator()(int i) const { return i; } };
struct MapMoe { int l; __device__ __forceinline__ int operator()(int i) const { const int kind = i >> 12, r = i & 4095; return IT_IN + IT_OUT + (kind < 2 ? kind * IT_G : 2 * IT_G) + l * 4096 + r; } };
__device__ __forceinline__ void convert_moe_filler(const Frame& F, const CAS Args* a, int l, int nunits, bool both = false) {
    const int c = (int)blockIdx.x, nfull = nunits % F.G;
    int first = nfull, nf = F.G - nfull - (both ? nfull : 0);
    if (nfull == 0 || nf <= 0) { first = 0; nf = F.G; }
    if (c < first || c >= first + nf) return;
    convert_items(F, a, 3 * 4096, (c - first) * NWAVES + F.wave, nf * NWAVES, MapMoe{l});
}

__device__ __forceinline__ void p0_convert(const Frame& F, const CAS Args* a) {
    unsigned char* ws = F.ws;
    convert_items(F, a, IT_IN + IT_OUT, F.gw, F.NGW, MapSmall{});
    for (int idx = F.gw * 64 + F.lane; idx < 2 * 2 * 256 * 128; idx += F.NGW * 64) {
        const int kc = idx & 127, n = (idx >> 7) & 255, dir = (idx >> 15) & 1, l = idx >> 16;
        const float* up = a->in[dir ? I_UPB : I_UPF] + (size_t)l * 16 * 256 + n;
        float u[16];
#pragma unroll
        for (int r = 0; r < 16; ++r) u[r] = up[r * 256];
        float o[8];
#pragma unroll
        for (int kk = 0; kk < 8; ++kk) {
            const f32x4* wz = (const f32x4*)(a->in[I_WIN] + ((size_t)l * D + kc * 8 + kk) * WIN_COLS + 1536 + dir * 16);
            float s = 0.f;
#pragma unroll
            for (int q = 0; q < 4; ++q) { const f32x4 w = wz[q]; s += w[0] * u[4 * q] + w[1] * u[4 * q + 1] + w[2] * u[4 * q + 2] + w[3] * u[4 * q + 3]; }
            o[kk] = s;
        }
        u32x2 ov; ov.x = pk4_fp8(o[0] * W1_SCALE, o[1] * W1_SCALE, o[2] * W1_SCALE, o[3] * W1_SCALE); ov.y = pk4_fp8(o[4] * W1_SCALE, o[5] * W1_SCALE, o[6] * W1_SCALE, o[7] * W1_SCALE);
        *(u32x2*)(ws + WS_WIN + ((size_t)l * NIN + PC_GF + dir * 256 + n) * D + kc * 8) = ov;
    }
}
__device__ __forceinline__ void p0_prologue(const Frame& F, const CAS Args* a) {
    unsigned char* ws = F.ws;
    if (blockIdx.x == (unsigned)(F.G - 1)) {
        float* tc = (float*)(ws + WS_ROPE); float* tsn = tc + 2048;
        for (int i = F.tid; i < 2048; i += NWAVES * 64) { const int pos = i >> 4, j = i & 15; const float inv = powf(10000.0f, -(float)j * (1.0f / 16.0f)); const float ang = (float)pos * inv;
            tc[i] = cosf(ang); tsn[i] = sinf(ang); }
    }
    __syncthreads();
    {
        LAS float* cs = (LAS float*)F.lds; LAS float* red = cs + 3072;
        for (int i = F.tid; i < 3072; i += NWAVES * 64) { const int v = i >> 10, k = i & 1023; const float cv = v < 2 ? a->in[I_C][v * D + k] : a->in[I_CCTX][k]; cs[i] = cv / (1.0f + expf(-cv)); }
        __syncthreads();
        for (int u = blockIdx.x; u < 192; u += F.G) {
            const int l = u / 96, jg = u % 96, jl = F.tid & 63, ks = F.tid >> 6;
            const float* wp = a->in[I_WADA] + ((size_t)l * D + ks * 128) * 6144 + jg * 64 + jl;
            float a0 = 0.f, a1 = 0.f, a2 = 0.f;
#pragma unroll 1
            for (int k0 = 0; k0 < 128; k0 += 32) {
                float wv[32];
#pragma unroll
                for (int k = 0; k < 32; ++k) wv[k] = wp[(size_t)(k0 + k) * 6144];
#pragma unroll
                for (int k = 0; k < 32; ++k) { const int kk = ks * 128 + k0 + k; a0 += cs[kk] * wv[k]; a1 += cs[1024 + kk] * wv[k]; a2 += cs[2048 + kk] * wv[k]; }
            }
            red[(ks * 3 + 0) * 64 + jl] = a0; red[(ks * 3 + 1) * 64 + jl] = a1; red[(ks * 3 + 2) * 64 + jl] = a2;
            __syncthreads();
            if (F.tid < 192) { const int v = F.tid >> 6, j2 = F.tid & 63; float s = 0.f;
#pragma unroll
                for (int q = 0; q < 8; ++q) s += red[(q * 3 + v) * 64 + j2];
                ((float*)(ws + WS_MOD))[(l * 3 + v) * 6144 + jg * 64 + j2] = s + a->in[I_BADA][l * 6144 + jg * 64 + j2]; }
            __syncthreads();
        }
    }
}

__device__ __forceinline__ f32x4 ld_y4(const bf16* p) { const u32x2 w = *(const u32x2*)p; return (f32x4){bflo(w.x), bfhi(w.x), bflo(w.y), bfhi(w.y)}; }
__device__ __forceinline__ void n1_load(const Frame& F, const CAS Args* a, int l, int m, f32x4 (&x)[4], f32x4 (&y)[4]) {
    unsigned char* ws = F.ws;
    const bf16* Y0 = (const bf16*)(ws + WS_Y); const bf16* Y1 = Y0 + (size_t)TT * D;
    const float* src = (l == 0) ? (m < TL ? a->in[I_X] + (size_t)m * D : a->in[I_CTX] + (size_t)(m - TL) * D) : (const float*)(ws + WS_XC) + (size_t)(m - TL) * D;
    const bool from_b = (l > 0) && (m < TL);
#pragma unroll
    for (int j = 0; j < 4; ++j) { const int col = 4 * F.lane + 256 * j; x[j] = from_b ? ld_y4(F.xlb + (size_t)m * D + col) : *(const f32x4*)(src + col);
        if (l > 0) y[j] = ld_y4(Y0 + (size_t)m * D + col) + ld_y4(Y1 + (size_t)m * D + col); }
}
__device__ __forceinline__ void n1_row(const Frame& F, const CAS Args* a, int l, int m, f32x4 (&x)[4], const f32x4 (&y)[4]) {
    unsigned char* ws = F.ws;
    const float* mod = (const float*)(ws + WS_MOD);
    bf16* H = (bf16*)(ws + WS_H);
    const int v = m < TL ? (m >> 13) : 2;
    float* xrow = (float*)(ws + WS_XC) + (size_t)(m - TL) * D;
    float ss = 0.f;
#pragma unroll
    for (int j = 0; j < 4; ++j) {
        const int col = 4 * F.lane + 256 * j;
        if (l > 0) { const f32x4 g2 = *(const f32x4*)(mod + ((l - 1) * 3 + v) * 6144 + 5 * D + col); x[j] = x[j] + g2 * y[j];
            if (m < TL) { u32x2 o; o.x = pk2(x[j][0], x[j][1]); o.y = pk2(x[j][2], x[j][3]); *(u32x2*)(F.xlb + (size_t)m * D + col) = o; } else *(f32x4*)(xrow + col) = x[j]; }
        ss += (x[j][0] * x[j][0] + x[j][1] * x[j][1]) + (x[j][2] * x[j][2] + x[j][3] * x[j][3]);
    }
    const float rstd = 1.0f / sqrtf(wave_sum(ss) * (1.0f / D) + EPS);
#pragma unroll
    for (int j = 0; j < 4; ++j) {
        const int col = 4 * F.lane + 256 * j;
        const f32x4 nw = *(const f32x4*)(a->in[I_NORM1] + l * D + col);
        const f32x4 sh = *(const f32x4*)(mod + (l * 3 + v) * 6144 + 0 * D + col);
        const f32x4 sc = *(const f32x4*)(mod + (l * 3 + v) * 6144 + 1 * D + col);
        const f32x4 h = x[j] * rstd * nw * (1.0f + sc) + sh;
        *(unsigned*)((unsigned char*)H + (size_t)m * D + col) = pk4_fp8(h[0], h[1], h[2], h[3]);
    }
}
__device__ __forceinline__ void n1_phase(const Frame& F, const CAS Args* a, int l) {
    for (int m = F.gw; m < TT; m += 2 * F.NGW) {
        const int m2 = m + F.NGW; const bool two = m2 < TT;
        f32x4 xa[4], ya[4], xb[4], yb[4];
        n1_load(F, a, l, m, xa, ya);
        if (two) n1_load(F, a, l, m2, xb, yb);
        n1_row(F, a, l, m, xa, ya);
        if (two) n1_row(F, a, l, m2, xb, yb);
    }
}

struct EpiIn {
    static constexpr bool PERM = true;
    bf16* P; const float* bias_f; const float* bias_b; const float* tcos; const float* tsin; int abl;
    template <int KIND>
    __device__ __forceinline__ void body(const f32x4 (&acc)[2][2][4][2], const pg8::Unit& u, int wr, int wc, int fr, int fq) const {
        const int row0 = u.pm * 256 + wr * 64 + fr, colw = wc * 32 + 8 * fq;
        f32x4 cs[4], sn[4], b0[2], b1[2];
        const bool wodd = (wc & 1) != 0;
        if (KIND == 3 || KIND == 5) {
            const int t0 = row0 & (SEQ - 1);
#pragma unroll
            for (int j = 0; j < 4; ++j) { const int pos = wodd ? ((t0 + 16 * j) & 63) : ((t0 + 128 * (j & 1)) >> 6);
                cs[j] = *(const f32x4*)(tcos + pos * 16 + 4 * fq); sn[j] = *(const f32x4*)(tsin + pos * 16 + 4 * fq); }
        }
        if (KIND == 2) {
#pragma unroll
            for (int bj = 0; bj < 2; ++bj) { const float* bp = (u.pn == 9 ? bias_f : bias_b) + colw + bj * 128; b0[bj] = *(const f32x4*)bp; b1[bj] = *(const f32x4*)(bp + 4); }
        }
#pragma unroll
        for (int ai = 0; ai < 2; ++ai)
#pragma unroll
            for (int m = 0; m < 4; ++m) {
                const int row = row0 + ai * 128 + m * 16;
                bf16* rowp = P + (size_t)row * NIN + u.pn * 256 + colw;
#pragma unroll
                for (int bj = 0; bj < 2; ++bj) {
                    f32x4 v0 = acc[ai][bj][m][0], v1 = acc[ai][bj][m][1];
                    if (KIND == 1) { v0 = v0 * 0.125f; v1 = v1 * 0.125f; }
                    if (KIND == 2) {
#pragma unroll
                        for (int i = 0; i < 4; ++i) { float x0 = v0[i] + b0[bj][i], x1 = v1[i] + b1[bj][i];
                            v0[i] = (fminf(x0, 0.f) - __logf(1.0f + __expf(-fabsf(x0)))) * 0.0625f; v1[i] = (fminf(x1, 0.f) - __logf(1.0f + __expf(-fabsf(x1)))) * 0.0625f; }
                    }
                    if (KIND == 3 || (KIND == 5 && bj == 0)) {
                        const f32x4 c = wodd ? cs[m] : cs[ai], sv = wodd ? sn[m] : sn[ai];
                        const f32x4 o0 = v0 * c - v1 * sv, o1 = v1 * c + v0 * sv; v0 = o0; v1 = o1;
                    }
                    if (KIND == 3 || KIND == 4) { v0 = v0 * QSCALE; v1 = v1 * QSCALE; }
                    u32x4 w; w.x = pg8::cvt_pk_bf16(v0[0], v0[1]); w.y = pg8::cvt_pk_bf16(v0[2], v0[3]); w.z = pg8::cvt_pk_bf16(v1[0], v1[1]); w.w = pg8::cvt_pk_bf16(v1[2], v1[3]);
                    *(u32x4*)(rowp + bj * 128) = w;
                }
            }
    }
    __device__ __forceinline__ void operator()(const f32x4 (&acc)[2][2][4][2], const pg8::Unit& u, int wr, int wc, int fr, int fq) const {
        const int pn = u.pn; const bool latent = u.pm < 64;
        if (pn == 0) body<1>(acc, u, wr, wc, fr, fq);
        else if (pn < 6) body<0>(acc, u, wr, wc, fr, fq);
        else if (pn < 8) { if (latent) body<3>(acc, u, wr, wc, fr, fq); else body<4>(acc, u, wr, wc, fr, fq); }
        else if (pn == 8) { if (latent) body<5>(acc, u, wr, wc, fr, fq); else body<0>(acc, u, wr, wc, fr, fq); }
        else body<2>(acc, u, wr, wc, fr, fq);
    }
};
struct EpiOut {
    static constexpr bool PERM = false;
    const float* resL; const float* resC; bf16* xlb; float* outC; const float* mod_l; bool res_b;
    __device__ __forceinline__ void operator()(const f32x4 (&acc)[2][2][4][2], const pg8::Unit& u, int wr, int wc, int fr, int fq) const {
        const bool latent = u.pm < 64;
        const int v = latent ? (u.pm >> 5) : 2;
        const int rowb = (latent ? u.pm * 256 : u.pm * 256 - TL) + wr * 64 + fr;
        const int col0 = u.pn * 256 + wc * 32 + 4 * fq;
        const float* g1p = mod_l + v * 6144 + 2 * D + col0;
        f32x4 g1[2][2];
#pragma unroll
        for (int bj = 0; bj < 2; ++bj)
#pragma unroll
            for (int n = 0; n < 2; ++n) g1[bj][n] = *(const f32x4*)(g1p + bj * 128 + n * 16);
        const bool rb = latent && res_b;
        const float* res = latent ? resL : resC;
#pragma unroll
        for (int ai = 0; ai < 2; ++ai)
#pragma unroll
            for (int mp = 0; mp < 4; mp += 2) {
                f32x4 r[2][2][2];
#pragma unroll
                for (int m = 0; m < 2; ++m) { const size_t off = (size_t)(rowb + ai * 128 + (mp + m) * 16) * D + col0;
#pragma unroll
                    for (int bj = 0; bj < 2; ++bj)
#pragma unroll
                        for (int n = 0; n < 2; ++n) r[m][bj][n] = rb ? ld_y4(xlb + off + bj * 128 + n * 16) : *(const f32x4*)(res + off + bj * 128 + n * 16); }
#pragma unroll
                for (int m = 0; m < 2; ++m) { const size_t off = (size_t)(rowb + ai * 128 + (mp + m) * 16) * D + col0;
#pragma unroll
                    for (int bj = 0; bj < 2; ++bj)
#pragma unroll
                        for (int n = 0; n < 2; ++n) { const f32x4 o = r[m][bj][n] + g1[bj][n] * acc[ai][bj][mp + m][n];
                            if (latent) { u32x2 w; w.x = pk2(o[0], o[1]); w.y = pk2(o[2], o[3]); *(u32x2*)(xlb + off + bj * 128 + n * 16) = w; }
                            else *(f32x4*)(outC + off + bj * 128 + n * 16) = o; } }
                asm volatile("" ::: "memory");
            }
    }
};
struct EpiGU {
    static constexpr bool PERM = true;
    bf16* Hmid;
    __device__ __forceinline__ void operator()(const f32x4 (&acc)[2][2][4][2], const pg8::Unit& u, int wr, int wc, int fr, int fq) const {
        const int row0 = u.pm * 256 + wr * 64 + fr, hid0 = u.pn * 128 + wc * 16 + fq * 4;
#pragma unroll
        for (int ai = 0; ai < 2; ++ai)
#pragma unroll
            for (int m = 0; m < 4; ++m) {
                unsigned char* rowp = (unsigned char*)Hmid + (size_t)(row0 + ai * 128 + m * 16) * DE + hid0;
#pragma unroll
                for (int bj = 0; bj < 2; ++bj) {
                    const f32x4 g = acc[ai][bj][m][0], up = acc[ai][bj][m][1]; f32x4 o;
#pragma unroll
                    for (int i = 0; i < 4; ++i) o[i] = g[i] * __builtin_amdgcn_rcpf(1.0f + __expf(-g[i])) * up[i];
                    __hip_atomic_store((unsigned*)(rowp + bj * 64), pk4_fp8(o[0] * HMID_SCALE, o[1] * HMID_SCALE, o[2] * HMID_SCALE, o[3] * HMID_SCALE), __ATOMIC_RELAXED, __HIP_MEMORY_SCOPE_AGENT);
                }
            }
    }
};
struct EpiDown {
    static constexpr bool PERM = true;
    bf16* Y; const unsigned* list; const float* listw; const LAS int* tab;
    __device__ __forceinline__ void operator()(const f32x4 (&acc)[2][2][4][2], const pg8::Unit& u, int wr, int wc, int fr, int fq) const {
        const int ce = tab[u.e];
        const int r0 = u.mt * 256 + wr * 64 + fr, col0 = u.pn * 256 + wc * 32 + 8 * fq;
        const unsigned* lp = list + (size_t)u.e * LISTCAP; const float* lw = listw + (size_t)u.e * LISTCAP;
        unsigned tsv[2][4]; float wv[2][4];
#pragma unroll
        for (int ai = 0; ai < 2; ++ai)
#pragma unroll
            for (int m = 0; m < 4; ++m) { const int r = r0 + ai * 128 + m * 16; const bool ok = r < ce; tsv[ai][m] = ok ? __builtin_nontemporal_load(lp + r) : 0xffffffffu; wv[ai][m] = ok ? __builtin_nontemporal_load(lw + r) : 0.f; }
#pragma unroll
        for (int ai = 0; ai < 2; ++ai)
#pragma unroll
            for (int m = 0; m < 4; ++m) {
                const unsigned ts = tsv[ai][m]; const float w = wv[ai][m];
                if (ts != 0xffffffffu) {
                    bf16* rowp = Y + ((size_t)(ts & 1u) * TT + (ts >> 1)) * D + col0;
#pragma unroll
                    for (int bj = 0; bj < 2; ++bj) {
                        const f32x4 v0 = acc[ai][bj][m][0] * w, v1 = acc[ai][bj][m][1] * w;
                        u32x4 o; o.x = pg8::cvt_pk_bf16(v0[0], v0[1]); o.y = pg8::cvt_pk_bf16(v0[2], v0[3]); o.z = pg8::cvt_pk_bf16(v1[0], v1[1]); o.w = pg8::cvt_pk_bf16(v1[2], v1[3]);
                        *(u32x4*)(rowp + bj * 128) = o;
                    }
                }
            }
    }
};

__device__ __forceinline__ void swa_naive(const Frame& F, const CAS Args* a, int l) {
    const bf16* P = (const bf16*)(F.ws + WS_P); bf16* MIX = (bf16*)(F.ws + WS_MIX);
    const int total = (l == 0 ? TT : TL) * 8;
    for (int idx = F.gw * 64 + F.lane; idx < total; idx += F.NGW * 64) {
        const int m = idx >> 3, hq = idx & 7, kvh = hq >> 2;
        const bool latent = m < TL;
        const int b = latent ? (m >> 13) : ((m - TL) >> 8), t = m & (SEQ - 1);
        float q[64];
        { const u32x4* qp = (const u32x4*)(P + (size_t)m * NIN + PC_SQ + hq * 64);
#pragma unroll
          for (int c = 0; c < 8; ++c) { const u32x4 w = qp[c]; q[8 * c] = bflo(w.x); q[8 * c + 1] = bfhi(w.x); q[8 * c + 2] = bflo(w.y); q[8 * c + 3] = bfhi(w.y);
              q[8 * c + 4] = bflo(w.z); q[8 * c + 5] = bfhi(w.z); q[8 * c + 6] = bflo(w.w); q[8 * c + 7] = bfhi(w.w); } }
        float o[64];
#pragma unroll
        for (int d = 0; d < 64; ++d) o[d] = 0.f;
        const float sink = a->in[I_SINK][l * 8 + hq] * LOG2E;
        float mx = sink, den = 1.0f;
        const int lo = latent ? (t - 128 < 0 ? 0 : t - 128) : 0, hi = latent ? (t + 128 > SEQ - 1 ? SEQ - 1 : t + 128) : -1;
        const int nloc = hi - lo + 1;
        for (int kk = 0; kk < nloc + LC; ++kk) {
            const int krow = kk < nloc ? b * SEQ + lo + kk : TL + b * LC + (kk - nloc);
            const u32x4* kp = (const u32x4*)(P + (size_t)krow * NIN + PC_SK + kvh * 64);
            float s = 0.f;
#pragma unroll
            for (int c = 0; c < 8; ++c) { const u32x4 w = kp[c]; s += q[8 * c] * bflo(w.x) + q[8 * c + 1] * bfhi(w.x) + q[8 * c + 2] * bflo(w.y) + q[8 * c + 3] * bfhi(w.y)
                + q[8 * c + 4] * bflo(w.z) + q[8 * c + 5] * bfhi(w.z) + q[8 * c + 6] * bflo(w.w) + q[8 * c + 7] * bfhi(w.w); }
            const float mn = fmaxf(mx, s), f = exp2f(mx - mn), p = exp2f(s - mn);
            den = den * f + p; mx = mn;
            const u32x4* vp = (const u32x4*)(P + (size_t)krow * NIN + PC_SV + kvh * 64);
#pragma unroll
            for (int c = 0; c < 8; ++c) { const u32x4 w = vp[c];
                o[8 * c] = o[8 * c] * f + p * bflo(w.x); o[8 * c + 1] = o[8 * c + 1] * f + p * bfhi(w.x); o[8 * c + 2] = o[8 * c + 2] * f + p * bflo(w.y); o[8 * c + 3] = o[8 * c + 3] * f + p * bfhi(w.y);
                o[8 * c + 4] = o[8 * c + 4] * f + p * bflo(w.z); o[8 * c + 5] = o[8 * c + 5] * f + p * bfhi(w.z); o[8 * c + 6] = o[8 * c + 6] * f + p * bflo(w.w); o[8 * c + 7] = o[8 * c + 7] * f + p * bfhi(w.w); }
        }
        const float inv = 1.0f / den;
        u32x4* op = (u32x4*)(MIX + (size_t)m * D + 512 + hq * 64);
#pragma unroll
        for (int c = 0; c < 8; ++c) { u32x4 w; w.x = pk2(o[8 * c] * inv, o[8 * c + 1] * inv); w.y = pk2(o[8 * c + 2] * inv, o[8 * c + 3] * inv); w.z = pk2(o[8 * c + 4] * inv, o[8 * c + 5] * inv); w.w = pk2(o[8 * c + 6] * inv, o[8 * c + 7] * inv); op[c] = w; }
    }
}


typedef float f32x16 __attribute__((ext_vector_type(16)));
typedef short s16x4 __attribute__((ext_vector_type(4)));
__device__ __forceinline__ int crow(int r, int hi) { return (r & 3) + 8 * (r >> 2) + 4 * hi; }
__device__ __forceinline__ s16x4 vtr(const LAS unsigned char* p) { return __builtin_bit_cast(s16x4, __builtin_amdgcn_ds_read_tr16_b64_v4i16((LAS s16x4*)p)); }
constexpr int SWA_K = 0, SWA_V = 49152;
__device__ __forceinline__ void swa_kload(const LAS unsigned char* Kt, int kb, int lane, bf16x8 (&kf)[4]) {
    const int r32 = lane & 31, hi = lane >> 5;
#pragma unroll
    for (int d0 = 0; d0 < 4; ++d0) kf[d0] = *(const LAS bf16x8*)(Kt + (2 * d0 + hi) * 1024 + (32 * kb + r32) * 16);
}
__device__ __forceinline__ void swa_tile(const LAS unsigned char* Kt, const LAS unsigned char* Vt, const LAS unsigned char* Kn, int mtype, const bf16x8 (&qf)[2][4], f32x16 (&o)[2][2], float (&mrun)[2], float (&lrun)[2], int lane, int abl = 0) {
    const int r32 = lane & 31, hi = lane >> 5; bf16x8 kf[4]; (void)Kn;
    const LAS unsigned char* vp = Vt + ((lane >> 4) & 1) * 32 + (lane & 3) * 8 + (4 * hi + ((lane & 15) >> 2)) * 64;
#pragma unroll
    for (int kb = 0; kb < 2; ++kb) {
        f32x16 s[2];
        swa_kload(Kt, kb, lane, kf);
#pragma unroll
        for (int d0 = 0; d0 < 4; ++d0)
#pragma unroll
            for (int qt = 0; qt < 2; ++qt) {
                if (d0 == 0) { f32x16 z;
#pragma unroll
                    for (int r = 0; r < 16; ++r) z[r] = 0.f;
                    s[qt] = __builtin_amdgcn_mfma_f32_32x32x16_bf16(kf[0], qf[qt][0], z, 0, 0, 0); }
                else if (abl != 4) s[qt] = __builtin_amdgcn_mfma_f32_32x32x16_bf16(kf[d0], qf[qt][d0], s[qt], 0, 0, 0);
            }
        __builtin_amdgcn_sched_barrier(0);
        s16x4 vlo[2][2], vhi[2][2];
#pragma unroll
        for (int dt = 0; dt < 2; ++dt)
#pragma unroll
            for (int sp = 0; sp < 2; ++sp) { vlo[dt][sp] = vtr(vp + dt * 4096 + (2 * kb + sp) * 1024); vhi[dt][sp] = vtr(vp + dt * 4096 + (2 * kb + sp) * 1024 + 512); }
        __builtin_amdgcn_sched_barrier(0);
        bf16x8 pf[2][2];
#pragma unroll
        for (int qt = 0; qt < 2; ++qt) {
            if (mtype != 0) {
                int thr = r32 + 32 * qt - 4 * hi - 32 * kb; asm volatile("" : "+v"(thr));
                if (mtype == 1) {
#pragma unroll
                    for (int r = 0; r < 16; ++r) { const int cc = (r & 3) + 8 * (r >> 2); if (cc < thr) s[qt][r] = -INFINITY; }
                } else {
#pragma unroll
                    for (int r = 0; r < 16; ++r) { const int cc = (r & 3) + 8 * (r >> 2); if (cc > thr) s[qt][r] = -INFINITY; }
                }
            }
            float rm = s[qt][0];
            if (abl != 1) {
#pragma unroll
            for (int r = 1; r < 16; ++r) rm = fmaxf(rm, s[qt][r]);
            }
            { auto rr = __builtin_amdgcn_permlane32_swap(__float_as_uint(rm), __float_as_uint(rm), false, false); rm = fmaxf(__uint_as_float(rr[0]), __uint_as_float(rr[1])); }
            const float mn = fmaxf(mrun[qt], rm);
            if (__any(mn > mrun[qt])) {
                const float alpha = __builtin_amdgcn_exp2f(mrun[qt] - mn);
                lrun[qt] *= alpha;
#pragma unroll
                for (int dt = 0; dt < 2; ++dt)
#pragma unroll
                    for (int r = 0; r < 16; ++r) o[dt][qt][r] *= alpha;
                mrun[qt] = mn;
            }
            float rs = 0.f;
            if (abl != 1) {
#pragma unroll
            for (int r = 0; r < 16; ++r) { const float p = __builtin_amdgcn_exp2f(s[qt][r] - mn); s[qt][r] = p; rs += p; }
            }
            lrun[qt] += rs;
#pragma unroll
            for (int sp = 0; sp < 2; ++sp) {
                u32x4 w; w.x = pg8::cvt_pk_bf16(s[qt][8 * sp + 0], s[qt][8 * sp + 1]); w.y = pg8::cvt_pk_bf16(s[qt][8 * sp + 2], s[qt][8 * sp + 3]);
                w.z = pg8::cvt_pk_bf16(s[qt][8 * sp + 4], s[qt][8 * sp + 5]); w.w = pg8::cvt_pk_bf16(s[qt][8 * sp + 6], s[qt][8 * sp + 7]);
                pf[qt][sp] = __builtin_bit_cast(bf16x8, w);
            }
        }
#pragma unroll
        for (int dt = 0; dt < 2; ++dt)
#pragma unroll
            for (int sp = 0; sp < 2; ++sp) {
                const bf16x8 vf = (bf16x8){vlo[dt][sp][0], vlo[dt][sp][1], vlo[dt][sp][2], vlo[dt][sp][3], vhi[dt][sp][0], vhi[dt][sp][1], vhi[dt][sp][2], vhi[dt][sp][3]};
#pragma unroll
                for (int qt = 0; qt < 2; ++qt) if (abl != 2) o[dt][qt] = __builtin_amdgcn_mfma_f32_32x32x16_bf16(vf, pf[qt][sp], o[dt][qt], 0, 0, 0);
            }
    }
}
__device__ __forceinline__ void swa_stage(const Frame& F, const bf16* P, int grow, int kvh, int ti) {
    { const int key = 8 * F.wave + (F.lane & 7), ch = F.lane >> 3;
      const u32x4 v = *(const u32x4*)(P + (size_t)(grow + key) * NIN + PC_SK + kvh * 64 + ch * 8);
      *(LAS u32x4*)(F.lds + SWA_K + ti * 8192 + ch * 1024 + key * 16) = v; }
    { const int key = 8 * F.wave + (F.lane >> 3), ch = F.lane & 7;
      const u32x4 v = *(const u32x4*)(P + (size_t)(grow + key) * NIN + PC_SV + kvh * 64 + ch * 8);
      *(LAS u32x4*)(F.lds + SWA_V + ti * 8192 + (ch >> 2) * 4096 + key * 64 + (ch & 3) * 16) = v; }
}
__device__ __forceinline__ void swa_flash(const Frame& F, const CAS Args* a, int l, int abl = 0) {
    const bf16* P = (const bf16*)(F.ws + WS_P); bf16* MIX = (bf16*)(F.ws + WS_MIX);
    const int nunits = 256 + (l == 0 ? 8 : 0);
    const int lane = F.lane, r32 = lane & 31, hi = lane >> 5;
    for (int u = F.vcu; u < nunits; u += F.G) {
        const bool latent = u < 256;
        const int b = latent ? (u >> 7) : ((u - 256) >> 2), kvh = latent ? ((u >> 6) & 1) : (((u - 256) >> 1) & 1), qb = latent ? (u & 63) : ((u - 256) & 1);
        const int q0 = qb * 128, g = F.wave >> 1, qs = F.wave & 1, hq = kvh * 4 + g;
        const int mrow0 = (latent ? b * SEQ : TL + b * LC) + q0 + 64 * qs;
        bf16x8 qf[2][4];
#pragma unroll
        for (int qt = 0; qt < 2; ++qt)
#pragma unroll
            for (int d0 = 0; d0 < 4; ++d0) { if (abl != 7) qf[qt][d0] = *(const bf16x8*)(P + (size_t)(mrow0 + 32 * qt + r32) * NIN + PC_SQ + hq * 64 + 16 * d0 + 8 * hi); else qf[qt][d0] = (bf16x8){(short)lane, 1, 2, 3, 4, 5, 6, 7}; }
        f32x16 o[2][2];
#pragma unroll
        for (int dt = 0; dt < 2; ++dt)
#pragma unroll
            for (int qt = 0; qt < 2; ++qt)
#pragma unroll
                for (int r = 0; r < 16; ++r) o[dt][qt][r] = 0.f;
        const float sink2 = a->in[I_SINK][l * 8 + hq] * LOG2E;
        float mrun[2] = {sink2, sink2}, lrun[2] = {hi == 0 ? 1.f : 0.f, hi == 0 ? 1.f : 0.f};
        if (latent) {
#pragma unroll 1
            for (int j = 0; j < 6; ++j) { const int ks = q0 - 128 + 64 * j; if (ks >= 0 && ks < SEQ && abl != 3) swa_stage(F, P, b * SEQ + ks, kvh, j); }
            LDS_BARRIER();
            { int jf = qs; while (q0 - 128 + 64 * jf < 0) ++jf;
              (void)jf;
#pragma unroll 1
              for (int tt = 0; tt < 5; ++tt) { const int j = qs + tt, ks = q0 - 128 + 64 * j;
                  if (ks >= 0 && ks < SEQ && abl != 8) { const int jn = (j + 1 < 6) ? j + 1 : j;
                      swa_tile(F.lds + SWA_K + j * 8192, F.lds + SWA_V + j * 8192, F.lds + SWA_K + jn * 8192, tt == 0 ? 1 : (tt == 4 ? 2 : 0), qf, o, mrun, lrun, lane, abl); } } }
            LDS_BARRIER();
        }
#pragma unroll 1
        for (int j = 0; j < 4; ++j) if (abl != 3) swa_stage(F, P, TL + b * LC + 64 * j, kvh, j);
        LDS_BARRIER();
        {
#pragma unroll 1
          for (int j = 0; j < 4; ++j) if (abl != 8) swa_tile(F.lds + SWA_K + j * 8192, F.lds + SWA_V + j * 8192, F.lds + SWA_K + (j < 3 ? j + 1 : j) * 8192, 0, qf, o, mrun, lrun, lane, abl); }
        LDS_BARRIER();
        LAS unsigned char* stg = F.lds + F.wave * 4096;
#pragma unroll
        for (int qt = 0; qt < 2; ++qt) {
            float lt = lrun[qt];
            { auto rr = __builtin_amdgcn_permlane32_swap(__float_as_uint(lt), __float_as_uint(lt), false, false); lt = __uint_as_float(rr[0]) + __uint_as_float(rr[1]); }
            const float is = MIX_SCALE / lt;
#pragma unroll
            for (int dt = 0; dt < 2; ++dt)
#pragma unroll
                for (int rg = 0; rg < 4; ++rg)
                    *(LAS unsigned*)(stg + (32 * qt + r32) * 64 + 32 * dt + 8 * rg + 4 * hi) = pk4_fp8(o[dt][qt][4 * rg] * is, o[dt][qt][4 * rg + 1] * is, o[dt][qt][4 * rg + 2] * is, o[dt][qt][4 * rg + 3] * is);
        }
        LDS_WAIT();
        if (abl != 7) {
            int le = lane; asm volatile("" : "+v"(le));
#pragma unroll
            for (int i = 0; i < 4; ++i) { const int row = 16 * i + (le >> 2), ch = le & 3;
                const u32x4 v = *(const LAS u32x4*)(stg + row * 64 + ch * 16);
                *(u32x4*)((unsigned char*)MIX + (size_t)(mrow0 + row) * D + 512 + hq * 64 + ch * 16) = v; }
        }
        LDS_BARRIER();
    }
}

constexpr size_t WS_US = WS_GL, WS_USC = WS_GL + 32 * MiB, WS_DEC = 7 * MiB;
static_assert(WS_USC + (size_t)16 * 4 * 8192 * 2 <= WS_END && WS_DEC + (size_t)16 * 132 * 64 * 4 <= WS_WIN, "ws map (gla)");
constexpr int GL_V = 0, GL_M0 = 16384, GL_MSZ = 64 * 72 * 2, GL_RED = GL_M0 + 4 * GL_MSZ;
__device__ __forceinline__ float wave_scan_incl(float v) {
    v += DPP_F(v, 0x111, 0xF); v += DPP_F(v, 0x112, 0xF); v += DPP_F(v, 0x114, 0xF); v += DPP_F(v, 0x118, 0xF);
    v += DPP_F(v, 0x142, 0xA); v += DPP_F(v, 0x143, 0xC); return v;
}
__device__ __forceinline__ float lane63(float v) { return __builtin_bit_cast(float, __builtin_amdgcn_readlane(__builtin_bit_cast(int, v), 63)); }
__device__ __forceinline__ void unpack8(const u32x4 w, float (&f)[8]) { f[0] = bflo(w.x); f[1] = bfhi(w.x); f[2] = bflo(w.y); f[3] = bfhi(w.y); f[4] = bflo(w.z); f[5] = bfhi(w.z); f[6] = bflo(w.w); f[7] = bfhi(w.w); }
__device__ __forceinline__ void gla_stage_v(const Frame& F, const bf16* P, int m0, int h) {
#pragma unroll
    for (int i = 0; i < 2; ++i) { const int p = F.tid + 512 * i, t = p >> 4, ch = p & 15;
        const u32x4 v = *(const u32x4*)(P + (size_t)(m0 + t) * NIN + PC_V + h * 128 + ch * 8);
        *(LAS u32x4*)(F.lds + GL_V + (ch >> 2) * 4096 + t * 64 + (ch & 3) * 16) = v; }
}
__device__ __forceinline__ void gla_g1_unit(const Frame& F, const bf16* P, int m0, int h, bf16* Uf, bf16* Ub, float* decf, float* decb) {
    const int w = F.wave, t = F.lane, c = t & 31, hi = t >> 5;
    const bf16* row = P + (size_t)(m0 + t) * NIN + h * 64 + 8 * w;
    float laf[8], lab[8], kk[8];
    unpack8(*(const u32x4*)(row + PC_GF), laf); unpack8(*(const u32x4*)(row + PC_GB), lab); unpack8(*(const u32x4*)(row + PC_K), kk);
    gla_stage_v(F, P, m0, h);
    LAS bf16* KOF = (LAS bf16*)(F.lds + GL_M0); LAS bf16* KOB = (LAS bf16*)(F.lds + GL_M0 + GL_MSZ);
#pragma unroll
    for (int i = 0; i < 8; ++i) {
        const float incf = wave_scan_incl(laf[i]), tf = lane63(incf), incb = wave_scan_incl(lab[i]), tb = lane63(incb);
        KOF[(8 * w + i) * 72 + t] = (bf16)f2bf(kk[i] * __expf(tf - incf));
        KOB[(8 * w + i) * 72 + t] = (bf16)f2bf(kk[i] * __expf(incb - lab[i]));
        if (t == 0) { decf[8 * w + i] = __expf(tf); decb[8 * w + i] = __expf(tb); }
    }
    LDS_BARRIER();
    const int dir = w >> 2, dvt = w & 3;
    const LAS unsigned char* vp = F.lds + GL_V + dvt * 4096 + ((t >> 4) & 1) * 32 + (t & 3) * 8 + ((t & 15) >> 2) * 64 + hi * 512;
    const LAS unsigned char* kb = F.lds + GL_M0 + dir * GL_MSZ + (c * 72 + 8 * hi) * 2;
    f32x16 acc[2];
#pragma unroll
    for (int j = 0; j < 2; ++j)
#pragma unroll
        for (int r = 0; r < 16; ++r) acc[j][r] = 0.f;
#pragma unroll
    for (int sp = 0; sp < 4; ++sp) {
        const s16x4 lo = vtr(vp + sp * 1024), hi4 = vtr(vp + sp * 1024 + 256);
        const bf16x8 vf = (bf16x8){lo[0], lo[1], lo[2], lo[3], hi4[0], hi4[1], hi4[2], hi4[3]};
#pragma unroll
        for (int j = 0; j < 2; ++j) { const bf16x8 kf = *(const LAS bf16x8*)(kb + j * 32 * 144 + sp * 32); acc[j] = __builtin_amdgcn_mfma_f32_32x32x16_bf16(kf, vf, acc[j], 0, 0, 0); }
    }
    bf16* U = dir ? Ub : Uf;
#pragma unroll
    for (int j = 0; j < 2; ++j) {
        u32x4 w0, w1;
        w0.x = pk2(acc[j][0], acc[j][1]); w0.y = pk2(acc[j][2], acc[j][3]); w0.z = pk2(acc[j][4], acc[j][5]); w0.w = pk2(acc[j][6], acc[j][7]);
        w1.x = pk2(acc[j][8], acc[j][9]); w1.y = pk2(acc[j][10], acc[j][11]); w1.z = pk2(acc[j][12], acc[j][13]); w1.w = pk2(acc[j][14], acc[j][15]);
        u32x4* up = (u32x4*)(U + ((j * 4 + dvt) * 64 + t) * 16);
        up[0] = w0; up[1] = w1;
    }
    LDS_BARRIER();
}
__device__ __forceinline__ void gla_g1(const Frame& F0, int l) {
    Frame F = F0; { int l_; asm volatile("v_mbcnt_lo_u32_b32 %0, -1, 0\n\tv_mbcnt_hi_u32_b32 %0, -1, %0" : "=v"(l_)); F.lane = l_; F.tid = F.wave * 64 + l_; }
    const bf16* P = (const bf16*)(F.ws + WS_P);
    bf16* US = (bf16*)(F.ws + WS_US); bf16* USC = (bf16*)(F.ws + WS_USC); float* DEC = (float*)(F.ws + WS_DEC);
    for (int u = F.vcu; u < 1056; u += F.G) {
        const bool latent = u < 1024; const int cc = u - 1024;
        const int b = latent ? (u >> 9) : (cc >> 4), h = latent ? ((u >> 7) & 3) : ((cc >> 2) & 3), n = latent ? (u & 127) : (cc & 3);
        const int m0 = latent ? b * SEQ + 64 * n : TL + b * LC + 64 * n;
        const int sf = (b * 4 + h) * 2;
        bf16* Uf = latent ? US + ((size_t)sf * 128 + n) * 8192 : USC + ((size_t)sf * 4 + n) * 8192;
        bf16* Ub = latent ? US + ((size_t)(sf + 1) * 128 + n) * 8192 : USC + ((size_t)(sf + 1) * 4 + n) * 8192;
        const int nd = latent ? n : 128 + n;
        gla_g1_unit(F, P, m0, h, Uf, Ub, DEC + ((size_t)sf * 132 + nd) * 64, DEC + ((size_t)(sf + 1) * 132 + nd) * 64);
    }
}
constexpr size_t WS_SS = WS_H, WS_SSC = WS_H + 32 * MiB;
static_assert(WS_SSC + (size_t)16 * 4 * 8192 * 2 <= WS_P, "ws map (gla states)");
__device__ __forceinline__ void gla_scan(const Frame& F) {
    for (int w0 = (F.vcu * NWAVES + F.wave) * 64; w0 < 16 * 4096; w0 += F.G * NWAVES * 64) {
        const int seq = __builtin_amdgcn_readfirstlane(w0 >> 12), ew = __builtin_amdgcn_readfirstlane((w0 & 4095) * 2);
        const int dir = seq & 1;
        const unsigned voff = (unsigned)F.lane * 4u;
        unsigned doff;
        { const int e = ew + 2 * F.lane, r = e & 15, ln = (e >> 4) & 63, dkt = e >> 12; doff = (unsigned)(32 * dkt + (r & 3) + 8 * (r >> 2) + 4 * (ln >> 5)) * 4u; }
        const char* decb = (const char*)(F.ws + WS_DEC) + (size_t)seq * 132 * 256;
        float s0 = 0.f, s1 = 0.f;
        { const char* ub = (const char*)(F.ws + WS_USC) + ((size_t)seq * 4 * 8192 + ew) * 2; char* sb = (char*)(F.ws + WS_SSC) + ((size_t)seq * 4 * 8192 + ew) * 2;
          unsigned u[4]; f32x2 d[4];
#pragma unroll
          for (int i = 0; i < 4; ++i) { const int n = dir ? 3 - i : i; u[i] = *(const unsigned*)(ub + (size_t)n * 16384 + voff); d[i] = *(const f32x2*)(decb + (size_t)(128 + n) * 256 + doff); }
#pragma unroll
          for (int i = 0; i < 4; ++i) { const int n = dir ? 3 - i : i; *(unsigned*)(sb + (size_t)n * 16384 + voff) = pk2(s0, s1); s0 = d[i][0] * s0 + bflo(u[i]); s1 = d[i][1] * s1 + bfhi(u[i]); } }
        const long stride = dir ? -16384 : 16384, dstride = dir ? -256 : 256;
        const char* ub = (const char*)(F.ws + WS_US) + ((size_t)seq * 128 * 8192 + ew) * 2 + (dir ? (size_t)127 * 16384 : 0);
        char* sb = (char*)(F.ws + WS_SS) + ((size_t)seq * 128 * 8192 + ew) * 2 + (dir ? (size_t)127 * 16384 : 0);
        const char* db = decb + (dir ? 127 * 256 : 0);
#pragma unroll 1
        for (int i0 = 0; i0 < 128; i0 += 32) {
            unsigned u[32]; f32x2 d[32];
#pragma unroll
            for (int j = 0; j < 32; ++j) { u[j] = *(const unsigned*)(ub + j * stride + voff); d[j] = *(const f32x2*)(db + j * dstride + doff); }
#pragma unroll
            for (int j = 0; j < 32; ++j) { *(unsigned*)(sb + j * stride + voff) = pk2(s0, s1); s0 = d[j][0] * s0 + bflo(u[j]); s1 = d[j][1] * s1 + bfhi(u[j]); }
            ub += 32 * stride; sb += 32 * stride; db += 32 * dstride;
        }
    }
}
__device__ __forceinline__ void gla_g3_unit(const Frame& F, const CAS Args* a, int l, const bf16* P, int m0, int h, const bf16* Sf, const bf16* Sb, bf16* MIX) {
    const int w = F.wave, t = F.lane, c = t & 31, hi = t >> 5;
    bf16x8 sfr[4], sbr[4]; u32x2 gwv[4]; f32x4 nwv[4];
    { const int dvt_ = w >> 1, tt_ = w & 1;
#pragma unroll
      for (int kd = 0; kd < 4; ++kd) { const size_t off = (size_t)(((kd >> 1) * 4 + dvt_) * 64 + t) * 16 + 8 * (kd & 1); sfr[kd] = *(const bf16x8*)(Sf + off); sbr[kd] = *(const bf16x8*)(Sb + off); }
#pragma unroll
      for (int rg = 0; rg < 4; ++rg) { const int dv = 32 * dvt_ + 8 * rg + 4 * hi;
          gwv[rg] = *(const u32x2*)(P + (size_t)(m0 + 32 * tt_ + c) * NIN + PC_G + h * 128 + dv); nwv[rg] = *(const f32x4*)(a->in[I_GLANORM] + l * 512 + h * 128 + dv); } }
    {
        const bf16* row = P + (size_t)(m0 + t) * NIN + h * 64 + 8 * w;
        float laf[8], lab[8], kk[8], qq[8];
        unpack8(*(const u32x4*)(row + PC_GF), laf); unpack8(*(const u32x4*)(row + PC_GB), lab); unpack8(*(const u32x4*)(row + PC_K), kk); unpack8(*(const u32x4*)(row + PC_Q), qq);
        gla_stage_v(F, P, m0, h);
        float qf[8], kf[8], qb[8], kb[8];
#pragma unroll
        for (int i = 0; i < 8; ++i) {
            const float bf = wave_scan_incl(laf[i]), incb = wave_scan_incl(lab[i]), bb = lane63(incb) - incb + lab[i];
            qf[i] = qq[i] * __expf(bf); kf[i] = kk[i] * __expf(-bf); qb[i] = qq[i] * __expf(bb); kb[i] = kk[i] * __expf(-bb);
        }
        LAS unsigned char* mb = F.lds + GL_M0 + (t * 72 + 8 * w) * 2;
        u32x4 o;
        o.x = pk2(qf[0], qf[1]); o.y = pk2(qf[2], qf[3]); o.z = pk2(qf[4], qf[5]); o.w = pk2(qf[6], qf[7]); *(LAS u32x4*)(mb) = o;
        o.x = pk2(kf[0], kf[1]); o.y = pk2(kf[2], kf[3]); o.z = pk2(kf[4], kf[5]); o.w = pk2(kf[6], kf[7]); *(LAS u32x4*)(mb + GL_MSZ) = o;
        o.x = pk2(qb[0], qb[1]); o.y = pk2(qb[2], qb[3]); o.z = pk2(qb[4], qb[5]); o.w = pk2(qb[6], qb[7]); *(LAS u32x4*)(mb + 2 * GL_MSZ) = o;
        o.x = pk2(kb[0], kb[1]); o.y = pk2(kb[2], kb[3]); o.z = pk2(kb[4], kb[5]); o.w = pk2(kb[6], kb[7]); *(LAS u32x4*)(mb + 3 * GL_MSZ) = o;
    }
    LDS_BARRIER();
    const int dvt = w >> 1, tt = w & 1;
    bf16x8 qfB[4], qbB[4], qfP[4], qbP[4];
    { const LAS unsigned char* qp = F.lds + GL_M0 + ((32 * tt + c) * 72 + 8 * hi) * 2;
#pragma unroll
      for (int kd = 0; kd < 4; ++kd) { qfB[kd] = *(const LAS bf16x8*)(qp + kd * 32); qbB[kd] = *(const LAS bf16x8*)(qp + 2 * GL_MSZ + kd * 32); }
      const LAS unsigned char* pp = F.lds + GL_M0 + ((32 * tt + c) * 72 + 4 * hi) * 2;
#pragma unroll
      for (int kd = 0; kd < 4; ++kd) {
          const u32x2 a0 = *(const LAS u32x2*)(pp + kd * 32), a1 = *(const LAS u32x2*)(pp + kd * 32 + 16);
          const u32x2 b0 = *(const LAS u32x2*)(pp + 2 * GL_MSZ + kd * 32), b1 = *(const LAS u32x2*)(pp + 2 * GL_MSZ + kd * 32 + 16);
          qfP[kd] = __builtin_bit_cast(bf16x8, (u32x4){a0.x, a0.y, a1.x, a1.y}); qbP[kd] = __builtin_bit_cast(bf16x8, (u32x4){b0.x, b0.y, b1.x, b1.y});
      } }
    bf16x8 pfr[2][2];
#pragma unroll
    for (int st = 0; st < 2; ++st) {
        const LAS unsigned char* kp = F.lds + GL_M0 + GL_MSZ + ((32 * st + c) * 72 + 8 * hi) * 2;
        f32x16 xf, xb;
#pragma unroll
        for (int r = 0; r < 16; ++r) { xf[r] = 0.f; xb[r] = 0.f; }
        const bool needF = st <= tt, needB = st >= tt;
        if (needF) {
#pragma unroll
            for (int kd = 0; kd < 4; ++kd) xf = __builtin_amdgcn_mfma_f32_32x32x16_bf16(*(const LAS bf16x8*)(kp + kd * 32), qfB[kd], xf, 0, 0, 0);
        }
        if (needB) {
#pragma unroll
            for (int kd = 0; kd < 4; ++kd) xb = __builtin_amdgcn_mfma_f32_32x32x16_bf16(*(const LAS bf16x8*)(kp + 2 * GL_MSZ + kd * 32), qbB[kd], xb, 0, 0, 0);
        }
        if (st == tt) {
            int thr = c - 4 * hi; asm volatile("" : "+v"(thr));
#pragma unroll
            for (int r = 0; r < 16; ++r) { const int cc = (r & 3) + 8 * (r >> 2); xf[r] = (cc <= thr ? xf[r] : 0.f) + (cc >= thr ? xb[r] : 0.f); }
        } else {
#pragma unroll
            for (int r = 0; r < 16; ++r) xf[r] += xb[r];
        }
#pragma unroll
        for (int sp = 0; sp < 2; ++sp) {
            u32x4 wv; wv.x = pg8::cvt_pk_bf16(xf[8 * sp + 0], xf[8 * sp + 1]); wv.y = pg8::cvt_pk_bf16(xf[8 * sp + 2], xf[8 * sp + 3]);
            wv.z = pg8::cvt_pk_bf16(xf[8 * sp + 4], xf[8 * sp + 5]); wv.w = pg8::cvt_pk_bf16(xf[8 * sp + 6], xf[8 * sp + 7]);
            pfr[st][sp] = __builtin_bit_cast(bf16x8, wv);
        }
    }
    f32x16 o;
#pragma unroll
    for (int r = 0; r < 16; ++r) o[r] = 0.f;
    { const LAS unsigned char* vp = F.lds + GL_V + dvt * 4096 + ((t >> 4) & 1) * 32 + (t & 3) * 8 + (4 * hi + ((t & 15) >> 2)) * 64;
#pragma unroll
      for (int ks = 0; ks < 4; ++ks) {
          const s16x4 lo = vtr(vp + ks * 1024), hi4 = vtr(vp + ks * 1024 + 512);
          const bf16x8 vf = (bf16x8){lo[0], lo[1], lo[2], lo[3], hi4[0], hi4[1], hi4[2], hi4[3]};
          o = __builtin_amdgcn_mfma_f32_32x32x16_bf16(vf, pfr[ks >> 1][ks & 1], o, 0, 0, 0);
      } }
#pragma unroll
    for (int kd = 0; kd < 4; ++kd) {
        o = __builtin_amdgcn_mfma_f32_32x32x16_bf16(sfr[kd], qfP[kd], o, 0, 0, 0);
        o = __builtin_amdgcn_mfma_f32_32x32x16_bf16(sbr[kd], qbP[kd], o, 0, 0, 0);
    }
    float ssq = 0.f;
#pragma unroll
    for (int r = 0; r < 16; ++r) ssq += o[r] * o[r];
    { auto rr = __builtin_amdgcn_permlane32_swap(__float_as_uint(ssq), __float_as_uint(ssq), false, false); ssq = __uint_as_float(rr[0]) + __uint_as_float(rr[1]); }
    LAS float* red = (LAS float*)(F.lds + GL_RED);
    if (hi == 0) red[dvt * 64 + 32 * tt + c] = ssq;
    LDS_BARRIER();
    const float tot = (red[32 * tt + c] + red[64 + 32 * tt + c]) + (red[128 + 32 * tt + c] + red[192 + 32 * tt + c]);
    const float rstd = 1.0f / sqrtf(tot * (1.0f / 128.0f) + EPS);
    const int mrow = m0 + 32 * tt + c;
#pragma unroll
    for (int rg = 0; rg < 4; ++rg) {
        const int dv = 32 * dvt + 8 * rg + 4 * hi;
        const u32x2 gw = gwv[rg]; const f32x4 nw = nwv[rg];
        const float g0 = bflo(gw.x), g1 = bfhi(gw.x), g2 = bflo(gw.y), g3 = bfhi(gw.y);
        const float rs = rstd * MIX_SCALE;
        *(unsigned*)((unsigned char*)MIX + (size_t)mrow * D + h * 128 + dv) = pk4_fp8(o[4 * rg] * rs * nw[0] * silu_f(g0), o[4 * rg + 1] * rs * nw[1] * silu_f(g1), o[4 * rg + 2] * rs * nw[2] * silu_f(g2), o[4 * rg + 3] * rs * nw[3] * silu_f(g3));
    }
    LDS_BARRIER();
}
__device__ __forceinline__ void gla_g3(const Frame& F, const CAS Args* a, int l) {
    const bf16* P = (const bf16*)(F.ws + WS_P); bf16* MIX = (bf16*)(F.ws + WS_MIX);
    const bf16* US = (const bf16*)(F.ws + WS_SS); const bf16* USC = (const bf16*)(F.ws + WS_SSC);
    const int nunits = 1024 + (l == 0 ? 32 : 0);
    for (int u = F.vcu; u < nunits; u += F.G) {
        const bool latent = u < 1024; const int cc = u - 1024;
        const int b = latent ? (u >> 9) : (cc >> 4), h = latent ? ((u >> 7) & 3) : ((cc >> 2) & 3), n = latent ? (u & 127) : (cc & 3);
        const int m0 = latent ? b * SEQ + 64 * n : TL + b * LC + 64 * n;
        const int sf = (b * 4 + h) * 2;
        const bf16* Sf = latent ? US + ((size_t)sf * 128 + n) * 8192 : USC + ((size_t)sf * 4 + n) * 8192;
        const bf16* Sb = latent ? US + ((size_t)(sf + 1) * 128 + n) * 8192 : USC + ((size_t)(sf + 1) * 4 + n) * 8192;
        gla_g3_unit(F, a, l, P, m0, h, Sf, Sb, MIX);
    }
}

__device__ __forceinline__ void gla_naive(const Frame& F, const CAS Args* a, int l) {
    const bf16* P = (const bf16*)(F.ws + WS_P);
    bf16* OF = (bf16*)(F.ws + WS_GL);
    for (int w = F.gw; w < 2048; w += F.NGW) {
        const int dv = w & 127, dir = (w >> 7) & 1, h = (w >> 8) & 3, b = w >> 10;
        const int pcg = dir ? PC_GB : PC_GF;
        float S = 0.f;
        for (int step = 0; step < LC + SEQ; ++step) {
            int m;
            if (dir == 0) m = step < LC ? TL + b * LC + step : b * SEQ + (step - LC);
            else m = step < LC ? TL + b * LC + (LC - 1 - step) : b * SEQ + (SEQ - 1 - (step - LC));
            const bf16* row = P + (size_t)m * NIN;
            const float la = bf2f(row[pcg + h * 64 + F.lane]), kk = bf2f(row[PC_K + h * 64 + F.lane]), qq = bf2f(row[PC_Q + h * 64 + F.lane]), vv = bf2f(row[PC_V + h * 128 + dv]);
            S = __expf(la) * S + kk * vv;
            const float o = wave_sum(qq * S);
            if (F.lane == 0) OF[((size_t)dir * TT + m) * 512 + h * 128 + dv] = (bf16)f2bf(o);
        }
    }
}
__device__ __forceinline__ void gla_out_naive(const Frame& F, const CAS Args* a, int l) {
    const bf16* P = (const bf16*)(F.ws + WS_P); bf16* MIX = (bf16*)(F.ws + WS_MIX);
    const bf16* OF = (const bf16*)(F.ws + WS_GL);
    const int rows = (l == 0) ? TT : TL;
    for (int m = F.gw; m < rows; m += F.NGW) {
        const int c0 = 8 * F.lane;
        const u32x4 wa = *(const u32x4*)(OF + (size_t)m * 512 + c0), wb = *(const u32x4*)(OF + ((size_t)TT + m) * 512 + c0);
        float o[8] = {bflo(wa.x) + bflo(wb.x), bfhi(wa.x) + bfhi(wb.x), bflo(wa.y) + bflo(wb.y), bfhi(wa.y) + bfhi(wb.y), bflo(wa.z) + bflo(wb.z), bfhi(wa.z) + bfhi(wb.z), bflo(wa.w) + bflo(wb.w), bfhi(wa.w) + bfhi(wb.w)};
        float ss = 0.f;
#pragma unroll
        for (int i = 0; i < 8; ++i) ss += o[i] * o[i];
        ss = row16_sum(ss);
        const float rstd = 1.0f / sqrtf(ss * (1.0f / 128.0f) + EPS);
        const u32x4 wg = *(const u32x4*)(P + (size_t)m * NIN + PC_G + c0);
        const float g[8] = {bflo(wg.x), bfhi(wg.x), bflo(wg.y), bfhi(wg.y), bflo(wg.z), bfhi(wg.z), bflo(wg.w), bfhi(wg.w)};
        const f32x4 n0 = *(const f32x4*)(a->in[I_GLANORM] + l * 512 + c0), n1 = *(const f32x4*)(a->in[I_GLANORM] + l * 512 + c0 + 4);
        float r[8];
#pragma unroll
        for (int i = 0; i < 8; ++i) r[i] = o[i] * rstd * (i < 4 ? n0[i] : n1[i - 4]) * silu_f(g[i]);
        u32x4 w; w.x = pk2(r[0], r[1]); w.y = pk2(r[2], r[3]); w.z = pk2(r[4], r[5]); w.w = pk2(r[6], r[7]);
        *(u32x4*)(MIX + (size_t)m * D + c0) = w;
    }
}

constexpr int N2_W = 0, N2_H = 32768, N2_PART = 98304, N2_CNT = 132096, N2_RT = 20;
static_assert(N2_PART + 16384 <= RING_BYTES && N2_CNT + 256 + NWAVES * N2_RT * 16 <= LDS_BYTES && N2_CNT >= MISC_OFF + 64 + 128, "N2 LDS map");
__device__ __forceinline__ int n2_addr(int r, int k) { return r * 2048 + ((((k >> 3) ^ r) & 127) << 4) + (k & 7) * 2; }
__device__ __forceinline__ void n2_route_phase(const Frame& F, const CAS Args* a, int l, bool do_route, int cset) {
    unsigned char* ws = F.ws;
    const float* mod = (const float*)(ws + WS_MOD);
    bf16* H = (bf16*)(ws + WS_H);
    unsigned* cnt = (unsigned*)(ws + WS_CTL) + CW_CNT + cset * NE * CNT_STRIDE;
    unsigned* list = (unsigned*)(ws + WS_LIST); float* listw = (float*)(ws + WS_LISTW);
    LAS unsigned* lcnt = (LAS unsigned*)(F.lds + N2_CNT); LAS unsigned* lbase = lcnt + 16; LAS unsigned* rec = lcnt + 64;
    for (int i = F.tid; i < D * NE; i += NWAVES * 64) { const int e = i & 15, k = i >> 4; *(LAS bf16*)(F.lds + N2_W + n2_addr(e, k)) = (bf16)f2bf(a->in[I_WROUTER][i]); }
    if (F.tid < 32) lcnt[F.tid] = 0u;
    LDS_BARRIER();
    const int rows = (l == 0) ? TT : TL;
    const int t0 = F.gw;
    const int nch = (rows - F.vcu * NWAVES + F.NGW - 1) / F.NGW;
    f32x4 xc[4][4], xq[4][4];
#pragma unroll
    for (int q = 0; q < 4; ++q) { const int m = t0 + q * F.NGW;
        if (m < rows) { const float* xr = (const float*)(ws + WS_XC) + (size_t)(m - TL) * D;
#pragma unroll
            for (int j = 0; j < 4; ++j) xq[q][j] = m < TL ? ld_y4(F.xlb + (size_t)m * D + 4 * F.lane + 256 * j) : *(const f32x4*)(xr + 4 * F.lane + 256 * j); } }
    for (int c4 = 0; c4 < nch; c4 += 4) {
#pragma unroll
        for (int q = 0; q < 4; ++q)
#pragma unroll
            for (int j = 0; j < 4; ++j) xc[q][j] = xq[q][j];
#pragma unroll
        for (int q = 0; q < 4; ++q) { const int m = t0 + (c4 + 4 + q) * F.NGW;
            if (m < rows) { const float* xr = (const float*)(ws + WS_XC) + (size_t)(m - TL) * D;
#pragma unroll
                for (int j = 0; j < 4; ++j) xq[q][j] = m < TL ? ld_y4(F.xlb + (size_t)m * D + 4 * F.lane + 256 * j) : *(const f32x4*)(xr + 4 * F.lane + 256 * j); } }
#pragma unroll
        for (int q = 0; q < 4; ++q) {
            const int m = t0 + (c4 + q) * F.NGW, r = 8 * q + F.wave;
            if (m < rows) {
                const int v = m < TL ? (m >> 13) : 2;
                float ss = 0.f;
#pragma unroll
                for (int j = 0; j < 4; ++j) ss += (xc[q][j][0] * xc[q][j][0] + xc[q][j][1] * xc[q][j][1]) + (xc[q][j][2] * xc[q][j][2] + xc[q][j][3] * xc[q][j][3]);
                const float rstd = 1.0f / sqrtf(wave_sum(ss) * (1.0f / D) + EPS);
#pragma unroll
                for (int j = 0; j < 4; ++j) {
                    const int col = 4 * F.lane + 256 * j;
                    const f32x4 nw = *(const f32x4*)(a->in[I_NORM2] + l * D + col);
                    const f32x4 sh = *(const f32x4*)(mod + (l * 3 + v) * 6144 + 3 * D + col);
                    const f32x4 sc = *(const f32x4*)(mod + (l * 3 + v) * 6144 + 4 * D + col);
                    const f32x4 h = xc[q][j] * rstd * nw * (1.0f + sc) + sh;
                    *(unsigned*)((unsigned char*)H + (size_t)m * D + col) = pk4_fp8(h[0], h[1], h[2], h[3]);
                    u32x2 o; o.x = pk2(h[0], h[1]); o.y = pk2(h[2], h[3]);
                    *(LAS u32x2*)(F.lds + N2_H + n2_addr(r, col)) = o;
                }
            }
        }
        LDS_BARRIER();
        {
            const int rr = F.lane & 15, kg = F.lane >> 4;
            f32x4 acc0 = (f32x4){0.f, 0.f, 0.f, 0.f}, acc1 = acc0;
#pragma unroll
            for (int ks = 0; ks < 4; ++ks) {
                const int k = 128 * F.wave + 32 * ks + 8 * kg;
                const bf16x8 wf = *(const LAS bf16x8*)(F.lds + N2_W + n2_addr(rr, k));
                const bf16x8 h0 = *(const LAS bf16x8*)(F.lds + N2_H + n2_addr(rr, k)), h1 = *(const LAS bf16x8*)(F.lds + N2_H + n2_addr(16 + rr, k));
                acc0 = __builtin_amdgcn_mfma_f32_16x16x32_bf16(wf, h0, acc0, 0, 0, 0);
                acc1 = __builtin_amdgcn_mfma_f32_16x16x32_bf16(wf, h1, acc1, 0, 0, 0);
            }
            *(LAS f32x4*)(F.lds + N2_PART + ((F.wave * 32 + rr) * 16 + 4 * kg) * 4) = acc0;
            *(LAS f32x4*)(F.lds + N2_PART + ((F.wave * 32 + 16 + rr) * 16 + 4 * kg) * 4) = acc1;
        }
        LDS_BARRIER();
        if (F.wave < 2) {
            const int rr = F.lane & 15, eg = F.lane >> 4, row = 16 * F.wave + rr;
            f32x4 lg = (f32x4){0.f, 0.f, 0.f, 0.f};
#pragma unroll
            for (int w = 0; w < NWAVES; ++w) lg = lg + *(const LAS f32x4*)(F.lds + N2_PART + ((w * 32 + row) * 16 + 4 * eg) * 4);
            const f32x4 br = *(const f32x4*)(a->in[I_BROUTER] + 4 * eg);
            float sg[4], sb[4];
#pragma unroll
            for (int i = 0; i < 4; ++i) { sg[i] = 1.0f / (1.0f + __expf(-lg[i])); sb[i] = sg[i] + br[i]; }
            int i0 = 0, i1 = 0; float b0 = -1e30f, b1 = -1e30f, s0 = 0.f, s1 = 0.f;
#pragma unroll
            for (int i = 0; i < 4; ++i) { const float val = sb[i];
                if (val > b0) { b1 = b0; i1 = i0; s1 = s0; b0 = val; i0 = i; s0 = sg[i]; } else if (val > b1) { b1 = val; i1 = i; s1 = sg[i]; } }
            const float gs = b0 + b1;
            float best = gs; int bg = eg;
#pragma unroll
            for (int st = 16; st < 64; st <<= 1) {
                const float og = __builtin_bit_cast(float, __builtin_amdgcn_ds_bpermute((F.lane ^ st) << 2, __builtin_bit_cast(int, best)));
                const int oi = __builtin_amdgcn_ds_bpermute((F.lane ^ st) << 2, bg);
                if (og > best || (og == best && oi < bg)) { best = og; bg = oi; }
            }
            const int wv = row & 7, ch = c4 + (row >> 3);
            const int m = F.vcu * NWAVES + wv + ch * F.NGW;
            if (do_route && bg == eg && m < rows) {
                const int e0 = 4 * eg + i0, e1 = 4 * eg + i1; const float inv = 1.0f / (s0 + s1);
                if (ch < N2_RT) {
                    const int slot = wv * N2_RT + ch;
                    const unsigned l0 = atomicAdd((unsigned*)(lcnt + e0), 1u), l1 = atomicAdd((unsigned*)(lcnt + e1), 1u);
                    rec[slot * 4 + 0] = (unsigned)m; rec[slot * 4 + 1] = (unsigned)e0 | ((unsigned)e1 << 8) | (l0 << 16) | (l1 << 24);
                    rec[slot * 4 + 2] = __float_as_uint(s0 * inv); rec[slot * 4 + 3] = __float_as_uint(s1 * inv);
                } else {
                    const unsigned p0 = atomicAdd(cnt + e0 * CNT_STRIDE, 1u); list[(size_t)e0 * LISTCAP + p0] = (unsigned)m * 2u; listw[(size_t)e0 * LISTCAP + p0] = s0 * inv;
                    const unsigned p1 = atomicAdd(cnt + e1 * CNT_STRIDE, 1u); list[(size_t)e1 * LISTCAP + p1] = (unsigned)m * 2u + 1u; listw[(size_t)e1 * LISTCAP + p1] = s1 * inv;
                }
            }
        }
    }
    LDS_BARRIER();
    if (do_route) {
        if (F.tid < NE) { const unsigned c = lcnt[F.tid]; lbase[F.tid] = c ? atomicAdd(cnt + F.tid * CNT_STRIDE, c) : 0u; }
        LDS_BARRIER();
        for (int i = F.tid; i < NWAVES * N2_RT; i += NWAVES * 64) {
            const int wv = i / N2_RT, k = i % N2_RT;
            if (F.vcu * NWAVES + wv + k * F.NGW < rows) {
                const unsigned m = rec[i * 4], pk = rec[i * 4 + 1]; const unsigned e0 = pk & 255u, e1 = (pk >> 8) & 255u, l0 = (pk >> 16) & 255u, l1 = pk >> 24;
                const unsigned p0 = lbase[e0] + l0, p1 = lbase[e1] + l1;
                list[(size_t)e0 * LISTCAP + p0] = m * 2u; listw[(size_t)e0 * LISTCAP + p0] = __uint_as_float(rec[i * 4 + 2]);
                list[(size_t)e1 * LISTCAP + p1] = m * 2u + 1u; listw[(size_t)e1 * LISTCAP + p1] = __uint_as_float(rec[i * 4 + 3]);
            }
        }
    }
    LDS_BARRIER();
}

__device__ __forceinline__ void moe_setup(pg8::MoeOrder& S, const Frame& F, int cset, int nN) {
    unsigned* cnt = (unsigned*)(F.ws + WS_CTL) + CW_CNT + cset * NE * CNT_STRIDE;
    LAS int* tab = (LAS int*)(F.lds + MISC_OFF + 64);
    __syncthreads();
    if (F.tid == 0) { int run = 0;
        for (int e = 0; e < NE; ++e) { const int c = (int)__hip_atomic_load(cnt + e * CNT_STRIDE, __ATOMIC_RELAXED, __HIP_MEMORY_SCOPE_AGENT); tab[e] = c; run += (c + 255) >> 8; tab[16 + e] = run; } }
    __syncthreads();
    S.tab = tab; S.nN = nN; S.nunits = __builtin_amdgcn_readfirstlane(tab[31]) * nN; S.G = F.G; S.c = (int)blockIdx.x;
    S.tdone = (unsigned*)(F.ws + WS_CTL) + CW_TDONE + cset * 160 * 16; S.role = 0;
    S.list = (const unsigned*)(F.ws + WS_LIST);
}
__device__ __forceinline__ void moe1_phase(const Frame& F, const CAS Args* a, int l, int cset) {
    pg8::MoeOrder S; moe_setup(S, F, cset, 4);
    S.A = (const char*)(F.ws + WS_H); S.Bt = (const char*)(F.ws + WS_WGU) + (size_t)l * NE * D * D; S.K = D / 2; S.bstride_e = (size_t)D * D; S.gather = true; S.role = 1;
    EpiGU E{(bf16*)(F.ws + WS_HMID)};
    pg8::gemm_phase<EpiGU, pg8::MoeOrder, true>(F.lds, F.tid, S, E, SC_W1, SC_ONE);
}
__device__ __forceinline__ void moe2_phase(const Frame& F, const CAS Args* a, int l, int cset) {
    pg8::MoeOrder S; moe_setup(S, F, cset, 4);
    S.A = (const char*)(F.ws + WS_HMID); S.Bt = (const char*)(F.ws + WS_WD) + (size_t)l * NE * D * DE; S.K = DE / 2; S.bstride_e = (size_t)D * DE; S.gather = false; S.role = 2; S.c = F.G - 1 - (int)blockIdx.x;
    EpiDown E; E.Y = (bf16*)(F.ws + WS_Y); E.list = (const unsigned*)(F.ws + WS_LIST); E.listw = (const float*)(F.ws + WS_LISTW); E.tab = S.tab;
    pg8::gemm_phase<EpiDown, pg8::MoeOrder, true>(F.lds, F.tid, S, E, SC_W2, SC_HMID);
    if (l == 0 && cset == 0) convert_moe_filler(F, a, 1, S.nunits, true);
}

__device__ __forceinline__ void final_load(const Frame& F, int m, f32x4 (&x)[4]) {
    const float* mod = (const float*)(F.ws + WS_MOD);
    const bf16* Y0 = (const bf16*)(F.ws + WS_Y); const bf16* Y1 = Y0 + (size_t)TT * D;
    const int v = m >> 13; const bf16* xrow = F.xlb + (size_t)m * D;
#pragma unroll
    for (int j = 0; j < 4; ++j) {
        const int col = 4 * F.lane + 256 * j;
        const f32x4 g2 = *(const f32x4*)(mod + (3 + v) * 6144 + 5 * D + col);
        const f32x4 y = ld_y4(Y0 + (size_t)m * D + col) + ld_y4(Y1 + (size_t)m * D + col);
        x[j] = ld_y4(xrow + col) + g2 * y;
    }
}
__device__ __forceinline__ void final_row(const Frame& F, const CAS Args* a, int m, const f32x4 (&x)[4]) {
    float* xrow = F.out + (size_t)m * D; float ss = 0.f;
#pragma unroll
    for (int j = 0; j < 4; ++j) ss += (x[j][0] * x[j][0] + x[j][1] * x[j][1]) + (x[j][2] * x[j][2] + x[j][3] * x[j][3]);
    const float rstd = 1.0f / sqrtf(wave_sum(ss) * (1.0f / D) + EPS);
#pragma unroll
    for (int j = 0; j < 4; ++j) { const int col = 4 * F.lane + 256 * j; const f32x4 nw = *(const f32x4*)(a->in[I_FNORM] + col); *(f32x4*)(xrow + col) = x[j] * rstd * nw; }
}
__device__ __forceinline__ void final_phase(const Frame& F, const CAS Args* a) {
    for (int m = F.gw; m < TL; m += 2 * F.NGW) {
        const int m2 = m + F.NGW; const bool two = m2 < TL;
        f32x4 xa[4], xb[4];
        final_load(F, m, xa);
        if (two) final_load(F, m2, xb);
        final_row(F, a, m, xa);
        if (two) final_row(F, a, m2, xb);
    }
}

#ifndef NPASS
#define NPASS 1
#endif
#ifndef PROBE_PH
#define PROBE_PH -1
#endif
#ifndef PROBE_R
#define PROBE_R 3
#endif
#ifndef PROBE_UPTO
#define PROBE_UPTO -1
#endif
#ifndef PROBE_ABL
#define PROBE_ABL 0
#endif
constexpr int PH_PER_LAYER = 8;
constexpr int N_PHASES = 1 + DEPTH * PH_PER_LAYER + 1;

template <int ph0>
__device__ __forceinline__ void do_phase(Frame& F, XcdBarrier& bar, LAS unsigned char* lds, int lo, int hi) {
    constexpr int ph = ph0 % N_PHASES, pass = ph0 / N_PHASES;
    if (!(lo <= ph && ph < hi)) return;
    if (pass == 1 && (PROBE_UPTO >= 0 ? ph >= PROBE_UPTO : ph != PROBE_PH)) return;
    const CAS Args* ap;
        { int l_; asm volatile("v_mbcnt_lo_u32_b32 %0, -1, 0\n\tv_mbcnt_hi_u32_b32 %0, -1, %0" : "=v"(l_)); F.lane = l_; F.tid = F.wave * 64 + l_; ap = (const CAS Args*)__builtin_amdgcn_kernarg_segment_ptr(); asm volatile("" : "+s"(ap)); F.ws = ap->ws; F.out = (pass == 1) ? (float*)(ap->ws + WS_P) : ap->out; F.xlb = (bf16*)(ap->ws + ((pass == 1) ? WS_P + 64 * MiB : WS_XLB));
          LAS unsigned char* lb_ = (LAS unsigned char*)lds; asm volatile("" : "+s"(lb_)); __builtin_assume((((unsigned)(__UINTPTR_TYPE__)lb_) & 1023u) == 0u); F.lds = lb_;
          bar.bar = (unsigned*)(F.ws + WS_CTL) + CW_BAR; bar.st = (volatile LAS unsigned*)(F.lds + MISC_OFF) + 8; }
        if (ph == 0) { if (PH_ON(10)) REP(10, true) p0_prologue(F, ap); }
        else if (ph == N_PHASES - 1) { if (PH_ON(11)) REP(11, false) final_phase(F, ap); }
        else {
            const int l = (ph - 1) / PH_PER_LAYER, s = (ph - 1) % PH_PER_LAYER;
            unsigned char* ws = F.ws;
            if (s == 0) { if (PH_ON(0)) REP(0, l == 0) { n1_phase(F, ap, l); if (l == 0) p0_convert(F, ap); } }
            else if (s == 1 && PH_ON(1)) REP(1, true) {
                pg8::DenseOrder S; S.init(ws + WS_H, ws + WS_WIN + (size_t)l * NIN * D, TT, NIN, D / 2, F.G, (int)blockIdx.x);
                EpiIn E{(bf16*)(ws + WS_P), ap->in[I_BIASF] + l * 256, ap->in[I_BIASB] + l * 256, (const float*)(ws + WS_ROPE), (const float*)(ws + WS_ROPE) + 2048, (pass == 1) ? PROBE_ABL : 0};
                pg8::gemm_phase<EpiIn, pg8::DenseOrder, true>(F.lds, F.tid, S, E, SC_W1, SC_ONE, GIN_STAG);
            }
            else if (s == 2) { constexpr int abl = (pass == 1) ? PROBE_ABL : 0; if (PH_ON(2) && abl != 5) REP(2, true) swa_flash(F, ap, l, abl); if (PH_ON(12) && abl != 6) REP(12, true) gla_g1(F, l); }
            else if (s == 3) { if (PH_ON(13)) REP(13, true) gla_scan(F); }
            else if (s == 4) { if (PH_ON(3)) REP(3, true) gla_g3(F, ap, l); }
            else if (s == 5 && PH_ON(4)) REP(4, l == 0) {
                pg8::DenseOrder S; S.init(ws + WS_MIX, ws + WS_WOUT + (size_t)l * D * D, l == 0 ? TT : TL, D, D / 2, F.G, (int)blockIdx.x);
                EpiOut E{ap->in[I_X], l == 0 ? ap->in[I_CTX] : (const float*)(ws + WS_XC), F.xlb, (float*)(ws + WS_XC), (const float*)(ws + WS_MOD) + l * 3 * 6144, l > 0};
                pg8::gemm_phase<EpiOut, pg8::DenseOrder, true>(F.lds, F.tid, S, E, SC_W1, SC_HMID);
                if (l == 0 && pass == 0) convert_moe_filler(F, ap, 0, S.nwg);
            }
            else if (s == 6) { if (PH_ON(5)) REP(5, true) n2_route_phase(F, ap, l, rep_ == 0 || pass == 1, l + 2 * pass); }
            else { if (PH_ON(6)) { moe1_phase(F, ap, l, l + 2 * pass); moe2_phase(F, ap, l, l + 2 * pass); } }
        }
        if (ph0 + 1 < NPASS * N_PHASES) for (int rb_ = 0; rb_ < (REPEAT_S == 20 ? REPEAT_N : 1); ++rb_) xcd_barrier(bar, F.tid);
}
template <int... I>
__device__ __forceinline__ void run_all(Frame& F, XcdBarrier& bar, LAS unsigned char* lds, int lo, int hi, std::integer_sequence<int, I...>) { (do_phase<I>(F, bar, lds, lo, hi), ...); }

#ifdef VGPR_CAP
__attribute__((amdgpu_num_vgpr(VGPR_CAP)))
#endif
__global__ void __launch_bounds__(NWAVES * 64, 2) mk_fwd(Args args) {
    extern __shared__ __attribute__((aligned(16))) unsigned char lds[];
    Frame F;
    F.lds = (LAS unsigned char*)lds;
    F.tid = threadIdx.x; F.lane = F.tid & 63; F.wave = __builtin_amdgcn_readfirstlane(F.tid >> 6);
    F.G = gridDim.x; { const int bx = blockIdx.x; F.vcu = (F.G % 8 == 0) ? (bx % 8) * (F.G / 8) + bx / 8 : bx; }
    F.gw = F.vcu * NWAVES + F.wave; F.NGW = F.G * NWAVES;
    const CAS Args* ap = (const CAS Args*)__builtin_amdgcn_kernarg_segment_ptr();
    F.ws = ap->ws; F.out = ap->out; F.xlb = (bf16*)(ap->ws + WS_XLB);
    volatile LAS unsigned* MISC = (volatile LAS unsigned*)(F.lds + MISC_OFF);
    for (int u = F.tid; u < (LDS_BYTES - LDSCTL_OFF) / 4; u += NWAVES * 64) ((LAS unsigned*)(F.lds + LDSCTL_OFF))[u] = 0u;
    __syncthreads();
    XcdBarrier bar; bar.bar = (unsigned*)(F.ws + WS_CTL) + CW_BAR; bar.x = 0; bar.st = nullptr;
    const bool fused = (ap->ph_hi - ap->ph_lo) > 1;
    if (fused) bar = xcd_barrier_post((unsigned*)(F.ws + WS_CTL) + CW_BAR, MISC + 8);
    const int lo = ap->ph_lo, hi = ap->ph_hi;
    run_all(F, bar, (LAS unsigned char*)lds, lo, hi, std::make_integer_sequence<int, NPASS * N_PHASES>{});
}

extern "C" void kernel_launch(void* const* d_in, const int* in_sizes, int n_in, void* d_out, int out_size, void* d_ws, size_t ws_size, hipStream_t stream) {
    static int grid = 0;
    if (grid == 0) {
        if (n_in != 22 || out_size != TL * D || ws_size < WS_END) { fprintf(stderr, "kernel_launch: unexpected shapes (n_in %d out %d ws %zu)\n", n_in, out_size, ws_size); grid = -1; return; }
        int dev = 0, cus = 0, per_cu = 0;
        if (hipGetDevice(&dev) != hipSuccess || hipDeviceGetAttribute(&cus, hipDeviceAttributeMultiprocessorCount, dev) != hipSuccess) { grid = -1; return; }
        if (hipFuncSetAttribute((const void*)mk_fwd, hipFuncAttributeMaxDynamicSharedMemorySize, LDS_BYTES) != hipSuccess) { fprintf(stderr, "kernel_launch: hipFuncSetAttribute failed\n"); grid = -1; return; }
        if (hipOccupancyMaxActiveBlocksPerMultiprocessor(&per_cu, (const void*)mk_fwd, NWAVES * 64, LDS_BYTES) != hipSuccess || per_cu < 1) fprintf(stderr, "kernel_launch: occupancy query says %d\n", per_cu);
        (void)hipGetLastError();
        grid = cus;
    }
    if (grid < 0) return;
    (void)hipMemsetAsync((char*)d_ws + WS_CTL, 0, CTL_ZERO_BYTES, stream);
    Args a{};
    for (int i = 0; i < 22; ++i) a.in[i] = (const float*)d_in[i];
    a.out = (float*)d_out; a.ws = (unsigned char*)d_ws; a.li = 0; a.pad = 0;
#if MK_N_LAUNCHES == 1
    a.ph_lo = 0; a.ph_hi = N_PHASES;
    hipLaunchKernelGGL(mk_fwd, dim3(grid), dim3(NWAVES * 64), LDS_BYTES, stream, a);
#else
    for (int ph = 0; ph < N_PHASES; ++ph) { a.ph_lo = ph; a.ph_hi = ph + 1; hipLaunchKernelGGL(mk_fwd, dim3(grid), dim3(NWAVES * 64), LDS_BYTES, stream, a); }
#endif
}
```

```cpp
#include <hip/hip_runtime.h>
#include <cstdio>
#include <cstdint>
#include <utility>

#ifndef GIN_STAG
#define GIN_STAG 0
#endif
#ifndef ALIGN_EPI
#define ALIGN_EPI 1
#endif
#ifndef ONLY_S
#define ONLY_S -1
#endif
#define PH_ON(k) (ONLY_S < 0 || ONLY_S == (k))
#ifndef REPEAT_S
#define REPEAT_S -1
#endif
#ifndef REPEAT_N
#define REPEAT_N 4
#endif
#define REP(k, cond) for (int rep_ = 0; rep_ < ((pass == 1) ? PROBE_R : ((REPEAT_S == (k) && (cond)) ? REPEAT_N : 1)); ++rep_)
#ifndef MK_N_LAUNCHES
#define MK_N_LAUNCHES 1
#endif

#define GAS __attribute__((address_space(1)))
#define LAS __attribute__((address_space(3)))
#define CAS __attribute__((address_space(4)))
typedef unsigned short bf16;
typedef short bf16x8 __attribute__((ext_vector_type(8)));
typedef float f32x4 __attribute__((ext_vector_type(4)));
typedef float f32x2 __attribute__((ext_vector_type(2)));
typedef unsigned u32x4 __attribute__((ext_vector_type(4)));
typedef unsigned u32x2 __attribute__((ext_vector_type(2)));
typedef int v8i __attribute__((ext_vector_type(8)));

constexpr int D = 1024, SEQ = 8192, LC = 256, TL = 16384, TC = 512, TT = TL + TC, DEPTH = 2;
constexpr int NE = 16, DE = 512;
constexpr int NIN = 2816;
constexpr int PC_Q = 0, PC_K = 256, PC_V = 512, PC_G = 1024, PC_SQ = 1536, PC_SK = 2048, PC_SV = 2176, PC_GF = 2304, PC_GB = 2560;
constexpr int WIN_COLS = 2336;
constexpr float EPS = 1e-6f;
constexpr float LOG2E = 1.4426950408889634f, QSCALE = 0.125f * LOG2E;
constexpr int LISTCAP = TT;

constexpr size_t MiB = 1u << 20;
constexpr size_t WS_CTL = 0, CTL_ZERO_BYTES = 131072;
constexpr size_t WS_MOD = 1 * MiB;
constexpr size_t WS_ROPE = 1 * MiB + 256 * 1024;
constexpr size_t WS_LIST = 2 * MiB;
constexpr size_t WS_LISTW = 2 * MiB + 1536 * 1024;
constexpr size_t WS_XC = 5 * MiB;
constexpr size_t WS_WIN = 8 * MiB;
constexpr size_t WS_WOUT = 19 * MiB;
constexpr size_t WS_WGU = 23 * MiB;
constexpr size_t WS_WD = 87 * MiB;
constexpr size_t WS_XLB = 55 * MiB;
constexpr size_t WS_H = 119 * MiB;
constexpr size_t WS_P = 152 * MiB;
constexpr size_t WS_MIX = 243 * MiB;
constexpr size_t WS_GL = 276 * MiB;
constexpr size_t WS_HMID = 152 * MiB;
constexpr size_t WS_Y = 190 * MiB;
constexpr size_t WS_END = 309 * MiB;
static_assert(WS_LIST + (size_t)NE * LISTCAP * 4 <= WS_LISTW && WS_LISTW + (size_t)NE * LISTCAP * 4 <= WS_XC, "ws map");
static_assert(WS_P + (size_t)TT * NIN * 2 <= WS_MIX && WS_MIX + (size_t)TT * D * 2 <= WS_GL, "ws map");
static_assert(WS_HMID + (size_t)37888 * 512 * 2 <= WS_Y && WS_Y + (size_t)2 * TT * D * 2 <= WS_GL, "ws map");
constexpr int CW_CNT = 8192, CNT_STRIDE = 64;
constexpr int CW_TDONE = 16384;
constexpr int CW_BAR = 4096;

__device__ __forceinline__ unsigned f2bf(float f) { unsigned u = __builtin_bit_cast(unsigned, f); return (u + 0x7fffu + ((u >> 16) & 1u)) >> 16; }
__device__ __forceinline__ unsigned pk2(float lo, float hi) { return f2bf(lo) | (f2bf(hi) << 16); }
__device__ __forceinline__ float bf2f(unsigned h) { return __builtin_bit_cast(float, h << 16); }
__device__ __forceinline__ float bflo(unsigned w) { return __builtin_bit_cast(float, w << 16); }
__device__ __forceinline__ float bfhi(unsigned w) { return __builtin_bit_cast(float, w & 0xffff0000u); }
__device__ __forceinline__ float dpp_add(float v, float t) { return v + t; }
#define DPP_F(v, ctrl, rmask) __builtin_bit_cast(float, __builtin_amdgcn_update_dpp(0, __builtin_bit_cast(int, (v)), (ctrl), (rmask), 0xF, false))
__device__ __forceinline__ float row16_sum(float v) {
    v += DPP_F(v, 0xB1, 0xF); v += DPP_F(v, 0x4E, 0xF); v += DPP_F(v, 0x141, 0xF); v += DPP_F(v, 0x140, 0xF); return v;
}
__device__ __forceinline__ float wave_sum(float v) {
    v = row16_sum(v);
    v += DPP_F(v, 0x142, 0xA); v += DPP_F(v, 0x143, 0xC);
    return __builtin_bit_cast(float, __builtin_amdgcn_readlane(__builtin_bit_cast(int, v), 63));
}
__device__ __forceinline__ float silu_f(float x) { return x / (1.0f + __expf(-x)); }
__device__ __forceinline__ unsigned pk4_fp8(float a, float b, float c, float d) {
    a = fminf(fmaxf(a, -448.f), 448.f); b = fminf(fmaxf(b, -448.f), 448.f); c = fminf(fmaxf(c, -448.f), 448.f); d = fminf(fmaxf(d, -448.f), 448.f);
    int w = __builtin_amdgcn_cvt_pk_fp8_f32(a, b, 0, false); w = __builtin_amdgcn_cvt_pk_fp8_f32(c, d, w, true); return (unsigned)w;
}
constexpr float W1_SCALE = 64.f, W2_SCALE = 32.f, HMID_SCALE = 4.f, MIX_SCALE = 4.f;
constexpr int SC_ONE = 127, SC_W1 = 121, SC_W2 = 122, SC_HMID = 125;
#define LDS_BARRIER() asm volatile("s_waitcnt lgkmcnt(0)\n\ts_barrier" ::: "memory")
#define LDS_WAIT() asm volatile("s_waitcnt lgkmcnt(0)" ::: "memory")
#define VM_WAIT() asm volatile("s_waitcnt vmcnt(0)" ::: "memory")

namespace pg8 {
constexpr int BM = 256, BK = 64, HALF = 128, HTB = HALF * BK * 2, STAGE_BYTES = 8 * HTB, NXCD = 8, WGM = 8;
__host__ __device__ __forceinline__ int lds_byte(int r, int c) { const int st = (r >> 4) * 2 + (c >> 5), rr = r & 15, cc = c & 31, ob = rr * 64 + cc * 2; return st * 1024 + (ob ^ (((ob >> 9) & 1) << 5)); }
__host__ __device__ __forceinline__ void stage_rc(int b, int& R, int& C) { const int st = b / 1024, sb = b % 1024, swz = sb ^ (((sb >> 9) & 1) << 5); R = (st >> 1) * 16 + swz / 64; C = (st & 1) * 32 + (swz % 64) / 2; }
__host__ __device__ __forceinline__ int perm32(int rho) { const int n = rho >> 4, i = rho & 15; return 8 * (i >> 2) + 4 * n + (i & 3); }

struct Unit { int pm, pn, e, mt; };

__device__ __forceinline__ int xcd_remap(int wgid, int nwg) { const int q = nwg / NXCD, r = nwg % NXCD, xcd = wgid % NXCD, off = wgid / NXCD; return (xcd < r ? xcd * (q + 1) : r * (q + 1) + (xcd - r) * q) + off; }

struct DenseOrder {
    static constexpr bool DYN_A = false;
    const char* A; const char* Bt; int K; int nM, nN, nwg, G, c;
    __device__ void init(const void* A_, const void* Bt_, int M, int N, int K_, int G_, int c_) { A = (const char*)A_; Bt = (const char*)Bt_; K = K_; nM = M / BM; nN = N / BM; nwg = nM * nN; G = G_; c = c_; }
    __device__ __forceinline__ bool next(int i, Unit& u) const {
        const long L = (long)i * G + c; if (L >= nwg) return false;
        const int wgid = xcd_remap((int)L, nwg);
        const int nig = WGM * nN, gid = wgid / nig, fm = gid * WGM, gsz = (nM - fm) < WGM ? (nM - fm) : WGM;
        u.pm = fm + ((wgid % nig) % gsz); u.pn = (wgid % nig) / gsz; u.e = 0; u.mt = 0; return true;
    }
    __device__ __forceinline__ void a_ready(const Unit&, int) const {}
    __device__ __forceinline__ void done(const Unit&, int) const {}
    __device__ __forceinline__ const char* a_ptr(const Unit& u) const { return A + (size_t)u.pm * (size_t)(BM * K * 2); }
    __device__ __forceinline__ const char* b_ptr(const Unit& u) const { return Bt + (size_t)u.pn * (size_t)(BM * K * 2); }
    __device__ __forceinline__ void a_voff(const Unit&, const int (&R)[2], const int (&C)[2], unsigned (&v0)[2], unsigned (&v1)[2]) const {
#pragma unroll
        for (int i = 0; i < 2; ++i) { v0[i] = (unsigned)(R[i] * K + C[i]) * 2u; v1[i] = v0[i] + (unsigned)(HALF * K * 2); }
    }
};

struct MoeOrder {
    static constexpr bool DYN_A = true;
    const char* A; const char* Bt; int K; size_t bstride_e; int G, c, nunits, nN; bool gather;
    const unsigned* list; const LAS int* tab;
    unsigned* tdone; int role;
    __device__ __forceinline__ void a_ready(const Unit& u, int wid) const {
        if (role == 2) {
            if (wid == 0) { unsigned sp = 0;
                while (__hip_atomic_load(tdone + u.pm * 16, __ATOMIC_RELAXED, __HIP_MEMORY_SCOPE_AGENT) < 32u) { __builtin_amdgcn_s_sleep(2); if (++sp > (1u << 22)) break; }
                __builtin_amdgcn_fence(__ATOMIC_ACQUIRE, "agent"); asm volatile("s_waitcnt vmcnt(0)" ::: "memory"); }
            __builtin_amdgcn_s_barrier();
        }
    }
    __device__ __forceinline__ void done(const Unit& u, int lane) const {
        if (role == 1) { asm volatile("s_waitcnt vmcnt(0)" ::: "memory");
            if (lane == 0) __hip_atomic_fetch_add(tdone + u.pm * 16, 1u, __ATOMIC_RELAXED, __HIP_MEMORY_SCOPE_AGENT); }
    }
    __device__ __forceinline__ bool next(int i, Unit& u) const {
        const long L = (long)i * G + c; if (L >= nunits) return false;
        const int wgid = xcd_remap((int)L, nunits);
        const int tl = wgid / nN; u.pn = wgid % nN;
        int e = 0, tstart = 0;
#pragma unroll 1
        for (int k = 0; k < NE - 1; ++k) { const int te = tab[16 + k]; if (tl >= te) { e = k + 1; tstart = te; } }
        u.e = __builtin_amdgcn_readfirstlane(e); u.mt = __builtin_amdgcn_readfirstlane(tl - tstart); u.pm = tl; return true;
    }
    __device__ __forceinline__ const char* a_ptr(const Unit& u) const { return gather ? A : A + (size_t)u.pm * (size_t)(BM * K * 2); }
    __device__ __forceinline__ const char* b_ptr(const Unit& u) const { return Bt + (size_t)u.e * bstride_e + (size_t)u.pn * (size_t)(BM * K * 2); }
    __device__ __forceinline__ void a_voff(const Unit& u, const int (&R)[2], const int (&C)[2], unsigned (&v0)[2], unsigned (&v1)[2]) const {
        if (gather) {
            const int ce = tab[u.e];
            const unsigned* lp = list + (size_t)u.e * LISTCAP + u.mt * BM;
#pragma unroll
            for (int i = 0; i < 2; ++i) {
                const int r0 = R[i], r1 = R[i] + HALF;
                const unsigned t0 = (u.mt * BM + r0 < ce) ? (__builtin_nontemporal_load(lp + r0) >> 1) : 0u;
                const unsigned t1 = (u.mt * BM + r1 < ce) ? (__builtin_nontemporal_load(lp + r1) >> 1) : 0u;
                v0[i] = (t0 * (unsigned)K + (unsigned)C[i]) * 2u; v1[i] = (t1 * (unsigned)K + (unsigned)C[i]) * 2u;
            }
        } else {
#pragma unroll
            for (int i = 0; i < 2; ++i) { v0[i] = (unsigned)(R[i] * K + C[i]) * 2u; v1[i] = v0[i] + (unsigned)(HALF * K * 2); }
        }
    }
};

__device__ __forceinline__ unsigned cvt_pk_bf16(float lo, float hi) { unsigned r; asm volatile("v_cvt_pk_bf16_f32 %0, %1, %2" : "=v"(r) : "v"(lo), "v"(hi)); return r; }

template <class Epi, class Sched, bool F8 = false>
__device__ __forceinline__ void gemm_phase(LAS unsigned char* lds, int tid, const Sched& S, const Epi& E, int sc_w = 127, int sc_a = 127, int stag = 0) {
    if (stag) {
        const unsigned long long t0 = __builtin_amdgcn_s_memrealtime(), dl = (unsigned long long)((blockIdx.x >> 3) & 3) * (unsigned)stag;
        while (__builtin_amdgcn_s_memrealtime() - t0 < dl) __builtin_amdgcn_s_sleep(8);
    }
    const int wid = __builtin_amdgcn_readfirstlane(tid >> 6), lane = tid & 63, wr = wid >> 2, wc = wid & 3, fr = lane & 15, fq = lane >> 4;
    const int K = S.K, nt = K / BK;
    int Rr[2], Cc[2]; unsigned voffB[2];
#pragma unroll
    for (int i = 0; i < 2; ++i) { int R, C; stage_rc(tid * 16 + i * 8192, R, C); const int Rb = Epi::PERM ? ((R & ~31) + perm32(R & 31)) : R;
        Rr[i] = R; Cc[i] = C; voffB[i] = (unsigned)(Rb * K + C) * 2u; }
    const size_t kstep = (size_t)(BK * 2);
    const size_t hstep = (size_t)HALF * K * 2;
    const unsigned ldsw = (unsigned)wid * 1024u;
    const int aoff = lds_byte(wr * 64 + fr, fq * 8), boff = lds_byte(wc * 32 + fr, fq * 8);
#define PG8_SA(b, h) (((b) * 2 + (h)) * HTB)
#define PG8_SB(b, h) ((4 + (b) * 2 + (h)) * HTB)
#define PG8_STAGE(bufoff, gbase, voff) do { _Pragma("unroll") for (int _i = 0; _i < 2; ++_i) \
        __builtin_amdgcn_global_load_lds((const unsigned*)((const char*)(gbase) + (voff)[_i]), (LAS unsigned*)(lds + (bufoff) + ldsw + _i * 8192), 16, 0, 0); } while (0)
#define PG8_CAT(lo_, hi_) ((v8i){(int)(lo_).x, (int)(lo_).y, (int)(lo_).z, (int)(lo_).w, (int)(hi_).x, (int)(hi_).y, (int)(hi_).z, (int)(hi_).w})
#define PG8_LDA(dst, b, h) do { _Pragma("unroll") for (int m = 0; m < 4; ++m) { if constexpr (F8) { const u32x4 l_ = *(const LAS u32x4*)(lds + PG8_SA(b, h) + aoff + m * 2048), h_ = *(const LAS u32x4*)(lds + PG8_SA(b, h) + aoff + m * 2048 + 1024); dst##8[m] = PG8_CAT(l_, h_); } \
        else { _Pragma("unroll") for (int k = 0; k < 2; ++k) dst[m][k] = *(const LAS bf16x8*)(lds + PG8_SA(b, h) + aoff + m * 2048 + k * 1024); } } } while (0)
#define PG8_LDB(dst, b, h) do { _Pragma("unroll") for (int n = 0; n < 2; ++n) { if constexpr (F8) { const u32x4 l_ = *(const LAS u32x4*)(lds + PG8_SB(b, h) + boff + n * 2048), h_ = *(const LAS u32x4*)(lds + PG8_SB(b, h) + boff + n * 2048 + 1024); dst##8[n] = PG8_CAT(l_, h_); } \
        else { _Pragma("unroll") for (int k = 0; k < 2; ++k) dst[n][k] = *(const LAS bf16x8*)(lds + PG8_SB(b, h) + boff + n * 2048 + k * 1024); } } } while (0)
#define PG8_MMA(ai, bj, At, Bt) do { __builtin_amdgcn_s_setprio(1); _Pragma("unroll") for (int m = 0; m < 4; ++m) _Pragma("unroll") for (int n = 0; n < 2; ++n) { \
        if constexpr (F8) asm volatile("v_mfma_scale_f32_16x16x128_f8f6f4 %0, %1, %2, %0, %3, %4 op_sel_hi:[0,0,0]" : "+v"(acc[ai][bj][m][n]) : "v"(Bt##8[n]), "v"(At##8[m]), "v"(sc_w), "v"(sc_a)); \
        else { _Pragma("unroll") for (int k = 0; k < 2; ++k) acc[ai][bj][m][n] = __builtin_amdgcn_mfma_f32_16x16x32_bf16(Bt[n][k], At[m][k], acc[ai][bj][m][n], 0, 0, 0); } } \
        __builtin_amdgcn_s_setprio(0); } while (0)
#define PG8_WAIT_V(n) asm volatile("s_waitcnt vmcnt(" #n ")" ::: "memory")
#define PG8_WAIT_L(n) asm volatile("s_waitcnt lgkmcnt(" #n ")" ::: "memory")
#define PG8_BAR __builtin_amdgcn_s_barrier()
#define PG8_SCHED __builtin_amdgcn_sched_barrier(0)
    Unit cur, nxt; int ui = 0;
    if (!S.next(0, cur)) return;
    f32x4 acc[2][2][4][2];
#pragma unroll
    for (int a = 0; a < 2; ++a)
#pragma unroll
        for (int b = 0; b < 2; ++b)
#pragma unroll
            for (int m = 0; m < 4; ++m)
#pragma unroll
                for (int n = 0; n < 2; ++n) acc[a][b][m][n] = (f32x4){0.f, 0.f, 0.f, 0.f};
    bf16x8 At[4][2], B0[2][2], B1[2][2]; v8i At8[4], B08[2], B18[2];
    const char* cA = S.a_ptr(cur); const char* cB = S.b_ptr(cur);
    unsigned cv0[2], cv1[2], nv0[2], nv1[2];
    S.a_ready(cur, wid);
    S.a_voff(cur, Rr, Cc, cv0, cv1);
    PG8_STAGE(PG8_SB(0, 0), cB, voffB); PG8_STAGE(PG8_SB(0, 1), cB + hstep, voffB); PG8_STAGE(PG8_SA(0, 0), cA, cv0); PG8_STAGE(PG8_SA(0, 1), cA, cv1);
    if (wr == 1) PG8_BAR;
    PG8_WAIT_V(2); PG8_BAR;
    PG8_STAGE(PG8_SB(1, 0), cB + kstep, voffB); PG8_STAGE(PG8_SA(1, 0), cA + kstep, cv0); PG8_STAGE(PG8_SB(1, 1), cB + hstep + kstep, voffB);
    PG8_WAIT_V(6); PG8_BAR;
    for (;;) {
        const bool has_next = S.next(ui + 1, nxt);
        const char* nA = has_next ? S.a_ptr(nxt) : cA; const char* nB = has_next ? S.b_ptr(nxt) : cB;
        if (has_next) S.a_voff(nxt, Rr, Cc, nv0, nv1); else { nv0[0] = cv0[0]; nv0[1] = cv0[1]; nv1[0] = cv1[0]; nv1[1] = cv1[1]; }
        if constexpr (Sched::DYN_A) asm volatile("" : "+v"(nv0[0]), "+v"(nv0[1]), "+v"(nv1[0]), "+v"(nv1[1]));
        for (int t = 0; t < nt; t += 2) {
            const bool last = (t == nt - 2);
            if (last && has_next) S.a_ready(nxt, wid);
            const char* a1 = cA + (size_t)(t + 1) * kstep;
            const char* a2 = last ? nA : cA + (size_t)(t + 2) * kstep; const char* b2 = last ? nB : cB + (size_t)(t + 2) * kstep;
            const char* a3 = a2 + kstep; const char* b3 = b2 + kstep;
            unsigned w0[2], w1[2];
            w0[0] = last ? nv0[0] : cv0[0]; w0[1] = last ? nv0[1] : cv0[1]; w1[0] = last ? nv1[0] : cv1[0]; w1[1] = last ? nv1[1] : cv1[1];
            PG8_LDB(B0, 0, 0); PG8_LDB(B1, 0, 1); PG8_SCHED; PG8_LDA(At, 0, 0); PG8_STAGE(PG8_SA(1, 1), a1, cv1);
            PG8_WAIT_V(8); PG8_WAIT_L(0); PG8_BAR; PG8_MMA(0, 0, At, B0); PG8_MMA(0, 1, At, B1); PG8_BAR; PG8_SCHED;
            PG8_LDA(At, 0, 1); PG8_STAGE(PG8_SB(0, 0), b2, voffB); PG8_STAGE(PG8_SB(0, 1), b2 + hstep, voffB); PG8_STAGE(PG8_SA(0, 0), a2, w0);
            PG8_WAIT_V(8); PG8_WAIT_L(0); PG8_BAR; PG8_MMA(1, 0, At, B0); PG8_MMA(1, 1, At, B1); PG8_BAR; PG8_SCHED;
            PG8_LDB(B0, 1, 0); PG8_LDB(B1, 1, 1); PG8_SCHED; PG8_LDA(At, 1, 0); PG8_STAGE(PG8_SA(0, 1), a2, w1);
            PG8_WAIT_V(8); PG8_WAIT_L(0); PG8_BAR; PG8_MMA(0, 0, At, B0); PG8_MMA(0, 1, At, B1); PG8_BAR; PG8_SCHED;
            PG8_LDA(At, 1, 1); PG8_STAGE(PG8_SB(1, 0), b3, voffB); PG8_STAGE(PG8_SB(1, 1), b3 + hstep, voffB); PG8_STAGE(PG8_SA(1, 0), a3, w0);
            PG8_WAIT_V(8); PG8_WAIT_L(0); PG8_BAR; PG8_MMA(1, 0, At, B0); PG8_MMA(1, 1, At, B1); PG8_BAR; PG8_SCHED;
        }
        if constexpr (F8) asm volatile("s_nop 15\n\ts_nop 15" ::: "memory");
        if (ALIGN_EPI) { if (wr == 0) PG8_BAR; }
        E(acc, cur, wr, wc, fr, fq);
        S.done(cur, lane);
        if (!has_next) break;
#pragma unroll
        for (int a = 0; a < 2; ++a)
#pragma unroll
            for (int b = 0; b < 2; ++b)
#pragma unroll
                for (int m = 0; m < 4; ++m)
#pragma unroll
                    for (int n = 0; n < 2; ++n) acc[a][b][m][n] = (f32x4){0.f, 0.f, 0.f, 0.f};
        cur = nxt; cA = nA; cB = nB; ++ui;
        cv0[0] = nv0[0]; cv0[1] = nv0[1]; cv1[0] = nv1[0]; cv1[1] = nv1[1];
        if (ALIGN_EPI) { if (wr == 1) PG8_BAR; }
    }
    PG8_WAIT_V(0);
    if (!ALIGN_EPI) { if (wr == 0) PG8_BAR; }
    PG8_BAR;
#undef PG8_SA
#undef PG8_SB
#undef PG8_STAGE
#undef PG8_CAT
#undef PG8_LDA
#undef PG8_LDB
#undef PG8_MMA
#undef PG8_WAIT_V
#undef PG8_WAIT_L
#undef PG8_BAR
#undef PG8_SCHED
}
}

#define XB_TMO      128
#define XB_XCNT(j)  (256  + 64 * (j))
#define XB_XSUB(j)  (1280 + 64 * (j))
#define XB_XGEN(j)  (2304 + 64 * (j))
#define XB_TOP      3328
#define XB_TOPGEN   3392
#define XCD_BAR_WORDS 3456
#define XB_SPIN_CAP (1u << 18)
__device__ __forceinline__ unsigned xb_ld(unsigned* p)              { return __hip_atomic_load(p, __ATOMIC_RELAXED, __HIP_MEMORY_SCOPE_AGENT); }
__device__ __forceinline__ unsigned xb_add(unsigned* p, unsigned v) { return __hip_atomic_fetch_add(p, v, __ATOMIC_RELAXED, __HIP_MEMORY_SCOPE_AGENT); }
__device__ __forceinline__ unsigned xb_xcc_id() { return (unsigned)__builtin_amdgcn_s_getreg((3 << 11) | 20) & 0xFu; }
#define XB_SPIN(cond, bar) do { unsigned _sp = 0; while (cond) { __builtin_amdgcn_s_sleep(1); \
    if ((++_sp & 255u) == 0u) { if (xb_ld(&(bar)[XB_TMO])) break; if (_sp > XB_SPIN_CAP) { atomicAdd(&(bar)[XB_TMO], 1u); break; } } } } while (0)
struct XcdBarrier { unsigned* bar; unsigned x; volatile LAS unsigned* st; };
__device__ __forceinline__ XcdBarrier xcd_barrier_post(unsigned* bar, volatile LAS unsigned* st) {
    XcdBarrier b; b.bar = bar; b.x = xb_xcc_id(); b.st = st;
    if (threadIdx.x == 0) (void)xb_add(&bar[XB_XCNT(b.x)], 1u);
    return b;
}
__device__ __forceinline__ void xcd_barrier_complete(unsigned* bar, unsigned x, unsigned& nloc, unsigned& nx) {
    const unsigned G = gridDim.x * gridDim.y * gridDim.z;
    unsigned sum, cnt, mine, sp = 0u;
    for (;;) {
        sum = 0u; cnt = 0u; mine = 0u;
#pragma unroll
        for (unsigned j = 0; j < 16; ++j) { const unsigned c = xb_ld(&bar[XB_XCNT(j)]); sum += c; cnt += (c > 0u) ? 1u : 0u; mine = (j == x) ? c : mine; }
        if (sum == G) break;
        __builtin_amdgcn_s_sleep(1);
        if ((++sp & 255u) == 0u) { if (xb_ld(&bar[XB_TMO])) break; if (sp > XB_SPIN_CAP) { atomicAdd(&bar[XB_TMO], 1u); break; } }
    }
    nloc = mine > 0u ? mine : 1u; nx = cnt > 0u ? cnt : 1u;
}
__device__ __forceinline__ void xcd_barrier(const XcdBarrier& b, int tid) {
    asm volatile("s_waitcnt vmcnt(0)" ::: "memory");
    __syncthreads();
    if (tid == 0) {
        unsigned* bar = b.bar;
        __builtin_amdgcn_s_waitcnt(0);
        unsigned nloc = b.st[0], nx = b.st[1];
        if (nloc == 0u) { xcd_barrier_complete(bar, b.x, nloc, nx); b.st[0] = nloc; b.st[1] = nx; }
        const unsigned old = xb_add(&bar[XB_XSUB(b.x)], 1u);
        const unsigned gen = old / nloc;
        if (old + 1u == (gen + 1u) * nloc) {
            __builtin_amdgcn_fence(__ATOMIC_RELEASE, "agent");
            asm volatile("s_waitcnt vmcnt(0)" ::: "memory");
            const unsigned og = xb_add(&bar[XB_TOP], 1u);
            const unsigned tg = og / nx;
            if (og + 1u == (tg + 1u) * nx) xb_add(&bar[XB_TOPGEN], 1u);
            else XB_SPIN(xb_ld(&bar[XB_TOPGEN]) == tg, bar);
            __builtin_amdgcn_fence(__ATOMIC_ACQUIRE, "agent");
            xb_add(&bar[XB_XGEN(b.x)], 1u);
            asm volatile("s_waitcnt vmcnt(0)" ::: "memory");
        } else {
            XB_SPIN(xb_ld(&bar[XB_XGEN(b.x)]) == gen, bar);
            __builtin_amdgcn_fence(__ATOMIC_ACQUIRE, "agent");
            asm volatile("s_waitcnt vmcnt(0)" ::: "memory");
        }
    }
    __syncthreads();
}

constexpr int NWAVES = 8;
constexpr int RING_BYTES = 131072, LDSCTL_OFF = RING_BYTES, MISC_OFF = LDSCTL_OFF + 320, LDS_BYTES = 147456;
struct Args { const float* in[22]; float* out; unsigned char* ws; int ph_lo, ph_hi, li, pad; };
enum { I_X = 0, I_C, I_CTX, I_CCTX, I_WADA, I_BADA, I_NORM1, I_NORM2, I_WIN, I_UPF, I_BIASF, I_UPB, I_BIASB, I_GLANORM, I_SINK, I_WOUT, I_WROUTER, I_BROUTER, I_WGATE, I_WUP, I_WDOWN, I_FNORM };

struct Frame {
    LAS unsigned char* lds; int tid, lane, wave, vcu, G, gw, NGW;
    unsigned char* ws; float* out; bf16* xlb;
};

__device__ __forceinline__ int rope_pos(int d) { return 8 * ((d & 15) >> 2) + 4 * (d >> 4) + (d & 3); }
__device__ __forceinline__ int gu_row(int h, int gu) { return (h >> 7) * 256 + ((h >> 6) & 1) * 128 + ((h >> 4) & 3) * 32 + ((h >> 2) & 3) * 8 + gu * 4 + (h & 3); }
struct TItem { const float* src; bf16* dst; int N, Kd, n0, rbase, mode; bool ok; float f8scale; };
__device__ __forceinline__ void titem_load(const TItem& t, int lane, f32x4 (&v)[8]) {
    const int g = lane >> 3, i8 = lane & 7;
    const float* src = t.src + (size_t)(8 * g) * t.N + 4 * i8;
#pragma unroll
    for (int q = 0; q < 8; ++q) v[q] = *(const f32x4*)(src + (size_t)q * t.N);
}
__device__ __forceinline__ void titem_store(const TItem& t, int lane, const f32x4 (&v)[8]) {
    const int g = lane >> 3, i8 = lane & 7;
#pragma unroll
    for (int i = 0; i < 4; ++i) {
        const int n = 4 * i8 + i;
        const int row = (t.mode == 0) ? t.rbase + n : (t.mode == 1) ? t.rbase + rope_pos(n) : gu_row(t.n0 + n, t.mode - 2);
        if (t.f8scale != 0.f) {
            const float sc = t.f8scale; u32x2 o; o.x = pk4_fp8(v[0][i] * sc, v[1][i] * sc, v[2][i] * sc, v[3][i] * sc); o.y = pk4_fp8(v[4][i] * sc, v[5][i] * sc, v[6][i] * sc, v[7][i] * sc);
            *(u32x2*)((unsigned char*)t.dst + (size_t)row * t.Kd + 8 * g) = o;
        } else {
            u32x4 o; o.x = pk2(v[0][i], v[1][i]); o.y = pk2(v[2][i], v[3][i]); o.z = pk2(v[4][i], v[5][i]); o.w = pk2(v[6][i], v[7][i]);
            *(u32x4*)(t.dst + (size_t)row * t.Kd + 8 * g) = o;
        }
    }
}
constexpr int IT_IN = 2 * 16 * 73, IT_OUT = 2 * 16 * 32, IT_G = 32 * 16 * 16, IT_D = 32 * 8 * 32, NITEMS = IT_IN + IT_OUT + 2 * IT_G + IT_D;
__device__ __forceinline__ TItem titem_decode(const CAS Args* a, unsigned char* ws, int it) {
    TItem t; t.ok = it < NITEMS; t.mode = 0; t.rbase = 0; t.n0 = 0; t.N = D; t.Kd = D; t.src = nullptr; t.dst = nullptr; t.f8scale = 0.f;
    if (!t.ok) return t;
    int r = it;
    if (r < IT_IN) {
        const int l = r / 1168, rr = r % 1168, kb = rr / 73, nb = rr % 73;
        if (nb == 48) { t.ok = false; return t; }
        const int n0 = nb * 32; t.n0 = n0;
        if (n0 < 1536) t.rbase = n0;
        else if (n0 < 2080) { t.rbase = PC_SQ + (n0 - 1568); t.mode = 1; }
        else if (n0 < 2208) { t.rbase = PC_SK + (n0 - 2080); t.mode = 1; }
        else t.rbase = PC_SV + (n0 - 2208);
        t.N = WIN_COLS; t.Kd = D; t.src = a->in[I_WIN] + (size_t)l * D * WIN_COLS + (size_t)(kb * 64) * WIN_COLS + n0; t.dst = (bf16*)(ws + WS_WIN + (size_t)l * NIN * D + kb * 64); t.f8scale = W1_SCALE;
        return t;
    }
    r -= IT_IN;
    if (r < IT_OUT) { const int l = r / 512, rr = r % 512, kb = rr / 32, nb = rr % 32;
        t.n0 = nb * 32; t.rbase = nb * 32; t.N = D; t.Kd = D; t.src = a->in[I_WOUT] + (size_t)l * D * D + (size_t)(kb * 64) * D + nb * 32; t.dst = (bf16*)(ws + WS_WOUT + (size_t)l * D * D + kb * 64); t.f8scale = W1_SCALE; return t; }
    r -= IT_OUT;
    if (r < 2 * IT_G) { const int gu = r / IT_G, r2 = r % IT_G, le = r2 / 256, rr = r2 % 256, kb = rr / 16, nb = rr % 16;
        t.n0 = nb * 32; t.mode = 2 + gu; t.N = DE; t.Kd = D; t.src = a->in[gu ? I_WUP : I_WGATE] + (size_t)le * D * DE + (size_t)(kb * 64) * DE + nb * 32; t.dst = (bf16*)(ws + WS_WGU + (size_t)le * D * D + kb * 64); t.f8scale = W1_SCALE; return t; }
    r -= 2 * IT_G;
    { const int le = r / 256, rr = r % 256, kb = rr / 32, nb = rr % 32;
        t.n0 = nb * 32; t.rbase = nb * 32; t.N = D; t.Kd = DE; t.src = a->in[I_WDOWN] + (size_t)le * DE * D + (size_t)(kb * 64) * D + nb * 32; t.dst = (bf16*)(ws + WS_WD + (size_t)le * D * DE + kb * 64); t.f8scale = W2_SCALE; }
    return t;
}

template <class Map>
__device__ __forceinline__ void convert_items(const Frame& F, const CAS Args* a, int n, int worker, int nworkers, Map map) {
    unsigned char* ws = F.ws;
    for (int i = worker; i < n; i += 2 * nworkers) {
        const int i2 = i + nworkers;
        const TItem ta = titem_decode(a, ws, map(i)), tb = titem_decode(a, ws, i2 < n ? map(i2) : NITEMS);
        f32x4 va[8], vb[8];
        if (ta.ok) titem_load(ta, F.lane, va);
        if (tb.ok) titem_load(tb, F.lane, vb);
        if (ta.ok) titem_store(ta, F.lane, va);
        if (tb.ok) titem_store(tb, F.lane, vb);
    }
}
struct MapSmall { __device__ __forceinline__ int operator()(int i) const { return i; } };
struct MapMoe { int l; __device__ __forceinline__ int operator()(int i) const { const int kind = i >> 12, r = i & 4095; return IT_IN + IT_OUT + (kind < 2 ? kind * IT_G : 2 * IT_G) + l * 4096 + r; } };
__device__ __forceinline__ void convert_moe_filler(const Frame& F, const CAS Args* a, int l, int nunits, bool both = false) {
    const int c = (int)blockIdx.x, nfull = nunits % F.G;
    int first = nfull, nf = F.G - nfull - (both ? nfull : 0);
    if (nfull == 0 || nf <= 0) { first = 0; nf = F.G; }
    if (c < first || c >= first + nf) return;
    convert_items(F, a, 3 * 4096, (c - first) * NWAVES + F.wave, nf * NWAVES, MapMoe{l});
}

__device__ __forceinline__ void p0_convert(const Frame& F, const CAS Args* a) {
    unsigned char* ws = F.ws;
    convert_items(F, a, IT_IN + IT_OUT, F.gw, F.NGW, MapSmall{});
    for (int idx = F.gw * 64 + F.lane; idx < 2 * 2 * 256 * 128; idx += F.NGW * 64) {
        const int kc = idx & 127, n = (idx >> 7) & 255, dir = (idx >> 15) & 1, l = idx >> 16;
        const float* up = a->in[dir ? I_UPB : I_UPF] + (size_t)l * 16 * 256 + n;
        float u[16];
#pragma unroll
        for (int r = 0; r < 16; ++r) u[r] = up[r * 256];
        float o[8];
#pragma unroll
        for (int kk = 0; kk < 8; ++kk) {
            const f32x4* wz = (const f32x4*)(a->in[I_WIN] + ((size_t)l * D + kc * 8 + kk) * WIN_COLS + 1536 + dir * 16);
            float s = 0.f;
#pragma unroll
            for (int q = 0; q < 4; ++q) { const f32x4 w = wz[q]; s += w[0] * u[4 * q] + w[1] * u[4 * q + 1] + w[2] * u[4 * q + 2] + w[3] * u[4 * q + 3]; }
            o[kk] = s;
        }
        u32x2 ov; ov.x = pk4_fp8(o[0] * W1_SCALE, o[1] * W1_SCALE, o[2] * W1_SCALE, o[3] * W1_SCALE); ov.y = pk4_fp8(o[4] * W1_SCALE, o[5] * W1_SCALE, o[6] * W1_SCALE, o[7] * W1_SCALE);
        *(u32x2*)(ws + WS_WIN + ((size_t)l * NIN + PC_GF + dir * 256 + n) * D + kc * 8) = ov;
    }
}
__device__ __forceinline__ void p0_prologue(const Frame& F, const CAS Args* a) {
    unsigned char* ws = F.ws;
    if (blockIdx.x == (unsigned)(F.G - 1)) {
        float* tc = (float*)(ws + WS_ROPE); float* tsn = tc + 2048;
        for (int i = F.tid; i < 2048; i += NWAVES * 64) { const int pos = i >> 4, j = i & 15; const float inv = powf(10000.0f, -(float)j * (1.0f / 16.0f)); const float ang = (float)pos * inv;
            tc[i] = cosf(ang); tsn[i] = sinf(ang); }
    }
    __syncthreads();
    {
        LAS float* cs = (LAS float*)F.lds; LAS float* red = cs + 3072;
        for (int i = F.tid; i < 3072; i += NWAVES * 64) { const int v = i >> 10, k = i & 1023; const float cv = v < 2 ? a->in[I_C][v * D + k] : a->in[I_CCTX][k]; cs[i] = cv / (1.0f + expf(-cv)); }
        __syncthreads();
        for (int u = blockIdx.x; u < 192; u += F.G) {
            const int l = u / 96, jg = u % 96, jl = F.tid & 63, ks = F.tid >> 6;
            const float* wp = a->in[I_WADA] + ((size_t)l * D + ks * 128) * 6144 + jg * 64 + jl;
            float a0 = 0.f, a1 = 0.f, a2 = 0.f;
#pragma unroll 1
            for (int k0 = 0; k0 < 128; k0 += 32) {
                float wv[32];
#pragma unroll
                for (int k = 0; k < 32; ++k) wv[k] = wp[(size_t)(k0 + k) * 6144];
#pragma unroll
                for (int k = 0; k < 32; ++k) { const int kk = ks * 128 + k0 + k; a0 += cs[kk] * wv[k]; a1 += cs[1024 + kk] * wv[k]; a2 += cs[2048 + kk] * wv[k]; }
            }
            red[(ks * 3 + 0) * 64 + jl] = a0; red[(ks * 3 + 1) * 64 + jl] = a1; red[(ks * 3 + 2) * 64 + jl] = a2;
            __syncthreads();
            if (F.tid < 192) { const int v = F.tid >> 6, j2 = F.tid & 63; float s = 0.f;
#pragma unroll
                for (int q = 0; q < 8; ++q) s += red[(q * 3 + v) * 64 + j2];
                ((float*)(ws + WS_MOD))[(l * 3 + v) * 6144 + jg * 64 + j2] = s + a->in[I_BADA][l * 6144 + jg * 64 + j2]; }
            __syncthreads();
        }
    }
}

__device__ __forceinline__ f32x4 ld_y4(const bf16* p) { const u32x2 w = *(const u32x2*)p; return (f32x4){bflo(w.x), bfhi(w.x), bflo(w.y), bfhi(w.y)}; }
__device__ __forceinline__ void n1_load(const Frame& F, const CAS Args* a, int l, int m, f32x4 (&x)[4], f32x4 (&y)[4]) {
    unsigned char* ws = F.ws;
    const bf16* Y0 = (const bf16*)(ws + WS_Y); const bf16* Y1 = Y0 + (size_t)TT * D;
    const float* src = (l == 0) ? (m < TL ? a->in[I_X] + (size_t)m * D : a->in[I_CTX] + (size_t)(m - TL) * D) : (const float*)(ws + WS_XC) + (size_t)(m - TL) * D;
    const bool from_b = (l > 0) && (m < TL);
#pragma unroll
    for (int j = 0; j < 4; ++j) { const int col = 4 * F.lane + 256 * j; x[j] = from_b ? ld_y4(F.xlb + (size_t)m * D + col) : *(const f32x4*)(src + col);
        if (l > 0) y[j] = ld_y4(Y0 + (size_t)m * D + col) + ld_y4(Y1 + (size_t)m * D + col); }
}
__device__ __forceinline__ void n1_row(const Frame& F, const CAS Args* a, int l, int m, f32x4 (&x)[4], const f32x4 (&y)[4]) {
    unsigned char* ws = F.ws;
    const float* mod = (const float*)(ws + WS_MOD);
    bf16* H = (bf16*)(ws + WS_H);
    const int v = m < TL ? (m >> 13) : 2;
    float* xrow = (float*)(ws + WS_XC) + (size_t)(m - TL) * D;
    float ss = 0.f;
#pragma unroll
    for (int j = 0; j < 4; ++j) {
        const int col = 4 * F.lane + 256 * j;
        if (l > 0) { const f32x4 g2 = *(const f32x4*)(mod + ((l - 1) * 3 + v) * 6144 + 5 * D + col); x[j] = x[j] + g2 * y[j];
            if (m < TL) { u32x2 o; o.x = pk2(x[j][0], x[j][1]); o.y = pk2(x[j][2], x[j][3]); *(u32x2*)(F.xlb + (size_t)m * D + col) = o; } else *(f32x4*)(xrow + col) = x[j]; }
        ss += (x[j][0] * x[j][0] + x[j][1] * x[j][1]) + (x[j][2] * x[j][2] + x[j][3] * x[j][3]);
    }
    const float rstd = 1.0f / sqrtf(wave_sum(ss) * (1.0f / D) + EPS);
#pragma unroll
    for (int j = 0; j < 4; ++j) {
        const int col = 4 * F.lane + 256 * j;
        const f32x4 nw = *(const f32x4*)(a->in[I_NORM1] + l * D + col);
        const f32x4 sh = *(const f32x4*)(mod + (l * 3 + v) * 6144 + 0 * D + col);
        const f32x4 sc = *(const f32x4*)(mod + (l * 3 + v) * 6144 + 1 * D + col);
        const f32x4 h = x[j] * rstd * nw * (1.0f + sc) + sh;
        *(unsigned*)((unsigned char*)H + (size_t)m * D + col) = pk4_fp8(h[0], h[1], h[2], h[3]);
    }
}
__device__ __forceinline__ void n1_phase(const Frame& F, const CAS Args* a, int l) {
    for (int m = F.gw; m < TT; m += 2 * F.NGW) {
        const int m2 = m + F.NGW; const bool two = m2 < TT;
        f32x4 xa[4], ya[4], xb[4], yb[4];
        n1_load(F, a, l, m, xa, ya);
        if (two) n1_load(F, a, l, m2, xb, yb);
        n1_row(F, a, l, m, xa, ya);
        if (two) n1_row(F, a, l, m2, xb, yb);
    }
}

struct EpiIn {
    static constexpr bool PERM = true;
    bf16* P; const float* bias_f; const float* bias_b; const float* tcos; const float* tsin; int abl;
    template <int KIND>
    __device__ __forceinline__ void body(const f32x4 (&acc)[2][2][4][2], const pg8::Unit& u, int wr, int wc, int fr, int fq) const {
        const int row0 = u.pm * 256 + wr * 64 + fr, colw = wc * 32 + 8 * fq;
        f32x4 cs[4], sn[4], b0[2], b1[2];
        const bool wodd = (wc & 1) != 0;
        if (KIND == 3 || KIND == 5) {
            const int t0 = row0 & (SEQ - 1);
#pragma unroll
            for (int j = 0; j < 4; ++j) { const int pos = wodd ? ((t0 + 16 * j) & 63) : ((t0 + 128 * (j & 1)) >> 6);
                cs[j] = *(const f32x4*)(tcos + pos * 16 + 4 * fq); sn[j] = *(const f32x4*)(tsin + pos * 16 + 4 * fq); }
        }
        if (KIND == 2) {
#pragma unroll
            for (int bj = 0; bj < 2; ++bj) { const float* bp = (u.pn == 9 ? bias_f : bias_b) + colw + bj * 128; b0[bj] = *(const f32x4*)bp; b1[bj] = *(const f32x4*)(bp + 4); }
        }
#pragma unroll
        for (int ai = 0; ai < 2; ++ai)
#pragma unroll
            for (int m = 0; m < 4; ++m) {
                const int row = row0 + ai * 128 + m * 16;
                bf16* rowp = P + (size_t)row * NIN + u.pn * 256 + colw;
#pragma unroll
                for (int bj = 0; bj < 2; ++bj) {
                    f32x4 v0 = acc[ai][bj][m][0], v1 = acc[ai][bj][m][1];
                    if (KIND == 1) { v0 = v0 * 0.125f; v1 = v1 * 0.125f; }
                    if (KIND == 2) {
#pragma unroll
                        for (int i = 0; i < 4; ++i) { float x0 = v0[i] + b0[bj][i], x1 = v1[i] + b1[bj][i];
                            v0[i] = (fminf(x0, 0.f) - __logf(1.0f + __expf(-fabsf(x0)))) * 0.0625f; v1[i] = (fminf(x1, 0.f) - __logf(1.0f + __expf(-fabsf(x1)))) * 0.0625f; }
                    }
                    if (KIND == 3 || (KIND == 5 && bj == 0)) {
                        const f32x4 c = wodd ? cs[m] : cs[ai], sv = wodd ? sn[m] : sn[ai];
                        const f32x4 o0 = v0 * c - v1 * sv, o1 = v1 * c + v0 * sv; v0 = o0; v1 = o1;
                    }
                    if (KIND == 3 || KIND == 4) { v0 = v0 * QSCALE; v1 = v1 * QSCALE; }
                    u32x4 w; w.x = pg8::cvt_pk_bf16(v0[0], v0[1]); w.y = pg8::cvt_pk_bf16(v0[2], v0[3]); w.z = pg8::cvt_pk_bf16(v1[0], v1[1]); w.w = pg8::cvt_pk_bf16(v1[2], v1[3]);
                    *(u32x4*)(rowp + bj * 128) = w;
                }
            }
    }
    __device__ __forceinline__ void operator()(const f32x4 (&acc)[2][2][4][2], const pg8::Unit& u, int wr, int wc, int fr, int fq) const {
        const int pn = u.pn; const bool latent = u.pm < 64;
        if (pn == 0) body<1>(acc, u, wr, wc, fr, fq);
        else if (pn < 6) body<0>(acc, u, wr, wc, fr, fq);
        else if (pn < 8) { if (latent) body<3>(acc, u, wr, wc, fr, fq); else body<4>(acc, u, wr, wc, fr, fq); }
        else if (pn == 8) { if (latent) body<5>(acc, u, wr, wc, fr, fq); else body<0>(acc, u, wr, wc, fr, fq); }
        else body<2>(acc, u, wr, wc, fr, fq);
    }
};
struct EpiOut {
    static constexpr bool PERM = false;
    const float* resL; const float* resC; bf16* xlb; float* outC; const float* mod_l; bool res_b;
    __device__ __forceinline__ void operator()(const f32x4 (&acc)[2][2][4][2], const pg8::Unit& u, int wr, int wc, int fr, int fq) const {
        const bool latent = u.pm < 64;
        const int v = latent ? (u.pm >> 5) : 2;
        const int rowb = (latent ? u.pm * 256 : u.pm * 256 - TL) + wr * 64 + fr;
        const int col0 = u.pn * 256 + wc * 32 + 4 * fq;
        const float* g1p = mod_l + v * 6144 + 2 * D + col0;
        f32x4 g1[2][2];
#pragma unroll
        for (int bj = 0; bj < 2; ++bj)
#pragma unroll
            for (int n = 0; n < 2; ++n) g1[bj][n] = *(const f32x4*)(g1p + bj * 128 + n * 16);
        const bool rb = latent && res_b;
        const float* res = latent ? resL : resC;
#pragma unroll
        for (int ai = 0; ai < 2; ++ai)
#pragma unroll
            for (int mp = 0; mp < 4; mp += 2) {
                f32x4 r[2][2][2];
#pragma unroll
                for (int m = 0; m < 2; ++m) { const size_t off = (size_t)(rowb + ai * 128 + (mp + m) * 16) * D + col0;
#pragma unroll
                    for (int bj = 0; bj < 2; ++bj)
#pragma unroll
                        for (int n = 0; n < 2; ++n) r[m][bj][n] = rb ? ld_y4(xlb + off + bj * 128 + n * 16) : *(const f32x4*)(res + off + bj * 128 + n * 16); }
#pragma unroll
                for (int m = 0; m < 2; ++m) { const size_t off = (size_t)(rowb + ai * 128 + (mp + m) * 16) * D + col0;
#pragma unroll
                    for (int bj = 0; bj < 2; ++bj)
#pragma unroll
                        for (int n = 0; n < 2; ++n) { const f32x4 o = r[m][bj][n] + g1[bj][n] * acc[ai][bj][mp + m][n];
                            if (latent) { u32x2 w; w.x = pk2(o[0], o[1]); w.y = pk2(o[2], o[3]); *(u32x2*)(xlb + off + bj * 128 + n * 16) = w; }
                            else *(f32x4*)(outC + off + bj * 128 + n * 16) = o; } }
                asm volatile("" ::: "memory");
            }
    }
};
struct EpiGU {
    static constexpr bool PERM = true;
    bf16* Hmid;
    __device__ __forceinline__ void operator()(const f32x4 (&acc)[2][2][4][2], const pg8::Unit& u, int wr, int wc, int fr, int fq) const {
        const int row0 = u.pm * 256 + wr * 64 + fr, hid0 = u.pn * 128 + wc * 16 + fq * 4;
#pragma unroll
        for (int ai = 0; ai < 2; ++ai)
#pragma unroll
            for (int m = 0; m < 4; ++m) {
                unsigned char* rowp = (unsigned char*)Hmid + (size_t)(row0 + ai * 128 + m * 16) * DE + hid0;
#pragma unroll
                for (int bj = 0; bj < 2; ++bj) {
                    const f32x4 g = acc[ai][bj][m][0], up = acc[ai][bj][m][1]; f32x4 o;
#pragma unroll
                    for (int i = 0; i < 4; ++i) o[i] = g[i] * __builtin_amdgcn_rcpf(1.0f + __expf(-g[i])) * up[i];
                    __hip_atomic_store((unsigned*)(rowp + bj * 64), pk4_fp8(o[0] * HMID_SCALE, o[1] * HMID_SCALE, o[2] * HMID_SCALE, o[3] * HMID_SCALE), __ATOMIC_RELAXED, __HIP_MEMORY_SCOPE_AGENT);
                }
            }
    }
};
struct EpiDown {
    static constexpr bool PERM = true;
    bf16* Y; const unsigned* list; const float* listw; const LAS int* tab;
    __device__ __forceinline__ void operator()(const f32x4 (&acc)[2][2][4][2], const pg8::Unit& u, int wr, int wc, int fr, int fq) const {
        const int ce = tab[u.e];
        const int r0 = u.mt * 256 + wr * 64 + fr, col0 = u.pn * 256 + wc * 32 + 8 * fq;
        const unsigned* lp = list + (size_t)u.e * LISTCAP; const float* lw = listw + (size_t)u.e * LISTCAP;
        unsigned tsv[2][4]; float wv[2][4];
#pragma unroll
        for (int ai = 0; ai < 2; ++ai)
#pragma unroll
            for (int m = 0; m < 4; ++m) { const int r = r0 + ai * 128 + m * 16; const bool ok = r < ce; tsv[ai][m] = ok ? __builtin_nontemporal_load(lp + r) : 0xffffffffu; wv[ai][m] = ok ? __builtin_nontemporal_load(lw + r) : 0.f; }
#pragma unroll
        for (int ai = 0; ai < 2; ++ai)
#pragma unroll
            for (int m = 0; m < 4; ++m) {
                const unsigned ts = tsv[ai][m]; const float w = wv[ai][m];
                if (ts != 0xffffffffu) {
                    bf16* rowp = Y + ((size_t)(ts & 1u) * TT + (ts >> 1)) * D + col0;
#pragma unroll
                    for (int bj = 0; bj < 2; ++bj) {
                        const f32x4 v0 = acc[ai][bj][m][0] * w, v1 = acc[ai][bj][m][1] * w;
                        u32x4 o; o.x = pg8::cvt_pk_bf16(v0[0], v0[1]); o.y = pg8::cvt_pk_bf16(v0[2], v0[3]); o.z = pg8::cvt_pk_bf16(v1[0], v1[1]); o.w = pg8::cvt_pk_bf16(v1[2], v1[3]);
                        *(u32x4*)(rowp + bj * 128) = o;
                    }
                }
            }
    }
};

__device__ __forceinline__ void swa_naive(const Frame& F, const CAS Args* a, int l) {
    const bf16* P = (const bf16*)(F.ws + WS_P); bf16* MIX = (bf16*)(F.ws + WS_MIX);
    const int total = (l == 0 ? TT : TL) * 8;
    for (int idx = F.gw * 64 + F.lane; idx < total; idx += F.NGW * 64) {
        const int m = idx >> 3, hq = idx & 7, kvh = hq >> 2;
        const bool latent = m < TL;
        const int b = latent ? (m >> 13) : ((m - TL) >> 8), t = m & (SEQ - 1);
        float q[64];
        { const u32x4* qp = (const u32x4*)(P + (size_t)m * NIN + PC_SQ + hq * 64);
#pragma unroll
          for (int c = 0; c < 8; ++c) { const u32x4 w = qp[c]; q[8 * c] = bflo(w.x); q[8 * c + 1] = bfhi(w.x); q[8 * c + 2] = bflo(w.y); q[8 * c + 3] = bfhi(w.y);
              q[8 * c + 4] = bflo(w.z); q[8 * c + 5] = bfhi(w.z); q[8 * c + 6] = bflo(w.w); q[8 * c + 7] = bfhi(w.w); } }
        float o[64];
#pragma unroll
        for (int d = 0; d < 64; ++d) o[d] = 0.f;
        const float sink = a->in[I_SINK][l * 8 + hq] * LOG2E;
        float mx = sink, den = 1.0f;
        const int lo = latent ? (t - 128 < 0 ? 0 : t - 128) : 0, hi = latent ? (t + 128 > SEQ - 1 ? SEQ - 1 : t + 128) : -1;
        const int nloc = hi - lo + 1;
        for (int kk = 0; kk < nloc + LC; ++kk) {
            const int krow = kk < nloc ? b * SEQ + lo + kk : TL + b * LC + (kk - nloc);
            const u32x4* kp = (const u32x4*)(P + (size_t)krow * NIN + PC_SK + kvh * 64);
            float s = 0.f;
#pragma unroll
            for (int c = 0; c < 8; ++c) { const u32x4 w = kp[c]; s += q[8 * c] * bflo(w.x) + q[8 * c + 1] * bfhi(w.x) + q[8 * c + 2] * bflo(w.y) + q[8 * c + 3] * bfhi(w.y)
                + q[8 * c + 4] * bflo(w.z) + q[8 * c + 5] * bfhi(w.z) + q[8 * c + 6] * bflo(w.w) + q[8 * c + 7] * bfhi(w.w); }
            const float mn = fmaxf(mx, s), f = exp2f(mx - mn), p = exp2f(s - mn);
            den = den * f + p; mx = mn;
            const u32x4* vp = (const u32x4*)(P + (size_t)krow * NIN + PC_SV + kvh * 64);
#pragma unroll
            for (int c = 0; c < 8; ++c) { const u32x4 w = vp[c];
                o[8 * c] = o[8 * c] * f + p * bflo(w.x); o[8 * c + 1] = o[8 * c + 1] * f + p * bfhi(w.x); o[8 * c + 2] = o[8 * c + 2] * f + p * bflo(w.y); o[8 * c + 3] = o[8 * c + 3] * f + p * bfhi(w.y);
                o[8 * c + 4] = o[8 * c + 4] * f + p * bflo(w.z); o[8 * c + 5] = o[8 * c + 5] * f + p * bfhi(w.z); o[8 * c + 6] = o[8 * c + 6] * f + p * bflo(w.w); o[8 * c + 7] = o[8 * c + 7] * f + p * bfhi(w.w); }
        }
        const float inv = 1.0f / den;
        u32x4* op = (u32x4*)(MIX + (size_t)m * D + 512 + hq * 64);
#pragma unroll
        for (int c = 0; c < 8; ++c) { u32x4 w; w.x = pk2(o[8 * c] * inv, o[8 * c + 1] * inv); w.y = pk2(o[8 * c + 2] * inv, o[8 * c + 3] * inv); w.z = pk2(o[8 * c + 4] * inv, o[8 * c + 5] * inv); w.w = pk2(o[8 * c + 6] * inv, o[8 * c + 7] * inv); op[c] = w; }
    }
}


typedef float f32x16 __attribute__((ext_vector_type(16)));
typedef short s16x4 __attribute__((ext_vector_type(4)));
__device__ __forceinline__ int crow(int r, int hi) { return (r & 3) + 8 * (r >> 2) + 4 * hi; }
__device__ __forceinline__ s16x4 vtr(const LAS unsigned char* p) { return __builtin_bit_cast(s16x4, __builtin_amdgcn_ds_read_tr16_b64_v4i16((LAS s16x4*)p)); }
constexpr int SWA_K = 0, SWA_V = 49152;
__device__ __forceinline__ void swa_kload(const LAS unsigned char* Kt, int kb, int lane, bf16x8 (&kf)[4]) {
    const int r32 = lane & 31, hi = lane >> 5;
#pragma unroll
    for (int d0 = 0; d0 < 4; ++d0) kf[d0] = *(const LAS bf16x8*)(Kt + (2 * d0 + hi) * 1024 + (32 * kb + r32) * 16);
}
__device__ __forceinline__ void swa_tile(const LAS unsigned char* Kt, const LAS unsigned char* Vt, const LAS unsigned char* Kn, int mtype, const bf16x8 (&qf)[2][4], f32x16 (&o)[2][2], float (&mrun)[2], float (&lrun)[2], int lane, int abl = 0) {
    const int r32 = lane & 31, hi = lane >> 5; bf16x8 kf[4]; (void)Kn;
    const LAS unsigned char* vp = Vt + ((lane >> 4) & 1) * 32 + (lane & 3) * 8 + (4 * hi + ((lane & 15) >> 2)) * 64;
#pragma unroll
    for (int kb = 0; kb < 2; ++kb) {
        f32x16 s[2];
        swa_kload(Kt, kb, lane, kf);
#pragma unroll
        for (int d0 = 0; d0 < 4; ++d0)
#pragma unroll
            for (int qt = 0; qt < 2; ++qt) {
                if (d0 == 0) { f32x16 z;
#pragma unroll
                    for (int r = 0; r < 16; ++r) z[r] = 0.f;
                    s[qt] = __builtin_amdgcn_mfma_f32_32x32x16_bf16(kf[0], qf[qt][0], z, 0, 0, 0); }
                else if (abl != 4) s[qt] = __builtin_amdgcn_mfma_f32_32x32x16_bf16(kf[d0], qf[qt][d0], s[qt], 0, 0, 0);
            }
        __builtin_amdgcn_sched_barrier(0);
        s16x4 vlo[2][2], vhi[2][2];
#pragma unroll
        for (int dt = 0; dt < 2; ++dt)
#pragma unroll
            for (int sp = 0; sp < 2; ++sp) { vlo[dt][sp] = vtr(vp + dt * 4096 + (2 * kb + sp) * 1024); vhi[dt][sp] = vtr(vp + dt * 4096 + (2 * kb + sp) * 1024 + 512); }
        __builtin_amdgcn_sched_barrier(0);
        bf16x8 pf[2][2];
#pragma unroll
        for (int qt = 0; qt < 2; ++qt) {
            if (mtype != 0) {
                int thr = r32 + 32 * qt - 4 * hi - 32 * kb; asm volatile("" : "+v"(thr));
                if (mtype == 1) {
#pragma unroll
                    for (int r = 0; r < 16; ++r) { const int cc = (r & 3) + 8 * (r >> 2); if (cc < thr) s[qt][r] = -INFINITY; }
                } else {
#pragma unroll
                    for (int r = 0; r < 16; ++r) { const int cc = (r & 3) + 8 * (r >> 2); if (cc > thr) s[qt][r] = -INFINITY; }
                }
            }
            float rm = s[qt][0];
            if (abl != 1) {
#pragma unroll
            for (int r = 1; r < 16; ++r) rm = fmaxf(rm, s[qt][r]);
            }
            { auto rr = __builtin_amdgcn_permlane32_swap(__float_as_uint(rm), __float_as_uint(rm), false, false); rm = fmaxf(__uint_as_float(rr[0]), __uint_as_float(rr[1])); }
            const float mn = fmaxf(mrun[qt], rm);
            if (__any(mn > mrun[qt])) {
                const float alpha = __builtin_amdgcn_exp2f(mrun[qt] - mn);
                lrun[qt] *= alpha;
#pragma unroll
                for (int dt = 0; dt < 2; ++dt)
#pragma unroll
                    for (int r = 0; r < 16; ++r) o[dt][qt][r] *= alpha;
                mrun[qt] = mn;
            }
            float rs = 0.f;
            if (abl != 1) {
#pragma unroll
            for (int r = 0; r < 16; ++r) { const float p = __builtin_amdgcn_exp2f(s[qt][r] - mn); s[qt][r] = p; rs += p; }
            }
            lrun[qt] += rs;
#pragma unroll
            for (int sp = 0; sp < 2; ++sp) {
                u32x4 w; w.x = pg8::cvt_pk_bf16(s[qt][8 * sp + 0], s[qt][8 * sp + 1]); w.y = pg8::cvt_pk_bf16(s[qt][8 * sp + 2], s[qt][8 * sp + 3]);
                w.z = pg8::cvt_pk_bf16(s[qt][8 * sp + 4], s[qt][8 * sp + 5]); w.w = pg8::cvt_pk_bf16(s[qt][8 * sp + 6], s[qt][8 * sp + 7]);
                pf[qt][sp] = __builtin_bit_cast(bf16x8, w);
            }
        }
#pragma unroll
        for (int dt = 0; dt < 2; ++dt)
#pragma unroll
            for (int sp = 0; sp < 2; ++sp) {
                const bf16x8 vf = (bf16x8){vlo[dt][sp][0], vlo[dt][sp][1], vlo[dt][sp][2], vlo[dt][sp][3], vhi[dt][sp][0], vhi[dt][sp][1], vhi[dt][sp][2], vhi[dt][sp][3]};
#pragma unroll
                for (int qt = 0; qt < 2; ++qt) if (abl != 2) o[dt][qt] = __builtin_amdgcn_mfma_f32_32x32x16_bf16(vf, pf[qt][sp], o[dt][qt], 0, 0, 0);
            }
    }
}
__device__ __forceinline__ void swa_stage(const Frame& F, const bf16* P, int grow, int kvh, int ti) {
    { const int key = 8 * F.wave + (F.lane & 7), ch = F.lane >> 3;
      const u32x4 v = *(const u32x4*)(P + (size_t)(grow + key) * NIN + PC_SK + kvh * 64 + ch * 8);
      *(LAS u32x4*)(F.lds + SWA_K + ti * 8192 + ch * 1024 + key * 16) = v; }
    { const int key = 8 * F.wave + (F.lane >> 3), ch = F.lane & 7;
      const u32x4 v = *(const u32x4*)(P + (size_t)(grow + key) * NIN + PC_SV + kvh * 64 + ch * 8);
      *(LAS u32x4*)(F.lds + SWA_V + ti * 8192 + (ch >> 2) * 4096 + key * 64 + (ch & 3) * 16) = v; }
}
__device__ __forceinline__ void swa_flash(const Frame& F, const CAS Args* a, int l, int abl = 0) {
    const bf16* P = (const bf16*)(F.ws + WS_P); bf16* MIX = (bf16*)(F.ws + WS_MIX);
    const int nunits = 256 + (l == 0 ? 8 : 0);
    const int lane = F.lane, r32 = lane & 31, hi = lane >> 5;
    for (int u = F.vcu; u < nunits; u += F.G) {
        const bool latent = u < 256;
        const int b = latent ? (u >> 7) : ((u - 256) >> 2), kvh = latent ? ((u >> 6) & 1) : (((u - 256) >> 1) & 1), qb = latent ? (u & 63) : ((u - 256) & 1);
        const int q0 = qb * 128, g = F.wave >> 1, qs = F.wave & 1, hq = kvh * 4 + g;
        const int mrow0 = (latent ? b * SEQ : TL + b * LC) + q0 + 64 * qs;
        bf16x8 qf[2][4];
#pragma unroll
        for (int qt = 0; qt < 2; ++qt)
#pragma unroll
            for (int d0 = 0; d0 < 4; ++d0) { if (abl != 7) qf[qt][d0] = *(const bf16x8*)(P + (size_t)(mrow0 + 32 * qt + r32) * NIN + PC_SQ + hq * 64 + 16 * d0 + 8 * hi); else qf[qt][d0] = (bf16x8){(short)lane, 1, 2, 3, 4, 5, 6, 7}; }
        f32x16 o[2][2];
#pragma unroll
        for (int dt = 0; dt < 2; ++dt)
#pragma unroll
            for (int qt = 0; qt < 2; ++qt)
#pragma unroll
                for (int r = 0; r < 16; ++r) o[dt][qt][r] = 0.f;
        const float sink2 = a->in[I_SINK][l * 8 + hq] * LOG2E;
        float mrun[2] = {sink2, sink2}, lrun[2] = {hi == 0 ? 1.f : 0.f, hi == 0 ? 1.f : 0.f};
        if (latent) {
#pragma unroll 1
            for (int j = 0; j < 6; ++j) { const int ks = q0 - 128 + 64 * j; if (ks >= 0 && ks < SEQ && abl != 3) swa_stage(F, P, b * SEQ + ks, kvh, j); }
            LDS_BARRIER();
            { int jf = qs; while (q0 - 128 + 64 * jf < 0) ++jf;
              (void)jf;
#pragma unroll 1
              for (int tt = 0; tt < 5; ++tt) { const int j = qs + tt, ks = q0 - 128 + 64 * j;
                  if (ks >= 0 && ks < SEQ && abl != 8) { const int jn = (j + 1 < 6) ? j + 1 : j;
                      swa_tile(F.lds + SWA_K + j * 8192, F.lds + SWA_V + j * 8192, F.lds + SWA_K + jn * 8192, tt == 0 ? 1 : (tt == 4 ? 2 : 0), qf, o, mrun, lrun, lane, abl); } } }
            LDS_BARRIER();
        }
#pragma unroll 1
        for (int j = 0; j < 4; ++j) if (abl != 3) swa_stage(F, P, TL + b * LC + 64 * j, kvh, j);
        LDS_BARRIER();
        {
#pragma unroll 1
          for (int j = 0; j < 4; ++j) if (abl != 8) swa_tile(F.lds + SWA_K + j * 8192, F.lds + SWA_V + j * 8192, F.lds + SWA_K + (j < 3 ? j + 1 : j) * 8192, 0, qf, o, mrun, lrun, lane, abl); }
        LDS_BARRIER();
        LAS unsigned char* stg = F.lds + F.wave * 4096;
#pragma unroll
        for (int qt = 0; qt < 2; ++qt) {
            float lt = lrun[qt];
            { auto rr = __builtin_amdgcn_permlane32_swap(__float_as_uint(lt), __float_as_uint(lt), false, false); lt = __uint_as_float(rr[0]) + __uint_as_float(rr[1]); }
            const float is = MIX_SCALE / lt;
#pragma unroll
            for (int dt = 0; dt < 2; ++dt)
#pragma unroll
                for (int rg = 0; rg < 4; ++rg)
                    *(LAS unsigned*)(stg + (32 * qt + r32) * 64 + 32 * dt + 8 * rg + 4 * hi) = pk4_fp8(o[dt][qt][4 * rg] * is, o[dt][qt][4 * rg + 1] * is, o[dt][qt][4 * rg + 2] * is, o[dt][qt][4 * rg + 3] * is);
        }
        LDS_WAIT();
        if (abl != 7) {
            int le = lane; asm volatile("" : "+v"(le));
#pragma unroll
            for (int i = 0; i < 4; ++i) { const int row = 16 * i + (le >> 2), ch = le & 3;
                const u32x4 v = *(const LAS u32x4*)(stg + row * 64 + ch * 16);
                *(u32x4*)((unsigned char*)MIX + (size_t)(mrow0 + row) * D + 512 + hq * 64 + ch * 16) = v; }
        }
        LDS_BARRIER();
    }
}

constexpr size_t WS_US = WS_GL, WS_USC = WS_GL + 32 * MiB, WS_DEC = 7 * MiB;
static_assert(WS_USC + (size_t)16 * 4 * 8192 * 2 <= WS_END && WS_DEC + (size_t)16 * 132 * 64 * 4 <= WS_WIN, "ws map (gla)");
constexpr int GL_V = 0, GL_M0 = 16384, GL_MSZ = 64 * 72 * 2, GL_RED = GL_M0 + 4 * GL_MSZ;
__device__ __forceinline__ float wave_scan_incl(float v) {
    v += DPP_F(v, 0x111, 0xF); v += DPP_F(v, 0x112, 0xF); v += DPP_F(v, 0x114, 0xF); v += DPP_F(v, 0x118, 0xF);
    v += DPP_F(v, 0x142, 0xA); v += DPP_F(v, 0x143, 0xC); return v;
}
__device__ __forceinline__ float lane63(float v) { return __builtin_bit_cast(float, __builtin_amdgcn_readlane(__builtin_bit_cast(int, v), 63)); }
__device__ __forceinline__ void unpack8(const u32x4 w, float (&f)[8]) { f[0] = bflo(w.x); f[1] = bfhi(w.x); f[2] = bflo(w.y); f[3] = bfhi(w.y); f[4] = bflo(w.z); f[5] = bfhi(w.z); f[6] = bflo(w.w); f[7] = bfhi(w.w); }
__device__ __forceinline__ void gla_stage_v(const Frame& F, const bf16* P, int m0, int h) {
#pragma unroll
    for (int i = 0; i < 2; ++i) { const int p = F.tid + 512 * i, t = p >> 4, ch = p & 15;
        const u32x4 v = *(const u32x4*)(P + (size_t)(m0 + t) * NIN + PC_V + h * 128 + ch * 8);
        *(LAS u32x4*)(F.lds + GL_V + (ch >> 2) * 4096 + t * 64 + (ch & 3) * 16) = v; }
}
struct GlaPre { u32x4 laf, lab, kk, qq, v0, v1; };
__device__ __forceinline__ void gla_pre_load(const Frame& F, const bf16* P, int m0, int h, bool want_q, GlaPre& p) {
    const bf16* row = P + (size_t)(m0 + F.lane) * NIN + h * 64 + 8 * F.wave;
    p.laf = *(const u32x4*)(row + PC_GF); p.lab = *(const u32x4*)(row + PC_GB); p.kk = *(const u32x4*)(row + PC_K);
    if (want_q) p.qq = *(const u32x4*)(row + PC_Q);
    { const int q0 = F.tid, q1 = F.tid + 512;
      p.v0 = *(const u32x4*)(P + (size_t)(m0 + (q0 >> 4)) * NIN + PC_V + h * 128 + (q0 & 15) * 8);
      p.v1 = *(const u32x4*)(P + (size_t)(m0 + (q1 >> 4)) * NIN + PC_V + h * 128 + (q1 & 15) * 8); }
}
__device__ __forceinline__ void gla_pre_stage_v(const Frame& F, const GlaPre& p) {
    { const int q = F.tid, t = q >> 4, ch = q & 15; *(LAS u32x4*)(F.lds + GL_V + (ch >> 2) * 4096 + t * 64 + (ch & 3) * 16) = p.v0; }
    { const int q = F.tid + 512, t = q >> 4, ch = q & 15; *(LAS u32x4*)(F.lds + GL_V + (ch >> 2) * 4096 + t * 64 + (ch & 3) * 16) = p.v1; }
}
__device__ __forceinline__ void gla_unit_decode(int u, int& m0, int& h, int& sf, int& n, bool& latent) {
    latent = u < 1024; const int cc = u - 1024;
    const int b = latent ? (u >> 9) : (cc >> 4); h = latent ? ((u >> 7) & 3) : ((cc >> 2) & 3); n = latent ? (u & 127) : (cc & 3);
    m0 = latent ? b * SEQ + 64 * n : TL + b * LC + 64 * n; sf = (b * 4 + h) * 2;
}
__device__ __forceinline__ void gla_g1_unit(const Frame& F, const GlaPre& pre, bf16* Uf, bf16* Ub, float* decf, float* decb) {
    const int w = F.wave, t = F.lane, c = t & 31, hi = t >> 5;
    float laf[8], lab[8], kk[8];
    unpack8(pre.laf, laf); unpack8(pre.lab, lab); unpack8(pre.kk, kk);
    gla_pre_stage_v(F, pre);
    LAS bf16* KOF = (LAS bf16*)(F.lds + GL_M0); LAS bf16* KOB = (LAS bf16*)(F.lds + GL_M0 + GL_MSZ);
#pragma unroll
    for (int i = 0; i < 8; ++i) {
        const float incf = wave_scan_incl(laf[i]), tf = lane63(incf), incb = wave_scan_incl(lab[i]), tb = lane63(incb);
        KOF[(8 * w + i) * 72 + t] = (bf16)f2bf(kk[i] * __expf(tf - incf));
        KOB[(8 * w + i) * 72 + t] = (bf16)f2bf(kk[i] * __expf(incb - lab[i]));
        if (t == 0) { decf[8 * w + i] = __expf(tf); decb[8 * w + i] = __expf(tb); }
    }
    LDS_BARRIER();
    const int dir = w >> 2, dvt = w & 3;
    const LAS unsigned char* vp = F.lds + GL_V + dvt * 4096 + ((t >> 4) & 1) * 32 + (t & 3) * 8 + ((t & 15) >> 2) * 64 + hi * 512;
    const LAS unsigned char* kb = F.lds + GL_M0 + dir * GL_MSZ + (c * 72 + 8 * hi) * 2;
    f32x16 acc[2];
#pragma unroll
    for (int j = 0; j < 2; ++j)
#pragma unroll
        for (int r = 0; r < 16; ++r) acc[j][r] = 0.f;
#pragma unroll
    for (int sp = 0; sp < 4; ++sp) {
        const s16x4 lo = vtr(vp + sp * 1024), hi4 = vtr(vp + sp * 1024 + 256);
        const bf16x8 vf = (bf16x8){lo[0], lo[1], lo[2], lo[3], hi4[0], hi4[1], hi4[2], hi4[3]};
#pragma unroll
        for (int j = 0; j < 2; ++j) { const bf16x8 kf = *(const LAS bf16x8*)(kb + j * 32 * 144 + sp * 32); acc[j] = __builtin_amdgcn_mfma_f32_32x32x16_bf16(kf, vf, acc[j], 0, 0, 0); }
    }
    bf16* U = dir ? Ub : Uf;
#pragma unroll
    for (int j = 0; j < 2; ++j) {
        u32x4 w0, w1;
        w0.x = pk2(acc[j][0], acc[j][1]); w0.y = pk2(acc[j][2], acc[j][3]); w0.z = pk2(acc[j][4], acc[j][5]); w0.w = pk2(acc[j][6], acc[j][7]);
        w1.x = pk2(acc[j][8], acc[j][9]); w1.y = pk2(acc[j][10], acc[j][11]); w1.z = pk2(acc[j][12], acc[j][13]); w1.w = pk2(acc[j][14], acc[j][15]);
        u32x4* up = (u32x4*)(U + ((j * 4 + dvt) * 64 + t) * 16);
        up[0] = w0; up[1] = w1;
    }
    LDS_BARRIER();
}
__device__ __forceinline__ void gla_g1(const Frame& F0, int l) {
    Frame F = F0; { int l_; asm volatile("v_mbcnt_lo_u32_b32 %0, -1, 0\n\tv_mbcnt_hi_u32_b32 %0, -1, %0" : "=v"(l_)); F.lane = l_; F.tid = F.wave * 64 + l_; }
    const bf16* P = (const bf16*)(F.ws + WS_P);
    bf16* US = (bf16*)(F.ws + WS_US); bf16* USC = (bf16*)(F.ws + WS_USC); float* DEC = (float*)(F.ws + WS_DEC);
    GlaPre pre, nx;
    { int m0, h, sf, n; bool latent; if (F.vcu < 1056) { gla_unit_decode(F.vcu, m0, h, sf, n, latent); gla_pre_load(F, P, m0, h, false, pre); } }
    for (int u = F.vcu; u < 1056; u += F.G) {
        int m0, h, sf, n; bool latent; gla_unit_decode(u, m0, h, sf, n, latent);
        if (u + F.G < 1056) { int m1, h1, s1, n1; bool l1; gla_unit_decode(u + F.G, m1, h1, s1, n1, l1); gla_pre_load(F, P, m1, h1, false, nx); }
        bf16* Uf = latent ? US + ((size_t)sf * 128 + n) * 8192 : USC + ((size_t)sf * 4 + n) * 8192;
        bf16* Ub = latent ? US + ((size_t)(sf + 1) * 128 + n) * 8192 : USC + ((size_t)(sf + 1) * 4 + n) * 8192;
        const int nd = latent ? n : 128 + n;
        gla_g1_unit(F, pre, Uf, Ub, DEC + ((size_t)sf * 132 + nd) * 64, DEC + ((size_t)(sf + 1) * 132 + nd) * 64);
        pre = nx;
    }
}
constexpr size_t WS_SS = WS_H, WS_SSC = WS_H + 32 * MiB;
static_assert(WS_SSC + (size_t)16 * 4 * 8192 * 2 <= WS_P, "ws map (gla states)");
__device__ __forceinline__ void gla_scan(const Frame& F) {
    for (int w0 = (F.vcu * NWAVES + F.wave) * 64; w0 < 16 * 4096; w0 += F.G * NWAVES * 64) {
        const int seq = __builtin_amdgcn_readfirstlane(w0 >> 12), ew = __builtin_amdgcn_readfirstlane((w0 & 4095) * 2);
        const int dir = seq & 1;
        const unsigned voff = (unsigned)F.lane * 4u;
        unsigned doff;
        { const int e = ew + 2 * F.lane, r = e & 15, ln = (e >> 4) & 63, dkt = e >> 12; doff = (unsigned)(32 * dkt + (r & 3) + 8 * (r >> 2) + 4 * (ln >> 5)) * 4u; }
        const char* decb = (const char*)(F.ws + WS_DEC) + (size_t)seq * 132 * 256;
        float s0 = 0.f, s1 = 0.f;
        { const char* ub = (const char*)(F.ws + WS_USC) + ((size_t)seq * 4 * 8192 + ew) * 2; char* sb = (char*)(F.ws + WS_SSC) + ((size_t)seq * 4 * 8192 + ew) * 2;
          unsigned u[4]; f32x2 d[4];
#pragma unroll
          for (int i = 0; i < 4; ++i) { const int n = dir ? 3 - i : i; u[i] = *(const unsigned*)(ub + (size_t)n * 16384 + voff); d[i] = *(const f32x2*)(decb + (size_t)(128 + n) * 256 + doff); }
#pragma unroll
          for (int i = 0; i < 4; ++i) { const int n = dir ? 3 - i : i; *(unsigned*)(sb + (size_t)n * 16384 + voff) = pk2(s0, s1); s0 = d[i][0] * s0 + bflo(u[i]); s1 = d[i][1] * s1 + bfhi(u[i]); } }
        const long stride = dir ? -16384 : 16384, dstride = dir ? -256 : 256;
        const char* ub = (const char*)(F.ws + WS_US) + ((size_t)seq * 128 * 8192 + ew) * 2 + (dir ? (size_t)127 * 16384 : 0);
        char* sb = (char*)(F.ws + WS_SS) + ((size_t)seq * 128 * 8192 + ew) * 2 + (dir ? (size_t)127 * 16384 : 0);
        const char* db = decb + (dir ? 127 * 256 : 0);
#pragma unroll 1
        for (int i0 = 0; i0 < 128; i0 += 32) {
            unsigned u[32]; f32x2 d[32];
#pragma unroll
            for (int j = 0; j < 32; ++j) { u[j] = *(const unsigned*)(ub + j * stride + voff); d[j] = *(const f32x2*)(db + j * dstride + doff); }
#pragma unroll
            for (int j = 0; j < 32; ++j) { *(unsigned*)(sb + j * stride + voff) = pk2(s0, s1); s0 = d[j][0] * s0 + bflo(u[j]); s1 = d[j][1] * s1 + bfhi(u[j]); }
            ub += 32 * stride; sb += 32 * stride; db += 32 * dstride;
        }
    }
}
__device__ __forceinline__ void gla_g3_unit(const Frame& F, const CAS Args* a, int l, const bf16* P, int m0, int h, const bf16* Sf, const bf16* Sb, bf16* MIX, const GlaPre& pre) {
    const int w = F.wave, t = F.lane, c = t & 31, hi = t >> 5;
    bf16x8 sfr[4], sbr[4]; u32x2 gwv[4]; f32x4 nwv[4];
    { const int dvt_ = w >> 1, tt_ = w & 1;
#pragma unroll
      for (int kd = 0; kd < 4; ++kd) { const size_t off = (size_t)(((kd >> 1) * 4 + dvt_) * 64 + t) * 16 + 8 * (kd & 1); sfr[kd] = *(const bf16x8*)(Sf + off); sbr[kd] = *(const bf16x8*)(Sb + off); }
#pragma unroll
      for (int rg = 0; rg < 4; ++rg) { const int dv = 32 * dvt_ + 8 * rg + 4 * hi;
          gwv[rg] = *(const u32x2*)(P + (size_t)(m0 + 32 * tt_ + c) * NIN + PC_G + h * 128 + dv); nwv[rg] = *(const f32x4*)(a->in[I_GLANORM] + l * 512 + h * 128 + dv); } }
    {
        float laf[8], lab[8], kk[8], qq[8];
        unpack8(pre.laf, laf); unpack8(pre.lab, lab); unpack8(pre.kk, kk); unpack8(pre.qq, qq);
        gla_pre_stage_v(F, pre);
        float qf[8], kf[8], qb[8], kb[8];
#pragma unroll
        for (int i = 0; i < 8; ++i) {
            const float bf = wave_scan_incl(laf[i]), incb = wave_scan_incl(lab[i]), bb = lane63(incb) - incb + lab[i];
            qf[i] = qq[i] * __expf(bf); kf[i] = kk[i] * __expf(-bf); qb[i] = qq[i] * __expf(bb); kb[i] = kk[i] * __expf(-bb);
        }
        LAS unsigned char* mb = F.lds + GL_M0 + (t * 72 + 8 * w) * 2;
        u32x4 o;
        o.x = pk2(qf[0], qf[1]); o.y = pk2(qf[2], qf[3]); o.z = pk2(qf[4], qf[5]); o.w = pk2(qf[6], qf[7]); *(LAS u32x4*)(mb) = o;
        o.x = pk2(kf[0], kf[1]); o.y = pk2(kf[2], kf[3]); o.z = pk2(kf[4], kf[5]); o.w = pk2(kf[6], kf[7]); *(LAS u32x4*)(mb + GL_MSZ) = o;
        o.x = pk2(qb[0], qb[1]); o.y = pk2(qb[2], qb[3]); o.z = pk2(qb[4], qb[5]); o.w = pk2(qb[6], qb[7]); *(LAS u32x4*)(mb + 2 * GL_MSZ) = o;
        o.x = pk2(kb[0], kb[1]); o.y = pk2(kb[2], kb[3]); o.z = pk2(kb[4], kb[5]); o.w = pk2(kb[6], kb[7]); *(LAS u32x4*)(mb + 3 * GL_MSZ) = o;
    }
    LDS_BARRIER();
    const int dvt = w >> 1, tt = w & 1;
    bf16x8 qfB[4], qbB[4], qfP[4], qbP[4];
    { const LAS unsigned char* qp = F.lds + GL_M0 + ((32 * tt + c) * 72 + 8 * hi) * 2;
#pragma unroll
      for (int kd = 0; kd < 4; ++kd) { qfB[kd] = *(const LAS bf16x8*)(qp + kd * 32); qbB[kd] = *(const LAS bf16x8*)(qp + 2 * GL_MSZ + kd * 32); }
      const LAS unsigned char* pp = F.lds + GL_M0 + ((32 * tt + c) * 72 + 4 * hi) * 2;
#pragma unroll
      for (int kd = 0; kd < 4; ++kd) {
          const u32x2 a0 = *(const LAS u32x2*)(pp + kd * 32), a1 = *(const LAS u32x2*)(pp + kd * 32 + 16);
          const u32x2 b0 = *(const LAS u32x2*)(pp + 2 * GL_MSZ + kd * 32), b1 = *(const LAS u32x2*)(pp + 2 * GL_MSZ + kd * 32 + 16);
          qfP[kd] = __builtin_bit_cast(bf16x8, (u32x4){a0.x, a0.y, a1.x, a1.y}); qbP[kd] = __builtin_bit_cast(bf16x8, (u32x4){b0.x, b0.y, b1.x, b1.y});
      } }
    bf16x8 pfr[2][2];
#pragma unroll
    for (int st = 0; st < 2; ++st) {
        const LAS unsigned char* kp = F.lds + GL_M0 + GL_MSZ + ((32 * st + c) * 72 + 8 * hi) * 2;
        f32x16 xf, xb;
#pragma unroll
        for (int r = 0; r < 16; ++r) { xf[r] = 0.f; xb[r] = 0.f; }
        const bool needF = st <= tt, needB = st >= tt;
        if (needF) {
#pragma unroll
            for (int kd = 0; kd < 4; ++kd) xf = __builtin_amdgcn_mfma_f32_32x32x16_bf16(*(const LAS bf16x8*)(kp + kd * 32), qfB[kd], xf, 0, 0, 0);
        }
        if (needB) {
#pragma unroll
            for (int kd = 0; kd < 4; ++kd) xb = __builtin_amdgcn_mfma_f32_32x32x16_bf16(*(const LAS bf16x8*)(kp + 2 * GL_MSZ + kd * 32), qbB[kd], xb, 0, 0, 0);
        }
        if (st == tt) {
            int thr = c - 4 * hi; asm volatile("" : "+v"(thr));
#pragma unroll
            for (int r = 0; r < 16; ++r) { const int cc = (r & 3) + 8 * (r >> 2); xf[r] = (cc <= thr ? xf[r] : 0.f) + (cc >= thr ? xb[r] : 0.f); }
        } else {
#pragma unroll
            for (int r = 0; r < 16; ++r) xf[r] += xb[r];
        }
#pragma unroll
        for (int sp = 0; sp < 2; ++sp) {
            u32x4 wv; wv.x = pg8::cvt_pk_bf16(xf[8 * sp + 0], xf[8 * sp + 1]); wv.y = pg8::cvt_pk_bf16(xf[8 * sp + 2], xf[8 * sp + 3]);
            wv.z = pg8::cvt_pk_bf16(xf[8 * sp + 4], xf[8 * sp + 5]); wv.w = pg8::cvt_pk_bf16(xf[8 * sp + 6], xf[8 * sp + 7]);
            pfr[st][sp] = __builtin_bit_cast(bf16x8, wv);
        }
    }
    f32x16 o;
#pragma unroll
    for (int r = 0; r < 16; ++r) o[r] = 0.f;
    { const LAS unsigned char* vp = F.lds + GL_V + dvt * 4096 + ((t >> 4) & 1) * 32 + (t & 3) * 8 + (4 * hi + ((t & 15) >> 2)) * 64;
#pragma unroll
      for (int ks = 0; ks < 4; ++ks) {
          const s16x4 lo = vtr(vp + ks * 1024), hi4 = vtr(vp + ks * 1024 + 512);
          const bf16x8 vf = (bf16x8){lo[0], lo[1], lo[2], lo[3], hi4[0], hi4[1], hi4[2], hi4[3]};
          o = __builtin_amdgcn_mfma_f32_32x32x16_bf16(vf, pfr[ks >> 1][ks & 1], o, 0, 0, 0);
      } }
#pragma unroll
    for (int kd = 0; kd < 4; ++kd) {
        o = __builtin_amdgcn_mfma_f32_32x32x16_bf16(sfr[kd], qfP[kd], o, 0, 0, 0);
        o = __builtin_amdgcn_mfma_f32_32x32x16_bf16(sbr[kd], qbP[kd], o, 0, 0, 0);
    }
    float ssq = 0.f;
#pragma unroll
    for (int r = 0; r < 16; ++r) ssq += o[r] * o[r];
    { auto rr = __builtin_amdgcn_permlane32_swap(__float_as_uint(ssq), __float_as_uint(ssq), false, false); ssq = __uint_as_float(rr[0]) + __uint_as_float(rr[1]); }
    LAS float* red = (LAS float*)(F.lds + GL_RED);
    if (hi == 0) red[dvt * 64 + 32 * tt + c] = ssq;
    LDS_BARRIER();
    const float tot = (red[32 * tt + c] + red[64 + 32 * tt + c]) + (red[128 + 32 * tt + c] + red[192 + 32 * tt + c]);
    const float rstd = 1.0f / sqrtf(tot * (1.0f / 128.0f) + EPS);
    const int mrow = m0 + 32 * tt + c;
#pragma unroll
    for (int rg = 0; rg < 4; ++rg) {
        const int dv = 32 * dvt + 8 * rg + 4 * hi;
        const u32x2 gw = gwv[rg]; const f32x4 nw = nwv[rg];
        const float g0 = bflo(gw.x), g1 = bfhi(gw.x), g2 = bflo(gw.y), g3 = bfhi(gw.y);
        const float rs = rstd * MIX_SCALE;
        *(unsigned*)((unsigned char*)MIX + (size_t)mrow * D + h * 128 + dv) = pk4_fp8(o[4 * rg] * rs * nw[0] * silu_f(g0), o[4 * rg + 1] * rs * nw[1] * silu_f(g1), o[4 * rg + 2] * rs * nw[2] * silu_f(g2), o[4 * rg + 3] * rs * nw[3] * silu_f(g3));
    }
    LDS_BARRIER();
}
__device__ __forceinline__ void gla_g3(const Frame& F, const CAS Args* a, int l) {
    const bf16* P = (const bf16*)(F.ws + WS_P); bf16* MIX = (bf16*)(F.ws + WS_MIX);
    const bf16* US = (const bf16*)(F.ws + WS_SS); const bf16* USC = (const bf16*)(F.ws + WS_SSC);
    const int nunits = 1024 + (l == 0 ? 32 : 0);
    GlaPre pre, nx;
    { int m0, h, sf, n; bool latent; if (F.vcu < nunits) { gla_unit_decode(F.vcu, m0, h, sf, n, latent); gla_pre_load(F, P, m0, h, true, pre); } }
    for (int u = F.vcu; u < nunits; u += F.G) {
        int m0, h, sf, n; bool latent; gla_unit_decode(u, m0, h, sf, n, latent);
        if (u + F.G < nunits) { int m1, h1, s1, n1; bool l1; gla_unit_decode(u + F.G, m1, h1, s1, n1, l1); gla_pre_load(F, P, m1, h1, true, nx); }
        const bf16* Sf = latent ? US + ((size_t)sf * 128 + n) * 8192 : USC + ((size_t)sf * 4 + n) * 8192;
        const bf16* Sb = latent ? US + ((size_t)(sf + 1) * 128 + n) * 8192 : USC + ((size_t)(sf + 1) * 4 + n) * 8192;
        gla_g3_unit(F, a, l, P, m0, h, Sf, Sb, MIX, pre);
        pre = nx;
    }
}

__device__ __forceinline__ void gla_naive(const Frame& F, const CAS Args* a, int l) {
    const bf16* P = (const bf16*)(F.ws + WS_P);
    bf16* OF = (bf16*)(F.ws + WS_GL);
    for (int w = F.gw; w < 2048; w += F.NGW) {
        const int dv = w & 127, dir = (w >> 7) & 1, h = (w >> 8) & 3, b = w >> 10;
        const int pcg = dir ? PC_GB : PC_GF;
        float S = 0.f;
        for (int step = 0; step < LC + SEQ; ++step) {
            int m;
            if (dir == 0) m = step < LC ? TL + b * LC + step : b * SEQ + (step - LC);
            else m = step < LC ? TL + b * LC + (LC - 1 - step) : b * SEQ + (SEQ - 1 - (step - LC));
            const bf16* row = P + (size_t)m * NIN;
            const float la = bf2f(row[pcg + h * 64 + F.lane]), kk = bf2f(row[PC_K + h * 64 + F.lane]), qq = bf2f(row[PC_Q + h * 64 + F.lane]), vv = bf2f(row[PC_V + h * 128 + dv]);
            S = __expf(la) * S + kk * vv;
            const float o = wave_sum(qq * S);
            if (F.lane == 0) OF[((size_t)dir * TT + m) * 512 + h * 128 + dv] = (bf16)f2bf(o);
        }
    }
}
__device__ __forceinline__ void gla_out_naive(const Frame& F, const CAS Args* a, int l) {
    const bf16* P = (const bf16*)(F.ws + WS_P); bf16* MIX = (bf16*)(F.ws + WS_MIX);
    const bf16* OF = (const bf16*)(F.ws + WS_GL);
    const int rows = (l == 0) ? TT : TL;
    for (int m = F.gw; m < rows; m += F.NGW) {
        const int c0 = 8 * F.lane;
        const u32x4 wa = *(const u32x4*)(OF + (size_t)m * 512 + c0), wb = *(const u32x4*)(OF + ((size_t)TT + m) * 512 + c0);
        float o[8] = {bflo(wa.x) + bflo(wb.x), bfhi(wa.x) + bfhi(wb.x), bflo(wa.y) + bflo(wb.y), bfhi(wa.y) + bfhi(wb.y), bflo(wa.z) + bflo(wb.z), bfhi(wa.z) + bfhi(wb.z), bflo(wa.w) + bflo(wb.w), bfhi(wa.w) + bfhi(wb.w)};
        float ss = 0.f;
#pragma unroll
        for (int i = 0; i < 8; ++i) ss += o[i] * o[i];
        ss = row16_sum(ss);
        const float rstd = 1.0f / sqrtf(ss * (1.0f / 128.0f) + EPS);
        const u32x4 wg = *(const u32x4*)(P + (size_t)m * NIN + PC_G + c0);
        const float g[8] = {bflo(wg.x), bfhi(wg.x), bflo(wg.y), bfhi(wg.y), bflo(wg.z), bfhi(wg.z), bflo(wg.w), bfhi(wg.w)};
        const f32x4 n0 = *(const f32x4*)(a->in[I_GLANORM] + l * 512 + c0), n1 = *(const f32x4*)(a->in[I_GLANORM] + l * 512 + c0 + 4);
        float r[8];
#pragma unroll
        for (int i = 0; i < 8; ++i) r[i] = o[i] * rstd * (i < 4 ? n0[i] : n1[i - 4]) * silu_f(g[i]);
        u32x4 w; w.x = pk2(r[0], r[1]); w.y = pk2(r[2], r[3]); w.z = pk2(r[4], r[5]); w.w = pk2(r[6], r[7]);
        *(u32x4*)(MIX + (size_t)m * D + c0) = w;
    }
}

constexpr int N2_W = 0, N2_H = 32768, N2_PART = 98304, N2_CNT = 132096, N2_RT = 20;
static_assert(N2_PART + 16384 <= RING_BYTES && N2_CNT + 256 + NWAVES * N2_RT * 16 <= LDS_BYTES && N2_CNT >= MISC_OFF + 64 + 128, "N2 LDS map");
__device__ __forceinline__ int n2_addr(int r, int k) { return r * 2048 + ((((k >> 3) ^ r) & 127) << 4) + (k & 7) * 2; }
__device__ __forceinline__ void n2_route_phase(const Frame& F, const CAS Args* a, int l, bool do_route, int cset) {
    unsigned char* ws = F.ws;
    const float* mod = (const float*)(ws + WS_MOD);
    bf16* H = (bf16*)(ws + WS_H);
    unsigned* cnt = (unsigned*)(ws + WS_CTL) + CW_CNT + cset * NE * CNT_STRIDE;
    unsigned* list = (unsigned*)(ws + WS_LIST); float* listw = (float*)(ws + WS_LISTW);
    LAS unsigned* lcnt = (LAS unsigned*)(F.lds + N2_CNT); LAS unsigned* lbase = lcnt + 16; LAS unsigned* rec = lcnt + 64;
    for (int i = F.tid; i < D * NE; i += NWAVES * 64) { const int e = i & 15, k = i >> 4; *(LAS bf16*)(F.lds + N2_W + n2_addr(e, k)) = (bf16)f2bf(a->in[I_WROUTER][i]); }
    if (F.tid < 32) lcnt[F.tid] = 0u;
    LDS_BARRIER();
    const int rows = (l == 0) ? TT : TL;
    const int t0 = F.gw;
    const int nch = (rows - F.vcu * NWAVES + F.NGW - 1) / F.NGW;
    f32x4 xc[4][4], xq[4][4];
#pragma unroll
    for (int q = 0; q < 4; ++q) { const int m = t0 + q * F.NGW;
        if (m < rows) { const float* xr = (const float*)(ws + WS_XC) + (size_t)(m - TL) * D;
#pragma unroll
            for (int j = 0; j < 4; ++j) xq[q][j] = m < TL ? ld_y4(F.xlb + (size_t)m * D + 4 * F.lane + 256 * j) : *(const f32x4*)(xr + 4 * F.lane + 256 * j); } }
    for (int c4 = 0; c4 < nch; c4 += 4) {
#pragma unroll
        for (int q = 0; q < 4; ++q)
#pragma unroll
            for (int j = 0; j < 4; ++j) xc[q][j] = xq[q][j];
#pragma unroll
        for (int q = 0; q < 4; ++q) { const int m = t0 + (c4 + 4 + q) * F.NGW;
            if (m < rows) { const float* xr = (const float*)(ws + WS_XC) + (size_t)(m - TL) * D;
#pragma unroll
                for (int j = 0; j < 4; ++j) xq[q][j] = m < TL ? ld_y4(F.xlb + (size_t)m * D + 4 * F.lane + 256 * j) : *(const f32x4*)(xr + 4 * F.lane + 256 * j); } }
#pragma unroll
        for (int q = 0; q < 4; ++q) {
            const int m = t0 + (c4 + q) * F.NGW, r = 8 * q + F.wave;
            if (m < rows) {
                const int v = m < TL ? (m >> 13) : 2;
                float ss = 0.f;
#pragma unroll
                for (int j = 0; j < 4; ++j) ss += (xc[q][j][0] * xc[q][j][0] + xc[q][j][1] * xc[q][j][1]) + (xc[q][j][2] * xc[q][j][2] + xc[q][j][3] * xc[q][j][3]);
                const float rstd = 1.0f / sqrtf(wave_sum(ss) * (1.0f / D) + EPS);
#pragma unroll
                for (int j = 0; j < 4; ++j) {
                    const int col = 4 * F.lane + 256 * j;
                    const f32x4 nw = *(const f32x4*)(a->in[I_NORM2] + l * D + col);
                    const f32x4 sh = *(const f32x4*)(mod + (l * 3 + v) * 6144 + 3 * D + col);
                    const f32x4 sc = *(const f32x4*)(mod + (l * 3 + v) * 6144 + 4 * D + col);
                    const f32x4 h = xc[q][j] * rstd * nw * (1.0f + sc) + sh;
                    *(unsigned*)((unsigned char*)H + (size_t)m * D + col) = pk4_fp8(h[0], h[1], h[2], h[3]);
                    u32x2 o; o.x = pk2(h[0], h[1]); o.y = pk2(h[2], h[3]);
                    *(LAS u32x2*)(F.lds + N2_H + n2_addr(r, col)) = o;
                }
            }
        }
        LDS_BARRIER();
        {
            const int rr = F.lane & 15, kg = F.lane >> 4;
            f32x4 acc0 = (f32x4){0.f, 0.f, 0.f, 0.f}, acc1 = acc0;
#pragma unroll
            for (int ks = 0; ks < 4; ++ks) {
                const int k = 128 * F.wave + 32 * ks + 8 * kg;
                const bf16x8 wf = *(const LAS bf16x8*)(F.lds + N2_W + n2_addr(rr, k));
                const bf16x8 h0 = *(const LAS bf16x8*)(F.lds + N2_H + n2_addr(rr, k)), h1 = *(const LAS bf16x8*)(F.lds + N2_H + n2_addr(16 + rr, k));
                acc0 = __builtin_amdgcn_mfma_f32_16x16x32_bf16(wf, h0, acc0, 0, 0, 0);
                acc1 = __builtin_amdgcn_mfma_f32_16x16x32_bf16(wf, h1, acc1, 0, 0, 0);
            }
            *(LAS f32x4*)(F.lds + N2_PART + ((F.wave * 32 + rr) * 16 + 4 * kg) * 4) = acc0;
            *(LAS f32x4*)(F.lds + N2_PART + ((F.wave * 32 + 16 + rr) * 16 + 4 * kg) * 4) = acc1;
        }
        LDS_BARRIER();
        if (F.wave < 2) {
            const int rr = F.lane & 15, eg = F.lane >> 4, row = 16 * F.wave + rr;
            f32x4 lg = (f32x4){0.f, 0.f, 0.f, 0.f};
#pragma unroll
            for (int w = 0; w < NWAVES; ++w) lg = lg + *(const LAS f32x4*)(F.lds + N2_PART + ((w * 32 + row) * 16 + 4 * eg) * 4);
            const f32x4 br = *(const f32x4*)(a->in[I_BROUTER] + 4 * eg);
            float sg[4], sb[4];
#pragma unroll
            for (int i = 0; i < 4; ++i) { sg[i] = 1.0f / (1.0f + __expf(-lg[i])); sb[i] = sg[i] + br[i]; }
            int i0 = 0, i1 = 0; float b0 = -1e30f, b1 = -1e30f, s0 = 0.f, s1 = 0.f;
#pragma unroll
            for (int i = 0; i < 4; ++i) { const float val = sb[i];
                if (val > b0) { b1 = b0; i1 = i0; s1 = s0; b0 = val; i0 = i; s0 = sg[i]; } else if (val > b1) { b1 = val; i1 = i; s1 = sg[i]; } }
            const float gs = b0 + b1;
            float best = gs; int bg = eg;
#pragma unroll
            for (int st = 16; st < 64; st <<= 1) {
                const float og = __builtin_bit_cast(float, __builtin_amdgcn_ds_bpermute((F.lane ^ st) << 2, __builtin_bit_cast(int, best)));
                const int oi = __builtin_amdgcn_ds_bpermute((F.lane ^ st) << 2, bg);
                if (og > best || (og == best && oi < bg)) { best = og; bg = oi; }
            }
            const int wv = row & 7, ch = c4 + (row >> 3);
            const int m = F.vcu * NWAVES + wv + ch * F.NGW;
            if (do_route && bg == eg && m < rows) {
                const int e0 = 4 * eg + i0, e1 = 4 * eg + i1; const float inv = 1.0f / (s0 + s1);
                if (ch < N2_RT) {
                    const int slot = wv * N2_RT + ch;
                    const unsigned l0 = atomicAdd((unsigned*)(lcnt + e0), 1u), l1 = atomicAdd((unsigned*)(lcnt + e1), 1u);
                    rec[slot * 4 + 0] = (unsigned)m; rec[slot * 4 + 1] = (unsigned)e0 | ((unsigned)e1 << 8) | (l0 << 16) | (l1 << 24);
                    rec[slot * 4 + 2] = __float_as_uint(s0 * inv); rec[slot * 4 + 3] = __float_as_uint(s1 * inv);
                } else {
                    const unsigned p0 = atomicAdd(cnt + e0 * CNT_STRIDE, 1u); list[(size_t)e0 * LISTCAP + p0] = (unsigned)m * 2u; listw[(size_t)e0 * LISTCAP + p0] = s0 * inv;
                    const unsigned p1 = atomicAdd(cnt + e1 * CNT_STRIDE, 1u); list[(size_t)e1 * LISTCAP + p1] = (unsigned)m * 2u + 1u; listw[(size_t)e1 * LISTCAP + p1] = s1 * inv;
                }
            }
        }
    }
    LDS_BARRIER();
    if (do_route) {
        if (F.tid < NE) { const unsigned c = lcnt[F.tid]; lbase[F.tid] = c ? atomicAdd(cnt + F.tid * CNT_STRIDE, c) : 0u; }
        LDS_BARRIER();
        for (int i = F.tid; i < NWAVES * N2_RT; i += NWAVES * 64) {
            const int wv = i / N2_RT, k = i % N2_RT;
            if (F.vcu * NWAVES + wv + k * F.NGW < rows) {
                const unsigned m = rec[i * 4], pk = rec[i * 4 + 1]; const unsigned e0 = pk & 255u, e1 = (pk >> 8) & 255u, l0 = (pk >> 16) & 255u, l1 = pk >> 24;
                const unsigned p0 = lbase[e0] + l0, p1 = lbase[e1] + l1;
                list[(size_t)e0 * LISTCAP + p0] = m * 2u; listw[(size_t)e0 * LISTCAP + p0] = __uint_as_float(rec[i * 4 + 2]);
                list[(size_t)e1 * LISTCAP + p1] = m * 2u + 1u; listw[(size_t)e1 * LISTCAP + p1] = __uint_as_float(rec[i * 4 + 3]);
            }
        }
    }
    LDS_BARRIER();
}

__device__ __forceinline__ void moe_setup(pg8::MoeOrder& S, const Frame& F, int cset, int nN, bool reuse = false) {
    unsigned* cnt = (unsigned*)(F.ws + WS_CTL) + CW_CNT + cset * NE * CNT_STRIDE;
    LAS int* tab = (LAS int*)(F.lds + MISC_OFF + 64);
    __syncthreads();
    if (F.tid == 0 && !reuse) { int run = 0;
        for (int e = 0; e < NE; ++e) { const int c = (int)__hip_atomic_load(cnt + e * CNT_STRIDE, __ATOMIC_RELAXED, __HIP_MEMORY_SCOPE_AGENT); tab[e] = c; run += (c + 255) >> 8; tab[16 + e] = run; } }
    __syncthreads();
    S.tab = tab; S.nN = nN; S.nunits = __builtin_amdgcn_readfirstlane(tab[31]) * nN; S.G = F.G; S.c = (int)blockIdx.x;
    S.tdone = (unsigned*)(F.ws + WS_CTL) + CW_TDONE + cset * 160 * 16; S.role = 0;
    S.list = (const unsigned*)(F.ws + WS_LIST);
}
__device__ __forceinline__ void moe1_phase(const Frame& F, const CAS Args* a, int l, int cset) {
    pg8::MoeOrder S; moe_setup(S, F, cset, 4);
    S.A = (const char*)(F.ws + WS_H); S.Bt = (const char*)(F.ws + WS_WGU) + (size_t)l * NE * D * D; S.K = D / 2; S.bstride_e = (size_t)D * D; S.gather = true; S.role = 1;
    EpiGU E{(bf16*)(F.ws + WS_HMID)};
    pg8::gemm_phase<EpiGU, pg8::MoeOrder, true>(F.lds, F.tid, S, E, SC_W1, SC_ONE);
}
__device__ __forceinline__ void moe2_phase(const Frame& F, const CAS Args* a, int l, int cset) {
    pg8::MoeOrder S; moe_setup(S, F, cset, 4, true);
    S.A = (const char*)(F.ws + WS_HMID); S.Bt = (const char*)(F.ws + WS_WD) + (size_t)l * NE * D * DE; S.K = DE / 2; S.bstride_e = (size_t)D * DE; S.gather = false; S.role = 2; S.c = F.G - 1 - (int)blockIdx.x;
    EpiDown E; E.Y = (bf16*)(F.ws + WS_Y); E.list = (const unsigned*)(F.ws + WS_LIST); E.listw = (const float*)(F.ws + WS_LISTW); E.tab = S.tab;
    pg8::gemm_phase<EpiDown, pg8::MoeOrder, true>(F.lds, F.tid, S, E, SC_W2, SC_HMID);
    if (l == 0 && cset == 0) convert_moe_filler(F, a, 1, S.nunits, true);
}

__device__ __forceinline__ void final_load(const Frame& F, int m, f32x4 (&x)[4]) {
    const float* mod = (const float*)(F.ws + WS_MOD);
    const bf16* Y0 = (const bf16*)(F.ws + WS_Y); const bf16* Y1 = Y0 + (size_t)TT * D;
    const int v = m >> 13; const bf16* xrow = F.xlb + (size_t)m * D;
#pragma unroll
    for (int j = 0; j < 4; ++j) {
        const int col = 4 * F.lane + 256 * j;
        const f32x4 g2 = *(const f32x4*)(mod + (3 + v) * 6144 + 5 * D + col);
        const f32x4 y = ld_y4(Y0 + (size_t)m * D + col) + ld_y4(Y1 + (size_t)m * D + col);
        x[j] = ld_y4(xrow + col) + g2 * y;
    }
}
__device__ __forceinline__ void final_row(const Frame& F, const CAS Args* a, int m, const f32x4 (&x)[4]) {
    float* xrow = F.out + (size_t)m * D; float ss = 0.f;
#pragma unroll
    for (int j = 0; j < 4; ++j) ss += (x[j][0] * x[j][0] + x[j][1] * x[j][1]) + (x[j][2] * x[j][2] + x[j][3] * x[j][3]);
    const float rstd = 1.0f / sqrtf(wave_sum(ss) * (1.0f / D) + EPS);
#pragma unroll
    for (int j = 0; j < 4; ++j) { const int col = 4 * F.lane + 256 * j; const f32x4 nw = *(const f32x4*)(a->in[I_FNORM] + col); *(f32x4*)(xrow + col) = x[j] * rstd * nw; }
}
__device__ __forceinline__ void final_phase(const Frame& F, const CAS Args* a) {
    for (int m = F.gw; m < TL; m += 2 * F.NGW) {
        const int m2 = m + F.NGW; const bool two = m2 < TL;
        f32x4 xa[4], xb[4];
        final_load(F, m, xa);
        if (two) final_load(F, m2, xb);
        final_row(F, a, m, xa);
        if (two) final_row(F, a, m2, xb);
    }
}

#ifndef NPASS
#define NPASS 1
#endif
#ifndef PROBE_PH
#define PROBE_PH -1
#endif
#ifndef PROBE_R
#define PROBE_R 3
#endif
#ifndef PROBE_UPTO
#define PROBE_UPTO -1
#endif
#ifndef PROBE_ABL
#define PROBE_ABL 0
#endif
constexpr int PH_PER_LAYER = 8;
constexpr int N_PHASES = 1 + DEPTH * PH_PER_LAYER + 1;

template <int ph0>
__device__ __forceinline__ void do_phase(Frame& F, XcdBarrier& bar, LAS unsigned char* lds, int lo, int hi) {
    constexpr int ph = ph0 % N_PHASES, pass = ph0 / N_PHASES;
    if (!(lo <= ph && ph < hi)) return;
    if (pass == 1 && (PROBE_UPTO >= 0 ? ph >= PROBE_UPTO : ph != PROBE_PH)) return;
    const CAS Args* ap;
        { int l_; asm volatile("v_mbcnt_lo_u32_b32 %0, -1, 0\n\tv_mbcnt_hi_u32_b32 %0, -1, %0" : "=v"(l_)); F.lane = l_; F.tid = F.wave * 64 + l_; ap = (const CAS Args*)__builtin_amdgcn_kernarg_segment_ptr(); asm volatile("" : "+s"(ap)); F.ws = ap->ws; F.out = (pass == 1) ? (float*)(ap->ws + WS_P) : ap->out; F.xlb = (bf16*)(ap->ws + ((pass == 1) ? WS_P + 64 * MiB : WS_XLB));
          LAS unsigned char* lb_ = (LAS unsigned char*)lds; asm volatile("" : "+s"(lb_)); __builtin_assume((((unsigned)(__UINTPTR_TYPE__)lb_) & 1023u) == 0u); F.lds = lb_;
          bar.bar = (unsigned*)(F.ws + WS_CTL) + CW_BAR; bar.st = (volatile LAS unsigned*)(F.lds + MISC_OFF) + 8; }
        if (ph == 0) { if (PH_ON(10)) REP(10, true) p0_prologue(F, ap); }
        else if (ph == N_PHASES - 1) { if (PH_ON(11)) REP(11, false) final_phase(F, ap); }
        else {
            const int l = (ph - 1) / PH_PER_LAYER, s = (ph - 1) % PH_PER_LAYER;
            unsigned char* ws = F.ws;
            if (s == 0) { if (PH_ON(0)) REP(0, l == 0) { n1_phase(F, ap, l); if (l == 0) p0_convert(F, ap); } }
            else if (s == 1 && PH_ON(1)) REP(1, true) {
                pg8::DenseOrder S; S.init(ws + WS_H, ws + WS_WIN + (size_t)l * NIN * D, TT, NIN, D / 2, F.G, (int)blockIdx.x);
                EpiIn E{(bf16*)(ws + WS_P), ap->in[I_BIASF] + l * 256, ap->in[I_BIASB] + l * 256, (const float*)(ws + WS_ROPE), (const float*)(ws + WS_ROPE) + 2048, (pass == 1) ? PROBE_ABL : 0};
                pg8::gemm_phase<EpiIn, pg8::DenseOrder, true>(F.lds, F.tid, S, E, SC_W1, SC_ONE, GIN_STAG);
            }
            else if (s == 2) { constexpr int abl = (pass == 1) ? PROBE_ABL : 0; if (PH_ON(2) && abl != 5) REP(2, true) swa_flash(F, ap, l, abl); if (PH_ON(12) && abl != 6) REP(12, true) gla_g1(F, l); }
            else if (s == 3) { if (PH_ON(13)) REP(13, true) gla_scan(F); }
            else if (s == 4) { if (PH_ON(3)) REP(3, true) gla_g3(F, ap, l); }
            else if (s == 5 && PH_ON(4)) REP(4, l == 0) {
                pg8::DenseOrder S; S.init(ws + WS_MIX, ws + WS_WOUT + (size_t)l * D * D, l == 0 ? TT : TL, D, D / 2, F.G, (int)blockIdx.x);
                EpiOut E{ap->in[I_X], l == 0 ? ap->in[I_CTX] : (const float*)(ws + WS_XC), F.xlb, (float*)(ws + WS_XC), (const float*)(ws + WS_MOD) + l * 3 * 6144, l > 0};
                pg8::gemm_phase<EpiOut, pg8::DenseOrder, true>(F.lds, F.tid, S, E, SC_W1, SC_HMID);
                if (l == 0 && pass == 0) convert_moe_filler(F, ap, 0, S.nwg);
            }
            else if (s == 6) { if (PH_ON(5)) REP(5, true) n2_route_phase(F, ap, l, rep_ == 0 || pass == 1, l + 2 * pass); }
            else { if (PH_ON(6)) { moe1_phase(F, ap, l, l + 2 * pass); moe2_phase(F, ap, l, l + 2 * pass); } }
        }
        if (ph0 + 1 < NPASS * N_PHASES) for (int rb_ = 0; rb_ < (REPEAT_S == 20 ? REPEAT_N : 1); ++rb_) xcd_barrier(bar, F.tid);
}
template <int... I>
__device__ __forceinline__ void run_all(Frame& F, XcdBarrier& bar, LAS unsigned char* lds, int lo, int hi, std::integer_sequence<int, I...>) { (do_phase<I>(F, bar, lds, lo, hi), ...); }

#ifdef VGPR_CAP
__attribute__((amdgpu_num_vgpr(VGPR_CAP)))
#endif
__global__ void __launch_bounds__(NWAVES * 64, 2) mk_fwd(Args args) {
    extern __shared__ __attribute__((aligned(16))) unsigned char lds[];
    Frame F;
    F.lds = (LAS unsigned char*)lds;
    F.tid = threadIdx.x; F.lane = F.tid & 63; F.wave = __builtin_amdgcn_readfirstlane(F.tid >> 6);
    F.G = gridDim.x; { const int bx = blockIdx.x; F.vcu = (F.G % 8 == 0) ? (bx % 8) * (F.G / 8) + bx / 8 : bx; }
    F.gw = F.vcu * NWAVES + F.wave; F.NGW = F.G * NWAVES;
    const CAS Args* ap = (const CAS Args*)__builtin_amdgcn_kernarg_segment_ptr();
    F.ws = ap->ws; F.out = ap->out; F.xlb = (bf16*)(ap->ws + WS_XLB);
    volatile LAS unsigned* MISC = (volatile LAS unsigned*)(F.lds + MISC_OFF);
    for (int u = F.tid; u < (LDS_BYTES - LDSCTL_OFF) / 4; u += NWAVES * 64) ((LAS unsigned*)(F.lds + LDSCTL_OFF))[u] = 0u;
    __syncthreads();
    XcdBarrier bar; bar.bar = (unsigned*)(F.ws + WS_CTL) + CW_BAR; bar.x = 0; bar.st = nullptr;
    const bool fused = (ap->ph_hi - ap->ph_lo) > 1;
    if (fused) bar = xcd_barrier_post((unsigned*)(F.ws + WS_CTL) + CW_BAR, MISC + 8);
    const int lo = ap->ph_lo, hi = ap->ph_hi;
    run_all(F, bar, (LAS unsigned char*)lds, lo, hi, std::make_integer_sequence<int, NPASS * N_PHASES>{});
}

extern "C" void kernel_launch(void* const* d_in, const int* in_sizes, int n_in, void* d_out, int out_size, void* d_ws, size_t ws_size, hipStream_t stream) {
    static int grid = 0;
    if (grid == 0) {
        if (n_in != 22 || out_size != TL * D || ws_size < WS_END) { fprintf(stderr, "kernel_launch: unexpected shapes (n_in %d out %d ws %zu)\n", n_in, out_size, ws_size); grid = -1; return; }
        int dev = 0, cus = 0, per_cu = 0;
        if (hipGetDevice(&dev) != hipSuccess || hipDeviceGetAttribute(&cus, hipDeviceAttributeMultiprocessorCount, dev) != hipSuccess) { grid = -1; return; }
        if (hipFuncSetAttribute((const void*)mk_fwd, hipFuncAttributeMaxDynamicSharedMemorySize, LDS_BYTES) != hipSuccess) { fprintf(stderr, "kernel_launch: hipFuncSetAttribute failed\n"); grid = -1; return; }
        if (hipOccupancyMaxActiveBlocksPerMultiprocessor(&per_cu, (const void*)mk_fwd, NWAVES * 64, LDS_BYTES) != hipSuccess || per_cu < 1) fprintf(stderr, "kernel_launch: occupancy query says %d\n", per_cu);
        (void)hipGetLastError();
        grid = cus;
    }
    if (grid < 0) return;
    (void)hipMemsetAsync((char*)d_ws + WS_CTL, 0, CTL_ZERO_BYTES, stream);
    Args a{};
    for (int i = 0; i < 22; ++i) a.in[i] = (const float*)d_in[i];
    a.out = (float*)d_out; a.ws = (unsigned char*)d_ws; a.li = 0; a.pad = 0;
#if MK_N_LAUNCHES == 1
    a.ph_lo = 0; a.ph_hi = N_PHASES;
    hipLaunchKernelGGL(mk_fwd, dim3(grid), dim3(NWAVES * 64), LDS_BYTES, stream, a);
#else
    for (int ph = 0; ph < N_PHASES; ++ph) { a.ph_lo = ph; a.ph_hi = ph + 1; hipLaunchKernelGGL(mk_fwd, dim3(grid), dim3(NWAVES * 64), LDS_BYTES, stream, a); }
#endif
}
```

```cpp
#include <hip/hip_runtime.h>
#include <cstdio>
#include <cstdint>
#include <utility>

#ifndef GIN_STAG
#define GIN_STAG 0
#endif
#ifndef ALIGN_EPI
#define ALIGN_EPI 1
#endif
#ifndef ONLY_S
#define ONLY_S -1
#endif
#define PH_ON(k) (ONLY_S < 0 || ONLY_S == (k))
#ifndef REPEAT_S
#define REPEAT_S -1
#endif
#ifndef REPEAT_N
#define REPEAT_N 4
#endif
#define REP(k, cond) for (int rep_ = 0; rep_ < ((pass == 1) ? PROBE_R : ((REPEAT_S == (k) && (cond)) ? REPEAT_N : 1)); ++rep_)
#ifndef MK_N_LAUNCHES
#define MK_N_LAUNCHES 1
#endif

#define GAS __attribute__((address_space(1)))
#define LAS __attribute__((address_space(3)))
#define CAS __attribute__((address_space(4)))
typedef unsigned short bf16;
typedef short bf16x8 __attribute__((ext_vector_type(8)));
typedef float f32x4 __attribute__((ext_vector_type(4)));
typedef float f32x2 __attribute__((ext_vector_type(2)));
typedef unsigned u32x4 __attribute__((ext_vector_type(4)));
typedef unsigned u32x2 __attribute__((ext_vector_type(2)));
typedef int v8i __attribute__((ext_vector_type(8)));

constexpr int D = 1024, SEQ = 8192, LC = 256, TL = 16384, TC = 512, TT = TL + TC, DEPTH = 2;
constexpr int NE = 16, DE = 512;
constexpr int NIN = 2816;
constexpr int PC_Q = 0, PC_K = 256, PC_V = 512, PC_G = 1024, PC_SQ = 1536, PC_SK = 2048, PC_SV = 2176, PC_GF = 2304, PC_GB = 2560;
constexpr int WIN_COLS = 2336;
constexpr float EPS = 1e-6f;
constexpr float LOG2E = 1.4426950408889634f, QSCALE = 0.125f * LOG2E;
constexpr int LISTCAP = TT;

constexpr size_t MiB = 1u << 20;
constexpr size_t WS_CTL = 0, CTL_ZERO_BYTES = 131072;
constexpr size_t WS_MOD = 1 * MiB;
constexpr size_t WS_ROPE = 1 * MiB + 256 * 1024;
constexpr size_t WS_LIST = 2 * MiB;
constexpr size_t WS_LISTW = 2 * MiB + 1536 * 1024;
constexpr size_t WS_XC = 5 * MiB;
constexpr size_t WS_WIN = 8 * MiB;
constexpr size_t WS_WOUT = 19 * MiB;
constexpr size_t WS_WGU = 23 * MiB;
constexpr size_t WS_WD = 87 * MiB;
constexpr size_t WS_XLB = 55 * MiB;
constexpr size_t WS_H = 119 * MiB;
constexpr size_t WS_P = 152 * MiB;
constexpr size_t WS_MIX = 243 * MiB;
constexpr size_t WS_GL = 276 * MiB;
constexpr size_t WS_HMID = 152 * MiB;
constexpr size_t WS_Y = 190 * MiB;
constexpr size_t WS_END = 309 * MiB;
static_assert(WS_LIST + (size_t)NE * LISTCAP * 4 <= WS_LISTW && WS_LISTW + (size_t)NE * LISTCAP * 4 <= WS_XC, "ws map");
static_assert(WS_P + (size_t)TT * NIN * 2 <= WS_MIX && WS_MIX + (size_t)TT * D * 2 <= WS_GL, "ws map");
static_assert(WS_HMID + (size_t)37888 * 512 * 2 <= WS_Y && WS_Y + (size_t)2 * TT * D * 2 <= WS_GL, "ws map");
constexpr int CW_CNT = 8192, CNT_STRIDE = 64;
constexpr int CW_TDONE = 16384;
constexpr int CW_BAR = 4096;

__device__ __forceinline__ unsigned f2bf(float f) { unsigned u = __builtin_bit_cast(unsigned, f); return (u + 0x7fffu + ((u >> 16) & 1u)) >> 16; }
__device__ __forceinline__ unsigned pk2(float lo, float hi) { return f2bf(lo) | (f2bf(hi) << 16); }
__device__ __forceinline__ float bf2f(unsigned h) { return __builtin_bit_cast(float, h << 16); }
__device__ __forceinline__ float bflo(unsigned w) { return __builtin_bit_cast(float, w << 16); }
__device__ __forceinline__ float bfhi(unsigned w) { return __builtin_bit_cast(float, w & 0xffff0000u); }
__device__ __forceinline__ float dpp_add(float v, float t) { return v + t; }
#define DPP_F(v, ctrl, rmask) __builtin_bit_cast(float, __builtin_amdgcn_update_dpp(0, __builtin_bit_cast(int, (v)), (ctrl), (rmask), 0xF, false))
__device__ __forceinline__ float row16_sum(float v) {
    v += DPP_F(v, 0xB1, 0xF); v += DPP_F(v, 0x4E, 0xF); v += DPP_F(v, 0x141, 0xF); v += DPP_F(v, 0x140, 0xF); return v;
}
__device__ __forceinline__ float wave_sum(float v) {
    v = row16_sum(v);
    v += DPP_F(v, 0x142, 0xA); v += DPP_F(v, 0x143, 0xC);
    return __builtin_bit_cast(float, __builtin_amdgcn_readlane(__builtin_bit_cast(int, v), 63));
}
__device__ __forceinline__ float silu_f(float x) { return x / (1.0f + __expf(-x)); }
__device__ __forceinline__ unsigned pk4_fp8(float a, float b, float c, float d) {
    a = fminf(fmaxf(a, -448.f), 448.f); b = fminf(fmaxf(b, -448.f), 448.f); c = fminf(fmaxf(c, -448.f), 448.f); d = fminf(fmaxf(d, -448.f), 448.f);
    int w = __builtin_amdgcn_cvt_pk_fp8_f32(a, b, 0, false); w = __builtin_amdgcn_cvt_pk_fp8_f32(c, d, w, true); return (unsigned)w;
}
constexpr float W1_SCALE = 64.f, W2_SCALE = 32.f, HMID_SCALE = 4.f, MIX_SCALE = 4.f;
constexpr int SC_ONE = 127, SC_W1 = 121, SC_W2 = 122, SC_HMID = 125;
#define LDS_BARRIER() asm volatile("s_waitcnt lgkmcnt(0)\n\ts_barrier" ::: "memory")
#define LDS_WAIT() asm volatile("s_waitcnt lgkmcnt(0)" ::: "memory")
#define VM_WAIT() asm volatile("s_waitcnt vmcnt(0)" ::: "memory")

namespace pg8 {
constexpr int BM = 256, BK = 64, HALF = 128, HTB = HALF * BK * 2, STAGE_BYTES = 8 * HTB, NXCD = 8, WGM = 8;
__host__ __device__ __forceinline__ int lds_byte(int r, int c) { const int st = (r >> 4) * 2 + (c >> 5), rr = r & 15, cc = c & 31, ob = rr * 64 + cc * 2; return st * 1024 + (ob ^ (((ob >> 9) & 1) << 5)); }
__host__ __device__ __forceinline__ void stage_rc(int b, int& R, int& C) { const int st = b / 1024, sb = b % 1024, swz = sb ^ (((sb >> 9) & 1) << 5); R = (st >> 1) * 16 + swz / 64; C = (st & 1) * 32 + (swz % 64) / 2; }
__host__ __device__ __forceinline__ int perm32(int rho) { const int n = rho >> 4, i = rho & 15; return 8 * (i >> 2) + 4 * n + (i & 3); }

struct Unit { int pm, pn, e, mt; };

__device__ __forceinline__ int xcd_remap(int wgid, int nwg) { const int q = nwg / NXCD, r = nwg % NXCD, xcd = wgid % NXCD, off = wgid / NXCD; return (xcd < r ? xcd * (q + 1) : r * (q + 1) + (xcd - r) * q) + off; }

struct DenseOrder {
    static constexpr bool DYN_A = false;
    const char* A; const char* Bt; int K; int nM, nN, nwg, G, c;
    __device__ void init(const void* A_, const void* Bt_, int M, int N, int K_, int G_, int c_) { A = (const char*)A_; Bt = (const char*)Bt_; K = K_; nM = M / BM; nN = N / BM; nwg = nM * nN; G = G_; c = c_; }
    __device__ __forceinline__ bool next(int i, Unit& u) const {
        const long L = (long)i * G + c; if (L >= nwg) return false;
        const int wgid = xcd_remap((int)L, nwg);
        const int nig = WGM * nN, gid = wgid / nig, fm = gid * WGM, gsz = (nM - fm) < WGM ? (nM - fm) : WGM;
        u.pm = fm + ((wgid % nig) % gsz); u.pn = (wgid % nig) / gsz; u.e = 0; u.mt = 0; return true;
    }
    __device__ __forceinline__ void a_ready(const Unit&, int) const {}
    __device__ __forceinline__ void done(const Unit&, int) const {}
    __device__ __forceinline__ const char* a_ptr(const Unit& u) const { return A + (size_t)u.pm * (size_t)(BM * K * 2); }
    __device__ __forceinline__ const char* b_ptr(const Unit& u) const { return Bt + (size_t)u.pn * (size_t)(BM * K * 2); }
    __device__ __forceinline__ void a_voff(const Unit&, const int (&R)[2], const int (&C)[2], unsigned (&v0)[2], unsigned (&v1)[2]) const {
#pragma unroll
        for (int i = 0; i < 2; ++i) { v0[i] = (unsigned)(R[i] * K + C[i]) * 2u; v1[i] = v0[i] + (unsigned)(HALF * K * 2); }
    }
};

struct MoeOrder {
    static constexpr bool DYN_A = true;
    const char* A; const char* Bt; int K; size_t bstride_e; int G, c, nunits, nN; bool gather;
    const unsigned* list; const LAS int* tab;
    unsigned* tdone; int role;
    __device__ __forceinline__ void a_ready(const Unit& u, int wid) const {
        if (role == 2) {
            if (wid == 0) { unsigned sp = 0;
                while (__hip_atomic_load(tdone + u.pm * 16, __ATOMIC_RELAXED, __HIP_MEMORY_SCOPE_AGENT) < 32u) { __builtin_amdgcn_s_sleep(2); if (++sp > (1u << 22)) break; }
                __builtin_amdgcn_fence(__ATOMIC_ACQUIRE, "agent"); asm volatile("s_waitcnt vmcnt(0)" ::: "memory"); }
            __builtin_amdgcn_s_barrier();
        }
    }
    __device__ __forceinline__ void done(const Unit& u, int lane) const {
        if (role == 1) { asm volatile("s_waitcnt vmcnt(0)" ::: "memory");
            if (lane == 0) __hip_atomic_fetch_add(tdone + u.pm * 16, 1u, __ATOMIC_RELAXED, __HIP_MEMORY_SCOPE_AGENT); }
    }
    __device__ __forceinline__ bool next(int i, Unit& u) const {
        const long L = (long)i * G + c; if (L >= nunits) return false;
        const int wgid = xcd_remap((int)L, nunits);
        const int tl = wgid / nN; u.pn = wgid % nN;
        int e = 0, tstart = 0;
#pragma unroll 1
        for (int k = 0; k < NE - 1; ++k) { const int te = tab[16 + k]; if (tl >= te) { e = k + 1; tstart = te; } }
        u.e = __builtin_amdgcn_readfirstlane(e); u.mt = __builtin_amdgcn_readfirstlane(tl - tstart); u.pm = tl; return true;
    }
    __device__ __forceinline__ const char* a_ptr(const Unit& u) const { return gather ? A : A + (size_t)u.pm * (size_t)(BM * K * 2); }
    __device__ __forceinline__ const char* b_ptr(const Unit& u) const { return Bt + (size_t)u.e * bstride_e + (size_t)u.pn * (size_t)(BM * K * 2); }
    __device__ __forceinline__ void a_voff(const Unit& u, const int (&R)[2], const int (&C)[2], unsigned (&v0)[2], unsigned (&v1)[2]) const {
        if (gather) {
            const int ce = tab[u.e];
            const unsigned* lp = list + (size_t)u.e * LISTCAP + u.mt * BM;
#pragma unroll
            for (int i = 0; i < 2; ++i) {
                const int r0 = R[i], r1 = R[i] + HALF;
                const unsigned t0 = (u.mt * BM + r0 < ce) ? (__builtin_nontemporal_load(lp + r0) >> 1) : 0u;
                const unsigned t1 = (u.mt * BM + r1 < ce) ? (__builtin_nontemporal_load(lp + r1) >> 1) : 0u;
                v0[i] = (t0 * (unsigned)K + (unsigned)C[i]) * 2u; v1[i] = (t1 * (unsigned)K + (unsigned)C[i]) * 2u;
            }
        } else {
#pragma unroll
            for (int i = 0; i < 2; ++i) { v0[i] = (unsigned)(R[i] * K + C[i]) * 2u; v1[i] = v0[i] + (unsigned)(HALF * K * 2); }
        }
    }
};

__device__ __forceinline__ unsigned cvt_pk_bf16(float lo, float hi) { unsigned r; asm volatile("v_cvt_pk_bf16_f32 %0, %1, %2" : "=v"(r) : "v"(lo), "v"(hi)); return r; }

template <class Epi, class Sched, bool F8 = false>
__device__ __forceinline__ void gemm_phase(LAS unsigned char* lds, int tid, const Sched& S, const Epi& E, int sc_w = 127, int sc_a = 127, int stag = 0) {
    if (stag) {
        const unsigned long long t0 = __builtin_amdgcn_s_memrealtime(), dl = (unsigned long long)((blockIdx.x >> 3) & 3) * (unsigned)stag;
        while (__builtin_amdgcn_s_memrealtime() - t0 < dl) __builtin_amdgcn_s_sleep(8);
    }
    const int wid = __builtin_amdgcn_readfirstlane(tid >> 6), lane = tid & 63, wr = wid >> 2, wc = wid & 3, fr = lane & 15, fq = lane >> 4;
    const int K = S.K, nt = K / BK;
    int Rr[2], Cc[2]; unsigned voffB[2];
#pragma unroll
    for (int i = 0; i < 2; ++i) { int R, C; stage_rc(tid * 16 + i * 8192, R, C); const int Rb = Epi::PERM ? ((R & ~31) + perm32(R & 31)) : R;
        Rr[i] = R; Cc[i] = C; voffB[i] = (unsigned)(Rb * K + C) * 2u; }
    const size_t kstep = (size_t)(BK * 2);
    const size_t hstep = (size_t)HALF * K * 2;
    const unsigned ldsw = (unsigned)wid * 1024u;
    const int aoff = lds_byte(wr * 64 + fr, fq * 8), boff = lds_byte(wc * 32 + fr, fq * 8);
#define PG8_SA(b, h) (((b) * 2 + (h)) * HTB)
#define PG8_SB(b, h) ((4 + (b) * 2 + (h)) * HTB)
#define PG8_STAGE(bufoff, gbase, voff) do { _Pragma("unroll") for (int _i = 0; _i < 2; ++_i) \
        __builtin_amdgcn_global_load_lds((const unsigned*)((const char*)(gbase) + (voff)[_i]), (LAS unsigned*)(lds + (bufoff) + ldsw + _i * 8192), 16, 0, 0); } while (0)
#define PG8_CAT(lo_, hi_) ((v8i){(int)(lo_).x, (int)(lo_).y, (int)(lo_).z, (int)(lo_).w, (int)(hi_).x, (int)(hi_).y, (int)(hi_).z, (int)(hi_).w})
#define PG8_LDA(dst, b, h) do { _Pragma("unroll") for (int m = 0; m < 4; ++m) { if constexpr (F8) { const u32x4 l_ = *(const LAS u32x4*)(lds + PG8_SA(b, h) + aoff + m * 2048), h_ = *(const LAS u32x4*)(lds + PG8_SA(b, h) + aoff + m * 2048 + 1024); dst##8[m] = PG8_CAT(l_, h_); } \
        else { _Pragma("unroll") for (int k = 0; k < 2; ++k) dst[m][k] = *(const LAS bf16x8*)(lds + PG8_SA(b, h) + aoff + m * 2048 + k * 1024); } } } while (0)
#define PG8_LDB(dst, b, h) do { _Pragma("unroll") for (int n = 0; n < 2; ++n) { if constexpr (F8) { const u32x4 l_ = *(const LAS u32x4*)(lds + PG8_SB(b, h) + boff + n * 2048), h_ = *(const LAS u32x4*)(lds + PG8_SB(b, h) + boff + n * 2048 + 1024); dst##8[n] = PG8_CAT(l_, h_); } \
        else { _Pragma("unroll") for (int k = 0; k < 2; ++k) dst[n][k] = *(const LAS bf16x8*)(lds + PG8_SB(b, h) + boff + n * 2048 + k * 1024); } } } while (0)
#define PG8_MMA(ai, bj, At, Bt) do { __builtin_amdgcn_s_setprio(1); _Pragma("unroll") for (int m = 0; m < 4; ++m) _Pragma("unroll") for (int n = 0; n < 2; ++n) { \
        if constexpr (F8) asm volatile("v_mfma_scale_f32_16x16x128_f8f6f4 %0, %1, %2, %0, %3, %4 op_sel_hi:[0,0,0]" : "+v"(acc[ai][bj][m][n]) : "v"(Bt##8[n]), "v"(At##8[m]), "v"(sc_w), "v"(sc_a)); \
        else { _Pragma("unroll") for (int k = 0; k < 2; ++k) acc[ai][bj][m][n] = __builtin_amdgcn_mfma_f32_16x16x32_bf16(Bt[n][k], At[m][k], acc[ai][bj][m][n], 0, 0, 0); } } \
        __builtin_amdgcn_s_setprio(0); } while (0)
#define PG8_WAIT_V(n) asm volatile("s_waitcnt vmcnt(" #n ")" ::: "memory")
#define PG8_WAIT_L(n) asm volatile("s_waitcnt lgkmcnt(" #n ")" ::: "memory")
#define PG8_BAR __builtin_amdgcn_s_barrier()
#define PG8_SCHED __builtin_amdgcn_sched_barrier(0)
    Unit cur, nxt; int ui = 0;
    if (!S.next(0, cur)) return;
    f32x4 acc[2][2][4][2];
#pragma unroll
    for (int a = 0; a < 2; ++a)
#pragma unroll
        for (int b = 0; b < 2; ++b)
#pragma unroll
            for (int m = 0; m < 4; ++m)
#pragma unroll
                for (int n = 0; n < 2; ++n) acc[a][b][m][n] = (f32x4){0.f, 0.f, 0.f, 0.f};
    bf16x8 At[4][2], B0[2][2], B1[2][2]; v8i At8[4], B08[2], B18[2];
    const char* cA = S.a_ptr(cur); const char* cB = S.b_ptr(cur);
    unsigned cv0[2], cv1[2], nv0[2], nv1[2];
    S.a_ready(cur, wid);
    S.a_voff(cur, Rr, Cc, cv0, cv1);
    PG8_STAGE(PG8_SB(0, 0), cB, voffB); PG8_STAGE(PG8_SB(0, 1), cB + hstep, voffB); PG8_STAGE(PG8_SA(0, 0), cA, cv0); PG8_STAGE(PG8_SA(0, 1), cA, cv1);
    if (wr == 1) PG8_BAR;
    PG8_WAIT_V(2); PG8_BAR;
    PG8_STAGE(PG8_SB(1, 0), cB + kstep, voffB); PG8_STAGE(PG8_SA(1, 0), cA + kstep, cv0); PG8_STAGE(PG8_SB(1, 1), cB + hstep + kstep, voffB);
    PG8_WAIT_V(6); PG8_BAR;
    for (;;) {
        const bool has_next = S.next(ui + 1, nxt);
        const char* nA = has_next ? S.a_ptr(nxt) : cA; const char* nB = has_next ? S.b_ptr(nxt) : cB;
        if (has_next) S.a_voff(nxt, Rr, Cc, nv0, nv1); else { nv0[0] = cv0[0]; nv0[1] = cv0[1]; nv1[0] = cv1[0]; nv1[1] = cv1[1]; }
        if constexpr (Sched::DYN_A) asm volatile("" : "+v"(nv0[0]), "+v"(nv0[1]), "+v"(nv1[0]), "+v"(nv1[1]));
        for (int t = 0; t < nt; t += 2) {
            const bool last = (t == nt - 2);
            if (last && has_next) S.a_ready(nxt, wid);
            const char* a1 = cA + (size_t)(t + 1) * kstep;
            const char* a2 = last ? nA : cA + (size_t)(t + 2) * kstep; const char* b2 = last ? nB : cB + (size_t)(t + 2) * kstep;
            const char* a3 = a2 + kstep; const char* b3 = b2 + kstep;
            unsigned w0[2], w1[2];
            w0[0] = last ? nv0[0] : cv0[0]; w0[1] = last ? nv0[1] : cv0[1]; w1[0] = last ? nv1[0] : cv1[0]; w1[1] = last ? nv1[1] : cv1[1];
            PG8_LDB(B0, 0, 0); PG8_LDB(B1, 0, 1); PG8_SCHED; PG8_LDA(At, 0, 0); PG8_STAGE(PG8_SA(1, 1), a1, cv1);
            PG8_WAIT_V(8); PG8_WAIT_L(0); PG8_BAR; PG8_MMA(0, 0, At, B0); PG8_MMA(0, 1, At, B1); PG8_BAR; PG8_SCHED;
            PG8_LDA(At, 0, 1); PG8_STAGE(PG8_SB(0, 0), b2, voffB); PG8_STAGE(PG8_SB(0, 1), b2 + hstep, voffB); PG8_STAGE(PG8_SA(0, 0), a2, w0);
            PG8_WAIT_V(8); PG8_WAIT_L(0); PG8_BAR; PG8_MMA(1, 0, At, B0); PG8_MMA(1, 1, At, B1); PG8_BAR; PG8_SCHED;
            PG8_LDB(B0, 1, 0); PG8_LDB(B1, 1, 1); PG8_SCHED; PG8_LDA(At, 1, 0); PG8_STAGE(PG8_SA(0, 1), a2, w1);
            PG8_WAIT_V(8); PG8_WAIT_L(0); PG8_BAR; PG8_MMA(0, 0, At, B0); PG8_MMA(0, 1, At, B1); PG8_BAR; PG8_SCHED;
            PG8_LDA(At, 1, 1); PG8_STAGE(PG8_SB(1, 0), b3, voffB); PG8_STAGE(PG8_SB(1, 1), b3 + hstep, voffB); PG8_STAGE(PG8_SA(1, 0), a3, w0);
            PG8_WAIT_V(8); PG8_WAIT_L(0); PG8_BAR; PG8_MMA(1, 0, At, B0); PG8_MMA(1, 1, At, B1); PG8_BAR; PG8_SCHED;
        }
        if constexpr (F8) asm volatile("s_nop 15\n\ts_nop 15" ::: "memory");
        if (ALIGN_EPI) { if (wr == 0) PG8_BAR; }
        E(acc, cur, wr, wc, fr, fq);
        S.done(cur, lane);
        if (!has_next) break;
#pragma unroll
        for (int a = 0; a < 2; ++a)
#pragma unroll
            for (int b = 0; b < 2; ++b)
#pragma unroll
                for (int m = 0; m < 4; ++m)
#pragma unroll
                    for (int n = 0; n < 2; ++n) acc[a][b][m][n] = (f32x4){0.f, 0.f, 0.f, 0.f};
        cur = nxt; cA = nA; cB = nB; ++ui;
        cv0[0] = nv0[0]; cv0[1] = nv0[1]; cv1[0] = nv1[0]; cv1[1] = nv1[1];
        if (ALIGN_EPI) { if (wr == 1) PG8_BAR; }
    }
    PG8_WAIT_V(0);
    if (!ALIGN_EPI) { if (wr == 0) PG8_BAR; }
    PG8_BAR;
#undef PG8_SA
#undef PG8_SB
#undef PG8_STAGE
#undef PG8_CAT
#undef PG8_LDA
#undef PG8_LDB
#undef PG8_MMA
#undef PG8_WAIT_V
#undef PG8_WAIT_L
#undef PG8_BAR
#undef PG8_SCHED
}
}

#define XB_TMO      128
#define XB_XCNT(j)  (256  + 64 * (j))
#define XB_XSUB(j)  (1280 + 64 * (j))
#define XB_XGEN(j)  (2304 + 64 * (j))
#define XB_TOP      3328
#define XB_TOPGEN   3392
#define XCD_BAR_WORDS 3456
#define XB_SPIN_CAP (1u << 18)
__device__ __forceinline__ unsigned xb_ld(unsigned* p)              { return __hip_atomic_load(p, __ATOMIC_RELAXED, __HIP_MEMORY_SCOPE_AGENT); }
__device__ __forceinline__ unsigned xb_add(unsigned* p, unsigned v) { return __hip_atomic_fetch_add(p, v, __ATOMIC_RELAXED, __HIP_MEMORY_SCOPE_AGENT); }
__device__ __forceinline__ unsigned xb_xcc_id() { return (unsigned)__builtin_amdgcn_s_getreg((3 << 11) | 20) & 0xFu; }
#define XB_SPIN(cond, bar) do { unsigned _sp = 0; while (cond) { __builtin_amdgcn_s_sleep(1); \
    if ((++_sp & 255u) == 0u) { if (xb_ld(&(bar)[XB_TMO])) break; if (_sp > XB_SPIN_CAP) { atomicAdd(&(bar)[XB_TMO], 1u); break; } } } } while (0)
struct XcdBarrier { unsigned* bar; unsigned x; volatile LAS unsigned* st; };
__device__ __forceinline__ XcdBarrier xcd_barrier_post(unsigned* bar, volatile LAS unsigned* st) {
    XcdBarrier b; b.bar = bar; b.x = xb_xcc_id(); b.st = st;
    if (threadIdx.x == 0) (void)xb_add(&bar[XB_XCNT(b.x)], 1u);
    return b;
}
__device__ __forceinline__ void xcd_barrier_complete(unsigned* bar, unsigned x, unsigned& nloc, unsigned& nx) {
    const unsigned G = gridDim.x * gridDim.y * gridDim.z;
    unsigned sum, cnt, mine, sp = 0u;
    for (;;) {
        sum = 0u; cnt = 0u; mine = 0u;
#pragma unroll
        for (unsigned j = 0; j < 16; ++j) { const unsigned c = xb_ld(&bar[XB_XCNT(j)]); sum += c; cnt += (c > 0u) ? 1u : 0u; mine = (j == x) ? c : mine; }
        if (sum == G) break;
        __builtin_amdgcn_s_sleep(1);
        if ((++sp & 255u) == 0u) { if (xb_ld(&bar[XB_TMO])) break; if (sp > XB_SPIN_CAP) { atomicAdd(&bar[XB_TMO], 1u); break; } }
    }
    nloc = mine > 0u ? mine : 1u; nx = cnt > 0u ? cnt : 1u;
}
__device__ __forceinline__ void xcd_barrier(const XcdBarrier& b, int tid) {
    asm volatile("s_waitcnt vmcnt(0)" ::: "memory");
    __syncthreads();
    if (tid == 0) {
        unsigned* bar = b.bar;
        __builtin_amdgcn_s_waitcnt(0);
        unsigned nloc = b.st[0], nx = b.st[1];
        if (nloc == 0u) { xcd_barrier_complete(bar, b.x, nloc, nx); b.st[0] = nloc; b.st[1] = nx; }
        const unsigned old = xb_add(&bar[XB_XSUB(b.x)], 1u);
        const unsigned gen = old / nloc;
        if (old + 1u == (gen + 1u) * nloc) {
            __builtin_amdgcn_fence(__ATOMIC_RELEASE, "agent");
            asm volatile("s_waitcnt vmcnt(0)" ::: "memory");
            const unsigned og = xb_add(&bar[XB_TOP], 1u);
            const unsigned tg = og / nx;
            if (og + 1u == (tg + 1u) * nx) xb_add(&bar[XB_TOPGEN], 1u);
            else XB_SPIN(xb_ld(&bar[XB_TOPGEN]) == tg, bar);
            __builtin_amdgcn_fence(__ATOMIC_ACQUIRE, "agent");
            xb_add(&bar[XB_XGEN(b.x)], 1u);
            asm volatile("s_waitcnt vmcnt(0)" ::: "memory");
        } else {
            XB_SPIN(xb_ld(&bar[XB_XGEN(b.x)]) == gen, bar);
            __builtin_amdgcn_fence(__ATOMIC_ACQUIRE, "agent");
            asm volatile("s_waitcnt vmcnt(0)" ::: "memory");
        }
    }
    __syncthreads();
}

constexpr int NWAVES = 8;
constexpr int RING_BYTES = 131072, LDSCTL_OFF = RING_BYTES, MISC_OFF = LDSCTL_OFF + 320, LDS_BYTES = 147456;
struct Args { const float* in[22]; float* out; unsigned char* ws; int ph_lo, ph_hi, li, pad; };
enum { I_X = 0, I_C, I_CTX, I_CCTX, I_WADA, I_BADA, I_NORM1, I_NORM2, I_WIN, I_UPF, I_BIASF, I_UPB, I_BIASB, I_GLANORM, I_SINK, I_WOUT, I_WROUTER, I_BROUTER, I_WGATE, I_WUP, I_WDOWN, I_FNORM };

struct Frame {
    LAS unsigned char* lds; int tid, lane, wave, vcu, G, gw, NGW;
    unsigned char* ws; float* out; bf16* xlb;
};

__device__ __forceinline__ int rope_pos(int d) { return 8 * ((d & 15) >> 2) + 4 * (d >> 4) + (d & 3); }
__device__ __forceinline__ int gu_row(int h, int gu) { return (h >> 7) * 256 + ((h >> 2) & 1) * 128 + ((h >> 5) & 3) * 32 + ((h >> 3) & 3) * 8 + gu * 4 + (h & 3); }
struct TItem { const float* src; bf16* dst; int N, Kd, n0, rbase, mode; bool ok; float f8scale; };
__device__ __forceinline__ void titem_load(const TItem& t, int lane, f32x4 (&v)[8]) {
    const int g = lane >> 3, i8 = lane & 7;
    const float* src = t.src + (size_t)(8 * g) * t.N + 4 * i8;
#pragma unroll
    for (int q = 0; q < 8; ++q) v[q] = *(const f32x4*)(src + (size_t)q * t.N);
}
__device__ __forceinline__ void titem_store(const TItem& t, int lane, const f32x4 (&v)[8]) {
    const int g = lane >> 3, i8 = lane & 7;
#pragma unroll
    for (int i = 0; i < 4; ++i) {
        const int n = 4 * i8 + i;
        const int row = (t.mode == 0) ? t.rbase + n : (t.mode == 1) ? t.rbase + rope_pos(n) : gu_row(t.n0 + n, t.mode - 2);
        if (t.f8scale != 0.f) {
            const float sc = t.f8scale; u32x2 o; o.x = pk4_fp8(v[0][i] * sc, v[1][i] * sc, v[2][i] * sc, v[3][i] * sc); o.y = pk4_fp8(v[4][i] * sc, v[5][i] * sc, v[6][i] * sc, v[7][i] * sc);
            *(u32x2*)((unsigned char*)t.dst + (size_t)row * t.Kd + 8 * g) = o;
        } else {
            u32x4 o; o.x = pk2(v[0][i], v[1][i]); o.y = pk2(v[2][i], v[3][i]); o.z = pk2(v[4][i], v[5][i]); o.w = pk2(v[6][i], v[7][i]);
            *(u32x4*)(t.dst + (size_t)row * t.Kd + 8 * g) = o;
        }
    }
}
constexpr int IT_IN = 2 * 16 * 73, IT_OUT = 2 * 16 * 32, IT_G = 32 * 16 * 16, IT_D = 32 * 8 * 32, NITEMS = IT_IN + IT_OUT + 2 * IT_G + IT_D;
__device__ __forceinline__ TItem titem_decode(const CAS Args* a, unsigned char* ws, int it) {
    TItem t; t.ok = it < NITEMS; t.mode = 0; t.rbase = 0; t.n0 = 0; t.N = D; t.Kd = D; t.src = nullptr; t.dst = nullptr; t.f8scale = 0.f;
    if (!t.ok) return t;
    int r = it;
    if (r < IT_IN) {
        const int l = r / 1168, rr = r % 1168, kb = rr / 73, nb = rr % 73;
        if (nb == 48) { t.ok = false; return t; }
        const int n0 = nb * 32; t.n0 = n0;
        if (n0 < 1536) t.rbase = n0;
        else if (n0 < 2080) { t.rbase = PC_SQ + (n0 - 1568); t.mode = 1; }
        else if (n0 < 2208) { t.rbase = PC_SK + (n0 - 2080); t.mode = 1; }
        else t.rbase = PC_SV + (n0 - 2208);
        t.N = WIN_COLS; t.Kd = D; t.src = a->in[I_WIN] + (size_t)l * D * WIN_COLS + (size_t)(kb * 64) * WIN_COLS + n0; t.dst = (bf16*)(ws + WS_WIN + (size_t)l * NIN * D + kb * 64); t.f8scale = W1_SCALE;
        return t;
    }
    r -= IT_IN;
    if (r < IT_OUT) { const int l = r / 512, rr = r % 512, kb = rr / 32, nb = rr % 32;
        t.n0 = nb * 32; t.rbase = nb * 32; t.N = D; t.Kd = D; t.src = a->in[I_WOUT] + (size_t)l * D * D + (size_t)(kb * 64) * D + nb * 32; t.dst = (bf16*)(ws + WS_WOUT + (size_t)l * D * D + kb * 64); t.f8scale = W1_SCALE; return t; }
    r -= IT_OUT;
    if (r < 2 * IT_G) { const int gu = r / IT_G, r2 = r % IT_G, le = r2 / 256, rr = r2 % 256, kb = rr / 16, nb = rr % 16;
        t.n0 = nb * 32; t.mode = 2 + gu; t.N = DE; t.Kd = D; t.src = a->in[gu ? I_WUP : I_WGATE] + (size_t)le * D * DE + (size_t)(kb * 64) * DE + nb * 32; t.dst = (bf16*)(ws + WS_WGU + (size_t)le * D * D + kb * 64); t.f8scale = W1_SCALE; return t; }
    r -= 2 * IT_G;
    { const int le = r / 256, rr = r % 256, kb = rr / 32, nb = rr % 32;
        t.n0 = nb * 32; t.rbase = nb * 32; t.N = D; t.Kd = DE; t.src = a->in[I_WDOWN] + (size_t)le * DE * D + (size_t)(kb * 64) * D + nb * 32; t.dst = (bf16*)(ws + WS_WD + (size_t)le * D * DE + kb * 64); t.f8scale = W2_SCALE; }
    return t;
}

template <class Map>
__device__ __forceinline__ void convert_items(const Frame& F, const CAS Args* a, int n, int worker, int nworkers, Map map) {
    unsigned char* ws = F.ws;
    for (int i = worker; i < n; i += 2 * nworkers) {
        const int i2 = i + nworkers;
        const TItem ta = titem_decode(a, ws, map(i)), tb = titem_decode(a, ws, i2 < n ? map(i2) : NITEMS);
        f32x4 va[8], vb[8];
        if (ta.ok) titem_load(ta, F.lane, va);
        if (tb.ok) titem_load(tb, F.lane, vb);
        if (ta.ok) titem_store(ta, F.lane, va);
        if (tb.ok) titem_store(tb, F.lane, vb);
    }
}
struct MapSmall { __device__ __forceinline__ int operator()(int i) const { return i; } };
struct MapMoe { int l; __device__ __forceinline__ int operator()(int i) const { const int kind = i >> 12, r = i & 4095; return IT_IN + IT_OUT + (kind < 2 ? kind * IT_G : 2 * IT_G) + l * 4096 + r; } };
__device__ __forceinline__ void convert_moe_filler(const Frame& F, const CAS Args* a, int l, int nunits, bool both = false) {
    const int c = (int)blockIdx.x, nfull = nunits % F.G;
    int first = nfull, nf = F.G - nfull - (both ? nfull : 0);
    if (nfull == 0 || nf <= 0) { first = 0; nf = F.G; }
    if (c < first || c >= first + nf) return;
    convert_items(F, a, 3 * 4096, (c - first) * NWAVES + F.wave, nf * NWAVES, MapMoe{l});
}

__device__ __forceinline__ void p0_convert(const Frame& F, const CAS Args* a) {
    unsigned char* ws = F.ws;
    convert_items(F, a, IT_IN + IT_OUT, F.gw, F.NGW, MapSmall{});
    for (int idx = F.gw * 64 + F.lane; idx < 2 * 2 * 256 * 128; idx += F.NGW * 64) {
        const int kc = idx & 127, n = (idx >> 7) & 255, dir = (idx >> 15) & 1, l = idx >> 16;
        const float* up = a->in[dir ? I_UPB : I_UPF] + (size_t)l * 16 * 256 + n;
        float u[16];
#pragma unroll
        for (int r = 0; r < 16; ++r) u[r] = up[r * 256];
        float o[8];
#pragma unroll
        for (int kk = 0; kk < 8; ++kk) {
            const f32x4* wz = (const f32x4*)(a->in[I_WIN] + ((size_t)l * D + kc * 8 + kk) * WIN_COLS + 1536 + dir * 16);
            float s = 0.f;
#pragma unroll
            for (int q = 0; q < 4; ++q) { const f32x4 w = wz[q]; s += w[0] * u[4 * q] + w[1] * u[4 * q + 1] + w[2] * u[4 * q + 2] + w[3] * u[4 * q + 3]; }
            o[kk] = s;
        }
        u32x2 ov; ov.x = pk4_fp8(o[0] * W1_SCALE, o[1] * W1_SCALE, o[2] * W1_SCALE, o[3] * W1_SCALE); ov.y = pk4_fp8(o[4] * W1_SCALE, o[5] * W1_SCALE, o[6] * W1_SCALE, o[7] * W1_SCALE);
        *(u32x2*)(ws + WS_WIN + ((size_t)l * NIN + PC_GF + dir * 256 + n) * D + kc * 8) = ov;
    }
}
__device__ __forceinline__ void p0_prologue(const Frame& F, const CAS Args* a) {
    unsigned char* ws = F.ws;
    if (blockIdx.x == (unsigned)(F.G - 1)) {
        float* tc = (float*)(ws + WS_ROPE); float* tsn = tc + 2048;
        for (int i = F.tid; i < 2048; i += NWAVES * 64) { const int pos = i >> 4, j = i & 15; const float inv = powf(10000.0f, -(float)j * (1.0f / 16.0f)); const float ang = (float)pos * inv;
            tc[i] = cosf(ang); tsn[i] = sinf(ang); }
    }
    __syncthreads();
    {
        LAS float* cs = (LAS float*)F.lds; LAS float* red = cs + 3072;
        for (int i = F.tid; i < 3072; i += NWAVES * 64) { const int v = i >> 10, k = i & 1023; const float cv = v < 2 ? a->in[I_C][v * D + k] : a->in[I_CCTX][k]; cs[i] = cv / (1.0f + expf(-cv)); }
        __syncthreads();
        for (int u = blockIdx.x; u < 192; u += F.G) {
            const int l = u / 96, jg = u % 96, jl = F.tid & 63, ks = F.tid >> 6;
            const float* wp = a->in[I_WADA] + ((size_t)l * D + ks * 128) * 6144 + jg * 64 + jl;
            float a0 = 0.f, a1 = 0.f, a2 = 0.f;
#pragma unroll 1
            for (int k0 = 0; k0 < 128; k0 += 32) {
                float wv[32];
#pragma unroll
                for (int k = 0; k < 32; ++k) wv[k] = wp[(size_t)(k0 + k) * 6144];
#pragma unroll
                for (int k = 0; k < 32; ++k) { const int kk = ks * 128 + k0 + k; a0 += cs[kk] * wv[k]; a1 += cs[1024 + kk] * wv[k]; a2 += cs[2048 + kk] * wv[k]; }
            }
            red[(ks * 3 + 0) * 64 + jl] = a0; red[(ks * 3 + 1) * 64 + jl] = a1; red[(ks * 3 + 2) * 64 + jl] = a2;
            __syncthreads();
            if (F.tid < 192) { const int v = F.tid >> 6, j2 = F.tid & 63; float s = 0.f;
#pragma unroll
                for (int q = 0; q < 8; ++q) s += red[(q * 3 + v) * 64 + j2];
                ((float*)(ws + WS_MOD))[(l * 3 + v) * 6144 + jg * 64 + j2] = s + a->in[I_BADA][l * 6144 + jg * 64 + j2]; }
            __syncthreads();
        }
    }
}

__device__ __forceinline__ f32x4 ld_y4(const bf16* p) { const u32x2 w = *(const u32x2*)p; return (f32x4){bflo(w.x), bfhi(w.x), bflo(w.y), bfhi(w.y)}; }
__device__ __forceinline__ void n1_load(const Frame& F, const CAS Args* a, int l, int m, f32x4 (&x)[4], f32x4 (&y)[4]) {
    unsigned char* ws = F.ws;
    const bf16* Y0 = (const bf16*)(ws + WS_Y); const bf16* Y1 = Y0 + (size_t)TT * D;
    const float* src = (l == 0) ? (m < TL ? a->in[I_X] + (size_t)m * D : a->in[I_CTX] + (size_t)(m - TL) * D) : (const float*)(ws + WS_XC) + (size_t)(m - TL) * D;
    const bool from_b = (l > 0) && (m < TL);
#pragma unroll
    for (int j = 0; j < 4; ++j) { const int col = 4 * F.lane + 256 * j; x[j] = from_b ? ld_y4(F.xlb + (size_t)m * D + col) : *(const f32x4*)(src + col);
        if (l > 0) y[j] = ld_y4(Y0 + (size_t)m * D + col) + ld_y4(Y1 + (size_t)m * D + col); }
}
__device__ __forceinline__ void n1_row(const Frame& F, const CAS Args* a, int l, int m, f32x4 (&x)[4], const f32x4 (&y)[4]) {
    unsigned char* ws = F.ws;
    const float* mod = (const float*)(ws + WS_MOD);
    bf16* H = (bf16*)(ws + WS_H);
    const int v = m < TL ? (m >> 13) : 2;
    float* xrow = (float*)(ws + WS_XC) + (size_t)(m - TL) * D;
    float ss = 0.f;
#pragma unroll
    for (int j = 0; j < 4; ++j) {
        const int col = 4 * F.lane + 256 * j;
        if (l > 0) { const f32x4 g2 = *(const f32x4*)(mod + ((l - 1) * 3 + v) * 6144 + 5 * D + col); x[j] = x[j] + g2 * y[j];
            if (m < TL) { u32x2 o; o.x = pk2(x[j][0], x[j][1]); o.y = pk2(x[j][2], x[j][3]); *(u32x2*)(F.xlb + (size_t)m * D + col) = o; } else *(f32x4*)(xrow + col) = x[j]; }
        ss += (x[j][0] * x[j][0] + x[j][1] * x[j][1]) + (x[j][2] * x[j][2] + x[j][3] * x[j][3]);
    }
    const float rstd = 1.0f / sqrtf(wave_sum(ss) * (1.0f / D) + EPS);
#pragma unroll
    for (int j = 0; j < 4; ++j) {
        const int col = 4 * F.lane + 256 * j;
        const f32x4 nw = *(const f32x4*)(a->in[I_NORM1] + l * D + col);
        const f32x4 sh = *(const f32x4*)(mod + (l * 3 + v) * 6144 + 0 * D + col);
        const f32x4 sc = *(const f32x4*)(mod + (l * 3 + v) * 6144 + 1 * D + col);
        const f32x4 h = x[j] * rstd * nw * (1.0f + sc) + sh;
        *(unsigned*)((unsigned char*)H + (size_t)m * D + col) = pk4_fp8(h[0], h[1], h[2], h[3]);
    }
}
__device__ __forceinline__ void n1_phase(const Frame& F, const CAS Args* a, int l) {
    for (int m = F.gw; m < TT; m += 2 * F.NGW) {
        const int m2 = m + F.NGW; const bool two = m2 < TT;
        f32x4 xa[4], ya[4], xb[4], yb[4];
        n1_load(F, a, l, m, xa, ya);
        if (two) n1_load(F, a, l, m2, xb, yb);
        n1_row(F, a, l, m, xa, ya);
        if (two) n1_row(F, a, l, m2, xb, yb);
    }
}

struct EpiIn {
    static constexpr bool PERM = true;
    bf16* P; const float* bias_f; const float* bias_b; const float* tcos; const float* tsin; int abl;
    template <int KIND>
    __device__ __forceinline__ void body(const f32x4 (&acc)[2][2][4][2], const pg8::Unit& u, int wr, int wc, int fr, int fq) const {
        const int row0 = u.pm * 256 + wr * 64 + fr, colw = wc * 32 + 8 * fq;
        f32x4 cs[4], sn[4], b0[2], b1[2];
        const bool wodd = (wc & 1) != 0;
        if (KIND == 3 || KIND == 5) {
            const int t0 = row0 & (SEQ - 1);
#pragma unroll
            for (int j = 0; j < 4; ++j) { const int pos = wodd ? ((t0 + 16 * j) & 63) : ((t0 + 128 * (j & 1)) >> 6);
                cs[j] = *(const f32x4*)(tcos + pos * 16 + 4 * fq); sn[j] = *(const f32x4*)(tsin + pos * 16 + 4 * fq); }
        }
        if (KIND == 2) {
#pragma unroll
            for (int bj = 0; bj < 2; ++bj) { const float* bp = (u.pn == 9 ? bias_f : bias_b) + colw + bj * 128; b0[bj] = *(const f32x4*)bp; b1[bj] = *(const f32x4*)(bp + 4); }
        }
#pragma unroll
        for (int ai = 0; ai < 2; ++ai)
#pragma unroll
            for (int m = 0; m < 4; ++m) {
                const int row = row0 + ai * 128 + m * 16;
                bf16* rowp = P + (size_t)row * NIN + u.pn * 256 + colw;
#pragma unroll
                for (int bj = 0; bj < 2; ++bj) {
                    f32x4 v0 = acc[ai][bj][m][0], v1 = acc[ai][bj][m][1];
                    if (KIND == 1) { v0 = v0 * 0.125f; v1 = v1 * 0.125f; }
                    if (KIND == 2) {
#pragma unroll
                        for (int i = 0; i < 4; ++i) { float x0 = v0[i] + b0[bj][i], x1 = v1[i] + b1[bj][i];
                            v0[i] = (fminf(x0, 0.f) - __logf(1.0f + __expf(-fabsf(x0)))) * 0.0625f; v1[i] = (fminf(x1, 0.f) - __logf(1.0f + __expf(-fabsf(x1)))) * 0.0625f; }
                    }
                    if (KIND == 3 || (KIND == 5 && bj == 0)) {
                        const f32x4 c = wodd ? cs[m] : cs[ai], sv = wodd ? sn[m] : sn[ai];
                        const f32x4 o0 = v0 * c - v1 * sv, o1 = v1 * c + v0 * sv; v0 = o0; v1 = o1;
                    }
                    if (KIND == 3 || KIND == 4) { v0 = v0 * QSCALE; v1 = v1 * QSCALE; }
                    u32x4 w; w.x = pg8::cvt_pk_bf16(v0[0], v0[1]); w.y = pg8::cvt_pk_bf16(v0[2], v0[3]); w.z = pg8::cvt_pk_bf16(v1[0], v1[1]); w.w = pg8::cvt_pk_bf16(v1[2], v1[3]);
                    *(u32x4*)(rowp + bj * 128) = w;
                }
            }
    }
    __device__ __forceinline__ void operator()(const f32x4 (&acc)[2][2][4][2], const pg8::Unit& u, int wr, int wc, int fr, int fq) const {
        const int pn = u.pn; const bool latent = u.pm < 64;
        if (pn == 0) body<1>(acc, u, wr, wc, fr, fq);
        else if (pn < 6) body<0>(acc, u, wr, wc, fr, fq);
        else if (pn < 8) { if (latent) body<3>(acc, u, wr, wc, fr, fq); else body<4>(acc, u, wr, wc, fr, fq); }
        else if (pn == 8) { if (latent) body<5>(acc, u, wr, wc, fr, fq); else body<0>(acc, u, wr, wc, fr, fq); }
        else body<2>(acc, u, wr, wc, fr, fq);
    }
};
struct EpiOut {
    static constexpr bool PERM = true;
    const float* resL; const float* resC; bf16* xlb; float* outC; const float* mod_l; bool res_b;
    __device__ __forceinline__ void operator()(const f32x4 (&acc)[2][2][4][2], const pg8::Unit& u, int wr, int wc, int fr, int fq) const {
        const bool latent = u.pm < 64;
        const int v = latent ? (u.pm >> 5) : 2;
        const int rowb = (latent ? u.pm * 256 : u.pm * 256 - TL) + wr * 64 + fr;
        const int col0 = u.pn * 256 + wc * 32 + 8 * fq;
        const float* g1p = mod_l + v * 6144 + 2 * D + col0;
        f32x4 g1[2][2];
#pragma unroll
        for (int bj = 0; bj < 2; ++bj)
#pragma unroll
            for (int n = 0; n < 2; ++n) g1[bj][n] = *(const f32x4*)(g1p + bj * 128 + n * 4);
        const bool rb = latent && res_b;
        const float* res = latent ? resL : resC;
#pragma unroll
        for (int ai = 0; ai < 2; ++ai)
#pragma unroll
            for (int mp = 0; mp < 4; mp += 2) {
                f32x4 r[2][2][2];
#pragma unroll
                for (int m = 0; m < 2; ++m) { const size_t off = (size_t)(rowb + ai * 128 + (mp + m) * 16) * D + col0;
#pragma unroll
                    for (int bj = 0; bj < 2; ++bj) {
                        if (rb) { const u32x4 w = *(const u32x4*)(xlb + off + bj * 128);
                            r[m][bj][0] = (f32x4){bflo(w.x), bfhi(w.x), bflo(w.y), bfhi(w.y)}; r[m][bj][1] = (f32x4){bflo(w.z), bfhi(w.z), bflo(w.w), bfhi(w.w)}; }
                        else { r[m][bj][0] = *(const f32x4*)(res + off + bj * 128); r[m][bj][1] = *(const f32x4*)(res + off + bj * 128 + 4); }
                    } }
#pragma unroll
                for (int m = 0; m < 2; ++m) { const size_t off = (size_t)(rowb + ai * 128 + (mp + m) * 16) * D + col0;
#pragma unroll
                    for (int bj = 0; bj < 2; ++bj) {
                        const f32x4 o0 = r[m][bj][0] + g1[bj][0] * acc[ai][bj][mp + m][0], o1 = r[m][bj][1] + g1[bj][1] * acc[ai][bj][mp + m][1];
                        if (latent) { u32x4 w; w.x = pk2(o0[0], o0[1]); w.y = pk2(o0[2], o0[3]); w.z = pk2(o1[0], o1[1]); w.w = pk2(o1[2], o1[3]); *(u32x4*)(xlb + off + bj * 128) = w; }
                        else { *(f32x4*)(outC + off + bj * 128) = o0; *(f32x4*)(outC + off + bj * 128 + 4) = o1; }
                    } }
                asm volatile("" ::: "memory");
            }
    }
};
struct EpiGU {
    static constexpr bool PERM = true;
    bf16* Hmid;
    __device__ __forceinline__ void operator()(const f32x4 (&acc)[2][2][4][2], const pg8::Unit& u, int wr, int wc, int fr, int fq) const {
        const int row0 = u.pm * 256 + wr * 64 + fr, hid0 = u.pn * 128 + wc * 32 + fq * 8;
#pragma unroll
        for (int ai = 0; ai < 2; ++ai)
#pragma unroll
            for (int m = 0; m < 4; ++m) {
                unsigned char* rowp = (unsigned char*)Hmid + (size_t)(row0 + ai * 128 + m * 16) * DE + hid0;
                unsigned wv[2];
#pragma unroll
                for (int bj = 0; bj < 2; ++bj) {
                    const f32x4 g = acc[ai][bj][m][0], up = acc[ai][bj][m][1]; f32x4 o;
#pragma unroll
                    for (int i = 0; i < 4; ++i) o[i] = g[i] * __builtin_amdgcn_rcpf(1.0f + __expf(-g[i])) * up[i];
                    wv[bj] = pk4_fp8(o[0] * HMID_SCALE, o[1] * HMID_SCALE, o[2] * HMID_SCALE, o[3] * HMID_SCALE);
                }
                __hip_atomic_store((unsigned long long*)rowp, ((unsigned long long)wv[1] << 32) | wv[0], __ATOMIC_RELAXED, __HIP_MEMORY_SCOPE_AGENT);
            }
    }
};
struct EpiDown {
    static constexpr bool PERM = true;
    bf16* Y; const unsigned* list; const float* listw; const LAS int* tab;
    __device__ __forceinline__ void operator()(const f32x4 (&acc)[2][2][4][2], const pg8::Unit& u, int wr, int wc, int fr, int fq) const {
        const int ce = tab[u.e];
        const int r0 = u.mt * 256 + wr * 64 + fr, col0 = u.pn * 256 + wc * 32 + 8 * fq;
        const unsigned* lp = list + (size_t)u.e * LISTCAP; const float* lw = listw + (size_t)u.e * LISTCAP;
        unsigned tsv[2][4]; float wv[2][4];
#pragma unroll
        for (int ai = 0; ai < 2; ++ai)
#pragma unroll
            for (int m = 0; m < 4; ++m) { const int r = r0 + ai * 128 + m * 16; const bool ok = r < ce; tsv[ai][m] = ok ? __builtin_nontemporal_load(lp + r) : 0xffffffffu; wv[ai][m] = ok ? __builtin_nontemporal_load(lw + r) : 0.f; }
#pragma unroll
        for (int ai = 0; ai < 2; ++ai)
#pragma unroll
            for (int m = 0; m < 4; ++m) {
                const unsigned ts = tsv[ai][m]; const float w = wv[ai][m];
                if (ts != 0xffffffffu) {
                    bf16* rowp = Y + ((size_t)(ts & 1u) * TT + (ts >> 1)) * D + col0;
#pragma unroll
                    for (int bj = 0; bj < 2; ++bj) {
                        const f32x4 v0 = acc[ai][bj][m][0] * w, v1 = acc[ai][bj][m][1] * w;
                        u32x4 o; o.x = pg8::cvt_pk_bf16(v0[0], v0[1]); o.y = pg8::cvt_pk_bf16(v0[2], v0[3]); o.z = pg8::cvt_pk_bf16(v1[0], v1[1]); o.w = pg8::cvt_pk_bf16(v1[2], v1[3]);
                        *(u32x4*)(rowp + bj * 128) = o;
                    }
                }
            }
    }
};

__device__ __forceinline__ void swa_naive(const Frame& F, const CAS Args* a, int l) {
    const bf16* P = (const bf16*)(F.ws + WS_P); bf16* MIX = (bf16*)(F.ws + WS_MIX);
    const int total = (l == 0 ? TT : TL) * 8;
    for (int idx = F.gw * 64 + F.lane; idx < total; idx += F.NGW * 64) {
        const int m = idx >> 3, hq = idx & 7, kvh = hq >> 2;
        const bool latent = m < TL;
        const int b = latent ? (m >> 13) : ((m - TL) >> 8), t = m & (SEQ - 1);
        float q[64];
        { const u32x4* qp = (const u32x4*)(P + (size_t)m * NIN + PC_SQ + hq * 64);
#pragma unroll
          for (int c = 0; c < 8; ++c) { const u32x4 w = qp[c]; q[8 * c] = bflo(w.x); q[8 * c + 1] = bfhi(w.x); q[8 * c + 2] = bflo(w.y); q[8 * c + 3] = bfhi(w.y);
              q[8 * c + 4] = bflo(w.z); q[8 * c + 5] = bfhi(w.z); q[8 * c + 6] = bflo(w.w); q[8 * c + 7] = bfhi(w.w); } }
        float o[64];
#pragma unroll
        for (int d = 0; d < 64; ++d) o[d] = 0.f;
        const float sink = a->in[I_SINK][l * 8 + hq] * LOG2E;
        float mx = sink, den = 1.0f;
        const int lo = latent ? (t - 128 < 0 ? 0 : t - 128) : 0, hi = latent ? (t + 128 > SEQ - 1 ? SEQ - 1 : t + 128) : -1;
        const int nloc = hi - lo + 1;
        for (int kk = 0; kk < nloc + LC; ++kk) {
            const int krow = kk < nloc ? b * SEQ + lo + kk : TL + b * LC + (kk - nloc);
            const u32x4* kp = (const u32x4*)(P + (size_t)krow * NIN + PC_SK + kvh * 64);
            float s = 0.f;
#pragma unroll
            for (int c = 0; c < 8; ++c) { const u32x4 w = kp[c]; s += q[8 * c] * bflo(w.x) + q[8 * c + 1] * bfhi(w.x) + q[8 * c + 2] * bflo(w.y) + q[8 * c + 3] * bfhi(w.y)
                + q[8 * c + 4] * bflo(w.z) + q[8 * c + 5] * bfhi(w.z) + q[8 * c + 6] * bflo(w.w) + q[8 * c + 7] * bfhi(w.w); }
            const float mn = fmaxf(mx, s), f = exp2f(mx - mn), p = exp2f(s - mn);
            den = den * f + p; mx = mn;
            const u32x4* vp = (const u32x4*)(P + (size_t)krow * NIN + PC_SV + kvh * 64);
#pragma unroll
            for (int c = 0; c < 8; ++c) { const u32x4 w = vp[c];
                o[8 * c] = o[8 * c] * f + p * bflo(w.x); o[8 * c + 1] = o[8 * c + 1] * f + p * bfhi(w.x); o[8 * c + 2] = o[8 * c + 2] * f + p * bflo(w.y); o[8 * c + 3] = o[8 * c + 3] * f + p * bfhi(w.y);
                o[8 * c + 4] = o[8 * c + 4] * f + p * bflo(w.z); o[8 * c + 5] = o[8 * c + 5] * f + p * bfhi(w.z); o[8 * c + 6] = o[8 * c + 6] * f + p * bflo(w.w); o[8 * c + 7] = o[8 * c + 7] * f + p * bfhi(w.w); }
        }
        const float inv = 1.0f / den;
        u32x4* op = (u32x4*)(MIX + (size_t)m * D + 512 + hq * 64);
#pragma unroll
        for (int c = 0; c < 8; ++c) { u32x4 w; w.x = pk2(o[8 * c] * inv, o[8 * c + 1] * inv); w.y = pk2(o[8 * c + 2] * inv, o[8 * c + 3] * inv); w.z = pk2(o[8 * c + 4] * inv, o[8 * c + 5] * inv); w.w = pk2(o[8 * c + 6] * inv, o[8 * c + 7] * inv); op[c] = w; }
    }
}


typedef float f32x16 __attribute__((ext_vector_type(16)));
typedef short s16x4 __attribute__((ext_vector_type(4)));
__device__ __forceinline__ int crow(int r, int hi) { return (r & 3) + 8 * (r >> 2) + 4 * hi; }
__device__ __forceinline__ s16x4 vtr(const LAS unsigned char* p) { return __builtin_bit_cast(s16x4, __builtin_amdgcn_ds_read_tr16_b64_v4i16((LAS s16x4*)p)); }
constexpr int SWA_K = 0, SWA_V = 49152;
__device__ __forceinline__ void swa_kload(const LAS unsigned char* Kt, int kb, int lane, bf16x8 (&kf)[4]) {
    const int r32 = lane & 31, hi = lane >> 5;
#pragma unroll
    for (int d0 = 0; d0 < 4; ++d0) kf[d0] = *(const LAS bf16x8*)(Kt + (2 * d0 + hi) * 1024 + (32 * kb + r32) * 16);
}
__device__ __forceinline__ void swa_tile(const LAS unsigned char* Kt, const LAS unsigned char* Vt, const LAS unsigned char* Kn, int mtype, const bf16x8 (&qf)[2][4], f32x16 (&o)[2][2], float (&mrun)[2], float (&lrun)[2], int lane, int abl = 0) {
    const int r32 = lane & 31, hi = lane >> 5; bf16x8 kf[4]; (void)Kn;
    const LAS unsigned char* vp = Vt + ((lane >> 4) & 1) * 32 + (lane & 3) * 8 + (4 * hi + ((lane & 15) >> 2)) * 64;
#pragma unroll
    for (int kb = 0; kb < 2; ++kb) {
        f32x16 s[2];
        swa_kload(Kt, kb, lane, kf);
#pragma unroll
        for (int d0 = 0; d0 < 4; ++d0)
#pragma unroll
            for (int qt = 0; qt < 2; ++qt) {
                if (d0 == 0) { f32x16 z;
#pragma unroll
                    for (int r = 0; r < 16; ++r) z[r] = 0.f;
                    s[qt] = __builtin_amdgcn_mfma_f32_32x32x16_bf16(kf[0], qf[qt][0], z, 0, 0, 0); }
                else if (abl != 4) s[qt] = __builtin_amdgcn_mfma_f32_32x32x16_bf16(kf[d0], qf[qt][d0], s[qt], 0, 0, 0);
            }
        __builtin_amdgcn_sched_barrier(0);
        s16x4 vlo[2][2], vhi[2][2];
#pragma unroll
        for (int dt = 0; dt < 2; ++dt)
#pragma unroll
            for (int sp = 0; sp < 2; ++sp) { vlo[dt][sp] = vtr(vp + dt * 4096 + (2 * kb + sp) * 1024); vhi[dt][sp] = vtr(vp + dt * 4096 + (2 * kb + sp) * 1024 + 512); }
        __builtin_amdgcn_sched_barrier(0);
        bf16x8 pf[2][2];
#pragma unroll
        for (int qt = 0; qt < 2; ++qt) {
            if (mtype != 0) {
                int thr = r32 + 32 * qt - 4 * hi - 32 * kb; asm volatile("" : "+v"(thr));
                if (mtype == 1) {
#pragma unroll
                    for (int r = 0; r < 16; ++r) { const int cc = (r & 3) + 8 * (r >> 2); if (cc < thr) s[qt][r] = -INFINITY; }
                } else {
#pragma unroll
                    for (int r = 0; r < 16; ++r) { const int cc = (r & 3) + 8 * (r >> 2); if (cc > thr) s[qt][r] = -INFINITY; }
                }
            }
            float rm = s[qt][0];
            if (abl != 1) {
#pragma unroll
            for (int r = 1; r < 16; ++r) rm = fmaxf(rm, s[qt][r]);
            }
            { auto rr = __builtin_amdgcn_permlane32_swap(__float_as_uint(rm), __float_as_uint(rm), false, false); rm = fmaxf(__uint_as_float(rr[0]), __uint_as_float(rr[1])); }
            const float mn = fmaxf(mrun[qt], rm);
            if (__any(mn > mrun[qt])) {
                const float alpha = __builtin_amdgcn_exp2f(mrun[qt] - mn);
                lrun[qt] *= alpha;
#pragma unroll
                for (int dt = 0; dt < 2; ++dt)
#pragma unroll
                    for (int r = 0; r < 16; ++r) o[dt][qt][r] *= alpha;
                mrun[qt] = mn;
            }
            float rs = 0.f;
            if (abl != 1) {
#pragma unroll
            for (int r = 0; r < 16; ++r) { const float p = __builtin_amdgcn_exp2f(s[qt][r] - mn); s[qt][r] = p; rs += p; }
            }
            lrun[qt] += rs;
#pragma unroll
            for (int sp = 0; sp < 2; ++sp) {
                u32x4 w; w.x = pg8::cvt_pk_bf16(s[qt][8 * sp + 0], s[qt][8 * sp + 1]); w.y = pg8::cvt_pk_bf16(s[qt][8 * sp + 2], s[qt][8 * sp + 3]);
                w.z = pg8::cvt_pk_bf16(s[qt][8 * sp + 4], s[qt][8 * sp + 5]); w.w = pg8::cvt_pk_bf16(s[qt][8 * sp + 6], s[qt][8 * sp + 7]);
                pf[qt][sp] = __builtin_bit_cast(bf16x8, w);
            }
        }
#pragma unroll
        for (int dt = 0; dt < 2; ++dt)
#pragma unroll
            for (int sp = 0; sp < 2; ++sp) {
                const bf16x8 vf = (bf16x8){vlo[dt][sp][0], vlo[dt][sp][1], vlo[dt][sp][2], vlo[dt][sp][3], vhi[dt][sp][0], vhi[dt][sp][1], vhi[dt][sp][2], vhi[dt][sp][3]};
#pragma unroll
                for (int qt = 0; qt < 2; ++qt) if (abl != 2) o[dt][qt] = __builtin_amdgcn_mfma_f32_32x32x16_bf16(vf, pf[qt][sp], o[dt][qt], 0, 0, 0);
            }
    }
}
__device__ __forceinline__ void swa_stage(const Frame& F, const bf16* P, int grow, int kvh, int ti) {
    { const int key = 8 * F.wave + (F.lane & 7), ch = F.lane >> 3;
      const u32x4 v = *(const u32x4*)(P + (size_t)(grow + key) * NIN + PC_SK + kvh * 64 + ch * 8);
      *(LAS u32x4*)(F.lds + SWA_K + ti * 8192 + ch * 1024 + key * 16) = v; }
    { const int key = 8 * F.wave + (F.lane >> 3), ch = F.lane & 7;
      const u32x4 v = *(const u32x4*)(P + (size_t)(grow + key) * NIN + PC_SV + kvh * 64 + ch * 8);
      *(LAS u32x4*)(F.lds + SWA_V + ti * 8192 + (ch >> 2) * 4096 + key * 64 + (ch & 3) * 16) = v; }
}
__device__ __forceinline__ void swa_flash(const Frame& F, const CAS Args* a, int l, int abl = 0) {
    const bf16* P = (const bf16*)(F.ws + WS_P); bf16* MIX = (bf16*)(F.ws + WS_MIX);
    const int nunits = 256 + (l == 0 ? 8 : 0);
    const int lane = F.lane, r32 = lane & 31, hi = lane >> 5;
    for (int u = F.vcu; u < nunits; u += F.G) {
        const bool latent = u < 256;
        const int b = latent ? (u >> 7) : ((u - 256) >> 2), kvh = latent ? ((u >> 6) & 1) : (((u - 256) >> 1) & 1), qb = latent ? (u & 63) : ((u - 256) & 1);
        const int q0 = qb * 128, g = F.wave >> 1, qs = F.wave & 1, hq = kvh * 4 + g;
        const int mrow0 = (latent ? b * SEQ : TL + b * LC) + q0 + 64 * qs;
        bf16x8 qf[2][4];
#pragma unroll
        for (int qt = 0; qt < 2; ++qt)
#pragma unroll
            for (int d0 = 0; d0 < 4; ++d0) { if (abl != 7) qf[qt][d0] = *(const bf16x8*)(P + (size_t)(mrow0 + 32 * qt + r32) * NIN + PC_SQ + hq * 64 + 16 * d0 + 8 * hi); else qf[qt][d0] = (bf16x8){(short)lane, 1, 2, 3, 4, 5, 6, 7}; }
        f32x16 o[2][2];
#pragma unroll
        for (int dt = 0; dt < 2; ++dt)
#pragma unroll
            for (int qt = 0; qt < 2; ++qt)
#pragma unroll
                for (int r = 0; r < 16; ++r) o[dt][qt][r] = 0.f;
        const float sink2 = a->in[I_SINK][l * 8 + hq] * LOG2E;
        float mrun[2] = {sink2, sink2}, lrun[2] = {hi == 0 ? 1.f : 0.f, hi == 0 ? 1.f : 0.f};
        if (latent) {
#pragma unroll 1
            for (int j = 0; j < 6; ++j) { const int ks = q0 - 128 + 64 * j; if (ks >= 0 && ks < SEQ && abl != 3) swa_stage(F, P, b * SEQ + ks, kvh, j); }
            LDS_BARRIER();
            { int jf = qs; while (q0 - 128 + 64 * jf < 0) ++jf;
              (void)jf;
#pragma unroll 1
              for (int tt = 0; tt < 5; ++tt) { const int j = qs + tt, ks = q0 - 128 + 64 * j;
                  if (ks >= 0 && ks < SEQ && abl != 8) { const int jn = (j + 1 < 6) ? j + 1 : j;
                      swa_tile(F.lds + SWA_K + j * 8192, F.lds + SWA_V + j * 8192, F.lds + SWA_K + jn * 8192, tt == 0 ? 1 : (tt == 4 ? 2 : 0), qf, o, mrun, lrun, lane, abl); } } }
            LDS_BARRIER();
        }
#pragma unroll 1
        for (int j = 0; j < 4; ++j) if (abl != 3) swa_stage(F, P, TL + b * LC + 64 * j, kvh, j);
        LDS_BARRIER();
        {
#pragma unroll 1
          for (int j = 0; j < 4; ++j) if (abl != 8) swa_tile(F.lds + SWA_K + j * 8192, F.lds + SWA_V + j * 8192, F.lds + SWA_K + (j < 3 ? j + 1 : j) * 8192, 0, qf, o, mrun, lrun, lane, abl); }
        LDS_BARRIER();
        LAS unsigned char* stg = F.lds + F.wave * 4096;
#pragma unroll
        for (int qt = 0; qt < 2; ++qt) {
            float lt = lrun[qt];
            { auto rr = __builtin_amdgcn_permlane32_swap(__float_as_uint(lt), __float_as_uint(lt), false, false); lt = __uint_as_float(rr[0]) + __uint_as_float(rr[1]); }
            const float is = MIX_SCALE / lt;
#pragma unroll
            for (int dt = 0; dt < 2; ++dt)
#pragma unroll
                for (int rg = 0; rg < 4; ++rg)
                    *(LAS unsigned*)(stg + (32 * qt + r32) * 64 + 32 * dt + 8 * rg + 4 * hi) = pk4_fp8(o[dt][qt][4 * rg] * is, o[dt][qt][4 * rg + 1] * is, o[dt][qt][4 * rg + 2] * is, o[dt][qt][4 * rg + 3] * is);
        }
        LDS_WAIT();
        if (abl != 7) {
            int le = lane; asm volatile("" : "+v"(le));
#pragma unroll
            for (int i = 0; i < 4; ++i) { const int row = 16 * i + (le >> 2), ch = le & 3;
                const u32x4 v = *(const LAS u32x4*)(stg + row * 64 + ch * 16);
                *(u32x4*)((unsigned char*)MIX + (size_t)(mrow0 + row) * D + 512 + hq * 64 + ch * 16) = v; }
        }
        LDS_BARRIER();
    }
}

constexpr size_t WS_US = WS_GL, WS_USC = WS_GL + 32 * MiB, WS_DEC = 7 * MiB;
static_assert(WS_USC + (size_t)16 * 4 * 8192 * 2 <= WS_END && WS_DEC + (size_t)16 * 132 * 64 * 4 <= WS_WIN, "ws map (gla)");
constexpr int GL_V = 0, GL_M0 = 16384, GL_MSZ = 64 * 72 * 2, GL_RED = GL_M0 + 4 * GL_MSZ, GL_STG = GL_RED + 1024;
__device__ __forceinline__ float wave_scan_incl(float v) {
    v += DPP_F(v, 0x111, 0xF); v += DPP_F(v, 0x112, 0xF); v += DPP_F(v, 0x114, 0xF); v += DPP_F(v, 0x118, 0xF);
    v += DPP_F(v, 0x142, 0xA); v += DPP_F(v, 0x143, 0xC); return v;
}
__device__ __forceinline__ float lane63(float v) { return __builtin_bit_cast(float, __builtin_amdgcn_readlane(__builtin_bit_cast(int, v), 63)); }
__device__ __forceinline__ void unpack8(const u32x4 w, float (&f)[8]) { f[0] = bflo(w.x); f[1] = bfhi(w.x); f[2] = bflo(w.y); f[3] = bfhi(w.y); f[4] = bflo(w.z); f[5] = bfhi(w.z); f[6] = bflo(w.w); f[7] = bfhi(w.w); }
__device__ __forceinline__ void gla_stage_v(const Frame& F, const bf16* P, int m0, int h) {
#pragma unroll
    for (int i = 0; i < 2; ++i) { const int p = F.tid + 512 * i, t = p >> 4, ch = p & 15;
        const u32x4 v = *(const u32x4*)(P + (size_t)(m0 + t) * NIN + PC_V + h * 128 + ch * 8);
        *(LAS u32x4*)(F.lds + GL_V + (ch >> 2) * 4096 + t * 64 + (ch & 3) * 16) = v; }
}
struct GlaPre { u32x4 laf, lab, kk, qq, v0, v1; };
__device__ __forceinline__ void gla_pre_load(const Frame& F, const bf16* P, int m0, int h, bool want_q, GlaPre& p) {
    const bf16* row = P + (size_t)(m0 + F.lane) * NIN + h * 64 + 8 * F.wave;
    p.laf = *(const u32x4*)(row + PC_GF); p.lab = *(const u32x4*)(row + PC_GB); p.kk = *(const u32x4*)(row + PC_K);
    if (want_q) p.qq = *(const u32x4*)(row + PC_Q);
    { const int q0 = F.tid, q1 = F.tid + 512;
      p.v0 = *(const u32x4*)(P + (size_t)(m0 + (q0 >> 4)) * NIN + PC_V + h * 128 + (q0 & 15) * 8);
      p.v1 = *(const u32x4*)(P + (size_t)(m0 + (q1 >> 4)) * NIN + PC_V + h * 128 + (q1 & 15) * 8); }
}
__device__ __forceinline__ void gla_pre_stage_v(const Frame& F, const GlaPre& p) {
    { const int q = F.tid, t = q >> 4, ch = q & 15; *(LAS u32x4*)(F.lds + GL_V + (ch >> 2) * 4096 + t * 64 + (ch & 3) * 16) = p.v0; }
    { const int q = F.tid + 512, t = q >> 4, ch = q & 15; *(LAS u32x4*)(F.lds + GL_V + (ch >> 2) * 4096 + t * 64 + (ch & 3) * 16) = p.v1; }
}
__device__ __forceinline__ void gla_unit_decode(int u, int& m0, int& h, int& sf, int& n, bool& latent) {
    latent = u < 1024; const int cc = u - 1024;
    const int b = latent ? (u >> 9) : (cc >> 4); h = latent ? ((u >> 7) & 3) : ((cc >> 2) & 3); n = latent ? (u & 127) : (cc & 3);
    m0 = latent ? b * SEQ + 64 * n : TL + b * LC + 64 * n; sf = (b * 4 + h) * 2;
}
__device__ __forceinline__ void gla_g1_unit(const Frame& F, const GlaPre& pre, bf16* Uf, bf16* Ub, float* decf, float* decb) {
    const int w = F.wave, t = F.lane, c = t & 31, hi = t >> 5;
    float laf[8], lab[8], kk[8];
    unpack8(pre.laf, laf); unpack8(pre.lab, lab); unpack8(pre.kk, kk);
    gla_pre_stage_v(F, pre);
    LAS bf16* KOF = (LAS bf16*)(F.lds + GL_M0); LAS bf16* KOB = (LAS bf16*)(F.lds + GL_M0 + GL_MSZ);
#pragma unroll
    for (int i = 0; i < 8; ++i) {
        const float incf = wave_scan_incl(laf[i]), tf = lane63(incf), incb = wave_scan_incl(lab[i]), tb = lane63(incb);
        KOF[(8 * w + i) * 72 + t] = (bf16)f2bf(kk[i] * __expf(tf - incf));
        KOB[(8 * w + i) * 72 + t] = (bf16)f2bf(kk[i] * __expf(incb - lab[i]));
        if (t == 0) { decf[8 * w + i] = __expf(tf); decb[8 * w + i] = __expf(tb); }
    }
    LDS_BARRIER();
    const int dir = w >> 2, dvt = w & 3;
    const LAS unsigned char* vp = F.lds + GL_V + dvt * 4096 + ((t >> 4) & 1) * 32 + (t & 3) * 8 + ((t & 15) >> 2) * 64 + hi * 512;
    const LAS unsigned char* kb = F.lds + GL_M0 + dir * GL_MSZ + (c * 72 + 8 * hi) * 2;
    f32x16 acc[2];
#pragma unroll
    for (int j = 0; j < 2; ++j)
#pragma unroll
        for (int r = 0; r < 16; ++r) acc[j][r] = 0.f;
#pragma unroll
    for (int sp = 0; sp < 4; ++sp) {
        const s16x4 lo = vtr(vp + sp * 1024), hi4 = vtr(vp + sp * 1024 + 256);
        const bf16x8 vf = (bf16x8){lo[0], lo[1], lo[2], lo[3], hi4[0], hi4[1], hi4[2], hi4[3]};
#pragma unroll
        for (int j = 0; j < 2; ++j) { const bf16x8 kf = *(const LAS bf16x8*)(kb + j * 32 * 144 + sp * 32); acc[j] = __builtin_amdgcn_mfma_f32_32x32x16_bf16(kf, vf, acc[j], 0, 0, 0); }
    }
    bf16* U = dir ? Ub : Uf;
#pragma unroll
    for (int j = 0; j < 2; ++j) {
        u32x4 w0, w1;
        w0.x = pk2(acc[j][0], acc[j][1]); w0.y = pk2(acc[j][2], acc[j][3]); w0.z = pk2(acc[j][4], acc[j][5]); w0.w = pk2(acc[j][6], acc[j][7]);
        w1.x = pk2(acc[j][8], acc[j][9]); w1.y = pk2(acc[j][10], acc[j][11]); w1.z = pk2(acc[j][12], acc[j][13]); w1.w = pk2(acc[j][14], acc[j][15]);
        u32x4* up = (u32x4*)(U + ((j * 4 + dvt) * 64 + t) * 16);
        up[0] = w0; up[1] = w1;
    }
    LDS_BARRIER();
}
__device__ __forceinline__ void gla_g1(const Frame& F0, int l) {
    Frame F = F0; { int l_; asm volatile("v_mbcnt_lo_u32_b32 %0, -1, 0\n\tv_mbcnt_hi_u32_b32 %0, -1, %0" : "=v"(l_)); F.lane = l_; F.tid = F.wave * 64 + l_; }
    const bf16* P = (const bf16*)(F.ws + WS_P);
    bf16* US = (bf16*)(F.ws + WS_US); bf16* USC = (bf16*)(F.ws + WS_USC); float* DEC = (float*)(F.ws + WS_DEC);
    GlaPre pre, nx;
    { int m0, h, sf, n; bool latent; if (F.vcu < 1056) { gla_unit_decode(F.vcu, m0, h, sf, n, latent); gla_pre_load(F, P, m0, h, false, pre); } }
    for (int u = F.vcu; u < 1056; u += F.G) {
        int m0, h, sf, n; bool latent; gla_unit_decode(u, m0, h, sf, n, latent);
        if (u + F.G < 1056) { int m1, h1, s1, n1; bool l1; gla_unit_decode(u + F.G, m1, h1, s1, n1, l1); gla_pre_load(F, P, m1, h1, false, nx); }
        bf16* Uf = latent ? US + ((size_t)sf * 128 + n) * 8192 : USC + ((size_t)sf * 4 + n) * 8192;
        bf16* Ub = latent ? US + ((size_t)(sf + 1) * 128 + n) * 8192 : USC + ((size_t)(sf + 1) * 4 + n) * 8192;
        const int nd = latent ? n : 128 + n;
        gla_g1_unit(F, pre, Uf, Ub, DEC + ((size_t)sf * 132 + nd) * 64, DEC + ((size_t)(sf + 1) * 132 + nd) * 64);
        pre = nx;
    }
}
constexpr size_t WS_SS = WS_H, WS_SSC = WS_H + 32 * MiB;
static_assert(WS_SSC + (size_t)16 * 4 * 8192 * 2 <= WS_P, "ws map (gla states)");
__device__ __forceinline__ void gla_scan(const Frame& F) {
    for (int w0 = (F.vcu * NWAVES + F.wave) * 64; w0 < 16 * 4096; w0 += F.G * NWAVES * 64) {
        const int seq = __builtin_amdgcn_readfirstlane(w0 >> 12), ew = __builtin_amdgcn_readfirstlane((w0 & 4095) * 2);
        const int dir = seq & 1;
        const unsigned voff = (unsigned)F.lane * 4u;
        unsigned doff;
        { const int e = ew + 2 * F.lane, r = e & 15, ln = (e >> 4) & 63, dkt = e >> 12; doff = (unsigned)(32 * dkt + (r & 3) + 8 * (r >> 2) + 4 * (ln >> 5)) * 4u; }
        const char* decb = (const char*)(F.ws + WS_DEC) + (size_t)seq * 132 * 256;
        float s0 = 0.f, s1 = 0.f;
        { const char* ub = (const char*)(F.ws + WS_USC) + ((size_t)seq * 4 * 8192 + ew) * 2; char* sb = (char*)(F.ws + WS_SSC) + ((size_t)seq * 4 * 8192 + ew) * 2;
          unsigned u[4]; f32x2 d[4];
#pragma unroll
          for (int i = 0; i < 4; ++i) { const int n = dir ? 3 - i : i; u[i] = *(const unsigned*)(ub + (size_t)n * 16384 + voff); d[i] = *(const f32x2*)(decb + (size_t)(128 + n) * 256 + doff); }
#pragma unroll
          for (int i = 0; i < 4; ++i) { const int n = dir ? 3 - i : i; *(unsigned*)(sb + (size_t)n * 16384 + voff) = pk2(s0, s1); s0 = d[i][0] * s0 + bflo(u[i]); s1 = d[i][1] * s1 + bfhi(u[i]); } }
        const long stride = dir ? -16384 : 16384, dstride = dir ? -256 : 256;
        const char* ub = (const char*)(F.ws + WS_US) + ((size_t)seq * 128 * 8192 + ew) * 2 + (dir ? (size_t)127 * 16384 : 0);
        char* sb = (char*)(F.ws + WS_SS) + ((size_t)seq * 128 * 8192 + ew) * 2 + (dir ? (size_t)127 * 16384 : 0);
        const char* db = decb + (dir ? 127 * 256 : 0);
#pragma unroll 1
        for (int i0 = 0; i0 < 128; i0 += 32) {
            unsigned u[32]; f32x2 d[32];
#pragma unroll
            for (int j = 0; j < 32; ++j) { u[j] = *(const unsigned*)(ub + j * stride + voff); d[j] = *(const f32x2*)(db + j * dstride + doff); }
#pragma unroll
            for (int j = 0; j < 32; ++j) { *(unsigned*)(sb + j * stride + voff) = pk2(s0, s1); s0 = d[j][0] * s0 + bflo(u[j]); s1 = d[j][1] * s1 + bfhi(u[j]); }
            ub += 32 * stride; sb += 32 * stride; db += 32 * dstride;
        }
    }
}
__device__ __forceinline__ void gla_g3_unit(const Frame& F, const CAS Args* a, int l, const bf16* P, int m0, int h, const bf16* Sf, const bf16* Sb, bf16* MIX, const GlaPre& pre) {
    const int w = F.wave, t = F.lane, c = t & 31, hi = t >> 5;
    bf16x8 sfr[4], sbr[4]; u32x2 gwv[4]; f32x4 nwv[4];
    { const int dvt_ = w >> 1, tt_ = w & 1;
#pragma unroll
      for (int kd = 0; kd < 4; ++kd) { const size_t off = (size_t)(((kd >> 1) * 4 + dvt_) * 64 + t) * 16 + 8 * (kd & 1); sfr[kd] = *(const bf16x8*)(Sf + off); sbr[kd] = *(const bf16x8*)(Sb + off); }
#pragma unroll
      for (int rg = 0; rg < 4; ++rg) { const int dv = 32 * dvt_ + 8 * rg + 4 * hi;
          gwv[rg] = *(const u32x2*)(P + (size_t)(m0 + 32 * tt_ + c) * NIN + PC_G + h * 128 + dv); nwv[rg] = *(const f32x4*)(a->in[I_GLANORM] + l * 512 + h * 128 + dv); } }
    {
        float laf[8], lab[8], kk[8], qq[8];
        unpack8(pre.laf, laf); unpack8(pre.lab, lab); unpack8(pre.kk, kk); unpack8(pre.qq, qq);
        gla_pre_stage_v(F, pre);
        float qf[8], kf[8], qb[8], kb[8];
#pragma unroll
        for (int i = 0; i < 8; ++i) {
            const float bf = wave_scan_incl(laf[i]), incb = wave_scan_incl(lab[i]), bb = lane63(incb) - incb + lab[i];
            qf[i] = qq[i] * __expf(bf); kf[i] = kk[i] * __expf(-bf); qb[i] = qq[i] * __expf(bb); kb[i] = kk[i] * __expf(-bb);
        }
        LAS unsigned char* mb = F.lds + GL_M0 + (t * 72 + 8 * w) * 2;
        u32x4 o;
        o.x = pk2(qf[0], qf[1]); o.y = pk2(qf[2], qf[3]); o.z = pk2(qf[4], qf[5]); o.w = pk2(qf[6], qf[7]); *(LAS u32x4*)(mb) = o;
        o.x = pk2(kf[0], kf[1]); o.y = pk2(kf[2], kf[3]); o.z = pk2(kf[4], kf[5]); o.w = pk2(kf[6], kf[7]); *(LAS u32x4*)(mb + GL_MSZ) = o;
        o.x = pk2(qb[0], qb[1]); o.y = pk2(qb[2], qb[3]); o.z = pk2(qb[4], qb[5]); o.w = pk2(qb[6], qb[7]); *(LAS u32x4*)(mb + 2 * GL_MSZ) = o;
        o.x = pk2(kb[0], kb[1]); o.y = pk2(kb[2], kb[3]); o.z = pk2(kb[4], kb[5]); o.w = pk2(kb[6], kb[7]); *(LAS u32x4*)(mb + 3 * GL_MSZ) = o;
    }
    LDS_BARRIER();
    const int dvt = w >> 1, tt = w & 1;
    bf16x8 qfB[4], qbB[4], qfP[4], qbP[4];
    { const LAS unsigned char* qp = F.lds + GL_M0 + ((32 * tt + c) * 72 + 8 * hi) * 2;
#pragma unroll
      for (int kd = 0; kd < 4; ++kd) { qfB[kd] = *(const LAS bf16x8*)(qp + kd * 32); qbB[kd] = *(const LAS bf16x8*)(qp + 2 * GL_MSZ + kd * 32); }
      const LAS unsigned char* pp = F.lds + GL_M0 + ((32 * tt + c) * 72 + 4 * hi) * 2;
#pragma unroll
      for (int kd = 0; kd < 4; ++kd) {
          const u32x2 a0 = *(const LAS u32x2*)(pp + kd * 32), a1 = *(const LAS u32x2*)(pp + kd * 32 + 16);
          const u32x2 b0 = *(const LAS u32x2*)(pp + 2 * GL_MSZ + kd * 32), b1 = *(const LAS u32x2*)(pp + 2 * GL_MSZ + kd * 32 + 16);
          qfP[kd] = __builtin_bit_cast(bf16x8, (u32x4){a0.x, a0.y, a1.x, a1.y}); qbP[kd] = __builtin_bit_cast(bf16x8, (u32x4){b0.x, b0.y, b1.x, b1.y});
      } }
    bf16x8 pfr[2][2];
#pragma unroll
    for (int st = 0; st < 2; ++st) {
        const LAS unsigned char* kp = F.lds + GL_M0 + GL_MSZ + ((32 * st + c) * 72 + 8 * hi) * 2;
        f32x16 xf, xb;
#pragma unroll
        for (int r = 0; r < 16; ++r) { xf[r] = 0.f; xb[r] = 0.f; }
        const bool needF = st <= tt, needB = st >= tt;
        if (needF) {
#pragma unroll
            for (int kd = 0; kd < 4; ++kd) xf = __builtin_amdgcn_mfma_f32_32x32x16_bf16(*(const LAS bf16x8*)(kp + kd * 32), qfB[kd], xf, 0, 0, 0);
        }
        if (needB) {
#pragma unroll
            for (int kd = 0; kd < 4; ++kd) xb = __builtin_amdgcn_mfma_f32_32x32x16_bf16(*(const LAS bf16x8*)(kp + 2 * GL_MSZ + kd * 32), qbB[kd], xb, 0, 0, 0);
        }
        if (st == tt) {
            int thr = c - 4 * hi; asm volatile("" : "+v"(thr));
#pragma unroll
            for (int r = 0; r < 16; ++r) { const int cc = (r & 3) + 8 * (r >> 2); xf[r] = (cc <= thr ? xf[r] : 0.f) + (cc >= thr ? xb[r] : 0.f); }
        } else {
#pragma unroll
            for (int r = 0; r < 16; ++r) xf[r] += xb[r];
        }
#pragma unroll
        for (int sp = 0; sp < 2; ++sp) {
            u32x4 wv; wv.x = pg8::cvt_pk_bf16(xf[8 * sp + 0], xf[8 * sp + 1]); wv.y = pg8::cvt_pk_bf16(xf[8 * sp + 2], xf[8 * sp + 3]);
            wv.z = pg8::cvt_pk_bf16(xf[8 * sp + 4], xf[8 * sp + 5]); wv.w = pg8::cvt_pk_bf16(xf[8 * sp + 6], xf[8 * sp + 7]);
            pfr[st][sp] = __builtin_bit_cast(bf16x8, wv);
        }
    }
    f32x16 o;
#pragma unroll
    for (int r = 0; r < 16; ++r) o[r] = 0.f;
    { const LAS unsigned char* vp = F.lds + GL_V + dvt * 4096 + ((t >> 4) & 1) * 32 + (t & 3) * 8 + (4 * hi + ((t & 15) >> 2)) * 64;
#pragma unroll
      for (int ks = 0; ks < 4; ++ks) {
          const s16x4 lo = vtr(vp + ks * 1024), hi4 = vtr(vp + ks * 1024 + 512);
          const bf16x8 vf = (bf16x8){lo[0], lo[1], lo[2], lo[3], hi4[0], hi4[1], hi4[2], hi4[3]};
          o = __builtin_amdgcn_mfma_f32_32x32x16_bf16(vf, pfr[ks >> 1][ks & 1], o, 0, 0, 0);
      } }
#pragma unroll
    for (int kd = 0; kd < 4; ++kd) {
        o = __builtin_amdgcn_mfma_f32_32x32x16_bf16(sfr[kd], qfP[kd], o, 0, 0, 0);
        o = __builtin_amdgcn_mfma_f32_32x32x16_bf16(sbr[kd], qbP[kd], o, 0, 0, 0);
    }
    float ssq = 0.f;
#pragma unroll
    for (int r = 0; r < 16; ++r) ssq += o[r] * o[r];
    { auto rr = __builtin_amdgcn_permlane32_swap(__float_as_uint(ssq), __float_as_uint(ssq), false, false); ssq = __uint_as_float(rr[0]) + __uint_as_float(rr[1]); }
    LAS float* red = (LAS float*)(F.lds + GL_RED);
    if (hi == 0) red[dvt * 64 + 32 * tt + c] = ssq;
    LDS_BARRIER();
    const float tot = (red[32 * tt + c] + red[64 + 32 * tt + c]) + (red[128 + 32 * tt + c] + red[192 + 32 * tt + c]);
    const float rstd = 1.0f / sqrtf(tot * (1.0f / 128.0f) + EPS);
    LAS unsigned char* stg = F.lds + GL_STG + w * 1024;
#pragma unroll
    for (int rg = 0; rg < 4; ++rg) {
        const u32x2 gw = gwv[rg]; const f32x4 nw = nwv[rg];
        const float g0 = bflo(gw.x), g1 = bfhi(gw.x), g2 = bflo(gw.y), g3 = bfhi(gw.y);
        const float rs = rstd * MIX_SCALE;
        *(LAS unsigned*)(stg + c * 32 + 8 * rg + 4 * hi) = pk4_fp8(o[4 * rg] * rs * nw[0] * silu_f(g0), o[4 * rg + 1] * rs * nw[1] * silu_f(g1), o[4 * rg + 2] * rs * nw[2] * silu_f(g2), o[4 * rg + 3] * rs * nw[3] * silu_f(g3));
    }
    LDS_WAIT();
    { const int row = t >> 1, hf = t & 1;
      const u32x4 v = *(const LAS u32x4*)(stg + row * 32 + hf * 16);
      *(u32x4*)((unsigned char*)MIX + (size_t)(m0 + 32 * tt + row) * D + h * 128 + 32 * dvt + hf * 16) = v; }
    LDS_BARRIER();
}
__device__ __forceinline__ void gla_g3(const Frame& F, const CAS Args* a, int l) {
    const bf16* P = (const bf16*)(F.ws + WS_P); bf16* MIX = (bf16*)(F.ws + WS_MIX);
    const bf16* US = (const bf16*)(F.ws + WS_SS); const bf16* USC = (const bf16*)(F.ws + WS_SSC);
    const int nunits = 1024 + (l == 0 ? 32 : 0);
    GlaPre pre, nx;
    { int m0, h, sf, n; bool latent; if (F.vcu < nunits) { gla_unit_decode(F.vcu, m0, h, sf, n, latent); gla_pre_load(F, P, m0, h, true, pre); } }
    for (int u = F.vcu; u < nunits; u += F.G) {
        int m0, h, sf, n; bool latent; gla_unit_decode(u, m0, h, sf, n, latent);
        if (u + F.G < nunits) { int m1, h1, s1, n1; bool l1; gla_unit_decode(u + F.G, m1, h1, s1, n1, l1); gla_pre_load(F, P, m1, h1, true, nx); }
        const bf16* Sf = latent ? US + ((size_t)sf * 128 + n) * 8192 : USC + ((size_t)sf * 4 + n) * 8192;
        const bf16* Sb = latent ? US + ((size_t)(sf + 1) * 128 + n) * 8192 : USC + ((size_t)(sf + 1) * 4 + n) * 8192;
        gla_g3_unit(F, a, l, P, m0, h, Sf, Sb, MIX, pre);
        pre = nx;
    }
}

__device__ __forceinline__ void gla_naive(const Frame& F, const CAS Args* a, int l) {
    const bf16* P = (const bf16*)(F.ws + WS_P);
    bf16* OF = (bf16*)(F.ws + WS_GL);
    for (int w = F.gw; w < 2048; w += F.NGW) {
        const int dv = w & 127, dir = (w >> 7) & 1, h = (w >> 8) & 3, b = w >> 10;
        const int pcg = dir ? PC_GB : PC_GF;
        float S = 0.f;
        for (int step = 0; step < LC + SEQ; ++step) {
            int m;
            if (dir == 0) m = step < LC ? TL + b * LC + step : b * SEQ + (step - LC);
            else m = step < LC ? TL + b * LC + (LC - 1 - step) : b * SEQ + (SEQ - 1 - (step - LC));
            const bf16* row = P + (size_t)m * NIN;
            const float la = bf2f(row[pcg + h * 64 + F.lane]), kk = bf2f(row[PC_K + h * 64 + F.lane]), qq = bf2f(row[PC_Q + h * 64 + F.lane]), vv = bf2f(row[PC_V + h * 128 + dv]);
            S = __expf(la) * S + kk * vv;
            const float o = wave_sum(qq * S);
            if (F.lane == 0) OF[((size_t)dir * TT + m) * 512 + h * 128 + dv] = (bf16)f2bf(o);
        }
    }
}
__device__ __forceinline__ void gla_out_naive(const Frame& F, const CAS Args* a, int l) {
    const bf16* P = (const bf16*)(F.ws + WS_P); bf16* MIX = (bf16*)(F.ws + WS_MIX);
    const bf16* OF = (const bf16*)(F.ws + WS_GL);
    const int rows = (l == 0) ? TT : TL;
    for (int m = F.gw; m < rows; m += F.NGW) {
        const int c0 = 8 * F.lane;
        const u32x4 wa = *(const u32x4*)(OF + (size_t)m * 512 + c0), wb = *(const u32x4*)(OF + ((size_t)TT + m) * 512 + c0);
        float o[8] = {bflo(wa.x) + bflo(wb.x), bfhi(wa.x) + bfhi(wb.x), bflo(wa.y) + bflo(wb.y), bfhi(wa.y) + bfhi(wb.y), bflo(wa.z) + bflo(wb.z), bfhi(wa.z) + bfhi(wb.z), bflo(wa.w) + bflo(wb.w), bfhi(wa.w) + bfhi(wb.w)};
        float ss = 0.f;
#pragma unroll
        for (int i = 0; i < 8; ++i) ss += o[i] * o[i];
        ss = row16_sum(ss);
        const float rstd = 1.0f / sqrtf(ss * (1.0f / 128.0f) + EPS);
        const u32x4 wg = *(const u32x4*)(P + (size_t)m * NIN + PC_G + c0);
        const float g[8] = {bflo(wg.x), bfhi(wg.x), bflo(wg.y), bfhi(wg.y), bflo(wg.z), bfhi(wg.z), bflo(wg.w), bfhi(wg.w)};
        const f32x4 n0 = *(const f32x4*)(a->in[I_GLANORM] + l * 512 + c0), n1 = *(const f32x4*)(a->in[I_GLANORM] + l * 512 + c0 + 4);
        float r[8];
#pragma unroll
        for (int i = 0; i < 8; ++i) r[i] = o[i] * rstd * (i < 4 ? n0[i] : n1[i - 4]) * silu_f(g[i]);
        u32x4 w; w.x = pk2(r[0], r[1]); w.y = pk2(r[2], r[3]); w.z = pk2(r[4], r[5]); w.w = pk2(r[6], r[7]);
        *(u32x4*)(MIX + (size_t)m * D + c0) = w;
    }
}

constexpr int N2_W = 0, N2_H = 32768, N2_PART = 98304, N2_CNT = 132096, N2_RT = 20;
static_assert(N2_PART + 16384 <= RING_BYTES && N2_CNT + 256 + NWAVES * N2_RT * 16 <= LDS_BYTES && N2_CNT >= MISC_OFF + 64 + 128, "N2 LDS map");
__device__ __forceinline__ int n2_addr(int r, int k) { return r * 2048 + ((((k >> 3) ^ r) & 127) << 4) + (k & 7) * 2; }
__device__ __forceinline__ void n2_route_phase(const Frame& F, const CAS Args* a, int l, bool do_route, int cset) {
    unsigned char* ws = F.ws;
    const float* mod = (const float*)(ws + WS_MOD);
    bf16* H = (bf16*)(ws + WS_H);
    unsigned* cnt = (unsigned*)(ws + WS_CTL) + CW_CNT + cset * NE * CNT_STRIDE;
    unsigned* list = (unsigned*)(ws + WS_LIST); float* listw = (float*)(ws + WS_LISTW);
    LAS unsigned* lcnt = (LAS unsigned*)(F.lds + N2_CNT); LAS unsigned* lbase = lcnt + 16; LAS unsigned* rec = lcnt + 64;
    for (int i = F.tid; i < D * NE; i += NWAVES * 64) { const int e = i & 15, k = i >> 4; *(LAS bf16*)(F.lds + N2_W + n2_addr(e, k)) = (bf16)f2bf(a->in[I_WROUTER][i]); }
    if (F.tid < 32) lcnt[F.tid] = 0u;
    LDS_BARRIER();
    const int rows = (l == 0) ? TT : TL;
    const int t0 = F.gw;
    const int nch = (rows - F.vcu * NWAVES + F.NGW - 1) / F.NGW;
    f32x4 xc[4][4], xq[4][4];
#pragma unroll
    for (int q = 0; q < 4; ++q) { const int m = t0 + q * F.NGW;
        if (m < rows) { const float* xr = (const float*)(ws + WS_XC) + (size_t)(m - TL) * D;
#pragma unroll
            for (int j = 0; j < 4; ++j) xq[q][j] = m < TL ? ld_y4(F.xlb + (size_t)m * D + 4 * F.lane + 256 * j) : *(const f32x4*)(xr + 4 * F.lane + 256 * j); } }
    for (int c4 = 0; c4 < nch; c4 += 4) {
#pragma unroll
        for (int q = 0; q < 4; ++q)
#pragma unroll
            for (int j = 0; j < 4; ++j) xc[q][j] = xq[q][j];
#pragma unroll
        for (int q = 0; q < 4; ++q) { const int m = t0 + (c4 + 4 + q) * F.NGW;
            if (m < rows) { const float* xr = (const float*)(ws + WS_XC) + (size_t)(m - TL) * D;
#pragma unroll
                for (int j = 0; j < 4; ++j) xq[q][j] = m < TL ? ld_y4(F.xlb + (size_t)m * D + 4 * F.lane + 256 * j) : *(const f32x4*)(xr + 4 * F.lane + 256 * j); } }
#pragma unroll
        for (int q = 0; q < 4; ++q) {
            const int m = t0 + (c4 + q) * F.NGW, r = 8 * q + F.wave;
            if (m < rows) {
                const int v = m < TL ? (m >> 13) : 2;
                float ss = 0.f;
#pragma unroll
                for (int j = 0; j < 4; ++j) ss += (xc[q][j][0] * xc[q][j][0] + xc[q][j][1] * xc[q][j][1]) + (xc[q][j][2] * xc[q][j][2] + xc[q][j][3] * xc[q][j][3]);
                const float rstd = 1.0f / sqrtf(wave_sum(ss) * (1.0f / D) + EPS);
#pragma unroll
                for (int j = 0; j < 4; ++j) {
                    const int col = 4 * F.lane + 256 * j;
                    const f32x4 nw = *(const f32x4*)(a->in[I_NORM2] + l * D + col);
                    const f32x4 sh = *(const f32x4*)(mod + (l * 3 + v) * 6144 + 3 * D + col);
                    const f32x4 sc = *(const f32x4*)(mod + (l * 3 + v) * 6144 + 4 * D + col);
                    const f32x4 h = xc[q][j] * rstd * nw * (1.0f + sc) + sh;
                    *(unsigned*)((unsigned char*)H + (size_t)m * D + col) = pk4_fp8(h[0], h[1], h[2], h[3]);
                    u32x2 o; o.x = pk2(h[0], h[1]); o.y = pk2(h[2], h[3]);
                    *(LAS u32x2*)(F.lds + N2_H + n2_addr(r, col)) = o;
                }
            }
        }
        LDS_BARRIER();
        {
            const int rr = F.lane & 15, kg = F.lane >> 4;
            f32x4 acc0 = (f32x4){0.f, 0.f, 0.f, 0.f}, acc1 = acc0;
#pragma unroll
            for (int ks = 0; ks < 4; ++ks) {
                const int k = 128 * F.wave + 32 * ks + 8 * kg;
                const bf16x8 wf = *(const LAS bf16x8*)(F.lds + N2_W + n2_addr(rr, k));
                const bf16x8 h0 = *(const LAS bf16x8*)(F.lds + N2_H + n2_addr(rr, k)), h1 = *(const LAS bf16x8*)(F.lds + N2_H + n2_addr(16 + rr, k));
                acc0 = __builtin_amdgcn_mfma_f32_16x16x32_bf16(wf, h0, acc0, 0, 0, 0);
                acc1 = __builtin_amdgcn_mfma_f32_16x16x32_bf16(wf, h1, acc1, 0, 0, 0);
            }
            *(LAS f32x4*)(F.lds + N2_PART + ((F.wave * 32 + rr) * 16 + 4 * kg) * 4) = acc0;
            *(LAS f32x4*)(F.lds + N2_PART + ((F.wave * 32 + 16 + rr) * 16 + 4 * kg) * 4) = acc1;
        }
        LDS_BARRIER();
        if (F.wave < 2) {
            const int rr = F.lane & 15, eg = F.lane >> 4, row = 16 * F.wave + rr;
            f32x4 lg = (f32x4){0.f, 0.f, 0.f, 0.f};
#pragma unroll
            for (int w = 0; w < NWAVES; ++w) lg = lg + *(const LAS f32x4*)(F.lds + N2_PART + ((w * 32 + row) * 16 + 4 * eg) * 4);
            const f32x4 br = *(const f32x4*)(a->in[I_BROUTER] + 4 * eg);
            float sg[4], sb[4];
#pragma unroll
            for (int i = 0; i < 4; ++i) { sg[i] = 1.0f / (1.0f + __expf(-lg[i])); sb[i] = sg[i] + br[i]; }
            int i0 = 0, i1 = 0; float b0 = -1e30f, b1 = -1e30f, s0 = 0.f, s1 = 0.f;
#pragma unroll
            for (int i = 0; i < 4; ++i) { const float val = sb[i];
                if (val > b0) { b1 = b0; i1 = i0; s1 = s0; b0 = val; i0 = i; s0 = sg[i]; } else if (val > b1) { b1 = val; i1 = i; s1 = sg[i]; } }
            const float gs = b0 + b1;
            float best = gs; int bg = eg;
#pragma unroll
            for (int st = 16; st < 64; st <<= 1) {
                const float og = __builtin_bit_cast(float, __builtin_amdgcn_ds_bpermute((F.lane ^ st) << 2, __builtin_bit_cast(int, best)));
                const int oi = __builtin_amdgcn_ds_bpermute((F.lane ^ st) << 2, bg);
                if (og > best || (og == best && oi < bg)) { best = og; bg = oi; }
            }
            const int wv = row & 7, ch = c4 + (row >> 3);
            const int m = F.vcu * NWAVES + wv + ch * F.NGW;
            if (do_route && bg == eg && m < rows) {
                const int e0 = 4 * eg + i0, e1 = 4 * eg + i1; const float inv = 1.0f / (s0 + s1);
                if (ch < N2_RT) {
                    const int slot = wv * N2_RT + ch;
                    const unsigned l0 = atomicAdd((unsigned*)(lcnt + e0), 1u), l1 = atomicAdd((unsigned*)(lcnt + e1), 1u);
                    rec[slot * 4 + 0] = (unsigned)m; rec[slot * 4 + 1] = (unsigned)e0 | ((unsigned)e1 << 8) | (l0 << 16) | (l1 << 24);
                    rec[slot * 4 + 2] = __float_as_uint(s0 * inv); rec[slot * 4 + 3] = __float_as_uint(s1 * inv);
                } else {
                    const unsigned p0 = atomicAdd(cnt + e0 * CNT_STRIDE, 1u); list[(size_t)e0 * LISTCAP + p0] = (unsigned)m * 2u; listw[(size_t)e0 * LISTCAP + p0] = s0 * inv;
                    const unsigned p1 = atomicAdd(cnt + e1 * CNT_STRIDE, 1u); list[(size_t)e1 * LISTCAP + p1] = (unsigned)m * 2u + 1u; listw[(size_t)e1 * LISTCAP + p1] = s1 * inv;
                }
            }
        }
    }
    LDS_BARRIER();
    if (do_route) {
        if (F.tid < NE) { const unsigned c = lcnt[F.tid]; lbase[F.tid] = c ? atomicAdd(cnt + F.tid * CNT_STRIDE, c) : 0u; }
        LDS_BARRIER();
        for (int i = F.tid; i < NWAVES * N2_RT; i += NWAVES * 64) {
            const int wv = i / N2_RT, k = i % N2_RT;
            if (F.vcu * NWAVES + wv + k * F.NGW < rows) {
                const unsigned m = rec[i * 4], pk = rec[i * 4 + 1]; const unsigned e0 = pk & 255u, e1 = (pk >> 8) & 255u, l0 = (pk >> 16) & 255u, l1 = pk >> 24;
                const unsigned p0 = lbase[e0] + l0, p1 = lbase[e1] + l1;
                list[(size_t)e0 * LISTCAP + p0] = m * 2u; listw[(size_t)e0 * LISTCAP + p0] = __uint_as_float(rec[i * 4 + 2]);
                list[(size_t)e1 * LISTCAP + p1] = m * 2u + 1u; listw[(size_t)e1 * LISTCAP + p1] = __uint_as_float(rec[i * 4 + 3]);
            }
        }
    }
    LDS_BARRIER();
}

__device__ __forceinline__ void moe_setup(pg8::MoeOrder& S, const Frame& F, int cset, int nN, bool reuse = false) {
    unsigned* cnt = (unsigned*)(F.ws + WS_CTL) + CW_CNT + cset * NE * CNT_STRIDE;
    LAS int* tab = (LAS int*)(F.lds + MISC_OFF + 64);
    __syncthreads();
    if (F.tid == 0 && !reuse) { int run = 0;
        for (int e = 0; e < NE; ++e) { const int c = (int)__hip_atomic_load(cnt + e * CNT_STRIDE, __ATOMIC_RELAXED, __HIP_MEMORY_SCOPE_AGENT); tab[e] = c; run += (c + 255) >> 8; tab[16 + e] = run; } }
    __syncthreads();
    S.tab = tab; S.nN = nN; S.nunits = __builtin_amdgcn_readfirstlane(tab[31]) * nN; S.G = F.G; S.c = (int)blockIdx.x;
    S.tdone = (unsigned*)(F.ws + WS_CTL) + CW_TDONE + cset * 160 * 16; S.role = 0;
    S.list = (const unsigned*)(F.ws + WS_LIST);
}
__device__ __forceinline__ void moe1_phase(const Frame& F, const CAS Args* a, int l, int cset) {
    pg8::MoeOrder S; moe_setup(S, F, cset, 4);
    S.A = (const char*)(F.ws + WS_H); S.Bt = (const char*)(F.ws + WS_WGU) + (size_t)l * NE * D * D; S.K = D / 2; S.bstride_e = (size_t)D * D; S.gather = true; S.role = 1;
    EpiGU E{(bf16*)(F.ws + WS_HMID)};
    pg8::gemm_phase<EpiGU, pg8::MoeOrder, true>(F.lds, F.tid, S, E, SC_W1, SC_ONE);
}
__device__ __forceinline__ void moe2_phase(const Frame& F, const CAS Args* a, int l, int cset) {
    pg8::MoeOrder S; moe_setup(S, F, cset, 4, true);
    S.A = (const char*)(F.ws + WS_HMID); S.Bt = (const char*)(F.ws + WS_WD) + (size_t)l * NE * D * DE; S.K = DE / 2; S.bstride_e = (size_t)D * DE; S.gather = false; S.role = 2; S.c = F.G - 1 - (int)blockIdx.x;
    EpiDown E; E.Y = (bf16*)(F.ws + WS_Y); E.list = (const unsigned*)(F.ws + WS_LIST); E.listw = (const float*)(F.ws + WS_LISTW); E.tab = S.tab;
    pg8::gemm_phase<EpiDown, pg8::MoeOrder, true>(F.lds, F.tid, S, E, SC_W2, SC_HMID);
    if (l == 0 && cset == 0) convert_moe_filler(F, a, 1, S.nunits, true);
}

__device__ __forceinline__ void final_load(const Frame& F, int m, f32x4 (&x)[4]) {
    const float* mod = (const float*)(F.ws + WS_MOD);
    const bf16* Y0 = (const bf16*)(F.ws + WS_Y); const bf16* Y1 = Y0 + (size_t)TT * D;
    const int v = m >> 13; const bf16* xrow = F.xlb + (size_t)m * D;
#pragma unroll
    for (int j = 0; j < 4; ++j) {
        const int col = 4 * F.lane + 256 * j;
        const f32x4 g2 = *(const f32x4*)(mod + (3 + v) * 6144 + 5 * D + col);
        const f32x4 y = ld_y4(Y0 + (size_t)m * D + col) + ld_y4(Y1 + (size_t)m * D + col);
        x[j] = ld_y4(xrow + col) + g2 * y;
    }
}
__device__ __forceinline__ void final_row(const Frame& F, const CAS Args* a, int m, const f32x4 (&x)[4]) {
    float* xrow = F.out + (size_t)m * D; float ss = 0.f;
#pragma unroll
    for (int j = 0; j < 4; ++j) ss += (x[j][0] * x[j][0] + x[j][1] * x[j][1]) + (x[j][2] * x[j][2] + x[j][3] * x[j][3]);
    const float rstd = 1.0f / sqrtf(wave_sum(ss) * (1.0f / D) + EPS);
#pragma unroll
    for (int j = 0; j < 4; ++j) { const int col = 4 * F.lane + 256 * j; const f32x4 nw = *(const f32x4*)(a->in[I_FNORM] + col); *(f32x4*)(xrow + col) = x[j] * rstd * nw; }
}
__device__ __forceinline__ void final_phase(const Frame& F, const CAS Args* a) {
    for (int m = F.gw; m < TL; m += 2 * F.NGW) {
        const int m2 = m + F.NGW; const bool two = m2 < TL;
        f32x4 xa[4], xb[4];
        final_load(F, m, xa);
        if (two) final_load(F, m2, xb);
        final_row(F, a, m, xa);
        if (two) final_row(F, a, m2, xb);
    }
}

#ifndef NPASS
#define NPASS 1
#endif
#ifndef PROBE_PH
#define PROBE_PH -1
#endif
#ifndef PROBE_R
#define PROBE_R 3
#endif
#ifndef PROBE_UPTO
#define PROBE_UPTO -1
#endif
#ifndef PROBE_ABL
#define PROBE_ABL 0
#endif
constexpr int PH_PER_LAYER = 8;
constexpr int N_PHASES = 1 + DEPTH * PH_PER_LAYER + 1;

template <int ph0>
__device__ __forceinline__ void do_phase(Frame& F, XcdBarrier& bar, LAS unsigned char* lds, int lo, int hi) {
    constexpr int ph = ph0 % N_PHASES, pass = ph0 / N_PHASES;
    if (!(lo <= ph && ph < hi)) return;
    if (pass == 1 && (PROBE_UPTO >= 0 ? ph >= PROBE_UPTO : ph != PROBE_PH)) return;
    const CAS Args* ap;
        { int l_; asm volatile("v_mbcnt_lo_u32_b32 %0, -1, 0\n\tv_mbcnt_hi_u32_b32 %0, -1, %0" : "=v"(l_)); F.lane = l_; F.tid = F.wave * 64 + l_; ap = (const CAS Args*)__builtin_amdgcn_kernarg_segment_ptr(); asm volatile("" : "+s"(ap)); F.ws = ap->ws; F.out = (pass == 1) ? (float*)(ap->ws + WS_P) : ap->out; F.xlb = (bf16*)(ap->ws + ((pass == 1) ? WS_P + 64 * MiB : WS_XLB));
          LAS unsigned char* lb_ = (LAS unsigned char*)lds; asm volatile("" : "+s"(lb_)); __builtin_assume((((unsigned)(__UINTPTR_TYPE__)lb_) & 1023u) == 0u); F.lds = lb_;
          bar.bar = (unsigned*)(F.ws + WS_CTL) + CW_BAR; bar.st = (volatile LAS unsigned*)(F.lds + MISC_OFF) + 8; }
        if (ph == 0) { if (PH_ON(10)) REP(10, true) p0_prologue(F, ap); }
        else if (ph == N_PHASES - 1) { if (PH_ON(11)) REP(11, false) final_phase(F, ap); }
        else {
            const int l = (ph - 1) / PH_PER_LAYER, s = (ph - 1) % PH_PER_LAYER;
            unsigned char* ws = F.ws;
            if (s == 0) { if (PH_ON(0)) REP(0, l == 0) { n1_phase(F, ap, l); if (l == 0) p0_convert(F, ap); } }
            else if (s == 1 && PH_ON(1)) REP(1, true) {
                pg8::DenseOrder S; S.init(ws + WS_H, ws + WS_WIN + (size_t)l * NIN * D, TT, NIN, D / 2, F.G, (int)blockIdx.x);
                EpiIn E{(bf16*)(ws + WS_P), ap->in[I_BIASF] + l * 256, ap->in[I_BIASB] + l * 256, (const float*)(ws + WS_ROPE), (const float*)(ws + WS_ROPE) + 2048, (pass == 1) ? PROBE_ABL : 0};
                pg8::gemm_phase<EpiIn, pg8::DenseOrder, true>(F.lds, F.tid, S, E, SC_W1, SC_ONE, GIN_STAG);
            }
            else if (s == 2) { constexpr int abl = (pass == 1) ? PROBE_ABL : 0; if (PH_ON(2) && abl != 5) REP(2, true) swa_flash(F, ap, l, abl); if (PH_ON(12) && abl != 6) REP(12, true) gla_g1(F, l); }
            else if (s == 3) { if (PH_ON(13)) REP(13, true) gla_scan(F); }
            else if (s == 4) { if (PH_ON(3)) REP(3, true) gla_g3(F, ap, l); }
            else if (s == 5 && PH_ON(4)) REP(4, l == 0) {
                pg8::DenseOrder S; S.init(ws + WS_MIX, ws + WS_WOUT + (size_t)l * D * D, l == 0 ? TT : TL, D, D / 2, F.G, (int)blockIdx.x);
                EpiOut E{ap->in[I_X], l == 0 ? ap->in[I_CTX] : (const float*)(ws + WS_XC), F.xlb, (float*)(ws + WS_XC), (const float*)(ws + WS_MOD) + l * 3 * 6144, l > 0};
                pg8::gemm_phase<EpiOut, pg8::DenseOrder, true>(F.lds, F.tid, S, E, SC_W1, SC_HMID);
                if (l == 0 && pass == 0) convert_moe_filler(F, ap, 0, S.nwg);
            }
            else if (s == 6) { if (PH_ON(5)) REP(5, true) n2_route_phase(F, ap, l, rep_ == 0 || pass == 1, l + 2 * pass); }
            else { constexpr int abl = (pass == 1) ? PROBE_ABL : 0; if (PH_ON(6)) { constexpr int cs_ = (pass == 1 && PROBE_UPTO < 0) ? l : l + 2 * pass; if (abl != 2) moe1_phase(F, ap, l, cs_); if (abl != 1) moe2_phase(F, ap, l, cs_); } }
        }
        if (ph0 + 1 < NPASS * N_PHASES) for (int rb_ = 0; rb_ < (REPEAT_S == 20 ? REPEAT_N : 1); ++rb_) xcd_barrier(bar, F.tid);
}
template <int... I>
__device__ __forceinline__ void run_all(Frame& F, XcdBarrier& bar, LAS unsigned char* lds, int lo, int hi, std::integer_sequence<int, I...>) { (do_phase<I>(F, bar, lds, lo, hi), ...); }

#ifdef VGPR_CAP
__attribute__((amdgpu_num_vgpr(VGPR_CAP)))
#endif
__global__ void __launch_bounds__(NWAVES * 64, 2) mk_fwd(Args args) {
    extern __shared__ __attribute__((aligned(16))) unsigned char lds[];
    Frame F;
    F.lds = (LAS unsigned char*)lds;
    F.tid = threadIdx.x; F.lane = F.tid & 63; F.wave = __builtin_amdgcn_readfirstlane(F.tid >> 6);
    F.G = gridDim.x; { const int bx = blockIdx.x; F.vcu = (F.G % 8 == 0) ? (bx % 8) * (F.G / 8) + bx / 8 : bx; }
    F.gw = F.vcu * NWAVES + F.wave; F.NGW = F.G * NWAVES;
    const CAS Args* ap = (const CAS Args*)__builtin_amdgcn_kernarg_segment_ptr();
    F.ws = ap->ws; F.out = ap->out; F.xlb = (bf16*)(ap->ws + WS_XLB);
    volatile LAS unsigned* MISC = (volatile LAS unsigned*)(F.lds + MISC_OFF);
    for (int u = F.tid; u < (LDS_BYTES - LDSCTL_OFF) / 4; u += NWAVES * 64) ((LAS unsigned*)(F.lds + LDSCTL_OFF))[u] = 0u;
    __syncthreads();
    XcdBarrier bar; bar.bar = (unsigned*)(F.ws + WS_CTL) + CW_BAR; bar.x = 0; bar.st = nullptr;
    const bool fused = (ap->ph_hi - ap->ph_lo) > 1;
    if (fused) bar = xcd_barrier_post((unsigned*)(F.ws + WS_CTL) + CW_BAR, MISC + 8);
    const int lo = ap->ph_lo, hi = ap->ph_hi;
    run_all(F, bar, (LAS unsigned char*)lds, lo, hi, std::make_integer_sequence<int, NPASS * N_PHASES>{});
}

extern "C" void kernel_launch(void* const* d_in, const int* in_sizes, int n_in, void* d_out, int out_size, void* d_ws, size_t ws_size, hipStream_t stream) {
    static int grid = 0;
    if (grid == 0) {
        if (n_in != 22 || out_size != TL * D || ws_size < WS_END) { fprintf(stderr, "kernel_launch: unexpected shapes (n_in %d out %d ws %zu)\n", n_in, out_size, ws_size); grid = -1; return; }
        int dev = 0, cus = 0, per_cu = 0;
        if (hipGetDevice(&dev) != hipSuccess || hipDeviceGetAttribute(&cus, hipDeviceAttributeMultiprocessorCount, dev) != hipSuccess) { grid = -1; return; }
        if (hipFuncSetAttribute((const void*)mk_fwd, hipFuncAttributeMaxDynamicSharedMemorySize, LDS_BYTES) != hipSuccess) { fprintf(stderr, "kernel_launch: hipFuncSetAttribute failed\n"); grid = -1; return; }
        if (hipOccupancyMaxActiveBlocksPerMultiprocessor(&per_cu, (const void*)mk_fwd, NWAVES * 64, LDS_BYTES) != hipSuccess || per_cu < 1) fprintf(stderr, "kernel_launch: occupancy query says %d\n", per_cu);
        (void)hipGetLastError();
        grid = cus;
    }
    if (grid < 0) return;
    (void)hipMemsetAsync((char*)d_ws + WS_CTL, 0, CTL_ZERO_BYTES, stream);
    Args a{};
    for (int i = 0; i < 22; ++i) a.in[i] = (const float*)d_in[i];
    a.out = (float*)d_out; a.ws = (unsigned char*)d_ws; a.li = 0; a.pad = 0;
#if MK_N_LAUNCHES == 1
    a.ph_lo = 0; a.ph_hi = N_PHASES;
    hipLaunchKernelGGL(mk_fwd, dim3(grid), dim3(NWAVES * 64), LDS_BYTES, stream, a);
#else
    for (int ph = 0; ph < N_PHASES; ++ph) { a.ph_lo = ph; a.ph_hi = ph + 1; hipLaunchKernelGGL(mk_fwd, dim3(grid), dim3(NWAVES * 64), LDS_BYTES, stream, a); }
#endif
}
```

```cpp
#include <hip/hip_runtime.h>
#include <cstdio>
#include <cstdint>
#include <utility>

#ifndef GIN_STAG
#define GIN_STAG 0
#endif
#ifndef ALIGN_EPI
#define ALIGN_EPI 1
#endif
#ifndef ONLY_S
#define ONLY_S -1
#endif
#define PH_ON(k) (ONLY_S < 0 || ONLY_S == (k))
#ifndef REPEAT_S
#define REPEAT_S -1
#endif
#ifndef REPEAT_N
#define REPEAT_N 4
#endif
#define REP(k, cond) for (int rep_ = 0; rep_ < ((pass == 1) ? PROBE_R : ((REPEAT_S == (k) && (cond)) ? REPEAT_N : 1)); ++rep_)
#ifndef MK_N_LAUNCHES
#define MK_N_LAUNCHES 1
#endif

#define GAS __attribute__((address_space(1)))
#define LAS __attribute__((address_space(3)))
#define CAS __attribute__((address_space(4)))
typedef unsigned short bf16;
typedef short bf16x8 __attribute__((ext_vector_type(8)));
typedef float f32x4 __attribute__((ext_vector_type(4)));
typedef float f32x2 __attribute__((ext_vector_type(2)));
typedef unsigned u32x4 __attribute__((ext_vector_type(4)));
typedef unsigned u32x2 __attribute__((ext_vector_type(2)));
typedef int v8i __attribute__((ext_vector_type(8)));

constexpr int D = 1024, SEQ = 8192, LC = 256, TL = 16384, TC = 512, TT = TL + TC, DEPTH = 2;
constexpr int NE = 16, DE = 512;
constexpr int NIN = 2816;
constexpr int PC_Q = 0, PC_K = 256, PC_V = 512, PC_G = 1024, PC_SQ = 1536, PC_SK = 2048, PC_SV = 2176, PC_GF = 2304, PC_GB = 2560;
constexpr int WIN_COLS = 2336;
constexpr float EPS = 1e-6f;
constexpr float LOG2E = 1.4426950408889634f, QSCALE = 0.125f * LOG2E;
constexpr int LISTCAP = TT;

constexpr size_t MiB = 1u << 20;
constexpr size_t WS_CTL = 0, CTL_ZERO_BYTES = 131072;
constexpr size_t WS_MOD = 1 * MiB;
constexpr size_t WS_ROPE = 1 * MiB + 256 * 1024;
constexpr size_t WS_LIST = 2 * MiB;
constexpr size_t WS_LISTW = 2 * MiB + 1536 * 1024;
constexpr size_t WS_XC = 5 * MiB;
constexpr size_t WS_WIN = 8 * MiB;
constexpr size_t WS_WOUT = 19 * MiB;
constexpr size_t WS_WGU = 23 * MiB;
constexpr size_t WS_WD = 87 * MiB;
constexpr size_t WS_XLB = 55 * MiB;
constexpr size_t WS_H = 119 * MiB;
constexpr size_t WS_P = 152 * MiB;
constexpr size_t WS_MIX = 243 * MiB;
constexpr size_t WS_GL = 276 * MiB;
constexpr size_t WS_HMID = 152 * MiB;
constexpr size_t WS_Y = 190 * MiB;
constexpr size_t WS_END = 309 * MiB;
static_assert(WS_LIST + (size_t)NE * LISTCAP * 4 <= WS_LISTW && WS_LISTW + (size_t)NE * LISTCAP * 4 <= WS_XC, "ws map");
static_assert(WS_P + (size_t)TT * NIN * 2 <= WS_MIX && WS_MIX + (size_t)TT * D * 2 <= WS_GL, "ws map");
static_assert(WS_HMID + (size_t)37888 * 512 * 2 <= WS_Y && WS_Y + (size_t)2 * TT * D * 2 <= WS_GL, "ws map");
constexpr int CW_CNT = 8192, CNT_STRIDE = 64;
constexpr int CW_TDONE = 16384;
constexpr int CW_BAR = 4096;

__device__ __forceinline__ unsigned f2bf(float f) { unsigned u = __builtin_bit_cast(unsigned, f); return (u + 0x7fffu + ((u >> 16) & 1u)) >> 16; }
__device__ __forceinline__ unsigned pk2(float lo, float hi) { return f2bf(lo) | (f2bf(hi) << 16); }
__device__ __forceinline__ float bf2f(unsigned h) { return __builtin_bit_cast(float, h << 16); }
__device__ __forceinline__ float bflo(unsigned w) { return __builtin_bit_cast(float, w << 16); }
__device__ __forceinline__ float bfhi(unsigned w) { return __builtin_bit_cast(float, w & 0xffff0000u); }
__device__ __forceinline__ float dpp_add(float v, float t) { return v + t; }
#define DPP_F(v, ctrl, rmask) __builtin_bit_cast(float, __builtin_amdgcn_update_dpp(0, __builtin_bit_cast(int, (v)), (ctrl), (rmask), 0xF, false))
__device__ __forceinline__ float row16_sum(float v) {
    v += DPP_F(v, 0xB1, 0xF); v += DPP_F(v, 0x4E, 0xF); v += DPP_F(v, 0x141, 0xF); v += DPP_F(v, 0x140, 0xF); return v;
}
__device__ __forceinline__ float wave_sum(float v) {
    v = row16_sum(v);
    v += DPP_F(v, 0x142, 0xA); v += DPP_F(v, 0x143, 0xC);
    return __builtin_bit_cast(float, __builtin_amdgcn_readlane(__builtin_bit_cast(int, v), 63));
}
__device__ __forceinline__ float silu_f(float x) { return x / (1.0f + __expf(-x)); }
__device__ __forceinline__ unsigned pk4_fp8(float a, float b, float c, float d) {
    a = fminf(fmaxf(a, -448.f), 448.f); b = fminf(fmaxf(b, -448.f), 448.f); c = fminf(fmaxf(c, -448.f), 448.f); d = fminf(fmaxf(d, -448.f), 448.f);
    int w = __builtin_amdgcn_cvt_pk_fp8_f32(a, b, 0, false); w = __builtin_amdgcn_cvt_pk_fp8_f32(c, d, w, true); return (unsigned)w;
}
constexpr float W1_SCALE = 64.f, W2_SCALE = 32.f, HMID_SCALE = 4.f, MIX_SCALE = 4.f, Y_SCALE = 8.f;
constexpr int SC_ONE = 127, SC_W1 = 121, SC_W2 = 122, SC_HMID = 125;
#define LDS_BARRIER() asm volatile("s_waitcnt lgkmcnt(0)\n\ts_barrier" ::: "memory")
#define LDS_WAIT() asm volatile("s_waitcnt lgkmcnt(0)" ::: "memory")
#define VM_WAIT() asm volatile("s_waitcnt vmcnt(0)" ::: "memory")

namespace pg8 {
constexpr int BM = 256, BK = 64, HALF = 128, HTB = HALF * BK * 2, STAGE_BYTES = 8 * HTB, NXCD = 8, WGM = 8;
__host__ __device__ __forceinline__ int lds_byte(int r, int c) { const int st = (r >> 4) * 2 + (c >> 5), rr = r & 15, cc = c & 31, ob = rr * 64 + cc * 2; return st * 1024 + (ob ^ (((ob >> 9) & 1) << 5)); }
__host__ __device__ __forceinline__ void stage_rc(int b, int& R, int& C) { const int st = b / 1024, sb = b % 1024, swz = sb ^ (((sb >> 9) & 1) << 5); R = (st >> 1) * 16 + swz / 64; C = (st & 1) * 32 + (swz % 64) / 2; }
__host__ __device__ __forceinline__ int perm32(int rho) { const int n = rho >> 4, i = rho & 15; return 8 * (i >> 2) + 4 * n + (i & 3); }

struct Unit { int pm, pn, e, mt; };

__device__ __forceinline__ int xcd_remap(int wgid, int nwg) { const int q = nwg / NXCD, r = nwg % NXCD, xcd = wgid % NXCD, off = wgid / NXCD; return (xcd < r ? xcd * (q + 1) : r * (q + 1) + (xcd - r) * q) + off; }

struct DenseOrder {
    static constexpr bool DYN_A = false;
    const char* A; const char* Bt; int K; int nM, nN, nwg, G, c;
    __device__ void init(const void* A_, const void* Bt_, int M, int N, int K_, int G_, int c_) { A = (const char*)A_; Bt = (const char*)Bt_; K = K_; nM = M / BM; nN = N / BM; nwg = nM * nN; G = G_; c = c_; }
    __device__ __forceinline__ bool next(int i, Unit& u) const {
        const long L = (long)i * G + c; if (L >= nwg) return false;
        const int wgid = xcd_remap((int)L, nwg);
        const int nig = WGM * nN, gid = wgid / nig, fm = gid * WGM, gsz = (nM - fm) < WGM ? (nM - fm) : WGM;
        u.pm = fm + ((wgid % nig) % gsz); u.pn = (wgid % nig) / gsz; u.e = 0; u.mt = 0; return true;
    }
    __device__ __forceinline__ void a_ready(const Unit&, int) const {}
    __device__ __forceinline__ void done(const Unit&, int) const {}
    __device__ __forceinline__ const char* a_ptr(const Unit& u) const { return A + (size_t)u.pm * (size_t)(BM * K * 2); }
    __device__ __forceinline__ const char* b_ptr(const Unit& u) const { return Bt + (size_t)u.pn * (size_t)(BM * K * 2); }
    __device__ __forceinline__ void a_voff(const Unit&, const int (&R)[2], const int (&C)[2], unsigned (&v0)[2], unsigned (&v1)[2]) const {
#pragma unroll
        for (int i = 0; i < 2; ++i) { v0[i] = (unsigned)(R[i] * K + C[i]) * 2u; v1[i] = v0[i] + (unsigned)(HALF * K * 2); }
    }
};

struct MoeOrder {
    static constexpr bool DYN_A = true;
    const char* A; const char* Bt; int K; size_t bstride_e; int G, c, nunits, nN; bool gather;
    const unsigned* list; const LAS int* tab;
    unsigned* tdone; int role;
    __device__ __forceinline__ void a_ready(const Unit& u, int wid) const {
        if (role == 2) {
            if (wid == 0) { unsigned sp = 0;
                while (__hip_atomic_load(tdone + u.pm * 16, __ATOMIC_RELAXED, __HIP_MEMORY_SCOPE_AGENT) < 32u) { __builtin_amdgcn_s_sleep(2); if (++sp > (1u << 22)) break; }
                __builtin_amdgcn_fence(__ATOMIC_ACQUIRE, "agent"); asm volatile("s_waitcnt vmcnt(0)" ::: "memory"); }
            __builtin_amdgcn_s_barrier();
        }
    }
    __device__ __forceinline__ void done(const Unit& u, int lane) const {
        if (role == 1) { asm volatile("s_waitcnt vmcnt(0)" ::: "memory");
            if (lane == 0) __hip_atomic_fetch_add(tdone + u.pm * 16, 1u, __ATOMIC_RELAXED, __HIP_MEMORY_SCOPE_AGENT); }
    }
    __device__ __forceinline__ bool next(int i, Unit& u) const {
        const long L = (long)i * G + c; if (L >= nunits) return false;
        const int wgid = xcd_remap((int)L, nunits);
        const int tl = wgid / nN; u.pn = wgid % nN;
        int e = 0, tstart = 0;
#pragma unroll 1
        for (int k = 0; k < NE - 1; ++k) { const int te = tab[16 + k]; if (tl >= te) { e = k + 1; tstart = te; } }
        u.e = __builtin_amdgcn_readfirstlane(e); u.mt = __builtin_amdgcn_readfirstlane(tl - tstart); u.pm = tl; return true;
    }
    __device__ __forceinline__ const char* a_ptr(const Unit& u) const { return gather ? A : A + (size_t)u.pm * (size_t)(BM * K * 2); }
    __device__ __forceinline__ const char* b_ptr(const Unit& u) const { return Bt + (size_t)u.e * bstride_e + (size_t)u.pn * (size_t)(BM * K * 2); }
    __device__ __forceinline__ void a_voff(const Unit& u, const int (&R)[2], const int (&C)[2], unsigned (&v0)[2], unsigned (&v1)[2]) const {
        if (gather) {
            const int ce = tab[u.e];
            const unsigned* lp = list + (size_t)u.e * LISTCAP + u.mt * BM;
#pragma unroll
            for (int i = 0; i < 2; ++i) {
                const int r0 = R[i], r1 = R[i] + HALF;
                const unsigned t0 = (u.mt * BM + r0 < ce) ? (__builtin_nontemporal_load(lp + r0) >> 1) : 0u;
                const unsigned t1 = (u.mt * BM + r1 < ce) ? (__builtin_nontemporal_load(lp + r1) >> 1) : 0u;
                v0[i] = (t0 * (unsigned)K + (unsigned)C[i]) * 2u; v1[i] = (t1 * (unsigned)K + (unsigned)C[i]) * 2u;
            }
        } else {
#pragma unroll
            for (int i = 0; i < 2; ++i) { v0[i] = (unsigned)(R[i] * K + C[i]) * 2u; v1[i] = v0[i] + (unsigned)(HALF * K * 2); }
        }
    }
};

__device__ __forceinline__ unsigned cvt_pk_bf16(float lo, float hi) { unsigned r; asm volatile("v_cvt_pk_bf16_f32 %0, %1, %2" : "=v"(r) : "v"(lo), "v"(hi)); return r; }

template <class Epi, class Sched, bool F8 = false>
__device__ __forceinline__ void gemm_phase(LAS unsigned char* lds, int tid, const Sched& S, const Epi& E, int sc_w = 127, int sc_a = 127, int stag = 0) {
    if (stag) {
        const unsigned long long t0 = __builtin_amdgcn_s_memrealtime(), dl = (unsigned long long)((blockIdx.x >> 3) & 3) * (unsigned)stag;
        while (__builtin_amdgcn_s_memrealtime() - t0 < dl) __builtin_amdgcn_s_sleep(8);
    }
    const int wid = __builtin_amdgcn_readfirstlane(tid >> 6), lane = tid & 63, wr = wid >> 2, wc = wid & 3, fr = lane & 15, fq = lane >> 4;
    const int K = S.K, nt = K / BK;
    int Rr[2], Cc[2]; unsigned voffB[2];
#pragma unroll
    for (int i = 0; i < 2; ++i) { int R, C; stage_rc(tid * 16 + i * 8192, R, C); const int Rb = Epi::PERM ? ((R & ~31) + perm32(R & 31)) : R;
        Rr[i] = R; Cc[i] = C; voffB[i] = (unsigned)(Rb * K + C) * 2u; }
    const size_t kstep = (size_t)(BK * 2);
    const size_t hstep = (size_t)HALF * K * 2;
    const unsigned ldsw = (unsigned)wid * 1024u;
    const int aoff = lds_byte(wr * 64 + fr, fq * 8), boff = lds_byte(wc * 32 + fr, fq * 8);
#define PG8_SA(b, h) (((b) * 2 + (h)) * HTB)
#define PG8_SB(b, h) ((4 + (b) * 2 + (h)) * HTB)
#define PG8_STAGE(bufoff, gbase, voff) do { _Pragma("unroll") for (int _i = 0; _i < 2; ++_i) \
        __builtin_amdgcn_global_load_lds((const unsigned*)((const char*)(gbase) + (voff)[_i]), (LAS unsigned*)(lds + (bufoff) + ldsw + _i * 8192), 16, 0, 0); } while (0)
#define PG8_CAT(lo_, hi_) ((v8i){(int)(lo_).x, (int)(lo_).y, (int)(lo_).z, (int)(lo_).w, (int)(hi_).x, (int)(hi_).y, (int)(hi_).z, (int)(hi_).w})
#define PG8_LDA(dst, b, h) do { _Pragma("unroll") for (int m = 0; m < 4; ++m) { if constexpr (F8) { const u32x4 l_ = *(const LAS u32x4*)(lds + PG8_SA(b, h) + aoff + m * 2048), h_ = *(const LAS u32x4*)(lds + PG8_SA(b, h) + aoff + m * 2048 + 1024); dst##8[m] = PG8_CAT(l_, h_); } \
        else { _Pragma("unroll") for (int k = 0; k < 2; ++k) dst[m][k] = *(const LAS bf16x8*)(lds + PG8_SA(b, h) + aoff + m * 2048 + k * 1024); } } } while (0)
#define PG8_LDB(dst, b, h) do { _Pragma("unroll") for (int n = 0; n < 2; ++n) { if constexpr (F8) { const u32x4 l_ = *(const LAS u32x4*)(lds + PG8_SB(b, h) + boff + n * 2048), h_ = *(const LAS u32x4*)(lds + PG8_SB(b, h) + boff + n * 2048 + 1024); dst##8[n] = PG8_CAT(l_, h_); } \
        else { _Pragma("unroll") for (int k = 0; k < 2; ++k) dst[n][k] = *(const LAS bf16x8*)(lds + PG8_SB(b, h) + boff + n * 2048 + k * 1024); } } } while (0)
#define PG8_MMA(ai, bj, At, Bt) do { __builtin_amdgcn_s_setprio(1); _Pragma("unroll") for (int m = 0; m < 4; ++m) _Pragma("unroll") for (int n = 0; n < 2; ++n) { \
        if constexpr (F8) asm volatile("v_mfma_scale_f32_16x16x128_f8f6f4 %0, %1, %2, %0, %3, %4 op_sel_hi:[0,0,0]" : "+v"(acc[ai][bj][m][n]) : "v"(Bt##8[n]), "v"(At##8[m]), "v"(sc_w), "v"(sc_a)); \
        else { _Pragma("unroll") for (int k = 0; k < 2; ++k) acc[ai][bj][m][n] = __builtin_amdgcn_mfma_f32_16x16x32_bf16(Bt[n][k], At[m][k], acc[ai][bj][m][n], 0, 0, 0); } } \
        __builtin_amdgcn_s_setprio(0); } while (0)
#define PG8_WAIT_V(n) asm volatile("s_waitcnt vmcnt(" #n ")" ::: "memory")
#define PG8_WAIT_L(n) asm volatile("s_waitcnt lgkmcnt(" #n ")" ::: "memory")
#define PG8_BAR __builtin_amdgcn_s_barrier()
#define PG8_SCHED __builtin_amdgcn_sched_barrier(0)
    Unit cur, nxt; int ui = 0;
    if (!S.next(0, cur)) return;
    f32x4 acc[2][2][4][2];
#pragma unroll
    for (int a = 0; a < 2; ++a)
#pragma unroll
        for (int b = 0; b < 2; ++b)
#pragma unroll
            for (int m = 0; m < 4; ++m)
#pragma unroll
                for (int n = 0; n < 2; ++n) acc[a][b][m][n] = (f32x4){0.f, 0.f, 0.f, 0.f};
    bf16x8 At[4][2], B0[2][2], B1[2][2]; v8i At8[4], B08[2], B18[2];
    const char* cA = S.a_ptr(cur); const char* cB = S.b_ptr(cur);
    unsigned cv0[2], cv1[2], nv0[2], nv1[2];
    S.a_ready(cur, wid);
    S.a_voff(cur, Rr, Cc, cv0, cv1);
    PG8_STAGE(PG8_SB(0, 0), cB, voffB); PG8_STAGE(PG8_SB(0, 1), cB + hstep, voffB); PG8_STAGE(PG8_SA(0, 0), cA, cv0); PG8_STAGE(PG8_SA(0, 1), cA, cv1);
    if (wr == 1) PG8_BAR;
    PG8_WAIT_V(2); PG8_BAR;
    PG8_STAGE(PG8_SB(1, 0), cB + kstep, voffB); PG8_STAGE(PG8_SA(1, 0), cA + kstep, cv0); PG8_STAGE(PG8_SB(1, 1), cB + hstep + kstep, voffB);
    PG8_WAIT_V(6); PG8_BAR;
    for (;;) {
        const bool has_next = S.next(ui + 1, nxt);
        const char* nA = has_next ? S.a_ptr(nxt) : cA; const char* nB = has_next ? S.b_ptr(nxt) : cB;
        if (has_next) S.a_voff(nxt, Rr, Cc, nv0, nv1); else { nv0[0] = cv0[0]; nv0[1] = cv0[1]; nv1[0] = cv1[0]; nv1[1] = cv1[1]; }
        if constexpr (Sched::DYN_A) asm volatile("" : "+v"(nv0[0]), "+v"(nv0[1]), "+v"(nv1[0]), "+v"(nv1[1]));
        for (int t = 0; t < nt; t += 2) {
            const bool last = (t == nt - 2);
            if (last && has_next) S.a_ready(nxt, wid);
            const char* a1 = cA + (size_t)(t + 1) * kstep;
            const char* a2 = last ? nA : cA + (size_t)(t + 2) * kstep; const char* b2 = last ? nB : cB + (size_t)(t + 2) * kstep;
            const char* a3 = a2 + kstep; const char* b3 = b2 + kstep;
            unsigned w0[2], w1[2];
            w0[0] = last ? nv0[0] : cv0[0]; w0[1] = last ? nv0[1] : cv0[1]; w1[0] = last ? nv1[0] : cv1[0]; w1[1] = last ? nv1[1] : cv1[1];
            PG8_LDB(B0, 0, 0); PG8_LDB(B1, 0, 1); PG8_SCHED; PG8_LDA(At, 0, 0); PG8_STAGE(PG8_SA(1, 1), a1, cv1);
            PG8_WAIT_V(8); PG8_WAIT_L(0); PG8_BAR; PG8_MMA(0, 0, At, B0); PG8_MMA(0, 1, At, B1); PG8_BAR; PG8_SCHED;
            PG8_LDA(At, 0, 1); PG8_STAGE(PG8_SB(0, 0), b2, voffB); PG8_STAGE(PG8_SB(0, 1), b2 + hstep, voffB); PG8_STAGE(PG8_SA(0, 0), a2, w0);
            PG8_WAIT_V(8); PG8_WAIT_L(0); PG8_BAR; PG8_MMA(1, 0, At, B0); PG8_MMA(1, 1, At, B1); PG8_BAR; PG8_SCHED;
            PG8_LDB(B0, 1, 0); PG8_LDB(B1, 1, 1); PG8_SCHED; PG8_LDA(At, 1, 0); PG8_STAGE(PG8_SA(0, 1), a2, w1);
            PG8_WAIT_V(8); PG8_WAIT_L(0); PG8_BAR; PG8_MMA(0, 0, At, B0); PG8_MMA(0, 1, At, B1); PG8_BAR; PG8_SCHED;
            PG8_LDA(At, 1, 1); PG8_STAGE(PG8_SB(1, 0), b3, voffB); PG8_STAGE(PG8_SB(1, 1), b3 + hstep, voffB); PG8_STAGE(PG8_SA(1, 0), a3, w0);
            PG8_WAIT_V(8); PG8_WAIT_L(0); PG8_BAR; PG8_MMA(1, 0, At, B0); PG8_MMA(1, 1, At, B1); PG8_BAR; PG8_SCHED;
        }
        if constexpr (F8) asm volatile("s_nop 15\n\ts_nop 15" ::: "memory");
        if (ALIGN_EPI) { if (wr == 0) PG8_BAR; }
        E(acc, cur, wr, wc, fr, fq);
        S.done(cur, lane);
        if (!has_next) break;
#pragma unroll
        for (int a = 0; a < 2; ++a)
#pragma unroll
            for (int b = 0; b < 2; ++b)
#pragma unroll
                for (int m = 0; m < 4; ++m)
#pragma unroll
                    for (int n = 0; n < 2; ++n) acc[a][b][m][n] = (f32x4){0.f, 0.f, 0.f, 0.f};
        cur = nxt; cA = nA; cB = nB; ++ui;
        cv0[0] = nv0[0]; cv0[1] = nv0[1]; cv1[0] = nv1[0]; cv1[1] = nv1[1];
        if (ALIGN_EPI) { if (wr == 1) PG8_BAR; }
    }
    PG8_WAIT_V(0);
    if (!ALIGN_EPI) { if (wr == 0) PG8_BAR; }
    PG8_BAR;
#undef PG8_SA
#undef PG8_SB
#undef PG8_STAGE
#undef PG8_CAT
#undef PG8_LDA
#undef PG8_LDB
#undef PG8_MMA
#undef PG8_WAIT_V
#undef PG8_WAIT_L
#undef PG8_BAR
#undef PG8_SCHED
}
}

#define XB_TMO      128
#define XB_XCNT(j)  (256  + 64 * (j))
#define XB_XSUB(j)  (1280 + 64 * (j))
#define XB_XGEN(j)  (2304 + 64 * (j))
#define XB_TOP      3328
#define XB_TOPGEN   3392
#define XCD_BAR_WORDS 3456
#define XB_SPIN_CAP (1u << 18)
__device__ __forceinline__ unsigned xb_ld(unsigned* p)              { return __hip_atomic_load(p, __ATOMIC_RELAXED, __HIP_MEMORY_SCOPE_AGENT); }
__device__ __forceinline__ unsigned xb_add(unsigned* p, unsigned v) { return __hip_atomic_fetch_add(p, v, __ATOMIC_RELAXED, __HIP_MEMORY_SCOPE_AGENT); }
__device__ __forceinline__ unsigned xb_xcc_id() { return (unsigned)__builtin_amdgcn_s_getreg((3 << 11) | 20) & 0xFu; }
#define XB_SPIN(cond, bar) do { unsigned _sp = 0; while (cond) { __builtin_amdgcn_s_sleep(1); \
    if ((++_sp & 255u) == 0u) { if (xb_ld(&(bar)[XB_TMO])) break; if (_sp > XB_SPIN_CAP) { atomicAdd(&(bar)[XB_TMO], 1u); break; } } } } while (0)
struct XcdBarrier { unsigned* bar; unsigned x; volatile LAS unsigned* st; };
__device__ __forceinline__ XcdBarrier xcd_barrier_post(unsigned* bar, volatile LAS unsigned* st) {
    XcdBarrier b; b.bar = bar; b.x = xb_xcc_id(); b.st = st;
    if (threadIdx.x == 0) (void)xb_add(&bar[XB_XCNT(b.x)], 1u);
    return b;
}
__device__ __forceinline__ void xcd_barrier_complete(unsigned* bar, unsigned x, unsigned& nloc, unsigned& nx) {
    const unsigned G = gridDim.x * gridDim.y * gridDim.z;
    unsigned sum, cnt, mine, sp = 0u;
    for (;;) {
        sum = 0u; cnt = 0u; mine = 0u;
#pragma unroll
        for (unsigned j = 0; j < 16; ++j) { const unsigned c = xb_ld(&bar[XB_XCNT(j)]); sum += c; cnt += (c > 0u) ? 1u : 0u; mine = (j == x) ? c : mine; }
        if (sum == G) break;
        __builtin_amdgcn_s_sleep(1);
        if ((++sp & 255u) == 0u) { if (xb_ld(&bar[XB_TMO])) break; if (sp > XB_SPIN_CAP) { atomicAdd(&bar[XB_TMO], 1u); break; } }
    }
    nloc = mine > 0u ? mine : 1u; nx = cnt > 0u ? cnt : 1u;
}
__device__ __forceinline__ void xcd_barrier(const XcdBarrier& b, int tid) {
    asm volatile("s_waitcnt vmcnt(0)" ::: "memory");
    __syncthreads();
    if (tid == 0) {
        unsigned* bar = b.bar;
        __builtin_amdgcn_s_waitcnt(0);
        unsigned nloc = b.st[0], nx = b.st[1];
        if (nloc == 0u) { xcd_barrier_complete(bar, b.x, nloc, nx); b.st[0] = nloc; b.st[1] = nx; }
        const unsigned old = xb_add(&bar[XB_XSUB(b.x)], 1u);
        const unsigned gen = old / nloc;
        if (old + 1u == (gen + 1u) * nloc) {
            __builtin_amdgcn_fence(__ATOMIC_RELEASE, "agent");
            asm volatile("s_waitcnt vmcnt(0)" ::: "memory");
            const unsigned og = xb_add(&bar[XB_TOP], 1u);
            const unsigned tg = og / nx;
            if (og + 1u == (tg + 1u) * nx) xb_add(&bar[XB_TOPGEN], 1u);
            else XB_SPIN(xb_ld(&bar[XB_TOPGEN]) == tg, bar);
            __builtin_amdgcn_fence(__ATOMIC_ACQUIRE, "agent");
            xb_add(&bar[XB_XGEN(b.x)], 1u);
            asm volatile("s_waitcnt vmcnt(0)" ::: "memory");
        } else {
            XB_SPIN(xb_ld(&bar[XB_XGEN(b.x)]) == gen, bar);
            __builtin_amdgcn_fence(__ATOMIC_ACQUIRE, "agent");
            asm volatile("s_waitcnt vmcnt(0)" ::: "memory");
        }
    }
    __syncthreads();
}

constexpr int NWAVES = 8;
constexpr int RING_BYTES = 131072, LDSCTL_OFF = RING_BYTES, MISC_OFF = LDSCTL_OFF + 320, LDS_BYTES = 147456;
struct Args { const float* in[22]; float* out; unsigned char* ws; int ph_lo, ph_hi, li, pad; };
enum { I_X = 0, I_C, I_CTX, I_CCTX, I_WADA, I_BADA, I_NORM1, I_NORM2, I_WIN, I_UPF, I_BIASF, I_UPB, I_BIASB, I_GLANORM, I_SINK, I_WOUT, I_WROUTER, I_BROUTER, I_WGATE, I_WUP, I_WDOWN, I_FNORM };

struct Frame {
    LAS unsigned char* lds; int tid, lane, wave, vcu, G, gw, NGW;
    unsigned char* ws; float* out; bf16* xlb;
};

__device__ __forceinline__ int rope_pos(int d) { return 8 * ((d & 15) >> 2) + 4 * (d >> 4) + (d & 3); }
__device__ __forceinline__ int gu_row(int h, int gu) { return (h >> 7) * 256 + ((h >> 2) & 1) * 128 + ((h >> 5) & 3) * 32 + ((h >> 3) & 3) * 8 + gu * 4 + (h & 3); }
struct TItem { const float* src; bf16* dst; int N, Kd, n0, rbase, mode; bool ok; float f8scale; };
__device__ __forceinline__ void titem_load(const TItem& t, int lane, f32x4 (&v)[8]) {
    const int g = lane >> 3, i8 = lane & 7;
    const float* src = t.src + (size_t)(8 * g) * t.N + 4 * i8;
#pragma unroll
    for (int q = 0; q < 8; ++q) v[q] = *(const f32x4*)(src + (size_t)q * t.N);
}
__device__ __forceinline__ void titem_store(const TItem& t, int lane, const f32x4 (&v)[8]) {
    const int g = lane >> 3, i8 = lane & 7;
#pragma unroll
    for (int i = 0; i < 4; ++i) {
        const int n = 4 * i8 + i;
        const int row = (t.mode == 0) ? t.rbase + n : (t.mode == 1) ? t.rbase + rope_pos(n) : gu_row(t.n0 + n, t.mode - 2);
        if (t.f8scale != 0.f) {
            const float sc = t.f8scale; u32x2 o; o.x = pk4_fp8(v[0][i] * sc, v[1][i] * sc, v[2][i] * sc, v[3][i] * sc); o.y = pk4_fp8(v[4][i] * sc, v[5][i] * sc, v[6][i] * sc, v[7][i] * sc);
            *(u32x2*)((unsigned char*)t.dst + (size_t)row * t.Kd + 8 * g) = o;
        } else {
            u32x4 o; o.x = pk2(v[0][i], v[1][i]); o.y = pk2(v[2][i], v[3][i]); o.z = pk2(v[4][i], v[5][i]); o.w = pk2(v[6][i], v[7][i]);
            *(u32x4*)(t.dst + (size_t)row * t.Kd + 8 * g) = o;
        }
    }
}
constexpr int IT_IN = 2 * 16 * 73, IT_OUT = 2 * 16 * 32, IT_G = 32 * 16 * 16, IT_D = 32 * 8 * 32, NITEMS = IT_IN + IT_OUT + 2 * IT_G + IT_D;
__device__ __forceinline__ TItem titem_decode(const CAS Args* a, unsigned char* ws, int it) {
    TItem t; t.ok = it < NITEMS; t.mode = 0; t.rbase = 0; t.n0 = 0; t.N = D; t.Kd = D; t.src = nullptr; t.dst = nullptr; t.f8scale = 0.f;
    if (!t.ok) return t;
    int r = it;
    if (r < IT_IN) {
        const int l = r / 1168, rr = r % 1168, kb = rr / 73, nb = rr % 73;
        if (nb == 48) { t.ok = false; return t; }
        const int n0 = nb * 32; t.n0 = n0;
        if (n0 < 1536) t.rbase = n0;
        else if (n0 < 2080) { t.rbase = PC_SQ + (n0 - 1568); t.mode = 1; }
        else if (n0 < 2208) { t.rbase = PC_SK + (n0 - 2080); t.mode = 1; }
        else t.rbase = PC_SV + (n0 - 2208);
        t.N = WIN_COLS; t.Kd = D; t.src = a->in[I_WIN] + (size_t)l * D * WIN_COLS + (size_t)(kb * 64) * WIN_COLS + n0; t.dst = (bf16*)(ws + WS_WIN + (size_t)l * NIN * D + kb * 64); t.f8scale = W1_SCALE;
        return t;
    }
    r -= IT_IN;
    if (r < IT_OUT) { const int l = r / 512, rr = r % 512, kb = rr / 32, nb = rr % 32;
        t.n0 = nb * 32; t.rbase = nb * 32; t.N = D; t.Kd = D; t.src = a->in[I_WOUT] + (size_t)l * D * D + (size_t)(kb * 64) * D + nb * 32; t.dst = (bf16*)(ws + WS_WOUT + (size_t)l * D * D + kb * 64); t.f8scale = W1_SCALE; return t; }
    r -= IT_OUT;
    if (r < 2 * IT_G) { const int gu = r / IT_G, r2 = r % IT_G, le = r2 / 256, rr = r2 % 256, kb = rr / 16, nb = rr % 16;
        t.n0 = nb * 32; t.mode = 2 + gu; t.N = DE; t.Kd = D; t.src = a->in[gu ? I_WUP : I_WGATE] + (size_t)le * D * DE + (size_t)(kb * 64) * DE + nb * 32; t.dst = (bf16*)(ws + WS_WGU + (size_t)le * D * D + kb * 64); t.f8scale = W1_SCALE; return t; }
    r -= 2 * IT_G;
    { const int le = r / 256, rr = r % 256, kb = rr / 32, nb = rr % 32;
        t.n0 = nb * 32; t.rbase = nb * 32; t.N = D; t.Kd = DE; t.src = a->in[I_WDOWN] + (size_t)le * DE * D + (size_t)(kb * 64) * D + nb * 32; t.dst = (bf16*)(ws + WS_WD + (size_t)le * D * DE + kb * 64); t.f8scale = W2_SCALE; }
    return t;
}

template <class Map>
__device__ __forceinline__ void convert_items(const Frame& F, const CAS Args* a, int n, int worker, int nworkers, Map map) {
    unsigned char* ws = F.ws;
    for (int i = worker; i < n; i += 2 * nworkers) {
        const int i2 = i + nworkers;
        const TItem ta = titem_decode(a, ws, map(i)), tb = titem_decode(a, ws, i2 < n ? map(i2) : NITEMS);
        f32x4 va[8], vb[8];
        if (ta.ok) titem_load(ta, F.lane, va);
        if (tb.ok) titem_load(tb, F.lane, vb);
        if (ta.ok) titem_store(ta, F.lane, va);
        if (tb.ok) titem_store(tb, F.lane, vb);
    }
}
struct MapSmall { __device__ __forceinline__ int operator()(int i) const { return i; } };
struct MapMoe { int l; __device__ __forceinline__ int operator()(int i) const { const int kind = i >> 12, r = i & 4095; return IT_IN + IT_OUT + (kind < 2 ? kind * IT_G : 2 * IT_G) + l * 4096 + r; } };
__device__ __forceinline__ void convert_moe_filler(const Frame& F, const CAS Args* a, int l, int nunits, bool both = false) {
    const int c = (int)blockIdx.x, nfull = nunits % F.G;
    int first = nfull, nf = F.G - nfull - (both ? nfull : 0);
    if (nfull == 0 || nf <= 0) { first = 0; nf = F.G; }
    if (c < first || c >= first + nf) return;
    convert_items(F, a, 3 * 4096, (c - first) * NWAVES + F.wave, nf * NWAVES, MapMoe{l});
}

__device__ __forceinline__ void p0_convert(const Frame& F, const CAS Args* a) {
    unsigned char* ws = F.ws;
    convert_items(F, a, IT_IN + IT_OUT, F.gw, F.NGW, MapSmall{});
    for (int idx = F.gw * 64 + F.lane; idx < 2 * 2 * 256 * 128; idx += F.NGW * 64) {
        const int kc = idx & 127, n = (idx >> 7) & 255, dir = (idx >> 15) & 1, l = idx >> 16;
        const float* up = a->in[dir ? I_UPB : I_UPF] + (size_t)l * 16 * 256 + n;
        float u[16];
#pragma unroll
        for (int r = 0; r < 16; ++r) u[r] = up[r * 256];
        float o[8];
#pragma unroll
        for (int kk = 0; kk < 8; ++kk) {
            const f32x4* wz = (const f32x4*)(a->in[I_WIN] + ((size_t)l * D + kc * 8 + kk) * WIN_COLS + 1536 + dir * 16);
            float s = 0.f;
#pragma unroll
            for (int q = 0; q < 4; ++q) { const f32x4 w = wz[q]; s += w[0] * u[4 * q] + w[1] * u[4 * q + 1] + w[2] * u[4 * q + 2] + w[3] * u[4 * q + 3]; }
            o[kk] = s;
        }
        u32x2 ov; ov.x = pk4_fp8(o[0] * W1_SCALE, o[1] * W1_SCALE, o[2] * W1_SCALE, o[3] * W1_SCALE); ov.y = pk4_fp8(o[4] * W1_SCALE, o[5] * W1_SCALE, o[6] * W1_SCALE, o[7] * W1_SCALE);
        *(u32x2*)(ws + WS_WIN + ((size_t)l * NIN + PC_GF + dir * 256 + n) * D + kc * 8) = ov;
    }
}
__device__ __forceinline__ void p0_prologue(const Frame& F, const CAS Args* a) {
    unsigned char* ws = F.ws;
    if (blockIdx.x == (unsigned)(F.G - 1)) {
        float* tc = (float*)(ws + WS_ROPE); float* tsn = tc + 2048;
        for (int i = F.tid; i < 2048; i += NWAVES * 64) { const int pos = i >> 4, j = i & 15; const float inv = powf(10000.0f, -(float)j * (1.0f / 16.0f)); const float ang = (float)pos * inv;
            tc[i] = cosf(ang); tsn[i] = sinf(ang); }
    }
    __syncthreads();
    {
        LAS float* cs = (LAS float*)F.lds; LAS float* red = cs + 3072;
        for (int i = F.tid; i < 3072; i += NWAVES * 64) { const int v = i >> 10, k = i & 1023; const float cv = v < 2 ? a->in[I_C][v * D + k] : a->in[I_CCTX][k]; cs[i] = cv / (1.0f + expf(-cv)); }
        __syncthreads();
        for (int u = blockIdx.x; u < 192; u += F.G) {
            const int l = u / 96, jg = u % 96, jl = F.tid & 63, ks = F.tid >> 6;
            const float* wp = a->in[I_WADA] + ((size_t)l * D + ks * 128) * 6144 + jg * 64 + jl;
            float a0 = 0.f, a1 = 0.f, a2 = 0.f;
#pragma unroll 1
            for (int k0 = 0; k0 < 128; k0 += 32) {
                float wv[32];
#pragma unroll
                for (int k = 0; k < 32; ++k) wv[k] = wp[(size_t)(k0 + k) * 6144];
#pragma unroll
                for (int k = 0; k < 32; ++k) { const int kk = ks * 128 + k0 + k; a0 += cs[kk] * wv[k]; a1 += cs[1024 + kk] * wv[k]; a2 += cs[2048 + kk] * wv[k]; }
            }
            red[(ks * 3 + 0) * 64 + jl] = a0; red[(ks * 3 + 1) * 64 + jl] = a1; red[(ks * 3 + 2) * 64 + jl] = a2;
            __syncthreads();
            if (F.tid < 192) { const int v = F.tid >> 6, j2 = F.tid & 63; float s = 0.f;
#pragma unroll
                for (int q = 0; q < 8; ++q) s += red[(q * 3 + v) * 64 + j2];
                ((float*)(ws + WS_MOD))[(l * 3 + v) * 6144 + jg * 64 + j2] = s + a->in[I_BADA][l * 6144 + jg * 64 + j2]; }
            __syncthreads();
        }
    }
}

__device__ __forceinline__ f32x4 ld_y4(const bf16* p) { const u32x2 w = *(const u32x2*)p; return (f32x4){bflo(w.x), bfhi(w.x), bflo(w.y), bfhi(w.y)}; }
__device__ __forceinline__ f32x4 ld_y8(const unsigned char* p) { const int w = *(const int*)p; const f32x2 lo = __builtin_amdgcn_cvt_pk_f32_fp8(w, false), hi = __builtin_amdgcn_cvt_pk_f32_fp8(w, true); return (f32x4){lo[0], lo[1], hi[0], hi[1]} * (1.0f / Y_SCALE); }
__device__ __forceinline__ void n1_load(const Frame& F, const CAS Args* a, int l, int m, f32x4 (&x)[4], f32x4 (&y)[4]) {
    unsigned char* ws = F.ws;
    const unsigned char* Y0 = ws + WS_Y; const unsigned char* Y1 = Y0 + (size_t)TT * D;
    const float* src = (l == 0) ? (m < TL ? a->in[I_X] + (size_t)m * D : a->in[I_CTX] + (size_t)(m - TL) * D) : (const float*)(ws + WS_XC) + (size_t)(m - TL) * D;
    const bool from_b = (l > 0) && (m < TL);
#pragma unroll
    for (int j = 0; j < 4; ++j) { const int col = 4 * F.lane + 256 * j; x[j] = from_b ? ld_y4(F.xlb + (size_t)m * D + col) : *(const f32x4*)(src + col);
        if (l > 0) y[j] = ld_y8(Y0 + (size_t)m * D + col) + ld_y8(Y1 + (size_t)m * D + col); }
}
__device__ __forceinline__ void n1_row(const Frame& F, const CAS Args* a, int l, int m, f32x4 (&x)[4], const f32x4 (&y)[4]) {
    unsigned char* ws = F.ws;
    const float* mod = (const float*)(ws + WS_MOD);
    bf16* H = (bf16*)(ws + WS_H);
    const int v = m < TL ? (m >> 13) : 2;
    float* xrow = (float*)(ws + WS_XC) + (size_t)(m - TL) * D;
    float ss = 0.f;
#pragma unroll
    for (int j = 0; j < 4; ++j) {
        const int col = 4 * F.lane + 256 * j;
        if (l > 0) { const f32x4 g2 = *(const f32x4*)(mod + ((l - 1) * 3 + v) * 6144 + 5 * D + col); x[j] = x[j] + g2 * y[j];
            if (m < TL) { u32x2 o; o.x = pk2(x[j][0], x[j][1]); o.y = pk2(x[j][2], x[j][3]); *(u32x2*)(F.xlb + (size_t)m * D + col) = o; } else *(f32x4*)(xrow + col) = x[j]; }
        ss += (x[j][0] * x[j][0] + x[j][1] * x[j][1]) + (x[j][2] * x[j][2] + x[j][3] * x[j][3]);
    }
    const float rstd = 1.0f / sqrtf(wave_sum(ss) * (1.0f / D) + EPS);
#pragma unroll
    for (int j = 0; j < 4; ++j) {
        const int col = 4 * F.lane + 256 * j;
        const f32x4 nw = *(const f32x4*)(a->in[I_NORM1] + l * D + col);
        const f32x4 sh = *(const f32x4*)(mod + (l * 3 + v) * 6144 + 0 * D + col);
        const f32x4 sc = *(const f32x4*)(mod + (l * 3 + v) * 6144 + 1 * D + col);
        const f32x4 h = x[j] * rstd * nw * (1.0f + sc) + sh;
        *(unsigned*)((unsigned char*)H + (size_t)m * D + col) = pk4_fp8(h[0], h[1], h[2], h[3]);
    }
}
__device__ __forceinline__ void n1_phase(const Frame& F, const CAS Args* a, int l) {
    for (int m = F.gw; m < TT; m += 2 * F.NGW) {
        const int m2 = m + F.NGW; const bool two = m2 < TT;
        f32x4 xa[4], ya[4], xb[4], yb[4];
        n1_load(F, a, l, m, xa, ya);
        if (two) n1_load(F, a, l, m2, xb, yb);
        n1_row(F, a, l, m, xa, ya);
        if (two) n1_row(F, a, l, m2, xb, yb);
    }
}

struct EpiIn {
    static constexpr bool PERM = true;
    bf16* P; const float* bias_f; const float* bias_b; const float* tcos; const float* tsin; int abl;
    template <int KIND>
    __device__ __forceinline__ void body(const f32x4 (&acc)[2][2][4][2], const pg8::Unit& u, int wr, int wc, int fr, int fq) const {
        const int row0 = u.pm * 256 + wr * 64 + fr, colw = wc * 32 + 8 * fq;
        f32x4 cs[4], sn[4], b0[2], b1[2];
        const bool wodd = (wc & 1) != 0;
        if (KIND == 3 || KIND == 5) {
            const int t0 = row0 & (SEQ - 1);
#pragma unroll
            for (int j = 0; j < 4; ++j) { const int pos = wodd ? ((t0 + 16 * j) & 63) : ((t0 + 128 * (j & 1)) >> 6);
                cs[j] = *(const f32x4*)(tcos + pos * 16 + 4 * fq); sn[j] = *(const f32x4*)(tsin + pos * 16 + 4 * fq); }
        }
        if (KIND == 2) {
#pragma unroll
            for (int bj = 0; bj < 2; ++bj) { const float* bp = (u.pn == 9 ? bias_f : bias_b) + colw + bj * 128; b0[bj] = *(const f32x4*)bp; b1[bj] = *(const f32x4*)(bp + 4); }
        }
#pragma unroll
        for (int ai = 0; ai < 2; ++ai)
#pragma unroll
            for (int m = 0; m < 4; ++m) {
                const int row = row0 + ai * 128 + m * 16;
                bf16* rowp = P + (size_t)row * NIN + u.pn * 256 + colw;
#pragma unroll
                for (int bj = 0; bj < 2; ++bj) {
                    f32x4 v0 = acc[ai][bj][m][0], v1 = acc[ai][bj][m][1];
                    if (KIND == 1) { v0 = v0 * 0.125f; v1 = v1 * 0.125f; }
                    if (KIND == 2) {
#pragma unroll
                        for (int i = 0; i < 4; ++i) { float x0 = v0[i] + b0[bj][i], x1 = v1[i] + b1[bj][i];
                            v0[i] = (fminf(x0, 0.f) - __logf(1.0f + __expf(-fabsf(x0)))) * 0.0625f; v1[i] = (fminf(x1, 0.f) - __logf(1.0f + __expf(-fabsf(x1)))) * 0.0625f; }
                    }
                    if (KIND == 3 || (KIND == 5 && bj == 0)) {
                        const f32x4 c = wodd ? cs[m] : cs[ai], sv = wodd ? sn[m] : sn[ai];
                        const f32x4 o0 = v0 * c - v1 * sv, o1 = v1 * c + v0 * sv; v0 = o0; v1 = o1;
                    }
                    if (KIND == 3 || KIND == 4) { v0 = v0 * QSCALE; v1 = v1 * QSCALE; }
                    u32x4 w; w.x = pg8::cvt_pk_bf16(v0[0], v0[1]); w.y = pg8::cvt_pk_bf16(v0[2], v0[3]); w.z = pg8::cvt_pk_bf16(v1[0], v1[1]); w.w = pg8::cvt_pk_bf16(v1[2], v1[3]);
                    *(u32x4*)(rowp + bj * 128) = w;
                }
            }
    }
    __device__ __forceinline__ void operator()(const f32x4 (&acc)[2][2][4][2], const pg8::Unit& u, int wr, int wc, int fr, int fq) const {
        const int pn = u.pn; const bool latent = u.pm < 64;
        if (pn == 0) body<1>(acc, u, wr, wc, fr, fq);
        else if (pn < 6) body<0>(acc, u, wr, wc, fr, fq);
        else if (pn < 8) { if (latent) body<3>(acc, u, wr, wc, fr, fq); else body<4>(acc, u, wr, wc, fr, fq); }
        else if (pn == 8) { if (latent) body<5>(acc, u, wr, wc, fr, fq); else body<0>(acc, u, wr, wc, fr, fq); }
        else body<2>(acc, u, wr, wc, fr, fq);
    }
};
struct EpiOut {
    static constexpr bool PERM = true;
    const float* resL; const float* resC; bf16* xlb; float* outC; const float* mod_l; bool res_b;
    __device__ __forceinline__ void operator()(const f32x4 (&acc)[2][2][4][2], const pg8::Unit& u, int wr, int wc, int fr, int fq) const {
        const bool latent = u.pm < 64;
        const int v = latent ? (u.pm >> 5) : 2;
        const int rowb = (latent ? u.pm * 256 : u.pm * 256 - TL) + wr * 64 + fr;
        const int col0 = u.pn * 256 + wc * 32 + 8 * fq;
        const float* g1p = mod_l + v * 6144 + 2 * D + col0;
        f32x4 g1[2][2];
#pragma unroll
        for (int bj = 0; bj < 2; ++bj)
#pragma unroll
            for (int n = 0; n < 2; ++n) g1[bj][n] = *(const f32x4*)(g1p + bj * 128 + n * 4);
        const bool rb = latent && res_b;
        const float* res = latent ? resL : resC;
#pragma unroll
        for (int ai = 0; ai < 2; ++ai)
#pragma unroll
            for (int mp = 0; mp < 4; mp += 2) {
                f32x4 r[2][2][2];
#pragma unroll
                for (int m = 0; m < 2; ++m) { const size_t off = (size_t)(rowb + ai * 128 + (mp + m) * 16) * D + col0;
#pragma unroll
                    for (int bj = 0; bj < 2; ++bj) {
                        if (rb) { const u32x4 w = *(const u32x4*)(xlb + off + bj * 128);
                            r[m][bj][0] = (f32x4){bflo(w.x), bfhi(w.x), bflo(w.y), bfhi(w.y)}; r[m][bj][1] = (f32x4){bflo(w.z), bfhi(w.z), bflo(w.w), bfhi(w.w)}; }
                        else { r[m][bj][0] = *(const f32x4*)(res + off + bj * 128); r[m][bj][1] = *(const f32x4*)(res + off + bj * 128 + 4); }
                    } }
#pragma unroll
                for (int m = 0; m < 2; ++m) { const size_t off = (size_t)(rowb + ai * 128 + (mp + m) * 16) * D + col0;
#pragma unroll
                    for (int bj = 0; bj < 2; ++bj) {
                        const f32x4 o0 = r[m][bj][0] + g1[bj][0] * acc[ai][bj][mp + m][0], o1 = r[m][bj][1] + g1[bj][1] * acc[ai][bj][mp + m][1];
                        if (latent) { u32x4 w; w.x = pk2(o0[0], o0[1]); w.y = pk2(o0[2], o0[3]); w.z = pk2(o1[0], o1[1]); w.w = pk2(o1[2], o1[3]); *(u32x4*)(xlb + off + bj * 128) = w; }
                        else { *(f32x4*)(outC + off + bj * 128) = o0; *(f32x4*)(outC + off + bj * 128 + 4) = o1; }
                    } }
                asm volatile("" ::: "memory");
            }
    }
};
struct EpiGU {
    static constexpr bool PERM = true;
    bf16* Hmid;
    __device__ __forceinline__ void operator()(const f32x4 (&acc)[2][2][4][2], const pg8::Unit& u, int wr, int wc, int fr, int fq) const {
        const int row0 = u.pm * 256 + wr * 64 + fr, hid0 = u.pn * 128 + wc * 32 + fq * 8;
#pragma unroll
        for (int ai = 0; ai < 2; ++ai)
#pragma unroll
            for (int m = 0; m < 4; ++m) {
                unsigned char* rowp = (unsigned char*)Hmid + (size_t)(row0 + ai * 128 + m * 16) * DE + hid0;
                unsigned wv[2];
#pragma unroll
                for (int bj = 0; bj < 2; ++bj) {
                    const f32x4 g = acc[ai][bj][m][0], up = acc[ai][bj][m][1]; f32x4 o;
#pragma unroll
                    for (int i = 0; i < 4; ++i) o[i] = g[i] * __builtin_amdgcn_rcpf(1.0f + __expf(-g[i])) * up[i];
                    wv[bj] = pk4_fp8(o[0] * HMID_SCALE, o[1] * HMID_SCALE, o[2] * HMID_SCALE, o[3] * HMID_SCALE);
                }
                __hip_atomic_store((unsigned long long*)rowp, ((unsigned long long)wv[1] << 32) | wv[0], __ATOMIC_RELAXED, __HIP_MEMORY_SCOPE_AGENT);
            }
    }
};
struct EpiDown {
    static constexpr bool PERM = true;
    bf16* Y; const unsigned* list; const float* listw; const LAS int* tab;
    __device__ __forceinline__ void operator()(const f32x4 (&acc)[2][2][4][2], const pg8::Unit& u, int wr, int wc, int fr, int fq) const {
        const int ce = tab[u.e];
        const int r0 = u.mt * 256 + wr * 64 + fr, col0 = u.pn * 256 + wc * 32 + 8 * fq;
        const unsigned* lp = list + (size_t)u.e * LISTCAP; const float* lw = listw + (size_t)u.e * LISTCAP;
        unsigned tsv[2][4]; float wv[2][4];
#pragma unroll
        for (int ai = 0; ai < 2; ++ai)
#pragma unroll
            for (int m = 0; m < 4; ++m) { const int r = r0 + ai * 128 + m * 16; const bool ok = r < ce; tsv[ai][m] = ok ? __builtin_nontemporal_load(lp + r) : 0xffffffffu; wv[ai][m] = ok ? __builtin_nontemporal_load(lw + r) : 0.f; }
#pragma unroll
        for (int ai = 0; ai < 2; ++ai)
#pragma unroll
            for (int m = 0; m < 4; ++m) {
                const unsigned ts = tsv[ai][m]; const float w = wv[ai][m];
                if (ts != 0xffffffffu) {
                    unsigned char* rowp = (unsigned char*)Y + ((size_t)(ts & 1u) * TT + (ts >> 1)) * D + col0;
                    const float ws_ = w * Y_SCALE;
#pragma unroll
                    for (int bj = 0; bj < 2; ++bj) {
                        const f32x4 v0 = acc[ai][bj][m][0] * ws_, v1 = acc[ai][bj][m][1] * ws_;
                        u32x2 o; o.x = pk4_fp8(v0[0], v0[1], v0[2], v0[3]); o.y = pk4_fp8(v1[0], v1[1], v1[2], v1[3]);
                        *(u32x2*)(rowp + bj * 128) = o;
                    }
                }
            }
    }
};

__device__ __forceinline__ void swa_naive(const Frame& F, const CAS Args* a, int l) {
    const bf16* P = (const bf16*)(F.ws + WS_P); bf16* MIX = (bf16*)(F.ws + WS_MIX);
    const int total = (l == 0 ? TT : TL) * 8;
    for (int idx = F.gw * 64 + F.lane; idx < total; idx += F.NGW * 64) {
        const int m = idx >> 3, hq = idx & 7, kvh = hq >> 2;
        const bool latent = m < TL;
        const int b = latent ? (m >> 13) : ((m - TL) >> 8), t = m & (SEQ - 1);
        float q[64];
        { const u32x4* qp = (const u32x4*)(P + (size_t)m * NIN + PC_SQ + hq * 64);
#pragma unroll
          for (int c = 0; c < 8; ++c) { const u32x4 w = qp[c]; q[8 * c] = bflo(w.x); q[8 * c + 1] = bfhi(w.x); q[8 * c + 2] = bflo(w.y); q[8 * c + 3] = bfhi(w.y);
              q[8 * c + 4] = bflo(w.z); q[8 * c + 5] = bfhi(w.z); q[8 * c + 6] = bflo(w.w); q[8 * c + 7] = bfhi(w.w); } }
        float o[64];
#pragma unroll
        for (int d = 0; d < 64; ++d) o[d] = 0.f;
        const float sink = a->in[I_SINK][l * 8 + hq] * LOG2E;
        float mx = sink, den = 1.0f;
        const int lo = latent ? (t - 128 < 0 ? 0 : t - 128) : 0, hi = latent ? (t + 128 > SEQ - 1 ? SEQ - 1 : t + 128) : -1;
        const int nloc = hi - lo + 1;
        for (int kk = 0; kk < nloc + LC; ++kk) {
            const int krow = kk < nloc ? b * SEQ + lo + kk : TL + b * LC + (kk - nloc);
            const u32x4* kp = (const u32x4*)(P + (size_t)krow * NIN + PC_SK + kvh * 64);
            float s = 0.f;
#pragma unroll
            for (int c = 0; c < 8; ++c) { const u32x4 w = kp[c]; s += q[8 * c] * bflo(w.x) + q[8 * c + 1] * bfhi(w.x) + q[8 * c + 2] * bflo(w.y) + q[8 * c + 3] * bfhi(w.y)
                + q[8 * c + 4] * bflo(w.z) + q[8 * c + 5] * bfhi(w.z) + q[8 * c + 6] * bflo(w.w) + q[8 * c + 7] * bfhi(w.w); }
            const float mn = fmaxf(mx, s), f = exp2f(mx - mn), p = exp2f(s - mn);
            den = den * f + p; mx = mn;
            const u32x4* vp = (const u32x4*)(P + (size_t)krow * NIN + PC_SV + kvh * 64);
#pragma unroll
            for (int c = 0; c < 8; ++c) { const u32x4 w = vp[c];
                o[8 * c] = o[8 * c] * f + p * bflo(w.x); o[8 * c + 1] = o[8 * c + 1] * f + p * bfhi(w.x); o[8 * c + 2] = o[8 * c + 2] * f + p * bflo(w.y); o[8 * c + 3] = o[8 * c + 3] * f + p * bfhi(w.y);
                o[8 * c + 4] = o[8 * c + 4] * f + p * bflo(w.z); o[8 * c + 5] = o[8 * c + 5] * f + p * bfhi(w.z); o[8 * c + 6] = o[8 * c + 6] * f + p * bflo(w.w); o[8 * c + 7] = o[8 * c + 7] * f + p * bfhi(w.w); }
        }
        const float inv = 1.0f / den;
        u32x4* op = (u32x4*)(MIX + (size_t)m * D + 512 + hq * 64);
#pragma unroll
        for (int c = 0; c < 8; ++c) { u32x4 w; w.x = pk2(o[8 * c] * inv, o[8 * c + 1] * inv); w.y = pk2(o[8 * c + 2] * inv, o[8 * c + 3] * inv); w.z = pk2(o[8 * c + 4] * inv, o[8 * c + 5] * inv); w.w = pk2(o[8 * c + 6] * inv, o[8 * c + 7] * inv); op[c] = w; }
    }
}


typedef float f32x16 __attribute__((ext_vector_type(16)));
typedef short s16x4 __attribute__((ext_vector_type(4)));
__device__ __forceinline__ int crow(int r, int hi) { return (r & 3) + 8 * (r >> 2) + 4 * hi; }
__device__ __forceinline__ s16x4 vtr(const LAS unsigned char* p) { return __builtin_bit_cast(s16x4, __builtin_amdgcn_ds_read_tr16_b64_v4i16((LAS s16x4*)p)); }
constexpr int SWA_K = 0, SWA_V = 49152;
__device__ __forceinline__ void swa_kload(const LAS unsigned char* Kt, int kb, int lane, bf16x8 (&kf)[4]) {
    const int r32 = lane & 31, hi = lane >> 5;
#pragma unroll
    for (int d0 = 0; d0 < 4; ++d0) kf[d0] = *(const LAS bf16x8*)(Kt + (2 * d0 + hi) * 1024 + (32 * kb + r32) * 16);
}
__device__ __forceinline__ void swa_tile(const LAS unsigned char* Kt, const LAS unsigned char* Vt, const LAS unsigned char* Kn, int mtype, const bf16x8 (&qf)[2][4], f32x16 (&o)[2][2], float (&mrun)[2], float (&lrun)[2], int lane, int abl = 0) {
    const int r32 = lane & 31, hi = lane >> 5; bf16x8 kf[4]; (void)Kn;
    const LAS unsigned char* vp = Vt + ((lane >> 4) & 1) * 32 + (lane & 3) * 8 + (4 * hi + ((lane & 15) >> 2)) * 64;
#pragma unroll
    for (int kb = 0; kb < 2; ++kb) {
        f32x16 s[2];
        swa_kload(Kt, kb, lane, kf);
#pragma unroll
        for (int d0 = 0; d0 < 4; ++d0)
#pragma unroll
            for (int qt = 0; qt < 2; ++qt) {
                if (d0 == 0) { f32x16 z;
#pragma unroll
                    for (int r = 0; r < 16; ++r) z[r] = 0.f;
                    s[qt] = __builtin_amdgcn_mfma_f32_32x32x16_bf16(kf[0], qf[qt][0], z, 0, 0, 0); }
                else if (abl != 4) s[qt] = __builtin_amdgcn_mfma_f32_32x32x16_bf16(kf[d0], qf[qt][d0], s[qt], 0, 0, 0);
            }
        __builtin_amdgcn_sched_barrier(0);
        s16x4 vlo[2][2], vhi[2][2];
#pragma unroll
        for (int dt = 0; dt < 2; ++dt)
#pragma unroll
            for (int sp = 0; sp < 2; ++sp) { vlo[dt][sp] = vtr(vp + dt * 4096 + (2 * kb + sp) * 1024); vhi[dt][sp] = vtr(vp + dt * 4096 + (2 * kb + sp) * 1024 + 512); }
        __builtin_amdgcn_sched_barrier(0);
        bf16x8 pf[2][2];
#pragma unroll
        for (int qt = 0; qt < 2; ++qt) {
            if (mtype != 0) {
                int thr = r32 + 32 * qt - 4 * hi - 32 * kb; asm volatile("" : "+v"(thr));
                if (mtype == 1) {
#pragma unroll
                    for (int r = 0; r < 16; ++r) { const int cc = (r & 3) + 8 * (r >> 2); if (cc < thr) s[qt][r] = -INFINITY; }
                } else {
#pragma unroll
                    for (int r = 0; r < 16; ++r) { const int cc = (r & 3) + 8 * (r >> 2); if (cc > thr) s[qt][r] = -INFINITY; }
                }
            }
            float rm = s[qt][0];
            if (abl != 1) {
#pragma unroll
            for (int r = 1; r < 16; ++r) rm = fmaxf(rm, s[qt][r]);
            }
            { auto rr = __builtin_amdgcn_permlane32_swap(__float_as_uint(rm), __float_as_uint(rm), false, false); rm = fmaxf(__uint_as_float(rr[0]), __uint_as_float(rr[1])); }
            const float mn = fmaxf(mrun[qt], rm);
            if (__any(mn > mrun[qt])) {
                const float alpha = __builtin_amdgcn_exp2f(mrun[qt] - mn);
                lrun[qt] *= alpha;
#pragma unroll
                for (int dt = 0; dt < 2; ++dt)
#pragma unroll
                    for (int r = 0; r < 16; ++r) o[dt][qt][r] *= alpha;
                mrun[qt] = mn;
            }
            float rs = 0.f;
            if (abl != 1) {
#pragma unroll
            for (int r = 0; r < 16; ++r) { const float p = __builtin_amdgcn_exp2f(s[qt][r] - mn); s[qt][r] = p; rs += p; }
            }
            lrun[qt] += rs;
#pragma unroll
            for (int sp = 0; sp < 2; ++sp) {
                u32x4 w; w.x = pg8::cvt_pk_bf16(s[qt][8 * sp + 0], s[qt][8 * sp + 1]); w.y = pg8::cvt_pk_bf16(s[qt][8 * sp + 2], s[qt][8 * sp + 3]);
                w.z = pg8::cvt_pk_bf16(s[qt][8 * sp + 4], s[qt][8 * sp + 5]); w.w = pg8::cvt_pk_bf16(s[qt][8 * sp + 6], s[qt][8 * sp + 7]);
                pf[qt][sp] = __builtin_bit_cast(bf16x8, w);
            }
        }
#pragma unroll
        for (int dt = 0; dt < 2; ++dt)
#pragma unroll
            for (int sp = 0; sp < 2; ++sp) {
                const bf16x8 vf = (bf16x8){vlo[dt][sp][0], vlo[dt][sp][1], vlo[dt][sp][2], vlo[dt][sp][3], vhi[dt][sp][0], vhi[dt][sp][1], vhi[dt][sp][2], vhi[dt][sp][3]};
#pragma unroll
                for (int qt = 0; qt < 2; ++qt) if (abl != 2) o[dt][qt] = __builtin_amdgcn_mfma_f32_32x32x16_bf16(vf, pf[qt][sp], o[dt][qt], 0, 0, 0);
            }
    }
}
__device__ __forceinline__ void swa_stage(const Frame& F, const bf16* P, int grow, int kvh, int ti) {
    { const int key = 8 * F.wave + (F.lane & 7), ch = F.lane >> 3;
      const u32x4 v = *(const u32x4*)(P + (size_t)(grow + key) * NIN + PC_SK + kvh * 64 + ch * 8);
      *(LAS u32x4*)(F.lds + SWA_K + ti * 8192 + ch * 1024 + key * 16) = v; }
    { const int key = 8 * F.wave + (F.lane >> 3), ch = F.lane & 7;
      const u32x4 v = *(const u32x4*)(P + (size_t)(grow + key) * NIN + PC_SV + kvh * 64 + ch * 8);
      *(LAS u32x4*)(F.lds + SWA_V + ti * 8192 + (ch >> 2) * 4096 + key * 64 + (ch & 3) * 16) = v; }
}
__device__ __forceinline__ void swa_flash(const Frame& F, const CAS Args* a, int l, int abl = 0) {
    const bf16* P = (const bf16*)(F.ws + WS_P); bf16* MIX = (bf16*)(F.ws + WS_MIX);
    const int nunits = 256 + (l == 0 ? 8 : 0);
    const int lane = F.lane, r32 = lane & 31, hi = lane >> 5;
    for (int u = F.vcu; u < nunits; u += F.G) {
        const bool latent = u < 256;
        const int b = latent ? (u >> 7) : ((u - 256) >> 2), kvh = latent ? ((u >> 6) & 1) : (((u - 256) >> 1) & 1), qb = latent ? (u & 63) : ((u - 256) & 1);
        const int q0 = qb * 128, g = F.wave >> 1, qs = F.wave & 1, hq = kvh * 4 + g;
        const int mrow0 = (latent ? b * SEQ : TL + b * LC) + q0 + 64 * qs;
        bf16x8 qf[2][4];
#pragma unroll
        for (int qt = 0; qt < 2; ++qt)
#pragma unroll
            for (int d0 = 0; d0 < 4; ++d0) { if (abl != 7) qf[qt][d0] = *(const bf16x8*)(P + (size_t)(mrow0 + 32 * qt + r32) * NIN + PC_SQ + hq * 64 + 16 * d0 + 8 * hi); else qf[qt][d0] = (bf16x8){(short)lane, 1, 2, 3, 4, 5, 6, 7}; }
        f32x16 o[2][2];
#pragma unroll
        for (int dt = 0; dt < 2; ++dt)
#pragma unroll
            for (int qt = 0; qt < 2; ++qt)
#pragma unroll
                for (int r = 0; r < 16; ++r) o[dt][qt][r] = 0.f;
        const float sink2 = a->in[I_SINK][l * 8 + hq] * LOG2E;
        float mrun[2] = {sink2, sink2}, lrun[2] = {hi == 0 ? 1.f : 0.f, hi == 0 ? 1.f : 0.f};
        if (latent) {
#pragma unroll 1
            for (int j = 0; j < 6; ++j) { const int ks = q0 - 128 + 64 * j; if (ks >= 0 && ks < SEQ && abl != 3) swa_stage(F, P, b * SEQ + ks, kvh, j); }
            LDS_BARRIER();
            { int jf = qs; while (q0 - 128 + 64 * jf < 0) ++jf;
              (void)jf;
#pragma unroll 1
              for (int tt = 0; tt < 5; ++tt) { const int j = qs + tt, ks = q0 - 128 + 64 * j;
                  if (ks >= 0 && ks < SEQ && abl != 8) { const int jn = (j + 1 < 6) ? j + 1 : j;
                      swa_tile(F.lds + SWA_K + j * 8192, F.lds + SWA_V + j * 8192, F.lds + SWA_K + jn * 8192, tt == 0 ? 1 : (tt == 4 ? 2 : 0), qf, o, mrun, lrun, lane, abl); } } }
            LDS_BARRIER();
        }
#pragma unroll 1
        for (int j = 0; j < 4; ++j) if (abl != 3) swa_stage(F, P, TL + b * LC + 64 * j, kvh, j);
        LDS_BARRIER();
        {
#pragma unroll 1
          for (int j = 0; j < 4; ++j) if (abl != 8) swa_tile(F.lds + SWA_K + j * 8192, F.lds + SWA_V + j * 8192, F.lds + SWA_K + (j < 3 ? j + 1 : j) * 8192, 0, qf, o, mrun, lrun, lane, abl); }
        LDS_BARRIER();
        LAS unsigned char* stg = F.lds + F.wave * 4096;
#pragma unroll
        for (int qt = 0; qt < 2; ++qt) {
            float lt = lrun[qt];
            { auto rr = __builtin_amdgcn_permlane32_swap(__float_as_uint(lt), __float_as_uint(lt), false, false); lt = __uint_as_float(rr[0]) + __uint_as_float(rr[1]); }
            const float is = MIX_SCALE / lt;
#pragma unroll
            for (int dt = 0; dt < 2; ++dt)
#pragma unroll
                for (int rg = 0; rg < 4; ++rg)
                    *(LAS unsigned*)(stg + (32 * qt + r32) * 64 + 32 * dt + 8 * rg + 4 * hi) = pk4_fp8(o[dt][qt][4 * rg] * is, o[dt][qt][4 * rg + 1] * is, o[dt][qt][4 * rg + 2] * is, o[dt][qt][4 * rg + 3] * is);
        }
        LDS_WAIT();
        if (abl != 7) {
            int le = lane; asm volatile("" : "+v"(le));
#pragma unroll
            for (int i = 0; i < 4; ++i) { const int row = 16 * i + (le >> 2), ch = le & 3;
                const u32x4 v = *(const LAS u32x4*)(stg + row * 64 + ch * 16);
                *(u32x4*)((unsigned char*)MIX + (size_t)(mrow0 + row) * D + 512 + hq * 64 + ch * 16) = v; }
        }
        LDS_BARRIER();
    }
}

constexpr size_t WS_US = WS_GL, WS_USC = WS_GL + 32 * MiB, WS_DEC = 7 * MiB;
static_assert(WS_USC + (size_t)16 * 4 * 8192 * 2 <= WS_END && WS_DEC + (size_t)16 * 132 * 64 * 4 <= WS_WIN, "ws map (gla)");
constexpr int GL_V = 0, GL_M0 = 16384, GL_MSZ = 64 * 72 * 2, GL_RED = GL_M0 + 4 * GL_MSZ, GL_STG = GL_RED + 1024;
__device__ __forceinline__ float wave_scan_incl(float v) {
    v += DPP_F(v, 0x111, 0xF); v += DPP_F(v, 0x112, 0xF); v += DPP_F(v, 0x114, 0xF); v += DPP_F(v, 0x118, 0xF);
    v += DPP_F(v, 0x142, 0xA); v += DPP_F(v, 0x143, 0xC); return v;
}
__device__ __forceinline__ float lane63(float v) { return __builtin_bit_cast(float, __builtin_amdgcn_readlane(__builtin_bit_cast(int, v), 63)); }
__device__ __forceinline__ void unpack8(const u32x4 w, float (&f)[8]) { f[0] = bflo(w.x); f[1] = bfhi(w.x); f[2] = bflo(w.y); f[3] = bfhi(w.y); f[4] = bflo(w.z); f[5] = bfhi(w.z); f[6] = bflo(w.w); f[7] = bfhi(w.w); }
__device__ __forceinline__ void gla_stage_v(const Frame& F, const bf16* P, int m0, int h) {
#pragma unroll
    for (int i = 0; i < 2; ++i) { const int p = F.tid + 512 * i, t = p >> 4, ch = p & 15;
        const u32x4 v = *(const u32x4*)(P + (size_t)(m0 + t) * NIN + PC_V + h * 128 + ch * 8);
        *(LAS u32x4*)(F.lds + GL_V + (ch >> 2) * 4096 + t * 64 + (ch & 3) * 16) = v; }
}
struct GlaPre { u32x4 laf, lab, kk, qq, v0, v1; };
__device__ __forceinline__ void gla_pre_load(const Frame& F, const bf16* P, int m0, int h, bool want_q, GlaPre& p) {
    const bf16* row = P + (size_t)(m0 + F.lane) * NIN + h * 64 + 8 * F.wave;
    p.laf = *(const u32x4*)(row + PC_GF); p.lab = *(const u32x4*)(row + PC_GB); p.kk = *(const u32x4*)(row + PC_K);
    if (want_q) p.qq = *(const u32x4*)(row + PC_Q);
    { const int q0 = F.tid, q1 = F.tid + 512;
      p.v0 = *(const u32x4*)(P + (size_t)(m0 + (q0 >> 4)) * NIN + PC_V + h * 128 + (q0 & 15) * 8);
      p.v1 = *(const u32x4*)(P + (size_t)(m0 + (q1 >> 4)) * NIN + PC_V + h * 128 + (q1 & 15) * 8); }
}
__device__ __forceinline__ void gla_pre_stage_v(const Frame& F, const GlaPre& p) {
    { const int q = F.tid, t = q >> 4, ch = q & 15; *(LAS u32x4*)(F.lds + GL_V + (ch >> 2) * 4096 + t * 64 + (ch & 3) * 16) = p.v0; }
    { const int q = F.tid + 512, t = q >> 4, ch = q & 15; *(LAS u32x4*)(F.lds + GL_V + (ch >> 2) * 4096 + t * 64 + (ch & 3) * 16) = p.v1; }
}
__device__ __forceinline__ void gla_unit_decode(int u, int& m0, int& h, int& sf, int& n, bool& latent) {
    latent = u < 1024; const int cc = u - 1024;
    const int b = latent ? (u >> 9) : (cc >> 4); h = latent ? ((u >> 7) & 3) : ((cc >> 2) & 3); n = latent ? (u & 127) : (cc & 3);
    m0 = latent ? b * SEQ + 64 * n : TL + b * LC + 64 * n; sf = (b * 4 + h) * 2;
}
__device__ __forceinline__ void gla_g1_unit(const Frame& F, const GlaPre& pre, bf16* Uf, bf16* Ub, float* decf, float* decb) {
    const int w = F.wave, t = F.lane, c = t & 31, hi = t >> 5;
    float laf[8], lab[8], kk[8];
    unpack8(pre.laf, laf); unpack8(pre.lab, lab); unpack8(pre.kk, kk);
    gla_pre_stage_v(F, pre);
    LAS bf16* KOF = (LAS bf16*)(F.lds + GL_M0); LAS bf16* KOB = (LAS bf16*)(F.lds + GL_M0 + GL_MSZ);
#pragma unroll
    for (int i = 0; i < 8; ++i) {
        const float incf = wave_scan_incl(laf[i]), tf = lane63(incf), incb = wave_scan_incl(lab[i]), tb = lane63(incb);
        KOF[(8 * w + i) * 72 + t] = (bf16)f2bf(kk[i] * __expf(tf - incf));
        KOB[(8 * w + i) * 72 + t] = (bf16)f2bf(kk[i] * __expf(incb - lab[i]));
        if (t == 0) { decf[8 * w + i] = __expf(tf); decb[8 * w + i] = __expf(tb); }
    }
    LDS_BARRIER();
    const int dir = w >> 2, dvt = w & 3;
    const LAS unsigned char* vp = F.lds + GL_V + dvt * 4096 + ((t >> 4) & 1) * 32 + (t & 3) * 8 + ((t & 15) >> 2) * 64 + hi * 512;
    const LAS unsigned char* kb = F.lds + GL_M0 + dir * GL_MSZ + (c * 72 + 8 * hi) * 2;
    f32x16 acc[2];
#pragma unroll
    for (int j = 0; j < 2; ++j)
#pragma unroll
        for (int r = 0; r < 16; ++r) acc[j][r] = 0.f;
#pragma unroll
    for (int sp = 0; sp < 4; ++sp) {
        const s16x4 lo = vtr(vp + sp * 1024), hi4 = vtr(vp + sp * 1024 + 256);
        const bf16x8 vf = (bf16x8){lo[0], lo[1], lo[2], lo[3], hi4[0], hi4[1], hi4[2], hi4[3]};
#pragma unroll
        for (int j = 0; j < 2; ++j) { const bf16x8 kf = *(const LAS bf16x8*)(kb + j * 32 * 144 + sp * 32); acc[j] = __builtin_amdgcn_mfma_f32_32x32x16_bf16(kf, vf, acc[j], 0, 0, 0); }
    }
    bf16* U = dir ? Ub : Uf;
#pragma unroll
    for (int j = 0; j < 2; ++j) {
        u32x4 w0, w1;
        w0.x = pk2(acc[j][0], acc[j][1]); w0.y = pk2(acc[j][2], acc[j][3]); w0.z = pk2(acc[j][4], acc[j][5]); w0.w = pk2(acc[j][6], acc[j][7]);
        w1.x = pk2(acc[j][8], acc[j][9]); w1.y = pk2(acc[j][10], acc[j][11]); w1.z = pk2(acc[j][12], acc[j][13]); w1.w = pk2(acc[j][14], acc[j][15]);
        u32x4* up = (u32x4*)(U + ((j * 4 + dvt) * 64 + t) * 16);
        up[0] = w0; up[1] = w1;
    }
    LDS_BARRIER();
}
__device__ __forceinline__ void gla_g1(const Frame& F0, int l) {
    Frame F = F0; { int l_; asm volatile("v_mbcnt_lo_u32_b32 %0, -1, 0\n\tv_mbcnt_hi_u32_b32 %0, -1, %0" : "=v"(l_)); F.lane = l_; F.tid = F.wave * 64 + l_; }
    const bf16* P = (const bf16*)(F.ws + WS_P);
    bf16* US = (bf16*)(F.ws + WS_US); bf16* USC = (bf16*)(F.ws + WS_USC); float* DEC = (float*)(F.ws + WS_DEC);
    GlaPre pre, nx;
    { int m0, h, sf, n; bool latent; if (F.vcu < 1056) { gla_unit_decode(F.vcu, m0, h, sf, n, latent); gla_pre_load(F, P, m0, h, false, pre); } }
    for (int u = F.vcu; u < 1056; u += F.G) {
        int m0, h, sf, n; bool latent; gla_unit_decode(u, m0, h, sf, n, latent);
        if (u + F.G < 1056) { int m1, h1, s1, n1; bool l1; gla_unit_decode(u + F.G, m1, h1, s1, n1, l1); gla_pre_load(F, P, m1, h1, false, nx); }
        bf16* Uf = latent ? US + ((size_t)sf * 128 + n) * 8192 : USC + ((size_t)sf * 4 + n) * 8192;
        bf16* Ub = latent ? US + ((size_t)(sf + 1) * 128 + n) * 8192 : USC + ((size_t)(sf + 1) * 4 + n) * 8192;
        const int nd = latent ? n : 128 + n;
        gla_g1_unit(F, pre, Uf, Ub, DEC + ((size_t)sf * 132 + nd) * 64, DEC + ((size_t)(sf + 1) * 132 + nd) * 64);
        pre = nx;
    }
}
constexpr size_t WS_SS = WS_H, WS_SSC = WS_H + 32 * MiB;
static_assert(WS_SSC + (size_t)16 * 4 * 8192 * 2 <= WS_P, "ws map (gla states)");
__device__ __forceinline__ void gla_scan(const Frame& F) {
    for (int w0 = (F.vcu * NWAVES + F.wave) * 64; w0 < 16 * 4096; w0 += F.G * NWAVES * 64) {
        const int seq = __builtin_amdgcn_readfirstlane(w0 >> 12), ew = __builtin_amdgcn_readfirstlane((w0 & 4095) * 2);
        const int dir = seq & 1;
        const unsigned voff = (unsigned)F.lane * 4u;
        unsigned doff;
        { const int e = ew + 2 * F.lane, r = e & 15, ln = (e >> 4) & 63, dkt = e >> 12; doff = (unsigned)(32 * dkt + (r & 3) + 8 * (r >> 2) + 4 * (ln >> 5)) * 4u; }
        const char* decb = (const char*)(F.ws + WS_DEC) + (size_t)seq * 132 * 256;
        float s0 = 0.f, s1 = 0.f;
        { const char* ub = (const char*)(F.ws + WS_USC) + ((size_t)seq * 4 * 8192 + ew) * 2; char* sb = (char*)(F.ws + WS_SSC) + ((size_t)seq * 4 * 8192 + ew) * 2;
          unsigned u[4]; f32x2 d[4];
#pragma unroll
          for (int i = 0; i < 4; ++i) { const int n = dir ? 3 - i : i; u[i] = *(const unsigned*)(ub + (size_t)n * 16384 + voff); d[i] = *(const f32x2*)(decb + (size_t)(128 + n) * 256 + doff); }
#pragma unroll
          for (int i = 0; i < 4; ++i) { const int n = dir ? 3 - i : i; *(unsigned*)(sb + (size_t)n * 16384 + voff) = pk2(s0, s1); s0 = d[i][0] * s0 + bflo(u[i]); s1 = d[i][1] * s1 + bfhi(u[i]); } }
        const long stride = dir ? -16384 : 16384, dstride = dir ? -256 : 256;
        const char* ub = (const char*)(F.ws + WS_US) + ((size_t)seq * 128 * 8192 + ew) * 2 + (dir ? (size_t)127 * 16384 : 0);
        char* sb = (char*)(F.ws + WS_SS) + ((size_t)seq * 128 * 8192 + ew) * 2 + (dir ? (size_t)127 * 16384 : 0);
        const char* db = decb + (dir ? 127 * 256 : 0);
#pragma unroll 1
        for (int i0 = 0; i0 < 128; i0 += 32) {
            unsigned u[32]; f32x2 d[32];
#pragma unroll
            for (int j = 0; j < 32; ++j) { u[j] = *(const unsigned*)(ub + j * stride + voff); d[j] = *(const f32x2*)(db + j * dstride + doff); }
#pragma unroll
            for (int j = 0; j < 32; ++j) { *(unsigned*)(sb + j * stride + voff) = pk2(s0, s1); s0 = d[j][0] * s0 + bflo(u[j]); s1 = d[j][1] * s1 + bfhi(u[j]); }
            ub += 32 * stride; sb += 32 * stride; db += 32 * dstride;
        }
    }
}
__device__ __forceinline__ void gla_g3_unit(const Frame& F, const CAS Args* a, int l, const bf16* P, int m0, int h, const bf16* Sf, const bf16* Sb, bf16* MIX, const GlaPre& pre) {
    const int w = F.wave, t = F.lane, c = t & 31, hi = t >> 5;
    bf16x8 sfr[4], sbr[4]; u32x2 gwv[4]; f32x4 nwv[4];
    { const int dvt_ = w >> 1, tt_ = w & 1;
#pragma unroll
      for (int kd = 0; kd < 4; ++kd) { const size_t off = (size_t)(((kd >> 1) * 4 + dvt_) * 64 + t) * 16 + 8 * (kd & 1); sfr[kd] = *(const bf16x8*)(Sf + off); sbr[kd] = *(const bf16x8*)(Sb + off); }
#pragma unroll
      for (int rg = 0; rg < 4; ++rg) { const int dv = 32 * dvt_ + 8 * rg + 4 * hi;
          gwv[rg] = *(const u32x2*)(P + (size_t)(m0 + 32 * tt_ + c) * NIN + PC_G + h * 128 + dv); nwv[rg] = *(const f32x4*)(a->in[I_GLANORM] + l * 512 + h * 128 + dv); } }
    {
        float laf[8], lab[8], kk[8], qq[8];
        unpack8(pre.laf, laf); unpack8(pre.lab, lab); unpack8(pre.kk, kk); unpack8(pre.qq, qq);
        gla_pre_stage_v(F, pre);
        float qf[8], kf[8], qb[8], kb[8];
#pragma unroll
        for (int i = 0; i < 8; ++i) {
            const float bf = wave_scan_incl(laf[i]), incb = wave_scan_incl(lab[i]), bb = lane63(incb) - incb + lab[i];
            qf[i] = qq[i] * __expf(bf); kf[i] = kk[i] * __expf(-bf); qb[i] = qq[i] * __expf(bb); kb[i] = kk[i] * __expf(-bb);
        }
        LAS unsigned char* mb = F.lds + GL_M0 + (t * 72 + 8 * w) * 2;
        u32x4 o;
        o.x = pk2(qf[0], qf[1]); o.y = pk2(qf[2], qf[3]); o.z = pk2(qf[4], qf[5]); o.w = pk2(qf[6], qf[7]); *(LAS u32x4*)(mb) = o;
        o.x = pk2(kf[0], kf[1]); o.y = pk2(kf[2], kf[3]); o.z = pk2(kf[4], kf[5]); o.w = pk2(kf[6], kf[7]); *(LAS u32x4*)(mb + GL_MSZ) = o;
        o.x = pk2(qb[0], qb[1]); o.y = pk2(qb[2], qb[3]); o.z = pk2(qb[4], qb[5]); o.w = pk2(qb[6], qb[7]); *(LAS u32x4*)(mb + 2 * GL_MSZ) = o;
        o.x = pk2(kb[0], kb[1]); o.y = pk2(kb[2], kb[3]); o.z = pk2(kb[4], kb[5]); o.w = pk2(kb[6], kb[7]); *(LAS u32x4*)(mb + 3 * GL_MSZ) = o;
    }
    LDS_BARRIER();
    const int dvt = w >> 1, tt = w & 1;
    bf16x8 qfB[4], qbB[4], qfP[4], qbP[4];
    { const LAS unsigned char* qp = F.lds + GL_M0 + ((32 * tt + c) * 72 + 8 * hi) * 2;
#pragma unroll
      for (int kd = 0; kd < 4; ++kd) { qfB[kd] = *(const LAS bf16x8*)(qp + kd * 32); qbB[kd] = *(const LAS bf16x8*)(qp + 2 * GL_MSZ + kd * 32); }
      const LAS unsigned char* pp = F.lds + GL_M0 + ((32 * tt + c) * 72 + 4 * hi) * 2;
#pragma unroll
      for (int kd = 0; kd < 4; ++kd) {
          const u32x2 a0 = *(const LAS u32x2*)(pp + kd * 32), a1 = *(const LAS u32x2*)(pp + kd * 32 + 16);
          const u32x2 b0 = *(const LAS u32x2*)(pp + 2 * GL_MSZ + kd * 32), b1 = *(const LAS u32x2*)(pp + 2 * GL_MSZ + kd * 32 + 16);
          qfP[kd] = __builtin_bit_cast(bf16x8, (u32x4){a0.x, a0.y, a1.x, a1.y}); qbP[kd] = __builtin_bit_cast(bf16x8, (u32x4){b0.x, b0.y, b1.x, b1.y});
      } }
    bf16x8 pfr[2][2];
#pragma unroll
    for (int st = 0; st < 2; ++st) {
        const LAS unsigned char* kp = F.lds + GL_M0 + GL_MSZ + ((32 * st + c) * 72 + 8 * hi) * 2;
        f32x16 xf, xb;
#pragma unroll
        for (int r = 0; r < 16; ++r) { xf[r] = 0.f; xb[r] = 0.f; }
        const bool needF = st <= tt, needB = st >= tt;
        if (needF) {
#pragma unroll
            for (int kd = 0; kd < 4; ++kd) xf = __builtin_amdgcn_mfma_f32_32x32x16_bf16(*(const LAS bf16x8*)(kp + kd * 32), qfB[kd], xf, 0, 0, 0);
        }
        if (needB) {
#pragma unroll
            for (int kd = 0; kd < 4; ++kd) xb = __builtin_amdgcn_mfma_f32_32x32x16_bf16(*(const LAS bf16x8*)(kp + 2 * GL_MSZ + kd * 32), qbB[kd], xb, 0, 0, 0);
        }
        if (st == tt) {
            int thr = c - 4 * hi; asm volatile("" : "+v"(thr));
#pragma unroll
            for (int r = 0; r < 16; ++r) { const int cc = (r & 3) + 8 * (r >> 2); xf[r] = (cc <= thr ? xf[r] : 0.f) + (cc >= thr ? xb[r] : 0.f); }
        } else {
#pragma unroll
            for (int r = 0; r < 16; ++r) xf[r] += xb[r];
        }
#pragma unroll
        for (int sp = 0; sp < 2; ++sp) {
            u32x4 wv; wv.x = pg8::cvt_pk_bf16(xf[8 * sp + 0], xf[8 * sp + 1]); wv.y = pg8::cvt_pk_bf16(xf[8 * sp + 2], xf[8 * sp + 3]);
            wv.z = pg8::cvt_pk_bf16(xf[8 * sp + 4], xf[8 * sp + 5]); wv.w = pg8::cvt_pk_bf16(xf[8 * sp + 6], xf[8 * sp + 7]);
            pfr[st][sp] = __builtin_bit_cast(bf16x8, wv);
        }
    }
    f32x16 o;
#pragma unroll
    for (int r = 0; r < 16; ++r) o[r] = 0.f;
    { const LAS unsigned char* vp = F.lds + GL_V + dvt * 4096 + ((t >> 4) & 1) * 32 + (t & 3) * 8 + (4 * hi + ((t & 15) >> 2)) * 64;
#pragma unroll
      for (int ks = 0; ks < 4; ++ks) {
          const s16x4 lo = vtr(vp + ks * 1024), hi4 = vtr(vp + ks * 1024 + 512);
          const bf16x8 vf = (bf16x8){lo[0], lo[1], lo[2], lo[3], hi4[0], hi4[1], hi4[2], hi4[3]};
          o = __builtin_amdgcn_mfma_f32_32x32x16_bf16(vf, pfr[ks >> 1][ks & 1], o, 0, 0, 0);
      } }
#pragma unroll
    for (int kd = 0; kd < 4; ++kd) {
        o = __builtin_amdgcn_mfma_f32_32x32x16_bf16(sfr[kd], qfP[kd], o, 0, 0, 0);
        o = __builtin_amdgcn_mfma_f32_32x32x16_bf16(sbr[kd], qbP[kd], o, 0, 0, 0);
    }
    float ssq = 0.f;
#pragma unroll
    for (int r = 0; r < 16; ++r) ssq += o[r] * o[r];
    { auto rr = __builtin_amdgcn_permlane32_swap(__float_as_uint(ssq), __float_as_uint(ssq), false, false); ssq = __uint_as_float(rr[0]) + __uint_as_float(rr[1]); }
    LAS float* red = (LAS float*)(F.lds + GL_RED);
    if (hi == 0) red[dvt * 64 + 32 * tt + c] = ssq;
    LDS_BARRIER();
    const float tot = (red[32 * tt + c] + red[64 + 32 * tt + c]) + (red[128 + 32 * tt + c] + red[192 + 32 * tt + c]);
    const float rstd = 1.0f / sqrtf(tot * (1.0f / 128.0f) + EPS);
    LAS unsigned char* stg = F.lds + GL_STG + w * 1024;
#pragma unroll
    for (int rg = 0; rg < 4; ++rg) {
        const u32x2 gw = gwv[rg]; const f32x4 nw = nwv[rg];
        const float g0 = bflo(gw.x), g1 = bfhi(gw.x), g2 = bflo(gw.y), g3 = bfhi(gw.y);
        const float rs = rstd * MIX_SCALE;
        *(LAS unsigned*)(stg + c * 32 + 8 * rg + 4 * hi) = pk4_fp8(o[4 * rg] * rs * nw[0] * silu_f(g0), o[4 * rg + 1] * rs * nw[1] * silu_f(g1), o[4 * rg + 2] * rs * nw[2] * silu_f(g2), o[4 * rg + 3] * rs * nw[3] * silu_f(g3));
    }
    LDS_WAIT();
    { const int row = t >> 1, hf = t & 1;
      const u32x4 v = *(const LAS u32x4*)(stg + row * 32 + hf * 16);
      *(u32x4*)((unsigned char*)MIX + (size_t)(m0 + 32 * tt + row) * D + h * 128 + 32 * dvt + hf * 16) = v; }
    LDS_BARRIER();
}
__device__ __forceinline__ void gla_g3(const Frame& F, const CAS Args* a, int l) {
    const bf16* P = (const bf16*)(F.ws + WS_P); bf16* MIX = (bf16*)(F.ws + WS_MIX);
    const bf16* US = (const bf16*)(F.ws + WS_SS); const bf16* USC = (const bf16*)(F.ws + WS_SSC);
    const int nunits = 1024 + (l == 0 ? 32 : 0);
    GlaPre pre, nx;
    { int m0, h, sf, n; bool latent; if (F.vcu < nunits) { gla_unit_decode(F.vcu, m0, h, sf, n, latent); gla_pre_load(F, P, m0, h, true, pre); } }
    for (int u = F.vcu; u < nunits; u += F.G) {
        int m0, h, sf, n; bool latent; gla_unit_decode(u, m0, h, sf, n, latent);
        if (u + F.G < nunits) { int m1, h1, s1, n1; bool l1; gla_unit_decode(u + F.G, m1, h1, s1, n1, l1); gla_pre_load(F, P, m1, h1, true, nx); }
        const bf16* Sf = latent ? US + ((size_t)sf * 128 + n) * 8192 : USC + ((size_t)sf * 4 + n) * 8192;
        const bf16* Sb = latent ? US + ((size_t)(sf + 1) * 128 + n) * 8192 : USC + ((size_t)(sf + 1) * 4 + n) * 8192;
        gla_g3_unit(F, a, l, P, m0, h, Sf, Sb, MIX, pre);
        pre = nx;
    }
}

__device__ __forceinline__ void gla_naive(const Frame& F, const CAS Args* a, int l) {
    const bf16* P = (const bf16*)(F.ws + WS_P);
    bf16* OF = (bf16*)(F.ws + WS_GL);
    for (int w = F.gw; w < 2048; w += F.NGW) {
        const int dv = w & 127, dir = (w >> 7) & 1, h = (w >> 8) & 3, b = w >> 10;
        const int pcg = dir ? PC_GB : PC_GF;
        float S = 0.f;
        for (int step = 0; step < LC + SEQ; ++step) {
            int m;
            if (dir == 0) m = step < LC ? TL + b * LC + step : b * SEQ + (step - LC);
            else m = step < LC ? TL + b * LC + (LC - 1 - step) : b * SEQ + (SEQ - 1 - (step - LC));
            const bf16* row = P + (size_t)m * NIN;
            const float la = bf2f(row[pcg + h * 64 + F.lane]), kk = bf2f(row[PC_K + h * 64 + F.lane]), qq = bf2f(row[PC_Q + h * 64 + F.lane]), vv = bf2f(row[PC_V + h * 128 + dv]);
            S = __expf(la) * S + kk * vv;
            const float o = wave_sum(qq * S);
            if (F.lane == 0) OF[((size_t)dir * TT + m) * 512 + h * 128 + dv] = (bf16)f2bf(o);
        }
    }
}
__device__ __forceinline__ void gla_out_naive(const Frame& F, const CAS Args* a, int l) {
    const bf16* P = (const bf16*)(F.ws + WS_P); bf16* MIX = (bf16*)(F.ws + WS_MIX);
    const bf16* OF = (const bf16*)(F.ws + WS_GL);
    const int rows = (l == 0) ? TT : TL;
    for (int m = F.gw; m < rows; m += F.NGW) {
        const int c0 = 8 * F.lane;
        const u32x4 wa = *(const u32x4*)(OF + (size_t)m * 512 + c0), wb = *(const u32x4*)(OF + ((size_t)TT + m) * 512 + c0);
        float o[8] = {bflo(wa.x) + bflo(wb.x), bfhi(wa.x) + bfhi(wb.x), bflo(wa.y) + bflo(wb.y), bfhi(wa.y) + bfhi(wb.y), bflo(wa.z) + bflo(wb.z), bfhi(wa.z) + bfhi(wb.z), bflo(wa.w) + bflo(wb.w), bfhi(wa.w) + bfhi(wb.w)};
        float ss = 0.f;
#pragma unroll
        for (int i = 0; i < 8; ++i) ss += o[i] * o[i];
        ss = row16_sum(ss);
        const float rstd = 1.0f / sqrtf(ss * (1.0f / 128.0f) + EPS);
        const u32x4 wg = *(const u32x4*)(P + (size_t)m * NIN + PC_G + c0);
        const float g[8] = {bflo(wg.x), bfhi(wg.x), bflo(wg.y), bfhi(wg.y), bflo(wg.z), bfhi(wg.z), bflo(wg.w), bfhi(wg.w)};
        const f32x4 n0 = *(const f32x4*)(a->in[I_GLANORM] + l * 512 + c0), n1 = *(const f32x4*)(a->in[I_GLANORM] + l * 512 + c0 + 4);
        float r[8];
#pragma unroll
        for (int i = 0; i < 8; ++i) r[i] = o[i] * rstd * (i < 4 ? n0[i] : n1[i - 4]) * silu_f(g[i]);
        u32x4 w; w.x = pk2(r[0], r[1]); w.y = pk2(r[2], r[3]); w.z = pk2(r[4], r[5]); w.w = pk2(r[6], r[7]);
        *(u32x4*)(MIX + (size_t)m * D + c0) = w;
    }
}

constexpr int N2_W = 0, N2_H = 32768, N2_PART = 98304, N2_CNT = 132096, N2_RT = 20;
static_assert(N2_PART + 16384 <= RING_BYTES && N2_CNT + 256 + NWAVES * N2_RT * 16 <= LDS_BYTES && N2_CNT >= MISC_OFF + 64 + 128, "N2 LDS map");
__device__ __forceinline__ int n2_addr(int r, int k) { return r * 2048 + ((((k >> 3) ^ r) & 127) << 4) + (k & 7) * 2; }
__device__ __forceinline__ void n2_route_phase(const Frame& F, const CAS Args* a, int l, bool do_route, int cset) {
    unsigned char* ws = F.ws;
    const float* mod = (const float*)(ws + WS_MOD);
    bf16* H = (bf16*)(ws + WS_H);
    unsigned* cnt = (unsigned*)(ws + WS_CTL) + CW_CNT + cset * NE * CNT_STRIDE;
    unsigned* list = (unsigned*)(ws + WS_LIST); float* listw = (float*)(ws + WS_LISTW);
    LAS unsigned* lcnt = (LAS unsigned*)(F.lds + N2_CNT); LAS unsigned* lbase = lcnt + 16; LAS unsigned* rec = lcnt + 64;
    for (int i = F.tid; i < D * NE; i += NWAVES * 64) { const int e = i & 15, k = i >> 4; *(LAS bf16*)(F.lds + N2_W + n2_addr(e, k)) = (bf16)f2bf(a->in[I_WROUTER][i]); }
    if (F.tid < 32) lcnt[F.tid] = 0u;
    LDS_BARRIER();
    const int rows = (l == 0) ? TT : TL;
    const int t0 = F.gw;
    const int nch = (rows - F.vcu * NWAVES + F.NGW - 1) / F.NGW;
    f32x4 xc[4][4], xq[4][4];
#pragma unroll
    for (int q = 0; q < 4; ++q) { const int m = t0 + q * F.NGW;
        if (m < rows) { const float* xr = (const float*)(ws + WS_XC) + (size_t)(m - TL) * D;
#pragma unroll
            for (int j = 0; j < 4; ++j) xq[q][j] = m < TL ? ld_y4(F.xlb + (size_t)m * D + 4 * F.lane + 256 * j) : *(const f32x4*)(xr + 4 * F.lane + 256 * j); } }
    for (int c4 = 0; c4 < nch; c4 += 4) {
#pragma unroll
        for (int q = 0; q < 4; ++q)
#pragma unroll
            for (int j = 0; j < 4; ++j) xc[q][j] = xq[q][j];
#pragma unroll
        for (int q = 0; q < 4; ++q) { const int m = t0 + (c4 + 4 + q) * F.NGW;
            if (m < rows) { const float* xr = (const float*)(ws + WS_XC) + (size_t)(m - TL) * D;
#pragma unroll
                for (int j = 0; j < 4; ++j) xq[q][j] = m < TL ? ld_y4(F.xlb + (size_t)m * D + 4 * F.lane + 256 * j) : *(const f32x4*)(xr + 4 * F.lane + 256 * j); } }
#pragma unroll
        for (int q = 0; q < 4; ++q) {
            const int m = t0 + (c4 + q) * F.NGW, r = 8 * q + F.wave;
            if (m < rows) {
                const int v = m < TL ? (m >> 13) : 2;
                float ss = 0.f;
#pragma unroll
                for (int j = 0; j < 4; ++j) ss += (xc[q][j][0] * xc[q][j][0] + xc[q][j][1] * xc[q][j][1]) + (xc[q][j][2] * xc[q][j][2] + xc[q][j][3] * xc[q][j][3]);
                const float rstd = 1.0f / sqrtf(wave_sum(ss) * (1.0f / D) + EPS);
#pragma unroll
                for (int j = 0; j < 4; ++j) {
                    const int col = 4 * F.lane + 256 * j;
                    const f32x4 nw = *(const f32x4*)(a->in[I_NORM2] + l * D + col);
                    const f32x4 sh = *(const f32x4*)(mod + (l * 3 + v) * 6144 + 3 * D + col);
                    const f32x4 sc = *(const f32x4*)(mod + (l * 3 + v) * 6144 + 4 * D + col);
                    const f32x4 h = xc[q][j] * rstd * nw * (1.0f + sc) + sh;
                    *(unsigned*)((unsigned char*)H + (size_t)m * D + col) = pk4_fp8(h[0], h[1], h[2], h[3]);
                    u32x2 o; o.x = pk2(h[0], h[1]); o.y = pk2(h[2], h[3]);
                    *(LAS u32x2*)(F.lds + N2_H + n2_addr(r, col)) = o;
                }
            }
        }
        LDS_BARRIER();
        {
            const int rr = F.lane & 15, kg = F.lane >> 4;
            f32x4 acc0 = (f32x4){0.f, 0.f, 0.f, 0.f}, acc1 = acc0;
#pragma unroll
            for (int ks = 0; ks < 4; ++ks) {
                const int k = 128 * F.wave + 32 * ks + 8 * kg;
                const bf16x8 wf = *(const LAS bf16x8*)(F.lds + N2_W + n2_addr(rr, k));
                const bf16x8 h0 = *(const LAS bf16x8*)(F.lds + N2_H + n2_addr(rr, k)), h1 = *(const LAS bf16x8*)(F.lds + N2_H + n2_addr(16 + rr, k));
                acc0 = __builtin_amdgcn_mfma_f32_16x16x32_bf16(wf, h0, acc0, 0, 0, 0);
                acc1 = __builtin_amdgcn_mfma_f32_16x16x32_bf16(wf, h1, acc1, 0, 0, 0);
            }
            *(LAS f32x4*)(F.lds + N2_PART + ((F.wave * 32 + rr) * 16 + 4 * kg) * 4) = acc0;
            *(LAS f32x4*)(F.lds + N2_PART + ((F.wave * 32 + 16 + rr) * 16 + 4 * kg) * 4) = acc1;
        }
        LDS_BARRIER();
        if (F.wave < 2) {
            const int rr = F.lane & 15, eg = F.lane >> 4, row = 16 * F.wave + rr;
            f32x4 lg = (f32x4){0.f, 0.f, 0.f, 0.f};
#pragma unroll
            for (int w = 0; w < NWAVES; ++w) lg = lg + *(const LAS f32x4*)(F.lds + N2_PART + ((w * 32 + row) * 16 + 4 * eg) * 4);
            const f32x4 br = *(const f32x4*)(a->in[I_BROUTER] + 4 * eg);
            float sg[4], sb[4];
#pragma unroll
            for (int i = 0; i < 4; ++i) { sg[i] = 1.0f / (1.0f + __expf(-lg[i])); sb[i] = sg[i] + br[i]; }
            int i0 = 0, i1 = 0; float b0 = -1e30f, b1 = -1e30f, s0 = 0.f, s1 = 0.f;
#pragma unroll
            for (int i = 0; i < 4; ++i) { const float val = sb[i];
                if (val > b0) { b1 = b0; i1 = i0; s1 = s0; b0 = val; i0 = i; s0 = sg[i]; } else if (val > b1) { b1 = val; i1 = i; s1 = sg[i]; } }
            const float gs = b0 + b1;
            float best = gs; int bg = eg;
#pragma unroll
            for (int st = 16; st < 64; st <<= 1) {
                const float og = __builtin_bit_cast(float, __builtin_amdgcn_ds_bpermute((F.lane ^ st) << 2, __builtin_bit_cast(int, best)));
                const int oi = __builtin_amdgcn_ds_bpermute((F.lane ^ st) << 2, bg);
                if (og > best || (og == best && oi < bg)) { best = og; bg = oi; }
            }
            const int wv = row & 7, ch = c4 + (row >> 3);
            const int m = F.vcu * NWAVES + wv + ch * F.NGW;
            if (do_route && bg == eg && m < rows) {
                const int e0 = 4 * eg + i0, e1 = 4 * eg + i1; const float inv = 1.0f / (s0 + s1);
                if (ch < N2_RT) {
                    const int slot = wv * N2_RT + ch;
                    const unsigned l0 = atomicAdd((unsigned*)(lcnt + e0), 1u), l1 = atomicAdd((unsigned*)(lcnt + e1), 1u);
                    rec[slot * 4 + 0] = (unsigned)m; rec[slot * 4 + 1] = (unsigned)e0 | ((unsigned)e1 << 8) | (l0 << 16) | (l1 << 24);
                    rec[slot * 4 + 2] = __float_as_uint(s0 * inv); rec[slot * 4 + 3] = __float_as_uint(s1 * inv);
                } else {
                    const unsigned p0 = atomicAdd(cnt + e0 * CNT_STRIDE, 1u); list[(size_t)e0 * LISTCAP + p0] = (unsigned)m * 2u; listw[(size_t)e0 * LISTCAP + p0] = s0 * inv;
                    const unsigned p1 = atomicAdd(cnt + e1 * CNT_STRIDE, 1u); list[(size_t)e1 * LISTCAP + p1] = (unsigned)m * 2u + 1u; listw[(size_t)e1 * LISTCAP + p1] = s1 * inv;
                }
            }
        }
    }
    LDS_BARRIER();
    if (do_route) {
        if (F.tid < NE) { const unsigned c = lcnt[F.tid]; lbase[F.tid] = c ? atomicAdd(cnt + F.tid * CNT_STRIDE, c) : 0u; }
        LDS_BARRIER();
        for (int i = F.tid; i < NWAVES * N2_RT; i += NWAVES * 64) {
            const int wv = i / N2_RT, k = i % N2_RT;
            if (F.vcu * NWAVES + wv + k * F.NGW < rows) {
                const unsigned m = rec[i * 4], pk = rec[i * 4 + 1]; const unsigned e0 = pk & 255u, e1 = (pk >> 8) & 255u, l0 = (pk >> 16) & 255u, l1 = pk >> 24;
                const unsigned p0 = lbase[e0] + l0, p1 = lbase[e1] + l1;
                list[(size_t)e0 * LISTCAP + p0] = m * 2u; listw[(size_t)e0 * LISTCAP + p0] = __uint_as_float(rec[i * 4 + 2]);
                list[(size_t)e1 * LISTCAP + p1] = m * 2u + 1u; listw[(size_t)e1 * LISTCAP + p1] = __uint_as_float(rec[i * 4 + 3]);
            }
        }
    }
    LDS_BARRIER();
}

__device__ __forceinline__ void moe_setup(pg8::MoeOrder& S, const Frame& F, int cset, int nN, bool reuse = false) {
    unsigned* cnt = (unsigned*)(F.ws + WS_CTL) + CW_CNT + cset * NE * CNT_STRIDE;
    LAS int* tab = (LAS int*)(F.lds + MISC_OFF + 64);
    __syncthreads();
    if (F.tid == 0 && !reuse) { int run = 0;
        for (int e = 0; e < NE; ++e) { const int c = (int)__hip_atomic_load(cnt + e * CNT_STRIDE, __ATOMIC_RELAXED, __HIP_MEMORY_SCOPE_AGENT); tab[e] = c; run += (c + 255) >> 8; tab[16 + e] = run; } }
    __syncthreads();
    S.tab = tab; S.nN = nN; S.nunits = __builtin_amdgcn_readfirstlane(tab[31]) * nN; S.G = F.G; S.c = (int)blockIdx.x;
    S.tdone = (unsigned*)(F.ws + WS_CTL) + CW_TDONE + cset * 160 * 16; S.role = 0;
    S.list = (const unsigned*)(F.ws + WS_LIST);
}
__device__ __forceinline__ void moe1_phase(const Frame& F, const CAS Args* a, int l, int cset) {
    pg8::MoeOrder S; moe_setup(S, F, cset, 4);
    S.A = (const char*)(F.ws + WS_H); S.Bt = (const char*)(F.ws + WS_WGU) + (size_t)l * NE * D * D; S.K = D / 2; S.bstride_e = (size_t)D * D; S.gather = true; S.role = 1;
    EpiGU E{(bf16*)(F.ws + WS_HMID)};
    pg8::gemm_phase<EpiGU, pg8::MoeOrder, true>(F.lds, F.tid, S, E, SC_W1, SC_ONE);
}
__device__ __forceinline__ void moe2_phase(const Frame& F, const CAS Args* a, int l, int cset) {
    pg8::MoeOrder S; moe_setup(S, F, cset, 4, true);
    S.A = (const char*)(F.ws + WS_HMID); S.Bt = (const char*)(F.ws + WS_WD) + (size_t)l * NE * D * DE; S.K = DE / 2; S.bstride_e = (size_t)D * DE; S.gather = false; S.role = 2; S.c = F.G - 1 - (int)blockIdx.x;
    EpiDown E; E.Y = (bf16*)(F.ws + WS_Y); E.list = (const unsigned*)(F.ws + WS_LIST); E.listw = (const float*)(F.ws + WS_LISTW); E.tab = S.tab;
    pg8::gemm_phase<EpiDown, pg8::MoeOrder, true>(F.lds, F.tid, S, E, SC_W2, SC_HMID);
    if (l == 0 && cset == 0) convert_moe_filler(F, a, 1, S.nunits, true);
}

__device__ __forceinline__ void final_load(const Frame& F, int m, f32x4 (&x)[4]) {
    const float* mod = (const float*)(F.ws + WS_MOD);
    const unsigned char* Y0 = F.ws + WS_Y; const unsigned char* Y1 = Y0 + (size_t)TT * D;
    const int v = m >> 13; const bf16* xrow = F.xlb + (size_t)m * D;
#pragma unroll
    for (int j = 0; j < 4; ++j) {
        const int col = 4 * F.lane + 256 * j;
        const f32x4 g2 = *(const f32x4*)(mod + (3 + v) * 6144 + 5 * D + col);
        const f32x4 y = ld_y8(Y0 + (size_t)m * D + col) + ld_y8(Y1 + (size_t)m * D + col);
        x[j] = ld_y4(xrow + col) + g2 * y;
    }
}
__device__ __forceinline__ void final_row(const Frame& F, const CAS Args* a, int m, const f32x4 (&x)[4]) {
    float* xrow = F.out + (size_t)m * D; float ss = 0.f;
#pragma unroll
    for (int j = 0; j < 4; ++j) ss += (x[j][0] * x[j][0] + x[j][1] * x[j][1]) + (x[j][2] * x[j][2] + x[j][3] * x[j][3]);
    const float rstd = 1.0f / sqrtf(wave_sum(ss) * (1.0f / D) + EPS);
#pragma unroll
    for (int j = 0; j < 4; ++j) { const int col = 4 * F.lane + 256 * j; const f32x4 nw = *(const f32x4*)(a->in[I_FNORM] + col); *(f32x4*)(xrow + col) = x[j] * rstd * nw; }
}
__device__ __forceinline__ void final_phase(const Frame& F, const CAS Args* a) {
    for (int m = F.gw; m < TL; m += 2 * F.NGW) {
        const int m2 = m + F.NGW; const bool two = m2 < TL;
        f32x4 xa[4], xb[4];
        final_load(F, m, xa);
        if (two) final_load(F, m2, xb);
        final_row(F, a, m, xa);
        if (two) final_row(F, a, m2, xb);
    }
}

#ifndef NPASS
#define NPASS 1
#endif
#ifndef PROBE_PH
#define PROBE_PH -1
#endif
#ifndef PROBE_R
#define PROBE_R 3
#endif
#ifndef PROBE_UPTO
#define PROBE_UPTO -1
#endif
#ifndef PROBE_ABL
#define PROBE_ABL 0
#endif
constexpr int PH_PER_LAYER = 8;
constexpr int N_PHASES = 1 + DEPTH * PH_PER_LAYER + 1;

template <int ph0>
__device__ __forceinline__ void do_phase(Frame& F, XcdBarrier& bar, LAS unsigned char* lds, int lo, int hi) {
    constexpr int ph = ph0 % N_PHASES, pass = ph0 / N_PHASES;
    if (!(lo <= ph && ph < hi)) return;
    if (pass == 1 && (PROBE_UPTO >= 0 ? ph >= PROBE_UPTO : ph != PROBE_PH)) return;
    const CAS Args* ap;
        { int l_; asm volatile("v_mbcnt_lo_u32_b32 %0, -1, 0\n\tv_mbcnt_hi_u32_b32 %0, -1, %0" : "=v"(l_)); F.lane = l_; F.tid = F.wave * 64 + l_; ap = (const CAS Args*)__builtin_amdgcn_kernarg_segment_ptr(); asm volatile("" : "+s"(ap)); F.ws = ap->ws; F.out = (pass == 1) ? (float*)(ap->ws + WS_P) : ap->out; F.xlb = (bf16*)(ap->ws + ((pass == 1) ? WS_P + 64 * MiB : WS_XLB));
          LAS unsigned char* lb_ = (LAS unsigned char*)lds; asm volatile("" : "+s"(lb_)); __builtin_assume((((unsigned)(__UINTPTR_TYPE__)lb_) & 1023u) == 0u); F.lds = lb_;
          bar.bar = (unsigned*)(F.ws + WS_CTL) + CW_BAR; bar.st = (volatile LAS unsigned*)(F.lds + MISC_OFF) + 8; }
        if (ph == 0) { if (PH_ON(10)) REP(10, true) p0_prologue(F, ap); }
        else if (ph == N_PHASES - 1) { if (PH_ON(11)) REP(11, false) final_phase(F, ap); }
        else {
            const int l = (ph - 1) / PH_PER_LAYER, s = (ph - 1) % PH_PER_LAYER;
            unsigned char* ws = F.ws;
            if (s == 0) { if (PH_ON(0)) REP(0, l == 0) { n1_phase(F, ap, l); if (l == 0) p0_convert(F, ap); } }
            else if (s == 1 && PH_ON(1)) REP(1, true) {
                pg8::DenseOrder S; S.init(ws + WS_H, ws + WS_WIN + (size_t)l * NIN * D, TT, NIN, D / 2, F.G, (int)blockIdx.x);
                EpiIn E{(bf16*)(ws + WS_P), ap->in[I_BIASF] + l * 256, ap->in[I_BIASB] + l * 256, (const float*)(ws + WS_ROPE), (const float*)(ws + WS_ROPE) + 2048, (pass == 1) ? PROBE_ABL : 0};
                pg8::gemm_phase<EpiIn, pg8::DenseOrder, true>(F.lds, F.tid, S, E, SC_W1, SC_ONE, GIN_STAG);
            }
            else if (s == 2) { constexpr int abl = (pass == 1) ? PROBE_ABL : 0; if (PH_ON(2) && abl != 5) REP(2, true) swa_flash(F, ap, l, abl); if (PH_ON(12) && abl != 6) REP(12, true) gla_g1(F, l); }
            else if (s == 3) { if (PH_ON(13)) REP(13, true) gla_scan(F); }
            else if (s == 4) { if (PH_ON(3)) REP(3, true) gla_g3(F, ap, l); }
            else if (s == 5 && PH_ON(4)) REP(4, l == 0) {
                pg8::DenseOrder S; S.init(ws + WS_MIX, ws + WS_WOUT + (size_t)l * D * D, l == 0 ? TT : TL, D, D / 2, F.G, (int)blockIdx.x);
                EpiOut E{ap->in[I_X], l == 0 ? ap->in[I_CTX] : (const float*)(ws + WS_XC), F.xlb, (float*)(ws + WS_XC), (const float*)(ws + WS_MOD) + l * 3 * 6144, l > 0};
                pg8::gemm_phase<EpiOut, pg8::DenseOrder, true>(F.lds, F.tid, S, E, SC_W1, SC_HMID);
                if (l == 0 && pass == 0) convert_moe_filler(F, ap, 0, S.nwg);
            }
            else if (s == 6) { if (PH_ON(5)) REP(5, true) n2_route_phase(F, ap, l, rep_ == 0 || pass == 1, l + 2 * pass); }
            else { constexpr int abl = (pass == 1) ? PROBE_ABL : 0; if (PH_ON(6)) { constexpr int cs_ = (pass == 1 && PROBE_UPTO < 0) ? l : l + 2 * pass; if (abl != 2) moe1_phase(F, ap, l, cs_); if (abl != 1) moe2_phase(F, ap, l, cs_); } }
        }
        if (ph0 + 1 < NPASS * N_PHASES) for (int rb_ = 0; rb_ < (REPEAT_S == 20 ? REPEAT_N : 1); ++rb_) xcd_barrier(bar, F.tid);
}
template <int... I>
__device__ __forceinline__ void run_all(Frame& F, XcdBarrier& bar, LAS unsigned char* lds, int lo, int hi, std::integer_sequence<int, I...>) { (do_phase<I>(F, bar, lds, lo, hi), ...); }

#ifdef VGPR_CAP
__attribute__((amdgpu_num_vgpr(VGPR_CAP)))
#endif
__global__ void __launch_bounds__(NWAVES * 64, 2) mk_fwd(Args args) {
    extern __shared__ __attribute__((aligned(16))) unsigned char lds[];
    Frame F;
    F.lds = (LAS unsigned char*)lds;
    F.tid = threadIdx.x; F.lane = F.tid & 63; F.wave = __builtin_amdgcn_readfirstlane(F.tid >> 6);
    F.G = gridDim.x; { const int bx = blockIdx.x; F.vcu = (F.G % 8 == 0) ? (bx % 8) * (F.G / 8) + bx / 8 : bx; }
    F.gw = F.vcu * NWAVES + F.wave; F.NGW = F.G * NWAVES;
    const CAS Args* ap = (const CAS Args*)__builtin_amdgcn_kernarg_segment_ptr();
    F.ws = ap->ws; F.out = ap->out; F.xlb = (bf16*)(ap->ws + WS_XLB);
    volatile LAS unsigned* MISC = (volatile LAS unsigned*)(F.lds + MISC_OFF);
    for (int u = F.tid; u < (LDS_BYTES - LDSCTL_OFF) / 4; u += NWAVES * 64) ((LAS unsigned*)(F.lds + LDSCTL_OFF))[u] = 0u;
    __syncthreads();
    XcdBarrier bar; bar.bar = (unsigned*)(F.ws + WS_CTL) + CW_BAR; bar.x = 0; bar.st = nullptr;
    const bool fused = (ap->ph_hi - ap->ph_lo) > 1;
    if (fused) bar = xcd_barrier_post((unsigned*)(F.ws + WS_CTL) + CW_BAR, MISC + 8);
    const int lo = ap->ph_lo, hi = ap->ph_hi;
    run_all(F, bar, (LAS unsigned char*)lds, lo, hi, std::make_integer_sequence<int, NPASS * N_PHASES>{});
}

extern "C" void kernel_launch(void* const* d_in, const int* in_sizes, int n_in, void* d_out, int out_size, void* d_ws, size_t ws_size, hipStream_t stream) {
    static int grid = 0;
    if (grid == 0) {
        if (n_in != 22 || out_size != TL * D || ws_size < WS_END) { fprintf(stderr, "kernel_launch: unexpected shapes (n_in %d out %d ws %zu)\n", n_in, out_size, ws_size); grid = -1; return; }
        int dev = 0, cus = 0, per_cu = 0;
        if (hipGetDevice(&dev) != hipSuccess || hipDeviceGetAttribute(&cus, hipDeviceAttributeMultiprocessorCount, dev) != hipSuccess) { grid = -1; return; }
        if (hipFuncSetAttribute((const void*)mk_fwd, hipFuncAttributeMaxDynamicSharedMemorySize, LDS_BYTES) != hipSuccess) { fprintf(stderr, "kernel_launch: hipFuncSetAttribute failed\n"); grid = -1; return; }
        if (hipOccupancyMaxActiveBlocksPerMultiprocessor(&per_cu, (const void*)mk_fwd, NWAVES * 64, LDS_BYTES) != hipSuccess || per_cu < 1) fprintf(stderr, "kernel_launch: occupancy query says %d\n", per_cu);
        (void)hipGetLastError();
        grid = cus;
    }
    if (grid < 0) return;
    (void)hipMemsetAsync((char*)d_ws + WS_CTL, 0, CTL_ZERO_BYTES, stream);
    Args a{};
    for (int i = 0; i < 22; ++i) a.in[i] = (const float*)d_in[i];
    a.out = (float*)d_out; a.ws = (unsigned char*)d_ws; a.li = 0; a.pad = 0;
#if MK_N_LAUNCHES == 1
    a.ph_lo = 0; a.ph_hi = N_PHASES;
    hipLaunchKernelGGL(mk_fwd, dim3(grid), dim3(NWAVES * 64), LDS_BYTES, stream, a);
#else
    for (int ph = 0; ph < N_PHASES; ++ph) { a.ph_lo = ph; a.ph_hi = ph + 1; hipLaunchKernelGGL(mk_fwd, dim3(grid), dim3(NWAVES * 64), LDS_BYTES, stream, a); }
#endif
}
```

```cpp
#include <hip/hip_runtime.h>
#include <cstdio>
#include <cstdint>
#include <utility>

#ifndef GIN_STAG
#define GIN_STAG 0
#endif
#ifndef ALIGN_EPI
#define ALIGN_EPI 1
#endif
#ifndef ONLY_S
#define ONLY_S -1
#endif
#define PH_ON(k) (ONLY_S < 0 || ONLY_S == (k))
#ifndef REPEAT_S
#define REPEAT_S -1
#endif
#ifndef REPEAT_N
#define REPEAT_N 4
#endif
#define REP(k, cond) for (int rep_ = 0; rep_ < ((pass == 1) ? PROBE_R : ((REPEAT_S == (k) && (cond)) ? REPEAT_N : 1)); ++rep_)
#ifndef MK_N_LAUNCHES
#define MK_N_LAUNCHES 1
#endif

#define GAS __attribute__((address_space(1)))
#define LAS __attribute__((address_space(3)))
#define CAS __attribute__((address_space(4)))
typedef unsigned short bf16;
typedef short bf16x8 __attribute__((ext_vector_type(8)));
typedef float f32x4 __attribute__((ext_vector_type(4)));
typedef float f32x2 __attribute__((ext_vector_type(2)));
typedef unsigned u32x4 __attribute__((ext_vector_type(4)));
typedef unsigned u32x2 __attribute__((ext_vector_type(2)));
typedef int v8i __attribute__((ext_vector_type(8)));

constexpr int D = 1024, SEQ = 8192, LC = 256, TL = 16384, TC = 512, TT = TL + TC, DEPTH = 2;
constexpr int NE = 16, DE = 512;
constexpr int NIN = 2816;
constexpr int PC_Q = 0, PC_K = 256, PC_V = 512, PC_G = 1024, PC_SQ = 1536, PC_SK = 2048, PC_SV = 2176, PC_GF = 2304, PC_GB = 2560;
constexpr int WIN_COLS = 2336;
constexpr float EPS = 1e-6f;
constexpr float LOG2E = 1.4426950408889634f, QSCALE = 0.125f * LOG2E;
constexpr int LISTCAP = TT;

constexpr size_t MiB = 1u << 20;
constexpr size_t WS_CTL = 0, CTL_ZERO_BYTES = 131072;
constexpr size_t WS_MOD = 1 * MiB;
constexpr size_t WS_ROPE = 1 * MiB + 256 * 1024;
constexpr size_t WS_LIST = 2 * MiB;
constexpr size_t WS_LISTW = 2 * MiB + 1536 * 1024;
constexpr size_t WS_XC = 5 * MiB;
constexpr size_t WS_WIN = 8 * MiB;
constexpr size_t WS_WOUT = 19 * MiB;
constexpr size_t WS_WGU = 23 * MiB;
constexpr size_t WS_WD = 87 * MiB;
constexpr size_t WS_XLB = 55 * MiB;
constexpr size_t WS_H = 119 * MiB;
constexpr size_t WS_P = 152 * MiB;
constexpr size_t WS_MIX = 243 * MiB;
constexpr size_t WS_GL = 276 * MiB;
constexpr size_t WS_HMID = 152 * MiB;
constexpr size_t WS_Y = 190 * MiB;
constexpr size_t WS_END = 309 * MiB;
static_assert(WS_LIST + (size_t)NE * LISTCAP * 4 <= WS_LISTW && WS_LISTW + (size_t)NE * LISTCAP * 4 <= WS_XC, "ws map");
static_assert(WS_P + (size_t)TT * NIN * 2 <= WS_MIX && WS_MIX + (size_t)TT * D * 2 <= WS_GL, "ws map");
static_assert(WS_HMID + (size_t)37888 * 512 * 2 <= WS_Y && WS_Y + (size_t)2 * TT * D * 2 <= WS_GL, "ws map");
constexpr int CW_CNT = 8192, CNT_STRIDE = 64;
constexpr int CW_CTXG3 = 64;
constexpr int CW_TDONE = 16384;
constexpr int CW_BAR = 4096;

typedef __bf16 bf16x2_t __attribute__((ext_vector_type(2)));
__device__ __forceinline__ unsigned pk2(float lo, float hi) { const f32x2 v = {lo, hi}; return __builtin_bit_cast(unsigned, __builtin_convertvector(v, bf16x2_t)); }
__device__ __forceinline__ unsigned f2bf(float f) { return pk2(f, 0.f) & 0xffffu; }
__device__ __forceinline__ float bf2f(unsigned h) { return __builtin_bit_cast(float, h << 16); }
__device__ __forceinline__ float bflo(unsigned w) { return __builtin_bit_cast(float, w << 16); }
__device__ __forceinline__ float bfhi(unsigned w) { return __builtin_bit_cast(float, w & 0xffff0000u); }
__device__ __forceinline__ float dpp_add(float v, float t) { return v + t; }
#define DPP_F(v, ctrl, rmask) __builtin_bit_cast(float, __builtin_amdgcn_update_dpp(0, __builtin_bit_cast(int, (v)), (ctrl), (rmask), 0xF, false))
__device__ __forceinline__ float row16_sum(float v) {
    v += DPP_F(v, 0xB1, 0xF); v += DPP_F(v, 0x4E, 0xF); v += DPP_F(v, 0x141, 0xF); v += DPP_F(v, 0x140, 0xF); return v;
}
__device__ __forceinline__ float wave_sum(float v) {
    v = row16_sum(v);
    v += DPP_F(v, 0x142, 0xA); v += DPP_F(v, 0x143, 0xC);
    return __builtin_bit_cast(float, __builtin_amdgcn_readlane(__builtin_bit_cast(int, v), 63));
}
__device__ __forceinline__ float silu_f(float x) { return x * __builtin_amdgcn_rcpf(1.0f + __expf(-x)); }
__device__ __forceinline__ unsigned pk4_fp8(float a, float b, float c, float d) {
    a = __builtin_amdgcn_fmed3f(a, -448.f, 448.f); b = __builtin_amdgcn_fmed3f(b, -448.f, 448.f); c = __builtin_amdgcn_fmed3f(c, -448.f, 448.f); d = __builtin_amdgcn_fmed3f(d, -448.f, 448.f);
    int w = __builtin_amdgcn_cvt_pk_fp8_f32(a, b, 0, false); w = __builtin_amdgcn_cvt_pk_fp8_f32(c, d, w, true); return (unsigned)w;
}
constexpr float W1_SCALE = 64.f, W2_SCALE = 32.f, HMID_SCALE = 4.f, MIX_SCALE = 4.f, Y_SCALE = 8.f;
constexpr int SC_ONE = 127, SC_W1 = 121, SC_W2 = 122, SC_HMID = 125;
#define LDS_BARRIER() asm volatile("s_waitcnt lgkmcnt(0)\n\ts_barrier" ::: "memory")
__device__ __forceinline__ void st16_wt(void* p, u32x4 v) { asm volatile("global_store_dwordx4 %0, %1, off sc1\n\ts_nop 1" :: "v"(p), "v"(v) : "memory"); }
#define LDS_WAIT() asm volatile("s_waitcnt lgkmcnt(0)" ::: "memory")
#define VM_WAIT() asm volatile("s_waitcnt vmcnt(0)" ::: "memory")

namespace pg8 {
constexpr int BM = 256, BK = 64, HALF = 128, HTB = HALF * BK * 2, STAGE_BYTES = 8 * HTB, NXCD = 8, WGM = 8;
__host__ __device__ __forceinline__ int lds_byte(int r, int c) { const int st = (r >> 4) * 2 + (c >> 5), rr = r & 15, cc = c & 31, ob = rr * 64 + cc * 2; return st * 1024 + (ob ^ (((ob >> 9) & 1) << 5)); }
__host__ __device__ __forceinline__ void stage_rc(int b, int& R, int& C) { const int st = b / 1024, sb = b % 1024, swz = sb ^ (((sb >> 9) & 1) << 5); R = (st >> 1) * 16 + swz / 64; C = (st & 1) * 32 + (swz % 64) / 2; }
__host__ __device__ __forceinline__ int perm32(int rho) { const int n = rho >> 4, i = rho & 15; return 8 * (i >> 2) + 4 * n + (i & 3); }

struct Unit { int pm, pn, e, mt; };

__device__ __forceinline__ int xcd_remap(int wgid, int nwg) { const int q = nwg / NXCD, r = nwg % NXCD, xcd = wgid % NXCD, off = wgid / NXCD; return (xcd < r ? xcd * (q + 1) : r * (q + 1) + (xcd - r) * q) + off; }

struct DenseOrder {
    static constexpr bool DYN_A = false;
    const char* A; const char* Bt; int K; int nM, nN, nwg, G, c;
    unsigned* dep = nullptr; unsigned dep_need = 0; int dep_pm = 1 << 30;
    __device__ void init(const void* A_, const void* Bt_, int M, int N, int K_, int G_, int c_) { A = (const char*)A_; Bt = (const char*)Bt_; K = K_; nM = M / BM; nN = N / BM; nwg = nM * nN; G = G_; c = c_; }
    __device__ __forceinline__ bool next(int i, Unit& u) const {
        const long L = (long)i * G + c; if (L >= nwg) return false;
        const int wgid = xcd_remap((int)L, nwg);
        const int nig = WGM * nN, gid = wgid / nig, fm = gid * WGM, gsz = (nM - fm) < WGM ? (nM - fm) : WGM;
        u.pm = fm + ((wgid % nig) % gsz); u.pn = (wgid % nig) / gsz; u.e = 0; u.mt = 0; return true;
    }
    __device__ __forceinline__ void a_ready(const Unit& u, int wid) const {
        if (dep && u.pm >= dep_pm) {
            if (wid == 0) { unsigned sp = 0;
                while (__hip_atomic_load(dep, __ATOMIC_RELAXED, __HIP_MEMORY_SCOPE_AGENT) < dep_need) { __builtin_amdgcn_s_sleep(2); if (++sp > (1u << 22)) break; }
                __builtin_amdgcn_fence(__ATOMIC_ACQUIRE, "agent"); asm volatile("s_waitcnt vmcnt(0)" ::: "memory"); }
            __builtin_amdgcn_s_barrier();
        }
    }
    __device__ __forceinline__ void done(const Unit&, int) const {}
    __device__ __forceinline__ const char* a_ptr(const Unit& u) const { return A + (size_t)u.pm * (size_t)(BM * K * 2); }
    __device__ __forceinline__ const char* b_ptr(const Unit& u) const { return Bt + (size_t)u.pn * (size_t)(BM * K * 2); }
    __device__ __forceinline__ void a_voff(const Unit&, const int (&R)[2], const int (&C)[2], unsigned (&v0)[2], unsigned (&v1)[2]) const {
#pragma unroll
        for (int i = 0; i < 2; ++i) { v0[i] = (unsigned)(R[i] * K + C[i]) * 2u; v1[i] = v0[i] + (unsigned)(HALF * K * 2); }
    }
};

struct MoeOrder {
    static constexpr bool DYN_A = true;
    const char* A; const char* Bt; int K; size_t bstride_e; int G, c, nunits, nN; bool gather;
    const unsigned* list; const LAS int* tab;
    unsigned* tdone; int role;
    __device__ __forceinline__ void a_ready(const Unit& u, int wid) const {
        if (role == 2) {
            if (wid == 0) { unsigned sp = 0;
                while (__hip_atomic_load(tdone + u.pm * 16, __ATOMIC_RELAXED, __HIP_MEMORY_SCOPE_AGENT) < 32u) { __builtin_amdgcn_s_sleep(2); if (++sp > (1u << 22)) break; }
                __builtin_amdgcn_fence(__ATOMIC_ACQUIRE, "agent"); asm volatile("s_waitcnt vmcnt(0)" ::: "memory"); }
            __builtin_amdgcn_s_barrier();
        }
    }
    __device__ __forceinline__ void done(const Unit& u, int lane) const {
        if (role == 1) { asm volatile("s_waitcnt vmcnt(0)" ::: "memory");
            if (lane == 0) __hip_atomic_fetch_add(tdone + u.pm * 16, 1u, __ATOMIC_RELAXED, __HIP_MEMORY_SCOPE_AGENT); }
    }
    __device__ __forceinline__ bool next(int i, Unit& u) const {
        const long L = (long)i * G + c; if (L >= nunits) return false;
        const int wgid = xcd_remap((int)L, nunits);
        const int tl = wgid / nN; u.pn = wgid % nN;
        const int ln = (int)__builtin_amdgcn_mbcnt_lo(~0u, 0u), te = tab[16 + (ln & 15)];
        const unsigned bal = (unsigned)__builtin_amdgcn_ballot_w64(tl >= te) & 0x7fffu;
        const int e = __builtin_popcount(bal), tstart = e ? __builtin_amdgcn_readlane(te, e - 1) : 0;
        u.e = e; u.mt = tl - tstart; u.pm = tl; return true;
    }
    __device__ __forceinline__ const char* a_ptr(const Unit& u) const { return gather ? A : A + (size_t)u.pm * (size_t)(BM * K * 2); }
    __device__ __forceinline__ const char* b_ptr(const Unit& u) const { return Bt + (size_t)u.e * bstride_e + (size_t)u.pn * (size_t)(BM * K * 2); }
    __device__ __forceinline__ void a_issue(const Unit& u, const int (&R)[2], unsigned (&raw)[4]) const {
        const int nv = tab[u.e] - u.mt * BM;
        const unsigned* lp = list + (size_t)u.e * LISTCAP + u.mt * BM;
#pragma unroll
        for (int i = 0; i < 2; ++i) {
            const int r0 = R[i], r1 = R[i] + HALF;
            const unsigned* p0 = lp + (r0 < nv ? r0 : 0); const unsigned* p1 = lp + (r1 < nv ? r1 : 0);
            asm volatile("global_load_dword %0, %1, off nt" : "=v"(raw[2 * i]) : "v"(p0));
            asm volatile("global_load_dword %0, %1, off nt" : "=v"(raw[2 * i + 1]) : "v"(p1));
        }
    }
    __device__ __forceinline__ void a_fin(const unsigned (&raw)[4], const int (&C)[2], unsigned (&v0)[2], unsigned (&v1)[2]) const {
#pragma unroll
        for (int i = 0; i < 2; ++i) { v0[i] = ((raw[2 * i] >> 1) * (unsigned)K + (unsigned)C[i]) * 2u; v1[i] = ((raw[2 * i + 1] >> 1) * (unsigned)K + (unsigned)C[i]) * 2u; }
    }
    __device__ __forceinline__ void a_voff(const Unit& u, const int (&R)[2], const int (&C)[2], unsigned (&v0)[2], unsigned (&v1)[2]) const {
        if (gather) {
            const int ce = tab[u.e];
            const unsigned* lp = list + (size_t)u.e * LISTCAP + u.mt * BM;
#pragma unroll
            for (int i = 0; i < 2; ++i) {
                const int r0 = R[i], r1 = R[i] + HALF;
                const unsigned t0 = (u.mt * BM + r0 < ce) ? (__builtin_nontemporal_load(lp + r0) >> 1) : 0u;
                const unsigned t1 = (u.mt * BM + r1 < ce) ? (__builtin_nontemporal_load(lp + r1) >> 1) : 0u;
                v0[i] = (t0 * (unsigned)K + (unsigned)C[i]) * 2u; v1[i] = (t1 * (unsigned)K + (unsigned)C[i]) * 2u;
            }
        } else {
#pragma unroll
            for (int i = 0; i < 2; ++i) { v0[i] = (unsigned)(R[i] * K + C[i]) * 2u; v1[i] = v0[i] + (unsigned)(HALF * K * 2); }
        }
    }
};

__device__ __forceinline__ unsigned cvt_pk_bf16(float lo, float hi) { unsigned r; asm volatile("v_cvt_pk_bf16_f32 %0, %1, %2" : "=v"(r) : "v"(lo), "v"(hi)); return r; }

struct NoPre {};
template <class Epi, bool H> struct EpiPre { typedef NoPre type; };
template <class Epi> struct EpiPre<Epi, true> { typedef typename Epi::Pre type; };
template <class Epi, class Sched, bool F8 = false>
__device__ __forceinline__ void gemm_phase(LAS unsigned char* lds, int tid, const Sched& S, const Epi& E, int sc_w = 127, int sc_a = 127, int stag = 0) {
    if (stag) {
        const unsigned long long t0 = __builtin_amdgcn_s_memrealtime(), dl = (unsigned long long)((blockIdx.x >> 3) & 3) * (unsigned)stag;
        while (__builtin_amdgcn_s_memrealtime() - t0 < dl) __builtin_amdgcn_s_sleep(8);
    }
    const int wid = __builtin_amdgcn_readfirstlane(tid >> 6), lane = tid & 63, wr = wid >> 2, wc = wid & 3, fr = lane & 15, fq = lane >> 4;
    const int K = S.K, nt = K / BK;
    int Rr[2], Cc[2]; unsigned voffB[2];
#pragma unroll
    for (int i = 0; i < 2; ++i) { int R, C; stage_rc(tid * 16 + i * 8192, R, C); const int Rb = Epi::PERM ? ((R & ~31) + perm32(R & 31)) : R;
        Rr[i] = R; Cc[i] = C; voffB[i] = (unsigned)(Rb * K + C) * 2u; }
    const size_t kstep = (size_t)(BK * 2);
    const size_t hstep = (size_t)HALF * K * 2;
    const unsigned ldsw = (unsigned)wid * 1024u;
    const int aoff = lds_byte(wr * 64 + fr, fq * 8), boff = lds_byte(wc * 32 + fr, fq * 8);
#define PG8_SA(b, h) (((b) * 2 + (h)) * HTB)
#define PG8_SB(b, h) ((4 + (b) * 2 + (h)) * HTB)
#define PG8_STAGE(bufoff, gbase, voff) do { _Pragma("unroll") for (int _i = 0; _i < 2; ++_i) \
        __builtin_amdgcn_global_load_lds((const unsigned*)((const char*)(gbase) + (voff)[_i]), (LAS unsigned*)(lds + (bufoff) + ldsw + _i * 8192), 16, 0, 0); } while (0)
#define PG8_CAT(lo_, hi_) ((v8i){(int)(lo_).x, (int)(lo_).y, (int)(lo_).z, (int)(lo_).w, (int)(hi_).x, (int)(hi_).y, (int)(hi_).z, (int)(hi_).w})
#define PG8_LDA(dst, b, h) do { _Pragma("unroll") for (int m = 0; m < 4; ++m) { if constexpr (F8) { const u32x4 l_ = *(const LAS u32x4*)(lds + PG8_SA(b, h) + aoff + m * 2048), h_ = *(const LAS u32x4*)(lds + PG8_SA(b, h) + aoff + m * 2048 + 1024); dst##8[m] = PG8_CAT(l_, h_); } \
        else { _Pragma("unroll") for (int k = 0; k < 2; ++k) dst[m][k] = *(const LAS bf16x8*)(lds + PG8_SA(b, h) + aoff + m * 2048 + k * 1024); } } } while (0)
#define PG8_LDB(dst, b, h) do { _Pragma("unroll") for (int n = 0; n < 2; ++n) { if constexpr (F8) { const u32x4 l_ = *(const LAS u32x4*)(lds + PG8_SB(b, h) + boff + n * 2048), h_ = *(const LAS u32x4*)(lds + PG8_SB(b, h) + boff + n * 2048 + 1024); dst##8[n] = PG8_CAT(l_, h_); } \
        else { _Pragma("unroll") for (int k = 0; k < 2; ++k) dst[n][k] = *(const LAS bf16x8*)(lds + PG8_SB(b, h) + boff + n * 2048 + k * 1024); } } } while (0)
#define PG8_MMA(ai, bj, At, Bt) do { __builtin_amdgcn_s_setprio(1); _Pragma("unroll") for (int m = 0; m < 4; ++m) _Pragma("unroll") for (int n = 0; n < 2; ++n) { \
        if constexpr (F8) asm volatile("v_mfma_scale_f32_16x16x128_f8f6f4 %0, %1, %2, %0, %3, %4 op_sel_hi:[0,0,0]" : "+v"(acc[ai][bj][m][n]) : "v"(Bt##8[n]), "v"(At##8[m]), "v"(sc_w), "v"(sc_a)); \
        else { _Pragma("unroll") for (int k = 0; k < 2; ++k) acc[ai][bj][m][n] = __builtin_amdgcn_mfma_f32_16x16x32_bf16(Bt[n][k], At[m][k], acc[ai][bj][m][n], 0, 0, 0); } } \
        __builtin_amdgcn_s_setprio(0); } while (0)
#define PG8_MMAZ(ai, bj, At, Bt) do { __builtin_amdgcn_s_setprio(1); _Pragma("unroll") for (int m = 0; m < 4; ++m) _Pragma("unroll") for (int n = 0; n < 2; ++n) \
        asm volatile("v_mfma_scale_f32_16x16x128_f8f6f4 %0, %1, %2, 0, %3, %4 op_sel_hi:[0,0,0]" : "=&v"(acc[ai][bj][m][n]) : "v"(Bt##8[n]), "v"(At##8[m]), "v"(sc_w), "v"(sc_a)); \
        __builtin_amdgcn_s_setprio(0); } while (0)
#define PG8_WAIT_V(n) asm volatile("s_waitcnt vmcnt(" #n ")" ::: "memory")
#define PG8_WAIT_L(n) asm volatile("s_waitcnt lgkmcnt(" #n ")" ::: "memory")
#define PG8_BAR __builtin_amdgcn_s_barrier()
#define PG8_SCHED __builtin_amdgcn_sched_barrier(0)
    Unit cur, nxt; int ui = 0;
    if (!S.next(0, cur)) return;
    f32x4 acc[2][2][4][2];
#pragma unroll
    for (int a = 0; a < 2; ++a)
#pragma unroll
        for (int b = 0; b < 2; ++b)
#pragma unroll
            for (int m = 0; m < 4; ++m)
#pragma unroll
                for (int n = 0; n < 2; ++n) acc[a][b][m][n] = (f32x4){0.f, 0.f, 0.f, 0.f};
    bf16x8 At[4][2], B0[2][2], B1[2][2]; v8i At8[4], B08[2], B18[2];
    const char* cA = S.a_ptr(cur); const char* cB = S.b_ptr(cur);
    unsigned cv0[2], cv1[2], nv0[2], nv1[2], raw[4] = {0u, 0u, 0u, 0u};
    typename EpiPre<Epi, Epi::HAS_PRE>::type epre;
    S.a_ready(cur, wid);
    S.a_voff(cur, Rr, Cc, cv0, cv1);
    PG8_STAGE(PG8_SB(0, 0), cB, voffB); PG8_STAGE(PG8_SB(0, 1), cB + hstep, voffB); PG8_STAGE(PG8_SA(0, 0), cA, cv0); PG8_STAGE(PG8_SA(0, 1), cA, cv1);
    if (wr == 1) PG8_BAR;
    PG8_WAIT_V(2); PG8_BAR;
    PG8_STAGE(PG8_SB(1, 0), cB + kstep, voffB); PG8_STAGE(PG8_SA(1, 0), cA + kstep, cv0); PG8_STAGE(PG8_SB(1, 1), cB + hstep + kstep, voffB);
    PG8_WAIT_V(6); PG8_BAR;
    for (;;) {
        const bool has_next = S.next(ui + 1, nxt);
        const char* nA = has_next ? S.a_ptr(nxt) : cA; const char* nB = has_next ? S.b_ptr(nxt) : cB;
        bool defer = false;
        if constexpr (Sched::DYN_A) defer = S.gather && has_next;
        if constexpr (Sched::DYN_A) { if (defer) S.a_issue(nxt, Rr, raw); }
        if (!defer) { if (has_next) S.a_voff(nxt, Rr, Cc, nv0, nv1); else { nv0[0] = cv0[0]; nv0[1] = cv0[1]; nv1[0] = cv1[0]; nv1[1] = cv1[1]; } }
        for (int t = 0; t < nt; t += 2) {
            const bool last = (t == nt - 2);
            if constexpr (Epi::HAS_PRE) { if (last) E.issue(cur, wr, fr, epre); }
            if constexpr (Sched::DYN_A) { if (last && defer) { asm volatile("" : "+v"(raw[0]), "+v"(raw[1]), "+v"(raw[2]), "+v"(raw[3])); S.a_fin(raw, Cc, nv0, nv1); } }
            if (last && has_next) S.a_ready(nxt, wid);
            const char* a1 = cA + (size_t)(t + 1) * kstep;
            const char* a2 = last ? nA : cA + (size_t)(t + 2) * kstep; const char* b2 = last ? nB : cB + (size_t)(t + 2) * kstep;
            const char* a3 = a2 + kstep; const char* b3 = b2 + kstep;
            unsigned w0[2], w1[2];
            w0[0] = last ? nv0[0] : cv0[0]; w0[1] = last ? nv0[1] : cv0[1]; w1[0] = last ? nv1[0] : cv1[0]; w1[1] = last ? nv1[1] : cv1[1];
            PG8_LDB(B0, 0, 0); PG8_LDB(B1, 0, 1); PG8_SCHED; PG8_LDA(At, 0, 0); PG8_STAGE(PG8_SA(1, 1), a1, cv1);
            PG8_WAIT_V(8); PG8_WAIT_L(0); PG8_BAR; if (F8 && t == 0) { PG8_MMAZ(0, 0, At, B0); PG8_MMAZ(0, 1, At, B1); } else { PG8_MMA(0, 0, At, B0); PG8_MMA(0, 1, At, B1); } PG8_BAR; PG8_SCHED;
            PG8_LDA(At, 0, 1); PG8_STAGE(PG8_SB(0, 0), b2, voffB); PG8_STAGE(PG8_SB(0, 1), b2 + hstep, voffB); PG8_STAGE(PG8_SA(0, 0), a2, w0);
            PG8_WAIT_V(8); PG8_WAIT_L(0); PG8_BAR; if (F8 && t == 0) { PG8_MMAZ(1, 0, At, B0); PG8_MMAZ(1, 1, At, B1); } else { PG8_MMA(1, 0, At, B0); PG8_MMA(1, 1, At, B1); } PG8_BAR; PG8_SCHED;
            PG8_LDB(B0, 1, 0); PG8_LDB(B1, 1, 1); PG8_SCHED; PG8_LDA(At, 1, 0); PG8_STAGE(PG8_SA(0, 1), a2, w1);
            PG8_WAIT_V(8); PG8_WAIT_L(0); PG8_BAR; PG8_MMA(0, 0, At, B0); PG8_MMA(0, 1, At, B1); PG8_BAR; PG8_SCHED;
            PG8_LDA(At, 1, 1); PG8_STAGE(PG8_SB(1, 0), b3, voffB); PG8_STAGE(PG8_SB(1, 1), b3 + hstep, voffB); PG8_STAGE(PG8_SA(1, 0), a3, w0);
            PG8_WAIT_V(8); PG8_WAIT_L(0); PG8_BAR; PG8_MMA(1, 0, At, B0); PG8_MMA(1, 1, At, B1); PG8_BAR; PG8_SCHED;
        }
        if constexpr (F8) asm volatile("s_nop 15\n\ts_nop 15" ::: "memory");
        if (ALIGN_EPI) { if (wr == 0) PG8_BAR; }
        if constexpr (Epi::HAS_PRE) E(acc, cur, wr, wc, fr, fq, epre); else E(acc, cur, wr, wc, fr, fq);
        S.done(cur, lane);
        if (!has_next) break;
        if constexpr (!F8) {
#pragma unroll
        for (int a = 0; a < 2; ++a)
#pragma unroll
            for (int b = 0; b < 2; ++b)
#pragma unroll
                for (int m = 0; m < 4; ++m)
#pragma unroll
                    for (int n = 0; n < 2; ++n) acc[a][b][m][n] = (f32x4){0.f, 0.f, 0.f, 0.f};
        }
        cur = nxt; cA = nA; cB = nB; ++ui;
        cv0[0] = nv0[0]; cv0[1] = nv0[1]; cv1[0] = nv1[0]; cv1[1] = nv1[1];
        if (ALIGN_EPI) { if (wr == 1) PG8_BAR; }
    }
    PG8_WAIT_V(0);
    if (!ALIGN_EPI) { if (wr == 0) PG8_BAR; }
    PG8_BAR;
#undef PG8_SA
#undef PG8_SB
#undef PG8_STAGE
#undef PG8_CAT
#undef PG8_LDA
#undef PG8_LDB
#undef PG8_MMA
#undef PG8_MMAZ
#undef PG8_WAIT_V
#undef PG8_WAIT_L
#undef PG8_BAR
#undef PG8_SCHED
}
}

#define XB_TMO      128
#define XB_XCNT(j)  (256  + 64 * (j))
#define XB_XSUB(j)  (1280 + 64 * (j))
#define XB_XGEN(j)  (2304 + 64 * (j))
#define XB_TOP      3328
#define XB_TOPGEN   3392
#define XCD_BAR_WORDS 3456
#define XB_SPIN_CAP (1u << 18)
__device__ __forceinline__ unsigned xb_ld(unsigned* p)              { return __hip_atomic_load(p, __ATOMIC_RELAXED, __HIP_MEMORY_SCOPE_AGENT); }
__device__ __forceinline__ unsigned xb_add(unsigned* p, unsigned v) { return __hip_atomic_fetch_add(p, v, __ATOMIC_RELAXED, __HIP_MEMORY_SCOPE_AGENT); }
__device__ __forceinline__ unsigned xb_xcc_id() { return (unsigned)__builtin_amdgcn_s_getreg((3 << 11) | 20) & 0xFu; }
#define XB_SPIN(cond, bar) do { unsigned _sp = 0; while (cond) { __builtin_amdgcn_s_sleep(1); \
    if ((++_sp & 255u) == 0u) { if (xb_ld(&(bar)[XB_TMO])) break; if (_sp > XB_SPIN_CAP) { atomicAdd(&(bar)[XB_TMO], 1u); break; } } } } while (0)
struct XcdBarrier { unsigned* bar; unsigned x; volatile LAS unsigned* st; };
__device__ __forceinline__ XcdBarrier xcd_barrier_post(unsigned* bar, volatile LAS unsigned* st) {
    XcdBarrier b; b.bar = bar; b.x = xb_xcc_id(); b.st = st;
    if (threadIdx.x == 0) (void)xb_add(&bar[XB_XCNT(b.x)], 1u);
    return b;
}
__device__ __forceinline__ void xcd_barrier_complete(unsigned* bar, unsigned x, unsigned& nloc, unsigned& nx) {
    const unsigned G = gridDim.x * gridDim.y * gridDim.z;
    unsigned sum, cnt, mine, sp = 0u;
    for (;;) {
        sum = 0u; cnt = 0u; mine = 0u;
#pragma unroll
        for (unsigned j = 0; j < 16; ++j) { const unsigned c = xb_ld(&bar[XB_XCNT(j)]); sum += c; cnt += (c > 0u) ? 1u : 0u; mine = (j == x) ? c : mine; }
        if (sum == G) break;
        __builtin_amdgcn_s_sleep(1);
        if ((++sp & 255u) == 0u) { if (xb_ld(&bar[XB_TMO])) break; if (sp > XB_SPIN_CAP) { atomicAdd(&bar[XB_TMO], 1u); break; } }
    }
    nloc = mine > 0u ? mine : 1u; nx = cnt > 0u ? cnt : 1u;
}
__device__ __forceinline__ void xcd_barrier(const XcdBarrier& b, int tid) {
    asm volatile("s_waitcnt vmcnt(0)" ::: "memory");
    __syncthreads();
    if (tid == 0) {
        unsigned* bar = b.bar;
        __builtin_amdgcn_s_waitcnt(0);
        unsigned nloc = b.st[0], nx = b.st[1];
        if (nloc == 0u) { xcd_barrier_complete(bar, b.x, nloc, nx); b.st[0] = nloc; b.st[1] = nx; }
        const unsigned old = xb_add(&bar[XB_XSUB(b.x)], 1u);
        const unsigned gen = old / nloc;
        if (old + 1u == (gen + 1u) * nloc) {
            __builtin_amdgcn_fence(__ATOMIC_RELEASE, "agent");
            asm volatile("s_waitcnt vmcnt(0)" ::: "memory");
            const unsigned og = xb_add(&bar[XB_TOP], 1u);
            const unsigned tg = og / nx;
            if (og + 1u == (tg + 1u) * nx) xb_add(&bar[XB_TOPGEN], 1u);
            else XB_SPIN(xb_ld(&bar[XB_TOPGEN]) == tg, bar);
            __builtin_amdgcn_fence(__ATOMIC_ACQUIRE, "agent");
            xb_add(&bar[XB_XGEN(b.x)], 1u);
            asm volatile("s_waitcnt vmcnt(0)" ::: "memory");
        } else {
            XB_SPIN(xb_ld(&bar[XB_XGEN(b.x)]) == gen, bar);
            __builtin_amdgcn_fence(__ATOMIC_ACQUIRE, "agent");
            asm volatile("s_waitcnt vmcnt(0)" ::: "memory");
        }
    }
    __syncthreads();
}

constexpr int NWAVES = 8;
constexpr int RING_BYTES = 131072, LDSCTL_OFF = RING_BYTES, MISC_OFF = LDSCTL_OFF + 320, LDS_BYTES = 147456;
struct Args { const float* in[22]; float* out; unsigned char* ws; int ph_lo, ph_hi, li, pad; };
enum { I_X = 0, I_C, I_CTX, I_CCTX, I_WADA, I_BADA, I_NORM1, I_NORM2, I_WIN, I_UPF, I_BIASF, I_UPB, I_BIASB, I_GLANORM, I_SINK, I_WOUT, I_WROUTER, I_BROUTER, I_WGATE, I_WUP, I_WDOWN, I_FNORM };

struct Frame {
    LAS unsigned char* lds; int tid, lane, wave, vcu, G, gw, NGW;
    unsigned char* ws; float* out; bf16* xlb;
};

__device__ __forceinline__ int rope_pos(int d) { return 8 * ((d & 15) >> 2) + 4 * (d >> 4) + (d & 3); }
__device__ __forceinline__ int gu_row(int h, int gu) { return (h >> 7) * 256 + ((h >> 2) & 1) * 128 + ((h >> 5) & 3) * 32 + ((h >> 3) & 3) * 8 + gu * 4 + (h & 3); }
struct TItem { const float* src; bf16* dst; int N, Kd, n0, rbase, mode; bool ok; float f8scale; };
__device__ __forceinline__ void titem_load(const TItem& t, int lane, f32x4 (&v)[8]) {
    const int g = lane >> 3, i8 = lane & 7;
    const float* src = t.src + (size_t)(8 * g) * t.N + 4 * i8;
#pragma unroll
    for (int q = 0; q < 8; ++q) v[q] = __builtin_nontemporal_load((const f32x4*)(src + (size_t)q * t.N));
}
__device__ __forceinline__ int down_row(int c) { return (c & ~255) | (((c >> 3) & 1) << 7) | (((c >> 6) & 3) << 5) | (((c >> 4) & 3) << 3) | (c & 7); }
__device__ __forceinline__ void titem_store(const TItem& t, int lane, const f32x4 (&v)[8]) {
    const int g = lane >> 3, i8 = lane & 7;
#pragma unroll
    for (int i = 0; i < 4; ++i) {
        const int n = 4 * i8 + i;
        const int row = (t.mode == 0) ? t.rbase + n : (t.mode == 1) ? t.rbase + rope_pos(n) : (t.mode == 4) ? down_row(t.rbase + n) : gu_row(t.n0 + n, t.mode - 2);
        if (t.f8scale != 0.f) {
            const float sc = t.f8scale; u32x2 o; o.x = pk4_fp8(v[0][i] * sc, v[1][i] * sc, v[2][i] * sc, v[3][i] * sc); o.y = pk4_fp8(v[4][i] * sc, v[5][i] * sc, v[6][i] * sc, v[7][i] * sc);
            *(u32x2*)((unsigned char*)t.dst + (size_t)row * t.Kd + 8 * g) = o;
        } else {
            u32x4 o; o.x = pk2(v[0][i], v[1][i]); o.y = pk2(v[2][i], v[3][i]); o.z = pk2(v[4][i], v[5][i]); o.w = pk2(v[6][i], v[7][i]);
            *(u32x4*)(t.dst + (size_t)row * t.Kd + 8 * g) = o;
        }
    }
}
constexpr int IT_IN = 2 * 16 * 73, IT_OUT = 2 * 16 * 32, IT_G = 32 * 16 * 16, IT_D = 32 * 8 * 32, NITEMS = IT_IN + IT_OUT + 2 * IT_G + IT_D;
__device__ __forceinline__ TItem titem_decode(const CAS Args* a, unsigned char* ws, int it) {
    TItem t; t.ok = it < NITEMS; t.mode = 0; t.rbase = 0; t.n0 = 0; t.N = D; t.Kd = D; t.src = nullptr; t.dst = nullptr; t.f8scale = 0.f;
    if (!t.ok) return t;
    int r = it;
    if (r < IT_IN) {
        const int l = r / 1168, rr = r % 1168, kb = rr / 73, nb = rr % 73;
        if (nb == 48) { t.ok = false; return t; }
        const int n0 = nb * 32; t.n0 = n0;
        if (n0 < 1536) t.rbase = n0;
        else if (n0 < 2080) { t.rbase = PC_SQ + (n0 - 1568); t.mode = 1; }
        else if (n0 < 2208) { t.rbase = PC_SK + (n0 - 2080); t.mode = 1; }
        else t.rbase = PC_SV + (n0 - 2208);
        t.N = WIN_COLS; t.Kd = D; t.src = a->in[I_WIN] + (size_t)l * D * WIN_COLS + (size_t)(kb * 64) * WIN_COLS + n0; t.dst = (bf16*)(ws + WS_WIN + (size_t)l * NIN * D + kb * 64); t.f8scale = W1_SCALE;
        return t;
    }
    r -= IT_IN;
    if (r < IT_OUT) { const int l = r / 512, rr = r % 512, kb = rr / 32, nb = rr % 32;
        t.n0 = nb * 32; t.rbase = nb * 32; t.N = D; t.Kd = D; t.src = a->in[I_WOUT] + (size_t)l * D * D + (size_t)(kb * 64) * D + nb * 32; t.dst = (bf16*)(ws + WS_WOUT + (size_t)l * D * D + kb * 64); t.f8scale = W1_SCALE; return t; }
    r -= IT_OUT;
    if (r < 2 * IT_G) { const int gu = r / IT_G, r2 = r % IT_G, le = r2 / 256, rr = r2 % 256, kb = rr / 16, nb = rr % 16;
        t.n0 = nb * 32; t.mode = 2 + gu; t.N = DE; t.Kd = D; t.src = a->in[gu ? I_WUP : I_WGATE] + (size_t)le * D * DE + (size_t)(kb * 64) * DE + nb * 32; t.dst = (bf16*)(ws + WS_WGU + (size_t)le * D * D + kb * 64); t.f8scale = W1_SCALE; return t; }
    r -= 2 * IT_G;
    { const int le = r / 256, rr = r % 256, kb = rr / 32, nb = rr % 32;
        t.n0 = nb * 32; t.rbase = nb * 32; t.mode = 4; t.N = D; t.Kd = DE; t.src = a->in[I_WDOWN] + (size_t)le * DE * D + (size_t)(kb * 64) * D + nb * 32; t.dst = (bf16*)(ws + WS_WD + (size_t)le * D * DE + kb * 64); t.f8scale = W2_SCALE; }
    return t;
}

template <class Map>
__device__ __forceinline__ void convert_items(const Frame& F, const CAS Args* a, int n, int worker, int nworkers, Map map) {
    unsigned char* ws = F.ws;
    for (int p = worker; 2 * p < n; p += nworkers) {
        const int i = 2 * p, i2 = i + 1;
        const TItem ta = titem_decode(a, ws, map(i)), tb = titem_decode(a, ws, i2 < n ? map(i2) : NITEMS);
        f32x4 va[8], vb[8];
        if (ta.ok) titem_load(ta, F.lane, va);
        if (tb.ok) titem_load(tb, F.lane, vb);
        if (ta.ok) titem_store(ta, F.lane, va);
        if (tb.ok) titem_store(tb, F.lane, vb);
    }
}
struct MapSmall { __device__ __forceinline__ int operator()(int i) const { return i; } };
struct MapMoe { int l; __device__ __forceinline__ int operator()(int i) const { const int kind = i >> 12, q = i & 4095, p = q >> 1, half = q & 1, le = p >> 7, rem = p & 127;
    const int r = kind < 2 ? le * 256 + (2 * (rem >> 4) + half) * 16 + (rem & 15) : le * 256 + (2 * (rem >> 5) + half) * 32 + (rem & 31);
    return IT_IN + IT_OUT + (kind < 2 ? kind * IT_G : 2 * IT_G) + l * 4096 + r; } };
__device__ __forceinline__ void convert_moe_filler(const Frame& F, const CAS Args* a, int l, int nunits, bool both = false) {
    const int c = (int)blockIdx.x, nfull = nunits % F.G;
    int first = nfull, nf = F.G - nfull - (both ? nfull : 0);
    if (nfull == 0 || nf <= 0) { first = 0; nf = F.G; }
    if (c < first || c >= first + nf) return;
    convert_items(F, a, 3 * 4096, (c - first) * NWAVES + F.wave, nf * NWAVES, MapMoe{l});
}

__device__ __forceinline__ void p0_convert(const Frame& F, const CAS Args* a) {
    unsigned char* ws = F.ws;
    convert_items(F, a, IT_IN + IT_OUT, F.gw, F.NGW, MapSmall{});
    for (int t = F.gw; t < 2 * 2 * 4 * 128; t += F.NGW) {
        const int kc = t & 127, ng = (t >> 7) & 3, dir = (t >> 9) & 1, l = t >> 10, n = ng * 64 + F.lane;
        const float* up = a->in[dir ? I_UPB : I_UPF] + (size_t)l * 16 * 256 + n;
        float u[16];
#pragma unroll
        for (int r = 0; r < 16; ++r) u[r] = up[r * 256];
        float o[8];
#pragma unroll
        for (int kk = 0; kk < 8; ++kk) {
            const f32x4* wz = (const f32x4*)(a->in[I_WIN] + ((size_t)l * D + kc * 8 + kk) * WIN_COLS + 1536 + dir * 16);
            float sm = 0.f;
#pragma unroll
            for (int q = 0; q < 4; ++q) { const f32x4 w = wz[q]; sm += w[0] * u[4 * q] + w[1] * u[4 * q + 1] + w[2] * u[4 * q + 2] + w[3] * u[4 * q + 3]; }
            o[kk] = sm;
        }
        u32x2 ov; ov.x = pk4_fp8(o[0] * W1_SCALE, o[1] * W1_SCALE, o[2] * W1_SCALE, o[3] * W1_SCALE); ov.y = pk4_fp8(o[4] * W1_SCALE, o[5] * W1_SCALE, o[6] * W1_SCALE, o[7] * W1_SCALE);
        *(u32x2*)(ws + WS_WIN + ((size_t)l * NIN + PC_GF + dir * 256 + n) * D + kc * 8) = ov;
    }
}
__device__ __forceinline__ void p0_prologue(const Frame& F, const CAS Args* a) {
    unsigned char* ws = F.ws;
    if (blockIdx.x == (unsigned)(F.G - 1)) {
        float* tc = (float*)(ws + WS_ROPE); float* tsn = tc + 2048;
        for (int i = F.tid; i < 2048; i += NWAVES * 64) { const int pos = i >> 4, j = i & 15; const float inv = powf(10000.0f, -(float)j * (1.0f / 16.0f)); const float ang = (float)pos * inv;
            tc[i] = cosf(ang); tsn[i] = sinf(ang); }
    }
    __syncthreads();
    {
        LAS float* cs = (LAS float*)F.lds; LAS float* red = cs + 3072;
        for (int i = F.tid; i < 3072; i += NWAVES * 64) { const int v = i >> 10, k = i & 1023; const float cv = v < 2 ? a->in[I_C][v * D + k] : a->in[I_CCTX][k]; cs[i] = cv / (1.0f + expf(-cv)); }
        __syncthreads();
        for (int u = blockIdx.x; u < 192; u += F.G) {
            const int l = u / 96, jg = u % 96, jl = F.tid & 63, ks = F.tid >> 6;
            const float* wp = a->in[I_WADA] + ((size_t)l * D + ks * 128) * 6144 + jg * 64 + jl;
            float a0 = 0.f, a1 = 0.f, a2 = 0.f;
#pragma unroll 1
            for (int k0 = 0; k0 < 128; k0 += 32) {
                float wv[32];
#pragma unroll
                for (int k = 0; k < 32; ++k) wv[k] = __builtin_nontemporal_load(wp + (size_t)(k0 + k) * 6144);
#pragma unroll
                for (int k = 0; k < 32; ++k) { const int kk = ks * 128 + k0 + k; a0 += cs[kk] * wv[k]; a1 += cs[1024 + kk] * wv[k]; a2 += cs[2048 + kk] * wv[k]; }
            }
            red[(ks * 3 + 0) * 64 + jl] = a0; red[(ks * 3 + 1) * 64 + jl] = a1; red[(ks * 3 + 2) * 64 + jl] = a2;
            __syncthreads();
            if (F.tid < 192) { const int v = F.tid >> 6, j2 = F.tid & 63; float s = 0.f;
#pragma unroll
                for (int q = 0; q < 8; ++q) s += red[(q * 3 + v) * 64 + j2];
                float val = s + a->in[I_BADA][l * 6144 + jg * 64 + j2];
                const int cix = jg * 64 + j2, seg = cix >> 10;
                if (seg == 1) val = (1.0f + val) * a->in[I_NORM1][l * D + (cix & 1023)]; else if (seg == 4) val = (1.0f + val) * a->in[I_NORM2][l * D + (cix & 1023)];
                ((float*)(ws + WS_MOD))[(l * 3 + v) * 6144 + jg * 64 + j2] = val; }
            __syncthreads();
        }
    }
}

__device__ __forceinline__ f32x4 ld_y4(const bf16* p) { const u32x2 w = *(const u32x2*)p; return (f32x4){bflo(w.x), bfhi(w.x), bflo(w.y), bfhi(w.y)}; }
__device__ __forceinline__ f32x4 ld_y8(const unsigned char* p) { const int w = *(const int*)p; const f32x2 lo = __builtin_amdgcn_cvt_pk_f32_fp8(w, false), hi = __builtin_amdgcn_cvt_pk_f32_fp8(w, true); return (f32x4){lo[0], lo[1], hi[0], hi[1]}; }
struct N1Raw { f32x4 xf[4]; u32x2 xb[4]; int y0[4], y1[4]; };
__device__ __forceinline__ int n1_col(int l, int lane, int j) { return l > 0 ? 512 * (j >> 1) + 8 * lane + 4 * (j & 1) : 4 * lane + 256 * j; }
__device__ __forceinline__ void n1_load(const Frame& F, const CAS Args* a, int l, int m, N1Raw& r) {
    unsigned char* ws = F.ws;
    const unsigned char* Y0 = ws + WS_Y; const unsigned char* Y1 = Y0 + (size_t)TT * D;
    const float* src = (l == 0) ? (m < TL ? a->in[I_X] + (size_t)m * D : a->in[I_CTX] + (size_t)(m - TL) * D) : (const float*)(ws + WS_XC) + (size_t)(m - TL) * D;
    const bool from_b = (l > 0) && (m < TL);
    if (l > 0) {
#pragma unroll
        for (int h = 0; h < 2; ++h) { const int col = 512 * h + 8 * F.lane;
            if (from_b) { const u32x4 w = *(const u32x4*)(F.xlb + (size_t)m * D + col); r.xb[2 * h] = (u32x2){w.x, w.y}; r.xb[2 * h + 1] = (u32x2){w.z, w.w}; }
            else { r.xf[2 * h] = *(const f32x4*)(src + col); r.xf[2 * h + 1] = *(const f32x4*)(src + col + 4); }
            const u32x2 a0 = __builtin_nontemporal_load((const u32x2*)(Y0 + (size_t)m * D + col)), a1 = __builtin_nontemporal_load((const u32x2*)(Y1 + (size_t)m * D + col));
            r.y0[2 * h] = (int)a0.x; r.y0[2 * h + 1] = (int)a0.y; r.y1[2 * h] = (int)a1.x; r.y1[2 * h + 1] = (int)a1.y; }
        return;
    }
#pragma unroll
    for (int j = 0; j < 4; ++j) { const int col = 4 * F.lane + 256 * j;
        r.xf[j] = __builtin_nontemporal_load((const f32x4*)(src + col)); }
}
__device__ __forceinline__ void n1_unpack(int l, int m, const N1Raw& r, f32x4 (&x)[4], f32x4 (&y)[4]) {
    const bool from_b = (l > 0) && (m < TL);
#pragma unroll
    for (int j = 0; j < 4; ++j) {
        x[j] = from_b ? (f32x4){bflo(r.xb[j].x), bfhi(r.xb[j].x), bflo(r.xb[j].y), bfhi(r.xb[j].y)} : r.xf[j];
        if (l > 0) { const f32x2 a0 = __builtin_amdgcn_cvt_pk_f32_fp8(r.y0[j], false), a1 = __builtin_amdgcn_cvt_pk_f32_fp8(r.y0[j], true), b0 = __builtin_amdgcn_cvt_pk_f32_fp8(r.y1[j], false), b1 = __builtin_amdgcn_cvt_pk_f32_fp8(r.y1[j], true);
            y[j] = (f32x4){a0[0] + b0[0], a0[1] + b0[1], a1[0] + b1[0], a1[1] + b1[1]}; }
    }
}
struct N1Coef { f32x4 ca[4], cb[4], cg[4]; int v; };
__device__ __forceinline__ void n1_coef(const Frame& F, const CAS Args* a, int l, int v, N1Coef& c) {
    const float* mod = (const float*)(F.ws + WS_MOD);
#pragma unroll
    for (int j = 0; j < 4; ++j) {
        const int col = n1_col(l, F.lane, j);
        c.ca[j] = *(const f32x4*)(mod + (l * 3 + v) * 6144 + 1 * D + col); c.cb[j] = *(const f32x4*)(mod + (l * 3 + v) * 6144 + 0 * D + col);
        if (l > 0) c.cg[j] = *(const f32x4*)(mod + ((l - 1) * 3 + v) * 6144 + 5 * D + col) * (1.0f / Y_SCALE);
    }
    c.v = v;
}
__device__ __forceinline__ void n1_row(const Frame& F, int l, int m, f32x4 (&x)[4], const f32x4 (&y)[4], const N1Coef& c) {
    unsigned char* ws = F.ws;
    bf16* H = (bf16*)(ws + WS_H);
    float* xrow = (float*)(ws + WS_XC) + (size_t)(m - TL) * D;
    float ss = 0.f;
    if (l > 0) {
#pragma unroll
        for (int j = 0; j < 4; ++j) x[j] = x[j] + c.cg[j] * y[j];
#pragma unroll
        for (int h = 0; h < 2; ++h) { const int col = 512 * h + 8 * F.lane;
            if (m < TL) { u32x4 o; o.x = pk2(x[2 * h][0], x[2 * h][1]); o.y = pk2(x[2 * h][2], x[2 * h][3]); o.z = pk2(x[2 * h + 1][0], x[2 * h + 1][1]); o.w = pk2(x[2 * h + 1][2], x[2 * h + 1][3]);
                *(u32x4*)(F.xlb + (size_t)m * D + col) = o; }
            else { *(f32x4*)(xrow + col) = x[2 * h]; *(f32x4*)(xrow + col + 4) = x[2 * h + 1]; } }
    }
#pragma unroll
    for (int j = 0; j < 4; ++j) ss += (x[j][0] * x[j][0] + x[j][1] * x[j][1]) + (x[j][2] * x[j][2] + x[j][3] * x[j][3]);
    const float rstd = 1.0f / sqrtf(wave_sum(ss) * (1.0f / D) + EPS);
    if (l > 0) {
#pragma unroll
        for (int h = 0; h < 2; ++h) { const int col = 512 * h + 8 * F.lane;
            const f32x4 h0 = x[2 * h] * rstd * c.ca[2 * h] + c.cb[2 * h], h1 = x[2 * h + 1] * rstd * c.ca[2 * h + 1] + c.cb[2 * h + 1];
            u32x2 o; o.x = pk4_fp8(h0[0], h0[1], h0[2], h0[3]); o.y = pk4_fp8(h1[0], h1[1], h1[2], h1[3]);
            *(u32x2*)((unsigned char*)H + (size_t)m * D + col) = o; }
        return;
    }
#pragma unroll
    for (int j = 0; j < 4; ++j) {
        const int col = 4 * F.lane + 256 * j;
        const f32x4 h = x[j] * rstd * c.ca[j] + c.cb[j];
        *(unsigned*)((unsigned char*)H + (size_t)m * D + col) = pk4_fp8(h[0], h[1], h[2], h[3]);
    }
}
__device__ __forceinline__ void n1_phase(const Frame& F, const CAS Args* a, int l) {
    N1Coef c; c.v = -1;
    N1Raw ra, rb, na, nb;
    if (F.gw < TT) n1_load(F, a, l, F.gw, ra);
    if (F.gw + F.NGW < TT) n1_load(F, a, l, F.gw + F.NGW, rb);
    for (int m = F.gw; m < TT; m += 2 * F.NGW) {
        const int m2 = m + F.NGW, m3 = m + 2 * F.NGW, m4 = m + 3 * F.NGW; const bool two = m2 < TT;
        if (m3 < TT) n1_load(F, a, l, m3, na);
        if (m4 < TT) n1_load(F, a, l, m4, nb);
        f32x4 x[4], y[4];
        { const int v = m < TL ? (m >> 13) : 2; if (v != c.v) n1_coef(F, a, l, v, c); }
        n1_unpack(l, m, ra, x, y); n1_row(F, l, m, x, y, c);
        if (two) { const int v = m2 < TL ? (m2 >> 13) : 2; if (v != c.v) n1_coef(F, a, l, v, c); n1_unpack(l, m2, rb, x, y); n1_row(F, l, m2, x, y, c); }
        ra = na; rb = nb;
    }
}

struct EpiIn {
    static constexpr bool PERM = true, HAS_PRE = false;
    bf16* P; const float* bias_f; const float* bias_b; const float* tcos; const float* tsin; int abl;
    template <int KIND, bool WODD = false>
    __device__ __forceinline__ void body(const f32x4 (&acc)[2][2][4][2], const pg8::Unit& u, int wr, int wc, int fr, int fq) const {
        const int row0 = u.pm * 256 + wr * 64 + fr, colw = wc * 32 + 8 * fq;
        f32x4 cs[4], sn[4], b0[2], b1[2];
        if (KIND == 3 || KIND == 5) {
            const int t0 = row0 & (SEQ - 1);
#pragma unroll
            for (int j = 0; j < (WODD ? 4 : 2); ++j) { const int pos = WODD ? ((t0 + 16 * j) & 63) : ((t0 + 128 * j) >> 6);
                cs[j] = *(const f32x4*)(tcos + pos * 16 + 4 * fq); sn[j] = *(const f32x4*)(tsin + pos * 16 + 4 * fq); }
        }
        if (KIND == 2) {
#pragma unroll
            for (int bj = 0; bj < 2; ++bj) { const float* bp = (u.pn == 9 ? bias_f : bias_b) + colw + bj * 128; b0[bj] = *(const f32x4*)bp * LOG2E; b1[bj] = *(const f32x4*)(bp + 4) * LOG2E; }
        }
#pragma unroll
        for (int ai = 0; ai < 2; ++ai)
#pragma unroll
            for (int m = 0; m < 4; ++m) {
                const int row = row0 + ai * 128 + m * 16;
                bf16* rowp = P + (size_t)row * NIN + u.pn * 256 + colw;
#pragma unroll
                for (int bj = 0; bj < 2; ++bj) {
                    f32x4 v0 = acc[ai][bj][m][0], v1 = acc[ai][bj][m][1];
                    if (KIND == 1) { v0 = v0 * 0.125f; v1 = v1 * 0.125f; }
                    if (KIND == 2) {
                        const f32x4 t0 = v0 * LOG2E + b0[bj], t1 = v1 * LOG2E + b1[bj]; f32x4 e0, e1, m0, m1;
#pragma unroll
                        for (int i = 0; i < 4; ++i) { e0[i] = __builtin_amdgcn_exp2f(-__builtin_fabsf(t0[i])); e1[i] = __builtin_amdgcn_exp2f(-__builtin_fabsf(t1[i])); m0[i] = fminf(t0[i], 0.f); m1[i] = fminf(t1[i], 0.f); }
                        e0 = e0 + 1.0f; e1 = e1 + 1.0f;
#pragma unroll
                        for (int i = 0; i < 4; ++i) { e0[i] = __builtin_amdgcn_logf(e0[i]); e1[i] = __builtin_amdgcn_logf(e1[i]); }
                        v0 = (m0 - e0) * (0.6931471805599453f * 0.0625f); v1 = (m1 - e1) * (0.6931471805599453f * 0.0625f);
                    }
                    if (KIND == 3 || (KIND == 5 && bj == 0)) {
                        const f32x4 c = WODD ? cs[m] : cs[ai], sv = WODD ? sn[m] : sn[ai];
                        const f32x4 o0 = v0 * c - v1 * sv, o1 = v1 * c + v0 * sv; v0 = o0; v1 = o1;
                    }
                    if (KIND == 3 || KIND == 4) { v0 = v0 * QSCALE; v1 = v1 * QSCALE; }
                    u32x4 w; w.x = pk2(v0[0], v0[1]); w.y = pk2(v0[2], v0[3]); w.z = pk2(v1[0], v1[1]); w.w = pk2(v1[2], v1[3]);
                    *(u32x4*)(rowp + bj * 128) = w;
                }
            }
    }
    __device__ __forceinline__ void operator()(const f32x4 (&acc)[2][2][4][2], const pg8::Unit& u, int wr, int wc, int fr, int fq) const {
        const int pn = u.pn; const bool latent = u.pm < 64, wodd = (wc & 1) != 0;
        if (pn == 0) body<1>(acc, u, wr, wc, fr, fq);
        else if (pn < 6) body<0>(acc, u, wr, wc, fr, fq);
        else if (pn < 8) { if (latent) { if (wodd) body<3, true>(acc, u, wr, wc, fr, fq); else body<3, false>(acc, u, wr, wc, fr, fq); } else body<4>(acc, u, wr, wc, fr, fq); }
        else if (pn == 8) { if (latent) { if (wodd) body<5, true>(acc, u, wr, wc, fr, fq); else body<5, false>(acc, u, wr, wc, fr, fq); } else body<0>(acc, u, wr, wc, fr, fq); }
        else body<2>(acc, u, wr, wc, fr, fq);
    }
};
template <bool RB>
struct EpiOut {
    static constexpr bool PERM = true, HAS_PRE = false;
    const float* resL; const float* resC; bf16* xlb; float* outC; const float* mod_l;
    struct Buf { f32x4 f[2][2][2]; u32x4 w[2][2]; };
    __device__ __forceinline__ void operator()(const f32x4 (&acc)[2][2][4][2], const pg8::Unit& u, int wr, int wc, int fr, int fq) const {
        const bool latent = RB || u.pm < 64;
        const int v = latent ? (u.pm >> 5) : 2;
        const int rowb = (latent ? u.pm * 256 : u.pm * 256 - TL) + wr * 64 + fr;
        const int col0 = u.pn * 256 + wc * 32 + 8 * fq;
        const float* g1p = mod_l + v * 6144 + 2 * D + col0;
        f32x4 g1[2][2];
#pragma unroll
        for (int bj = 0; bj < 2; ++bj)
#pragma unroll
            for (int n = 0; n < 2; ++n) g1[bj][n] = *(const f32x4*)(g1p + bj * 128 + n * 4);
        const float* res = latent ? resL : resC;
        auto ld = [&](int k, Buf& r) {
            const int ai = k >> 1, mp = (k & 1) * 2;
#pragma unroll
            for (int m = 0; m < 2; ++m) { const size_t off = (size_t)(rowb + ai * 128 + (mp + m) * 16) * D + col0;
#pragma unroll
                for (int bj = 0; bj < 2; ++bj) {
                    if (RB) r.w[m][bj] = *(const u32x4*)(xlb + off + bj * 128);
                    else { r.f[m][bj][0] = __builtin_nontemporal_load((const f32x4*)(res + off + bj * 128)); r.f[m][bj][1] = __builtin_nontemporal_load((const f32x4*)(res + off + bj * 128 + 4)); }
                } }
        };
        auto st = [&](int k, const Buf& r) {
            const int ai = k >> 1, mp = (k & 1) * 2;
#pragma unroll
            for (int m = 0; m < 2; ++m) { const size_t off = (size_t)(rowb + ai * 128 + (mp + m) * 16) * D + col0;
#pragma unroll
                for (int bj = 0; bj < 2; ++bj) {
                    f32x4 r0, r1;
                    if (RB) { const u32x4 w = r.w[m][bj]; r0 = (f32x4){bflo(w.x), bfhi(w.x), bflo(w.y), bfhi(w.y)}; r1 = (f32x4){bflo(w.z), bfhi(w.z), bflo(w.w), bfhi(w.w)}; }
                    else { r0 = r.f[m][bj][0]; r1 = r.f[m][bj][1]; }
                    const f32x4 o0 = r0 + g1[bj][0] * acc[ai][bj][mp + m][0], o1 = r1 + g1[bj][1] * acc[ai][bj][mp + m][1];
                    if (latent) { u32x4 w; w.x = pk2(o0[0], o0[1]); w.y = pk2(o0[2], o0[3]); w.z = pk2(o1[0], o1[1]); w.w = pk2(o1[2], o1[3]); *(u32x4*)(xlb + off + bj * 128) = w; }
                    else { *(f32x4*)(outC + off + bj * 128) = o0; *(f32x4*)(outC + off + bj * 128 + 4) = o1; }
                } }
        };
        Buf rA, rB;
        ld(0, rA);
        ld(1, rB); st(0, rA); asm volatile("" ::: "memory");
        ld(2, rA); st(1, rB); asm volatile("" ::: "memory");
        ld(3, rB); st(2, rA); asm volatile("" ::: "memory");
        st(3, rB);
    }
};
struct EpiGU {
    static constexpr bool PERM = true, HAS_PRE = false;
    bf16* Hmid;
    __device__ __forceinline__ void operator()(const f32x4 (&acc)[2][2][4][2], const pg8::Unit& u, int wr, int wc, int fr, int fq) const {
        const int row0 = u.pm * 256 + wr * 64 + fr, hid0 = u.pn * 128 + wc * 32 + fq * 8;
#pragma unroll
        for (int ai = 0; ai < 2; ++ai)
#pragma unroll
            for (int m = 0; m < 4; ++m) {
                unsigned char* rowp = (unsigned char*)Hmid + (size_t)(row0 + ai * 128 + m * 16) * DE + hid0;
                unsigned wv[2];
#pragma unroll
                for (int bj = 0; bj < 2; ++bj) {
                    const f32x4 g = acc[ai][bj][m][0], up = acc[ai][bj][m][1];
                    static_assert(HMID_SCALE == 4.f, "the fp8 pre-scale of the hidden activations is folded into the sigmoid below");
                    f32x4 e = g * (-LOG2E) - 2.0f;
#pragma unroll
                    for (int i = 0; i < 4; ++i) e[i] = __builtin_amdgcn_exp2f(e[i]);
                    e = e + 0.25f;
#pragma unroll
                    for (int i = 0; i < 4; ++i) e[i] = __builtin_amdgcn_rcpf(e[i]);
                    const f32x4 o = (g * up) * e;
                    wv[bj] = pk4_fp8(o[0], o[1], o[2], o[3]);
                }
                __hip_atomic_store((unsigned long long*)rowp, ((unsigned long long)wv[1] << 32) | wv[0], __ATOMIC_RELAXED, __HIP_MEMORY_SCOPE_AGENT);
            }
    }
};
struct EpiDown {
    static constexpr bool PERM = true, HAS_PRE = true;
    bf16* Y; const unsigned* list; const float* listw; const LAS int* tab;
    struct Pre { unsigned ts[2][4]; float w[2][4]; };
    __device__ __forceinline__ void issue(const pg8::Unit& u, int wr, int fr, Pre& p) const {
        const int nv = tab[u.e] - u.mt * 256, r0 = wr * 64 + fr;
        const unsigned* lp = list + (size_t)u.e * LISTCAP + u.mt * 256; const float* lw = listw + (size_t)u.e * LISTCAP + u.mt * 256;
#pragma unroll
        for (int ai = 0; ai < 2; ++ai)
#pragma unroll
            for (int m = 0; m < 4; ++m) { const int r = r0 + ai * 128 + m * 16, ri = r < nv ? r : 0;
                asm volatile("global_load_dword %0, %1, off nt" : "=v"(p.ts[ai][m]) : "v"(lp + ri));
                asm volatile("global_load_dword %0, %1, off nt" : "=v"(p.w[ai][m]) : "v"(lw + ri)); }
    }
    __device__ __forceinline__ void operator()(const f32x4 (&acc)[2][2][4][2], const pg8::Unit& u, int wr, int wc, int fr, int fq, Pre& p) const {
        const int nv = tab[u.e] - u.mt * 256;
        const int r0 = wr * 64 + fr, col0 = u.pn * 256 + wc * 64 + 16 * fq;
#pragma unroll
        for (int ai = 0; ai < 2; ++ai)
#pragma unroll
            for (int m = 0; m < 4; ++m) asm volatile("" : "+v"(p.ts[ai][m]), "+v"(p.w[ai][m]));
#pragma unroll
        for (int ai = 0; ai < 2; ++ai)
#pragma unroll
            for (int m = 0; m < 4; ++m) {
                const unsigned ts = p.ts[ai][m]; const float w = p.w[ai][m];
                if (r0 + ai * 128 + m * 16 < nv) {
                    unsigned char* rowp = (unsigned char*)Y + ((size_t)(ts & 1u) * TT + (ts >> 1)) * D + col0;
                    const float ws_ = w * Y_SCALE;
                    u32x4 o;
                    { const f32x4 v0 = acc[ai][0][m][0] * ws_, v1 = acc[ai][0][m][1] * ws_; o.x = pk4_fp8(v0[0], v0[1], v0[2], v0[3]); o.y = pk4_fp8(v1[0], v1[1], v1[2], v1[3]); }
                    { const f32x4 v0 = acc[ai][1][m][0] * ws_, v1 = acc[ai][1][m][1] * ws_; o.z = pk4_fp8(v0[0], v0[1], v0[2], v0[3]); o.w = pk4_fp8(v1[0], v1[1], v1[2], v1[3]); }
                    *(u32x4*)rowp = o;
                }
            }
    }
};

__device__ __forceinline__ void swa_naive(const Frame& F, const CAS Args* a, int l) {
    const bf16* P = (const bf16*)(F.ws + WS_P); bf16* MIX = (bf16*)(F.ws + WS_MIX);
    const int total = (l == 0 ? TT : TL) * 8;
    for (int idx = F.gw * 64 + F.lane; idx < total; idx += F.NGW * 64) {
        const int m = idx >> 3, hq = idx & 7, kvh = hq >> 2;
        const bool latent = m < TL;
        const int b = latent ? (m >> 13) : ((m - TL) >> 8), t = m & (SEQ - 1);
        float q[64];
        { const u32x4* qp = (const u32x4*)(P + (size_t)m * NIN + PC_SQ + hq * 64);
#pragma unroll
          for (int c = 0; c < 8; ++c) { const u32x4 w = qp[c]; q[8 * c] = bflo(w.x); q[8 * c + 1] = bfhi(w.x); q[8 * c + 2] = bflo(w.y); q[8 * c + 3] = bfhi(w.y);
              q[8 * c + 4] = bflo(w.z); q[8 * c + 5] = bfhi(w.z); q[8 * c + 6] = bflo(w.w); q[8 * c + 7] = bfhi(w.w); } }
        float o[64];
#pragma unroll
        for (int d = 0; d < 64; ++d) o[d] = 0.f;
        const float sink = a->in[I_SINK][l * 8 + hq] * LOG2E;
        float mx = sink, den = 1.0f;
        const int lo = latent ? (t - 128 < 0 ? 0 : t - 128) : 0, hi = latent ? (t + 128 > SEQ - 1 ? SEQ - 1 : t + 128) : -1;
        const int nloc = hi - lo + 1;
        for (int kk = 0; kk < nloc + LC; ++kk) {
            const int krow = kk < nloc ? b * SEQ + lo + kk : TL + b * LC + (kk - nloc);
            const u32x4* kp = (const u32x4*)(P + (size_t)krow * NIN + PC_SK + kvh * 64);
            float s = 0.f;
#pragma unroll
            for (int c = 0; c < 8; ++c) { const u32x4 w = kp[c]; s += q[8 * c] * bflo(w.x) + q[8 * c + 1] * bfhi(w.x) + q[8 * c + 2] * bflo(w.y) + q[8 * c + 3] * bfhi(w.y)
                + q[8 * c + 4] * bflo(w.z) + q[8 * c + 5] * bfhi(w.z) + q[8 * c + 6] * bflo(w.w) + q[8 * c + 7] * bfhi(w.w); }
            const float mn = fmaxf(mx, s), f = exp2f(mx - mn), p = exp2f(s - mn);
            den = den * f + p; mx = mn;
            const u32x4* vp = (const u32x4*)(P + (size_t)krow * NIN + PC_SV + kvh * 64);
#pragma unroll
            for (int c = 0; c < 8; ++c) { const u32x4 w = vp[c];
                o[8 * c] = o[8 * c] * f + p * bflo(w.x); o[8 * c + 1] = o[8 * c + 1] * f + p * bfhi(w.x); o[8 * c + 2] = o[8 * c + 2] * f + p * bflo(w.y); o[8 * c + 3] = o[8 * c + 3] * f + p * bfhi(w.y);
                o[8 * c + 4] = o[8 * c + 4] * f + p * bflo(w.z); o[8 * c + 5] = o[8 * c + 5] * f + p * bfhi(w.z); o[8 * c + 6] = o[8 * c + 6] * f + p * bflo(w.w); o[8 * c + 7] = o[8 * c + 7] * f + p * bfhi(w.w); }
        }
        const float inv = 1.0f / den;
        u32x4* op = (u32x4*)(MIX + (size_t)m * D + 512 + hq * 64);
#pragma unroll
        for (int c = 0; c < 8; ++c) { u32x4 w; w.x = pk2(o[8 * c] * inv, o[8 * c + 1] * inv); w.y = pk2(o[8 * c + 2] * inv, o[8 * c + 3] * inv); w.z = pk2(o[8 * c + 4] * inv, o[8 * c + 5] * inv); w.w = pk2(o[8 * c + 6] * inv, o[8 * c + 7] * inv); op[c] = w; }
    }
}


typedef float f32x16 __attribute__((ext_vector_type(16)));
typedef short s16x4 __attribute__((ext_vector_type(4)));
__device__ __forceinline__ int crow(int r, int hi) { return (r & 3) + 8 * (r >> 2) + 4 * hi; }
__device__ __forceinline__ s16x4 vtr(const LAS unsigned char* p) { return __builtin_bit_cast(s16x4, __builtin_amdgcn_ds_read_tr16_b64_v4i16((LAS s16x4*)p)); }
#ifndef SWA_THR
#define SWA_THR 8.0f
#endif
#ifndef SWA_STAGGER
#define SWA_STAGGER 10
#endif
constexpr int SWA_K = 0, SWA_V = 49152;
__device__ __forceinline__ void swa_kload(const LAS unsigned char* Kt, int kb, int lane, bf16x8 (&kf)[4]) {
    const int r32 = lane & 31, hi = lane >> 5;
#pragma unroll
    for (int d0 = 0; d0 < 4; ++d0) kf[d0] = *(const LAS bf16x8*)(Kt + (2 * d0 + hi) * 1024 + (32 * kb + r32) * 16);
}
__device__ __forceinline__ void swa_tile(const LAS unsigned char* Kt, const LAS unsigned char* Vt, const LAS unsigned char* Kn, int mtype, const bf16x8 (&qf)[2][4], f32x16 (&o)[2][2], float (&mrun)[2], float (&lrun)[2], int lane, int abl = 0) {
    const int r32 = lane & 31, hi = lane >> 5; bf16x8 kf[4]; (void)Kn;
    const LAS unsigned char* vp = Vt + ((lane >> 4) & 1) * 32 + (lane & 3) * 8 + (4 * hi + ((lane & 15) >> 2)) * 64;
#pragma unroll
    for (int kb = 0; kb < 2; ++kb) {
        f32x16 s[2];
        swa_kload(Kt, kb, lane, kf);
        __builtin_amdgcn_s_setprio(1);
#pragma unroll
        for (int d0 = 0; d0 < 4; ++d0)
#pragma unroll
            for (int qt = 0; qt < 2; ++qt) {
                if (d0 == 0) { f32x16 z;
#pragma unroll
                    for (int r = 0; r < 16; ++r) z[r] = 0.f;
                    s[qt] = __builtin_amdgcn_mfma_f32_32x32x16_bf16(kf[0], qf[qt][0], z, 0, 0, 0); }
                else if (abl != 4) s[qt] = __builtin_amdgcn_mfma_f32_32x32x16_bf16(kf[d0], qf[qt][d0], s[qt], 0, 0, 0);
            }
        __builtin_amdgcn_s_setprio(0);
        __builtin_amdgcn_sched_barrier(0);
        s16x4 vlo[2][2], vhi[2][2];
#pragma unroll
        for (int dt = 0; dt < 2; ++dt)
#pragma unroll
            for (int sp = 0; sp < 2; ++sp) { vlo[dt][sp] = vtr(vp + dt * 4096 + (2 * kb + sp) * 1024); vhi[dt][sp] = vtr(vp + dt * 4096 + (2 * kb + sp) * 1024 + 512); }
        __builtin_amdgcn_sched_barrier(0);
        bf16x8 pf[2][2];
#pragma unroll
        for (int qt = 0; qt < 2; ++qt) {
            if (mtype != 0) {
                int thr = r32 + 32 * qt - 4 * hi - 32 * kb; asm volatile("" : "+v"(thr));
                if (mtype == 1) {
#pragma unroll
                    for (int r = 0; r < 16; ++r) { const int cc = (r & 3) + 8 * (r >> 2); if (cc < thr) s[qt][r] = -INFINITY; }
                } else {
#pragma unroll
                    for (int r = 0; r < 16; ++r) { const int cc = (r & 3) + 8 * (r >> 2); if (cc > thr) s[qt][r] = -INFINITY; }
                }
            }
            float rm = s[qt][0];
            if (abl != 1) {
#pragma unroll
            for (int r = 1; r < 16; ++r) rm = fmaxf(rm, s[qt][r]);
            }
            { auto rr = __builtin_amdgcn_permlane32_swap(__float_as_uint(rm), __float_as_uint(rm), false, false); rm = fmaxf(__uint_as_float(rr[0]), __uint_as_float(rr[1])); }
            if (__any(rm > mrun[qt] + SWA_THR)) {
                const float mx = fmaxf(mrun[qt], rm);
                const float alpha = __builtin_amdgcn_exp2f(mrun[qt] - mx);
                lrun[qt] *= alpha;
#pragma unroll
                for (int dt = 0; dt < 2; ++dt)
#pragma unroll
                    for (int r = 0; r < 16; ++r) o[dt][qt][r] *= alpha;
                mrun[qt] = mx;
            }
            const float mn = mrun[qt];
            float rs = 0.f;
            if (abl != 1) {
            f32x2 rs2 = {0.f, 0.f}; const f32x2 mn2 = {mn, mn};
#pragma unroll
            for (int r = 0; r < 16; r += 2) { const f32x2 dlt = (f32x2){s[qt][r], s[qt][r + 1]} - mn2; const f32x2 p = {__builtin_amdgcn_exp2f(dlt[0]), __builtin_amdgcn_exp2f(dlt[1])}; s[qt][r] = p[0]; s[qt][r + 1] = p[1]; rs2 = rs2 + p; }
            rs = rs2[0] + rs2[1];
            }
            lrun[qt] += rs;
#pragma unroll
            for (int sp = 0; sp < 2; ++sp) {
                u32x4 w; w.x = pk2(s[qt][8 * sp + 0], s[qt][8 * sp + 1]); w.y = pk2(s[qt][8 * sp + 2], s[qt][8 * sp + 3]);
                w.z = pk2(s[qt][8 * sp + 4], s[qt][8 * sp + 5]); w.w = pk2(s[qt][8 * sp + 6], s[qt][8 * sp + 7]);
                pf[qt][sp] = __builtin_bit_cast(bf16x8, w);
            }
        }
        __builtin_amdgcn_s_setprio(1);
#pragma unroll
        for (int dt = 0; dt < 2; ++dt)
#pragma unroll
            for (int sp = 0; sp < 2; ++sp) {
                const bf16x8 vf = (bf16x8){vlo[dt][sp][0], vlo[dt][sp][1], vlo[dt][sp][2], vlo[dt][sp][3], vhi[dt][sp][0], vhi[dt][sp][1], vhi[dt][sp][2], vhi[dt][sp][3]};
#pragma unroll
                for (int qt = 0; qt < 2; ++qt) if (abl != 2) o[dt][qt] = __builtin_amdgcn_mfma_f32_32x32x16_bf16(vf, pf[qt][sp], o[dt][qt], 0, 0, 0);
            }
        __builtin_amdgcn_s_setprio(0);
    }
}
struct SwaStg { u32x4 k, v; };
__device__ __forceinline__ void swa_stage_load(const Frame& F, const bf16* P, int grow, int kvh, SwaStg& s) {
    { const int key = 8 * F.wave + (F.lane & 7), ch = F.lane >> 3; s.k = *(const u32x4*)(P + (size_t)(grow + key) * NIN + PC_SK + kvh * 64 + ch * 8); }
    { const int key = 8 * F.wave + (F.lane >> 3), ch = F.lane & 7; s.v = *(const u32x4*)(P + (size_t)(grow + key) * NIN + PC_SV + kvh * 64 + ch * 8); }
}
__device__ __forceinline__ void swa_stage_offs(const Frame& F, int& kb, int& vb) {
    { const int key = 8 * F.wave + (F.lane & 7), ch = F.lane >> 3; kb = SWA_K + ch * 1024 + key * 16; }
    { const int key = 8 * F.wave + (F.lane >> 3), ch = F.lane & 7; vb = SWA_V + (ch >> 2) * 4096 + key * 64 + (ch & 3) * 16; }
    asm volatile("" : "+v"(kb), "+v"(vb));
}
__device__ __forceinline__ void swa_stage_store(const Frame& F, int ti, const SwaStg& s, int kb, int vb) {
    *(LAS u32x4*)(F.lds + kb + ti * 8192) = s.k; *(LAS u32x4*)(F.lds + vb + ti * 8192) = s.v;
}
__device__ __forceinline__ void swa_flash(const Frame& F, const CAS Args* a, int l, int abl = 0) {
    const bf16* P = (const bf16*)(F.ws + WS_P); bf16* MIX = (bf16*)(F.ws + WS_MIX);
    const int nunits = 256 + (l == 0 ? 8 : 0);
    const int lane = F.lane, r32 = lane & 31, hi = lane >> 5;
    const int nlat = (256 - F.vcu + F.G - 1) / F.G, c0 = F.G - 1 - F.vcu, nctx = (l == 0 && c0 < 8) ? (8 - c0 + F.G - 1) / F.G : 0;
    int skb, svb; swa_stage_offs(F, skb, svb);
    for (int it = 0; it < nlat + nctx; ++it) {
        const int u = it < nlat ? F.vcu + it * F.G : 256 + c0 + (it - nlat) * F.G;
        const bool latent = u < 256;
        const int b = latent ? (u >> 7) : ((u - 256) >> 2), kvh = latent ? ((u >> 6) & 1) : (((u - 256) >> 1) & 1), qb = latent ? (u & 63) : ((u - 256) & 1);
        const int q0 = qb * 128, g = F.wave >> 1, qs = F.wave & 1, hq = kvh * 4 + g;
        const int mrow0 = (latent ? b * SEQ : TL + b * LC) + q0 + 64 * qs;
        if (latent) {
            SwaStg st[6];
#pragma unroll
            for (int j = 0; j < 6; ++j) { const int ks = q0 - 128 + 64 * j, kc = ks < 0 ? 0 : (ks > SEQ - 64 ? SEQ - 64 : ks); swa_stage_load(F, P, b * SEQ + kc, kvh, st[j]); }
#pragma unroll
            for (int j = 0; j < 6; ++j) swa_stage_store(F, j, st[j], skb, svb);
        }
        bf16x8 qf[2][4];
#pragma unroll
        for (int qt = 0; qt < 2; ++qt)
#pragma unroll
            for (int d0 = 0; d0 < 4; ++d0) { if (abl != 7) qf[qt][d0] = *(const bf16x8*)(P + (size_t)(mrow0 + 32 * qt + r32) * NIN + PC_SQ + hq * 64 + 16 * d0 + 8 * hi); else qf[qt][d0] = (bf16x8){(short)lane, 1, 2, 3, 4, 5, 6, 7}; }
        f32x16 o[2][2];
#pragma unroll
        for (int dt = 0; dt < 2; ++dt)
#pragma unroll
            for (int qt = 0; qt < 2; ++qt)
#pragma unroll
                for (int r = 0; r < 16; ++r) o[dt][qt][r] = 0.f;
        const float sink2 = a->in[I_SINK][l * 8 + hq] * LOG2E;
        float mrun[2] = {sink2, sink2}, lrun[2] = {hi == 0 ? 1.f : 0.f, hi == 0 ? 1.f : 0.f};
        if (latent) {
            LDS_BARRIER();
            if (F.wave >= 4) __builtin_amdgcn_s_sleep(SWA_STAGGER);
            { int jf = qs; while (q0 - 128 + 64 * jf < 0) ++jf;
              (void)jf;
#pragma unroll 1
              for (int tt = 0; tt < 5; ++tt) { const int j = qs + tt, ks = q0 - 128 + 64 * j;
                  if (ks >= 0 && ks < SEQ && abl != 8) { const int jn = (j + 1 < 6) ? j + 1 : j;
                      swa_tile(F.lds + SWA_K + j * 8192, F.lds + SWA_V + j * 8192, F.lds + SWA_K + jn * 8192, tt == 0 ? 1 : (tt == 4 ? 2 : 0), qf, o, mrun, lrun, lane, abl); } } }
            LDS_BARRIER();
        }
#pragma unroll 1
        for (int j = 0; j < 4; ++j) if (abl != 3) { SwaStg st; swa_stage_load(F, P, TL + b * LC + 64 * j, kvh, st); swa_stage_store(F, j, st, skb, svb); }
        LDS_BARRIER();
        if (F.wave >= 4) __builtin_amdgcn_s_sleep(SWA_STAGGER);
        {
#pragma unroll 1
          for (int j = 0; j < 4; ++j) if (abl != 8) swa_tile(F.lds + SWA_K + j * 8192, F.lds + SWA_V + j * 8192, F.lds + SWA_K + (j < 3 ? j + 1 : j) * 8192, 0, qf, o, mrun, lrun, lane, abl); }
        LDS_BARRIER();
        LAS unsigned char* stg = F.lds + qs * (64 * 272) + g * 64;
#pragma unroll
        for (int qt = 0; qt < 2; ++qt) {
            float lt = lrun[qt];
            { auto rr = __builtin_amdgcn_permlane32_swap(__float_as_uint(lt), __float_as_uint(lt), false, false); lt = __uint_as_float(rr[0]) + __uint_as_float(rr[1]); }
            const float is = MIX_SCALE / lt;
#pragma unroll
            for (int dt = 0; dt < 2; ++dt)
#pragma unroll
                for (int rg = 0; rg < 4; ++rg)
                    *(LAS unsigned*)(stg + (32 * qt + r32) * 272 + 32 * dt + 8 * rg + 4 * hi) = pk4_fp8(o[dt][qt][4 * rg] * is, o[dt][qt][4 * rg + 1] * is, o[dt][qt][4 * rg + 2] * is, o[dt][qt][4 * rg + 3] * is);
        }
        LDS_BARRIER();
        if (abl != 7) {
            int le = lane; asm volatile("" : "+v"(le));
#pragma unroll
            for (int i = 0; i < 4; ++i) { const int p = i * 256 + g * 64 + le, row = p >> 4, pc = p & 15;
                const u32x4 v = *(const LAS u32x4*)(F.lds + qs * (64 * 272) + row * 272 + pc * 16);
                *(u32x4*)((unsigned char*)MIX + (size_t)(mrow0 + row) * D + 512 + kvh * 256 + pc * 16) = v; }
        }
        LDS_BARRIER();
    }
}

constexpr size_t WS_US = WS_GL, WS_USC = WS_GL + 32 * MiB, WS_DEC = 7 * MiB;
static_assert(WS_USC + (size_t)16 * 4 * 8192 * 2 <= WS_END && WS_DEC + (size_t)16 * 132 * 64 * 4 <= WS_WIN, "ws map (gla)");
constexpr int GL_V = 0, GL_M0 = 16384, GL_MSZ = 64 * 72 * 2, GL_RED = GL_M0 + 4 * GL_MSZ, GL_STG = GL_RED + 1024;
__device__ __forceinline__ float wave_scan_incl(float v) {
    v += DPP_F(v, 0x111, 0xF); v += DPP_F(v, 0x112, 0xF); v += DPP_F(v, 0x114, 0xF); v += DPP_F(v, 0x118, 0xF);
    v += DPP_F(v, 0x142, 0xA); v += DPP_F(v, 0x143, 0xC); return v;
}
__device__ __forceinline__ float lane63(float v) { return __builtin_bit_cast(float, __builtin_amdgcn_readlane(__builtin_bit_cast(int, v), 63)); }
__device__ __forceinline__ void unpack8(const u32x4 w, float (&f)[8]) { f[0] = bflo(w.x); f[1] = bfhi(w.x); f[2] = bflo(w.y); f[3] = bfhi(w.y); f[4] = bflo(w.z); f[5] = bfhi(w.z); f[6] = bflo(w.w); f[7] = bfhi(w.w); }
__device__ __forceinline__ void gla_stage_v(const Frame& F, const bf16* P, int m0, int h) {
#pragma unroll
    for (int i = 0; i < 2; ++i) { const int p = F.tid + 512 * i, t = p >> 4, ch = p & 15;
        const u32x4 v = *(const u32x4*)(P + (size_t)(m0 + t) * NIN + PC_V + h * 128 + ch * 8);
        *(LAS u32x4*)(F.lds + GL_V + (ch >> 2) * 4096 + t * 64 + (ch & 3) * 16) = v; }
}
struct GlaPre { u32x4 laf, lab, kk, qq, v0, v1; };
__device__ __forceinline__ void gla_pre_load(const Frame& F, const bf16* P, int m0, int h, bool want_q, GlaPre& p) {
    const bf16* row = P + (size_t)(m0 + F.lane) * NIN + h * 64 + 8 * F.wave;
    p.laf = *(const u32x4*)(row + PC_GF); p.lab = *(const u32x4*)(row + PC_GB); p.kk = *(const u32x4*)(row + PC_K);
    if (want_q) p.qq = *(const u32x4*)(row + PC_Q);
    { const int q0 = F.tid, q1 = F.tid + 512;
      p.v0 = *(const u32x4*)(P + (size_t)(m0 + (q0 >> 4)) * NIN + PC_V + h * 128 + (q0 & 15) * 8);
      p.v1 = *(const u32x4*)(P + (size_t)(m0 + (q1 >> 4)) * NIN + PC_V + h * 128 + (q1 & 15) * 8); }
}
__device__ __forceinline__ void gla_pre_stage_v(const Frame& F, const GlaPre& p) {
    { const int q = F.tid, t = q >> 4, ch = q & 15; *(LAS u32x4*)(F.lds + GL_V + (ch >> 2) * 4096 + t * 64 + (ch & 3) * 16) = p.v0; }
    { const int q = F.tid + 512, t = q >> 4, ch = q & 15; *(LAS u32x4*)(F.lds + GL_V + (ch >> 2) * 4096 + t * 64 + (ch & 3) * 16) = p.v1; }
}
__device__ __forceinline__ void gla_unit_decode(int u, int& m0, int& h, int& sf, int& n, bool& latent) {
    latent = u < 1024; const int cc = u - 1024;
    const int b = latent ? (u >> 9) : (cc >> 4); h = latent ? ((u >> 7) & 3) : ((cc >> 2) & 3); n = latent ? (u & 127) : (cc & 3);
    m0 = latent ? b * SEQ + 64 * n : TL + b * LC + 64 * n; sf = (b * 4 + h) * 2;
}
__device__ __forceinline__ void gla_g1_unit(const Frame& F, const GlaPre& pre, bf16* Uf, bf16* Ub, float* decf, float* decb) {
    const int w = F.wave, t = F.lane, c = t & 31, hi = t >> 5;
    float laf[8], lab[8], kk[8];
    unpack8(pre.laf, laf); unpack8(pre.lab, lab); unpack8(pre.kk, kk);
    gla_pre_stage_v(F, pre);
    LAS bf16* KOF = (LAS bf16*)(F.lds + GL_M0); LAS bf16* KOB = (LAS bf16*)(F.lds + GL_M0 + GL_MSZ);
#pragma unroll
    for (int i = 0; i < 8; ++i) {
        const float incf = wave_scan_incl(laf[i]), tf = lane63(incf), incb = wave_scan_incl(lab[i]), tb = lane63(incb);
        KOF[(8 * w + i) * 72 + t] = (bf16)f2bf(kk[i] * __expf(tf - incf));
        KOB[(8 * w + i) * 72 + t] = (bf16)f2bf(kk[i] * __expf(incb - lab[i]));
        if (t == 0) { decf[8 * w + i] = __expf(tf); decb[8 * w + i] = __expf(tb); }
    }
    LDS_BARRIER();
    const int dir = w >> 2, dvt = w & 3;
    const LAS unsigned char* vp = F.lds + GL_V + dvt * 4096 + ((t >> 4) & 1) * 32 + (t & 3) * 8 + ((t & 15) >> 2) * 64 + hi * 512;
    const LAS unsigned char* kb = F.lds + GL_M0 + dir * GL_MSZ + (c * 72 + 8 * hi) * 2;
    f32x16 acc[2];
#pragma unroll
    for (int j = 0; j < 2; ++j)
#pragma unroll
        for (int r = 0; r < 16; ++r) acc[j][r] = 0.f;
#pragma unroll
    for (int sp = 0; sp < 4; ++sp) {
        const s16x4 lo = vtr(vp + sp * 1024), hi4 = vtr(vp + sp * 1024 + 256);
        const bf16x8 vf = (bf16x8){lo[0], lo[1], lo[2], lo[3], hi4[0], hi4[1], hi4[2], hi4[3]};
#pragma unroll
        for (int j = 0; j < 2; ++j) { const bf16x8 kf = *(const LAS bf16x8*)(kb + j * 32 * 144 + sp * 32); acc[j] = __builtin_amdgcn_mfma_f32_32x32x16_bf16(kf, vf, acc[j], 0, 0, 0); }
    }
    bf16* U = dir ? Ub : Uf;
#pragma unroll
    for (int j = 0; j < 2; ++j) {
        u32x4 w0, w1;
        w0.x = pk2(acc[j][0], acc[j][1]); w0.y = pk2(acc[j][2], acc[j][3]); w0.z = pk2(acc[j][4], acc[j][5]); w0.w = pk2(acc[j][6], acc[j][7]);
        w1.x = pk2(acc[j][8], acc[j][9]); w1.y = pk2(acc[j][10], acc[j][11]); w1.z = pk2(acc[j][12], acc[j][13]); w1.w = pk2(acc[j][14], acc[j][15]);
        u32x4* up = (u32x4*)(U + ((j * 4 + dvt) * 64 + t) * 16);
        up[0] = w0; up[1] = w1;
    }
    LDS_BARRIER();
}
__device__ __forceinline__ void g1_stage_a(const Frame& F, LAS unsigned char* lb, const GlaPre& pre, float* decf, float* decb) {
    const int w = F.wave, t = F.lane, c = t & 31, hi = t >> 5;
    float laf[8], lab[8], kk[8];
    unpack8(pre.laf, laf); unpack8(pre.lab, lab); unpack8(pre.kk, kk);
    { const int q = F.tid, t_ = q >> 4, ch = q & 15; *(LAS u32x4*)(lb + GL_V + (ch >> 2) * 4096 + t_ * 64 + (ch & 3) * 16) = pre.v0; }
    { const int q = F.tid + 512, t_ = q >> 4, ch = q & 15; *(LAS u32x4*)(lb + GL_V + (ch >> 2) * 4096 + t_ * 64 + (ch & 3) * 16) = pre.v1; }
    LAS bf16* KOF = (LAS bf16*)(lb + GL_M0); LAS bf16* KOB = (LAS bf16*)(lb + GL_M0 + GL_MSZ);
#pragma unroll
    for (int i = 0; i < 8; ++i) {
        const float incf = wave_scan_incl(laf[i]), tf = lane63(incf), incb = wave_scan_incl(lab[i]), tb = lane63(incb);
        KOF[(8 * w + i) * 72 + t] = (bf16)f2bf(kk[i] * __expf(tf - incf));
        KOB[(8 * w + i) * 72 + t] = (bf16)f2bf(kk[i] * __expf(incb - lab[i]));
        if (t == 0) { decf[8 * w + i] = __expf(tf); decb[8 * w + i] = __expf(tb); }
    }
}
__device__ __forceinline__ void g1_stage_b(const Frame& F, LAS unsigned char* lb, bf16* Uf, bf16* Ub) {
    const int w = F.wave, t = F.lane, c = t & 31, hi = t >> 5;
    const int dir = w >> 2, dvt = w & 3;
    const LAS unsigned char* vp = lb + GL_V + dvt * 4096 + ((t >> 4) & 1) * 32 + (t & 3) * 8 + ((t & 15) >> 2) * 64 + hi * 512;
    const LAS unsigned char* kb = lb + GL_M0 + dir * GL_MSZ + (c * 72 + 8 * hi) * 2;
    f32x16 acc[2];
#pragma unroll
    for (int j = 0; j < 2; ++j)
#pragma unroll
        for (int r = 0; r < 16; ++r) acc[j][r] = 0.f;
#pragma unroll
    for (int sp = 0; sp < 4; ++sp) {
        const s16x4 lo = vtr(vp + sp * 1024), hi4 = vtr(vp + sp * 1024 + 256);
        const bf16x8 vf = (bf16x8){lo[0], lo[1], lo[2], lo[3], hi4[0], hi4[1], hi4[2], hi4[3]};
#pragma unroll
        for (int j = 0; j < 2; ++j) { const bf16x8 kf = *(const LAS bf16x8*)(kb + j * 32 * 144 + sp * 32); acc[j] = __builtin_amdgcn_mfma_f32_32x32x16_bf16(kf, vf, acc[j], 0, 0, 0); }
    }
    bf16* U = dir ? Ub : Uf;
#pragma unroll
    for (int j = 0; j < 2; ++j) {
        u32x4 w0, w1;
        w0.x = pk2(acc[j][0], acc[j][1]); w0.y = pk2(acc[j][2], acc[j][3]); w0.z = pk2(acc[j][4], acc[j][5]); w0.w = pk2(acc[j][6], acc[j][7]);
        w1.x = pk2(acc[j][8], acc[j][9]); w1.y = pk2(acc[j][10], acc[j][11]); w1.z = pk2(acc[j][12], acc[j][13]); w1.w = pk2(acc[j][14], acc[j][15]);
        u32x4* up = (u32x4*)(U + ((j * 4 + dvt) * 64 + t) * 16);
        up[0] = w0; up[1] = w1;
    }
}
constexpr int GL_SET1 = 63488;
__device__ __forceinline__ void gla_g1(const Frame& F0, int l) {
    Frame F = F0; { int l_; asm volatile("v_mbcnt_lo_u32_b32 %0, -1, 0\n\tv_mbcnt_hi_u32_b32 %0, -1, %0" : "=v"(l_)); F.lane = l_; F.tid = F.wave * 64 + l_; }
    const bf16* P = (const bf16*)(F.ws + WS_P);
    bf16* US = (bf16*)(F.ws + WS_US); bf16* USC = (bf16*)(F.ws + WS_USC); float* DEC = (float*)(F.ws + WS_DEC);
    GlaPre pre, nx; bool par = false;
    const int E = (l == 0 && F.G >= 16) ? F.G - 8 : F.G;
    if (F.vcu >= E || F.vcu >= 1056) return;
    LAS unsigned char* const im0 = F.lds; LAS unsigned char* const im1 = F.lds + GL_SET1;
    int m0, h, sf, n; bool latent;
    gla_unit_decode(F.vcu, m0, h, sf, n, latent); gla_pre_load(F, P, m0, h, false, pre);
    if (F.vcu + E < 1056) { int m1, h1, s1, n1; bool l1; gla_unit_decode(F.vcu + E, m1, h1, s1, n1, l1); gla_pre_load(F, P, m1, h1, false, nx); }
    { const int nd = latent ? n : 128 + n; g1_stage_a(F, im0, pre, DEC + ((size_t)sf * 132 + nd) * 64, DEC + ((size_t)(sf + 1) * 132 + nd) * 64); }
    pre = nx;
    for (int u = F.vcu; u < 1056; u += E) {
        const bool has1 = u + E < 1056, has2 = u + 2 * E < 1056;
        gla_unit_decode(u, m0, h, sf, n, latent);
        if (has2) { int m2, h2, s2, n2; bool l2; gla_unit_decode(u + 2 * E, m2, h2, s2, n2, l2); gla_pre_load(F, P, m2, h2, false, nx); }
        bf16* Uf = latent ? US + ((size_t)sf * 128 + n) * 8192 : USC + ((size_t)sf * 4 + n) * 8192;
        bf16* Ub = latent ? US + ((size_t)(sf + 1) * 128 + n) * 8192 : USC + ((size_t)(sf + 1) * 4 + n) * 8192;
        LDS_BARRIER();
        g1_stage_b(F, par ? im1 : im0, Uf, Ub);
        if (has1) { int m1, h1, s1, n1; bool l1; gla_unit_decode(u + E, m1, h1, s1, n1, l1); const int nd = l1 ? n1 : 128 + n1;
            g1_stage_a(F, par ? im0 : im1, pre, DEC + ((size_t)s1 * 132 + nd) * 64, DEC + ((size_t)(s1 + 1) * 132 + nd) * 64); }
        pre = nx; par = !par;
    }
    LDS_BARRIER();
}
constexpr size_t WS_SS = WS_H, WS_SSC = WS_H + 32 * MiB;
static_assert(WS_SSC + (size_t)16 * 4 * 8192 * 2 <= WS_P, "ws map (gla states)");
__device__ __forceinline__ void gla_scan(const Frame& F) {
    for (int wb = F.vcu * 4 * 64; wb < 16 * 4096; wb += F.G * 4 * 64) {
        const int seq = __builtin_amdgcn_readfirstlane(wb >> 12), dir = seq & 1;
        { const char* dg = (const char*)(F.ws + WS_DEC) + (size_t)seq * 132 * 256;
          for (int i = F.tid; i < 132 * 256 / 16; i += NWAVES * 64) *(LAS u32x4*)(F.lds + 16 * i) = *(const u32x4*)(dg + 16 * i); }
        LDS_BARRIER();
        if (F.wave < 4) {
        const int w0 = wb + F.wave * 64;
        const int ew = __builtin_amdgcn_readfirstlane((w0 & 4095) * 2);
        const unsigned voff = (unsigned)F.lane * 4u;
        unsigned doff;
        { const int e = ew + 2 * F.lane, r = e & 15, ln = (e >> 4) & 63, dkt = e >> 12; doff = (unsigned)(32 * dkt + (r & 3) + 8 * (r >> 2) + 4 * (ln >> 5)) * 4u; }
        const LAS unsigned char* decl = F.lds + doff;
        float s0 = 0.f, s1 = 0.f;
        { const char* ub = (const char*)(F.ws + WS_USC) + ((size_t)seq * 4 * 8192 + ew) * 2; char* sb = (char*)(F.ws + WS_SSC) + ((size_t)seq * 4 * 8192 + ew) * 2;
          unsigned u[4]; f32x2 d[4];
#pragma unroll
          for (int i = 0; i < 4; ++i) { const int n = dir ? 3 - i : i; u[i] = *(const unsigned*)(ub + (size_t)n * 16384 + voff); d[i] = *(const LAS f32x2*)(decl + (128 + n) * 256); }
#pragma unroll
          for (int i = 0; i < 4; ++i) { const int n = dir ? 3 - i : i; *(unsigned*)(sb + (size_t)n * 16384 + voff) = pk2(s0, s1); s0 = d[i][0] * s0 + bflo(u[i]); s1 = d[i][1] * s1 + bfhi(u[i]); } }
        const long stride = dir ? -16384 : 16384; const int dstride = dir ? -256 : 256;
        const char* ub = (const char*)(F.ws + WS_US) + ((size_t)seq * 128 * 8192 + ew) * 2 + (dir ? (size_t)127 * 16384 : 0);
        char* sb = (char*)(F.ws + WS_SS) + ((size_t)seq * 128 * 8192 + ew) * 2 + (dir ? (size_t)127 * 16384 : 0);
        const LAS unsigned char* db = decl + (dir ? 127 * 256 : 0);
#pragma unroll 1
        for (int i0 = 0; i0 < 128; i0 += 32) {
            unsigned u[32];
#pragma unroll
            for (int j = 0; j < 32; ++j) u[j] = __builtin_nontemporal_load((const unsigned*)(ub + j * stride + voff));
#pragma unroll
            for (int j = 0; j < 32; ++j) { const f32x2 d = *(const LAS f32x2*)(db + j * dstride);
                *(unsigned*)(sb + j * stride + voff) = pk2(s0, s1); s0 = d[0] * s0 + bflo(u[j]); s1 = d[1] * s1 + bfhi(u[j]); }
            ub += 32 * stride; sb += 32 * stride; db += 32 * dstride;
        }
        }
        LDS_BARRIER();
    }
}
__device__ __forceinline__ void gla_g3_unit(const Frame& F, const CAS Args* a, int l, const bf16* P, int m0, int h, const bf16* Sf, const bf16* Sb, bf16* MIX, const GlaPre& pre, unsigned* publish = nullptr) {
    const int w = F.wave, t = F.lane, c = t & 31, hi = t >> 5;
    bf16x8 sfr[4], sbr[4]; u32x2 gwv[4]; f32x4 nwv[4];
    { const int dvt_ = w >> 1, tt_ = w & 1;
#pragma unroll
      for (int kd = 0; kd < 4; ++kd) { const size_t off = (size_t)(((kd >> 1) * 4 + dvt_) * 64 + t) * 16 + 8 * (kd & 1); sfr[kd] = *(const bf16x8*)(Sf + off); sbr[kd] = *(const bf16x8*)(Sb + off); }
#pragma unroll
      for (int rg = 0; rg < 4; ++rg) { const int dv = 32 * dvt_ + 8 * rg + 4 * hi;
          gwv[rg] = *(const u32x2*)(P + (size_t)(m0 + 32 * tt_ + c) * NIN + PC_G + h * 128 + dv); nwv[rg] = *(const f32x4*)(a->in[I_GLANORM] + l * 512 + h * 128 + dv); } }
    {
        float laf[8], lab[8], kk[8], qq[8];
        unpack8(pre.laf, laf); unpack8(pre.lab, lab); unpack8(pre.kk, kk); unpack8(pre.qq, qq);
        gla_pre_stage_v(F, pre);
        float qf[8], kf[8], qb[8], kb[8];
#pragma unroll
        for (int i = 0; i < 8; ++i) {
            const float bf = wave_scan_incl(laf[i]), incb = wave_scan_incl(lab[i]), bb = lane63(incb) - incb + lab[i];
            qf[i] = qq[i] * __expf(bf); kf[i] = kk[i] * __expf(-bf); qb[i] = qq[i] * __expf(bb); kb[i] = kk[i] * __expf(-bb);
        }
        LAS unsigned char* mb = F.lds + GL_M0 + (t * 72 + 8 * w) * 2;
        u32x4 o;
        o.x = pk2(qf[0], qf[1]); o.y = pk2(qf[2], qf[3]); o.z = pk2(qf[4], qf[5]); o.w = pk2(qf[6], qf[7]); *(LAS u32x4*)(mb) = o;
        o.x = pk2(kf[0], kf[1]); o.y = pk2(kf[2], kf[3]); o.z = pk2(kf[4], kf[5]); o.w = pk2(kf[6], kf[7]); *(LAS u32x4*)(mb + GL_MSZ) = o;
        o.x = pk2(qb[0], qb[1]); o.y = pk2(qb[2], qb[3]); o.z = pk2(qb[4], qb[5]); o.w = pk2(qb[6], qb[7]); *(LAS u32x4*)(mb + 2 * GL_MSZ) = o;
        o.x = pk2(kb[0], kb[1]); o.y = pk2(kb[2], kb[3]); o.z = pk2(kb[4], kb[5]); o.w = pk2(kb[6], kb[7]); *(LAS u32x4*)(mb + 3 * GL_MSZ) = o;
    }
    LDS_BARRIER();
    const int dvt = w >> 1, tt = w & 1;
    bf16x8 qfB[4], qbB[4], qfP[4], qbP[4];
    { const LAS unsigned char* qp = F.lds + GL_M0 + ((32 * tt + c) * 72 + 8 * hi) * 2;
#pragma unroll
      for (int kd = 0; kd < 4; ++kd) { qfB[kd] = *(const LAS bf16x8*)(qp + kd * 32); qbB[kd] = *(const LAS bf16x8*)(qp + 2 * GL_MSZ + kd * 32); }
      const LAS unsigned char* pp = F.lds + GL_M0 + ((32 * tt + c) * 72 + 4 * hi) * 2;
#pragma unroll
      for (int kd = 0; kd < 4; ++kd) {
          const u32x2 a0 = *(const LAS u32x2*)(pp + kd * 32), a1 = *(const LAS u32x2*)(pp + kd * 32 + 16);
          const u32x2 b0 = *(const LAS u32x2*)(pp + 2 * GL_MSZ + kd * 32), b1 = *(const LAS u32x2*)(pp + 2 * GL_MSZ + kd * 32 + 16);
          qfP[kd] = __builtin_bit_cast(bf16x8, (u32x4){a0.x, a0.y, a1.x, a1.y}); qbP[kd] = __builtin_bit_cast(bf16x8, (u32x4){b0.x, b0.y, b1.x, b1.y});
      } }
    bf16x8 pfr[2][2];
#pragma unroll
    for (int st = 0; st < 2; ++st) {
        const LAS unsigned char* kp = F.lds + GL_M0 + GL_MSZ + ((32 * st + c) * 72 + 8 * hi) * 2;
        f32x16 xf, xb;
#pragma unroll
        for (int r = 0; r < 16; ++r) { xf[r] = 0.f; xb[r] = 0.f; }
        const bool needF = st <= tt, needB = st >= tt;
        if (needF) {
#pragma unroll
            for (int kd = 0; kd < 4; ++kd) xf = __builtin_amdgcn_mfma_f32_32x32x16_bf16(*(const LAS bf16x8*)(kp + kd * 32), qfB[kd], xf, 0, 0, 0);
        }
        if (needB) {
#pragma unroll
            for (int kd = 0; kd < 4; ++kd) xb = __builtin_amdgcn_mfma_f32_32x32x16_bf16(*(const LAS bf16x8*)(kp + 2 * GL_MSZ + kd * 32), qbB[kd], xb, 0, 0, 0);
        }
        if (st == tt) {
            int thr = c - 4 * hi; asm volatile("" : "+v"(thr));
#pragma unroll
            for (int r = 0; r < 16; ++r) { const int cc = (r & 3) + 8 * (r >> 2); xf[r] = (cc <= thr ? xf[r] : 0.f) + (cc >= thr ? xb[r] : 0.f); }
        } else {
#pragma unroll
            for (int r = 0; r < 16; ++r) xf[r] += xb[r];
        }
#pragma unroll
        for (int sp = 0; sp < 2; ++sp) {
            u32x4 wv; wv.x = pk2(xf[8 * sp + 0], xf[8 * sp + 1]); wv.y = pk2(xf[8 * sp + 2], xf[8 * sp + 3]);
            wv.z = pk2(xf[8 * sp + 4], xf[8 * sp + 5]); wv.w = pk2(xf[8 * sp + 6], xf[8 * sp + 7]);
            pfr[st][sp] = __builtin_bit_cast(bf16x8, wv);
        }
    }
    f32x16 o;
#pragma unroll
    for (int r = 0; r < 16; ++r) o[r] = 0.f;
    { const LAS unsigned char* vp = F.lds + GL_V + dvt * 4096 + ((t >> 4) & 1) * 32 + (t & 3) * 8 + (4 * hi + ((t & 15) >> 2)) * 64;
#pragma unroll
      for (int ks = 0; ks < 4; ++ks) {
          const s16x4 lo = vtr(vp + ks * 1024), hi4 = vtr(vp + ks * 1024 + 512);
          const bf16x8 vf = (bf16x8){lo[0], lo[1], lo[2], lo[3], hi4[0], hi4[1], hi4[2], hi4[3]};
          o = __builtin_amdgcn_mfma_f32_32x32x16_bf16(vf, pfr[ks >> 1][ks & 1], o, 0, 0, 0);
      } }
#pragma unroll
    for (int kd = 0; kd < 4; ++kd) {
        o = __builtin_amdgcn_mfma_f32_32x32x16_bf16(sfr[kd], qfP[kd], o, 0, 0, 0);
        o = __builtin_amdgcn_mfma_f32_32x32x16_bf16(sbr[kd], qbP[kd], o, 0, 0, 0);
    }
    float ssq = 0.f;
#pragma unroll
    for (int r = 0; r < 16; ++r) ssq += o[r] * o[r];
    { auto rr = __builtin_amdgcn_permlane32_swap(__float_as_uint(ssq), __float_as_uint(ssq), false, false); ssq = __uint_as_float(rr[0]) + __uint_as_float(rr[1]); }
    LAS float* red = (LAS float*)(F.lds + GL_RED);
    if (hi == 0) red[dvt * 64 + 32 * tt + c] = ssq;
    LDS_BARRIER();
    const float tot = (red[32 * tt + c] + red[64 + 32 * tt + c]) + (red[128 + 32 * tt + c] + red[192 + 32 * tt + c]);
    const float rstd = 1.0f / sqrtf(tot * (1.0f / 128.0f) + EPS);
    LAS unsigned char* stg = F.lds + GL_STG + w * 1024;
#pragma unroll
    for (int rg = 0; rg < 4; ++rg) {
        const u32x2 gw = gwv[rg]; const f32x4 nw = nwv[rg];
        const float g0 = bflo(gw.x), g1 = bfhi(gw.x), g2 = bflo(gw.y), g3 = bfhi(gw.y);
        const float rs = rstd * MIX_SCALE;
        *(LAS unsigned*)(stg + c * 32 + 8 * rg + 4 * hi) = pk4_fp8(o[4 * rg] * rs * nw[0] * silu_f(g0), o[4 * rg + 1] * rs * nw[1] * silu_f(g1), o[4 * rg + 2] * rs * nw[2] * silu_f(g2), o[4 * rg + 3] * rs * nw[3] * silu_f(g3));
    }
    LDS_WAIT();
    { const int row = t >> 1, hf = t & 1;
      const u32x4 v = *(const LAS u32x4*)(stg + row * 32 + hf * 16);
      unsigned char* dst = (unsigned char*)MIX + (size_t)(m0 + 32 * tt + row) * D + h * 128 + 32 * dvt + hf * 16;
      if (publish) { st16_wt(dst, v); asm volatile("s_waitcnt vmcnt(0)" ::: "memory"); if (t == 0) __hip_atomic_fetch_add(publish, 1u, __ATOMIC_RELAXED, __HIP_MEMORY_SCOPE_AGENT); }
      else *(u32x4*)dst = v; }
    LDS_BARRIER();
}
struct G3Early { bf16x8 sf[4], sb[4]; };
struct G3Gate { u32x2 gw[4]; f32x4 nw[4]; };
__device__ __forceinline__ void g3_early(const Frame& F, const bf16* Sf, const bf16* Sb, G3Early& e) {
    const int t = F.lane, dvt_ = F.wave >> 1;
#pragma unroll
    for (int kd = 0; kd < 4; ++kd) { const size_t off = (size_t)(((kd >> 1) * 4 + dvt_) * 64 + t) * 16 + 8 * (kd & 1); e.sf[kd] = *(const bf16x8*)(Sf + off); e.sb[kd] = *(const bf16x8*)(Sb + off); }
}
__device__ __forceinline__ void g3_gate(const Frame& F, const CAS Args* a, int l, const bf16* P, int m0, int h, G3Gate& g) {
    const int t = F.lane, c = t & 31, hi = t >> 5, dvt_ = F.wave >> 1, tt_ = F.wave & 1;
#pragma unroll
    for (int rg = 0; rg < 4; ++rg) { const int dv = 32 * dvt_ + 8 * rg + 4 * hi;
        g.gw[rg] = *(const u32x2*)(P + (size_t)(m0 + 32 * tt_ + c) * NIN + PC_G + h * 128 + dv); g.nw[rg] = *(const f32x4*)(a->in[I_GLANORM] + l * 512 + h * 128 + dv); }
}
__device__ __forceinline__ void g3_stage_a(const Frame& F, LAS unsigned char* lb, const GlaPre& pre) {
    const int w = F.wave, t = F.lane, c = t & 31, hi = t >> 5;
    {
        float laf[8], lab[8], kk[8], qq[8];
        unpack8(pre.laf, laf); unpack8(pre.lab, lab); unpack8(pre.kk, kk); unpack8(pre.qq, qq);
        { const int q = F.tid, t_ = q >> 4, ch = q & 15; *(LAS u32x4*)(lb + GL_V + (ch >> 2) * 4096 + t_ * 64 + (ch & 3) * 16) = pre.v0; }
        { const int q = F.tid + 512, t_ = q >> 4, ch = q & 15; *(LAS u32x4*)(lb + GL_V + (ch >> 2) * 4096 + t_ * 64 + (ch & 3) * 16) = pre.v1; }
        float qf[8], kf[8], qb[8], kb[8];
#pragma unroll
        for (int i = 0; i < 8; ++i) {
            const float bf = wave_scan_incl(laf[i]), incb = wave_scan_incl(lab[i]), bb = lane63(incb) - incb + lab[i];
            qf[i] = qq[i] * __expf(bf); kf[i] = kk[i] * __expf(-bf); qb[i] = qq[i] * __expf(bb); kb[i] = kk[i] * __expf(-bb);
        }
        LAS unsigned char* mb = lb + GL_M0 + (t * 72 + 8 * w) * 2;
        u32x4 o;
        o.x = pk2(qf[0], qf[1]); o.y = pk2(qf[2], qf[3]); o.z = pk2(qf[4], qf[5]); o.w = pk2(qf[6], qf[7]); *(LAS u32x4*)(mb) = o;
        o.x = pk2(kf[0], kf[1]); o.y = pk2(kf[2], kf[3]); o.z = pk2(kf[4], kf[5]); o.w = pk2(kf[6], kf[7]); *(LAS u32x4*)(mb + GL_MSZ) = o;
        o.x = pk2(qb[0], qb[1]); o.y = pk2(qb[2], qb[3]); o.z = pk2(qb[4], qb[5]); o.w = pk2(qb[6], qb[7]); *(LAS u32x4*)(mb + 2 * GL_MSZ) = o;
        o.x = pk2(kb[0], kb[1]); o.y = pk2(kb[2], kb[3]); o.z = pk2(kb[4], kb[5]); o.w = pk2(kb[6], kb[7]); *(LAS u32x4*)(mb + 3 * GL_MSZ) = o;
    }
}
__device__ __forceinline__ void g3_stage_b(const Frame& F, LAS unsigned char* lb, const G3Early& e, f32x16& o) {
    const int w = F.wave, t = F.lane, c = t & 31, hi = t >> 5;
    const int dvt = w >> 1, tt = w & 1;
    bf16x8 qfB[4], qbB[4], qfP[4], qbP[4];
    { const LAS unsigned char* qp = lb + GL_M0 + ((32 * tt + c) * 72 + 8 * hi) * 2;
#pragma unroll
      for (int kd = 0; kd < 4; ++kd) { qfB[kd] = *(const LAS bf16x8*)(qp + kd * 32); qbB[kd] = *(const LAS bf16x8*)(qp + 2 * GL_MSZ + kd * 32); }
      const LAS unsigned char* pp = lb + GL_M0 + ((32 * tt + c) * 72 + 4 * hi) * 2;
#pragma unroll
      for (int kd = 0; kd < 4; ++kd) {
          const u32x2 a0 = *(const LAS u32x2*)(pp + kd * 32), a1 = *(const LAS u32x2*)(pp + kd * 32 + 16);
          const u32x2 b0 = *(const LAS u32x2*)(pp + 2 * GL_MSZ + kd * 32), b1 = *(const LAS u32x2*)(pp + 2 * GL_MSZ + kd * 32 + 16);
          qfP[kd] = __builtin_bit_cast(bf16x8, (u32x4){a0.x, a0.y, a1.x, a1.y}); qbP[kd] = __builtin_bit_cast(bf16x8, (u32x4){b0.x, b0.y, b1.x, b1.y});
      } }
    bf16x8 pfr[2][2];
#pragma unroll
    for (int st = 0; st < 2; ++st) {
        const LAS unsigned char* kp = lb + GL_M0 + GL_MSZ + ((32 * st + c) * 72 + 8 * hi) * 2;
        f32x16 xf, xb;
#pragma unroll
        for (int r = 0; r < 16; ++r) { xf[r] = 0.f; xb[r] = 0.f; }
        const bool needF = st <= tt, needB = st >= tt;
        if (needF) {
#pragma unroll
            for (int kd = 0; kd < 4; ++kd) xf = __builtin_amdgcn_mfma_f32_32x32x16_bf16(*(const LAS bf16x8*)(kp + kd * 32), qfB[kd], xf, 0, 0, 0);
        }
        if (needB) {
#pragma unroll
            for (int kd = 0; kd < 4; ++kd) xb = __builtin_amdgcn_mfma_f32_32x32x16_bf16(*(const LAS bf16x8*)(kp + 2 * GL_MSZ + kd * 32), qbB[kd], xb, 0, 0, 0);
        }
        if (st == tt) {
            int thr = c - 4 * hi; asm volatile("" : "+v"(thr));
#pragma unroll
            for (int r = 0; r < 16; ++r) { const int cc = (r & 3) + 8 * (r >> 2); xf[r] = (cc <= thr ? xf[r] : 0.f) + (cc >= thr ? xb[r] : 0.f); }
        } else {
#pragma unroll
            for (int r = 0; r < 16; ++r) xf[r] += xb[r];
        }
#pragma unroll
        for (int sp = 0; sp < 2; ++sp) {
            u32x4 wv; wv.x = pk2(xf[8 * sp + 0], xf[8 * sp + 1]); wv.y = pk2(xf[8 * sp + 2], xf[8 * sp + 3]);
            wv.z = pk2(xf[8 * sp + 4], xf[8 * sp + 5]); wv.w = pk2(xf[8 * sp + 6], xf[8 * sp + 7]);
            pfr[st][sp] = __builtin_bit_cast(bf16x8, wv);
        }
    }
#pragma unroll
    for (int r = 0; r < 16; ++r) o[r] = 0.f;
    { const LAS unsigned char* vp = lb + GL_V + dvt * 4096 + ((t >> 4) & 1) * 32 + (t & 3) * 8 + (4 * hi + ((t & 15) >> 2)) * 64;
#pragma unroll
      for (int ks = 0; ks < 4; ++ks) {
          const s16x4 lo = vtr(vp + ks * 1024), hi4 = vtr(vp + ks * 1024 + 512);
          const bf16x8 vf = (bf16x8){lo[0], lo[1], lo[2], lo[3], hi4[0], hi4[1], hi4[2], hi4[3]};
          o = __builtin_amdgcn_mfma_f32_32x32x16_bf16(vf, pfr[ks >> 1][ks & 1], o, 0, 0, 0);
      } }
#pragma unroll
    for (int kd = 0; kd < 4; ++kd) {
        o = __builtin_amdgcn_mfma_f32_32x32x16_bf16(e.sf[kd], qfP[kd], o, 0, 0, 0);
        o = __builtin_amdgcn_mfma_f32_32x32x16_bf16(e.sb[kd], qbP[kd], o, 0, 0, 0);
    }
    float ssq = 0.f;
#pragma unroll
    for (int r = 0; r < 16; ++r) ssq += o[r] * o[r];
    { auto rr = __builtin_amdgcn_permlane32_swap(__float_as_uint(ssq), __float_as_uint(ssq), false, false); ssq = __uint_as_float(rr[0]) + __uint_as_float(rr[1]); }
    LAS float* red = (LAS float*)(lb + GL_RED);
    if (hi == 0) red[dvt * 64 + 32 * tt + c] = ssq;
}
__device__ __forceinline__ void g3_stage_c(const Frame& F, LAS unsigned char* lb, const G3Gate& e, const f32x16& o, int m0, int h, bf16* MIX) {
    const int w = F.wave, t = F.lane, c = t & 31, hi = t >> 5;
    const int dvt = w >> 1, tt = w & 1;
    LAS float* red = (LAS float*)(lb + GL_RED);
    const float tot = (red[32 * tt + c] + red[64 + 32 * tt + c]) + (red[128 + 32 * tt + c] + red[192 + 32 * tt + c]);
    const float rstd = 1.0f / sqrtf(tot * (1.0f / 128.0f) + EPS);
    LAS unsigned char* sh = lb + GL_STG + (32 * tt + c) * 144 + 32 * dvt + 4 * hi;
#pragma unroll
    for (int rg = 0; rg < 4; ++rg) {
        const u32x2 gw = e.gw[rg]; const f32x4 nw = e.nw[rg];
        const float g0 = bflo(gw.x), g1 = bfhi(gw.x), g2 = bflo(gw.y), g3 = bfhi(gw.y);
        const float rs = rstd * MIX_SCALE;
        *(LAS unsigned*)(sh + 8 * rg) = pk4_fp8(o[4 * rg] * rs * nw[0] * silu_f(g0), o[4 * rg + 1] * rs * nw[1] * silu_f(g1), o[4 * rg + 2] * rs * nw[2] * silu_f(g2), o[4 * rg + 3] * rs * nw[3] * silu_f(g3));
    }
    (void)m0; (void)h; (void)MIX;
}
__device__ __forceinline__ void g3_flush(const Frame& F, LAS unsigned char* lb, int m0, int h, bf16* MIX) {
    const int row = 8 * F.wave + (F.lane >> 3), pc = F.lane & 7;
    const u32x4 v = *(const LAS u32x4*)(lb + GL_STG + row * 144 + pc * 16);
    *(u32x4*)((unsigned char*)MIX + (size_t)(m0 + row) * D + h * 128 + pc * 16) = v;
}
constexpr int GL_SET = 63488;
static_assert(GL_STG + 64 * 144 <= GL_SET && GL_STG + NWAVES * 1024 <= GL_SET && 2 * GL_SET <= RING_BYTES && GL_SET % 1024 == 0, "G3 LDS images");
__device__ __forceinline__ void gla_g3(const Frame& F, const CAS Args* a, int l) {
    const bf16* P = (const bf16*)(F.ws + WS_P); bf16* MIX = (bf16*)(F.ws + WS_MIX);
    const bf16* US = (const bf16*)(F.ws + WS_SS);
    const int nunits = 1024;
    if (F.vcu >= nunits) return;
    GlaPre pre, nx; G3Early ec, en; bool par = false; int pm0 = 0, ph = 0;
    LAS unsigned char* const im0 = F.lds; LAS unsigned char* const im1 = F.lds + GL_SET;
    int m0, h, sf, n; bool latent;
    gla_unit_decode(F.vcu, m0, h, sf, n, latent);
    gla_pre_load(F, P, m0, h, true, pre);
    g3_early(F, US + ((size_t)sf * 128 + n) * 8192, US + ((size_t)(sf + 1) * 128 + n) * 8192, ec);
    if (F.vcu + F.G < nunits) { int m1, h1, s1, n1; bool l1; gla_unit_decode(F.vcu + F.G, m1, h1, s1, n1, l1); gla_pre_load(F, P, m1, h1, true, nx); }
    g3_stage_a(F, im0, pre);
    pre = nx;
    for (int u = F.vcu; u < nunits; u += F.G) {
        const bool has1 = u + F.G < nunits, has2 = u + 2 * F.G < nunits;
        gla_unit_decode(u, m0, h, sf, n, latent);
        G3Gate gt; g3_gate(F, a, l, P, m0, h, gt);
        if (has2) { int m2, h2, s2, n2; bool l2; gla_unit_decode(u + 2 * F.G, m2, h2, s2, n2, l2); gla_pre_load(F, P, m2, h2, true, nx); }
        LDS_BARRIER();
        if (u != F.vcu) g3_flush(F, par ? im0 : im1, pm0, ph, MIX);
        f32x16 o;
        g3_stage_b(F, par ? im1 : im0, ec, o);
        if (has1) { int m1, h1, s1, n1; bool l1; gla_unit_decode(u + F.G, m1, h1, s1, n1, l1);
            g3_early(F, US + ((size_t)s1 * 128 + n1) * 8192, US + ((size_t)(s1 + 1) * 128 + n1) * 8192, ec);
            g3_stage_a(F, par ? im0 : im1, pre); }
        LDS_BARRIER();
        g3_stage_c(F, par ? im1 : im0, gt, o, m0, h, MIX);
        pm0 = m0; ph = h;
        pre = nx; par = !par;
    }
    LDS_BARRIER();
    g3_flush(F, par ? im0 : im1, pm0, ph, MIX);
}
__device__ __forceinline__ void gla_g3_ctx(const Frame& F, const CAS Args* a) {
    const bf16* P = (const bf16*)(F.ws + WS_P); bf16* MIX = (bf16*)(F.ws + WS_MIX);
    const bf16* USC = (const bf16*)(F.ws + WS_SSC);
    unsigned* cnt = (unsigned*)(F.ws + WS_CTL) + CW_CTXG3;
    const int nb = F.G < 32 ? F.G : 32, first = F.G - nb;
    if ((int)blockIdx.x < first) return;
    for (int u = 1024 + ((int)blockIdx.x - first); u < 1056; u += nb) {
        int m0, h, sf, n; bool latent; gla_unit_decode(u, m0, h, sf, n, latent);
        GlaPre pre; gla_pre_load(F, P, m0, h, true, pre);
        gla_g3_unit(F, a, 0, P, m0, h, USC + ((size_t)sf * 4 + n) * 8192, USC + ((size_t)(sf + 1) * 4 + n) * 8192, MIX, pre, cnt);
    }
}

__device__ __forceinline__ void gla_naive(const Frame& F, const CAS Args* a, int l) {
    const bf16* P = (const bf16*)(F.ws + WS_P);
    bf16* OF = (bf16*)(F.ws + WS_GL);
    for (int w = F.gw; w < 2048; w += F.NGW) {
        const int dv = w & 127, dir = (w >> 7) & 1, h = (w >> 8) & 3, b = w >> 10;
        const int pcg = dir ? PC_GB : PC_GF;
        float S = 0.f;
        for (int step = 0; step < LC + SEQ; ++step) {
            int m;
            if (dir == 0) m = step < LC ? TL + b * LC + step : b * SEQ + (step - LC);
            else m = step < LC ? TL + b * LC + (LC - 1 - step) : b * SEQ + (SEQ - 1 - (step - LC));
            const bf16* row = P + (size_t)m * NIN;
            const float la = bf2f(row[pcg + h * 64 + F.lane]), kk = bf2f(row[PC_K + h * 64 + F.lane]), qq = bf2f(row[PC_Q + h * 64 + F.lane]), vv = bf2f(row[PC_V + h * 128 + dv]);
            S = __expf(la) * S + kk * vv;
            const float o = wave_sum(qq * S);
            if (F.lane == 0) OF[((size_t)dir * TT + m) * 512 + h * 128 + dv] = (bf16)f2bf(o);
        }
    }
}
__device__ __forceinline__ void gla_out_naive(const Frame& F, const CAS Args* a, int l) {
    const bf16* P = (const bf16*)(F.ws + WS_P); bf16* MIX = (bf16*)(F.ws + WS_MIX);
    const bf16* OF = (const bf16*)(F.ws + WS_GL);
    const int rows = (l == 0) ? TT : TL;
    for (int m = F.gw; m < rows; m += F.NGW) {
        const int c0 = 8 * F.lane;
        const u32x4 wa = *(const u32x4*)(OF + (size_t)m * 512 + c0), wb = *(const u32x4*)(OF + ((size_t)TT + m) * 512 + c0);
        float o[8] = {bflo(wa.x) + bflo(wb.x), bfhi(wa.x) + bfhi(wb.x), bflo(wa.y) + bflo(wb.y), bfhi(wa.y) + bfhi(wb.y), bflo(wa.z) + bflo(wb.z), bfhi(wa.z) + bfhi(wb.z), bflo(wa.w) + bflo(wb.w), bfhi(wa.w) + bfhi(wb.w)};
        float ss = 0.f;
#pragma unroll
        for (int i = 0; i < 8; ++i) ss += o[i] * o[i];
        ss = row16_sum(ss);
        const float rstd = 1.0f / sqrtf(ss * (1.0f / 128.0f) + EPS);
        const u32x4 wg = *(const u32x4*)(P + (size_t)m * NIN + PC_G + c0);
        const float g[8] = {bflo(wg.x), bfhi(wg.x), bflo(wg.y), bfhi(wg.y), bflo(wg.z), bfhi(wg.z), bflo(wg.w), bfhi(wg.w)};
        const f32x4 n0 = *(const f32x4*)(a->in[I_GLANORM] + l * 512 + c0), n1 = *(const f32x4*)(a->in[I_GLANORM] + l * 512 + c0 + 4);
        float r[8];
#pragma unroll
        for (int i = 0; i < 8; ++i) r[i] = o[i] * rstd * (i < 4 ? n0[i] : n1[i - 4]) * silu_f(g[i]);
        u32x4 w; w.x = pk2(r[0], r[1]); w.y = pk2(r[2], r[3]); w.z = pk2(r[4], r[5]); w.w = pk2(r[6], r[7]);
        *(u32x4*)(MIX + (size_t)m * D + c0) = w;
    }
}

constexpr int N2_W = 0, N2_H = 32768, N2_PART = 98304, N2_CNT = 132096, N2_RT = 20;
static_assert(N2_PART + 16384 <= RING_BYTES && N2_CNT + 256 + NWAVES * N2_RT * 16 <= LDS_BYTES && N2_CNT >= MISC_OFF + 64 + 128, "N2 LDS map");
__device__ __forceinline__ int n2_addr(int r, int k) { return r * 2048 + ((((k >> 3) ^ r) & 127) << 4) + (k & 7) * 2; }
__device__ __forceinline__ void n2_route_phase(const Frame& F, const CAS Args* a, int l, bool do_route, int cset) {
    unsigned char* ws = F.ws;
    const float* mod = (const float*)(ws + WS_MOD);
    bf16* H = (bf16*)(ws + WS_H);
    unsigned* cnt = (unsigned*)(ws + WS_CTL) + CW_CNT + cset * NE * CNT_STRIDE;
    unsigned* list = (unsigned*)(ws + WS_LIST); float* listw = (float*)(ws + WS_LISTW);
    LAS unsigned* lcnt = (LAS unsigned*)(F.lds + N2_CNT); LAS unsigned* lbase = lcnt + 16; LAS unsigned* rec = lcnt + 64;
    const int rows = (l == 0) ? TT : TL;
    const int t0 = F.gw;
    const int nch = (rows - F.vcu * NWAVES + F.NGW - 1) / F.NGW;
    f32x4 xc[4][4], xq[4][4];
    f32x4 ca[4], cb[4]; int vcur = -1;
    f32x4 pca[4], pcb[4]; int vpre = -1;
    auto coef_issue = [&](int v) {
#pragma unroll
        for (int j = 0; j < 4; ++j) { const int col = n1_col(1, F.lane, j); pca[j] = *(const f32x4*)(mod + (l * 3 + v) * 6144 + 4 * D + col); pcb[j] = *(const f32x4*)(mod + (l * 3 + v) * 6144 + 3 * D + col); }
        vpre = v; };
    if (t0 < rows) coef_issue(t0 < TL ? (t0 >> 13) : 2);
#pragma unroll
    for (int q = 0; q < 4; ++q) { const int m = t0 + q * F.NGW;
        if (m < rows) { const float* xr = (const float*)(ws + WS_XC) + (size_t)(m - TL) * D;
#pragma unroll
            for (int hh = 0; hh < 2; ++hh) { const int col = 512 * hh + 8 * F.lane;
                    if (m < TL) { const u32x4 w_ = *(const u32x4*)(F.xlb + (size_t)m * D + col); xq[q][2 * hh] = (f32x4){bflo(w_.x), bfhi(w_.x), bflo(w_.y), bfhi(w_.y)}; xq[q][2 * hh + 1] = (f32x4){bflo(w_.z), bfhi(w_.z), bflo(w_.w), bfhi(w_.w)}; }
                    else { xq[q][2 * hh] = *(const f32x4*)(xr + col); xq[q][2 * hh + 1] = *(const f32x4*)(xr + col + 4); } } } }
    {
        static_assert(D * NE == 8 * 4 * NWAVES * 64, "router weight staging");
        f32x4 wv[8];
#pragma unroll
        for (int q = 0; q < 8; ++q) wv[q] = *(const f32x4*)(a->in[I_WROUTER] + 4 * (F.tid + q * NWAVES * 64));
#pragma unroll
        for (int q = 0; q < 8; ++q) { const int i = 4 * (F.tid + q * NWAVES * 64), e = i & 15, k = i >> 4;
#pragma unroll
            for (int j = 0; j < 4; ++j) *(LAS bf16*)(F.lds + N2_W + n2_addr(e + j, k)) = (bf16)f2bf(wv[q][j]); }
    }
    if (F.tid < 32) lcnt[F.tid] = 0u;
    LDS_BARRIER();
    for (int c4 = 0; c4 < nch; c4 += 4) {
#pragma unroll
        for (int q = 0; q < 4; ++q)
#pragma unroll
            for (int j = 0; j < 4; ++j) xc[q][j] = xq[q][j];
        { const int m = t0 + c4 * F.NGW;
          if (m < rows) { const int v = m < TL ? (m >> 13) : 2;
              if (v != vcur && v == vpre) {
#pragma unroll
                  for (int j = 0; j < 4; ++j) { ca[j] = pca[j]; cb[j] = pcb[j]; }
                  vcur = v; } } }
#pragma unroll
        for (int q = 0; q < 4; ++q) { const int m = t0 + (c4 + 4 + q) * F.NGW;
            if (m < rows) { const float* xr = (const float*)(ws + WS_XC) + (size_t)(m - TL) * D;
#pragma unroll
                for (int hh = 0; hh < 2; ++hh) { const int col = 512 * hh + 8 * F.lane;
                    if (m < TL) { const u32x4 w_ = *(const u32x4*)(F.xlb + (size_t)m * D + col); xq[q][2 * hh] = (f32x4){bflo(w_.x), bfhi(w_.x), bflo(w_.y), bfhi(w_.y)}; xq[q][2 * hh + 1] = (f32x4){bflo(w_.z), bfhi(w_.z), bflo(w_.w), bfhi(w_.w)}; }
                    else { xq[q][2 * hh] = *(const f32x4*)(xr + col); xq[q][2 * hh + 1] = *(const f32x4*)(xr + col + 4); } } } }
        { const int mn = t0 + (c4 + 4) * F.NGW; if (mn < rows) { const int vn = mn < TL ? (mn >> 13) : 2; if (vn != vcur) coef_issue(vn); } }
#pragma unroll
        for (int q = 0; q < 4; ++q) {
            const int m = t0 + (c4 + q) * F.NGW, r = 8 * q + F.wave;
            if (m < rows) {
                const int v = m < TL ? (m >> 13) : 2;
                float ss = 0.f;
#pragma unroll
                for (int j = 0; j < 4; ++j) ss += (xc[q][j][0] * xc[q][j][0] + xc[q][j][1] * xc[q][j][1]) + (xc[q][j][2] * xc[q][j][2] + xc[q][j][3] * xc[q][j][3]);
                const float rstd = 1.0f / sqrtf(wave_sum(ss) * (1.0f / D) + EPS);
                if (v != vcur) {
#pragma unroll
                    for (int j = 0; j < 4; ++j) { const int col = n1_col(1, F.lane, j);
                        ca[j] = *(const f32x4*)(mod + (l * 3 + v) * 6144 + 4 * D + col); cb[j] = *(const f32x4*)(mod + (l * 3 + v) * 6144 + 3 * D + col); }
                    vcur = v;
                }
#pragma unroll
                for (int hh = 0; hh < 2; ++hh) {
                    const int col = 512 * hh + 8 * F.lane;
                    const f32x4 h0 = xc[q][2 * hh] * rstd * ca[2 * hh] + cb[2 * hh], h1 = xc[q][2 * hh + 1] * rstd * ca[2 * hh + 1] + cb[2 * hh + 1];
                    u32x2 o8; o8.x = pk4_fp8(h0[0], h0[1], h0[2], h0[3]); o8.y = pk4_fp8(h1[0], h1[1], h1[2], h1[3]);
                    *(u32x2*)((unsigned char*)H + (size_t)m * D + col) = o8;
                    u32x4 o; o.x = pk2(h0[0], h0[1]); o.y = pk2(h0[2], h0[3]); o.z = pk2(h1[0], h1[1]); o.w = pk2(h1[2], h1[3]);
                    *(LAS u32x4*)(F.lds + N2_H + n2_addr(r, col)) = o;
                }
            }
        }
        LDS_BARRIER();
        {
            const int rr = F.lane & 15, kg = F.lane >> 4;
            f32x4 acc0 = (f32x4){0.f, 0.f, 0.f, 0.f}, acc1 = acc0;
#pragma unroll
            for (int ks = 0; ks < 4; ++ks) {
                const int k = 128 * F.wave + 32 * ks + 8 * kg;
                const bf16x8 wf = *(const LAS bf16x8*)(F.lds + N2_W + n2_addr(rr, k));
                const bf16x8 h0 = *(const LAS bf16x8*)(F.lds + N2_H + n2_addr(rr, k)), h1 = *(const LAS bf16x8*)(F.lds + N2_H + n2_addr(16 + rr, k));
                acc0 = __builtin_amdgcn_mfma_f32_16x16x32_bf16(wf, h0, acc0, 0, 0, 0);
                acc1 = __builtin_amdgcn_mfma_f32_16x16x32_bf16(wf, h1, acc1, 0, 0, 0);
            }
            *(LAS f32x4*)(F.lds + N2_PART + ((F.wave * 32 + rr) * 16 + 4 * kg) * 4) = acc0;
            *(LAS f32x4*)(F.lds + N2_PART + ((F.wave * 32 + 16 + rr) * 16 + 4 * kg) * 4) = acc1;
        }
        LDS_BARRIER();
        if (F.wave < 2) {
            const int rr = F.lane & 15, eg = F.lane >> 4, row = 16 * F.wave + rr;
            f32x4 lg = (f32x4){0.f, 0.f, 0.f, 0.f};
#pragma unroll
            for (int w = 0; w < NWAVES; ++w) lg = lg + *(const LAS f32x4*)(F.lds + N2_PART + ((w * 32 + row) * 16 + 4 * eg) * 4);
            const f32x4 br = *(const f32x4*)(a->in[I_BROUTER] + 4 * eg);
            float sg[4], sb[4];
#pragma unroll
            for (int i = 0; i < 4; ++i) { sg[i] = 1.0f / (1.0f + __expf(-lg[i])); sb[i] = sg[i] + br[i]; }
            int i0 = 0, i1 = 0; float b0 = -1e30f, b1 = -1e30f, s0 = 0.f, s1 = 0.f;
#pragma unroll
            for (int i = 0; i < 4; ++i) { const float val = sb[i];
                if (val > b0) { b1 = b0; i1 = i0; s1 = s0; b0 = val; i0 = i; s0 = sg[i]; } else if (val > b1) { b1 = val; i1 = i; s1 = sg[i]; } }
            const float gs = b0 + b1;
            float best = gs; int bg = eg;
#pragma unroll
            for (int st = 16; st < 64; st <<= 1) {
                const float og = __builtin_bit_cast(float, __builtin_amdgcn_ds_bpermute((F.lane ^ st) << 2, __builtin_bit_cast(int, best)));
                const int oi = __builtin_amdgcn_ds_bpermute((F.lane ^ st) << 2, bg);
                if (og > best || (og == best && oi < bg)) { best = og; bg = oi; }
            }
            const int wv = row & 7, ch = c4 + (row >> 3);
            const int m = F.vcu * NWAVES + wv + ch * F.NGW;
            if (do_route && bg == eg && m < rows) {
                const int e0 = 4 * eg + i0, e1 = 4 * eg + i1; const float inv = 1.0f / (s0 + s1);
                if (ch < N2_RT) {
                    const int slot = wv * N2_RT + ch;
                    const unsigned l0 = atomicAdd((unsigned*)(lcnt + e0), 1u), l1 = atomicAdd((unsigned*)(lcnt + e1), 1u);
                    rec[slot * 4 + 0] = (unsigned)m; rec[slot * 4 + 1] = (unsigned)e0 | ((unsigned)e1 << 8) | (l0 << 16) | (l1 << 24);
                    rec[slot * 4 + 2] = __float_as_uint(s0 * inv); rec[slot * 4 + 3] = __float_as_uint(s1 * inv);
                } else {
                    const unsigned p0 = atomicAdd(cnt + e0 * CNT_STRIDE, 1u); list[(size_t)e0 * LISTCAP + p0] = (unsigned)m * 2u; listw[(size_t)e0 * LISTCAP + p0] = s0 * inv;
                    const unsigned p1 = atomicAdd(cnt + e1 * CNT_STRIDE, 1u); list[(size_t)e1 * LISTCAP + p1] = (unsigned)m * 2u + 1u; listw[(size_t)e1 * LISTCAP + p1] = s1 * inv;
                }
            }
        }
    }
    LDS_BARRIER();
    if (do_route) {
        if (F.tid < NE) { const unsigned c = lcnt[F.tid]; lbase[F.tid] = c ? atomicAdd(cnt + F.tid * CNT_STRIDE, c) : 0u; }
        LDS_BARRIER();
        for (int i = F.tid; i < NWAVES * N2_RT; i += NWAVES * 64) {
            const int wv = i / N2_RT, k = i % N2_RT;
            if (F.vcu * NWAVES + wv + k * F.NGW < rows) {
                const unsigned m = rec[i * 4], pk = rec[i * 4 + 1]; const unsigned e0 = pk & 255u, e1 = (pk >> 8) & 255u, l0 = (pk >> 16) & 255u, l1 = pk >> 24;
                const unsigned p0 = lbase[e0] + l0, p1 = lbase[e1] + l1;
                list[(size_t)e0 * LISTCAP + p0] = m * 2u; listw[(size_t)e0 * LISTCAP + p0] = __uint_as_float(rec[i * 4 + 2]);
                list[(size_t)e1 * LISTCAP + p1] = m * 2u + 1u; listw[(size_t)e1 * LISTCAP + p1] = __uint_as_float(rec[i * 4 + 3]);
            }
        }
    }
    LDS_BARRIER();
}

__device__ __forceinline__ void moe_setup(pg8::MoeOrder& S, const Frame& F, int cset, int nN, bool reuse = false) {
    unsigned* cnt = (unsigned*)(F.ws + WS_CTL) + CW_CNT + cset * NE * CNT_STRIDE;
    LAS int* tab = (LAS int*)(F.lds + MISC_OFF + 64);
    __syncthreads();
    if (F.wave == 0 && !reuse) {
        const int c = F.lane < NE ? (int)__hip_atomic_load(cnt + F.lane * CNT_STRIDE, __ATOMIC_RELAXED, __HIP_MEMORY_SCOPE_AGENT) : 0;
        const int run = (int)wave_scan_incl((float)((c + 255) >> 8));
        if (F.lane < NE) { tab[F.lane] = c; tab[16 + F.lane] = run; } }
    __syncthreads();
    S.tab = tab; S.nN = nN; S.nunits = __builtin_amdgcn_readfirstlane(tab[31]) * nN; S.G = F.G; S.c = (int)blockIdx.x;
    S.tdone = (unsigned*)(F.ws + WS_CTL) + CW_TDONE + cset * 160 * 16; S.role = 0;
    S.list = (const unsigned*)(F.ws + WS_LIST);
}
__device__ __forceinline__ void moe1_phase(const Frame& F, const CAS Args* a, int l, int cset) {
    pg8::MoeOrder S; moe_setup(S, F, cset, 4);
    S.A = (const char*)(F.ws + WS_H); S.Bt = (const char*)(F.ws + WS_WGU) + (size_t)l * NE * D * D; S.K = D / 2; S.bstride_e = (size_t)D * D; S.gather = true; S.role = 1;
    EpiGU E{(bf16*)(F.ws + WS_HMID)};
    pg8::gemm_phase<EpiGU, pg8::MoeOrder, true>(F.lds, F.tid, S, E, SC_W1, SC_ONE);
}
__device__ __forceinline__ void moe2_phase(const Frame& F, const CAS Args* a, int l, int cset) {
    pg8::MoeOrder S; moe_setup(S, F, cset, 4, true);
    S.A = (const char*)(F.ws + WS_HMID); S.Bt = (const char*)(F.ws + WS_WD) + (size_t)l * NE * D * DE; S.K = DE / 2; S.bstride_e = (size_t)D * DE; S.gather = false; S.role = 2; S.c = F.G - 1 - (int)blockIdx.x;
    EpiDown E; E.Y = (bf16*)(F.ws + WS_Y); E.list = (const unsigned*)(F.ws + WS_LIST); E.listw = (const float*)(F.ws + WS_LISTW); E.tab = S.tab;
    pg8::gemm_phase<EpiDown, pg8::MoeOrder, true>(F.lds, F.tid, S, E, SC_W2, SC_HMID);
    if (l == 0 && cset == 0) convert_moe_filler(F, a, 1, S.nunits, true);
}

struct FinCoef { f32x4 nw[4], g2[4]; int v; };
struct FinRaw { u32x2 xb[4]; int y0[4], y1[4]; };
__device__ __forceinline__ void final_load(const Frame& F, int m, FinRaw& r) {
    const unsigned char* Y0 = F.ws + WS_Y; const unsigned char* Y1 = Y0 + (size_t)TT * D;
    const bf16* xrow = F.xlb + (size_t)m * D;
#pragma unroll
    for (int j = 0; j < 4; ++j) { const int col = 4 * F.lane + 256 * j;
        r.xb[j] = __builtin_nontemporal_load((const u32x2*)(xrow + col)); r.y0[j] = __builtin_nontemporal_load((const int*)(Y0 + (size_t)m * D + col)); r.y1[j] = __builtin_nontemporal_load((const int*)(Y1 + (size_t)m * D + col)); }
}
__device__ __forceinline__ void final_unpack(const FinRaw& r, f32x4 (&x)[4], f32x4 (&y)[4]) {
#pragma unroll
    for (int j = 0; j < 4; ++j) {
        x[j] = (f32x4){bflo(r.xb[j].x), bfhi(r.xb[j].x), bflo(r.xb[j].y), bfhi(r.xb[j].y)};
        const f32x2 a0 = __builtin_amdgcn_cvt_pk_f32_fp8(r.y0[j], false), a1 = __builtin_amdgcn_cvt_pk_f32_fp8(r.y0[j], true), b0 = __builtin_amdgcn_cvt_pk_f32_fp8(r.y1[j], false), b1 = __builtin_amdgcn_cvt_pk_f32_fp8(r.y1[j], true);
        y[j] = (f32x4){a0[0] + b0[0], a0[1] + b0[1], a1[0] + b1[0], a1[1] + b1[1]};
    }
}
__device__ __forceinline__ void final_row(const Frame& F, int m, f32x4 (&x)[4], const f32x4 (&y)[4], const FinCoef& c) {
    float* xrow = F.out + (size_t)m * D; float ss = 0.f;
#pragma unroll
    for (int j = 0; j < 4; ++j) { x[j] = x[j] + c.g2[j] * y[j]; ss += (x[j][0] * x[j][0] + x[j][1] * x[j][1]) + (x[j][2] * x[j][2] + x[j][3] * x[j][3]); }
    const float rstd = 1.0f / sqrtf(wave_sum(ss) * (1.0f / D) + EPS);
#pragma unroll
    for (int j = 0; j < 4; ++j) { const int col = 4 * F.lane + 256 * j; __builtin_nontemporal_store(x[j] * rstd * c.nw[j], (f32x4*)(xrow + col)); }
}
__device__ __forceinline__ void final_phase(const Frame& F, const CAS Args* a) {
    const float* mod = (const float*)(F.ws + WS_MOD);
    FinCoef c; c.v = -1;
#pragma unroll
    for (int j = 0; j < 4; ++j) c.nw[j] = *(const f32x4*)(a->in[I_FNORM] + 4 * F.lane + 256 * j);
    FinRaw ra, rb, na, nb;
    if (F.gw < TL) final_load(F, F.gw, ra);
    if (F.gw + F.NGW < TL) final_load(F, F.gw + F.NGW, rb);
    for (int m = F.gw; m < TL; m += 2 * F.NGW) {
        const int m2 = m + F.NGW, m3 = m + 2 * F.NGW, m4 = m + 3 * F.NGW; const bool two = m2 < TL;
        if (m3 < TL) final_load(F, m3, na);
        if (m4 < TL) final_load(F, m4, nb);
        f32x4 x[4], y[4];
        { const int v = m >> 13; if (v != c.v) {
#pragma unroll
            for (int j = 0; j < 4; ++j) c.g2[j] = *(const f32x4*)(mod + (3 + v) * 6144 + 5 * D + 4 * F.lane + 256 * j) * (1.0f / Y_SCALE);
            c.v = v; } }
        final_unpack(ra, x, y); final_row(F, m, x, y, c);
        if (two) { const int v = m2 >> 13; if (v != c.v) {
#pragma unroll
            for (int j = 0; j < 4; ++j) c.g2[j] = *(const f32x4*)(mod + (3 + v) * 6144 + 5 * D + 4 * F.lane + 256 * j) * (1.0f / Y_SCALE);
            c.v = v; }
            final_unpack(rb, x, y); final_row(F, m2, x, y, c); }
        ra = na; rb = nb;
    }
}

#ifndef NPASS
#define NPASS 1
#endif
#ifndef PROBE_PH
#define PROBE_PH -1
#endif
#ifndef PROBE_R
#define PROBE_R 3
#endif
#ifndef PROBE_UPTO
#define PROBE_UPTO -1
#endif
#ifndef PROBE_ABL
#define PROBE_ABL 0
#endif
constexpr int PH_PER_LAYER = 8;
constexpr int N_PHASES = 1 + DEPTH * PH_PER_LAYER + 1;

template <int ph0>
__device__ __forceinline__ void do_phase(Frame& F, XcdBarrier& bar, LAS unsigned char* lds, int lo, int hi) {
    constexpr int ph = ph0 % N_PHASES, pass = ph0 / N_PHASES;
    if (!(lo <= ph && ph < hi)) return;
    if (pass == 1 && (PROBE_UPTO >= 0 ? ph >= PROBE_UPTO : ph != PROBE_PH)) return;
    const CAS Args* ap;
        { int l_; asm volatile("v_mbcnt_lo_u32_b32 %0, -1, 0\n\tv_mbcnt_hi_u32_b32 %0, -1, %0" : "=v"(l_)); F.lane = l_; F.tid = F.wave * 64 + l_; ap = (const CAS Args*)__builtin_amdgcn_kernarg_segment_ptr(); asm volatile("" : "+s"(ap)); F.ws = ap->ws; F.out = (pass == 1) ? (float*)(ap->ws + WS_P) : ap->out; F.xlb = (bf16*)(ap->ws + ((pass == 1) ? WS_P + 64 * MiB : WS_XLB));
          LAS unsigned char* lb_ = (LAS unsigned char*)lds; asm volatile("" : "+s"(lb_)); __builtin_assume((((unsigned)(__UINTPTR_TYPE__)lb_) & 1023u) == 0u); F.lds = lb_;
          bar.bar = (unsigned*)(F.ws + WS_CTL) + CW_BAR; bar.st = (volatile LAS unsigned*)(F.lds + MISC_OFF) + 8; }
        if (ph == 0) { if (PH_ON(10)) REP(10, true) p0_prologue(F, ap); }
        else if (ph == N_PHASES - 1) { if (PH_ON(11)) REP(11, false) final_phase(F, ap); }
        else {
            constexpr int l = (ph - 1) / PH_PER_LAYER, s = (ph - 1) % PH_PER_LAYER;
            unsigned char* ws = F.ws;
            if (s == 0) { if (PH_ON(0)) REP(0, l == 0) { n1_phase(F, ap, l); if (l == 0) p0_convert(F, ap); } }
            else if (s == 1 && PH_ON(1)) REP(1, true) {
                pg8::DenseOrder S; S.init(ws + WS_H, ws + WS_WIN + (size_t)l * NIN * D, TT, NIN, D / 2, F.G, (int)blockIdx.x);
                EpiIn E{(bf16*)(ws + WS_P), ap->in[I_BIASF] + l * 256, ap->in[I_BIASB] + l * 256, (const float*)(ws + WS_ROPE), (const float*)(ws + WS_ROPE) + 2048, (pass == 1) ? PROBE_ABL : 0};
                pg8::gemm_phase<EpiIn, pg8::DenseOrder, true>(F.lds, F.tid, S, E, SC_W1, SC_ONE, GIN_STAG);
            }
            else if (s == 2) { constexpr int abl = (pass == 1) ? PROBE_ABL : 0; if (PH_ON(2) && abl != 5) REP(2, true) swa_flash(F, ap, l, abl); if (PH_ON(12) && abl != 6) REP(12, true) gla_g1(F, l); }
            else if (s == 3) { if (PH_ON(13)) REP(13, true) gla_scan(F); }
            else if (s == 4) { if (PH_ON(3)) REP(3, true) gla_g3(F, ap, l); }
            else if (s == 5 && PH_ON(4)) REP(4, l == 0) {
                if (l == 0) gla_g3_ctx(F, ap);
                pg8::DenseOrder S; S.init(ws + WS_MIX, ws + WS_WOUT + (size_t)l * D * D, l == 0 ? TT : TL, D, D / 2, F.G, (int)blockIdx.x);
                if (l == 0) { S.dep = (unsigned*)(ws + WS_CTL) + CW_CTXG3; S.dep_need = 32u * NWAVES * (pass + 1); S.dep_pm = 64; }
                EpiOut<(l > 0)> E{ap->in[I_X], l == 0 ? ap->in[I_CTX] : (const float*)(ws + WS_XC), F.xlb, (float*)(ws + WS_XC), (const float*)(ws + WS_MOD) + l * 3 * 6144};
                pg8::gemm_phase<EpiOut<(l > 0)>, pg8::DenseOrder, true>(F.lds, F.tid, S, E, SC_W1, SC_HMID);
                if (l == 0 && pass == 0) convert_moe_filler(F, ap, 0, S.nwg);
            }
            else if (s == 6) { if (PH_ON(5)) REP(5, true) n2_route_phase(F, ap, l, rep_ == 0 || pass == 1, l + 2 * pass); }
            else { constexpr int abl = (pass == 1) ? PROBE_ABL : 0; if (PH_ON(6)) { constexpr int cs_ = (pass == 1 && PROBE_UPTO < 0) ? l : l + 2 * pass; if (abl != 2) moe1_phase(F, ap, l, cs_); if (abl != 1) moe2_phase(F, ap, l, cs_); } }
        }
        if (ph0 + 1 < NPASS * N_PHASES) for (int rb_ = 0; rb_ < (REPEAT_S == 20 ? REPEAT_N : 1); ++rb_) xcd_barrier(bar, F.tid);
}
template <int... I>
__device__ __forceinline__ void run_all(Frame& F, XcdBarrier& bar, LAS unsigned char* lds, int lo, int hi, std::integer_sequence<int, I...>) { (do_phase<I>(F, bar, lds, lo, hi), ...); }

#ifdef VGPR_CAP
__attribute__((amdgpu_num_vgpr(VGPR_CAP)))
#endif
__global__ void __launch_bounds__(NWAVES * 64, 2) mk_fwd(Args args) {
    extern __shared__ __attribute__((aligned(16))) unsigned char lds[];
    Frame F;
    F.lds = (LAS unsigned char*)lds;
    F.tid = threadIdx.x; F.lane = F.tid & 63; F.wave = __builtin_amdgcn_readfirstlane(F.tid >> 6);
    F.G = gridDim.x; { const int bx = blockIdx.x; F.vcu = (F.G % 8 == 0) ? (bx % 8) * (F.G / 8) + bx / 8 : bx; }
    F.gw = F.vcu * NWAVES + F.wave; F.NGW = F.G * NWAVES;
    const CAS Args* ap = (const CAS Args*)__builtin_amdgcn_kernarg_segment_ptr();
    F.ws = ap->ws; F.out = ap->out; F.xlb = (bf16*)(ap->ws + WS_XLB);
    volatile LAS unsigned* MISC = (volatile LAS unsigned*)(F.lds + MISC_OFF);
    for (int u = F.tid; u < (LDS_BYTES - LDSCTL_OFF) / 4; u += NWAVES * 64) ((LAS unsigned*)(F.lds + LDSCTL_OFF))[u] = 0u;
    __syncthreads();
    XcdBarrier bar; bar.bar = (unsigned*)(F.ws + WS_CTL) + CW_BAR; bar.x = 0; bar.st = nullptr;
    const bool fused = (ap->ph_hi - ap->ph_lo) > 1;
    if (fused) bar = xcd_barrier_post((unsigned*)(F.ws + WS_CTL) + CW_BAR, MISC + 8);
    const int lo = ap->ph_lo, hi = ap->ph_hi;
    run_all(F, bar, (LAS unsigned char*)lds, lo, hi, std::make_integer_sequence<int, NPASS * N_PHASES>{});
}

extern "C" void kernel_launch(void* const* d_in, const int* in_sizes, int n_in, void* d_out, int out_size, void* d_ws, size_t ws_size, hipStream_t stream) {
    static int grid = 0;
    if (grid == 0) {
        if (n_in != 22 || out_size != TL * D || ws_size < WS_END) { fprintf(stderr, "kernel_launch: unexpected shapes (n_in %d out %d ws %zu)\n", n_in, out_size, ws_size); grid = -1; return; }
        int dev = 0, cus = 0, per_cu = 0;
        if (hipGetDevice(&dev) != hipSuccess || hipDeviceGetAttribute(&cus, hipDeviceAttributeMultiprocessorCount, dev) != hipSuccess) { grid = -1; return; }
        if (hipFuncSetAttribute((const void*)mk_fwd, hipFuncAttributeMaxDynamicSharedMemorySize, LDS_BYTES) != hipSuccess) { fprintf(stderr, "kernel_launch: hipFuncSetAttribute failed\n"); grid = -1; return; }
        if (hipOccupancyMaxActiveBlocksPerMultiprocessor(&per_cu, (const void*)mk_fwd, NWAVES * 64, LDS_BYTES) != hipSuccess || per_cu < 1) fprintf(stderr, "kernel_launch: occupancy query says %d\n", per_cu);
        (void)hipGetLastError();
        grid = cus;
    }
    if (grid < 0) return;
    (void)hipMemsetAsync((char*)d_ws + WS_CTL, 0, CTL_ZERO_BYTES, stream);
    Args a{};
    for (int i = 0; i < 22; ++i) a.in[i] = (const float*)d_in[i];
    a.out = (float*)d_out; a.ws = (unsigned char*)d_ws; a.li = 0; a.pad = 0;
#if MK_N_LAUNCHES == 1
    a.ph_lo = 0; a.ph_hi = N_PHASES;
    hipLaunchKernelGGL(mk_fwd, dim3(grid), dim3(NWAVES * 64), LDS_BYTES, stream, a);
#else
    for (int ph = 0; ph < N_PHASES; ++ph) { a.ph_lo = ph; a.ph_hi = ph + 1; hipLaunchKernelGGL(mk_fwd, dim3(grid), dim3(NWAVES * 64), LDS_BYTES, stream, a); }
#endif
}
```
